# Optimizing an MI355X kernel written in HIP

```python
import jax, jax.numpy as jnp
from jax import lax
import numpy as np

D_MODEL = 1024
BATCH = 16
SEQ = 256
DEPTH = 1
DEC_BATCH = 8
DEC_SEQ = 2048
PAST_LEN = 512

GRID_W = 64
EPS = 1e-6
MLA_HEADS = 8
MLA_NOPE = 64
MLA_ROPE = 32
MLA_V = 64
Q_LORA = 256
KV_LORA = 128
ROPE_BASE = 10000.0
ATTN_BLOCK = 128
RET_HEADS = 4
RET_DK = 128
RET_DV = 128
RET_CHUNK = 64
MIX_A = MLA_HEADS * MLA_V
MIX_B = RET_HEADS * RET_DV
IN_SIZES = (Q_LORA, KV_LORA, MLA_ROPE, RET_HEADS * RET_DK, RET_HEADS * RET_DK, MIX_B, MIX_B, D_MODEL, D_MODEL)
D_IN = Q_LORA + KV_LORA + MLA_ROPE + 2 * RET_HEADS * RET_DK + 2 * MIX_B + 2 * D_MODEL
PEER_HEADS = 8
PEER_DQ = 256
N_KEYS = 128
N_EXPERTS = N_KEYS * N_KEYS
PEER_TOPK = 16
PEER_BLOCK = 128

kernel_name = 'hybrid_mla_retention_peer_diffusion_step'


def _split(a, sizes):
    out = []
    start = 0
    for s in sizes:
        out.append(a[..., start:start + s])
        start += s
    return out


def _rmsnorm(x, g):
    xf = x.astype(jnp.float32)
    xf = xf * lax.rsqrt(jnp.mean(xf * xf, axis=-1, keepdims=True) + EPS)
    return xf.astype(x.dtype) * g


def _modulate(h, shift, scale):
    return h * (1 + scale) + shift


def _rope_2d(x):
    T = x.shape[1]
    rows = T // GRID_W
    row = jnp.repeat(jnp.arange(rows, dtype=jnp.float32), GRID_W)
    col = jnp.tile(jnp.arange(GRID_W, dtype=jnp.float32), rows)
    nf = MLA_ROPE // 4
    freqs = jnp.power(ROPE_BASE, -jnp.arange(nf, dtype=jnp.float32) / nf)
    ang = jnp.concatenate([row[:, None] * freqs, col[:, None] * freqs], axis=-1)
    ang = ang.reshape((T,) + (1,) * (x.ndim - 3) + (MLA_ROPE // 2,))
    cos = jnp.cos(ang).astype(x.dtype)
    sin = jnp.sin(ang).astype(x.dtype)
    x1, x2 = x[..., :MLA_ROPE // 2], x[..., MLA_ROPE // 2:]
    return jnp.concatenate([x1 * cos - x2 * sin, x1 * sin + x2 * cos], axis=-1)


def _project(h, w_in, q_norm, kv_norm, w_uq):
    B, T, _ = h.shape
    cq, ckv, kr, rq, rk, rv, rg, ga, gb = _split(h @ w_in, IN_SIZES)
    q = (_rmsnorm(cq, q_norm) @ w_uq).reshape(B, T, MLA_HEADS, MLA_NOPE + MLA_ROPE)
    qn, qr = q[..., :MLA_NOPE], q[..., MLA_NOPE:]
    ckv = _rmsnorm(ckv, kv_norm)
    rq = rq.reshape(B, T, RET_HEADS, RET_DK)
    rk = rk.reshape(B, T, RET_HEADS, RET_DK) * (RET_DK ** -0.5)
    rv = rv.reshape(B, T, RET_HEADS, RET_DV)
    return qn, qr, ckv, kr, rq, rk, rv, rg, ga, gb


def _expand_kv(ckv, w_ukv):
    B, T, _ = ckv.shape
    kv = (ckv @ w_ukv).reshape(B, T, MLA_HEADS, MLA_NOPE + MLA_V)
    return kv[..., :MLA_NOPE], kv[..., MLA_NOPE:]


def _mla_attend(q_nope, q_rope, k_nope, k_rope, v):
    B, Tq, H, _ = q_nope.shape
    nb = Tq // ATTN_BLOCK
    scale = (MLA_NOPE + MLA_ROPE) ** -0.5

    def block(qs):
        qn, qr = qs
        s = jnp.einsum('bqhd,bkhd->bhqk', qn, k_nope) + jnp.einsum('bqhr,bkr->bhqk', qr, k_rope)
        p = jax.nn.softmax(s.astype(jnp.float32) * scale, axis=-1).astype(v.dtype)
        return jnp.einsum('bhqk,bkhd->bqhd', p, v)

    qb = lambda a: jnp.moveaxis(a.reshape(B, nb, ATTN_BLOCK, H, a.shape[-1]), 1, 0)
    out = lax.map(block, (qb(q_nope), qb(q_rope)))
    return jnp.moveaxis(out, 0, 1).reshape(B, Tq, H * MLA_V)


def _retention_dir(q, k, v, decay_logit, s0):
    B, T, H, dk = q.shape
    dv = v.shape[-1]
    C = RET_CHUNK
    n = T // C
    lg = jax.nn.log_sigmoid(decay_logit.astype(jnp.float32))[:, None]
    idx = jnp.arange(C, dtype=jnp.float32)
    diff = idx[:, None] - idx[None, :]
    dmat = jnp.where(diff >= 0, jnp.exp(lg[:, :, None] * jnp.maximum(diff, 0.0)), 0.0)
    q_dec = jnp.exp(lg * (idx + 1.0)).T
    k_dec = jnp.exp(lg * (C - 1.0 - idx)).T
    c_dec = jnp.exp(lg[:, 0] * C)
    chunks = lambda a: jnp.moveaxis(a.astype(jnp.float32).reshape(B, n, C, H, a.shape[-1]), 1, 0)

    def step(S, inp):
        qc, kc, vc = inp
        sc = jnp.einsum('bihd,bjhd->bhij', qc, kc) * dmat
        intra = jnp.einsum('bhij,bjhe->bihe', sc, vc)
        cross = jnp.einsum('bihd,bhde->bihe', qc * q_dec[None, :, :, None], S)
        S_new = S * c_dec[None, :, None, None] + jnp.einsum('bjhd,bjhe->bhde', kc * k_dec[None, :, :, None], vc)
        return S_new, intra + cross

    S_fin, out = lax.scan(step, s0.astype(jnp.float32), (chunks(q), chunks(k), chunks(v)))
    out = jnp.moveaxis(out, 0, 1).reshape(B, T, H, dv)
    return out, S_fin.astype(s0.dtype)


def _retention(rq, rk, rv, rg, logit_f, logit_b, s0_f, s0_b, gn):
    y_f, s_f = _retention_dir(rq, rk, rv, logit_f, s0_f)
    y_b, s_b = _retention_dir(jnp.flip(rq, 1), jnp.flip(rk, 1), jnp.flip(rv, 1), logit_b, s0_b)
    y = y_f + jnp.flip(y_b, 1)
    mu = jnp.mean(y, axis=-1, keepdims=True)
    var = jnp.mean(jnp.square(y - mu), axis=-1, keepdims=True)
    y = ((y - mu) * lax.rsqrt(var + EPS)).astype(rv.dtype)
    B, T = y.shape[0], y.shape[1]
    y = y.reshape(B, T, MIX_B) * gn
    return jax.nn.silu(rg) * y, s_f, s_b


def _merge(attn, ret, ga, gb, w_up_a, w_up_b, w_o):
    return (jax.nn.sigmoid(ga) * (attn @ w_up_a) + jax.nn.sigmoid(gb) * (ret @ w_up_b)) @ w_o


def _peer(h, wq, keys1, keys2, u_tab, v_tab):
    B, T, D = h.shape
    xb_all = h.reshape(-1, PEER_BLOCK, D)

    def block(xb):
        q = (xb @ wq).reshape(PEER_BLOCK, PEER_HEADS, PEER_DQ)
        q1, q2 = q[..., :PEER_DQ // 2], q[..., PEER_DQ // 2:]
        s1 = jnp.einsum('nhd,hkd->nhk', q1, keys1).astype(jnp.float32)
        s2 = jnp.einsum('nhd,hkd->nhk', q2, keys2).astype(jnp.float32)
        v1, i1 = lax.top_k(s1, PEER_TOPK)
        v2, i2 = lax.top_k(s2, PEER_TOPK)
        cand = (v1[..., :, None] + v2[..., None, :]).reshape(PEER_BLOCK, PEER_HEADS, PEER_TOPK * PEER_TOPK)
        vals, ci = lax.top_k(cand, PEER_TOPK)
        e = jnp.take_along_axis(i1, ci // PEER_TOPK, axis=-1) * N_KEYS + jnp.take_along_axis(i2, ci % PEER_TOPK, axis=-1)
        g = jax.nn.softmax(vals, axis=-1).astype(xb.dtype)
        a = jax.nn.gelu(jnp.einsum('nd,nhkd->nhk', xb, u_tab[e]))
        return jnp.einsum('nhk,nhkd->nd', g * a, v_tab[e])

    return lax.map(block, xb_all).reshape(B, T, D)


def setup_inputs(seed: int = 0) -> dict:
    key = jax.random.key(seed)
    ks = iter(jax.random.split(key, 40))
    nrm = lambda shape, s: s * jax.random.normal(next(ks), shape, jnp.float32)
    ones = lambda shape: 1.0 + nrm(shape, 0.01)
    base_logit = jnp.log(jnp.exp2(5.0 + jnp.arange(RET_HEADS, dtype=jnp.float32)) - 1.0)
    return {
        'x_prompt': nrm((BATCH, SEQ, D_MODEL), 1.0),
        'x_sample': nrm((DEC_BATCH, DEC_SEQ, D_MODEL), 1.0),
        'c': nrm((DEC_BATCH, D_MODEL), 1.0),
        'cache_ckv': nrm((DEC_BATCH, DEPTH, PAST_LEN, KV_LORA), 1.0),
        'cache_krope': nrm((DEC_BATCH, DEPTH, PAST_LEN, MLA_ROPE), 1.0),
        'state_ret_fwd': nrm((DEC_BATCH, DEPTH, RET_HEADS, RET_DK, RET_DV), 0.5),
        'state_ret_bwd': nrm((DEC_BATCH, DEPTH, RET_HEADS, RET_DK, RET_DV), 0.5),
        'c_ctx': nrm((D_MODEL,), 1.0),
        'w_mod': nrm((DEPTH, D_MODEL, 6 * D_MODEL), 0.5 * D_MODEL ** -0.5),
        'b_mod': nrm((DEPTH, 6 * D_MODEL), 0.01),
        'norm_mix': ones((DEPTH, D_MODEL)),
        'norm_ffn': ones((DEPTH, D_MODEL)),
        'norm_final': ones((D_MODEL,)),
        'w_in': nrm((DEPTH, D_MODEL, D_IN), D_MODEL ** -0.5),
        'q_norm': ones((DEPTH, Q_LORA)),
        'kv_norm': ones((DEPTH, KV_LORA)),
        'w_uq': nrm((DEPTH, Q_LORA, MLA_HEADS * (MLA_NOPE + MLA_ROPE)), Q_LORA ** -0.5),
        'w_ukv': nrm((DEPTH, KV_LORA, MLA_HEADS * (MLA_NOPE + MLA_V)), KV_LORA ** -0.5),
        'ret_logit_fwd': base_logit[None, :] + nrm((DEPTH, RET_HEADS), 0.01),
        'ret_logit_bwd': base_logit[None, :] + nrm((DEPTH, RET_HEADS), 0.01),
        'ret_gn': ones((DEPTH, MIX_B)),
        'w_up_a': nrm((DEPTH, MIX_A, D_MODEL), MIX_A ** -0.5),
        'w_up_b': nrm((DEPTH, MIX_B, D_MODEL), MIX_B ** -0.5),
        'w_o': nrm((DEPTH, D_MODEL, D_MODEL), D_MODEL ** -0.5),
        'peer_wq': nrm((DEPTH, D_MODEL, PEER_HEADS * PEER_DQ), D_MODEL ** -0.5),
        'peer_keys1': nrm((DEPTH, PEER_HEADS, N_KEYS, PEER_DQ // 2), (PEER_DQ // 2) ** -0.5),
        'peer_keys2': nrm((DEPTH, PEER_HEADS, N_KEYS, PEER_DQ // 2), (PEER_DQ // 2) ** -0.5),
        'peer_u': nrm((DEPTH, N_EXPERTS, D_MODEL), D_MODEL ** -0.5),
        'peer_v': nrm((DEPTH, N_EXPERTS, D_MODEL), 0.1),
    }


def reference(x_prompt, x_sample, c, cache_ckv, cache_krope, state_ret_fwd, state_ret_bwd, c_ctx,
              w_mod, b_mod, norm_mix, norm_ffn, norm_final, w_in, q_norm, kv_norm, w_uq, w_ukv,
              ret_logit_fwd, ret_logit_bwd, ret_gn, w_up_a, w_up_b, w_o,
              peer_wq, peer_keys1, peer_keys2, peer_u, peer_v):
    xp, xs = x_prompt, x_sample
    new_ckv, new_kr, new_sf, new_sb = [], [], [], []
    for l in range(DEPTH):
        mod_c = jax.nn.silu(c_ctx) @ w_mod[l] + b_mod[l]
        mod_s = (jax.nn.silu(c) @ w_mod[l] + b_mod[l])[:, None, :]
        sh1c, sc1c, g1c, sh2c, sc2c, g2c = _split(mod_c, (D_MODEL,) * 6)
        sh1s, sc1s, g1s, sh2s, sc2s, g2s = _split(mod_s, (D_MODEL,) * 6)

        h = _modulate(_rmsnorm(xp, norm_mix[l]), sh1c, sc1c)
        qn, qr, ckv, kr, rq, rk, rv, rg, ga, gb = _project(h, w_in[l], q_norm[l], kv_norm[l], w_uq[l])
        kn, v = _expand_kv(ckv, w_ukv[l])
        attn = _mla_attend(qn, qr, kn, kr, v)
        zero = jnp.zeros((xp.shape[0], RET_HEADS, RET_DK, RET_DV), xp.dtype)
        ret, sf, sb = _retention(rq, rk, rv, rg, ret_logit_fwd[l], ret_logit_bwd[l], zero, zero, ret_gn[l])
        xp = xp + g1c * _merge(attn, ret, ga, gb, w_up_a[l], w_up_b[l], w_o[l])
        h = _modulate(_rmsnorm(xp, norm_ffn[l]), sh2c, sc2c)
        xp = xp + g2c * _peer(h, peer_wq[l], peer_keys1[l], peer_keys2[l], peer_u[l], peer_v[l])
        new_ckv.append(ckv)
        new_kr.append(kr)
        new_sf.append(sf)
        new_sb.append(sb)

        h = _modulate(_rmsnorm(xs, norm_mix[l]), sh1s, sc1s)
        qn, qr, ckv_s, kr_s, rq, rk, rv, rg, ga, gb = _project(h, w_in[l], q_norm[l], kv_norm[l], w_uq[l])
        qr = _rope_2d(qr)
        kr_s = _rope_2d(kr_s)
        ckv_all = jnp.concatenate([ckv_s, cache_ckv[:, l]], axis=1)
        kr_all = jnp.concatenate([kr_s, cache_krope[:, l]], axis=1)
        kn, v = _expand_kv(ckv_all, w_ukv[l])
        attn = _mla_attend(qn, qr, kn, kr_all, v)
        ret, _, _ = _retention(rq, rk, rv, rg, ret_logit_fwd[l], ret_logit_bwd[l],
                               state_ret_fwd[:, l], state_ret_bwd[:, l], ret_gn[l])
        xs = xs + g1s * _merge(attn, ret, ga, gb, w_up_a[l], w_up_b[l], w_o[l])
        h = _modulate(_rmsnorm(xs, norm_ffn[l]), sh2s, sc2s)
        xs = xs + g2s * _peer(h, peer_wq[l], peer_keys1[l], peer_keys2[l], peer_u[l], peer_v[l])

    y_prompt = _rmsnorm(xp, norm_final)
    y_sample = _rmsnorm(xs, norm_final)
    return (y_prompt, y_sample, jnp.stack(new_ckv, axis=1), jnp.stack(new_kr, axis=1),
            jnp.stack(new_sf, axis=1), jnp.stack(new_sb, axis=1))
```

```cpp
#include <hip/hip_runtime.h>
#include <hip/hip_cooperative_groups.h>
#include <cstdio>
namespace cg = cooperative_groups;

#define DI __device__ __forceinline__
typedef unsigned short bf16_t;
using bf16x8 = __attribute__((ext_vector_type(8))) short;
using f32x4 = __attribute__((ext_vector_type(4))) float;
using u32x4 = __attribute__((ext_vector_type(4))) unsigned;
using u32x2 = __attribute__((ext_vector_type(2))) unsigned;

#ifndef N_LAUNCH_SPLIT
#define N_LAUNCH_SPLIT 0
#endif

constexpr int NTOK = 20480, NPT = 4096, DM = 1024;
constexpr int NPHASE = 13;
constexpr size_t MiB = 1u << 20;
constexpr size_t OFF_WINT = 0, OFF_WUQT = 9 * MiB, OFF_WUKVT = 9 * MiB + 512 * 1024, OFF_WUPAT = 10 * MiB,
                 OFF_WUPBT = 11 * MiB, OFF_WOT = 12 * MiB, OFF_WCT = 14 * MiB, OFF_WPQB = 18 * MiB,
                 OFF_KEYSB = 22 * MiB, OFF_MOD = 22 * MiB + 512 * 1024, A0 = 24 * MiB;
constexpr size_t OFF_H1 = A0 + 0, OFF_CQ = A0 + 40 * MiB, OFF_CKVRAW = A0 + 50 * MiB, OFF_KRRAW = A0 + 60 * MiB,
                 OFF_RQ = A0 + 63 * MiB, OFF_RK = A0 + 83 * MiB, OFF_KT = A0 + 103 * MiB, OFF_VT = A0 + 123 * MiB,
                 OFF_SRG = A0 + 143 * MiB, OFF_CKVALL = A0 + 163 * MiB, OFF_KRALL = A0 + 169 * MiB,
                 OFF_UF = A0 + 171 * MiB, OFF_UB = A0 + 187 * MiB,
                 OFF_SF = A0 + 0, OFF_SB = A0 + 8 * MiB, OFF_RET = A0 + 16 * MiB,
                 OFF_Q = A0 + 63 * MiB, OFF_KN = A0 + 93 * MiB, OFF_VTA = A0 + 117 * MiB, OFF_ATTN = A0 + 141 * MiB,
                 OFF_M = A0 + 163 * MiB,
                 OFF_H2 = A0 + 0, OFF_TABU = A0 + 40 * MiB, OFF_TABV = A0 + 72 * MiB, OFF_SCORES = A0 + 104 * MiB;
constexpr size_t OUT_CKV = 20971520, OUT_KR = 21495808, OUT_SF = 21626880, OUT_SB = 22675456;
constexpr int NKV = 24576;
constexpr int SMEM_BYTES = 36864;

struct Params {
  const float *x_prompt, *x_sample, *c, *cache_ckv, *cache_krope, *st_f, *st_b, *c_ctx, *w_mod, *b_mod, *norm_mix,
      *norm_ffn, *norm_final, *w_in, *q_norm, *kv_norm, *w_uq, *w_ukv, *lg_f, *lg_b, *ret_gn, *w_up_a, *w_up_b, *w_o,
      *peer_wq, *keys1, *keys2, *peer_u, *peer_v;
  float* out;
  char* ws;
};

DI unsigned f2bf(float x) {
  unsigned u = __float_as_uint(x);
  u += 0x7fffu + ((u >> 16) & 1u);
  return u >> 16;
}
DI float bf2f(unsigned b) { return __uint_as_float(b << 16); }
DI unsigned pack2(float a, float b) { return f2bf(a) | (f2bf(b) << 16); }
DI float bflo(unsigned u) { return __uint_as_float(u << 16); }
DI float bfhi(unsigned u) { return __uint_as_float(u & 0xffff0000u); }
DI float wsum(float v) {
#pragma unroll
  for (int o = 32; o > 0; o >>= 1) v += __shfl_xor(v, o);
  return v;
}
DI float sigmoidf_(float x) { return 1.f / (1.f + __expf(-x)); }
DI float siluf_(float x) { return x / (1.f + __expf(-x)); }
DI float geluf_(float x) { return 0.5f * x * (1.f + tanhf(0.7978845608028654f * (x + 0.044715f * x * x * x))); }
DI const float* xrow(const Params& p, int tok) {
  return tok < NPT ? p.x_prompt + (size_t)tok * DM : p.x_sample + (size_t)(tok - NPT) * DM;
}
DI int modidx(int tok) { return tok < NPT ? 0 : 1 + ((tok - NPT) >> 11); }
DI int kvrow(int tok) {
  if (tok < NPT) return tok;
  int t = tok - NPT;
  return NPT + (t >> 11) * 2560 + (t & 2047);
}
DI void st_bf16x16(bf16_t* dst, const float (&v)[16]) {
  u32x4 a, b;
  a[0] = pack2(v[0], v[1]); a[1] = pack2(v[2], v[3]); a[2] = pack2(v[4], v[5]); a[3] = pack2(v[6], v[7]);
  b[0] = pack2(v[8], v[9]); b[1] = pack2(v[10], v[11]); b[2] = pack2(v[12], v[13]); b[3] = pack2(v[14], v[15]);
  *(u32x4*)dst = a;
  *(u32x4*)(dst + 8) = b;
}
DI void st_f32x16(float* dst, const float (&v)[16]) {
#pragma unroll
  for (int i = 0; i < 4; ++i) *(float4*)(dst + 4 * i) = make_float4(v[4 * i], v[4 * i + 1], v[4 * i + 2], v[4 * i + 3]);
}
DI void ld_bf16x16(const bf16_t* src, float (&v)[16]) {
  u32x4 a = *(const u32x4*)src, b = *(const u32x4*)(src + 8);
#pragma unroll
  for (int i = 0; i < 4; ++i) {
    v[2 * i] = bflo(a[i]); v[2 * i + 1] = bfhi(a[i]);
    v[8 + 2 * i] = bflo(b[i]); v[8 + 2 * i + 1] = bfhi(b[i]);
  }
}

constexpr int LDK = 72;
template <int SCALE>
DI void gemm_kloop(f32x4 (&acc)[4][4], const bf16_t* __restrict__ A, int lda, const bf16_t* __restrict__ B, int ldb,
                   int K, char* smem, float sc_a, float sc_b) {
  bf16_t* As = (bf16_t*)smem;
  bf16_t* Bs = As + 128 * LDK;
  const int tid = threadIdx.x, lane = tid & 63, w = tid >> 6, wm = w >> 1, wn = w & 1, l15 = lane & 15, g = lane >> 4;
  u32x4 ra[4], rb[4];
  int arow[4], kc[4], ldsa[4], ldsb[4];
#pragma unroll
  for (int i = 0; i < 4; ++i) {
    int c = tid + 256 * i;
    int r = c >> 3;
    kc[i] = (c & 7) * 8;
    arow[i] = r;
    int rr = r & 63;
    int rho = (r & 64) | (((rr >> 2) & 3) << 4) | ((rr >> 4) << 2) | (rr & 3);
    ldsa[i] = rho * LDK + kc[i];
    ldsb[i] = r * LDK + kc[i];
  }
#pragma unroll
  for (int i = 0; i < 4; ++i) {
    ra[i] = *(const u32x4*)(A + (size_t)arow[i] * lda + kc[i]);
    rb[i] = *(const u32x4*)(B + (size_t)arow[i] * ldb + kc[i]);
  }
  for (int k0 = 0; k0 < K; k0 += 64) {
    __syncthreads();
#pragma unroll
    for (int i = 0; i < 4; ++i) {
      *(u32x4*)(As + ldsa[i]) = ra[i];
      *(u32x4*)(Bs + ldsb[i]) = rb[i];
    }
    __syncthreads();
    if (k0 + 64 < K) {
#pragma unroll
      for (int i = 0; i < 4; ++i) {
        ra[i] = *(const u32x4*)(A + (size_t)arow[i] * lda + k0 + 64 + kc[i]);
        rb[i] = *(const u32x4*)(B + (size_t)arow[i] * ldb + k0 + 64 + kc[i]);
      }
    }
#pragma unroll
    for (int ks = 0; ks < 2; ++ks) {
      bf16x8 af[4], bfr[4];
#pragma unroll
      for (int f = 0; f < 4; ++f)
        af[f] = *(const bf16x8*)(As + (wm * 64 + f * 16 + l15) * LDK + ks * 32 + g * 8);
#pragma unroll
      for (int c = 0; c < 4; ++c)
        bfr[c] = *(const bf16x8*)(Bs + (wn * 64 + c * 16 + l15) * LDK + ks * 32 + g * 8);
      if (SCALE) {
        float fac[8];
#pragma unroll
        for (int i = 0; i < 8; ++i) fac[i] = exp2f(sc_a + sc_b * (float)(k0 + ks * 32 + g * 8 + i));
#pragma unroll
        for (int f = 0; f < 4; ++f) {
          u32x4 u = __builtin_bit_cast(u32x4, af[f]);
#pragma unroll
          for (int i = 0; i < 4; ++i) u[i] = pack2(bflo(u[i]) * fac[2 * i], bfhi(u[i]) * fac[2 * i + 1]);
          af[f] = __builtin_bit_cast(bf16x8, u);
        }
      }
#pragma unroll
      for (int f = 0; f < 4; ++f)
#pragma unroll
        for (int c = 0; c < 4; ++c) acc[f][c] = __builtin_amdgcn_mfma_f32_16x16x32_bf16(af[f], bfr[c], acc[f][c], 0, 0, 0);
    }
  }
}
DI void acc_zero(f32x4 (&acc)[4][4]) {
#pragma unroll
  for (int f = 0; f < 4; ++f)
#pragma unroll
    for (int c = 0; c < 4; ++c) acc[f][c] = f32x4{0.f, 0.f, 0.f, 0.f};
}
template <class F>
DI void epilogue(const f32x4 (&acc)[4][4], F&& epi) {
  const int tid = threadIdx.x, lane = tid & 63, w = tid >> 6, wm = w >> 1, wn = w & 1, l15 = lane & 15, g = lane >> 4;
#pragma unroll
  for (int c = 0; c < 4; ++c) {
    float v[16];
#pragma unroll
    for (int f = 0; f < 4; ++f)
#pragma unroll
      for (int j = 0; j < 4; ++j) v[f * 4 + j] = acc[f][c][j];
    epi(wm * 64 + 16 * g, wn * 64 + c * 16 + l15, v);
  }
}
DI bool tile_map(int it, int Ft, int Tt, int fsplit, int& ft, int& tt) {
  const int bid = blockIdx.x, nb = gridDim.x;
  int xcd = bid & 7, loc = bid >> 3, nloc = nb >> 3;
  if (loc >= nloc) return false;
  int fg = xcd % fsplit, tg = xcd / fsplit, tsplit = 8 / fsplit;
  int Fg = Ft / fsplit, Tg = Tt / tsplit;
  int i = loc + it * nloc;
  if (i >= Fg * Tg) return false;
  ft = fg * Fg + i % Fg;
  tt = tg * Tg + i / Fg;
  return true;
}
DI int vbid() {
  const int bid = blockIdx.x, nb = gridDim.x;
  if (nb & 7) return bid;
  return (bid & 7) * (nb >> 3) + (bid >> 3);
}

DI int colmap(int mode, int np) {
  if (mode == 1) return np < 416 ? np : (np < 512 ? -1 : np - 96);
  if (mode == 2) return np < 512 ? ((np >> 6) * 128 + (np & 63)) : (((np - 512) >> 6) * 128 + 64 + ((np - 512) & 63));
  return np;
}
DI void tconv_tile(const float* __restrict__ src, int ldsrc, bf16_t* __restrict__ dst, int K, int kt, int nt, int mode,
                   char* smem) {
  float* lds = (float*)smem;
  const int tid = threadIdx.x;
  {
    int col = tid & 63, rq = tid >> 6;
    int n = colmap(mode, nt * 64 + col);
#pragma unroll 4
    for (int r = 0; r < 16; ++r) {
      int kl = r * 4 + rq;
      float v = n >= 0 ? src[(size_t)(kt * 64 + kl) * ldsrc + n] : 0.f;
      lds[kl * 65 + col] = v;
    }
  }
  __syncthreads();
  {
    int nl = tid >> 2, kq = (tid & 3) * 16;
    float v[16];
#pragma unroll
    for (int i = 0; i < 16; ++i) v[i] = lds[(kq + i) * 65 + nl];
    st_bf16x16(dst + (size_t)(nt * 64 + nl) * K + kt * 64 + kq, v);
  }
  __syncthreads();
}
DI void mod_item(const Params& p, int item, char* smem) {
  float* sil = (float*)smem;
  const int tid = threadIdx.x;
  for (int i = tid; i < 9 * 1024; i += 256) {
    int j = i >> 10, k = i & 1023;
    float cv = j == 0 ? p.c_ctx[k] : p.c[(j - 1) * 1024 + k];
    sil[i] = siluf_(cv);
  }
  __syncthreads();
  const int kq = tid >> 6, nn = tid & 63, n0 = item * 64;
  float acc[9];
#pragma unroll
  for (int j = 0; j < 9; ++j) acc[j] = 0.f;
#pragma unroll 4
  for (int k = kq; k < 1024; k += 4) {
    float wv = p.w_mod[(size_t)k * 6144 + n0 + nn];
#pragma unroll
    for (int j = 0; j < 9; ++j) acc[j] += sil[j * 1024 + k] * wv;
  }
  __syncthreads();
  float* part = (float*)smem;
#pragma unroll
  for (int j = 0; j < 9; ++j) part[(kq * 9 + j) * 64 + nn] = acc[j];
  __syncthreads();
  float* mod = (float*)(p.ws + OFF_MOD);
  for (int i = tid; i < 9 * 64; i += 256) {
    int j = i >> 6, n = i & 63;
    float s = part[(0 * 9 + j) * 64 + n] + part[(1 * 9 + j) * 64 + n] + part[(2 * 9 + j) * 64 + n] + part[(3 * 9 + j) * 64 + n];
    mod[j * 6144 + n0 + n] = s + p.b_mod[n0 + n];
  }
  __syncthreads();
}
DI void conv_flat(const float* __restrict__ src, bf16_t* __restrict__ dst, size_t n) {
  size_t i = ((size_t)blockIdx.x * 256 + threadIdx.x) * 8;
  const size_t stride = (size_t)gridDim.x * 256 * 8;
  for (; i < n; i += stride) {
    float4 a = *(const float4*)(src + i), b = *(const float4*)(src + i + 4);
    u32x4 o;
    o[0] = pack2(a.x, a.y); o[1] = pack2(a.z, a.w); o[2] = pack2(b.x, b.y); o[3] = pack2(b.z, b.w);
    *(u32x4*)(dst + i) = o;
  }
}
DI void phase0(const Params& p, char* smem) {
  const int bid = blockIdx.x, nb = gridDim.x;
  char* ws = p.ws;
  const int n_mod = 96;
  const int t_in = 16 * 72, t_uq = 4 * 12, t_ukv = 2 * 16, t_upa = 8 * 16, t_upb = 8 * 16, t_o = 16 * 16;
  const int total = n_mod + t_in + t_uq + t_ukv + t_upa + t_upb + t_o;
  for (int it = bid; it < total; it += nb) {
    int i = it;
    if (i < n_mod) { mod_item(p, i, smem); continue; }
    i -= n_mod;
    if (i < t_in) { tconv_tile(p.w_in, 4512, (bf16_t*)(ws + OFF_WINT), 1024, i / 72, i % 72, 1, smem); continue; }
    i -= t_in;
    if (i < t_uq) { tconv_tile(p.w_uq, 768, (bf16_t*)(ws + OFF_WUQT), 256, i / 12, i % 12, 0, smem); continue; }
    i -= t_uq;
    if (i < t_ukv) { tconv_tile(p.w_ukv, 1024, (bf16_t*)(ws + OFF_WUKVT), 128, i / 16, i % 16, 2, smem); continue; }
    i -= t_ukv;
    if (i < t_upa) { tconv_tile(p.w_up_a, 1024, (bf16_t*)(ws + OFF_WUPAT), 512, i / 16, i % 16, 0, smem); continue; }
    i -= t_upa;
    if (i < t_upb) { tconv_tile(p.w_up_b, 1024, (bf16_t*)(ws + OFF_WUPBT), 512, i / 16, i % 16, 0, smem); continue; }
    i -= t_upb;
    tconv_tile(p.w_o, 1024, (bf16_t*)(ws + OFF_WOT), 1024, i / 16, i % 16, 0, smem);
  }
  conv_flat(p.peer_wq, (bf16_t*)(ws + OFF_WPQB), (size_t)1024 * 2048);
  {
    size_t i = ((size_t)bid * 256 + threadIdx.x) * 8;
    const size_t stride = (size_t)nb * 256 * 8;
    bf16_t* kb = (bf16_t*)(ws + OFF_KEYSB);
    for (; i < (size_t)2 * 131072; i += stride) {
      int half = i >= 131072;
      size_t s = i - (size_t)half * 131072;
      int h = (int)(s >> 14);
      size_t r = s & 16383;
      const float* src = (half ? p.keys2 : p.keys1) + s;
      float4 a = *(const float4*)(src), b = *(const float4*)(src + 4);
      u32x4 o;
      o[0] = pack2(a.x, a.y); o[1] = pack2(a.z, a.w); o[2] = pack2(b.x, b.y); o[3] = pack2(b.z, b.w);
      *(u32x4*)(kb + ((size_t)(h * 2 + half) << 14) + r) = o;
    }
  }
}

DI void rows_norm_mod(const Params& p, const float* nw, int sh_off, int sc_off, bool from_out, bf16_t* dst) {
  const int lane = threadIdx.x & 63, w = threadIdx.x >> 6;
  const float* mod = (const float*)(p.ws + OFF_MOD);
  for (int tok = blockIdx.x * 4 + w; tok < NTOK; tok += gridDim.x * 4) {
    const float* xr = from_out ? p.out + (size_t)tok * DM : xrow(p, tok);
    const float* mj = mod + modidx(tok) * 6144;
    float4 xv[4];
    float ss = 0.f;
#pragma unroll
    for (int i = 0; i < 4; ++i) {
      xv[i] = *(const float4*)(xr + (i * 64 + lane) * 4);
      ss += xv[i].x * xv[i].x + xv[i].y * xv[i].y + xv[i].z * xv[i].z + xv[i].w * xv[i].w;
    }
    ss = wsum(ss);
    float rstd = rsqrtf(ss * (1.f / 1024.f) + 1e-6f);
#pragma unroll
    for (int i = 0; i < 4; ++i) {
      int e = (i * 64 + lane) * 4;
      float4 nv = *(const float4*)(nw + e), sh = *(const float4*)(mj + sh_off + e), sc = *(const float4*)(mj + sc_off + e);
      float h0 = (xv[i].x * rstd) * nv.x * (1.f + sc.x) + sh.x;
      float h1 = (xv[i].y * rstd) * nv.y * (1.f + sc.y) + sh.y;
      float h2 = (xv[i].z * rstd) * nv.z * (1.f + sc.z) + sh.z;
      float h3 = (xv[i].w * rstd) * nv.w * (1.f + sc.w) + sh.w;
      u32x2 o;
      o[0] = pack2(h0, h1); o[1] = pack2(h2, h3);
      *(u32x2*)(dst + (size_t)tok * DM + e) = o;
    }
  }
}
DI void phase1(const Params& p, char* smem) {
  rows_norm_mod(p, p.norm_mix, 0, 1024, false, (bf16_t*)(p.ws + OFF_H1));
  const bf16_t* wpq = (const bf16_t*)(p.ws + OFF_WPQB);
  const bf16_t* kb = (const bf16_t*)(p.ws + OFF_KEYSB);
  bf16_t* wct = (bf16_t*)(p.ws + OFF_WCT);
  for (int it = blockIdx.x; it < 128; it += gridDim.x) {
    int hh = it >> 3, mt = it & 7;
    f32x4 acc[4][4];
    acc_zero(acc);
    gemm_kloop<0>(acc, wpq + (size_t)(mt * 128) * 2048 + hh * 128, 2048, kb + (size_t)hh * 16384, 128, 128, smem, 0.f, 0.f);
    epilogue(acc, [&](int m, int n, float (&v)[16]) { st_bf16x16(wct + (size_t)(hh * 128 + n) * 1024 + mt * 128 + m, v); });
  }
}

DI void phase2(const Params& p, char* smem) {
  char* ws = p.ws;
  const bf16_t* winT = (const bf16_t*)(ws + OFF_WINT);
  const bf16_t* h1 = (const bf16_t*)(ws + OFF_H1);
  bf16_t* cq = (bf16_t*)(ws + OFF_CQ);
  float* ckvraw = (float*)(ws + OFF_CKVRAW);
  float* krraw = (float*)(ws + OFF_KRRAW);
  bf16_t* rq = (bf16_t*)(ws + OFF_RQ);
  bf16_t* rk = (bf16_t*)(ws + OFF_RK);
  bf16_t* kT = (bf16_t*)(ws + OFF_KT);
  bf16_t* vT = (bf16_t*)(ws + OFF_VT);
  bf16_t* srg = (bf16_t*)(ws + OFF_SRG);
  bf16_t* sga = (bf16_t*)p.out;
  bf16_t* sgb = sga + (size_t)NTOK * 1024;
  for (int it = 0;; ++it) {
    int ft, tt;
    if (!tile_map(it, 36, 160, 4, ft, tt)) break;
    f32x4 acc[4][4];
    acc_zero(acc);
    const bf16_t* W = winT + (size_t)ft * 128 * 1024;
    const bf16_t* H = h1 + (size_t)tt * 128 * 1024;
    const int tok0 = tt * 128, f0 = ft * 128;
    if (ft >= 8 && ft < 16) {
      gemm_kloop<0>(acc, H, 1024, W, 1024, 1024, smem, 0.f, 0.f);
      if (ft < 12) {
        epilogue(acc, [&](int m, int n, float (&v)[16]) {
          int feat = f0 - 1024 + n, tok = tok0 + m;
#pragma unroll
          for (int i = 0; i < 16; ++i) v[i] *= 0.08838834764831845f;
          st_bf16x16(kT + (size_t)feat * NTOK + tok, v);
#pragma unroll
          for (int i = 0; i < 16; ++i) rk[(size_t)(tok + i) * 512 + feat] = (bf16_t)f2bf(v[i]);
        });
      } else {
        epilogue(acc, [&](int m, int n, float (&v)[16]) {
          int feat = f0 - 1536 + n, tok = tok0 + m;
          st_bf16x16(vT + (size_t)feat * NTOK + tok, v);
        });
      }
    } else {
      gemm_kloop<0>(acc, W, 1024, H, 1024, 1024, smem, 0.f, 0.f);
      if (ft < 2) {
        epilogue(acc, [&](int m, int n, float (&v)[16]) { st_bf16x16(cq + (size_t)(tok0 + n) * 256 + f0 + m, v); });
      } else if (ft == 2) {
        epilogue(acc, [&](int m, int n, float (&v)[16]) { st_f32x16(ckvraw + (size_t)(tok0 + n) * 128 + m, v); });
      } else if (ft == 3) {
        epilogue(acc, [&](int m, int n, float (&v)[16]) {
          if (m < 32) st_f32x16(krraw + (size_t)(tok0 + n) * 32 + m, v);
        });
      } else if (ft < 8) {
        epilogue(acc, [&](int m, int n, float (&v)[16]) { st_bf16x16(rq + (size_t)(tok0 + n) * 512 + f0 - 512 + m, v); });
      } else if (ft < 20) {
        epilogue(acc, [&](int m, int n, float (&v)[16]) {
#pragma unroll
          for (int i = 0; i < 16; ++i) v[i] = siluf_(v[i]);
          st_bf16x16(srg + (size_t)(tok0 + n) * 512 + f0 - 2048 + m, v);
        });
      } else if (ft < 28) {
        epilogue(acc, [&](int m, int n, float (&v)[16]) {
#pragma unroll
          for (int i = 0; i < 16; ++i) v[i] = sigmoidf_(v[i]);
          st_bf16x16(sga + (size_t)(tok0 + n) * 1024 + f0 - 2560 + m, v);
        });
      } else {
        epilogue(acc, [&](int m, int n, float (&v)[16]) {
#pragma unroll
          for (int i = 0; i < 16; ++i) v[i] = sigmoidf_(v[i]);
          st_bf16x16(sgb + (size_t)(tok0 + n) * 1024 + f0 - 3584 + m, v);
        });
      }
    }
  }
}

DI float log2gamma(float logit) { return -log1pf(expf(-logit)) * 1.4426950408889634f; }
DI void phase3(const Params& p, char* smem) {
  char* ws = p.ws;
  const int lane = threadIdx.x & 63, w = threadIdx.x >> 6;
  bf16_t* cq = (bf16_t*)(ws + OFF_CQ);
  const float* ckvraw = (const float*)(ws + OFF_CKVRAW);
  const float* krraw = (const float*)(ws + OFF_KRRAW);
  bf16_t* ckvall = (bf16_t*)(ws + OFF_CKVALL);
  bf16_t* krall = (bf16_t*)(ws + OFF_KRALL);
  for (int r = blockIdx.x * 4 + w; r < NTOK + 4096; r += gridDim.x * 4) {
    if (r < NTOK) {
      const int tok = r;
      {
        u32x2 u = *(const u32x2*)(cq + (size_t)tok * 256 + lane * 4);
        float a0 = bflo(u[0]), a1 = bfhi(u[0]), a2 = bflo(u[1]), a3 = bfhi(u[1]);
        float ss = wsum(a0 * a0 + a1 * a1 + a2 * a2 + a3 * a3);
        float rstd = rsqrtf(ss * (1.f / 256.f) + 1e-6f);
        float4 nq = *(const float4*)(p.q_norm + lane * 4);
        u32x2 o;
        o[0] = pack2(a0 * rstd * nq.x, a1 * rstd * nq.y);
        o[1] = pack2(a2 * rstd * nq.z, a3 * rstd * nq.w);
        *(u32x2*)(cq + (size_t)tok * 256 + lane * 4) = o;
      }
      const int row = kvrow(tok);
      {
        float2 v = *(const float2*)(ckvraw + (size_t)tok * 128 + lane * 2);
        float ss = wsum(v.x * v.x + v.y * v.y);
        float rstd = rsqrtf(ss * (1.f / 128.f) + 1e-6f);
        float2 nk = *(const float2*)(p.kv_norm + lane * 2);
        float o0 = v.x * rstd * nk.x, o1 = v.y * rstd * nk.y;
        if (tok < NPT) *(float2*)(p.out + OUT_CKV + (size_t)tok * 128 + lane * 2) = make_float2(o0, o1);
        *(unsigned*)(ckvall + (size_t)row * 128 + lane * 2) = pack2(o0, o1);
      }
      if (lane < 32) {
        float own = krraw[(size_t)tok * 32 + lane];
        float o = own;
        if (tok < NPT) {
          p.out[OUT_KR + (size_t)tok * 32 + lane] = own;
        } else {
          float partner = krraw[(size_t)tok * 32 + (lane ^ 16)];
          int t = (tok - NPT) & 2047;
          int a = lane & 15;
          float pos = (a < 8) ? (float)(t >> 6) : (float)(t & 63);
          float fr = exp2f(-(float)(a & 7) * 1.6609640474436813f);
          float sn, cs;
          sincosf(pos * fr, &sn, &cs);
          o = lane < 16 ? own * cs - partner * sn : partner * sn + own * cs;
        }
        krall[(size_t)row * 32 + lane] = (bf16_t)f2bf(o);
      }
    } else {
      const int cr = r - NTOK;
      const int b = cr >> 9, pos = cr & 511;
      const int row = NPT + b * 2560 + 2048 + pos;
      float2 v = *(const float2*)(p.cache_ckv + (size_t)cr * 128 + lane * 2);
      *(unsigned*)(ckvall + (size_t)row * 128 + lane * 2) = pack2(v.x, v.y);
      if (lane < 32) krall[(size_t)row * 32 + lane] = (bf16_t)f2bf(p.cache_krope[(size_t)cr * 32 + lane]);
    }
  }
  const bf16_t* kT = (const bf16_t*)(ws + OFF_KT);
  const bf16_t* vT = (const bf16_t*)(ws + OFF_VT);
  float* Uf = (float*)(ws + OFF_UF);
  float* Ub = (float*)(ws + OFF_UB);
  for (int it = blockIdx.x; it < 320; it += gridDim.x) {
    const int blk = it >> 2, h = it & 3;
    const float l2f = log2gamma(p.lg_f[h]), l2b = log2gamma(p.lg_b[h]);
    const bf16_t* Kp = kT + (size_t)(h * 128) * NTOK + blk * 256;
    const bf16_t* Vp = vT + (size_t)(h * 128) * NTOK + blk * 256;
#pragma unroll 1
    for (int dir = 0; dir < 2; ++dir) {
      const float sa = dir ? 0.f : l2f * 255.f, sb = dir ? l2b : -l2f;
      f32x4 acc[4][4];
      acc_zero(acc);
      if (blk < 16) {
        gemm_kloop<1>(acc, Vp, NTOK, Kp, NTOK, 256, smem, sa, sb);
        float* dst = p.out + (dir ? OUT_SB : OUT_SF) + (size_t)(blk * 4 + h) * 16384;
        epilogue(acc, [&](int m, int n, float (&v)[16]) { st_f32x16(dst + n * 128 + m, v); });
      } else {
        gemm_kloop<1>(acc, Kp, NTOK, Vp, NTOK, 256, smem, sa, sb);
        float* dst = (dir ? Ub : Uf) + (size_t)((blk - 16) * 4 + h) * 16384;
        epilogue(acc, [&](int m, int n, float (&v)[16]) { st_f32x16(dst + n * 128 + m, v); });
      }
    }
  }
}

DI void phase4(const Params& p) {
  char* ws = p.ws;
  const float* Uf = (const float*)(ws + OFF_UF);
  const float* Ub = (const float*)(ws + OFF_UB);
  bf16_t* Sf = (bf16_t*)(ws + OFF_SF);
  bf16_t* Sb = (bf16_t*)(ws + OFF_SB);
  for (int idx = blockIdx.x * 256 + threadIdx.x; idx < (1 << 20); idx += gridDim.x * 256) {
    int d = idx & 127, e = (idx >> 7) & 127, h = (idx >> 14) & 3, b = (idx >> 16) & 7, dir = idx >> 19;
    size_t eo = (size_t)e * 128 + d;
    if (dir == 0) {
      float cf = exp2f(log2gamma(p.lg_f[h]) * 256.f);
      float S = p.st_f[(size_t)(b * 4 + h) * 16384 + d * 128 + e];
#pragma unroll
      for (int blk = 0; blk < 8; ++blk) {
        size_t o = (size_t)((b * 8 + blk) * 4 + h) * 16384 + eo;
        Sf[o] = (bf16_t)f2bf(S);
        S = cf * S + Uf[o];
      }
    } else {
      float cb = exp2f(log2gamma(p.lg_b[h]) * 256.f);
      float S = p.st_b[(size_t)(b * 4 + h) * 16384 + d * 128 + e];
#pragma unroll
      for (int blk = 7; blk >= 0; --blk) {
        size_t o = (size_t)((b * 8 + blk) * 4 + h) * 16384 + eo;
        Sb[o] = (bf16_t)f2bf(S);
        S = cb * S + Ub[o];
      }
    }
  }
}

DI bf16x8 scale_frag(bf16x8 q, float s) {
  u32x4 u = __builtin_bit_cast(u32x4, q);
#pragma unroll
  for (int i = 0; i < 4; ++i) u[i] = pack2(bflo(u[i]) * s, bfhi(u[i]) * s);
  return __builtin_bit_cast(bf16x8, u);
}
constexpr int NQT = 1;
DI void phase5(const Params& p, char* smem) {
  char* ws = p.ws;
  const bf16_t* rq = (const bf16_t*)(ws + OFF_RQ);
  const bf16_t* rk = (const bf16_t*)(ws + OFF_RK);
  const bf16_t* vT = (const bf16_t*)(ws + OFF_VT);
  const bf16_t* srg = (const bf16_t*)(ws + OFF_SRG);
  const bf16_t* Sf = (const bf16_t*)(ws + OFF_SF);
  const bf16_t* Sb = (const bf16_t*)(ws + OFF_SB);
  bf16_t* ret = (bf16_t*)(ws + OFF_RET);
  bf16_t* Ks = (bf16_t*)smem;
  bf16_t* Vs = Ks + 64 * 136;
  const int tid = threadIdx.x, lane = tid & 63, w = tid >> 6, l15 = lane & 15, g = lane >> 4;
  for (int item = vbid(); item < 640 * (2 / NQT); item += gridDim.x) {
    const int qb = item >> 2, h = item & 3, blk = (qb * NQT) >> 2;
    const float l2f = log2gamma(p.lg_f[h]), l2b = log2gamma(p.lg_b[h]);
    const int tokw = qb * (64 * NQT) + w * (16 * NQT);
    bf16x8 Q[NQT][4];
#pragma unroll
    for (int qt = 0; qt < NQT; ++qt)
#pragma unroll
      for (int ks = 0; ks < 4; ++ks)
        Q[qt][ks] = *(const bf16x8*)(rq + (size_t)(tokw + qt * 16 + l15) * 512 + h * 128 + ks * 32 + g * 8);
    f32x4 o[8][NQT];
#pragma unroll
    for (int et = 0; et < 8; ++et)
#pragma unroll
      for (int qt = 0; qt < NQT; ++qt) o[et][qt] = f32x4{0.f, 0.f, 0.f, 0.f};
#pragma unroll 1
    for (int kt = 0; kt < 4; ++kt) {
      const int key0 = blk * 256 + kt * 64;
      __syncthreads();
#pragma unroll
      for (int i = 0; i < 4; ++i) {
        int c = tid + 256 * i;
        int r = c >> 4, cc = (c & 15) * 8;
        *(u32x4*)(Ks + r * 136 + cc) = *(const u32x4*)(rk + (size_t)(key0 + r) * 512 + h * 128 + cc);
        int e = c >> 3, c2 = (c & 7) * 8;
        *(u32x4*)(Vs + e * 72 + c2) = *(const u32x4*)(vT + (size_t)(h * 128 + e) * NTOK + key0 + c2);
      }
      __syncthreads();
      bf16x8 P[NQT][2];
#pragma unroll
      for (int qt = 0; qt < NQT; ++qt) {
        f32x4 s[4];
#pragma unroll
        for (int kk = 0; kk < 4; ++kk) s[kk] = f32x4{0.f, 0.f, 0.f, 0.f};
#pragma unroll
        for (int ks = 0; ks < 4; ++ks) {
#pragma unroll
          for (int kk = 0; kk < 4; ++kk) {
            bf16x8 a = *(const bf16x8*)(Ks + (kk * 16 + l15) * 136 + ks * 32 + g * 8);
            s[kk] = __builtin_amdgcn_mfma_f32_16x16x32_bf16(a, Q[qt][ks], s[kk], 0, 0, 0);
          }
        }
        const int iq = (tokw + qt * 16 + l15) & 255;
#pragma unroll
        for (int kk = 0; kk < 4; ++kk) {
#pragma unroll
          for (int j = 0; j < 4; ++j) {
            int jk = kt * 64 + kk * 16 + 4 * g + j;
            int diff = iq - jk;
            float dm = diff > 0 ? exp2f(l2f * (float)diff) : (diff < 0 ? exp2f(l2b * (float)(-diff)) : 2.f);
            s[kk][j] *= dm;
          }
        }
#pragma unroll
        for (int k2 = 0; k2 < 2; ++k2) {
          u32x4 u;
          u[0] = pack2(s[2 * k2][0], s[2 * k2][1]);
          u[1] = pack2(s[2 * k2][2], s[2 * k2][3]);
          u[2] = pack2(s[2 * k2 + 1][0], s[2 * k2 + 1][1]);
          u[3] = pack2(s[2 * k2 + 1][2], s[2 * k2 + 1][3]);
          P[qt][k2] = __builtin_bit_cast(bf16x8, u);
        }
      }
#pragma unroll
      for (int k2 = 0; k2 < 2; ++k2) {
#pragma unroll
        for (int et = 0; et < 8; ++et) {
          u32x2 lo = *(const u32x2*)(Vs + (et * 16 + l15) * 72 + k2 * 32 + 4 * g);
          u32x2 hi = *(const u32x2*)(Vs + (et * 16 + l15) * 72 + k2 * 32 + 16 + 4 * g);
          u32x4 u;
          u[0] = lo[0]; u[1] = lo[1]; u[2] = hi[0]; u[3] = hi[1];
          bf16x8 a = __builtin_bit_cast(bf16x8, u);
#pragma unroll
          for (int qt = 0; qt < NQT; ++qt) o[et][qt] = __builtin_amdgcn_mfma_f32_16x16x32_bf16(a, P[qt][k2], o[et][qt], 0, 0, 0);
        }
      }
    }
    if (blk >= 16) {
#pragma unroll 1
      for (int dir = 0; dir < 2; ++dir) {
        const bf16_t* S = (dir ? Sb : Sf) + (size_t)((blk - 16) * 4 + h) * 16384;
        float dq[NQT];
#pragma unroll
        for (int qt = 0; qt < NQT; ++qt) {
          int iq = (tokw + qt * 16 + l15) & 255;
          dq[qt] = dir ? exp2f(l2b * (float)(256 - iq)) : exp2f(l2f * (float)(iq + 1));
        }
#pragma unroll
        for (int ks = 0; ks < 4; ++ks) {
          bf16x8 qs[NQT];
#pragma unroll
          for (int qt = 0; qt < NQT; ++qt) qs[qt] = scale_frag(Q[qt][ks], dq[qt]);
#pragma unroll
          for (int et = 0; et < 8; ++et) {
            bf16x8 a = *(const bf16x8*)(S + (size_t)(et * 16 + l15) * 128 + ks * 32 + g * 8);
#pragma unroll
            for (int qt = 0; qt < NQT; ++qt) o[et][qt] = __builtin_amdgcn_mfma_f32_16x16x32_bf16(a, qs[qt], o[et][qt], 0, 0, 0);
          }
        }
      }
    }
#pragma unroll
    for (int qt = 0; qt < NQT; ++qt) {
      const int tok = tokw + qt * 16 + l15;
      float s1 = 0.f;
#pragma unroll
      for (int et = 0; et < 8; ++et)
#pragma unroll
        for (int j = 0; j < 4; ++j) s1 += o[et][qt][j];
      s1 += __shfl_xor(s1, 16);
      s1 += __shfl_xor(s1, 32);
      const float mu = s1 * (1.f / 128.f);
      float s2 = 0.f;
#pragma unroll
      for (int et = 0; et < 8; ++et)
#pragma unroll
        for (int j = 0; j < 4; ++j) {
          float dlt = o[et][qt][j] - mu;
          s2 += dlt * dlt;
        }
      s2 += __shfl_xor(s2, 16);
      s2 += __shfl_xor(s2, 32);
      const float rstd = rsqrtf(s2 * (1.f / 128.f) + 1e-6f);
#pragma unroll
      for (int et = 0; et < 8; ++et) {
        const int e = h * 128 + et * 16 + 4 * g;
        float4 gn = *(const float4*)(p.ret_gn + e);
        u32x2 sg = *(const u32x2*)(srg + (size_t)tok * 512 + e);
        u32x2 ov;
        ov[0] = pack2((o[et][qt][0] - mu) * rstd * gn.x * bflo(sg[0]), (o[et][qt][1] - mu) * rstd * gn.y * bfhi(sg[0]));
        ov[1] = pack2((o[et][qt][2] - mu) * rstd * gn.z * bflo(sg[1]), (o[et][qt][3] - mu) * rstd * gn.w * bfhi(sg[1]));
        *(u32x2*)(ret + (size_t)tok * 512 + e) = ov;
      }
    }
  }
}

DI void phase6(const Params& p, char* smem) {
  char* ws = p.ws;
  const bf16_t* cqn = (const bf16_t*)(ws + OFF_CQ);
  const bf16_t* wuqT = (const bf16_t*)(ws + OFF_WUQT);
  bf16_t* q = (bf16_t*)(ws + OFF_Q);
  for (int it = 0;; ++it) {
    int ft, tt;
    if (!tile_map(it, 6, 160, 1, ft, tt)) break;
    f32x4 acc[4][4];
    acc_zero(acc);
    gemm_kloop<0>(acc, wuqT + (size_t)ft * 128 * 256, 256, cqn + (size_t)tt * 128 * 256, 256, 256, smem, 0.f, 0.f);
    epilogue(acc, [&](int m, int n, float (&v)[16]) { st_bf16x16(q + (size_t)(tt * 128 + n) * 768 + ft * 128 + m, v); });
  }
  const bf16_t* ckvall = (const bf16_t*)(ws + OFF_CKVALL);
  const bf16_t* wukvT = (const bf16_t*)(ws + OFF_WUKVT);
  bf16_t* Kn = (bf16_t*)(ws + OFF_KN);
  bf16_t* Vt = (bf16_t*)(ws + OFF_VTA);
  for (int it = 0;; ++it) {
    int ft, tt;
    if (!tile_map(it, 8, 192, 1, ft, tt)) break;
    f32x4 acc[4][4];
    acc_zero(acc);
    const bf16_t* W = wukvT + (size_t)ft * 128 * 128;
    const bf16_t* X = ckvall + (size_t)tt * 128 * 128;
    if (ft < 4) {
      gemm_kloop<0>(acc, W, 128, X, 128, 128, smem, 0.f, 0.f);
      epilogue(acc, [&](int m, int n, float (&v)[16]) { st_bf16x16(Kn + (size_t)(tt * 128 + n) * 512 + ft * 128 + m, v); });
    } else {
      gemm_kloop<0>(acc, X, 128, W, 128, 128, smem, 0.f, 0.f);
      epilogue(acc, [&](int m, int n, float (&v)[16]) { st_bf16x16(Vt + (size_t)((ft - 4) * 128 + n) * NKV + tt * 128 + m, v); });
    }
  }
}

DI void phase7(const Params& p, char* smem) {
  char* ws = p.ws;
  const bf16_t* q = (const bf16_t*)(ws + OFF_Q);
  const bf16_t* Kn = (const bf16_t*)(ws + OFF_KN);
  const bf16_t* Vt = (const bf16_t*)(ws + OFF_VTA);
  const bf16_t* krall = (const bf16_t*)(ws + OFF_KRALL);
  bf16_t* attn = (bf16_t*)(ws + OFF_ATTN);
  bf16_t* Ks = (bf16_t*)smem;
  bf16_t* Vs = Ks + 64 * 104;
  const int tid = threadIdx.x, lane = tid & 63, w = tid >> 6, l15 = lane & 15, g = lane >> 4;
  const float qscale = 0.10206207261596577f * 1.4426950408889634f;
  for (int item = vbid(); item < 1280; item += gridDim.x) {
    int b, h, qtok0, keyrow0, nkt;
    bool sample;
    if (item < 1024) {
      sample = true; b = item >> 7; h = (item >> 4) & 7; int qb = item & 15;
      qtok0 = NPT + b * 2048 + qb * 128; keyrow0 = NPT + b * 2560; nkt = 40;
    } else {
      int it2 = item - 1024;
      sample = false; b = it2 >> 4; h = (it2 >> 1) & 7; int qb = it2 & 1;
      qtok0 = b * 256 + qb * 128; keyrow0 = b * 256; nkt = 4;
    }
    bf16x8 Q[2][3];
#pragma unroll
    for (int qt = 0; qt < 2; ++qt) {
      const int tokq = qtok0 + w * 32 + qt * 16 + l15;
      const bf16_t* qp = q + (size_t)tokq * 768 + h * 96;
#pragma unroll
      for (int ks = 0; ks < 3; ++ks) {
        u32x4 u = *(const u32x4*)(qp + ks * 32 + g * 8);
        float v[8];
#pragma unroll
        for (int i = 0; i < 4; ++i) { v[2 * i] = bflo(u[i]); v[2 * i + 1] = bfhi(u[i]); }
        if (ks == 2 && sample) {
          u32x4 up = *(const u32x4*)(qp + 64 + (g ^ 2) * 8);
          float pv[8];
#pragma unroll
          for (int i = 0; i < 4; ++i) { pv[2 * i] = bflo(up[i]); pv[2 * i + 1] = bfhi(up[i]); }
          int t = (tokq - NPT) & 2047;
          float pos = (g & 1) ? (float)(t & 63) : (float)(t >> 6);
#pragma unroll
          for (int i = 0; i < 8; ++i) {
            float fr = exp2f(-(float)i * 1.6609640474436813f);
            float sn, cs;
            sincosf(pos * fr, &sn, &cs);
            v[i] = g < 2 ? v[i] * cs - pv[i] * sn : pv[i] * sn + v[i] * cs;
          }
        }
        u32x4 o4;
#pragma unroll
        for (int i = 0; i < 4; ++i) o4[i] = pack2(v[2 * i] * qscale, v[2 * i + 1] * qscale);
        Q[qt][ks] = __builtin_bit_cast(bf16x8, o4);
      }
    }
    f32x4 o[4][2];
#pragma unroll
    for (int et = 0; et < 4; ++et)
#pragma unroll
      for (int qt = 0; qt < 2; ++qt) o[et][qt] = f32x4{0.f, 0.f, 0.f, 0.f};
    float mrun[2] = {-1e30f, -1e30f}, lrun[2] = {0.f, 0.f};
    u32x4 rk_[3], rv_[2];
    auto gload = [&](int kt) {
      const int row0 = keyrow0 + kt * 64;
#pragma unroll
      for (int i = 0; i < 3; ++i) {
        int c = tid + 256 * i;
        int r = c / 12, cc = c - r * 12;
        rk_[i] = cc < 8 ? *(const u32x4*)(Kn + (size_t)(row0 + r) * 512 + h * 64 + cc * 8)
                        : *(const u32x4*)(krall + (size_t)(row0 + r) * 32 + (cc - 8) * 8);
      }
#pragma unroll
      for (int i = 0; i < 2; ++i) {
        int c = tid + 256 * i;
        int e = c >> 3, cc = (c & 7) * 8;
        rv_[i] = *(const u32x4*)(Vt + (size_t)(h * 64 + e) * NKV + row0 + cc);
      }
    };
    gload(0);
#pragma unroll 1
    for (int kt = 0; kt < nkt; ++kt) {
      __syncthreads();
#pragma unroll
      for (int i = 0; i < 3; ++i) {
        int c = tid + 256 * i;
        int r = c / 12, cc = c - r * 12;
        *(u32x4*)(Ks + r * 104 + cc * 8) = rk_[i];
      }
#pragma unroll
      for (int i = 0; i < 2; ++i) {
        int c = tid + 256 * i;
        int e = c >> 3, cc = (c & 7) * 8;
        *(u32x4*)(Vs + e * 72 + cc) = rv_[i];
      }
      __syncthreads();
      if (kt + 1 < nkt) gload(kt + 1);
      f32x4 s[4][2];
#pragma unroll
      for (int kk = 0; kk < 4; ++kk)
#pragma unroll
        for (int qt = 0; qt < 2; ++qt) s[kk][qt] = f32x4{0.f, 0.f, 0.f, 0.f};
#pragma unroll
      for (int ks = 0; ks < 3; ++ks) {
#pragma unroll
        for (int kk = 0; kk < 4; ++kk) {
          bf16x8 a = *(const bf16x8*)(Ks + (kk * 16 + l15) * 104 + ks * 32 + g * 8);
#pragma unroll
          for (int qt = 0; qt < 2; ++qt) s[kk][qt] = __builtin_amdgcn_mfma_f32_16x16x32_bf16(a, Q[qt][ks], s[kk][qt], 0, 0, 0);
        }
      }
      bf16x8 P[2][2];
#pragma unroll
      for (int qt = 0; qt < 2; ++qt) {
        float mx = s[0][qt][0];
#pragma unroll
        for (int kk = 0; kk < 4; ++kk)
#pragma unroll
          for (int j = 0; j < 4; ++j) mx = fmaxf(mx, s[kk][qt][j]);
        mx = fmaxf(mx, __shfl_xor(mx, 16));
        mx = fmaxf(mx, __shfl_xor(mx, 32));
        const float mnew = fmaxf(mrun[qt], mx);
        const float alpha = exp2f(mrun[qt] - mnew);
        mrun[qt] = mnew;
        float ps = 0.f;
#pragma unroll
        for (int kk = 0; kk < 4; ++kk)
#pragma unroll
          for (int j = 0; j < 4; ++j) {
            float e_ = exp2f(s[kk][qt][j] - mnew);
            s[kk][qt][j] = e_;
            ps += e_;
          }
        lrun[qt] = lrun[qt] * alpha + ps;
#pragma unroll
        for (int et = 0; et < 4; ++et)
#pragma unroll
          for (int j = 0; j < 4; ++j) o[et][qt][j] *= alpha;
#pragma unroll
        for (int k2 = 0; k2 < 2; ++k2) {
          u32x4 u;
          u[0] = pack2(s[2 * k2][qt][0], s[2 * k2][qt][1]);
          u[1] = pack2(s[2 * k2][qt][2], s[2 * k2][qt][3]);
          u[2] = pack2(s[2 * k2 + 1][qt][0], s[2 * k2 + 1][qt][1]);
          u[3] = pack2(s[2 * k2 + 1][qt][2], s[2 * k2 + 1][qt][3]);
          P[qt][k2] = __builtin_bit_cast(bf16x8, u);
        }
      }
#pragma unroll
      for (int k2 = 0; k2 < 2; ++k2) {
#pragma unroll
        for (int et = 0; et < 4; ++et) {
          u32x2 lo = *(const u32x2*)(Vs + (et * 16 + l15) * 72 + k2 * 32 + 4 * g);
          u32x2 hi = *(const u32x2*)(Vs + (et * 16 + l15) * 72 + k2 * 32 + 16 + 4 * g);
          u32x4 u;
          u[0] = lo[0]; u[1] = lo[1]; u[2] = hi[0]; u[3] = hi[1];
          bf16x8 a = __builtin_bit_cast(bf16x8, u);
#pragma unroll
          for (int qt = 0; qt < 2; ++qt) o[et][qt] = __builtin_amdgcn_mfma_f32_16x16x32_bf16(a, P[qt][k2], o[et][qt], 0, 0, 0);
        }
      }
    }
#pragma unroll
    for (int qt = 0; qt < 2; ++qt) {
      const int tokq = qtok0 + w * 32 + qt * 16 + l15;
      float lt = lrun[qt];
      lt += __shfl_xor(lt, 16);
      lt += __shfl_xor(lt, 32);
      const float inv = 1.f / lt;
#pragma unroll
      for (int et = 0; et < 4; ++et) {
        u32x2 ov;
        ov[0] = pack2(o[et][qt][0] * inv, o[et][qt][1] * inv);
        ov[1] = pack2(o[et][qt][2] * inv, o[et][qt][3] * inv);
        *(u32x2*)(attn + (size_t)tokq * 512 + h * 64 + et * 16 + 4 * g) = ov;
      }
    }
  }
}

DI void phase8(const Params& p, char* smem) {
  char* ws = p.ws;
  const bf16_t* attn = (const bf16_t*)(ws + OFF_ATTN);
  const bf16_t* ret = (const bf16_t*)(ws + OFF_RET);
  const bf16_t* wa = (const bf16_t*)(ws + OFF_WUPAT);
  const bf16_t* wb = (const bf16_t*)(ws + OFF_WUPBT);
  const bf16_t* sga = (const bf16_t*)p.out;
  const bf16_t* sgb = sga + (size_t)NTOK * 1024;
  bf16_t* mbuf = (bf16_t*)(ws + OFF_M);
  const int tid = threadIdx.x, lane = tid & 63, w = tid >> 6, wm = w >> 1, wn = w & 1, l15 = lane & 15, g = lane >> 4;
  for (int it = 0;; ++it) {
    int ft, tt;
    if (!tile_map(it, 8, 160, 1, ft, tt)) break;
    f32x4 acc[4][4];
    acc_zero(acc);
    gemm_kloop<0>(acc, wa + (size_t)ft * 128 * 512, 512, attn + (size_t)tt * 128 * 512, 512, 512, smem, 0.f, 0.f);
#pragma unroll
    for (int c = 0; c < 4; ++c) {
      const size_t off = (size_t)(tt * 128 + wn * 64 + c * 16 + l15) * 1024 + ft * 128 + wm * 64 + 16 * g;
      float a[16], bq[16];
      ld_bf16x16(sga + off, a);
      ld_bf16x16(sgb + off, bq);
#pragma unroll
      for (int f = 0; f < 4; ++f)
#pragma unroll
        for (int j = 0; j < 4; ++j) acc[f][c][j] *= a[f * 4 + j] / fmaxf(bq[f * 4 + j], 1e-30f);
    }
    gemm_kloop<0>(acc, wb + (size_t)ft * 128 * 512, 512, ret + (size_t)tt * 128 * 512, 512, 512, smem, 0.f, 0.f);
    epilogue(acc, [&](int m, int n, float (&v)[16]) {
      const size_t off = (size_t)(tt * 128 + n) * 1024 + ft * 128 + m;
      float bq[16];
      ld_bf16x16(sgb + off, bq);
#pragma unroll
      for (int i = 0; i < 16; ++i) v[i] *= bq[i];
      st_bf16x16(mbuf + off, v);
    });
  }
}
DI void phase9(const Params& p, char* smem) {
  char* ws = p.ws;
  const bf16_t* mbuf = (const bf16_t*)(ws + OFF_M);
  const bf16_t* wo = (const bf16_t*)(ws + OFF_WOT);
  const float* mod = (const float*)(ws + OFF_MOD);
  for (int it = 0;; ++it) {
    int ft, tt;
    if (!tile_map(it, 8, 160, 1, ft, tt)) break;
    f32x4 acc[4][4];
    acc_zero(acc);
    gemm_kloop<0>(acc, wo + (size_t)ft * 128 * 1024, 1024, mbuf + (size_t)tt * 128 * 1024, 1024, 1024, smem, 0.f, 0.f);
    epilogue(acc, [&](int m, int n, float (&v)[16]) {
      const int tok = tt * 128 + n, feat = ft * 128 + m;
      const float* xr = xrow(p, tok) + feat;
      const float* g1 = mod + modidx(tok) * 6144 + 2048 + feat;
#pragma unroll
      for (int i = 0; i < 4; ++i) {
        float4 xv = *(const float4*)(xr + 4 * i), gv = *(const float4*)(g1 + 4 * i);
        v[4 * i] = xv.x + gv.x * v[4 * i];
        v[4 * i + 1] = xv.y + gv.y * v[4 * i + 1];
        v[4 * i + 2] = xv.z + gv.z * v[4 * i + 2];
        v[4 * i + 3] = xv.w + gv.w * v[4 * i + 3];
      }
      st_f32x16(p.out + (size_t)tok * DM + feat, v);
    });
  }
}
DI void phase10(const Params& p, char* smem) {
  rows_norm_mod(p, p.norm_ffn, 3072, 4096, true, (bf16_t*)(p.ws + OFF_H2));
  conv_flat(p.peer_u, (bf16_t*)(p.ws + OFF_TABU), (size_t)16384 * 1024);
  conv_flat(p.peer_v, (bf16_t*)(p.ws + OFF_TABV), (size_t)16384 * 1024);
}
DI void phase11(const Params& p, char* smem) {
  char* ws = p.ws;
  const bf16_t* h2 = (const bf16_t*)(ws + OFF_H2);
  const bf16_t* wct = (const bf16_t*)(ws + OFF_WCT);
  bf16_t* sc = (bf16_t*)(ws + OFF_SCORES);
  for (int it = 0;; ++it) {
    int ft, tt;
    if (!tile_map(it, 16, 160, 2, ft, tt)) break;
    f32x4 acc[4][4];
    acc_zero(acc);
    gemm_kloop<0>(acc, wct + (size_t)ft * 128 * 1024, 1024, h2 + (size_t)tt * 128 * 1024, 1024, 1024, smem, 0.f, 0.f);
    epilogue(acc, [&](int m, int n, float (&v)[16]) { st_bf16x16(sc + (size_t)(tt * 128 + n) * 2048 + ft * 128 + m, v); });
  }
}

DI unsigned okey(float f) {
  unsigned u = __float_as_uint(f);
  return (u & 0x80000000u) ? ~u : (u | 0x80000000u);
}
DI void wave_lds_sync() {
  __builtin_amdgcn_fence(__ATOMIC_ACQ_REL, "workgroup");
  __builtin_amdgcn_wave_barrier();
}
template <int V>
DI void topk16(const unsigned (&key)[V], int lowbit, int lane, int (&slot)[V]) {
  unsigned T = 0;
  for (int b = 31; b >= lowbit; --b) {
    unsigned cnd = T | (1u << b);
    int cnt = 0;
#pragma unroll
    for (int v = 0; v < V; ++v) cnt += __popcll(__ballot(key[v] >= cnd));
    if (cnt >= 16) T = cnd;
  }
  const unsigned Tp = T >> lowbit;
  const unsigned long long lt = (1ull << lane) - 1ull;
  int base = 0;
#pragma unroll
  for (int v = 0; v < V; ++v) {
    bool gt = (key[v] >> lowbit) > Tp;
    unsigned long long m = __ballot(gt);
    slot[v] = gt ? base + __popcll(m & lt) : -1;
    base += __popcll(m);
  }
  const int need = 16 - base;
  int eb = 0;
#pragma unroll
  for (int v = 0; v < V; ++v) {
    bool eq = (key[v] >> lowbit) == Tp;
    unsigned long long m = __ballot(eq);
    int r = eb + __popcll(m & lt);
    if (eq && r < need) slot[v] = base + r;
    eb += __popcll(m);
  }
}
DI void phase12(const Params& p, char* smem) {
  char* ws = p.ws;
  const bf16_t* sc = (const bf16_t*)(ws + OFF_SCORES);
  const bf16_t* h2 = (const bf16_t*)(ws + OFF_H2);
  const bf16_t* tabU = (const bf16_t*)(ws + OFF_TABU);
  const bf16_t* tabV = (const bf16_t*)(ws + OFF_TABV);
  const float* mod = (const float*)(ws + OFF_MOD);
  const int lane = threadIdx.x & 63, w = threadIdx.x >> 6;
  float* wl = (float*)(smem + w * 512);
  float* sv1 = wl;
  float* sv2 = wl + 16;
  int* si1 = (int*)(wl + 32);
  int* si2 = (int*)(wl + 48);
  float* lv = wl + 64;
  int* le = (int*)(wl + 80);
  const int kq = ((lane >> 5) & 1) * 8 + ((lane >> 4) & 1) * 4 + ((lane >> 3) & 1) * 2 + ((lane >> 2) & 1);
  for (int tok = blockIdx.x * 4 + w; tok < NTOK; tok += gridDim.x * 4) {
    float hf[16];
    {
      u32x4 a = *(const u32x4*)(h2 + (size_t)tok * DM + lane * 8), b = *(const u32x4*)(h2 + (size_t)tok * DM + 512 + lane * 8);
#pragma unroll
      for (int i = 0; i < 4; ++i) {
        hf[2 * i] = bflo(a[i]); hf[2 * i + 1] = bfhi(a[i]);
        hf[8 + 2 * i] = bflo(b[i]); hf[8 + 2 * i + 1] = bfhi(b[i]);
      }
    }
    float oacc[16];
#pragma unroll
    for (int i = 0; i < 16; ++i) oacc[i] = 0.f;
#pragma unroll 1
    for (int h = 0; h < 8; ++h) {
      const bf16_t* sp = sc + (size_t)tok * 2048 + h * 256;
#pragma unroll
      for (int half = 0; half < 2; ++half) {
        float v0 = bf2f(sp[half * 128 + lane]), v1 = bf2f(sp[half * 128 + 64 + lane]);
        unsigned key[2] = {okey(v0), okey(v1)};
        int slot[2];
        topk16<2>(key, 16, lane, slot);
        float* sv = half ? sv2 : sv1;
        int* si = half ? si2 : si1;
        if (slot[0] >= 0) { sv[slot[0]] = v0; si[slot[0]] = lane; }
        if (slot[1] >= 0) { sv[slot[1]] = v1; si[slot[1]] = 64 + lane; }
      }
      wave_lds_sync();
      {
        const float b2 = sv2[lane & 15];
        float cv[4];
        unsigned key[4];
        int slot[4];
#pragma unroll
        for (int v = 0; v < 4; ++v) {
          cv[v] = sv1[v * 4 + (lane >> 4)] + b2;
          key[v] = okey(cv[v]);
        }
        topk16<4>(key, 0, lane, slot);
        const int i2 = si2[lane & 15];
#pragma unroll
        for (int v = 0; v < 4; ++v) {
          if (slot[v] >= 0) {
            lv[slot[v]] = cv[v];
            le[slot[v]] = si1[v * 4 + (lane >> 4)] * 128 + i2;
          }
        }
      }
      wave_lds_sync();
      float mx = lv[0];
#pragma unroll
      for (int k = 1; k < 16; ++k) mx = fmaxf(mx, lv[k]);
      float den = 0.f;
#pragma unroll
      for (int k = 0; k < 16; ++k) den += __expf(lv[k] - mx);
      const float gk = __expf(lv[kq] - mx) / den;
      float pd[16];
#pragma unroll
      for (int hb = 0; hb < 2; ++hb) {
        u32x4 u0[8], u1[8];
#pragma unroll
        for (int k = 0; k < 8; ++k) {
          const bf16_t* up = tabU + (size_t)le[hb * 8 + k] * 1024 + lane * 8;
          u0[k] = *(const u32x4*)up;
          u1[k] = *(const u32x4*)(up + 512);
        }
#pragma unroll
        for (int k = 0; k < 8; ++k) {
          float d = 0.f;
#pragma unroll
          for (int i = 0; i < 4; ++i) {
            d += bflo(u0[k][i]) * hf[2 * i] + bfhi(u0[k][i]) * hf[2 * i + 1];
            d += bflo(u1[k][i]) * hf[8 + 2 * i] + bfhi(u1[k][i]) * hf[8 + 2 * i + 1];
          }
          pd[hb * 8 + k] = d;
        }
      }
      float q8[8], q4[4], q2[2], q1;
      {
        const bool hi = lane & 32;
#pragma unroll
        for (int i = 0; i < 8; ++i) {
          float send = hi ? pd[i] : pd[8 + i], keep = hi ? pd[8 + i] : pd[i];
          q8[i] = keep + __shfl_xor(send, 32);
        }
      }
      {
        const bool hi = lane & 16;
#pragma unroll
        for (int i = 0; i < 4; ++i) {
          float send = hi ? q8[i] : q8[4 + i], keep = hi ? q8[4 + i] : q8[i];
          q4[i] = keep + __shfl_xor(send, 16);
        }
      }
      {
        const bool hi = lane & 8;
#pragma unroll
        for (int i = 0; i < 2; ++i) {
          float send = hi ? q4[i] : q4[2 + i], keep = hi ? q4[2 + i] : q4[i];
          q2[i] = keep + __shfl_xor(send, 8);
        }
      }
      {
        const bool hi = lane & 4;
        float send = hi ? q2[0] : q2[1], keep = hi ? q2[1] : q2[0];
        q1 = keep + __shfl_xor(send, 4);
      }
      q1 += __shfl_xor(q1, 2);
      q1 += __shfl_xor(q1, 1);
      const float wk_own = gk * geluf_(q1);
#pragma unroll
      for (int hb = 0; hb < 2; ++hb) {
        u32x4 u0[8], u1[8];
#pragma unroll
        for (int k = 0; k < 8; ++k) {
          const bf16_t* vp = tabV + (size_t)le[hb * 8 + k] * 1024 + lane * 8;
          u0[k] = *(const u32x4*)vp;
          u1[k] = *(const u32x4*)(vp + 512);
        }
#pragma unroll
        for (int k = 0; k < 8; ++k) {
          const int kk = hb * 8 + k;
          const int src = (((kk >> 3) & 1) << 5) | (((kk >> 2) & 1) << 4) | (((kk >> 1) & 1) << 3) | ((kk & 1) << 2);
          const float wk = __shfl(wk_own, src);
#pragma unroll
          for (int i = 0; i < 4; ++i) {
            oacc[2 * i] += wk * bflo(u0[k][i]);
            oacc[2 * i + 1] += wk * bfhi(u0[k][i]);
            oacc[8 + 2 * i] += wk * bflo(u1[k][i]);
            oacc[8 + 2 * i + 1] += wk * bfhi(u1[k][i]);
          }
        }
      }
      wave_lds_sync();
    }
    float* xr = p.out + (size_t)tok * DM;
    const float* g2 = mod + modidx(tok) * 6144 + 5120;
    float y[16];
    float ss = 0.f;
#pragma unroll
    for (int hb = 0; hb < 2; ++hb)
#pragma unroll
      for (int i = 0; i < 2; ++i) {
        const int e = hb * 512 + lane * 8 + i * 4;
        float4 xv = *(const float4*)(xr + e), gv = *(const float4*)(g2 + e);
        float a0 = xv.x + gv.x * oacc[hb * 8 + i * 4], a1 = xv.y + gv.y * oacc[hb * 8 + i * 4 + 1];
        float a2 = xv.z + gv.z * oacc[hb * 8 + i * 4 + 2], a3 = xv.w + gv.w * oacc[hb * 8 + i * 4 + 3];
        y[hb * 8 + i * 4] = a0; y[hb * 8 + i * 4 + 1] = a1; y[hb * 8 + i * 4 + 2] = a2; y[hb * 8 + i * 4 + 3] = a3;
        ss += a0 * a0 + a1 * a1 + a2 * a2 + a3 * a3;
      }
    ss = wsum(ss);
    const float rstd = rsqrtf(ss * (1.f / 1024.f) + 1e-6f);
#pragma unroll
    for (int hb = 0; hb < 2; ++hb)
#pragma unroll
      for (int i = 0; i < 2; ++i) {
        const int e = hb * 512 + lane * 8 + i * 4;
        float4 nf = *(const float4*)(p.norm_final + e);
        *(float4*)(xr + e) = make_float4(y[hb * 8 + i * 4] * rstd * nf.x, y[hb * 8 + i * 4 + 1] * rstd * nf.y,
                                         y[hb * 8 + i * 4 + 2] * rstd * nf.z, y[hb * 8 + i * 4 + 3] * rstd * nf.w);
      }
  }
}

#ifdef ONLY_PHASE
#define RUNPH(n, call) if (ONLY_PHASE == n) { call; }
#else
#define RUNPH(n, call) if (lo <= n && n < hi) { call; if (n + 1 < hi) grid.sync(); }
#endif
__global__ void __launch_bounds__(256, 2) mega(Params p, int lo, int hi) {
  __shared__ __attribute__((aligned(16))) char smem[SMEM_BYTES];
  cg::grid_group grid = cg::this_grid();
  RUNPH(0, phase0(p, smem))
  RUNPH(1, phase1(p, smem))
  RUNPH(2, phase2(p, smem))
  RUNPH(3, phase3(p, smem))
  RUNPH(4, phase4(p))
  RUNPH(5, phase5(p, smem))
  RUNPH(6, phase6(p, smem))
  RUNPH(7, phase7(p, smem))
  RUNPH(8, phase8(p, smem))
  RUNPH(9, phase9(p, smem))
  RUNPH(10, phase10(p, smem))
  RUNPH(11, phase11(p, smem))
  RUNPH(12, phase12(p, smem))
}

extern "C" void kernel_launch(void* const* d_in, const int* in_sizes, int n_in, void* d_out, int out_size, void* d_ws,
                              size_t ws_size, hipStream_t stream) {
  static int grid_blocks = 0;
  if (!grid_blocks) {
    int dev = 0, cus = 0, per_cu = 0;
    hipGetDevice(&dev);
    hipDeviceGetAttribute(&cus, hipDeviceAttributeMultiprocessorCount, dev);
    hipOccupancyMaxActiveBlocksPerMultiprocessor(&per_cu, mega, 256, 0);
    if (per_cu > 2) per_cu = 2;
    if (per_cu < 1) per_cu = 1;
    grid_blocks = cus * per_cu;
  }
  Params p{};
  const float** pp = (const float**)&p;
  for (int i = 0; i < 29; ++i) pp[i] = (const float*)d_in[i];
  p.out = (float*)d_out;
  p.ws = (char*)d_ws;
#if N_LAUNCH_SPLIT
  for (int ph = 0; ph < NPHASE; ++ph) {
    hipLaunchKernelGGL(mega, dim3(grid_blocks), dim3(256), 0, stream, p, ph, ph + 1);
  }
#else
  int lo = 0, hi = NPHASE;
  void* args[] = {&p, &lo, &hi};
  hipError_t e = hipLaunchCooperativeKernel((void*)mega, dim3(grid_blocks), dim3(256), args, 0, stream);
  if (e != hipSuccess) fprintf(stderr, "cooperative launch failed: %s (grid %d)\n", hipGetErrorString(e), grid_blocks);
#endif
}
```

```cpp
#include <hip/hip_runtime.h>
#include <hip/hip_cooperative_groups.h>
#include <cstdio>
namespace cg = cooperative_groups;

#define DI __device__ __forceinline__
typedef unsigned short bf16_t;
using bf16x8 = __attribute__((ext_vector_type(8))) short;
using f32x4 = __attribute__((ext_vector_type(4))) float;
using u32x4 = __attribute__((ext_vector_type(4))) unsigned;
using u32x2 = __attribute__((ext_vector_type(2))) unsigned;

#ifndef N_LAUNCH_SPLIT
#define N_LAUNCH_SPLIT 0
#endif

constexpr int NTOK = 20480, NPT = 4096, DM = 1024;
constexpr int NPHASE = 13;
constexpr size_t MiB = 1u << 20;
constexpr size_t OFF_WINT = 0, OFF_WUQT = 9 * MiB, OFF_WUKVT = 9 * MiB + 512 * 1024, OFF_WUPAT = 10 * MiB,
                 OFF_WUPBT = 11 * MiB, OFF_WOT = 12 * MiB, OFF_WCT = 14 * MiB, OFF_WPQB = 18 * MiB,
                 OFF_KEYSB = 22 * MiB, OFF_MOD = 22 * MiB + 512 * 1024, OFF_BAR = 23 * MiB, A0 = 24 * MiB;
constexpr size_t OFF_H1 = A0 + 0, OFF_CQ = A0 + 40 * MiB, OFF_CKVRAW = A0 + 50 * MiB, OFF_KRRAW = A0 + 60 * MiB,
                 OFF_RQ = A0 + 63 * MiB, OFF_RK = A0 + 83 * MiB, OFF_KT = A0 + 103 * MiB, OFF_VT = A0 + 123 * MiB,
                 OFF_SRG = A0 + 143 * MiB, OFF_CKVALL = A0 + 163 * MiB, OFF_KRALL = A0 + 169 * MiB,
                 OFF_UF = A0 + 171 * MiB, OFF_UB = A0 + 187 * MiB,
                 OFF_SF = A0 + 0, OFF_SB = A0 + 8 * MiB, OFF_RET = A0 + 16 * MiB,
                 OFF_Q = A0 + 63 * MiB, OFF_KN = A0 + 93 * MiB, OFF_VTA = A0 + 117 * MiB, OFF_ATTN = A0 + 141 * MiB,
                 OFF_M = A0 + 163 * MiB,
                 OFF_H2 = A0 + 0, OFF_TABU = A0 + 40 * MiB, OFF_TABV = A0 + 72 * MiB, OFF_SCORES = A0 + 104 * MiB;
constexpr size_t OUT_CKV = 20971520, OUT_KR = 21495808, OUT_SF = 21626880, OUT_SB = 22675456;
constexpr int NKV = 24576;
constexpr int SMEM_BYTES = 36864;

struct Params {
  const float *x_prompt, *x_sample, *c, *cache_ckv, *cache_krope, *st_f, *st_b, *c_ctx, *w_mod, *b_mod, *norm_mix,
      *norm_ffn, *norm_final, *w_in, *q_norm, *kv_norm, *w_uq, *w_ukv, *lg_f, *lg_b, *ret_gn, *w_up_a, *w_up_b, *w_o,
      *peer_wq, *keys1, *keys2, *peer_u, *peer_v;
  float* out;
  char* ws;
};

DI unsigned f2bf(float x) {
  unsigned u = __float_as_uint(x);
  u += 0x7fffu + ((u >> 16) & 1u);
  return u >> 16;
}
DI float bf2f(unsigned b) { return __uint_as_float(b << 16); }
DI unsigned pack2(float a, float b) { return f2bf(a) | (f2bf(b) << 16); }
DI float bflo(unsigned u) { return __uint_as_float(u << 16); }
DI float bfhi(unsigned u) { return __uint_as_float(u & 0xffff0000u); }
DI float wsum(float v) {
#pragma unroll
  for (int o = 32; o > 0; o >>= 1) v += __shfl_xor(v, o);
  return v;
}
DI float sigmoidf_(float x) { return 1.f / (1.f + __expf(-x)); }
DI float siluf_(float x) { return x / (1.f + __expf(-x)); }
DI float geluf_(float x) { return 0.5f * x * (1.f + tanhf(0.7978845608028654f * (x + 0.044715f * x * x * x))); }
DI const float* xrow(const Params& p, int tok) {
  return tok < NPT ? p.x_prompt + (size_t)tok * DM : p.x_sample + (size_t)(tok - NPT) * DM;
}
DI int modidx(int tok) { return tok < NPT ? 0 : 1 + ((tok - NPT) >> 11); }
DI int kvrow(int tok) {
  if (tok < NPT) return tok;
  int t = tok - NPT;
  return NPT + (t >> 11) * 2560 + (t & 2047);
}
DI void st_bf16x16(bf16_t* dst, const float (&v)[16]) {
  u32x4 a, b;
  a[0] = pack2(v[0], v[1]); a[1] = pack2(v[2], v[3]); a[2] = pack2(v[4], v[5]); a[3] = pack2(v[6], v[7]);
  b[0] = pack2(v[8], v[9]); b[1] = pack2(v[10], v[11]); b[2] = pack2(v[12], v[13]); b[3] = pack2(v[14], v[15]);
  *(u32x4*)dst = a;
  *(u32x4*)(dst + 8) = b;
}
DI void st_f32x16(float* dst, const float (&v)[16]) {
#pragma unroll
  for (int i = 0; i < 4; ++i) *(float4*)(dst + 4 * i) = make_float4(v[4 * i], v[4 * i + 1], v[4 * i + 2], v[4 * i + 3]);
}
DI void ld_bf16x16(const bf16_t* src, float (&v)[16]) {
  u32x4 a = *(const u32x4*)src, b = *(const u32x4*)(src + 8);
#pragma unroll
  for (int i = 0; i < 4; ++i) {
    v[2 * i] = bflo(a[i]); v[2 * i + 1] = bfhi(a[i]);
    v[8 + 2 * i] = bflo(b[i]); v[8 + 2 * i + 1] = bfhi(b[i]);
  }
}

constexpr int LDK = 72;
template <int SCALE>
DI void gemm_kloop(f32x4 (&acc)[4][4], const bf16_t* __restrict__ A, int lda, const bf16_t* __restrict__ B, int ldb,
                   int K, char* smem, float sc_a, float sc_b) {
  bf16_t* As = (bf16_t*)smem;
  bf16_t* Bs = As + 128 * LDK;
  const int tid = threadIdx.x, lane = tid & 63, w = tid >> 6, wm = w >> 1, wn = w & 1, l15 = lane & 15, g = lane >> 4;
  u32x4 ra[4], rb[4];
  int arow[4], kc[4], ldsa[4], ldsb[4];
#pragma unroll
  for (int i = 0; i < 4; ++i) {
    int c = tid + 256 * i;
    int r = c >> 3;
    kc[i] = (c & 7) * 8;
    arow[i] = r;
    int rr = r & 63;
    int rho = (r & 64) | (((rr >> 2) & 3) << 4) | ((rr >> 4) << 2) | (rr & 3);
    ldsa[i] = rho * LDK + kc[i];
    ldsb[i] = r * LDK + kc[i];
  }
#pragma unroll
  for (int i = 0; i < 4; ++i) {
    ra[i] = *(const u32x4*)(A + (size_t)arow[i] * lda + kc[i]);
    rb[i] = *(const u32x4*)(B + (size_t)arow[i] * ldb + kc[i]);
  }
  for (int k0 = 0; k0 < K; k0 += 64) {
    __syncthreads();
#pragma unroll
    for (int i = 0; i < 4; ++i) {
      *(u32x4*)(As + ldsa[i]) = ra[i];
      *(u32x4*)(Bs + ldsb[i]) = rb[i];
    }
    __syncthreads();
    if (k0 + 64 < K) {
#pragma unroll
      for (int i = 0; i < 4; ++i) {
        ra[i] = *(const u32x4*)(A + (size_t)arow[i] * lda + k0 + 64 + kc[i]);
        rb[i] = *(const u32x4*)(B + (size_t)arow[i] * ldb + k0 + 64 + kc[i]);
      }
    }
#pragma unroll
    for (int ks = 0; ks < 2; ++ks) {
      bf16x8 af[4], bfr[4];
#pragma unroll
      for (int f = 0; f < 4; ++f)
        af[f] = *(const bf16x8*)(As + (wm * 64 + f * 16 + l15) * LDK + ks * 32 + g * 8);
#pragma unroll
      for (int c = 0; c < 4; ++c)
        bfr[c] = *(const bf16x8*)(Bs + (wn * 64 + c * 16 + l15) * LDK + ks * 32 + g * 8);
      if (SCALE) {
        float fac[8];
#pragma unroll
        for (int i = 0; i < 8; ++i) fac[i] = exp2f(sc_a + sc_b * (float)(k0 + ks * 32 + g * 8 + i));
#pragma unroll
        for (int f = 0; f < 4; ++f) {
          u32x4 u = __builtin_bit_cast(u32x4, af[f]);
#pragma unroll
          for (int i = 0; i < 4; ++i) u[i] = pack2(bflo(u[i]) * fac[2 * i], bfhi(u[i]) * fac[2 * i + 1]);
          af[f] = __builtin_bit_cast(bf16x8, u);
        }
      }
#pragma unroll
      for (int f = 0; f < 4; ++f)
#pragma unroll
        for (int c = 0; c < 4; ++c) acc[f][c] = __builtin_amdgcn_mfma_f32_16x16x32_bf16(af[f], bfr[c], acc[f][c], 0, 0, 0);
    }
  }
}
DI void acc_zero(f32x4 (&acc)[4][4]) {
#pragma unroll
  for (int f = 0; f < 4; ++f)
#pragma unroll
    for (int c = 0; c < 4; ++c) acc[f][c] = f32x4{0.f, 0.f, 0.f, 0.f};
}
template <class F>
DI void epilogue(const f32x4 (&acc)[4][4], F&& epi) {
  const int tid = threadIdx.x, lane = tid & 63, w = tid >> 6, wm = w >> 1, wn = w & 1, l15 = lane & 15, g = lane >> 4;
#pragma unroll
  for (int c = 0; c < 4; ++c) {
    float v[16];
#pragma unroll
    for (int f = 0; f < 4; ++f)
#pragma unroll
      for (int j = 0; j < 4; ++j) v[f * 4 + j] = acc[f][c][j];
    epi(wm * 64 + 16 * g, wn * 64 + c * 16 + l15, v);
  }
}
DI bool tile_map(int it, int Ft, int Tt, int fsplit, int& ft, int& tt) {
  const int bid = blockIdx.x, nb = gridDim.x;
  int xcd = bid & 7, loc = bid >> 3, nloc = nb >> 3;
  if (loc >= nloc) return false;
  int fg = xcd % fsplit, tg = xcd / fsplit, tsplit = 8 / fsplit;
  int Fg = Ft / fsplit, Tg = Tt / tsplit;
  int i = loc + it * nloc;
  if (i >= Fg * Tg) return false;
  ft = fg * Fg + i % Fg;
  tt = tg * Tg + i / Fg;
  return true;
}
DI int vbid() {
  const int bid = blockIdx.x, nb = gridDim.x;
  if (nb & 7) return bid;
  return (bid & 7) * (nb >> 3) + (bid >> 3);
}

DI int colmap(int mode, int np) {
  if (mode == 1) return np < 416 ? np : (np < 512 ? -1 : np - 96);
  if (mode == 2) return np < 512 ? ((np >> 6) * 128 + (np & 63)) : (((np - 512) >> 6) * 128 + 64 + ((np - 512) & 63));
  return np;
}
DI void tconv_tile(const float* __restrict__ src, int ldsrc, bf16_t* __restrict__ dst, int K, int kt, int nt, int mode,
                   char* smem) {
  float* lds = (float*)smem;
  const int tid = threadIdx.x;
  {
    int col = tid & 63, rq = tid >> 6;
    int n = colmap(mode, nt * 64 + col);
#pragma unroll 4
    for (int r = 0; r < 16; ++r) {
      int kl = r * 4 + rq;
      float v = n >= 0 ? src[(size_t)(kt * 64 + kl) * ldsrc + n] : 0.f;
      lds[kl * 65 + col] = v;
    }
  }
  __syncthreads();
  {
    int nl = tid >> 2, kq = (tid & 3) * 16;
    float v[16];
#pragma unroll
    for (int i = 0; i < 16; ++i) v[i] = lds[(kq + i) * 65 + nl];
    st_bf16x16(dst + (size_t)(nt * 64 + nl) * K + kt * 64 + kq, v);
  }
  __syncthreads();
}
DI void mod_item(const Params& p, int item, char* smem) {
  float* sil = (float*)smem;
  const int tid = threadIdx.x;
  for (int i = tid; i < 9 * 1024; i += 256) {
    int j = i >> 10, k = i & 1023;
    float cv = j == 0 ? p.c_ctx[k] : p.c[(j - 1) * 1024 + k];
    sil[i] = siluf_(cv);
  }
  __syncthreads();
  const int kq = tid >> 6, nn = tid & 63, n0 = item * 64;
  float acc[9];
#pragma unroll
  for (int j = 0; j < 9; ++j) acc[j] = 0.f;
#pragma unroll 4
  for (int k = kq; k < 1024; k += 4) {
    float wv = p.w_mod[(size_t)k * 6144 + n0 + nn];
#pragma unroll
    for (int j = 0; j < 9; ++j) acc[j] += sil[j * 1024 + k] * wv;
  }
  __syncthreads();
  float* part = (float*)smem;
#pragma unroll
  for (int j = 0; j < 9; ++j) part[(kq * 9 + j) * 64 + nn] = acc[j];
  __syncthreads();
  float* mod = (float*)(p.ws + OFF_MOD);
  for (int i = tid; i < 9 * 64; i += 256) {
    int j = i >> 6, n = i & 63;
    float s = part[(0 * 9 + j) * 64 + n] + part[(1 * 9 + j) * 64 + n] + part[(2 * 9 + j) * 64 + n] + part[(3 * 9 + j) * 64 + n];
    mod[j * 6144 + n0 + n] = s + p.b_mod[n0 + n];
  }
  __syncthreads();
}
DI void conv_flat(const float* __restrict__ src, bf16_t* __restrict__ dst, size_t n) {
  size_t i = ((size_t)blockIdx.x * 256 + threadIdx.x) * 8;
  const size_t stride = (size_t)gridDim.x * 256 * 8;
  for (; i < n; i += stride) {
    float4 a = *(const float4*)(src + i), b = *(const float4*)(src + i + 4);
    u32x4 o;
    o[0] = pack2(a.x, a.y); o[1] = pack2(a.z, a.w); o[2] = pack2(b.x, b.y); o[3] = pack2(b.z, b.w);
    *(u32x4*)(dst + i) = o;
  }
}
DI void phase0(const Params& p, char* smem) {
  const int bid = blockIdx.x, nb = gridDim.x;
  char* ws = p.ws;
  const int n_mod = 96;
  const int t_in = 16 * 72, t_uq = 4 * 12, t_ukv = 2 * 16, t_upa = 8 * 16, t_upb = 8 * 16, t_o = 16 * 16;
  const int total = n_mod + t_in + t_uq + t_ukv + t_upa + t_upb + t_o;
  for (int it = bid; it < total; it += nb) {
    int i = it;
    if (i < n_mod) { mod_item(p, i, smem); continue; }
    i -= n_mod;
    if (i < t_in) { tconv_tile(p.w_in, 4512, (bf16_t*)(ws + OFF_WINT), 1024, i / 72, i % 72, 1, smem); continue; }
    i -= t_in;
    if (i < t_uq) { tconv_tile(p.w_uq, 768, (bf16_t*)(ws + OFF_WUQT), 256, i / 12, i % 12, 0, smem); continue; }
    i -= t_uq;
    if (i < t_ukv) { tconv_tile(p.w_ukv, 1024, (bf16_t*)(ws + OFF_WUKVT), 128, i / 16, i % 16, 2, smem); continue; }
    i -= t_ukv;
    if (i < t_upa) { tconv_tile(p.w_up_a, 1024, (bf16_t*)(ws + OFF_WUPAT), 512, i / 16, i % 16, 0, smem); continue; }
    i -= t_upa;
    if (i < t_upb) { tconv_tile(p.w_up_b, 1024, (bf16_t*)(ws + OFF_WUPBT), 512, i / 16, i % 16, 0, smem); continue; }
    i -= t_upb;
    tconv_tile(p.w_o, 1024, (bf16_t*)(ws + OFF_WOT), 1024, i / 16, i % 16, 0, smem);
  }
  conv_flat(p.peer_wq, (bf16_t*)(ws + OFF_WPQB), (size_t)1024 * 2048);
  {
    size_t i = ((size_t)bid * 256 + threadIdx.x) * 8;
    const size_t stride = (size_t)nb * 256 * 8;
    bf16_t* kb = (bf16_t*)(ws + OFF_KEYSB);
    for (; i < (size_t)2 * 131072; i += stride) {
      int half = i >= 131072;
      size_t s = i - (size_t)half * 131072;
      int h = (int)(s >> 14);
      size_t r = s & 16383;
      const float* src = (half ? p.keys2 : p.keys1) + s;
      float4 a = *(const float4*)(src), b = *(const float4*)(src + 4);
      u32x4 o;
      o[0] = pack2(a.x, a.y); o[1] = pack2(a.z, a.w); o[2] = pack2(b.x, b.y); o[3] = pack2(b.z, b.w);
      *(u32x4*)(kb + ((size_t)(h * 2 + half) << 14) + r) = o;
    }
  }
}

DI void rows_norm_mod(const Params& p, const float* nw, int sh_off, int sc_off, bool from_out, bf16_t* dst) {
  const int lane = threadIdx.x & 63, w = threadIdx.x >> 6;
  const float* mod = (const float*)(p.ws + OFF_MOD);
  for (int tok = blockIdx.x * 4 + w; tok < NTOK; tok += gridDim.x * 4) {
    const float* xr = from_out ? p.out + (size_t)tok * DM : xrow(p, tok);
    const float* mj = mod + modidx(tok) * 6144;
    float4 xv[4];
    float ss = 0.f;
#pragma unroll
    for (int i = 0; i < 4; ++i) {
      xv[i] = *(const float4*)(xr + (i * 64 + lane) * 4);
      ss += xv[i].x * xv[i].x + xv[i].y * xv[i].y + xv[i].z * xv[i].z + xv[i].w * xv[i].w;
    }
    ss = wsum(ss);
    float rstd = rsqrtf(ss * (1.f / 1024.f) + 1e-6f);
#pragma unroll
    for (int i = 0; i < 4; ++i) {
      int e = (i * 64 + lane) * 4;
      float4 nv = *(const float4*)(nw + e), sh = *(const float4*)(mj + sh_off + e), sc = *(const float4*)(mj + sc_off + e);
      float h0 = (xv[i].x * rstd) * nv.x * (1.f + sc.x) + sh.x;
      float h1 = (xv[i].y * rstd) * nv.y * (1.f + sc.y) + sh.y;
      float h2 = (xv[i].z * rstd) * nv.z * (1.f + sc.z) + sh.z;
      float h3 = (xv[i].w * rstd) * nv.w * (1.f + sc.w) + sh.w;
      u32x2 o;
      o[0] = pack2(h0, h1); o[1] = pack2(h2, h3);
      *(u32x2*)(dst + (size_t)tok * DM + e) = o;
    }
  }
}
DI void phase1(const Params& p, char* smem) {
  rows_norm_mod(p, p.norm_mix, 0, 1024, false, (bf16_t*)(p.ws + OFF_H1));
  const bf16_t* wpq = (const bf16_t*)(p.ws + OFF_WPQB);
  const bf16_t* kb = (const bf16_t*)(p.ws + OFF_KEYSB);
  bf16_t* wct = (bf16_t*)(p.ws + OFF_WCT);
  for (int it = blockIdx.x; it < 128; it += gridDim.x) {
    int hh = it >> 3, mt = it & 7;
    f32x4 acc[4][4];
    acc_zero(acc);
    gemm_kloop<0>(acc, wpq + (size_t)(mt * 128) * 2048 + hh * 128, 2048, kb + (size_t)hh * 16384, 128, 128, smem, 0.f, 0.f);
    epilogue(acc, [&](int m, int n, float (&v)[16]) { st_bf16x16(wct + (size_t)(hh * 128 + n) * 1024 + mt * 128 + m, v); });
  }
}

DI void phase2(const Params& p, char* smem) {
  char* ws = p.ws;
  const bf16_t* winT = (const bf16_t*)(ws + OFF_WINT);
  const bf16_t* h1 = (const bf16_t*)(ws + OFF_H1);
  bf16_t* cq = (bf16_t*)(ws + OFF_CQ);
  float* ckvraw = (float*)(ws + OFF_CKVRAW);
  float* krraw = (float*)(ws + OFF_KRRAW);
  bf16_t* rq = (bf16_t*)(ws + OFF_RQ);
  bf16_t* rk = (bf16_t*)(ws + OFF_RK);
  bf16_t* kT = (bf16_t*)(ws + OFF_KT);
  bf16_t* vT = (bf16_t*)(ws + OFF_VT);
  bf16_t* srg = (bf16_t*)(ws + OFF_SRG);
  bf16_t* sga = (bf16_t*)p.out;
  bf16_t* sgb = sga + (size_t)NTOK * 1024;
  for (int it = 0;; ++it) {
    int ft, tt;
    if (!tile_map(it, 36, 160, 4, ft, tt)) break;
    f32x4 acc[4][4];
    acc_zero(acc);
    const bf16_t* W = winT + (size_t)ft * 128 * 1024;
    const bf16_t* H = h1 + (size_t)tt * 128 * 1024;
    const int tok0 = tt * 128, f0 = ft * 128;
    if (ft >= 8 && ft < 16) {
      gemm_kloop<0>(acc, H, 1024, W, 1024, 1024, smem, 0.f, 0.f);
      if (ft < 12) {
        epilogue(acc, [&](int m, int n, float (&v)[16]) {
          int feat = f0 - 1024 + n, tok = tok0 + m;
#pragma unroll
          for (int i = 0; i < 16; ++i) v[i] *= 0.08838834764831845f;
          st_bf16x16(kT + (size_t)feat * NTOK + tok, v);
#pragma unroll
          for (int i = 0; i < 16; ++i) rk[(size_t)(tok + i) * 512 + feat] = (bf16_t)f2bf(v[i]);
        });
      } else {
        epilogue(acc, [&](int m, int n, float (&v)[16]) {
          int feat = f0 - 1536 + n, tok = tok0 + m;
          st_bf16x16(vT + (size_t)feat * NTOK + tok, v);
        });
      }
    } else {
      gemm_kloop<0>(acc, W, 1024, H, 1024, 1024, smem, 0.f, 0.f);
      if (ft < 2) {
        epilogue(acc, [&](int m, int n, float (&v)[16]) { st_bf16x16(cq + (size_t)(tok0 + n) * 256 + f0 + m, v); });
      } else if (ft == 2) {
        epilogue(acc, [&](int m, int n, float (&v)[16]) { st_f32x16(ckvraw + (size_t)(tok0 + n) * 128 + m, v); });
      } else if (ft == 3) {
        epilogue(acc, [&](int m, int n, float (&v)[16]) {
          if (m < 32) st_f32x16(krraw + (size_t)(tok0 + n) * 32 + m, v);
        });
      } else if (ft < 8) {
        epilogue(acc, [&](int m, int n, float (&v)[16]) { st_bf16x16(rq + (size_t)(tok0 + n) * 512 + f0 - 512 + m, v); });
      } else if (ft < 20) {
        epilogue(acc, [&](int m, int n, float (&v)[16]) {
#pragma unroll
          for (int i = 0; i < 16; ++i) v[i] = siluf_(v[i]);
          st_bf16x16(srg + (size_t)(tok0 + n) * 512 + f0 - 2048 + m, v);
        });
      } else if (ft < 28) {
        epilogue(acc, [&](int m, int n, float (&v)[16]) {
#pragma unroll
          for (int i = 0; i < 16; ++i) v[i] = sigmoidf_(v[i]);
          st_bf16x16(sga + (size_t)(tok0 + n) * 1024 + f0 - 2560 + m, v);
        });
      } else {
        epilogue(acc, [&](int m, int n, float (&v)[16]) {
#pragma unroll
          for (int i = 0; i < 16; ++i) v[i] = sigmoidf_(v[i]);
          st_bf16x16(sgb + (size_t)(tok0 + n) * 1024 + f0 - 3584 + m, v);
        });
      }
    }
  }
}

DI float log2gamma(float logit) { return -log1pf(expf(-logit)) * 1.4426950408889634f; }
DI void phase3(const Params& p, char* smem) {
  char* ws = p.ws;
  const int lane = threadIdx.x & 63, w = threadIdx.x >> 6;
  bf16_t* cq = (bf16_t*)(ws + OFF_CQ);
  const float* ckvraw = (const float*)(ws + OFF_CKVRAW);
  const float* krraw = (const float*)(ws + OFF_KRRAW);
  bf16_t* ckvall = (bf16_t*)(ws + OFF_CKVALL);
  bf16_t* krall = (bf16_t*)(ws + OFF_KRALL);
  for (int r = blockIdx.x * 4 + w; r < NTOK + 4096; r += gridDim.x * 4) {
    if (r < NTOK) {
      const int tok = r;
      {
        u32x2 u = *(const u32x2*)(cq + (size_t)tok * 256 + lane * 4);
        float a0 = bflo(u[0]), a1 = bfhi(u[0]), a2 = bflo(u[1]), a3 = bfhi(u[1]);
        float ss = wsum(a0 * a0 + a1 * a1 + a2 * a2 + a3 * a3);
        float rstd = rsqrtf(ss * (1.f / 256.f) + 1e-6f);
        float4 nq = *(const float4*)(p.q_norm + lane * 4);
        u32x2 o;
        o[0] = pack2(a0 * rstd * nq.x, a1 * rstd * nq.y);
        o[1] = pack2(a2 * rstd * nq.z, a3 * rstd * nq.w);
        *(u32x2*)(cq + (size_t)tok * 256 + lane * 4) = o;
      }
      const int row = kvrow(tok);
      {
        float2 v = *(const float2*)(ckvraw + (size_t)tok * 128 + lane * 2);
        float ss = wsum(v.x * v.x + v.y * v.y);
        float rstd = rsqrtf(ss * (1.f / 128.f) + 1e-6f);
        float2 nk = *(const float2*)(p.kv_norm + lane * 2);
        float o0 = v.x * rstd * nk.x, o1 = v.y * rstd * nk.y;
        if (tok < NPT) *(float2*)(p.out + OUT_CKV + (size_t)tok * 128 + lane * 2) = make_float2(o0, o1);
        *(unsigned*)(ckvall + (size_t)row * 128 + lane * 2) = pack2(o0, o1);
      }
      if (lane < 32) {
        float own = krraw[(size_t)tok * 32 + lane];
        float o = own;
        if (tok < NPT) {
          p.out[OUT_KR + (size_t)tok * 32 + lane] = own;
        } else {
          float partner = krraw[(size_t)tok * 32 + (lane ^ 16)];
          int t = (tok - NPT) & 2047;
          int a = lane & 15;
          float pos = (a < 8) ? (float)(t >> 6) : (float)(t & 63);
          float fr = exp2f(-(float)(a & 7) * 1.6609640474436813f);
          float sn, cs;
          sincosf(pos * fr, &sn, &cs);
          o = lane < 16 ? own * cs - partner * sn : partner * sn + own * cs;
        }
        krall[(size_t)row * 32 + lane] = (bf16_t)f2bf(o);
      }
    } else {
      const int cr = r - NTOK;
      const int b = cr >> 9, pos = cr & 511;
      const int row = NPT + b * 2560 + 2048 + pos;
      float2 v = *(const float2*)(p.cache_ckv + (size_t)cr * 128 + lane * 2);
      *(unsigned*)(ckvall + (size_t)row * 128 + lane * 2) = pack2(v.x, v.y);
      if (lane < 32) krall[(size_t)row * 32 + lane] = (bf16_t)f2bf(p.cache_krope[(size_t)cr * 32 + lane]);
    }
  }
  const bf16_t* kT = (const bf16_t*)(ws + OFF_KT);
  const bf16_t* vT = (const bf16_t*)(ws + OFF_VT);
  float* Uf = (float*)(ws + OFF_UF);
  float* Ub = (float*)(ws + OFF_UB);
  for (int it = blockIdx.x; it < 320; it += gridDim.x) {
    const int blk = it >> 2, h = it & 3;
    const float l2f = log2gamma(p.lg_f[h]), l2b = log2gamma(p.lg_b[h]);
    const bf16_t* Kp = kT + (size_t)(h * 128) * NTOK + blk * 256;
    const bf16_t* Vp = vT + (size_t)(h * 128) * NTOK + blk * 256;
#pragma unroll 1
    for (int dir = 0; dir < 2; ++dir) {
      const float sa = dir ? 0.f : l2f * 255.f, sb = dir ? l2b : -l2f;
      f32x4 acc[4][4];
      acc_zero(acc);
      if (blk < 16) {
        gemm_kloop<1>(acc, Vp, NTOK, Kp, NTOK, 256, smem, sa, sb);
        float* dst = p.out + (dir ? OUT_SB : OUT_SF) + (size_t)(blk * 4 + h) * 16384;
        epilogue(acc, [&](int m, int n, float (&v)[16]) { st_f32x16(dst + n * 128 + m, v); });
      } else {
        gemm_kloop<1>(acc, Kp, NTOK, Vp, NTOK, 256, smem, sa, sb);
        float* dst = (dir ? Ub : Uf) + (size_t)((blk - 16) * 4 + h) * 16384;
        epilogue(acc, [&](int m, int n, float (&v)[16]) { st_f32x16(dst + n * 128 + m, v); });
      }
    }
  }
}

DI void phase4(const Params& p) {
  char* ws = p.ws;
  const float* Uf = (const float*)(ws + OFF_UF);
  const float* Ub = (const float*)(ws + OFF_UB);
  bf16_t* Sf = (bf16_t*)(ws + OFF_SF);
  bf16_t* Sb = (bf16_t*)(ws + OFF_SB);
  for (int idx = blockIdx.x * 256 + threadIdx.x; idx < (1 << 20); idx += gridDim.x * 256) {
    int d = idx & 127, e = (idx >> 7) & 127, h = (idx >> 14) & 3, b = (idx >> 16) & 7, dir = idx >> 19;
    size_t eo = (size_t)e * 128 + d;
    if (dir == 0) {
      float cf = exp2f(log2gamma(p.lg_f[h]) * 256.f);
      float S = p.st_f[(size_t)(b * 4 + h) * 16384 + d * 128 + e];
#pragma unroll
      for (int blk = 0; blk < 8; ++blk) {
        size_t o = (size_t)((b * 8 + blk) * 4 + h) * 16384 + eo;
        Sf[o] = (bf16_t)f2bf(S);
        S = cf * S + Uf[o];
      }
    } else {
      float cb = exp2f(log2gamma(p.lg_b[h]) * 256.f);
      float S = p.st_b[(size_t)(b * 4 + h) * 16384 + d * 128 + e];
#pragma unroll
      for (int blk = 7; blk >= 0; --blk) {
        size_t o = (size_t)((b * 8 + blk) * 4 + h) * 16384 + eo;
        Sb[o] = (bf16_t)f2bf(S);
        S = cb * S + Ub[o];
      }
    }
  }
}

DI bf16x8 scale_frag(bf16x8 q, float s) {
  u32x4 u = __builtin_bit_cast(u32x4, q);
#pragma unroll
  for (int i = 0; i < 4; ++i) u[i] = pack2(bflo(u[i]) * s, bfhi(u[i]) * s);
  return __builtin_bit_cast(bf16x8, u);
}
constexpr int NQT = 1;
DI void phase5(const Params& p, char* smem) {
  char* ws = p.ws;
  const bf16_t* rq = (const bf16_t*)(ws + OFF_RQ);
  const bf16_t* rk = (const bf16_t*)(ws + OFF_RK);
  const bf16_t* vT = (const bf16_t*)(ws + OFF_VT);
  const bf16_t* srg = (const bf16_t*)(ws + OFF_SRG);
  const bf16_t* Sf = (const bf16_t*)(ws + OFF_SF);
  const bf16_t* Sb = (const bf16_t*)(ws + OFF_SB);
  bf16_t* ret = (bf16_t*)(ws + OFF_RET);
  bf16_t* Ks = (bf16_t*)smem;
  bf16_t* Vs = Ks + 64 * 136;
  const int tid = threadIdx.x, lane = tid & 63, w = tid >> 6, l15 = lane & 15, g = lane >> 4;
  for (int item = vbid(); item < 640 * (2 / NQT); item += gridDim.x) {
    const int qb = item >> 2, h = item & 3, blk = (qb * NQT) >> 2;
    const float l2f = log2gamma(p.lg_f[h]), l2b = log2gamma(p.lg_b[h]);
    const int tokw = qb * (64 * NQT) + w * (16 * NQT);
    bf16x8 Q[NQT][4];
#pragma unroll
    for (int qt = 0; qt < NQT; ++qt)
#pragma unroll
      for (int ks = 0; ks < 4; ++ks)
        Q[qt][ks] = *(const bf16x8*)(rq + (size_t)(tokw + qt * 16 + l15) * 512 + h * 128 + ks * 32 + g * 8);
    f32x4 o[8][NQT];
#pragma unroll
    for (int et = 0; et < 8; ++et)
#pragma unroll
      for (int qt = 0; qt < NQT; ++qt) o[et][qt] = f32x4{0.f, 0.f, 0.f, 0.f};
#pragma unroll 1
    for (int kt = 0; kt < 4; ++kt) {
      const int key0 = blk * 256 + kt * 64;
      __syncthreads();
#pragma unroll
      for (int i = 0; i < 4; ++i) {
        int c = tid + 256 * i;
        int r = c >> 4, cc = (c & 15) * 8;
        *(u32x4*)(Ks + r * 136 + cc) = *(const u32x4*)(rk + (size_t)(key0 + r) * 512 + h * 128 + cc);
        int e = c >> 3, c2 = (c & 7) * 8;
        *(u32x4*)(Vs + e * 72 + c2) = *(const u32x4*)(vT + (size_t)(h * 128 + e) * NTOK + key0 + c2);
      }
      __syncthreads();
      bf16x8 P[NQT][2];
#pragma unroll
      for (int qt = 0; qt < NQT; ++qt) {
        f32x4 s[4];
#pragma unroll
        for (int kk = 0; kk < 4; ++kk) s[kk] = f32x4{0.f, 0.f, 0.f, 0.f};
#pragma unroll
        for (int ks = 0; ks < 4; ++ks) {
#pragma unroll
          for (int kk = 0; kk < 4; ++kk) {
            bf16x8 a = *(const bf16x8*)(Ks + (kk * 16 + l15) * 136 + ks * 32 + g * 8);
            s[kk] = __builtin_amdgcn_mfma_f32_16x16x32_bf16(a, Q[qt][ks], s[kk], 0, 0, 0);
          }
        }
        const int iq = (tokw + qt * 16 + l15) & 255;
#pragma unroll
        for (int kk = 0; kk < 4; ++kk) {
#pragma unroll
          for (int j = 0; j < 4; ++j) {
            int jk = kt * 64 + kk * 16 + 4 * g + j;
            int diff = iq - jk;
            float dm = diff > 0 ? exp2f(l2f * (float)diff) : (diff < 0 ? exp2f(l2b * (float)(-diff)) : 2.f);
            s[kk][j] *= dm;
          }
        }
#pragma unroll
        for (int k2 = 0; k2 < 2; ++k2) {
          u32x4 u;
          u[0] = pack2(s[2 * k2][0], s[2 * k2][1]);
          u[1] = pack2(s[2 * k2][2], s[2 * k2][3]);
          u[2] = pack2(s[2 * k2 + 1][0], s[2 * k2 + 1][1]);
          u[3] = pack2(s[2 * k2 + 1][2], s[2 * k2 + 1][3]);
          P[qt][k2] = __builtin_bit_cast(bf16x8, u);
        }
      }
#pragma unroll
      for (int k2 = 0; k2 < 2; ++k2) {
#pragma unroll
        for (int et = 0; et < 8; ++et) {
          u32x2 lo = *(const u32x2*)(Vs + (et * 16 + l15) * 72 + k2 * 32 + 4 * g);
          u32x2 hi = *(const u32x2*)(Vs + (et * 16 + l15) * 72 + k2 * 32 + 16 + 4 * g);
          u32x4 u;
          u[0] = lo[0]; u[1] = lo[1]; u[2] = hi[0]; u[3] = hi[1];
          bf16x8 a = __builtin_bit_cast(bf16x8, u);
#pragma unroll
          for (int qt = 0; qt < NQT; ++qt) o[et][qt] = __builtin_amdgcn_mfma_f32_16x16x32_bf16(a, P[qt][k2], o[et][qt], 0, 0, 0);
        }
      }
    }
    if (blk >= 16) {
#pragma unroll 1
      for (int dir = 0; dir < 2; ++dir) {
        const bf16_t* S = (dir ? Sb : Sf) + (size_t)((blk - 16) * 4 + h) * 16384;
        float dq[NQT];
#pragma unroll
        for (int qt = 0; qt < NQT; ++qt) {
          int iq = (tokw + qt * 16 + l15) & 255;
          dq[qt] = dir ? exp2f(l2b * (float)(256 - iq)) : exp2f(l2f * (float)(iq + 1));
        }
#pragma unroll
        for (int ks = 0; ks < 4; ++ks) {
          bf16x8 qs[NQT];
#pragma unroll
          for (int qt = 0; qt < NQT; ++qt) qs[qt] = scale_frag(Q[qt][ks], dq[qt]);
#pragma unroll
          for (int et = 0; et < 8; ++et) {
            bf16x8 a = *(const bf16x8*)(S + (size_t)(et * 16 + l15) * 128 + ks * 32 + g * 8);
#pragma unroll
            for (int qt = 0; qt < NQT; ++qt) o[et][qt] = __builtin_amdgcn_mfma_f32_16x16x32_bf16(a, qs[qt], o[et][qt], 0, 0, 0);
          }
        }
      }
    }
#pragma unroll
    for (int qt = 0; qt < NQT; ++qt) {
      const int tok = tokw + qt * 16 + l15;
      float s1 = 0.f;
#pragma unroll
      for (int et = 0; et < 8; ++et)
#pragma unroll
        for (int j = 0; j < 4; ++j) s1 += o[et][qt][j];
      s1 += __shfl_xor(s1, 16);
      s1 += __shfl_xor(s1, 32);
      const float mu = s1 * (1.f / 128.f);
      float s2 = 0.f;
#pragma unroll
      for (int et = 0; et < 8; ++et)
#pragma unroll
        for (int j = 0; j < 4; ++j) {
          float dlt = o[et][qt][j] - mu;
          s2 += dlt * dlt;
        }
      s2 += __shfl_xor(s2, 16);
      s2 += __shfl_xor(s2, 32);
      const float rstd = rsqrtf(s2 * (1.f / 128.f) + 1e-6f);
#pragma unroll
      for (int et = 0; et < 8; ++et) {
        const int e = h * 128 + et * 16 + 4 * g;
        float4 gn = *(const float4*)(p.ret_gn + e);
        u32x2 sg = *(const u32x2*)(srg + (size_t)tok * 512 + e);
        u32x2 ov;
        ov[0] = pack2((o[et][qt][0] - mu) * rstd * gn.x * bflo(sg[0]), (o[et][qt][1] - mu) * rstd * gn.y * bfhi(sg[0]));
        ov[1] = pack2((o[et][qt][2] - mu) * rstd * gn.z * bflo(sg[1]), (o[et][qt][3] - mu) * rstd * gn.w * bfhi(sg[1]));
        *(u32x2*)(ret + (size_t)tok * 512 + e) = ov;
      }
    }
  }
}

DI void phase6(const Params& p, char* smem) {
  char* ws = p.ws;
  const bf16_t* cqn = (const bf16_t*)(ws + OFF_CQ);
  const bf16_t* wuqT = (const bf16_t*)(ws + OFF_WUQT);
  bf16_t* q = (bf16_t*)(ws + OFF_Q);
  for (int it = 0;; ++it) {
    int ft, tt;
    if (!tile_map(it, 6, 160, 1, ft, tt)) break;
    f32x4 acc[4][4];
    acc_zero(acc);
    gemm_kloop<0>(acc, wuqT + (size_t)ft * 128 * 256, 256, cqn + (size_t)tt * 128 * 256, 256, 256, smem, 0.f, 0.f);
    epilogue(acc, [&](int m, int n, float (&v)[16]) { st_bf16x16(q + (size_t)(tt * 128 + n) * 768 + ft * 128 + m, v); });
  }
  const bf16_t* ckvall = (const bf16_t*)(ws + OFF_CKVALL);
  const bf16_t* wukvT = (const bf16_t*)(ws + OFF_WUKVT);
  bf16_t* Kn = (bf16_t*)(ws + OFF_KN);
  bf16_t* Vt = (bf16_t*)(ws + OFF_VTA);
  for (int it = 0;; ++it) {
    int ft, tt;
    if (!tile_map(it, 8, 192, 1, ft, tt)) break;
    f32x4 acc[4][4];
    acc_zero(acc);
    const bf16_t* W = wukvT + (size_t)ft * 128 * 128;
    const bf16_t* X = ckvall + (size_t)tt * 128 * 128;
    if (ft < 4) {
      gemm_kloop<0>(acc, W, 128, X, 128, 128, smem, 0.f, 0.f);
      epilogue(acc, [&](int m, int n, float (&v)[16]) { st_bf16x16(Kn + (size_t)(tt * 128 + n) * 512 + ft * 128 + m, v); });
    } else {
      gemm_kloop<0>(acc, X, 128, W, 128, 128, smem, 0.f, 0.f);
      epilogue(acc, [&](int m, int n, float (&v)[16]) { st_bf16x16(Vt + (size_t)((ft - 4) * 128 + n) * NKV + tt * 128 + m, v); });
    }
  }
}

DI void phase7(const Params& p, char* smem) {
  char* ws = p.ws;
  const bf16_t* q = (const bf16_t*)(ws + OFF_Q);
  const bf16_t* Kn = (const bf16_t*)(ws + OFF_KN);
  const bf16_t* Vt = (const bf16_t*)(ws + OFF_VTA);
  const bf16_t* krall = (const bf16_t*)(ws + OFF_KRALL);
  bf16_t* attn = (bf16_t*)(ws + OFF_ATTN);
  bf16_t* Ks = (bf16_t*)smem;
  bf16_t* Vs = Ks + 64 * 104;
  const int tid = threadIdx.x, lane = tid & 63, w = tid >> 6, l15 = lane & 15, g = lane >> 4;
  const float qscale = 0.10206207261596577f * 1.4426950408889634f;
  for (int item = vbid(); item < 1280; item += gridDim.x) {
    int b, h, qtok0, keyrow0, nkt;
    bool sample;
    if (item < 1024) {
      sample = true; b = item >> 7; h = (item >> 4) & 7; int qb = item & 15;
      qtok0 = NPT + b * 2048 + qb * 128; keyrow0 = NPT + b * 2560; nkt = 40;
    } else {
      int it2 = item - 1024;
      sample = false; b = it2 >> 4; h = (it2 >> 1) & 7; int qb = it2 & 1;
      qtok0 = b * 256 + qb * 128; keyrow0 = b * 256; nkt = 4;
    }
    bf16x8 Q[2][3];
#pragma unroll
    for (int qt = 0; qt < 2; ++qt) {
      const int tokq = qtok0 + w * 32 + qt * 16 + l15;
      const bf16_t* qp = q + (size_t)tokq * 768 + h * 96;
#pragma unroll
      for (int ks = 0; ks < 3; ++ks) {
        u32x4 u = *(const u32x4*)(qp + ks * 32 + g * 8);
        float v[8];
#pragma unroll
        for (int i = 0; i < 4; ++i) { v[2 * i] = bflo(u[i]); v[2 * i + 1] = bfhi(u[i]); }
        if (ks == 2 && sample) {
          u32x4 up = *(const u32x4*)(qp + 64 + (g ^ 2) * 8);
          float pv[8];
#pragma unroll
          for (int i = 0; i < 4; ++i) { pv[2 * i] = bflo(up[i]); pv[2 * i + 1] = bfhi(up[i]); }
          int t = (tokq - NPT) & 2047;
          float pos = (g & 1) ? (float)(t & 63) : (float)(t >> 6);
#pragma unroll
          for (int i = 0; i < 8; ++i) {
            float fr = exp2f(-(float)i * 1.6609640474436813f);
            float sn, cs;
            sincosf(pos * fr, &sn, &cs);
            v[i] = g < 2 ? v[i] * cs - pv[i] * sn : pv[i] * sn + v[i] * cs;
          }
        }
        u32x4 o4;
#pragma unroll
        for (int i = 0; i < 4; ++i) o4[i] = pack2(v[2 * i] * qscale, v[2 * i + 1] * qscale);
        Q[qt][ks] = __builtin_bit_cast(bf16x8, o4);
      }
    }
    f32x4 o[4][2];
#pragma unroll
    for (int et = 0; et < 4; ++et)
#pragma unroll
      for (int qt = 0; qt < 2; ++qt) o[et][qt] = f32x4{0.f, 0.f, 0.f, 0.f};
    float mrun[2] = {-1e30f, -1e30f}, lrun[2] = {0.f, 0.f};
    u32x4 rk_[3], rv_[2];
    auto gload = [&](int kt) {
      const int row0 = keyrow0 + kt * 64;
#pragma unroll
      for (int i = 0; i < 3; ++i) {
        int c = tid + 256 * i;
        int r = c / 12, cc = c - r * 12;
        rk_[i] = cc < 8 ? *(const u32x4*)(Kn + (size_t)(row0 + r) * 512 + h * 64 + cc * 8)
                        : *(const u32x4*)(krall + (size_t)(row0 + r) * 32 + (cc - 8) * 8);
      }
#pragma unroll
      for (int i = 0; i < 2; ++i) {
        int c = tid + 256 * i;
        int e = c >> 3, cc = (c & 7) * 8;
        rv_[i] = *(const u32x4*)(Vt + (size_t)(h * 64 + e) * NKV + row0 + cc);
      }
    };
    gload(0);
#pragma unroll 1
    for (int kt = 0; kt < nkt; ++kt) {
      __syncthreads();
#pragma unroll
      for (int i = 0; i < 3; ++i) {
        int c = tid + 256 * i;
        int r = c / 12, cc = c - r * 12;
        *(u32x4*)(Ks + r * 104 + cc * 8) = rk_[i];
      }
#pragma unroll
      for (int i = 0; i < 2; ++i) {
        int c = tid + 256 * i;
        int e = c >> 3, cc = (c & 7) * 8;
        *(u32x4*)(Vs + e * 72 + cc) = rv_[i];
      }
      __syncthreads();
      if (kt + 1 < nkt) gload(kt + 1);
      f32x4 s[4][2];
#pragma unroll
      for (int kk = 0; kk < 4; ++kk)
#pragma unroll
        for (int qt = 0; qt < 2; ++qt) s[kk][qt] = f32x4{0.f, 0.f, 0.f, 0.f};
#pragma unroll
      for (int ks = 0; ks < 3; ++ks) {
#pragma unroll
        for (int kk = 0; kk < 4; ++kk) {
          bf16x8 a = *(const bf16x8*)(Ks + (kk * 16 + l15) * 104 + ks * 32 + g * 8);
#pragma unroll
          for (int qt = 0; qt < 2; ++qt) s[kk][qt] = __builtin_amdgcn_mfma_f32_16x16x32_bf16(a, Q[qt][ks], s[kk][qt], 0, 0, 0);
        }
      }
      bf16x8 P[2][2];
#pragma unroll
      for (int qt = 0; qt < 2; ++qt) {
        float mx = s[0][qt][0];
#pragma unroll
        for (int kk = 0; kk < 4; ++kk)
#pragma unroll
          for (int j = 0; j < 4; ++j) mx = fmaxf(mx, s[kk][qt][j]);
        mx = fmaxf(mx, __shfl_xor(mx, 16));
        mx = fmaxf(mx, __shfl_xor(mx, 32));
        const float mnew = fmaxf(mrun[qt], mx);
        const float alpha = exp2f(mrun[qt] - mnew);
        mrun[qt] = mnew;
        float ps = 0.f;
#pragma unroll
        for (int kk = 0; kk < 4; ++kk)
#pragma unroll
          for (int j = 0; j < 4; ++j) {
            float e_ = exp2f(s[kk][qt][j] - mnew);
            s[kk][qt][j] = e_;
            ps += e_;
          }
        lrun[qt] = lrun[qt] * alpha + ps;
#pragma unroll
        for (int et = 0; et < 4; ++et)
#pragma unroll
          for (int j = 0; j < 4; ++j) o[et][qt][j] *= alpha;
#pragma unroll
        for (int k2 = 0; k2 < 2; ++k2) {
          u32x4 u;
          u[0] = pack2(s[2 * k2][qt][0], s[2 * k2][qt][1]);
          u[1] = pack2(s[2 * k2][qt][2], s[2 * k2][qt][3]);
          u[2] = pack2(s[2 * k2 + 1][qt][0], s[2 * k2 + 1][qt][1]);
          u[3] = pack2(s[2 * k2 + 1][qt][2], s[2 * k2 + 1][qt][3]);
          P[qt][k2] = __builtin_bit_cast(bf16x8, u);
        }
      }
#pragma unroll
      for (int k2 = 0; k2 < 2; ++k2) {
#pragma unroll
        for (int et = 0; et < 4; ++et) {
          u32x2 lo = *(const u32x2*)(Vs + (et * 16 + l15) * 72 + k2 * 32 + 4 * g);
          u32x2 hi = *(const u32x2*)(Vs + (et * 16 + l15) * 72 + k2 * 32 + 16 + 4 * g);
          u32x4 u;
          u[0] = lo[0]; u[1] = lo[1]; u[2] = hi[0]; u[3] = hi[1];
          bf16x8 a = __builtin_bit_cast(bf16x8, u);
#pragma unroll
          for (int qt = 0; qt < 2; ++qt) o[et][qt] = __builtin_amdgcn_mfma_f32_16x16x32_bf16(a, P[qt][k2], o[et][qt], 0, 0, 0);
        }
      }
    }
#pragma unroll
    for (int qt = 0; qt < 2; ++qt) {
      const int tokq = qtok0 + w * 32 + qt * 16 + l15;
      float lt = lrun[qt];
      lt += __shfl_xor(lt, 16);
      lt += __shfl_xor(lt, 32);
      const float inv = 1.f / lt;
#pragma unroll
      for (int et = 0; et < 4; ++et) {
        u32x2 ov;
        ov[0] = pack2(o[et][qt][0] * inv, o[et][qt][1] * inv);
        ov[1] = pack2(o[et][qt][2] * inv, o[et][qt][3] * inv);
        *(u32x2*)(attn + (size_t)tokq * 512 + h * 64 + et * 16 + 4 * g) = ov;
      }
    }
  }
}

DI void phase8(const Params& p, char* smem) {
  char* ws = p.ws;
  const bf16_t* attn = (const bf16_t*)(ws + OFF_ATTN);
  const bf16_t* ret = (const bf16_t*)(ws + OFF_RET);
  const bf16_t* wa = (const bf16_t*)(ws + OFF_WUPAT);
  const bf16_t* wb = (const bf16_t*)(ws + OFF_WUPBT);
  const bf16_t* sga = (const bf16_t*)p.out;
  const bf16_t* sgb = sga + (size_t)NTOK * 1024;
  bf16_t* mbuf = (bf16_t*)(ws + OFF_M);
  const int tid = threadIdx.x, lane = tid & 63, w = tid >> 6, wm = w >> 1, wn = w & 1, l15 = lane & 15, g = lane >> 4;
  for (int it = 0;; ++it) {
    int ft, tt;
    if (!tile_map(it, 8, 160, 1, ft, tt)) break;
    f32x4 acc[4][4];
    acc_zero(acc);
    gemm_kloop<0>(acc, wa + (size_t)ft * 128 * 512, 512, attn + (size_t)tt * 128 * 512, 512, 512, smem, 0.f, 0.f);
#pragma unroll
    for (int c = 0; c < 4; ++c) {
      const size_t off = (size_t)(tt * 128 + wn * 64 + c * 16 + l15) * 1024 + ft * 128 + wm * 64 + 16 * g;
      float a[16], bq[16];
      ld_bf16x16(sga + off, a);
      ld_bf16x16(sgb + off, bq);
#pragma unroll
      for (int f = 0; f < 4; ++f)
#pragma unroll
        for (int j = 0; j < 4; ++j) acc[f][c][j] *= a[f * 4 + j] / fmaxf(bq[f * 4 + j], 1e-30f);
    }
    gemm_kloop<0>(acc, wb + (size_t)ft * 128 * 512, 512, ret + (size_t)tt * 128 * 512, 512, 512, smem, 0.f, 0.f);
    epilogue(acc, [&](int m, int n, float (&v)[16]) {
      const size_t off = (size_t)(tt * 128 + n) * 1024 + ft * 128 + m;
      float bq[16];
      ld_bf16x16(sgb + off, bq);
#pragma unroll
      for (int i = 0; i < 16; ++i) v[i] *= bq[i];
      st_bf16x16(mbuf + off, v);
    });
  }
}
DI void phase9(const Params& p, char* smem) {
  char* ws = p.ws;
  const bf16_t* mbuf = (const bf16_t*)(ws + OFF_M);
  const bf16_t* wo = (const bf16_t*)(ws + OFF_WOT);
  const float* mod = (const float*)(ws + OFF_MOD);
  for (int it = 0;; ++it) {
    int ft, tt;
    if (!tile_map(it, 8, 160, 1, ft, tt)) break;
    f32x4 acc[4][4];
    acc_zero(acc);
    gemm_kloop<0>(acc, wo + (size_t)ft * 128 * 1024, 1024, mbuf + (size_t)tt * 128 * 1024, 1024, 1024, smem, 0.f, 0.f);
    epilogue(acc, [&](int m, int n, float (&v)[16]) {
      const int tok = tt * 128 + n, feat = ft * 128 + m;
      const float* xr = xrow(p, tok) + feat;
      const float* g1 = mod + modidx(tok) * 6144 + 2048 + feat;
#pragma unroll
      for (int i = 0; i < 4; ++i) {
        float4 xv = *(const float4*)(xr + 4 * i), gv = *(const float4*)(g1 + 4 * i);
        v[4 * i] = xv.x + gv.x * v[4 * i];
        v[4 * i + 1] = xv.y + gv.y * v[4 * i + 1];
        v[4 * i + 2] = xv.z + gv.z * v[4 * i + 2];
        v[4 * i + 3] = xv.w + gv.w * v[4 * i + 3];
      }
      st_f32x16(p.out + (size_t)tok * DM + feat, v);
    });
  }
}
DI void phase10(const Params& p, char* smem) {
  rows_norm_mod(p, p.norm_ffn, 3072, 4096, true, (bf16_t*)(p.ws + OFF_H2));
  conv_flat(p.peer_u, (bf16_t*)(p.ws + OFF_TABU), (size_t)16384 * 1024);
  conv_flat(p.peer_v, (bf16_t*)(p.ws + OFF_TABV), (size_t)16384 * 1024);
}
DI void phase11(const Params& p, char* smem) {
  char* ws = p.ws;
  const bf16_t* h2 = (const bf16_t*)(ws + OFF_H2);
  const bf16_t* wct = (const bf16_t*)(ws + OFF_WCT);
  bf16_t* sc = (bf16_t*)(ws + OFF_SCORES);
  for (int it = 0;; ++it) {
    int ft, tt;
    if (!tile_map(it, 16, 160, 2, ft, tt)) break;
    f32x4 acc[4][4];
    acc_zero(acc);
    gemm_kloop<0>(acc, wct + (size_t)ft * 128 * 1024, 1024, h2 + (size_t)tt * 128 * 1024, 1024, 1024, smem, 0.f, 0.f);
    epilogue(acc, [&](int m, int n, float (&v)[16]) { st_bf16x16(sc + (size_t)(tt * 128 + n) * 2048 + ft * 128 + m, v); });
  }
}

DI unsigned okey(float f) {
  unsigned u = __float_as_uint(f);
  return (u & 0x80000000u) ? ~u : (u | 0x80000000u);
}
DI void wave_lds_sync() {
  __builtin_amdgcn_fence(__ATOMIC_ACQ_REL, "workgroup");
  __builtin_amdgcn_wave_barrier();
}
template <int V>
DI void topk16(const unsigned (&key)[V], int lowbit, int lane, int (&slot)[V]) {
  unsigned T = 0;
  for (int b = 31; b >= lowbit; --b) {
    unsigned cnd = T | (1u << b);
    int cnt = 0;
#pragma unroll
    for (int v = 0; v < V; ++v) cnt += __popcll(__ballot(key[v] >= cnd));
    if (cnt >= 16) T = cnd;
  }
  const unsigned Tp = T >> lowbit;
  const unsigned long long lt = (1ull << lane) - 1ull;
  int base = 0;
#pragma unroll
  for (int v = 0; v < V; ++v) {
    bool gt = (key[v] >> lowbit) > Tp;
    unsigned long long m = __ballot(gt);
    slot[v] = gt ? base + __popcll(m & lt) : -1;
    base += __popcll(m);
  }
  const int need = 16 - base;
  int eb = 0;
#pragma unroll
  for (int v = 0; v < V; ++v) {
    bool eq = (key[v] >> lowbit) == Tp;
    unsigned long long m = __ballot(eq);
    int r = eb + __popcll(m & lt);
    if (eq && r < need) slot[v] = base + r;
    eb += __popcll(m);
  }
}
DI void phase12(const Params& p, char* smem) {
  char* ws = p.ws;
  const bf16_t* sc = (const bf16_t*)(ws + OFF_SCORES);
  const bf16_t* h2 = (const bf16_t*)(ws + OFF_H2);
  const bf16_t* tabU = (const bf16_t*)(ws + OFF_TABU);
  const bf16_t* tabV = (const bf16_t*)(ws + OFF_TABV);
  const float* mod = (const float*)(ws + OFF_MOD);
  const int lane = threadIdx.x & 63, w = threadIdx.x >> 6;
  float* wl = (float*)(smem + w * 512);
  float* sv1 = wl;
  float* sv2 = wl + 16;
  int* si1 = (int*)(wl + 32);
  int* si2 = (int*)(wl + 48);
  float* lv = wl + 64;
  int* le = (int*)(wl + 80);
  const int kq = ((lane >> 5) & 1) * 8 + ((lane >> 4) & 1) * 4 + ((lane >> 3) & 1) * 2 + ((lane >> 2) & 1);
  for (int tok = blockIdx.x * 4 + w; tok < NTOK; tok += gridDim.x * 4) {
    float hf[16];
    {
      u32x4 a = *(const u32x4*)(h2 + (size_t)tok * DM + lane * 8), b = *(const u32x4*)(h2 + (size_t)tok * DM + 512 + lane * 8);
#pragma unroll
      for (int i = 0; i < 4; ++i) {
        hf[2 * i] = bflo(a[i]); hf[2 * i + 1] = bfhi(a[i]);
        hf[8 + 2 * i] = bflo(b[i]); hf[8 + 2 * i + 1] = bfhi(b[i]);
      }
    }
    float oacc[16];
#pragma unroll
    for (int i = 0; i < 16; ++i) oacc[i] = 0.f;
#pragma unroll 1
    for (int h = 0; h < 8; ++h) {
      const bf16_t* sp = sc + (size_t)tok * 2048 + h * 256;
#pragma unroll
      for (int half = 0; half < 2; ++half) {
        float v0 = bf2f(sp[half * 128 + lane]), v1 = bf2f(sp[half * 128 + 64 + lane]);
        unsigned key[2] = {okey(v0), okey(v1)};
        int slot[2];
        topk16<2>(key, 16, lane, slot);
        float* sv = half ? sv2 : sv1;
        int* si = half ? si2 : si1;
        if (slot[0] >= 0) { sv[slot[0]] = v0; si[slot[0]] = lane; }
        if (slot[1] >= 0) { sv[slot[1]] = v1; si[slot[1]] = 64 + lane; }
      }
      wave_lds_sync();
      {
        const float b2 = sv2[lane & 15];
        float cv[4];
        unsigned key[4];
        int slot[4];
#pragma unroll
        for (int v = 0; v < 4; ++v) {
          cv[v] = sv1[v * 4 + (lane >> 4)] + b2;
          key[v] = okey(cv[v]);
        }
        topk16<4>(key, 0, lane, slot);
        const int i2 = si2[lane & 15];
#pragma unroll
        for (int v = 0; v < 4; ++v) {
          if (slot[v] >= 0) {
            lv[slot[v]] = cv[v];
            le[slot[v]] = si1[v * 4 + (lane >> 4)] * 128 + i2;
          }
        }
      }
      wave_lds_sync();
      float mx = lv[0];
#pragma unroll
      for (int k = 1; k < 16; ++k) mx = fmaxf(mx, lv[k]);
      float den = 0.f;
#pragma unroll
      for (int k = 0; k < 16; ++k) den += __expf(lv[k] - mx);
      const float gk = __expf(lv[kq] - mx) / den;
      float pd[16];
#pragma unroll
      for (int hb = 0; hb < 2; ++hb) {
        u32x4 u0[8], u1[8];
#pragma unroll
        for (int k = 0; k < 8; ++k) {
          const bf16_t* up = tabU + (size_t)le[hb * 8 + k] * 1024 + lane * 8;
          u0[k] = *(const u32x4*)up;
          u1[k] = *(const u32x4*)(up + 512);
        }
#pragma unroll
        for (int k = 0; k < 8; ++k) {
          float d = 0.f;
#pragma unroll
          for (int i = 0; i < 4; ++i) {
            d += bflo(u0[k][i]) * hf[2 * i] + bfhi(u0[k][i]) * hf[2 * i + 1];
            d += bflo(u1[k][i]) * hf[8 + 2 * i] + bfhi(u1[k][i]) * hf[8 + 2 * i + 1];
          }
          pd[hb * 8 + k] = d;
        }
      }
      float q8[8], q4[4], q2[2], q1;
      {
        const bool hi = lane & 32;
#pragma unroll
        for (int i = 0; i < 8; ++i) {
          float send = hi ? pd[i] : pd[8 + i], keep = hi ? pd[8 + i] : pd[i];
          q8[i] = keep + __shfl_xor(send, 32);
        }
      }
      {
        const bool hi = lane & 16;
#pragma unroll
        for (int i = 0; i < 4; ++i) {
          float send = hi ? q8[i] : q8[4 + i], keep = hi ? q8[4 + i] : q8[i];
          q4[i] = keep + __shfl_xor(send, 16);
        }
      }
      {
        const bool hi = lane & 8;
#pragma unroll
        for (int i = 0; i < 2; ++i) {
          float send = hi ? q4[i] : q4[2 + i], keep = hi ? q4[2 + i] : q4[i];
          q2[i] = keep + __shfl_xor(send, 8);
        }
      }
      {
        const bool hi = lane & 4;
        float send = hi ? q2[0] : q2[1], keep = hi ? q2[1] : q2[0];
        q1 = keep + __shfl_xor(send, 4);
      }
      q1 += __shfl_xor(q1, 2);
      q1 += __shfl_xor(q1, 1);
      const float wk_own = gk * geluf_(q1);
#pragma unroll
      for (int hb = 0; hb < 2; ++hb) {
        u32x4 u0[8], u1[8];
#pragma unroll
        for (int k = 0; k < 8; ++k) {
          const bf16_t* vp = tabV + (size_t)le[hb * 8 + k] * 1024 + lane * 8;
          u0[k] = *(const u32x4*)vp;
          u1[k] = *(const u32x4*)(vp + 512);
        }
#pragma unroll
        for (int k = 0; k < 8; ++k) {
          const int kk = hb * 8 + k;
          const int src = (((kk >> 3) & 1) << 5) | (((kk >> 2) & 1) << 4) | (((kk >> 1) & 1) << 3) | ((kk & 1) << 2);
          const float wk = __shfl(wk_own, src);
#pragma unroll
          for (int i = 0; i < 4; ++i) {
            oacc[2 * i] += wk * bflo(u0[k][i]);
            oacc[2 * i + 1] += wk * bfhi(u0[k][i]);
            oacc[8 + 2 * i] += wk * bflo(u1[k][i]);
            oacc[8 + 2 * i + 1] += wk * bfhi(u1[k][i]);
          }
        }
      }
      wave_lds_sync();
    }
    float* xr = p.out + (size_t)tok * DM;
    const float* g2 = mod + modidx(tok) * 6144 + 5120;
    float y[16];
    float ss = 0.f;
#pragma unroll
    for (int hb = 0; hb < 2; ++hb)
#pragma unroll
      for (int i = 0; i < 2; ++i) {
        const int e = hb * 512 + lane * 8 + i * 4;
        float4 xv = *(const float4*)(xr + e), gv = *(const float4*)(g2 + e);
        float a0 = xv.x + gv.x * oacc[hb * 8 + i * 4], a1 = xv.y + gv.y * oacc[hb * 8 + i * 4 + 1];
        float a2 = xv.z + gv.z * oacc[hb * 8 + i * 4 + 2], a3 = xv.w + gv.w * oacc[hb * 8 + i * 4 + 3];
        y[hb * 8 + i * 4] = a0; y[hb * 8 + i * 4 + 1] = a1; y[hb * 8 + i * 4 + 2] = a2; y[hb * 8 + i * 4 + 3] = a3;
        ss += a0 * a0 + a1 * a1 + a2 * a2 + a3 * a3;
      }
    ss = wsum(ss);
    const float rstd = rsqrtf(ss * (1.f / 1024.f) + 1e-6f);
#pragma unroll
    for (int hb = 0; hb < 2; ++hb)
#pragma unroll
      for (int i = 0; i < 2; ++i) {
        const int e = hb * 512 + lane * 8 + i * 4;
        float4 nf = *(const float4*)(p.norm_final + e);
        *(float4*)(xr + e) = make_float4(y[hb * 8 + i * 4] * rstd * nf.x, y[hb * 8 + i * 4 + 1] * rstd * nf.y,
                                         y[hb * 8 + i * 4 + 2] * rstd * nf.z, y[hb * 8 + i * 4 + 3] * rstd * nf.w);
      }
  }
}


#define XB_TMO      128
#define XB_XCNT(j)  (256  + 64 * (j))
#define XB_XSUB(j)  (1280 + 64 * (j))
#define XB_XGEN(j)  (2304 + 64 * (j))
#define XB_TOP      3328
#define XB_TOPGEN   3392
#define XCD_BAR_WORDS 3456
#define XB_SPIN_CAP (1u << 22)
#define LAS __attribute__((address_space(3)))
DI unsigned xb_ld(unsigned* p) { return __hip_atomic_load(p, __ATOMIC_RELAXED, __HIP_MEMORY_SCOPE_AGENT); }
DI unsigned xb_add(unsigned* p, unsigned v) { return __hip_atomic_fetch_add(p, v, __ATOMIC_RELAXED, __HIP_MEMORY_SCOPE_AGENT); }
DI unsigned xb_xcc_id() { return (unsigned)__builtin_amdgcn_s_getreg((3 << 11) | 20) & 0xFu; }
#define XB_SPIN(cond, bar) do { unsigned _sp = 0; while (cond) { __builtin_amdgcn_s_sleep(1); \
    if ((++_sp & 255u) == 0u) { if (xb_ld(&(bar)[XB_TMO])) break; if (_sp > XB_SPIN_CAP) { atomicAdd(&(bar)[XB_TMO], 1u); break; } } } } while (0)
struct XcdBarrier { unsigned* bar; unsigned x; volatile LAS unsigned* st; };
DI XcdBarrier xcd_barrier_post(unsigned* bar, volatile LAS unsigned* st) {
  XcdBarrier b; b.bar = bar; b.x = xb_xcc_id(); b.st = st;
  if (threadIdx.x == 0) (void)xb_add(&bar[XB_XCNT(b.x)], 1u);
  return b;
}
DI void xcd_barrier_complete(unsigned* bar, unsigned x, unsigned& nloc, unsigned& nx) {
  const unsigned G = gridDim.x * gridDim.y * gridDim.z;
  unsigned sum, cnt, mine, sp = 0u;
  for (;;) {
    sum = 0u; cnt = 0u; mine = 0u;
#pragma unroll
    for (unsigned j = 0; j < 16; ++j) { const unsigned c = xb_ld(&bar[XB_XCNT(j)]); sum += c; cnt += (c > 0u) ? 1u : 0u; mine = (j == x) ? c : mine; }
    if (sum == G) break;
    __builtin_amdgcn_s_sleep(1);
    if ((++sp & 255u) == 0u) { if (xb_ld(&bar[XB_TMO])) break; if (sp > XB_SPIN_CAP) { atomicAdd(&bar[XB_TMO], 1u); break; } }
  }
  nloc = mine > 0u ? mine : 1u; nx = cnt > 0u ? cnt : 1u;
}
DI void xcd_barrier(const XcdBarrier& b) {
  asm volatile("s_waitcnt vmcnt(0)" ::: "memory");
  __syncthreads();
  if (threadIdx.x == 0) {
    unsigned* bar = b.bar;
    __builtin_amdgcn_s_waitcnt(0);
    unsigned nloc = b.st[0], nx = b.st[1];
    if (nloc == 0u) { xcd_barrier_complete(bar, b.x, nloc, nx); b.st[0] = nloc; b.st[1] = nx; }
    const unsigned old = xb_add(&bar[XB_XSUB(b.x)], 1u);
    const unsigned gen = old / nloc;
    if (old + 1u == (gen + 1u) * nloc) {
      __builtin_amdgcn_fence(__ATOMIC_RELEASE, "agent");
      asm volatile("s_waitcnt vmcnt(0)" ::: "memory");
      const unsigned og = xb_add(&bar[XB_TOP], 1u);
      const unsigned tg = og / nx;
      if (og + 1u == (tg + 1u) * nx) xb_add(&bar[XB_TOPGEN], 1u);
      else XB_SPIN(xb_ld(&bar[XB_TOPGEN]) == tg, bar);
      __builtin_amdgcn_fence(__ATOMIC_ACQUIRE, "agent");
      xb_add(&bar[XB_XGEN(b.x)], 1u);
      asm volatile("s_waitcnt vmcnt(0)" ::: "memory");
    } else {
      XB_SPIN(xb_ld(&bar[XB_XGEN(b.x)]) == gen, bar);
      __builtin_amdgcn_fence(__ATOMIC_ACQUIRE, "agent");
      asm volatile("s_waitcnt vmcnt(0)" ::: "memory");
    }
  }
  __syncthreads();
}

#ifdef ONLY_PHASE
#define RUNPH(n, call) if (ONLY_PHASE == n) { call; }
#else
#define RUNPH(n, call) if (lo <= n && n < hi) { call; if (n + 1 < hi) xcd_barrier(xb); }
#endif
__global__ void __launch_bounds__(256, 2) mega(Params p, int lo, int hi) {
  __shared__ __attribute__((aligned(16))) char smem[SMEM_BYTES];
  __shared__ uint4 xb_words;
  cg::grid_group grid = cg::this_grid();
  if (lo < 0) grid.sync();
  if (threadIdx.x == 0) xb_words = make_uint4(0u, 0u, 0u, 0u);
  __syncthreads();
  XcdBarrier xb = xcd_barrier_post((unsigned*)(p.ws + OFF_BAR), (volatile LAS unsigned*)&xb_words);
  RUNPH(0, phase0(p, smem))
  RUNPH(1, phase1(p, smem))
  RUNPH(2, phase2(p, smem))
  RUNPH(3, phase3(p, smem))
  RUNPH(4, phase4(p))
  RUNPH(5, phase5(p, smem))
  RUNPH(6, phase6(p, smem))
  RUNPH(7, phase7(p, smem))
  RUNPH(8, phase8(p, smem))
  RUNPH(9, phase9(p, smem))
  RUNPH(10, phase10(p, smem))
  RUNPH(11, phase11(p, smem))
  RUNPH(12, phase12(p, smem))
}

extern "C" void kernel_launch(void* const* d_in, const int* in_sizes, int n_in, void* d_out, int out_size, void* d_ws,
                              size_t ws_size, hipStream_t stream) {
  static int grid_blocks = 0;
  if (!grid_blocks) {
    int dev = 0, cus = 0, per_cu = 0;
    hipGetDevice(&dev);
    hipDeviceGetAttribute(&cus, hipDeviceAttributeMultiprocessorCount, dev);
    hipOccupancyMaxActiveBlocksPerMultiprocessor(&per_cu, mega, 256, 0);
    if (per_cu > 2) per_cu = 2;
    if (per_cu < 1) per_cu = 1;
    grid_blocks = cus * per_cu;
  }
  Params p{};
  const float** pp = (const float**)&p;
  for (int i = 0; i < 29; ++i) pp[i] = (const float*)d_in[i];
  p.out = (float*)d_out;
  p.ws = (char*)d_ws;
#if N_LAUNCH_SPLIT
  for (int ph = 0; ph < NPHASE; ++ph) {
    hipLaunchKernelGGL(mega, dim3(grid_blocks), dim3(256), 0, stream, p, ph, ph + 1);
  }
#else
  hipMemsetAsync((char*)d_ws + OFF_BAR, 0, XCD_BAR_WORDS * sizeof(unsigned), stream);
  int lo = 0, hi = NPHASE;
  void* args[] = {&p, &lo, &hi};
  hipError_t e = hipLaunchCooperativeKernel((void*)mega, dim3(grid_blocks), dim3(256), args, 0, stream);
  if (e != hipSuccess) fprintf(stderr, "cooperative launch failed: %s (grid %d)\n", hipGetErrorString(e), grid_blocks);
#endif
}
```

```cpp
#include <hip/hip_runtime.h>
#include <hip/hip_cooperative_groups.h>
#include <cstdio>
namespace cg = cooperative_groups;

#define DI __device__ __forceinline__
typedef unsigned short bf16_t;
using bf16x8 = __attribute__((ext_vector_type(8))) short;
using f32x4 = __attribute__((ext_vector_type(4))) float;
using u32x4 = __attribute__((ext_vector_type(4))) unsigned;
using u32x2 = __attribute__((ext_vector_type(2))) unsigned;

#ifndef N_LAUNCH_SPLIT
#define N_LAUNCH_SPLIT 0
#endif

constexpr int NTOK = 20480, NPT = 4096, DM = 1024;
constexpr int NPHASE = 13;
constexpr size_t MiB = 1u << 20;
constexpr size_t OFF_WINT = 0, OFF_WUQT = 9 * MiB, OFF_WUKVT = 9 * MiB + 512 * 1024, OFF_WUPAT = 10 * MiB,
                 OFF_WUPBT = 11 * MiB, OFF_WOT = 12 * MiB, OFF_WCT = 14 * MiB, OFF_WPQB = 18 * MiB,
                 OFF_KEYSB = 22 * MiB, OFF_MOD = 22 * MiB + 512 * 1024, OFF_BAR = 23 * MiB, A0 = 24 * MiB;
constexpr size_t OFF_H1 = A0 + 0, OFF_CQ = A0 + 40 * MiB, OFF_CKVRAW = A0 + 50 * MiB, OFF_KRRAW = A0 + 60 * MiB,
                 OFF_RQ = A0 + 63 * MiB, OFF_RK = A0 + 83 * MiB, OFF_KT = A0 + 103 * MiB, OFF_VT = A0 + 123 * MiB,
                 OFF_SRG = A0 + 143 * MiB, OFF_CKVALL = A0 + 163 * MiB, OFF_KRALL = A0 + 169 * MiB,
                 OFF_UF = A0 + 171 * MiB, OFF_UB = A0 + 187 * MiB,
                 OFF_SF = A0 + 0, OFF_SB = A0 + 8 * MiB, OFF_RET = A0 + 16 * MiB,
                 OFF_Q = A0 + 63 * MiB, OFF_KN = A0 + 93 * MiB, OFF_VTA = A0 + 117 * MiB, OFF_ATTN = A0 + 141 * MiB,
                 OFF_M = A0 + 163 * MiB,
                 OFF_H2 = A0 + 0, OFF_TABU = A0 + 40 * MiB, OFF_TABV = A0 + 56 * MiB, OFF_INVU = A0 + 72 * MiB,
                 OFF_INVV = A0 + 73 * MiB, OFF_SCORES = A0 + 104 * MiB;
constexpr size_t OUT_CKV = 20971520, OUT_KR = 21495808, OUT_SF = 21626880, OUT_SB = 22675456;
constexpr int NKV = 24576;
constexpr int SMEM_BYTES = 36864;

struct Params {
  const float *x_prompt, *x_sample, *c, *cache_ckv, *cache_krope, *st_f, *st_b, *c_ctx, *w_mod, *b_mod, *norm_mix,
      *norm_ffn, *norm_final, *w_in, *q_norm, *kv_norm, *w_uq, *w_ukv, *lg_f, *lg_b, *ret_gn, *w_up_a, *w_up_b, *w_o,
      *peer_wq, *keys1, *keys2, *peer_u, *peer_v;
  float* out;
  char* ws;
};

DI unsigned f2bf(float x) {
  unsigned u = __float_as_uint(x);
  u += 0x7fffu + ((u >> 16) & 1u);
  return u >> 16;
}
DI float bf2f(unsigned b) { return __uint_as_float(b << 16); }
DI unsigned pack2(float a, float b) { return f2bf(a) | (f2bf(b) << 16); }
DI float bflo(unsigned u) { return __uint_as_float(u << 16); }
DI float bfhi(unsigned u) { return __uint_as_float(u & 0xffff0000u); }
DI float wsum(float v) {
#pragma unroll
  for (int o = 32; o > 0; o >>= 1) v += __shfl_xor(v, o);
  return v;
}
DI float sigmoidf_(float x) { return 1.f / (1.f + __expf(-x)); }
DI float siluf_(float x) { return x / (1.f + __expf(-x)); }
DI float geluf_(float x) { return 0.5f * x * (1.f + tanhf(0.7978845608028654f * (x + 0.044715f * x * x * x))); }
DI const float* xrow(const Params& p, int tok) {
  return tok < NPT ? p.x_prompt + (size_t)tok * DM : p.x_sample + (size_t)(tok - NPT) * DM;
}
DI int modidx(int tok) { return tok < NPT ? 0 : 1 + ((tok - NPT) >> 11); }
DI int kvrow(int tok) {
  if (tok < NPT) return tok;
  int t = tok - NPT;
  return NPT + (t >> 11) * 2560 + (t & 2047);
}
DI void st_bf16x16(bf16_t* dst, const float (&v)[16]) {
  u32x4 a, b;
  a[0] = pack2(v[0], v[1]); a[1] = pack2(v[2], v[3]); a[2] = pack2(v[4], v[5]); a[3] = pack2(v[6], v[7]);
  b[0] = pack2(v[8], v[9]); b[1] = pack2(v[10], v[11]); b[2] = pack2(v[12], v[13]); b[3] = pack2(v[14], v[15]);
  *(u32x4*)dst = a;
  *(u32x4*)(dst + 8) = b;
}
DI void st_f32x16(float* dst, const float (&v)[16]) {
#pragma unroll
  for (int i = 0; i < 4; ++i) *(float4*)(dst + 4 * i) = make_float4(v[4 * i], v[4 * i + 1], v[4 * i + 2], v[4 * i + 3]);
}
DI void ld_bf16x16(const bf16_t* src, float (&v)[16]) {
  u32x4 a = *(const u32x4*)src, b = *(const u32x4*)(src + 8);
#pragma unroll
  for (int i = 0; i < 4; ++i) {
    v[2 * i] = bflo(a[i]); v[2 * i + 1] = bfhi(a[i]);
    v[8 + 2 * i] = bflo(b[i]); v[8 + 2 * i + 1] = bfhi(b[i]);
  }
}

constexpr int LDK = 72;
template <int SCALE>
DI void gemm_kloop(f32x4 (&acc)[4][4], const bf16_t* __restrict__ A, int lda, const bf16_t* __restrict__ B, int ldb,
                   int K, char* smem, float sc_a, float sc_b) {
  bf16_t* As = (bf16_t*)smem;
  bf16_t* Bs = As + 128 * LDK;
  const int tid = threadIdx.x, lane = tid & 63, w = tid >> 6, wm = w >> 1, wn = w & 1, l15 = lane & 15, g = lane >> 4;
  u32x4 ra[4], rb[4];
  int arow[4], kc[4], ldsa[4], ldsb[4];
#pragma unroll
  for (int i = 0; i < 4; ++i) {
    int c = tid + 256 * i;
    int r = c >> 3;
    kc[i] = (c & 7) * 8;
    arow[i] = r;
    int rr = r & 63;
    int rho = (r & 64) | (((rr >> 2) & 3) << 4) | ((rr >> 4) << 2) | (rr & 3);
    ldsa[i] = rho * LDK + kc[i];
    ldsb[i] = r * LDK + kc[i];
  }
#pragma unroll
  for (int i = 0; i < 4; ++i) {
    ra[i] = *(const u32x4*)(A + (size_t)arow[i] * lda + kc[i]);
    rb[i] = *(const u32x4*)(B + (size_t)arow[i] * ldb + kc[i]);
  }
  for (int k0 = 0; k0 < K; k0 += 64) {
    __syncthreads();
#pragma unroll
    for (int i = 0; i < 4; ++i) {
      *(u32x4*)(As + ldsa[i]) = ra[i];
      *(u32x4*)(Bs + ldsb[i]) = rb[i];
    }
    __syncthreads();
    if (k0 + 64 < K) {
#pragma unroll
      for (int i = 0; i < 4; ++i) {
        ra[i] = *(const u32x4*)(A + (size_t)arow[i] * lda + k0 + 64 + kc[i]);
        rb[i] = *(const u32x4*)(B + (size_t)arow[i] * ldb + k0 + 64 + kc[i]);
      }
    }
#pragma unroll
    for (int ks = 0; ks < 2; ++ks) {
      bf16x8 af[4], bfr[4];
#pragma unroll
      for (int f = 0; f < 4; ++f)
        af[f] = *(const bf16x8*)(As + (wm * 64 + f * 16 + l15) * LDK + ks * 32 + g * 8);
#pragma unroll
      for (int c = 0; c < 4; ++c)
        bfr[c] = *(const bf16x8*)(Bs + (wn * 64 + c * 16 + l15) * LDK + ks * 32 + g * 8);
      if (SCALE) {
        float fac[8];
#pragma unroll
        for (int i = 0; i < 8; ++i) fac[i] = exp2f(sc_a + sc_b * (float)(k0 + ks * 32 + g * 8 + i));
#pragma unroll
        for (int f = 0; f < 4; ++f) {
          u32x4 u = __builtin_bit_cast(u32x4, af[f]);
#pragma unroll
          for (int i = 0; i < 4; ++i) u[i] = pack2(bflo(u[i]) * fac[2 * i], bfhi(u[i]) * fac[2 * i + 1]);
          af[f] = __builtin_bit_cast(bf16x8, u);
        }
      }
#pragma unroll
      for (int f = 0; f < 4; ++f)
#pragma unroll
        for (int c = 0; c < 4; ++c) acc[f][c] = __builtin_amdgcn_mfma_f32_16x16x32_bf16(af[f], bfr[c], acc[f][c], 0, 0, 0);
    }
  }
}
DI void acc_zero(f32x4 (&acc)[4][4]) {
#pragma unroll
  for (int f = 0; f < 4; ++f)
#pragma unroll
    for (int c = 0; c < 4; ++c) acc[f][c] = f32x4{0.f, 0.f, 0.f, 0.f};
}
template <class F>
DI void epilogue(const f32x4 (&acc)[4][4], F&& epi) {
  const int tid = threadIdx.x, lane = tid & 63, w = tid >> 6, wm = w >> 1, wn = w & 1, l15 = lane & 15, g = lane >> 4;
#pragma unroll
  for (int c = 0; c < 4; ++c) {
    float v[16];
#pragma unroll
    for (int f = 0; f < 4; ++f)
#pragma unroll
      for (int j = 0; j < 4; ++j) v[f * 4 + j] = acc[f][c][j];
    epi(wm * 64 + 16 * g, wn * 64 + c * 16 + l15, v);
  }
}
DI bool tile_map(int it, int Ft, int Tt, int fsplit, int& ft, int& tt) {
  const int bid = blockIdx.x, nb = gridDim.x;
  int xcd = bid & 7, loc = bid >> 3, nloc = nb >> 3;
  if (loc >= nloc) return false;
  int fg = xcd % fsplit, tg = xcd / fsplit, tsplit = 8 / fsplit;
  int Fg = Ft / fsplit, Tg = Tt / tsplit;
  int i = loc + it * nloc;
  if (i >= Fg * Tg) return false;
  ft = fg * Fg + i % Fg;
  tt = tg * Tg + i / Fg;
  return true;
}
DI int vbid() {
  const int bid = blockIdx.x, nb = gridDim.x;
  if (nb & 7) return bid;
  return (bid & 7) * (nb >> 3) + (bid >> 3);
}

DI int colmap(int mode, int np) {
  if (mode == 1) return np < 416 ? np : (np < 512 ? -1 : np - 96);
  if (mode == 2) return np < 512 ? ((np >> 6) * 128 + (np & 63)) : (((np - 512) >> 6) * 128 + 64 + ((np - 512) & 63));
  return np;
}
DI void tconv_tile(const float* __restrict__ src, int ldsrc, bf16_t* __restrict__ dst, int K, int kt, int nt, int mode,
                   char* smem) {
  float* lds = (float*)smem;
  const int tid = threadIdx.x;
  {
    int col = tid & 63, rq = tid >> 6;
    int n = colmap(mode, nt * 64 + col);
#pragma unroll 4
    for (int r = 0; r < 16; ++r) {
      int kl = r * 4 + rq;
      float v = n >= 0 ? src[(size_t)(kt * 64 + kl) * ldsrc + n] : 0.f;
      lds[kl * 65 + col] = v;
    }
  }
  __syncthreads();
  {
    int nl = tid >> 2, kq = (tid & 3) * 16;
    float v[16];
#pragma unroll
    for (int i = 0; i < 16; ++i) v[i] = lds[(kq + i) * 65 + nl];
    st_bf16x16(dst + (size_t)(nt * 64 + nl) * K + kt * 64 + kq, v);
  }
  __syncthreads();
}
DI void mod_item(const Params& p, int item, char* smem) {
  float* sil = (float*)smem;
  const int tid = threadIdx.x;
  for (int i = tid; i < 9 * 1024; i += 256) {
    int j = i >> 10, k = i & 1023;
    float cv = j == 0 ? p.c_ctx[k] : p.c[(j - 1) * 1024 + k];
    sil[i] = siluf_(cv);
  }
  __syncthreads();
  const int kq = tid >> 6, nn = tid & 63, n0 = item * 64;
  float acc[9];
#pragma unroll
  for (int j = 0; j < 9; ++j) acc[j] = 0.f;
#pragma unroll 4
  for (int k = kq; k < 1024; k += 4) {
    float wv = p.w_mod[(size_t)k * 6144 + n0 + nn];
#pragma unroll
    for (int j = 0; j < 9; ++j) acc[j] += sil[j * 1024 + k] * wv;
  }
  __syncthreads();
  float* part = (float*)smem;
#pragma unroll
  for (int j = 0; j < 9; ++j) part[(kq * 9 + j) * 64 + nn] = acc[j];
  __syncthreads();
  float* mod = (float*)(p.ws + OFF_MOD);
  for (int i = tid; i < 9 * 64; i += 256) {
    int j = i >> 6, n = i & 63;
    float s = part[(0 * 9 + j) * 64 + n] + part[(1 * 9 + j) * 64 + n] + part[(2 * 9 + j) * 64 + n] + part[(3 * 9 + j) * 64 + n];
    mod[j * 6144 + n0 + n] = s + p.b_mod[n0 + n];
  }
  __syncthreads();
}
DI void conv_flat(const float* __restrict__ src, bf16_t* __restrict__ dst, size_t n) {
  size_t i = ((size_t)blockIdx.x * 256 + threadIdx.x) * 8;
  const size_t stride = (size_t)gridDim.x * 256 * 8;
  for (; i < n; i += stride) {
    float4 a = *(const float4*)(src + i), b = *(const float4*)(src + i + 4);
    u32x4 o;
    o[0] = pack2(a.x, a.y); o[1] = pack2(a.z, a.w); o[2] = pack2(b.x, b.y); o[3] = pack2(b.z, b.w);
    *(u32x4*)(dst + i) = o;
  }
}
DI void phase0(const Params& p, char* smem) {
  const int bid = blockIdx.x, nb = gridDim.x;
  char* ws = p.ws;
  const int n_mod = 96;
  const int t_in = 16 * 72, t_uq = 4 * 12, t_ukv = 2 * 16, t_upa = 8 * 16, t_upb = 8 * 16, t_o = 16 * 16;
  const int total = n_mod + t_in + t_uq + t_ukv + t_upa + t_upb + t_o;
  for (int it = bid; it < total; it += nb) {
    int i = it;
    if (i < n_mod) { mod_item(p, i, smem); continue; }
    i -= n_mod;
    if (i < t_in) { tconv_tile(p.w_in, 4512, (bf16_t*)(ws + OFF_WINT), 1024, i / 72, i % 72, 1, smem); continue; }
    i -= t_in;
    if (i < t_uq) { tconv_tile(p.w_uq, 768, (bf16_t*)(ws + OFF_WUQT), 256, i / 12, i % 12, 0, smem); continue; }
    i -= t_uq;
    if (i < t_ukv) { tconv_tile(p.w_ukv, 1024, (bf16_t*)(ws + OFF_WUKVT), 128, i / 16, i % 16, 2, smem); continue; }
    i -= t_ukv;
    if (i < t_upa) { tconv_tile(p.w_up_a, 1024, (bf16_t*)(ws + OFF_WUPAT), 512, i / 16, i % 16, 0, smem); continue; }
    i -= t_upa;
    if (i < t_upb) { tconv_tile(p.w_up_b, 1024, (bf16_t*)(ws + OFF_WUPBT), 512, i / 16, i % 16, 0, smem); continue; }
    i -= t_upb;
    tconv_tile(p.w_o, 1024, (bf16_t*)(ws + OFF_WOT), 1024, i / 16, i % 16, 0, smem);
  }
  conv_flat(p.peer_wq, (bf16_t*)(ws + OFF_WPQB), (size_t)1024 * 2048);
  {
    size_t i = ((size_t)bid * 256 + threadIdx.x) * 8;
    const size_t stride = (size_t)nb * 256 * 8;
    bf16_t* kb = (bf16_t*)(ws + OFF_KEYSB);
    for (; i < (size_t)2 * 131072; i += stride) {
      int half = i >= 131072;
      size_t s = i - (size_t)half * 131072;
      int h = (int)(s >> 14);
      size_t r = s & 16383;
      const float* src = (half ? p.keys2 : p.keys1) + s;
      float4 a = *(const float4*)(src), b = *(const float4*)(src + 4);
      u32x4 o;
      o[0] = pack2(a.x, a.y); o[1] = pack2(a.z, a.w); o[2] = pack2(b.x, b.y); o[3] = pack2(b.z, b.w);
      *(u32x4*)(kb + ((size_t)(h * 2 + half) << 14) + r) = o;
    }
  }
}

DI void rows_norm_mod(const Params& p, const float* nw, int sh_off, int sc_off, bool from_out, bf16_t* dst) {
  const int lane = threadIdx.x & 63, w = threadIdx.x >> 6;
  const float* mod = (const float*)(p.ws + OFF_MOD);
  for (int tok = blockIdx.x * 4 + w; tok < NTOK; tok += gridDim.x * 4) {
    const float* xr = from_out ? p.out + (size_t)tok * DM : xrow(p, tok);
    const float* mj = mod + modidx(tok) * 6144;
    float4 xv[4];
    float ss = 0.f;
#pragma unroll
    for (int i = 0; i < 4; ++i) {
      xv[i] = *(const float4*)(xr + (i * 64 + lane) * 4);
      ss += xv[i].x * xv[i].x + xv[i].y * xv[i].y + xv[i].z * xv[i].z + xv[i].w * xv[i].w;
    }
    ss = wsum(ss);
    float rstd = rsqrtf(ss * (1.f / 1024.f) + 1e-6f);
#pragma unroll
    for (int i = 0; i < 4; ++i) {
      int e = (i * 64 + lane) * 4;
      float4 nv = *(const float4*)(nw + e), sh = *(const float4*)(mj + sh_off + e), sc = *(const float4*)(mj + sc_off + e);
      float h0 = (xv[i].x * rstd) * nv.x * (1.f + sc.x) + sh.x;
      float h1 = (xv[i].y * rstd) * nv.y * (1.f + sc.y) + sh.y;
      float h2 = (xv[i].z * rstd) * nv.z * (1.f + sc.z) + sh.z;
      float h3 = (xv[i].w * rstd) * nv.w * (1.f + sc.w) + sh.w;
      u32x2 o;
      o[0] = pack2(h0, h1); o[1] = pack2(h2, h3);
      *(u32x2*)(dst + (size_t)tok * DM + e) = o;
    }
  }
}
DI void phase1(const Params& p, char* smem) {
  rows_norm_mod(p, p.norm_mix, 0, 1024, false, (bf16_t*)(p.ws + OFF_H1));
  const bf16_t* wpq = (const bf16_t*)(p.ws + OFF_WPQB);
  const bf16_t* kb = (const bf16_t*)(p.ws + OFF_KEYSB);
  bf16_t* wct = (bf16_t*)(p.ws + OFF_WCT);
  for (int it = blockIdx.x; it < 128; it += gridDim.x) {
    int hh = it >> 3, mt = it & 7;
    f32x4 acc[4][4];
    acc_zero(acc);
    gemm_kloop<0>(acc, wpq + (size_t)(mt * 128) * 2048 + hh * 128, 2048, kb + (size_t)hh * 16384, 128, 128, smem, 0.f, 0.f);
    epilogue(acc, [&](int m, int n, float (&v)[16]) { st_bf16x16(wct + (size_t)(hh * 128 + n) * 1024 + mt * 128 + m, v); });
  }
}

DI void phase2(const Params& p, char* smem) {
  char* ws = p.ws;
  const bf16_t* winT = (const bf16_t*)(ws + OFF_WINT);
  const bf16_t* h1 = (const bf16_t*)(ws + OFF_H1);
  bf16_t* cq = (bf16_t*)(ws + OFF_CQ);
  float* ckvraw = (float*)(ws + OFF_CKVRAW);
  float* krraw = (float*)(ws + OFF_KRRAW);
  bf16_t* rq = (bf16_t*)(ws + OFF_RQ);
  bf16_t* rk = (bf16_t*)(ws + OFF_RK);
  bf16_t* kT = (bf16_t*)(ws + OFF_KT);
  bf16_t* vT = (bf16_t*)(ws + OFF_VT);
  bf16_t* srg = (bf16_t*)(ws + OFF_SRG);
  bf16_t* sga = (bf16_t*)p.out;
  bf16_t* sgb = sga + (size_t)NTOK * 1024;
  for (int it = 0;; ++it) {
    int ft, tt;
    if (!tile_map(it, 36, 160, 4, ft, tt)) break;
    f32x4 acc[4][4];
    acc_zero(acc);
    const bf16_t* W = winT + (size_t)ft * 128 * 1024;
    const bf16_t* H = h1 + (size_t)tt * 128 * 1024;
    const int tok0 = tt * 128, f0 = ft * 128;
    if (ft >= 8 && ft < 16) {
      gemm_kloop<0>(acc, H, 1024, W, 1024, 1024, smem, 0.f, 0.f);
      if (ft < 12) {
        epilogue(acc, [&](int m, int n, float (&v)[16]) {
          int feat = f0 - 1024 + n, tok = tok0 + m;
#pragma unroll
          for (int i = 0; i < 16; ++i) v[i] *= 0.08838834764831845f;
          st_bf16x16(kT + (size_t)feat * NTOK + tok, v);
#pragma unroll
          for (int i = 0; i < 16; ++i) rk[(size_t)(tok + i) * 512 + feat] = (bf16_t)f2bf(v[i]);
        });
      } else {
        epilogue(acc, [&](int m, int n, float (&v)[16]) {
          int feat = f0 - 1536 + n, tok = tok0 + m;
          st_bf16x16(vT + (size_t)feat * NTOK + tok, v);
        });
      }
    } else {
      gemm_kloop<0>(acc, W, 1024, H, 1024, 1024, smem, 0.f, 0.f);
      if (ft < 2) {
        epilogue(acc, [&](int m, int n, float (&v)[16]) { st_bf16x16(cq + (size_t)(tok0 + n) * 256 + f0 + m, v); });
      } else if (ft == 2) {
        epilogue(acc, [&](int m, int n, float (&v)[16]) { st_f32x16(ckvraw + (size_t)(tok0 + n) * 128 + m, v); });
      } else if (ft == 3) {
        epilogue(acc, [&](int m, int n, float (&v)[16]) {
          if (m < 32) st_f32x16(krraw + (size_t)(tok0 + n) * 32 + m, v);
        });
      } else if (ft < 8) {
        epilogue(acc, [&](int m, int n, float (&v)[16]) { st_bf16x16(rq + (size_t)(tok0 + n) * 512 + f0 - 512 + m, v); });
      } else if (ft < 20) {
        epilogue(acc, [&](int m, int n, float (&v)[16]) {
#pragma unroll
          for (int i = 0; i < 16; ++i) v[i] = siluf_(v[i]);
          st_bf16x16(srg + (size_t)(tok0 + n) * 512 + f0 - 2048 + m, v);
        });
      } else if (ft < 28) {
        epilogue(acc, [&](int m, int n, float (&v)[16]) {
#pragma unroll
          for (int i = 0; i < 16; ++i) v[i] = sigmoidf_(v[i]);
          st_bf16x16(sga + (size_t)(tok0 + n) * 1024 + f0 - 2560 + m, v);
        });
      } else {
        epilogue(acc, [&](int m, int n, float (&v)[16]) {
#pragma unroll
          for (int i = 0; i < 16; ++i) v[i] = sigmoidf_(v[i]);
          st_bf16x16(sgb + (size_t)(tok0 + n) * 1024 + f0 - 3584 + m, v);
        });
      }
    }
  }
}

DI float log2gamma(float logit) { return -log1pf(expf(-logit)) * 1.4426950408889634f; }
DI void phase3(const Params& p, char* smem) {
  char* ws = p.ws;
  const int lane = threadIdx.x & 63, w = threadIdx.x >> 6;
  bf16_t* cq = (bf16_t*)(ws + OFF_CQ);
  const float* ckvraw = (const float*)(ws + OFF_CKVRAW);
  const float* krraw = (const float*)(ws + OFF_KRRAW);
  bf16_t* ckvall = (bf16_t*)(ws + OFF_CKVALL);
  bf16_t* krall = (bf16_t*)(ws + OFF_KRALL);
  for (int r = blockIdx.x * 4 + w; r < NTOK + 4096; r += gridDim.x * 4) {
    if (r < NTOK) {
      const int tok = r;
      {
        u32x2 u = *(const u32x2*)(cq + (size_t)tok * 256 + lane * 4);
        float a0 = bflo(u[0]), a1 = bfhi(u[0]), a2 = bflo(u[1]), a3 = bfhi(u[1]);
        float ss = wsum(a0 * a0 + a1 * a1 + a2 * a2 + a3 * a3);
        float rstd = rsqrtf(ss * (1.f / 256.f) + 1e-6f);
        float4 nq = *(const float4*)(p.q_norm + lane * 4);
        u32x2 o;
        o[0] = pack2(a0 * rstd * nq.x, a1 * rstd * nq.y);
        o[1] = pack2(a2 * rstd * nq.z, a3 * rstd * nq.w);
        *(u32x2*)(cq + (size_t)tok * 256 + lane * 4) = o;
      }
      const int row = kvrow(tok);
      {
        float2 v = *(const float2*)(ckvraw + (size_t)tok * 128 + lane * 2);
        float ss = wsum(v.x * v.x + v.y * v.y);
        float rstd = rsqrtf(ss * (1.f / 128.f) + 1e-6f);
        float2 nk = *(const float2*)(p.kv_norm + lane * 2);
        float o0 = v.x * rstd * nk.x, o1 = v.y * rstd * nk.y;
        if (tok < NPT) *(float2*)(p.out + OUT_CKV + (size_t)tok * 128 + lane * 2) = make_float2(o0, o1);
        *(unsigned*)(ckvall + (size_t)row * 128 + lane * 2) = pack2(o0, o1);
      }
      if (lane < 32) {
        float own = krraw[(size_t)tok * 32 + lane];
        float o = own;
        if (tok < NPT) {
          p.out[OUT_KR + (size_t)tok * 32 + lane] = own;
        } else {
          float partner = krraw[(size_t)tok * 32 + (lane ^ 16)];
          int t = (tok - NPT) & 2047;
          int a = lane & 15;
          float pos = (a < 8) ? (float)(t >> 6) : (float)(t & 63);
          float fr = exp2f(-(float)(a & 7) * 1.6609640474436813f);
          float sn, cs;
          sincosf(pos * fr, &sn, &cs);
          o = lane < 16 ? own * cs - partner * sn : partner * sn + own * cs;
        }
        krall[(size_t)row * 32 + lane] = (bf16_t)f2bf(o);
      }
    } else {
      const int cr = r - NTOK;
      const int b = cr >> 9, pos = cr & 511;
      const int row = NPT + b * 2560 + 2048 + pos;
      float2 v = *(const float2*)(p.cache_ckv + (size_t)cr * 128 + lane * 2);
      *(unsigned*)(ckvall + (size_t)row * 128 + lane * 2) = pack2(v.x, v.y);
      if (lane < 32) krall[(size_t)row * 32 + lane] = (bf16_t)f2bf(p.cache_krope[(size_t)cr * 32 + lane]);
    }
  }
  const bf16_t* kT = (const bf16_t*)(ws + OFF_KT);
  const bf16_t* vT = (const bf16_t*)(ws + OFF_VT);
  float* Uf = (float*)(ws + OFF_UF);
  float* Ub = (float*)(ws + OFF_UB);
  for (int it = blockIdx.x; it < 320; it += gridDim.x) {
    const int blk = it >> 2, h = it & 3;
    const float l2f = log2gamma(p.lg_f[h]), l2b = log2gamma(p.lg_b[h]);
    const bf16_t* Kp = kT + (size_t)(h * 128) * NTOK + blk * 256;
    const bf16_t* Vp = vT + (size_t)(h * 128) * NTOK + blk * 256;
#pragma unroll 1
    for (int dir = 0; dir < 2; ++dir) {
      const float sa = dir ? 0.f : l2f * 255.f, sb = dir ? l2b : -l2f;
      f32x4 acc[4][4];
      acc_zero(acc);
      if (blk < 16) {
        gemm_kloop<1>(acc, Vp, NTOK, Kp, NTOK, 256, smem, sa, sb);
        float* dst = p.out + (dir ? OUT_SB : OUT_SF) + (size_t)(blk * 4 + h) * 16384;
        epilogue(acc, [&](int m, int n, float (&v)[16]) { st_f32x16(dst + n * 128 + m, v); });
      } else {
        gemm_kloop<1>(acc, Kp, NTOK, Vp, NTOK, 256, smem, sa, sb);
        float* dst = (dir ? Ub : Uf) + (size_t)((blk - 16) * 4 + h) * 16384;
        epilogue(acc, [&](int m, int n, float (&v)[16]) { st_f32x16(dst + n * 128 + m, v); });
      }
    }
  }
}

DI void phase4(const Params& p) {
  char* ws = p.ws;
  const float* Uf = (const float*)(ws + OFF_UF);
  const float* Ub = (const float*)(ws + OFF_UB);
  bf16_t* Sf = (bf16_t*)(ws + OFF_SF);
  bf16_t* Sb = (bf16_t*)(ws + OFF_SB);
  for (int idx = blockIdx.x * 256 + threadIdx.x; idx < (1 << 20); idx += gridDim.x * 256) {
    int d = idx & 127, e = (idx >> 7) & 127, h = (idx >> 14) & 3, b = (idx >> 16) & 7, dir = idx >> 19;
    size_t eo = (size_t)e * 128 + d;
    if (dir == 0) {
      float cf = exp2f(log2gamma(p.lg_f[h]) * 256.f);
      float S = p.st_f[(size_t)(b * 4 + h) * 16384 + d * 128 + e];
#pragma unroll
      for (int blk = 0; blk < 8; ++blk) {
        size_t o = (size_t)((b * 8 + blk) * 4 + h) * 16384 + eo;
        Sf[o] = (bf16_t)f2bf(S);
        S = cf * S + Uf[o];
      }
    } else {
      float cb = exp2f(log2gamma(p.lg_b[h]) * 256.f);
      float S = p.st_b[(size_t)(b * 4 + h) * 16384 + d * 128 + e];
#pragma unroll
      for (int blk = 7; blk >= 0; --blk) {
        size_t o = (size_t)((b * 8 + blk) * 4 + h) * 16384 + eo;
        Sb[o] = (bf16_t)f2bf(S);
        S = cb * S + Ub[o];
      }
    }
  }
}

DI bf16x8 scale_frag(bf16x8 q, float s) {
  u32x4 u = __builtin_bit_cast(u32x4, q);
#pragma unroll
  for (int i = 0; i < 4; ++i) u[i] = pack2(bflo(u[i]) * s, bfhi(u[i]) * s);
  return __builtin_bit_cast(bf16x8, u);
}
constexpr int NQT = 1;
DI void phase5(const Params& p, char* smem) {
  char* ws = p.ws;
  const bf16_t* rq = (const bf16_t*)(ws + OFF_RQ);
  const bf16_t* rk = (const bf16_t*)(ws + OFF_RK);
  const bf16_t* vT = (const bf16_t*)(ws + OFF_VT);
  const bf16_t* srg = (const bf16_t*)(ws + OFF_SRG);
  const bf16_t* Sf = (const bf16_t*)(ws + OFF_SF);
  const bf16_t* Sb = (const bf16_t*)(ws + OFF_SB);
  bf16_t* ret = (bf16_t*)(ws + OFF_RET);
  bf16_t* Ks = (bf16_t*)smem;
  bf16_t* Vs = Ks + 64 * 136;
  const int tid = threadIdx.x, lane = tid & 63, w = tid >> 6, l15 = lane & 15, g = lane >> 4;
  for (int item = vbid(); item < 640 * (2 / NQT); item += gridDim.x) {
    const int qb = item >> 2, h = item & 3, blk = (qb * NQT) >> 2;
    const float l2f = log2gamma(p.lg_f[h]), l2b = log2gamma(p.lg_b[h]);
    const int tokw = qb * (64 * NQT) + w * (16 * NQT);
    bf16x8 Q[NQT][4];
#pragma unroll
    for (int qt = 0; qt < NQT; ++qt)
#pragma unroll
      for (int ks = 0; ks < 4; ++ks)
        Q[qt][ks] = *(const bf16x8*)(rq + (size_t)(tokw + qt * 16 + l15) * 512 + h * 128 + ks * 32 + g * 8);
    f32x4 o[8][NQT];
#pragma unroll
    for (int et = 0; et < 8; ++et)
#pragma unroll
      for (int qt = 0; qt < NQT; ++qt) o[et][qt] = f32x4{0.f, 0.f, 0.f, 0.f};
#pragma unroll 1
    for (int kt = 0; kt < 4; ++kt) {
      const int key0 = blk * 256 + kt * 64;
      __syncthreads();
#pragma unroll
      for (int i = 0; i < 4; ++i) {
        int c = tid + 256 * i;
        int r = c >> 4, cc = (c & 15) * 8;
        *(u32x4*)(Ks + r * 136 + cc) = *(const u32x4*)(rk + (size_t)(key0 + r) * 512 + h * 128 + cc);
        int e = c >> 3, c2 = (c & 7) * 8;
        *(u32x4*)(Vs + e * 72 + c2) = *(const u32x4*)(vT + (size_t)(h * 128 + e) * NTOK + key0 + c2);
      }
      __syncthreads();
      bf16x8 P[NQT][2];
#pragma unroll
      for (int qt = 0; qt < NQT; ++qt) {
        f32x4 s[4];
#pragma unroll
        for (int kk = 0; kk < 4; ++kk) s[kk] = f32x4{0.f, 0.f, 0.f, 0.f};
#pragma unroll
        for (int ks = 0; ks < 4; ++ks) {
#pragma unroll
          for (int kk = 0; kk < 4; ++kk) {
            bf16x8 a = *(const bf16x8*)(Ks + (kk * 16 + l15) * 136 + ks * 32 + g * 8);
            s[kk] = __builtin_amdgcn_mfma_f32_16x16x32_bf16(a, Q[qt][ks], s[kk], 0, 0, 0);
          }
        }
        const int iq = (tokw + qt * 16 + l15) & 255;
#pragma unroll
        for (int kk = 0; kk < 4; ++kk) {
#pragma unroll
          for (int j = 0; j < 4; ++j) {
            int jk = kt * 64 + kk * 16 + 4 * g + j;
            int diff = iq - jk;
            float dm = diff > 0 ? exp2f(l2f * (float)diff) : (diff < 0 ? exp2f(l2b * (float)(-diff)) : 2.f);
            s[kk][j] *= dm;
          }
        }
#pragma unroll
        for (int k2 = 0; k2 < 2; ++k2) {
          u32x4 u;
          u[0] = pack2(s[2 * k2][0], s[2 * k2][1]);
          u[1] = pack2(s[2 * k2][2], s[2 * k2][3]);
          u[2] = pack2(s[2 * k2 + 1][0], s[2 * k2 + 1][1]);
          u[3] = pack2(s[2 * k2 + 1][2], s[2 * k2 + 1][3]);
          P[qt][k2] = __builtin_bit_cast(bf16x8, u);
        }
      }
#pragma unroll
      for (int k2 = 0; k2 < 2; ++k2) {
#pragma unroll
        for (int et = 0; et < 8; ++et) {
          u32x2 lo = *(const u32x2*)(Vs + (et * 16 + l15) * 72 + k2 * 32 + 4 * g);
          u32x2 hi = *(const u32x2*)(Vs + (et * 16 + l15) * 72 + k2 * 32 + 16 + 4 * g);
          u32x4 u;
          u[0] = lo[0]; u[1] = lo[1]; u[2] = hi[0]; u[3] = hi[1];
          bf16x8 a = __builtin_bit_cast(bf16x8, u);
#pragma unroll
          for (int qt = 0; qt < NQT; ++qt) o[et][qt] = __builtin_amdgcn_mfma_f32_16x16x32_bf16(a, P[qt][k2], o[et][qt], 0, 0, 0);
        }
      }
    }
    if (blk >= 16) {
#pragma unroll 1
      for (int dir = 0; dir < 2; ++dir) {
        const bf16_t* S = (dir ? Sb : Sf) + (size_t)((blk - 16) * 4 + h) * 16384;
        float dq[NQT];
#pragma unroll
        for (int qt = 0; qt < NQT; ++qt) {
          int iq = (tokw + qt * 16 + l15) & 255;
          dq[qt] = dir ? exp2f(l2b * (float)(256 - iq)) : exp2f(l2f * (float)(iq + 1));
        }
#pragma unroll
        for (int ks = 0; ks < 4; ++ks) {
          bf16x8 qs[NQT];
#pragma unroll
          for (int qt = 0; qt < NQT; ++qt) qs[qt] = scale_frag(Q[qt][ks], dq[qt]);
#pragma unroll
          for (int et = 0; et < 8; ++et) {
            bf16x8 a = *(const bf16x8*)(S + (size_t)(et * 16 + l15) * 128 + ks * 32 + g * 8);
#pragma unroll
            for (int qt = 0; qt < NQT; ++qt) o[et][qt] = __builtin_amdgcn_mfma_f32_16x16x32_bf16(a, qs[qt], o[et][qt], 0, 0, 0);
          }
        }
      }
    }
#pragma unroll
    for (int qt = 0; qt < NQT; ++qt) {
      const int tok = tokw + qt * 16 + l15;
      float s1 = 0.f;
#pragma unroll
      for (int et = 0; et < 8; ++et)
#pragma unroll
        for (int j = 0; j < 4; ++j) s1 += o[et][qt][j];
      s1 += __shfl_xor(s1, 16);
      s1 += __shfl_xor(s1, 32);
      const float mu = s1 * (1.f / 128.f);
      float s2 = 0.f;
#pragma unroll
      for (int et = 0; et < 8; ++et)
#pragma unroll
        for (int j = 0; j < 4; ++j) {
          float dlt = o[et][qt][j] - mu;
          s2 += dlt * dlt;
        }
      s2 += __shfl_xor(s2, 16);
      s2 += __shfl_xor(s2, 32);
      const float rstd = rsqrtf(s2 * (1.f / 128.f) + 1e-6f);
#pragma unroll
      for (int et = 0; et < 8; ++et) {
        const int e = h * 128 + et * 16 + 4 * g;
        float4 gn = *(const float4*)(p.ret_gn + e);
        u32x2 sg = *(const u32x2*)(srg + (size_t)tok * 512 + e);
        u32x2 ov;
        ov[0] = pack2((o[et][qt][0] - mu) * rstd * gn.x * bflo(sg[0]), (o[et][qt][1] - mu) * rstd * gn.y * bfhi(sg[0]));
        ov[1] = pack2((o[et][qt][2] - mu) * rstd * gn.z * bflo(sg[1]), (o[et][qt][3] - mu) * rstd * gn.w * bfhi(sg[1]));
        *(u32x2*)(ret + (size_t)tok * 512 + e) = ov;
      }
    }
  }
}

DI void phase6(const Params& p, char* smem) {
  char* ws = p.ws;
  const bf16_t* cqn = (const bf16_t*)(ws + OFF_CQ);
  const bf16_t* wuqT = (const bf16_t*)(ws + OFF_WUQT);
  bf16_t* q = (bf16_t*)(ws + OFF_Q);
  for (int it = 0;; ++it) {
    int ft, tt;
    if (!tile_map(it, 6, 160, 1, ft, tt)) break;
    f32x4 acc[4][4];
    acc_zero(acc);
    gemm_kloop<0>(acc, wuqT + (size_t)ft * 128 * 256, 256, cqn + (size_t)tt * 128 * 256, 256, 256, smem, 0.f, 0.f);
    epilogue(acc, [&](int m, int n, float (&v)[16]) { st_bf16x16(q + (size_t)(tt * 128 + n) * 768 + ft * 128 + m, v); });
  }
  const bf16_t* ckvall = (const bf16_t*)(ws + OFF_CKVALL);
  const bf16_t* wukvT = (const bf16_t*)(ws + OFF_WUKVT);
  bf16_t* Kn = (bf16_t*)(ws + OFF_KN);
  bf16_t* Vt = (bf16_t*)(ws + OFF_VTA);
  for (int it = 0;; ++it) {
    int ft, tt;
    if (!tile_map(it, 8, 192, 1, ft, tt)) break;
    f32x4 acc[4][4];
    acc_zero(acc);
    const bf16_t* W = wukvT + (size_t)ft * 128 * 128;
    const bf16_t* X = ckvall + (size_t)tt * 128 * 128;
    if (ft < 4) {
      gemm_kloop<0>(acc, W, 128, X, 128, 128, smem, 0.f, 0.f);
      epilogue(acc, [&](int m, int n, float (&v)[16]) { st_bf16x16(Kn + (size_t)(tt * 128 + n) * 512 + ft * 128 + m, v); });
    } else {
      gemm_kloop<0>(acc, X, 128, W, 128, 128, smem, 0.f, 0.f);
      epilogue(acc, [&](int m, int n, float (&v)[16]) { st_bf16x16(Vt + (size_t)((ft - 4) * 128 + n) * NKV + tt * 128 + m, v); });
    }
  }
}

DI void phase7(const Params& p, char* smem) {
  char* ws = p.ws;
  const bf16_t* q = (const bf16_t*)(ws + OFF_Q);
  const bf16_t* Kn = (const bf16_t*)(ws + OFF_KN);
  const bf16_t* Vt = (const bf16_t*)(ws + OFF_VTA);
  const bf16_t* krall = (const bf16_t*)(ws + OFF_KRALL);
  bf16_t* attn = (bf16_t*)(ws + OFF_ATTN);
  bf16_t* Ks = (bf16_t*)smem;
  bf16_t* Vs = Ks + 64 * 104;
  const int tid = threadIdx.x, lane = tid & 63, w = tid >> 6, l15 = lane & 15, g = lane >> 4;
  const float qscale = 0.10206207261596577f * 1.4426950408889634f;
  for (int item = vbid(); item < 1280; item += gridDim.x) {
    int b, h, qtok0, keyrow0, nkt;
    bool sample;
    if (item < 1024) {
      sample = true; b = item >> 7; h = (item >> 4) & 7; int qb = item & 15;
      qtok0 = NPT + b * 2048 + qb * 128; keyrow0 = NPT + b * 2560; nkt = 40;
    } else {
      int it2 = item - 1024;
      sample = false; b = it2 >> 4; h = (it2 >> 1) & 7; int qb = it2 & 1;
      qtok0 = b * 256 + qb * 128; keyrow0 = b * 256; nkt = 4;
    }
    bf16x8 Q[2][3];
#pragma unroll
    for (int qt = 0; qt < 2; ++qt) {
      const int tokq = qtok0 + w * 32 + qt * 16 + l15;
      const bf16_t* qp = q + (size_t)tokq * 768 + h * 96;
#pragma unroll
      for (int ks = 0; ks < 3; ++ks) {
        u32x4 u = *(const u32x4*)(qp + ks * 32 + g * 8);
        float v[8];
#pragma unroll
        for (int i = 0; i < 4; ++i) { v[2 * i] = bflo(u[i]); v[2 * i + 1] = bfhi(u[i]); }
        if (ks == 2 && sample) {
          u32x4 up = *(const u32x4*)(qp + 64 + (g ^ 2) * 8);
          float pv[8];
#pragma unroll
          for (int i = 0; i < 4; ++i) { pv[2 * i] = bflo(up[i]); pv[2 * i + 1] = bfhi(up[i]); }
          int t = (tokq - NPT) & 2047;
          float pos = (g & 1) ? (float)(t & 63) : (float)(t >> 6);
#pragma unroll
          for (int i = 0; i < 8; ++i) {
            float fr = exp2f(-(float)i * 1.6609640474436813f);
            float sn, cs;
            sincosf(pos * fr, &sn, &cs);
            v[i] = g < 2 ? v[i] * cs - pv[i] * sn : pv[i] * sn + v[i] * cs;
          }
        }
        u32x4 o4;
#pragma unroll
        for (int i = 0; i < 4; ++i) o4[i] = pack2(v[2 * i] * qscale, v[2 * i + 1] * qscale);
        Q[qt][ks] = __builtin_bit_cast(bf16x8, o4);
      }
    }
    f32x4 o[4][2];
#pragma unroll
    for (int et = 0; et < 4; ++et)
#pragma unroll
      for (int qt = 0; qt < 2; ++qt) o[et][qt] = f32x4{0.f, 0.f, 0.f, 0.f};
    float mrun[2] = {-1e30f, -1e30f}, lrun[2] = {0.f, 0.f};
    u32x4 rk_[3], rv_[2];
    auto gload = [&](int kt) {
      const int row0 = keyrow0 + kt * 64;
#pragma unroll
      for (int i = 0; i < 3; ++i) {
        int c = tid + 256 * i;
        int r = c / 12, cc = c - r * 12;
        rk_[i] = cc < 8 ? *(const u32x4*)(Kn + (size_t)(row0 + r) * 512 + h * 64 + cc * 8)
                        : *(const u32x4*)(krall + (size_t)(row0 + r) * 32 + (cc - 8) * 8);
      }
#pragma unroll
      for (int i = 0; i < 2; ++i) {
        int c = tid + 256 * i;
        int e = c >> 3, cc = (c & 7) * 8;
        rv_[i] = *(const u32x4*)(Vt + (size_t)(h * 64 + e) * NKV + row0 + cc);
      }
    };
    gload(0);
#pragma unroll 1
    for (int kt = 0; kt < nkt; ++kt) {
      __syncthreads();
#pragma unroll
      for (int i = 0; i < 3; ++i) {
        int c = tid + 256 * i;
        int r = c / 12, cc = c - r * 12;
        *(u32x4*)(Ks + r * 104 + cc * 8) = rk_[i];
      }
#pragma unroll
      for (int i = 0; i < 2; ++i) {
        int c = tid + 256 * i;
        int e = c >> 3, cc = (c & 7) * 8;
        *(u32x4*)(Vs + e * 72 + cc) = rv_[i];
      }
      __syncthreads();
      if (kt + 1 < nkt) gload(kt + 1);
      f32x4 s[4][2];
#pragma unroll
      for (int kk = 0; kk < 4; ++kk)
#pragma unroll
        for (int qt = 0; qt < 2; ++qt) s[kk][qt] = f32x4{0.f, 0.f, 0.f, 0.f};
#pragma unroll
      for (int ks = 0; ks < 3; ++ks) {
#pragma unroll
        for (int kk = 0; kk < 4; ++kk) {
          bf16x8 a = *(const bf16x8*)(Ks + (kk * 16 + l15) * 104 + ks * 32 + g * 8);
#pragma unroll
          for (int qt = 0; qt < 2; ++qt) s[kk][qt] = __builtin_amdgcn_mfma_f32_16x16x32_bf16(a, Q[qt][ks], s[kk][qt], 0, 0, 0);
        }
      }
      bf16x8 P[2][2];
#pragma unroll
      for (int qt = 0; qt < 2; ++qt) {
        float mx = s[0][qt][0];
#pragma unroll
        for (int kk = 0; kk < 4; ++kk)
#pragma unroll
          for (int j = 0; j < 4; ++j) mx = fmaxf(mx, s[kk][qt][j]);
        mx = fmaxf(mx, __shfl_xor(mx, 16));
        mx = fmaxf(mx, __shfl_xor(mx, 32));
        const float mnew = fmaxf(mrun[qt], mx);
        const float alpha = exp2f(mrun[qt] - mnew);
        mrun[qt] = mnew;
        float ps = 0.f;
#pragma unroll
        for (int kk = 0; kk < 4; ++kk)
#pragma unroll
          for (int j = 0; j < 4; ++j) {
            float e_ = exp2f(s[kk][qt][j] - mnew);
            s[kk][qt][j] = e_;
            ps += e_;
          }
        lrun[qt] = lrun[qt] * alpha + ps;
#pragma unroll
        for (int et = 0; et < 4; ++et)
#pragma unroll
          for (int j = 0; j < 4; ++j) o[et][qt][j] *= alpha;
#pragma unroll
        for (int k2 = 0; k2 < 2; ++k2) {
          u32x4 u;
          u[0] = pack2(s[2 * k2][qt][0], s[2 * k2][qt][1]);
          u[1] = pack2(s[2 * k2][qt][2], s[2 * k2][qt][3]);
          u[2] = pack2(s[2 * k2 + 1][qt][0], s[2 * k2 + 1][qt][1]);
          u[3] = pack2(s[2 * k2 + 1][qt][2], s[2 * k2 + 1][qt][3]);
          P[qt][k2] = __builtin_bit_cast(bf16x8, u);
        }
      }
#pragma unroll
      for (int k2 = 0; k2 < 2; ++k2) {
#pragma unroll
        for (int et = 0; et < 4; ++et) {
          u32x2 lo = *(const u32x2*)(Vs + (et * 16 + l15) * 72 + k2 * 32 + 4 * g);
          u32x2 hi = *(const u32x2*)(Vs + (et * 16 + l15) * 72 + k2 * 32 + 16 + 4 * g);
          u32x4 u;
          u[0] = lo[0]; u[1] = lo[1]; u[2] = hi[0]; u[3] = hi[1];
          bf16x8 a = __builtin_bit_cast(bf16x8, u);
#pragma unroll
          for (int qt = 0; qt < 2; ++qt) o[et][qt] = __builtin_amdgcn_mfma_f32_16x16x32_bf16(a, P[qt][k2], o[et][qt], 0, 0, 0);
        }
      }
    }
#pragma unroll
    for (int qt = 0; qt < 2; ++qt) {
      const int tokq = qtok0 + w * 32 + qt * 16 + l15;
      float lt = lrun[qt];
      lt += __shfl_xor(lt, 16);
      lt += __shfl_xor(lt, 32);
      const float inv = 1.f / lt;
#pragma unroll
      for (int et = 0; et < 4; ++et) {
        u32x2 ov;
        ov[0] = pack2(o[et][qt][0] * inv, o[et][qt][1] * inv);
        ov[1] = pack2(o[et][qt][2] * inv, o[et][qt][3] * inv);
        *(u32x2*)(attn + (size_t)tokq * 512 + h * 64 + et * 16 + 4 * g) = ov;
      }
    }
  }
}

DI void phase8(const Params& p, char* smem) {
  char* ws = p.ws;
  const bf16_t* attn = (const bf16_t*)(ws + OFF_ATTN);
  const bf16_t* ret = (const bf16_t*)(ws + OFF_RET);
  const bf16_t* wa = (const bf16_t*)(ws + OFF_WUPAT);
  const bf16_t* wb = (const bf16_t*)(ws + OFF_WUPBT);
  const bf16_t* sga = (const bf16_t*)p.out;
  const bf16_t* sgb = sga + (size_t)NTOK * 1024;
  bf16_t* mbuf = (bf16_t*)(ws + OFF_M);
  const int tid = threadIdx.x, lane = tid & 63, w = tid >> 6, wm = w >> 1, wn = w & 1, l15 = lane & 15, g = lane >> 4;
  for (int it = 0;; ++it) {
    int ft, tt;
    if (!tile_map(it, 8, 160, 1, ft, tt)) break;
    f32x4 acc[4][4];
    acc_zero(acc);
    gemm_kloop<0>(acc, wa + (size_t)ft * 128 * 512, 512, attn + (size_t)tt * 128 * 512, 512, 512, smem, 0.f, 0.f);
#pragma unroll
    for (int c = 0; c < 4; ++c) {
      const size_t off = (size_t)(tt * 128 + wn * 64 + c * 16 + l15) * 1024 + ft * 128 + wm * 64 + 16 * g;
      float a[16], bq[16];
      ld_bf16x16(sga + off, a);
      ld_bf16x16(sgb + off, bq);
#pragma unroll
      for (int f = 0; f < 4; ++f)
#pragma unroll
        for (int j = 0; j < 4; ++j) acc[f][c][j] *= a[f * 4 + j] / fmaxf(bq[f * 4 + j], 1e-30f);
    }
    gemm_kloop<0>(acc, wb + (size_t)ft * 128 * 512, 512, ret + (size_t)tt * 128 * 512, 512, 512, smem, 0.f, 0.f);
    epilogue(acc, [&](int m, int n, float (&v)[16]) {
      const size_t off = (size_t)(tt * 128 + n) * 1024 + ft * 128 + m;
      float bq[16];
      ld_bf16x16(sgb + off, bq);
#pragma unroll
      for (int i = 0; i < 16; ++i) v[i] *= bq[i];
      st_bf16x16(mbuf + off, v);
    });
  }
}
DI void phase9(const Params& p, char* smem) {
  char* ws = p.ws;
  const bf16_t* mbuf = (const bf16_t*)(ws + OFF_M);
  const bf16_t* wo = (const bf16_t*)(ws + OFF_WOT);
  const float* mod = (const float*)(ws + OFF_MOD);
  for (int it = 0;; ++it) {
    int ft, tt;
    if (!tile_map(it, 8, 160, 1, ft, tt)) break;
    f32x4 acc[4][4];
    acc_zero(acc);
    gemm_kloop<0>(acc, wo + (size_t)ft * 128 * 1024, 1024, mbuf + (size_t)tt * 128 * 1024, 1024, 1024, smem, 0.f, 0.f);
    epilogue(acc, [&](int m, int n, float (&v)[16]) {
      const int tok = tt * 128 + n, feat = ft * 128 + m;
      const float* xr = xrow(p, tok) + feat;
      const float* g1 = mod + modidx(tok) * 6144 + 2048 + feat;
#pragma unroll
      for (int i = 0; i < 4; ++i) {
        float4 xv = *(const float4*)(xr + 4 * i), gv = *(const float4*)(g1 + 4 * i);
        v[4 * i] = xv.x + gv.x * v[4 * i];
        v[4 * i + 1] = xv.y + gv.y * v[4 * i + 1];
        v[4 * i + 2] = xv.z + gv.z * v[4 * i + 2];
        v[4 * i + 3] = xv.w + gv.w * v[4 * i + 3];
      }
      st_f32x16(p.out + (size_t)tok * DM + feat, v);
    });
  }
}
DI void conv_fp8_rows(const float* __restrict__ src, unsigned char* __restrict__ dst, float* __restrict__ inv) {
  const int lane = threadIdx.x & 63, w = threadIdx.x >> 6;
  for (int r = blockIdx.x * 4 + w; r < 16384; r += gridDim.x * 4) {
    const float* sp = src + (size_t)r * 1024 + lane * 16;
    float4 v[4];
    float am = 0.f;
#pragma unroll
    for (int i = 0; i < 4; ++i) {
      v[i] = *(const float4*)(sp + 4 * i);
      am = fmaxf(am, fmaxf(fmaxf(fabsf(v[i].x), fabsf(v[i].y)), fmaxf(fabsf(v[i].z), fabsf(v[i].w))));
    }
#pragma unroll
    for (int o = 32; o > 0; o >>= 1) am = fmaxf(am, __shfl_xor(am, o));
    const float sc = am > 0.f ? 448.f / am : 1.f;
    u32x4 o4;
#pragma unroll
    for (int i = 0; i < 4; ++i) {
      int wd = 0;
      wd = __builtin_amdgcn_cvt_pk_fp8_f32(v[i].x * sc, v[i].y * sc, wd, false);
      wd = __builtin_amdgcn_cvt_pk_fp8_f32(v[i].z * sc, v[i].w * sc, wd, true);
      o4[i] = (unsigned)wd;
    }
    *(u32x4*)(dst + (size_t)r * 1024 + lane * 16) = o4;
    if (lane == 0) inv[r] = am > 0.f ? am * (1.f / 448.f) : 1.f;
  }
}
DI void phase10(const Params& p, char* smem) {
  rows_norm_mod(p, p.norm_ffn, 3072, 4096, true, (bf16_t*)(p.ws + OFF_H2));
  conv_fp8_rows(p.peer_u, (unsigned char*)(p.ws + OFF_TABU), (float*)(p.ws + OFF_INVU));
  conv_fp8_rows(p.peer_v, (unsigned char*)(p.ws + OFF_TABV), (float*)(p.ws + OFF_INVV));
}
DI void phase11(const Params& p, char* smem) {
  char* ws = p.ws;
  const bf16_t* h2 = (const bf16_t*)(ws + OFF_H2);
  const bf16_t* wct = (const bf16_t*)(ws + OFF_WCT);
  bf16_t* sc = (bf16_t*)(ws + OFF_SCORES);
  for (int it = 0;; ++it) {
    int ft, tt;
    if (!tile_map(it, 16, 160, 2, ft, tt)) break;
    f32x4 acc[4][4];
    acc_zero(acc);
    gemm_kloop<0>(acc, wct + (size_t)ft * 128 * 1024, 1024, h2 + (size_t)tt * 128 * 1024, 1024, 1024, smem, 0.f, 0.f);
    epilogue(acc, [&](int m, int n, float (&v)[16]) { st_bf16x16(sc + (size_t)(tt * 128 + n) * 2048 + ft * 128 + m, v); });
  }
}

DI unsigned okey(float f) {
  unsigned u = __float_as_uint(f);
  return (u & 0x80000000u) ? ~u : (u | 0x80000000u);
}
DI void wave_lds_sync() {
  __builtin_amdgcn_fence(__ATOMIC_ACQ_REL, "workgroup");
  __builtin_amdgcn_wave_barrier();
}
template <int V>
DI void topk16(const unsigned (&key)[V], int lowbit, int lane, int (&slot)[V]) {
  unsigned T = 0;
  for (int b = 31; b >= lowbit; --b) {
    unsigned cnd = T | (1u << b);
    int cnt = 0;
#pragma unroll
    for (int v = 0; v < V; ++v) cnt += __popcll(__ballot(key[v] >= cnd));
    if (cnt >= 16) T = cnd;
  }
  const unsigned Tp = T >> lowbit;
  const unsigned long long lt = (1ull << lane) - 1ull;
  int base = 0;
#pragma unroll
  for (int v = 0; v < V; ++v) {
    bool gt = (key[v] >> lowbit) > Tp;
    unsigned long long m = __ballot(gt);
    slot[v] = gt ? base + __popcll(m & lt) : -1;
    base += __popcll(m);
  }
  const int need = 16 - base;
  int eb = 0;
#pragma unroll
  for (int v = 0; v < V; ++v) {
    bool eq = (key[v] >> lowbit) == Tp;
    unsigned long long m = __ballot(eq);
    int r = eb + __popcll(m & lt);
    if (eq && r < need) slot[v] = base + r;
    eb += __popcll(m);
  }
}
DI void phase12(const Params& p, char* smem) {
  char* ws = p.ws;
  const bf16_t* sc = (const bf16_t*)(ws + OFF_SCORES);
  const bf16_t* h2 = (const bf16_t*)(ws + OFF_H2);
  const unsigned char* tabU = (const unsigned char*)(ws + OFF_TABU);
  const unsigned char* tabV = (const unsigned char*)(ws + OFF_TABV);
  const float* invU = (const float*)(ws + OFF_INVU);
  const float* invV = (const float*)(ws + OFF_INVV);
  const float* mod = (const float*)(ws + OFF_MOD);
  const int lane = threadIdx.x & 63, w = threadIdx.x >> 6;
  float* wl = (float*)(smem + w * 512);
  float* sv1 = wl;
  float* sv2 = wl + 16;
  int* si1 = (int*)(wl + 32);
  int* si2 = (int*)(wl + 48);
  float* lv = wl + 64;
  int* le = (int*)(wl + 80);
  for (int tok = blockIdx.x * 4 + w; tok < NTOK; tok += gridDim.x * 4) {
    float hf[16];
    {
      u32x4 a = *(const u32x4*)(h2 + (size_t)tok * DM + lane * 16), b = *(const u32x4*)(h2 + (size_t)tok * DM + lane * 16 + 8);
#pragma unroll
      for (int i = 0; i < 4; ++i) {
        hf[2 * i] = bflo(a[i]); hf[2 * i + 1] = bfhi(a[i]);
        hf[8 + 2 * i] = bflo(b[i]); hf[8 + 2 * i + 1] = bfhi(b[i]);
      }
    }
    float oacc[16];
#pragma unroll
    for (int i = 0; i < 16; ++i) oacc[i] = 0.f;
#pragma unroll 1
    for (int h = 0; h < 8; ++h) {
      int ln = lane;
      asm volatile("" : "+v"(ln));
      const int kq = ((ln >> 5) & 1) * 8 + ((ln >> 4) & 1) * 4 + ((ln >> 3) & 1) * 2 + ((ln >> 2) & 1);
      const bf16_t* sp = sc + (size_t)tok * 2048 + h * 256;
#pragma unroll
      for (int half = 0; half < 2; ++half) {
        float v0 = bf2f(sp[half * 128 + ln]), v1 = bf2f(sp[half * 128 + 64 + ln]);
        unsigned key[2] = {okey(v0), okey(v1)};
        int slot[2];
        topk16<2>(key, 16, ln, slot);
        float* sv = half ? sv2 : sv1;
        int* si = half ? si2 : si1;
        if (slot[0] >= 0) { sv[slot[0]] = v0; si[slot[0]] = ln; }
        if (slot[1] >= 0) { sv[slot[1]] = v1; si[slot[1]] = 64 + ln; }
      }
      wave_lds_sync();
      {
        const float b2 = sv2[ln & 15];
        float cv[4];
        unsigned key[4];
        int slot[4];
#pragma unroll
        for (int v = 0; v < 4; ++v) {
          cv[v] = sv1[v * 4 + (ln >> 4)] + b2;
          key[v] = okey(cv[v]);
        }
        topk16<4>(key, 0, ln, slot);
        const int i2 = si2[ln & 15];
#pragma unroll
        for (int v = 0; v < 4; ++v) {
          if (slot[v] >= 0) {
            lv[slot[v]] = cv[v];
            le[slot[v]] = si1[v * 4 + (ln >> 4)] * 128 + i2;
          }
        }
      }
      wave_lds_sync();
      float mx = lv[0];
#pragma unroll
      for (int k = 1; k < 16; ++k) mx = fmaxf(mx, lv[k]);
      float den = 0.f;
#pragma unroll
      for (int k = 0; k < 16; ++k) den += __expf(lv[k] - mx);
      const float gk = __expf(lv[kq] - mx) / den;
      const int eown = le[kq];
      const float iu = invU[eown], iv = invV[eown];
      float pd[16];
#pragma unroll
      for (int hb = 0; hb < 2; ++hb) {
        u32x4 ur[8];
#pragma unroll
        for (int k = 0; k < 8; ++k)
          ur[k] = *(const u32x4*)(tabU + (size_t)__builtin_amdgcn_readfirstlane(le[hb * 8 + k]) * 1024 + ln * 16);
#pragma unroll
        for (int k = 0; k < 8; ++k) {
          float d = 0.f;
#pragma unroll
          for (int i = 0; i < 4; ++i) {
            auto lo = __builtin_amdgcn_cvt_pk_f32_fp8((int)ur[k][i], false);
            auto hi2 = __builtin_amdgcn_cvt_pk_f32_fp8((int)ur[k][i], true);
            d += lo[0] * hf[4 * i] + lo[1] * hf[4 * i + 1] + hi2[0] * hf[4 * i + 2] + hi2[1] * hf[4 * i + 3];
          }
          pd[hb * 8 + k] = d;
        }
      }
      float q8[8], q4[4], q2[2], q1;
      {
        const bool hi = ln & 32;
#pragma unroll
        for (int i = 0; i < 8; ++i) {
          float send = hi ? pd[i] : pd[8 + i], keep = hi ? pd[8 + i] : pd[i];
          q8[i] = keep + __shfl_xor(send, 32);
        }
      }
      {
        const bool hi = ln & 16;
#pragma unroll
        for (int i = 0; i < 4; ++i) {
          float send = hi ? q8[i] : q8[4 + i], keep = hi ? q8[4 + i] : q8[i];
          q4[i] = keep + __shfl_xor(send, 16);
        }
      }
      {
        const bool hi = ln & 8;
#pragma unroll
        for (int i = 0; i < 2; ++i) {
          float send = hi ? q4[i] : q4[2 + i], keep = hi ? q4[2 + i] : q4[i];
          q2[i] = keep + __shfl_xor(send, 8);
        }
      }
      {
        const bool hi = ln & 4;
        float send = hi ? q2[0] : q2[1], keep = hi ? q2[1] : q2[0];
        q1 = keep + __shfl_xor(send, 4);
      }
      q1 += __shfl_xor(q1, 2);
      q1 += __shfl_xor(q1, 1);
      const float wk_own = gk * geluf_(q1 * iu) * iv;
#pragma unroll
      for (int hb = 0; hb < 2; ++hb) {
        u32x4 vr[8];
#pragma unroll
        for (int k = 0; k < 8; ++k)
          vr[k] = *(const u32x4*)(tabV + (size_t)__builtin_amdgcn_readfirstlane(le[hb * 8 + k]) * 1024 + ln * 16);
#pragma unroll
        for (int k = 0; k < 8; ++k) {
          const int kk = hb * 8 + k;
          const int src = (((kk >> 3) & 1) << 5) | (((kk >> 2) & 1) << 4) | (((kk >> 1) & 1) << 3) | ((kk & 1) << 2);
          const float wk = __shfl(wk_own, src);
#pragma unroll
          for (int i = 0; i < 4; ++i) {
            auto lo = __builtin_amdgcn_cvt_pk_f32_fp8((int)vr[k][i], false);
            auto hi2 = __builtin_amdgcn_cvt_pk_f32_fp8((int)vr[k][i], true);
            oacc[4 * i] += wk * lo[0];
            oacc[4 * i + 1] += wk * lo[1];
            oacc[4 * i + 2] += wk * hi2[0];
            oacc[4 * i + 3] += wk * hi2[1];
          }
        }
      }
      wave_lds_sync();
    }
    float* xr = p.out + (size_t)tok * DM;
    const float* g2 = mod + modidx(tok) * 6144 + 5120;
    float y[16];
    float ss = 0.f;
#pragma unroll
    for (int i = 0; i < 4; ++i) {
      const int e = lane * 16 + i * 4;
      float4 xv = *(const float4*)(xr + e), gv = *(const float4*)(g2 + e);
      float a0 = xv.x + gv.x * oacc[i * 4], a1 = xv.y + gv.y * oacc[i * 4 + 1];
      float a2 = xv.z + gv.z * oacc[i * 4 + 2], a3 = xv.w + gv.w * oacc[i * 4 + 3];
      y[i * 4] = a0; y[i * 4 + 1] = a1; y[i * 4 + 2] = a2; y[i * 4 + 3] = a3;
      ss += a0 * a0 + a1 * a1 + a2 * a2 + a3 * a3;
    }
    ss = wsum(ss);
    const float rstd = rsqrtf(ss * (1.f / 1024.f) + 1e-6f);
#pragma unroll
    for (int i = 0; i < 4; ++i) {
      const int e = lane * 16 + i * 4;
      float4 nf = *(const float4*)(p.norm_final + e);
      *(float4*)(xr + e) = make_float4(y[i * 4] * rstd * nf.x, y[i * 4 + 1] * rstd * nf.y, y[i * 4 + 2] * rstd * nf.z,
                                       y[i * 4 + 3] * rstd * nf.w);
    }
  }
}

#define XB_TMO      128
#define XB_XCNT(j)  (256  + 64 * (j))
#define XB_XSUB(j)  (1280 + 64 * (j))
#define XB_XGEN(j)  (2304 + 64 * (j))
#define XB_TOP      3328
#define XB_TOPGEN   3392
#define XCD_BAR_WORDS 3456
#define XB_SPIN_CAP (1u << 22)
#define LAS __attribute__((address_space(3)))
DI unsigned xb_ld(unsigned* p) { return __hip_atomic_load(p, __ATOMIC_RELAXED, __HIP_MEMORY_SCOPE_AGENT); }
DI unsigned xb_add(unsigned* p, unsigned v) { return __hip_atomic_fetch_add(p, v, __ATOMIC_RELAXED, __HIP_MEMORY_SCOPE_AGENT); }
DI unsigned xb_xcc_id() { return (unsigned)__builtin_amdgcn_s_getreg((3 << 11) | 20) & 0xFu; }
#define XB_SPIN(cond, bar) do { unsigned _sp = 0; while (cond) { __builtin_amdgcn_s_sleep(1); \
    if ((++_sp & 255u) == 0u) { if (xb_ld(&(bar)[XB_TMO])) break; if (_sp > XB_SPIN_CAP) { atomicAdd(&(bar)[XB_TMO], 1u); break; } } } } while (0)
struct XcdBarrier { unsigned* bar; unsigned x; volatile LAS unsigned* st; };
DI XcdBarrier xcd_barrier_post(unsigned* bar, volatile LAS unsigned* st) {
  XcdBarrier b; b.bar = bar; b.x = xb_xcc_id(); b.st = st;
  if (threadIdx.x == 0) (void)xb_add(&bar[XB_XCNT(b.x)], 1u);
  return b;
}
DI void xcd_barrier_complete(unsigned* bar, unsigned x, unsigned& nloc, unsigned& nx) {
  const unsigned G = gridDim.x * gridDim.y * gridDim.z;
  unsigned sum, cnt, mine, sp = 0u;
  for (;;) {
    sum = 0u; cnt = 0u; mine = 0u;
#pragma unroll
    for (unsigned j = 0; j < 16; ++j) { const unsigned c = xb_ld(&bar[XB_XCNT(j)]); sum += c; cnt += (c > 0u) ? 1u : 0u; mine = (j == x) ? c : mine; }
    if (sum == G) break;
    __builtin_amdgcn_s_sleep(1);
    if ((++sp & 255u) == 0u) { if (xb_ld(&bar[XB_TMO])) break; if (sp > XB_SPIN_CAP) { atomicAdd(&bar[XB_TMO], 1u); break; } }
  }
  nloc = mine > 0u ? mine : 1u; nx = cnt > 0u ? cnt : 1u;
}
DI void xcd_barrier(const XcdBarrier& b) {
  asm volatile("s_waitcnt vmcnt(0)" ::: "memory");
  __syncthreads();
  if (threadIdx.x == 0) {
    unsigned* bar = b.bar;
    __builtin_amdgcn_s_waitcnt(0);
    unsigned nloc = b.st[0], nx = b.st[1];
    if (nloc == 0u) { xcd_barrier_complete(bar, b.x, nloc, nx); b.st[0] = nloc; b.st[1] = nx; }
    const unsigned old = xb_add(&bar[XB_XSUB(b.x)], 1u);
    const unsigned gen = old / nloc;
    if (old + 1u == (gen + 1u) * nloc) {
      __builtin_amdgcn_fence(__ATOMIC_RELEASE, "agent");
      asm volatile("s_waitcnt vmcnt(0)" ::: "memory");
      const unsigned og = xb_add(&bar[XB_TOP], 1u);
      const unsigned tg = og / nx;
      if (og + 1u == (tg + 1u) * nx) xb_add(&bar[XB_TOPGEN], 1u);
      else XB_SPIN(xb_ld(&bar[XB_TOPGEN]) == tg, bar);
      __builtin_amdgcn_fence(__ATOMIC_ACQUIRE, "agent");
      xb_add(&bar[XB_XGEN(b.x)], 1u);
      asm volatile("s_waitcnt vmcnt(0)" ::: "memory");
    } else {
      XB_SPIN(xb_ld(&bar[XB_XGEN(b.x)]) == gen, bar);
      __builtin_amdgcn_fence(__ATOMIC_ACQUIRE, "agent");
      asm volatile("s_waitcnt vmcnt(0)" ::: "memory");
    }
  }
  __syncthreads();
}

#ifdef ONLY_PHASE
#define RUNPH(n, call) if (ONLY_PHASE == n) { call; }
#else
#ifndef DUP_PHASE
#define DUP_PHASE -1
#endif
#define RUNPH(n, call) if (lo <= n && n < hi) { call; if (n == DUP_PHASE) { xcd_barrier(xb); call; } if (n + 1 < hi) xcd_barrier(xb); }
#endif
__global__ void __launch_bounds__(256, 2) mega(Params p, int lo, int hi) {
  __shared__ __attribute__((aligned(16))) char smem[SMEM_BYTES];
  __shared__ uint4 xb_words;
  cg::grid_group grid = cg::this_grid();
  if (lo < 0) grid.sync();
  if (threadIdx.x == 0) xb_words = make_uint4(0u, 0u, 0u, 0u);
  __syncthreads();
  XcdBarrier xb = xcd_barrier_post((unsigned*)(p.ws + OFF_BAR), (volatile LAS unsigned*)&xb_words);
  RUNPH(0, phase0(p, smem))
  RUNPH(1, phase1(p, smem))
  RUNPH(2, phase2(p, smem))
  RUNPH(3, phase3(p, smem))
  RUNPH(4, phase4(p))
  RUNPH(5, phase5(p, smem))
  RUNPH(6, phase6(p, smem))
  RUNPH(7, phase7(p, smem))
  RUNPH(8, phase8(p, smem))
  RUNPH(9, phase9(p, smem))
  RUNPH(10, phase10(p, smem))
  RUNPH(11, phase11(p, smem))
  RUNPH(12, phase12(p, smem))
}

extern "C" void kernel_launch(void* const* d_in, const int* in_sizes, int n_in, void* d_out, int out_size, void* d_ws,
                              size_t ws_size, hipStream_t stream) {
  static int grid_blocks = 0;
  if (!grid_blocks) {
    int dev = 0, cus = 0, per_cu = 0;
    hipGetDevice(&dev);
    hipDeviceGetAttribute(&cus, hipDeviceAttributeMultiprocessorCount, dev);
    hipOccupancyMaxActiveBlocksPerMultiprocessor(&per_cu, mega, 256, 0);
    if (per_cu > 2) per_cu = 2;
    if (per_cu < 1) per_cu = 1;
    grid_blocks = cus * per_cu;
  }
  Params p{};
  const float** pp = (const float**)&p;
  for (int i = 0; i < 29; ++i) pp[i] = (const float*)d_in[i];
  p.out = (float*)d_out;
  p.ws = (char*)d_ws;
#if N_LAUNCH_SPLIT
  for (int ph = 0; ph < NPHASE; ++ph) {
    hipLaunchKernelGGL(mega, dim3(grid_blocks), dim3(256), 0, stream, p, ph, ph + 1);
  }
#else
  hipMemsetAsync((char*)d_ws + OFF_BAR, 0, XCD_BAR_WORDS * sizeof(unsigned), stream);
  int lo = 0, hi = NPHASE;
  void* args[] = {&p, &lo, &hi};
  hipError_t e = hipLaunchCooperativeKernel((void*)mega, dim3(grid_blocks), dim3(256), args, 0, stream);
  if (e != hipSuccess) fprintf(stderr, "cooperative launch failed: %s (grid %d)\n", hipGetErrorString(e), grid_blocks);
#endif
}
```

```cpp
#include <hip/hip_runtime.h>
#include <hip/hip_cooperative_groups.h>
#include <cstdio>
namespace cg = cooperative_groups;

#define DI __device__ __forceinline__
typedef unsigned short bf16_t;
using bf16x8 = __attribute__((ext_vector_type(8))) short;
using f32x4 = __attribute__((ext_vector_type(4))) float;
using u32x4 = __attribute__((ext_vector_type(4))) unsigned;
using u32x2 = __attribute__((ext_vector_type(2))) unsigned;

#ifndef N_LAUNCH_SPLIT
#define N_LAUNCH_SPLIT 0
#endif

constexpr int NTOK = 20480, NPT = 4096, DM = 1024;
constexpr int NPHASE = 13;
constexpr size_t MiB = 1u << 20;
constexpr size_t OFF_WINT = 0, OFF_WUQT = 9 * MiB, OFF_WUKVT = 9 * MiB + 512 * 1024, OFF_WUPAT = 10 * MiB,
                 OFF_WUPBT = 11 * MiB, OFF_WOT = 12 * MiB, OFF_WCT = 14 * MiB, OFF_WPQB = 18 * MiB,
                 OFF_KEYSB = 22 * MiB, OFF_MOD = 22 * MiB + 512 * 1024, OFF_BAR = 22 * MiB + 768 * 1024, A0 = 24 * MiB;
constexpr size_t OFF_H1 = A0 + 0, OFF_CQ = A0 + 40 * MiB, OFF_CKVRAW = A0 + 50 * MiB, OFF_KRRAW = A0 + 60 * MiB,
                 OFF_RQ = A0 + 63 * MiB, OFF_RK = A0 + 83 * MiB, OFF_KT = A0 + 103 * MiB, OFF_VT = A0 + 123 * MiB,
                 OFF_SRG = A0 + 143 * MiB, OFF_CKVALL = A0 + 163 * MiB, OFF_KRALL = A0 + 169 * MiB,
                 OFF_UF = A0 + 171 * MiB, OFF_UB = A0 + 187 * MiB,
                 OFF_SF = A0 + 0, OFF_SB = A0 + 8 * MiB, OFF_RET = A0 + 16 * MiB,
                 OFF_Q = A0 + 63 * MiB, OFF_KN = A0 + 93 * MiB, OFF_VTA = A0 + 117 * MiB, OFF_ATTN = A0 + 141 * MiB,
                 OFF_M = A0 + 163 * MiB,
                 OFF_H2 = A0 + 0, OFF_TABU = A0 + 40 * MiB, OFF_TABV = A0 + 56 * MiB, OFF_INVU = A0 + 72 * MiB,
                 OFF_INVV = A0 + 73 * MiB, OFF_SCORES = A0 + 104 * MiB;
constexpr size_t OUT_CKV = 20971520, OUT_KR = 21495808, OUT_SF = 21626880, OUT_SB = 22675456;
constexpr int NKV = 24576;
constexpr int SMEM_BYTES = 36864;

struct Params {
  const float *x_prompt, *x_sample, *c, *cache_ckv, *cache_krope, *st_f, *st_b, *c_ctx, *w_mod, *b_mod, *norm_mix,
      *norm_ffn, *norm_final, *w_in, *q_norm, *kv_norm, *w_uq, *w_ukv, *lg_f, *lg_b, *ret_gn, *w_up_a, *w_up_b, *w_o,
      *peer_wq, *keys1, *keys2, *peer_u, *peer_v;
  float* out;
  char* ws;
};

DI unsigned f2bf(float x) {
  unsigned u = __float_as_uint(x);
  u += 0x7fffu + ((u >> 16) & 1u);
  return u >> 16;
}
DI float bf2f(unsigned b) { return __uint_as_float(b << 16); }
typedef __bf16 hbf16x2_t __attribute__((ext_vector_type(2)));
typedef float hf32x2_t __attribute__((ext_vector_type(2)));
DI unsigned pack2(float a, float b) {
  hf32x2_t f = {a, b};
  return __builtin_bit_cast(unsigned, __builtin_convertvector(f, hbf16x2_t));
}
DI float ex2(float x) { return __builtin_amdgcn_exp2f(x); }
DI float bflo(unsigned u) { return __uint_as_float(u << 16); }
DI float bfhi(unsigned u) { return __uint_as_float(u & 0xffff0000u); }
DI float wsum(float v) {
#pragma unroll
  for (int o = 32; o > 0; o >>= 1) v += __shfl_xor(v, o);
  return v;
}
DI float sigmoidf_(float x) { return 1.f / (1.f + __expf(-x)); }
DI float siluf_(float x) { return x / (1.f + __expf(-x)); }
DI float geluf_(float x) { return 0.5f * x * (1.f + tanhf(0.7978845608028654f * (x + 0.044715f * x * x * x))); }
DI const float* xrow(const Params& p, int tok) {
  return tok < NPT ? p.x_prompt + (size_t)tok * DM : p.x_sample + (size_t)(tok - NPT) * DM;
}
DI int modidx(int tok) { return tok < NPT ? 0 : 1 + ((tok - NPT) >> 11); }
DI int kvrow(int tok) {
  if (tok < NPT) return tok;
  int t = tok - NPT;
  return NPT + (t >> 11) * 2560 + (t & 2047);
}
DI void st_bf16x16(bf16_t* dst, const float (&v)[16]) {
  u32x4 a, b;
  a[0] = pack2(v[0], v[1]); a[1] = pack2(v[2], v[3]); a[2] = pack2(v[4], v[5]); a[3] = pack2(v[6], v[7]);
  b[0] = pack2(v[8], v[9]); b[1] = pack2(v[10], v[11]); b[2] = pack2(v[12], v[13]); b[3] = pack2(v[14], v[15]);
  *(u32x4*)dst = a;
  *(u32x4*)(dst + 8) = b;
}
DI void st_f32x16(float* dst, const float (&v)[16]) {
#pragma unroll
  for (int i = 0; i < 4; ++i) *(float4*)(dst + 4 * i) = make_float4(v[4 * i], v[4 * i + 1], v[4 * i + 2], v[4 * i + 3]);
}
DI void ld_bf16x16(const bf16_t* src, float (&v)[16]) {
  u32x4 a = *(const u32x4*)src, b = *(const u32x4*)(src + 8);
#pragma unroll
  for (int i = 0; i < 4; ++i) {
    v[2 * i] = bflo(a[i]); v[2 * i + 1] = bfhi(a[i]);
    v[8 + 2 * i] = bflo(b[i]); v[8 + 2 * i + 1] = bfhi(b[i]);
  }
}

constexpr int LDK = 72;
template <int SCALE>
DI void gemm_kloop(f32x4 (&acc)[4][4], const bf16_t* __restrict__ A, int lda, const bf16_t* __restrict__ B, int ldb,
                   int K, char* smem, float sc_a, float sc_b) {
  bf16_t* As = (bf16_t*)smem;
  bf16_t* Bs = As + 128 * LDK;
  const int tid = threadIdx.x, lane = tid & 63, w = tid >> 6, wm = w >> 1, wn = w & 1, l15 = lane & 15, g = lane >> 4;
  u32x4 ra[4], rb[4];
  int arow[4], kc[4], ldsa[4], ldsb[4];
#pragma unroll
  for (int i = 0; i < 4; ++i) {
    int c = tid + 256 * i;
    int r = c >> 3;
    kc[i] = (c & 7) * 8;
    arow[i] = r;
    int rr = r & 63;
    int rho = (r & 64) | (((rr >> 2) & 3) << 4) | ((rr >> 4) << 2) | (rr & 3);
    ldsa[i] = rho * LDK + kc[i];
    ldsb[i] = r * LDK + kc[i];
  }
#pragma unroll
  for (int i = 0; i < 4; ++i) {
    ra[i] = *(const u32x4*)(A + (size_t)arow[i] * lda + kc[i]);
    rb[i] = *(const u32x4*)(B + (size_t)arow[i] * ldb + kc[i]);
  }
  for (int k0 = 0; k0 < K; k0 += 64) {
    __syncthreads();
#pragma unroll
    for (int i = 0; i < 4; ++i) {
      *(u32x4*)(As + ldsa[i]) = ra[i];
      *(u32x4*)(Bs + ldsb[i]) = rb[i];
    }
    __syncthreads();
    if (k0 + 64 < K) {
#pragma unroll
      for (int i = 0; i < 4; ++i) {
        ra[i] = *(const u32x4*)(A + (size_t)arow[i] * lda + k0 + 64 + kc[i]);
        rb[i] = *(const u32x4*)(B + (size_t)arow[i] * ldb + k0 + 64 + kc[i]);
      }
    }
#pragma unroll
    for (int ks = 0; ks < 2; ++ks) {
      bf16x8 af[4], bfr[4];
#pragma unroll
      for (int f = 0; f < 4; ++f)
        af[f] = *(const bf16x8*)(As + (wm * 64 + f * 16 + l15) * LDK + ks * 32 + g * 8);
#pragma unroll
      for (int c = 0; c < 4; ++c)
        bfr[c] = *(const bf16x8*)(Bs + (wn * 64 + c * 16 + l15) * LDK + ks * 32 + g * 8);
      if (SCALE) {
        float fac[8];
#pragma unroll
        for (int i = 0; i < 8; ++i) fac[i] = ex2(sc_a + sc_b * (float)(k0 + ks * 32 + g * 8 + i));
#pragma unroll
        for (int f = 0; f < 4; ++f) {
          u32x4 u = __builtin_bit_cast(u32x4, af[f]);
#pragma unroll
          for (int i = 0; i < 4; ++i) u[i] = pack2(bflo(u[i]) * fac[2 * i], bfhi(u[i]) * fac[2 * i + 1]);
          af[f] = __builtin_bit_cast(bf16x8, u);
        }
      }
#pragma unroll
      for (int f = 0; f < 4; ++f)
#pragma unroll
        for (int c = 0; c < 4; ++c) acc[f][c] = __builtin_amdgcn_mfma_f32_16x16x32_bf16(af[f], bfr[c], acc[f][c], 0, 0, 0);
    }
  }
}
DI void acc_zero(f32x4 (&acc)[4][4]) {
#pragma unroll
  for (int f = 0; f < 4; ++f)
#pragma unroll
    for (int c = 0; c < 4; ++c) acc[f][c] = f32x4{0.f, 0.f, 0.f, 0.f};
}
template <class F>
DI void epilogue(const f32x4 (&acc)[4][4], F&& epi) {
  const int tid = threadIdx.x, lane = tid & 63, w = tid >> 6, wm = w >> 1, wn = w & 1, l15 = lane & 15, g = lane >> 4;
#pragma unroll
  for (int c = 0; c < 4; ++c) {
    float v[16];
#pragma unroll
    for (int f = 0; f < 4; ++f)
#pragma unroll
      for (int j = 0; j < 4; ++j) v[f * 4 + j] = acc[f][c][j];
    epi(wm * 64 + 16 * g, wn * 64 + c * 16 + l15, v);
  }
}
DI bool tile_map(int it, int Ft, int Tt, int fsplit, int& ft, int& tt) {
  const int bid = blockIdx.x, nb = gridDim.x;
  int xcd = bid & 7, loc = bid >> 3, nloc = nb >> 3;
  if (loc >= nloc) return false;
  int fg = xcd % fsplit, tg = xcd / fsplit, tsplit = 8 / fsplit;
  int Fg = Ft / fsplit, Tg = Tt / tsplit;
  int i = loc + it * nloc;
  if (i >= Fg * Tg) return false;
  ft = fg * Fg + i % Fg;
  tt = tg * Tg + i / Fg;
  return true;
}
DI int vbid() {
  const int bid = blockIdx.x, nb = gridDim.x;
  if (nb & 7) return bid;
  return (bid & 7) * (nb >> 3) + (bid >> 3);
}

DI int colmap(int mode, int np) {
  if (mode == 1) return np < 416 ? np : (np < 512 ? -1 : np - 96);
  if (mode == 2) return np < 512 ? ((np >> 6) * 128 + (np & 63)) : (((np - 512) >> 6) * 128 + 64 + ((np - 512) & 63));
  return np;
}
DI void tconv_tile(const float* __restrict__ src, int ldsrc, bf16_t* __restrict__ dst, int K, int kt, int nt, int mode,
                   char* smem) {
  float* lds = (float*)smem;
  const int tid = threadIdx.x;
  {
    int col = tid & 63, rq = tid >> 6;
    int n = colmap(mode, nt * 64 + col);
#pragma unroll 4
    for (int r = 0; r < 16; ++r) {
      int kl = r * 4 + rq;
      float v = n >= 0 ? src[(size_t)(kt * 64 + kl) * ldsrc + n] : 0.f;
      lds[kl * 65 + col] = v;
    }
  }
  __syncthreads();
  {
    int nl = tid >> 2, kq = (tid & 3) * 16;
    float v[16];
#pragma unroll
    for (int i = 0; i < 16; ++i) v[i] = lds[(kq + i) * 65 + nl];
    st_bf16x16(dst + (size_t)(nt * 64 + nl) * K + kt * 64 + kq, v);
  }
  __syncthreads();
}
DI void mod_item(const Params& p, int item, char* smem) {
  float* sil = (float*)smem;
  const int tid = threadIdx.x;
  const int cg_ = item >> 2, slab = item & 3, kbase = slab * 256;
  for (int i = tid; i < 9 * 256; i += 256) {
    int j = i >> 8, k = kbase + (i & 255);
    float cv = j == 0 ? p.c_ctx[k] : p.c[(j - 1) * 1024 + k];
    sil[i] = siluf_(cv);
  }
  __syncthreads();
  const int kq = tid >> 6, nn = tid & 63, n0 = cg_ * 64;
  float acc[9];
#pragma unroll
  for (int j = 0; j < 9; ++j) acc[j] = 0.f;
#pragma unroll 1
  for (int i0 = 0; i0 < 64; i0 += 16) {
    float wv[16];
#pragma unroll
    for (int i = 0; i < 16; ++i) wv[i] = p.w_mod[(size_t)(kbase + kq + 4 * (i0 + i)) * 6144 + n0 + nn];
#pragma unroll
    for (int i = 0; i < 16; ++i)
#pragma unroll
      for (int j = 0; j < 9; ++j) acc[j] += sil[j * 256 + kq + 4 * (i0 + i)] * wv[i];
  }
  __syncthreads();
  float* part = (float*)smem + 9 * 256;
#pragma unroll
  for (int j = 0; j < 9; ++j) part[(kq * 9 + j) * 64 + nn] = acc[j];
  __syncthreads();
  float* mod = (float*)(p.ws + OFF_MOD);
  for (int i = tid; i < 9 * 64; i += 256) {
    int j = i >> 6, n = i & 63;
    float s = part[(0 * 9 + j) * 64 + n] + part[(1 * 9 + j) * 64 + n] + part[(2 * 9 + j) * 64 + n] + part[(3 * 9 + j) * 64 + n];
    if (slab == 0) s += p.b_mod[n0 + n];
    atomicAdd(mod + j * 6144 + n0 + n, s);
  }
  __syncthreads();
}
DI void conv_flat(const float* __restrict__ src, bf16_t* __restrict__ dst, size_t n) {
  size_t i = ((size_t)blockIdx.x * 256 + threadIdx.x) * 8;
  const size_t stride = (size_t)gridDim.x * 256 * 8;
  for (; i < n; i += stride) {
    float4 a = *(const float4*)(src + i), b = *(const float4*)(src + i + 4);
    u32x4 o;
    o[0] = pack2(a.x, a.y); o[1] = pack2(a.z, a.w); o[2] = pack2(b.x, b.y); o[3] = pack2(b.z, b.w);
    *(u32x4*)(dst + i) = o;
  }
}
DI void phase0(const Params& p, char* smem) {
  const int bid = blockIdx.x, nb = gridDim.x;
  char* ws = p.ws;
  const int n_mod = 384;
  const int t_in = 16 * 72, t_uq = 4 * 12, t_ukv = 2 * 16, t_upa = 8 * 16, t_upb = 8 * 16, t_o = 16 * 16;
  const int total = n_mod + t_in + t_uq + t_ukv + t_upa + t_upb + t_o;
  for (int it = bid; it < total; it += nb) {
    int i = it;
    if (i < n_mod) { mod_item(p, i, smem); continue; }
    i -= n_mod;
    if (i < t_in) { tconv_tile(p.w_in, 4512, (bf16_t*)(ws + OFF_WINT), 1024, i / 72, i % 72, 1, smem); continue; }
    i -= t_in;
    if (i < t_uq) { tconv_tile(p.w_uq, 768, (bf16_t*)(ws + OFF_WUQT), 256, i / 12, i % 12, 0, smem); continue; }
    i -= t_uq;
    if (i < t_ukv) { tconv_tile(p.w_ukv, 1024, (bf16_t*)(ws + OFF_WUKVT), 128, i / 16, i % 16, 2, smem); continue; }
    i -= t_ukv;
    if (i < t_upa) { tconv_tile(p.w_up_a, 1024, (bf16_t*)(ws + OFF_WUPAT), 512, i / 16, i % 16, 0, smem); continue; }
    i -= t_upa;
    if (i < t_upb) { tconv_tile(p.w_up_b, 1024, (bf16_t*)(ws + OFF_WUPBT), 512, i / 16, i % 16, 0, smem); continue; }
    i -= t_upb;
    tconv_tile(p.w_o, 1024, (bf16_t*)(ws + OFF_WOT), 1024, i / 16, i % 16, 0, smem);
  }
  conv_flat(p.peer_wq, (bf16_t*)(ws + OFF_WPQB), (size_t)1024 * 2048);
  {
    size_t i = ((size_t)bid * 256 + threadIdx.x) * 8;
    const size_t stride = (size_t)nb * 256 * 8;
    bf16_t* kb = (bf16_t*)(ws + OFF_KEYSB);
    for (; i < (size_t)2 * 131072; i += stride) {
      int half = i >= 131072;
      size_t s = i - (size_t)half * 131072;
      int h = (int)(s >> 14);
      size_t r = s & 16383;
      const float* src = (half ? p.keys2 : p.keys1) + s;
      float4 a = *(const float4*)(src), b = *(const float4*)(src + 4);
      u32x4 o;
      o[0] = pack2(a.x, a.y); o[1] = pack2(a.z, a.w); o[2] = pack2(b.x, b.y); o[3] = pack2(b.z, b.w);
      *(u32x4*)(kb + ((size_t)(h * 2 + half) << 14) + r) = o;
    }
  }
}

DI void rows_norm_mod(const Params& p, const float* nw, int sh_off, int sc_off, bool from_out, bf16_t* dst) {
  const int lane = threadIdx.x & 63, w = threadIdx.x >> 6;
  const float* mod = (const float*)(p.ws + OFF_MOD);
  for (int tok = blockIdx.x * 4 + w; tok < NTOK; tok += gridDim.x * 4) {
    const float* xr = from_out ? p.out + (size_t)tok * DM : xrow(p, tok);
    const float* mj = mod + modidx(tok) * 6144;
    float4 xv[4];
    float ss = 0.f;
#pragma unroll
    for (int i = 0; i < 4; ++i) {
      xv[i] = *(const float4*)(xr + (i * 64 + lane) * 4);
      ss += xv[i].x * xv[i].x + xv[i].y * xv[i].y + xv[i].z * xv[i].z + xv[i].w * xv[i].w;
    }
    ss = wsum(ss);
    float rstd = rsqrtf(ss * (1.f / 1024.f) + 1e-6f);
#pragma unroll
    for (int i = 0; i < 4; ++i) {
      int e = (i * 64 + lane) * 4;
      float4 nv = *(const float4*)(nw + e), sh = *(const float4*)(mj + sh_off + e), sc = *(const float4*)(mj + sc_off + e);
      float h0 = (xv[i].x * rstd) * nv.x * (1.f + sc.x) + sh.x;
      float h1 = (xv[i].y * rstd) * nv.y * (1.f + sc.y) + sh.y;
      float h2 = (xv[i].z * rstd) * nv.z * (1.f + sc.z) + sh.z;
      float h3 = (xv[i].w * rstd) * nv.w * (1.f + sc.w) + sh.w;
      u32x2 o;
      o[0] = pack2(h0, h1); o[1] = pack2(h2, h3);
      *(u32x2*)(dst + (size_t)tok * DM + e) = o;
    }
  }
}
DI void phase1(const Params& p, char* smem) {
  rows_norm_mod(p, p.norm_mix, 0, 1024, false, (bf16_t*)(p.ws + OFF_H1));
  const bf16_t* wpq = (const bf16_t*)(p.ws + OFF_WPQB);
  const bf16_t* kb = (const bf16_t*)(p.ws + OFF_KEYSB);
  bf16_t* wct = (bf16_t*)(p.ws + OFF_WCT);
  for (int it = blockIdx.x; it < 128; it += gridDim.x) {
    int hh = it >> 3, mt = it & 7;
    f32x4 acc[4][4];
    acc_zero(acc);
    gemm_kloop<0>(acc, wpq + (size_t)(mt * 128) * 2048 + hh * 128, 2048, kb + (size_t)hh * 16384, 128, 128, smem, 0.f, 0.f);
    epilogue(acc, [&](int m, int n, float (&v)[16]) { st_bf16x16(wct + (size_t)(hh * 128 + n) * 1024 + mt * 128 + m, v); });
  }
}

DI void phase2(const Params& p, char* smem) {
  char* ws = p.ws;
  const bf16_t* winT = (const bf16_t*)(ws + OFF_WINT);
  const bf16_t* h1 = (const bf16_t*)(ws + OFF_H1);
  bf16_t* cq = (bf16_t*)(ws + OFF_CQ);
  float* ckvraw = (float*)(ws + OFF_CKVRAW);
  float* krraw = (float*)(ws + OFF_KRRAW);
  bf16_t* rq = (bf16_t*)(ws + OFF_RQ);
  bf16_t* rk = (bf16_t*)(ws + OFF_RK);
  bf16_t* kT = (bf16_t*)(ws + OFF_KT);
  bf16_t* vT = (bf16_t*)(ws + OFF_VT);
  bf16_t* srg = (bf16_t*)(ws + OFF_SRG);
  bf16_t* sga = (bf16_t*)p.out;
  bf16_t* sgb = sga + (size_t)NTOK * 1024;
  for (int it = 0;; ++it) {
    int ft, tt;
    if (!tile_map(it, 36, 160, 4, ft, tt)) break;
    f32x4 acc[4][4];
    acc_zero(acc);
    const bf16_t* W = winT + (size_t)ft * 128 * 1024;
    const bf16_t* H = h1 + (size_t)tt * 128 * 1024;
    const int tok0 = tt * 128, f0 = ft * 128;
    if (ft >= 8 && ft < 16) {
      gemm_kloop<0>(acc, H, 1024, W, 1024, 1024, smem, 0.f, 0.f);
      if (ft < 12) {
        epilogue(acc, [&](int m, int n, float (&v)[16]) {
          int feat = f0 - 1024 + n, tok = tok0 + m;
#pragma unroll
          for (int i = 0; i < 16; ++i) v[i] *= 0.08838834764831845f;
          st_bf16x16(kT + (size_t)feat * NTOK + tok, v);
#pragma unroll
          for (int i = 0; i < 16; ++i) rk[(size_t)(tok + i) * 512 + feat] = (bf16_t)f2bf(v[i]);
        });
      } else {
        epilogue(acc, [&](int m, int n, float (&v)[16]) {
          int feat = f0 - 1536 + n, tok = tok0 + m;
          st_bf16x16(vT + (size_t)feat * NTOK + tok, v);
        });
      }
    } else {
      gemm_kloop<0>(acc, W, 1024, H, 1024, 1024, smem, 0.f, 0.f);
      if (ft < 2) {
        epilogue(acc, [&](int m, int n, float (&v)[16]) { st_bf16x16(cq + (size_t)(tok0 + n) * 256 + f0 + m, v); });
      } else if (ft == 2) {
        epilogue(acc, [&](int m, int n, float (&v)[16]) { st_f32x16(ckvraw + (size_t)(tok0 + n) * 128 + m, v); });
      } else if (ft == 3) {
        epilogue(acc, [&](int m, int n, float (&v)[16]) {
          if (m < 32) st_f32x16(krraw + (size_t)(tok0 + n) * 32 + m, v);
        });
      } else if (ft < 8) {
        epilogue(acc, [&](int m, int n, float (&v)[16]) { st_bf16x16(rq + (size_t)(tok0 + n) * 512 + f0 - 512 + m, v); });
      } else if (ft < 20) {
        epilogue(acc, [&](int m, int n, float (&v)[16]) {
#pragma unroll
          for (int i = 0; i < 16; ++i) v[i] = siluf_(v[i]);
          st_bf16x16(srg + (size_t)(tok0 + n) * 512 + f0 - 2048 + m, v);
        });
      } else if (ft < 28) {
        epilogue(acc, [&](int m, int n, float (&v)[16]) {
#pragma unroll
          for (int i = 0; i < 16; ++i) v[i] = sigmoidf_(v[i]);
          st_bf16x16(sga + (size_t)(tok0 + n) * 1024 + f0 - 2560 + m, v);
        });
      } else {
        epilogue(acc, [&](int m, int n, float (&v)[16]) {
#pragma unroll
          for (int i = 0; i < 16; ++i) v[i] = sigmoidf_(v[i]);
          st_bf16x16(sgb + (size_t)(tok0 + n) * 1024 + f0 - 3584 + m, v);
        });
      }
    }
  }
}

DI float log2gamma(float logit) { return -log1pf(expf(-logit)) * 1.4426950408889634f; }
DI void phase3(const Params& p, char* smem) {
  char* ws = p.ws;
  const int lane = threadIdx.x & 63, w = threadIdx.x >> 6;
  bf16_t* cq = (bf16_t*)(ws + OFF_CQ);
  const float* ckvraw = (const float*)(ws + OFF_CKVRAW);
  const float* krraw = (const float*)(ws + OFF_KRRAW);
  bf16_t* ckvall = (bf16_t*)(ws + OFF_CKVALL);
  bf16_t* krall = (bf16_t*)(ws + OFF_KRALL);
  for (int r = blockIdx.x * 4 + w; r < NTOK + 4096; r += gridDim.x * 4) {
    if (r < NTOK) {
      const int tok = r;
      {
        u32x2 u = *(const u32x2*)(cq + (size_t)tok * 256 + lane * 4);
        float a0 = bflo(u[0]), a1 = bfhi(u[0]), a2 = bflo(u[1]), a3 = bfhi(u[1]);
        float ss = wsum(a0 * a0 + a1 * a1 + a2 * a2 + a3 * a3);
        float rstd = rsqrtf(ss * (1.f / 256.f) + 1e-6f);
        float4 nq = *(const float4*)(p.q_norm + lane * 4);
        u32x2 o;
        o[0] = pack2(a0 * rstd * nq.x, a1 * rstd * nq.y);
        o[1] = pack2(a2 * rstd * nq.z, a3 * rstd * nq.w);
        *(u32x2*)(cq + (size_t)tok * 256 + lane * 4) = o;
      }
      const int row = kvrow(tok);
      {
        float2 v = *(const float2*)(ckvraw + (size_t)tok * 128 + lane * 2);
        float ss = wsum(v.x * v.x + v.y * v.y);
        float rstd = rsqrtf(ss * (1.f / 128.f) + 1e-6f);
        float2 nk = *(const float2*)(p.kv_norm + lane * 2);
        float o0 = v.x * rstd * nk.x, o1 = v.y * rstd * nk.y;
        if (tok < NPT) *(float2*)(p.out + OUT_CKV + (size_t)tok * 128 + lane * 2) = make_float2(o0, o1);
        *(unsigned*)(ckvall + (size_t)row * 128 + lane * 2) = pack2(o0, o1);
      }
      if (lane < 32) {
        float own = krraw[(size_t)tok * 32 + lane];
        float o = own;
        if (tok < NPT) {
          p.out[OUT_KR + (size_t)tok * 32 + lane] = own;
        } else {
          float partner = krraw[(size_t)tok * 32 + (lane ^ 16)];
          int t = (tok - NPT) & 2047;
          int a = lane & 15;
          float pos = (a < 8) ? (float)(t >> 6) : (float)(t & 63);
          float fr = exp2f(-(float)(a & 7) * 1.6609640474436813f);
          float sn, cs;
          sincosf(pos * fr, &sn, &cs);
          o = lane < 16 ? own * cs - partner * sn : partner * sn + own * cs;
        }
        krall[(size_t)row * 32 + lane] = (bf16_t)f2bf(o);
      }
    } else {
      const int cr = r - NTOK;
      const int b = cr >> 9, pos = cr & 511;
      const int row = NPT + b * 2560 + 2048 + pos;
      float2 v = *(const float2*)(p.cache_ckv + (size_t)cr * 128 + lane * 2);
      *(unsigned*)(ckvall + (size_t)row * 128 + lane * 2) = pack2(v.x, v.y);
      if (lane < 32) krall[(size_t)row * 32 + lane] = (bf16_t)f2bf(p.cache_krope[(size_t)cr * 32 + lane]);
    }
  }
  const bf16_t* kT = (const bf16_t*)(ws + OFF_KT);
  const bf16_t* vT = (const bf16_t*)(ws + OFF_VT);
  float* Uf = (float*)(ws + OFF_UF);
  float* Ub = (float*)(ws + OFF_UB);
  for (int it = blockIdx.x; it < 320; it += gridDim.x) {
    const int blk = it >> 2, h = it & 3;
    const float l2f = log2gamma(p.lg_f[h]), l2b = log2gamma(p.lg_b[h]);
    const bf16_t* Kp = kT + (size_t)(h * 128) * NTOK + blk * 256;
    const bf16_t* Vp = vT + (size_t)(h * 128) * NTOK + blk * 256;
#pragma unroll 1
    for (int dir = 0; dir < 2; ++dir) {
      const float sa = dir ? 0.f : l2f * 255.f, sb = dir ? l2b : -l2f;
      f32x4 acc[4][4];
      acc_zero(acc);
      if (blk < 16) {
        gemm_kloop<1>(acc, Vp, NTOK, Kp, NTOK, 256, smem, sa, sb);
        float* dst = p.out + (dir ? OUT_SB : OUT_SF) + (size_t)(blk * 4 + h) * 16384;
        epilogue(acc, [&](int m, int n, float (&v)[16]) { st_f32x16(dst + n * 128 + m, v); });
      } else {
        gemm_kloop<1>(acc, Kp, NTOK, Vp, NTOK, 256, smem, sa, sb);
        float* dst = (dir ? Ub : Uf) + (size_t)((blk - 16) * 4 + h) * 16384;
        epilogue(acc, [&](int m, int n, float (&v)[16]) { st_f32x16(dst + n * 128 + m, v); });
      }
    }
  }
}

DI void phase4(const Params& p) {
  char* ws = p.ws;
  const float* Uf = (const float*)(ws + OFF_UF);
  const float* Ub = (const float*)(ws + OFF_UB);
  bf16_t* Sf = (bf16_t*)(ws + OFF_SF);
  bf16_t* Sb = (bf16_t*)(ws + OFF_SB);
  for (int idx = blockIdx.x * 256 + threadIdx.x; idx < (1 << 20); idx += gridDim.x * 256) {
    int d = idx & 127, e = (idx >> 7) & 127, h = (idx >> 14) & 3, b = (idx >> 16) & 7, dir = idx >> 19;
    size_t eo = (size_t)e * 128 + d;
    if (dir == 0) {
      float cf = exp2f(log2gamma(p.lg_f[h]) * 256.f);
      float S = p.st_f[(size_t)(b * 4 + h) * 16384 + d * 128 + e];
#pragma unroll
      for (int blk = 0; blk < 8; ++blk) {
        size_t o = (size_t)((b * 8 + blk) * 4 + h) * 16384 + eo;
        Sf[o] = (bf16_t)f2bf(S);
        S = cf * S + Uf[o];
      }
    } else {
      float cb = exp2f(log2gamma(p.lg_b[h]) * 256.f);
      float S = p.st_b[(size_t)(b * 4 + h) * 16384 + d * 128 + e];
#pragma unroll
      for (int blk = 7; blk >= 0; --blk) {
        size_t o = (size_t)((b * 8 + blk) * 4 + h) * 16384 + eo;
        Sb[o] = (bf16_t)f2bf(S);
        S = cb * S + Ub[o];
      }
    }
  }
}

DI bf16x8 scale_frag(bf16x8 q, float s) {
  u32x4 u = __builtin_bit_cast(u32x4, q);
#pragma unroll
  for (int i = 0; i < 4; ++i) u[i] = pack2(bflo(u[i]) * s, bfhi(u[i]) * s);
  return __builtin_bit_cast(bf16x8, u);
}
constexpr int NQT = 1;
DI void phase5(const Params& p, char* smem) {
  char* ws = p.ws;
  const bf16_t* rq = (const bf16_t*)(ws + OFF_RQ);
  const bf16_t* rk = (const bf16_t*)(ws + OFF_RK);
  const bf16_t* vT = (const bf16_t*)(ws + OFF_VT);
  const bf16_t* srg = (const bf16_t*)(ws + OFF_SRG);
  const bf16_t* Sf = (const bf16_t*)(ws + OFF_SF);
  const bf16_t* Sb = (const bf16_t*)(ws + OFF_SB);
  bf16_t* ret = (bf16_t*)(ws + OFF_RET);
  bf16_t* Ks = (bf16_t*)smem;
  bf16_t* Vs = Ks + 64 * 136;
  const int tid = threadIdx.x, lane = tid & 63, w = tid >> 6, l15 = lane & 15, g = lane >> 4;
  for (int item = vbid(); item < 640 * (2 / NQT); item += gridDim.x) {
    const int qb = item >> 2, h = item & 3, blk = (qb * NQT) >> 2;
    const float l2f = log2gamma(p.lg_f[h]), l2b = log2gamma(p.lg_b[h]);
    const int tokw = qb * (64 * NQT) + w * (16 * NQT);
    bf16x8 Q[NQT][4];
#pragma unroll
    for (int qt = 0; qt < NQT; ++qt)
#pragma unroll
      for (int ks = 0; ks < 4; ++ks)
        Q[qt][ks] = *(const bf16x8*)(rq + (size_t)(tokw + qt * 16 + l15) * 512 + h * 128 + ks * 32 + g * 8);
    f32x4 o[8][NQT];
#pragma unroll
    for (int et = 0; et < 8; ++et)
#pragma unroll
      for (int qt = 0; qt < NQT; ++qt) o[et][qt] = f32x4{0.f, 0.f, 0.f, 0.f};
#pragma unroll 1
    for (int kt = 0; kt < 4; ++kt) {
      const int key0 = blk * 256 + kt * 64;
      __syncthreads();
#pragma unroll
      for (int i = 0; i < 4; ++i) {
        int c = tid + 256 * i;
        int r = c >> 4, cc = (c & 15) * 8;
        *(u32x4*)(Ks + r * 136 + cc) = *(const u32x4*)(rk + (size_t)(key0 + r) * 512 + h * 128 + cc);
        int e = c >> 3, c2 = (c & 7) * 8;
        *(u32x4*)(Vs + e * 72 + c2) = *(const u32x4*)(vT + (size_t)(h * 128 + e) * NTOK + key0 + c2);
      }
      __syncthreads();
      bf16x8 P[NQT][2];
#pragma unroll
      for (int qt = 0; qt < NQT; ++qt) {
        f32x4 s[4];
#pragma unroll
        for (int kk = 0; kk < 4; ++kk) s[kk] = f32x4{0.f, 0.f, 0.f, 0.f};
#pragma unroll
        for (int ks = 0; ks < 4; ++ks) {
#pragma unroll
          for (int kk = 0; kk < 4; ++kk) {
            bf16x8 a = *(const bf16x8*)(Ks + (kk * 16 + l15) * 136 + ks * 32 + g * 8);
            s[kk] = __builtin_amdgcn_mfma_f32_16x16x32_bf16(a, Q[qt][ks], s[kk], 0, 0, 0);
          }
        }
        const int iq = (tokw + qt * 16 + l15) & 255;
#pragma unroll
        for (int kk = 0; kk < 4; ++kk) {
#pragma unroll
          for (int j = 0; j < 4; ++j) {
            int jk = kt * 64 + kk * 16 + 4 * g + j;
            int diff = iq - jk;
            float dm = diff > 0 ? ex2(l2f * (float)diff) : (diff < 0 ? ex2(l2b * (float)(-diff)) : 2.f);
            s[kk][j] *= dm;
          }
        }
#pragma unroll
        for (int k2 = 0; k2 < 2; ++k2) {
          u32x4 u;
          u[0] = pack2(s[2 * k2][0], s[2 * k2][1]);
          u[1] = pack2(s[2 * k2][2], s[2 * k2][3]);
          u[2] = pack2(s[2 * k2 + 1][0], s[2 * k2 + 1][1]);
          u[3] = pack2(s[2 * k2 + 1][2], s[2 * k2 + 1][3]);
          P[qt][k2] = __builtin_bit_cast(bf16x8, u);
        }
      }
#pragma unroll
      for (int k2 = 0; k2 < 2; ++k2) {
#pragma unroll
        for (int et = 0; et < 8; ++et) {
          u32x2 lo = *(const u32x2*)(Vs + (et * 16 + l15) * 72 + k2 * 32 + 4 * g);
          u32x2 hi = *(const u32x2*)(Vs + (et * 16 + l15) * 72 + k2 * 32 + 16 + 4 * g);
          u32x4 u;
          u[0] = lo[0]; u[1] = lo[1]; u[2] = hi[0]; u[3] = hi[1];
          bf16x8 a = __builtin_bit_cast(bf16x8, u);
#pragma unroll
          for (int qt = 0; qt < NQT; ++qt) o[et][qt] = __builtin_amdgcn_mfma_f32_16x16x32_bf16(a, P[qt][k2], o[et][qt], 0, 0, 0);
        }
      }
    }
    if (blk >= 16) {
#pragma unroll 1
      for (int dir = 0; dir < 2; ++dir) {
        const bf16_t* S = (dir ? Sb : Sf) + (size_t)((blk - 16) * 4 + h) * 16384;
        float dq[NQT];
#pragma unroll
        for (int qt = 0; qt < NQT; ++qt) {
          int iq = (tokw + qt * 16 + l15) & 255;
          dq[qt] = dir ? exp2f(l2b * (float)(256 - iq)) : exp2f(l2f * (float)(iq + 1));
        }
#pragma unroll
        for (int ks = 0; ks < 4; ++ks) {
          bf16x8 qs[NQT];
#pragma unroll
          for (int qt = 0; qt < NQT; ++qt) qs[qt] = scale_frag(Q[qt][ks], dq[qt]);
#pragma unroll
          for (int et = 0; et < 8; ++et) {
            bf16x8 a = *(const bf16x8*)(S + (size_t)(et * 16 + l15) * 128 + ks * 32 + g * 8);
#pragma unroll
            for (int qt = 0; qt < NQT; ++qt) o[et][qt] = __builtin_amdgcn_mfma_f32_16x16x32_bf16(a, qs[qt], o[et][qt], 0, 0, 0);
          }
        }
      }
    }
#pragma unroll
    for (int qt = 0; qt < NQT; ++qt) {
      const int tok = tokw + qt * 16 + l15;
      float s1 = 0.f;
#pragma unroll
      for (int et = 0; et < 8; ++et)
#pragma unroll
        for (int j = 0; j < 4; ++j) s1 += o[et][qt][j];
      s1 += __shfl_xor(s1, 16);
      s1 += __shfl_xor(s1, 32);
      const float mu = s1 * (1.f / 128.f);
      float s2 = 0.f;
#pragma unroll
      for (int et = 0; et < 8; ++et)
#pragma unroll
        for (int j = 0; j < 4; ++j) {
          float dlt = o[et][qt][j] - mu;
          s2 += dlt * dlt;
        }
      s2 += __shfl_xor(s2, 16);
      s2 += __shfl_xor(s2, 32);
      const float rstd = rsqrtf(s2 * (1.f / 128.f) + 1e-6f);
#pragma unroll
      for (int et = 0; et < 8; ++et) {
        const int e = h * 128 + et * 16 + 4 * g;
        float4 gn = *(const float4*)(p.ret_gn + e);
        u32x2 sg = *(const u32x2*)(srg + (size_t)tok * 512 + e);
        u32x2 ov;
        ov[0] = pack2((o[et][qt][0] - mu) * rstd * gn.x * bflo(sg[0]), (o[et][qt][1] - mu) * rstd * gn.y * bfhi(sg[0]));
        ov[1] = pack2((o[et][qt][2] - mu) * rstd * gn.z * bflo(sg[1]), (o[et][qt][3] - mu) * rstd * gn.w * bfhi(sg[1]));
        *(u32x2*)(ret + (size_t)tok * 512 + e) = ov;
      }
    }
  }
}

DI void phase6(const Params& p, char* smem) {
  char* ws = p.ws;
  const bf16_t* cqn = (const bf16_t*)(ws + OFF_CQ);
  const bf16_t* wuqT = (const bf16_t*)(ws + OFF_WUQT);
  bf16_t* q = (bf16_t*)(ws + OFF_Q);
  for (int it = 0;; ++it) {
    int ft, tt;
    if (!tile_map(it, 6, 160, 1, ft, tt)) break;
    f32x4 acc[4][4];
    acc_zero(acc);
    gemm_kloop<0>(acc, wuqT + (size_t)ft * 128 * 256, 256, cqn + (size_t)tt * 128 * 256, 256, 256, smem, 0.f, 0.f);
    epilogue(acc, [&](int m, int n, float (&v)[16]) { st_bf16x16(q + (size_t)(tt * 128 + n) * 768 + ft * 128 + m, v); });
  }
  const bf16_t* ckvall = (const bf16_t*)(ws + OFF_CKVALL);
  const bf16_t* wukvT = (const bf16_t*)(ws + OFF_WUKVT);
  bf16_t* Kn = (bf16_t*)(ws + OFF_KN);
  bf16_t* Vt = (bf16_t*)(ws + OFF_VTA);
  for (int it = 0;; ++it) {
    int ft, tt;
    if (!tile_map(it, 8, 192, 1, ft, tt)) break;
    f32x4 acc[4][4];
    acc_zero(acc);
    const bf16_t* W = wukvT + (size_t)ft * 128 * 128;
    const bf16_t* X = ckvall + (size_t)tt * 128 * 128;
    if (ft < 4) {
      gemm_kloop<0>(acc, W, 128, X, 128, 128, smem, 0.f, 0.f);
      epilogue(acc, [&](int m, int n, float (&v)[16]) { st_bf16x16(Kn + (size_t)(tt * 128 + n) * 512 + ft * 128 + m, v); });
    } else {
      gemm_kloop<0>(acc, X, 128, W, 128, 128, smem, 0.f, 0.f);
      epilogue(acc, [&](int m, int n, float (&v)[16]) { st_bf16x16(Vt + (size_t)((ft - 4) * 128 + n) * NKV + tt * 128 + m, v); });
    }
  }
}

DI void phase7(const Params& p, char* smem) {
  char* ws = p.ws;
  const bf16_t* q = (const bf16_t*)(ws + OFF_Q);
  const bf16_t* Kn = (const bf16_t*)(ws + OFF_KN);
  const bf16_t* Vt = (const bf16_t*)(ws + OFF_VTA);
  const bf16_t* krall = (const bf16_t*)(ws + OFF_KRALL);
  bf16_t* attn = (bf16_t*)(ws + OFF_ATTN);
  bf16_t* Ks = (bf16_t*)smem;
  bf16_t* Vs = Ks + 64 * 104;
  const int tid = threadIdx.x, lane = tid & 63, w = tid >> 6, l15 = lane & 15, g = lane >> 4;
  const float qscale = 0.10206207261596577f * 1.4426950408889634f;
  for (int item = vbid(); item < 1280; item += gridDim.x) {
    int b, h, qtok0, keyrow0, nkt;
    bool sample;
    if (item < 1024) {
      sample = true; b = item >> 7; h = (item >> 4) & 7; int qb = item & 15;
      qtok0 = NPT + b * 2048 + qb * 128; keyrow0 = NPT + b * 2560; nkt = 40;
    } else {
      int it2 = item - 1024;
      sample = false; b = it2 >> 4; h = (it2 >> 1) & 7; int qb = it2 & 1;
      qtok0 = b * 256 + qb * 128; keyrow0 = b * 256; nkt = 4;
    }
    bf16x8 Q[2][3];
#pragma unroll
    for (int qt = 0; qt < 2; ++qt) {
      const int tokq = qtok0 + w * 32 + qt * 16 + l15;
      const bf16_t* qp = q + (size_t)tokq * 768 + h * 96;
#pragma unroll
      for (int ks = 0; ks < 3; ++ks) {
        u32x4 u = *(const u32x4*)(qp + ks * 32 + g * 8);
        float v[8];
#pragma unroll
        for (int i = 0; i < 4; ++i) { v[2 * i] = bflo(u[i]); v[2 * i + 1] = bfhi(u[i]); }
        if (ks == 2 && sample) {
          u32x4 up = *(const u32x4*)(qp + 64 + (g ^ 2) * 8);
          float pv[8];
#pragma unroll
          for (int i = 0; i < 4; ++i) { pv[2 * i] = bflo(up[i]); pv[2 * i + 1] = bfhi(up[i]); }
          int t = (tokq - NPT) & 2047;
          float pos = (g & 1) ? (float)(t & 63) : (float)(t >> 6);
#pragma unroll
          for (int i = 0; i < 8; ++i) {
            float fr = exp2f(-(float)i * 1.6609640474436813f);
            float sn, cs;
            sincosf(pos * fr, &sn, &cs);
            v[i] = g < 2 ? v[i] * cs - pv[i] * sn : pv[i] * sn + v[i] * cs;
          }
        }
        u32x4 o4;
#pragma unroll
        for (int i = 0; i < 4; ++i) o4[i] = pack2(v[2 * i] * qscale, v[2 * i + 1] * qscale);
        Q[qt][ks] = __builtin_bit_cast(bf16x8, o4);
      }
    }
    f32x4 o[4][2];
#pragma unroll
    for (int et = 0; et < 4; ++et)
#pragma unroll
      for (int qt = 0; qt < 2; ++qt) o[et][qt] = f32x4{0.f, 0.f, 0.f, 0.f};
    float mrun[2] = {-1e30f, -1e30f}, lrun[2] = {0.f, 0.f};
    u32x4 rk_[3], rv_[2];
    auto gload = [&](int kt) {
      const int row0 = keyrow0 + kt * 64;
#pragma unroll
      for (int i = 0; i < 3; ++i) {
        int c = tid + 256 * i;
        int r = c / 12, cc = c - r * 12;
        rk_[i] = cc < 8 ? *(const u32x4*)(Kn + (size_t)(row0 + r) * 512 + h * 64 + cc * 8)
                        : *(const u32x4*)(krall + (size_t)(row0 + r) * 32 + (cc - 8) * 8);
      }
#pragma unroll
      for (int i = 0; i < 2; ++i) {
        int c = tid + 256 * i;
        int e = c >> 3, cc = (c & 7) * 8;
        rv_[i] = *(const u32x4*)(Vt + (size_t)(h * 64 + e) * NKV + row0 + cc);
      }
    };
    gload(0);
#pragma unroll 1
    for (int kt = 0; kt < nkt; ++kt) {
      __syncthreads();
#pragma unroll
      for (int i = 0; i < 3; ++i) {
        int c = tid + 256 * i;
        int r = c / 12, cc = c - r * 12;
        *(u32x4*)(Ks + r * 104 + cc * 8) = rk_[i];
      }
#pragma unroll
      for (int i = 0; i < 2; ++i) {
        int c = tid + 256 * i;
        int e = c >> 3, cc = (c & 7) * 8;
        *(u32x4*)(Vs + e * 72 + cc) = rv_[i];
      }
      __syncthreads();
      if (kt + 1 < nkt) gload(kt + 1);
      f32x4 s[4][2];
#pragma unroll
      for (int kk = 0; kk < 4; ++kk)
#pragma unroll
        for (int qt = 0; qt < 2; ++qt) s[kk][qt] = f32x4{0.f, 0.f, 0.f, 0.f};
#pragma unroll
      for (int ks = 0; ks < 3; ++ks) {
#pragma unroll
        for (int kk = 0; kk < 4; ++kk) {
          bf16x8 a = *(const bf16x8*)(Ks + (kk * 16 + l15) * 104 + ks * 32 + g * 8);
#pragma unroll
          for (int qt = 0; qt < 2; ++qt) s[kk][qt] = __builtin_amdgcn_mfma_f32_16x16x32_bf16(a, Q[qt][ks], s[kk][qt], 0, 0, 0);
        }
      }
      bf16x8 P[2][2];
#pragma unroll
      for (int qt = 0; qt < 2; ++qt) {
        float mx = s[0][qt][0];
#pragma unroll
        for (int kk = 0; kk < 4; ++kk)
#pragma unroll
          for (int j = 0; j < 4; ++j) mx = fmaxf(mx, s[kk][qt][j]);
        mx = fmaxf(mx, __shfl_xor(mx, 16));
        mx = fmaxf(mx, __shfl_xor(mx, 32));
        const float mnew = fmaxf(mrun[qt], mx);
        const float alpha = ex2(mrun[qt] - mnew);
        mrun[qt] = mnew;
        float ps = 0.f;
#pragma unroll
        for (int kk = 0; kk < 4; ++kk)
#pragma unroll
          for (int j = 0; j < 4; ++j) {
            float e_ = ex2(s[kk][qt][j] - mnew);
            s[kk][qt][j] = e_;
            ps += e_;
          }
        lrun[qt] = lrun[qt] * alpha + ps;
#pragma unroll
        for (int et = 0; et < 4; ++et)
#pragma unroll
          for (int j = 0; j < 4; ++j) o[et][qt][j] *= alpha;
#pragma unroll
        for (int k2 = 0; k2 < 2; ++k2) {
          u32x4 u;
          u[0] = pack2(s[2 * k2][qt][0], s[2 * k2][qt][1]);
          u[1] = pack2(s[2 * k2][qt][2], s[2 * k2][qt][3]);
          u[2] = pack2(s[2 * k2 + 1][qt][0], s[2 * k2 + 1][qt][1]);
          u[3] = pack2(s[2 * k2 + 1][qt][2], s[2 * k2 + 1][qt][3]);
          P[qt][k2] = __builtin_bit_cast(bf16x8, u);
        }
      }
#pragma unroll
      for (int k2 = 0; k2 < 2; ++k2) {
#pragma unroll
        for (int et = 0; et < 4; ++et) {
          u32x2 lo = *(const u32x2*)(Vs + (et * 16 + l15) * 72 + k2 * 32 + 4 * g);
          u32x2 hi = *(const u32x2*)(Vs + (et * 16 + l15) * 72 + k2 * 32 + 16 + 4 * g);
          u32x4 u;
          u[0] = lo[0]; u[1] = lo[1]; u[2] = hi[0]; u[3] = hi[1];
          bf16x8 a = __builtin_bit_cast(bf16x8, u);
#pragma unroll
          for (int qt = 0; qt < 2; ++qt) o[et][qt] = __builtin_amdgcn_mfma_f32_16x16x32_bf16(a, P[qt][k2], o[et][qt], 0, 0, 0);
        }
      }
    }
#pragma unroll
    for (int qt = 0; qt < 2; ++qt) {
      const int tokq = qtok0 + w * 32 + qt * 16 + l15;
      float lt = lrun[qt];
      lt += __shfl_xor(lt, 16);
      lt += __shfl_xor(lt, 32);
      const float inv = 1.f / lt;
#pragma unroll
      for (int et = 0; et < 4; ++et) {
        u32x2 ov;
        ov[0] = pack2(o[et][qt][0] * inv, o[et][qt][1] * inv);
        ov[1] = pack2(o[et][qt][2] * inv, o[et][qt][3] * inv);
        *(u32x2*)(attn + (size_t)tokq * 512 + h * 64 + et * 16 + 4 * g) = ov;
      }
    }
  }
}

DI void phase8(const Params& p, char* smem) {
  char* ws = p.ws;
  const bf16_t* attn = (const bf16_t*)(ws + OFF_ATTN);
  const bf16_t* ret = (const bf16_t*)(ws + OFF_RET);
  const bf16_t* wa = (const bf16_t*)(ws + OFF_WUPAT);
  const bf16_t* wb = (const bf16_t*)(ws + OFF_WUPBT);
  const bf16_t* sga = (const bf16_t*)p.out;
  const bf16_t* sgb = sga + (size_t)NTOK * 1024;
  bf16_t* mbuf = (bf16_t*)(ws + OFF_M);
  const int tid = threadIdx.x, lane = tid & 63, w = tid >> 6, wm = w >> 1, wn = w & 1, l15 = lane & 15, g = lane >> 4;
  for (int it = 0;; ++it) {
    int ft, tt;
    if (!tile_map(it, 8, 160, 1, ft, tt)) break;
    f32x4 acc[4][4];
    acc_zero(acc);
    gemm_kloop<0>(acc, wa + (size_t)ft * 128 * 512, 512, attn + (size_t)tt * 128 * 512, 512, 512, smem, 0.f, 0.f);
#pragma unroll
    for (int c = 0; c < 4; ++c) {
      const size_t off = (size_t)(tt * 128 + wn * 64 + c * 16 + l15) * 1024 + ft * 128 + wm * 64 + 16 * g;
      float a[16], bq[16];
      ld_bf16x16(sga + off, a);
      ld_bf16x16(sgb + off, bq);
#pragma unroll
      for (int f = 0; f < 4; ++f)
#pragma unroll
        for (int j = 0; j < 4; ++j) acc[f][c][j] *= a[f * 4 + j] / fmaxf(bq[f * 4 + j], 1e-30f);
    }
    gemm_kloop<0>(acc, wb + (size_t)ft * 128 * 512, 512, ret + (size_t)tt * 128 * 512, 512, 512, smem, 0.f, 0.f);
    epilogue(acc, [&](int m, int n, float (&v)[16]) {
      const size_t off = (size_t)(tt * 128 + n) * 1024 + ft * 128 + m;
      float bq[16];
      ld_bf16x16(sgb + off, bq);
#pragma unroll
      for (int i = 0; i < 16; ++i) v[i] *= bq[i];
      st_bf16x16(mbuf + off, v);
    });
  }
}
DI void phase9(const Params& p, char* smem) {
  char* ws = p.ws;
  const bf16_t* mbuf = (const bf16_t*)(ws + OFF_M);
  const bf16_t* wo = (const bf16_t*)(ws + OFF_WOT);
  const float* mod = (const float*)(ws + OFF_MOD);
  for (int it = 0;; ++it) {
    int ft, tt;
    if (!tile_map(it, 8, 160, 1, ft, tt)) break;
    f32x4 acc[4][4];
    acc_zero(acc);
    gemm_kloop<0>(acc, wo + (size_t)ft * 128 * 1024, 1024, mbuf + (size_t)tt * 128 * 1024, 1024, 1024, smem, 0.f, 0.f);
    epilogue(acc, [&](int m, int n, float (&v)[16]) {
      const int tok = tt * 128 + n, feat = ft * 128 + m;
      const float* xr = xrow(p, tok) + feat;
      const float* g1 = mod + modidx(tok) * 6144 + 2048 + feat;
#pragma unroll
      for (int i = 0; i < 4; ++i) {
        float4 xv = *(const float4*)(xr + 4 * i), gv = *(const float4*)(g1 + 4 * i);
        v[4 * i] = xv.x + gv.x * v[4 * i];
        v[4 * i + 1] = xv.y + gv.y * v[4 * i + 1];
        v[4 * i + 2] = xv.z + gv.z * v[4 * i + 2];
        v[4 * i + 3] = xv.w + gv.w * v[4 * i + 3];
      }
      st_f32x16(p.out + (size_t)tok * DM + feat, v);
    });
  }
}
DI void conv_fp8_rows(const float* __restrict__ src, unsigned char* __restrict__ dst, float* __restrict__ inv) {
  const int lane = threadIdx.x & 63, w = threadIdx.x >> 6;
  for (int r = blockIdx.x * 4 + w; r < 16384; r += gridDim.x * 4) {
    const float* sp = src + (size_t)r * 1024 + lane * 16;
    float4 v[4];
    float am = 0.f;
#pragma unroll
    for (int i = 0; i < 4; ++i) {
      v[i] = *(const float4*)(sp + 4 * i);
      am = fmaxf(am, fmaxf(fmaxf(fabsf(v[i].x), fabsf(v[i].y)), fmaxf(fabsf(v[i].z), fabsf(v[i].w))));
    }
#pragma unroll
    for (int o = 32; o > 0; o >>= 1) am = fmaxf(am, __shfl_xor(am, o));
    const float sc = am > 0.f ? 448.f / am : 1.f;
    u32x4 o4;
#pragma unroll
    for (int i = 0; i < 4; ++i) {
      int wd = 0;
      wd = __builtin_amdgcn_cvt_pk_fp8_f32(v[i].x * sc, v[i].y * sc, wd, false);
      wd = __builtin_amdgcn_cvt_pk_fp8_f32(v[i].z * sc, v[i].w * sc, wd, true);
      o4[i] = (unsigned)wd;
    }
    *(u32x4*)(dst + (size_t)r * 1024 + lane * 16) = o4;
    if (lane == 0) inv[r] = am > 0.f ? am * (1.f / 448.f) : 1.f;
  }
}
DI void phase10(const Params& p, char* smem) {
  rows_norm_mod(p, p.norm_ffn, 3072, 4096, true, (bf16_t*)(p.ws + OFF_H2));
  conv_fp8_rows(p.peer_u, (unsigned char*)(p.ws + OFF_TABU), (float*)(p.ws + OFF_INVU));
  conv_fp8_rows(p.peer_v, (unsigned char*)(p.ws + OFF_TABV), (float*)(p.ws + OFF_INVV));
}
DI void phase11(const Params& p, char* smem) {
  char* ws = p.ws;
  const bf16_t* h2 = (const bf16_t*)(ws + OFF_H2);
  const bf16_t* wct = (const bf16_t*)(ws + OFF_WCT);
  bf16_t* sc = (bf16_t*)(ws + OFF_SCORES);
  for (int it = 0;; ++it) {
    int ft, tt;
    if (!tile_map(it, 16, 160, 2, ft, tt)) break;
    f32x4 acc[4][4];
    acc_zero(acc);
    gemm_kloop<0>(acc, wct + (size_t)ft * 128 * 1024, 1024, h2 + (size_t)tt * 128 * 1024, 1024, 1024, smem, 0.f, 0.f);
    epilogue(acc, [&](int m, int n, float (&v)[16]) { st_bf16x16(sc + (size_t)(tt * 128 + n) * 2048 + ft * 128 + m, v); });
  }
}

DI unsigned okey(float f) {
  unsigned u = __float_as_uint(f);
  return (u & 0x80000000u) ? ~u : (u | 0x80000000u);
}
DI void wave_lds_sync() {
  __builtin_amdgcn_fence(__ATOMIC_ACQ_REL, "workgroup");
  __builtin_amdgcn_wave_barrier();
}
template <int V>
DI void topk16(const unsigned (&key)[V], int lowbit, int lane, int (&slot)[V]) {
  unsigned T = 0;
  for (int b = 31; b >= lowbit; --b) {
    unsigned cnd = T | (1u << b);
    int cnt = 0;
#pragma unroll
    for (int v = 0; v < V; ++v) cnt += __popcll(__ballot(key[v] >= cnd));
    if (cnt >= 16) T = cnd;
    if (cnt == 16) break;
  }
  const unsigned Tp = T >> lowbit;
  const unsigned long long lt = (1ull << lane) - 1ull;
  int base = 0;
#pragma unroll
  for (int v = 0; v < V; ++v) {
    bool gt = (key[v] >> lowbit) > Tp;
    unsigned long long m = __ballot(gt);
    slot[v] = gt ? base + __popcll(m & lt) : -1;
    base += __popcll(m);
  }
  const int need = 16 - base;
  int eb = 0;
#pragma unroll
  for (int v = 0; v < V; ++v) {
    bool eq = (key[v] >> lowbit) == Tp;
    unsigned long long m = __ballot(eq);
    int r = eb + __popcll(m & lt);
    if (eq && r < need) slot[v] = base + r;
    eb += __popcll(m);
  }
}
DI void phase12(const Params& p, char* smem) {
  char* ws = p.ws;
  const bf16_t* sc = (const bf16_t*)(ws + OFF_SCORES);
  const bf16_t* h2 = (const bf16_t*)(ws + OFF_H2);
  const unsigned char* tabU = (const unsigned char*)(ws + OFF_TABU);
  const unsigned char* tabV = (const unsigned char*)(ws + OFF_TABV);
  const float* invU = (const float*)(ws + OFF_INVU);
  const float* invV = (const float*)(ws + OFF_INVV);
  const float* mod = (const float*)(ws + OFF_MOD);
  const int lane = threadIdx.x & 63, w = threadIdx.x >> 6;
  float* wl = (float*)(smem + w * 512);
  float* sv1 = wl;
  float* sv2 = wl + 16;
  int* si1 = (int*)(wl + 32);
  int* si2 = (int*)(wl + 48);
  float* lv = wl + 64;
  int* le = (int*)(wl + 80);
  for (int tok = blockIdx.x * 4 + w; tok < NTOK; tok += gridDim.x * 4) {
    float hf[16];
    {
      u32x4 a = *(const u32x4*)(h2 + (size_t)tok * DM + lane * 16), b = *(const u32x4*)(h2 + (size_t)tok * DM + lane * 16 + 8);
#pragma unroll
      for (int i = 0; i < 4; ++i) {
        hf[2 * i] = bflo(a[i]); hf[2 * i + 1] = bfhi(a[i]);
        hf[8 + 2 * i] = bflo(b[i]); hf[8 + 2 * i + 1] = bfhi(b[i]);
      }
    }
    float oacc[16];
#ifndef P12_REPS
#define P12_REPS 1
#endif
#pragma unroll 1
    for (int rep = 0; rep < P12_REPS; ++rep) {
#pragma unroll
    for (int i = 0; i < 16; ++i) oacc[i] = 0.f;
#pragma unroll 1
    for (int h = 0; h < 8; ++h) {
      int ln = lane;
      asm volatile("" : "+v"(ln));
      const int kq = ((ln >> 5) & 1) * 8 + ((ln >> 4) & 1) * 4 + ((ln >> 3) & 1) * 2 + ((ln >> 2) & 1);
      const bf16_t* sp = sc + (size_t)tok * 2048 + h * 256;
#pragma unroll
      for (int half = 0; half < 2; ++half) {
        float v0 = bf2f(sp[half * 128 + ln]), v1 = bf2f(sp[half * 128 + 64 + ln]);
        unsigned key[2] = {okey(v0), okey(v1)};
        int slot[2];
        topk16<2>(key, 16, ln, slot);
        float* sv = half ? sv2 : sv1;
        int* si = half ? si2 : si1;
        if (slot[0] >= 0) { sv[slot[0]] = v0; si[slot[0]] = ln; }
        if (slot[1] >= 0) { sv[slot[1]] = v1; si[slot[1]] = 64 + ln; }
      }
      wave_lds_sync();
      {
        const float b2 = sv2[ln & 15];
        float cv[4];
        unsigned key[4];
        int slot[4];
#pragma unroll
        for (int v = 0; v < 4; ++v) {
          cv[v] = sv1[v * 4 + (ln >> 4)] + b2;
          key[v] = okey(cv[v]);
        }
        topk16<4>(key, 0, ln, slot);
        const int i2 = si2[ln & 15];
#pragma unroll
        for (int v = 0; v < 4; ++v) {
          if (slot[v] >= 0) {
            lv[slot[v]] = cv[v];
            le[slot[v]] = si1[v * 4 + (ln >> 4)] * 128 + i2;
          }
        }
      }
      wave_lds_sync();
      float mx = lv[0];
#pragma unroll
      for (int k = 1; k < 16; ++k) mx = fmaxf(mx, lv[k]);
      float den = 0.f;
#pragma unroll
      for (int k = 0; k < 16; ++k) den += __expf(lv[k] - mx);
      const float gk = __expf(lv[kq] - mx) / den;
      const int eown = le[kq];
      const float iu = invU[eown], iv = invV[eown];
      float pd[16];
#pragma unroll
      for (int hb = 0; hb < 2; ++hb) {
        u32x4 ur[8];
#pragma unroll
        for (int k = 0; k < 8; ++k)
          ur[k] = *(const u32x4*)(tabU + (size_t)__builtin_amdgcn_readfirstlane(le[hb * 8 + k]) * 1024 + ln * 16);
#pragma unroll
        for (int k = 0; k < 8; ++k) {
          float d = 0.f;
#pragma unroll
          for (int i = 0; i < 4; ++i) {
            auto lo = __builtin_amdgcn_cvt_pk_f32_fp8((int)ur[k][i], false);
            auto hi2 = __builtin_amdgcn_cvt_pk_f32_fp8((int)ur[k][i], true);
            d += lo[0] * hf[4 * i] + lo[1] * hf[4 * i + 1] + hi2[0] * hf[4 * i + 2] + hi2[1] * hf[4 * i + 3];
          }
          pd[hb * 8 + k] = d;
        }
      }
      float q8[8], q4[4], q2[2], q1;
      {
        const bool hi = ln & 32;
#pragma unroll
        for (int i = 0; i < 8; ++i) {
          float send = hi ? pd[i] : pd[8 + i], keep = hi ? pd[8 + i] : pd[i];
          q8[i] = keep + __shfl_xor(send, 32);
        }
      }
      {
        const bool hi = ln & 16;
#pragma unroll
        for (int i = 0; i < 4; ++i) {
          float send = hi ? q8[i] : q8[4 + i], keep = hi ? q8[4 + i] : q8[i];
          q4[i] = keep + __shfl_xor(send, 16);
        }
      }
      {
        const bool hi = ln & 8;
#pragma unroll
        for (int i = 0; i < 2; ++i) {
          float send = hi ? q4[i] : q4[2 + i], keep = hi ? q4[2 + i] : q4[i];
          q2[i] = keep + __shfl_xor(send, 8);
        }
      }
      {
        const bool hi = ln & 4;
        float send = hi ? q2[0] : q2[1], keep = hi ? q2[1] : q2[0];
        q1 = keep + __shfl_xor(send, 4);
      }
      q1 += __shfl_xor(q1, 2);
      q1 += __shfl_xor(q1, 1);
      const float wk_own = gk * geluf_(q1 * iu) * iv;
#pragma unroll
      for (int hb = 0; hb < 2; ++hb) {
        u32x4 vr[8];
#pragma unroll
        for (int k = 0; k < 8; ++k)
          vr[k] = *(const u32x4*)(tabV + (size_t)__builtin_amdgcn_readfirstlane(le[hb * 8 + k]) * 1024 + ln * 16);
#pragma unroll
        for (int k = 0; k < 8; ++k) {
          const int kk = hb * 8 + k;
          const int src = (((kk >> 3) & 1) << 5) | (((kk >> 2) & 1) << 4) | (((kk >> 1) & 1) << 3) | ((kk & 1) << 2);
          const float wk = __shfl(wk_own, src);
#pragma unroll
          for (int i = 0; i < 4; ++i) {
            auto lo = __builtin_amdgcn_cvt_pk_f32_fp8((int)vr[k][i], false);
            auto hi2 = __builtin_amdgcn_cvt_pk_f32_fp8((int)vr[k][i], true);
            oacc[4 * i] += wk * lo[0];
            oacc[4 * i + 1] += wk * lo[1];
            oacc[4 * i + 2] += wk * hi2[0];
            oacc[4 * i + 3] += wk * hi2[1];
          }
        }
      }
      wave_lds_sync();
    }
    }
    float* xr = p.out + (size_t)tok * DM;
    const float* g2 = mod + modidx(tok) * 6144 + 5120;
    float y[16];
    float ss = 0.f;
#pragma unroll
    for (int i = 0; i < 4; ++i) {
      const int e = lane * 16 + i * 4;
      float4 xv = *(const float4*)(xr + e), gv = *(const float4*)(g2 + e);
      float a0 = xv.x + gv.x * oacc[i * 4], a1 = xv.y + gv.y * oacc[i * 4 + 1];
      float a2 = xv.z + gv.z * oacc[i * 4 + 2], a3 = xv.w + gv.w * oacc[i * 4 + 3];
      y[i * 4] = a0; y[i * 4 + 1] = a1; y[i * 4 + 2] = a2; y[i * 4 + 3] = a3;
      ss += a0 * a0 + a1 * a1 + a2 * a2 + a3 * a3;
    }
    ss = wsum(ss);
    const float rstd = rsqrtf(ss * (1.f / 1024.f) + 1e-6f);
#pragma unroll
    for (int i = 0; i < 4; ++i) {
      const int e = lane * 16 + i * 4;
      float4 nf = *(const float4*)(p.norm_final + e);
      *(float4*)(xr + e) = make_float4(y[i * 4] * rstd * nf.x, y[i * 4 + 1] * rstd * nf.y, y[i * 4 + 2] * rstd * nf.z,
                                       y[i * 4 + 3] * rstd * nf.w);
    }
  }
}

#define XB_TMO      128
#define XB_XCNT(j)  (256  + 64 * (j))
#define XB_XSUB(j)  (1280 + 64 * (j))
#define XB_XGEN(j)  (2304 + 64 * (j))
#define XB_TOP      3328
#define XB_TOPGEN   3392
#define XCD_BAR_WORDS 3456
#define XB_SPIN_CAP (1u << 22)
#define LAS __attribute__((address_space(3)))
DI unsigned xb_ld(unsigned* p) { return __hip_atomic_load(p, __ATOMIC_RELAXED, __HIP_MEMORY_SCOPE_AGENT); }
DI unsigned xb_add(unsigned* p, unsigned v) { return __hip_atomic_fetch_add(p, v, __ATOMIC_RELAXED, __HIP_MEMORY_SCOPE_AGENT); }
DI unsigned xb_xcc_id() { return (unsigned)__builtin_amdgcn_s_getreg((3 << 11) | 20) & 0xFu; }
#define XB_SPIN(cond, bar) do { unsigned _sp = 0; while (cond) { __builtin_amdgcn_s_sleep(1); \
    if ((++_sp & 255u) == 0u) { if (xb_ld(&(bar)[XB_TMO])) break; if (_sp > XB_SPIN_CAP) { atomicAdd(&(bar)[XB_TMO], 1u); break; } } } } while (0)
struct XcdBarrier { unsigned* bar; unsigned x; volatile LAS unsigned* st; };
DI XcdBarrier xcd_barrier_post(unsigned* bar, volatile LAS unsigned* st) {
  XcdBarrier b; b.bar = bar; b.x = xb_xcc_id(); b.st = st;
  if (threadIdx.x == 0) (void)xb_add(&bar[XB_XCNT(b.x)], 1u);
  return b;
}
DI void xcd_barrier_complete(unsigned* bar, unsigned x, unsigned& nloc, unsigned& nx) {
  const unsigned G = gridDim.x * gridDim.y * gridDim.z;
  unsigned sum, cnt, mine, sp = 0u;
  for (;;) {
    sum = 0u; cnt = 0u; mine = 0u;
#pragma unroll
    for (unsigned j = 0; j < 16; ++j) { const unsigned c = xb_ld(&bar[XB_XCNT(j)]); sum += c; cnt += (c > 0u) ? 1u : 0u; mine = (j == x) ? c : mine; }
    if (sum == G) break;
    __builtin_amdgcn_s_sleep(1);
    if ((++sp & 255u) == 0u) { if (xb_ld(&bar[XB_TMO])) break; if (sp > XB_SPIN_CAP) { atomicAdd(&bar[XB_TMO], 1u); break; } }
  }
  nloc = mine > 0u ? mine : 1u; nx = cnt > 0u ? cnt : 1u;
}
DI void xcd_barrier(const XcdBarrier& b) {
  asm volatile("s_waitcnt vmcnt(0)" ::: "memory");
  __syncthreads();
  if (threadIdx.x == 0) {
    unsigned* bar = b.bar;
    __builtin_amdgcn_s_waitcnt(0);
    unsigned nloc = b.st[0], nx = b.st[1];
    if (nloc == 0u) { xcd_barrier_complete(bar, b.x, nloc, nx); b.st[0] = nloc; b.st[1] = nx; }
    const unsigned old = xb_add(&bar[XB_XSUB(b.x)], 1u);
    const unsigned gen = old / nloc;
    if (old + 1u == (gen + 1u) * nloc) {
      __builtin_amdgcn_fence(__ATOMIC_RELEASE, "agent");
      asm volatile("s_waitcnt vmcnt(0)" ::: "memory");
      const unsigned og = xb_add(&bar[XB_TOP], 1u);
      const unsigned tg = og / nx;
      if (og + 1u == (tg + 1u) * nx) xb_add(&bar[XB_TOPGEN], 1u);
      else XB_SPIN(xb_ld(&bar[XB_TOPGEN]) == tg, bar);
      __builtin_amdgcn_fence(__ATOMIC_ACQUIRE, "agent");
      xb_add(&bar[XB_XGEN(b.x)], 1u);
      asm volatile("s_waitcnt vmcnt(0)" ::: "memory");
    } else {
      XB_SPIN(xb_ld(&bar[XB_XGEN(b.x)]) == gen, bar);
      __builtin_amdgcn_fence(__ATOMIC_ACQUIRE, "agent");
      asm volatile("s_waitcnt vmcnt(0)" ::: "memory");
    }
  }
  __syncthreads();
}

#ifdef ONLY_PHASE
#define RUNPH(n, call) if (ONLY_PHASE == n) { call; }
#else
#ifndef DUP_PHASE
#define DUP_PHASE -1
#endif
#define RUNPH(n, call) if (lo <= n && n < hi) { call; if (n == DUP_PHASE) { xcd_barrier(xb); call; } if (n + 1 < hi) xcd_barrier(xb); }
#endif
__global__ void __launch_bounds__(256, 2) mega(Params p, int lo, int hi) {
  __shared__ __attribute__((aligned(16))) char smem[SMEM_BYTES];
  __shared__ uint4 xb_words;
  cg::grid_group grid = cg::this_grid();
  if (lo < 0) grid.sync();
  if (threadIdx.x == 0) xb_words = make_uint4(0u, 0u, 0u, 0u);
  __syncthreads();
  XcdBarrier xb = xcd_barrier_post((unsigned*)(p.ws + OFF_BAR), (volatile LAS unsigned*)&xb_words);
  RUNPH(0, phase0(p, smem))
  RUNPH(1, phase1(p, smem))
  RUNPH(2, phase2(p, smem))
  RUNPH(3, phase3(p, smem))
  RUNPH(4, phase4(p))
  RUNPH(5, phase5(p, smem))
  RUNPH(6, phase6(p, smem))
  RUNPH(7, phase7(p, smem))
  RUNPH(8, phase8(p, smem))
  RUNPH(9, phase9(p, smem))
  RUNPH(10, phase10(p, smem))
  RUNPH(11, phase11(p, smem))
  RUNPH(12, phase12(p, smem))
}

extern "C" void kernel_launch(void* const* d_in, const int* in_sizes, int n_in, void* d_out, int out_size, void* d_ws,
                              size_t ws_size, hipStream_t stream) {
  static int grid_blocks = 0;
  if (!grid_blocks) {
    int dev = 0, cus = 0, per_cu = 0;
    hipGetDevice(&dev);
    hipDeviceGetAttribute(&cus, hipDeviceAttributeMultiprocessorCount, dev);
    hipOccupancyMaxActiveBlocksPerMultiprocessor(&per_cu, mega, 256, 0);
    if (per_cu > 2) per_cu = 2;
    if (per_cu < 1) per_cu = 1;
    grid_blocks = cus * per_cu;
  }
  Params p{};
  const float** pp = (const float**)&p;
  for (int i = 0; i < 29; ++i) pp[i] = (const float*)d_in[i];
  p.out = (float*)d_out;
  p.ws = (char*)d_ws;
#if N_LAUNCH_SPLIT
  for (int ph = 0; ph < NPHASE; ++ph) {
    hipLaunchKernelGGL(mega, dim3(grid_blocks), dim3(256), 0, stream, p, ph, ph + 1);
  }
#else
  hipMemsetAsync((char*)d_ws + OFF_MOD, 0, (OFF_BAR - OFF_MOD) + XCD_BAR_WORDS * sizeof(unsigned), stream);
  int lo = 0, hi = NPHASE;
  void* args[] = {&p, &lo, &hi};
  hipError_t e = hipLaunchCooperativeKernel((void*)mega, dim3(grid_blocks), dim3(256), args, 0, stream);
  if (e != hipSuccess) fprintf(stderr, "cooperative launch failed: %s (grid %d)\n", hipGetErrorString(e), grid_blocks);
#endif
}
```

```cpp
#include <hip/hip_runtime.h>
#include <hip/hip_cooperative_groups.h>
#include <cstdio>
namespace cg = cooperative_groups;

#define DI __device__ __forceinline__
typedef unsigned short bf16_t;
using bf16x8 = __attribute__((ext_vector_type(8))) short;
using f32x4 = __attribute__((ext_vector_type(4))) float;
using u32x4 = __attribute__((ext_vector_type(4))) unsigned;
using u32x2 = __attribute__((ext_vector_type(2))) unsigned;

#ifndef N_LAUNCH_SPLIT
#define N_LAUNCH_SPLIT 0
#endif

constexpr int NTOK = 20480, NPT = 4096, DM = 1024;
constexpr int NPHASE = 14;
constexpr size_t MiB = 1u << 20;
constexpr size_t OFF_WINT = 0, OFF_WUQT = 9 * MiB, OFF_WUKVT = 9 * MiB + 512 * 1024, OFF_WUPAT = 10 * MiB,
                 OFF_WUPBT = 11 * MiB, OFF_WOT = 12 * MiB, OFF_WCT = 14 * MiB, OFF_WPQB = 18 * MiB,
                 OFF_KEYSB = 22 * MiB, OFF_MOD = 22 * MiB + 512 * 1024, OFF_BAR = 22 * MiB + 768 * 1024, A0 = 24 * MiB;
constexpr size_t OFF_H1 = A0 + 0, OFF_CQ = A0 + 40 * MiB, OFF_CKVRAW = A0 + 50 * MiB, OFF_KRRAW = A0 + 60 * MiB,
                 OFF_RQ = A0 + 63 * MiB, OFF_RK = A0 + 83 * MiB, OFF_KT = A0 + 103 * MiB, OFF_VT = A0 + 123 * MiB,
                 OFF_SRG = A0 + 143 * MiB, OFF_CKVALL = A0 + 163 * MiB, OFF_KRALL = A0 + 169 * MiB,
                 OFF_UF = A0 + 171 * MiB, OFF_UB = A0 + 187 * MiB,
                 OFF_SF = A0 + 0, OFF_SB = A0 + 8 * MiB, OFF_RET = A0 + 16 * MiB,
                 OFF_Q = A0 + 63 * MiB, OFF_KN = A0 + 93 * MiB, OFF_VTA = A0 + 117 * MiB, OFF_ATTN = A0 + 141 * MiB,
                 OFF_M = A0 + 163 * MiB,
                 OFF_H2 = A0 + 0, OFF_TABU = A0 + 40 * MiB, OFF_TABV = A0 + 56 * MiB, OFF_INVU = A0 + 72 * MiB,
                 OFF_INVV = A0 + 73 * MiB, OFF_ELIST = A0 + 74 * MiB, OFF_GLIST = A0 + 84 * MiB, OFF_SCORES = A0 + 104 * MiB;
constexpr size_t OUT_CKV = 20971520, OUT_KR = 21495808, OUT_SF = 21626880, OUT_SB = 22675456;
constexpr int NKV = 24576;
constexpr int SMEM_BYTES = 36864;

struct Params {
  const float *x_prompt, *x_sample, *c, *cache_ckv, *cache_krope, *st_f, *st_b, *c_ctx, *w_mod, *b_mod, *norm_mix,
      *norm_ffn, *norm_final, *w_in, *q_norm, *kv_norm, *w_uq, *w_ukv, *lg_f, *lg_b, *ret_gn, *w_up_a, *w_up_b, *w_o,
      *peer_wq, *keys1, *keys2, *peer_u, *peer_v;
  float* out;
  char* ws;
};

DI unsigned f2bf(float x) {
  unsigned u = __float_as_uint(x);
  u += 0x7fffu + ((u >> 16) & 1u);
  return u >> 16;
}
DI float bf2f(unsigned b) { return __uint_as_float(b << 16); }
typedef __bf16 hbf16x2_t __attribute__((ext_vector_type(2)));
typedef float hf32x2_t __attribute__((ext_vector_type(2)));
DI unsigned pack2(float a, float b) {
  hf32x2_t f = {a, b};
  return __builtin_bit_cast(unsigned, __builtin_convertvector(f, hbf16x2_t));
}
DI float ex2(float x) { return __builtin_amdgcn_exp2f(x); }
DI float bflo(unsigned u) { return __uint_as_float(u << 16); }
DI float bfhi(unsigned u) { return __uint_as_float(u & 0xffff0000u); }
DI float wsum(float v) {
#pragma unroll
  for (int o = 32; o > 0; o >>= 1) v += __shfl_xor(v, o);
  return v;
}
DI float sigmoidf_(float x) { return 1.f / (1.f + __expf(-x)); }
DI float siluf_(float x) { return x / (1.f + __expf(-x)); }
DI float geluf_(float x) { return 0.5f * x * (1.f + tanhf(0.7978845608028654f * (x + 0.044715f * x * x * x))); }
DI const float* xrow(const Params& p, int tok) {
  return tok < NPT ? p.x_prompt + (size_t)tok * DM : p.x_sample + (size_t)(tok - NPT) * DM;
}
DI int modidx(int tok) { return tok < NPT ? 0 : 1 + ((tok - NPT) >> 11); }
DI int kvrow(int tok) {
  if (tok < NPT) return tok;
  int t = tok - NPT;
  return NPT + (t >> 11) * 2560 + (t & 2047);
}
DI void st_bf16x16(bf16_t* dst, const float (&v)[16]) {
  u32x4 a, b;
  a[0] = pack2(v[0], v[1]); a[1] = pack2(v[2], v[3]); a[2] = pack2(v[4], v[5]); a[3] = pack2(v[6], v[7]);
  b[0] = pack2(v[8], v[9]); b[1] = pack2(v[10], v[11]); b[2] = pack2(v[12], v[13]); b[3] = pack2(v[14], v[15]);
  *(u32x4*)dst = a;
  *(u32x4*)(dst + 8) = b;
}
DI void st_f32x16(float* dst, const float (&v)[16]) {
#pragma unroll
  for (int i = 0; i < 4; ++i) *(float4*)(dst + 4 * i) = make_float4(v[4 * i], v[4 * i + 1], v[4 * i + 2], v[4 * i + 3]);
}
DI void ld_bf16x16(const bf16_t* src, float (&v)[16]) {
  u32x4 a = *(const u32x4*)src, b = *(const u32x4*)(src + 8);
#pragma unroll
  for (int i = 0; i < 4; ++i) {
    v[2 * i] = bflo(a[i]); v[2 * i + 1] = bfhi(a[i]);
    v[8 + 2 * i] = bflo(b[i]); v[8 + 2 * i + 1] = bfhi(b[i]);
  }
}

constexpr int LDK = 72;
template <int SCALE>
DI void gemm_kloop(f32x4 (&acc)[4][4], const bf16_t* __restrict__ A, int lda, const bf16_t* __restrict__ B, int ldb,
                   int K, char* smem, float sc_a, float sc_b) {
  bf16_t* As = (bf16_t*)smem;
  bf16_t* Bs = As + 128 * LDK;
  const int tid = threadIdx.x, lane = tid & 63, w = tid >> 6, wm = w >> 1, wn = w & 1, l15 = lane & 15, g = lane >> 4;
  u32x4 ra[4], rb[4];
  int arow[4], kc[4], ldsa[4], ldsb[4];
#pragma unroll
  for (int i = 0; i < 4; ++i) {
    int c = tid + 256 * i;
    int r = c >> 3;
    kc[i] = (c & 7) * 8;
    arow[i] = r;
    int rr = r & 63;
    int rho = (r & 64) | (((rr >> 2) & 3) << 4) | ((rr >> 4) << 2) | (rr & 3);
    ldsa[i] = rho * LDK + kc[i];
    ldsb[i] = r * LDK + kc[i];
  }
#pragma unroll
  for (int i = 0; i < 4; ++i) {
    ra[i] = *(const u32x4*)(A + (size_t)arow[i] * lda + kc[i]);
    rb[i] = *(const u32x4*)(B + (size_t)arow[i] * ldb + kc[i]);
  }
  for (int k0 = 0; k0 < K; k0 += 64) {
    __syncthreads();
#pragma unroll
    for (int i = 0; i < 4; ++i) {
      *(u32x4*)(As + ldsa[i]) = ra[i];
      *(u32x4*)(Bs + ldsb[i]) = rb[i];
    }
    __syncthreads();
    if (k0 + 64 < K) {
#pragma unroll
      for (int i = 0; i < 4; ++i) {
        ra[i] = *(const u32x4*)(A + (size_t)arow[i] * lda + k0 + 64 + kc[i]);
        rb[i] = *(const u32x4*)(B + (size_t)arow[i] * ldb + k0 + 64 + kc[i]);
      }
    }
#pragma unroll
    for (int ks = 0; ks < 2; ++ks) {
      bf16x8 af[4], bfr[4];
#pragma unroll
      for (int f = 0; f < 4; ++f)
        af[f] = *(const bf16x8*)(As + (wm * 64 + f * 16 + l15) * LDK + ks * 32 + g * 8);
#pragma unroll
      for (int c = 0; c < 4; ++c)
        bfr[c] = *(const bf16x8*)(Bs + (wn * 64 + c * 16 + l15) * LDK + ks * 32 + g * 8);
      if (SCALE) {
        float fac[8];
#pragma unroll
        for (int i = 0; i < 8; ++i) fac[i] = ex2(sc_a + sc_b * (float)(k0 + ks * 32 + g * 8 + i));
#pragma unroll
        for (int f = 0; f < 4; ++f) {
          u32x4 u = __builtin_bit_cast(u32x4, af[f]);
#pragma unroll
          for (int i = 0; i < 4; ++i) u[i] = pack2(bflo(u[i]) * fac[2 * i], bfhi(u[i]) * fac[2 * i + 1]);
          af[f] = __builtin_bit_cast(bf16x8, u);
        }
      }
#pragma unroll
      for (int f = 0; f < 4; ++f)
#pragma unroll
        for (int c = 0; c < 4; ++c) acc[f][c] = __builtin_amdgcn_mfma_f32_16x16x32_bf16(af[f], bfr[c], acc[f][c], 0, 0, 0);
    }
  }
}
DI void acc_zero(f32x4 (&acc)[4][4]) {
#pragma unroll
  for (int f = 0; f < 4; ++f)
#pragma unroll
    for (int c = 0; c < 4; ++c) acc[f][c] = f32x4{0.f, 0.f, 0.f, 0.f};
}
template <class F>
DI void epilogue(const f32x4 (&acc)[4][4], F&& epi) {
  const int tid = threadIdx.x, lane = tid & 63, w = tid >> 6, wm = w >> 1, wn = w & 1, l15 = lane & 15, g = lane >> 4;
#pragma unroll
  for (int c = 0; c < 4; ++c) {
    float v[16];
#pragma unroll
    for (int f = 0; f < 4; ++f)
#pragma unroll
      for (int j = 0; j < 4; ++j) v[f * 4 + j] = acc[f][c][j];
    epi(wm * 64 + 16 * g, wn * 64 + c * 16 + l15, v);
  }
}
DI bool tile_map(int it, int Ft, int Tt, int fsplit, int& ft, int& tt) {
  const int bid = blockIdx.x, nb = gridDim.x;
  int xcd = bid & 7, loc = bid >> 3, nloc = nb >> 3;
  if (loc >= nloc) return false;
  int fg = xcd % fsplit, tg = xcd / fsplit, tsplit = 8 / fsplit;
  int Fg = Ft / fsplit, Tg = Tt / tsplit;
  int i = loc + it * nloc;
  if (i >= Fg * Tg) return false;
  ft = fg * Fg + i % Fg;
  tt = tg * Tg + i / Fg;
  return true;
}
DI int vbid() {
  const int bid = blockIdx.x, nb = gridDim.x;
  if (nb & 7) return bid;
  return (bid & 7) * (nb >> 3) + (bid >> 3);
}

DI int colmap(int mode, int np) {
  if (mode == 1) return np < 416 ? np : (np < 512 ? -1 : np - 96);
  if (mode == 2) return np < 512 ? ((np >> 6) * 128 + (np & 63)) : (((np - 512) >> 6) * 128 + 64 + ((np - 512) & 63));
  return np;
}
DI void tconv_tile(const float* __restrict__ src, int ldsrc, bf16_t* __restrict__ dst, int K, int kt, int nt, int mode,
                   char* smem) {
  float* lds = (float*)smem;
  const int tid = threadIdx.x;
  {
    int col = tid & 63, rq = tid >> 6;
    int n = colmap(mode, nt * 64 + col);
#pragma unroll 4
    for (int r = 0; r < 16; ++r) {
      int kl = r * 4 + rq;
      float v = n >= 0 ? src[(size_t)(kt * 64 + kl) * ldsrc + n] : 0.f;
      lds[kl * 65 + col] = v;
    }
  }
  __syncthreads();
  {
    int nl = tid >> 2, kq = (tid & 3) * 16;
    float v[16];
#pragma unroll
    for (int i = 0; i < 16; ++i) v[i] = lds[(kq + i) * 65 + nl];
    st_bf16x16(dst + (size_t)(nt * 64 + nl) * K + kt * 64 + kq, v);
  }
  __syncthreads();
}
DI void mod_item(const Params& p, int item, char* smem) {
  float* sil = (float*)smem;
  const int tid = threadIdx.x;
  const int cg_ = item >> 2, slab = item & 3, kbase = slab * 256;
  for (int i = tid; i < 9 * 256; i += 256) {
    int j = i >> 8, k = kbase + (i & 255);
    float cv = j == 0 ? p.c_ctx[k] : p.c[(j - 1) * 1024 + k];
    sil[i] = siluf_(cv);
  }
  __syncthreads();
  const int kq = tid >> 6, nn = tid & 63, n0 = cg_ * 64;
  float acc[9];
#pragma unroll
  for (int j = 0; j < 9; ++j) acc[j] = 0.f;
#pragma unroll 1
  for (int i0 = 0; i0 < 64; i0 += 16) {
    float wv[16];
#pragma unroll
    for (int i = 0; i < 16; ++i) wv[i] = p.w_mod[(size_t)(kbase + kq + 4 * (i0 + i)) * 6144 + n0 + nn];
#pragma unroll
    for (int i = 0; i < 16; ++i)
#pragma unroll
      for (int j = 0; j < 9; ++j) acc[j] += sil[j * 256 + kq + 4 * (i0 + i)] * wv[i];
  }
  __syncthreads();
  float* part = (float*)smem + 9 * 256;
#pragma unroll
  for (int j = 0; j < 9; ++j) part[(kq * 9 + j) * 64 + nn] = acc[j];
  __syncthreads();
  float* mod = (float*)(p.ws + OFF_MOD);
  for (int i = tid; i < 9 * 64; i += 256) {
    int j = i >> 6, n = i & 63;
    float s = part[(0 * 9 + j) * 64 + n] + part[(1 * 9 + j) * 64 + n] + part[(2 * 9 + j) * 64 + n] + part[(3 * 9 + j) * 64 + n];
    if (slab == 0) s += p.b_mod[n0 + n];
    atomicAdd(mod + j * 6144 + n0 + n, s);
  }
  __syncthreads();
}
DI void conv_flat(const float* __restrict__ src, bf16_t* __restrict__ dst, size_t n) {
  size_t i = ((size_t)blockIdx.x * 256 + threadIdx.x) * 8;
  const size_t stride = (size_t)gridDim.x * 256 * 8;
  for (; i < n; i += stride) {
    float4 a = *(const float4*)(src + i), b = *(const float4*)(src + i + 4);
    u32x4 o;
    o[0] = pack2(a.x, a.y); o[1] = pack2(a.z, a.w); o[2] = pack2(b.x, b.y); o[3] = pack2(b.z, b.w);
    *(u32x4*)(dst + i) = o;
  }
}
DI void phase0(const Params& p, char* smem) {
  const int bid = blockIdx.x, nb = gridDim.x;
  char* ws = p.ws;
  const int n_mod = 384;
  const int t_in = 16 * 72, t_uq = 4 * 12, t_ukv = 2 * 16, t_upa = 8 * 16, t_upb = 8 * 16, t_o = 16 * 16;
  const int total = n_mod + t_in + t_uq + t_ukv + t_upa + t_upb + t_o;
  for (int it = bid; it < total; it += nb) {
    int i = it;
    if (i < n_mod) { mod_item(p, i, smem); continue; }
    i -= n_mod;
    if (i < t_in) { tconv_tile(p.w_in, 4512, (bf16_t*)(ws + OFF_WINT), 1024, i / 72, i % 72, 1, smem); continue; }
    i -= t_in;
    if (i < t_uq) { tconv_tile(p.w_uq, 768, (bf16_t*)(ws + OFF_WUQT), 256, i / 12, i % 12, 0, smem); continue; }
    i -= t_uq;
    if (i < t_ukv) { tconv_tile(p.w_ukv, 1024, (bf16_t*)(ws + OFF_WUKVT), 128, i / 16, i % 16, 2, smem); continue; }
    i -= t_ukv;
    if (i < t_upa) { tconv_tile(p.w_up_a, 1024, (bf16_t*)(ws + OFF_WUPAT), 512, i / 16, i % 16, 0, smem); continue; }
    i -= t_upa;
    if (i < t_upb) { tconv_tile(p.w_up_b, 1024, (bf16_t*)(ws + OFF_WUPBT), 512, i / 16, i % 16, 0, smem); continue; }
    i -= t_upb;
    tconv_tile(p.w_o, 1024, (bf16_t*)(ws + OFF_WOT), 1024, i / 16, i % 16, 0, smem);
  }
  conv_flat(p.peer_wq, (bf16_t*)(ws + OFF_WPQB), (size_t)1024 * 2048);
  {
    size_t i = ((size_t)bid * 256 + threadIdx.x) * 8;
    const size_t stride = (size_t)nb * 256 * 8;
    bf16_t* kb = (bf16_t*)(ws + OFF_KEYSB);
    for (; i < (size_t)2 * 131072; i += stride) {
      int half = i >= 131072;
      size_t s = i - (size_t)half * 131072;
      int h = (int)(s >> 14);
      size_t r = s & 16383;
      const float* src = (half ? p.keys2 : p.keys1) + s;
      float4 a = *(const float4*)(src), b = *(const float4*)(src + 4);
      u32x4 o;
      o[0] = pack2(a.x, a.y); o[1] = pack2(a.z, a.w); o[2] = pack2(b.x, b.y); o[3] = pack2(b.z, b.w);
      *(u32x4*)(kb + ((size_t)(h * 2 + half) << 14) + r) = o;
    }
  }
}

DI void rows_norm_mod(const Params& p, const float* nw, int sh_off, int sc_off, bool from_out, bf16_t* dst) {
  const int lane = threadIdx.x & 63, w = threadIdx.x >> 6;
  const float* mod = (const float*)(p.ws + OFF_MOD);
  for (int tok = blockIdx.x * 4 + w; tok < NTOK; tok += gridDim.x * 4) {
    const float* xr = from_out ? p.out + (size_t)tok * DM : xrow(p, tok);
    const float* mj = mod + modidx(tok) * 6144;
    float4 xv[4];
    float ss = 0.f;
#pragma unroll
    for (int i = 0; i < 4; ++i) {
      xv[i] = *(const float4*)(xr + (i * 64 + lane) * 4);
      ss += xv[i].x * xv[i].x + xv[i].y * xv[i].y + xv[i].z * xv[i].z + xv[i].w * xv[i].w;
    }
    ss = wsum(ss);
    float rstd = rsqrtf(ss * (1.f / 1024.f) + 1e-6f);
#pragma unroll
    for (int i = 0; i < 4; ++i) {
      int e = (i * 64 + lane) * 4;
      float4 nv = *(const float4*)(nw + e), sh = *(const float4*)(mj + sh_off + e), sc = *(const float4*)(mj + sc_off + e);
      float h0 = (xv[i].x * rstd) * nv.x * (1.f + sc.x) + sh.x;
      float h1 = (xv[i].y * rstd) * nv.y * (1.f + sc.y) + sh.y;
      float h2 = (xv[i].z * rstd) * nv.z * (1.f + sc.z) + sh.z;
      float h3 = (xv[i].w * rstd) * nv.w * (1.f + sc.w) + sh.w;
      u32x2 o;
      o[0] = pack2(h0, h1); o[1] = pack2(h2, h3);
      *(u32x2*)(dst + (size_t)tok * DM + e) = o;
    }
  }
}
DI void phase1(const Params& p, char* smem) {
  rows_norm_mod(p, p.norm_mix, 0, 1024, false, (bf16_t*)(p.ws + OFF_H1));
  const bf16_t* wpq = (const bf16_t*)(p.ws + OFF_WPQB);
  const bf16_t* kb = (const bf16_t*)(p.ws + OFF_KEYSB);
  bf16_t* wct = (bf16_t*)(p.ws + OFF_WCT);
  for (int it = blockIdx.x; it < 128; it += gridDim.x) {
    int hh = it >> 3, mt = it & 7;
    f32x4 acc[4][4];
    acc_zero(acc);
    gemm_kloop<0>(acc, wpq + (size_t)(mt * 128) * 2048 + hh * 128, 2048, kb + (size_t)hh * 16384, 128, 128, smem, 0.f, 0.f);
    epilogue(acc, [&](int m, int n, float (&v)[16]) { st_bf16x16(wct + (size_t)(hh * 128 + n) * 1024 + mt * 128 + m, v); });
  }
}

DI void phase2(const Params& p, char* smem) {
  char* ws = p.ws;
  const bf16_t* winT = (const bf16_t*)(ws + OFF_WINT);
  const bf16_t* h1 = (const bf16_t*)(ws + OFF_H1);
  bf16_t* cq = (bf16_t*)(ws + OFF_CQ);
  float* ckvraw = (float*)(ws + OFF_CKVRAW);
  float* krraw = (float*)(ws + OFF_KRRAW);
  bf16_t* rq = (bf16_t*)(ws + OFF_RQ);
  bf16_t* rk = (bf16_t*)(ws + OFF_RK);
  bf16_t* kT = (bf16_t*)(ws + OFF_KT);
  bf16_t* vT = (bf16_t*)(ws + OFF_VT);
  bf16_t* srg = (bf16_t*)(ws + OFF_SRG);
  bf16_t* sga = (bf16_t*)p.out;
  bf16_t* sgb = sga + (size_t)NTOK * 1024;
  for (int it = 0;; ++it) {
    int ft, tt;
    if (!tile_map(it, 36, 160, 4, ft, tt)) break;
    f32x4 acc[4][4];
    acc_zero(acc);
    const bf16_t* W = winT + (size_t)ft * 128 * 1024;
    const bf16_t* H = h1 + (size_t)tt * 128 * 1024;
    const int tok0 = tt * 128, f0 = ft * 128;
    if (ft >= 8 && ft < 16) {
      gemm_kloop<0>(acc, H, 1024, W, 1024, 1024, smem, 0.f, 0.f);
      if (ft < 12) {
        epilogue(acc, [&](int m, int n, float (&v)[16]) {
          int feat = f0 - 1024 + n, tok = tok0 + m;
#pragma unroll
          for (int i = 0; i < 16; ++i) v[i] *= 0.08838834764831845f;
          st_bf16x16(kT + (size_t)feat * NTOK + tok, v);
#pragma unroll
          for (int i = 0; i < 16; ++i) rk[(size_t)(tok + i) * 512 + feat] = (bf16_t)f2bf(v[i]);
        });
      } else {
        epilogue(acc, [&](int m, int n, float (&v)[16]) {
          int feat = f0 - 1536 + n, tok = tok0 + m;
          st_bf16x16(vT + (size_t)feat * NTOK + tok, v);
        });
      }
    } else {
      gemm_kloop<0>(acc, W, 1024, H, 1024, 1024, smem, 0.f, 0.f);
      if (ft < 2) {
        epilogue(acc, [&](int m, int n, float (&v)[16]) { st_bf16x16(cq + (size_t)(tok0 + n) * 256 + f0 + m, v); });
      } else if (ft == 2) {
        epilogue(acc, [&](int m, int n, float (&v)[16]) { st_f32x16(ckvraw + (size_t)(tok0 + n) * 128 + m, v); });
      } else if (ft == 3) {
        epilogue(acc, [&](int m, int n, float (&v)[16]) {
          if (m < 32) st_f32x16(krraw + (size_t)(tok0 + n) * 32 + m, v);
        });
      } else if (ft < 8) {
        epilogue(acc, [&](int m, int n, float (&v)[16]) { st_bf16x16(rq + (size_t)(tok0 + n) * 512 + f0 - 512 + m, v); });
      } else if (ft < 20) {
        epilogue(acc, [&](int m, int n, float (&v)[16]) {
#pragma unroll
          for (int i = 0; i < 16; ++i) v[i] = siluf_(v[i]);
          st_bf16x16(srg + (size_t)(tok0 + n) * 512 + f0 - 2048 + m, v);
        });
      } else if (ft < 28) {
        epilogue(acc, [&](int m, int n, float (&v)[16]) {
#pragma unroll
          for (int i = 0; i < 16; ++i) v[i] = sigmoidf_(v[i]);
          st_bf16x16(sga + (size_t)(tok0 + n) * 1024 + f0 - 2560 + m, v);
        });
      } else {
        epilogue(acc, [&](int m, int n, float (&v)[16]) {
#pragma unroll
          for (int i = 0; i < 16; ++i) v[i] = sigmoidf_(v[i]);
          st_bf16x16(sgb + (size_t)(tok0 + n) * 1024 + f0 - 3584 + m, v);
        });
      }
    }
  }
}

DI float log2gamma(float logit) { return -log1pf(expf(-logit)) * 1.4426950408889634f; }
DI void phase3(const Params& p, char* smem) {
  char* ws = p.ws;
  const int lane = threadIdx.x & 63, w = threadIdx.x >> 6;
  bf16_t* cq = (bf16_t*)(ws + OFF_CQ);
  const float* ckvraw = (const float*)(ws + OFF_CKVRAW);
  const float* krraw = (const float*)(ws + OFF_KRRAW);
  bf16_t* ckvall = (bf16_t*)(ws + OFF_CKVALL);
  bf16_t* krall = (bf16_t*)(ws + OFF_KRALL);
  for (int r = blockIdx.x * 4 + w; r < NTOK + 4096; r += gridDim.x * 4) {
    if (r < NTOK) {
      const int tok = r;
      {
        u32x2 u = *(const u32x2*)(cq + (size_t)tok * 256 + lane * 4);
        float a0 = bflo(u[0]), a1 = bfhi(u[0]), a2 = bflo(u[1]), a3 = bfhi(u[1]);
        float ss = wsum(a0 * a0 + a1 * a1 + a2 * a2 + a3 * a3);
        float rstd = rsqrtf(ss * (1.f / 256.f) + 1e-6f);
        float4 nq = *(const float4*)(p.q_norm + lane * 4);
        u32x2 o;
        o[0] = pack2(a0 * rstd * nq.x, a1 * rstd * nq.y);
        o[1] = pack2(a2 * rstd * nq.z, a3 * rstd * nq.w);
        *(u32x2*)(cq + (size_t)tok * 256 + lane * 4) = o;
      }
      const int row = kvrow(tok);
      {
        float2 v = *(const float2*)(ckvraw + (size_t)tok * 128 + lane * 2);
        float ss = wsum(v.x * v.x + v.y * v.y);
        float rstd = rsqrtf(ss * (1.f / 128.f) + 1e-6f);
        float2 nk = *(const float2*)(p.kv_norm + lane * 2);
        float o0 = v.x * rstd * nk.x, o1 = v.y * rstd * nk.y;
        if (tok < NPT) *(float2*)(p.out + OUT_CKV + (size_t)tok * 128 + lane * 2) = make_float2(o0, o1);
        *(unsigned*)(ckvall + (size_t)row * 128 + lane * 2) = pack2(o0, o1);
      }
      if (lane < 32) {
        float own = krraw[(size_t)tok * 32 + lane];
        float o = own;
        if (tok < NPT) {
          p.out[OUT_KR + (size_t)tok * 32 + lane] = own;
        } else {
          float partner = krraw[(size_t)tok * 32 + (lane ^ 16)];
          int t = (tok - NPT) & 2047;
          int a = lane & 15;
          float pos = (a < 8) ? (float)(t >> 6) : (float)(t & 63);
          float fr = exp2f(-(float)(a & 7) * 1.6609640474436813f);
          float sn, cs;
          sincosf(pos * fr, &sn, &cs);
          o = lane < 16 ? own * cs - partner * sn : partner * sn + own * cs;
        }
        krall[(size_t)row * 32 + lane] = (bf16_t)f2bf(o);
      }
    } else {
      const int cr = r - NTOK;
      const int b = cr >> 9, pos = cr & 511;
      const int row = NPT + b * 2560 + 2048 + pos;
      float2 v = *(const float2*)(p.cache_ckv + (size_t)cr * 128 + lane * 2);
      *(unsigned*)(ckvall + (size_t)row * 128 + lane * 2) = pack2(v.x, v.y);
      if (lane < 32) krall[(size_t)row * 32 + lane] = (bf16_t)f2bf(p.cache_krope[(size_t)cr * 32 + lane]);
    }
  }
  const bf16_t* kT = (const bf16_t*)(ws + OFF_KT);
  const bf16_t* vT = (const bf16_t*)(ws + OFF_VT);
  float* Uf = (float*)(ws + OFF_UF);
  float* Ub = (float*)(ws + OFF_UB);
  for (int it = blockIdx.x; it < 320; it += gridDim.x) {
    const int blk = it >> 2, h = it & 3;
    const float l2f = log2gamma(p.lg_f[h]), l2b = log2gamma(p.lg_b[h]);
    const bf16_t* Kp = kT + (size_t)(h * 128) * NTOK + blk * 256;
    const bf16_t* Vp = vT + (size_t)(h * 128) * NTOK + blk * 256;
#pragma unroll 1
    for (int dir = 0; dir < 2; ++dir) {
      const float sa = dir ? 0.f : l2f * 255.f, sb = dir ? l2b : -l2f;
      f32x4 acc[4][4];
      acc_zero(acc);
      if (blk < 16) {
        gemm_kloop<1>(acc, Vp, NTOK, Kp, NTOK, 256, smem, sa, sb);
        float* dst = p.out + (dir ? OUT_SB : OUT_SF) + (size_t)(blk * 4 + h) * 16384;
        epilogue(acc, [&](int m, int n, float (&v)[16]) { st_f32x16(dst + n * 128 + m, v); });
      } else {
        gemm_kloop<1>(acc, Kp, NTOK, Vp, NTOK, 256, smem, sa, sb);
        float* dst = (dir ? Ub : Uf) + (size_t)((blk - 16) * 4 + h) * 16384;
        epilogue(acc, [&](int m, int n, float (&v)[16]) { st_f32x16(dst + n * 128 + m, v); });
      }
    }
  }
}

DI void phase4(const Params& p) {
  char* ws = p.ws;
  const float* Uf = (const float*)(ws + OFF_UF);
  const float* Ub = (const float*)(ws + OFF_UB);
  bf16_t* Sf = (bf16_t*)(ws + OFF_SF);
  bf16_t* Sb = (bf16_t*)(ws + OFF_SB);
  for (int idx = blockIdx.x * 256 + threadIdx.x; idx < (1 << 20); idx += gridDim.x * 256) {
    int d = idx & 127, e = (idx >> 7) & 127, h = (idx >> 14) & 3, b = (idx >> 16) & 7, dir = idx >> 19;
    size_t eo = (size_t)e * 128 + d;
    if (dir == 0) {
      float cf = exp2f(log2gamma(p.lg_f[h]) * 256.f);
      float S = p.st_f[(size_t)(b * 4 + h) * 16384 + d * 128 + e];
#pragma unroll
      for (int blk = 0; blk < 8; ++blk) {
        size_t o = (size_t)((b * 8 + blk) * 4 + h) * 16384 + eo;
        Sf[o] = (bf16_t)f2bf(S);
        S = cf * S + Uf[o];
      }
    } else {
      float cb = exp2f(log2gamma(p.lg_b[h]) * 256.f);
      float S = p.st_b[(size_t)(b * 4 + h) * 16384 + d * 128 + e];
#pragma unroll
      for (int blk = 7; blk >= 0; --blk) {
        size_t o = (size_t)((b * 8 + blk) * 4 + h) * 16384 + eo;
        Sb[o] = (bf16_t)f2bf(S);
        S = cb * S + Ub[o];
      }
    }
  }
}

DI bf16x8 scale_frag(bf16x8 q, float s) {
  u32x4 u = __builtin_bit_cast(u32x4, q);
#pragma unroll
  for (int i = 0; i < 4; ++i) u[i] = pack2(bflo(u[i]) * s, bfhi(u[i]) * s);
  return __builtin_bit_cast(bf16x8, u);
}
constexpr int NQT = 1;
DI void phase5(const Params& p, char* smem) {
  char* ws = p.ws;
  const bf16_t* rq = (const bf16_t*)(ws + OFF_RQ);
  const bf16_t* rk = (const bf16_t*)(ws + OFF_RK);
  const bf16_t* vT = (const bf16_t*)(ws + OFF_VT);
  const bf16_t* srg = (const bf16_t*)(ws + OFF_SRG);
  const bf16_t* Sf = (const bf16_t*)(ws + OFF_SF);
  const bf16_t* Sb = (const bf16_t*)(ws + OFF_SB);
  bf16_t* ret = (bf16_t*)(ws + OFF_RET);
  bf16_t* Ks = (bf16_t*)smem;
  bf16_t* Vs = Ks + 64 * 136;
  const int tid = threadIdx.x, lane = tid & 63, w = tid >> 6, l15 = lane & 15, g = lane >> 4;
  for (int item = vbid(); item < 640 * (2 / NQT); item += gridDim.x) {
    const int qb = item >> 2, h = item & 3, blk = (qb * NQT) >> 2;
    const float l2f = log2gamma(p.lg_f[h]), l2b = log2gamma(p.lg_b[h]);
    const int tokw = qb * (64 * NQT) + w * (16 * NQT);
    bf16x8 Q[NQT][4];
#pragma unroll
    for (int qt = 0; qt < NQT; ++qt)
#pragma unroll
      for (int ks = 0; ks < 4; ++ks)
        Q[qt][ks] = *(const bf16x8*)(rq + (size_t)(tokw + qt * 16 + l15) * 512 + h * 128 + ks * 32 + g * 8);
    f32x4 o[8][NQT];
#pragma unroll
    for (int et = 0; et < 8; ++et)
#pragma unroll
      for (int qt = 0; qt < NQT; ++qt) o[et][qt] = f32x4{0.f, 0.f, 0.f, 0.f};
#pragma unroll 1
    for (int kt = 0; kt < 4; ++kt) {
      const int key0 = blk * 256 + kt * 64;
      __syncthreads();
#pragma unroll
      for (int i = 0; i < 4; ++i) {
        int c = tid + 256 * i;
        int r = c >> 4, cc = (c & 15) * 8;
        *(u32x4*)(Ks + r * 136 + cc) = *(const u32x4*)(rk + (size_t)(key0 + r) * 512 + h * 128 + cc);
        int e = c >> 3, c2 = (c & 7) * 8;
        *(u32x4*)(Vs + e * 72 + c2) = *(const u32x4*)(vT + (size_t)(h * 128 + e) * NTOK + key0 + c2);
      }
      __syncthreads();
      bf16x8 P[NQT][2];
#pragma unroll
      for (int qt = 0; qt < NQT; ++qt) {
        f32x4 s[4];
#pragma unroll
        for (int kk = 0; kk < 4; ++kk) s[kk] = f32x4{0.f, 0.f, 0.f, 0.f};
#pragma unroll
        for (int ks = 0; ks < 4; ++ks) {
#pragma unroll
          for (int kk = 0; kk < 4; ++kk) {
            bf16x8 a = *(const bf16x8*)(Ks + (kk * 16 + l15) * 136 + ks * 32 + g * 8);
            s[kk] = __builtin_amdgcn_mfma_f32_16x16x32_bf16(a, Q[qt][ks], s[kk], 0, 0, 0);
          }
        }
        const int iq = (tokw + qt * 16 + l15) & 255;
#pragma unroll
        for (int kk = 0; kk < 4; ++kk) {
#pragma unroll
          for (int j = 0; j < 4; ++j) {
            int jk = kt * 64 + kk * 16 + 4 * g + j;
            int diff = iq - jk;
            float dm = diff > 0 ? ex2(l2f * (float)diff) : (diff < 0 ? ex2(l2b * (float)(-diff)) : 2.f);
            s[kk][j] *= dm;
          }
        }
#pragma unroll
        for (int k2 = 0; k2 < 2; ++k2) {
          u32x4 u;
          u[0] = pack2(s[2 * k2][0], s[2 * k2][1]);
          u[1] = pack2(s[2 * k2][2], s[2 * k2][3]);
          u[2] = pack2(s[2 * k2 + 1][0], s[2 * k2 + 1][1]);
          u[3] = pack2(s[2 * k2 + 1][2], s[2 * k2 + 1][3]);
          P[qt][k2] = __builtin_bit_cast(bf16x8, u);
        }
      }
#pragma unroll
      for (int k2 = 0; k2 < 2; ++k2) {
#pragma unroll
        for (int et = 0; et < 8; ++et) {
          u32x2 lo = *(const u32x2*)(Vs + (et * 16 + l15) * 72 + k2 * 32 + 4 * g);
          u32x2 hi = *(const u32x2*)(Vs + (et * 16 + l15) * 72 + k2 * 32 + 16 + 4 * g);
          u32x4 u;
          u[0] = lo[0]; u[1] = lo[1]; u[2] = hi[0]; u[3] = hi[1];
          bf16x8 a = __builtin_bit_cast(bf16x8, u);
#pragma unroll
          for (int qt = 0; qt < NQT; ++qt) o[et][qt] = __builtin_amdgcn_mfma_f32_16x16x32_bf16(a, P[qt][k2], o[et][qt], 0, 0, 0);
        }
      }
    }
    if (blk >= 16) {
#pragma unroll 1
      for (int dir = 0; dir < 2; ++dir) {
        const bf16_t* S = (dir ? Sb : Sf) + (size_t)((blk - 16) * 4 + h) * 16384;
        float dq[NQT];
#pragma unroll
        for (int qt = 0; qt < NQT; ++qt) {
          int iq = (tokw + qt * 16 + l15) & 255;
          dq[qt] = dir ? exp2f(l2b * (float)(256 - iq)) : exp2f(l2f * (float)(iq + 1));
        }
#pragma unroll
        for (int ks = 0; ks < 4; ++ks) {
          bf16x8 qs[NQT];
#pragma unroll
          for (int qt = 0; qt < NQT; ++qt) qs[qt] = scale_frag(Q[qt][ks], dq[qt]);
#pragma unroll
          for (int et = 0; et < 8; ++et) {
            bf16x8 a = *(const bf16x8*)(S + (size_t)(et * 16 + l15) * 128 + ks * 32 + g * 8);
#pragma unroll
            for (int qt = 0; qt < NQT; ++qt) o[et][qt] = __builtin_amdgcn_mfma_f32_16x16x32_bf16(a, qs[qt], o[et][qt], 0, 0, 0);
          }
        }
      }
    }
#pragma unroll
    for (int qt = 0; qt < NQT; ++qt) {
      const int tok = tokw + qt * 16 + l15;
      float s1 = 0.f;
#pragma unroll
      for (int et = 0; et < 8; ++et)
#pragma unroll
        for (int j = 0; j < 4; ++j) s1 += o[et][qt][j];
      s1 += __shfl_xor(s1, 16);
      s1 += __shfl_xor(s1, 32);
      const float mu = s1 * (1.f / 128.f);
      float s2 = 0.f;
#pragma unroll
      for (int et = 0; et < 8; ++et)
#pragma unroll
        for (int j = 0; j < 4; ++j) {
          float dlt = o[et][qt][j] - mu;
          s2 += dlt * dlt;
        }
      s2 += __shfl_xor(s2, 16);
      s2 += __shfl_xor(s2, 32);
      const float rstd = rsqrtf(s2 * (1.f / 128.f) + 1e-6f);
#pragma unroll
      for (int et = 0; et < 8; ++et) {
        const int e = h * 128 + et * 16 + 4 * g;
        float4 gn = *(const float4*)(p.ret_gn + e);
        u32x2 sg = *(const u32x2*)(srg + (size_t)tok * 512 + e);
        u32x2 ov;
        ov[0] = pack2((o[et][qt][0] - mu) * rstd * gn.x * bflo(sg[0]), (o[et][qt][1] - mu) * rstd * gn.y * bfhi(sg[0]));
        ov[1] = pack2((o[et][qt][2] - mu) * rstd * gn.z * bflo(sg[1]), (o[et][qt][3] - mu) * rstd * gn.w * bfhi(sg[1]));
        *(u32x2*)(ret + (size_t)tok * 512 + e) = ov;
      }
    }
  }
}

DI void phase6(const Params& p, char* smem) {
  char* ws = p.ws;
  const bf16_t* cqn = (const bf16_t*)(ws + OFF_CQ);
  const bf16_t* wuqT = (const bf16_t*)(ws + OFF_WUQT);
  bf16_t* q = (bf16_t*)(ws + OFF_Q);
  for (int it = 0;; ++it) {
    int ft, tt;
    if (!tile_map(it, 6, 160, 1, ft, tt)) break;
    f32x4 acc[4][4];
    acc_zero(acc);
    gemm_kloop<0>(acc, wuqT + (size_t)ft * 128 * 256, 256, cqn + (size_t)tt * 128 * 256, 256, 256, smem, 0.f, 0.f);
    epilogue(acc, [&](int m, int n, float (&v)[16]) { st_bf16x16(q + (size_t)(tt * 128 + n) * 768 + ft * 128 + m, v); });
  }
  const bf16_t* ckvall = (const bf16_t*)(ws + OFF_CKVALL);
  const bf16_t* wukvT = (const bf16_t*)(ws + OFF_WUKVT);
  bf16_t* Kn = (bf16_t*)(ws + OFF_KN);
  bf16_t* Vt = (bf16_t*)(ws + OFF_VTA);
  for (int it = 0;; ++it) {
    int ft, tt;
    if (!tile_map(it, 8, 192, 1, ft, tt)) break;
    f32x4 acc[4][4];
    acc_zero(acc);
    const bf16_t* W = wukvT + (size_t)ft * 128 * 128;
    const bf16_t* X = ckvall + (size_t)tt * 128 * 128;
    if (ft < 4) {
      gemm_kloop<0>(acc, W, 128, X, 128, 128, smem, 0.f, 0.f);
      epilogue(acc, [&](int m, int n, float (&v)[16]) { st_bf16x16(Kn + (size_t)(tt * 128 + n) * 512 + ft * 128 + m, v); });
    } else {
      gemm_kloop<0>(acc, X, 128, W, 128, 128, smem, 0.f, 0.f);
      epilogue(acc, [&](int m, int n, float (&v)[16]) { st_bf16x16(Vt + (size_t)((ft - 4) * 128 + n) * NKV + tt * 128 + m, v); });
    }
  }
}

DI void phase7(const Params& p, char* smem) {
  char* ws = p.ws;
  const bf16_t* q = (const bf16_t*)(ws + OFF_Q);
  const bf16_t* Kn = (const bf16_t*)(ws + OFF_KN);
  const bf16_t* Vt = (const bf16_t*)(ws + OFF_VTA);
  const bf16_t* krall = (const bf16_t*)(ws + OFF_KRALL);
  bf16_t* attn = (bf16_t*)(ws + OFF_ATTN);
  bf16_t* Ks = (bf16_t*)smem;
  bf16_t* Vs = Ks + 64 * 104;
  const int tid = threadIdx.x, lane = tid & 63, w = tid >> 6, l15 = lane & 15, g = lane >> 4;
  const float qscale = 0.10206207261596577f * 1.4426950408889634f;
  for (int item = vbid(); item < 1280; item += gridDim.x) {
    int b, h, qtok0, keyrow0, nkt;
    bool sample;
    if (item < 1024) {
      sample = true; b = item >> 7; h = (item >> 4) & 7; int qb = item & 15;
      qtok0 = NPT + b * 2048 + qb * 128; keyrow0 = NPT + b * 2560; nkt = 40;
    } else {
      int it2 = item - 1024;
      sample = false; b = it2 >> 4; h = (it2 >> 1) & 7; int qb = it2 & 1;
      qtok0 = b * 256 + qb * 128; keyrow0 = b * 256; nkt = 4;
    }
    bf16x8 Q[2][3];
#pragma unroll
    for (int qt = 0; qt < 2; ++qt) {
      const int tokq = qtok0 + w * 32 + qt * 16 + l15;
      const bf16_t* qp = q + (size_t)tokq * 768 + h * 96;
#pragma unroll
      for (int ks = 0; ks < 3; ++ks) {
        u32x4 u = *(const u32x4*)(qp + ks * 32 + g * 8);
        float v[8];
#pragma unroll
        for (int i = 0; i < 4; ++i) { v[2 * i] = bflo(u[i]); v[2 * i + 1] = bfhi(u[i]); }
        if (ks == 2 && sample) {
          u32x4 up = *(const u32x4*)(qp + 64 + (g ^ 2) * 8);
          float pv[8];
#pragma unroll
          for (int i = 0; i < 4; ++i) { pv[2 * i] = bflo(up[i]); pv[2 * i + 1] = bfhi(up[i]); }
          int t = (tokq - NPT) & 2047;
          float pos = (g & 1) ? (float)(t & 63) : (float)(t >> 6);
#pragma unroll
          for (int i = 0; i < 8; ++i) {
            float fr = exp2f(-(float)i * 1.6609640474436813f);
            float sn, cs;
            sincosf(pos * fr, &sn, &cs);
            v[i] = g < 2 ? v[i] * cs - pv[i] * sn : pv[i] * sn + v[i] * cs;
          }
        }
        u32x4 o4;
#pragma unroll
        for (int i = 0; i < 4; ++i) o4[i] = pack2(v[2 * i] * qscale, v[2 * i + 1] * qscale);
        Q[qt][ks] = __builtin_bit_cast(bf16x8, o4);
      }
    }
    f32x4 o[4][2];
#pragma unroll
    for (int et = 0; et < 4; ++et)
#pragma unroll
      for (int qt = 0; qt < 2; ++qt) o[et][qt] = f32x4{0.f, 0.f, 0.f, 0.f};
    float mrun[2] = {-1e30f, -1e30f}, lrun[2] = {0.f, 0.f};
    u32x4 rk_[3], rv_[2];
    auto gload = [&](int kt) {
      const int row0 = keyrow0 + kt * 64;
#pragma unroll
      for (int i = 0; i < 3; ++i) {
        int c = tid + 256 * i;
        int r = c / 12, cc = c - r * 12;
        rk_[i] = cc < 8 ? *(const u32x4*)(Kn + (size_t)(row0 + r) * 512 + h * 64 + cc * 8)
                        : *(const u32x4*)(krall + (size_t)(row0 + r) * 32 + (cc - 8) * 8);
      }
#pragma unroll
      for (int i = 0; i < 2; ++i) {
        int c = tid + 256 * i;
        int e = c >> 3, cc = (c & 7) * 8;
        rv_[i] = *(const u32x4*)(Vt + (size_t)(h * 64 + e) * NKV + row0 + cc);
      }
    };
    gload(0);
#pragma unroll 1
    for (int kt = 0; kt < nkt; ++kt) {
      __syncthreads();
#pragma unroll
      for (int i = 0; i < 3; ++i) {
        int c = tid + 256 * i;
        int r = c / 12, cc = c - r * 12;
        *(u32x4*)(Ks + r * 104 + cc * 8) = rk_[i];
      }
#pragma unroll
      for (int i = 0; i < 2; ++i) {
        int c = tid + 256 * i;
        int e = c >> 3, cc = (c & 7) * 8;
        *(u32x4*)(Vs + e * 72 + cc) = rv_[i];
      }
      __syncthreads();
      if (kt + 1 < nkt) gload(kt + 1);
      f32x4 s[4][2];
#pragma unroll
      for (int kk = 0; kk < 4; ++kk)
#pragma unroll
        for (int qt = 0; qt < 2; ++qt) s[kk][qt] = f32x4{0.f, 0.f, 0.f, 0.f};
#pragma unroll
      for (int ks = 0; ks < 3; ++ks) {
#pragma unroll
        for (int kk = 0; kk < 4; ++kk) {
          bf16x8 a = *(const bf16x8*)(Ks + (kk * 16 + l15) * 104 + ks * 32 + g * 8);
#pragma unroll
          for (int qt = 0; qt < 2; ++qt) s[kk][qt] = __builtin_amdgcn_mfma_f32_16x16x32_bf16(a, Q[qt][ks], s[kk][qt], 0, 0, 0);
        }
      }
      bf16x8 P[2][2];
#pragma unroll
      for (int qt = 0; qt < 2; ++qt) {
        float mx = s[0][qt][0];
#pragma unroll
        for (int kk = 0; kk < 4; ++kk)
#pragma unroll
          for (int j = 0; j < 4; ++j) mx = fmaxf(mx, s[kk][qt][j]);
        mx = fmaxf(mx, __shfl_xor(mx, 16));
        mx = fmaxf(mx, __shfl_xor(mx, 32));
        const float mnew = fmaxf(mrun[qt], mx);
        const float alpha = ex2(mrun[qt] - mnew);
        mrun[qt] = mnew;
        float ps = 0.f;
#pragma unroll
        for (int kk = 0; kk < 4; ++kk)
#pragma unroll
          for (int j = 0; j < 4; ++j) {
            float e_ = ex2(s[kk][qt][j] - mnew);
            s[kk][qt][j] = e_;
            ps += e_;
          }
        lrun[qt] = lrun[qt] * alpha + ps;
#pragma unroll
        for (int et = 0; et < 4; ++et)
#pragma unroll
          for (int j = 0; j < 4; ++j) o[et][qt][j] *= alpha;
#pragma unroll
        for (int k2 = 0; k2 < 2; ++k2) {
          u32x4 u;
          u[0] = pack2(s[2 * k2][qt][0], s[2 * k2][qt][1]);
          u[1] = pack2(s[2 * k2][qt][2], s[2 * k2][qt][3]);
          u[2] = pack2(s[2 * k2 + 1][qt][0], s[2 * k2 + 1][qt][1]);
          u[3] = pack2(s[2 * k2 + 1][qt][2], s[2 * k2 + 1][qt][3]);
          P[qt][k2] = __builtin_bit_cast(bf16x8, u);
        }
      }
#pragma unroll
      for (int k2 = 0; k2 < 2; ++k2) {
#pragma unroll
        for (int et = 0; et < 4; ++et) {
          u32x2 lo = *(const u32x2*)(Vs + (et * 16 + l15) * 72 + k2 * 32 + 4 * g);
          u32x2 hi = *(const u32x2*)(Vs + (et * 16 + l15) * 72 + k2 * 32 + 16 + 4 * g);
          u32x4 u;
          u[0] = lo[0]; u[1] = lo[1]; u[2] = hi[0]; u[3] = hi[1];
          bf16x8 a = __builtin_bit_cast(bf16x8, u);
#pragma unroll
          for (int qt = 0; qt < 2; ++qt) o[et][qt] = __builtin_amdgcn_mfma_f32_16x16x32_bf16(a, P[qt][k2], o[et][qt], 0, 0, 0);
        }
      }
    }
#pragma unroll
    for (int qt = 0; qt < 2; ++qt) {
      const int tokq = qtok0 + w * 32 + qt * 16 + l15;
      float lt = lrun[qt];
      lt += __shfl_xor(lt, 16);
      lt += __shfl_xor(lt, 32);
      const float inv = 1.f / lt;
#pragma unroll
      for (int et = 0; et < 4; ++et) {
        u32x2 ov;
        ov[0] = pack2(o[et][qt][0] * inv, o[et][qt][1] * inv);
        ov[1] = pack2(o[et][qt][2] * inv, o[et][qt][3] * inv);
        *(u32x2*)(attn + (size_t)tokq * 512 + h * 64 + et * 16 + 4 * g) = ov;
      }
    }
  }
}

DI void phase8(const Params& p, char* smem) {
  char* ws = p.ws;
  const bf16_t* attn = (const bf16_t*)(ws + OFF_ATTN);
  const bf16_t* ret = (const bf16_t*)(ws + OFF_RET);
  const bf16_t* wa = (const bf16_t*)(ws + OFF_WUPAT);
  const bf16_t* wb = (const bf16_t*)(ws + OFF_WUPBT);
  const bf16_t* sga = (const bf16_t*)p.out;
  const bf16_t* sgb = sga + (size_t)NTOK * 1024;
  bf16_t* mbuf = (bf16_t*)(ws + OFF_M);
  const int tid = threadIdx.x, lane = tid & 63, w = tid >> 6, wm = w >> 1, wn = w & 1, l15 = lane & 15, g = lane >> 4;
  for (int it = 0;; ++it) {
    int ft, tt;
    if (!tile_map(it, 8, 160, 1, ft, tt)) break;
    f32x4 acc[4][4];
    acc_zero(acc);
    gemm_kloop<0>(acc, wa + (size_t)ft * 128 * 512, 512, attn + (size_t)tt * 128 * 512, 512, 512, smem, 0.f, 0.f);
#pragma unroll
    for (int c = 0; c < 4; ++c) {
      const size_t off = (size_t)(tt * 128 + wn * 64 + c * 16 + l15) * 1024 + ft * 128 + wm * 64 + 16 * g;
      float a[16], bq[16];
      ld_bf16x16(sga + off, a);
      ld_bf16x16(sgb + off, bq);
#pragma unroll
      for (int f = 0; f < 4; ++f)
#pragma unroll
        for (int j = 0; j < 4; ++j) acc[f][c][j] *= a[f * 4 + j] / fmaxf(bq[f * 4 + j], 1e-30f);
    }
    gemm_kloop<0>(acc, wb + (size_t)ft * 128 * 512, 512, ret + (size_t)tt * 128 * 512, 512, 512, smem, 0.f, 0.f);
    epilogue(acc, [&](int m, int n, float (&v)[16]) {
      const size_t off = (size_t)(tt * 128 + n) * 1024 + ft * 128 + m;
      float bq[16];
      ld_bf16x16(sgb + off, bq);
#pragma unroll
      for (int i = 0; i < 16; ++i) v[i] *= bq[i];
      st_bf16x16(mbuf + off, v);
    });
  }
}
DI void phase9(const Params& p, char* smem) {
  char* ws = p.ws;
  const bf16_t* mbuf = (const bf16_t*)(ws + OFF_M);
  const bf16_t* wo = (const bf16_t*)(ws + OFF_WOT);
  const float* mod = (const float*)(ws + OFF_MOD);
  for (int it = 0;; ++it) {
    int ft, tt;
    if (!tile_map(it, 8, 160, 1, ft, tt)) break;
    f32x4 acc[4][4];
    acc_zero(acc);
    gemm_kloop<0>(acc, wo + (size_t)ft * 128 * 1024, 1024, mbuf + (size_t)tt * 128 * 1024, 1024, 1024, smem, 0.f, 0.f);
    epilogue(acc, [&](int m, int n, float (&v)[16]) {
      const int tok = tt * 128 + n, feat = ft * 128 + m;
      const float* xr = xrow(p, tok) + feat;
      const float* g1 = mod + modidx(tok) * 6144 + 2048 + feat;
#pragma unroll
      for (int i = 0; i < 4; ++i) {
        float4 xv = *(const float4*)(xr + 4 * i), gv = *(const float4*)(g1 + 4 * i);
        v[4 * i] = xv.x + gv.x * v[4 * i];
        v[4 * i + 1] = xv.y + gv.y * v[4 * i + 1];
        v[4 * i + 2] = xv.z + gv.z * v[4 * i + 2];
        v[4 * i + 3] = xv.w + gv.w * v[4 * i + 3];
      }
      st_f32x16(p.out + (size_t)tok * DM + feat, v);
    });
  }
}
DI void conv_fp8_rows(const float* __restrict__ src, unsigned char* __restrict__ dst, float* __restrict__ inv) {
  const int lane = threadIdx.x & 63, w = threadIdx.x >> 6;
  for (int r = blockIdx.x * 4 + w; r < 16384; r += gridDim.x * 4) {
    const float* sp = src + (size_t)r * 1024 + lane * 16;
    float4 v[4];
    float am = 0.f;
#pragma unroll
    for (int i = 0; i < 4; ++i) {
      v[i] = *(const float4*)(sp + 4 * i);
      am = fmaxf(am, fmaxf(fmaxf(fabsf(v[i].x), fabsf(v[i].y)), fmaxf(fabsf(v[i].z), fabsf(v[i].w))));
    }
#pragma unroll
    for (int o = 32; o > 0; o >>= 1) am = fmaxf(am, __shfl_xor(am, o));
    const float sc = am > 0.f ? 448.f / am : 1.f;
    u32x4 o4;
#pragma unroll
    for (int i = 0; i < 4; ++i) {
      int wd = 0;
      wd = __builtin_amdgcn_cvt_pk_fp8_f32(v[i].x * sc, v[i].y * sc, wd, false);
      wd = __builtin_amdgcn_cvt_pk_fp8_f32(v[i].z * sc, v[i].w * sc, wd, true);
      o4[i] = (unsigned)wd;
    }
    *(u32x4*)(dst + (size_t)r * 1024 + lane * 16) = o4;
    if (lane == 0) inv[r] = am > 0.f ? am * (1.f / 448.f) : 1.f;
  }
}
DI void phase10(const Params& p, char* smem) {
  rows_norm_mod(p, p.norm_ffn, 3072, 4096, true, (bf16_t*)(p.ws + OFF_H2));
  conv_fp8_rows(p.peer_u, (unsigned char*)(p.ws + OFF_TABU), (float*)(p.ws + OFF_INVU));
  conv_fp8_rows(p.peer_v, (unsigned char*)(p.ws + OFF_TABV), (float*)(p.ws + OFF_INVV));
}
DI void phase11(const Params& p, char* smem) {
  char* ws = p.ws;
  const bf16_t* h2 = (const bf16_t*)(ws + OFF_H2);
  const bf16_t* wct = (const bf16_t*)(ws + OFF_WCT);
  bf16_t* sc = (bf16_t*)(ws + OFF_SCORES);
  for (int it = 0;; ++it) {
    int ft, tt;
    if (!tile_map(it, 16, 160, 2, ft, tt)) break;
    f32x4 acc[4][4];
    acc_zero(acc);
    gemm_kloop<0>(acc, wct + (size_t)ft * 128 * 1024, 1024, h2 + (size_t)tt * 128 * 1024, 1024, 1024, smem, 0.f, 0.f);
    epilogue(acc, [&](int m, int n, float (&v)[16]) { st_bf16x16(sc + (size_t)(tt * 128 + n) * 2048 + ft * 128 + m, v); });
  }
}

DI unsigned okey(float f) {
  unsigned u = __float_as_uint(f);
  return (u & 0x80000000u) ? ~u : (u | 0x80000000u);
}
DI void wave_lds_sync() {
  __builtin_amdgcn_fence(__ATOMIC_ACQ_REL, "workgroup");
  __builtin_amdgcn_wave_barrier();
}
DI unsigned okey16(unsigned b) { return (b & 0x8000u) ? (~b & 0xFFFFu) : (b | 0x8000u); }
DI unsigned inv_okey16(unsigned k) { return (k & 0x8000u) ? (k & 0x7FFFu) : (~k & 0xFFFFu); }
DI unsigned inv_okey(unsigned k) { return (k & 0x80000000u) ? (k & 0x7FFFFFFFu) : ~k; }
DI void ins16(unsigned (&L)[16], unsigned x) {
#pragma unroll
  for (int i = 0; i < 16; ++i) {
    unsigned t = max(L[i], x);
    x = min(L[i], x);
    L[i] = t;
  }
}
DI unsigned sel16(const unsigned (&A)[16], int i) {
  unsigned r = 0u;
#pragma unroll
  for (int t = 0; t < 16; ++t) r |= A[t] & (0u - (unsigned)(i == t));
  return r;
}
DI void phase12(const Params& p, char* smem) {
  char* ws = p.ws;
  const bf16_t* sc = (const bf16_t*)(ws + OFF_SCORES);
  int* elist = (int*)(ws + OFF_ELIST);
  float* glist = (float*)(ws + OFF_GLIST);
  const int lane = threadIdx.x & 63, w = threadIdx.x >> 6;
  for (int batch = blockIdx.x * 4 + w; batch < NTOK / 4; batch += gridDim.x * 4) {
    const int tok = batch * 4 + (lane >> 4), hh = lane & 15;
    const bf16_t* row = sc + (size_t)tok * 2048 + hh * 128;
    unsigned L[16];
#pragma unroll
    for (int i = 0; i < 16; ++i) L[i] = 0u;
#pragma unroll
    for (int c = 0; c < 16; ++c) {
      u32x4 u = *(const u32x4*)(row + c * 8);
#pragma unroll
      for (int i = 0; i < 4; ++i) {
        unsigned b0 = u[i] & 0xFFFFu, b1 = u[i] >> 16;
        ins16(L, (okey16(b0) << 16) | (unsigned)(127 - (c * 8 + 2 * i)));
        ins16(L, (okey16(b1) << 16) | (unsigned)(127 - (c * 8 + 2 * i + 1)));
      }
    }
    unsigned M[16];
#pragma unroll
    for (int i = 0; i < 16; ++i) M[i] = (unsigned)__shfl_xor((int)L[i], 1);
    float v1[16], v2[16];
#pragma unroll
    for (int i = 0; i < 16; ++i) {
      v1[i] = bf2f(inv_okey16(L[i] >> 16));
      v2[i] = bf2f(inv_okey16(M[i] >> 16));
    }
    unsigned C[16];
#pragma unroll
    for (int i = 0; i < 16; ++i) C[i] = 0u;
    ins16(C, (okey(v1[0] + v2[0]) & 0xFFFFFF00u) | 255u);
    ins16(C, (okey(v1[0] + v2[1]) & 0xFFFFFF00u) | 254u);
    ins16(C, (okey(v1[0] + v2[2]) & 0xFFFFFF00u) | 253u);
    ins16(C, (okey(v1[0] + v2[3]) & 0xFFFFFF00u) | 252u);
    ins16(C, (okey(v1[0] + v2[4]) & 0xFFFFFF00u) | 251u);
    ins16(C, (okey(v1[0] + v2[5]) & 0xFFFFFF00u) | 250u);
    ins16(C, (okey(v1[0] + v2[6]) & 0xFFFFFF00u) | 249u);
    ins16(C, (okey(v1[0] + v2[7]) & 0xFFFFFF00u) | 248u);
    ins16(C, (okey(v1[0] + v2[8]) & 0xFFFFFF00u) | 247u);
    ins16(C, (okey(v1[0] + v2[9]) & 0xFFFFFF00u) | 246u);
    ins16(C, (okey(v1[0] + v2[10]) & 0xFFFFFF00u) | 245u);
    ins16(C, (okey(v1[0] + v2[11]) & 0xFFFFFF00u) | 244u);
    ins16(C, (okey(v1[0] + v2[12]) & 0xFFFFFF00u) | 243u);
    ins16(C, (okey(v1[0] + v2[13]) & 0xFFFFFF00u) | 242u);
    ins16(C, (okey(v1[0] + v2[14]) & 0xFFFFFF00u) | 241u);
    ins16(C, (okey(v1[0] + v2[15]) & 0xFFFFFF00u) | 240u);
    ins16(C, (okey(v1[1] + v2[0]) & 0xFFFFFF00u) | 239u);
    ins16(C, (okey(v1[1] + v2[1]) & 0xFFFFFF00u) | 238u);
    ins16(C, (okey(v1[1] + v2[2]) & 0xFFFFFF00u) | 237u);
    ins16(C, (okey(v1[1] + v2[3]) & 0xFFFFFF00u) | 236u);
    ins16(C, (okey(v1[1] + v2[4]) & 0xFFFFFF00u) | 235u);
    ins16(C, (okey(v1[1] + v2[5]) & 0xFFFFFF00u) | 234u);
    ins16(C, (okey(v1[1] + v2[6]) & 0xFFFFFF00u) | 233u);
    ins16(C, (okey(v1[1] + v2[7]) & 0xFFFFFF00u) | 232u);
    ins16(C, (okey(v1[2] + v2[0]) & 0xFFFFFF00u) | 223u);
    ins16(C, (okey(v1[2] + v2[1]) & 0xFFFFFF00u) | 222u);
    ins16(C, (okey(v1[2] + v2[2]) & 0xFFFFFF00u) | 221u);
    ins16(C, (okey(v1[2] + v2[3]) & 0xFFFFFF00u) | 220u);
    ins16(C, (okey(v1[2] + v2[4]) & 0xFFFFFF00u) | 219u);
    ins16(C, (okey(v1[3] + v2[0]) & 0xFFFFFF00u) | 207u);
    ins16(C, (okey(v1[3] + v2[1]) & 0xFFFFFF00u) | 206u);
    ins16(C, (okey(v1[3] + v2[2]) & 0xFFFFFF00u) | 205u);
    ins16(C, (okey(v1[3] + v2[3]) & 0xFFFFFF00u) | 204u);
    ins16(C, (okey(v1[4] + v2[0]) & 0xFFFFFF00u) | 191u);
    ins16(C, (okey(v1[4] + v2[1]) & 0xFFFFFF00u) | 190u);
    ins16(C, (okey(v1[4] + v2[2]) & 0xFFFFFF00u) | 189u);
    ins16(C, (okey(v1[5] + v2[0]) & 0xFFFFFF00u) | 175u);
    ins16(C, (okey(v1[5] + v2[1]) & 0xFFFFFF00u) | 174u);
    ins16(C, (okey(v1[6] + v2[0]) & 0xFFFFFF00u) | 159u);
    ins16(C, (okey(v1[6] + v2[1]) & 0xFFFFFF00u) | 158u);
    ins16(C, (okey(v1[7] + v2[0]) & 0xFFFFFF00u) | 143u);
    ins16(C, (okey(v1[7] + v2[1]) & 0xFFFFFF00u) | 142u);
    ins16(C, (okey(v1[8] + v2[0]) & 0xFFFFFF00u) | 127u);
    ins16(C, (okey(v1[9] + v2[0]) & 0xFFFFFF00u) | 111u);
    ins16(C, (okey(v1[10] + v2[0]) & 0xFFFFFF00u) | 95u);
    ins16(C, (okey(v1[11] + v2[0]) & 0xFFFFFF00u) | 79u);
    ins16(C, (okey(v1[12] + v2[0]) & 0xFFFFFF00u) | 63u);
    ins16(C, (okey(v1[13] + v2[0]) & 0xFFFFFF00u) | 47u);
    ins16(C, (okey(v1[14] + v2[0]) & 0xFFFFFF00u) | 31u);
    ins16(C, (okey(v1[15] + v2[0]) & 0xFFFFFF00u) | 15u);
    int ev[16];
    float gv[16];
    const float mx = __uint_as_float(inv_okey(C[0] & 0xFFFFFF00u));
    float den = 0.f;
#pragma unroll
    for (int k = 0; k < 16; ++k) {
      const int ci = 255 - (int)(C[k] & 0xFFu);
      const unsigned a1 = sel16(L, ci >> 4), a2 = sel16(M, ci & 15);
      ev[k] = (127 - (int)(a1 & 0xFFFFu)) * 128 + (127 - (int)(a2 & 0xFFFFu));
      gv[k] = __expf(__uint_as_float(inv_okey(C[k] & 0xFFFFFF00u)) - mx);
      den += gv[k];
    }
    const float inv = 1.f / den;
    if ((lane & 1) == 0) {
      int* ep = elist + (size_t)tok * 128 + (hh >> 1) * 16;
      float* gp = glist + (size_t)tok * 128 + (hh >> 1) * 16;
#pragma unroll
      for (int k = 0; k < 4; ++k) {
        *(int4*)(ep + 4 * k) = make_int4(ev[4 * k], ev[4 * k + 1], ev[4 * k + 2], ev[4 * k + 3]);
        *(float4*)(gp + 4 * k) = make_float4(gv[4 * k] * inv, gv[4 * k + 1] * inv, gv[4 * k + 2] * inv, gv[4 * k + 3] * inv);
      }
    }
  }
}
DI void phase13(const Params& p, char* smem) {
  char* ws = p.ws;
  const bf16_t* h2 = (const bf16_t*)(ws + OFF_H2);
  const unsigned char* tabU = (const unsigned char*)(ws + OFF_TABU);
  const unsigned char* tabV = (const unsigned char*)(ws + OFF_TABV);
  const float* invU = (const float*)(ws + OFF_INVU);
  const float* invV = (const float*)(ws + OFF_INVV);
  const int* elist = (const int*)(ws + OFF_ELIST);
  const float* glist = (const float*)(ws + OFF_GLIST);
  const float* mod = (const float*)(ws + OFF_MOD);
  const int lane = threadIdx.x & 63, w = threadIdx.x >> 6;
  for (int tok = blockIdx.x * 4 + w; tok < NTOK; tok += gridDim.x * 4) {
    float hf[16];
    {
      u32x4 a = *(const u32x4*)(h2 + (size_t)tok * DM + lane * 16), b = *(const u32x4*)(h2 + (size_t)tok * DM + lane * 16 + 8);
#pragma unroll
      for (int i = 0; i < 4; ++i) {
        hf[2 * i] = bflo(a[i]); hf[2 * i + 1] = bfhi(a[i]);
        hf[8 + 2 * i] = bflo(b[i]); hf[8 + 2 * i + 1] = bfhi(b[i]);
      }
    }
    const int ev0 = elist[(size_t)tok * 128 + lane], ev1 = elist[(size_t)tok * 128 + 64 + lane];
    const float gv0 = glist[(size_t)tok * 128 + lane], gv1 = glist[(size_t)tok * 128 + 64 + lane];
    float oacc[16];
#pragma unroll
    for (int i = 0; i < 16; ++i) oacc[i] = 0.f;
#pragma unroll 1
    for (int h = 0; h < 8; ++h) {
      int ln = lane;
      asm volatile("" : "+v"(ln));
      const int kq = ((ln >> 5) & 1) * 8 + ((ln >> 4) & 1) * 4 + ((ln >> 3) & 1) * 2 + ((ln >> 2) & 1);
      const int evh = h < 4 ? ev0 : ev1;
      const float gvh = h < 4 ? gv0 : gv1;
      const int lbase = (h & 3) * 16;
      const int eown = __shfl(evh, lbase + kq);
      const float gk = __shfl(gvh, lbase + kq);
      const float iu = invU[eown], iv = invV[eown];
      float pd[16];
#pragma unroll
      for (int hb = 0; hb < 2; ++hb) {
        u32x4 ur[8];
#pragma unroll
        for (int k = 0; k < 8; ++k)
          ur[k] = *(const u32x4*)(tabU + (size_t)__builtin_amdgcn_readlane(evh, lbase + hb * 8 + k) * 1024 + ln * 16);
#pragma unroll
        for (int k = 0; k < 8; ++k) {
          float d = 0.f;
#pragma unroll
          for (int i = 0; i < 4; ++i) {
            auto lo = __builtin_amdgcn_cvt_pk_f32_fp8((int)ur[k][i], false);
            auto hi2 = __builtin_amdgcn_cvt_pk_f32_fp8((int)ur[k][i], true);
            d += lo[0] * hf[4 * i] + lo[1] * hf[4 * i + 1] + hi2[0] * hf[4 * i + 2] + hi2[1] * hf[4 * i + 3];
          }
          pd[hb * 8 + k] = d;
        }
      }
      float q8[8], q4[4], q2[2], q1;
      {
        const bool hi = ln & 32;
#pragma unroll
        for (int i = 0; i < 8; ++i) {
          float send = hi ? pd[i] : pd[8 + i], keep = hi ? pd[8 + i] : pd[i];
          q8[i] = keep + __shfl_xor(send, 32);
        }
      }
      {
        const bool hi = ln & 16;
#pragma unroll
        for (int i = 0; i < 4; ++i) {
          float send = hi ? q8[i] : q8[4 + i], keep = hi ? q8[4 + i] : q8[i];
          q4[i] = keep + __shfl_xor(send, 16);
        }
      }
      {
        const bool hi = ln & 8;
#pragma unroll
        for (int i = 0; i < 2; ++i) {
          float send = hi ? q4[i] : q4[2 + i], keep = hi ? q4[2 + i] : q4[i];
          q2[i] = keep + __shfl_xor(send, 8);
        }
      }
      {
        const bool hi = ln & 4;
        float send = hi ? q2[0] : q2[1], keep = hi ? q2[1] : q2[0];
        q1 = keep + __shfl_xor(send, 4);
      }
      q1 += __shfl_xor(q1, 2);
      q1 += __shfl_xor(q1, 1);
      const float wk_own = gk * geluf_(q1 * iu) * iv;
#pragma unroll
      for (int hb = 0; hb < 2; ++hb) {
        u32x4 vr[8];
#pragma unroll
        for (int k = 0; k < 8; ++k)
          vr[k] = *(const u32x4*)(tabV + (size_t)__builtin_amdgcn_readlane(evh, lbase + hb * 8 + k) * 1024 + ln * 16);
#pragma unroll
        for (int k = 0; k < 8; ++k) {
          const int kk = hb * 8 + k;
          const int src = (((kk >> 3) & 1) << 5) | (((kk >> 2) & 1) << 4) | (((kk >> 1) & 1) << 3) | ((kk & 1) << 2);
          const float wk = __shfl(wk_own, src);
#pragma unroll
          for (int i = 0; i < 4; ++i) {
            auto lo = __builtin_amdgcn_cvt_pk_f32_fp8((int)vr[k][i], false);
            auto hi2 = __builtin_amdgcn_cvt_pk_f32_fp8((int)vr[k][i], true);
            oacc[4 * i] += wk * lo[0];
            oacc[4 * i + 1] += wk * lo[1];
            oacc[4 * i + 2] += wk * hi2[0];
            oacc[4 * i + 3] += wk * hi2[1];
          }
        }
      }
    }
    float* xr = p.out + (size_t)tok * DM;
    const float* g2 = mod + modidx(tok) * 6144 + 5120;
    float y[16];
    float ss = 0.f;
#pragma unroll
    for (int i = 0; i < 4; ++i) {
      const int e = lane * 16 + i * 4;
      float4 xv = *(const float4*)(xr + e), gv = *(const float4*)(g2 + e);
      float a0 = xv.x + gv.x * oacc[i * 4], a1 = xv.y + gv.y * oacc[i * 4 + 1];
      float a2 = xv.z + gv.z * oacc[i * 4 + 2], a3 = xv.w + gv.w * oacc[i * 4 + 3];
      y[i * 4] = a0; y[i * 4 + 1] = a1; y[i * 4 + 2] = a2; y[i * 4 + 3] = a3;
      ss += a0 * a0 + a1 * a1 + a2 * a2 + a3 * a3;
    }
    ss = wsum(ss);
    const float rstd = rsqrtf(ss * (1.f / 1024.f) + 1e-6f);
#pragma unroll
    for (int i = 0; i < 4; ++i) {
      const int e = lane * 16 + i * 4;
      float4 nf = *(const float4*)(p.norm_final + e);
      *(float4*)(xr + e) = make_float4(y[i * 4] * rstd * nf.x, y[i * 4 + 1] * rstd * nf.y, y[i * 4 + 2] * rstd * nf.z,
                                       y[i * 4 + 3] * rstd * nf.w);
    }
  }
}

#define XB_TMO      128
#define XB_XCNT(j)  (256  + 64 * (j))
#define XB_XSUB(j)  (1280 + 64 * (j))
#define XB_XGEN(j)  (2304 + 64 * (j))
#define XB_TOP      3328
#define XB_TOPGEN   3392
#define XCD_BAR_WORDS 3456
#define XB_SPIN_CAP (1u << 22)
#define LAS __attribute__((address_space(3)))
DI unsigned xb_ld(unsigned* p) { return __hip_atomic_load(p, __ATOMIC_RELAXED, __HIP_MEMORY_SCOPE_AGENT); }
DI unsigned xb_add(unsigned* p, unsigned v) { return __hip_atomic_fetch_add(p, v, __ATOMIC_RELAXED, __HIP_MEMORY_SCOPE_AGENT); }
DI unsigned xb_xcc_id() { return (unsigned)__builtin_amdgcn_s_getreg((3 << 11) | 20) & 0xFu; }
#define XB_SPIN(cond, bar) do { unsigned _sp = 0; while (cond) { __builtin_amdgcn_s_sleep(1); \
    if ((++_sp & 255u) == 0u) { if (xb_ld(&(bar)[XB_TMO])) break; if (_sp > XB_SPIN_CAP) { atomicAdd(&(bar)[XB_TMO], 1u); break; } } } } while (0)
struct XcdBarrier { unsigned* bar; unsigned x; volatile LAS unsigned* st; };
DI XcdBarrier xcd_barrier_post(unsigned* bar, volatile LAS unsigned* st) {
  XcdBarrier b; b.bar = bar; b.x = xb_xcc_id(); b.st = st;
  if (threadIdx.x == 0) (void)xb_add(&bar[XB_XCNT(b.x)], 1u);
  return b;
}
DI void xcd_barrier_complete(unsigned* bar, unsigned x, unsigned& nloc, unsigned& nx) {
  const unsigned G = gridDim.x * gridDim.y * gridDim.z;
  unsigned sum, cnt, mine, sp = 0u;
  for (;;) {
    sum = 0u; cnt = 0u; mine = 0u;
#pragma unroll
    for (unsigned j = 0; j < 16; ++j) { const unsigned c = xb_ld(&bar[XB_XCNT(j)]); sum += c; cnt += (c > 0u) ? 1u : 0u; mine = (j == x) ? c : mine; }
    if (sum == G) break;
    __builtin_amdgcn_s_sleep(1);
    if ((++sp & 255u) == 0u) { if (xb_ld(&bar[XB_TMO])) break; if (sp > XB_SPIN_CAP) { atomicAdd(&bar[XB_TMO], 1u); break; } }
  }
  nloc = mine > 0u ? mine : 1u; nx = cnt > 0u ? cnt : 1u;
}
DI void xcd_barrier(const XcdBarrier& b) {
  asm volatile("s_waitcnt vmcnt(0)" ::: "memory");
  __syncthreads();
  if (threadIdx.x == 0) {
    unsigned* bar = b.bar;
    __builtin_amdgcn_s_waitcnt(0);
    unsigned nloc = b.st[0], nx = b.st[1];
    if (nloc == 0u) { xcd_barrier_complete(bar, b.x, nloc, nx); b.st[0] = nloc; b.st[1] = nx; }
    const unsigned old = xb_add(&bar[XB_XSUB(b.x)], 1u);
    const unsigned gen = old / nloc;
    if (old + 1u == (gen + 1u) * nloc) {
      __builtin_amdgcn_fence(__ATOMIC_RELEASE, "agent");
      asm volatile("s_waitcnt vmcnt(0)" ::: "memory");
      const unsigned og = xb_add(&bar[XB_TOP], 1u);
      const unsigned tg = og / nx;
      if (og + 1u == (tg + 1u) * nx) xb_add(&bar[XB_TOPGEN], 1u);
      else XB_SPIN(xb_ld(&bar[XB_TOPGEN]) == tg, bar);
      __builtin_amdgcn_fence(__ATOMIC_ACQUIRE, "agent");
      xb_add(&bar[XB_XGEN(b.x)], 1u);
      asm volatile("s_waitcnt vmcnt(0)" ::: "memory");
    } else {
      XB_SPIN(xb_ld(&bar[XB_XGEN(b.x)]) == gen, bar);
      __builtin_amdgcn_fence(__ATOMIC_ACQUIRE, "agent");
      asm volatile("s_waitcnt vmcnt(0)" ::: "memory");
    }
  }
  __syncthreads();
}

#ifdef ONLY_PHASE
#define RUNPH(n, call) if (ONLY_PHASE == n) { call; }
#else
#ifndef DUP_PHASE
#define DUP_PHASE -1
#endif
#define RUNPH(n, call) if (lo <= n && n < hi) { call; if (n == DUP_PHASE) { xcd_barrier(xb); call; } if (n + 1 < hi) xcd_barrier(xb); }
#endif
__global__ void __launch_bounds__(256, 2) mega(Params p, int lo, int hi) {
  __shared__ __attribute__((aligned(16))) char smem[SMEM_BYTES];
  __shared__ uint4 xb_words;
  cg::grid_group grid = cg::this_grid();
  if (lo < 0) grid.sync();
  if (threadIdx.x == 0) xb_words = make_uint4(0u, 0u, 0u, 0u);
  __syncthreads();
  XcdBarrier xb = xcd_barrier_post((unsigned*)(p.ws + OFF_BAR), (volatile LAS unsigned*)&xb_words);
  RUNPH(0, phase0(p, smem))
  RUNPH(1, phase1(p, smem))
  RUNPH(2, phase2(p, smem))
  RUNPH(3, phase3(p, smem))
  RUNPH(4, phase4(p))
  RUNPH(5, phase5(p, smem))
  RUNPH(6, phase6(p, smem))
  RUNPH(7, phase7(p, smem))
  RUNPH(8, phase8(p, smem))
  RUNPH(9, phase9(p, smem))
  RUNPH(10, phase10(p, smem))
  RUNPH(11, phase11(p, smem))
  RUNPH(12, phase12(p, smem))
  RUNPH(13, phase13(p, smem))
}

extern "C" void kernel_launch(void* const* d_in, const int* in_sizes, int n_in, void* d_out, int out_size, void* d_ws,
                              size_t ws_size, hipStream_t stream) {
  static int grid_blocks = 0;
  if (!grid_blocks) {
    int dev = 0, cus = 0, per_cu = 0;
    hipGetDevice(&dev);
    hipDeviceGetAttribute(&cus, hipDeviceAttributeMultiprocessorCount, dev);
    hipOccupancyMaxActiveBlocksPerMultiprocessor(&per_cu, mega, 256, 0);
    if (per_cu > 2) per_cu = 2;
    if (per_cu < 1) per_cu = 1;
    grid_blocks = cus * per_cu;
  }
  Params p{};
  const float** pp = (const float**)&p;
  for (int i = 0; i < 29; ++i) pp[i] = (const float*)d_in[i];
  p.out = (float*)d_out;
  p.ws = (char*)d_ws;
#if N_LAUNCH_SPLIT
  for (int ph = 0; ph < NPHASE; ++ph) {
    hipLaunchKernelGGL(mega, dim3(grid_blocks), dim3(256), 0, stream, p, ph, ph + 1);
  }
#else
  hipMemsetAsync((char*)d_ws + OFF_MOD, 0, (OFF_BAR - OFF_MOD) + XCD_BAR_WORDS * sizeof(unsigned), stream);
  int lo = 0, hi = NPHASE;
  void* args[] = {&p, &lo, &hi};
  hipError_t e = hipLaunchCooperativeKernel((void*)mega, dim3(grid_blocks), dim3(256), args, 0, stream);
  if (e != hipSuccess) fprintf(stderr, "cooperative launch failed: %s (grid %d)\n", hipGetErrorString(e), grid_blocks);
#endif
}
```

```cpp
#include <hip/hip_runtime.h>
#include <hip/hip_cooperative_groups.h>
#include <cstdio>
namespace cg = cooperative_groups;

#define DI __device__ __forceinline__
typedef unsigned short bf16_t;
using bf16x8 = __attribute__((ext_vector_type(8))) short;
using f32x4 = __attribute__((ext_vector_type(4))) float;
using u32x4 = __attribute__((ext_vector_type(4))) unsigned;
using u32x2 = __attribute__((ext_vector_type(2))) unsigned;

#ifndef N_LAUNCH_SPLIT
#define N_LAUNCH_SPLIT 0
#endif

constexpr int NTOK = 20480, NPT = 4096, DM = 1024;
constexpr int NPHASE = 17;
constexpr size_t MiB = 1u << 20;
constexpr size_t OFF_WINT = 0, OFF_WUQT = 9 * MiB, OFF_WUKVT = 9 * MiB + 512 * 1024, OFF_WUPAT = 10 * MiB,
                 OFF_WUPBT = 11 * MiB, OFF_WOT = 12 * MiB, OFF_WCT = 14 * MiB, OFF_WPQB = 18 * MiB,
                 OFF_KEYSB = 22 * MiB, OFF_MOD = 22 * MiB + 512 * 1024, OFF_BAR = 22 * MiB + 768 * 1024, A0 = 24 * MiB;
constexpr size_t OFF_PD = A0 + 104 * MiB, OFF_H1 = A0 + 0, OFF_CQ = A0 + 40 * MiB, OFF_CKVRAW = A0 + 50 * MiB, OFF_KRRAW = A0 + 60 * MiB,
                 OFF_RQ = A0 + 63 * MiB, OFF_RK = A0 + 83 * MiB, OFF_KT = A0 + 103 * MiB, OFF_VT = A0 + 123 * MiB,
                 OFF_SRG = A0 + 143 * MiB, OFF_CKVALL = A0 + 163 * MiB, OFF_KRALL = A0 + 169 * MiB,
                 OFF_UF = A0 + 171 * MiB, OFF_UB = A0 + 187 * MiB,
                 OFF_SF = A0 + 0, OFF_SB = A0 + 8 * MiB, OFF_RET = A0 + 16 * MiB,
                 OFF_Q = A0 + 63 * MiB, OFF_KN = A0 + 93 * MiB, OFF_VTA = A0 + 117 * MiB, OFF_ATTN = A0 + 141 * MiB,
                 OFF_M = A0 + 163 * MiB,
                 OFF_H2 = A0 + 0, OFF_TABU = A0 + 40 * MiB, OFF_TABV = A0 + 56 * MiB, OFF_INVU = A0 + 72 * MiB,
                 OFF_INVV = A0 + 73 * MiB, OFF_ELIST = A0 + 74 * MiB, OFF_GLIST = A0 + 84 * MiB, OFF_SCORES = A0 + 104 * MiB;
constexpr size_t OUT_CKV = 20971520, OUT_KR = 21495808, OUT_SF = 21626880, OUT_SB = 22675456;
constexpr int NKV = 24576;
constexpr int SMEM_BYTES = 36864;

struct Params {
  const float *x_prompt, *x_sample, *c, *cache_ckv, *cache_krope, *st_f, *st_b, *c_ctx, *w_mod, *b_mod, *norm_mix,
      *norm_ffn, *norm_final, *w_in, *q_norm, *kv_norm, *w_uq, *w_ukv, *lg_f, *lg_b, *ret_gn, *w_up_a, *w_up_b, *w_o,
      *peer_wq, *keys1, *keys2, *peer_u, *peer_v;
  float* out;
  char* ws;
};

DI unsigned f2bf(float x) {
  unsigned u = __float_as_uint(x);
  u += 0x7fffu + ((u >> 16) & 1u);
  return u >> 16;
}
DI float bf2f(unsigned b) { return __uint_as_float(b << 16); }
typedef __bf16 hbf16x2_t __attribute__((ext_vector_type(2)));
typedef float hf32x2_t __attribute__((ext_vector_type(2)));
DI unsigned pack2(float a, float b) {
  hf32x2_t f = {a, b};
  return __builtin_bit_cast(unsigned, __builtin_convertvector(f, hbf16x2_t));
}
DI float ex2(float x) { return __builtin_amdgcn_exp2f(x); }
DI float bflo(unsigned u) { return __uint_as_float(u << 16); }
DI float bfhi(unsigned u) { return __uint_as_float(u & 0xffff0000u); }
DI float wsum(float v) {
#pragma unroll
  for (int o = 32; o > 0; o >>= 1) v += __shfl_xor(v, o);
  return v;
}
DI float sigmoidf_(float x) { return 1.f / (1.f + __expf(-x)); }
DI float siluf_(float x) { return x / (1.f + __expf(-x)); }
DI float geluf_(float x) { return 0.5f * x * (1.f + tanhf(0.7978845608028654f * (x + 0.044715f * x * x * x))); }
DI const float* xrow(const Params& p, int tok) {
  return tok < NPT ? p.x_prompt + (size_t)tok * DM : p.x_sample + (size_t)(tok - NPT) * DM;
}
DI int modidx(int tok) { return tok < NPT ? 0 : 1 + ((tok - NPT) >> 11); }
DI int kvrow(int tok) {
  if (tok < NPT) return tok;
  int t = tok - NPT;
  return NPT + (t >> 11) * 2560 + (t & 2047);
}
DI void st_bf16x16(bf16_t* dst, const float (&v)[16]) {
  u32x4 a, b;
  a[0] = pack2(v[0], v[1]); a[1] = pack2(v[2], v[3]); a[2] = pack2(v[4], v[5]); a[3] = pack2(v[6], v[7]);
  b[0] = pack2(v[8], v[9]); b[1] = pack2(v[10], v[11]); b[2] = pack2(v[12], v[13]); b[3] = pack2(v[14], v[15]);
  *(u32x4*)dst = a;
  *(u32x4*)(dst + 8) = b;
}
DI void st_f32x16(float* dst, const float (&v)[16]) {
#pragma unroll
  for (int i = 0; i < 4; ++i) *(float4*)(dst + 4 * i) = make_float4(v[4 * i], v[4 * i + 1], v[4 * i + 2], v[4 * i + 3]);
}
DI void ld_bf16x16(const bf16_t* src, float (&v)[16]) {
  u32x4 a = *(const u32x4*)src, b = *(const u32x4*)(src + 8);
#pragma unroll
  for (int i = 0; i < 4; ++i) {
    v[2 * i] = bflo(a[i]); v[2 * i + 1] = bfhi(a[i]);
    v[8 + 2 * i] = bflo(b[i]); v[8 + 2 * i + 1] = bfhi(b[i]);
  }
}

constexpr int LDK = 72;
template <int SCALE>
DI void gemm_kloop(f32x4 (&acc)[4][4], const bf16_t* __restrict__ A, int lda, const bf16_t* __restrict__ B, int ldb,
                   int K, char* smem, float sc_a, float sc_b) {
  bf16_t* As = (bf16_t*)smem;
  bf16_t* Bs = As + 128 * LDK;
  const int tid = threadIdx.x, lane = tid & 63, w = tid >> 6, wm = w >> 1, wn = w & 1, l15 = lane & 15, g = lane >> 4;
  u32x4 ra[4], rb[4];
  int arow[4], kc[4], ldsa[4], ldsb[4];
#pragma unroll
  for (int i = 0; i < 4; ++i) {
    int c = tid + 256 * i;
    int r = c >> 3;
    kc[i] = (c & 7) * 8;
    arow[i] = r;
    int rr = r & 63;
    int rho = (r & 64) | (((rr >> 2) & 3) << 4) | ((rr >> 4) << 2) | (rr & 3);
    ldsa[i] = rho * LDK + kc[i];
    ldsb[i] = r * LDK + kc[i];
  }
#pragma unroll
  for (int i = 0; i < 4; ++i) {
    ra[i] = *(const u32x4*)(A + (size_t)arow[i] * lda + kc[i]);
    rb[i] = *(const u32x4*)(B + (size_t)arow[i] * ldb + kc[i]);
  }
  for (int k0 = 0; k0 < K; k0 += 64) {
    __syncthreads();
#pragma unroll
    for (int i = 0; i < 4; ++i) {
      *(u32x4*)(As + ldsa[i]) = ra[i];
      *(u32x4*)(Bs + ldsb[i]) = rb[i];
    }
    __syncthreads();
    if (k0 + 64 < K) {
#pragma unroll
      for (int i = 0; i < 4; ++i) {
        ra[i] = *(const u32x4*)(A + (size_t)arow[i] * lda + k0 + 64 + kc[i]);
        rb[i] = *(const u32x4*)(B + (size_t)arow[i] * ldb + k0 + 64 + kc[i]);
      }
    }
#pragma unroll
    for (int ks = 0; ks < 2; ++ks) {
      bf16x8 af[4], bfr[4];
#pragma unroll
      for (int f = 0; f < 4; ++f)
        af[f] = *(const bf16x8*)(As + (wm * 64 + f * 16 + l15) * LDK + ks * 32 + g * 8);
#pragma unroll
      for (int c = 0; c < 4; ++c)
        bfr[c] = *(const bf16x8*)(Bs + (wn * 64 + c * 16 + l15) * LDK + ks * 32 + g * 8);
      if (SCALE) {
        float fac[8];
#pragma unroll
        for (int i = 0; i < 8; ++i) fac[i] = ex2(sc_a + sc_b * (float)(k0 + ks * 32 + g * 8 + i));
#pragma unroll
        for (int f = 0; f < 4; ++f) {
          u32x4 u = __builtin_bit_cast(u32x4, af[f]);
#pragma unroll
          for (int i = 0; i < 4; ++i) u[i] = pack2(bflo(u[i]) * fac[2 * i], bfhi(u[i]) * fac[2 * i + 1]);
          af[f] = __builtin_bit_cast(bf16x8, u);
        }
      }
#pragma unroll
      for (int f = 0; f < 4; ++f)
#pragma unroll
        for (int c = 0; c < 4; ++c) acc[f][c] = __builtin_amdgcn_mfma_f32_16x16x32_bf16(af[f], bfr[c], acc[f][c], 0, 0, 0);
    }
  }
}
DI void acc_zero(f32x4 (&acc)[4][4]) {
#pragma unroll
  for (int f = 0; f < 4; ++f)
#pragma unroll
    for (int c = 0; c < 4; ++c) acc[f][c] = f32x4{0.f, 0.f, 0.f, 0.f};
}
template <class F>
DI void epilogue(const f32x4 (&acc)[4][4], F&& epi) {
  const int tid = threadIdx.x, lane = tid & 63, w = tid >> 6, wm = w >> 1, wn = w & 1, l15 = lane & 15, g = lane >> 4;
#pragma unroll
  for (int c = 0; c < 4; ++c) {
    float v[16];
#pragma unroll
    for (int f = 0; f < 4; ++f)
#pragma unroll
      for (int j = 0; j < 4; ++j) v[f * 4 + j] = acc[f][c][j];
    epi(wm * 64 + 16 * g, wn * 64 + c * 16 + l15, v);
  }
}
DI bool tile_map(int it, int Ft, int Tt, int fsplit, int& ft, int& tt) {
  const int bid = blockIdx.x, nb = gridDim.x;
  int xcd = bid & 7, loc = bid >> 3, nloc = nb >> 3;
  if (loc >= nloc) return false;
  int fg = xcd % fsplit, tg = xcd / fsplit, tsplit = 8 / fsplit;
  int Fg = Ft / fsplit, Tg = Tt / tsplit;
  int i = loc + it * nloc;
  if (i >= Fg * Tg) return false;
  ft = fg * Fg + i % Fg;
  tt = tg * Tg + i / Fg;
  return true;
}
DI int vbid() {
  const int bid = blockIdx.x, nb = gridDim.x;
  if (nb & 7) return bid;
  return (bid & 7) * (nb >> 3) + (bid >> 3);
}

DI int colmap(int mode, int np) {
  if (mode == 1) return np < 416 ? np : (np < 512 ? -1 : np - 96);
  if (mode == 2) return np < 512 ? ((np >> 6) * 128 + (np & 63)) : (((np - 512) >> 6) * 128 + 64 + ((np - 512) & 63));
  return np;
}
DI void tconv_tile(const float* __restrict__ src, int ldsrc, bf16_t* __restrict__ dst, int K, int kt, int nt, int mode,
                   char* smem) {
  float* lds = (float*)smem;
  const int tid = threadIdx.x;
  {
    int col = tid & 63, rq = tid >> 6;
    int n = colmap(mode, nt * 64 + col);
#pragma unroll 4
    for (int r = 0; r < 16; ++r) {
      int kl = r * 4 + rq;
      float v = n >= 0 ? src[(size_t)(kt * 64 + kl) * ldsrc + n] : 0.f;
      lds[kl * 65 + col] = v;
    }
  }
  __syncthreads();
  {
    int nl = tid >> 2, kq = (tid & 3) * 16;
    float v[16];
#pragma unroll
    for (int i = 0; i < 16; ++i) v[i] = lds[(kq + i) * 65 + nl];
    st_bf16x16(dst + (size_t)(nt * 64 + nl) * K + kt * 64 + kq, v);
  }
  __syncthreads();
}
DI void mod_item(const Params& p, int item, char* smem) {
  float* sil = (float*)smem;
  const int tid = threadIdx.x;
  const int cg_ = item >> 2, slab = item & 3, kbase = slab * 256;
  for (int i = tid; i < 9 * 256; i += 256) {
    int j = i >> 8, k = kbase + (i & 255);
    float cv = j == 0 ? p.c_ctx[k] : p.c[(j - 1) * 1024 + k];
    sil[i] = siluf_(cv);
  }
  __syncthreads();
  const int kq = tid >> 6, nn = tid & 63, n0 = cg_ * 64;
  float acc[9];
#pragma unroll
  for (int j = 0; j < 9; ++j) acc[j] = 0.f;
#pragma unroll 1
  for (int i0 = 0; i0 < 64; i0 += 16) {
    float wv[16];
#pragma unroll
    for (int i = 0; i < 16; ++i) wv[i] = p.w_mod[(size_t)(kbase + kq + 4 * (i0 + i)) * 6144 + n0 + nn];
#pragma unroll
    for (int i = 0; i < 16; ++i)
#pragma unroll
      for (int j = 0; j < 9; ++j) acc[j] += sil[j * 256 + kq + 4 * (i0 + i)] * wv[i];
  }
  __syncthreads();
  float* part = (float*)smem + 9 * 256;
#pragma unroll
  for (int j = 0; j < 9; ++j) part[(kq * 9 + j) * 64 + nn] = acc[j];
  __syncthreads();
  float* mod = (float*)(p.ws + OFF_MOD);
  for (int i = tid; i < 9 * 64; i += 256) {
    int j = i >> 6, n = i & 63;
    float s = part[(0 * 9 + j) * 64 + n] + part[(1 * 9 + j) * 64 + n] + part[(2 * 9 + j) * 64 + n] + part[(3 * 9 + j) * 64 + n];
    if (slab == 0) s += p.b_mod[n0 + n];
    atomicAdd(mod + j * 6144 + n0 + n, s);
  }
  __syncthreads();
}
DI void conv_flat(const float* __restrict__ src, bf16_t* __restrict__ dst, size_t n) {
  size_t i = ((size_t)blockIdx.x * 256 + threadIdx.x) * 8;
  const size_t stride = (size_t)gridDim.x * 256 * 8;
  for (; i < n; i += stride) {
    float4 a = *(const float4*)(src + i), b = *(const float4*)(src + i + 4);
    u32x4 o;
    o[0] = pack2(a.x, a.y); o[1] = pack2(a.z, a.w); o[2] = pack2(b.x, b.y); o[3] = pack2(b.z, b.w);
    *(u32x4*)(dst + i) = o;
  }
}
DI void phase0(const Params& p, char* smem) {
  const int bid = blockIdx.x, nb = gridDim.x;
  char* ws = p.ws;
  const int n_mod = 384;
  const int t_in = 16 * 72, t_uq = 4 * 12, t_ukv = 2 * 16, t_upa = 8 * 16, t_upb = 8 * 16, t_o = 16 * 16;
  const int total = n_mod + t_in + t_uq + t_ukv + t_upa + t_upb + t_o;
  for (int it = bid; it < total; it += nb) {
    int i = it;
    if (i < n_mod) { mod_item(p, i, smem); continue; }
    i -= n_mod;
    if (i < t_in) { tconv_tile(p.w_in, 4512, (bf16_t*)(ws + OFF_WINT), 1024, i / 72, i % 72, 1, smem); continue; }
    i -= t_in;
    if (i < t_uq) { tconv_tile(p.w_uq, 768, (bf16_t*)(ws + OFF_WUQT), 256, i / 12, i % 12, 0, smem); continue; }
    i -= t_uq;
    if (i < t_ukv) { tconv_tile(p.w_ukv, 1024, (bf16_t*)(ws + OFF_WUKVT), 128, i / 16, i % 16, 2, smem); continue; }
    i -= t_ukv;
    if (i < t_upa) { tconv_tile(p.w_up_a, 1024, (bf16_t*)(ws + OFF_WUPAT), 512, i / 16, i % 16, 0, smem); continue; }
    i -= t_upa;
    if (i < t_upb) { tconv_tile(p.w_up_b, 1024, (bf16_t*)(ws + OFF_WUPBT), 512, i / 16, i % 16, 0, smem); continue; }
    i -= t_upb;
    tconv_tile(p.w_o, 1024, (bf16_t*)(ws + OFF_WOT), 1024, i / 16, i % 16, 0, smem);
  }
  conv_flat(p.peer_wq, (bf16_t*)(ws + OFF_WPQB), (size_t)1024 * 2048);
  {
    size_t i = ((size_t)bid * 256 + threadIdx.x) * 8;
    const size_t stride = (size_t)nb * 256 * 8;
    bf16_t* kb = (bf16_t*)(ws + OFF_KEYSB);
    for (; i < (size_t)2 * 131072; i += stride) {
      int half = i >= 131072;
      size_t s = i - (size_t)half * 131072;
      int h = (int)(s >> 14);
      size_t r = s & 16383;
      const float* src = (half ? p.keys2 : p.keys1) + s;
      float4 a = *(const float4*)(src), b = *(const float4*)(src + 4);
      u32x4 o;
      o[0] = pack2(a.x, a.y); o[1] = pack2(a.z, a.w); o[2] = pack2(b.x, b.y); o[3] = pack2(b.z, b.w);
      *(u32x4*)(kb + ((size_t)(h * 2 + half) << 14) + r) = o;
    }
  }
}

DI void rows_norm_mod(const Params& p, const float* nw, int sh_off, int sc_off, bool from_out, bf16_t* dst) {
  const int lane = threadIdx.x & 63, w = threadIdx.x >> 6;
  const float* mod = (const float*)(p.ws + OFF_MOD);
  for (int tok = blockIdx.x * 4 + w; tok < NTOK; tok += gridDim.x * 4) {
    const float* xr = from_out ? p.out + (size_t)tok * DM : xrow(p, tok);
    const float* mj = mod + modidx(tok) * 6144;
    float4 xv[4];
    float ss = 0.f;
#pragma unroll
    for (int i = 0; i < 4; ++i) {
      xv[i] = *(const float4*)(xr + (i * 64 + lane) * 4);
      ss += xv[i].x * xv[i].x + xv[i].y * xv[i].y + xv[i].z * xv[i].z + xv[i].w * xv[i].w;
    }
    ss = wsum(ss);
    float rstd = rsqrtf(ss * (1.f / 1024.f) + 1e-6f);
#pragma unroll
    for (int i = 0; i < 4; ++i) {
      int e = (i * 64 + lane) * 4;
      float4 nv = *(const float4*)(nw + e), sh = *(const float4*)(mj + sh_off + e), sc = *(const float4*)(mj + sc_off + e);
      float h0 = (xv[i].x * rstd) * nv.x * (1.f + sc.x) + sh.x;
      float h1 = (xv[i].y * rstd) * nv.y * (1.f + sc.y) + sh.y;
      float h2 = (xv[i].z * rstd) * nv.z * (1.f + sc.z) + sh.z;
      float h3 = (xv[i].w * rstd) * nv.w * (1.f + sc.w) + sh.w;
      u32x2 o;
      o[0] = pack2(h0, h1); o[1] = pack2(h2, h3);
      *(u32x2*)(dst + (size_t)tok * DM + e) = o;
    }
  }
}
DI void phase1(const Params& p, char* smem) {
  rows_norm_mod(p, p.norm_mix, 0, 1024, false, (bf16_t*)(p.ws + OFF_H1));
  const bf16_t* wpq = (const bf16_t*)(p.ws + OFF_WPQB);
  const bf16_t* kb = (const bf16_t*)(p.ws + OFF_KEYSB);
  bf16_t* wct = (bf16_t*)(p.ws + OFF_WCT);
  for (int it = blockIdx.x; it < 128; it += gridDim.x) {
    int hh = it >> 3, mt = it & 7;
    f32x4 acc[4][4];
    acc_zero(acc);
    gemm_kloop<0>(acc, wpq + (size_t)(mt * 128) * 2048 + hh * 128, 2048, kb + (size_t)hh * 16384, 128, 128, smem, 0.f, 0.f);
    epilogue(acc, [&](int m, int n, float (&v)[16]) { st_bf16x16(wct + (size_t)(hh * 128 + n) * 1024 + mt * 128 + m, v); });
  }
}

DI void phase2(const Params& p, char* smem) {
  char* ws = p.ws;
  const bf16_t* winT = (const bf16_t*)(ws + OFF_WINT);
  const bf16_t* h1 = (const bf16_t*)(ws + OFF_H1);
  bf16_t* cq = (bf16_t*)(ws + OFF_CQ);
  float* ckvraw = (float*)(ws + OFF_CKVRAW);
  float* krraw = (float*)(ws + OFF_KRRAW);
  bf16_t* rq = (bf16_t*)(ws + OFF_RQ);
  bf16_t* rk = (bf16_t*)(ws + OFF_RK);
  bf16_t* kT = (bf16_t*)(ws + OFF_KT);
  bf16_t* vT = (bf16_t*)(ws + OFF_VT);
  bf16_t* srg = (bf16_t*)(ws + OFF_SRG);
  bf16_t* sga = (bf16_t*)p.out;
  bf16_t* sgb = sga + (size_t)NTOK * 1024;
  for (int it = 0;; ++it) {
    int ft, tt;
    if (!tile_map(it, 36, 160, 4, ft, tt)) break;
    f32x4 acc[4][4];
    acc_zero(acc);
    const bf16_t* W = winT + (size_t)ft * 128 * 1024;
    const bf16_t* H = h1 + (size_t)tt * 128 * 1024;
    const int tok0 = tt * 128, f0 = ft * 128;
    if (ft >= 8 && ft < 16) {
      gemm_kloop<0>(acc, H, 1024, W, 1024, 1024, smem, 0.f, 0.f);
      if (ft < 12) {
        epilogue(acc, [&](int m, int n, float (&v)[16]) {
          int feat = f0 - 1024 + n, tok = tok0 + m;
#pragma unroll
          for (int i = 0; i < 16; ++i) v[i] *= 0.08838834764831845f;
          st_bf16x16(kT + (size_t)feat * NTOK + tok, v);
#pragma unroll
          for (int i = 0; i < 16; ++i) rk[(size_t)(tok + i) * 512 + feat] = (bf16_t)f2bf(v[i]);
        });
      } else {
        epilogue(acc, [&](int m, int n, float (&v)[16]) {
          int feat = f0 - 1536 + n, tok = tok0 + m;
          st_bf16x16(vT + (size_t)feat * NTOK + tok, v);
        });
      }
    } else {
      gemm_kloop<0>(acc, W, 1024, H, 1024, 1024, smem, 0.f, 0.f);
      if (ft < 2) {
        epilogue(acc, [&](int m, int n, float (&v)[16]) { st_bf16x16(cq + (size_t)(tok0 + n) * 256 + f0 + m, v); });
      } else if (ft == 2) {
        epilogue(acc, [&](int m, int n, float (&v)[16]) { st_f32x16(ckvraw + (size_t)(tok0 + n) * 128 + m, v); });
      } else if (ft == 3) {
        epilogue(acc, [&](int m, int n, float (&v)[16]) {
          if (m < 32) st_f32x16(krraw + (size_t)(tok0 + n) * 32 + m, v);
        });
      } else if (ft < 8) {
        epilogue(acc, [&](int m, int n, float (&v)[16]) { st_bf16x16(rq + (size_t)(tok0 + n) * 512 + f0 - 512 + m, v); });
      } else if (ft < 20) {
        epilogue(acc, [&](int m, int n, float (&v)[16]) {
#pragma unroll
          for (int i = 0; i < 16; ++i) v[i] = siluf_(v[i]);
          st_bf16x16(srg + (size_t)(tok0 + n) * 512 + f0 - 2048 + m, v);
        });
      } else if (ft < 28) {
        epilogue(acc, [&](int m, int n, float (&v)[16]) {
#pragma unroll
          for (int i = 0; i < 16; ++i) v[i] = sigmoidf_(v[i]);
          st_bf16x16(sga + (size_t)(tok0 + n) * 1024 + f0 - 2560 + m, v);
        });
      } else {
        epilogue(acc, [&](int m, int n, float (&v)[16]) {
#pragma unroll
          for (int i = 0; i < 16; ++i) v[i] = sigmoidf_(v[i]);
          st_bf16x16(sgb + (size_t)(tok0 + n) * 1024 + f0 - 3584 + m, v);
        });
      }
    }
  }
}

DI float log2gamma(float logit) { return -log1pf(expf(-logit)) * 1.4426950408889634f; }
DI void phase3(const Params& p, char* smem) {
  char* ws = p.ws;
  const int lane = threadIdx.x & 63, w = threadIdx.x >> 6;
  bf16_t* cq = (bf16_t*)(ws + OFF_CQ);
  const float* ckvraw = (const float*)(ws + OFF_CKVRAW);
  const float* krraw = (const float*)(ws + OFF_KRRAW);
  bf16_t* ckvall = (bf16_t*)(ws + OFF_CKVALL);
  bf16_t* krall = (bf16_t*)(ws + OFF_KRALL);
  for (int r = blockIdx.x * 4 + w; r < NTOK + 4096; r += gridDim.x * 4) {
    if (r < NTOK) {
      const int tok = r;
      {
        u32x2 u = *(const u32x2*)(cq + (size_t)tok * 256 + lane * 4);
        float a0 = bflo(u[0]), a1 = bfhi(u[0]), a2 = bflo(u[1]), a3 = bfhi(u[1]);
        float ss = wsum(a0 * a0 + a1 * a1 + a2 * a2 + a3 * a3);
        float rstd = rsqrtf(ss * (1.f / 256.f) + 1e-6f);
        float4 nq = *(const float4*)(p.q_norm + lane * 4);
        u32x2 o;
        o[0] = pack2(a0 * rstd * nq.x, a1 * rstd * nq.y);
        o[1] = pack2(a2 * rstd * nq.z, a3 * rstd * nq.w);
        *(u32x2*)(cq + (size_t)tok * 256 + lane * 4) = o;
      }
      const int row = kvrow(tok);
      {
        float2 v = *(const float2*)(ckvraw + (size_t)tok * 128 + lane * 2);
        float ss = wsum(v.x * v.x + v.y * v.y);
        float rstd = rsqrtf(ss * (1.f / 128.f) + 1e-6f);
        float2 nk = *(const float2*)(p.kv_norm + lane * 2);
        float o0 = v.x * rstd * nk.x, o1 = v.y * rstd * nk.y;
        if (tok < NPT) *(float2*)(p.out + OUT_CKV + (size_t)tok * 128 + lane * 2) = make_float2(o0, o1);
        *(unsigned*)(ckvall + (size_t)row * 128 + lane * 2) = pack2(o0, o1);
      }
      if (lane < 32) {
        float own = krraw[(size_t)tok * 32 + lane];
        float o = own;
        if (tok < NPT) {
          p.out[OUT_KR + (size_t)tok * 32 + lane] = own;
        } else {
          float partner = krraw[(size_t)tok * 32 + (lane ^ 16)];
          int t = (tok - NPT) & 2047;
          int a = lane & 15;
          float pos = (a < 8) ? (float)(t >> 6) : (float)(t & 63);
          float fr = exp2f(-(float)(a & 7) * 1.6609640474436813f);
          float sn, cs;
          sincosf(pos * fr, &sn, &cs);
          o = lane < 16 ? own * cs - partner * sn : partner * sn + own * cs;
        }
        krall[(size_t)row * 32 + lane] = (bf16_t)f2bf(o);
      }
    } else {
      const int cr = r - NTOK;
      const int b = cr >> 9, pos = cr & 511;
      const int row = NPT + b * 2560 + 2048 + pos;
      float2 v = *(const float2*)(p.cache_ckv + (size_t)cr * 128 + lane * 2);
      *(unsigned*)(ckvall + (size_t)row * 128 + lane * 2) = pack2(v.x, v.y);
      if (lane < 32) krall[(size_t)row * 32 + lane] = (bf16_t)f2bf(p.cache_krope[(size_t)cr * 32 + lane]);
    }
  }
  const bf16_t* kT = (const bf16_t*)(ws + OFF_KT);
  const bf16_t* vT = (const bf16_t*)(ws + OFF_VT);
  float* Uf = (float*)(ws + OFF_UF);
  float* Ub = (float*)(ws + OFF_UB);
  for (int it = blockIdx.x; it < 320; it += gridDim.x) {
    const int blk = it >> 2, h = it & 3;
    const float l2f = log2gamma(p.lg_f[h]), l2b = log2gamma(p.lg_b[h]);
    const bf16_t* Kp = kT + (size_t)(h * 128) * NTOK + blk * 256;
    const bf16_t* Vp = vT + (size_t)(h * 128) * NTOK + blk * 256;
#pragma unroll 1
    for (int dir = 0; dir < 2; ++dir) {
      const float sa = dir ? 0.f : l2f * 255.f, sb = dir ? l2b : -l2f;
      f32x4 acc[4][4];
      acc_zero(acc);
      if (blk < 16) {
        gemm_kloop<1>(acc, Vp, NTOK, Kp, NTOK, 256, smem, sa, sb);
        float* dst = p.out + (dir ? OUT_SB : OUT_SF) + (size_t)(blk * 4 + h) * 16384;
        epilogue(acc, [&](int m, int n, float (&v)[16]) { st_f32x16(dst + n * 128 + m, v); });
      } else {
        gemm_kloop<1>(acc, Kp, NTOK, Vp, NTOK, 256, smem, sa, sb);
        float* dst = (dir ? Ub : Uf) + (size_t)((blk - 16) * 4 + h) * 16384;
        epilogue(acc, [&](int m, int n, float (&v)[16]) { st_f32x16(dst + n * 128 + m, v); });
      }
    }
  }
}

DI void phase4(const Params& p) {
  char* ws = p.ws;
  const float* Uf = (const float*)(ws + OFF_UF);
  const float* Ub = (const float*)(ws + OFF_UB);
  bf16_t* Sf = (bf16_t*)(ws + OFF_SF);
  bf16_t* Sb = (bf16_t*)(ws + OFF_SB);
  for (int idx = blockIdx.x * 256 + threadIdx.x; idx < (1 << 20); idx += gridDim.x * 256) {
    int d = idx & 127, e = (idx >> 7) & 127, h = (idx >> 14) & 3, b = (idx >> 16) & 7, dir = idx >> 19;
    size_t eo = (size_t)e * 128 + d;
    if (dir == 0) {
      float cf = exp2f(log2gamma(p.lg_f[h]) * 256.f);
      float S = p.st_f[(size_t)(b * 4 + h) * 16384 + d * 128 + e];
#pragma unroll
      for (int blk = 0; blk < 8; ++blk) {
        size_t o = (size_t)((b * 8 + blk) * 4 + h) * 16384 + eo;
        Sf[o] = (bf16_t)f2bf(S);
        S = cf * S + Uf[o];
      }
    } else {
      float cb = exp2f(log2gamma(p.lg_b[h]) * 256.f);
      float S = p.st_b[(size_t)(b * 4 + h) * 16384 + d * 128 + e];
#pragma unroll
      for (int blk = 7; blk >= 0; --blk) {
        size_t o = (size_t)((b * 8 + blk) * 4 + h) * 16384 + eo;
        Sb[o] = (bf16_t)f2bf(S);
        S = cb * S + Ub[o];
      }
    }
  }
}

DI bf16x8 scale_frag(bf16x8 q, float s) {
  u32x4 u = __builtin_bit_cast(u32x4, q);
#pragma unroll
  for (int i = 0; i < 4; ++i) u[i] = pack2(bflo(u[i]) * s, bfhi(u[i]) * s);
  return __builtin_bit_cast(bf16x8, u);
}
constexpr int NQT = 1;
DI void phase5(const Params& p, char* smem) {
  char* ws = p.ws;
  const bf16_t* rq = (const bf16_t*)(ws + OFF_RQ);
  const bf16_t* rk = (const bf16_t*)(ws + OFF_RK);
  const bf16_t* vT = (const bf16_t*)(ws + OFF_VT);
  const bf16_t* srg = (const bf16_t*)(ws + OFF_SRG);
  const bf16_t* Sf = (const bf16_t*)(ws + OFF_SF);
  const bf16_t* Sb = (const bf16_t*)(ws + OFF_SB);
  bf16_t* ret = (bf16_t*)(ws + OFF_RET);
  bf16_t* Ks = (bf16_t*)smem;
  bf16_t* Vs = Ks + 64 * 136;
  const int tid = threadIdx.x, lane = tid & 63, w = tid >> 6, l15 = lane & 15, g = lane >> 4;
  for (int item = vbid(); item < 640 * (2 / NQT); item += gridDim.x) {
    const int qb = item >> 2, h = item & 3, blk = (qb * NQT) >> 2;
    const float l2f = log2gamma(p.lg_f[h]), l2b = log2gamma(p.lg_b[h]);
    const int tokw = qb * (64 * NQT) + w * (16 * NQT);
    bf16x8 Q[NQT][4];
#pragma unroll
    for (int qt = 0; qt < NQT; ++qt)
#pragma unroll
      for (int ks = 0; ks < 4; ++ks)
        Q[qt][ks] = *(const bf16x8*)(rq + (size_t)(tokw + qt * 16 + l15) * 512 + h * 128 + ks * 32 + g * 8);
    f32x4 o[8][NQT];
#pragma unroll
    for (int et = 0; et < 8; ++et)
#pragma unroll
      for (int qt = 0; qt < NQT; ++qt) o[et][qt] = f32x4{0.f, 0.f, 0.f, 0.f};
#pragma unroll 1
    for (int kt = 0; kt < 4; ++kt) {
      const int key0 = blk * 256 + kt * 64;
      __syncthreads();
#pragma unroll
      for (int i = 0; i < 4; ++i) {
        int c = tid + 256 * i;
        int r = c >> 4, cc = (c & 15) * 8;
        *(u32x4*)(Ks + r * 136 + cc) = *(const u32x4*)(rk + (size_t)(key0 + r) * 512 + h * 128 + cc);
        int e = c >> 3, c2 = (c & 7) * 8;
        *(u32x4*)(Vs + e * 72 + c2) = *(const u32x4*)(vT + (size_t)(h * 128 + e) * NTOK + key0 + c2);
      }
      __syncthreads();
      bf16x8 P[NQT][2];
#pragma unroll
      for (int qt = 0; qt < NQT; ++qt) {
        f32x4 s[4];
#pragma unroll
        for (int kk = 0; kk < 4; ++kk) s[kk] = f32x4{0.f, 0.f, 0.f, 0.f};
#pragma unroll
        for (int ks = 0; ks < 4; ++ks) {
#pragma unroll
          for (int kk = 0; kk < 4; ++kk) {
            bf16x8 a = *(const bf16x8*)(Ks + (kk * 16 + l15) * 136 + ks * 32 + g * 8);
            s[kk] = __builtin_amdgcn_mfma_f32_16x16x32_bf16(a, Q[qt][ks], s[kk], 0, 0, 0);
          }
        }
        const int iq = (tokw + qt * 16 + l15) & 255;
#pragma unroll
        for (int kk = 0; kk < 4; ++kk) {
#pragma unroll
          for (int j = 0; j < 4; ++j) {
            int jk = kt * 64 + kk * 16 + 4 * g + j;
            int diff = iq - jk;
            float dm = diff > 0 ? ex2(l2f * (float)diff) : (diff < 0 ? ex2(l2b * (float)(-diff)) : 2.f);
            s[kk][j] *= dm;
          }
        }
#pragma unroll
        for (int k2 = 0; k2 < 2; ++k2) {
          u32x4 u;
          u[0] = pack2(s[2 * k2][0], s[2 * k2][1]);
          u[1] = pack2(s[2 * k2][2], s[2 * k2][3]);
          u[2] = pack2(s[2 * k2 + 1][0], s[2 * k2 + 1][1]);
          u[3] = pack2(s[2 * k2 + 1][2], s[2 * k2 + 1][3]);
          P[qt][k2] = __builtin_bit_cast(bf16x8, u);
        }
      }
#pragma unroll
      for (int k2 = 0; k2 < 2; ++k2) {
#pragma unroll
        for (int et = 0; et < 8; ++et) {
          u32x2 lo = *(const u32x2*)(Vs + (et * 16 + l15) * 72 + k2 * 32 + 4 * g);
          u32x2 hi = *(const u32x2*)(Vs + (et * 16 + l15) * 72 + k2 * 32 + 16 + 4 * g);
          u32x4 u;
          u[0] = lo[0]; u[1] = lo[1]; u[2] = hi[0]; u[3] = hi[1];
          bf16x8 a = __builtin_bit_cast(bf16x8, u);
#pragma unroll
          for (int qt = 0; qt < NQT; ++qt) o[et][qt] = __builtin_amdgcn_mfma_f32_16x16x32_bf16(a, P[qt][k2], o[et][qt], 0, 0, 0);
        }
      }
    }
    if (blk >= 16) {
#pragma unroll 1
      for (int dir = 0; dir < 2; ++dir) {
        const bf16_t* S = (dir ? Sb : Sf) + (size_t)((blk - 16) * 4 + h) * 16384;
        float dq[NQT];
#pragma unroll
        for (int qt = 0; qt < NQT; ++qt) {
          int iq = (tokw + qt * 16 + l15) & 255;
          dq[qt] = dir ? exp2f(l2b * (float)(256 - iq)) : exp2f(l2f * (float)(iq + 1));
        }
#pragma unroll
        for (int ks = 0; ks < 4; ++ks) {
          bf16x8 qs[NQT];
#pragma unroll
          for (int qt = 0; qt < NQT; ++qt) qs[qt] = scale_frag(Q[qt][ks], dq[qt]);
#pragma unroll
          for (int et = 0; et < 8; ++et) {
            bf16x8 a = *(const bf16x8*)(S + (size_t)(et * 16 + l15) * 128 + ks * 32 + g * 8);
#pragma unroll
            for (int qt = 0; qt < NQT; ++qt) o[et][qt] = __builtin_amdgcn_mfma_f32_16x16x32_bf16(a, qs[qt], o[et][qt], 0, 0, 0);
          }
        }
      }
    }
#pragma unroll
    for (int qt = 0; qt < NQT; ++qt) {
      const int tok = tokw + qt * 16 + l15;
      float s1 = 0.f;
#pragma unroll
      for (int et = 0; et < 8; ++et)
#pragma unroll
        for (int j = 0; j < 4; ++j) s1 += o[et][qt][j];
      s1 += __shfl_xor(s1, 16);
      s1 += __shfl_xor(s1, 32);
      const float mu = s1 * (1.f / 128.f);
      float s2 = 0.f;
#pragma unroll
      for (int et = 0; et < 8; ++et)
#pragma unroll
        for (int j = 0; j < 4; ++j) {
          float dlt = o[et][qt][j] - mu;
          s2 += dlt * dlt;
        }
      s2 += __shfl_xor(s2, 16);
      s2 += __shfl_xor(s2, 32);
      const float rstd = rsqrtf(s2 * (1.f / 128.f) + 1e-6f);
#pragma unroll
      for (int et = 0; et < 8; ++et) {
        const int e = h * 128 + et * 16 + 4 * g;
        float4 gn = *(const float4*)(p.ret_gn + e);
        u32x2 sg = *(const u32x2*)(srg + (size_t)tok * 512 + e);
        u32x2 ov;
        ov[0] = pack2((o[et][qt][0] - mu) * rstd * gn.x * bflo(sg[0]), (o[et][qt][1] - mu) * rstd * gn.y * bfhi(sg[0]));
        ov[1] = pack2((o[et][qt][2] - mu) * rstd * gn.z * bflo(sg[1]), (o[et][qt][3] - mu) * rstd * gn.w * bfhi(sg[1]));
        *(u32x2*)(ret + (size_t)tok * 512 + e) = ov;
      }
    }
  }
}

DI void phase6(const Params& p, char* smem) {
  char* ws = p.ws;
  const bf16_t* cqn = (const bf16_t*)(ws + OFF_CQ);
  const bf16_t* wuqT = (const bf16_t*)(ws + OFF_WUQT);
  bf16_t* q = (bf16_t*)(ws + OFF_Q);
  for (int it = 0;; ++it) {
    int ft, tt;
    if (!tile_map(it, 6, 160, 1, ft, tt)) break;
    f32x4 acc[4][4];
    acc_zero(acc);
    gemm_kloop<0>(acc, wuqT + (size_t)ft * 128 * 256, 256, cqn + (size_t)tt * 128 * 256, 256, 256, smem, 0.f, 0.f);
    epilogue(acc, [&](int m, int n, float (&v)[16]) { st_bf16x16(q + (size_t)(tt * 128 + n) * 768 + ft * 128 + m, v); });
  }
  const bf16_t* ckvall = (const bf16_t*)(ws + OFF_CKVALL);
  const bf16_t* wukvT = (const bf16_t*)(ws + OFF_WUKVT);
  bf16_t* Kn = (bf16_t*)(ws + OFF_KN);
  bf16_t* Vt = (bf16_t*)(ws + OFF_VTA);
  for (int it = 0;; ++it) {
    int ft, tt;
    if (!tile_map(it, 8, 192, 1, ft, tt)) break;
    f32x4 acc[4][4];
    acc_zero(acc);
    const bf16_t* W = wukvT + (size_t)ft * 128 * 128;
    const bf16_t* X = ckvall + (size_t)tt * 128 * 128;
    if (ft < 4) {
      gemm_kloop<0>(acc, W, 128, X, 128, 128, smem, 0.f, 0.f);
      epilogue(acc, [&](int m, int n, float (&v)[16]) { st_bf16x16(Kn + (size_t)(tt * 128 + n) * 512 + ft * 128 + m, v); });
    } else {
      gemm_kloop<0>(acc, X, 128, W, 128, 128, smem, 0.f, 0.f);
      epilogue(acc, [&](int m, int n, float (&v)[16]) { st_bf16x16(Vt + (size_t)((ft - 4) * 128 + n) * NKV + tt * 128 + m, v); });
    }
  }
}

DI void phase7(const Params& p, char* smem) {
  char* ws = p.ws;
  const bf16_t* q = (const bf16_t*)(ws + OFF_Q);
  const bf16_t* Kn = (const bf16_t*)(ws + OFF_KN);
  const bf16_t* Vt = (const bf16_t*)(ws + OFF_VTA);
  const bf16_t* krall = (const bf16_t*)(ws + OFF_KRALL);
  bf16_t* attn = (bf16_t*)(ws + OFF_ATTN);
  bf16_t* Ks = (bf16_t*)smem;
  bf16_t* Vs = Ks + 64 * 104;
  const int tid = threadIdx.x, lane = tid & 63, w = tid >> 6, l15 = lane & 15, g = lane >> 4;
  const float qscale = 0.10206207261596577f * 1.4426950408889634f;
  for (int item = vbid(); item < 1280; item += gridDim.x) {
    int b, h, qtok0, keyrow0, nkt;
    bool sample;
    if (item < 1024) {
      sample = true; b = item >> 7; h = (item >> 4) & 7; int qb = item & 15;
      qtok0 = NPT + b * 2048 + qb * 128; keyrow0 = NPT + b * 2560; nkt = 40;
    } else {
      int it2 = item - 1024;
      sample = false; b = it2 >> 4; h = (it2 >> 1) & 7; int qb = it2 & 1;
      qtok0 = b * 256 + qb * 128; keyrow0 = b * 256; nkt = 4;
    }
    bf16x8 Q[2][3];
#pragma unroll
    for (int qt = 0; qt < 2; ++qt) {
      const int tokq = qtok0 + w * 32 + qt * 16 + l15;
      const bf16_t* qp = q + (size_t)tokq * 768 + h * 96;
#pragma unroll
      for (int ks = 0; ks < 3; ++ks) {
        u32x4 u = *(const u32x4*)(qp + ks * 32 + g * 8);
        float v[8];
#pragma unroll
        for (int i = 0; i < 4; ++i) { v[2 * i] = bflo(u[i]); v[2 * i + 1] = bfhi(u[i]); }
        if (ks == 2 && sample) {
          u32x4 up = *(const u32x4*)(qp + 64 + (g ^ 2) * 8);
          float pv[8];
#pragma unroll
          for (int i = 0; i < 4; ++i) { pv[2 * i] = bflo(up[i]); pv[2 * i + 1] = bfhi(up[i]); }
          int t = (tokq - NPT) & 2047;
          float pos = (g & 1) ? (float)(t & 63) : (float)(t >> 6);
#pragma unroll
          for (int i = 0; i < 8; ++i) {
            float fr = exp2f(-(float)i * 1.6609640474436813f);
            float sn, cs;
            sincosf(pos * fr, &sn, &cs);
            v[i] = g < 2 ? v[i] * cs - pv[i] * sn : pv[i] * sn + v[i] * cs;
          }
        }
        u32x4 o4;
#pragma unroll
        for (int i = 0; i < 4; ++i) o4[i] = pack2(v[2 * i] * qscale, v[2 * i + 1] * qscale);
        Q[qt][ks] = __builtin_bit_cast(bf16x8, o4);
      }
    }
    f32x4 o[4][2];
#pragma unroll
    for (int et = 0; et < 4; ++et)
#pragma unroll
      for (int qt = 0; qt < 2; ++qt) o[et][qt] = f32x4{0.f, 0.f, 0.f, 0.f};
    float mrun[2] = {-1e30f, -1e30f}, lrun[2] = {0.f, 0.f};
    u32x4 rk_[3], rv_[2];
    auto gload = [&](int kt) {
      const int row0 = keyrow0 + kt * 64;
#pragma unroll
      for (int i = 0; i < 3; ++i) {
        int c = tid + 256 * i;
        int r = c / 12, cc = c - r * 12;
        rk_[i] = cc < 8 ? *(const u32x4*)(Kn + (size_t)(row0 + r) * 512 + h * 64 + cc * 8)
                        : *(const u32x4*)(krall + (size_t)(row0 + r) * 32 + (cc - 8) * 8);
      }
#pragma unroll
      for (int i = 0; i < 2; ++i) {
        int c = tid + 256 * i;
        int e = c >> 3, cc = (c & 7) * 8;
        rv_[i] = *(const u32x4*)(Vt + (size_t)(h * 64 + e) * NKV + row0 + cc);
      }
    };
    gload(0);
#pragma unroll 1
    for (int kt = 0; kt < nkt; ++kt) {
      __syncthreads();
#pragma unroll
      for (int i = 0; i < 3; ++i) {
        int c = tid + 256 * i;
        int r = c / 12, cc = c - r * 12;
        *(u32x4*)(Ks + r * 104 + cc * 8) = rk_[i];
      }
#pragma unroll
      for (int i = 0; i < 2; ++i) {
        int c = tid + 256 * i;
        int e = c >> 3, cc = (c & 7) * 8;
        *(u32x4*)(Vs + e * 72 + cc) = rv_[i];
      }
      __syncthreads();
      if (kt + 1 < nkt) gload(kt + 1);
      f32x4 s[4][2];
#pragma unroll
      for (int kk = 0; kk < 4; ++kk)
#pragma unroll
        for (int qt = 0; qt < 2; ++qt) s[kk][qt] = f32x4{0.f, 0.f, 0.f, 0.f};
#pragma unroll
      for (int ks = 0; ks < 3; ++ks) {
#pragma unroll
        for (int kk = 0; kk < 4; ++kk) {
          bf16x8 a = *(const bf16x8*)(Ks + (kk * 16 + l15) * 104 + ks * 32 + g * 8);
#pragma unroll
          for (int qt = 0; qt < 2; ++qt) s[kk][qt] = __builtin_amdgcn_mfma_f32_16x16x32_bf16(a, Q[qt][ks], s[kk][qt], 0, 0, 0);
        }
      }
      bf16x8 P[2][2];
#pragma unroll
      for (int qt = 0; qt < 2; ++qt) {
        float mx = s[0][qt][0];
#pragma unroll
        for (int kk = 0; kk < 4; ++kk)
#pragma unroll
          for (int j = 0; j < 4; ++j) mx = fmaxf(mx, s[kk][qt][j]);
        mx = fmaxf(mx, __shfl_xor(mx, 16));
        mx = fmaxf(mx, __shfl_xor(mx, 32));
        const float mnew = fmaxf(mrun[qt], mx);
        const float alpha = ex2(mrun[qt] - mnew);
        mrun[qt] = mnew;
        float ps = 0.f;
#pragma unroll
        for (int kk = 0; kk < 4; ++kk)
#pragma unroll
          for (int j = 0; j < 4; ++j) {
            float e_ = ex2(s[kk][qt][j] - mnew);
            s[kk][qt][j] = e_;
            ps += e_;
          }
        lrun[qt] = lrun[qt] * alpha + ps;
#pragma unroll
        for (int et = 0; et < 4; ++et)
#pragma unroll
          for (int j = 0; j < 4; ++j) o[et][qt][j] *= alpha;
#pragma unroll
        for (int k2 = 0; k2 < 2; ++k2) {
          u32x4 u;
          u[0] = pack2(s[2 * k2][qt][0], s[2 * k2][qt][1]);
          u[1] = pack2(s[2 * k2][qt][2], s[2 * k2][qt][3]);
          u[2] = pack2(s[2 * k2 + 1][qt][0], s[2 * k2 + 1][qt][1]);
          u[3] = pack2(s[2 * k2 + 1][qt][2], s[2 * k2 + 1][qt][3]);
          P[qt][k2] = __builtin_bit_cast(bf16x8, u);
        }
      }
#pragma unroll
      for (int k2 = 0; k2 < 2; ++k2) {
#pragma unroll
        for (int et = 0; et < 4; ++et) {
          u32x2 lo = *(const u32x2*)(Vs + (et * 16 + l15) * 72 + k2 * 32 + 4 * g);
          u32x2 hi = *(const u32x2*)(Vs + (et * 16 + l15) * 72 + k2 * 32 + 16 + 4 * g);
          u32x4 u;
          u[0] = lo[0]; u[1] = lo[1]; u[2] = hi[0]; u[3] = hi[1];
          bf16x8 a = __builtin_bit_cast(bf16x8, u);
#pragma unroll
          for (int qt = 0; qt < 2; ++qt) o[et][qt] = __builtin_amdgcn_mfma_f32_16x16x32_bf16(a, P[qt][k2], o[et][qt], 0, 0, 0);
        }
      }
    }
#pragma unroll
    for (int qt = 0; qt < 2; ++qt) {
      const int tokq = qtok0 + w * 32 + qt * 16 + l15;
      float lt = lrun[qt];
      lt += __shfl_xor(lt, 16);
      lt += __shfl_xor(lt, 32);
      const float inv = 1.f / lt;
#pragma unroll
      for (int et = 0; et < 4; ++et) {
        u32x2 ov;
        ov[0] = pack2(o[et][qt][0] * inv, o[et][qt][1] * inv);
        ov[1] = pack2(o[et][qt][2] * inv, o[et][qt][3] * inv);
        *(u32x2*)(attn + (size_t)tokq * 512 + h * 64 + et * 16 + 4 * g) = ov;
      }
    }
  }
}

DI void phase8(const Params& p, char* smem) {
  char* ws = p.ws;
  const bf16_t* attn = (const bf16_t*)(ws + OFF_ATTN);
  const bf16_t* ret = (const bf16_t*)(ws + OFF_RET);
  const bf16_t* wa = (const bf16_t*)(ws + OFF_WUPAT);
  const bf16_t* wb = (const bf16_t*)(ws + OFF_WUPBT);
  const bf16_t* sga = (const bf16_t*)p.out;
  const bf16_t* sgb = sga + (size_t)NTOK * 1024;
  bf16_t* mbuf = (bf16_t*)(ws + OFF_M);
  const int tid = threadIdx.x, lane = tid & 63, w = tid >> 6, wm = w >> 1, wn = w & 1, l15 = lane & 15, g = lane >> 4;
  for (int it = 0;; ++it) {
    int ft, tt;
    if (!tile_map(it, 8, 160, 1, ft, tt)) break;
    f32x4 acc[4][4];
    acc_zero(acc);
    gemm_kloop<0>(acc, wa + (size_t)ft * 128 * 512, 512, attn + (size_t)tt * 128 * 512, 512, 512, smem, 0.f, 0.f);
#pragma unroll
    for (int c = 0; c < 4; ++c) {
      const size_t off = (size_t)(tt * 128 + wn * 64 + c * 16 + l15) * 1024 + ft * 128 + wm * 64 + 16 * g;
      float a[16], bq[16];
      ld_bf16x16(sga + off, a);
      ld_bf16x16(sgb + off, bq);
#pragma unroll
      for (int f = 0; f < 4; ++f)
#pragma unroll
        for (int j = 0; j < 4; ++j) acc[f][c][j] *= a[f * 4 + j] / fmaxf(bq[f * 4 + j], 1e-30f);
    }
    gemm_kloop<0>(acc, wb + (size_t)ft * 128 * 512, 512, ret + (size_t)tt * 128 * 512, 512, 512, smem, 0.f, 0.f);
    epilogue(acc, [&](int m, int n, float (&v)[16]) {
      const size_t off = (size_t)(tt * 128 + n) * 1024 + ft * 128 + m;
      float bq[16];
      ld_bf16x16(sgb + off, bq);
#pragma unroll
      for (int i = 0; i < 16; ++i) v[i] *= bq[i];
      st_bf16x16(mbuf + off, v);
    });
  }
}
DI void phase9(const Params& p, char* smem) {
  char* ws = p.ws;
  const bf16_t* mbuf = (const bf16_t*)(ws + OFF_M);
  const bf16_t* wo = (const bf16_t*)(ws + OFF_WOT);
  const float* mod = (const float*)(ws + OFF_MOD);
  for (int it = 0;; ++it) {
    int ft, tt;
    if (!tile_map(it, 8, 160, 1, ft, tt)) break;
    f32x4 acc[4][4];
    acc_zero(acc);
    gemm_kloop<0>(acc, wo + (size_t)ft * 128 * 1024, 1024, mbuf + (size_t)tt * 128 * 1024, 1024, 1024, smem, 0.f, 0.f);
    epilogue(acc, [&](int m, int n, float (&v)[16]) {
      const int tok = tt * 128 + n, feat = ft * 128 + m;
      const float* xr = xrow(p, tok) + feat;
      const float* g1 = mod + modidx(tok) * 6144 + 2048 + feat;
#pragma unroll
      for (int i = 0; i < 4; ++i) {
        float4 xv = *(const float4*)(xr + 4 * i), gv = *(const float4*)(g1 + 4 * i);
        v[4 * i] = xv.x + gv.x * v[4 * i];
        v[4 * i + 1] = xv.y + gv.y * v[4 * i + 1];
        v[4 * i + 2] = xv.z + gv.z * v[4 * i + 2];
        v[4 * i + 3] = xv.w + gv.w * v[4 * i + 3];
      }
      st_f32x16(p.out + (size_t)tok * DM + feat, v);
    });
  }
}
DI void conv_fp8_rows(const float* __restrict__ src, unsigned char* __restrict__ dst, float* __restrict__ inv) {
  const int lane = threadIdx.x & 63, w = threadIdx.x >> 6;
  for (int r = blockIdx.x * 4 + w; r < 16384; r += gridDim.x * 4) {
    const float* sp = src + (size_t)r * 1024 + lane * 16;
    float4 v[4];
    float am = 0.f;
#pragma unroll
    for (int i = 0; i < 4; ++i) {
      v[i] = *(const float4*)(sp + 4 * i);
      am = fmaxf(am, fmaxf(fmaxf(fabsf(v[i].x), fabsf(v[i].y)), fmaxf(fabsf(v[i].z), fabsf(v[i].w))));
    }
#pragma unroll
    for (int o = 32; o > 0; o >>= 1) am = fmaxf(am, __shfl_xor(am, o));
    const float sc = am > 0.f ? 448.f / am : 1.f;
    u32x4 o4;
#pragma unroll
    for (int i = 0; i < 4; ++i) {
      int wd = 0;
      wd = __builtin_amdgcn_cvt_pk_fp8_f32(v[i].x * sc, v[i].y * sc, wd, false);
      wd = __builtin_amdgcn_cvt_pk_fp8_f32(v[i].z * sc, v[i].w * sc, wd, true);
      o4[i] = (unsigned)wd;
    }
    *(u32x4*)(dst + ((size_t)(lane >> 3) * 16384 + r) * 128 + (lane & 7) * 16) = o4;
    if (lane == 0) inv[r] = am > 0.f ? am * (1.f / 448.f) : 1.f;
  }
}
DI void phase10(const Params& p, char* smem) {
  rows_norm_mod(p, p.norm_ffn, 3072, 4096, true, (bf16_t*)(p.ws + OFF_H2));
  conv_fp8_rows(p.peer_u, (unsigned char*)(p.ws + OFF_TABU), (float*)(p.ws + OFF_INVU));
  conv_fp8_rows(p.peer_v, (unsigned char*)(p.ws + OFF_TABV), (float*)(p.ws + OFF_INVV));
}
DI void phase11(const Params& p, char* smem) {
  char* ws = p.ws;
  const bf16_t* h2 = (const bf16_t*)(ws + OFF_H2);
  const bf16_t* wct = (const bf16_t*)(ws + OFF_WCT);
  bf16_t* sc = (bf16_t*)(ws + OFF_SCORES);
  for (int it = 0;; ++it) {
    int ft, tt;
    if (!tile_map(it, 16, 160, 2, ft, tt)) break;
    f32x4 acc[4][4];
    acc_zero(acc);
    gemm_kloop<0>(acc, wct + (size_t)ft * 128 * 1024, 1024, h2 + (size_t)tt * 128 * 1024, 1024, 1024, smem, 0.f, 0.f);
    epilogue(acc, [&](int m, int n, float (&v)[16]) { st_bf16x16(sc + (size_t)(tt * 128 + n) * 2048 + ft * 128 + m, v); });
  }
}

DI unsigned okey(float f) {
  unsigned u = __float_as_uint(f);
  return (u & 0x80000000u) ? ~u : (u | 0x80000000u);
}
DI void wave_lds_sync() {
  __builtin_amdgcn_fence(__ATOMIC_ACQ_REL, "workgroup");
  __builtin_amdgcn_wave_barrier();
}
DI unsigned okey16(unsigned b) { return (b & 0x8000u) ? (~b & 0xFFFFu) : (b | 0x8000u); }
DI unsigned inv_okey16(unsigned k) { return (k & 0x8000u) ? (k & 0x7FFFu) : (~k & 0xFFFFu); }
DI unsigned inv_okey(unsigned k) { return (k & 0x80000000u) ? (k & 0x7FFFFFFFu) : ~k; }
DI void ins16(unsigned (&L)[16], unsigned x) {
#pragma unroll
  for (int i = 0; i < 16; ++i) {
    unsigned t = max(L[i], x);
    x = min(L[i], x);
    L[i] = t;
  }
}
DI unsigned sel16(const unsigned (&A)[16], int i) {
  unsigned r = 0u;
#pragma unroll
  for (int t = 0; t < 16; ++t) r |= A[t] & (0u - (unsigned)(i == t));
  return r;
}
DI void phase12(const Params& p, char* smem) {
  char* ws = p.ws;
  const bf16_t* sc = (const bf16_t*)(ws + OFF_SCORES);
  int* elist = (int*)(ws + OFF_ELIST);
  float* glist = (float*)(ws + OFF_GLIST);
  const int lane = threadIdx.x & 63, w = threadIdx.x >> 6;
  for (int batch = blockIdx.x * 4 + w; batch < NTOK / 4; batch += gridDim.x * 4) {
    const int tok = batch * 4 + (lane >> 4), hh = lane & 15;
    const bf16_t* row = sc + (size_t)tok * 2048 + hh * 128;
    unsigned L[16];
#pragma unroll
    for (int i = 0; i < 16; ++i) L[i] = 0u;
#pragma unroll
    for (int c = 0; c < 16; ++c) {
      u32x4 u = *(const u32x4*)(row + c * 8);
#pragma unroll
      for (int i = 0; i < 4; ++i) {
        unsigned b0 = u[i] & 0xFFFFu, b1 = u[i] >> 16;
        ins16(L, (okey16(b0) << 16) | (unsigned)(127 - (c * 8 + 2 * i)));
        ins16(L, (okey16(b1) << 16) | (unsigned)(127 - (c * 8 + 2 * i + 1)));
      }
    }
    unsigned M[16];
#pragma unroll
    for (int i = 0; i < 16; ++i) M[i] = (unsigned)__shfl_xor((int)L[i], 1);
    float v1[16], v2[16];
#pragma unroll
    for (int i = 0; i < 16; ++i) {
      v1[i] = bf2f(inv_okey16(L[i] >> 16));
      v2[i] = bf2f(inv_okey16(M[i] >> 16));
    }
    unsigned C[16];
#pragma unroll
    for (int i = 0; i < 16; ++i) C[i] = 0u;
    ins16(C, (okey(v1[0] + v2[0]) & 0xFFFFFF00u) | 255u);
    ins16(C, (okey(v1[0] + v2[1]) & 0xFFFFFF00u) | 254u);
    ins16(C, (okey(v1[0] + v2[2]) & 0xFFFFFF00u) | 253u);
    ins16(C, (okey(v1[0] + v2[3]) & 0xFFFFFF00u) | 252u);
    ins16(C, (okey(v1[0] + v2[4]) & 0xFFFFFF00u) | 251u);
    ins16(C, (okey(v1[0] + v2[5]) & 0xFFFFFF00u) | 250u);
    ins16(C, (okey(v1[0] + v2[6]) & 0xFFFFFF00u) | 249u);
    ins16(C, (okey(v1[0] + v2[7]) & 0xFFFFFF00u) | 248u);
    ins16(C, (okey(v1[0] + v2[8]) & 0xFFFFFF00u) | 247u);
    ins16(C, (okey(v1[0] + v2[9]) & 0xFFFFFF00u) | 246u);
    ins16(C, (okey(v1[0] + v2[10]) & 0xFFFFFF00u) | 245u);
    ins16(C, (okey(v1[0] + v2[11]) & 0xFFFFFF00u) | 244u);
    ins16(C, (okey(v1[0] + v2[12]) & 0xFFFFFF00u) | 243u);
    ins16(C, (okey(v1[0] + v2[13]) & 0xFFFFFF00u) | 242u);
    ins16(C, (okey(v1[0] + v2[14]) & 0xFFFFFF00u) | 241u);
    ins16(C, (okey(v1[0] + v2[15]) & 0xFFFFFF00u) | 240u);
    ins16(C, (okey(v1[1] + v2[0]) & 0xFFFFFF00u) | 239u);
    ins16(C, (okey(v1[1] + v2[1]) & 0xFFFFFF00u) | 238u);
    ins16(C, (okey(v1[1] + v2[2]) & 0xFFFFFF00u) | 237u);
    ins16(C, (okey(v1[1] + v2[3]) & 0xFFFFFF00u) | 236u);
    ins16(C, (okey(v1[1] + v2[4]) & 0xFFFFFF00u) | 235u);
    ins16(C, (okey(v1[1] + v2[5]) & 0xFFFFFF00u) | 234u);
    ins16(C, (okey(v1[1] + v2[6]) & 0xFFFFFF00u) | 233u);
    ins16(C, (okey(v1[1] + v2[7]) & 0xFFFFFF00u) | 232u);
    ins16(C, (okey(v1[2] + v2[0]) & 0xFFFFFF00u) | 223u);
    ins16(C, (okey(v1[2] + v2[1]) & 0xFFFFFF00u) | 222u);
    ins16(C, (okey(v1[2] + v2[2]) & 0xFFFFFF00u) | 221u);
    ins16(C, (okey(v1[2] + v2[3]) & 0xFFFFFF00u) | 220u);
    ins16(C, (okey(v1[2] + v2[4]) & 0xFFFFFF00u) | 219u);
    ins16(C, (okey(v1[3] + v2[0]) & 0xFFFFFF00u) | 207u);
    ins16(C, (okey(v1[3] + v2[1]) & 0xFFFFFF00u) | 206u);
    ins16(C, (okey(v1[3] + v2[2]) & 0xFFFFFF00u) | 205u);
    ins16(C, (okey(v1[3] + v2[3]) & 0xFFFFFF00u) | 204u);
    ins16(C, (okey(v1[4] + v2[0]) & 0xFFFFFF00u) | 191u);
    ins16(C, (okey(v1[4] + v2[1]) & 0xFFFFFF00u) | 190u);
    ins16(C, (okey(v1[4] + v2[2]) & 0xFFFFFF00u) | 189u);
    ins16(C, (okey(v1[5] + v2[0]) & 0xFFFFFF00u) | 175u);
    ins16(C, (okey(v1[5] + v2[1]) & 0xFFFFFF00u) | 174u);
    ins16(C, (okey(v1[6] + v2[0]) & 0xFFFFFF00u) | 159u);
    ins16(C, (okey(v1[6] + v2[1]) & 0xFFFFFF00u) | 158u);
    ins16(C, (okey(v1[7] + v2[0]) & 0xFFFFFF00u) | 143u);
    ins16(C, (okey(v1[7] + v2[1]) & 0xFFFFFF00u) | 142u);
    ins16(C, (okey(v1[8] + v2[0]) & 0xFFFFFF00u) | 127u);
    ins16(C, (okey(v1[9] + v2[0]) & 0xFFFFFF00u) | 111u);
    ins16(C, (okey(v1[10] + v2[0]) & 0xFFFFFF00u) | 95u);
    ins16(C, (okey(v1[11] + v2[0]) & 0xFFFFFF00u) | 79u);
    ins16(C, (okey(v1[12] + v2[0]) & 0xFFFFFF00u) | 63u);
    ins16(C, (okey(v1[13] + v2[0]) & 0xFFFFFF00u) | 47u);
    ins16(C, (okey(v1[14] + v2[0]) & 0xFFFFFF00u) | 31u);
    ins16(C, (okey(v1[15] + v2[0]) & 0xFFFFFF00u) | 15u);
    int ev[16];
    float gv[16];
    const float mx = __uint_as_float(inv_okey(C[0] & 0xFFFFFF00u));
    float den = 0.f;
#pragma unroll
    for (int k = 0; k < 16; ++k) {
      const int ci = 255 - (int)(C[k] & 0xFFu);
      const unsigned a1 = sel16(L, ci >> 4), a2 = sel16(M, ci & 15);
      ev[k] = (127 - (int)(a1 & 0xFFFFu)) * 128 + (127 - (int)(a2 & 0xFFFFu));
      gv[k] = __expf(__uint_as_float(inv_okey(C[k] & 0xFFFFFF00u)) - mx);
      den += gv[k];
    }
    const float inv = 1.f / den;
    if ((lane & 1) == 0) {
      int* ep = elist + (size_t)tok * 128 + (hh >> 1) * 16;
      float* gp = glist + (size_t)tok * 128 + (hh >> 1) * 16;
#pragma unroll
      for (int k = 0; k < 4; ++k) {
        *(int4*)(ep + 4 * k) = make_int4(ev[4 * k], ev[4 * k + 1], ev[4 * k + 2], ev[4 * k + 3]);
        *(float4*)(gp + 4 * k) = make_float4(gv[4 * k] * inv, gv[4 * k + 1] * inv, gv[4 * k + 2] * inv, gv[4 * k + 3] * inv);
      }
    }
  }
}
using f32x2 = __attribute__((ext_vector_type(2))) float;
DI f32x2 cvt8(unsigned w, bool hi) {
  return hi ? __builtin_amdgcn_cvt_pk_f32_fp8((int)w, true) : __builtin_amdgcn_cvt_pk_f32_fp8((int)w, false);
}
struct SMeta { int e[16]; u32x4 ha, hb; };
template <int MODE>
DI void sl_meta(const Params& p, int t, int s, int grp, int ch, SMeta& m) {
  const int* elist = (const int*)(p.ws + (MODE == 0 ? OFF_ELIST : OFF_GLIST));
#pragma unroll
  for (int i = 0; i < 16; ++i) m.e[i] = elist[(size_t)t * 128 + i * 8 + grp];
  if (MODE == 0) {
    const bf16_t* hq = (const bf16_t*)(p.ws + OFF_H2) + (size_t)t * DM + s * 128 + ch * 16;
    m.ha = *(const u32x4*)hq;
    m.hb = *(const u32x4*)(hq + 8);
  }
}
template <int MODE>
DI void sl_rows(const Params& p, int s, int ch, const SMeta& m, u32x4 (&r)[16]) {
  const unsigned char* tab = (const unsigned char*)(p.ws + (MODE == 0 ? OFF_TABU : OFF_TABV));
#pragma unroll
  for (int i = 0; i < 16; ++i) r[i] = *(const u32x4*)(tab + ((size_t)s * 16384 + (m.e[i] & 0xFFFF)) * 128 + ch * 16);
}
template <int MODE>
DI void sl_compute(const Params& p, int t, int s, int lane, const SMeta& m, const u32x4 (&r)[16]) {
  const int grp = lane >> 3, ch = lane & 7;
  if (MODE == 0) {
    f32x2 hp[8];
#pragma unroll
    for (int i = 0; i < 4; ++i) {
      hp[i] = f32x2{bflo(m.ha[i]), bfhi(m.ha[i])};
      hp[4 + i] = f32x2{bflo(m.hb[i]), bfhi(m.hb[i])};
    }
    float keep0 = 0.f, keep1 = 0.f;
#pragma unroll
    for (int i = 0; i < 16; ++i) {
      f32x2 d2 = f32x2{0.f, 0.f};
#pragma unroll
      for (int j = 0; j < 4; ++j) {
        d2 += cvt8(r[i][j], false) * hp[2 * j];
        d2 += cvt8(r[i][j], true) * hp[2 * j + 1];
      }
      float d = d2[0] + d2[1];
      d += __shfl_xor(d, 1);
      d += __shfl_xor(d, 2);
      d += __shfl_xor(d, 4);
      if (i < 8) keep0 = (ch == i) ? d : keep0;
      else keep1 = (ch == i - 8) ? d : keep1;
    }
    float* po = (float*)(p.ws + OFF_PD) + (size_t)t * 1024 + s * 128;
    po[ch * 8 + grp] = keep0;
    po[(ch + 8) * 8 + grp] = keep1;
  } else {
    f32x2 acc[8];
#pragma unroll
    for (int q = 0; q < 8; ++q) acc[q] = f32x2{0.f, 0.f};
#pragma unroll
    for (int i = 0; i < 16; ++i) {
      const float wsc = __uint_as_float((unsigned)m.e[i] & 0xFFFF0000u);
      const f32x2 w2 = f32x2{wsc, wsc};
#pragma unroll
      for (int j = 0; j < 4; ++j) {
        acc[2 * j] += w2 * cvt8(r[i][j], false);
        acc[2 * j + 1] += w2 * cvt8(r[i][j], true);
      }
    }
    float v[16];
#pragma unroll
    for (int q = 0; q < 8; ++q) { v[2 * q] = acc[q][0]; v[2 * q + 1] = acc[q][1]; }
    float q8[8], q4[4], q2[2];
    {
      const bool hi = lane & 32;
#pragma unroll
      for (int i = 0; i < 8; ++i) {
        float send = hi ? v[i] : v[8 + i], keep = hi ? v[8 + i] : v[i];
        q8[i] = keep + __shfl_xor(send, 32);
      }
    }
    {
      const bool hi = lane & 16;
#pragma unroll
      for (int i = 0; i < 4; ++i) {
        float send = hi ? q8[i] : q8[4 + i], keep = hi ? q8[4 + i] : q8[i];
        q4[i] = keep + __shfl_xor(send, 16);
      }
    }
    {
      const bool hi = lane & 8;
#pragma unroll
      for (int i = 0; i < 2; ++i) {
        float send = hi ? q4[i] : q4[2 + i], keep = hi ? q4[2 + i] : q4[i];
        q2[i] = keep + __shfl_xor(send, 8);
      }
    }
    const int f = s * 128 + ch * 16 + 2 * grp;
    float* xr = p.out + (size_t)t * DM + f;
    const float2 xv = *(const float2*)xr;
    const float2 gv = *(const float2*)((const float*)(p.ws + OFF_MOD) + modidx(t) * 6144 + 5120 + f);
    *(float2*)xr = make_float2(xv.x + gv.x * q2[0], xv.y + gv.y * q2[1]);
  }
}
template <int MODE>
DI void sliced_pass(const Params& p) {
  const int s = blockIdx.x & 7, loc = blockIdx.x >> 3, nloc = gridDim.x >> 3;
  if (loc >= nloc) return;
  const int lane = threadIdx.x & 63, w = threadIdx.x >> 6, grp = lane >> 3, ch = lane & 7;
  const int stride = nloc * 4;
  SMeta mA, mB;
  u32x4 rA[16], rB[16];
  int t = loc * 4 + w;
  if (t < NTOK) {
    sl_meta<MODE>(p, t, s, grp, ch, mA);
    sl_rows<MODE>(p, s, ch, mA, rA);
  }
  if (t + stride < NTOK) sl_meta<MODE>(p, t + stride, s, grp, ch, mB);
#pragma unroll 1
  for (; t < NTOK; t += 2 * stride) {
    const int t1 = t + stride, t2 = t + 2 * stride, t3 = t + 3 * stride;
    if (t1 < NTOK) sl_rows<MODE>(p, s, ch, mB, rB);
    sl_compute<MODE>(p, t, s, lane, mA, rA);
    if (t2 < NTOK) sl_meta<MODE>(p, t2, s, grp, ch, mA);
    if (t1 < NTOK) {
      if (t2 < NTOK) sl_rows<MODE>(p, s, ch, mA, rA);
      sl_compute<MODE>(p, t1, s, lane, mB, rB);
      if (t3 < NTOK) sl_meta<MODE>(p, t3, s, grp, ch, mB);
    }
  }
}
DI void phase13(const Params& p) { sliced_pass<0>(p); }
DI void phase14(const Params& p) {
  char* ws = p.ws;
  const float* invU = (const float*)(ws + OFF_INVU);
  const float* invV = (const float*)(ws + OFF_INVV);
  const int* elist = (const int*)(ws + OFF_ELIST);
  float* glist = (float*)(ws + OFF_GLIST);
  const float* pd = (const float*)(ws + OFF_PD);
  const int lane = threadIdx.x & 63, w = threadIdx.x >> 6;
  for (int t = blockIdx.x * 4 + w; t < NTOK; t += gridDim.x * 4) {
#pragma unroll
    for (int hf_ = 0; hf_ < 2; ++hf_) {
      const int k = hf_ * 64 + lane;
      float d = 0.f;
#pragma unroll
      for (int s = 0; s < 8; ++s) d += pd[(size_t)t * 1024 + s * 128 + k];
      const int e = elist[(size_t)t * 128 + k];
      const float g = glist[(size_t)t * 128 + k];
      ((unsigned*)glist)[(size_t)t * 128 + k] = (pack2(0.f, g * geluf_(d * invU[e]) * invV[e]) & 0xFFFF0000u) | (unsigned)e;
    }
  }
}
DI void phase15(const Params& p) { sliced_pass<1>(p); }
DI void phase16(const Params& p) {
  const int lane = threadIdx.x & 63, w = threadIdx.x >> 6;
  for (int tok = blockIdx.x * 4 + w; tok < NTOK; tok += gridDim.x * 4) {
    float* xr = p.out + (size_t)tok * DM;
    float4 xv[4];
    float ss = 0.f;
#pragma unroll
    for (int i = 0; i < 4; ++i) {
      xv[i] = *(const float4*)(xr + (i * 64 + lane) * 4);
      ss += xv[i].x * xv[i].x + xv[i].y * xv[i].y + xv[i].z * xv[i].z + xv[i].w * xv[i].w;
    }
    ss = wsum(ss);
    const float rstd = rsqrtf(ss * (1.f / 1024.f) + 1e-6f);
#pragma unroll
    for (int i = 0; i < 4; ++i) {
      const int e = (i * 64 + lane) * 4;
      float4 nf = *(const float4*)(p.norm_final + e);
      *(float4*)(xr + e) = make_float4(xv[i].x * rstd * nf.x, xv[i].y * rstd * nf.y, xv[i].z * rstd * nf.z, xv[i].w * rstd * nf.w);
    }
  }
}

#define XB_TMO      128
#define XB_XCNT(j)  (256  + 64 * (j))
#define XB_XSUB(j)  (1280 + 64 * (j))
#define XB_XGEN(j)  (2304 + 64 * (j))
#define XB_TOP      3328
#define XB_TOPGEN   3392
#define XCD_BAR_WORDS 3456
#define XB_SPIN_CAP (1u << 22)
#define LAS __attribute__((address_space(3)))
DI unsigned xb_ld(unsigned* p) { return __hip_atomic_load(p, __ATOMIC_RELAXED, __HIP_MEMORY_SCOPE_AGENT); }
DI unsigned xb_add(unsigned* p, unsigned v) { return __hip_atomic_fetch_add(p, v, __ATOMIC_RELAXED, __HIP_MEMORY_SCOPE_AGENT); }
DI unsigned xb_xcc_id() { return (unsigned)__builtin_amdgcn_s_getreg((3 << 11) | 20) & 0xFu; }
#define XB_SPIN(cond, bar) do { unsigned _sp = 0; while (cond) { __builtin_amdgcn_s_sleep(1); \
    if ((++_sp & 255u) == 0u) { if (xb_ld(&(bar)[XB_TMO])) break; if (_sp > XB_SPIN_CAP) { atomicAdd(&(bar)[XB_TMO], 1u); break; } } } } while (0)
struct XcdBarrier { unsigned* bar; unsigned x; volatile LAS unsigned* st; };
DI XcdBarrier xcd_barrier_post(unsigned* bar, volatile LAS unsigned* st) {
  XcdBarrier b; b.bar = bar; b.x = xb_xcc_id(); b.st = st;
  if (threadIdx.x == 0) (void)xb_add(&bar[XB_XCNT(b.x)], 1u);
  return b;
}
DI void xcd_barrier_complete(unsigned* bar, unsigned x, unsigned& nloc, unsigned& nx) {
  const unsigned G = gridDim.x * gridDim.y * gridDim.z;
  unsigned sum, cnt, mine, sp = 0u;
  for (;;) {
    sum = 0u; cnt = 0u; mine = 0u;
#pragma unroll
    for (unsigned j = 0; j < 16; ++j) { const unsigned c = xb_ld(&bar[XB_XCNT(j)]); sum += c; cnt += (c > 0u) ? 1u : 0u; mine = (j == x) ? c : mine; }
    if (sum == G) break;
    __builtin_amdgcn_s_sleep(1);
    if ((++sp & 255u) == 0u) { if (xb_ld(&bar[XB_TMO])) break; if (sp > XB_SPIN_CAP) { atomicAdd(&bar[XB_TMO], 1u); break; } }
  }
  nloc = mine > 0u ? mine : 1u; nx = cnt > 0u ? cnt : 1u;
}
DI void xcd_barrier(const XcdBarrier& b) {
  asm volatile("s_waitcnt vmcnt(0)" ::: "memory");
  __syncthreads();
  if (threadIdx.x == 0) {
    unsigned* bar = b.bar;
    __builtin_amdgcn_s_waitcnt(0);
    unsigned nloc = b.st[0], nx = b.st[1];
    if (nloc == 0u) { xcd_barrier_complete(bar, b.x, nloc, nx); b.st[0] = nloc; b.st[1] = nx; }
    const unsigned old = xb_add(&bar[XB_XSUB(b.x)], 1u);
    const unsigned gen = old / nloc;
    if (old + 1u == (gen + 1u) * nloc) {
      __builtin_amdgcn_fence(__ATOMIC_RELEASE, "agent");
      asm volatile("s_waitcnt vmcnt(0)" ::: "memory");
      const unsigned og = xb_add(&bar[XB_TOP], 1u);
      const unsigned tg = og / nx;
      if (og + 1u == (tg + 1u) * nx) xb_add(&bar[XB_TOPGEN], 1u);
      else XB_SPIN(xb_ld(&bar[XB_TOPGEN]) == tg, bar);
      __builtin_amdgcn_fence(__ATOMIC_ACQUIRE, "agent");
      xb_add(&bar[XB_XGEN(b.x)], 1u);
      asm volatile("s_waitcnt vmcnt(0)" ::: "memory");
    } else {
      XB_SPIN(xb_ld(&bar[XB_XGEN(b.x)]) == gen, bar);
      __builtin_amdgcn_fence(__ATOMIC_ACQUIRE, "agent");
      asm volatile("s_waitcnt vmcnt(0)" ::: "memory");
    }
  }
  __syncthreads();
}

#ifdef ONLY_PHASE
#define RUNPH(n, call) if (ONLY_PHASE == n) { call; }
#else
#ifndef DUP_PHASE
#define DUP_PHASE -1
#endif
#define RUNPH(n, call) if (lo <= n && n < hi) { call; if (n == DUP_PHASE) { xcd_barrier(xb); call; } if (n + 1 < hi) xcd_barrier(xb); }
#endif
__global__ void __launch_bounds__(256, 2) mega(Params p, int lo, int hi) {
  __shared__ __attribute__((aligned(16))) char smem[SMEM_BYTES];
  __shared__ uint4 xb_words;
  cg::grid_group grid = cg::this_grid();
  if (lo < 0) grid.sync();
  if (threadIdx.x == 0) xb_words = make_uint4(0u, 0u, 0u, 0u);
  __syncthreads();
  XcdBarrier xb = xcd_barrier_post((unsigned*)(p.ws + OFF_BAR), (volatile LAS unsigned*)&xb_words);
  RUNPH(0, phase0(p, smem))
  RUNPH(1, phase1(p, smem))
  RUNPH(2, phase2(p, smem))
  RUNPH(3, phase3(p, smem))
  RUNPH(4, phase4(p))
  RUNPH(5, phase5(p, smem))
  RUNPH(6, phase6(p, smem))
  RUNPH(7, phase7(p, smem))
  RUNPH(8, phase8(p, smem))
  RUNPH(9, phase9(p, smem))
  RUNPH(10, phase10(p, smem))
  RUNPH(11, phase11(p, smem))
  RUNPH(12, phase12(p, smem))
  RUNPH(13, phase13(p))
  RUNPH(14, phase14(p))
  RUNPH(15, phase15(p))
  RUNPH(16, phase16(p))
}

extern "C" void kernel_launch(void* const* d_in, const int* in_sizes, int n_in, void* d_out, int out_size, void* d_ws,
                              size_t ws_size, hipStream_t stream) {
  static int grid_blocks = 0;
  if (!grid_blocks) {
    int dev = 0, cus = 0, per_cu = 0;
    hipGetDevice(&dev);
    hipDeviceGetAttribute(&cus, hipDeviceAttributeMultiprocessorCount, dev);
    hipOccupancyMaxActiveBlocksPerMultiprocessor(&per_cu, mega, 256, 0);
    if (per_cu > 2) per_cu = 2;
    if (per_cu < 1) per_cu = 1;
    grid_blocks = cus * per_cu;
  }
  Params p{};
  const float** pp = (const float**)&p;
  for (int i = 0; i < 29; ++i) pp[i] = (const float*)d_in[i];
  p.out = (float*)d_out;
  p.ws = (char*)d_ws;
#if N_LAUNCH_SPLIT
  for (int ph = 0; ph < NPHASE; ++ph) {
    hipLaunchKernelGGL(mega, dim3(grid_blocks), dim3(256), 0, stream, p, ph, ph + 1);
  }
#else
  hipMemsetAsync((char*)d_ws + OFF_MOD, 0, (OFF_BAR - OFF_MOD) + XCD_BAR_WORDS * sizeof(unsigned), stream);
  int lo = 0, hi = NPHASE;
  void* args[] = {&p, &lo, &hi};
  hipError_t e = hipLaunchCooperativeKernel((void*)mega, dim3(grid_blocks), dim3(256), args, 0, stream);
  if (e != hipSuccess) fprintf(stderr, "cooperative launch failed: %s (grid %d)\n", hipGetErrorString(e), grid_blocks);
#endif
}
```

```cpp
#include <hip/hip_runtime.h>
#include <hip/hip_cooperative_groups.h>
#include <cstdio>
namespace cg = cooperative_groups;

#define DI __device__ __forceinline__
typedef unsigned short bf16_t;
using bf16x8 = __attribute__((ext_vector_type(8))) short;
using f32x4 = __attribute__((ext_vector_type(4))) float;
using u32x4 = __attribute__((ext_vector_type(4))) unsigned;
using u32x2 = __attribute__((ext_vector_type(2))) unsigned;

#ifndef N_LAUNCH_SPLIT
#define N_LAUNCH_SPLIT 0
#endif

constexpr int NTOK = 20480, NPT = 4096, DM = 1024;
constexpr int NPHASE = 17;
constexpr size_t MiB = 1u << 20;
constexpr size_t OFF_WINT = 0, OFF_WUQT = 9 * MiB, OFF_WUKVT = 9 * MiB + 512 * 1024, OFF_WUPAT = 10 * MiB,
                 OFF_WUPBT = 11 * MiB, OFF_WOT = 12 * MiB, OFF_WCT = 14 * MiB, OFF_WPQB = 18 * MiB,
                 OFF_KEYSB = 22 * MiB, OFF_MOD = 22 * MiB + 512 * 1024, OFF_BAR = 22 * MiB + 768 * 1024, A0 = 24 * MiB;
constexpr size_t OFF_PD = A0 + 104 * MiB, OFF_H1 = A0 + 0, OFF_CQ = A0 + 40 * MiB, OFF_CKVRAW = A0 + 50 * MiB, OFF_KRRAW = A0 + 60 * MiB,
                 OFF_RQ = A0 + 63 * MiB, OFF_RK = A0 + 83 * MiB, OFF_KT = A0 + 103 * MiB, OFF_VT = A0 + 123 * MiB,
                 OFF_SRG = A0 + 143 * MiB, OFF_CKVALL = A0 + 163 * MiB, OFF_KRALL = A0 + 169 * MiB,
                 OFF_UF = A0 + 171 * MiB, OFF_UB = A0 + 187 * MiB,
                 OFF_SF = A0 + 0, OFF_SB = A0 + 8 * MiB, OFF_RET = A0 + 16 * MiB,
                 OFF_Q = A0 + 63 * MiB, OFF_KN = A0 + 93 * MiB, OFF_VTA = A0 + 117 * MiB, OFF_ATTN = A0 + 141 * MiB,
                 OFF_M = A0 + 163 * MiB,
                 OFF_H2 = A0 + 0, OFF_TABU = A0 + 40 * MiB, OFF_TABV = A0 + 56 * MiB, OFF_INVU = A0 + 72 * MiB,
                 OFF_INVV = A0 + 73 * MiB, OFF_ELIST = A0 + 74 * MiB, OFF_GLIST = A0 + 84 * MiB, OFF_SCORES = A0 + 104 * MiB;
constexpr size_t OUT_CKV = 20971520, OUT_KR = 21495808, OUT_SF = 21626880, OUT_SB = 22675456;
constexpr int NKV = 24576;
constexpr int SMEM_BYTES = 73728;

struct Params {
  const float *x_prompt, *x_sample, *c, *cache_ckv, *cache_krope, *st_f, *st_b, *c_ctx, *w_mod, *b_mod, *norm_mix,
      *norm_ffn, *norm_final, *w_in, *q_norm, *kv_norm, *w_uq, *w_ukv, *lg_f, *lg_b, *ret_gn, *w_up_a, *w_up_b, *w_o,
      *peer_wq, *keys1, *keys2, *peer_u, *peer_v;
  float* out;
  char* ws;
};

DI unsigned f2bf(float x) {
  unsigned u = __float_as_uint(x);
  u += 0x7fffu + ((u >> 16) & 1u);
  return u >> 16;
}
DI float bf2f(unsigned b) { return __uint_as_float(b << 16); }
typedef __bf16 hbf16x2_t __attribute__((ext_vector_type(2)));
typedef float hf32x2_t __attribute__((ext_vector_type(2)));
DI unsigned pack2(float a, float b) {
  hf32x2_t f = {a, b};
  return __builtin_bit_cast(unsigned, __builtin_convertvector(f, hbf16x2_t));
}
DI float ex2(float x) { return __builtin_amdgcn_exp2f(x); }
DI float bflo(unsigned u) { return __uint_as_float(u << 16); }
DI float bfhi(unsigned u) { return __uint_as_float(u & 0xffff0000u); }
DI float wsum(float v) {
#pragma unroll
  for (int o = 32; o > 0; o >>= 1) v += __shfl_xor(v, o);
  return v;
}
DI float sigmoidf_(float x) { return 1.f / (1.f + __expf(-x)); }
DI float siluf_(float x) { return x / (1.f + __expf(-x)); }
DI float geluf_(float x) { return 0.5f * x * (1.f + tanhf(0.7978845608028654f * (x + 0.044715f * x * x * x))); }
DI const float* xrow(const Params& p, int tok) {
  return tok < NPT ? p.x_prompt + (size_t)tok * DM : p.x_sample + (size_t)(tok - NPT) * DM;
}
DI int modidx(int tok) { return tok < NPT ? 0 : 1 + ((tok - NPT) >> 11); }
DI int kvrow(int tok) {
  if (tok < NPT) return tok;
  int t = tok - NPT;
  return NPT + (t >> 11) * 2560 + (t & 2047);
}
DI void st_bf16x16(bf16_t* dst, const float (&v)[16]) {
  u32x4 a, b;
  a[0] = pack2(v[0], v[1]); a[1] = pack2(v[2], v[3]); a[2] = pack2(v[4], v[5]); a[3] = pack2(v[6], v[7]);
  b[0] = pack2(v[8], v[9]); b[1] = pack2(v[10], v[11]); b[2] = pack2(v[12], v[13]); b[3] = pack2(v[14], v[15]);
  *(u32x4*)dst = a;
  *(u32x4*)(dst + 8) = b;
}
DI void st_f32x16(float* dst, const float (&v)[16]) {
#pragma unroll
  for (int i = 0; i < 4; ++i) *(float4*)(dst + 4 * i) = make_float4(v[4 * i], v[4 * i + 1], v[4 * i + 2], v[4 * i + 3]);
}
DI void ld_bf16x16(const bf16_t* src, float (&v)[16]) {
  u32x4 a = *(const u32x4*)src, b = *(const u32x4*)(src + 8);
#pragma unroll
  for (int i = 0; i < 4; ++i) {
    v[2 * i] = bflo(a[i]); v[2 * i + 1] = bfhi(a[i]);
    v[8 + 2 * i] = bflo(b[i]); v[8 + 2 * i + 1] = bfhi(b[i]);
  }
}

constexpr int LDK = 72;
template <int SCALE>
DI void gemm_kloop(f32x4 (&acc)[4][4], const bf16_t* __restrict__ A, int lda, const bf16_t* __restrict__ B, int ldb,
                   int K, char* smem, float sc_a, float sc_b) {
  bf16_t* As = (bf16_t*)smem;
  bf16_t* Bs = As + 128 * LDK;
  const int tid = threadIdx.x, lane = tid & 63, w = tid >> 6, wm = w >> 1, wn = w & 1, l15 = lane & 15, g = lane >> 4;
  u32x4 ra[4], rb[4];
  int arow[4], kc[4], ldsa[4], ldsb[4];
#pragma unroll
  for (int i = 0; i < 4; ++i) {
    int c = tid + 256 * i;
    int r = c >> 3;
    kc[i] = (c & 7) * 8;
    arow[i] = r;
    int rr = r & 63;
    int rho = (r & 64) | (((rr >> 2) & 3) << 4) | ((rr >> 4) << 2) | (rr & 3);
    ldsa[i] = rho * LDK + kc[i];
    ldsb[i] = r * LDK + kc[i];
  }
#pragma unroll
  for (int i = 0; i < 4; ++i) {
    ra[i] = *(const u32x4*)(A + (size_t)arow[i] * lda + kc[i]);
    rb[i] = *(const u32x4*)(B + (size_t)arow[i] * ldb + kc[i]);
  }
  __syncthreads();
#pragma unroll
  for (int i = 0; i < 4; ++i) {
    *(u32x4*)(As + ldsa[i]) = ra[i];
    *(u32x4*)(Bs + ldsb[i]) = rb[i];
  }
  if (64 < K) {
#pragma unroll
    for (int i = 0; i < 4; ++i) {
      ra[i] = *(const u32x4*)(A + (size_t)arow[i] * lda + 64 + kc[i]);
      rb[i] = *(const u32x4*)(B + (size_t)arow[i] * ldb + 64 + kc[i]);
    }
  }
  __syncthreads();
  int buf = 0;
  for (int k0 = 0; k0 < K; k0 += 64, buf ^= 1) {
    const bf16_t* Ac = As + buf * (256 * LDK);
    const bf16_t* Bc = Bs + buf * (256 * LDK);
#pragma unroll
    for (int ks = 0; ks < 2; ++ks) {
      bf16x8 af[4], bfr[4];
#pragma unroll
      for (int f = 0; f < 4; ++f)
        af[f] = *(const bf16x8*)(Ac + (wm * 64 + f * 16 + l15) * LDK + ks * 32 + g * 8);
#pragma unroll
      for (int c = 0; c < 4; ++c)
        bfr[c] = *(const bf16x8*)(Bc + (wn * 64 + c * 16 + l15) * LDK + ks * 32 + g * 8);
      if (SCALE) {
        float fac[8];
#pragma unroll
        for (int i = 0; i < 8; ++i) fac[i] = ex2(sc_a + sc_b * (float)(k0 + ks * 32 + g * 8 + i));
#pragma unroll
        for (int f = 0; f < 4; ++f) {
          u32x4 u = __builtin_bit_cast(u32x4, af[f]);
#pragma unroll
          for (int i = 0; i < 4; ++i) u[i] = pack2(bflo(u[i]) * fac[2 * i], bfhi(u[i]) * fac[2 * i + 1]);
          af[f] = __builtin_bit_cast(bf16x8, u);
        }
      }
#pragma unroll
      for (int f = 0; f < 4; ++f)
#pragma unroll
        for (int c = 0; c < 4; ++c) acc[f][c] = __builtin_amdgcn_mfma_f32_16x16x32_bf16(af[f], bfr[c], acc[f][c], 0, 0, 0);
    }
    if (k0 + 64 < K) {
      bf16_t* An = As + (buf ^ 1) * (256 * LDK);
      bf16_t* Bn = Bs + (buf ^ 1) * (256 * LDK);
#pragma unroll
      for (int i = 0; i < 4; ++i) {
        *(u32x4*)(An + ldsa[i]) = ra[i];
        *(u32x4*)(Bn + ldsb[i]) = rb[i];
      }
      if (k0 + 128 < K) {
#pragma unroll
        for (int i = 0; i < 4; ++i) {
          ra[i] = *(const u32x4*)(A + (size_t)arow[i] * lda + k0 + 128 + kc[i]);
          rb[i] = *(const u32x4*)(B + (size_t)arow[i] * ldb + k0 + 128 + kc[i]);
        }
      }
      __syncthreads();
    }
  }
}
DI void acc_zero(f32x4 (&acc)[4][4]) {
#pragma unroll
  for (int f = 0; f < 4; ++f)
#pragma unroll
    for (int c = 0; c < 4; ++c) acc[f][c] = f32x4{0.f, 0.f, 0.f, 0.f};
}
template <class F>
DI void epilogue(const f32x4 (&acc)[4][4], F&& epi) {
  const int tid = threadIdx.x, lane = tid & 63, w = tid >> 6, wm = w >> 1, wn = w & 1, l15 = lane & 15, g = lane >> 4;
#pragma unroll
  for (int c = 0; c < 4; ++c) {
    float v[16];
#pragma unroll
    for (int f = 0; f < 4; ++f)
#pragma unroll
      for (int j = 0; j < 4; ++j) v[f * 4 + j] = acc[f][c][j];
    epi(wm * 64 + 16 * g, wn * 64 + c * 16 + l15, v);
  }
}
DI bool tile_map(int it, int Ft, int Tt, int fsplit, int& ft, int& tt) {
  const int bid = blockIdx.x, nb = gridDim.x;
  int xcd = bid & 7, loc = bid >> 3, nloc = nb >> 3;
  if (loc >= nloc) return false;
  int fg = xcd % fsplit, tg = xcd / fsplit, tsplit = 8 / fsplit;
  int Fg = Ft / fsplit, Tg = Tt / tsplit;
  int i = loc + it * nloc;
  if (i >= Fg * Tg) return false;
  ft = fg * Fg + i % Fg;
  tt = tg * Tg + i / Fg;
  return true;
}
DI int vbid() {
  const int bid = blockIdx.x, nb = gridDim.x;
  if (nb & 7) return bid;
  return (bid & 7) * (nb >> 3) + (bid >> 3);
}

DI int colmap(int mode, int np) {
  if (mode == 1) return np < 416 ? np : (np < 512 ? -1 : np - 96);
  if (mode == 2) return np < 512 ? ((np >> 6) * 128 + (np & 63)) : (((np - 512) >> 6) * 128 + 64 + ((np - 512) & 63));
  return np;
}
DI void tconv_tile(const float* __restrict__ src, int ldsrc, bf16_t* __restrict__ dst, int K, int kt, int nt, int mode,
                   char* smem) {
  float* lds = (float*)smem;
  const int tid = threadIdx.x;
  {
    int col = tid & 63, rq = tid >> 6;
    int n = colmap(mode, nt * 64 + col);
#pragma unroll 4
    for (int r = 0; r < 16; ++r) {
      int kl = r * 4 + rq;
      float v = n >= 0 ? src[(size_t)(kt * 64 + kl) * ldsrc + n] : 0.f;
      lds[kl * 65 + col] = v;
    }
  }
  __syncthreads();
  {
    int nl = tid >> 2, kq = (tid & 3) * 16;
    float v[16];
#pragma unroll
    for (int i = 0; i < 16; ++i) v[i] = lds[(kq + i) * 65 + nl];
    st_bf16x16(dst + (size_t)(nt * 64 + nl) * K + kt * 64 + kq, v);
  }
  __syncthreads();
}
DI void mod_item(const Params& p, int item, char* smem) {
  float* sil = (float*)smem;
  const int tid = threadIdx.x;
  const int cg_ = item >> 2, slab = item & 3, kbase = slab * 256;
  for (int i = tid; i < 9 * 256; i += 256) {
    int j = i >> 8, k = kbase + (i & 255);
    float cv = j == 0 ? p.c_ctx[k] : p.c[(j - 1) * 1024 + k];
    sil[i] = siluf_(cv);
  }
  __syncthreads();
  const int kq = tid >> 6, nn = tid & 63, n0 = cg_ * 64;
  float acc[9];
#pragma unroll
  for (int j = 0; j < 9; ++j) acc[j] = 0.f;
#pragma unroll 1
  for (int i0 = 0; i0 < 64; i0 += 16) {
    float wv[16];
#pragma unroll
    for (int i = 0; i < 16; ++i) wv[i] = p.w_mod[(size_t)(kbase + kq + 4 * (i0 + i)) * 6144 + n0 + nn];
#pragma unroll
    for (int i = 0; i < 16; ++i)
#pragma unroll
      for (int j = 0; j < 9; ++j) acc[j] += sil[j * 256 + kq + 4 * (i0 + i)] * wv[i];
  }
  __syncthreads();
  float* part = (float*)smem + 9 * 256;
#pragma unroll
  for (int j = 0; j < 9; ++j) part[(kq * 9 + j) * 64 + nn] = acc[j];
  __syncthreads();
  float* mod = (float*)(p.ws + OFF_MOD);
  for (int i = tid; i < 9 * 64; i += 256) {
    int j = i >> 6, n = i & 63;
    float s = part[(0 * 9 + j) * 64 + n] + part[(1 * 9 + j) * 64 + n] + part[(2 * 9 + j) * 64 + n] + part[(3 * 9 + j) * 64 + n];
    if (slab == 0) s += p.b_mod[n0 + n];
    atomicAdd(mod + j * 6144 + n0 + n, s);
  }
  __syncthreads();
}
DI void conv_flat(const float* __restrict__ src, bf16_t* __restrict__ dst, size_t n) {
  size_t i = ((size_t)blockIdx.x * 256 + threadIdx.x) * 8;
  const size_t stride = (size_t)gridDim.x * 256 * 8;
  for (; i < n; i += stride) {
    float4 a = *(const float4*)(src + i), b = *(const float4*)(src + i + 4);
    u32x4 o;
    o[0] = pack2(a.x, a.y); o[1] = pack2(a.z, a.w); o[2] = pack2(b.x, b.y); o[3] = pack2(b.z, b.w);
    *(u32x4*)(dst + i) = o;
  }
}
DI void phase0(const Params& p, char* smem) {
  const int bid = blockIdx.x, nb = gridDim.x;
  char* ws = p.ws;
  const int n_mod = 384;
  const int t_in = 16 * 72, t_uq = 4 * 12, t_ukv = 2 * 16, t_upa = 8 * 16, t_upb = 8 * 16, t_o = 16 * 16;
  const int total = n_mod + t_in + t_uq + t_ukv + t_upa + t_upb + t_o;
  for (int it = bid; it < total; it += nb) {
    int i = it;
    if (i < n_mod) { mod_item(p, i, smem); continue; }
    i -= n_mod;
    if (i < t_in) { tconv_tile(p.w_in, 4512, (bf16_t*)(ws + OFF_WINT), 1024, i / 72, i % 72, 1, smem); continue; }
    i -= t_in;
    if (i < t_uq) { tconv_tile(p.w_uq, 768, (bf16_t*)(ws + OFF_WUQT), 256, i / 12, i % 12, 0, smem); continue; }
    i -= t_uq;
    if (i < t_ukv) { tconv_tile(p.w_ukv, 1024, (bf16_t*)(ws + OFF_WUKVT), 128, i / 16, i % 16, 2, smem); continue; }
    i -= t_ukv;
    if (i < t_upa) { tconv_tile(p.w_up_a, 1024, (bf16_t*)(ws + OFF_WUPAT), 512, i / 16, i % 16, 0, smem); continue; }
    i -= t_upa;
    if (i < t_upb) { tconv_tile(p.w_up_b, 1024, (bf16_t*)(ws + OFF_WUPBT), 512, i / 16, i % 16, 0, smem); continue; }
    i -= t_upb;
    tconv_tile(p.w_o, 1024, (bf16_t*)(ws + OFF_WOT), 1024, i / 16, i % 16, 0, smem);
  }
  conv_flat(p.peer_wq, (bf16_t*)(ws + OFF_WPQB), (size_t)1024 * 2048);
  {
    size_t i = ((size_t)bid * 256 + threadIdx.x) * 8;
    const size_t stride = (size_t)nb * 256 * 8;
    bf16_t* kb = (bf16_t*)(ws + OFF_KEYSB);
    for (; i < (size_t)2 * 131072; i += stride) {
      int half = i >= 131072;
      size_t s = i - (size_t)half * 131072;
      int h = (int)(s >> 14);
      size_t r = s & 16383;
      const float* src = (half ? p.keys2 : p.keys1) + s;
      float4 a = *(const float4*)(src), b = *(const float4*)(src + 4);
      u32x4 o;
      o[0] = pack2(a.x, a.y); o[1] = pack2(a.z, a.w); o[2] = pack2(b.x, b.y); o[3] = pack2(b.z, b.w);
      *(u32x4*)(kb + ((size_t)(h * 2 + half) << 14) + r) = o;
    }
  }
}

DI void rows_norm_mod(const Params& p, const float* nw, int sh_off, int sc_off, bool from_out, bf16_t* dst) {
  const int lane = threadIdx.x & 63, w = threadIdx.x >> 6;
  const float* mod = (const float*)(p.ws + OFF_MOD);
  for (int tok = blockIdx.x * 4 + w; tok < NTOK; tok += gridDim.x * 4) {
    const float* xr = from_out ? p.out + (size_t)tok * DM : xrow(p, tok);
    const float* mj = mod + modidx(tok) * 6144;
    float4 xv[4];
    float ss = 0.f;
#pragma unroll
    for (int i = 0; i < 4; ++i) {
      xv[i] = *(const float4*)(xr + (i * 64 + lane) * 4);
      ss += xv[i].x * xv[i].x + xv[i].y * xv[i].y + xv[i].z * xv[i].z + xv[i].w * xv[i].w;
    }
    ss = wsum(ss);
    float rstd = rsqrtf(ss * (1.f / 1024.f) + 1e-6f);
#pragma unroll
    for (int i = 0; i < 4; ++i) {
      int e = (i * 64 + lane) * 4;
      float4 nv = *(const float4*)(nw + e), sh = *(const float4*)(mj + sh_off + e), sc = *(const float4*)(mj + sc_off + e);
      float h0 = (xv[i].x * rstd) * nv.x * (1.f + sc.x) + sh.x;
      float h1 = (xv[i].y * rstd) * nv.y * (1.f + sc.y) + sh.y;
      float h2 = (xv[i].z * rstd) * nv.z * (1.f + sc.z) + sh.z;
      float h3 = (xv[i].w * rstd) * nv.w * (1.f + sc.w) + sh.w;
      u32x2 o;
      o[0] = pack2(h0, h1); o[1] = pack2(h2, h3);
      *(u32x2*)(dst + (size_t)tok * DM + e) = o;
    }
  }
}
DI void phase1(const Params& p, char* smem) {
  rows_norm_mod(p, p.norm_mix, 0, 1024, false, (bf16_t*)(p.ws + OFF_H1));
  const bf16_t* wpq = (const bf16_t*)(p.ws + OFF_WPQB);
  const bf16_t* kb = (const bf16_t*)(p.ws + OFF_KEYSB);
  bf16_t* wct = (bf16_t*)(p.ws + OFF_WCT);
  for (int it = blockIdx.x; it < 128; it += gridDim.x) {
    int hh = it >> 3, mt = it & 7;
    f32x4 acc[4][4];
    acc_zero(acc);
    gemm_kloop<0>(acc, wpq + (size_t)(mt * 128) * 2048 + hh * 128, 2048, kb + (size_t)hh * 16384, 128, 128, smem, 0.f, 0.f);
    epilogue(acc, [&](int m, int n, float (&v)[16]) { st_bf16x16(wct + (size_t)(hh * 128 + n) * 1024 + mt * 128 + m, v); });
  }
}

DI void phase2(const Params& p, char* smem) {
  char* ws = p.ws;
  const bf16_t* winT = (const bf16_t*)(ws + OFF_WINT);
  const bf16_t* h1 = (const bf16_t*)(ws + OFF_H1);
  bf16_t* cq = (bf16_t*)(ws + OFF_CQ);
  float* ckvraw = (float*)(ws + OFF_CKVRAW);
  float* krraw = (float*)(ws + OFF_KRRAW);
  bf16_t* rq = (bf16_t*)(ws + OFF_RQ);
  bf16_t* rk = (bf16_t*)(ws + OFF_RK);
  bf16_t* kT = (bf16_t*)(ws + OFF_KT);
  bf16_t* vT = (bf16_t*)(ws + OFF_VT);
  bf16_t* srg = (bf16_t*)(ws + OFF_SRG);
  bf16_t* sga = (bf16_t*)p.out;
  bf16_t* sgb = sga + (size_t)NTOK * 1024;
  for (int it = 0;; ++it) {
    int ft, tt;
    if (!tile_map(it, 36, 160, 4, ft, tt)) break;
    f32x4 acc[4][4];
    acc_zero(acc);
    const bf16_t* W = winT + (size_t)ft * 128 * 1024;
    const bf16_t* H = h1 + (size_t)tt * 128 * 1024;
    const int tok0 = tt * 128, f0 = ft * 128;
    if (ft >= 8 && ft < 16) {
      gemm_kloop<0>(acc, H, 1024, W, 1024, 1024, smem, 0.f, 0.f);
      if (ft < 12) {
        epilogue(acc, [&](int m, int n, float (&v)[16]) {
          int feat = f0 - 1024 + n, tok = tok0 + m;
#pragma unroll
          for (int i = 0; i < 16; ++i) v[i] *= 0.08838834764831845f;
          st_bf16x16(kT + (size_t)feat * NTOK + tok, v);
#pragma unroll
          for (int i = 0; i < 16; ++i) rk[(size_t)(tok + i) * 512 + feat] = (bf16_t)f2bf(v[i]);
        });
      } else {
        epilogue(acc, [&](int m, int n, float (&v)[16]) {
          int feat = f0 - 1536 + n, tok = tok0 + m;
          st_bf16x16(vT + (size_t)feat * NTOK + tok, v);
        });
      }
    } else {
      gemm_kloop<0>(acc, W, 1024, H, 1024, 1024, smem, 0.f, 0.f);
      if (ft < 2) {
        epilogue(acc, [&](int m, int n, float (&v)[16]) { st_bf16x16(cq + (size_t)(tok0 + n) * 256 + f0 + m, v); });
      } else if (ft == 2) {
        epilogue(acc, [&](int m, int n, float (&v)[16]) { st_f32x16(ckvraw + (size_t)(tok0 + n) * 128 + m, v); });
      } else if (ft == 3) {
        epilogue(acc, [&](int m, int n, float (&v)[16]) {
          if (m < 32) st_f32x16(krraw + (size_t)(tok0 + n) * 32 + m, v);
        });
      } else if (ft < 8) {
        epilogue(acc, [&](int m, int n, float (&v)[16]) { st_bf16x16(rq + (size_t)(tok0 + n) * 512 + f0 - 512 + m, v); });
      } else if (ft < 20) {
        epilogue(acc, [&](int m, int n, float (&v)[16]) {
#pragma unroll
          for (int i = 0; i < 16; ++i) v[i] = siluf_(v[i]);
          st_bf16x16(srg + (size_t)(tok0 + n) * 512 + f0 - 2048 + m, v);
        });
      } else if (ft < 28) {
        epilogue(acc, [&](int m, int n, float (&v)[16]) {
#pragma unroll
          for (int i = 0; i < 16; ++i) v[i] = sigmoidf_(v[i]);
          st_bf16x16(sga + (size_t)(tok0 + n) * 1024 + f0 - 2560 + m, v);
        });
      } else {
        epilogue(acc, [&](int m, int n, float (&v)[16]) {
#pragma unroll
          for (int i = 0; i < 16; ++i) v[i] = sigmoidf_(v[i]);
          st_bf16x16(sgb + (size_t)(tok0 + n) * 1024 + f0 - 3584 + m, v);
        });
      }
    }
  }
}

DI float log2gamma(float logit) { return -log1pf(expf(-logit)) * 1.4426950408889634f; }
DI void phase3(const Params& p, char* smem) {
  char* ws = p.ws;
  const int lane = threadIdx.x & 63, w = threadIdx.x >> 6;
  bf16_t* cq = (bf16_t*)(ws + OFF_CQ);
  const float* ckvraw = (const float*)(ws + OFF_CKVRAW);
  const float* krraw = (const float*)(ws + OFF_KRRAW);
  bf16_t* ckvall = (bf16_t*)(ws + OFF_CKVALL);
  bf16_t* krall = (bf16_t*)(ws + OFF_KRALL);
  for (int r = blockIdx.x * 4 + w; r < NTOK + 4096; r += gridDim.x * 4) {
    if (r < NTOK) {
      const int tok = r;
      {
        u32x2 u = *(const u32x2*)(cq + (size_t)tok * 256 + lane * 4);
        float a0 = bflo(u[0]), a1 = bfhi(u[0]), a2 = bflo(u[1]), a3 = bfhi(u[1]);
        float ss = wsum(a0 * a0 + a1 * a1 + a2 * a2 + a3 * a3);
        float rstd = rsqrtf(ss * (1.f / 256.f) + 1e-6f);
        float4 nq = *(const float4*)(p.q_norm + lane * 4);
        u32x2 o;
        o[0] = pack2(a0 * rstd * nq.x, a1 * rstd * nq.y);
        o[1] = pack2(a2 * rstd * nq.z, a3 * rstd * nq.w);
        *(u32x2*)(cq + (size_t)tok * 256 + lane * 4) = o;
      }
      const int row = kvrow(tok);
      {
        float2 v = *(const float2*)(ckvraw + (size_t)tok * 128 + lane * 2);
        float ss = wsum(v.x * v.x + v.y * v.y);
        float rstd = rsqrtf(ss * (1.f / 128.f) + 1e-6f);
        float2 nk = *(const float2*)(p.kv_norm + lane * 2);
        float o0 = v.x * rstd * nk.x, o1 = v.y * rstd * nk.y;
        if (tok < NPT) *(float2*)(p.out + OUT_CKV + (size_t)tok * 128 + lane * 2) = make_float2(o0, o1);
        *(unsigned*)(ckvall + (size_t)row * 128 + lane * 2) = pack2(o0, o1);
      }
      if (lane < 32) {
        float own = krraw[(size_t)tok * 32 + lane];
        float o = own;
        if (tok < NPT) {
          p.out[OUT_KR + (size_t)tok * 32 + lane] = own;
        } else {
          float partner = krraw[(size_t)tok * 32 + (lane ^ 16)];
          int t = (tok - NPT) & 2047;
          int a = lane & 15;
          float pos = (a < 8) ? (float)(t >> 6) : (float)(t & 63);
          float fr = exp2f(-(float)(a & 7) * 1.6609640474436813f);
          float sn, cs;
          sincosf(pos * fr, &sn, &cs);
          o = lane < 16 ? own * cs - partner * sn : partner * sn + own * cs;
        }
        krall[(size_t)row * 32 + lane] = (bf16_t)f2bf(o);
      }
    } else {
      const int cr = r - NTOK;
      const int b = cr >> 9, pos = cr & 511;
      const int row = NPT + b * 2560 + 2048 + pos;
      float2 v = *(const float2*)(p.cache_ckv + (size_t)cr * 128 + lane * 2);
      *(unsigned*)(ckvall + (size_t)row * 128 + lane * 2) = pack2(v.x, v.y);
      if (lane < 32) krall[(size_t)row * 32 + lane] = (bf16_t)f2bf(p.cache_krope[(size_t)cr * 32 + lane]);
    }
  }
  const bf16_t* kT = (const bf16_t*)(ws + OFF_KT);
  const bf16_t* vT = (const bf16_t*)(ws + OFF_VT);
  float* Uf = (float*)(ws + OFF_UF);
  float* Ub = (float*)(ws + OFF_UB);
  for (int it = blockIdx.x; it < 320; it += gridDim.x) {
    const int blk = it >> 2, h = it & 3;
    const float l2f = log2gamma(p.lg_f[h]), l2b = log2gamma(p.lg_b[h]);
    const bf16_t* Kp = kT + (size_t)(h * 128) * NTOK + blk * 256;
    const bf16_t* Vp = vT + (size_t)(h * 128) * NTOK + blk * 256;
#pragma unroll 1
    for (int dir = 0; dir < 2; ++dir) {
      const float sa = dir ? 0.f : l2f * 255.f, sb = dir ? l2b : -l2f;
      f32x4 acc[4][4];
      acc_zero(acc);
      if (blk < 16) {
        gemm_kloop<1>(acc, Vp, NTOK, Kp, NTOK, 256, smem, sa, sb);
        float* dst = p.out + (dir ? OUT_SB : OUT_SF) + (size_t)(blk * 4 + h) * 16384;
        epilogue(acc, [&](int m, int n, float (&v)[16]) { st_f32x16(dst + n * 128 + m, v); });
      } else {
        gemm_kloop<1>(acc, Kp, NTOK, Vp, NTOK, 256, smem, sa, sb);
        float* dst = (dir ? Ub : Uf) + (size_t)((blk - 16) * 4 + h) * 16384;
        epilogue(acc, [&](int m, int n, float (&v)[16]) { st_f32x16(dst + n * 128 + m, v); });
      }
    }
  }
}

DI void phase4(const Params& p) {
  char* ws = p.ws;
  const float* Uf = (const float*)(ws + OFF_UF);
  const float* Ub = (const float*)(ws + OFF_UB);
  bf16_t* Sf = (bf16_t*)(ws + OFF_SF);
  bf16_t* Sb = (bf16_t*)(ws + OFF_SB);
  for (int idx = blockIdx.x * 256 + threadIdx.x; idx < (1 << 20); idx += gridDim.x * 256) {
    int d = idx & 127, e = (idx >> 7) & 127, h = (idx >> 14) & 3, b = (idx >> 16) & 7, dir = idx >> 19;
    size_t eo = (size_t)e * 128 + d;
    if (dir == 0) {
      float cf = exp2f(log2gamma(p.lg_f[h]) * 256.f);
      float S = p.st_f[(size_t)(b * 4 + h) * 16384 + d * 128 + e];
#pragma unroll
      for (int blk = 0; blk < 8; ++blk) {
        size_t o = (size_t)((b * 8 + blk) * 4 + h) * 16384 + eo;
        Sf[o] = (bf16_t)f2bf(S);
        S = cf * S + Uf[o];
      }
    } else {
      float cb = exp2f(log2gamma(p.lg_b[h]) * 256.f);
      float S = p.st_b[(size_t)(b * 4 + h) * 16384 + d * 128 + e];
#pragma unroll
      for (int blk = 7; blk >= 0; --blk) {
        size_t o = (size_t)((b * 8 + blk) * 4 + h) * 16384 + eo;
        Sb[o] = (bf16_t)f2bf(S);
        S = cb * S + Ub[o];
      }
    }
  }
}

DI bf16x8 scale_frag(bf16x8 q, float s) {
  u32x4 u = __builtin_bit_cast(u32x4, q);
#pragma unroll
  for (int i = 0; i < 4; ++i) u[i] = pack2(bflo(u[i]) * s, bfhi(u[i]) * s);
  return __builtin_bit_cast(bf16x8, u);
}
constexpr int NQT = 1;
DI void phase5(const Params& p, char* smem) {
  char* ws = p.ws;
  const bf16_t* rq = (const bf16_t*)(ws + OFF_RQ);
  const bf16_t* rk = (const bf16_t*)(ws + OFF_RK);
  const bf16_t* vT = (const bf16_t*)(ws + OFF_VT);
  const bf16_t* srg = (const bf16_t*)(ws + OFF_SRG);
  const bf16_t* Sf = (const bf16_t*)(ws + OFF_SF);
  const bf16_t* Sb = (const bf16_t*)(ws + OFF_SB);
  bf16_t* ret = (bf16_t*)(ws + OFF_RET);
  bf16_t* Ks = (bf16_t*)smem;
  bf16_t* Vs = Ks + 64 * 136;
  const int tid = threadIdx.x, lane = tid & 63, w = tid >> 6, l15 = lane & 15, g = lane >> 4;
  for (int item = vbid(); item < 640 * (2 / NQT); item += gridDim.x) {
    const int qb = item >> 2, h = item & 3, blk = (qb * NQT) >> 2;
    const float l2f = log2gamma(p.lg_f[h]), l2b = log2gamma(p.lg_b[h]);
    const int tokw = qb * (64 * NQT) + w * (16 * NQT);
    bf16x8 Q[NQT][4];
#pragma unroll
    for (int qt = 0; qt < NQT; ++qt)
#pragma unroll
      for (int ks = 0; ks < 4; ++ks)
        Q[qt][ks] = *(const bf16x8*)(rq + (size_t)(tokw + qt * 16 + l15) * 512 + h * 128 + ks * 32 + g * 8);
    f32x4 o[8][NQT];
#pragma unroll
    for (int et = 0; et < 8; ++et)
#pragma unroll
      for (int qt = 0; qt < NQT; ++qt) o[et][qt] = f32x4{0.f, 0.f, 0.f, 0.f};
#pragma unroll 1
    for (int kt = 0; kt < 4; ++kt) {
      const int key0 = blk * 256 + kt * 64;
      __syncthreads();
#pragma unroll
      for (int i = 0; i < 4; ++i) {
        int c = tid + 256 * i;
        int r = c >> 4, cc = (c & 15) * 8;
        *(u32x4*)(Ks + r * 136 + cc) = *(const u32x4*)(rk + (size_t)(key0 + r) * 512 + h * 128 + cc);
        int e = c >> 3, c2 = (c & 7) * 8;
        *(u32x4*)(Vs + e * 72 + c2) = *(const u32x4*)(vT + (size_t)(h * 128 + e) * NTOK + key0 + c2);
      }
      __syncthreads();
      bf16x8 P[NQT][2];
#pragma unroll
      for (int qt = 0; qt < NQT; ++qt) {
        f32x4 s[4];
#pragma unroll
        for (int kk = 0; kk < 4; ++kk) s[kk] = f32x4{0.f, 0.f, 0.f, 0.f};
#pragma unroll
        for (int ks = 0; ks < 4; ++ks) {
#pragma unroll
          for (int kk = 0; kk < 4; ++kk) {
            bf16x8 a = *(const bf16x8*)(Ks + (kk * 16 + l15) * 136 + ks * 32 + g * 8);
            s[kk] = __builtin_amdgcn_mfma_f32_16x16x32_bf16(a, Q[qt][ks], s[kk], 0, 0, 0);
          }
        }
        const int iq = (tokw + qt * 16 + l15) & 255;
#pragma unroll
        for (int kk = 0; kk < 4; ++kk) {
#pragma unroll
          for (int j = 0; j < 4; ++j) {
            int jk = kt * 64 + kk * 16 + 4 * g + j;
            int diff = iq - jk;
            float dm = diff > 0 ? ex2(l2f * (float)diff) : (diff < 0 ? ex2(l2b * (float)(-diff)) : 2.f);
            s[kk][j] *= dm;
          }
        }
#pragma unroll
        for (int k2 = 0; k2 < 2; ++k2) {
          u32x4 u;
          u[0] = pack2(s[2 * k2][0], s[2 * k2][1]);
          u[1] = pack2(s[2 * k2][2], s[2 * k2][3]);
          u[2] = pack2(s[2 * k2 + 1][0], s[2 * k2 + 1][1]);
          u[3] = pack2(s[2 * k2 + 1][2], s[2 * k2 + 1][3]);
          P[qt][k2] = __builtin_bit_cast(bf16x8, u);
        }
      }
#pragma unroll
      for (int k2 = 0; k2 < 2; ++k2) {
#pragma unroll
        for (int et = 0; et < 8; ++et) {
          u32x2 lo = *(const u32x2*)(Vs + (et * 16 + l15) * 72 + k2 * 32 + 4 * g);
          u32x2 hi = *(const u32x2*)(Vs + (et * 16 + l15) * 72 + k2 * 32 + 16 + 4 * g);
          u32x4 u;
          u[0] = lo[0]; u[1] = lo[1]; u[2] = hi[0]; u[3] = hi[1];
          bf16x8 a = __builtin_bit_cast(bf16x8, u);
#pragma unroll
          for (int qt = 0; qt < NQT; ++qt) o[et][qt] = __builtin_amdgcn_mfma_f32_16x16x32_bf16(a, P[qt][k2], o[et][qt], 0, 0, 0);
        }
      }
    }
    if (blk >= 16) {
#pragma unroll 1
      for (int dir = 0; dir < 2; ++dir) {
        const bf16_t* S = (dir ? Sb : Sf) + (size_t)((blk - 16) * 4 + h) * 16384;
        float dq[NQT];
#pragma unroll
        for (int qt = 0; qt < NQT; ++qt) {
          int iq = (tokw + qt * 16 + l15) & 255;
          dq[qt] = dir ? exp2f(l2b * (float)(256 - iq)) : exp2f(l2f * (float)(iq + 1));
        }
#pragma unroll
        for (int ks = 0; ks < 4; ++ks) {
          bf16x8 qs[NQT];
#pragma unroll
          for (int qt = 0; qt < NQT; ++qt) qs[qt] = scale_frag(Q[qt][ks], dq[qt]);
#pragma unroll
          for (int et = 0; et < 8; ++et) {
            bf16x8 a = *(const bf16x8*)(S + (size_t)(et * 16 + l15) * 128 + ks * 32 + g * 8);
#pragma unroll
            for (int qt = 0; qt < NQT; ++qt) o[et][qt] = __builtin_amdgcn_mfma_f32_16x16x32_bf16(a, qs[qt], o[et][qt], 0, 0, 0);
          }
        }
      }
    }
#pragma unroll
    for (int qt = 0; qt < NQT; ++qt) {
      const int tok = tokw + qt * 16 + l15;
      float s1 = 0.f;
#pragma unroll
      for (int et = 0; et < 8; ++et)
#pragma unroll
        for (int j = 0; j < 4; ++j) s1 += o[et][qt][j];
      s1 += __shfl_xor(s1, 16);
      s1 += __shfl_xor(s1, 32);
      const float mu = s1 * (1.f / 128.f);
      float s2 = 0.f;
#pragma unroll
      for (int et = 0; et < 8; ++et)
#pragma unroll
        for (int j = 0; j < 4; ++j) {
          float dlt = o[et][qt][j] - mu;
          s2 += dlt * dlt;
        }
      s2 += __shfl_xor(s2, 16);
      s2 += __shfl_xor(s2, 32);
      const float rstd = rsqrtf(s2 * (1.f / 128.f) + 1e-6f);
#pragma unroll
      for (int et = 0; et < 8; ++et) {
        const int e = h * 128 + et * 16 + 4 * g;
        float4 gn = *(const float4*)(p.ret_gn + e);
        u32x2 sg = *(const u32x2*)(srg + (size_t)tok * 512 + e);
        u32x2 ov;
        ov[0] = pack2((o[et][qt][0] - mu) * rstd * gn.x * bflo(sg[0]), (o[et][qt][1] - mu) * rstd * gn.y * bfhi(sg[0]));
        ov[1] = pack2((o[et][qt][2] - mu) * rstd * gn.z * bflo(sg[1]), (o[et][qt][3] - mu) * rstd * gn.w * bfhi(sg[1]));
        *(u32x2*)(ret + (size_t)tok * 512 + e) = ov;
      }
    }
  }
}

DI void phase6(const Params& p, char* smem) {
  char* ws = p.ws;
  const bf16_t* cqn = (const bf16_t*)(ws + OFF_CQ);
  const bf16_t* wuqT = (const bf16_t*)(ws + OFF_WUQT);
  bf16_t* q = (bf16_t*)(ws + OFF_Q);
  for (int it = 0;; ++it) {
    int ft, tt;
    if (!tile_map(it, 6, 160, 1, ft, tt)) break;
    f32x4 acc[4][4];
    acc_zero(acc);
    gemm_kloop<0>(acc, wuqT + (size_t)ft * 128 * 256, 256, cqn + (size_t)tt * 128 * 256, 256, 256, smem, 0.f, 0.f);
    epilogue(acc, [&](int m, int n, float (&v)[16]) { st_bf16x16(q + (size_t)(tt * 128 + n) * 768 + ft * 128 + m, v); });
  }
  const bf16_t* ckvall = (const bf16_t*)(ws + OFF_CKVALL);
  const bf16_t* wukvT = (const bf16_t*)(ws + OFF_WUKVT);
  bf16_t* Kn = (bf16_t*)(ws + OFF_KN);
  bf16_t* Vt = (bf16_t*)(ws + OFF_VTA);
  for (int it = 0;; ++it) {
    int ft, tt;
    if (!tile_map(it, 8, 192, 1, ft, tt)) break;
    f32x4 acc[4][4];
    acc_zero(acc);
    const bf16_t* W = wukvT + (size_t)ft * 128 * 128;
    const bf16_t* X = ckvall + (size_t)tt * 128 * 128;
    if (ft < 4) {
      gemm_kloop<0>(acc, W, 128, X, 128, 128, smem, 0.f, 0.f);
      epilogue(acc, [&](int m, int n, float (&v)[16]) { st_bf16x16(Kn + (size_t)(tt * 128 + n) * 512 + ft * 128 + m, v); });
    } else {
      gemm_kloop<0>(acc, X, 128, W, 128, 128, smem, 0.f, 0.f);
      epilogue(acc, [&](int m, int n, float (&v)[16]) { st_bf16x16(Vt + (size_t)((ft - 4) * 128 + n) * NKV + tt * 128 + m, v); });
    }
  }
}

DI void phase7(const Params& p, char* smem) {
  char* ws = p.ws;
  const bf16_t* q = (const bf16_t*)(ws + OFF_Q);
  const bf16_t* Kn = (const bf16_t*)(ws + OFF_KN);
  const bf16_t* Vt = (const bf16_t*)(ws + OFF_VTA);
  const bf16_t* krall = (const bf16_t*)(ws + OFF_KRALL);
  bf16_t* attn = (bf16_t*)(ws + OFF_ATTN);
  bf16_t* Ks0 = (bf16_t*)smem;
  const int tid = threadIdx.x, lane = tid & 63, w = tid >> 6, l15 = lane & 15, g = lane >> 4;
  const float qscale = 0.10206207261596577f * 1.4426950408889634f;
  for (int item = vbid(); item < 1280; item += gridDim.x) {
    int b, h, qtok0, keyrow0, nkt;
    bool sample;
    if (item < 1024) {
      sample = true; b = item >> 7; h = (item >> 4) & 7; int qb = item & 15;
      qtok0 = NPT + b * 2048 + qb * 128; keyrow0 = NPT + b * 2560; nkt = 40;
    } else {
      int it2 = item - 1024;
      sample = false; b = it2 >> 4; h = (it2 >> 1) & 7; int qb = it2 & 1;
      qtok0 = b * 256 + qb * 128; keyrow0 = b * 256; nkt = 4;
    }
    bf16x8 Q[2][3];
#pragma unroll
    for (int qt = 0; qt < 2; ++qt) {
      const int tokq = qtok0 + w * 32 + qt * 16 + l15;
      const bf16_t* qp = q + (size_t)tokq * 768 + h * 96;
#pragma unroll
      for (int ks = 0; ks < 3; ++ks) {
        u32x4 u = *(const u32x4*)(qp + ks * 32 + g * 8);
        float v[8];
#pragma unroll
        for (int i = 0; i < 4; ++i) { v[2 * i] = bflo(u[i]); v[2 * i + 1] = bfhi(u[i]); }
        if (ks == 2 && sample) {
          u32x4 up = *(const u32x4*)(qp + 64 + (g ^ 2) * 8);
          float pv[8];
#pragma unroll
          for (int i = 0; i < 4; ++i) { pv[2 * i] = bflo(up[i]); pv[2 * i + 1] = bfhi(up[i]); }
          int t = (tokq - NPT) & 2047;
          float pos = (g & 1) ? (float)(t & 63) : (float)(t >> 6);
#pragma unroll
          for (int i = 0; i < 8; ++i) {
            float fr = exp2f(-(float)i * 1.6609640474436813f);
            float sn, cs;
            sincosf(pos * fr, &sn, &cs);
            v[i] = g < 2 ? v[i] * cs - pv[i] * sn : pv[i] * sn + v[i] * cs;
          }
        }
        u32x4 o4;
#pragma unroll
        for (int i = 0; i < 4; ++i) o4[i] = pack2(v[2 * i] * qscale, v[2 * i + 1] * qscale);
        Q[qt][ks] = __builtin_bit_cast(bf16x8, o4);
      }
    }
    f32x4 o[4][2];
#pragma unroll
    for (int et = 0; et < 4; ++et)
#pragma unroll
      for (int qt = 0; qt < 2; ++qt) o[et][qt] = f32x4{0.f, 0.f, 0.f, 0.f};
    float mrun[2] = {-1e30f, -1e30f}, lrun[2] = {0.f, 0.f};
    u32x4 rk_[3], rv_[2];
    auto gload = [&](int kt) {
      const int row0 = keyrow0 + kt * 64;
#pragma unroll
      for (int i = 0; i < 3; ++i) {
        int c = tid + 256 * i;
        int r = c / 12, cc = c - r * 12;
        rk_[i] = cc < 8 ? *(const u32x4*)(Kn + (size_t)(row0 + r) * 512 + h * 64 + cc * 8)
                        : *(const u32x4*)(krall + (size_t)(row0 + r) * 32 + (cc - 8) * 8);
      }
#pragma unroll
      for (int i = 0; i < 2; ++i) {
        int c = tid + 256 * i;
        int e = c >> 3, cc = (c & 7) * 8;
        rv_[i] = *(const u32x4*)(Vt + (size_t)(h * 64 + e) * NKV + row0 + cc);
      }
    };
    auto lstore = [&](int b) {
      bf16_t* Kd = Ks0 + b * 11264;
      bf16_t* Vd = Kd + 64 * 104;
#pragma unroll
      for (int i = 0; i < 3; ++i) {
        int c = tid + 256 * i;
        int r = c / 12, cc = c - r * 12;
        *(u32x4*)(Kd + r * 104 + cc * 8) = rk_[i];
      }
#pragma unroll
      for (int i = 0; i < 2; ++i) {
        int c = tid + 256 * i;
        int e = c >> 3, cc = (c & 7) * 8;
        *(u32x4*)(Vd + e * 72 + cc) = rv_[i];
      }
    };
    gload(0);
    __syncthreads();
    lstore(0);
    if (nkt > 1) gload(1);
    __syncthreads();
#pragma unroll 1
    for (int kt = 0; kt < nkt; ++kt) {
      const bf16_t* Ks = Ks0 + (kt & 1) * 11264;
      const bf16_t* Vs = Ks + 64 * 104;
      f32x4 s[4][2];
#pragma unroll
      for (int kk = 0; kk < 4; ++kk)
#pragma unroll
        for (int qt = 0; qt < 2; ++qt) s[kk][qt] = f32x4{0.f, 0.f, 0.f, 0.f};
#pragma unroll
      for (int ks = 0; ks < 3; ++ks) {
#pragma unroll
        for (int kk = 0; kk < 4; ++kk) {
          bf16x8 a = *(const bf16x8*)(Ks + (kk * 16 + l15) * 104 + ks * 32 + g * 8);
#pragma unroll
          for (int qt = 0; qt < 2; ++qt) s[kk][qt] = __builtin_amdgcn_mfma_f32_16x16x32_bf16(a, Q[qt][ks], s[kk][qt], 0, 0, 0);
        }
      }
      bf16x8 P[2][2];
#pragma unroll
      for (int qt = 0; qt < 2; ++qt) {
        float mx = s[0][qt][0];
#pragma unroll
        for (int kk = 0; kk < 4; ++kk)
#pragma unroll
          for (int j = 0; j < 4; ++j) mx = fmaxf(mx, s[kk][qt][j]);
        mx = fmaxf(mx, __shfl_xor(mx, 16));
        mx = fmaxf(mx, __shfl_xor(mx, 32));
        const float mnew = fmaxf(mrun[qt], mx);
        const float alpha = ex2(mrun[qt] - mnew);
        mrun[qt] = mnew;
        float ps = 0.f;
#pragma unroll
        for (int kk = 0; kk < 4; ++kk)
#pragma unroll
          for (int j = 0; j < 4; ++j) {
            float e_ = ex2(s[kk][qt][j] - mnew);
            s[kk][qt][j] = e_;
            ps += e_;
          }
        lrun[qt] = lrun[qt] * alpha + ps;
#pragma unroll
        for (int et = 0; et < 4; ++et)
#pragma unroll
          for (int j = 0; j < 4; ++j) o[et][qt][j] *= alpha;
#pragma unroll
        for (int k2 = 0; k2 < 2; ++k2) {
          u32x4 u;
          u[0] = pack2(s[2 * k2][qt][0], s[2 * k2][qt][1]);
          u[1] = pack2(s[2 * k2][qt][2], s[2 * k2][qt][3]);
          u[2] = pack2(s[2 * k2 + 1][qt][0], s[2 * k2 + 1][qt][1]);
          u[3] = pack2(s[2 * k2 + 1][qt][2], s[2 * k2 + 1][qt][3]);
          P[qt][k2] = __builtin_bit_cast(bf16x8, u);
        }
      }
#pragma unroll
      for (int k2 = 0; k2 < 2; ++k2) {
#pragma unroll
        for (int et = 0; et < 4; ++et) {
          u32x2 lo = *(const u32x2*)(Vs + (et * 16 + l15) * 72 + k2 * 32 + 4 * g);
          u32x2 hi = *(const u32x2*)(Vs + (et * 16 + l15) * 72 + k2 * 32 + 16 + 4 * g);
          u32x4 u;
          u[0] = lo[0]; u[1] = lo[1]; u[2] = hi[0]; u[3] = hi[1];
          bf16x8 a = __builtin_bit_cast(bf16x8, u);
#pragma unroll
          for (int qt = 0; qt < 2; ++qt) o[et][qt] = __builtin_amdgcn_mfma_f32_16x16x32_bf16(a, P[qt][k2], o[et][qt], 0, 0, 0);
        }
      }
      if (kt + 1 < nkt) {
        lstore((kt + 1) & 1);
        if (kt + 2 < nkt) gload(kt + 2);
        __syncthreads();
      }
    }
#pragma unroll
    for (int qt = 0; qt < 2; ++qt) {
      const int tokq = qtok0 + w * 32 + qt * 16 + l15;
      float lt = lrun[qt];
      lt += __shfl_xor(lt, 16);
      lt += __shfl_xor(lt, 32);
      const float inv = 1.f / lt;
#pragma unroll
      for (int et = 0; et < 4; ++et) {
        u32x2 ov;
        ov[0] = pack2(o[et][qt][0] * inv, o[et][qt][1] * inv);
        ov[1] = pack2(o[et][qt][2] * inv, o[et][qt][3] * inv);
        *(u32x2*)(attn + (size_t)tokq * 512 + h * 64 + et * 16 + 4 * g) = ov;
      }
    }
  }
}

DI void phase8(const Params& p, char* smem) {
  char* ws = p.ws;
  const bf16_t* attn = (const bf16_t*)(ws + OFF_ATTN);
  const bf16_t* ret = (const bf16_t*)(ws + OFF_RET);
  const bf16_t* wa = (const bf16_t*)(ws + OFF_WUPAT);
  const bf16_t* wb = (const bf16_t*)(ws + OFF_WUPBT);
  const bf16_t* sga = (const bf16_t*)p.out;
  const bf16_t* sgb = sga + (size_t)NTOK * 1024;
  bf16_t* mbuf = (bf16_t*)(ws + OFF_M);
  const int tid = threadIdx.x, lane = tid & 63, w = tid >> 6, wm = w >> 1, wn = w & 1, l15 = lane & 15, g = lane >> 4;
  for (int it = 0;; ++it) {
    int ft, tt;
    if (!tile_map(it, 8, 160, 1, ft, tt)) break;
    f32x4 acc[4][4];
    acc_zero(acc);
    gemm_kloop<0>(acc, wa + (size_t)ft * 128 * 512, 512, attn + (size_t)tt * 128 * 512, 512, 512, smem, 0.f, 0.f);
#pragma unroll
    for (int c = 0; c < 4; ++c) {
      const size_t off = (size_t)(tt * 128 + wn * 64 + c * 16 + l15) * 1024 + ft * 128 + wm * 64 + 16 * g;
      float a[16], bq[16];
      ld_bf16x16(sga + off, a);
      ld_bf16x16(sgb + off, bq);
#pragma unroll
      for (int f = 0; f < 4; ++f)
#pragma unroll
        for (int j = 0; j < 4; ++j) acc[f][c][j] *= a[f * 4 + j] / fmaxf(bq[f * 4 + j], 1e-30f);
    }
    gemm_kloop<0>(acc, wb + (size_t)ft * 128 * 512, 512, ret + (size_t)tt * 128 * 512, 512, 512, smem, 0.f, 0.f);
    epilogue(acc, [&](int m, int n, float (&v)[16]) {
      const size_t off = (size_t)(tt * 128 + n) * 1024 + ft * 128 + m;
      float bq[16];
      ld_bf16x16(sgb + off, bq);
#pragma unroll
      for (int i = 0; i < 16; ++i) v[i] *= bq[i];
      st_bf16x16(mbuf + off, v);
    });
  }
}
DI void phase9(const Params& p, char* smem) {
  char* ws = p.ws;
  const bf16_t* mbuf = (const bf16_t*)(ws + OFF_M);
  const bf16_t* wo = (const bf16_t*)(ws + OFF_WOT);
  const float* mod = (const float*)(ws + OFF_MOD);
  for (int it = 0;; ++it) {
    int ft, tt;
    if (!tile_map(it, 8, 160, 1, ft, tt)) break;
    f32x4 acc[4][4];
    acc_zero(acc);
    gemm_kloop<0>(acc, wo + (size_t)ft * 128 * 1024, 1024, mbuf + (size_t)tt * 128 * 1024, 1024, 1024, smem, 0.f, 0.f);
    epilogue(acc, [&](int m, int n, float (&v)[16]) {
      const int tok = tt * 128 + n, feat = ft * 128 + m;
      const float* xr = xrow(p, tok) + feat;
      const float* g1 = mod + modidx(tok) * 6144 + 2048 + feat;
#pragma unroll
      for (int i = 0; i < 4; ++i) {
        float4 xv = *(const float4*)(xr + 4 * i), gv = *(const float4*)(g1 + 4 * i);
        v[4 * i] = xv.x + gv.x * v[4 * i];
        v[4 * i + 1] = xv.y + gv.y * v[4 * i + 1];
        v[4 * i + 2] = xv.z + gv.z * v[4 * i + 2];
        v[4 * i + 3] = xv.w + gv.w * v[4 * i + 3];
      }
      st_f32x16(p.out + (size_t)tok * DM + feat, v);
    });
  }
}
DI void conv_fp8_rows(const float* __restrict__ src, unsigned char* __restrict__ dst, float* __restrict__ inv) {
  const int lane = threadIdx.x & 63, w = threadIdx.x >> 6;
  for (int r = blockIdx.x * 4 + w; r < 16384; r += gridDim.x * 4) {
    const float* sp = src + (size_t)r * 1024 + lane * 16;
    float4 v[4];
    float am = 0.f;
#pragma unroll
    for (int i = 0; i < 4; ++i) {
      v[i] = *(const float4*)(sp + 4 * i);
      am = fmaxf(am, fmaxf(fmaxf(fabsf(v[i].x), fabsf(v[i].y)), fmaxf(fabsf(v[i].z), fabsf(v[i].w))));
    }
#pragma unroll
    for (int o = 32; o > 0; o >>= 1) am = fmaxf(am, __shfl_xor(am, o));
    const float sc = am > 0.f ? 448.f / am : 1.f;
    u32x4 o4;
#pragma unroll
    for (int i = 0; i < 4; ++i) {
      int wd = 0;
      wd = __builtin_amdgcn_cvt_pk_fp8_f32(v[i].x * sc, v[i].y * sc, wd, false);
      wd = __builtin_amdgcn_cvt_pk_fp8_f32(v[i].z * sc, v[i].w * sc, wd, true);
      o4[i] = (unsigned)wd;
    }
    *(u32x4*)(dst + ((size_t)(lane >> 3) * 16384 + r) * 128 + (lane & 7) * 16) = o4;
    if (lane == 0) inv[r] = am > 0.f ? am * (1.f / 448.f) : 1.f;
  }
}
DI void phase10(const Params& p, char* smem) {
  rows_norm_mod(p, p.norm_ffn, 3072, 4096, true, (bf16_t*)(p.ws + OFF_H2));
  conv_fp8_rows(p.peer_u, (unsigned char*)(p.ws + OFF_TABU), (float*)(p.ws + OFF_INVU));
  conv_fp8_rows(p.peer_v, (unsigned char*)(p.ws + OFF_TABV), (float*)(p.ws + OFF_INVV));
}
DI void phase11(const Params& p, char* smem) {
  char* ws = p.ws;
  const bf16_t* h2 = (const bf16_t*)(ws + OFF_H2);
  const bf16_t* wct = (const bf16_t*)(ws + OFF_WCT);
  bf16_t* sc = (bf16_t*)(ws + OFF_SCORES);
  for (int it = 0;; ++it) {
    int ft, tt;
    if (!tile_map(it, 16, 160, 2, ft, tt)) break;
    f32x4 acc[4][4];
    acc_zero(acc);
    gemm_kloop<0>(acc, wct + (size_t)ft * 128 * 1024, 1024, h2 + (size_t)tt * 128 * 1024, 1024, 1024, smem, 0.f, 0.f);
    epilogue(acc, [&](int m, int n, float (&v)[16]) { st_bf16x16(sc + (size_t)(tt * 128 + n) * 2048 + ft * 128 + m, v); });
  }
}

DI unsigned okey(float f) {
  unsigned u = __float_as_uint(f);
  return (u & 0x80000000u) ? ~u : (u | 0x80000000u);
}
DI void wave_lds_sync() {
  __builtin_amdgcn_fence(__ATOMIC_ACQ_REL, "workgroup");
  __builtin_amdgcn_wave_barrier();
}
DI unsigned okey16(unsigned b) { return (b & 0x8000u) ? (~b & 0xFFFFu) : (b | 0x8000u); }
DI unsigned inv_okey16(unsigned k) { return (k & 0x8000u) ? (k & 0x7FFFu) : (~k & 0xFFFFu); }
DI unsigned inv_okey(unsigned k) { return (k & 0x80000000u) ? (k & 0x7FFFFFFFu) : ~k; }
DI void ins16(unsigned (&L)[16], unsigned x) {
#pragma unroll
  for (int i = 0; i < 16; ++i) {
    unsigned t = max(L[i], x);
    x = min(L[i], x);
    L[i] = t;
  }
}
DI unsigned sel16(const unsigned (&A)[16], int i) {
  unsigned r = 0u;
#pragma unroll
  for (int t = 0; t < 16; ++t) r |= A[t] & (0u - (unsigned)(i == t));
  return r;
}
DI void phase12(const Params& p, char* smem) {
  char* ws = p.ws;
  const bf16_t* sc = (const bf16_t*)(ws + OFF_SCORES);
  int* elist = (int*)(ws + OFF_ELIST);
  float* glist = (float*)(ws + OFF_GLIST);
  const int lane = threadIdx.x & 63, w = threadIdx.x >> 6;
  for (int batch = blockIdx.x * 4 + w; batch < NTOK / 4; batch += gridDim.x * 4) {
    const int tok = batch * 4 + (lane >> 4), hh = lane & 15;
    const bf16_t* row = sc + (size_t)tok * 2048 + hh * 128;
    unsigned L[16];
#pragma unroll
    for (int i = 0; i < 16; ++i) L[i] = 0u;
#pragma unroll
    for (int c = 0; c < 16; ++c) {
      u32x4 u = *(const u32x4*)(row + c * 8);
#pragma unroll
      for (int i = 0; i < 4; ++i) {
        unsigned b0 = u[i] & 0xFFFFu, b1 = u[i] >> 16;
        ins16(L, (okey16(b0) << 16) | (unsigned)(127 - (c * 8 + 2 * i)));
        ins16(L, (okey16(b1) << 16) | (unsigned)(127 - (c * 8 + 2 * i + 1)));
      }
    }
    unsigned M[16];
#pragma unroll
    for (int i = 0; i < 16; ++i) M[i] = (unsigned)__shfl_xor((int)L[i], 1);
    float v1[16], v2[16];
#pragma unroll
    for (int i = 0; i < 16; ++i) {
      v1[i] = bf2f(inv_okey16(L[i] >> 16));
      v2[i] = bf2f(inv_okey16(M[i] >> 16));
    }
    unsigned C[16];
#pragma unroll
    for (int i = 0; i < 16; ++i) C[i] = 0u;
    ins16(C, (okey(v1[0] + v2[0]) & 0xFFFFFF00u) | 255u);
    ins16(C, (okey(v1[0] + v2[1]) & 0xFFFFFF00u) | 254u);
    ins16(C, (okey(v1[0] + v2[2]) & 0xFFFFFF00u) | 253u);
    ins16(C, (okey(v1[0] + v2[3]) & 0xFFFFFF00u) | 252u);
    ins16(C, (okey(v1[0] + v2[4]) & 0xFFFFFF00u) | 251u);
    ins16(C, (okey(v1[0] + v2[5]) & 0xFFFFFF00u) | 250u);
    ins16(C, (okey(v1[0] + v2[6]) & 0xFFFFFF00u) | 249u);
    ins16(C, (okey(v1[0] + v2[7]) & 0xFFFFFF00u) | 248u);
    ins16(C, (okey(v1[0] + v2[8]) & 0xFFFFFF00u) | 247u);
    ins16(C, (okey(v1[0] + v2[9]) & 0xFFFFFF00u) | 246u);
    ins16(C, (okey(v1[0] + v2[10]) & 0xFFFFFF00u) | 245u);
    ins16(C, (okey(v1[0] + v2[11]) & 0xFFFFFF00u) | 244u);
    ins16(C, (okey(v1[0] + v2[12]) & 0xFFFFFF00u) | 243u);
    ins16(C, (okey(v1[0] + v2[13]) & 0xFFFFFF00u) | 242u);
    ins16(C, (okey(v1[0] + v2[14]) & 0xFFFFFF00u) | 241u);
    ins16(C, (okey(v1[0] + v2[15]) & 0xFFFFFF00u) | 240u);
    ins16(C, (okey(v1[1] + v2[0]) & 0xFFFFFF00u) | 239u);
    ins16(C, (okey(v1[1] + v2[1]) & 0xFFFFFF00u) | 238u);
    ins16(C, (okey(v1[1] + v2[2]) & 0xFFFFFF00u) | 237u);
    ins16(C, (okey(v1[1] + v2[3]) & 0xFFFFFF00u) | 236u);
    ins16(C, (okey(v1[1] + v2[4]) & 0xFFFFFF00u) | 235u);
    ins16(C, (okey(v1[1] + v2[5]) & 0xFFFFFF00u) | 234u);
    ins16(C, (okey(v1[1] + v2[6]) & 0xFFFFFF00u) | 233u);
    ins16(C, (okey(v1[1] + v2[7]) & 0xFFFFFF00u) | 232u);
    ins16(C, (okey(v1[2] + v2[0]) & 0xFFFFFF00u) | 223u);
    ins16(C, (okey(v1[2] + v2[1]) & 0xFFFFFF00u) | 222u);
    ins16(C, (okey(v1[2] + v2[2]) & 0xFFFFFF00u) | 221u);
    ins16(C, (okey(v1[2] + v2[3]) & 0xFFFFFF00u) | 220u);
    ins16(C, (okey(v1[2] + v2[4]) & 0xFFFFFF00u) | 219u);
    ins16(C, (okey(v1[3] + v2[0]) & 0xFFFFFF00u) | 207u);
    ins16(C, (okey(v1[3] + v2[1]) & 0xFFFFFF00u) | 206u);
    ins16(C, (okey(v1[3] + v2[2]) & 0xFFFFFF00u) | 205u);
    ins16(C, (okey(v1[3] + v2[3]) & 0xFFFFFF00u) | 204u);
    ins16(C, (okey(v1[4] + v2[0]) & 0xFFFFFF00u) | 191u);
    ins16(C, (okey(v1[4] + v2[1]) & 0xFFFFFF00u) | 190u);
    ins16(C, (okey(v1[4] + v2[2]) & 0xFFFFFF00u) | 189u);
    ins16(C, (okey(v1[5] + v2[0]) & 0xFFFFFF00u) | 175u);
    ins16(C, (okey(v1[5] + v2[1]) & 0xFFFFFF00u) | 174u);
    ins16(C, (okey(v1[6] + v2[0]) & 0xFFFFFF00u) | 159u);
    ins16(C, (okey(v1[6] + v2[1]) & 0xFFFFFF00u) | 158u);
    ins16(C, (okey(v1[7] + v2[0]) & 0xFFFFFF00u) | 143u);
    ins16(C, (okey(v1[7] + v2[1]) & 0xFFFFFF00u) | 142u);
    ins16(C, (okey(v1[8] + v2[0]) & 0xFFFFFF00u) | 127u);
    ins16(C, (okey(v1[9] + v2[0]) & 0xFFFFFF00u) | 111u);
    ins16(C, (okey(v1[10] + v2[0]) & 0xFFFFFF00u) | 95u);
    ins16(C, (okey(v1[11] + v2[0]) & 0xFFFFFF00u) | 79u);
    ins16(C, (okey(v1[12] + v2[0]) & 0xFFFFFF00u) | 63u);
    ins16(C, (okey(v1[13] + v2[0]) & 0xFFFFFF00u) | 47u);
    ins16(C, (okey(v1[14] + v2[0]) & 0xFFFFFF00u) | 31u);
    ins16(C, (okey(v1[15] + v2[0]) & 0xFFFFFF00u) | 15u);
    int ev[16];
    float gv[16];
    const float mx = __uint_as_float(inv_okey(C[0] & 0xFFFFFF00u));
    float den = 0.f;
#pragma unroll
    for (int k = 0; k < 16; ++k) {
      const int ci = 255 - (int)(C[k] & 0xFFu);
      const unsigned a1 = sel16(L, ci >> 4), a2 = sel16(M, ci & 15);
      ev[k] = (127 - (int)(a1 & 0xFFFFu)) * 128 + (127 - (int)(a2 & 0xFFFFu));
      gv[k] = __expf(__uint_as_float(inv_okey(C[k] & 0xFFFFFF00u)) - mx);
      den += gv[k];
    }
    const float inv = 1.f / den;
    if ((lane & 1) == 0) {
      int* ep = elist + (size_t)tok * 128 + (hh >> 1) * 16;
      float* gp = glist + (size_t)tok * 128 + (hh >> 1) * 16;
#pragma unroll
      for (int k = 0; k < 4; ++k) {
        *(int4*)(ep + 4 * k) = make_int4(ev[4 * k], ev[4 * k + 1], ev[4 * k + 2], ev[4 * k + 3]);
        *(float4*)(gp + 4 * k) = make_float4(gv[4 * k] * inv, gv[4 * k + 1] * inv, gv[4 * k + 2] * inv, gv[4 * k + 3] * inv);
      }
    }
  }
}
using f32x2 = __attribute__((ext_vector_type(2))) float;
DI f32x2 cvt8(unsigned w, bool hi) {
  return hi ? __builtin_amdgcn_cvt_pk_f32_fp8((int)w, true) : __builtin_amdgcn_cvt_pk_f32_fp8((int)w, false);
}
struct SMeta { int e[16]; u32x4 ha, hb; };
template <int MODE>
DI void sl_meta(const Params& p, int t, int s, int grp, int ch, SMeta& m) {
  const int* elist = (const int*)(p.ws + (MODE == 0 ? OFF_ELIST : OFF_GLIST));
#pragma unroll
  for (int i = 0; i < 16; ++i) m.e[i] = elist[(size_t)t * 128 + i * 8 + grp];
  if (MODE == 0) {
    const bf16_t* hq = (const bf16_t*)(p.ws + OFF_H2) + (size_t)t * DM + s * 128 + ch * 16;
    m.ha = *(const u32x4*)hq;
    m.hb = *(const u32x4*)(hq + 8);
  }
}
template <int MODE>
DI void sl_rows(const Params& p, int s, int ch, const SMeta& m, u32x4 (&r)[16]) {
  const unsigned char* tab = (const unsigned char*)(p.ws + (MODE == 0 ? OFF_TABU : OFF_TABV));
#pragma unroll
  for (int i = 0; i < 16; ++i) r[i] = *(const u32x4*)(tab + ((size_t)s * 16384 + (m.e[i] & 0xFFFF)) * 128 + ch * 16);
}
template <int MODE>
DI void sl_compute(const Params& p, int t, int s, int lane, const SMeta& m, const u32x4 (&r)[16]) {
  const int grp = lane >> 3, ch = lane & 7;
  if (MODE == 0) {
    f32x2 hp[8];
#pragma unroll
    for (int i = 0; i < 4; ++i) {
      hp[i] = f32x2{bflo(m.ha[i]), bfhi(m.ha[i])};
      hp[4 + i] = f32x2{bflo(m.hb[i]), bfhi(m.hb[i])};
    }
    float keep0 = 0.f, keep1 = 0.f;
#pragma unroll
    for (int i = 0; i < 16; ++i) {
      f32x2 d2 = f32x2{0.f, 0.f};
#pragma unroll
      for (int j = 0; j < 4; ++j) {
        d2 += cvt8(r[i][j], false) * hp[2 * j];
        d2 += cvt8(r[i][j], true) * hp[2 * j + 1];
      }
      float d = d2[0] + d2[1];
      d += __shfl_xor(d, 1);
      d += __shfl_xor(d, 2);
      d += __shfl_xor(d, 4);
      if (i < 8) keep0 = (ch == i) ? d : keep0;
      else keep1 = (ch == i - 8) ? d : keep1;
    }
    float* po = (float*)(p.ws + OFF_PD) + (size_t)t * 1024 + s * 128;
    po[ch * 8 + grp] = keep0;
    po[(ch + 8) * 8 + grp] = keep1;
  } else {
    f32x2 acc[8];
#pragma unroll
    for (int q = 0; q < 8; ++q) acc[q] = f32x2{0.f, 0.f};
#pragma unroll
    for (int i = 0; i < 16; ++i) {
      const float wsc = __uint_as_float((unsigned)m.e[i] & 0xFFFF0000u);
      const f32x2 w2 = f32x2{wsc, wsc};
#pragma unroll
      for (int j = 0; j < 4; ++j) {
        acc[2 * j] += w2 * cvt8(r[i][j], false);
        acc[2 * j + 1] += w2 * cvt8(r[i][j], true);
      }
    }
    float v[16];
#pragma unroll
    for (int q = 0; q < 8; ++q) { v[2 * q] = acc[q][0]; v[2 * q + 1] = acc[q][1]; }
    float q8[8], q4[4], q2[2];
    {
      const bool hi = lane & 32;
#pragma unroll
      for (int i = 0; i < 8; ++i) {
        float send = hi ? v[i] : v[8 + i], keep = hi ? v[8 + i] : v[i];
        q8[i] = keep + __shfl_xor(send, 32);
      }
    }
    {
      const bool hi = lane & 16;
#pragma unroll
      for (int i = 0; i < 4; ++i) {
        float send = hi ? q8[i] : q8[4 + i], keep = hi ? q8[4 + i] : q8[i];
        q4[i] = keep + __shfl_xor(send, 16);
      }
    }
    {
      const bool hi = lane & 8;
#pragma unroll
      for (int i = 0; i < 2; ++i) {
        float send = hi ? q4[i] : q4[2 + i], keep = hi ? q4[2 + i] : q4[i];
        q2[i] = keep + __shfl_xor(send, 8);
      }
    }
    const int f = s * 128 + ch * 16 + 2 * grp;
    float* xr = p.out + (size_t)t * DM + f;
    const float2 xv = *(const float2*)xr;
    const float2 gv = *(const float2*)((const float*)(p.ws + OFF_MOD) + modidx(t) * 6144 + 5120 + f);
    *(float2*)xr = make_float2(xv.x + gv.x * q2[0], xv.y + gv.y * q2[1]);
  }
}
template <int MODE>
DI void sliced_pass(const Params& p) {
  const int s = blockIdx.x & 7, loc = blockIdx.x >> 3, nloc = gridDim.x >> 3;
  if (loc >= nloc) return;
  const int lane = threadIdx.x & 63, w = threadIdx.x >> 6, grp = lane >> 3, ch = lane & 7;
  const int stride = nloc * 4;
  SMeta mA, mB;
  u32x4 rA[16], rB[16];
  int t = loc * 4 + w;
  if (t < NTOK) {
    sl_meta<MODE>(p, t, s, grp, ch, mA);
    sl_rows<MODE>(p, s, ch, mA, rA);
  }
  if (t + stride < NTOK) sl_meta<MODE>(p, t + stride, s, grp, ch, mB);
#pragma unroll 1
  for (; t < NTOK; t += 2 * stride) {
    const int t1 = t + stride, t2 = t + 2 * stride, t3 = t + 3 * stride;
    if (t1 < NTOK) sl_rows<MODE>(p, s, ch, mB, rB);
    sl_compute<MODE>(p, t, s, lane, mA, rA);
    if (t2 < NTOK) sl_meta<MODE>(p, t2, s, grp, ch, mA);
    if (t1 < NTOK) {
      if (t2 < NTOK) sl_rows<MODE>(p, s, ch, mA, rA);
      sl_compute<MODE>(p, t1, s, lane, mB, rB);
      if (t3 < NTOK) sl_meta<MODE>(p, t3, s, grp, ch, mB);
    }
  }
}
DI void phase13(const Params& p) { sliced_pass<0>(p); }
DI void phase14(const Params& p) {
  char* ws = p.ws;
  const float* invU = (const float*)(ws + OFF_INVU);
  const float* invV = (const float*)(ws + OFF_INVV);
  const int* elist = (const int*)(ws + OFF_ELIST);
  float* glist = (float*)(ws + OFF_GLIST);
  const float* pd = (const float*)(ws + OFF_PD);
  const int lane = threadIdx.x & 63, w = threadIdx.x >> 6;
  for (int t = blockIdx.x * 4 + w; t < NTOK; t += gridDim.x * 4) {
#pragma unroll
    for (int hf_ = 0; hf_ < 2; ++hf_) {
      const int k = hf_ * 64 + lane;
      float d = 0.f;
#pragma unroll
      for (int s = 0; s < 8; ++s) d += pd[(size_t)t * 1024 + s * 128 + k];
      const int e = elist[(size_t)t * 128 + k];
      const float g = glist[(size_t)t * 128 + k];
      ((unsigned*)glist)[(size_t)t * 128 + k] = (pack2(0.f, g * geluf_(d * invU[e]) * invV[e]) & 0xFFFF0000u) | (unsigned)e;
    }
  }
}
DI void phase15(const Params& p) { sliced_pass<1>(p); }
DI void phase16(const Params& p) {
  const int lane = threadIdx.x & 63, w = threadIdx.x >> 6;
  for (int tok = blockIdx.x * 4 + w; tok < NTOK; tok += gridDim.x * 4) {
    float* xr = p.out + (size_t)tok * DM;
    float4 xv[4];
    float ss = 0.f;
#pragma unroll
    for (int i = 0; i < 4; ++i) {
      xv[i] = *(const float4*)(xr + (i * 64 + lane) * 4);
      ss += xv[i].x * xv[i].x + xv[i].y * xv[i].y + xv[i].z * xv[i].z + xv[i].w * xv[i].w;
    }
    ss = wsum(ss);
    const float rstd = rsqrtf(ss * (1.f / 1024.f) + 1e-6f);
#pragma unroll
    for (int i = 0; i < 4; ++i) {
      const int e = (i * 64 + lane) * 4;
      float4 nf = *(const float4*)(p.norm_final + e);
      *(float4*)(xr + e) = make_float4(xv[i].x * rstd * nf.x, xv[i].y * rstd * nf.y, xv[i].z * rstd * nf.z, xv[i].w * rstd * nf.w);
    }
  }
}

#define XB_TMO      128
#define XB_XCNT(j)  (256  + 64 * (j))
#define XB_XSUB(j)  (1280 + 64 * (j))
#define XB_XGEN(j)  (2304 + 64 * (j))
#define XB_TOP      3328
#define XB_TOPGEN   3392
#define XCD_BAR_WORDS 3456
#define XB_SPIN_CAP (1u << 22)
#define LAS __attribute__((address_space(3)))
DI unsigned xb_ld(unsigned* p) { return __hip_atomic_load(p, __ATOMIC_RELAXED, __HIP_MEMORY_SCOPE_AGENT); }
DI unsigned xb_add(unsigned* p, unsigned v) { return __hip_atomic_fetch_add(p, v, __ATOMIC_RELAXED, __HIP_MEMORY_SCOPE_AGENT); }
DI unsigned xb_xcc_id() { return (unsigned)__builtin_amdgcn_s_getreg((3 << 11) | 20) & 0xFu; }
#define XB_SPIN(cond, bar) do { unsigned _sp = 0; while (cond) { __builtin_amdgcn_s_sleep(1); \
    if ((++_sp & 255u) == 0u) { if (xb_ld(&(bar)[XB_TMO])) break; if (_sp > XB_SPIN_CAP) { atomicAdd(&(bar)[XB_TMO], 1u); break; } } } } while (0)
struct XcdBarrier { unsigned* bar; unsigned x; volatile LAS unsigned* st; };
DI XcdBarrier xcd_barrier_post(unsigned* bar, volatile LAS unsigned* st) {
  XcdBarrier b; b.bar = bar; b.x = xb_xcc_id(); b.st = st;
  if (threadIdx.x == 0) (void)xb_add(&bar[XB_XCNT(b.x)], 1u);
  return b;
}
DI void xcd_barrier_complete(unsigned* bar, unsigned x, unsigned& nloc, unsigned& nx) {
  const unsigned G = gridDim.x * gridDim.y * gridDim.z;
  unsigned sum, cnt, mine, sp = 0u;
  for (;;) {
    sum = 0u; cnt = 0u; mine = 0u;
#pragma unroll
    for (unsigned j = 0; j < 16; ++j) { const unsigned c = xb_ld(&bar[XB_XCNT(j)]); sum += c; cnt += (c > 0u) ? 1u : 0u; mine = (j == x) ? c : mine; }
    if (sum == G) break;
    __builtin_amdgcn_s_sleep(1);
    if ((++sp & 255u) == 0u) { if (xb_ld(&bar[XB_TMO])) break; if (sp > XB_SPIN_CAP) { atomicAdd(&bar[XB_TMO], 1u); break; } }
  }
  nloc = mine > 0u ? mine : 1u; nx = cnt > 0u ? cnt : 1u;
}
DI void xcd_barrier(const XcdBarrier& b) {
  asm volatile("s_waitcnt vmcnt(0)" ::: "memory");
  __syncthreads();
  if (threadIdx.x == 0) {
    unsigned* bar = b.bar;
    __builtin_amdgcn_s_waitcnt(0);
    unsigned nloc = b.st[0], nx = b.st[1];
    if (nloc == 0u) { xcd_barrier_complete(bar, b.x, nloc, nx); b.st[0] = nloc; b.st[1] = nx; }
    const unsigned old = xb_add(&bar[XB_XSUB(b.x)], 1u);
    const unsigned gen = old / nloc;
    if (old + 1u == (gen + 1u) * nloc) {
      __builtin_amdgcn_fence(__ATOMIC_RELEASE, "agent");
      asm volatile("s_waitcnt vmcnt(0)" ::: "memory");
      const unsigned og = xb_add(&bar[XB_TOP], 1u);
      const unsigned tg = og / nx;
      if (og + 1u == (tg + 1u) * nx) xb_add(&bar[XB_TOPGEN], 1u);
      else XB_SPIN(xb_ld(&bar[XB_TOPGEN]) == tg, bar);
      __builtin_amdgcn_fence(__ATOMIC_ACQUIRE, "agent");
      xb_add(&bar[XB_XGEN(b.x)], 1u);
      asm volatile("s_waitcnt vmcnt(0)" ::: "memory");
    } else {
      XB_SPIN(xb_ld(&bar[XB_XGEN(b.x)]) == gen, bar);
      __builtin_amdgcn_fence(__ATOMIC_ACQUIRE, "agent");
      asm volatile("s_waitcnt vmcnt(0)" ::: "memory");
    }
  }
  __syncthreads();
}

#ifdef ONLY_PHASE
#define RUNPH(n, call) if (ONLY_PHASE == n) { call; }
#else
#ifndef DUP_PHASE
#define DUP_PHASE -1
#endif
#define RUNPH(n, call) if (lo <= n && n < hi) { call; if (n == DUP_PHASE) { xcd_barrier(xb); call; } if (n + 1 < hi) xcd_barrier(xb); }
#endif
__global__ void __launch_bounds__(256, 2) mega(Params p, int lo, int hi) {
  __shared__ __attribute__((aligned(16))) char smem[SMEM_BYTES];
  __shared__ uint4 xb_words;
  cg::grid_group grid = cg::this_grid();
  if (lo < 0) grid.sync();
  if (threadIdx.x == 0) xb_words = make_uint4(0u, 0u, 0u, 0u);
  __syncthreads();
  XcdBarrier xb = xcd_barrier_post((unsigned*)(p.ws + OFF_BAR), (volatile LAS unsigned*)&xb_words);
  RUNPH(0, phase0(p, smem))
  RUNPH(1, phase1(p, smem))
  RUNPH(2, phase2(p, smem))
  RUNPH(3, phase3(p, smem))
  RUNPH(4, phase4(p))
  RUNPH(5, phase5(p, smem))
  RUNPH(6, phase6(p, smem))
  RUNPH(7, phase7(p, smem))
  RUNPH(8, phase8(p, smem))
  RUNPH(9, phase9(p, smem))
  RUNPH(10, phase10(p, smem))
  RUNPH(11, phase11(p, smem))
  RUNPH(12, phase12(p, smem))
  RUNPH(13, phase13(p))
  RUNPH(14, phase14(p))
  RUNPH(15, phase15(p))
  RUNPH(16, phase16(p))
}

extern "C" void kernel_launch(void* const* d_in, const int* in_sizes, int n_in, void* d_out, int out_size, void* d_ws,
                              size_t ws_size, hipStream_t stream) {
  static int grid_blocks = 0;
  if (!grid_blocks) {
    int dev = 0, cus = 0, per_cu = 0;
    hipGetDevice(&dev);
    hipDeviceGetAttribute(&cus, hipDeviceAttributeMultiprocessorCount, dev);
    hipOccupancyMaxActiveBlocksPerMultiprocessor(&per_cu, mega, 256, 0);
    if (per_cu > 2) per_cu = 2;
    if (per_cu < 1) per_cu = 1;
    grid_blocks = cus * per_cu;
  }
  Params p{};
  const float** pp = (const float**)&p;
  for (int i = 0; i < 29; ++i) pp[i] = (const float*)d_in[i];
  p.out = (float*)d_out;
  p.ws = (char*)d_ws;
#if N_LAUNCH_SPLIT
  for (int ph = 0; ph < NPHASE; ++ph) {
    hipLaunchKernelGGL(mega, dim3(grid_blocks), dim3(256), 0, stream, p, ph, ph + 1);
  }
#else
  hipMemsetAsync((char*)d_ws + OFF_MOD, 0, (OFF_BAR - OFF_MOD) + XCD_BAR_WORDS * sizeof(unsigned), stream);
  int lo = 0, hi = NPHASE;
  void* args[] = {&p, &lo, &hi};
  hipError_t e = hipLaunchCooperativeKernel((void*)mega, dim3(grid_blocks), dim3(256), args, 0, stream);
  if (e != hipSuccess) fprintf(stderr, "cooperative launch failed: %s (grid %d)\n", hipGetErrorString(e), grid_blocks);
#endif
}
```

```cpp
#include <hip/hip_runtime.h>
#include <hip/hip_cooperative_groups.h>
#include <cstdio>
namespace cg = cooperative_groups;

#define DI __device__ __forceinline__
typedef unsigned short bf16_t;
using bf16x8 = __attribute__((ext_vector_type(8))) short;
using f32x4 = __attribute__((ext_vector_type(4))) float;
using u32x4 = __attribute__((ext_vector_type(4))) unsigned;
using u32x2 = __attribute__((ext_vector_type(2))) unsigned;

#ifndef N_LAUNCH_SPLIT
#define N_LAUNCH_SPLIT 0
#endif

constexpr int NTOK = 20480, NPT = 4096, DM = 1024;
constexpr int NPHASE = 17;
constexpr size_t MiB = 1u << 20;
constexpr size_t OFF_WINT = 0, OFF_WUQT = 9 * MiB, OFF_WUKVT = 9 * MiB + 512 * 1024, OFF_WUPAT = 10 * MiB,
                 OFF_WUPBT = 11 * MiB, OFF_WOT = 12 * MiB, OFF_WCT = 14 * MiB, OFF_WPQB = 18 * MiB,
                 OFF_KEYSB = 22 * MiB, OFF_MOD = 22 * MiB + 512 * 1024, OFF_BAR = 22 * MiB + 768 * 1024, A0 = 24 * MiB;
constexpr size_t OFF_PD = A0 + 104 * MiB, OFF_H1 = A0 + 0, OFF_CQ = A0 + 40 * MiB, OFF_CKVRAW = A0 + 50 * MiB, OFF_KRRAW = A0 + 60 * MiB,
                 OFF_RQ = A0 + 63 * MiB, OFF_RK = A0 + 83 * MiB, OFF_KT = A0 + 103 * MiB, OFF_VT = A0 + 123 * MiB,
                 OFF_SRG = A0 + 143 * MiB, OFF_CKVALL = A0 + 163 * MiB, OFF_KRALL = A0 + 169 * MiB,
                 OFF_UF = A0 + 171 * MiB, OFF_UB = A0 + 187 * MiB,
                 OFF_SF = A0 + 0, OFF_SB = A0 + 8 * MiB, OFF_RET = A0 + 16 * MiB,
                 OFF_Q = A0 + 63 * MiB, OFF_KN = A0 + 93 * MiB, OFF_VTA = A0 + 117 * MiB, OFF_ATTN = A0 + 141 * MiB,
                 OFF_M = A0 + 163 * MiB,
                 OFF_H2 = A0 + 56 * MiB, OFF_TABU = A0 + 36 * MiB, OFF_TABV = A0 + 0, OFF_INVU = A0 + 52 * MiB,
                 OFF_INVV = A0 + 53 * MiB, OFF_ELIST = A0 + 16 * MiB, OFF_GLIST = A0 + 26 * MiB, OFF_SCORES = A0 + 104 * MiB;
constexpr size_t OUT_CKV = 20971520, OUT_KR = 21495808, OUT_SF = 21626880, OUT_SB = 22675456;
constexpr int NKV = 24576;
constexpr int SMEM_BYTES = 73728;

struct Params {
  const float *x_prompt, *x_sample, *c, *cache_ckv, *cache_krope, *st_f, *st_b, *c_ctx, *w_mod, *b_mod, *norm_mix,
      *norm_ffn, *norm_final, *w_in, *q_norm, *kv_norm, *w_uq, *w_ukv, *lg_f, *lg_b, *ret_gn, *w_up_a, *w_up_b, *w_o,
      *peer_wq, *keys1, *keys2, *peer_u, *peer_v;
  float* out;
  char* ws;
};

DI unsigned f2bf(float x) {
  unsigned u = __float_as_uint(x);
  u += 0x7fffu + ((u >> 16) & 1u);
  return u >> 16;
}
DI float bf2f(unsigned b) { return __uint_as_float(b << 16); }
typedef __bf16 hbf16x2_t __attribute__((ext_vector_type(2)));
typedef float hf32x2_t __attribute__((ext_vector_type(2)));
DI unsigned pack2(float a, float b) {
  hf32x2_t f = {a, b};
  return __builtin_bit_cast(unsigned, __builtin_convertvector(f, hbf16x2_t));
}
DI float ex2(float x) { return __builtin_amdgcn_exp2f(x); }
DI float bflo(unsigned u) { return __uint_as_float(u << 16); }
DI float bfhi(unsigned u) { return __uint_as_float(u & 0xffff0000u); }
DI float wsum(float v) {
#pragma unroll
  for (int o = 32; o > 0; o >>= 1) v += __shfl_xor(v, o);
  return v;
}
DI float sigmoidf_(float x) { return 1.f / (1.f + __expf(-x)); }
DI float siluf_(float x) { return x / (1.f + __expf(-x)); }
DI float geluf_(float x) { return 0.5f * x * (1.f + tanhf(0.7978845608028654f * (x + 0.044715f * x * x * x))); }
DI const float* xrow(const Params& p, int tok) {
  return tok < NPT ? p.x_prompt + (size_t)tok * DM : p.x_sample + (size_t)(tok - NPT) * DM;
}
DI int modidx(int tok) { return tok < NPT ? 0 : 1 + ((tok - NPT) >> 11); }
DI int kvrow(int tok) {
  if (tok < NPT) return tok;
  int t = tok - NPT;
  return NPT + (t >> 11) * 2560 + (t & 2047);
}
DI void st_bf16x16(bf16_t* dst, const float (&v)[16]) {
  u32x4 a, b;
  a[0] = pack2(v[0], v[1]); a[1] = pack2(v[2], v[3]); a[2] = pack2(v[4], v[5]); a[3] = pack2(v[6], v[7]);
  b[0] = pack2(v[8], v[9]); b[1] = pack2(v[10], v[11]); b[2] = pack2(v[12], v[13]); b[3] = pack2(v[14], v[15]);
  *(u32x4*)dst = a;
  *(u32x4*)(dst + 8) = b;
}
DI void st_f32x16(float* dst, const float (&v)[16]) {
#pragma unroll
  for (int i = 0; i < 4; ++i) *(float4*)(dst + 4 * i) = make_float4(v[4 * i], v[4 * i + 1], v[4 * i + 2], v[4 * i + 3]);
}
DI void ld_bf16x16(const bf16_t* src, float (&v)[16]) {
  u32x4 a = *(const u32x4*)src, b = *(const u32x4*)(src + 8);
#pragma unroll
  for (int i = 0; i < 4; ++i) {
    v[2 * i] = bflo(a[i]); v[2 * i + 1] = bfhi(a[i]);
    v[8 + 2 * i] = bflo(b[i]); v[8 + 2 * i + 1] = bfhi(b[i]);
  }
}

constexpr int LDK = 72;
template <int SCALE>
DI void gemm_kloop(f32x4 (&acc)[4][4], const bf16_t* __restrict__ A, int lda, const bf16_t* __restrict__ B, int ldb,
                   int K, char* smem, float sc_a, float sc_b) {
  bf16_t* As = (bf16_t*)smem;
  bf16_t* Bs = As + 128 * LDK;
  const int tid = threadIdx.x, lane = tid & 63, w = tid >> 6, wm = w >> 1, wn = w & 1, l15 = lane & 15, g = lane >> 4;
  u32x4 ra[4], rb[4];
  int arow[4], kc[4], ldsa[4], ldsb[4];
#pragma unroll
  for (int i = 0; i < 4; ++i) {
    int c = tid + 256 * i;
    int r = c >> 3;
    kc[i] = (c & 7) * 8;
    arow[i] = r;
    int rr = r & 63;
    int rho = (r & 64) | (((rr >> 2) & 3) << 4) | ((rr >> 4) << 2) | (rr & 3);
    ldsa[i] = rho * LDK + kc[i];
    ldsb[i] = r * LDK + kc[i];
  }
#pragma unroll
  for (int i = 0; i < 4; ++i) {
    ra[i] = *(const u32x4*)(A + (size_t)arow[i] * lda + kc[i]);
    rb[i] = *(const u32x4*)(B + (size_t)arow[i] * ldb + kc[i]);
  }
  __syncthreads();
#pragma unroll
  for (int i = 0; i < 4; ++i) {
    *(u32x4*)(As + ldsa[i]) = ra[i];
    *(u32x4*)(Bs + ldsb[i]) = rb[i];
  }
  if (64 < K) {
#pragma unroll
    for (int i = 0; i < 4; ++i) {
      ra[i] = *(const u32x4*)(A + (size_t)arow[i] * lda + 64 + kc[i]);
      rb[i] = *(const u32x4*)(B + (size_t)arow[i] * ldb + 64 + kc[i]);
    }
  }
  __syncthreads();
  int buf = 0;
  for (int k0 = 0; k0 < K; k0 += 64, buf ^= 1) {
    const bf16_t* Ac = As + buf * (256 * LDK);
    const bf16_t* Bc = Bs + buf * (256 * LDK);
#pragma unroll
    for (int ks = 0; ks < 2; ++ks) {
      bf16x8 af[4], bfr[4];
#pragma unroll
      for (int f = 0; f < 4; ++f)
        af[f] = *(const bf16x8*)(Ac + (wm * 64 + f * 16 + l15) * LDK + ks * 32 + g * 8);
#pragma unroll
      for (int c = 0; c < 4; ++c)
        bfr[c] = *(const bf16x8*)(Bc + (wn * 64 + c * 16 + l15) * LDK + ks * 32 + g * 8);
      if (SCALE) {
        float fac[8];
#pragma unroll
        for (int i = 0; i < 8; ++i) fac[i] = ex2(sc_a + sc_b * (float)(k0 + ks * 32 + g * 8 + i));
#pragma unroll
        for (int f = 0; f < 4; ++f) {
          u32x4 u = __builtin_bit_cast(u32x4, af[f]);
#pragma unroll
          for (int i = 0; i < 4; ++i) u[i] = pack2(bflo(u[i]) * fac[2 * i], bfhi(u[i]) * fac[2 * i + 1]);
          af[f] = __builtin_bit_cast(bf16x8, u);
        }
      }
#pragma unroll
      for (int f = 0; f < 4; ++f)
#pragma unroll
        for (int c = 0; c < 4; ++c) acc[f][c] = __builtin_amdgcn_mfma_f32_16x16x32_bf16(af[f], bfr[c], acc[f][c], 0, 0, 0);
    }
    if (k0 + 64 < K) {
      bf16_t* An = As + (buf ^ 1) * (256 * LDK);
      bf16_t* Bn = Bs + (buf ^ 1) * (256 * LDK);
#pragma unroll
      for (int i = 0; i < 4; ++i) {
        *(u32x4*)(An + ldsa[i]) = ra[i];
        *(u32x4*)(Bn + ldsb[i]) = rb[i];
      }
      if (k0 + 128 < K) {
#pragma unroll
        for (int i = 0; i < 4; ++i) {
          ra[i] = *(const u32x4*)(A + (size_t)arow[i] * lda + k0 + 128 + kc[i]);
          rb[i] = *(const u32x4*)(B + (size_t)arow[i] * ldb + k0 + 128 + kc[i]);
        }
      }
      __syncthreads();
    }
  }
}
DI void acc_zero(f32x4 (&acc)[4][4]) {
#pragma unroll
  for (int f = 0; f < 4; ++f)
#pragma unroll
    for (int c = 0; c < 4; ++c) acc[f][c] = f32x4{0.f, 0.f, 0.f, 0.f};
}
template <class F>
DI void epilogue(const f32x4 (&acc)[4][4], F&& epi) {
  const int tid = threadIdx.x, lane = tid & 63, w = tid >> 6, wm = w >> 1, wn = w & 1, l15 = lane & 15, g = lane >> 4;
#pragma unroll
  for (int c = 0; c < 4; ++c) {
    float v[16];
#pragma unroll
    for (int f = 0; f < 4; ++f)
#pragma unroll
      for (int j = 0; j < 4; ++j) v[f * 4 + j] = acc[f][c][j];
    epi(wm * 64 + 16 * g, wn * 64 + c * 16 + l15, v);
  }
}
DI bool tile_map(int it, int Ft, int Tt, int fsplit, int& ft, int& tt) {
  const int bid = blockIdx.x, nb = gridDim.x;
  int xcd = bid & 7, loc = bid >> 3, nloc = nb >> 3;
  if (loc >= nloc) return false;
  int fg = xcd % fsplit, tg = xcd / fsplit, tsplit = 8 / fsplit;
  int Fg = Ft / fsplit, Tg = Tt / tsplit;
  int i = loc + it * nloc;
  if (i >= Fg * Tg) return false;
  ft = fg * Fg + i % Fg;
  tt = tg * Tg + i / Fg;
  return true;
}
DI int vbid() {
  const int bid = blockIdx.x, nb = gridDim.x;
  if (nb & 7) return bid;
  return (bid & 7) * (nb >> 3) + (bid >> 3);
}

DI int colmap(int mode, int np) {
  if (mode == 1) return np < 416 ? np : (np < 512 ? -1 : np - 96);
  if (mode == 2) return np < 512 ? ((np >> 6) * 128 + (np & 63)) : (((np - 512) >> 6) * 128 + 64 + ((np - 512) & 63));
  return np;
}
DI void tconv_tile(const float* __restrict__ src, int ldsrc, bf16_t* __restrict__ dst, int K, int kt, int nt, int mode,
                   char* smem) {
  float* lds = (float*)smem;
  const int tid = threadIdx.x;
  {
    int col = tid & 63, rq = tid >> 6;
    int n = colmap(mode, nt * 64 + col);
#pragma unroll 4
    for (int r = 0; r < 16; ++r) {
      int kl = r * 4 + rq;
      float v = n >= 0 ? src[(size_t)(kt * 64 + kl) * ldsrc + n] : 0.f;
      lds[kl * 65 + col] = v;
    }
  }
  __syncthreads();
  {
    int nl = tid >> 2, kq = (tid & 3) * 16;
    float v[16];
#pragma unroll
    for (int i = 0; i < 16; ++i) v[i] = lds[(kq + i) * 65 + nl];
    st_bf16x16(dst + (size_t)(nt * 64 + nl) * K + kt * 64 + kq, v);
  }
  __syncthreads();
}
DI void mod_item(const Params& p, int item, char* smem) {
  float* sil = (float*)smem;
  const int tid = threadIdx.x;
  const int cg_ = item >> 2, slab = item & 3, kbase = slab * 256;
  for (int i = tid; i < 9 * 256; i += 256) {
    int j = i >> 8, k = kbase + (i & 255);
    float cv = j == 0 ? p.c_ctx[k] : p.c[(j - 1) * 1024 + k];
    sil[i] = siluf_(cv);
  }
  __syncthreads();
  const int kq = tid >> 6, nn = tid & 63, n0 = cg_ * 64;
  float acc[9];
#pragma unroll
  for (int j = 0; j < 9; ++j) acc[j] = 0.f;
#pragma unroll 1
  for (int i0 = 0; i0 < 64; i0 += 16) {
    float wv[16];
#pragma unroll
    for (int i = 0; i < 16; ++i) wv[i] = p.w_mod[(size_t)(kbase + kq + 4 * (i0 + i)) * 6144 + n0 + nn];
#pragma unroll
    for (int i = 0; i < 16; ++i)
#pragma unroll
      for (int j = 0; j < 9; ++j) acc[j] += sil[j * 256 + kq + 4 * (i0 + i)] * wv[i];
  }
  __syncthreads();
  float* part = (float*)smem + 9 * 256;
#pragma unroll
  for (int j = 0; j < 9; ++j) part[(kq * 9 + j) * 64 + nn] = acc[j];
  __syncthreads();
  float* mod = (float*)(p.ws + OFF_MOD);
  for (int i = tid; i < 9 * 64; i += 256) {
    int j = i >> 6, n = i & 63;
    float s = part[(0 * 9 + j) * 64 + n] + part[(1 * 9 + j) * 64 + n] + part[(2 * 9 + j) * 64 + n] + part[(3 * 9 + j) * 64 + n];
    if (slab == 0) s += p.b_mod[n0 + n];
    atomicAdd(mod + j * 6144 + n0 + n, s);
  }
  __syncthreads();
}
DI void conv_flat(const float* __restrict__ src, bf16_t* __restrict__ dst, size_t n) {
  size_t i = ((size_t)blockIdx.x * 256 + threadIdx.x) * 8;
  const size_t stride = (size_t)gridDim.x * 256 * 8;
  for (; i < n; i += stride) {
    float4 a = *(const float4*)(src + i), b = *(const float4*)(src + i + 4);
    u32x4 o;
    o[0] = pack2(a.x, a.y); o[1] = pack2(a.z, a.w); o[2] = pack2(b.x, b.y); o[3] = pack2(b.z, b.w);
    *(u32x4*)(dst + i) = o;
  }
}
DI void phase0(const Params& p, char* smem) {
  const int bid = blockIdx.x, nb = gridDim.x;
  char* ws = p.ws;
  const int n_mod = 384;
  const int t_in = 16 * 72, t_uq = 4 * 12, t_ukv = 2 * 16, t_upa = 8 * 16, t_upb = 8 * 16, t_o = 16 * 16;
  const int total = n_mod + t_in + t_uq + t_ukv + t_upa + t_upb + t_o;
  for (int it = bid; it < total; it += nb) {
    int i = it;
    if (i < n_mod) { mod_item(p, i, smem); continue; }
    i -= n_mod;
    if (i < t_in) { tconv_tile(p.w_in, 4512, (bf16_t*)(ws + OFF_WINT), 1024, i / 72, i % 72, 1, smem); continue; }
    i -= t_in;
    if (i < t_uq) { tconv_tile(p.w_uq, 768, (bf16_t*)(ws + OFF_WUQT), 256, i / 12, i % 12, 0, smem); continue; }
    i -= t_uq;
    if (i < t_ukv) { tconv_tile(p.w_ukv, 1024, (bf16_t*)(ws + OFF_WUKVT), 128, i / 16, i % 16, 2, smem); continue; }
    i -= t_ukv;
    if (i < t_upa) { tconv_tile(p.w_up_a, 1024, (bf16_t*)(ws + OFF_WUPAT), 512, i / 16, i % 16, 0, smem); continue; }
    i -= t_upa;
    if (i < t_upb) { tconv_tile(p.w_up_b, 1024, (bf16_t*)(ws + OFF_WUPBT), 512, i / 16, i % 16, 0, smem); continue; }
    i -= t_upb;
    tconv_tile(p.w_o, 1024, (bf16_t*)(ws + OFF_WOT), 1024, i / 16, i % 16, 0, smem);
  }
  conv_flat(p.peer_wq, (bf16_t*)(ws + OFF_WPQB), (size_t)1024 * 2048);
  {
    size_t i = ((size_t)bid * 256 + threadIdx.x) * 8;
    const size_t stride = (size_t)nb * 256 * 8;
    bf16_t* kb = (bf16_t*)(ws + OFF_KEYSB);
    for (; i < (size_t)2 * 131072; i += stride) {
      int half = i >= 131072;
      size_t s = i - (size_t)half * 131072;
      int h = (int)(s >> 14);
      size_t r = s & 16383;
      const float* src = (half ? p.keys2 : p.keys1) + s;
      float4 a = *(const float4*)(src), b = *(const float4*)(src + 4);
      u32x4 o;
      o[0] = pack2(a.x, a.y); o[1] = pack2(a.z, a.w); o[2] = pack2(b.x, b.y); o[3] = pack2(b.z, b.w);
      *(u32x4*)(kb + ((size_t)(h * 2 + half) << 14) + r) = o;
    }
  }
}

DI void rows_norm_mod(const Params& p, const float* nw, int sh_off, int sc_off, bool from_out, bf16_t* dst) {
  const int lane = threadIdx.x & 63, w = threadIdx.x >> 6;
  const float* mod = (const float*)(p.ws + OFF_MOD);
  for (int tok = blockIdx.x * 4 + w; tok < NTOK; tok += gridDim.x * 4) {
    const float* xr = from_out ? p.out + (size_t)tok * DM : xrow(p, tok);
    const float* mj = mod + modidx(tok) * 6144;
    float4 xv[4];
    float ss = 0.f;
#pragma unroll
    for (int i = 0; i < 4; ++i) {
      xv[i] = *(const float4*)(xr + (i * 64 + lane) * 4);
      ss += xv[i].x * xv[i].x + xv[i].y * xv[i].y + xv[i].z * xv[i].z + xv[i].w * xv[i].w;
    }
    ss = wsum(ss);
    float rstd = rsqrtf(ss * (1.f / 1024.f) + 1e-6f);
#pragma unroll
    for (int i = 0; i < 4; ++i) {
      int e = (i * 64 + lane) * 4;
      float4 nv = *(const float4*)(nw + e), sh = *(const float4*)(mj + sh_off + e), sc = *(const float4*)(mj + sc_off + e);
      float h0 = (xv[i].x * rstd) * nv.x * (1.f + sc.x) + sh.x;
      float h1 = (xv[i].y * rstd) * nv.y * (1.f + sc.y) + sh.y;
      float h2 = (xv[i].z * rstd) * nv.z * (1.f + sc.z) + sh.z;
      float h3 = (xv[i].w * rstd) * nv.w * (1.f + sc.w) + sh.w;
      u32x2 o;
      o[0] = pack2(h0, h1); o[1] = pack2(h2, h3);
      *(u32x2*)(dst + (size_t)tok * DM + e) = o;
    }
  }
}
DI void phase1(const Params& p, char* smem) {
  rows_norm_mod(p, p.norm_mix, 0, 1024, false, (bf16_t*)(p.ws + OFF_H1));
  const bf16_t* wpq = (const bf16_t*)(p.ws + OFF_WPQB);
  const bf16_t* kb = (const bf16_t*)(p.ws + OFF_KEYSB);
  bf16_t* wct = (bf16_t*)(p.ws + OFF_WCT);
  for (int it = blockIdx.x; it < 128; it += gridDim.x) {
    int hh = it >> 3, mt = it & 7;
    f32x4 acc[4][4];
    acc_zero(acc);
    gemm_kloop<0>(acc, wpq + (size_t)(mt * 128) * 2048 + hh * 128, 2048, kb + (size_t)hh * 16384, 128, 128, smem, 0.f, 0.f);
    epilogue(acc, [&](int m, int n, float (&v)[16]) { st_bf16x16(wct + (size_t)(hh * 128 + n) * 1024 + mt * 128 + m, v); });
  }
}

DI void phase2(const Params& p, char* smem) {
  char* ws = p.ws;
  const bf16_t* winT = (const bf16_t*)(ws + OFF_WINT);
  const bf16_t* h1 = (const bf16_t*)(ws + OFF_H1);
  bf16_t* cq = (bf16_t*)(ws + OFF_CQ);
  float* ckvraw = (float*)(ws + OFF_CKVRAW);
  float* krraw = (float*)(ws + OFF_KRRAW);
  bf16_t* rq = (bf16_t*)(ws + OFF_RQ);
  bf16_t* rk = (bf16_t*)(ws + OFF_RK);
  bf16_t* kT = (bf16_t*)(ws + OFF_KT);
  bf16_t* vT = (bf16_t*)(ws + OFF_VT);
  bf16_t* srg = (bf16_t*)(ws + OFF_SRG);
  bf16_t* sga = (bf16_t*)p.out;
  bf16_t* sgb = sga + (size_t)NTOK * 1024;
  for (int it = 0;; ++it) {
    int ft, tt;
    if (!tile_map(it, 36, 160, 4, ft, tt)) break;
    f32x4 acc[4][4];
    acc_zero(acc);
    const bf16_t* W = winT + (size_t)ft * 128 * 1024;
    const bf16_t* H = h1 + (size_t)tt * 128 * 1024;
    const int tok0 = tt * 128, f0 = ft * 128;
    if (ft >= 8 && ft < 16) {
      gemm_kloop<0>(acc, H, 1024, W, 1024, 1024, smem, 0.f, 0.f);
      if (ft < 12) {
        epilogue(acc, [&](int m, int n, float (&v)[16]) {
          int feat = f0 - 1024 + n, tok = tok0 + m;
#pragma unroll
          for (int i = 0; i < 16; ++i) v[i] *= 0.08838834764831845f;
          st_bf16x16(kT + (size_t)feat * NTOK + tok, v);
#pragma unroll
          for (int i = 0; i < 16; ++i) rk[(size_t)(tok + i) * 512 + feat] = (bf16_t)f2bf(v[i]);
        });
      } else {
        epilogue(acc, [&](int m, int n, float (&v)[16]) {
          int feat = f0 - 1536 + n, tok = tok0 + m;
          st_bf16x16(vT + (size_t)feat * NTOK + tok, v);
        });
      }
    } else {
      gemm_kloop<0>(acc, W, 1024, H, 1024, 1024, smem, 0.f, 0.f);
      if (ft < 2) {
        epilogue(acc, [&](int m, int n, float (&v)[16]) { st_bf16x16(cq + (size_t)(tok0 + n) * 256 + f0 + m, v); });
      } else if (ft == 2) {
        epilogue(acc, [&](int m, int n, float (&v)[16]) { st_f32x16(ckvraw + (size_t)(tok0 + n) * 128 + m, v); });
      } else if (ft == 3) {
        epilogue(acc, [&](int m, int n, float (&v)[16]) {
          if (m < 32) st_f32x16(krraw + (size_t)(tok0 + n) * 32 + m, v);
        });
      } else if (ft < 8) {
        epilogue(acc, [&](int m, int n, float (&v)[16]) { st_bf16x16(rq + (size_t)(tok0 + n) * 512 + f0 - 512 + m, v); });
      } else if (ft < 20) {
        epilogue(acc, [&](int m, int n, float (&v)[16]) {
#pragma unroll
          for (int i = 0; i < 16; ++i) v[i] = siluf_(v[i]);
          st_bf16x16(srg + (size_t)(tok0 + n) * 512 + f0 - 2048 + m, v);
        });
      } else if (ft < 28) {
        epilogue(acc, [&](int m, int n, float (&v)[16]) {
#pragma unroll
          for (int i = 0; i < 16; ++i) v[i] = sigmoidf_(v[i]);
          st_bf16x16(sga + (size_t)(tok0 + n) * 1024 + f0 - 2560 + m, v);
        });
      } else {
        epilogue(acc, [&](int m, int n, float (&v)[16]) {
#pragma unroll
          for (int i = 0; i < 16; ++i) v[i] = sigmoidf_(v[i]);
          st_bf16x16(sgb + (size_t)(tok0 + n) * 1024 + f0 - 3584 + m, v);
        });
      }
    }
  }
}

DI float log2gamma(float logit) { return -log1pf(expf(-logit)) * 1.4426950408889634f; }
DI void phase3(const Params& p, char* smem) {
  char* ws = p.ws;
  const int lane = threadIdx.x & 63, w = threadIdx.x >> 6;
  bf16_t* cq = (bf16_t*)(ws + OFF_CQ);
  const float* ckvraw = (const float*)(ws + OFF_CKVRAW);
  const float* krraw = (const float*)(ws + OFF_KRRAW);
  bf16_t* ckvall = (bf16_t*)(ws + OFF_CKVALL);
  bf16_t* krall = (bf16_t*)(ws + OFF_KRALL);
  for (int r = blockIdx.x * 4 + w; r < NTOK + 4096; r += gridDim.x * 4) {
    if (r < NTOK) {
      const int tok = r;
      {
        u32x2 u = *(const u32x2*)(cq + (size_t)tok * 256 + lane * 4);
        float a0 = bflo(u[0]), a1 = bfhi(u[0]), a2 = bflo(u[1]), a3 = bfhi(u[1]);
        float ss = wsum(a0 * a0 + a1 * a1 + a2 * a2 + a3 * a3);
        float rstd = rsqrtf(ss * (1.f / 256.f) + 1e-6f);
        float4 nq = *(const float4*)(p.q_norm + lane * 4);
        u32x2 o;
        o[0] = pack2(a0 * rstd * nq.x, a1 * rstd * nq.y);
        o[1] = pack2(a2 * rstd * nq.z, a3 * rstd * nq.w);
        *(u32x2*)(cq + (size_t)tok * 256 + lane * 4) = o;
      }
      const int row = kvrow(tok);
      {
        float2 v = *(const float2*)(ckvraw + (size_t)tok * 128 + lane * 2);
        float ss = wsum(v.x * v.x + v.y * v.y);
        float rstd = rsqrtf(ss * (1.f / 128.f) + 1e-6f);
        float2 nk = *(const float2*)(p.kv_norm + lane * 2);
        float o0 = v.x * rstd * nk.x, o1 = v.y * rstd * nk.y;
        if (tok < NPT) *(float2*)(p.out + OUT_CKV + (size_t)tok * 128 + lane * 2) = make_float2(o0, o1);
        *(unsigned*)(ckvall + (size_t)row * 128 + lane * 2) = pack2(o0, o1);
      }
      if (lane < 32) {
        float own = krraw[(size_t)tok * 32 + lane];
        float o = own;
        if (tok < NPT) {
          p.out[OUT_KR + (size_t)tok * 32 + lane] = own;
        } else {
          float partner = krraw[(size_t)tok * 32 + (lane ^ 16)];
          int t = (tok - NPT) & 2047;
          int a = lane & 15;
          float pos = (a < 8) ? (float)(t >> 6) : (float)(t & 63);
          float fr = exp2f(-(float)(a & 7) * 1.6609640474436813f);
          float sn, cs;
          sincosf(pos * fr, &sn, &cs);
          o = lane < 16 ? own * cs - partner * sn : partner * sn + own * cs;
        }
        krall[(size_t)row * 32 + lane] = (bf16_t)f2bf(o);
      }
    } else {
      const int cr = r - NTOK;
      const int b = cr >> 9, pos = cr & 511;
      const int row = NPT + b * 2560 + 2048 + pos;
      float2 v = *(const float2*)(p.cache_ckv + (size_t)cr * 128 + lane * 2);
      *(unsigned*)(ckvall + (size_t)row * 128 + lane * 2) = pack2(v.x, v.y);
      if (lane < 32) krall[(size_t)row * 32 + lane] = (bf16_t)f2bf(p.cache_krope[(size_t)cr * 32 + lane]);
    }
  }
  const bf16_t* kT = (const bf16_t*)(ws + OFF_KT);
  const bf16_t* vT = (const bf16_t*)(ws + OFF_VT);
  float* Uf = (float*)(ws + OFF_UF);
  float* Ub = (float*)(ws + OFF_UB);
  for (int it = blockIdx.x; it < 320; it += gridDim.x) {
    const int blk = it >> 2, h = it & 3;
    const float l2f = log2gamma(p.lg_f[h]), l2b = log2gamma(p.lg_b[h]);
    const bf16_t* Kp = kT + (size_t)(h * 128) * NTOK + blk * 256;
    const bf16_t* Vp = vT + (size_t)(h * 128) * NTOK + blk * 256;
#pragma unroll 1
    for (int dir = 0; dir < 2; ++dir) {
      const float sa = dir ? 0.f : l2f * 255.f, sb = dir ? l2b : -l2f;
      f32x4 acc[4][4];
      acc_zero(acc);
      if (blk < 16) {
        gemm_kloop<1>(acc, Vp, NTOK, Kp, NTOK, 256, smem, sa, sb);
        float* dst = p.out + (dir ? OUT_SB : OUT_SF) + (size_t)(blk * 4 + h) * 16384;
        epilogue(acc, [&](int m, int n, float (&v)[16]) { st_f32x16(dst + n * 128 + m, v); });
      } else {
        gemm_kloop<1>(acc, Kp, NTOK, Vp, NTOK, 256, smem, sa, sb);
        float* dst = (dir ? Ub : Uf) + (size_t)((blk - 16) * 4 + h) * 16384;
        epilogue(acc, [&](int m, int n, float (&v)[16]) { st_f32x16(dst + n * 128 + m, v); });
      }
    }
  }
}

DI void phase4(const Params& p) {
  char* ws = p.ws;
  const float* Uf = (const float*)(ws + OFF_UF);
  const float* Ub = (const float*)(ws + OFF_UB);
  bf16_t* Sf = (bf16_t*)(ws + OFF_SF);
  bf16_t* Sb = (bf16_t*)(ws + OFF_SB);
  for (int idx = blockIdx.x * 256 + threadIdx.x; idx < (1 << 20); idx += gridDim.x * 256) {
    int d = idx & 127, e = (idx >> 7) & 127, h = (idx >> 14) & 3, b = (idx >> 16) & 7, dir = idx >> 19;
    size_t eo = (size_t)e * 128 + d;
    if (dir == 0) {
      float cf = exp2f(log2gamma(p.lg_f[h]) * 256.f);
      float S = p.st_f[(size_t)(b * 4 + h) * 16384 + d * 128 + e];
#pragma unroll
      for (int blk = 0; blk < 8; ++blk) {
        size_t o = (size_t)((b * 8 + blk) * 4 + h) * 16384 + eo;
        Sf[o] = (bf16_t)f2bf(S);
        S = cf * S + Uf[o];
      }
    } else {
      float cb = exp2f(log2gamma(p.lg_b[h]) * 256.f);
      float S = p.st_b[(size_t)(b * 4 + h) * 16384 + d * 128 + e];
#pragma unroll
      for (int blk = 7; blk >= 0; --blk) {
        size_t o = (size_t)((b * 8 + blk) * 4 + h) * 16384 + eo;
        Sb[o] = (bf16_t)f2bf(S);
        S = cb * S + Ub[o];
      }
    }
  }
}

DI bf16x8 scale_frag(bf16x8 q, float s) {
  u32x4 u = __builtin_bit_cast(u32x4, q);
#pragma unroll
  for (int i = 0; i < 4; ++i) u[i] = pack2(bflo(u[i]) * s, bfhi(u[i]) * s);
  return __builtin_bit_cast(bf16x8, u);
}
constexpr int NQT = 1;
DI void phase5(const Params& p, char* smem) {
  char* ws = p.ws;
  const bf16_t* rq = (const bf16_t*)(ws + OFF_RQ);
  const bf16_t* rk = (const bf16_t*)(ws + OFF_RK);
  const bf16_t* vT = (const bf16_t*)(ws + OFF_VT);
  const bf16_t* srg = (const bf16_t*)(ws + OFF_SRG);
  const bf16_t* Sf = (const bf16_t*)(ws + OFF_SF);
  const bf16_t* Sb = (const bf16_t*)(ws + OFF_SB);
  bf16_t* ret = (bf16_t*)(ws + OFF_RET);
  bf16_t* Ks = (bf16_t*)smem;
  bf16_t* Vs = Ks + 64 * 136;
  const int tid = threadIdx.x, lane = tid & 63, w = tid >> 6, l15 = lane & 15, g = lane >> 4;
  for (int item = vbid(); item < 640 * (2 / NQT); item += gridDim.x) {
    const int qb = item >> 2, h = item & 3, blk = (qb * NQT) >> 2;
    const float l2f = log2gamma(p.lg_f[h]), l2b = log2gamma(p.lg_b[h]);
    const int tokw = qb * (64 * NQT) + w * (16 * NQT);
    bf16x8 Q[NQT][4];
#pragma unroll
    for (int qt = 0; qt < NQT; ++qt)
#pragma unroll
      for (int ks = 0; ks < 4; ++ks)
        Q[qt][ks] = *(const bf16x8*)(rq + (size_t)(tokw + qt * 16 + l15) * 512 + h * 128 + ks * 32 + g * 8);
    f32x4 o[8][NQT];
#pragma unroll
    for (int et = 0; et < 8; ++et)
#pragma unroll
      for (int qt = 0; qt < NQT; ++qt) o[et][qt] = f32x4{0.f, 0.f, 0.f, 0.f};
#pragma unroll 1
    for (int kt = 0; kt < 4; ++kt) {
      const int key0 = blk * 256 + kt * 64;
      __syncthreads();
#pragma unroll
      for (int i = 0; i < 4; ++i) {
        int c = tid + 256 * i;
        int r = c >> 4, cc = (c & 15) * 8;
        *(u32x4*)(Ks + r * 136 + cc) = *(const u32x4*)(rk + (size_t)(key0 + r) * 512 + h * 128 + cc);
        int e = c >> 3, c2 = (c & 7) * 8;
        *(u32x4*)(Vs + e * 72 + c2) = *(const u32x4*)(vT + (size_t)(h * 128 + e) * NTOK + key0 + c2);
      }
      __syncthreads();
      bf16x8 P[NQT][2];
#pragma unroll
      for (int qt = 0; qt < NQT; ++qt) {
        f32x4 s[4];
#pragma unroll
        for (int kk = 0; kk < 4; ++kk) s[kk] = f32x4{0.f, 0.f, 0.f, 0.f};
#pragma unroll
        for (int ks = 0; ks < 4; ++ks) {
#pragma unroll
          for (int kk = 0; kk < 4; ++kk) {
            bf16x8 a = *(const bf16x8*)(Ks + (kk * 16 + l15) * 136 + ks * 32 + g * 8);
            s[kk] = __builtin_amdgcn_mfma_f32_16x16x32_bf16(a, Q[qt][ks], s[kk], 0, 0, 0);
          }
        }
        const int iq = (tokw + qt * 16 + l15) & 255;
#pragma unroll
        for (int kk = 0; kk < 4; ++kk) {
#pragma unroll
          for (int j = 0; j < 4; ++j) {
            int jk = kt * 64 + kk * 16 + 4 * g + j;
            int diff = iq - jk;
            float dm = diff > 0 ? ex2(l2f * (float)diff) : (diff < 0 ? ex2(l2b * (float)(-diff)) : 2.f);
            s[kk][j] *= dm;
          }
        }
#pragma unroll
        for (int k2 = 0; k2 < 2; ++k2) {
          u32x4 u;
          u[0] = pack2(s[2 * k2][0], s[2 * k2][1]);
          u[1] = pack2(s[2 * k2][2], s[2 * k2][3]);
          u[2] = pack2(s[2 * k2 + 1][0], s[2 * k2 + 1][1]);
          u[3] = pack2(s[2 * k2 + 1][2], s[2 * k2 + 1][3]);
          P[qt][k2] = __builtin_bit_cast(bf16x8, u);
        }
      }
#pragma unroll
      for (int k2 = 0; k2 < 2; ++k2) {
#pragma unroll
        for (int et = 0; et < 8; ++et) {
          u32x2 lo = *(const u32x2*)(Vs + (et * 16 + l15) * 72 + k2 * 32 + 4 * g);
          u32x2 hi = *(const u32x2*)(Vs + (et * 16 + l15) * 72 + k2 * 32 + 16 + 4 * g);
          u32x4 u;
          u[0] = lo[0]; u[1] = lo[1]; u[2] = hi[0]; u[3] = hi[1];
          bf16x8 a = __builtin_bit_cast(bf16x8, u);
#pragma unroll
          for (int qt = 0; qt < NQT; ++qt) o[et][qt] = __builtin_amdgcn_mfma_f32_16x16x32_bf16(a, P[qt][k2], o[et][qt], 0, 0, 0);
        }
      }
    }
    if (blk >= 16) {
#pragma unroll 1
      for (int dir = 0; dir < 2; ++dir) {
        const bf16_t* S = (dir ? Sb : Sf) + (size_t)((blk - 16) * 4 + h) * 16384;
        float dq[NQT];
#pragma unroll
        for (int qt = 0; qt < NQT; ++qt) {
          int iq = (tokw + qt * 16 + l15) & 255;
          dq[qt] = dir ? exp2f(l2b * (float)(256 - iq)) : exp2f(l2f * (float)(iq + 1));
        }
#pragma unroll
        for (int ks = 0; ks < 4; ++ks) {
          bf16x8 qs[NQT];
#pragma unroll
          for (int qt = 0; qt < NQT; ++qt) qs[qt] = scale_frag(Q[qt][ks], dq[qt]);
#pragma unroll
          for (int et = 0; et < 8; ++et) {
            bf16x8 a = *(const bf16x8*)(S + (size_t)(et * 16 + l15) * 128 + ks * 32 + g * 8);
#pragma unroll
            for (int qt = 0; qt < NQT; ++qt) o[et][qt] = __builtin_amdgcn_mfma_f32_16x16x32_bf16(a, qs[qt], o[et][qt], 0, 0, 0);
          }
        }
      }
    }
#pragma unroll
    for (int qt = 0; qt < NQT; ++qt) {
      const int tok = tokw + qt * 16 + l15;
      float s1 = 0.f;
#pragma unroll
      for (int et = 0; et < 8; ++et)
#pragma unroll
        for (int j = 0; j < 4; ++j) s1 += o[et][qt][j];
      s1 += __shfl_xor(s1, 16);
      s1 += __shfl_xor(s1, 32);
      const float mu = s1 * (1.f / 128.f);
      float s2 = 0.f;
#pragma unroll
      for (int et = 0; et < 8; ++et)
#pragma unroll
        for (int j = 0; j < 4; ++j) {
          float dlt = o[et][qt][j] - mu;
          s2 += dlt * dlt;
        }
      s2 += __shfl_xor(s2, 16);
      s2 += __shfl_xor(s2, 32);
      const float rstd = rsqrtf(s2 * (1.f / 128.f) + 1e-6f);
#pragma unroll
      for (int et = 0; et < 8; ++et) {
        const int e = h * 128 + et * 16 + 4 * g;
        float4 gn = *(const float4*)(p.ret_gn + e);
        u32x2 sg = *(const u32x2*)(srg + (size_t)tok * 512 + e);
        u32x2 ov;
        ov[0] = pack2((o[et][qt][0] - mu) * rstd * gn.x * bflo(sg[0]), (o[et][qt][1] - mu) * rstd * gn.y * bfhi(sg[0]));
        ov[1] = pack2((o[et][qt][2] - mu) * rstd * gn.z * bflo(sg[1]), (o[et][qt][3] - mu) * rstd * gn.w * bfhi(sg[1]));
        *(u32x2*)(ret + (size_t)tok * 512 + e) = ov;
      }
    }
  }
}

DI void phase6(const Params& p, char* smem) {
  char* ws = p.ws;
  const bf16_t* cqn = (const bf16_t*)(ws + OFF_CQ);
  const bf16_t* wuqT = (const bf16_t*)(ws + OFF_WUQT);
  bf16_t* q = (bf16_t*)(ws + OFF_Q);
  for (int it = 0;; ++it) {
    int ft, tt;
    if (!tile_map(it, 6, 160, 1, ft, tt)) break;
    f32x4 acc[4][4];
    acc_zero(acc);
    gemm_kloop<0>(acc, wuqT + (size_t)ft * 128 * 256, 256, cqn + (size_t)tt * 128 * 256, 256, 256, smem, 0.f, 0.f);
    epilogue(acc, [&](int m, int n, float (&v)[16]) { st_bf16x16(q + (size_t)(tt * 128 + n) * 768 + ft * 128 + m, v); });
  }
  const bf16_t* ckvall = (const bf16_t*)(ws + OFF_CKVALL);
  const bf16_t* wukvT = (const bf16_t*)(ws + OFF_WUKVT);
  bf16_t* Kn = (bf16_t*)(ws + OFF_KN);
  bf16_t* Vt = (bf16_t*)(ws + OFF_VTA);
  for (int it = 0;; ++it) {
    int ft, tt;
    if (!tile_map(it, 8, 192, 1, ft, tt)) break;
    f32x4 acc[4][4];
    acc_zero(acc);
    const bf16_t* W = wukvT + (size_t)ft * 128 * 128;
    const bf16_t* X = ckvall + (size_t)tt * 128 * 128;
    if (ft < 4) {
      gemm_kloop<0>(acc, W, 128, X, 128, 128, smem, 0.f, 0.f);
      epilogue(acc, [&](int m, int n, float (&v)[16]) { st_bf16x16(Kn + (size_t)(tt * 128 + n) * 512 + ft * 128 + m, v); });
    } else {
      gemm_kloop<0>(acc, X, 128, W, 128, 128, smem, 0.f, 0.f);
      epilogue(acc, [&](int m, int n, float (&v)[16]) { st_bf16x16(Vt + (size_t)((ft - 4) * 128 + n) * NKV + tt * 128 + m, v); });
    }
  }
}

DI void conv_fp8_rows(const float* __restrict__ src, unsigned char* __restrict__ dst, float* __restrict__ inv);
DI void phase7(const Params& p, char* smem) {
  char* ws = p.ws;
  const bf16_t* q = (const bf16_t*)(ws + OFF_Q);
  const bf16_t* Kn = (const bf16_t*)(ws + OFF_KN);
  const bf16_t* Vt = (const bf16_t*)(ws + OFF_VTA);
  const bf16_t* krall = (const bf16_t*)(ws + OFF_KRALL);
  bf16_t* attn = (bf16_t*)(ws + OFF_ATTN);
  bf16_t* Ks0 = (bf16_t*)smem;
  const int tid = threadIdx.x, lane = tid & 63, w = tid >> 6, l15 = lane & 15, g = lane >> 4;
  const float qscale = 0.10206207261596577f * 1.4426950408889634f;
  for (int item = vbid(); item < 1280; item += gridDim.x) {
    int b, h, qtok0, keyrow0, nkt;
    bool sample;
    if (item < 1024) {
      sample = true; b = item >> 7; h = (item >> 4) & 7; int qb = item & 15;
      qtok0 = NPT + b * 2048 + qb * 128; keyrow0 = NPT + b * 2560; nkt = 40;
    } else {
      int it2 = item - 1024;
      sample = false; b = it2 >> 4; h = (it2 >> 1) & 7; int qb = it2 & 1;
      qtok0 = b * 256 + qb * 128; keyrow0 = b * 256; nkt = 4;
    }
    bf16x8 Q[2][3];
#pragma unroll
    for (int qt = 0; qt < 2; ++qt) {
      const int tokq = qtok0 + w * 32 + qt * 16 + l15;
      const bf16_t* qp = q + (size_t)tokq * 768 + h * 96;
#pragma unroll
      for (int ks = 0; ks < 3; ++ks) {
        u32x4 u = *(const u32x4*)(qp + ks * 32 + g * 8);
        float v[8];
#pragma unroll
        for (int i = 0; i < 4; ++i) { v[2 * i] = bflo(u[i]); v[2 * i + 1] = bfhi(u[i]); }
        if (ks == 2 && sample) {
          u32x4 up = *(const u32x4*)(qp + 64 + (g ^ 2) * 8);
          float pv[8];
#pragma unroll
          for (int i = 0; i < 4; ++i) { pv[2 * i] = bflo(up[i]); pv[2 * i + 1] = bfhi(up[i]); }
          int t = (tokq - NPT) & 2047;
          float pos = (g & 1) ? (float)(t & 63) : (float)(t >> 6);
#pragma unroll
          for (int i = 0; i < 8; ++i) {
            float fr = exp2f(-(float)i * 1.6609640474436813f);
            float sn, cs;
            sincosf(pos * fr, &sn, &cs);
            v[i] = g < 2 ? v[i] * cs - pv[i] * sn : pv[i] * sn + v[i] * cs;
          }
        }
        u32x4 o4;
#pragma unroll
        for (int i = 0; i < 4; ++i) o4[i] = pack2(v[2 * i] * qscale, v[2 * i + 1] * qscale);
        Q[qt][ks] = __builtin_bit_cast(bf16x8, o4);
      }
    }
    f32x4 o[4][2];
#pragma unroll
    for (int et = 0; et < 4; ++et)
#pragma unroll
      for (int qt = 0; qt < 2; ++qt) o[et][qt] = f32x4{0.f, 0.f, 0.f, 0.f};
    float mrun[2] = {-1e30f, -1e30f}, lrun[2] = {0.f, 0.f};
    u32x4 rk_[3], rv_[2];
    auto gload = [&](int kt) {
      const int row0 = keyrow0 + kt * 64;
#pragma unroll
      for (int i = 0; i < 3; ++i) {
        int c = tid + 256 * i;
        int r = c / 12, cc = c - r * 12;
        rk_[i] = cc < 8 ? *(const u32x4*)(Kn + (size_t)(row0 + r) * 512 + h * 64 + cc * 8)
                        : *(const u32x4*)(krall + (size_t)(row0 + r) * 32 + (cc - 8) * 8);
      }
#pragma unroll
      for (int i = 0; i < 2; ++i) {
        int c = tid + 256 * i;
        int e = c >> 3, cc = (c & 7) * 8;
        rv_[i] = *(const u32x4*)(Vt + (size_t)(h * 64 + e) * NKV + row0 + cc);
      }
    };
    auto lstore = [&](int b) {
      bf16_t* Kd = Ks0 + b * 11264;
      bf16_t* Vd = Kd + 64 * 104;
#pragma unroll
      for (int i = 0; i < 3; ++i) {
        int c = tid + 256 * i;
        int r = c / 12, cc = c - r * 12;
        *(u32x4*)(Kd + r * 104 + cc * 8) = rk_[i];
      }
#pragma unroll
      for (int i = 0; i < 2; ++i) {
        int c = tid + 256 * i;
        int e = c >> 3, cc = (c & 7) * 8;
        *(u32x4*)(Vd + e * 72 + cc) = rv_[i];
      }
    };
    gload(0);
    __syncthreads();
    lstore(0);
    if (nkt > 1) gload(1);
    __syncthreads();
#pragma unroll 1
    for (int kt = 0; kt < nkt; ++kt) {
      const bf16_t* Ks = Ks0 + (kt & 1) * 11264;
      const bf16_t* Vs = Ks + 64 * 104;
      f32x4 s[4][2];
#pragma unroll
      for (int kk = 0; kk < 4; ++kk)
#pragma unroll
        for (int qt = 0; qt < 2; ++qt) s[kk][qt] = f32x4{0.f, 0.f, 0.f, 0.f};
#pragma unroll
      for (int ks = 0; ks < 3; ++ks) {
#pragma unroll
        for (int kk = 0; kk < 4; ++kk) {
          bf16x8 a = *(const bf16x8*)(Ks + (kk * 16 + l15) * 104 + ks * 32 + g * 8);
#pragma unroll
          for (int qt = 0; qt < 2; ++qt) s[kk][qt] = __builtin_amdgcn_mfma_f32_16x16x32_bf16(a, Q[qt][ks], s[kk][qt], 0, 0, 0);
        }
      }
      bf16x8 P[2][2];
#pragma unroll
      for (int qt = 0; qt < 2; ++qt) {
        float mx = s[0][qt][0];
#pragma unroll
        for (int kk = 0; kk < 4; ++kk)
#pragma unroll
          for (int j = 0; j < 4; ++j) mx = fmaxf(mx, s[kk][qt][j]);
        mx = fmaxf(mx, __shfl_xor(mx, 16));
        mx = fmaxf(mx, __shfl_xor(mx, 32));
        const float mnew = fmaxf(mrun[qt], mx);
        const float alpha = ex2(mrun[qt] - mnew);
        mrun[qt] = mnew;
        float ps = 0.f;
#pragma unroll
        for (int kk = 0; kk < 4; ++kk)
#pragma unroll
          for (int j = 0; j < 4; ++j) {
            float e_ = ex2(s[kk][qt][j] - mnew);
            s[kk][qt][j] = e_;
            ps += e_;
          }
        lrun[qt] = lrun[qt] * alpha + ps;
#pragma unroll
        for (int et = 0; et < 4; ++et)
#pragma unroll
          for (int j = 0; j < 4; ++j) o[et][qt][j] *= alpha;
#pragma unroll
        for (int k2 = 0; k2 < 2; ++k2) {
          u32x4 u;
          u[0] = pack2(s[2 * k2][qt][0], s[2 * k2][qt][1]);
          u[1] = pack2(s[2 * k2][qt][2], s[2 * k2][qt][3]);
          u[2] = pack2(s[2 * k2 + 1][qt][0], s[2 * k2 + 1][qt][1]);
          u[3] = pack2(s[2 * k2 + 1][qt][2], s[2 * k2 + 1][qt][3]);
          P[qt][k2] = __builtin_bit_cast(bf16x8, u);
        }
      }
#pragma unroll
      for (int k2 = 0; k2 < 2; ++k2) {
#pragma unroll
        for (int et = 0; et < 4; ++et) {
          u32x2 lo = *(const u32x2*)(Vs + (et * 16 + l15) * 72 + k2 * 32 + 4 * g);
          u32x2 hi = *(const u32x2*)(Vs + (et * 16 + l15) * 72 + k2 * 32 + 16 + 4 * g);
          u32x4 u;
          u[0] = lo[0]; u[1] = lo[1]; u[2] = hi[0]; u[3] = hi[1];
          bf16x8 a = __builtin_bit_cast(bf16x8, u);
#pragma unroll
          for (int qt = 0; qt < 2; ++qt) o[et][qt] = __builtin_amdgcn_mfma_f32_16x16x32_bf16(a, P[qt][k2], o[et][qt], 0, 0, 0);
        }
      }
      if (kt + 1 < nkt) {
        lstore((kt + 1) & 1);
        if (kt + 2 < nkt) gload(kt + 2);
        __syncthreads();
      }
    }
#pragma unroll
    for (int qt = 0; qt < 2; ++qt) {
      const int tokq = qtok0 + w * 32 + qt * 16 + l15;
      float lt = lrun[qt];
      lt += __shfl_xor(lt, 16);
      lt += __shfl_xor(lt, 32);
      const float inv = 1.f / lt;
#pragma unroll
      for (int et = 0; et < 4; ++et) {
        u32x2 ov;
        ov[0] = pack2(o[et][qt][0] * inv, o[et][qt][1] * inv);
        ov[1] = pack2(o[et][qt][2] * inv, o[et][qt][3] * inv);
        *(u32x2*)(attn + (size_t)tokq * 512 + h * 64 + et * 16 + 4 * g) = ov;
      }
    }
  }
  conv_fp8_rows(p.peer_u, (unsigned char*)(p.ws + OFF_TABU), (float*)(p.ws + OFF_INVU));
  conv_fp8_rows(p.peer_v, (unsigned char*)(p.ws + OFF_TABV), (float*)(p.ws + OFF_INVV));
}

DI void phase8(const Params& p, char* smem) {
  char* ws = p.ws;
  const bf16_t* attn = (const bf16_t*)(ws + OFF_ATTN);
  const bf16_t* ret = (const bf16_t*)(ws + OFF_RET);
  const bf16_t* wa = (const bf16_t*)(ws + OFF_WUPAT);
  const bf16_t* wb = (const bf16_t*)(ws + OFF_WUPBT);
  const bf16_t* sga = (const bf16_t*)p.out;
  const bf16_t* sgb = sga + (size_t)NTOK * 1024;
  bf16_t* mbuf = (bf16_t*)(ws + OFF_M);
  const int tid = threadIdx.x, lane = tid & 63, w = tid >> 6, wm = w >> 1, wn = w & 1, l15 = lane & 15, g = lane >> 4;
  for (int it = 0;; ++it) {
    int ft, tt;
    if (!tile_map(it, 8, 160, 1, ft, tt)) break;
    f32x4 acc[4][4];
    acc_zero(acc);
    gemm_kloop<0>(acc, wa + (size_t)ft * 128 * 512, 512, attn + (size_t)tt * 128 * 512, 512, 512, smem, 0.f, 0.f);
#pragma unroll
    for (int c = 0; c < 4; ++c) {
      const size_t off = (size_t)(tt * 128 + wn * 64 + c * 16 + l15) * 1024 + ft * 128 + wm * 64 + 16 * g;
      float a[16], bq[16];
      ld_bf16x16(sga + off, a);
      ld_bf16x16(sgb + off, bq);
#pragma unroll
      for (int f = 0; f < 4; ++f)
#pragma unroll
        for (int j = 0; j < 4; ++j) acc[f][c][j] *= a[f * 4 + j] / fmaxf(bq[f * 4 + j], 1e-30f);
    }
    gemm_kloop<0>(acc, wb + (size_t)ft * 128 * 512, 512, ret + (size_t)tt * 128 * 512, 512, 512, smem, 0.f, 0.f);
    epilogue(acc, [&](int m, int n, float (&v)[16]) {
      const size_t off = (size_t)(tt * 128 + n) * 1024 + ft * 128 + m;
      float bq[16];
      ld_bf16x16(sgb + off, bq);
#pragma unroll
      for (int i = 0; i < 16; ++i) v[i] *= bq[i];
      st_bf16x16(mbuf + off, v);
    });
  }
}
DI void phase9(const Params& p, char* smem) {
  char* ws = p.ws;
  const bf16_t* mbuf = (const bf16_t*)(ws + OFF_M);
  const bf16_t* wo = (const bf16_t*)(ws + OFF_WOT);
  const float* mod = (const float*)(ws + OFF_MOD);
  for (int it = 0;; ++it) {
    int ft, tt;
    if (!tile_map(it, 8, 160, 1, ft, tt)) break;
    f32x4 acc[4][4];
    acc_zero(acc);
    gemm_kloop<0>(acc, wo + (size_t)ft * 128 * 1024, 1024, mbuf + (size_t)tt * 128 * 1024, 1024, 1024, smem, 0.f, 0.f);
    epilogue(acc, [&](int m, int n, float (&v)[16]) {
      const int tok = tt * 128 + n, feat = ft * 128 + m;
      const float* xr = xrow(p, tok) + feat;
      const float* g1 = mod + modidx(tok) * 6144 + 2048 + feat;
#pragma unroll
      for (int i = 0; i < 4; ++i) {
        float4 xv = *(const float4*)(xr + 4 * i), gv = *(const float4*)(g1 + 4 * i);
        v[4 * i] = xv.x + gv.x * v[4 * i];
        v[4 * i + 1] = xv.y + gv.y * v[4 * i + 1];
        v[4 * i + 2] = xv.z + gv.z * v[4 * i + 2];
        v[4 * i + 3] = xv.w + gv.w * v[4 * i + 3];
      }
      st_f32x16(p.out + (size_t)tok * DM + feat, v);
    });
  }
}
DI void conv_fp8_rows(const float* __restrict__ src, unsigned char* __restrict__ dst, float* __restrict__ inv) {
  const int lane = threadIdx.x & 63, w = threadIdx.x >> 6;
  for (int r = blockIdx.x * 4 + w; r < 16384; r += gridDim.x * 4) {
    const float* sp = src + (size_t)r * 1024 + lane * 16;
    float4 v[4];
    float am = 0.f;
#pragma unroll
    for (int i = 0; i < 4; ++i) {
      v[i] = *(const float4*)(sp + 4 * i);
      am = fmaxf(am, fmaxf(fmaxf(fabsf(v[i].x), fabsf(v[i].y)), fmaxf(fabsf(v[i].z), fabsf(v[i].w))));
    }
#pragma unroll
    for (int o = 32; o > 0; o >>= 1) am = fmaxf(am, __shfl_xor(am, o));
    const float sc = am > 0.f ? 448.f / am : 1.f;
    u32x4 o4;
#pragma unroll
    for (int i = 0; i < 4; ++i) {
      int wd = 0;
      wd = __builtin_amdgcn_cvt_pk_fp8_f32(v[i].x * sc, v[i].y * sc, wd, false);
      wd = __builtin_amdgcn_cvt_pk_fp8_f32(v[i].z * sc, v[i].w * sc, wd, true);
      o4[i] = (unsigned)wd;
    }
    *(u32x4*)(dst + ((size_t)(lane >> 3) * 16384 + r) * 128 + (lane & 7) * 16) = o4;
    if (lane == 0) inv[r] = am > 0.f ? am * (1.f / 448.f) : 1.f;
  }
}
DI void phase10(const Params& p, char* smem) {
  rows_norm_mod(p, p.norm_ffn, 3072, 4096, true, (bf16_t*)(p.ws + OFF_H2));
}
DI void phase11(const Params& p, char* smem) {
  char* ws = p.ws;
  const bf16_t* h2 = (const bf16_t*)(ws + OFF_H2);
  const bf16_t* wct = (const bf16_t*)(ws + OFF_WCT);
  bf16_t* sc = (bf16_t*)(ws + OFF_SCORES);
  for (int it = 0;; ++it) {
    int ft, tt;
    if (!tile_map(it, 16, 160, 2, ft, tt)) break;
    f32x4 acc[4][4];
    acc_zero(acc);
    gemm_kloop<0>(acc, wct + (size_t)ft * 128 * 1024, 1024, h2 + (size_t)tt * 128 * 1024, 1024, 1024, smem, 0.f, 0.f);
    epilogue(acc, [&](int m, int n, float (&v)[16]) { st_bf16x16(sc + (size_t)(tt * 128 + n) * 2048 + ft * 128 + m, v); });
  }
}

DI unsigned okey(float f) {
  unsigned u = __float_as_uint(f);
  return (u & 0x80000000u) ? ~u : (u | 0x80000000u);
}
DI void wave_lds_sync() {
  __builtin_amdgcn_fence(__ATOMIC_ACQ_REL, "workgroup");
  __builtin_amdgcn_wave_barrier();
}
DI unsigned okey16(unsigned b) { return (b & 0x8000u) ? (~b & 0xFFFFu) : (b | 0x8000u); }
DI unsigned inv_okey16(unsigned k) { return (k & 0x8000u) ? (k & 0x7FFFu) : (~k & 0xFFFFu); }
DI unsigned inv_okey(unsigned k) { return (k & 0x80000000u) ? (k & 0x7FFFFFFFu) : ~k; }
DI void ins16(unsigned (&L)[16], unsigned x) {
#pragma unroll
  for (int i = 0; i < 16; ++i) {
    unsigned t = max(L[i], x);
    x = min(L[i], x);
    L[i] = t;
  }
}
DI unsigned sel16(const unsigned (&A)[16], int i) {
  unsigned r = 0u;
#pragma unroll
  for (int t = 0; t < 16; ++t) r |= A[t] & (0u - (unsigned)(i == t));
  return r;
}
DI void phase12(const Params& p, char* smem) {
  char* ws = p.ws;
  const bf16_t* sc = (const bf16_t*)(ws + OFF_SCORES);
  int* elist = (int*)(ws + OFF_ELIST);
  float* glist = (float*)(ws + OFF_GLIST);
  const int lane = threadIdx.x & 63, w = threadIdx.x >> 6;
  for (int batch = blockIdx.x * 4 + w; batch < NTOK / 4; batch += gridDim.x * 4) {
    const int tok = batch * 4 + (lane >> 4), hh = lane & 15;
    const bf16_t* row = sc + (size_t)tok * 2048 + hh * 128;
    unsigned L[16];
#pragma unroll
    for (int i = 0; i < 16; ++i) L[i] = 0u;
#pragma unroll
    for (int c = 0; c < 16; ++c) {
      u32x4 u = *(const u32x4*)(row + c * 8);
#pragma unroll
      for (int i = 0; i < 4; ++i) {
        unsigned b0 = u[i] & 0xFFFFu, b1 = u[i] >> 16;
        ins16(L, (okey16(b0) << 16) | (unsigned)(127 - (c * 8 + 2 * i)));
        ins16(L, (okey16(b1) << 16) | (unsigned)(127 - (c * 8 + 2 * i + 1)));
      }
    }
    unsigned M[16];
#pragma unroll
    for (int i = 0; i < 16; ++i) M[i] = (unsigned)__shfl_xor((int)L[i], 1);
    float v1[16], v2[16];
#pragma unroll
    for (int i = 0; i < 16; ++i) {
      v1[i] = bf2f(inv_okey16(L[i] >> 16));
      v2[i] = bf2f(inv_okey16(M[i] >> 16));
    }
    unsigned C[16];
#pragma unroll
    for (int i = 0; i < 16; ++i) C[i] = 0u;
    ins16(C, (okey(v1[0] + v2[0]) & 0xFFFFFF00u) | 255u);
    ins16(C, (okey(v1[0] + v2[1]) & 0xFFFFFF00u) | 254u);
    ins16(C, (okey(v1[0] + v2[2]) & 0xFFFFFF00u) | 253u);
    ins16(C, (okey(v1[0] + v2[3]) & 0xFFFFFF00u) | 252u);
    ins16(C, (okey(v1[0] + v2[4]) & 0xFFFFFF00u) | 251u);
    ins16(C, (okey(v1[0] + v2[5]) & 0xFFFFFF00u) | 250u);
    ins16(C, (okey(v1[0] + v2[6]) & 0xFFFFFF00u) | 249u);
    ins16(C, (okey(v1[0] + v2[7]) & 0xFFFFFF00u) | 248u);
    ins16(C, (okey(v1[0] + v2[8]) & 0xFFFFFF00u) | 247u);
    ins16(C, (okey(v1[0] + v2[9]) & 0xFFFFFF00u) | 246u);
    ins16(C, (okey(v1[0] + v2[10]) & 0xFFFFFF00u) | 245u);
    ins16(C, (okey(v1[0] + v2[11]) & 0xFFFFFF00u) | 244u);
    ins16(C, (okey(v1[0] + v2[12]) & 0xFFFFFF00u) | 243u);
    ins16(C, (okey(v1[0] + v2[13]) & 0xFFFFFF00u) | 242u);
    ins16(C, (okey(v1[0] + v2[14]) & 0xFFFFFF00u) | 241u);
    ins16(C, (okey(v1[0] + v2[15]) & 0xFFFFFF00u) | 240u);
    ins16(C, (okey(v1[1] + v2[0]) & 0xFFFFFF00u) | 239u);
    ins16(C, (okey(v1[1] + v2[1]) & 0xFFFFFF00u) | 238u);
    ins16(C, (okey(v1[1] + v2[2]) & 0xFFFFFF00u) | 237u);
    ins16(C, (okey(v1[1] + v2[3]) & 0xFFFFFF00u) | 236u);
    ins16(C, (okey(v1[1] + v2[4]) & 0xFFFFFF00u) | 235u);
    ins16(C, (okey(v1[1] + v2[5]) & 0xFFFFFF00u) | 234u);
    ins16(C, (okey(v1[1] + v2[6]) & 0xFFFFFF00u) | 233u);
    ins16(C, (okey(v1[1] + v2[7]) & 0xFFFFFF00u) | 232u);
    ins16(C, (okey(v1[2] + v2[0]) & 0xFFFFFF00u) | 223u);
    ins16(C, (okey(v1[2] + v2[1]) & 0xFFFFFF00u) | 222u);
    ins16(C, (okey(v1[2] + v2[2]) & 0xFFFFFF00u) | 221u);
    ins16(C, (okey(v1[2] + v2[3]) & 0xFFFFFF00u) | 220u);
    ins16(C, (okey(v1[2] + v2[4]) & 0xFFFFFF00u) | 219u);
    ins16(C, (okey(v1[3] + v2[0]) & 0xFFFFFF00u) | 207u);
    ins16(C, (okey(v1[3] + v2[1]) & 0xFFFFFF00u) | 206u);
    ins16(C, (okey(v1[3] + v2[2]) & 0xFFFFFF00u) | 205u);
    ins16(C, (okey(v1[3] + v2[3]) & 0xFFFFFF00u) | 204u);
    ins16(C, (okey(v1[4] + v2[0]) & 0xFFFFFF00u) | 191u);
    ins16(C, (okey(v1[4] + v2[1]) & 0xFFFFFF00u) | 190u);
    ins16(C, (okey(v1[4] + v2[2]) & 0xFFFFFF00u) | 189u);
    ins16(C, (okey(v1[5] + v2[0]) & 0xFFFFFF00u) | 175u);
    ins16(C, (okey(v1[5] + v2[1]) & 0xFFFFFF00u) | 174u);
    ins16(C, (okey(v1[6] + v2[0]) & 0xFFFFFF00u) | 159u);
    ins16(C, (okey(v1[6] + v2[1]) & 0xFFFFFF00u) | 158u);
    ins16(C, (okey(v1[7] + v2[0]) & 0xFFFFFF00u) | 143u);
    ins16(C, (okey(v1[7] + v2[1]) & 0xFFFFFF00u) | 142u);
    ins16(C, (okey(v1[8] + v2[0]) & 0xFFFFFF00u) | 127u);
    ins16(C, (okey(v1[9] + v2[0]) & 0xFFFFFF00u) | 111u);
    ins16(C, (okey(v1[10] + v2[0]) & 0xFFFFFF00u) | 95u);
    ins16(C, (okey(v1[11] + v2[0]) & 0xFFFFFF00u) | 79u);
    ins16(C, (okey(v1[12] + v2[0]) & 0xFFFFFF00u) | 63u);
    ins16(C, (okey(v1[13] + v2[0]) & 0xFFFFFF00u) | 47u);
    ins16(C, (okey(v1[14] + v2[0]) & 0xFFFFFF00u) | 31u);
    ins16(C, (okey(v1[15] + v2[0]) & 0xFFFFFF00u) | 15u);
    int ev[16];
    float gv[16];
    const float mx = __uint_as_float(inv_okey(C[0] & 0xFFFFFF00u));
    float den = 0.f;
#pragma unroll
    for (int k = 0; k < 16; ++k) {
      const int ci = 255 - (int)(C[k] & 0xFFu);
      const unsigned a1 = sel16(L, ci >> 4), a2 = sel16(M, ci & 15);
      ev[k] = (127 - (int)(a1 & 0xFFFFu)) * 128 + (127 - (int)(a2 & 0xFFFFu));
      gv[k] = __expf(__uint_as_float(inv_okey(C[k] & 0xFFFFFF00u)) - mx);
      den += gv[k];
    }
    const float inv = 1.f / den;
    if ((lane & 1) == 0) {
      int* ep = elist + (size_t)tok * 128 + (hh >> 1) * 16;
      float* gp = glist + (size_t)tok * 128 + (hh >> 1) * 16;
#pragma unroll
      for (int k = 0; k < 4; ++k) {
        *(int4*)(ep + 4 * k) = make_int4(ev[4 * k], ev[4 * k + 1], ev[4 * k + 2], ev[4 * k + 3]);
        *(float4*)(gp + 4 * k) = make_float4(gv[4 * k] * inv, gv[4 * k + 1] * inv, gv[4 * k + 2] * inv, gv[4 * k + 3] * inv);
      }
    }
  }
}
using f32x2 = __attribute__((ext_vector_type(2))) float;
DI f32x2 cvt8(unsigned w, bool hi) {
  return hi ? __builtin_amdgcn_cvt_pk_f32_fp8((int)w, true) : __builtin_amdgcn_cvt_pk_f32_fp8((int)w, false);
}
struct SMeta { int e[16]; u32x4 ha, hb; };
template <int MODE>
DI void sl_meta(const Params& p, int t, int s, int grp, int ch, SMeta& m) {
  const int* elist = (const int*)(p.ws + (MODE == 0 ? OFF_ELIST : OFF_GLIST));
#pragma unroll
  for (int i = 0; i < 16; ++i) m.e[i] = elist[(size_t)t * 128 + i * 8 + grp];
  if (MODE == 0) {
    const bf16_t* hq = (const bf16_t*)(p.ws + OFF_H2) + (size_t)t * DM + s * 128 + ch * 16;
    m.ha = *(const u32x4*)hq;
    m.hb = *(const u32x4*)(hq + 8);
  }
}
template <int MODE>
DI void sl_rows(const Params& p, int s, int ch, const SMeta& m, u32x4 (&r)[16]) {
  const unsigned char* tab = (const unsigned char*)(p.ws + (MODE == 0 ? OFF_TABU : OFF_TABV));
#pragma unroll
  for (int i = 0; i < 16; ++i) r[i] = *(const u32x4*)(tab + ((size_t)s * 16384 + (m.e[i] & 0xFFFF)) * 128 + ch * 16);
}
template <int MODE>
DI void sl_compute(const Params& p, int t, int s, int lane, const SMeta& m, const u32x4 (&r)[16]) {
  const int grp = lane >> 3, ch = lane & 7;
  if (MODE == 0) {
    f32x2 hp[8];
#pragma unroll
    for (int i = 0; i < 4; ++i) {
      hp[i] = f32x2{bflo(m.ha[i]), bfhi(m.ha[i])};
      hp[4 + i] = f32x2{bflo(m.hb[i]), bfhi(m.hb[i])};
    }
    float keep0 = 0.f, keep1 = 0.f;
#pragma unroll
    for (int i = 0; i < 16; ++i) {
      f32x2 d2 = f32x2{0.f, 0.f};
#pragma unroll
      for (int j = 0; j < 4; ++j) {
        d2 += cvt8(r[i][j], false) * hp[2 * j];
        d2 += cvt8(r[i][j], true) * hp[2 * j + 1];
      }
      float d = d2[0] + d2[1];
      d += __shfl_xor(d, 1);
      d += __shfl_xor(d, 2);
      d += __shfl_xor(d, 4);
      if (i < 8) keep0 = (ch == i) ? d : keep0;
      else keep1 = (ch == i - 8) ? d : keep1;
    }
    float* po = (float*)(p.ws + OFF_PD) + (size_t)t * 1024 + s * 128;
    po[ch * 8 + grp] = keep0;
    po[(ch + 8) * 8 + grp] = keep1;
  } else {
    f32x2 acc[8];
#pragma unroll
    for (int q = 0; q < 8; ++q) acc[q] = f32x2{0.f, 0.f};
#pragma unroll
    for (int i = 0; i < 16; ++i) {
      const float wsc = __uint_as_float((unsigned)m.e[i] & 0xFFFF0000u);
      const f32x2 w2 = f32x2{wsc, wsc};
#pragma unroll
      for (int j = 0; j < 4; ++j) {
        acc[2 * j] += w2 * cvt8(r[i][j], false);
        acc[2 * j + 1] += w2 * cvt8(r[i][j], true);
      }
    }
    float v[16];
#pragma unroll
    for (int q = 0; q < 8; ++q) { v[2 * q] = acc[q][0]; v[2 * q + 1] = acc[q][1]; }
    float q8[8], q4[4], q2[2];
    {
      const bool hi = lane & 32;
#pragma unroll
      for (int i = 0; i < 8; ++i) {
        float send = hi ? v[i] : v[8 + i], keep = hi ? v[8 + i] : v[i];
        q8[i] = keep + __shfl_xor(send, 32);
      }
    }
    {
      const bool hi = lane & 16;
#pragma unroll
      for (int i = 0; i < 4; ++i) {
        float send = hi ? q8[i] : q8[4 + i], keep = hi ? q8[4 + i] : q8[i];
        q4[i] = keep + __shfl_xor(send, 16);
      }
    }
    {
      const bool hi = lane & 8;
#pragma unroll
      for (int i = 0; i < 2; ++i) {
        float send = hi ? q4[i] : q4[2 + i], keep = hi ? q4[2 + i] : q4[i];
        q2[i] = keep + __shfl_xor(send, 8);
      }
    }
    const int f = s * 128 + ch * 16 + 2 * grp;
    float* xr = p.out + (size_t)t * DM + f;
    const float2 xv = *(const float2*)xr;
    const float2 gv = *(const float2*)((const float*)(p.ws + OFF_MOD) + modidx(t) * 6144 + 5120 + f);
    *(float2*)xr = make_float2(xv.x + gv.x * q2[0], xv.y + gv.y * q2[1]);
  }
}
template <int MODE>
DI void sliced_pass(const Params& p) {
  const int s = blockIdx.x & 7, loc = blockIdx.x >> 3, nloc = gridDim.x >> 3;
  if (loc >= nloc) return;
  const int lane = threadIdx.x & 63, w = threadIdx.x >> 6, grp = lane >> 3, ch = lane & 7;
  const int stride = nloc * 4;
  SMeta mA, mB;
  u32x4 rA[16], rB[16];
  int t = loc * 4 + w;
  if (t < NTOK) {
    sl_meta<MODE>(p, t, s, grp, ch, mA);
    sl_rows<MODE>(p, s, ch, mA, rA);
  }
  if (t + stride < NTOK) sl_meta<MODE>(p, t + stride, s, grp, ch, mB);
#pragma unroll 1
  for (; t < NTOK; t += 2 * stride) {
    const int t1 = t + stride, t2 = t + 2 * stride, t3 = t + 3 * stride;
    if (t1 < NTOK) sl_rows<MODE>(p, s, ch, mB, rB);
    sl_compute<MODE>(p, t, s, lane, mA, rA);
    if (t2 < NTOK) sl_meta<MODE>(p, t2, s, grp, ch, mA);
    if (t1 < NTOK) {
      if (t2 < NTOK) sl_rows<MODE>(p, s, ch, mA, rA);
      sl_compute<MODE>(p, t1, s, lane, mB, rB);
      if (t3 < NTOK) sl_meta<MODE>(p, t3, s, grp, ch, mB);
    }
  }
}
DI void phase13(const Params& p) { sliced_pass<0>(p); }
DI void phase14(const Params& p) {
  char* ws = p.ws;
  const float* invU = (const float*)(ws + OFF_INVU);
  const float* invV = (const float*)(ws + OFF_INVV);
  const int* elist = (const int*)(ws + OFF_ELIST);
  float* glist = (float*)(ws + OFF_GLIST);
  const float* pd = (const float*)(ws + OFF_PD);
  const int lane = threadIdx.x & 63, w = threadIdx.x >> 6;
  for (int t = blockIdx.x * 4 + w; t < NTOK; t += gridDim.x * 4) {
#pragma unroll
    for (int hf_ = 0; hf_ < 2; ++hf_) {
      const int k = hf_ * 64 + lane;
      float d = 0.f;
#pragma unroll
      for (int s = 0; s < 8; ++s) d += pd[(size_t)t * 1024 + s * 128 + k];
      const int e = elist[(size_t)t * 128 + k];
      const float g = glist[(size_t)t * 128 + k];
      ((unsigned*)glist)[(size_t)t * 128 + k] = (pack2(0.f, g * geluf_(d * invU[e]) * invV[e]) & 0xFFFF0000u) | (unsigned)e;
    }
  }
}
DI void phase15(const Params& p) { sliced_pass<1>(p); }
DI void phase16(const Params& p) {
  const int lane = threadIdx.x & 63, w = threadIdx.x >> 6;
  for (int tok = blockIdx.x * 4 + w; tok < NTOK; tok += gridDim.x * 4) {
    float* xr = p.out + (size_t)tok * DM;
    float4 xv[4];
    float ss = 0.f;
#pragma unroll
    for (int i = 0; i < 4; ++i) {
      xv[i] = *(const float4*)(xr + (i * 64 + lane) * 4);
      ss += xv[i].x * xv[i].x + xv[i].y * xv[i].y + xv[i].z * xv[i].z + xv[i].w * xv[i].w;
    }
    ss = wsum(ss);
    const float rstd = rsqrtf(ss * (1.f / 1024.f) + 1e-6f);
#pragma unroll
    for (int i = 0; i < 4; ++i) {
      const int e = (i * 64 + lane) * 4;
      float4 nf = *(const float4*)(p.norm_final + e);
      *(float4*)(xr + e) = make_float4(xv[i].x * rstd * nf.x, xv[i].y * rstd * nf.y, xv[i].z * rstd * nf.z, xv[i].w * rstd * nf.w);
    }
  }
}

#define XB_TMO      128
#define XB_XCNT(j)  (256  + 64 * (j))
#define XB_XSUB(j)  (1280 + 64 * (j))
#define XB_XGEN(j)  (2304 + 64 * (j))
#define XB_TOP      3328
#define XB_TOPGEN   3392
#define XCD_BAR_WORDS 3456
#define XB_SPIN_CAP (1u << 22)
#define LAS __attribute__((address_space(3)))
DI unsigned xb_ld(unsigned* p) { return __hip_atomic_load(p, __ATOMIC_RELAXED, __HIP_MEMORY_SCOPE_AGENT); }
DI unsigned xb_add(unsigned* p, unsigned v) { return __hip_atomic_fetch_add(p, v, __ATOMIC_RELAXED, __HIP_MEMORY_SCOPE_AGENT); }
DI unsigned xb_xcc_id() { return (unsigned)__builtin_amdgcn_s_getreg((3 << 11) | 20) & 0xFu; }
#define XB_SPIN(cond, bar) do { unsigned _sp = 0; while (cond) { __builtin_amdgcn_s_sleep(1); \
    if ((++_sp & 255u) == 0u) { if (xb_ld(&(bar)[XB_TMO])) break; if (_sp > XB_SPIN_CAP) { atomicAdd(&(bar)[XB_TMO], 1u); break; } } } } while (0)
struct XcdBarrier { unsigned* bar; unsigned x; volatile LAS unsigned* st; };
DI XcdBarrier xcd_barrier_post(unsigned* bar, volatile LAS unsigned* st) {
  XcdBarrier b; b.bar = bar; b.x = xb_xcc_id(); b.st = st;
  if (threadIdx.x == 0) (void)xb_add(&bar[XB_XCNT(b.x)], 1u);
  return b;
}
DI void xcd_barrier_complete(unsigned* bar, unsigned x, unsigned& nloc, unsigned& nx) {
  const unsigned G = gridDim.x * gridDim.y * gridDim.z;
  unsigned sum, cnt, mine, sp = 0u;
  for (;;) {
    sum = 0u; cnt = 0u; mine = 0u;
#pragma unroll
    for (unsigned j = 0; j < 16; ++j) { const unsigned c = xb_ld(&bar[XB_XCNT(j)]); sum += c; cnt += (c > 0u) ? 1u : 0u; mine = (j == x) ? c : mine; }
    if (sum == G) break;
    __builtin_amdgcn_s_sleep(1);
    if ((++sp & 255u) == 0u) { if (xb_ld(&bar[XB_TMO])) break; if (sp > XB_SPIN_CAP) { atomicAdd(&bar[XB_TMO], 1u); break; } }
  }
  nloc = mine > 0u ? mine : 1u; nx = cnt > 0u ? cnt : 1u;
}
DI void xcd_barrier(const XcdBarrier& b) {
  asm volatile("s_waitcnt vmcnt(0)" ::: "memory");
  __syncthreads();
  if (threadIdx.x == 0) {
    unsigned* bar = b.bar;
    __builtin_amdgcn_s_waitcnt(0);
    unsigned nloc = b.st[0], nx = b.st[1];
    if (nloc == 0u) { xcd_barrier_complete(bar, b.x, nloc, nx); b.st[0] = nloc; b.st[1] = nx; }
    const unsigned old = xb_add(&bar[XB_XSUB(b.x)], 1u);
    const unsigned gen = old / nloc;
    if (old + 1u == (gen + 1u) * nloc) {
      __builtin_amdgcn_fence(__ATOMIC_RELEASE, "agent");
      asm volatile("s_waitcnt vmcnt(0)" ::: "memory");
      const unsigned og = xb_add(&bar[XB_TOP], 1u);
      const unsigned tg = og / nx;
      if (og + 1u == (tg + 1u) * nx) xb_add(&bar[XB_TOPGEN], 1u);
      else XB_SPIN(xb_ld(&bar[XB_TOPGEN]) == tg, bar);
      __builtin_amdgcn_fence(__ATOMIC_ACQUIRE, "agent");
      xb_add(&bar[XB_XGEN(b.x)], 1u);
      asm volatile("s_waitcnt vmcnt(0)" ::: "memory");
    } else {
      XB_SPIN(xb_ld(&bar[XB_XGEN(b.x)]) == gen, bar);
      __builtin_amdgcn_fence(__ATOMIC_ACQUIRE, "agent");
      asm volatile("s_waitcnt vmcnt(0)" ::: "memory");
    }
  }
  __syncthreads();
}

#ifdef ONLY_PHASE
#define RUNPH(n, call) if (ONLY_PHASE == n) { call; }
#else
#ifndef DUP_PHASE
#define DUP_PHASE -1
#endif
#define RUNPH(n, call) if (lo <= n && n < hi) { call; if (n == DUP_PHASE) { xcd_barrier(xb); call; } if (n + 1 < hi) xcd_barrier(xb); }
#endif
__global__ void __launch_bounds__(256, 2) mega(Params p, int lo, int hi) {
  __shared__ __attribute__((aligned(16))) char smem[SMEM_BYTES];
  __shared__ uint4 xb_words;
  cg::grid_group grid = cg::this_grid();
  if (lo < 0) grid.sync();
  if (threadIdx.x == 0) xb_words = make_uint4(0u, 0u, 0u, 0u);
  __syncthreads();
  XcdBarrier xb = xcd_barrier_post((unsigned*)(p.ws + OFF_BAR), (volatile LAS unsigned*)&xb_words);
  RUNPH(0, phase0(p, smem))
  RUNPH(1, phase1(p, smem))
  RUNPH(2, phase2(p, smem))
  RUNPH(3, phase3(p, smem))
  RUNPH(4, phase4(p))
  RUNPH(5, phase5(p, smem))
  RUNPH(6, phase6(p, smem))
  RUNPH(7, phase7(p, smem))
  RUNPH(8, phase8(p, smem))
  RUNPH(9, phase9(p, smem))
  RUNPH(10, phase10(p, smem))
  RUNPH(11, phase11(p, smem))
  RUNPH(12, phase12(p, smem))
  RUNPH(13, phase13(p))
  RUNPH(14, phase14(p))
  RUNPH(15, phase15(p))
  RUNPH(16, phase16(p))
}

extern "C" void kernel_launch(void* const* d_in, const int* in_sizes, int n_in, void* d_out, int out_size, void* d_ws,
                              size_t ws_size, hipStream_t stream) {
  static int grid_blocks = 0;
  if (!grid_blocks) {
    int dev = 0, cus = 0, per_cu = 0;
    hipGetDevice(&dev);
    hipDeviceGetAttribute(&cus, hipDeviceAttributeMultiprocessorCount, dev);
    hipOccupancyMaxActiveBlocksPerMultiprocessor(&per_cu, mega, 256, 0);
    if (per_cu > 2) per_cu = 2;
    if (per_cu < 1) per_cu = 1;
    grid_blocks = cus * per_cu;
  }
  Params p{};
  const float** pp = (const float**)&p;
  for (int i = 0; i < 29; ++i) pp[i] = (const float*)d_in[i];
  p.out = (float*)d_out;
  p.ws = (char*)d_ws;
#if N_LAUNCH_SPLIT
  for (int ph = 0; ph < NPHASE; ++ph) {
    hipLaunchKernelGGL(mega, dim3(grid_blocks), dim3(256), 0, stream, p, ph, ph + 1);
  }
#else
  hipMemsetAsync((char*)d_ws + OFF_MOD, 0, (OFF_BAR - OFF_MOD) + XCD_BAR_WORDS * sizeof(unsigned), stream);
  int lo = 0, hi = NPHASE;
  void* args[] = {&p, &lo, &hi};
  hipError_t e = hipLaunchCooperativeKernel((void*)mega, dim3(grid_blocks), dim3(256), args, 0, stream);
  if (e != hipSuccess) fprintf(stderr, "cooperative launch failed: %s (grid %d)\n", hipGetErrorString(e), grid_blocks);
#endif
}
```

```cpp
#include <hip/hip_runtime.h>
#include <hip/hip_cooperative_groups.h>
#include <cstdio>
namespace cg = cooperative_groups;

#define DI __device__ __forceinline__
typedef unsigned short bf16_t;
using bf16x8 = __attribute__((ext_vector_type(8))) short;
using f32x4 = __attribute__((ext_vector_type(4))) float;
using u32x4 = __attribute__((ext_vector_type(4))) unsigned;
using u32x2 = __attribute__((ext_vector_type(2))) unsigned;

#ifndef N_LAUNCH_SPLIT
#define N_LAUNCH_SPLIT 0
#endif

constexpr int NTOK = 20480, NPT = 4096, DM = 1024;
constexpr int NPHASE = 17;
constexpr size_t MiB = 1u << 20;
constexpr size_t OFF_WINT = 0, OFF_WUQT = 9 * MiB, OFF_WUKVT = 9 * MiB + 512 * 1024, OFF_WUPAT = 10 * MiB,
                 OFF_WUPBT = 11 * MiB, OFF_WOT = 12 * MiB, OFF_WCT = 14 * MiB, OFF_WPQB = 18 * MiB,
                 OFF_KEYSB = 22 * MiB, OFF_MOD = 22 * MiB + 512 * 1024, OFF_BAR = 22 * MiB + 768 * 1024, A0 = 24 * MiB;
constexpr size_t OFF_PD = A0 + 104 * MiB, OFF_H1 = A0 + 0, OFF_CQ = A0 + 40 * MiB, OFF_CKVRAW = A0 + 50 * MiB, OFF_KRRAW = A0 + 60 * MiB,
                 OFF_RQ = A0 + 63 * MiB, OFF_RK = A0 + 83 * MiB, OFF_KT = A0 + 103 * MiB, OFF_VT = A0 + 123 * MiB,
                 OFF_SRG = A0 + 143 * MiB, OFF_CKVALL = A0 + 163 * MiB, OFF_KRALL = A0 + 169 * MiB,
                 OFF_UF = A0 + 171 * MiB, OFF_UB = A0 + 187 * MiB,
                 OFF_SF = A0 + 0, OFF_SB = A0 + 8 * MiB, OFF_RET = A0 + 16 * MiB,
                 OFF_Q = A0 + 63 * MiB, OFF_KN = A0 + 93 * MiB, OFF_VTA = A0 + 117 * MiB, OFF_ATTN = A0 + 141 * MiB,
                 OFF_M = A0 + 163 * MiB,
                 OFF_H2 = A0 + 56 * MiB, OFF_TABU = A0 + 36 * MiB, OFF_TABV = A0 + 0, OFF_INVU = A0 + 52 * MiB,
                 OFF_INVV = A0 + 53 * MiB, OFF_ELIST = A0 + 16 * MiB, OFF_GLIST = A0 + 26 * MiB, OFF_SCORES = A0 + 104 * MiB;
constexpr size_t OUT_CKV = 20971520, OUT_KR = 21495808, OUT_SF = 21626880, OUT_SB = 22675456;
constexpr int NKV = 24576;
constexpr int SMEM_BYTES = 73728;

struct Params {
  const float *x_prompt, *x_sample, *c, *cache_ckv, *cache_krope, *st_f, *st_b, *c_ctx, *w_mod, *b_mod, *norm_mix,
      *norm_ffn, *norm_final, *w_in, *q_norm, *kv_norm, *w_uq, *w_ukv, *lg_f, *lg_b, *ret_gn, *w_up_a, *w_up_b, *w_o,
      *peer_wq, *keys1, *keys2, *peer_u, *peer_v;
  float* out;
  char* ws;
};

DI unsigned f2bf(float x) {
  unsigned u = __float_as_uint(x);
  u += 0x7fffu + ((u >> 16) & 1u);
  return u >> 16;
}
DI float bf2f(unsigned b) { return __uint_as_float(b << 16); }
typedef __bf16 hbf16x2_t __attribute__((ext_vector_type(2)));
typedef float hf32x2_t __attribute__((ext_vector_type(2)));
DI unsigned pack2(float a, float b) {
  hf32x2_t f = {a, b};
  return __builtin_bit_cast(unsigned, __builtin_convertvector(f, hbf16x2_t));
}
DI float ex2(float x) { return __builtin_amdgcn_exp2f(x); }
DI float bflo(unsigned u) { return __uint_as_float(u << 16); }
DI float bfhi(unsigned u) { return __uint_as_float(u & 0xffff0000u); }
DI float wsum(float v) {
#pragma unroll
  for (int o = 32; o > 0; o >>= 1) v += __shfl_xor(v, o);
  return v;
}
DI float sigmoidf_(float x) { return 1.f / (1.f + __expf(-x)); }
DI float siluf_(float x) { return x / (1.f + __expf(-x)); }
DI float geluf_(float x) { return 0.5f * x * (1.f + tanhf(0.7978845608028654f * (x + 0.044715f * x * x * x))); }
DI const float* xrow(const Params& p, int tok) {
  return tok < NPT ? p.x_prompt + (size_t)tok * DM : p.x_sample + (size_t)(tok - NPT) * DM;
}
DI int modidx(int tok) { return tok < NPT ? 0 : 1 + ((tok - NPT) >> 11); }
DI int kvrow(int tok) {
  if (tok < NPT) return tok;
  int t = tok - NPT;
  return NPT + (t >> 11) * 2560 + (t & 2047);
}
DI void st_bf16x16(bf16_t* dst, const float (&v)[16]) {
  u32x4 a, b;
  a[0] = pack2(v[0], v[1]); a[1] = pack2(v[2], v[3]); a[2] = pack2(v[4], v[5]); a[3] = pack2(v[6], v[7]);
  b[0] = pack2(v[8], v[9]); b[1] = pack2(v[10], v[11]); b[2] = pack2(v[12], v[13]); b[3] = pack2(v[14], v[15]);
  *(u32x4*)dst = a;
  *(u32x4*)(dst + 8) = b;
}
DI void st_f32x16(float* dst, const float (&v)[16]) {
#pragma unroll
  for (int i = 0; i < 4; ++i) *(float4*)(dst + 4 * i) = make_float4(v[4 * i], v[4 * i + 1], v[4 * i + 2], v[4 * i + 3]);
}
DI void ld_bf16x16(const bf16_t* src, float (&v)[16]) {
  u32x4 a = *(const u32x4*)src, b = *(const u32x4*)(src + 8);
#pragma unroll
  for (int i = 0; i < 4; ++i) {
    v[2 * i] = bflo(a[i]); v[2 * i + 1] = bfhi(a[i]);
    v[8 + 2 * i] = bflo(b[i]); v[8 + 2 * i + 1] = bfhi(b[i]);
  }
}

constexpr int LDK = 72;
template <int SCALE>
DI void gemm_kloop(f32x4 (&acc)[4][4], const bf16_t* __restrict__ A, int lda, const bf16_t* __restrict__ B, int ldb,
                   int K, char* smem, float sc_a, float sc_b) {
  bf16_t* As = (bf16_t*)smem;
  bf16_t* Bs = As + 128 * LDK;
  const int tid = threadIdx.x, lane = tid & 63, w = tid >> 6, wm = w >> 1, wn = w & 1, l15 = lane & 15, g = lane >> 4;
  u32x4 ra[4], rb[4];
  int arow[4], kc[4], ldsa[4], ldsb[4];
#pragma unroll
  for (int i = 0; i < 4; ++i) {
    int c = tid + 256 * i;
    int r = c >> 3;
    kc[i] = (c & 7) * 8;
    arow[i] = r;
    int rr = r & 63;
    int rho = (r & 64) | (((rr >> 2) & 3) << 4) | ((rr >> 4) << 2) | (rr & 3);
    ldsa[i] = rho * LDK + kc[i];
    ldsb[i] = r * LDK + kc[i];
  }
#pragma unroll
  for (int i = 0; i < 4; ++i) {
    ra[i] = *(const u32x4*)(A + (size_t)arow[i] * lda + kc[i]);
    rb[i] = *(const u32x4*)(B + (size_t)arow[i] * ldb + kc[i]);
  }
  __syncthreads();
#pragma unroll
  for (int i = 0; i < 4; ++i) {
    *(u32x4*)(As + ldsa[i]) = ra[i];
    *(u32x4*)(Bs + ldsb[i]) = rb[i];
  }
  if (64 < K) {
#pragma unroll
    for (int i = 0; i < 4; ++i) {
      ra[i] = *(const u32x4*)(A + (size_t)arow[i] * lda + 64 + kc[i]);
      rb[i] = *(const u32x4*)(B + (size_t)arow[i] * ldb + 64 + kc[i]);
    }
  }
  __syncthreads();
  int buf = 0;
  for (int k0 = 0; k0 < K; k0 += 64, buf ^= 1) {
    const bf16_t* Ac = As + buf * (256 * LDK);
    const bf16_t* Bc = Bs + buf * (256 * LDK);
#pragma unroll
    for (int ks = 0; ks < 2; ++ks) {
      bf16x8 af[4], bfr[4];
#pragma unroll
      for (int f = 0; f < 4; ++f)
        af[f] = *(const bf16x8*)(Ac + (wm * 64 + f * 16 + l15) * LDK + ks * 32 + g * 8);
#pragma unroll
      for (int c = 0; c < 4; ++c)
        bfr[c] = *(const bf16x8*)(Bc + (wn * 64 + c * 16 + l15) * LDK + ks * 32 + g * 8);
      if (SCALE) {
        float fac[8];
#pragma unroll
        for (int i = 0; i < 8; ++i) fac[i] = ex2(sc_a + sc_b * (float)(k0 + ks * 32 + g * 8 + i));
#pragma unroll
        for (int f = 0; f < 4; ++f) {
          u32x4 u = __builtin_bit_cast(u32x4, af[f]);
#pragma unroll
          for (int i = 0; i < 4; ++i) u[i] = pack2(bflo(u[i]) * fac[2 * i], bfhi(u[i]) * fac[2 * i + 1]);
          af[f] = __builtin_bit_cast(bf16x8, u);
        }
      }
#pragma unroll
      for (int f = 0; f < 4; ++f)
#pragma unroll
        for (int c = 0; c < 4; ++c) acc[f][c] = __builtin_amdgcn_mfma_f32_16x16x32_bf16(af[f], bfr[c], acc[f][c], 0, 0, 0);
    }
    if (k0 + 64 < K) {
      bf16_t* An = As + (buf ^ 1) * (256 * LDK);
      bf16_t* Bn = Bs + (buf ^ 1) * (256 * LDK);
#pragma unroll
      for (int i = 0; i < 4; ++i) {
        *(u32x4*)(An + ldsa[i]) = ra[i];
        *(u32x4*)(Bn + ldsb[i]) = rb[i];
      }
      if (k0 + 128 < K) {
#pragma unroll
        for (int i = 0; i < 4; ++i) {
          ra[i] = *(const u32x4*)(A + (size_t)arow[i] * lda + k0 + 128 + kc[i]);
          rb[i] = *(const u32x4*)(B + (size_t)arow[i] * ldb + k0 + 128 + kc[i]);
        }
      }
      __syncthreads();
    }
  }
}
DI void acc_zero(f32x4 (&acc)[4][4]) {
#pragma unroll
  for (int f = 0; f < 4; ++f)
#pragma unroll
    for (int c = 0; c < 4; ++c) acc[f][c] = f32x4{0.f, 0.f, 0.f, 0.f};
}
template <class F>
DI void epilogue(const f32x4 (&acc)[4][4], F&& epi) {
  const int tid = threadIdx.x, lane = tid & 63, w = tid >> 6, wm = w >> 1, wn = w & 1, l15 = lane & 15, g = lane >> 4;
#pragma unroll
  for (int c = 0; c < 4; ++c) {
    float v[16];
#pragma unroll
    for (int f = 0; f < 4; ++f)
#pragma unroll
      for (int j = 0; j < 4; ++j) v[f * 4 + j] = acc[f][c][j];
    epi(wm * 64 + 16 * g, wn * 64 + c * 16 + l15, v);
  }
}
DI bool tile_map(int it, int Ft, int Tt, int fsplit, int& ft, int& tt) {
  const int bid = blockIdx.x, nb = gridDim.x;
  int xcd = bid & 7, loc = bid >> 3, nloc = nb >> 3;
  if (loc >= nloc) return false;
  int fg = xcd % fsplit, tg = xcd / fsplit, tsplit = 8 / fsplit;
  int Fg = Ft / fsplit, Tg = Tt / tsplit;
  int i = loc + it * nloc;
  if (i >= Fg * Tg) return false;
  ft = fg * Fg + i % Fg;
  tt = tg * Tg + i / Fg;
  return true;
}
DI int vbid() {
  const int bid = blockIdx.x, nb = gridDim.x;
  if (nb & 7) return bid;
  return (bid & 7) * (nb >> 3) + (bid >> 3);
}

DI int colmap(int mode, int np) {
  if (mode == 1) return np < 416 ? np : (np < 512 ? -1 : np - 96);
  if (mode == 2) return np < 512 ? ((np >> 6) * 128 + (np & 63)) : (((np - 512) >> 6) * 128 + 64 + ((np - 512) & 63));
  return np;
}
DI void tconv_tile(const float* __restrict__ src, int ldsrc, bf16_t* __restrict__ dst, int K, int kt, int nt, int mode,
                   char* smem) {
  float* lds = (float*)smem;
  const int tid = threadIdx.x;
  {
    int col = tid & 63, rq = tid >> 6;
    int n = colmap(mode, nt * 64 + col);
#pragma unroll 4
    for (int r = 0; r < 16; ++r) {
      int kl = r * 4 + rq;
      float v = n >= 0 ? src[(size_t)(kt * 64 + kl) * ldsrc + n] : 0.f;
      lds[kl * 65 + col] = v;
    }
  }
  __syncthreads();
  {
    int nl = tid >> 2, kq = (tid & 3) * 16;
    float v[16];
#pragma unroll
    for (int i = 0; i < 16; ++i) v[i] = lds[(kq + i) * 65 + nl];
    st_bf16x16(dst + (size_t)(nt * 64 + nl) * K + kt * 64 + kq, v);
  }
  __syncthreads();
}
DI void mod_item(const Params& p, int item, char* smem) {
  float* sil = (float*)smem;
  const int tid = threadIdx.x;
  const int cg_ = item >> 2, slab = item & 3, kbase = slab * 256;
  for (int i = tid; i < 9 * 256; i += 256) {
    int j = i >> 8, k = kbase + (i & 255);
    float cv = j == 0 ? p.c_ctx[k] : p.c[(j - 1) * 1024 + k];
    sil[i] = siluf_(cv);
  }
  __syncthreads();
  const int kq = tid >> 6, nn = tid & 63, n0 = cg_ * 64;
  float acc[9];
#pragma unroll
  for (int j = 0; j < 9; ++j) acc[j] = 0.f;
#pragma unroll 1
  for (int i0 = 0; i0 < 64; i0 += 16) {
    float wv[16];
#pragma unroll
    for (int i = 0; i < 16; ++i) wv[i] = p.w_mod[(size_t)(kbase + kq + 4 * (i0 + i)) * 6144 + n0 + nn];
#pragma unroll
    for (int i = 0; i < 16; ++i)
#pragma unroll
      for (int j = 0; j < 9; ++j) acc[j] += sil[j * 256 + kq + 4 * (i0 + i)] * wv[i];
  }
  __syncthreads();
  float* part = (float*)smem + 9 * 256;
#pragma unroll
  for (int j = 0; j < 9; ++j) part[(kq * 9 + j) * 64 + nn] = acc[j];
  __syncthreads();
  float* mod = (float*)(p.ws + OFF_MOD);
  for (int i = tid; i < 9 * 64; i += 256) {
    int j = i >> 6, n = i & 63;
    float s = part[(0 * 9 + j) * 64 + n] + part[(1 * 9 + j) * 64 + n] + part[(2 * 9 + j) * 64 + n] + part[(3 * 9 + j) * 64 + n];
    if (slab == 0) s += p.b_mod[n0 + n];
    atomicAdd(mod + j * 6144 + n0 + n, s);
  }
  __syncthreads();
}
DI void conv_flat(const float* __restrict__ src, bf16_t* __restrict__ dst, size_t n) {
  size_t i = ((size_t)blockIdx.x * 256 + threadIdx.x) * 8;
  const size_t stride = (size_t)gridDim.x * 256 * 8;
  for (; i < n; i += stride) {
    float4 a = *(const float4*)(src + i), b = *(const float4*)(src + i + 4);
    u32x4 o;
    o[0] = pack2(a.x, a.y); o[1] = pack2(a.z, a.w); o[2] = pack2(b.x, b.y); o[3] = pack2(b.z, b.w);
    *(u32x4*)(dst + i) = o;
  }
}
DI void phase0(const Params& p, char* smem) {
  const int bid = blockIdx.x, nb = gridDim.x;
  char* ws = p.ws;
  const int n_mod = 384;
  const int t_in = 16 * 72, t_uq = 4 * 12, t_ukv = 2 * 16, t_upa = 8 * 16, t_upb = 8 * 16, t_o = 16 * 16;
  const int total = n_mod + t_in + t_uq + t_ukv + t_upa + t_upb + t_o;
  for (int it = bid; it < total; it += nb) {
    int i = it;
    if (i < n_mod) { mod_item(p, i, smem); continue; }
    i -= n_mod;
    if (i < t_in) { tconv_tile(p.w_in, 4512, (bf16_t*)(ws + OFF_WINT), 1024, i / 72, i % 72, 1, smem); continue; }
    i -= t_in;
    if (i < t_uq) { tconv_tile(p.w_uq, 768, (bf16_t*)(ws + OFF_WUQT), 256, i / 12, i % 12, 0, smem); continue; }
    i -= t_uq;
    if (i < t_ukv) { tconv_tile(p.w_ukv, 1024, (bf16_t*)(ws + OFF_WUKVT), 128, i / 16, i % 16, 2, smem); continue; }
    i -= t_ukv;
    if (i < t_upa) { tconv_tile(p.w_up_a, 1024, (bf16_t*)(ws + OFF_WUPAT), 512, i / 16, i % 16, 0, smem); continue; }
    i -= t_upa;
    if (i < t_upb) { tconv_tile(p.w_up_b, 1024, (bf16_t*)(ws + OFF_WUPBT), 512, i / 16, i % 16, 0, smem); continue; }
    i -= t_upb;
    tconv_tile(p.w_o, 1024, (bf16_t*)(ws + OFF_WOT), 1024, i / 16, i % 16, 0, smem);
  }
  conv_flat(p.peer_wq, (bf16_t*)(ws + OFF_WPQB), (size_t)1024 * 2048);
  {
    size_t i = ((size_t)bid * 256 + threadIdx.x) * 8;
    const size_t stride = (size_t)nb * 256 * 8;
    bf16_t* kb = (bf16_t*)(ws + OFF_KEYSB);
    for (; i < (size_t)2 * 131072; i += stride) {
      int half = i >= 131072;
      size_t s = i - (size_t)half * 131072;
      int h = (int)(s >> 14);
      size_t r = s & 16383;
      const float* src = (half ? p.keys2 : p.keys1) + s;
      float4 a = *(const float4*)(src), b = *(const float4*)(src + 4);
      u32x4 o;
      o[0] = pack2(a.x, a.y); o[1] = pack2(a.z, a.w); o[2] = pack2(b.x, b.y); o[3] = pack2(b.z, b.w);
      *(u32x4*)(kb + ((size_t)(h * 2 + half) << 14) + r) = o;
    }
  }
}

DI void rows_norm_mod(const Params& p, const float* nw, int sh_off, int sc_off, bool from_out, bf16_t* dst) {
  const int lane = threadIdx.x & 63, w = threadIdx.x >> 6;
  const float* mod = (const float*)(p.ws + OFF_MOD);
  for (int tok = blockIdx.x * 4 + w; tok < NTOK; tok += gridDim.x * 4) {
    const float* xr = from_out ? p.out + (size_t)tok * DM : xrow(p, tok);
    const float* mj = mod + modidx(tok) * 6144;
    float4 xv[4];
    float ss = 0.f;
#pragma unroll
    for (int i = 0; i < 4; ++i) {
      xv[i] = *(const float4*)(xr + (i * 64 + lane) * 4);
      ss += xv[i].x * xv[i].x + xv[i].y * xv[i].y + xv[i].z * xv[i].z + xv[i].w * xv[i].w;
    }
    ss = wsum(ss);
    float rstd = rsqrtf(ss * (1.f / 1024.f) + 1e-6f);
#pragma unroll
    for (int i = 0; i < 4; ++i) {
      int e = (i * 64 + lane) * 4;
      float4 nv = *(const float4*)(nw + e), sh = *(const float4*)(mj + sh_off + e), sc = *(const float4*)(mj + sc_off + e);
      float h0 = (xv[i].x * rstd) * nv.x * (1.f + sc.x) + sh.x;
      float h1 = (xv[i].y * rstd) * nv.y * (1.f + sc.y) + sh.y;
      float h2 = (xv[i].z * rstd) * nv.z * (1.f + sc.z) + sh.z;
      float h3 = (xv[i].w * rstd) * nv.w * (1.f + sc.w) + sh.w;
      u32x2 o;
      o[0] = pack2(h0, h1); o[1] = pack2(h2, h3);
      *(u32x2*)(dst + (size_t)tok * DM + e) = o;
    }
  }
}
DI void phase1(const Params& p, char* smem) {
  rows_norm_mod(p, p.norm_mix, 0, 1024, false, (bf16_t*)(p.ws + OFF_H1));
  const bf16_t* wpq = (const bf16_t*)(p.ws + OFF_WPQB);
  const bf16_t* kb = (const bf16_t*)(p.ws + OFF_KEYSB);
  bf16_t* wct = (bf16_t*)(p.ws + OFF_WCT);
  for (int it = blockIdx.x; it < 128; it += gridDim.x) {
    int hh = it >> 3, mt = it & 7;
    f32x4 acc[4][4];
    acc_zero(acc);
    gemm_kloop<0>(acc, wpq + (size_t)(mt * 128) * 2048 + hh * 128, 2048, kb + (size_t)hh * 16384, 128, 128, smem, 0.f, 0.f);
    epilogue(acc, [&](int m, int n, float (&v)[16]) { st_bf16x16(wct + (size_t)(hh * 128 + n) * 1024 + mt * 128 + m, v); });
  }
}

DI void phase2(const Params& p, char* smem) {
  char* ws = p.ws;
  const bf16_t* winT = (const bf16_t*)(ws + OFF_WINT);
  const bf16_t* h1 = (const bf16_t*)(ws + OFF_H1);
  bf16_t* cq = (bf16_t*)(ws + OFF_CQ);
  float* ckvraw = (float*)(ws + OFF_CKVRAW);
  float* krraw = (float*)(ws + OFF_KRRAW);
  bf16_t* rq = (bf16_t*)(ws + OFF_RQ);
  bf16_t* rk = (bf16_t*)(ws + OFF_RK);
  bf16_t* kT = (bf16_t*)(ws + OFF_KT);
  bf16_t* vT = (bf16_t*)(ws + OFF_VT);
  bf16_t* srg = (bf16_t*)(ws + OFF_SRG);
  bf16_t* sga = (bf16_t*)p.out;
  bf16_t* sgb = sga + (size_t)NTOK * 1024;
  for (int it = 0;; ++it) {
    int ft, tt;
    if (!tile_map(it, 36, 160, 4, ft, tt)) break;
    f32x4 acc[4][4];
    acc_zero(acc);
    const bf16_t* W = winT + (size_t)ft * 128 * 1024;
    const bf16_t* H = h1 + (size_t)tt * 128 * 1024;
    const int tok0 = tt * 128, f0 = ft * 128;
    if (ft >= 8 && ft < 16) {
      gemm_kloop<0>(acc, H, 1024, W, 1024, 1024, smem, 0.f, 0.f);
      if (ft < 12) {
        epilogue(acc, [&](int m, int n, float (&v)[16]) {
          int feat = f0 - 1024 + n, tok = tok0 + m;
#pragma unroll
          for (int i = 0; i < 16; ++i) v[i] *= 0.08838834764831845f;
          st_bf16x16(kT + (size_t)feat * NTOK + tok, v);
#pragma unroll
          for (int i = 0; i < 16; ++i) rk[(size_t)(tok + i) * 512 + feat] = (bf16_t)f2bf(v[i]);
        });
      } else {
        epilogue(acc, [&](int m, int n, float (&v)[16]) {
          int feat = f0 - 1536 + n, tok = tok0 + m;
          st_bf16x16(vT + (size_t)feat * NTOK + tok, v);
        });
      }
    } else {
      gemm_kloop<0>(acc, W, 1024, H, 1024, 1024, smem, 0.f, 0.f);
      if (ft < 2) {
        epilogue(acc, [&](int m, int n, float (&v)[16]) { st_bf16x16(cq + (size_t)(tok0 + n) * 256 + f0 + m, v); });
      } else if (ft == 2) {
        epilogue(acc, [&](int m, int n, float (&v)[16]) { st_f32x16(ckvraw + (size_t)(tok0 + n) * 128 + m, v); });
      } else if (ft == 3) {
        epilogue(acc, [&](int m, int n, float (&v)[16]) {
          if (m < 32) st_f32x16(krraw + (size_t)(tok0 + n) * 32 + m, v);
        });
      } else if (ft < 8) {
        epilogue(acc, [&](int m, int n, float (&v)[16]) { st_bf16x16(rq + (size_t)(tok0 + n) * 512 + f0 - 512 + m, v); });
      } else if (ft < 20) {
        epilogue(acc, [&](int m, int n, float (&v)[16]) {
#pragma unroll
          for (int i = 0; i < 16; ++i) v[i] = siluf_(v[i]);
          st_bf16x16(srg + (size_t)(tok0 + n) * 512 + f0 - 2048 + m, v);
        });
      } else if (ft < 28) {
        epilogue(acc, [&](int m, int n, float (&v)[16]) {
#pragma unroll
          for (int i = 0; i < 16; ++i) v[i] = sigmoidf_(v[i]);
          st_bf16x16(sga + (size_t)(tok0 + n) * 1024 + f0 - 2560 + m, v);
        });
      } else {
        epilogue(acc, [&](int m, int n, float (&v)[16]) {
#pragma unroll
          for (int i = 0; i < 16; ++i) v[i] = sigmoidf_(v[i]);
          st_bf16x16(sgb + (size_t)(tok0 + n) * 1024 + f0 - 3584 + m, v);
        });
      }
    }
  }
}

DI float log2gamma(float logit) { return -log1pf(expf(-logit)) * 1.4426950408889634f; }
DI void phase3(const Params& p, char* smem) {
  char* ws = p.ws;
  const int lane = threadIdx.x & 63, w = threadIdx.x >> 6;
  bf16_t* cq = (bf16_t*)(ws + OFF_CQ);
  const float* ckvraw = (const float*)(ws + OFF_CKVRAW);
  const float* krraw = (const float*)(ws + OFF_KRRAW);
  bf16_t* ckvall = (bf16_t*)(ws + OFF_CKVALL);
  bf16_t* krall = (bf16_t*)(ws + OFF_KRALL);
  for (int r = blockIdx.x * 4 + w; r < NTOK + 4096; r += gridDim.x * 4) {
    if (r < NTOK) {
      const int tok = r;
      {
        u32x2 u = *(const u32x2*)(cq + (size_t)tok * 256 + lane * 4);
        float a0 = bflo(u[0]), a1 = bfhi(u[0]), a2 = bflo(u[1]), a3 = bfhi(u[1]);
        float ss = wsum(a0 * a0 + a1 * a1 + a2 * a2 + a3 * a3);
        float rstd = rsqrtf(ss * (1.f / 256.f) + 1e-6f);
        float4 nq = *(const float4*)(p.q_norm + lane * 4);
        u32x2 o;
        o[0] = pack2(a0 * rstd * nq.x, a1 * rstd * nq.y);
        o[1] = pack2(a2 * rstd * nq.z, a3 * rstd * nq.w);
        *(u32x2*)(cq + (size_t)tok * 256 + lane * 4) = o;
      }
      const int row = kvrow(tok);
      {
        float2 v = *(const float2*)(ckvraw + (size_t)tok * 128 + lane * 2);
        float ss = wsum(v.x * v.x + v.y * v.y);
        float rstd = rsqrtf(ss * (1.f / 128.f) + 1e-6f);
        float2 nk = *(const float2*)(p.kv_norm + lane * 2);
        float o0 = v.x * rstd * nk.x, o1 = v.y * rstd * nk.y;
        if (tok < NPT) *(float2*)(p.out + OUT_CKV + (size_t)tok * 128 + lane * 2) = make_float2(o0, o1);
        *(unsigned*)(ckvall + (size_t)row * 128 + lane * 2) = pack2(o0, o1);
      }
      if (lane < 32) {
        float own = krraw[(size_t)tok * 32 + lane];
        float o = own;
        if (tok < NPT) {
          p.out[OUT_KR + (size_t)tok * 32 + lane] = own;
        } else {
          float partner = krraw[(size_t)tok * 32 + (lane ^ 16)];
          int t = (tok - NPT) & 2047;
          int a = lane & 15;
          float pos = (a < 8) ? (float)(t >> 6) : (float)(t & 63);
          float fr = exp2f(-(float)(a & 7) * 1.6609640474436813f);
          float sn, cs;
          sincosf(pos * fr, &sn, &cs);
          o = lane < 16 ? own * cs - partner * sn : partner * sn + own * cs;
        }
        krall[(size_t)row * 32 + lane] = (bf16_t)f2bf(o);
      }
    } else {
      const int cr = r - NTOK;
      const int b = cr >> 9, pos = cr & 511;
      const int row = NPT + b * 2560 + 2048 + pos;
      float2 v = *(const float2*)(p.cache_ckv + (size_t)cr * 128 + lane * 2);
      *(unsigned*)(ckvall + (size_t)row * 128 + lane * 2) = pack2(v.x, v.y);
      if (lane < 32) krall[(size_t)row * 32 + lane] = (bf16_t)f2bf(p.cache_krope[(size_t)cr * 32 + lane]);
    }
  }
  const bf16_t* kT = (const bf16_t*)(ws + OFF_KT);
  const bf16_t* vT = (const bf16_t*)(ws + OFF_VT);
  float* Uf = (float*)(ws + OFF_UF);
  float* Ub = (float*)(ws + OFF_UB);
  for (int it = blockIdx.x; it < 320; it += gridDim.x) {
    const int blk = it >> 2, h = it & 3;
    const float l2f = log2gamma(p.lg_f[h]), l2b = log2gamma(p.lg_b[h]);
    const bf16_t* Kp = kT + (size_t)(h * 128) * NTOK + blk * 256;
    const bf16_t* Vp = vT + (size_t)(h * 128) * NTOK + blk * 256;
#pragma unroll 1
    for (int dir = 0; dir < 2; ++dir) {
      const float sa = dir ? 0.f : l2f * 255.f, sb = dir ? l2b : -l2f;
      f32x4 acc[4][4];
      acc_zero(acc);
      if (blk < 16) {
        gemm_kloop<1>(acc, Vp, NTOK, Kp, NTOK, 256, smem, sa, sb);
        float* dst = p.out + (dir ? OUT_SB : OUT_SF) + (size_t)(blk * 4 + h) * 16384;
        epilogue(acc, [&](int m, int n, float (&v)[16]) { st_f32x16(dst + n * 128 + m, v); });
      } else {
        gemm_kloop<1>(acc, Kp, NTOK, Vp, NTOK, 256, smem, sa, sb);
        float* dst = (dir ? Ub : Uf) + (size_t)((blk - 16) * 4 + h) * 16384;
        epilogue(acc, [&](int m, int n, float (&v)[16]) { st_f32x16(dst + n * 128 + m, v); });
      }
    }
  }
}

DI void phase4(const Params& p) {
  char* ws = p.ws;
  const float* Uf = (const float*)(ws + OFF_UF);
  const float* Ub = (const float*)(ws + OFF_UB);
  bf16_t* Sf = (bf16_t*)(ws + OFF_SF);
  bf16_t* Sb = (bf16_t*)(ws + OFF_SB);
  for (int idx = blockIdx.x * 256 + threadIdx.x; idx < (1 << 20); idx += gridDim.x * 256) {
    int d = idx & 127, e = (idx >> 7) & 127, h = (idx >> 14) & 3, b = (idx >> 16) & 7, dir = idx >> 19;
    size_t eo = (size_t)e * 128 + d;
    if (dir == 0) {
      float cf = exp2f(log2gamma(p.lg_f[h]) * 256.f);
      float S = p.st_f[(size_t)(b * 4 + h) * 16384 + d * 128 + e];
#pragma unroll
      for (int blk = 0; blk < 8; ++blk) {
        size_t o = (size_t)((b * 8 + blk) * 4 + h) * 16384 + eo;
        Sf[o] = (bf16_t)f2bf(S);
        S = cf * S + Uf[o];
      }
    } else {
      float cb = exp2f(log2gamma(p.lg_b[h]) * 256.f);
      float S = p.st_b[(size_t)(b * 4 + h) * 16384 + d * 128 + e];
#pragma unroll
      for (int blk = 7; blk >= 0; --blk) {
        size_t o = (size_t)((b * 8 + blk) * 4 + h) * 16384 + eo;
        Sb[o] = (bf16_t)f2bf(S);
        S = cb * S + Ub[o];
      }
    }
  }
}

DI bf16x8 scale_frag(bf16x8 q, float s) {
  u32x4 u = __builtin_bit_cast(u32x4, q);
#pragma unroll
  for (int i = 0; i < 4; ++i) u[i] = pack2(bflo(u[i]) * s, bfhi(u[i]) * s);
  return __builtin_bit_cast(bf16x8, u);
}
constexpr int NQT = 1;
DI void phase5(const Params& p, char* smem) {
  char* ws = p.ws;
  const bf16_t* rq = (const bf16_t*)(ws + OFF_RQ);
  const bf16_t* rk = (const bf16_t*)(ws + OFF_RK);
  const bf16_t* vT = (const bf16_t*)(ws + OFF_VT);
  const bf16_t* srg = (const bf16_t*)(ws + OFF_SRG);
  const bf16_t* Sf = (const bf16_t*)(ws + OFF_SF);
  const bf16_t* Sb = (const bf16_t*)(ws + OFF_SB);
  bf16_t* ret = (bf16_t*)(ws + OFF_RET);
  bf16_t* Ks = (bf16_t*)smem;
  bf16_t* Vs = Ks + 64 * 136;
  const int tid = threadIdx.x, lane = tid & 63, w = tid >> 6, l15 = lane & 15, g = lane >> 4;
  for (int item = vbid(); item < 640 * (2 / NQT); item += gridDim.x) {
    const int qb = item >> 2, h = item & 3, blk = (qb * NQT) >> 2;
    const float l2f = log2gamma(p.lg_f[h]), l2b = log2gamma(p.lg_b[h]);
    const int tokw = qb * (64 * NQT) + w * (16 * NQT);
    bf16x8 Q[NQT][4];
#pragma unroll
    for (int qt = 0; qt < NQT; ++qt)
#pragma unroll
      for (int ks = 0; ks < 4; ++ks)
        Q[qt][ks] = *(const bf16x8*)(rq + (size_t)(tokw + qt * 16 + l15) * 512 + h * 128 + ks * 32 + g * 8);
    f32x4 o[8][NQT];
#pragma unroll
    for (int et = 0; et < 8; ++et)
#pragma unroll
      for (int qt = 0; qt < NQT; ++qt) o[et][qt] = f32x4{0.f, 0.f, 0.f, 0.f};
#pragma unroll 1
    for (int kt = 0; kt < 4; ++kt) {
      const int key0 = blk * 256 + kt * 64;
      __syncthreads();
#pragma unroll
      for (int i = 0; i < 4; ++i) {
        int c = tid + 256 * i;
        int r = c >> 4, cc = (c & 15) * 8;
        *(u32x4*)(Ks + r * 136 + cc) = *(const u32x4*)(rk + (size_t)(key0 + r) * 512 + h * 128 + cc);
        int e = c >> 3, c2 = (c & 7) * 8;
        *(u32x4*)(Vs + e * 72 + c2) = *(const u32x4*)(vT + (size_t)(h * 128 + e) * NTOK + key0 + c2);
      }
      __syncthreads();
      bf16x8 P[NQT][2];
#pragma unroll
      for (int qt = 0; qt < NQT; ++qt) {
        f32x4 s[4];
#pragma unroll
        for (int kk = 0; kk < 4; ++kk) s[kk] = f32x4{0.f, 0.f, 0.f, 0.f};
#pragma unroll
        for (int ks = 0; ks < 4; ++ks) {
#pragma unroll
          for (int kk = 0; kk < 4; ++kk) {
            bf16x8 a = *(const bf16x8*)(Ks + (kk * 16 + l15) * 136 + ks * 32 + g * 8);
            s[kk] = __builtin_amdgcn_mfma_f32_16x16x32_bf16(a, Q[qt][ks], s[kk], 0, 0, 0);
          }
        }
        const int iq = (tokw + qt * 16 + l15) & 255;
#pragma unroll
        for (int kk = 0; kk < 4; ++kk) {
#pragma unroll
          for (int j = 0; j < 4; ++j) {
            int jk = kt * 64 + kk * 16 + 4 * g + j;
            int diff = iq - jk;
            float dm = diff > 0 ? ex2(l2f * (float)diff) : (diff < 0 ? ex2(l2b * (float)(-diff)) : 2.f);
            s[kk][j] *= dm;
          }
        }
#pragma unroll
        for (int k2 = 0; k2 < 2; ++k2) {
          u32x4 u;
          u[0] = pack2(s[2 * k2][0], s[2 * k2][1]);
          u[1] = pack2(s[2 * k2][2], s[2 * k2][3]);
          u[2] = pack2(s[2 * k2 + 1][0], s[2 * k2 + 1][1]);
          u[3] = pack2(s[2 * k2 + 1][2], s[2 * k2 + 1][3]);
          P[qt][k2] = __builtin_bit_cast(bf16x8, u);
        }
      }
#pragma unroll
      for (int k2 = 0; k2 < 2; ++k2) {
#pragma unroll
        for (int et = 0; et < 8; ++et) {
          u32x2 lo = *(const u32x2*)(Vs + (et * 16 + l15) * 72 + k2 * 32 + 4 * g);
          u32x2 hi = *(const u32x2*)(Vs + (et * 16 + l15) * 72 + k2 * 32 + 16 + 4 * g);
          u32x4 u;
          u[0] = lo[0]; u[1] = lo[1]; u[2] = hi[0]; u[3] = hi[1];
          bf16x8 a = __builtin_bit_cast(bf16x8, u);
#pragma unroll
          for (int qt = 0; qt < NQT; ++qt) o[et][qt] = __builtin_amdgcn_mfma_f32_16x16x32_bf16(a, P[qt][k2], o[et][qt], 0, 0, 0);
        }
      }
    }
    if (blk >= 16) {
#pragma unroll 1
      for (int dir = 0; dir < 2; ++dir) {
        const bf16_t* S = (dir ? Sb : Sf) + (size_t)((blk - 16) * 4 + h) * 16384;
        float dq[NQT];
#pragma unroll
        for (int qt = 0; qt < NQT; ++qt) {
          int iq = (tokw + qt * 16 + l15) & 255;
          dq[qt] = dir ? exp2f(l2b * (float)(256 - iq)) : exp2f(l2f * (float)(iq + 1));
        }
#pragma unroll
        for (int ks = 0; ks < 4; ++ks) {
          bf16x8 qs[NQT];
#pragma unroll
          for (int qt = 0; qt < NQT; ++qt) qs[qt] = scale_frag(Q[qt][ks], dq[qt]);
#pragma unroll
          for (int et = 0; et < 8; ++et) {
            bf16x8 a = *(const bf16x8*)(S + (size_t)(et * 16 + l15) * 128 + ks * 32 + g * 8);
#pragma unroll
            for (int qt = 0; qt < NQT; ++qt) o[et][qt] = __builtin_amdgcn_mfma_f32_16x16x32_bf16(a, qs[qt], o[et][qt], 0, 0, 0);
          }
        }
      }
    }
#pragma unroll
    for (int qt = 0; qt < NQT; ++qt) {
      const int tok = tokw + qt * 16 + l15;
      float s1 = 0.f;
#pragma unroll
      for (int et = 0; et < 8; ++et)
#pragma unroll
        for (int j = 0; j < 4; ++j) s1 += o[et][qt][j];
      s1 += __shfl_xor(s1, 16);
      s1 += __shfl_xor(s1, 32);
      const float mu = s1 * (1.f / 128.f);
      float s2 = 0.f;
#pragma unroll
      for (int et = 0; et < 8; ++et)
#pragma unroll
        for (int j = 0; j < 4; ++j) {
          float dlt = o[et][qt][j] - mu;
          s2 += dlt * dlt;
        }
      s2 += __shfl_xor(s2, 16);
      s2 += __shfl_xor(s2, 32);
      const float rstd = rsqrtf(s2 * (1.f / 128.f) + 1e-6f);
#pragma unroll
      for (int et = 0; et < 8; ++et) {
        const int e = h * 128 + et * 16 + 4 * g;
        float4 gn = *(const float4*)(p.ret_gn + e);
        u32x2 sg = *(const u32x2*)(srg + (size_t)tok * 512 + e);
        u32x2 ov;
        ov[0] = pack2((o[et][qt][0] - mu) * rstd * gn.x * bflo(sg[0]), (o[et][qt][1] - mu) * rstd * gn.y * bfhi(sg[0]));
        ov[1] = pack2((o[et][qt][2] - mu) * rstd * gn.z * bflo(sg[1]), (o[et][qt][3] - mu) * rstd * gn.w * bfhi(sg[1]));
        *(u32x2*)(ret + (size_t)tok * 512 + e) = ov;
      }
    }
  }
}

DI void phase6(const Params& p, char* smem) {
  char* ws = p.ws;
  const bf16_t* cqn = (const bf16_t*)(ws + OFF_CQ);
  const bf16_t* wuqT = (const bf16_t*)(ws + OFF_WUQT);
  bf16_t* q = (bf16_t*)(ws + OFF_Q);
  for (int it = 0;; ++it) {
    int ft, tt;
    if (!tile_map(it, 6, 160, 1, ft, tt)) break;
    f32x4 acc[4][4];
    acc_zero(acc);
    gemm_kloop<0>(acc, wuqT + (size_t)ft * 128 * 256, 256, cqn + (size_t)tt * 128 * 256, 256, 256, smem, 0.f, 0.f);
    epilogue(acc, [&](int m, int n, float (&v)[16]) { st_bf16x16(q + (size_t)(tt * 128 + n) * 768 + ft * 128 + m, v); });
  }
  const bf16_t* ckvall = (const bf16_t*)(ws + OFF_CKVALL);
  const bf16_t* wukvT = (const bf16_t*)(ws + OFF_WUKVT);
  bf16_t* Kn = (bf16_t*)(ws + OFF_KN);
  bf16_t* Vt = (bf16_t*)(ws + OFF_VTA);
  for (int it = 0;; ++it) {
    int ft, tt;
    if (!tile_map(it, 8, 192, 1, ft, tt)) break;
    f32x4 acc[4][4];
    acc_zero(acc);
    const bf16_t* W = wukvT + (size_t)ft * 128 * 128;
    const bf16_t* X = ckvall + (size_t)tt * 128 * 128;
    if (ft < 4) {
      gemm_kloop<0>(acc, W, 128, X, 128, 128, smem, 0.f, 0.f);
      epilogue(acc, [&](int m, int n, float (&v)[16]) { st_bf16x16(Kn + (size_t)(tt * 128 + n) * 512 + ft * 128 + m, v); });
    } else {
      gemm_kloop<0>(acc, X, 128, W, 128, 128, smem, 0.f, 0.f);
      epilogue(acc, [&](int m, int n, float (&v)[16]) { st_bf16x16(Vt + (size_t)((ft - 4) * 128 + n) * NKV + tt * 128 + m, v); });
    }
  }
}

DI void conv_fp8_rows(const float* __restrict__ src, unsigned char* __restrict__ dst, float* __restrict__ inv);
DI void phase7(const Params& p, char* smem) {
  char* ws = p.ws;
  const bf16_t* q = (const bf16_t*)(ws + OFF_Q);
  const bf16_t* Kn = (const bf16_t*)(ws + OFF_KN);
  const bf16_t* Vt = (const bf16_t*)(ws + OFF_VTA);
  const bf16_t* krall = (const bf16_t*)(ws + OFF_KRALL);
  bf16_t* attn = (bf16_t*)(ws + OFF_ATTN);
  bf16_t* Ks0 = (bf16_t*)smem;
  const int tid = threadIdx.x, lane = tid & 63, w = tid >> 6, l15 = lane & 15, g = lane >> 4;
  const float qscale = 0.10206207261596577f * 1.4426950408889634f;
  for (int item = vbid(); item < 1280; item += gridDim.x) {
    int b, h, qtok0, keyrow0, nkt;
    bool sample;
    if (item < 1024) {
      sample = true; b = item >> 7; h = (item >> 4) & 7; int qb = item & 15;
      qtok0 = NPT + b * 2048 + qb * 128; keyrow0 = NPT + b * 2560; nkt = 40;
    } else {
      int it2 = item - 1024;
      sample = false; b = it2 >> 4; h = (it2 >> 1) & 7; int qb = it2 & 1;
      qtok0 = b * 256 + qb * 128; keyrow0 = b * 256; nkt = 4;
    }
    bf16x8 Q[2][3];
#pragma unroll
    for (int qt = 0; qt < 2; ++qt) {
      const int tokq = qtok0 + w * 32 + qt * 16 + l15;
      const bf16_t* qp = q + (size_t)tokq * 768 + h * 96;
#pragma unroll
      for (int ks = 0; ks < 3; ++ks) {
        u32x4 u = *(const u32x4*)(qp + ks * 32 + g * 8);
        float v[8];
#pragma unroll
        for (int i = 0; i < 4; ++i) { v[2 * i] = bflo(u[i]); v[2 * i + 1] = bfhi(u[i]); }
        if (ks == 2 && sample) {
          u32x4 up = *(const u32x4*)(qp + 64 + (g ^ 2) * 8);
          float pv[8];
#pragma unroll
          for (int i = 0; i < 4; ++i) { pv[2 * i] = bflo(up[i]); pv[2 * i + 1] = bfhi(up[i]); }
          int t = (tokq - NPT) & 2047;
          float pos = (g & 1) ? (float)(t & 63) : (float)(t >> 6);
#pragma unroll
          for (int i = 0; i < 8; ++i) {
            float fr = exp2f(-(float)i * 1.6609640474436813f);
            float sn, cs;
            sincosf(pos * fr, &sn, &cs);
            v[i] = g < 2 ? v[i] * cs - pv[i] * sn : pv[i] * sn + v[i] * cs;
          }
        }
        u32x4 o4;
#pragma unroll
        for (int i = 0; i < 4; ++i) o4[i] = pack2(v[2 * i] * qscale, v[2 * i + 1] * qscale);
        Q[qt][ks] = __builtin_bit_cast(bf16x8, o4);
      }
    }
    f32x4 o[4][2];
#pragma unroll
    for (int et = 0; et < 4; ++et)
#pragma unroll
      for (int qt = 0; qt < 2; ++qt) o[et][qt] = f32x4{0.f, 0.f, 0.f, 0.f};
    float mrun[2] = {-1e30f, -1e30f}, lrun[2] = {0.f, 0.f};
    u32x4 rk_[3], rv_[2];
    auto gload = [&](int kt) {
      const int row0 = keyrow0 + kt * 64;
#pragma unroll
      for (int i = 0; i < 3; ++i) {
        int c = tid + 256 * i;
        int r = c / 12, cc = c - r * 12;
        rk_[i] = cc < 8 ? *(const u32x4*)(Kn + (size_t)(row0 + r) * 512 + h * 64 + cc * 8)
                        : *(const u32x4*)(krall + (size_t)(row0 + r) * 32 + (cc - 8) * 8);
      }
#pragma unroll
      for (int i = 0; i < 2; ++i) {
        int c = tid + 256 * i;
        int e = c >> 3, cc = (c & 7) * 8;
        rv_[i] = *(const u32x4*)(Vt + (size_t)(h * 64 + e) * NKV + row0 + cc);
      }
    };
    auto lstore = [&](int b) {
      bf16_t* Kd = Ks0 + b * 11264;
      bf16_t* Vd = Kd + 64 * 104;
#pragma unroll
      for (int i = 0; i < 3; ++i) {
        int c = tid + 256 * i;
        int r = c / 12, cc = c - r * 12;
        *(u32x4*)(Kd + r * 104 + cc * 8) = rk_[i];
      }
#pragma unroll
      for (int i = 0; i < 2; ++i) {
        int c = tid + 256 * i;
        int e = c >> 3, cc = (c & 7) * 8;
        *(u32x4*)(Vd + e * 72 + cc) = rv_[i];
      }
    };
    gload(0);
    __syncthreads();
    lstore(0);
    if (nkt > 1) gload(1);
    __syncthreads();
#pragma unroll 1
    for (int kt = 0; kt < nkt; ++kt) {
      const bf16_t* Ks = Ks0 + (kt & 1) * 11264;
      const bf16_t* Vs = Ks + 64 * 104;
      f32x4 s[4][2];
#pragma unroll
      for (int kk = 0; kk < 4; ++kk)
#pragma unroll
        for (int qt = 0; qt < 2; ++qt) s[kk][qt] = f32x4{0.f, 0.f, 0.f, 0.f};
#pragma unroll
      for (int ks = 0; ks < 3; ++ks) {
#pragma unroll
        for (int kk = 0; kk < 4; ++kk) {
          bf16x8 a = *(const bf16x8*)(Ks + (kk * 16 + l15) * 104 + ks * 32 + g * 8);
#pragma unroll
          for (int qt = 0; qt < 2; ++qt) s[kk][qt] = __builtin_amdgcn_mfma_f32_16x16x32_bf16(a, Q[qt][ks], s[kk][qt], 0, 0, 0);
        }
      }
      bf16x8 P[2][2];
#pragma unroll
      for (int qt = 0; qt < 2; ++qt) {
        float mx = s[0][qt][0];
#pragma unroll
        for (int kk = 0; kk < 4; ++kk)
#pragma unroll
          for (int j = 0; j < 4; ++j) mx = fmaxf(mx, s[kk][qt][j]);
        mx = fmaxf(mx, __shfl_xor(mx, 16));
        mx = fmaxf(mx, __shfl_xor(mx, 32));
        const float mnew = fmaxf(mrun[qt], mx);
        const bool grow = __ballot(mx > mrun[qt]) != 0ull;
        const float alpha = grow ? ex2(mrun[qt] - mnew) : 1.f;
        mrun[qt] = mnew;
        float ps = 0.f;
#pragma unroll
        for (int kk = 0; kk < 4; ++kk)
#pragma unroll
          for (int j = 0; j < 4; ++j) {
            float e_ = ex2(s[kk][qt][j] - mnew);
            s[kk][qt][j] = e_;
            ps += e_;
          }
        if (grow) {
          lrun[qt] = lrun[qt] * alpha + ps;
#pragma unroll
          for (int et = 0; et < 4; ++et)
#pragma unroll
            for (int j = 0; j < 4; ++j) o[et][qt][j] *= alpha;
        } else {
          lrun[qt] += ps;
        }
#pragma unroll
        for (int k2 = 0; k2 < 2; ++k2) {
          u32x4 u;
          u[0] = pack2(s[2 * k2][qt][0], s[2 * k2][qt][1]);
          u[1] = pack2(s[2 * k2][qt][2], s[2 * k2][qt][3]);
          u[2] = pack2(s[2 * k2 + 1][qt][0], s[2 * k2 + 1][qt][1]);
          u[3] = pack2(s[2 * k2 + 1][qt][2], s[2 * k2 + 1][qt][3]);
          P[qt][k2] = __builtin_bit_cast(bf16x8, u);
        }
      }
#pragma unroll
      for (int k2 = 0; k2 < 2; ++k2) {
#pragma unroll
        for (int et = 0; et < 4; ++et) {
          u32x2 lo = *(const u32x2*)(Vs + (et * 16 + l15) * 72 + k2 * 32 + 4 * g);
          u32x2 hi = *(const u32x2*)(Vs + (et * 16 + l15) * 72 + k2 * 32 + 16 + 4 * g);
          u32x4 u;
          u[0] = lo[0]; u[1] = lo[1]; u[2] = hi[0]; u[3] = hi[1];
          bf16x8 a = __builtin_bit_cast(bf16x8, u);
#pragma unroll
          for (int qt = 0; qt < 2; ++qt) o[et][qt] = __builtin_amdgcn_mfma_f32_16x16x32_bf16(a, P[qt][k2], o[et][qt], 0, 0, 0);
        }
      }
      if (kt + 1 < nkt) {
        lstore((kt + 1) & 1);
        if (kt + 2 < nkt) gload(kt + 2);
        __syncthreads();
      }
    }
#pragma unroll
    for (int qt = 0; qt < 2; ++qt) {
      const int tokq = qtok0 + w * 32 + qt * 16 + l15;
      float lt = lrun[qt];
      lt += __shfl_xor(lt, 16);
      lt += __shfl_xor(lt, 32);
      const float inv = 1.f / lt;
#pragma unroll
      for (int et = 0; et < 4; ++et) {
        u32x2 ov;
        ov[0] = pack2(o[et][qt][0] * inv, o[et][qt][1] * inv);
        ov[1] = pack2(o[et][qt][2] * inv, o[et][qt][3] * inv);
        *(u32x2*)(attn + (size_t)tokq * 512 + h * 64 + et * 16 + 4 * g) = ov;
      }
    }
  }
  conv_fp8_rows(p.peer_u, (unsigned char*)(p.ws + OFF_TABU), (float*)(p.ws + OFF_INVU));
  conv_fp8_rows(p.peer_v, (unsigned char*)(p.ws + OFF_TABV), (float*)(p.ws + OFF_INVV));
}

DI void phase8(const Params& p, char* smem) {
  char* ws = p.ws;
  const bf16_t* attn = (const bf16_t*)(ws + OFF_ATTN);
  const bf16_t* ret = (const bf16_t*)(ws + OFF_RET);
  const bf16_t* wa = (const bf16_t*)(ws + OFF_WUPAT);
  const bf16_t* wb = (const bf16_t*)(ws + OFF_WUPBT);
  const bf16_t* sga = (const bf16_t*)p.out;
  const bf16_t* sgb = sga + (size_t)NTOK * 1024;
  bf16_t* mbuf = (bf16_t*)(ws + OFF_M);
  const int tid = threadIdx.x, lane = tid & 63, w = tid >> 6, wm = w >> 1, wn = w & 1, l15 = lane & 15, g = lane >> 4;
  for (int it = 0;; ++it) {
    int ft, tt;
    if (!tile_map(it, 8, 160, 1, ft, tt)) break;
    f32x4 acc[4][4];
    acc_zero(acc);
    gemm_kloop<0>(acc, wa + (size_t)ft * 128 * 512, 512, attn + (size_t)tt * 128 * 512, 512, 512, smem, 0.f, 0.f);
#pragma unroll
    for (int c = 0; c < 4; ++c) {
      const size_t off = (size_t)(tt * 128 + wn * 64 + c * 16 + l15) * 1024 + ft * 128 + wm * 64 + 16 * g;
      float a[16], bq[16];
      ld_bf16x16(sga + off, a);
      ld_bf16x16(sgb + off, bq);
#pragma unroll
      for (int f = 0; f < 4; ++f)
#pragma unroll
        for (int j = 0; j < 4; ++j) acc[f][c][j] *= a[f * 4 + j] / fmaxf(bq[f * 4 + j], 1e-30f);
    }
    gemm_kloop<0>(acc, wb + (size_t)ft * 128 * 512, 512, ret + (size_t)tt * 128 * 512, 512, 512, smem, 0.f, 0.f);
    epilogue(acc, [&](int m, int n, float (&v)[16]) {
      const size_t off = (size_t)(tt * 128 + n) * 1024 + ft * 128 + m;
      float bq[16];
      ld_bf16x16(sgb + off, bq);
#pragma unroll
      for (int i = 0; i < 16; ++i) v[i] *= bq[i];
      st_bf16x16(mbuf + off, v);
    });
  }
}
DI void phase9(const Params& p, char* smem) {
  char* ws = p.ws;
  const bf16_t* mbuf = (const bf16_t*)(ws + OFF_M);
  const bf16_t* wo = (const bf16_t*)(ws + OFF_WOT);
  const float* mod = (const float*)(ws + OFF_MOD);
  for (int it = 0;; ++it) {
    int ft, tt;
    if (!tile_map(it, 8, 160, 1, ft, tt)) break;
    f32x4 acc[4][4];
    acc_zero(acc);
    gemm_kloop<0>(acc, wo + (size_t)ft * 128 * 1024, 1024, mbuf + (size_t)tt * 128 * 1024, 1024, 1024, smem, 0.f, 0.f);
    epilogue(acc, [&](int m, int n, float (&v)[16]) {
      const int tok = tt * 128 + n, feat = ft * 128 + m;
      const float* xr = xrow(p, tok) + feat;
      const float* g1 = mod + modidx(tok) * 6144 + 2048 + feat;
#pragma unroll
      for (int i = 0; i < 4; ++i) {
        float4 xv = *(const float4*)(xr + 4 * i), gv = *(const float4*)(g1 + 4 * i);
        v[4 * i] = xv.x + gv.x * v[4 * i];
        v[4 * i + 1] = xv.y + gv.y * v[4 * i + 1];
        v[4 * i + 2] = xv.z + gv.z * v[4 * i + 2];
        v[4 * i + 3] = xv.w + gv.w * v[4 * i + 3];
      }
      st_f32x16(p.out + (size_t)tok * DM + feat, v);
    });
  }
}
DI void conv_fp8_rows(const float* __restrict__ src, unsigned char* __restrict__ dst, float* __restrict__ inv) {
  const int lane = threadIdx.x & 63, w = threadIdx.x >> 6;
  for (int r = blockIdx.x * 4 + w; r < 16384; r += gridDim.x * 4) {
    const float* sp = src + (size_t)r * 1024 + lane * 16;
    float4 v[4];
    float am = 0.f;
#pragma unroll
    for (int i = 0; i < 4; ++i) {
      v[i] = *(const float4*)(sp + 4 * i);
      am = fmaxf(am, fmaxf(fmaxf(fabsf(v[i].x), fabsf(v[i].y)), fmaxf(fabsf(v[i].z), fabsf(v[i].w))));
    }
#pragma unroll
    for (int o = 32; o > 0; o >>= 1) am = fmaxf(am, __shfl_xor(am, o));
    const float sc = am > 0.f ? 448.f / am : 1.f;
    u32x4 o4;
#pragma unroll
    for (int i = 0; i < 4; ++i) {
      int wd = 0;
      wd = __builtin_amdgcn_cvt_pk_fp8_f32(v[i].x * sc, v[i].y * sc, wd, false);
      wd = __builtin_amdgcn_cvt_pk_fp8_f32(v[i].z * sc, v[i].w * sc, wd, true);
      o4[i] = (unsigned)wd;
    }
    *(u32x4*)(dst + ((size_t)(lane >> 3) * 16384 + r) * 128 + (lane & 7) * 16) = o4;
    if (lane == 0) inv[r] = am > 0.f ? am * (1.f / 448.f) : 1.f;
  }
}
DI void phase10(const Params& p, char* smem) {
  rows_norm_mod(p, p.norm_ffn, 3072, 4096, true, (bf16_t*)(p.ws + OFF_H2));
}
DI void phase11(const Params& p, char* smem) {
  char* ws = p.ws;
  const bf16_t* h2 = (const bf16_t*)(ws + OFF_H2);
  const bf16_t* wct = (const bf16_t*)(ws + OFF_WCT);
  bf16_t* sc = (bf16_t*)(ws + OFF_SCORES);
  for (int it = 0;; ++it) {
    int ft, tt;
    if (!tile_map(it, 16, 160, 2, ft, tt)) break;
    f32x4 acc[4][4];
    acc_zero(acc);
    gemm_kloop<0>(acc, wct + (size_t)ft * 128 * 1024, 1024, h2 + (size_t)tt * 128 * 1024, 1024, 1024, smem, 0.f, 0.f);
    epilogue(acc, [&](int m, int n, float (&v)[16]) { st_bf16x16(sc + (size_t)(tt * 128 + n) * 2048 + ft * 128 + m, v); });
  }
}

DI unsigned okey(float f) {
  unsigned u = __float_as_uint(f);
  return (u & 0x80000000u) ? ~u : (u | 0x80000000u);
}
DI void wave_lds_sync() {
  __builtin_amdgcn_fence(__ATOMIC_ACQ_REL, "workgroup");
  __builtin_amdgcn_wave_barrier();
}
DI unsigned okey16(unsigned b) { return (b & 0x8000u) ? (~b & 0xFFFFu) : (b | 0x8000u); }
DI unsigned inv_okey16(unsigned k) { return (k & 0x8000u) ? (k & 0x7FFFu) : (~k & 0xFFFFu); }
DI unsigned inv_okey(unsigned k) { return (k & 0x80000000u) ? (k & 0x7FFFFFFFu) : ~k; }
DI void ins16(unsigned (&L)[16], unsigned x) {
#pragma unroll
  for (int i = 0; i < 16; ++i) {
    unsigned t = max(L[i], x);
    x = min(L[i], x);
    L[i] = t;
  }
}
DI unsigned sel16(const unsigned (&A)[16], int i) {
  unsigned r = 0u;
#pragma unroll
  for (int t = 0; t < 16; ++t) r |= A[t] & (0u - (unsigned)(i == t));
  return r;
}
DI void phase12(const Params& p, char* smem) {
  char* ws = p.ws;
  const bf16_t* sc = (const bf16_t*)(ws + OFF_SCORES);
  int* elist = (int*)(ws + OFF_ELIST);
  float* glist = (float*)(ws + OFF_GLIST);
  const int lane = threadIdx.x & 63, w = threadIdx.x >> 6;
  for (int batch = blockIdx.x * 4 + w; batch < NTOK / 4; batch += gridDim.x * 4) {
    const int tok = batch * 4 + (lane >> 4), hh = lane & 15;
    const bf16_t* row = sc + (size_t)tok * 2048 + hh * 128;
    unsigned L[16];
#pragma unroll
    for (int i = 0; i < 16; ++i) L[i] = 0u;
#pragma unroll
    for (int c = 0; c < 16; ++c) {
      u32x4 u = *(const u32x4*)(row + c * 8);
#pragma unroll
      for (int i = 0; i < 4; ++i) {
        unsigned b0 = u[i] & 0xFFFFu, b1 = u[i] >> 16;
        ins16(L, (okey16(b0) << 16) | (unsigned)(127 - (c * 8 + 2 * i)));
        ins16(L, (okey16(b1) << 16) | (unsigned)(127 - (c * 8 + 2 * i + 1)));
      }
    }
    unsigned M[16];
#pragma unroll
    for (int i = 0; i < 16; ++i) M[i] = (unsigned)__shfl_xor((int)L[i], 1);
    float v1[16], v2[16];
#pragma unroll
    for (int i = 0; i < 16; ++i) {
      v1[i] = bf2f(inv_okey16(L[i] >> 16));
      v2[i] = bf2f(inv_okey16(M[i] >> 16));
    }
    unsigned C[16];
#pragma unroll
    for (int i = 0; i < 16; ++i) C[i] = 0u;
    ins16(C, (okey(v1[0] + v2[0]) & 0xFFFFFF00u) | 255u);
    ins16(C, (okey(v1[0] + v2[1]) & 0xFFFFFF00u) | 254u);
    ins16(C, (okey(v1[0] + v2[2]) & 0xFFFFFF00u) | 253u);
    ins16(C, (okey(v1[0] + v2[3]) & 0xFFFFFF00u) | 252u);
    ins16(C, (okey(v1[0] + v2[4]) & 0xFFFFFF00u) | 251u);
    ins16(C, (okey(v1[0] + v2[5]) & 0xFFFFFF00u) | 250u);
    ins16(C, (okey(v1[0] + v2[6]) & 0xFFFFFF00u) | 249u);
    ins16(C, (okey(v1[0] + v2[7]) & 0xFFFFFF00u) | 248u);
    ins16(C, (okey(v1[0] + v2[8]) & 0xFFFFFF00u) | 247u);
    ins16(C, (okey(v1[0] + v2[9]) & 0xFFFFFF00u) | 246u);
    ins16(C, (okey(v1[0] + v2[10]) & 0xFFFFFF00u) | 245u);
    ins16(C, (okey(v1[0] + v2[11]) & 0xFFFFFF00u) | 244u);
    ins16(C, (okey(v1[0] + v2[12]) & 0xFFFFFF00u) | 243u);
    ins16(C, (okey(v1[0] + v2[13]) & 0xFFFFFF00u) | 242u);
    ins16(C, (okey(v1[0] + v2[14]) & 0xFFFFFF00u) | 241u);
    ins16(C, (okey(v1[0] + v2[15]) & 0xFFFFFF00u) | 240u);
    ins16(C, (okey(v1[1] + v2[0]) & 0xFFFFFF00u) | 239u);
    ins16(C, (okey(v1[1] + v2[1]) & 0xFFFFFF00u) | 238u);
    ins16(C, (okey(v1[1] + v2[2]) & 0xFFFFFF00u) | 237u);
    ins16(C, (okey(v1[1] + v2[3]) & 0xFFFFFF00u) | 236u);
    ins16(C, (okey(v1[1] + v2[4]) & 0xFFFFFF00u) | 235u);
    ins16(C, (okey(v1[1] + v2[5]) & 0xFFFFFF00u) | 234u);
    ins16(C, (okey(v1[1] + v2[6]) & 0xFFFFFF00u) | 233u);
    ins16(C, (okey(v1[1] + v2[7]) & 0xFFFFFF00u) | 232u);
    ins16(C, (okey(v1[2] + v2[0]) & 0xFFFFFF00u) | 223u);
    ins16(C, (okey(v1[2] + v2[1]) & 0xFFFFFF00u) | 222u);
    ins16(C, (okey(v1[2] + v2[2]) & 0xFFFFFF00u) | 221u);
    ins16(C, (okey(v1[2] + v2[3]) & 0xFFFFFF00u) | 220u);
    ins16(C, (okey(v1[2] + v2[4]) & 0xFFFFFF00u) | 219u);
    ins16(C, (okey(v1[3] + v2[0]) & 0xFFFFFF00u) | 207u);
    ins16(C, (okey(v1[3] + v2[1]) & 0xFFFFFF00u) | 206u);
    ins16(C, (okey(v1[3] + v2[2]) & 0xFFFFFF00u) | 205u);
    ins16(C, (okey(v1[3] + v2[3]) & 0xFFFFFF00u) | 204u);
    ins16(C, (okey(v1[4] + v2[0]) & 0xFFFFFF00u) | 191u);
    ins16(C, (okey(v1[4] + v2[1]) & 0xFFFFFF00u) | 190u);
    ins16(C, (okey(v1[4] + v2[2]) & 0xFFFFFF00u) | 189u);
    ins16(C, (okey(v1[5] + v2[0]) & 0xFFFFFF00u) | 175u);
    ins16(C, (okey(v1[5] + v2[1]) & 0xFFFFFF00u) | 174u);
    ins16(C, (okey(v1[6] + v2[0]) & 0xFFFFFF00u) | 159u);
    ins16(C, (okey(v1[6] + v2[1]) & 0xFFFFFF00u) | 158u);
    ins16(C, (okey(v1[7] + v2[0]) & 0xFFFFFF00u) | 143u);
    ins16(C, (okey(v1[7] + v2[1]) & 0xFFFFFF00u) | 142u);
    ins16(C, (okey(v1[8] + v2[0]) & 0xFFFFFF00u) | 127u);
    ins16(C, (okey(v1[9] + v2[0]) & 0xFFFFFF00u) | 111u);
    ins16(C, (okey(v1[10] + v2[0]) & 0xFFFFFF00u) | 95u);
    ins16(C, (okey(v1[11] + v2[0]) & 0xFFFFFF00u) | 79u);
    ins16(C, (okey(v1[12] + v2[0]) & 0xFFFFFF00u) | 63u);
    ins16(C, (okey(v1[13] + v2[0]) & 0xFFFFFF00u) | 47u);
    ins16(C, (okey(v1[14] + v2[0]) & 0xFFFFFF00u) | 31u);
    ins16(C, (okey(v1[15] + v2[0]) & 0xFFFFFF00u) | 15u);
    int ev[16];
    float gv[16];
    const float mx = __uint_as_float(inv_okey(C[0] & 0xFFFFFF00u));
    float den = 0.f;
#pragma unroll
    for (int k = 0; k < 16; ++k) {
      const int ci = 255 - (int)(C[k] & 0xFFu);
      const unsigned a1 = sel16(L, ci >> 4), a2 = sel16(M, ci & 15);
      ev[k] = (127 - (int)(a1 & 0xFFFFu)) * 128 + (127 - (int)(a2 & 0xFFFFu));
      gv[k] = __expf(__uint_as_float(inv_okey(C[k] & 0xFFFFFF00u)) - mx);
      den += gv[k];
    }
    const float inv = 1.f / den;
    if ((lane & 1) == 0) {
      int* ep = elist + (size_t)tok * 128 + (hh >> 1) * 16;
      float* gp = glist + (size_t)tok * 128 + (hh >> 1) * 16;
#pragma unroll
      for (int k = 0; k < 4; ++k) {
        *(int4*)(ep + 4 * k) = make_int4(ev[4 * k], ev[4 * k + 1], ev[4 * k + 2], ev[4 * k + 3]);
        *(float4*)(gp + 4 * k) = make_float4(gv[4 * k] * inv, gv[4 * k + 1] * inv, gv[4 * k + 2] * inv, gv[4 * k + 3] * inv);
      }
    }
  }
}
using f32x2 = __attribute__((ext_vector_type(2))) float;
DI f32x2 cvt8(unsigned w, bool hi) {
  return hi ? __builtin_amdgcn_cvt_pk_f32_fp8((int)w, true) : __builtin_amdgcn_cvt_pk_f32_fp8((int)w, false);
}
struct SMeta { int e[16]; u32x4 ha, hb; };
template <int MODE>
DI void sl_meta(const Params& p, int t, int s, int grp, int ch, SMeta& m) {
  const int* elist = (const int*)(p.ws + (MODE == 0 ? OFF_ELIST : OFF_GLIST));
#pragma unroll
  for (int i = 0; i < 16; ++i) m.e[i] = elist[(size_t)t * 128 + i * 8 + grp];
  if (MODE == 0) {
    const bf16_t* hq = (const bf16_t*)(p.ws + OFF_H2) + (size_t)t * DM + s * 128 + ch * 16;
    m.ha = *(const u32x4*)hq;
    m.hb = *(const u32x4*)(hq + 8);
  }
}
template <int MODE>
DI void sl_rows(const Params& p, int s, int ch, const SMeta& m, u32x4 (&r)[16]) {
  const unsigned char* tab = (const unsigned char*)(p.ws + (MODE == 0 ? OFF_TABU : OFF_TABV));
#pragma unroll
  for (int i = 0; i < 16; ++i) r[i] = *(const u32x4*)(tab + ((size_t)s * 16384 + (m.e[i] & 0xFFFF)) * 128 + ch * 16);
}
template <int MODE>
DI void sl_compute(const Params& p, int t, int s, int lane, const SMeta& m, const u32x4 (&r)[16]) {
  const int grp = lane >> 3, ch = lane & 7;
  if (MODE == 0) {
    f32x2 hp[8];
#pragma unroll
    for (int i = 0; i < 4; ++i) {
      hp[i] = f32x2{bflo(m.ha[i]), bfhi(m.ha[i])};
      hp[4 + i] = f32x2{bflo(m.hb[i]), bfhi(m.hb[i])};
    }
    float keep0 = 0.f, keep1 = 0.f;
#pragma unroll
    for (int i = 0; i < 16; ++i) {
      f32x2 d2 = f32x2{0.f, 0.f};
#pragma unroll
      for (int j = 0; j < 4; ++j) {
        d2 += cvt8(r[i][j], false) * hp[2 * j];
        d2 += cvt8(r[i][j], true) * hp[2 * j + 1];
      }
      float d = d2[0] + d2[1];
      d += __shfl_xor(d, 1);
      d += __shfl_xor(d, 2);
      d += __shfl_xor(d, 4);
      if (i < 8) keep0 = (ch == i) ? d : keep0;
      else keep1 = (ch == i - 8) ? d : keep1;
    }
    float* po = (float*)(p.ws + OFF_PD) + (size_t)t * 1024 + s * 128;
    po[ch * 8 + grp] = keep0;
    po[(ch + 8) * 8 + grp] = keep1;
  } else {
    f32x2 acc[8];
#pragma unroll
    for (int q = 0; q < 8; ++q) acc[q] = f32x2{0.f, 0.f};
#pragma unroll
    for (int i = 0; i < 16; ++i) {
      const float wsc = __uint_as_float((unsigned)m.e[i] & 0xFFFF0000u);
      const f32x2 w2 = f32x2{wsc, wsc};
#pragma unroll
      for (int j = 0; j < 4; ++j) {
        acc[2 * j] += w2 * cvt8(r[i][j], false);
        acc[2 * j + 1] += w2 * cvt8(r[i][j], true);
      }
    }
    float v[16];
#pragma unroll
    for (int q = 0; q < 8; ++q) { v[2 * q] = acc[q][0]; v[2 * q + 1] = acc[q][1]; }
    float q8[8], q4[4], q2[2];
    {
      const bool hi = lane & 32;
#pragma unroll
      for (int i = 0; i < 8; ++i) {
        float send = hi ? v[i] : v[8 + i], keep = hi ? v[8 + i] : v[i];
        q8[i] = keep + __shfl_xor(send, 32);
      }
    }
    {
      const bool hi = lane & 16;
#pragma unroll
      for (int i = 0; i < 4; ++i) {
        float send = hi ? q8[i] : q8[4 + i], keep = hi ? q8[4 + i] : q8[i];
        q4[i] = keep + __shfl_xor(send, 16);
      }
    }
    {
      const bool hi = lane & 8;
#pragma unroll
      for (int i = 0; i < 2; ++i) {
        float send = hi ? q4[i] : q4[2 + i], keep = hi ? q4[2 + i] : q4[i];
        q2[i] = keep + __shfl_xor(send, 8);
      }
    }
    const int f = s * 128 + ch * 16 + 2 * grp;
    float* xr = p.out + (size_t)t * DM + f;
    const float2 xv = *(const float2*)xr;
    const float2 gv = *(const float2*)((const float*)(p.ws + OFF_MOD) + modidx(t) * 6144 + 5120 + f);
    *(float2*)xr = make_float2(xv.x + gv.x * q2[0], xv.y + gv.y * q2[1]);
  }
}
template <int MODE>
DI void sliced_pass(const Params& p) {
  const int s = blockIdx.x & 7, loc = blockIdx.x >> 3, nloc = gridDim.x >> 3;
  if (loc >= nloc) return;
  const int lane = threadIdx.x & 63, w = threadIdx.x >> 6, grp = lane >> 3, ch = lane & 7;
  const int stride = nloc * 4;
  SMeta mA, mB;
  u32x4 rA[16], rB[16];
  int t = loc * 4 + w;
  if (t < NTOK) {
    sl_meta<MODE>(p, t, s, grp, ch, mA);
    sl_rows<MODE>(p, s, ch, mA, rA);
  }
  if (t + stride < NTOK) sl_meta<MODE>(p, t + stride, s, grp, ch, mB);
#pragma unroll 1
  for (; t < NTOK; t += 2 * stride) {
    const int t1 = t + stride, t2 = t + 2 * stride, t3 = t + 3 * stride;
    if (t1 < NTOK) sl_rows<MODE>(p, s, ch, mB, rB);
    sl_compute<MODE>(p, t, s, lane, mA, rA);
    if (t2 < NTOK) sl_meta<MODE>(p, t2, s, grp, ch, mA);
    if (t1 < NTOK) {
      if (t2 < NTOK) sl_rows<MODE>(p, s, ch, mA, rA);
      sl_compute<MODE>(p, t1, s, lane, mB, rB);
      if (t3 < NTOK) sl_meta<MODE>(p, t3, s, grp, ch, mB);
    }
  }
}
DI void phase13(const Params& p) { sliced_pass<0>(p); }
DI void phase14(const Params& p) {
  char* ws = p.ws;
  const float* invU = (const float*)(ws + OFF_INVU);
  const float* invV = (const float*)(ws + OFF_INVV);
  const int* elist = (const int*)(ws + OFF_ELIST);
  float* glist = (float*)(ws + OFF_GLIST);
  const float* pd = (const float*)(ws + OFF_PD);
  const int lane = threadIdx.x & 63, w = threadIdx.x >> 6;
  for (int t = blockIdx.x * 4 + w; t < NTOK; t += gridDim.x * 4) {
#pragma unroll
    for (int hf_ = 0; hf_ < 2; ++hf_) {
      const int k = hf_ * 64 + lane;
      float d = 0.f;
#pragma unroll
      for (int s = 0; s < 8; ++s) d += pd[(size_t)t * 1024 + s * 128 + k];
      const int e = elist[(size_t)t * 128 + k];
      const float g = glist[(size_t)t * 128 + k];
      ((unsigned*)glist)[(size_t)t * 128 + k] = (pack2(0.f, g * geluf_(d * invU[e]) * invV[e]) & 0xFFFF0000u) | (unsigned)e;
    }
  }
}
DI void phase15(const Params& p) { sliced_pass<1>(p); }
DI void phase16(const Params& p) {
  const int lane = threadIdx.x & 63, w = threadIdx.x >> 6;
  for (int tok = blockIdx.x * 4 + w; tok < NTOK; tok += gridDim.x * 4) {
    float* xr = p.out + (size_t)tok * DM;
    float4 xv[4];
    float ss = 0.f;
#pragma unroll
    for (int i = 0; i < 4; ++i) {
      xv[i] = *(const float4*)(xr + (i * 64 + lane) * 4);
      ss += xv[i].x * xv[i].x + xv[i].y * xv[i].y + xv[i].z * xv[i].z + xv[i].w * xv[i].w;
    }
    ss = wsum(ss);
    const float rstd = rsqrtf(ss * (1.f / 1024.f) + 1e-6f);
#pragma unroll
    for (int i = 0; i < 4; ++i) {
      const int e = (i * 64 + lane) * 4;
      float4 nf = *(const float4*)(p.norm_final + e);
      *(float4*)(xr + e) = make_float4(xv[i].x * rstd * nf.x, xv[i].y * rstd * nf.y, xv[i].z * rstd * nf.z, xv[i].w * rstd * nf.w);
    }
  }
}

#define XB_TMO      128
#define XB_XCNT(j)  (256  + 64 * (j))
#define XB_XSUB(j)  (1280 + 64 * (j))
#define XB_XGEN(j)  (2304 + 64 * (j))
#define XB_TOP      3328
#define XB_TOPGEN   3392
#define XCD_BAR_WORDS 3456
#define XB_SPIN_CAP (1u << 22)
#define LAS __attribute__((address_space(3)))
DI unsigned xb_ld(unsigned* p) { return __hip_atomic_load(p, __ATOMIC_RELAXED, __HIP_MEMORY_SCOPE_AGENT); }
DI unsigned xb_add(unsigned* p, unsigned v) { return __hip_atomic_fetch_add(p, v, __ATOMIC_RELAXED, __HIP_MEMORY_SCOPE_AGENT); }
DI unsigned xb_xcc_id() { return (unsigned)__builtin_amdgcn_s_getreg((3 << 11) | 20) & 0xFu; }
#define XB_SPIN(cond, bar) do { unsigned _sp = 0; while (cond) { __builtin_amdgcn_s_sleep(1); \
    if ((++_sp & 255u) == 0u) { if (xb_ld(&(bar)[XB_TMO])) break; if (_sp > XB_SPIN_CAP) { atomicAdd(&(bar)[XB_TMO], 1u); break; } } } } while (0)
struct XcdBarrier { unsigned* bar; unsigned x; volatile LAS unsigned* st; };
DI XcdBarrier xcd_barrier_post(unsigned* bar, volatile LAS unsigned* st) {
  XcdBarrier b; b.bar = bar; b.x = xb_xcc_id(); b.st = st;
  if (threadIdx.x == 0) (void)xb_add(&bar[XB_XCNT(b.x)], 1u);
  return b;
}
DI void xcd_barrier_complete(unsigned* bar, unsigned x, unsigned& nloc, unsigned& nx) {
  const unsigned G = gridDim.x * gridDim.y * gridDim.z;
  unsigned sum, cnt, mine, sp = 0u;
  for (;;) {
    sum = 0u; cnt = 0u; mine = 0u;
#pragma unroll
    for (unsigned j = 0; j < 16; ++j) { const unsigned c = xb_ld(&bar[XB_XCNT(j)]); sum += c; cnt += (c > 0u) ? 1u : 0u; mine = (j == x) ? c : mine; }
    if (sum == G) break;
    __builtin_amdgcn_s_sleep(1);
    if ((++sp & 255u) == 0u) { if (xb_ld(&bar[XB_TMO])) break; if (sp > XB_SPIN_CAP) { atomicAdd(&bar[XB_TMO], 1u); break; } }
  }
  nloc = mine > 0u ? mine : 1u; nx = cnt > 0u ? cnt : 1u;
}
DI void xcd_barrier(const XcdBarrier& b) {
  asm volatile("s_waitcnt vmcnt(0)" ::: "memory");
  __syncthreads();
  if (threadIdx.x == 0) {
    unsigned* bar = b.bar;
    __builtin_amdgcn_s_waitcnt(0);
    unsigned nloc = b.st[0], nx = b.st[1];
    if (nloc == 0u) { xcd_barrier_complete(bar, b.x, nloc, nx); b.st[0] = nloc; b.st[1] = nx; }
    const unsigned old = xb_add(&bar[XB_XSUB(b.x)], 1u);
    const unsigned gen = old / nloc;
    if (old + 1u == (gen + 1u) * nloc) {
      __builtin_amdgcn_fence(__ATOMIC_RELEASE, "agent");
      asm volatile("s_waitcnt vmcnt(0)" ::: "memory");
      const unsigned og = xb_add(&bar[XB_TOP], 1u);
      const unsigned tg = og / nx;
      if (og + 1u == (tg + 1u) * nx) xb_add(&bar[XB_TOPGEN], 1u);
      else XB_SPIN(xb_ld(&bar[XB_TOPGEN]) == tg, bar);
      __builtin_amdgcn_fence(__ATOMIC_ACQUIRE, "agent");
      xb_add(&bar[XB_XGEN(b.x)], 1u);
      asm volatile("s_waitcnt vmcnt(0)" ::: "memory");
    } else {
      XB_SPIN(xb_ld(&bar[XB_XGEN(b.x)]) == gen, bar);
      __builtin_amdgcn_fence(__ATOMIC_ACQUIRE, "agent");
      asm volatile("s_waitcnt vmcnt(0)" ::: "memory");
    }
  }
  __syncthreads();
}

#ifdef ONLY_PHASE
#define RUNPH(n, call) if (ONLY_PHASE == n) { call; }
#else
#ifndef DUP_PHASE
#define DUP_PHASE -1
#endif
#define RUNPH(n, call) if (lo <= n && n < hi) { call; if (n == DUP_PHASE) { xcd_barrier(xb); call; } if (n + 1 < hi) xcd_barrier(xb); }
#endif
__global__ void __launch_bounds__(256, 2) mega(Params p, int lo, int hi) {
  __shared__ __attribute__((aligned(16))) char smem[SMEM_BYTES];
  __shared__ uint4 xb_words;
  cg::grid_group grid = cg::this_grid();
  if (lo < 0) grid.sync();
  if (threadIdx.x == 0) xb_words = make_uint4(0u, 0u, 0u, 0u);
  __syncthreads();
  XcdBarrier xb = xcd_barrier_post((unsigned*)(p.ws + OFF_BAR), (volatile LAS unsigned*)&xb_words);
  RUNPH(0, phase0(p, smem))
  RUNPH(1, phase1(p, smem))
  RUNPH(2, phase2(p, smem))
  RUNPH(3, phase3(p, smem))
  RUNPH(4, phase4(p))
  RUNPH(5, phase5(p, smem))
  RUNPH(6, phase6(p, smem))
  RUNPH(7, phase7(p, smem))
  RUNPH(8, phase8(p, smem))
  RUNPH(9, phase9(p, smem))
  RUNPH(10, phase10(p, smem))
  RUNPH(11, phase11(p, smem))
  RUNPH(12, phase12(p, smem))
  RUNPH(13, phase13(p))
  RUNPH(14, phase14(p))
  RUNPH(15, phase15(p))
  RUNPH(16, phase16(p))
}

extern "C" void kernel_launch(void* const* d_in, const int* in_sizes, int n_in, void* d_out, int out_size, void* d_ws,
                              size_t ws_size, hipStream_t stream) {
  static int grid_blocks = 0;
  if (!grid_blocks) {
    int dev = 0, cus = 0, per_cu = 0;
    hipGetDevice(&dev);
    hipDeviceGetAttribute(&cus, hipDeviceAttributeMultiprocessorCount, dev);
    hipOccupancyMaxActiveBlocksPerMultiprocessor(&per_cu, mega, 256, 0);
    if (per_cu > 2) per_cu = 2;
    if (per_cu < 1) per_cu = 1;
    grid_blocks = cus * per_cu;
  }
  Params p{};
  const float** pp = (const float**)&p;
  for (int i = 0; i < 29; ++i) pp[i] = (const float*)d_in[i];
  p.out = (float*)d_out;
  p.ws = (char*)d_ws;
#if N_LAUNCH_SPLIT
  for (int ph = 0; ph < NPHASE; ++ph) {
    hipLaunchKernelGGL(mega, dim3(grid_blocks), dim3(256), 0, stream, p, ph, ph + 1);
  }
#else
  hipMemsetAsync((char*)d_ws + OFF_MOD, 0, (OFF_BAR - OFF_MOD) + XCD_BAR_WORDS * sizeof(unsigned), stream);
  int lo = 0, hi = NPHASE;
  void* args[] = {&p, &lo, &hi};
  hipError_t e = hipLaunchCooperativeKernel((void*)mega, dim3(grid_blocks), dim3(256), args, 0, stream);
  if (e != hipSuccess) fprintf(stderr, "cooperative launch failed: %s (grid %d)\n", hipGetErrorString(e), grid_blocks);
#endif
}
```

```cpp
#include <hip/hip_runtime.h>
#include <hip/hip_cooperative_groups.h>
#include <cstdio>
namespace cg = cooperative_groups;

#define DI __device__ __forceinline__
typedef unsigned short bf16_t;
using bf16x8 = __attribute__((ext_vector_type(8))) short;
using f32x4 = __attribute__((ext_vector_type(4))) float;
using u32x4 = __attribute__((ext_vector_type(4))) unsigned;
using u32x2 = __attribute__((ext_vector_type(2))) unsigned;

#ifndef N_LAUNCH_SPLIT
#define N_LAUNCH_SPLIT 0
#endif

constexpr int NTOK = 20480, NPT = 4096, DM = 1024;
constexpr int NPHASE = 17;
constexpr size_t MiB = 1u << 20;
constexpr size_t OFF_WINT = 0, OFF_WUQT = 9 * MiB, OFF_WUKVT = 9 * MiB + 512 * 1024, OFF_WUPAT = 10 * MiB,
                 OFF_WUPBT = 11 * MiB, OFF_WOT = 12 * MiB, OFF_WCT = 14 * MiB, OFF_WPQB = 18 * MiB,
                 OFF_KEYSB = 22 * MiB, OFF_MOD = 22 * MiB + 512 * 1024, OFF_BAR = 22 * MiB + 768 * 1024, A0 = 24 * MiB;
constexpr size_t OFF_PD = A0 + 104 * MiB, OFF_H1 = A0 + 0, OFF_CQ = A0 + 40 * MiB, OFF_CKVRAW = A0 + 50 * MiB, OFF_KRRAW = A0 + 60 * MiB,
                 OFF_RQ = A0 + 63 * MiB, OFF_RK = A0 + 83 * MiB, OFF_KT = A0 + 103 * MiB, OFF_VT = A0 + 123 * MiB,
                 OFF_SRG = A0 + 143 * MiB, OFF_CKVALL = A0 + 163 * MiB, OFF_KRALL = A0 + 169 * MiB,
                 OFF_UF = A0 + 171 * MiB, OFF_UB = A0 + 187 * MiB,
                 OFF_SF = A0 + 0, OFF_SB = A0 + 8 * MiB, OFF_RET = A0 + 16 * MiB,
                 OFF_Q = A0 + 63 * MiB, OFF_KN = A0 + 93 * MiB, OFF_VTA = A0 + 117 * MiB, OFF_ATTN = A0 + 141 * MiB,
                 OFF_M = A0 + 163 * MiB,
                 OFF_H2 = A0 + 56 * MiB, OFF_TABU = A0 + 36 * MiB, OFF_TABV = A0 + 0, OFF_INVU = A0 + 52 * MiB,
                 OFF_INVV = A0 + 53 * MiB, OFF_ELIST = A0 + 16 * MiB, OFF_GLIST = A0 + 26 * MiB, OFF_SCORES = A0 + 104 * MiB;
constexpr size_t OUT_CKV = 20971520, OUT_KR = 21495808, OUT_SF = 21626880, OUT_SB = 22675456;
constexpr int NKV = 24576;
constexpr int SMEM_BYTES = 73728;

struct Params {
  const float *x_prompt, *x_sample, *c, *cache_ckv, *cache_krope, *st_f, *st_b, *c_ctx, *w_mod, *b_mod, *norm_mix,
      *norm_ffn, *norm_final, *w_in, *q_norm, *kv_norm, *w_uq, *w_ukv, *lg_f, *lg_b, *ret_gn, *w_up_a, *w_up_b, *w_o,
      *peer_wq, *keys1, *keys2, *peer_u, *peer_v;
  float* out;
  char* ws;
};

DI unsigned f2bf(float x) {
  unsigned u = __float_as_uint(x);
  u += 0x7fffu + ((u >> 16) & 1u);
  return u >> 16;
}
DI float bf2f(unsigned b) { return __uint_as_float(b << 16); }
typedef __bf16 hbf16x2_t __attribute__((ext_vector_type(2)));
typedef float hf32x2_t __attribute__((ext_vector_type(2)));
DI unsigned pack2(float a, float b) {
  hf32x2_t f = {a, b};
  return __builtin_bit_cast(unsigned, __builtin_convertvector(f, hbf16x2_t));
}
DI float ex2(float x) { return __builtin_amdgcn_exp2f(x); }
DI float bflo(unsigned u) { return __uint_as_float(u << 16); }
DI float bfhi(unsigned u) { return __uint_as_float(u & 0xffff0000u); }
DI float wsum(float v) {
#pragma unroll
  for (int o = 32; o > 0; o >>= 1) v += __shfl_xor(v, o);
  return v;
}
DI float sigmoidf_(float x) { return 1.f / (1.f + __expf(-x)); }
DI float siluf_(float x) { return x / (1.f + __expf(-x)); }
DI float geluf_(float x) { return 0.5f * x * (1.f + tanhf(0.7978845608028654f * (x + 0.044715f * x * x * x))); }
DI const float* xrow(const Params& p, int tok) {
  return tok < NPT ? p.x_prompt + (size_t)tok * DM : p.x_sample + (size_t)(tok - NPT) * DM;
}
DI int modidx(int tok) { return tok < NPT ? 0 : 1 + ((tok - NPT) >> 11); }
DI int kvrow(int tok) {
  if (tok < NPT) return tok;
  int t = tok - NPT;
  return NPT + (t >> 11) * 2560 + (t & 2047);
}
DI void st_bf16x16(bf16_t* dst, const float (&v)[16]) {
  u32x4 a, b;
  a[0] = pack2(v[0], v[1]); a[1] = pack2(v[2], v[3]); a[2] = pack2(v[4], v[5]); a[3] = pack2(v[6], v[7]);
  b[0] = pack2(v[8], v[9]); b[1] = pack2(v[10], v[11]); b[2] = pack2(v[12], v[13]); b[3] = pack2(v[14], v[15]);
  *(u32x4*)dst = a;
  *(u32x4*)(dst + 8) = b;
}
DI void st_f32x16(float* dst, const float (&v)[16]) {
#pragma unroll
  for (int i = 0; i < 4; ++i) *(float4*)(dst + 4 * i) = make_float4(v[4 * i], v[4 * i + 1], v[4 * i + 2], v[4 * i + 3]);
}
DI void ld_bf16x16(const bf16_t* src, float (&v)[16]) {
  u32x4 a = *(const u32x4*)src, b = *(const u32x4*)(src + 8);
#pragma unroll
  for (int i = 0; i < 4; ++i) {
    v[2 * i] = bflo(a[i]); v[2 * i + 1] = bfhi(a[i]);
    v[8 + 2 * i] = bflo(b[i]); v[8 + 2 * i + 1] = bfhi(b[i]);
  }
}

constexpr int LDK = 72;
template <int SCALE>
DI void gemm_kloop(f32x4 (&acc)[4][4], const bf16_t* __restrict__ A, int lda, const bf16_t* __restrict__ B, int ldb,
                   int K, char* smem, float sc_a, float sc_b) {
  bf16_t* As = (bf16_t*)smem;
  bf16_t* Bs = As + 128 * LDK;
  const int tid = threadIdx.x, lane = tid & 63, w = tid >> 6, wm = w >> 1, wn = w & 1, l15 = lane & 15, g = lane >> 4;
  u32x4 ra[4], rb[4];
  int arow[4], kc[4], ldsa[4], ldsb[4];
#pragma unroll
  for (int i = 0; i < 4; ++i) {
    int c = tid + 256 * i;
    int r = c >> 3;
    kc[i] = (c & 7) * 8;
    arow[i] = r;
    int rr = r & 63;
    int rho = (r & 64) | (((rr >> 2) & 3) << 4) | ((rr >> 4) << 2) | (rr & 3);
    ldsa[i] = rho * LDK + kc[i];
    ldsb[i] = r * LDK + kc[i];
  }
#pragma unroll
  for (int i = 0; i < 4; ++i) {
    ra[i] = *(const u32x4*)(A + (size_t)arow[i] * lda + kc[i]);
    rb[i] = *(const u32x4*)(B + (size_t)arow[i] * ldb + kc[i]);
  }
  __syncthreads();
#pragma unroll
  for (int i = 0; i < 4; ++i) {
    *(u32x4*)(As + ldsa[i]) = ra[i];
    *(u32x4*)(Bs + ldsb[i]) = rb[i];
  }
  if (64 < K) {
#pragma unroll
    for (int i = 0; i < 4; ++i) {
      ra[i] = *(const u32x4*)(A + (size_t)arow[i] * lda + 64 + kc[i]);
      rb[i] = *(const u32x4*)(B + (size_t)arow[i] * ldb + 64 + kc[i]);
    }
  }
  __syncthreads();
  int buf = 0;
  for (int k0 = 0; k0 < K; k0 += 64, buf ^= 1) {
    const bf16_t* Ac = As + buf * (256 * LDK);
    const bf16_t* Bc = Bs + buf * (256 * LDK);
#pragma unroll
    for (int ks = 0; ks < 2; ++ks) {
      bf16x8 af[4], bfr[4];
#pragma unroll
      for (int f = 0; f < 4; ++f)
        af[f] = *(const bf16x8*)(Ac + (wm * 64 + f * 16 + l15) * LDK + ks * 32 + g * 8);
#pragma unroll
      for (int c = 0; c < 4; ++c)
        bfr[c] = *(const bf16x8*)(Bc + (wn * 64 + c * 16 + l15) * LDK + ks * 32 + g * 8);
      if (SCALE) {
        float fac[8];
#pragma unroll
        for (int i = 0; i < 8; ++i) fac[i] = ex2(sc_a + sc_b * (float)(k0 + ks * 32 + g * 8 + i));
#pragma unroll
        for (int f = 0; f < 4; ++f) {
          u32x4 u = __builtin_bit_cast(u32x4, af[f]);
#pragma unroll
          for (int i = 0; i < 4; ++i) u[i] = pack2(bflo(u[i]) * fac[2 * i], bfhi(u[i]) * fac[2 * i + 1]);
          af[f] = __builtin_bit_cast(bf16x8, u);
        }
      }
#pragma unroll
      for (int f = 0; f < 4; ++f)
#pragma unroll
        for (int c = 0; c < 4; ++c) acc[f][c] = __builtin_amdgcn_mfma_f32_16x16x32_bf16(af[f], bfr[c], acc[f][c], 0, 0, 0);
    }
    if (k0 + 64 < K) {
      bf16_t* An = As + (buf ^ 1) * (256 * LDK);
      bf16_t* Bn = Bs + (buf ^ 1) * (256 * LDK);
#pragma unroll
      for (int i = 0; i < 4; ++i) {
        *(u32x4*)(An + ldsa[i]) = ra[i];
        *(u32x4*)(Bn + ldsb[i]) = rb[i];
      }
      if (k0 + 128 < K) {
#pragma unroll
        for (int i = 0; i < 4; ++i) {
          ra[i] = *(const u32x4*)(A + (size_t)arow[i] * lda + k0 + 128 + kc[i]);
          rb[i] = *(const u32x4*)(B + (size_t)arow[i] * ldb + k0 + 128 + kc[i]);
        }
      }
      __syncthreads();
    }
  }
}
DI void acc_zero(f32x4 (&acc)[4][4]) {
#pragma unroll
  for (int f = 0; f < 4; ++f)
#pragma unroll
    for (int c = 0; c < 4; ++c) acc[f][c] = f32x4{0.f, 0.f, 0.f, 0.f};
}
template <class F>
DI void epilogue(const f32x4 (&acc)[4][4], F&& epi) {
  const int tid = threadIdx.x, lane = tid & 63, w = tid >> 6, wm = w >> 1, wn = w & 1, l15 = lane & 15, g = lane >> 4;
#pragma unroll
  for (int c = 0; c < 4; ++c) {
    float v[16];
#pragma unroll
    for (int f = 0; f < 4; ++f)
#pragma unroll
      for (int j = 0; j < 4; ++j) v[f * 4 + j] = acc[f][c][j];
    epi(wm * 64 + 16 * g, wn * 64 + c * 16 + l15, v);
  }
}
DI bool tile_map(int it, int Ft, int Tt, int fsplit, int& ft, int& tt) {
  const int bid = blockIdx.x, nb = gridDim.x;
  int xcd = bid & 7, loc = bid >> 3, nloc = nb >> 3;
  if (loc >= nloc) return false;
  int fg = xcd % fsplit, tg = xcd / fsplit, tsplit = 8 / fsplit;
  int Fg = Ft / fsplit, Tg = Tt / tsplit;
  int i = loc + it * nloc;
  if (i >= Fg * Tg) return false;
  ft = fg * Fg + i % Fg;
  tt = tg * Tg + i / Fg;
  return true;
}
DI int vbid() {
  const int bid = blockIdx.x, nb = gridDim.x;
  if (nb & 7) return bid;
  return (bid & 7) * (nb >> 3) + (bid >> 3);
}

DI int colmap(int mode, int np) {
  if (mode == 1) return np < 416 ? np : (np < 512 ? -1 : np - 96);
  if (mode == 2) return np < 512 ? ((np >> 6) * 128 + (np & 63)) : (((np - 512) >> 6) * 128 + 64 + ((np - 512) & 63));
  return np;
}
DI void tconv_tile(const float* __restrict__ src, int ldsrc, bf16_t* __restrict__ dst, int K, int kt, int nt, int mode,
                   char* smem) {
  float* lds = (float*)smem;
  const int tid = threadIdx.x;
  {
    int col = tid & 63, rq = tid >> 6;
    int n = colmap(mode, nt * 64 + col);
#pragma unroll 4
    for (int r = 0; r < 16; ++r) {
      int kl = r * 4 + rq;
      float v = n >= 0 ? src[(size_t)(kt * 64 + kl) * ldsrc + n] : 0.f;
      lds[kl * 65 + col] = v;
    }
  }
  __syncthreads();
  {
    int nl = tid >> 2, kq = (tid & 3) * 16;
    float v[16];
#pragma unroll
    for (int i = 0; i < 16; ++i) v[i] = lds[(kq + i) * 65 + nl];
    st_bf16x16(dst + (size_t)(nt * 64 + nl) * K + kt * 64 + kq, v);
  }
  __syncthreads();
}
DI void mod_item(const Params& p, int item, char* smem) {
  float* sil = (float*)smem;
  const int tid = threadIdx.x;
  const int cg_ = item >> 2, slab = item & 3, kbase = slab * 256;
  for (int i = tid; i < 9 * 256; i += 256) {
    int j = i >> 8, k = kbase + (i & 255);
    float cv = j == 0 ? p.c_ctx[k] : p.c[(j - 1) * 1024 + k];
    sil[i] = siluf_(cv);
  }
  __syncthreads();
  const int kq = tid >> 6, nn = tid & 63, n0 = cg_ * 64;
  float acc[9];
#pragma unroll
  for (int j = 0; j < 9; ++j) acc[j] = 0.f;
#pragma unroll 1
  for (int i0 = 0; i0 < 64; i0 += 16) {
    float wv[16];
#pragma unroll
    for (int i = 0; i < 16; ++i) wv[i] = p.w_mod[(size_t)(kbase + kq + 4 * (i0 + i)) * 6144 + n0 + nn];
#pragma unroll
    for (int i = 0; i < 16; ++i)
#pragma unroll
      for (int j = 0; j < 9; ++j) acc[j] += sil[j * 256 + kq + 4 * (i0 + i)] * wv[i];
  }
  __syncthreads();
  float* part = (float*)smem + 9 * 256;
#pragma unroll
  for (int j = 0; j < 9; ++j) part[(kq * 9 + j) * 64 + nn] = acc[j];
  __syncthreads();
  float* mod = (float*)(p.ws + OFF_MOD);
  for (int i = tid; i < 9 * 64; i += 256) {
    int j = i >> 6, n = i & 63;
    float s = part[(0 * 9 + j) * 64 + n] + part[(1 * 9 + j) * 64 + n] + part[(2 * 9 + j) * 64 + n] + part[(3 * 9 + j) * 64 + n];
    if (slab == 0) s += p.b_mod[n0 + n];
    atomicAdd(mod + j * 6144 + n0 + n, s);
  }
  __syncthreads();
}
DI void conv_flat(const float* __restrict__ src, bf16_t* __restrict__ dst, size_t n) {
  size_t i = ((size_t)blockIdx.x * 256 + threadIdx.x) * 8;
  const size_t stride = (size_t)gridDim.x * 256 * 8;
  for (; i < n; i += stride) {
    float4 a = *(const float4*)(src + i), b = *(const float4*)(src + i + 4);
    u32x4 o;
    o[0] = pack2(a.x, a.y); o[1] = pack2(a.z, a.w); o[2] = pack2(b.x, b.y); o[3] = pack2(b.z, b.w);
    *(u32x4*)(dst + i) = o;
  }
}
DI void phase0(const Params& p, char* smem) {
  const int bid = blockIdx.x, nb = gridDim.x;
  char* ws = p.ws;
  const int n_mod = 384;
  const int t_in = 16 * 72, t_uq = 4 * 12, t_ukv = 2 * 16, t_upa = 8 * 16, t_upb = 8 * 16, t_o = 16 * 16;
  const int total = n_mod + t_in + t_uq + t_ukv + t_upa + t_upb + t_o;
  for (int it = bid; it < total; it += nb) {
    int i = it;
    if (i < n_mod) { mod_item(p, i, smem); continue; }
    i -= n_mod;
    if (i < t_in) { tconv_tile(p.w_in, 4512, (bf16_t*)(ws + OFF_WINT), 1024, i / 72, i % 72, 1, smem); continue; }
    i -= t_in;
    if (i < t_uq) { tconv_tile(p.w_uq, 768, (bf16_t*)(ws + OFF_WUQT), 256, i / 12, i % 12, 0, smem); continue; }
    i -= t_uq;
    if (i < t_ukv) { tconv_tile(p.w_ukv, 1024, (bf16_t*)(ws + OFF_WUKVT), 128, i / 16, i % 16, 2, smem); continue; }
    i -= t_ukv;
    if (i < t_upa) { tconv_tile(p.w_up_a, 1024, (bf16_t*)(ws + OFF_WUPAT), 512, i / 16, i % 16, 0, smem); continue; }
    i -= t_upa;
    if (i < t_upb) { tconv_tile(p.w_up_b, 1024, (bf16_t*)(ws + OFF_WUPBT), 512, i / 16, i % 16, 0, smem); continue; }
    i -= t_upb;
    tconv_tile(p.w_o, 1024, (bf16_t*)(ws + OFF_WOT), 1024, i / 16, i % 16, 0, smem);
  }
  conv_flat(p.peer_wq, (bf16_t*)(ws + OFF_WPQB), (size_t)1024 * 2048);
  {
    size_t i = ((size_t)bid * 256 + threadIdx.x) * 8;
    const size_t stride = (size_t)nb * 256 * 8;
    bf16_t* kb = (bf16_t*)(ws + OFF_KEYSB);
    for (; i < (size_t)2 * 131072; i += stride) {
      int half = i >= 131072;
      size_t s = i - (size_t)half * 131072;
      int h = (int)(s >> 14);
      size_t r = s & 16383;
      const float* src = (half ? p.keys2 : p.keys1) + s;
      float4 a = *(const float4*)(src), b = *(const float4*)(src + 4);
      u32x4 o;
      o[0] = pack2(a.x, a.y); o[1] = pack2(a.z, a.w); o[2] = pack2(b.x, b.y); o[3] = pack2(b.z, b.w);
      *(u32x4*)(kb + ((size_t)(h * 2 + half) << 14) + r) = o;
    }
  }
}

DI void rows_norm_mod(const Params& p, const float* nw, int sh_off, int sc_off, bool from_out, bf16_t* dst) {
  const int lane = threadIdx.x & 63, w = threadIdx.x >> 6;
  const float* mod = (const float*)(p.ws + OFF_MOD);
  for (int tok = blockIdx.x * 4 + w; tok < NTOK; tok += gridDim.x * 4) {
    const float* xr = from_out ? p.out + (size_t)tok * DM : xrow(p, tok);
    const float* mj = mod + modidx(tok) * 6144;
    float4 xv[4];
    float ss = 0.f;
#pragma unroll
    for (int i = 0; i < 4; ++i) {
      xv[i] = *(const float4*)(xr + (i * 64 + lane) * 4);
      ss += xv[i].x * xv[i].x + xv[i].y * xv[i].y + xv[i].z * xv[i].z + xv[i].w * xv[i].w;
    }
    ss = wsum(ss);
    float rstd = rsqrtf(ss * (1.f / 1024.f) + 1e-6f);
#pragma unroll
    for (int i = 0; i < 4; ++i) {
      int e = (i * 64 + lane) * 4;
      float4 nv = *(const float4*)(nw + e), sh = *(const float4*)(mj + sh_off + e), sc = *(const float4*)(mj + sc_off + e);
      float h0 = (xv[i].x * rstd) * nv.x * (1.f + sc.x) + sh.x;
      float h1 = (xv[i].y * rstd) * nv.y * (1.f + sc.y) + sh.y;
      float h2 = (xv[i].z * rstd) * nv.z * (1.f + sc.z) + sh.z;
      float h3 = (xv[i].w * rstd) * nv.w * (1.f + sc.w) + sh.w;
      u32x2 o;
      o[0] = pack2(h0, h1); o[1] = pack2(h2, h3);
      *(u32x2*)(dst + (size_t)tok * DM + e) = o;
    }
  }
}
DI void phase1(const Params& p, char* smem) {
  rows_norm_mod(p, p.norm_mix, 0, 1024, false, (bf16_t*)(p.ws + OFF_H1));
  const bf16_t* wpq = (const bf16_t*)(p.ws + OFF_WPQB);
  const bf16_t* kb = (const bf16_t*)(p.ws + OFF_KEYSB);
  bf16_t* wct = (bf16_t*)(p.ws + OFF_WCT);
  for (int it = blockIdx.x; it < 128; it += gridDim.x) {
    int hh = it >> 3, mt = it & 7;
    f32x4 acc[4][4];
    acc_zero(acc);
    gemm_kloop<0>(acc, wpq + (size_t)(mt * 128) * 2048 + hh * 128, 2048, kb + (size_t)hh * 16384, 128, 128, smem, 0.f, 0.f);
    epilogue(acc, [&](int m, int n, float (&v)[16]) { st_bf16x16(wct + (size_t)(hh * 128 + n) * 1024 + mt * 128 + m, v); });
  }
}

DI void phase2(const Params& p, char* smem) {
  char* ws = p.ws;
  const bf16_t* winT = (const bf16_t*)(ws + OFF_WINT);
  const bf16_t* h1 = (const bf16_t*)(ws + OFF_H1);
  bf16_t* cq = (bf16_t*)(ws + OFF_CQ);
  float* ckvraw = (float*)(ws + OFF_CKVRAW);
  float* krraw = (float*)(ws + OFF_KRRAW);
  bf16_t* rq = (bf16_t*)(ws + OFF_RQ);
  bf16_t* rk = (bf16_t*)(ws + OFF_RK);
  bf16_t* kT = (bf16_t*)(ws + OFF_KT);
  bf16_t* vT = (bf16_t*)(ws + OFF_VT);
  bf16_t* srg = (bf16_t*)(ws + OFF_SRG);
  bf16_t* sga = (bf16_t*)p.out;
  bf16_t* sgb = sga + (size_t)NTOK * 1024;
  for (int it = 0;; ++it) {
    int ft, tt;
    if (!tile_map(it, 36, 160, 4, ft, tt)) break;
    f32x4 acc[4][4];
    acc_zero(acc);
    const bf16_t* W = winT + (size_t)ft * 128 * 1024;
    const bf16_t* H = h1 + (size_t)tt * 128 * 1024;
    const int tok0 = tt * 128, f0 = ft * 128;
    if (ft >= 8 && ft < 16) {
      gemm_kloop<0>(acc, H, 1024, W, 1024, 1024, smem, 0.f, 0.f);
      if (ft < 12) {
        epilogue(acc, [&](int m, int n, float (&v)[16]) {
          int feat = f0 - 1024 + n, tok = tok0 + m;
#pragma unroll
          for (int i = 0; i < 16; ++i) v[i] *= 0.08838834764831845f;
          st_bf16x16(kT + (size_t)feat * NTOK + tok, v);
#pragma unroll
          for (int i = 0; i < 16; ++i) rk[(size_t)(tok + i) * 512 + feat] = (bf16_t)f2bf(v[i]);
        });
      } else {
        epilogue(acc, [&](int m, int n, float (&v)[16]) {
          int feat = f0 - 1536 + n, tok = tok0 + m;
          st_bf16x16(vT + (size_t)feat * NTOK + tok, v);
        });
      }
    } else {
      gemm_kloop<0>(acc, W, 1024, H, 1024, 1024, smem, 0.f, 0.f);
      if (ft < 2) {
        epilogue(acc, [&](int m, int n, float (&v)[16]) { st_bf16x16(cq + (size_t)(tok0 + n) * 256 + f0 + m, v); });
      } else if (ft == 2) {
        epilogue(acc, [&](int m, int n, float (&v)[16]) { st_f32x16(ckvraw + (size_t)(tok0 + n) * 128 + m, v); });
      } else if (ft == 3) {
        epilogue(acc, [&](int m, int n, float (&v)[16]) {
          if (m < 32) st_f32x16(krraw + (size_t)(tok0 + n) * 32 + m, v);
        });
      } else if (ft < 8) {
        epilogue(acc, [&](int m, int n, float (&v)[16]) { st_bf16x16(rq + (size_t)(tok0 + n) * 512 + f0 - 512 + m, v); });
      } else if (ft < 20) {
        epilogue(acc, [&](int m, int n, float (&v)[16]) {
#pragma unroll
          for (int i = 0; i < 16; ++i) v[i] = siluf_(v[i]);
          st_bf16x16(srg + (size_t)(tok0 + n) * 512 + f0 - 2048 + m, v);
        });
      } else if (ft < 28) {
        epilogue(acc, [&](int m, int n, float (&v)[16]) {
#pragma unroll
          for (int i = 0; i < 16; ++i) v[i] = sigmoidf_(v[i]);
          st_bf16x16(sga + (size_t)(tok0 + n) * 1024 + f0 - 2560 + m, v);
        });
      } else {
        epilogue(acc, [&](int m, int n, float (&v)[16]) {
#pragma unroll
          for (int i = 0; i < 16; ++i) v[i] = sigmoidf_(v[i]);
          st_bf16x16(sgb + (size_t)(tok0 + n) * 1024 + f0 - 3584 + m, v);
        });
      }
    }
  }
}

DI float log2gamma(float logit) { return -log1pf(expf(-logit)) * 1.4426950408889634f; }
DI void phase3(const Params& p, char* smem) {
  char* ws = p.ws;
  const int lane = threadIdx.x & 63, w = threadIdx.x >> 6;
  bf16_t* cq = (bf16_t*)(ws + OFF_CQ);
  const float* ckvraw = (const float*)(ws + OFF_CKVRAW);
  const float* krraw = (const float*)(ws + OFF_KRRAW);
  bf16_t* ckvall = (bf16_t*)(ws + OFF_CKVALL);
  bf16_t* krall = (bf16_t*)(ws + OFF_KRALL);
  for (int r = blockIdx.x * 4 + w; r < NTOK + 4096; r += gridDim.x * 4) {
    if (r < NTOK) {
      const int tok = r;
      {
        u32x2 u = *(const u32x2*)(cq + (size_t)tok * 256 + lane * 4);
        float a0 = bflo(u[0]), a1 = bfhi(u[0]), a2 = bflo(u[1]), a3 = bfhi(u[1]);
        float ss = wsum(a0 * a0 + a1 * a1 + a2 * a2 + a3 * a3);
        float rstd = rsqrtf(ss * (1.f / 256.f) + 1e-6f);
        float4 nq = *(const float4*)(p.q_norm + lane * 4);
        u32x2 o;
        o[0] = pack2(a0 * rstd * nq.x, a1 * rstd * nq.y);
        o[1] = pack2(a2 * rstd * nq.z, a3 * rstd * nq.w);
        *(u32x2*)(cq + (size_t)tok * 256 + lane * 4) = o;
      }
      const int row = kvrow(tok);
      {
        float2 v = *(const float2*)(ckvraw + (size_t)tok * 128 + lane * 2);
        float ss = wsum(v.x * v.x + v.y * v.y);
        float rstd = rsqrtf(ss * (1.f / 128.f) + 1e-6f);
        float2 nk = *(const float2*)(p.kv_norm + lane * 2);
        float o0 = v.x * rstd * nk.x, o1 = v.y * rstd * nk.y;
        if (tok < NPT) *(float2*)(p.out + OUT_CKV + (size_t)tok * 128 + lane * 2) = make_float2(o0, o1);
        *(unsigned*)(ckvall + (size_t)row * 128 + lane * 2) = pack2(o0, o1);
      }
      if (lane < 32) {
        float own = krraw[(size_t)tok * 32 + lane];
        float o = own;
        if (tok < NPT) {
          p.out[OUT_KR + (size_t)tok * 32 + lane] = own;
        } else {
          float partner = krraw[(size_t)tok * 32 + (lane ^ 16)];
          int t = (tok - NPT) & 2047;
          int a = lane & 15;
          float pos = (a < 8) ? (float)(t >> 6) : (float)(t & 63);
          float fr = exp2f(-(float)(a & 7) * 1.6609640474436813f);
          float sn, cs;
          sincosf(pos * fr, &sn, &cs);
          o = lane < 16 ? own * cs - partner * sn : partner * sn + own * cs;
        }
        krall[(size_t)row * 32 + lane] = (bf16_t)f2bf(o);
      }
    } else {
      const int cr = r - NTOK;
      const int b = cr >> 9, pos = cr & 511;
      const int row = NPT + b * 2560 + 2048 + pos;
      float2 v = *(const float2*)(p.cache_ckv + (size_t)cr * 128 + lane * 2);
      *(unsigned*)(ckvall + (size_t)row * 128 + lane * 2) = pack2(v.x, v.y);
      if (lane < 32) krall[(size_t)row * 32 + lane] = (bf16_t)f2bf(p.cache_krope[(size_t)cr * 32 + lane]);
    }
  }
  const bf16_t* kT = (const bf16_t*)(ws + OFF_KT);
  const bf16_t* vT = (const bf16_t*)(ws + OFF_VT);
  float* Uf = (float*)(ws + OFF_UF);
  float* Ub = (float*)(ws + OFF_UB);
  for (int it = blockIdx.x; it < 320; it += gridDim.x) {
    const int blk = it >> 2, h = it & 3;
    const float l2f = log2gamma(p.lg_f[h]), l2b = log2gamma(p.lg_b[h]);
    const bf16_t* Kp = kT + (size_t)(h * 128) * NTOK + blk * 256;
    const bf16_t* Vp = vT + (size_t)(h * 128) * NTOK + blk * 256;
#pragma unroll 1
    for (int dir = 0; dir < 2; ++dir) {
      const float sa = dir ? 0.f : l2f * 255.f, sb = dir ? l2b : -l2f;
      f32x4 acc[4][4];
      acc_zero(acc);
      if (blk < 16) {
        gemm_kloop<1>(acc, Vp, NTOK, Kp, NTOK, 256, smem, sa, sb);
        float* dst = p.out + (dir ? OUT_SB : OUT_SF) + (size_t)(blk * 4 + h) * 16384;
        epilogue(acc, [&](int m, int n, float (&v)[16]) { st_f32x16(dst + n * 128 + m, v); });
      } else {
        gemm_kloop<1>(acc, Kp, NTOK, Vp, NTOK, 256, smem, sa, sb);
        float* dst = (dir ? Ub : Uf) + (size_t)((blk - 16) * 4 + h) * 16384;
        epilogue(acc, [&](int m, int n, float (&v)[16]) { st_f32x16(dst + n * 128 + m, v); });
      }
    }
  }
}

DI void phase4(const Params& p) {
  char* ws = p.ws;
  const float* Uf = (const float*)(ws + OFF_UF);
  const float* Ub = (const float*)(ws + OFF_UB);
  bf16_t* Sf = (bf16_t*)(ws + OFF_SF);
  bf16_t* Sb = (bf16_t*)(ws + OFF_SB);
  for (int idx = blockIdx.x * 256 + threadIdx.x; idx < (1 << 20); idx += gridDim.x * 256) {
    int d = idx & 127, e = (idx >> 7) & 127, h = (idx >> 14) & 3, b = (idx >> 16) & 7, dir = idx >> 19;
    size_t eo = (size_t)e * 128 + d;
    if (dir == 0) {
      float cf = exp2f(log2gamma(p.lg_f[h]) * 256.f);
      float S = p.st_f[(size_t)(b * 4 + h) * 16384 + d * 128 + e];
#pragma unroll
      for (int blk = 0; blk < 8; ++blk) {
        size_t o = (size_t)((b * 8 + blk) * 4 + h) * 16384 + eo;
        Sf[o] = (bf16_t)f2bf(S);
        S = cf * S + Uf[o];
      }
    } else {
      float cb = exp2f(log2gamma(p.lg_b[h]) * 256.f);
      float S = p.st_b[(size_t)(b * 4 + h) * 16384 + d * 128 + e];
#pragma unroll
      for (int blk = 7; blk >= 0; --blk) {
        size_t o = (size_t)((b * 8 + blk) * 4 + h) * 16384 + eo;
        Sb[o] = (bf16_t)f2bf(S);
        S = cb * S + Ub[o];
      }
    }
  }
}

DI bf16x8 scale_frag(bf16x8 q, float s) {
  u32x4 u = __builtin_bit_cast(u32x4, q);
#pragma unroll
  for (int i = 0; i < 4; ++i) u[i] = pack2(bflo(u[i]) * s, bfhi(u[i]) * s);
  return __builtin_bit_cast(bf16x8, u);
}
constexpr int NQT = 1;
DI void phase5(const Params& p, char* smem) {
  char* ws = p.ws;
  const bf16_t* rq = (const bf16_t*)(ws + OFF_RQ);
  const bf16_t* rk = (const bf16_t*)(ws + OFF_RK);
  const bf16_t* vT = (const bf16_t*)(ws + OFF_VT);
  const bf16_t* srg = (const bf16_t*)(ws + OFF_SRG);
  const bf16_t* Sf = (const bf16_t*)(ws + OFF_SF);
  const bf16_t* Sb = (const bf16_t*)(ws + OFF_SB);
  bf16_t* ret = (bf16_t*)(ws + OFF_RET);
  bf16_t* Ks = (bf16_t*)smem;
  bf16_t* Vs = Ks + 64 * 136;
  const int tid = threadIdx.x, lane = tid & 63, w = tid >> 6, l15 = lane & 15, g = lane >> 4;
  for (int item = vbid(); item < 640 * (2 / NQT); item += gridDim.x) {
    const int qb = item >> 2, h = item & 3, blk = (qb * NQT) >> 2;
    const float l2f = log2gamma(p.lg_f[h]), l2b = log2gamma(p.lg_b[h]);
    const int tokw = qb * (64 * NQT) + w * (16 * NQT);
    bf16x8 Q[NQT][4];
#pragma unroll
    for (int qt = 0; qt < NQT; ++qt)
#pragma unroll
      for (int ks = 0; ks < 4; ++ks)
        Q[qt][ks] = *(const bf16x8*)(rq + (size_t)(tokw + qt * 16 + l15) * 512 + h * 128 + ks * 32 + g * 8);
    f32x4 o[8][NQT];
#pragma unroll
    for (int et = 0; et < 8; ++et)
#pragma unroll
      for (int qt = 0; qt < NQT; ++qt) o[et][qt] = f32x4{0.f, 0.f, 0.f, 0.f};
#pragma unroll 1
    for (int kt = 0; kt < 4; ++kt) {
      const int key0 = blk * 256 + kt * 64;
      __syncthreads();
#pragma unroll
      for (int i = 0; i < 4; ++i) {
        int c = tid + 256 * i;
        int r = c >> 4, cc = (c & 15) * 8;
        *(u32x4*)(Ks + r * 136 + cc) = *(const u32x4*)(rk + (size_t)(key0 + r) * 512 + h * 128 + cc);
        int e = c >> 3, c2 = (c & 7) * 8;
        *(u32x4*)(Vs + e * 72 + c2) = *(const u32x4*)(vT + (size_t)(h * 128 + e) * NTOK + key0 + c2);
      }
      __syncthreads();
      bf16x8 P[NQT][2];
#pragma unroll
      for (int qt = 0; qt < NQT; ++qt) {
        f32x4 s[4];
#pragma unroll
        for (int kk = 0; kk < 4; ++kk) s[kk] = f32x4{0.f, 0.f, 0.f, 0.f};
#pragma unroll
        for (int ks = 0; ks < 4; ++ks) {
#pragma unroll
          for (int kk = 0; kk < 4; ++kk) {
            bf16x8 a = *(const bf16x8*)(Ks + (kk * 16 + l15) * 136 + ks * 32 + g * 8);
            s[kk] = __builtin_amdgcn_mfma_f32_16x16x32_bf16(a, Q[qt][ks], s[kk], 0, 0, 0);
          }
        }
        const int iq = (tokw + qt * 16 + l15) & 255;
#pragma unroll
        for (int kk = 0; kk < 4; ++kk) {
#pragma unroll
          for (int j = 0; j < 4; ++j) {
            int jk = kt * 64 + kk * 16 + 4 * g + j;
            int diff = iq - jk;
            float dm = diff > 0 ? ex2(l2f * (float)diff) : (diff < 0 ? ex2(l2b * (float)(-diff)) : 2.f);
            s[kk][j] *= dm;
          }
        }
#pragma unroll
        for (int k2 = 0; k2 < 2; ++k2) {
          u32x4 u;
          u[0] = pack2(s[2 * k2][0], s[2 * k2][1]);
          u[1] = pack2(s[2 * k2][2], s[2 * k2][3]);
          u[2] = pack2(s[2 * k2 + 1][0], s[2 * k2 + 1][1]);
          u[3] = pack2(s[2 * k2 + 1][2], s[2 * k2 + 1][3]);
          P[qt][k2] = __builtin_bit_cast(bf16x8, u);
        }
      }
#pragma unroll
      for (int k2 = 0; k2 < 2; ++k2) {
#pragma unroll
        for (int et = 0; et < 8; ++et) {
          u32x2 lo = *(const u32x2*)(Vs + (et * 16 + l15) * 72 + k2 * 32 + 4 * g);
          u32x2 hi = *(const u32x2*)(Vs + (et * 16 + l15) * 72 + k2 * 32 + 16 + 4 * g);
          u32x4 u;
          u[0] = lo[0]; u[1] = lo[1]; u[2] = hi[0]; u[3] = hi[1];
          bf16x8 a = __builtin_bit_cast(bf16x8, u);
#pragma unroll
          for (int qt = 0; qt < NQT; ++qt) o[et][qt] = __builtin_amdgcn_mfma_f32_16x16x32_bf16(a, P[qt][k2], o[et][qt], 0, 0, 0);
        }
      }
    }
    if (blk >= 16) {
#pragma unroll 1
      for (int dir = 0; dir < 2; ++dir) {
        const bf16_t* S = (dir ? Sb : Sf) + (size_t)((blk - 16) * 4 + h) * 16384;
        float dq[NQT];
#pragma unroll
        for (int qt = 0; qt < NQT; ++qt) {
          int iq = (tokw + qt * 16 + l15) & 255;
          dq[qt] = dir ? exp2f(l2b * (float)(256 - iq)) : exp2f(l2f * (float)(iq + 1));
        }
#pragma unroll
        for (int ks = 0; ks < 4; ++ks) {
          bf16x8 qs[NQT];
#pragma unroll
          for (int qt = 0; qt < NQT; ++qt) qs[qt] = scale_frag(Q[qt][ks], dq[qt]);
#pragma unroll
          for (int et = 0; et < 8; ++et) {
            bf16x8 a = *(const bf16x8*)(S + (size_t)(et * 16 + l15) * 128 + ks * 32 + g * 8);
#pragma unroll
            for (int qt = 0; qt < NQT; ++qt) o[et][qt] = __builtin_amdgcn_mfma_f32_16x16x32_bf16(a, qs[qt], o[et][qt], 0, 0, 0);
          }
        }
      }
    }
#pragma unroll
    for (int qt = 0; qt < NQT; ++qt) {
      const int tok = tokw + qt * 16 + l15;
      float s1 = 0.f;
#pragma unroll
      for (int et = 0; et < 8; ++et)
#pragma unroll
        for (int j = 0; j < 4; ++j) s1 += o[et][qt][j];
      s1 += __shfl_xor(s1, 16);
      s1 += __shfl_xor(s1, 32);
      const float mu = s1 * (1.f / 128.f);
      float s2 = 0.f;
#pragma unroll
      for (int et = 0; et < 8; ++et)
#pragma unroll
        for (int j = 0; j < 4; ++j) {
          float dlt = o[et][qt][j] - mu;
          s2 += dlt * dlt;
        }
      s2 += __shfl_xor(s2, 16);
      s2 += __shfl_xor(s2, 32);
      const float rstd = rsqrtf(s2 * (1.f / 128.f) + 1e-6f);
#pragma unroll
      for (int et = 0; et < 8; ++et) {
        const int e = h * 128 + et * 16 + 4 * g;
        float4 gn = *(const float4*)(p.ret_gn + e);
        u32x2 sg = *(const u32x2*)(srg + (size_t)tok * 512 + e);
        u32x2 ov;
        ov[0] = pack2((o[et][qt][0] - mu) * rstd * gn.x * bflo(sg[0]), (o[et][qt][1] - mu) * rstd * gn.y * bfhi(sg[0]));
        ov[1] = pack2((o[et][qt][2] - mu) * rstd * gn.z * bflo(sg[1]), (o[et][qt][3] - mu) * rstd * gn.w * bfhi(sg[1]));
        *(u32x2*)(ret + (size_t)tok * 512 + e) = ov;
      }
    }
  }
}

DI void phase6(const Params& p, char* smem) {
  char* ws = p.ws;
  const bf16_t* cqn = (const bf16_t*)(ws + OFF_CQ);
  const bf16_t* wuqT = (const bf16_t*)(ws + OFF_WUQT);
  bf16_t* q = (bf16_t*)(ws + OFF_Q);
  for (int it = 0;; ++it) {
    int ft, tt;
    if (!tile_map(it, 6, 160, 1, ft, tt)) break;
    f32x4 acc[4][4];
    acc_zero(acc);
    gemm_kloop<0>(acc, wuqT + (size_t)ft * 128 * 256, 256, cqn + (size_t)tt * 128 * 256, 256, 256, smem, 0.f, 0.f);
    epilogue(acc, [&](int m, int n, float (&v)[16]) { st_bf16x16(q + (size_t)(tt * 128 + n) * 768 + ft * 128 + m, v); });
  }
  const bf16_t* ckvall = (const bf16_t*)(ws + OFF_CKVALL);
  const bf16_t* wukvT = (const bf16_t*)(ws + OFF_WUKVT);
  bf16_t* Kn = (bf16_t*)(ws + OFF_KN);
  bf16_t* Vt = (bf16_t*)(ws + OFF_VTA);
  for (int it = 0;; ++it) {
    int ft, tt;
    if (!tile_map(it, 8, 192, 1, ft, tt)) break;
    f32x4 acc[4][4];
    acc_zero(acc);
    const bf16_t* W = wukvT + (size_t)ft * 128 * 128;
    const bf16_t* X = ckvall + (size_t)tt * 128 * 128;
    if (ft < 4) {
      gemm_kloop<0>(acc, W, 128, X, 128, 128, smem, 0.f, 0.f);
      epilogue(acc, [&](int m, int n, float (&v)[16]) { st_bf16x16(Kn + (size_t)(tt * 128 + n) * 512 + ft * 128 + m, v); });
    } else {
      gemm_kloop<0>(acc, X, 128, W, 128, 128, smem, 0.f, 0.f);
      epilogue(acc, [&](int m, int n, float (&v)[16]) { st_bf16x16(Vt + (size_t)((ft - 4) * 128 + n) * NKV + tt * 128 + m, v); });
    }
  }
}

DI void conv_fp8_rows(const float* __restrict__ src, unsigned char* __restrict__ dst, float* __restrict__ inv);
DI void phase7(const Params& p, char* smem) {
  char* ws = p.ws;
  const bf16_t* q = (const bf16_t*)(ws + OFF_Q);
  const bf16_t* Kn = (const bf16_t*)(ws + OFF_KN);
  const bf16_t* Vt = (const bf16_t*)(ws + OFF_VTA);
  const bf16_t* krall = (const bf16_t*)(ws + OFF_KRALL);
  bf16_t* attn = (bf16_t*)(ws + OFF_ATTN);
  bf16_t* Ks0 = (bf16_t*)smem;
  const int tid = threadIdx.x, lane = tid & 63, w = tid >> 6, l15 = lane & 15, g = lane >> 4;
  const float qscale = 0.10206207261596577f * 1.4426950408889634f;
  for (int item = vbid(); item < 1280; item += gridDim.x) {
    int b, h, qtok0, keyrow0, nkt;
    bool sample;
    if (item < 1024) {
      sample = true; b = item >> 7; h = (item >> 4) & 7; int qb = item & 15;
      qtok0 = NPT + b * 2048 + qb * 128; keyrow0 = NPT + b * 2560; nkt = 40;
    } else {
      int it2 = item - 1024;
      sample = false; b = it2 >> 4; h = (it2 >> 1) & 7; int qb = it2 & 1;
      qtok0 = b * 256 + qb * 128; keyrow0 = b * 256; nkt = 4;
    }
    bf16x8 Q[2][3];
#pragma unroll
    for (int qt = 0; qt < 2; ++qt) {
      const int tokq = qtok0 + w * 32 + qt * 16 + l15;
      const bf16_t* qp = q + (size_t)tokq * 768 + h * 96;
#pragma unroll
      for (int ks = 0; ks < 3; ++ks) {
        u32x4 u = *(const u32x4*)(qp + ks * 32 + g * 8);
        float v[8];
#pragma unroll
        for (int i = 0; i < 4; ++i) { v[2 * i] = bflo(u[i]); v[2 * i + 1] = bfhi(u[i]); }
        if (ks == 2 && sample) {
          u32x4 up = *(const u32x4*)(qp + 64 + (g ^ 2) * 8);
          float pv[8];
#pragma unroll
          for (int i = 0; i < 4; ++i) { pv[2 * i] = bflo(up[i]); pv[2 * i + 1] = bfhi(up[i]); }
          int t = (tokq - NPT) & 2047;
          float pos = (g & 1) ? (float)(t & 63) : (float)(t >> 6);
#pragma unroll
          for (int i = 0; i < 8; ++i) {
            float fr = exp2f(-(float)i * 1.6609640474436813f);
            float sn, cs;
            sincosf(pos * fr, &sn, &cs);
            v[i] = g < 2 ? v[i] * cs - pv[i] * sn : pv[i] * sn + v[i] * cs;
          }
        }
        u32x4 o4;
#pragma unroll
        for (int i = 0; i < 4; ++i) o4[i] = pack2(v[2 * i] * qscale, v[2 * i + 1] * qscale);
        Q[qt][ks] = __builtin_bit_cast(bf16x8, o4);
      }
    }
    f32x4 o[4][2];
#pragma unroll
    for (int et = 0; et < 4; ++et)
#pragma unroll
      for (int qt = 0; qt < 2; ++qt) o[et][qt] = f32x4{0.f, 0.f, 0.f, 0.f};
    float mrun[2] = {-1e30f, -1e30f}, lrun[2] = {0.f, 0.f};
    u32x4 rk_[3], rv_[2];
    auto gload = [&](int kt) {
      const int row0 = keyrow0 + kt * 64;
#pragma unroll
      for (int i = 0; i < 3; ++i) {
        int c = tid + 256 * i;
        int r = c / 12, cc = c - r * 12;
        rk_[i] = cc < 8 ? *(const u32x4*)(Kn + (size_t)(row0 + r) * 512 + h * 64 + cc * 8)
                        : *(const u32x4*)(krall + (size_t)(row0 + r) * 32 + (cc - 8) * 8);
      }
#pragma unroll
      for (int i = 0; i < 2; ++i) {
        int c = tid + 256 * i;
        int e = c >> 3, cc = (c & 7) * 8;
        rv_[i] = *(const u32x4*)(Vt + (size_t)(h * 64 + e) * NKV + row0 + cc);
      }
    };
    auto lstore = [&](int b) {
      bf16_t* Kd = Ks0 + b * 11264;
      bf16_t* Vd = Kd + 64 * 104;
#pragma unroll
      for (int i = 0; i < 3; ++i) {
        int c = tid + 256 * i;
        int r = c / 12, cc = c - r * 12;
        *(u32x4*)(Kd + r * 104 + cc * 8) = rk_[i];
      }
#pragma unroll
      for (int i = 0; i < 2; ++i) {
        int c = tid + 256 * i;
        int e = c >> 3, cc = (c & 7) * 8;
        *(u32x4*)(Vd + e * 72 + cc) = rv_[i];
      }
    };
    gload(0);
    __syncthreads();
    lstore(0);
    if (nkt > 1) gload(1);
    __syncthreads();
#pragma unroll 1
    for (int kt = 0; kt < nkt; ++kt) {
      const bf16_t* Ks = Ks0 + (kt & 1) * 11264;
      const bf16_t* Vs = Ks + 64 * 104;
      f32x4 s[4][2];
#pragma unroll
      for (int kk = 0; kk < 4; ++kk)
#pragma unroll
        for (int qt = 0; qt < 2; ++qt) s[kk][qt] = f32x4{0.f, 0.f, 0.f, 0.f};
#pragma unroll
      for (int ks = 0; ks < 3; ++ks) {
#pragma unroll
        for (int kk = 0; kk < 4; ++kk) {
          bf16x8 a = *(const bf16x8*)(Ks + (kk * 16 + l15) * 104 + ks * 32 + g * 8);
#pragma unroll
          for (int qt = 0; qt < 2; ++qt) s[kk][qt] = __builtin_amdgcn_mfma_f32_16x16x32_bf16(a, Q[qt][ks], s[kk][qt], 0, 0, 0);
        }
      }
      bf16x8 P[2][2];
#pragma unroll
      for (int qt = 0; qt < 2; ++qt) {
        float mx = s[0][qt][0];
#pragma unroll
        for (int kk = 0; kk < 4; ++kk)
#pragma unroll
          for (int j = 0; j < 4; ++j) mx = fmaxf(mx, s[kk][qt][j]);
        mx = fmaxf(mx, __shfl_xor(mx, 16));
        mx = fmaxf(mx, __shfl_xor(mx, 32));
        const float mnew = fmaxf(mrun[qt], mx);
        const bool grow = __ballot(mx > mrun[qt]) != 0ull;
        const float alpha = grow ? ex2(mrun[qt] - mnew) : 1.f;
        mrun[qt] = mnew;
        float ps = 0.f;
#pragma unroll
        for (int kk = 0; kk < 4; ++kk)
#pragma unroll
          for (int j = 0; j < 4; ++j) {
            float e_ = ex2(s[kk][qt][j] - mnew);
            s[kk][qt][j] = e_;
            ps += e_;
          }
        if (grow) {
          lrun[qt] = lrun[qt] * alpha + ps;
#pragma unroll
          for (int et = 0; et < 4; ++et)
#pragma unroll
            for (int j = 0; j < 4; ++j) o[et][qt][j] *= alpha;
        } else {
          lrun[qt] += ps;
        }
#pragma unroll
        for (int k2 = 0; k2 < 2; ++k2) {
          u32x4 u;
          u[0] = pack2(s[2 * k2][qt][0], s[2 * k2][qt][1]);
          u[1] = pack2(s[2 * k2][qt][2], s[2 * k2][qt][3]);
          u[2] = pack2(s[2 * k2 + 1][qt][0], s[2 * k2 + 1][qt][1]);
          u[3] = pack2(s[2 * k2 + 1][qt][2], s[2 * k2 + 1][qt][3]);
          P[qt][k2] = __builtin_bit_cast(bf16x8, u);
        }
      }
#pragma unroll
      for (int k2 = 0; k2 < 2; ++k2) {
#pragma unroll
        for (int et = 0; et < 4; ++et) {
          u32x2 lo = *(const u32x2*)(Vs + (et * 16 + l15) * 72 + k2 * 32 + 4 * g);
          u32x2 hi = *(const u32x2*)(Vs + (et * 16 + l15) * 72 + k2 * 32 + 16 + 4 * g);
          u32x4 u;
          u[0] = lo[0]; u[1] = lo[1]; u[2] = hi[0]; u[3] = hi[1];
          bf16x8 a = __builtin_bit_cast(bf16x8, u);
#pragma unroll
          for (int qt = 0; qt < 2; ++qt) o[et][qt] = __builtin_amdgcn_mfma_f32_16x16x32_bf16(a, P[qt][k2], o[et][qt], 0, 0, 0);
        }
      }
      if (kt + 1 < nkt) {
        lstore((kt + 1) & 1);
        if (kt + 2 < nkt) gload(kt + 2);
        __syncthreads();
      }
    }
#pragma unroll
    for (int qt = 0; qt < 2; ++qt) {
      const int tokq = qtok0 + w * 32 + qt * 16 + l15;
      float lt = lrun[qt];
      lt += __shfl_xor(lt, 16);
      lt += __shfl_xor(lt, 32);
      const float inv = 1.f / lt;
#pragma unroll
      for (int et = 0; et < 4; ++et) {
        u32x2 ov;
        ov[0] = pack2(o[et][qt][0] * inv, o[et][qt][1] * inv);
        ov[1] = pack2(o[et][qt][2] * inv, o[et][qt][3] * inv);
        *(u32x2*)(attn + (size_t)tokq * 512 + h * 64 + et * 16 + 4 * g) = ov;
      }
    }
  }
  conv_fp8_rows(p.peer_u, (unsigned char*)(p.ws + OFF_TABU), (float*)(p.ws + OFF_INVU));
  conv_fp8_rows(p.peer_v, (unsigned char*)(p.ws + OFF_TABV), (float*)(p.ws + OFF_INVV));
}

DI void phase8(const Params& p, char* smem) {
  char* ws = p.ws;
  const bf16_t* attn = (const bf16_t*)(ws + OFF_ATTN);
  const bf16_t* ret = (const bf16_t*)(ws + OFF_RET);
  const bf16_t* wa = (const bf16_t*)(ws + OFF_WUPAT);
  const bf16_t* wb = (const bf16_t*)(ws + OFF_WUPBT);
  const bf16_t* sga = (const bf16_t*)p.out;
  const bf16_t* sgb = sga + (size_t)NTOK * 1024;
  bf16_t* mbuf = (bf16_t*)(ws + OFF_M);
  const int tid = threadIdx.x, lane = tid & 63, w = tid >> 6, wm = w >> 1, wn = w & 1, l15 = lane & 15, g = lane >> 4;
  for (int it = 0;; ++it) {
    int ft, tt;
    if (!tile_map(it, 8, 160, 1, ft, tt)) break;
    f32x4 acc[4][4];
    acc_zero(acc);
    gemm_kloop<0>(acc, wa + (size_t)ft * 128 * 512, 512, attn + (size_t)tt * 128 * 512, 512, 512, smem, 0.f, 0.f);
#pragma unroll
    for (int c = 0; c < 4; ++c) {
      const size_t off = (size_t)(tt * 128 + wn * 64 + c * 16 + l15) * 1024 + ft * 128 + wm * 64 + 16 * g;
      float a[16], bq[16];
      ld_bf16x16(sga + off, a);
      ld_bf16x16(sgb + off, bq);
#pragma unroll
      for (int f = 0; f < 4; ++f)
#pragma unroll
        for (int j = 0; j < 4; ++j) acc[f][c][j] *= a[f * 4 + j] / fmaxf(bq[f * 4 + j], 1e-30f);
    }
    gemm_kloop<0>(acc, wb + (size_t)ft * 128 * 512, 512, ret + (size_t)tt * 128 * 512, 512, 512, smem, 0.f, 0.f);
    epilogue(acc, [&](int m, int n, float (&v)[16]) {
      const size_t off = (size_t)(tt * 128 + n) * 1024 + ft * 128 + m;
      float bq[16];
      ld_bf16x16(sgb + off, bq);
#pragma unroll
      for (int i = 0; i < 16; ++i) v[i] *= bq[i];
      st_bf16x16(mbuf + off, v);
    });
  }
}
DI void phase9(const Params& p, char* smem) {
  char* ws = p.ws;
  const bf16_t* mbuf = (const bf16_t*)(ws + OFF_M);
  const bf16_t* wo = (const bf16_t*)(ws + OFF_WOT);
  const float* mod = (const float*)(ws + OFF_MOD);
  for (int it = 0;; ++it) {
    int ft, tt;
    if (!tile_map(it, 8, 160, 1, ft, tt)) break;
    f32x4 acc[4][4];
    acc_zero(acc);
    gemm_kloop<0>(acc, wo + (size_t)ft * 128 * 1024, 1024, mbuf + (size_t)tt * 128 * 1024, 1024, 1024, smem, 0.f, 0.f);
    epilogue(acc, [&](int m, int n, float (&v)[16]) {
      const int tok = tt * 128 + n, feat = ft * 128 + m;
      const float* xr = xrow(p, tok) + feat;
      const float* g1 = mod + modidx(tok) * 6144 + 2048 + feat;
#pragma unroll
      for (int i = 0; i < 4; ++i) {
        float4 xv = *(const float4*)(xr + 4 * i), gv = *(const float4*)(g1 + 4 * i);
        v[4 * i] = xv.x + gv.x * v[4 * i];
        v[4 * i + 1] = xv.y + gv.y * v[4 * i + 1];
        v[4 * i + 2] = xv.z + gv.z * v[4 * i + 2];
        v[4 * i + 3] = xv.w + gv.w * v[4 * i + 3];
      }
      st_f32x16(p.out + (size_t)tok * DM + feat, v);
    });
  }
}
DI void conv_fp8_rows(const float* __restrict__ src, unsigned char* __restrict__ dst, float* __restrict__ inv) {
  const int lane = threadIdx.x & 63, w = threadIdx.x >> 6;
  for (int r = blockIdx.x * 4 + w; r < 16384; r += gridDim.x * 4) {
    const float* sp = src + (size_t)r * 1024 + lane * 16;
    float4 v[4];
    float am = 0.f;
#pragma unroll
    for (int i = 0; i < 4; ++i) {
      v[i] = *(const float4*)(sp + 4 * i);
      am = fmaxf(am, fmaxf(fmaxf(fabsf(v[i].x), fabsf(v[i].y)), fmaxf(fabsf(v[i].z), fabsf(v[i].w))));
    }
#pragma unroll
    for (int o = 32; o > 0; o >>= 1) am = fmaxf(am, __shfl_xor(am, o));
    const float sc = am > 0.f ? 448.f / am : 1.f;
    u32x4 o4;
#pragma unroll
    for (int i = 0; i < 4; ++i) {
      int wd = 0;
      wd = __builtin_amdgcn_cvt_pk_fp8_f32(v[i].x * sc, v[i].y * sc, wd, false);
      wd = __builtin_amdgcn_cvt_pk_fp8_f32(v[i].z * sc, v[i].w * sc, wd, true);
      o4[i] = (unsigned)wd;
    }
    *(u32x4*)(dst + ((size_t)(lane >> 3) * 16384 + r) * 128 + (lane & 7) * 16) = o4;
    if (lane == 0) inv[r] = am > 0.f ? am * (1.f / 448.f) : 1.f;
  }
}
DI void phase10(const Params& p, char* smem) {
  rows_norm_mod(p, p.norm_ffn, 3072, 4096, true, (bf16_t*)(p.ws + OFF_H2));
}
DI void phase11(const Params& p, char* smem) {
  char* ws = p.ws;
  const bf16_t* h2 = (const bf16_t*)(ws + OFF_H2);
  const bf16_t* wct = (const bf16_t*)(ws + OFF_WCT);
  bf16_t* sc = (bf16_t*)(ws + OFF_SCORES);
  for (int it = 0;; ++it) {
    int ft, tt;
    if (!tile_map(it, 16, 160, 2, ft, tt)) break;
    f32x4 acc[4][4];
    acc_zero(acc);
    gemm_kloop<0>(acc, wct + (size_t)ft * 128 * 1024, 1024, h2 + (size_t)tt * 128 * 1024, 1024, 1024, smem, 0.f, 0.f);
    epilogue(acc, [&](int m, int n, float (&v)[16]) { st_bf16x16(sc + (size_t)(tt * 128 + n) * 2048 + ft * 128 + m, v); });
  }
}

DI unsigned okey(float f) {
  unsigned u = __float_as_uint(f);
  return (u & 0x80000000u) ? ~u : (u | 0x80000000u);
}
DI void wave_lds_sync() {
  __builtin_amdgcn_fence(__ATOMIC_ACQ_REL, "workgroup");
  __builtin_amdgcn_wave_barrier();
}
DI unsigned okey16(unsigned b) { return (b & 0x8000u) ? (~b & 0xFFFFu) : (b | 0x8000u); }
DI unsigned inv_okey16(unsigned k) { return (k & 0x8000u) ? (k & 0x7FFFu) : (~k & 0xFFFFu); }
DI unsigned inv_okey(unsigned k) { return (k & 0x80000000u) ? (k & 0x7FFFFFFFu) : ~k; }
DI void ins16(unsigned (&L)[16], unsigned x) {
#pragma unroll
  for (int i = 0; i < 16; ++i) {
    unsigned t = max(L[i], x);
    x = min(L[i], x);
    L[i] = t;
  }
}
DI void ce_desc(unsigned& a, unsigned& b) {
  const unsigned t = max(a, b);
  b = min(a, b);
  a = t;
}
DI void sort16_desc(unsigned (&a)[16]) {
#pragma unroll
  for (int ks = 1; ks <= 4; ++ks) {
#pragma unroll
    for (int js = ks - 1; js >= 0; --js) {
#pragma unroll
      for (int i = 0; i < 16; ++i) {
        const int k = 1 << ks, j = 1 << js, l = i ^ j;
        if (l > i) {
          if ((i & k) == 0) ce_desc(a[i], a[l]);
          else ce_desc(a[l], a[i]);
        }
      }
    }
  }
}
DI void merge_top16(unsigned (&L)[16], const unsigned (&G)[16]) {
#pragma unroll
  for (int i = 0; i < 16; ++i) L[i] = max(L[i], G[15 - i]);
#pragma unroll
  for (int js = 3; js >= 0; --js) {
#pragma unroll
    for (int i = 0; i < 16; ++i) {
      const int j = 1 << js, l = i ^ j;
      if (l > i) ce_desc(L[i], L[l]);
    }
  }
}
DI unsigned byte16(const unsigned (&d)[4], int i) {
  unsigned r = 0u;
#pragma unroll
  for (int q = 0; q < 4; ++q) r |= d[q] & (0u - (unsigned)((i >> 2) == q));
  return (r >> ((i & 3) * 8)) & 0xFFu;
}
DI unsigned sel16(const unsigned (&A)[16], int i) {
  unsigned r = 0u;
#pragma unroll
  for (int t = 0; t < 16; ++t) r |= A[t] & (0u - (unsigned)(i == t));
  return r;
}
DI void phase12(const Params& p, char* smem) {
  char* ws = p.ws;
  const bf16_t* sc = (const bf16_t*)(ws + OFF_SCORES);
  int* elist = (int*)(ws + OFF_ELIST);
  float* glist = (float*)(ws + OFF_GLIST);
  const int lane = threadIdx.x & 63, w = threadIdx.x >> 6;
  for (int batch = blockIdx.x * 4 + w; batch < NTOK / 4; batch += gridDim.x * 4) {
    const int tok = batch * 4 + (lane >> 4), hh = lane & 15;
    const bf16_t* row = sc + (size_t)tok * 2048 + hh * 128;
    unsigned L[16];
#pragma unroll
    for (int grp8 = 0; grp8 < 8; ++grp8) {
      unsigned G[16];
#pragma unroll
      for (int cc = 0; cc < 2; ++cc) {
        const int c = grp8 * 2 + cc;
        u32x4 u = *(const u32x4*)(row + c * 8);
#pragma unroll
        for (int i = 0; i < 4; ++i) {
          unsigned b0 = u[i] & 0xFFFFu, b1 = u[i] >> 16;
          G[cc * 8 + 2 * i] = (okey16(b0) << 16) | (unsigned)(127 - (c * 8 + 2 * i));
          G[cc * 8 + 2 * i + 1] = (okey16(b1) << 16) | (unsigned)(127 - (c * 8 + 2 * i + 1));
        }
      }
      sort16_desc(G);
      if (grp8 == 0) {
#pragma unroll
        for (int i = 0; i < 16; ++i) L[i] = G[i];
      } else {
        merge_top16(L, G);
      }
    }
    unsigned M[16];
#pragma unroll
    for (int i = 0; i < 16; ++i) M[i] = (unsigned)__shfl_xor((int)L[i], 1);
    float v1[16], v2[16];
#pragma unroll
    for (int i = 0; i < 16; ++i) {
      v1[i] = bf2f(inv_okey16(L[i] >> 16));
      v2[i] = bf2f(inv_okey16(M[i] >> 16));
    }
    unsigned C[16];
#pragma unroll
    for (int i = 0; i < 16; ++i) C[i] = 0u;
    ins16(C, (okey(v1[0] + v2[0]) & 0xFFFFFF00u) | 255u);
    ins16(C, (okey(v1[0] + v2[1]) & 0xFFFFFF00u) | 254u);
    ins16(C, (okey(v1[0] + v2[2]) & 0xFFFFFF00u) | 253u);
    ins16(C, (okey(v1[0] + v2[3]) & 0xFFFFFF00u) | 252u);
    ins16(C, (okey(v1[0] + v2[4]) & 0xFFFFFF00u) | 251u);
    ins16(C, (okey(v1[0] + v2[5]) & 0xFFFFFF00u) | 250u);
    ins16(C, (okey(v1[0] + v2[6]) & 0xFFFFFF00u) | 249u);
    ins16(C, (okey(v1[0] + v2[7]) & 0xFFFFFF00u) | 248u);
    ins16(C, (okey(v1[0] + v2[8]) & 0xFFFFFF00u) | 247u);
    ins16(C, (okey(v1[0] + v2[9]) & 0xFFFFFF00u) | 246u);
    ins16(C, (okey(v1[0] + v2[10]) & 0xFFFFFF00u) | 245u);
    ins16(C, (okey(v1[0] + v2[11]) & 0xFFFFFF00u) | 244u);
    ins16(C, (okey(v1[0] + v2[12]) & 0xFFFFFF00u) | 243u);
    ins16(C, (okey(v1[0] + v2[13]) & 0xFFFFFF00u) | 242u);
    ins16(C, (okey(v1[0] + v2[14]) & 0xFFFFFF00u) | 241u);
    ins16(C, (okey(v1[0] + v2[15]) & 0xFFFFFF00u) | 240u);
    ins16(C, (okey(v1[1] + v2[0]) & 0xFFFFFF00u) | 239u);
    ins16(C, (okey(v1[1] + v2[1]) & 0xFFFFFF00u) | 238u);
    ins16(C, (okey(v1[1] + v2[2]) & 0xFFFFFF00u) | 237u);
    ins16(C, (okey(v1[1] + v2[3]) & 0xFFFFFF00u) | 236u);
    ins16(C, (okey(v1[1] + v2[4]) & 0xFFFFFF00u) | 235u);
    ins16(C, (okey(v1[1] + v2[5]) & 0xFFFFFF00u) | 234u);
    ins16(C, (okey(v1[1] + v2[6]) & 0xFFFFFF00u) | 233u);
    ins16(C, (okey(v1[1] + v2[7]) & 0xFFFFFF00u) | 232u);
    ins16(C, (okey(v1[2] + v2[0]) & 0xFFFFFF00u) | 223u);
    ins16(C, (okey(v1[2] + v2[1]) & 0xFFFFFF00u) | 222u);
    ins16(C, (okey(v1[2] + v2[2]) & 0xFFFFFF00u) | 221u);
    ins16(C, (okey(v1[2] + v2[3]) & 0xFFFFFF00u) | 220u);
    ins16(C, (okey(v1[2] + v2[4]) & 0xFFFFFF00u) | 219u);
    ins16(C, (okey(v1[3] + v2[0]) & 0xFFFFFF00u) | 207u);
    ins16(C, (okey(v1[3] + v2[1]) & 0xFFFFFF00u) | 206u);
    ins16(C, (okey(v1[3] + v2[2]) & 0xFFFFFF00u) | 205u);
    ins16(C, (okey(v1[3] + v2[3]) & 0xFFFFFF00u) | 204u);
    ins16(C, (okey(v1[4] + v2[0]) & 0xFFFFFF00u) | 191u);
    ins16(C, (okey(v1[4] + v2[1]) & 0xFFFFFF00u) | 190u);
    ins16(C, (okey(v1[4] + v2[2]) & 0xFFFFFF00u) | 189u);
    ins16(C, (okey(v1[5] + v2[0]) & 0xFFFFFF00u) | 175u);
    ins16(C, (okey(v1[5] + v2[1]) & 0xFFFFFF00u) | 174u);
    ins16(C, (okey(v1[6] + v2[0]) & 0xFFFFFF00u) | 159u);
    ins16(C, (okey(v1[6] + v2[1]) & 0xFFFFFF00u) | 158u);
    ins16(C, (okey(v1[7] + v2[0]) & 0xFFFFFF00u) | 143u);
    ins16(C, (okey(v1[7] + v2[1]) & 0xFFFFFF00u) | 142u);
    ins16(C, (okey(v1[8] + v2[0]) & 0xFFFFFF00u) | 127u);
    ins16(C, (okey(v1[9] + v2[0]) & 0xFFFFFF00u) | 111u);
    ins16(C, (okey(v1[10] + v2[0]) & 0xFFFFFF00u) | 95u);
    ins16(C, (okey(v1[11] + v2[0]) & 0xFFFFFF00u) | 79u);
    ins16(C, (okey(v1[12] + v2[0]) & 0xFFFFFF00u) | 63u);
    ins16(C, (okey(v1[13] + v2[0]) & 0xFFFFFF00u) | 47u);
    ins16(C, (okey(v1[14] + v2[0]) & 0xFFFFFF00u) | 31u);
    ins16(C, (okey(v1[15] + v2[0]) & 0xFFFFFF00u) | 15u);
    unsigned ib1[4], ib2[4];
#pragma unroll
    for (int q = 0; q < 4; ++q) {
      ib1[q] = (L[4 * q] & 0xFFu) | ((L[4 * q + 1] & 0xFFu) << 8) | ((L[4 * q + 2] & 0xFFu) << 16) | ((L[4 * q + 3] & 0xFFu) << 24);
      ib2[q] = (M[4 * q] & 0xFFu) | ((M[4 * q + 1] & 0xFFu) << 8) | ((M[4 * q + 2] & 0xFFu) << 16) | ((M[4 * q + 3] & 0xFFu) << 24);
    }
    int ev[16];
    float gv[16];
    const float mx = __uint_as_float(inv_okey(C[0] & 0xFFFFFF00u));
    float den = 0.f;
#pragma unroll
    for (int k = 0; k < 16; ++k) {
      const int ci = 255 - (int)(C[k] & 0xFFu);
      ev[k] = (127 - (int)byte16(ib1, ci >> 4)) * 128 + (127 - (int)byte16(ib2, ci & 15));
      gv[k] = __expf(__uint_as_float(inv_okey(C[k] & 0xFFFFFF00u)) - mx);
      den += gv[k];
    }
    const float inv = 1.f / den;
    if ((lane & 1) == 0) {
      int* ep = elist + (size_t)tok * 128 + (hh >> 1) * 16;
      float* gp = glist + (size_t)tok * 128 + (hh >> 1) * 16;
#pragma unroll
      for (int k = 0; k < 4; ++k) {
        *(int4*)(ep + 4 * k) = make_int4(ev[4 * k], ev[4 * k + 1], ev[4 * k + 2], ev[4 * k + 3]);
        *(float4*)(gp + 4 * k) = make_float4(gv[4 * k] * inv, gv[4 * k + 1] * inv, gv[4 * k + 2] * inv, gv[4 * k + 3] * inv);
      }
    }
  }
}
using f32x2 = __attribute__((ext_vector_type(2))) float;
DI f32x2 cvt8(unsigned w, bool hi) {
  return hi ? __builtin_amdgcn_cvt_pk_f32_fp8((int)w, true) : __builtin_amdgcn_cvt_pk_f32_fp8((int)w, false);
}
struct SMeta { int e[16]; u32x4 ha, hb; };
template <int MODE>
DI void sl_meta(const Params& p, int t, int s, int grp, int ch, SMeta& m) {
  const int* elist = (const int*)(p.ws + (MODE == 0 ? OFF_ELIST : OFF_GLIST));
#pragma unroll
  for (int i = 0; i < 16; ++i) m.e[i] = elist[(size_t)t * 128 + i * 8 + grp];
  if (MODE == 0) {
    const bf16_t* hq = (const bf16_t*)(p.ws + OFF_H2) + (size_t)t * DM + s * 128 + ch * 16;
    m.ha = *(const u32x4*)hq;
    m.hb = *(const u32x4*)(hq + 8);
  }
}
template <int MODE>
DI void sl_rows(const Params& p, int s, int ch, const SMeta& m, u32x4 (&r)[16]) {
  const unsigned char* tab = (const unsigned char*)(p.ws + (MODE == 0 ? OFF_TABU : OFF_TABV));
#pragma unroll
  for (int i = 0; i < 16; ++i) r[i] = *(const u32x4*)(tab + ((size_t)s * 16384 + (m.e[i] & 0xFFFF)) * 128 + ch * 16);
}
template <int MODE>
DI void sl_compute(const Params& p, int t, int s, int lane, const SMeta& m, const u32x4 (&r)[16]) {
  const int grp = lane >> 3, ch = lane & 7;
  if (MODE == 0) {
    f32x2 hp[8];
#pragma unroll
    for (int i = 0; i < 4; ++i) {
      hp[i] = f32x2{bflo(m.ha[i]), bfhi(m.ha[i])};
      hp[4 + i] = f32x2{bflo(m.hb[i]), bfhi(m.hb[i])};
    }
    float keep0 = 0.f, keep1 = 0.f;
#pragma unroll
    for (int i = 0; i < 16; ++i) {
      f32x2 d2 = f32x2{0.f, 0.f};
#pragma unroll
      for (int j = 0; j < 4; ++j) {
        d2 += cvt8(r[i][j], false) * hp[2 * j];
        d2 += cvt8(r[i][j], true) * hp[2 * j + 1];
      }
      float d = d2[0] + d2[1];
      d += __shfl_xor(d, 1);
      d += __shfl_xor(d, 2);
      d += __shfl_xor(d, 4);
      if (i < 8) keep0 = (ch == i) ? d : keep0;
      else keep1 = (ch == i - 8) ? d : keep1;
    }
    float* po = (float*)(p.ws + OFF_PD) + (size_t)t * 1024 + s * 128;
    po[ch * 8 + grp] = keep0;
    po[(ch + 8) * 8 + grp] = keep1;
  } else {
    f32x2 acc[8];
#pragma unroll
    for (int q = 0; q < 8; ++q) acc[q] = f32x2{0.f, 0.f};
#pragma unroll
    for (int i = 0; i < 16; ++i) {
      const float wsc = __uint_as_float((unsigned)m.e[i] & 0xFFFF0000u);
      const f32x2 w2 = f32x2{wsc, wsc};
#pragma unroll
      for (int j = 0; j < 4; ++j) {
        acc[2 * j] += w2 * cvt8(r[i][j], false);
        acc[2 * j + 1] += w2 * cvt8(r[i][j], true);
      }
    }
    float v[16];
#pragma unroll
    for (int q = 0; q < 8; ++q) { v[2 * q] = acc[q][0]; v[2 * q + 1] = acc[q][1]; }
    float q8[8], q4[4], q2[2];
    {
      const bool hi = lane & 32;
#pragma unroll
      for (int i = 0; i < 8; ++i) {
        float send = hi ? v[i] : v[8 + i], keep = hi ? v[8 + i] : v[i];
        q8[i] = keep + __shfl_xor(send, 32);
      }
    }
    {
      const bool hi = lane & 16;
#pragma unroll
      for (int i = 0; i < 4; ++i) {
        float send = hi ? q8[i] : q8[4 + i], keep = hi ? q8[4 + i] : q8[i];
        q4[i] = keep + __shfl_xor(send, 16);
      }
    }
    {
      const bool hi = lane & 8;
#pragma unroll
      for (int i = 0; i < 2; ++i) {
        float send = hi ? q4[i] : q4[2 + i], keep = hi ? q4[2 + i] : q4[i];
        q2[i] = keep + __shfl_xor(send, 8);
      }
    }
    const int f = s * 128 + ch * 16 + 2 * grp;
    float* xr = p.out + (size_t)t * DM + f;
    const float2 xv = *(const float2*)xr;
    const float2 gv = *(const float2*)((const float*)(p.ws + OFF_MOD) + modidx(t) * 6144 + 5120 + f);
    *(float2*)xr = make_float2(xv.x + gv.x * q2[0], xv.y + gv.y * q2[1]);
  }
}
template <int MODE>
DI void sliced_pass(const Params& p) {
  const int s = blockIdx.x & 7, loc = blockIdx.x >> 3, nloc = gridDim.x >> 3;
  if (loc >= nloc) return;
  const int lane = threadIdx.x & 63, w = threadIdx.x >> 6, grp = lane >> 3, ch = lane & 7;
  const int stride = nloc * 4;
  SMeta mA, mB;
  u32x4 rA[16], rB[16];
  int t = loc * 4 + w;
  if (t < NTOK) {
    sl_meta<MODE>(p, t, s, grp, ch, mA);
    sl_rows<MODE>(p, s, ch, mA, rA);
  }
  if (t + stride < NTOK) sl_meta<MODE>(p, t + stride, s, grp, ch, mB);
#pragma unroll 1
  for (; t < NTOK; t += 2 * stride) {
    const int t1 = t + stride, t2 = t + 2 * stride, t3 = t + 3 * stride;
    if (t1 < NTOK) sl_rows<MODE>(p, s, ch, mB, rB);
    sl_compute<MODE>(p, t, s, lane, mA, rA);
    if (t2 < NTOK) sl_meta<MODE>(p, t2, s, grp, ch, mA);
    if (t1 < NTOK) {
      if (t2 < NTOK) sl_rows<MODE>(p, s, ch, mA, rA);
      sl_compute<MODE>(p, t1, s, lane, mB, rB);
      if (t3 < NTOK) sl_meta<MODE>(p, t3, s, grp, ch, mB);
    }
  }
}
DI void phase13(const Params& p) { sliced_pass<0>(p); }
DI void phase14(const Params& p) {
  char* ws = p.ws;
  const float* invU = (const float*)(ws + OFF_INVU);
  const float* invV = (const float*)(ws + OFF_INVV);
  const int* elist = (const int*)(ws + OFF_ELIST);
  float* glist = (float*)(ws + OFF_GLIST);
  const float* pd = (const float*)(ws + OFF_PD);
  const int lane = threadIdx.x & 63, w = threadIdx.x >> 6;
  for (int t = blockIdx.x * 4 + w; t < NTOK; t += gridDim.x * 4) {
#pragma unroll
    for (int hf_ = 0; hf_ < 2; ++hf_) {
      const int k = hf_ * 64 + lane;
      float d = 0.f;
#pragma unroll
      for (int s = 0; s < 8; ++s) d += pd[(size_t)t * 1024 + s * 128 + k];
      const int e = elist[(size_t)t * 128 + k];
      const float g = glist[(size_t)t * 128 + k];
      ((unsigned*)glist)[(size_t)t * 128 + k] = (pack2(0.f, g * geluf_(d * invU[e]) * invV[e]) & 0xFFFF0000u) | (unsigned)e;
    }
  }
}
DI void phase15(const Params& p) { sliced_pass<1>(p); }
DI void phase16(const Params& p) {
  const int lane = threadIdx.x & 63, w = threadIdx.x >> 6;
  for (int tok = blockIdx.x * 4 + w; tok < NTOK; tok += gridDim.x * 4) {
    float* xr = p.out + (size_t)tok * DM;
    float4 xv[4];
    float ss = 0.f;
#pragma unroll
    for (int i = 0; i < 4; ++i) {
      xv[i] = *(const float4*)(xr + (i * 64 + lane) * 4);
      ss += xv[i].x * xv[i].x + xv[i].y * xv[i].y + xv[i].z * xv[i].z + xv[i].w * xv[i].w;
    }
    ss = wsum(ss);
    const float rstd = rsqrtf(ss * (1.f / 1024.f) + 1e-6f);
#pragma unroll
    for (int i = 0; i < 4; ++i) {
      const int e = (i * 64 + lane) * 4;
      float4 nf = *(const float4*)(p.norm_final + e);
      *(float4*)(xr + e) = make_float4(xv[i].x * rstd * nf.x, xv[i].y * rstd * nf.y, xv[i].z * rstd * nf.z, xv[i].w * rstd * nf.w);
    }
  }
}

#define XB_TMO      128
#define XB_XCNT(j)  (256  + 64 * (j))
#define XB_XSUB(j)  (1280 + 64 * (j))
#define XB_XGEN(j)  (2304 + 64 * (j))
#define XB_TOP      3328
#define XB_TOPGEN   3392
#define XCD_BAR_WORDS 3456
#define XB_SPIN_CAP (1u << 22)
#define LAS __attribute__((address_space(3)))
DI unsigned xb_ld(unsigned* p) { return __hip_atomic_load(p, __ATOMIC_RELAXED, __HIP_MEMORY_SCOPE_AGENT); }
DI unsigned xb_add(unsigned* p, unsigned v) { return __hip_atomic_fetch_add(p, v, __ATOMIC_RELAXED, __HIP_MEMORY_SCOPE_AGENT); }
DI unsigned xb_xcc_id() { return (unsigned)__builtin_amdgcn_s_getreg((3 << 11) | 20) & 0xFu; }
#define XB_SPIN(cond, bar) do { unsigned _sp = 0; while (cond) { __builtin_amdgcn_s_sleep(1); \
    if ((++_sp & 255u) == 0u) { if (xb_ld(&(bar)[XB_TMO])) break; if (_sp > XB_SPIN_CAP) { atomicAdd(&(bar)[XB_TMO], 1u); break; } } } } while (0)
struct XcdBarrier { unsigned* bar; unsigned x; volatile LAS unsigned* st; };
DI XcdBarrier xcd_barrier_post(unsigned* bar, volatile LAS unsigned* st) {
  XcdBarrier b; b.bar = bar; b.x = xb_xcc_id(); b.st = st;
  if (threadIdx.x == 0) (void)xb_add(&bar[XB_XCNT(b.x)], 1u);
  return b;
}
DI void xcd_barrier_complete(unsigned* bar, unsigned x, unsigned& nloc, unsigned& nx) {
  const unsigned G = gridDim.x * gridDim.y * gridDim.z;
  unsigned sum, cnt, mine, sp = 0u;
  for (;;) {
    sum = 0u; cnt = 0u; mine = 0u;
#pragma unroll
    for (unsigned j = 0; j < 16; ++j) { const unsigned c = xb_ld(&bar[XB_XCNT(j)]); sum += c; cnt += (c > 0u) ? 1u : 0u; mine = (j == x) ? c : mine; }
    if (sum == G) break;
    __builtin_amdgcn_s_sleep(1);
    if ((++sp & 255u) == 0u) { if (xb_ld(&bar[XB_TMO])) break; if (sp > XB_SPIN_CAP) { atomicAdd(&bar[XB_TMO], 1u); break; } }
  }
  nloc = mine > 0u ? mine : 1u; nx = cnt > 0u ? cnt : 1u;
}
DI void xcd_barrier(const XcdBarrier& b) {
  asm volatile("s_waitcnt vmcnt(0)" ::: "memory");
  __syncthreads();
  if (threadIdx.x == 0) {
    unsigned* bar = b.bar;
    __builtin_amdgcn_s_waitcnt(0);
    unsigned nloc = b.st[0], nx = b.st[1];
    if (nloc == 0u) { xcd_barrier_complete(bar, b.x, nloc, nx); b.st[0] = nloc; b.st[1] = nx; }
    const unsigned old = xb_add(&bar[XB_XSUB(b.x)], 1u);
    const unsigned gen = old / nloc;
    if (old + 1u == (gen + 1u) * nloc) {
      __builtin_amdgcn_fence(__ATOMIC_RELEASE, "agent");
      asm volatile("s_waitcnt vmcnt(0)" ::: "memory");
      const unsigned og = xb_add(&bar[XB_TOP], 1u);
      const unsigned tg = og / nx;
      if (og + 1u == (tg + 1u) * nx) xb_add(&bar[XB_TOPGEN], 1u);
      else XB_SPIN(xb_ld(&bar[XB_TOPGEN]) == tg, bar);
      __builtin_amdgcn_fence(__ATOMIC_ACQUIRE, "agent");
      xb_add(&bar[XB_XGEN(b.x)], 1u);
      asm volatile("s_waitcnt vmcnt(0)" ::: "memory");
    } else {
      XB_SPIN(xb_ld(&bar[XB_XGEN(b.x)]) == gen, bar);
      __builtin_amdgcn_fence(__ATOMIC_ACQUIRE, "agent");
      asm volatile("s_waitcnt vmcnt(0)" ::: "memory");
    }
  }
  __syncthreads();
}

#ifdef ONLY_PHASE
#define RUNPH(n, call) if (ONLY_PHASE == n) { call; }
#else
#ifndef DUP_PHASE
#define DUP_PHASE -1
#endif
#define RUNPH(n, call) if (lo <= n && n < hi) { call; if (n == DUP_PHASE) { xcd_barrier(xb); call; } if (n + 1 < hi) xcd_barrier(xb); }
#endif
__global__ void __launch_bounds__(256, 2) mega(Params p, int lo, int hi) {
  __shared__ __attribute__((aligned(16))) char smem[SMEM_BYTES];
  __shared__ uint4 xb_words;
  cg::grid_group grid = cg::this_grid();
  if (lo < 0) grid.sync();
  if (threadIdx.x == 0) xb_words = make_uint4(0u, 0u, 0u, 0u);
  __syncthreads();
  XcdBarrier xb = xcd_barrier_post((unsigned*)(p.ws + OFF_BAR), (volatile LAS unsigned*)&xb_words);
  RUNPH(0, phase0(p, smem))
  RUNPH(1, phase1(p, smem))
  RUNPH(2, phase2(p, smem))
  RUNPH(3, phase3(p, smem))
  RUNPH(4, phase4(p))
  RUNPH(5, phase5(p, smem))
  RUNPH(6, phase6(p, smem))
  RUNPH(7, phase7(p, smem))
  RUNPH(8, phase8(p, smem))
  RUNPH(9, phase9(p, smem))
  RUNPH(10, phase10(p, smem))
  RUNPH(11, phase11(p, smem))
  RUNPH(12, phase12(p, smem))
  RUNPH(13, phase13(p))
  RUNPH(14, phase14(p))
  RUNPH(15, phase15(p))
  RUNPH(16, phase16(p))
}

extern "C" void kernel_launch(void* const* d_in, const int* in_sizes, int n_in, void* d_out, int out_size, void* d_ws,
                              size_t ws_size, hipStream_t stream) {
  static int grid_blocks = 0;
  if (!grid_blocks) {
    int dev = 0, cus = 0, per_cu = 0;
    hipGetDevice(&dev);
    hipDeviceGetAttribute(&cus, hipDeviceAttributeMultiprocessorCount, dev);
    hipOccupancyMaxActiveBlocksPerMultiprocessor(&per_cu, mega, 256, 0);
    if (per_cu > 2) per_cu = 2;
    if (per_cu < 1) per_cu = 1;
    grid_blocks = cus * per_cu;
  }
  Params p{};
  const float** pp = (const float**)&p;
  for (int i = 0; i < 29; ++i) pp[i] = (const float*)d_in[i];
  p.out = (float*)d_out;
  p.ws = (char*)d_ws;
#if N_LAUNCH_SPLIT
  for (int ph = 0; ph < NPHASE; ++ph) {
    hipLaunchKernelGGL(mega, dim3(grid_blocks), dim3(256), 0, stream, p, ph, ph + 1);
  }
#else
  hipMemsetAsync((char*)d_ws + OFF_MOD, 0, (OFF_BAR - OFF_MOD) + XCD_BAR_WORDS * sizeof(unsigned), stream);
  int lo = 0, hi = NPHASE;
  void* args[] = {&p, &lo, &hi};
  hipError_t e = hipLaunchCooperativeKernel((void*)mega, dim3(grid_blocks), dim3(256), args, 0, stream);
  if (e != hipSuccess) fprintf(stderr, "cooperative launch failed: %s (grid %d)\n", hipGetErrorString(e), grid_blocks);
#endif
}
```

```cpp
#include <hip/hip_runtime.h>
#include <hip/hip_cooperative_groups.h>
#include <cstdio>
namespace cg = cooperative_groups;

#define DI __device__ __forceinline__
typedef unsigned short bf16_t;
using bf16x8 = __attribute__((ext_vector_type(8))) short;
using f32x4 = __attribute__((ext_vector_type(4))) float;
using u32x4 = __attribute__((ext_vector_type(4))) unsigned;
using u32x2 = __attribute__((ext_vector_type(2))) unsigned;

#ifndef N_LAUNCH_SPLIT
#define N_LAUNCH_SPLIT 0
#endif

constexpr int NTOK = 20480, NPT = 4096, DM = 1024;
constexpr int NPHASE = 17;
constexpr size_t MiB = 1u << 20;
constexpr size_t OFF_WINT = 0, OFF_WUQT = 9 * MiB, OFF_WUKVT = 9 * MiB + 512 * 1024, OFF_WUPAT = 10 * MiB,
                 OFF_WUPBT = 11 * MiB, OFF_WOT = 12 * MiB, OFF_WCT = 14 * MiB, OFF_WPQB = 18 * MiB,
                 OFF_KEYSB = 22 * MiB, OFF_MOD = 22 * MiB + 512 * 1024, OFF_BAR = 22 * MiB + 768 * 1024, A0 = 24 * MiB;
constexpr size_t OFF_PD = A0 + 104 * MiB, OFF_H1 = A0 + 0, OFF_CQ = A0 + 40 * MiB, OFF_CKVRAW = A0 + 50 * MiB, OFF_KRRAW = A0 + 60 * MiB,
                 OFF_RQ = A0 + 63 * MiB, OFF_RK = A0 + 83 * MiB, OFF_KT = A0 + 103 * MiB, OFF_VT = A0 + 123 * MiB,
                 OFF_SRG = A0 + 143 * MiB, OFF_CKVALL = A0 + 163 * MiB, OFF_KRALL = A0 + 169 * MiB,
                 OFF_UF = A0 + 171 * MiB, OFF_UB = A0 + 187 * MiB,
                 OFF_SF = A0 + 0, OFF_SB = A0 + 8 * MiB, OFF_RET = A0 + 16 * MiB,
                 OFF_Q = A0 + 63 * MiB, OFF_KN = A0 + 93 * MiB, OFF_VTA = A0 + 117 * MiB, OFF_ATTN = A0 + 141 * MiB,
                 OFF_M = A0 + 163 * MiB,
                 OFF_H2 = A0 + 56 * MiB, OFF_TABU = A0 + 36 * MiB, OFF_TABV = A0 + 0, OFF_INVU = A0 + 52 * MiB,
                 OFF_INVV = A0 + 53 * MiB, OFF_ELIST = A0 + 16 * MiB, OFF_GLIST = A0 + 26 * MiB, OFF_SCORES = A0 + 104 * MiB;
constexpr size_t OUT_CKV = 20971520, OUT_KR = 21495808, OUT_SF = 21626880, OUT_SB = 22675456;
constexpr int NKV = 24576;
constexpr int SMEM_BYTES = 73728;

struct Params {
  const float *x_prompt, *x_sample, *c, *cache_ckv, *cache_krope, *st_f, *st_b, *c_ctx, *w_mod, *b_mod, *norm_mix,
      *norm_ffn, *norm_final, *w_in, *q_norm, *kv_norm, *w_uq, *w_ukv, *lg_f, *lg_b, *ret_gn, *w_up_a, *w_up_b, *w_o,
      *peer_wq, *keys1, *keys2, *peer_u, *peer_v;
  float* out;
  char* ws;
};

DI unsigned f2bf(float x) {
  unsigned u = __float_as_uint(x);
  u += 0x7fffu + ((u >> 16) & 1u);
  return u >> 16;
}
DI float bf2f(unsigned b) { return __uint_as_float(b << 16); }
typedef __bf16 hbf16x2_t __attribute__((ext_vector_type(2)));
typedef float hf32x2_t __attribute__((ext_vector_type(2)));
DI unsigned pack2(float a, float b) {
  hf32x2_t f = {a, b};
  return __builtin_bit_cast(unsigned, __builtin_convertvector(f, hbf16x2_t));
}
DI float ex2(float x) { return __builtin_amdgcn_exp2f(x); }
DI float bflo(unsigned u) { return __uint_as_float(u << 16); }
DI float bfhi(unsigned u) { return __uint_as_float(u & 0xffff0000u); }
DI float wsum(float v) {
#pragma unroll
  for (int o = 32; o > 0; o >>= 1) v += __shfl_xor(v, o);
  return v;
}
DI float sigmoidf_(float x) { return 1.f / (1.f + __expf(-x)); }
DI float siluf_(float x) { return x / (1.f + __expf(-x)); }
DI float geluf_(float x) { return 0.5f * x * (1.f + tanhf(0.7978845608028654f * (x + 0.044715f * x * x * x))); }
DI const float* xrow(const Params& p, int tok) {
  return tok < NPT ? p.x_prompt + (size_t)tok * DM : p.x_sample + (size_t)(tok - NPT) * DM;
}
DI int modidx(int tok) { return tok < NPT ? 0 : 1 + ((tok - NPT) >> 11); }
DI int kvrow(int tok) {
  if (tok < NPT) return tok;
  int t = tok - NPT;
  return NPT + (t >> 11) * 2560 + (t & 2047);
}
DI void st_bf16x16(bf16_t* dst, const float (&v)[16]) {
  u32x4 a, b;
  a[0] = pack2(v[0], v[1]); a[1] = pack2(v[2], v[3]); a[2] = pack2(v[4], v[5]); a[3] = pack2(v[6], v[7]);
  b[0] = pack2(v[8], v[9]); b[1] = pack2(v[10], v[11]); b[2] = pack2(v[12], v[13]); b[3] = pack2(v[14], v[15]);
  *(u32x4*)dst = a;
  *(u32x4*)(dst + 8) = b;
}
DI void st_f32x16(float* dst, const float (&v)[16]) {
#pragma unroll
  for (int i = 0; i < 4; ++i) *(float4*)(dst + 4 * i) = make_float4(v[4 * i], v[4 * i + 1], v[4 * i + 2], v[4 * i + 3]);
}
DI void ld_bf16x16(const bf16_t* src, float (&v)[16]) {
  u32x4 a = *(const u32x4*)src, b = *(const u32x4*)(src + 8);
#pragma unroll
  for (int i = 0; i < 4; ++i) {
    v[2 * i] = bflo(a[i]); v[2 * i + 1] = bfhi(a[i]);
    v[8 + 2 * i] = bflo(b[i]); v[8 + 2 * i + 1] = bfhi(b[i]);
  }
}

constexpr int LDK = 64;
template <int SCALE>
DI void gemm_kloop(f32x4 (&acc)[4][4], const bf16_t* __restrict__ A, int lda, const bf16_t* __restrict__ B, int ldb,
                   int K, char* smem, float sc_a, float sc_b) {
  bf16_t* As = (bf16_t*)smem;
  bf16_t* Bs = As + 128 * LDK;
  const int tid = threadIdx.x, lane = tid & 63, w = tid >> 6, wm = w >> 1, wn = w & 1, l15 = lane & 15, g = lane >> 4;
  u32x4 ra[4], rb[4];
  int arow[4], kc[4], ldsa[4], ldsb[4];
#pragma unroll
  for (int i = 0; i < 4; ++i) {
    int c = tid + 256 * i;
    int r = c >> 3;
    kc[i] = (c & 7) * 8;
    arow[i] = r;
    int rr = r & 63;
    int rho = (r & 64) | (((rr >> 2) & 3) << 4) | ((rr >> 4) << 2) | (rr & 3);
    ldsa[i] = rho * LDK + (((c & 7) ^ ((rho >> 1) & 7)) * 8);
    ldsb[i] = r * LDK + (((c & 7) ^ ((r >> 1) & 7)) * 8);
  }
#pragma unroll
  for (int i = 0; i < 4; ++i) {
    ra[i] = *(const u32x4*)(A + (size_t)arow[i] * lda + kc[i]);
    rb[i] = *(const u32x4*)(B + (size_t)arow[i] * ldb + kc[i]);
  }
  __syncthreads();
#pragma unroll
  for (int i = 0; i < 4; ++i) {
    *(u32x4*)(As + ldsa[i]) = ra[i];
    *(u32x4*)(Bs + ldsb[i]) = rb[i];
  }
  if (64 < K) {
#pragma unroll
    for (int i = 0; i < 4; ++i) {
      ra[i] = *(const u32x4*)(A + (size_t)arow[i] * lda + 64 + kc[i]);
      rb[i] = *(const u32x4*)(B + (size_t)arow[i] * ldb + 64 + kc[i]);
    }
  }
  __syncthreads();
  int buf = 0;
  for (int k0 = 0; k0 < K; k0 += 64, buf ^= 1) {
    const bf16_t* Ac = As + buf * (256 * LDK);
    const bf16_t* Bc = Bs + buf * (256 * LDK);
#pragma unroll
    for (int ks = 0; ks < 2; ++ks) {
      bf16x8 af[4], bfr[4];
#pragma unroll
      for (int f = 0; f < 4; ++f)
        af[f] = *(const bf16x8*)(Ac + (wm * 64 + f * 16 + l15) * LDK + (((ks * 4 + g) ^ (l15 >> 1)) * 8));
#pragma unroll
      for (int c = 0; c < 4; ++c)
        bfr[c] = *(const bf16x8*)(Bc + (wn * 64 + c * 16 + l15) * LDK + (((ks * 4 + g) ^ (l15 >> 1)) * 8));
      if (SCALE) {
        float fac[8];
#pragma unroll
        for (int i = 0; i < 8; ++i) fac[i] = ex2(sc_a + sc_b * (float)(k0 + ks * 32 + g * 8 + i));
#pragma unroll
        for (int f = 0; f < 4; ++f) {
          u32x4 u = __builtin_bit_cast(u32x4, af[f]);
#pragma unroll
          for (int i = 0; i < 4; ++i) u[i] = pack2(bflo(u[i]) * fac[2 * i], bfhi(u[i]) * fac[2 * i + 1]);
          af[f] = __builtin_bit_cast(bf16x8, u);
        }
      }
#pragma unroll
      for (int f = 0; f < 4; ++f)
#pragma unroll
        for (int c = 0; c < 4; ++c) acc[f][c] = __builtin_amdgcn_mfma_f32_16x16x32_bf16(af[f], bfr[c], acc[f][c], 0, 0, 0);
    }
    if (k0 + 64 < K) {
      bf16_t* An = As + (buf ^ 1) * (256 * LDK);
      bf16_t* Bn = Bs + (buf ^ 1) * (256 * LDK);
#pragma unroll
      for (int i = 0; i < 4; ++i) {
        *(u32x4*)(An + ldsa[i]) = ra[i];
        *(u32x4*)(Bn + ldsb[i]) = rb[i];
      }
      if (k0 + 128 < K) {
#pragma unroll
        for (int i = 0; i < 4; ++i) {
          ra[i] = *(const u32x4*)(A + (size_t)arow[i] * lda + k0 + 128 + kc[i]);
          rb[i] = *(const u32x4*)(B + (size_t)arow[i] * ldb + k0 + 128 + kc[i]);
        }
      }
      __syncthreads();
    }
  }
}
DI void acc_zero(f32x4 (&acc)[4][4]) {
#pragma unroll
  for (int f = 0; f < 4; ++f)
#pragma unroll
    for (int c = 0; c < 4; ++c) acc[f][c] = f32x4{0.f, 0.f, 0.f, 0.f};
}
template <class F>
DI void epilogue(const f32x4 (&acc)[4][4], F&& epi) {
  const int tid = threadIdx.x, lane = tid & 63, w = tid >> 6, wm = w >> 1, wn = w & 1, l15 = lane & 15, g = lane >> 4;
#pragma unroll
  for (int c = 0; c < 4; ++c) {
    float v[16];
#pragma unroll
    for (int f = 0; f < 4; ++f)
#pragma unroll
      for (int j = 0; j < 4; ++j) v[f * 4 + j] = acc[f][c][j];
    epi(wm * 64 + 16 * g, wn * 64 + c * 16 + l15, v);
  }
}
DI bool tile_map(int it, int Ft, int Tt, int fsplit, int& ft, int& tt) {
  const int bid = blockIdx.x, nb = gridDim.x;
  int xcd = bid & 7, loc = bid >> 3, nloc = nb >> 3;
  if (loc >= nloc) return false;
  int fg = xcd % fsplit, tg = xcd / fsplit, tsplit = 8 / fsplit;
  int Fg = Ft / fsplit, Tg = Tt / tsplit;
  int i = loc + it * nloc;
  if (i >= Fg * Tg) return false;
  ft = fg * Fg + i % Fg;
  tt = tg * Tg + i / Fg;
  return true;
}
DI int vbid() {
  const int bid = blockIdx.x, nb = gridDim.x;
  if (nb & 7) return bid;
  return (bid & 7) * (nb >> 3) + (bid >> 3);
}

DI int colmap(int mode, int np) {
  if (mode == 1) return np < 416 ? np : (np < 512 ? -1 : np - 96);
  if (mode == 2) return np < 512 ? ((np >> 6) * 128 + (np & 63)) : (((np - 512) >> 6) * 128 + 64 + ((np - 512) & 63));
  return np;
}
DI void tconv_tile(const float* __restrict__ src, int ldsrc, bf16_t* __restrict__ dst, int K, int kt, int nt, int mode,
                   char* smem) {
  float* lds = (float*)smem;
  const int tid = threadIdx.x;
  {
    int col = tid & 63, rq = tid >> 6;
    int n = colmap(mode, nt * 64 + col);
#pragma unroll 4
    for (int r = 0; r < 16; ++r) {
      int kl = r * 4 + rq;
      float v = n >= 0 ? src[(size_t)(kt * 64 + kl) * ldsrc + n] : 0.f;
      lds[kl * 65 + col] = v;
    }
  }
  __syncthreads();
  {
    int nl = tid >> 2, kq = (tid & 3) * 16;
    float v[16];
#pragma unroll
    for (int i = 0; i < 16; ++i) v[i] = lds[(kq + i) * 65 + nl];
    st_bf16x16(dst + (size_t)(nt * 64 + nl) * K + kt * 64 + kq, v);
  }
  __syncthreads();
}
DI void mod_item(const Params& p, int item, char* smem) {
  float* sil = (float*)smem;
  const int tid = threadIdx.x;
  const int cg_ = item >> 2, slab = item & 3, kbase = slab * 256;
  for (int i = tid; i < 9 * 256; i += 256) {
    int j = i >> 8, k = kbase + (i & 255);
    float cv = j == 0 ? p.c_ctx[k] : p.c[(j - 1) * 1024 + k];
    sil[i] = siluf_(cv);
  }
  __syncthreads();
  const int kq = tid >> 6, nn = tid & 63, n0 = cg_ * 64;
  float acc[9];
#pragma unroll
  for (int j = 0; j < 9; ++j) acc[j] = 0.f;
#pragma unroll 1
  for (int i0 = 0; i0 < 64; i0 += 16) {
    float wv[16];
#pragma unroll
    for (int i = 0; i < 16; ++i) wv[i] = p.w_mod[(size_t)(kbase + kq + 4 * (i0 + i)) * 6144 + n0 + nn];
#pragma unroll
    for (int i = 0; i < 16; ++i)
#pragma unroll
      for (int j = 0; j < 9; ++j) acc[j] += sil[j * 256 + kq + 4 * (i0 + i)] * wv[i];
  }
  __syncthreads();
  float* part = (float*)smem + 9 * 256;
#pragma unroll
  for (int j = 0; j < 9; ++j) part[(kq * 9 + j) * 64 + nn] = acc[j];
  __syncthreads();
  float* mod = (float*)(p.ws + OFF_MOD);
  for (int i = tid; i < 9 * 64; i += 256) {
    int j = i >> 6, n = i & 63;
    float s = part[(0 * 9 + j) * 64 + n] + part[(1 * 9 + j) * 64 + n] + part[(2 * 9 + j) * 64 + n] + part[(3 * 9 + j) * 64 + n];
    if (slab == 0) s += p.b_mod[n0 + n];
    atomicAdd(mod + j * 6144 + n0 + n, s);
  }
  __syncthreads();
}
DI void conv_flat(const float* __restrict__ src, bf16_t* __restrict__ dst, size_t n) {
  size_t i = ((size_t)blockIdx.x * 256 + threadIdx.x) * 8;
  const size_t stride = (size_t)gridDim.x * 256 * 8;
  for (; i < n; i += stride) {
    float4 a = *(const float4*)(src + i), b = *(const float4*)(src + i + 4);
    u32x4 o;
    o[0] = pack2(a.x, a.y); o[1] = pack2(a.z, a.w); o[2] = pack2(b.x, b.y); o[3] = pack2(b.z, b.w);
    *(u32x4*)(dst + i) = o;
  }
}
DI void phase0(const Params& p, char* smem) {
  const int bid = blockIdx.x, nb = gridDim.x;
  char* ws = p.ws;
  const int n_mod = 384;
  const int t_in = 16 * 72, t_uq = 4 * 12, t_ukv = 2 * 16, t_upa = 8 * 16, t_upb = 8 * 16, t_o = 16 * 16;
  const int total = n_mod + t_in + t_uq + t_ukv + t_upa + t_upb + t_o;
  for (int it = bid; it < total; it += nb) {
    int i = it;
    if (i < n_mod) { mod_item(p, i, smem); continue; }
    i -= n_mod;
    if (i < t_in) { tconv_tile(p.w_in, 4512, (bf16_t*)(ws + OFF_WINT), 1024, i / 72, i % 72, 1, smem); continue; }
    i -= t_in;
    if (i < t_uq) { tconv_tile(p.w_uq, 768, (bf16_t*)(ws + OFF_WUQT), 256, i / 12, i % 12, 0, smem); continue; }
    i -= t_uq;
    if (i < t_ukv) { tconv_tile(p.w_ukv, 1024, (bf16_t*)(ws + OFF_WUKVT), 128, i / 16, i % 16, 2, smem); continue; }
    i -= t_ukv;
    if (i < t_upa) { tconv_tile(p.w_up_a, 1024, (bf16_t*)(ws + OFF_WUPAT), 512, i / 16, i % 16, 0, smem); continue; }
    i -= t_upa;
    if (i < t_upb) { tconv_tile(p.w_up_b, 1024, (bf16_t*)(ws + OFF_WUPBT), 512, i / 16, i % 16, 0, smem); continue; }
    i -= t_upb;
    tconv_tile(p.w_o, 1024, (bf16_t*)(ws + OFF_WOT), 1024, i / 16, i % 16, 0, smem);
  }
  conv_flat(p.peer_wq, (bf16_t*)(ws + OFF_WPQB), (size_t)1024 * 2048);
  {
    size_t i = ((size_t)bid * 256 + threadIdx.x) * 8;
    const size_t stride = (size_t)nb * 256 * 8;
    bf16_t* kb = (bf16_t*)(ws + OFF_KEYSB);
    for (; i < (size_t)2 * 131072; i += stride) {
      int half = i >= 131072;
      size_t s = i - (size_t)half * 131072;
      int h = (int)(s >> 14);
      size_t r = s & 16383;
      const float* src = (half ? p.keys2 : p.keys1) + s;
      float4 a = *(const float4*)(src), b = *(const float4*)(src + 4);
      u32x4 o;
      o[0] = pack2(a.x, a.y); o[1] = pack2(a.z, a.w); o[2] = pack2(b.x, b.y); o[3] = pack2(b.z, b.w);
      *(u32x4*)(kb + ((size_t)(h * 2 + half) << 14) + r) = o;
    }
  }
}

DI void rows_norm_mod(const Params& p, const float* nw, int sh_off, int sc_off, bool from_out, bf16_t* dst) {
  const int lane = threadIdx.x & 63, w = threadIdx.x >> 6;
  const float* mod = (const float*)(p.ws + OFF_MOD);
  for (int tok = blockIdx.x * 4 + w; tok < NTOK; tok += gridDim.x * 4) {
    const float* xr = from_out ? p.out + (size_t)tok * DM : xrow(p, tok);
    const float* mj = mod + modidx(tok) * 6144;
    float4 xv[4];
    float ss = 0.f;
#pragma unroll
    for (int i = 0; i < 4; ++i) {
      xv[i] = *(const float4*)(xr + (i * 64 + lane) * 4);
      ss += xv[i].x * xv[i].x + xv[i].y * xv[i].y + xv[i].z * xv[i].z + xv[i].w * xv[i].w;
    }
    ss = wsum(ss);
    float rstd = rsqrtf(ss * (1.f / 1024.f) + 1e-6f);
#pragma unroll
    for (int i = 0; i < 4; ++i) {
      int e = (i * 64 + lane) * 4;
      float4 nv = *(const float4*)(nw + e), sh = *(const float4*)(mj + sh_off + e), sc = *(const float4*)(mj + sc_off + e);
      float h0 = (xv[i].x * rstd) * nv.x * (1.f + sc.x) + sh.x;
      float h1 = (xv[i].y * rstd) * nv.y * (1.f + sc.y) + sh.y;
      float h2 = (xv[i].z * rstd) * nv.z * (1.f + sc.z) + sh.z;
      float h3 = (xv[i].w * rstd) * nv.w * (1.f + sc.w) + sh.w;
      u32x2 o;
      o[0] = pack2(h0, h1); o[1] = pack2(h2, h3);
      *(u32x2*)(dst + (size_t)tok * DM + e) = o;
    }
  }
}
DI void phase1(const Params& p, char* smem) {
  rows_norm_mod(p, p.norm_mix, 0, 1024, false, (bf16_t*)(p.ws + OFF_H1));
  const bf16_t* wpq = (const bf16_t*)(p.ws + OFF_WPQB);
  const bf16_t* kb = (const bf16_t*)(p.ws + OFF_KEYSB);
  bf16_t* wct = (bf16_t*)(p.ws + OFF_WCT);
  for (int it = blockIdx.x; it < 128; it += gridDim.x) {
    int hh = it >> 3, mt = it & 7;
    f32x4 acc[4][4];
    acc_zero(acc);
    gemm_kloop<0>(acc, wpq + (size_t)(mt * 128) * 2048 + hh * 128, 2048, kb + (size_t)hh * 16384, 128, 128, smem, 0.f, 0.f);
    epilogue(acc, [&](int m, int n, float (&v)[16]) { st_bf16x16(wct + (size_t)(hh * 128 + n) * 1024 + mt * 128 + m, v); });
  }
}

DI void phase2(const Params& p, char* smem) {
  char* ws = p.ws;
  const bf16_t* winT = (const bf16_t*)(ws + OFF_WINT);
  const bf16_t* h1 = (const bf16_t*)(ws + OFF_H1);
  bf16_t* cq = (bf16_t*)(ws + OFF_CQ);
  float* ckvraw = (float*)(ws + OFF_CKVRAW);
  float* krraw = (float*)(ws + OFF_KRRAW);
  bf16_t* rq = (bf16_t*)(ws + OFF_RQ);
  bf16_t* rk = (bf16_t*)(ws + OFF_RK);
  bf16_t* kT = (bf16_t*)(ws + OFF_KT);
  bf16_t* vT = (bf16_t*)(ws + OFF_VT);
  bf16_t* srg = (bf16_t*)(ws + OFF_SRG);
  bf16_t* sga = (bf16_t*)p.out;
  bf16_t* sgb = sga + (size_t)NTOK * 1024;
  for (int it = 0;; ++it) {
    int ft, tt;
    if (!tile_map(it, 36, 160, 4, ft, tt)) break;
    f32x4 acc[4][4];
    acc_zero(acc);
    const bf16_t* W = winT + (size_t)ft * 128 * 1024;
    const bf16_t* H = h1 + (size_t)tt * 128 * 1024;
    const int tok0 = tt * 128, f0 = ft * 128;
    if (ft >= 8 && ft < 16) {
      gemm_kloop<0>(acc, H, 1024, W, 1024, 1024, smem, 0.f, 0.f);
      if (ft < 12) {
        epilogue(acc, [&](int m, int n, float (&v)[16]) {
          int feat = f0 - 1024 + n, tok = tok0 + m;
#pragma unroll
          for (int i = 0; i < 16; ++i) v[i] *= 0.08838834764831845f;
          st_bf16x16(kT + (size_t)feat * NTOK + tok, v);
#pragma unroll
          for (int i = 0; i < 16; ++i) rk[(size_t)(tok + i) * 512 + feat] = (bf16_t)f2bf(v[i]);
        });
      } else {
        epilogue(acc, [&](int m, int n, float (&v)[16]) {
          int feat = f0 - 1536 + n, tok = tok0 + m;
          st_bf16x16(vT + (size_t)feat * NTOK + tok, v);
        });
      }
    } else {
      gemm_kloop<0>(acc, W, 1024, H, 1024, 1024, smem, 0.f, 0.f);
      if (ft < 2) {
        epilogue(acc, [&](int m, int n, float (&v)[16]) { st_bf16x16(cq + (size_t)(tok0 + n) * 256 + f0 + m, v); });
      } else if (ft == 2) {
        epilogue(acc, [&](int m, int n, float (&v)[16]) { st_f32x16(ckvraw + (size_t)(tok0 + n) * 128 + m, v); });
      } else if (ft == 3) {
        epilogue(acc, [&](int m, int n, float (&v)[16]) {
          if (m < 32) st_f32x16(krraw + (size_t)(tok0 + n) * 32 + m, v);
        });
      } else if (ft < 8) {
        epilogue(acc, [&](int m, int n, float (&v)[16]) { st_bf16x16(rq + (size_t)(tok0 + n) * 512 + f0 - 512 + m, v); });
      } else if (ft < 20) {
        epilogue(acc, [&](int m, int n, float (&v)[16]) {
#pragma unroll
          for (int i = 0; i < 16; ++i) v[i] = siluf_(v[i]);
          st_bf16x16(srg + (size_t)(tok0 + n) * 512 + f0 - 2048 + m, v);
        });
      } else if (ft < 28) {
        epilogue(acc, [&](int m, int n, float (&v)[16]) {
#pragma unroll
          for (int i = 0; i < 16; ++i) v[i] = sigmoidf_(v[i]);
          st_bf16x16(sga + (size_t)(tok0 + n) * 1024 + f0 - 2560 + m, v);
        });
      } else {
        epilogue(acc, [&](int m, int n, float (&v)[16]) {
#pragma unroll
          for (int i = 0; i < 16; ++i) v[i] = sigmoidf_(v[i]);
          st_bf16x16(sgb + (size_t)(tok0 + n) * 1024 + f0 - 3584 + m, v);
        });
      }
    }
  }
}

DI float log2gamma(float logit) { return -log1pf(expf(-logit)) * 1.4426950408889634f; }
DI void phase3(const Params& p, char* smem) {
  char* ws = p.ws;
  const int lane = threadIdx.x & 63, w = threadIdx.x >> 6;
  bf16_t* cq = (bf16_t*)(ws + OFF_CQ);
  const float* ckvraw = (const float*)(ws + OFF_CKVRAW);
  const float* krraw = (const float*)(ws + OFF_KRRAW);
  bf16_t* ckvall = (bf16_t*)(ws + OFF_CKVALL);
  bf16_t* krall = (bf16_t*)(ws + OFF_KRALL);
  for (int r = blockIdx.x * 4 + w; r < NTOK + 4096; r += gridDim.x * 4) {
    if (r < NTOK) {
      const int tok = r;
      {
        u32x2 u = *(const u32x2*)(cq + (size_t)tok * 256 + lane * 4);
        float a0 = bflo(u[0]), a1 = bfhi(u[0]), a2 = bflo(u[1]), a3 = bfhi(u[1]);
        float ss = wsum(a0 * a0 + a1 * a1 + a2 * a2 + a3 * a3);
        float rstd = rsqrtf(ss * (1.f / 256.f) + 1e-6f);
        float4 nq = *(const float4*)(p.q_norm + lane * 4);
        u32x2 o;
        o[0] = pack2(a0 * rstd * nq.x, a1 * rstd * nq.y);
        o[1] = pack2(a2 * rstd * nq.z, a3 * rstd * nq.w);
        *(u32x2*)(cq + (size_t)tok * 256 + lane * 4) = o;
      }
      const int row = kvrow(tok);
      {
        float2 v = *(const float2*)(ckvraw + (size_t)tok * 128 + lane * 2);
        float ss = wsum(v.x * v.x + v.y * v.y);
        float rstd = rsqrtf(ss * (1.f / 128.f) + 1e-6f);
        float2 nk = *(const float2*)(p.kv_norm + lane * 2);
        float o0 = v.x * rstd * nk.x, o1 = v.y * rstd * nk.y;
        if (tok < NPT) *(float2*)(p.out + OUT_CKV + (size_t)tok * 128 + lane * 2) = make_float2(o0, o1);
        *(unsigned*)(ckvall + (size_t)row * 128 + lane * 2) = pack2(o0, o1);
      }
      if (lane < 32) {
        float own = krraw[(size_t)tok * 32 + lane];
        float o = own;
        if (tok < NPT) {
          p.out[OUT_KR + (size_t)tok * 32 + lane] = own;
        } else {
          float partner = krraw[(size_t)tok * 32 + (lane ^ 16)];
          int t = (tok - NPT) & 2047;
          int a = lane & 15;
          float pos = (a < 8) ? (float)(t >> 6) : (float)(t & 63);
          float fr = exp2f(-(float)(a & 7) * 1.6609640474436813f);
          float sn, cs;
          sincosf(pos * fr, &sn, &cs);
          o = lane < 16 ? own * cs - partner * sn : partner * sn + own * cs;
        }
        krall[(size_t)row * 32 + lane] = (bf16_t)f2bf(o);
      }
    } else {
      const int cr = r - NTOK;
      const int b = cr >> 9, pos = cr & 511;
      const int row = NPT + b * 2560 + 2048 + pos;
      float2 v = *(const float2*)(p.cache_ckv + (size_t)cr * 128 + lane * 2);
      *(unsigned*)(ckvall + (size_t)row * 128 + lane * 2) = pack2(v.x, v.y);
      if (lane < 32) krall[(size_t)row * 32 + lane] = (bf16_t)f2bf(p.cache_krope[(size_t)cr * 32 + lane]);
    }
  }
  const bf16_t* kT = (const bf16_t*)(ws + OFF_KT);
  const bf16_t* vT = (const bf16_t*)(ws + OFF_VT);
  float* Uf = (float*)(ws + OFF_UF);
  float* Ub = (float*)(ws + OFF_UB);
  for (int it = blockIdx.x; it < 320; it += gridDim.x) {
    const int blk = it >> 2, h = it & 3;
    const float l2f = log2gamma(p.lg_f[h]), l2b = log2gamma(p.lg_b[h]);
    const bf16_t* Kp = kT + (size_t)(h * 128) * NTOK + blk * 256;
    const bf16_t* Vp = vT + (size_t)(h * 128) * NTOK + blk * 256;
#pragma unroll 1
    for (int dir = 0; dir < 2; ++dir) {
      const float sa = dir ? 0.f : l2f * 255.f, sb = dir ? l2b : -l2f;
      f32x4 acc[4][4];
      acc_zero(acc);
      if (blk < 16) {
        gemm_kloop<1>(acc, Vp, NTOK, Kp, NTOK, 256, smem, sa, sb);
        float* dst = p.out + (dir ? OUT_SB : OUT_SF) + (size_t)(blk * 4 + h) * 16384;
        epilogue(acc, [&](int m, int n, float (&v)[16]) { st_f32x16(dst + n * 128 + m, v); });
      } else {
        gemm_kloop<1>(acc, Kp, NTOK, Vp, NTOK, 256, smem, sa, sb);
        float* dst = (dir ? Ub : Uf) + (size_t)((blk - 16) * 4 + h) * 16384;
        epilogue(acc, [&](int m, int n, float (&v)[16]) { st_f32x16(dst + n * 128 + m, v); });
      }
    }
  }
}

DI void phase4(const Params& p) {
  char* ws = p.ws;
  const float* Uf = (const float*)(ws + OFF_UF);
  const float* Ub = (const float*)(ws + OFF_UB);
  bf16_t* Sf = (bf16_t*)(ws + OFF_SF);
  bf16_t* Sb = (bf16_t*)(ws + OFF_SB);
  for (int idx = blockIdx.x * 256 + threadIdx.x; idx < (1 << 20); idx += gridDim.x * 256) {
    int d = idx & 127, e = (idx >> 7) & 127, h = (idx >> 14) & 3, b = (idx >> 16) & 7, dir = idx >> 19;
    size_t eo = (size_t)e * 128 + d;
    if (dir == 0) {
      float cf = exp2f(log2gamma(p.lg_f[h]) * 256.f);
      float S = p.st_f[(size_t)(b * 4 + h) * 16384 + d * 128 + e];
#pragma unroll
      for (int blk = 0; blk < 8; ++blk) {
        size_t o = (size_t)((b * 8 + blk) * 4 + h) * 16384 + eo;
        Sf[o] = (bf16_t)f2bf(S);
        S = cf * S + Uf[o];
      }
    } else {
      float cb = exp2f(log2gamma(p.lg_b[h]) * 256.f);
      float S = p.st_b[(size_t)(b * 4 + h) * 16384 + d * 128 + e];
#pragma unroll
      for (int blk = 7; blk >= 0; --blk) {
        size_t o = (size_t)((b * 8 + blk) * 4 + h) * 16384 + eo;
        Sb[o] = (bf16_t)f2bf(S);
        S = cb * S + Ub[o];
      }
    }
  }
}

DI bf16x8 scale_frag(bf16x8 q, float s) {
  u32x4 u = __builtin_bit_cast(u32x4, q);
#pragma unroll
  for (int i = 0; i < 4; ++i) u[i] = pack2(bflo(u[i]) * s, bfhi(u[i]) * s);
  return __builtin_bit_cast(bf16x8, u);
}
constexpr int NQT = 1;
DI void phase5(const Params& p, char* smem) {
  char* ws = p.ws;
  const bf16_t* rq = (const bf16_t*)(ws + OFF_RQ);
  const bf16_t* rk = (const bf16_t*)(ws + OFF_RK);
  const bf16_t* vT = (const bf16_t*)(ws + OFF_VT);
  const bf16_t* srg = (const bf16_t*)(ws + OFF_SRG);
  const bf16_t* Sf = (const bf16_t*)(ws + OFF_SF);
  const bf16_t* Sb = (const bf16_t*)(ws + OFF_SB);
  bf16_t* ret = (bf16_t*)(ws + OFF_RET);
  bf16_t* Ks = (bf16_t*)smem;
  bf16_t* Vs = Ks + 64 * 144;
  const int tid = threadIdx.x, lane = tid & 63, w = tid >> 6, l15 = lane & 15, g = lane >> 4;
  for (int item = vbid(); item < 640 * (2 / NQT); item += gridDim.x) {
    const int qb = item >> 2, h = item & 3, blk = (qb * NQT) >> 2;
    const float l2f = log2gamma(p.lg_f[h]), l2b = log2gamma(p.lg_b[h]);
    const int tokw = qb * (64 * NQT) + w * (16 * NQT);
    bf16x8 Q[NQT][4];
#pragma unroll
    for (int qt = 0; qt < NQT; ++qt)
#pragma unroll
      for (int ks = 0; ks < 4; ++ks)
        Q[qt][ks] = *(const bf16x8*)(rq + (size_t)(tokw + qt * 16 + l15) * 512 + h * 128 + ks * 32 + g * 8);
    f32x4 o[8][NQT];
#pragma unroll
    for (int et = 0; et < 8; ++et)
#pragma unroll
      for (int qt = 0; qt < NQT; ++qt) o[et][qt] = f32x4{0.f, 0.f, 0.f, 0.f};
#pragma unroll 1
    for (int kt = 0; kt < 4; ++kt) {
      const int key0 = blk * 256 + kt * 64;
      __syncthreads();
#pragma unroll
      for (int i = 0; i < 4; ++i) {
        int c = tid + 256 * i;
        int r = c >> 4, cc = (c & 15) * 8;
        *(u32x4*)(Ks + r * 144 + cc) = *(const u32x4*)(rk + (size_t)(key0 + r) * 512 + h * 128 + cc);
        int e = c >> 3, c2 = (c & 7) * 8;
        *(u32x4*)(Vs + e * 72 + c2) = *(const u32x4*)(vT + (size_t)(h * 128 + e) * NTOK + key0 + c2);
      }
      __syncthreads();
      bf16x8 P[NQT][2];
#pragma unroll
      for (int qt = 0; qt < NQT; ++qt) {
        f32x4 s[4];
#pragma unroll
        for (int kk = 0; kk < 4; ++kk) s[kk] = f32x4{0.f, 0.f, 0.f, 0.f};
#pragma unroll
        for (int ks = 0; ks < 4; ++ks) {
#pragma unroll
          for (int kk = 0; kk < 4; ++kk) {
            bf16x8 a = *(const bf16x8*)(Ks + (kk * 16 + l15) * 144 + ks * 32 + g * 8);
            s[kk] = __builtin_amdgcn_mfma_f32_16x16x32_bf16(a, Q[qt][ks], s[kk], 0, 0, 0);
          }
        }
        const int iq = (tokw + qt * 16 + l15) & 255;
#pragma unroll
        for (int kk = 0; kk < 4; ++kk) {
#pragma unroll
          for (int j = 0; j < 4; ++j) {
            int jk = kt * 64 + kk * 16 + 4 * g + j;
            int diff = iq - jk;
            float dm = diff > 0 ? ex2(l2f * (float)diff) : (diff < 0 ? ex2(l2b * (float)(-diff)) : 2.f);
            s[kk][j] *= dm;
          }
        }
#pragma unroll
        for (int k2 = 0; k2 < 2; ++k2) {
          u32x4 u;
          u[0] = pack2(s[2 * k2][0], s[2 * k2][1]);
          u[1] = pack2(s[2 * k2][2], s[2 * k2][3]);
          u[2] = pack2(s[2 * k2 + 1][0], s[2 * k2 + 1][1]);
          u[3] = pack2(s[2 * k2 + 1][2], s[2 * k2 + 1][3]);
          P[qt][k2] = __builtin_bit_cast(bf16x8, u);
        }
      }
#pragma unroll
      for (int k2 = 0; k2 < 2; ++k2) {
#pragma unroll
        for (int et = 0; et < 8; ++et) {
          u32x2 lo = *(const u32x2*)(Vs + (et * 16 + l15) * 72 + k2 * 32 + 4 * g);
          u32x2 hi = *(const u32x2*)(Vs + (et * 16 + l15) * 72 + k2 * 32 + 16 + 4 * g);
          u32x4 u;
          u[0] = lo[0]; u[1] = lo[1]; u[2] = hi[0]; u[3] = hi[1];
          bf16x8 a = __builtin_bit_cast(bf16x8, u);
#pragma unroll
          for (int qt = 0; qt < NQT; ++qt) o[et][qt] = __builtin_amdgcn_mfma_f32_16x16x32_bf16(a, P[qt][k2], o[et][qt], 0, 0, 0);
        }
      }
    }
    if (blk >= 16) {
#pragma unroll 1
      for (int dir = 0; dir < 2; ++dir) {
        const bf16_t* S = (dir ? Sb : Sf) + (size_t)((blk - 16) * 4 + h) * 16384;
        float dq[NQT];
#pragma unroll
        for (int qt = 0; qt < NQT; ++qt) {
          int iq = (tokw + qt * 16 + l15) & 255;
          dq[qt] = dir ? exp2f(l2b * (float)(256 - iq)) : exp2f(l2f * (float)(iq + 1));
        }
#pragma unroll
        for (int ks = 0; ks < 4; ++ks) {
          bf16x8 qs[NQT];
#pragma unroll
          for (int qt = 0; qt < NQT; ++qt) qs[qt] = scale_frag(Q[qt][ks], dq[qt]);
#pragma unroll
          for (int et = 0; et < 8; ++et) {
            bf16x8 a = *(const bf16x8*)(S + (size_t)(et * 16 + l15) * 128 + ks * 32 + g * 8);
#pragma unroll
            for (int qt = 0; qt < NQT; ++qt) o[et][qt] = __builtin_amdgcn_mfma_f32_16x16x32_bf16(a, qs[qt], o[et][qt], 0, 0, 0);
          }
        }
      }
    }
#pragma unroll
    for (int qt = 0; qt < NQT; ++qt) {
      const int tok = tokw + qt * 16 + l15;
      float s1 = 0.f;
#pragma unroll
      for (int et = 0; et < 8; ++et)
#pragma unroll
        for (int j = 0; j < 4; ++j) s1 += o[et][qt][j];
      s1 += __shfl_xor(s1, 16);
      s1 += __shfl_xor(s1, 32);
      const float mu = s1 * (1.f / 128.f);
      float s2 = 0.f;
#pragma unroll
      for (int et = 0; et < 8; ++et)
#pragma unroll
        for (int j = 0; j < 4; ++j) {
          float dlt = o[et][qt][j] - mu;
          s2 += dlt * dlt;
        }
      s2 += __shfl_xor(s2, 16);
      s2 += __shfl_xor(s2, 32);
      const float rstd = rsqrtf(s2 * (1.f / 128.f) + 1e-6f);
#pragma unroll
      for (int et = 0; et < 8; ++et) {
        const int e = h * 128 + et * 16 + 4 * g;
        float4 gn = *(const float4*)(p.ret_gn + e);
        u32x2 sg = *(const u32x2*)(srg + (size_t)tok * 512 + e);
        u32x2 ov;
        ov[0] = pack2((o[et][qt][0] - mu) * rstd * gn.x * bflo(sg[0]), (o[et][qt][1] - mu) * rstd * gn.y * bfhi(sg[0]));
        ov[1] = pack2((o[et][qt][2] - mu) * rstd * gn.z * bflo(sg[1]), (o[et][qt][3] - mu) * rstd * gn.w * bfhi(sg[1]));
        *(u32x2*)(ret + (size_t)tok * 512 + e) = ov;
      }
    }
  }
}

DI void phase6(const Params& p, char* smem) {
  char* ws = p.ws;
  const bf16_t* cqn = (const bf16_t*)(ws + OFF_CQ);
  const bf16_t* wuqT = (const bf16_t*)(ws + OFF_WUQT);
  bf16_t* q = (bf16_t*)(ws + OFF_Q);
  for (int it = 0;; ++it) {
    int ft, tt;
    if (!tile_map(it, 6, 160, 1, ft, tt)) break;
    f32x4 acc[4][4];
    acc_zero(acc);
    gemm_kloop<0>(acc, wuqT + (size_t)ft * 128 * 256, 256, cqn + (size_t)tt * 128 * 256, 256, 256, smem, 0.f, 0.f);
    epilogue(acc, [&](int m, int n, float (&v)[16]) { st_bf16x16(q + (size_t)(tt * 128 + n) * 768 + ft * 128 + m, v); });
  }
  const bf16_t* ckvall = (const bf16_t*)(ws + OFF_CKVALL);
  const bf16_t* wukvT = (const bf16_t*)(ws + OFF_WUKVT);
  bf16_t* Kn = (bf16_t*)(ws + OFF_KN);
  bf16_t* Vt = (bf16_t*)(ws + OFF_VTA);
  for (int it = 0;; ++it) {
    int ft, tt;
    if (!tile_map(it, 8, 192, 1, ft, tt)) break;
    f32x4 acc[4][4];
    acc_zero(acc);
    const bf16_t* W = wukvT + (size_t)ft * 128 * 128;
    const bf16_t* X = ckvall + (size_t)tt * 128 * 128;
    if (ft < 4) {
      gemm_kloop<0>(acc, W, 128, X, 128, 128, smem, 0.f, 0.f);
      epilogue(acc, [&](int m, int n, float (&v)[16]) { st_bf16x16(Kn + (size_t)(tt * 128 + n) * 512 + ft * 128 + m, v); });
    } else {
      gemm_kloop<0>(acc, X, 128, W, 128, 128, smem, 0.f, 0.f);
      epilogue(acc, [&](int m, int n, float (&v)[16]) { st_bf16x16(Vt + (size_t)((ft - 4) * 128 + n) * NKV + tt * 128 + m, v); });
    }
  }
}

DI void conv_fp8_rows(const float* __restrict__ src, unsigned char* __restrict__ dst, float* __restrict__ inv);
DI void phase7(const Params& p, char* smem) {
  char* ws = p.ws;
  const bf16_t* q = (const bf16_t*)(ws + OFF_Q);
  const bf16_t* Kn = (const bf16_t*)(ws + OFF_KN);
  const bf16_t* Vt = (const bf16_t*)(ws + OFF_VTA);
  const bf16_t* krall = (const bf16_t*)(ws + OFF_KRALL);
  bf16_t* attn = (bf16_t*)(ws + OFF_ATTN);
  bf16_t* Ks0 = (bf16_t*)smem;
  const int tid = threadIdx.x, lane = tid & 63, w = tid >> 6, l15 = lane & 15, g = lane >> 4;
  const float qscale = 0.10206207261596577f * 1.4426950408889634f;
  for (int item = vbid(); item < 1280; item += gridDim.x) {
    int b, h, qtok0, keyrow0, nkt;
    bool sample;
    if (item < 1024) {
      sample = true; b = item >> 7; h = (item >> 4) & 7; int qb = item & 15;
      qtok0 = NPT + b * 2048 + qb * 128; keyrow0 = NPT + b * 2560; nkt = 40;
    } else {
      int it2 = item - 1024;
      sample = false; b = it2 >> 4; h = (it2 >> 1) & 7; int qb = it2 & 1;
      qtok0 = b * 256 + qb * 128; keyrow0 = b * 256; nkt = 4;
    }
    bf16x8 Q[2][3];
#pragma unroll
    for (int qt = 0; qt < 2; ++qt) {
      const int tokq = qtok0 + w * 32 + qt * 16 + l15;
      const bf16_t* qp = q + (size_t)tokq * 768 + h * 96;
#pragma unroll
      for (int ks = 0; ks < 3; ++ks) {
        u32x4 u = *(const u32x4*)(qp + ks * 32 + g * 8);
        float v[8];
#pragma unroll
        for (int i = 0; i < 4; ++i) { v[2 * i] = bflo(u[i]); v[2 * i + 1] = bfhi(u[i]); }
        if (ks == 2 && sample) {
          u32x4 up = *(const u32x4*)(qp + 64 + (g ^ 2) * 8);
          float pv[8];
#pragma unroll
          for (int i = 0; i < 4; ++i) { pv[2 * i] = bflo(up[i]); pv[2 * i + 1] = bfhi(up[i]); }
          int t = (tokq - NPT) & 2047;
          float pos = (g & 1) ? (float)(t & 63) : (float)(t >> 6);
#pragma unroll
          for (int i = 0; i < 8; ++i) {
            float fr = exp2f(-(float)i * 1.6609640474436813f);
            float sn, cs;
            sincosf(pos * fr, &sn, &cs);
            v[i] = g < 2 ? v[i] * cs - pv[i] * sn : pv[i] * sn + v[i] * cs;
          }
        }
        u32x4 o4;
#pragma unroll
        for (int i = 0; i < 4; ++i) o4[i] = pack2(v[2 * i] * qscale, v[2 * i + 1] * qscale);
        Q[qt][ks] = __builtin_bit_cast(bf16x8, o4);
      }
    }
    f32x4 o[4][2];
#pragma unroll
    for (int et = 0; et < 4; ++et)
#pragma unroll
      for (int qt = 0; qt < 2; ++qt) o[et][qt] = f32x4{0.f, 0.f, 0.f, 0.f};
    float mrun[2] = {-1e30f, -1e30f}, lrun[2] = {0.f, 0.f};
    u32x4 rk_[3], rv_[2];
    auto gload = [&](int kt) {
      const int row0 = keyrow0 + kt * 64;
#pragma unroll
      for (int i = 0; i < 3; ++i) {
        int c = tid + 256 * i;
        int r = c / 12, cc = c - r * 12;
        rk_[i] = cc < 8 ? *(const u32x4*)(Kn + (size_t)(row0 + r) * 512 + h * 64 + cc * 8)
                        : *(const u32x4*)(krall + (size_t)(row0 + r) * 32 + (cc - 8) * 8);
      }
#pragma unroll
      for (int i = 0; i < 2; ++i) {
        int c = tid + 256 * i;
        int e = c >> 3, cc = (c & 7) * 8;
        rv_[i] = *(const u32x4*)(Vt + (size_t)(h * 64 + e) * NKV + row0 + cc);
      }
    };
    auto lstore = [&](int b) {
      bf16_t* Kd = Ks0 + b * 11776;
      bf16_t* Vd = Kd + 64 * 112;
#pragma unroll
      for (int i = 0; i < 3; ++i) {
        int c = tid + 256 * i;
        int r = c / 12, cc = c - r * 12;
        *(u32x4*)(Kd + r * 112 + cc * 8) = rk_[i];
      }
#pragma unroll
      for (int i = 0; i < 2; ++i) {
        int c = tid + 256 * i;
        int e = c >> 3, cc = (c & 7) * 8;
        *(u32x4*)(Vd + e * 72 + cc) = rv_[i];
      }
    };
    gload(0);
    __syncthreads();
    lstore(0);
    if (nkt > 1) gload(1);
    __syncthreads();
#pragma unroll 1
    for (int kt = 0; kt < nkt; ++kt) {
      const bf16_t* Ks = Ks0 + (kt & 1) * 11776;
      const bf16_t* Vs = Ks + 64 * 112;
      f32x4 s[4][2];
#pragma unroll
      for (int kk = 0; kk < 4; ++kk)
#pragma unroll
        for (int qt = 0; qt < 2; ++qt) s[kk][qt] = f32x4{0.f, 0.f, 0.f, 0.f};
#pragma unroll
      for (int ks = 0; ks < 3; ++ks) {
#pragma unroll
        for (int kk = 0; kk < 4; ++kk) {
          bf16x8 a = *(const bf16x8*)(Ks + (kk * 16 + l15) * 112 + ks * 32 + g * 8);
#pragma unroll
          for (int qt = 0; qt < 2; ++qt) s[kk][qt] = __builtin_amdgcn_mfma_f32_16x16x32_bf16(a, Q[qt][ks], s[kk][qt], 0, 0, 0);
        }
      }
      bf16x8 P[2][2];
#pragma unroll
      for (int qt = 0; qt < 2; ++qt) {
        float mx = s[0][qt][0];
#pragma unroll
        for (int kk = 0; kk < 4; ++kk)
#pragma unroll
          for (int j = 0; j < 4; ++j) mx = fmaxf(mx, s[kk][qt][j]);
        mx = fmaxf(mx, __shfl_xor(mx, 16));
        mx = fmaxf(mx, __shfl_xor(mx, 32));
        const float mnew = fmaxf(mrun[qt], mx);
        const bool grow = __ballot(mx > mrun[qt]) != 0ull;
        const float alpha = grow ? ex2(mrun[qt] - mnew) : 1.f;
        mrun[qt] = mnew;
        float ps = 0.f;
#pragma unroll
        for (int kk = 0; kk < 4; ++kk)
#pragma unroll
          for (int j = 0; j < 4; ++j) {
            float e_ = ex2(s[kk][qt][j] - mnew);
            s[kk][qt][j] = e_;
            ps += e_;
          }
        if (grow) {
          lrun[qt] = lrun[qt] * alpha + ps;
#pragma unroll
          for (int et = 0; et < 4; ++et)
#pragma unroll
            for (int j = 0; j < 4; ++j) o[et][qt][j] *= alpha;
        } else {
          lrun[qt] += ps;
        }
#pragma unroll
        for (int k2 = 0; k2 < 2; ++k2) {
          u32x4 u;
          u[0] = pack2(s[2 * k2][qt][0], s[2 * k2][qt][1]);
          u[1] = pack2(s[2 * k2][qt][2], s[2 * k2][qt][3]);
          u[2] = pack2(s[2 * k2 + 1][qt][0], s[2 * k2 + 1][qt][1]);
          u[3] = pack2(s[2 * k2 + 1][qt][2], s[2 * k2 + 1][qt][3]);
          P[qt][k2] = __builtin_bit_cast(bf16x8, u);
        }
      }
#pragma unroll
      for (int k2 = 0; k2 < 2; ++k2) {
#pragma unroll
        for (int et = 0; et < 4; ++et) {
          u32x2 lo = *(const u32x2*)(Vs + (et * 16 + l15) * 72 + k2 * 32 + 4 * g);
          u32x2 hi = *(const u32x2*)(Vs + (et * 16 + l15) * 72 + k2 * 32 + 16 + 4 * g);
          u32x4 u;
          u[0] = lo[0]; u[1] = lo[1]; u[2] = hi[0]; u[3] = hi[1];
          bf16x8 a = __builtin_bit_cast(bf16x8, u);
#pragma unroll
          for (int qt = 0; qt < 2; ++qt) o[et][qt] = __builtin_amdgcn_mfma_f32_16x16x32_bf16(a, P[qt][k2], o[et][qt], 0, 0, 0);
        }
      }
      if (kt + 1 < nkt) {
        lstore((kt + 1) & 1);
        if (kt + 2 < nkt) gload(kt + 2);
        __syncthreads();
      }
    }
#pragma unroll
    for (int qt = 0; qt < 2; ++qt) {
      const int tokq = qtok0 + w * 32 + qt * 16 + l15;
      float lt = lrun[qt];
      lt += __shfl_xor(lt, 16);
      lt += __shfl_xor(lt, 32);
      const float inv = 1.f / lt;
#pragma unroll
      for (int et = 0; et < 4; ++et) {
        u32x2 ov;
        ov[0] = pack2(o[et][qt][0] * inv, o[et][qt][1] * inv);
        ov[1] = pack2(o[et][qt][2] * inv, o[et][qt][3] * inv);
        *(u32x2*)(attn + (size_t)tokq * 512 + h * 64 + et * 16 + 4 * g) = ov;
      }
    }
  }
  conv_fp8_rows(p.peer_u, (unsigned char*)(p.ws + OFF_TABU), (float*)(p.ws + OFF_INVU));
  conv_fp8_rows(p.peer_v, (unsigned char*)(p.ws + OFF_TABV), (float*)(p.ws + OFF_INVV));
}

DI void phase8(const Params& p, char* smem) {
  char* ws = p.ws;
  const bf16_t* attn = (const bf16_t*)(ws + OFF_ATTN);
  const bf16_t* ret = (const bf16_t*)(ws + OFF_RET);
  const bf16_t* wa = (const bf16_t*)(ws + OFF_WUPAT);
  const bf16_t* wb = (const bf16_t*)(ws + OFF_WUPBT);
  const bf16_t* sga = (const bf16_t*)p.out;
  const bf16_t* sgb = sga + (size_t)NTOK * 1024;
  bf16_t* mbuf = (bf16_t*)(ws + OFF_M);
  const int tid = threadIdx.x, lane = tid & 63, w = tid >> 6, wm = w >> 1, wn = w & 1, l15 = lane & 15, g = lane >> 4;
  for (int it = 0;; ++it) {
    int ft, tt;
    if (!tile_map(it, 8, 160, 1, ft, tt)) break;
    f32x4 acc[4][4];
    acc_zero(acc);
    gemm_kloop<0>(acc, wa + (size_t)ft * 128 * 512, 512, attn + (size_t)tt * 128 * 512, 512, 512, smem, 0.f, 0.f);
#pragma unroll
    for (int c = 0; c < 4; ++c) {
      const size_t off = (size_t)(tt * 128 + wn * 64 + c * 16 + l15) * 1024 + ft * 128 + wm * 64 + 16 * g;
      float a[16], bq[16];
      ld_bf16x16(sga + off, a);
      ld_bf16x16(sgb + off, bq);
#pragma unroll
      for (int f = 0; f < 4; ++f)
#pragma unroll
        for (int j = 0; j < 4; ++j) acc[f][c][j] *= a[f * 4 + j] / fmaxf(bq[f * 4 + j], 1e-30f);
    }
    gemm_kloop<0>(acc, wb + (size_t)ft * 128 * 512, 512, ret + (size_t)tt * 128 * 512, 512, 512, smem, 0.f, 0.f);
    epilogue(acc, [&](int m, int n, float (&v)[16]) {
      const size_t off = (size_t)(tt * 128 + n) * 1024 + ft * 128 + m;
      float bq[16];
      ld_bf16x16(sgb + off, bq);
#pragma unroll
      for (int i = 0; i < 16; ++i) v[i] *= bq[i];
      st_bf16x16(mbuf + off, v);
    });
  }
}
DI void phase9(const Params& p, char* smem) {
  char* ws = p.ws;
  const bf16_t* mbuf = (const bf16_t*)(ws + OFF_M);
  const bf16_t* wo = (const bf16_t*)(ws + OFF_WOT);
  const float* mod = (const float*)(ws + OFF_MOD);
  for (int it = 0;; ++it) {
    int ft, tt;
    if (!tile_map(it, 8, 160, 1, ft, tt)) break;
    f32x4 acc[4][4];
    acc_zero(acc);
    gemm_kloop<0>(acc, wo + (size_t)ft * 128 * 1024, 1024, mbuf + (size_t)tt * 128 * 1024, 1024, 1024, smem, 0.f, 0.f);
    epilogue(acc, [&](int m, int n, float (&v)[16]) {
      const int tok = tt * 128 + n, feat = ft * 128 + m;
      const float* xr = xrow(p, tok) + feat;
      const float* g1 = mod + modidx(tok) * 6144 + 2048 + feat;
#pragma unroll
      for (int i = 0; i < 4; ++i) {
        float4 xv = *(const float4*)(xr + 4 * i), gv = *(const float4*)(g1 + 4 * i);
        v[4 * i] = xv.x + gv.x * v[4 * i];
        v[4 * i + 1] = xv.y + gv.y * v[4 * i + 1];
        v[4 * i + 2] = xv.z + gv.z * v[4 * i + 2];
        v[4 * i + 3] = xv.w + gv.w * v[4 * i + 3];
      }
      st_f32x16(p.out + (size_t)tok * DM + feat, v);
    });
  }
}
DI void conv_fp8_rows(const float* __restrict__ src, unsigned char* __restrict__ dst, float* __restrict__ inv) {
  const int lane = threadIdx.x & 63, w = threadIdx.x >> 6;
  for (int r = blockIdx.x * 4 + w; r < 16384; r += gridDim.x * 4) {
    const float* sp = src + (size_t)r * 1024 + lane * 16;
    float4 v[4];
    float am = 0.f;
#pragma unroll
    for (int i = 0; i < 4; ++i) {
      v[i] = *(const float4*)(sp + 4 * i);
      am = fmaxf(am, fmaxf(fmaxf(fabsf(v[i].x), fabsf(v[i].y)), fmaxf(fabsf(v[i].z), fabsf(v[i].w))));
    }
#pragma unroll
    for (int o = 32; o > 0; o >>= 1) am = fmaxf(am, __shfl_xor(am, o));
    const float sc = am > 0.f ? 448.f / am : 1.f;
    u32x4 o4;
#pragma unroll
    for (int i = 0; i < 4; ++i) {
      int wd = 0;
      wd = __builtin_amdgcn_cvt_pk_fp8_f32(v[i].x * sc, v[i].y * sc, wd, false);
      wd = __builtin_amdgcn_cvt_pk_fp8_f32(v[i].z * sc, v[i].w * sc, wd, true);
      o4[i] = (unsigned)wd;
    }
    *(u32x4*)(dst + ((size_t)(lane >> 3) * 16384 + r) * 128 + (lane & 7) * 16) = o4;
    if (lane == 0) inv[r] = am > 0.f ? am * (1.f / 448.f) : 1.f;
  }
}
DI void phase10(const Params& p, char* smem) {
  rows_norm_mod(p, p.norm_ffn, 3072, 4096, true, (bf16_t*)(p.ws + OFF_H2));
}
DI void phase11(const Params& p, char* smem) {
  char* ws = p.ws;
  const bf16_t* h2 = (const bf16_t*)(ws + OFF_H2);
  const bf16_t* wct = (const bf16_t*)(ws + OFF_WCT);
  bf16_t* sc = (bf16_t*)(ws + OFF_SCORES);
  for (int it = 0;; ++it) {
    int ft, tt;
    if (!tile_map(it, 16, 160, 2, ft, tt)) break;
    f32x4 acc[4][4];
    acc_zero(acc);
    gemm_kloop<0>(acc, wct + (size_t)ft * 128 * 1024, 1024, h2 + (size_t)tt * 128 * 1024, 1024, 1024, smem, 0.f, 0.f);
    epilogue(acc, [&](int m, int n, float (&v)[16]) { st_bf16x16(sc + (size_t)(tt * 128 + n) * 2048 + ft * 128 + m, v); });
  }
}

DI unsigned okey(float f) {
  unsigned u = __float_as_uint(f);
  return (u & 0x80000000u) ? ~u : (u | 0x80000000u);
}
DI void wave_lds_sync() {
  __builtin_amdgcn_fence(__ATOMIC_ACQ_REL, "workgroup");
  __builtin_amdgcn_wave_barrier();
}
DI unsigned okey16(unsigned b) { return (b & 0x8000u) ? (~b & 0xFFFFu) : (b | 0x8000u); }
DI unsigned inv_okey16(unsigned k) { return (k & 0x8000u) ? (k & 0x7FFFu) : (~k & 0xFFFFu); }
DI unsigned inv_okey(unsigned k) { return (k & 0x80000000u) ? (k & 0x7FFFFFFFu) : ~k; }
DI void ins16(unsigned (&L)[16], unsigned x) {
#pragma unroll
  for (int i = 0; i < 16; ++i) {
    unsigned t = max(L[i], x);
    x = min(L[i], x);
    L[i] = t;
  }
}
DI void ce_desc(unsigned& a, unsigned& b) {
  const unsigned t = max(a, b);
  b = min(a, b);
  a = t;
}
DI void sort16_desc(unsigned (&a)[16]) {
#pragma unroll
  for (int ks = 1; ks <= 4; ++ks) {
#pragma unroll
    for (int js = ks - 1; js >= 0; --js) {
#pragma unroll
      for (int i = 0; i < 16; ++i) {
        const int k = 1 << ks, j = 1 << js, l = i ^ j;
        if (l > i) {
          if ((i & k) == 0) ce_desc(a[i], a[l]);
          else ce_desc(a[l], a[i]);
        }
      }
    }
  }
}
DI void merge_top16(unsigned (&L)[16], const unsigned (&G)[16]) {
#pragma unroll
  for (int i = 0; i < 16; ++i) L[i] = max(L[i], G[15 - i]);
#pragma unroll
  for (int js = 3; js >= 0; --js) {
#pragma unroll
    for (int i = 0; i < 16; ++i) {
      const int j = 1 << js, l = i ^ j;
      if (l > i) ce_desc(L[i], L[l]);
    }
  }
}
DI unsigned byte16(const unsigned (&d)[4], int i) {
  unsigned r = 0u;
#pragma unroll
  for (int q = 0; q < 4; ++q) r |= d[q] & (0u - (unsigned)((i >> 2) == q));
  return (r >> ((i & 3) * 8)) & 0xFFu;
}
DI unsigned sel16(const unsigned (&A)[16], int i) {
  unsigned r = 0u;
#pragma unroll
  for (int t = 0; t < 16; ++t) r |= A[t] & (0u - (unsigned)(i == t));
  return r;
}
DI void phase12(const Params& p, char* smem) {
  char* ws = p.ws;
  const bf16_t* sc = (const bf16_t*)(ws + OFF_SCORES);
  int* elist = (int*)(ws + OFF_ELIST);
  float* glist = (float*)(ws + OFF_GLIST);
  const int lane = threadIdx.x & 63, w = threadIdx.x >> 6;
  for (int batch = blockIdx.x * 4 + w; batch < NTOK / 4; batch += gridDim.x * 4) {
    const int tok = batch * 4 + (lane >> 4), hh = lane & 15;
    const bf16_t* row = sc + (size_t)tok * 2048 + hh * 128;
    unsigned L[16];
#pragma unroll
    for (int grp8 = 0; grp8 < 8; ++grp8) {
      unsigned G[16];
#pragma unroll
      for (int cc = 0; cc < 2; ++cc) {
        const int c = grp8 * 2 + cc;
        u32x4 u = *(const u32x4*)(row + c * 8);
#pragma unroll
        for (int i = 0; i < 4; ++i) {
          unsigned b0 = u[i] & 0xFFFFu, b1 = u[i] >> 16;
          G[cc * 8 + 2 * i] = (okey16(b0) << 16) | (unsigned)(127 - (c * 8 + 2 * i));
          G[cc * 8 + 2 * i + 1] = (okey16(b1) << 16) | (unsigned)(127 - (c * 8 + 2 * i + 1));
        }
      }
      sort16_desc(G);
      if (grp8 == 0) {
#pragma unroll
        for (int i = 0; i < 16; ++i) L[i] = G[i];
      } else {
        merge_top16(L, G);
      }
    }
    unsigned M[16];
#pragma unroll
    for (int i = 0; i < 16; ++i) M[i] = (unsigned)__shfl_xor((int)L[i], 1);
    float v1[16], v2[16];
#pragma unroll
    for (int i = 0; i < 16; ++i) {
      v1[i] = bf2f(inv_okey16(L[i] >> 16));
      v2[i] = bf2f(inv_okey16(M[i] >> 16));
    }
    unsigned C[16];
#pragma unroll
    for (int i = 0; i < 16; ++i) C[i] = 0u;
    ins16(C, (okey(v1[0] + v2[0]) & 0xFFFFFF00u) | 255u);
    ins16(C, (okey(v1[0] + v2[1]) & 0xFFFFFF00u) | 254u);
    ins16(C, (okey(v1[0] + v2[2]) & 0xFFFFFF00u) | 253u);
    ins16(C, (okey(v1[0] + v2[3]) & 0xFFFFFF00u) | 252u);
    ins16(C, (okey(v1[0] + v2[4]) & 0xFFFFFF00u) | 251u);
    ins16(C, (okey(v1[0] + v2[5]) & 0xFFFFFF00u) | 250u);
    ins16(C, (okey(v1[0] + v2[6]) & 0xFFFFFF00u) | 249u);
    ins16(C, (okey(v1[0] + v2[7]) & 0xFFFFFF00u) | 248u);
    ins16(C, (okey(v1[0] + v2[8]) & 0xFFFFFF00u) | 247u);
    ins16(C, (okey(v1[0] + v2[9]) & 0xFFFFFF00u) | 246u);
    ins16(C, (okey(v1[0] + v2[10]) & 0xFFFFFF00u) | 245u);
    ins16(C, (okey(v1[0] + v2[11]) & 0xFFFFFF00u) | 244u);
    ins16(C, (okey(v1[0] + v2[12]) & 0xFFFFFF00u) | 243u);
    ins16(C, (okey(v1[0] + v2[13]) & 0xFFFFFF00u) | 242u);
    ins16(C, (okey(v1[0] + v2[14]) & 0xFFFFFF00u) | 241u);
    ins16(C, (okey(v1[0] + v2[15]) & 0xFFFFFF00u) | 240u);
    ins16(C, (okey(v1[1] + v2[0]) & 0xFFFFFF00u) | 239u);
    ins16(C, (okey(v1[1] + v2[1]) & 0xFFFFFF00u) | 238u);
    ins16(C, (okey(v1[1] + v2[2]) & 0xFFFFFF00u) | 237u);
    ins16(C, (okey(v1[1] + v2[3]) & 0xFFFFFF00u) | 236u);
    ins16(C, (okey(v1[1] + v2[4]) & 0xFFFFFF00u) | 235u);
    ins16(C, (okey(v1[1] + v2[5]) & 0xFFFFFF00u) | 234u);
    ins16(C, (okey(v1[1] + v2[6]) & 0xFFFFFF00u) | 233u);
    ins16(C, (okey(v1[1] + v2[7]) & 0xFFFFFF00u) | 232u);
    ins16(C, (okey(v1[2] + v2[0]) & 0xFFFFFF00u) | 223u);
    ins16(C, (okey(v1[2] + v2[1]) & 0xFFFFFF00u) | 222u);
    ins16(C, (okey(v1[2] + v2[2]) & 0xFFFFFF00u) | 221u);
    ins16(C, (okey(v1[2] + v2[3]) & 0xFFFFFF00u) | 220u);
    ins16(C, (okey(v1[2] + v2[4]) & 0xFFFFFF00u) | 219u);
    ins16(C, (okey(v1[3] + v2[0]) & 0xFFFFFF00u) | 207u);
    ins16(C, (okey(v1[3] + v2[1]) & 0xFFFFFF00u) | 206u);
    ins16(C, (okey(v1[3] + v2[2]) & 0xFFFFFF00u) | 205u);
    ins16(C, (okey(v1[3] + v2[3]) & 0xFFFFFF00u) | 204u);
    ins16(C, (okey(v1[4] + v2[0]) & 0xFFFFFF00u) | 191u);
    ins16(C, (okey(v1[4] + v2[1]) & 0xFFFFFF00u) | 190u);
    ins16(C, (okey(v1[4] + v2[2]) & 0xFFFFFF00u) | 189u);
    ins16(C, (okey(v1[5] + v2[0]) & 0xFFFFFF00u) | 175u);
    ins16(C, (okey(v1[5] + v2[1]) & 0xFFFFFF00u) | 174u);
    ins16(C, (okey(v1[6] + v2[0]) & 0xFFFFFF00u) | 159u);
    ins16(C, (okey(v1[6] + v2[1]) & 0xFFFFFF00u) | 158u);
    ins16(C, (okey(v1[7] + v2[0]) & 0xFFFFFF00u) | 143u);
    ins16(C, (okey(v1[7] + v2[1]) & 0xFFFFFF00u) | 142u);
    ins16(C, (okey(v1[8] + v2[0]) & 0xFFFFFF00u) | 127u);
    ins16(C, (okey(v1[9] + v2[0]) & 0xFFFFFF00u) | 111u);
    ins16(C, (okey(v1[10] + v2[0]) & 0xFFFFFF00u) | 95u);
    ins16(C, (okey(v1[11] + v2[0]) & 0xFFFFFF00u) | 79u);
    ins16(C, (okey(v1[12] + v2[0]) & 0xFFFFFF00u) | 63u);
    ins16(C, (okey(v1[13] + v2[0]) & 0xFFFFFF00u) | 47u);
    ins16(C, (okey(v1[14] + v2[0]) & 0xFFFFFF00u) | 31u);
    ins16(C, (okey(v1[15] + v2[0]) & 0xFFFFFF00u) | 15u);
    unsigned ib1[4], ib2[4];
#pragma unroll
    for (int q = 0; q < 4; ++q) {
      ib1[q] = (L[4 * q] & 0xFFu) | ((L[4 * q + 1] & 0xFFu) << 8) | ((L[4 * q + 2] & 0xFFu) << 16) | ((L[4 * q + 3] & 0xFFu) << 24);
      ib2[q] = (M[4 * q] & 0xFFu) | ((M[4 * q + 1] & 0xFFu) << 8) | ((M[4 * q + 2] & 0xFFu) << 16) | ((M[4 * q + 3] & 0xFFu) << 24);
    }
    int ev[16];
    float gv[16];
    const float mx = __uint_as_float(inv_okey(C[0] & 0xFFFFFF00u));
    float den = 0.f;
#pragma unroll
    for (int k = 0; k < 16; ++k) {
      const int ci = 255 - (int)(C[k] & 0xFFu);
      ev[k] = (127 - (int)byte16(ib1, ci >> 4)) * 128 + (127 - (int)byte16(ib2, ci & 15));
      gv[k] = __expf(__uint_as_float(inv_okey(C[k] & 0xFFFFFF00u)) - mx);
      den += gv[k];
    }
    const float inv = 1.f / den;
    if ((lane & 1) == 0) {
      int* ep = elist + (size_t)tok * 128 + (hh >> 1) * 16;
      float* gp = glist + (size_t)tok * 128 + (hh >> 1) * 16;
#pragma unroll
      for (int k = 0; k < 4; ++k) {
        *(int4*)(ep + 4 * k) = make_int4(ev[4 * k], ev[4 * k + 1], ev[4 * k + 2], ev[4 * k + 3]);
        *(float4*)(gp + 4 * k) = make_float4(gv[4 * k] * inv, gv[4 * k + 1] * inv, gv[4 * k + 2] * inv, gv[4 * k + 3] * inv);
      }
    }
  }
}
using f32x2 = __attribute__((ext_vector_type(2))) float;
DI f32x2 cvt8(unsigned w, bool hi) {
  return hi ? __builtin_amdgcn_cvt_pk_f32_fp8((int)w, true) : __builtin_amdgcn_cvt_pk_f32_fp8((int)w, false);
}
struct SMeta { int e[16]; u32x4 ha, hb; };
template <int MODE>
DI void sl_meta(const Params& p, int t, int s, int grp, int ch, SMeta& m) {
  const int* elist = (const int*)(p.ws + (MODE == 0 ? OFF_ELIST : OFF_GLIST));
#pragma unroll
  for (int i = 0; i < 16; ++i) m.e[i] = elist[(size_t)t * 128 + i * 8 + grp];
  if (MODE == 0) {
    const bf16_t* hq = (const bf16_t*)(p.ws + OFF_H2) + (size_t)t * DM + s * 128 + ch * 16;
    m.ha = *(const u32x4*)hq;
    m.hb = *(const u32x4*)(hq + 8);
  }
}
template <int MODE>
DI void sl_rows(const Params& p, int s, int ch, const SMeta& m, u32x4 (&r)[16]) {
  const unsigned char* tab = (const unsigned char*)(p.ws + (MODE == 0 ? OFF_TABU : OFF_TABV));
#pragma unroll
  for (int i = 0; i < 16; ++i) r[i] = *(const u32x4*)(tab + ((size_t)s * 16384 + (m.e[i] & 0xFFFF)) * 128 + ch * 16);
}
template <int MODE>
DI void sl_compute(const Params& p, int t, int s, int lane, const SMeta& m, const u32x4 (&r)[16]) {
  const int grp = lane >> 3, ch = lane & 7;
  if (MODE == 0) {
    f32x2 hp[8];
#pragma unroll
    for (int i = 0; i < 4; ++i) {
      hp[i] = f32x2{bflo(m.ha[i]), bfhi(m.ha[i])};
      hp[4 + i] = f32x2{bflo(m.hb[i]), bfhi(m.hb[i])};
    }
    float keep0 = 0.f, keep1 = 0.f;
#pragma unroll
    for (int i = 0; i < 16; ++i) {
      f32x2 d2 = f32x2{0.f, 0.f};
#pragma unroll
      for (int j = 0; j < 4; ++j) {
        d2 += cvt8(r[i][j], false) * hp[2 * j];
        d2 += cvt8(r[i][j], true) * hp[2 * j + 1];
      }
      float d = d2[0] + d2[1];
      d += __shfl_xor(d, 1);
      d += __shfl_xor(d, 2);
      d += __shfl_xor(d, 4);
      if (i < 8) keep0 = (ch == i) ? d : keep0;
      else keep1 = (ch == i - 8) ? d : keep1;
    }
    float* po = (float*)(p.ws + OFF_PD) + (size_t)t * 1024 + s * 128;
    po[ch * 8 + grp] = keep0;
    po[(ch + 8) * 8 + grp] = keep1;
  } else {
    f32x2 acc[8];
#pragma unroll
    for (int q = 0; q < 8; ++q) acc[q] = f32x2{0.f, 0.f};
#pragma unroll
    for (int i = 0; i < 16; ++i) {
      const float wsc = __uint_as_float((unsigned)m.e[i] & 0xFFFF0000u);
      const f32x2 w2 = f32x2{wsc, wsc};
#pragma unroll
      for (int j = 0; j < 4; ++j) {
        acc[2 * j] += w2 * cvt8(r[i][j], false);
        acc[2 * j + 1] += w2 * cvt8(r[i][j], true);
      }
    }
    float v[16];
#pragma unroll
    for (int q = 0; q < 8; ++q) { v[2 * q] = acc[q][0]; v[2 * q + 1] = acc[q][1]; }
    float q8[8], q4[4], q2[2];
    {
      const bool hi = lane & 32;
#pragma unroll
      for (int i = 0; i < 8; ++i) {
        float send = hi ? v[i] : v[8 + i], keep = hi ? v[8 + i] : v[i];
        q8[i] = keep + __shfl_xor(send, 32);
      }
    }
    {
      const bool hi = lane & 16;
#pragma unroll
      for (int i = 0; i < 4; ++i) {
        float send = hi ? q8[i] : q8[4 + i], keep = hi ? q8[4 + i] : q8[i];
        q4[i] = keep + __shfl_xor(send, 16);
      }
    }
    {
      const bool hi = lane & 8;
#pragma unroll
      for (int i = 0; i < 2; ++i) {
        float send = hi ? q4[i] : q4[2 + i], keep = hi ? q4[2 + i] : q4[i];
        q2[i] = keep + __shfl_xor(send, 8);
      }
    }
    const int f = s * 128 + ch * 16 + 2 * grp;
    float* xr = p.out + (size_t)t * DM + f;
    const float2 xv = *(const float2*)xr;
    const float2 gv = *(const float2*)((const float*)(p.ws + OFF_MOD) + modidx(t) * 6144 + 5120 + f);
    *(float2*)xr = make_float2(xv.x + gv.x * q2[0], xv.y + gv.y * q2[1]);
  }
}
template <int MODE>
DI void sliced_pass(const Params& p) {
  const int s = blockIdx.x & 7, loc = blockIdx.x >> 3, nloc = gridDim.x >> 3;
  if (loc >= nloc) return;
  const int lane = threadIdx.x & 63, w = threadIdx.x >> 6, grp = lane >> 3, ch = lane & 7;
  const int stride = nloc * 4;
  SMeta mA, mB;
  u32x4 rA[16], rB[16];
  int t = loc * 4 + w;
  if (t < NTOK) {
    sl_meta<MODE>(p, t, s, grp, ch, mA);
    sl_rows<MODE>(p, s, ch, mA, rA);
  }
  if (t + stride < NTOK) sl_meta<MODE>(p, t + stride, s, grp, ch, mB);
#pragma unroll 1
  for (; t < NTOK; t += 2 * stride) {
    const int t1 = t + stride, t2 = t + 2 * stride, t3 = t + 3 * stride;
    if (t1 < NTOK) sl_rows<MODE>(p, s, ch, mB, rB);
    sl_compute<MODE>(p, t, s, lane, mA, rA);
    if (t2 < NTOK) sl_meta<MODE>(p, t2, s, grp, ch, mA);
    if (t1 < NTOK) {
      if (t2 < NTOK) sl_rows<MODE>(p, s, ch, mA, rA);
      sl_compute<MODE>(p, t1, s, lane, mB, rB);
      if (t3 < NTOK) sl_meta<MODE>(p, t3, s, grp, ch, mB);
    }
  }
}
DI void phase13(const Params& p) { sliced_pass<0>(p); }
DI void phase14(const Params& p) {
  char* ws = p.ws;
  const float* invU = (const float*)(ws + OFF_INVU);
  const float* invV = (const float*)(ws + OFF_INVV);
  const int* elist = (const int*)(ws + OFF_ELIST);
  float* glist = (float*)(ws + OFF_GLIST);
  const float* pd = (const float*)(ws + OFF_PD);
  const int lane = threadIdx.x & 63, w = threadIdx.x >> 6;
  for (int t = blockIdx.x * 4 + w; t < NTOK; t += gridDim.x * 4) {
#pragma unroll
    for (int hf_ = 0; hf_ < 2; ++hf_) {
      const int k = hf_ * 64 + lane;
      float d = 0.f;
#pragma unroll
      for (int s = 0; s < 8; ++s) d += pd[(size_t)t * 1024 + s * 128 + k];
      const int e = elist[(size_t)t * 128 + k];
      const float g = glist[(size_t)t * 128 + k];
      ((unsigned*)glist)[(size_t)t * 128 + k] = (pack2(0.f, g * geluf_(d * invU[e]) * invV[e]) & 0xFFFF0000u) | (unsigned)e;
    }
  }
}
DI void phase15(const Params& p) { sliced_pass<1>(p); }
DI void phase16(const Params& p) {
  const int lane = threadIdx.x & 63, w = threadIdx.x >> 6;
  for (int tok = blockIdx.x * 4 + w; tok < NTOK; tok += gridDim.x * 4) {
    float* xr = p.out + (size_t)tok * DM;
    float4 xv[4];
    float ss = 0.f;
#pragma unroll
    for (int i = 0; i < 4; ++i) {
      xv[i] = *(const float4*)(xr + (i * 64 + lane) * 4);
      ss += xv[i].x * xv[i].x + xv[i].y * xv[i].y + xv[i].z * xv[i].z + xv[i].w * xv[i].w;
    }
    ss = wsum(ss);
    const float rstd = rsqrtf(ss * (1.f / 1024.f) + 1e-6f);
#pragma unroll
    for (int i = 0; i < 4; ++i) {
      const int e = (i * 64 + lane) * 4;
      float4 nf = *(const float4*)(p.norm_final + e);
      *(float4*)(xr + e) = make_float4(xv[i].x * rstd * nf.x, xv[i].y * rstd * nf.y, xv[i].z * rstd * nf.z, xv[i].w * rstd * nf.w);
    }
  }
}

#define XB_TMO      128
#define XB_XCNT(j)  (256  + 64 * (j))
#define XB_XSUB(j)  (1280 + 64 * (j))
#define XB_XGEN(j)  (2304 + 64 * (j))
#define XB_TOP      3328
#define XB_TOPGEN   3392
#define XCD_BAR_WORDS 3456
#define XB_SPIN_CAP (1u << 22)
#define LAS __attribute__((address_space(3)))
DI unsigned xb_ld(unsigned* p) { return __hip_atomic_load(p, __ATOMIC_RELAXED, __HIP_MEMORY_SCOPE_AGENT); }
DI unsigned xb_add(unsigned* p, unsigned v) { return __hip_atomic_fetch_add(p, v, __ATOMIC_RELAXED, __HIP_MEMORY_SCOPE_AGENT); }
DI unsigned xb_xcc_id() { return (unsigned)__builtin_amdgcn_s_getreg((3 << 11) | 20) & 0xFu; }
#define XB_SPIN(cond, bar) do { unsigned _sp = 0; while (cond) { __builtin_amdgcn_s_sleep(1); \
    if ((++_sp & 255u) == 0u) { if (xb_ld(&(bar)[XB_TMO])) break; if (_sp > XB_SPIN_CAP) { atomicAdd(&(bar)[XB_TMO], 1u); break; } } } } while (0)
struct XcdBarrier { unsigned* bar; unsigned x; volatile LAS unsigned* st; };
DI XcdBarrier xcd_barrier_post(unsigned* bar, volatile LAS unsigned* st) {
  XcdBarrier b; b.bar = bar; b.x = xb_xcc_id(); b.st = st;
  if (threadIdx.x == 0) (void)xb_add(&bar[XB_XCNT(b.x)], 1u);
  return b;
}
DI void xcd_barrier_complete(unsigned* bar, unsigned x, unsigned& nloc, unsigned& nx) {
  const unsigned G = gridDim.x * gridDim.y * gridDim.z;
  unsigned sum, cnt, mine, sp = 0u;
  for (;;) {
    sum = 0u; cnt = 0u; mine = 0u;
#pragma unroll
    for (unsigned j = 0; j < 16; ++j) { const unsigned c = xb_ld(&bar[XB_XCNT(j)]); sum += c; cnt += (c > 0u) ? 1u : 0u; mine = (j == x) ? c : mine; }
    if (sum == G) break;
    __builtin_amdgcn_s_sleep(1);
    if ((++sp & 255u) == 0u) { if (xb_ld(&bar[XB_TMO])) break; if (sp > XB_SPIN_CAP) { atomicAdd(&bar[XB_TMO], 1u); break; } }
  }
  nloc = mine > 0u ? mine : 1u; nx = cnt > 0u ? cnt : 1u;
}
DI void xcd_barrier(const XcdBarrier& b) {
  asm volatile("s_waitcnt vmcnt(0)" ::: "memory");
  __syncthreads();
  if (threadIdx.x == 0) {
    unsigned* bar = b.bar;
    __builtin_amdgcn_s_waitcnt(0);
    unsigned nloc = b.st[0], nx = b.st[1];
    if (nloc == 0u) { xcd_barrier_complete(bar, b.x, nloc, nx); b.st[0] = nloc; b.st[1] = nx; }
    const unsigned old = xb_add(&bar[XB_XSUB(b.x)], 1u);
    const unsigned gen = old / nloc;
    if (old + 1u == (gen + 1u) * nloc) {
      __builtin_amdgcn_fence(__ATOMIC_RELEASE, "agent");
      asm volatile("s_waitcnt vmcnt(0)" ::: "memory");
      const unsigned og = xb_add(&bar[XB_TOP], 1u);
      const unsigned tg = og / nx;
      if (og + 1u == (tg + 1u) * nx) xb_add(&bar[XB_TOPGEN], 1u);
      else XB_SPIN(xb_ld(&bar[XB_TOPGEN]) == tg, bar);
      __builtin_amdgcn_fence(__ATOMIC_ACQUIRE, "agent");
      xb_add(&bar[XB_XGEN(b.x)], 1u);
      asm volatile("s_waitcnt vmcnt(0)" ::: "memory");
    } else {
      XB_SPIN(xb_ld(&bar[XB_XGEN(b.x)]) == gen, bar);
      __builtin_amdgcn_fence(__ATOMIC_ACQUIRE, "agent");
      asm volatile("s_waitcnt vmcnt(0)" ::: "memory");
    }
  }
  __syncthreads();
}

#ifdef ONLY_PHASE
#define RUNPH(n, call) if (ONLY_PHASE == n) { call; }
#else
#ifndef DUP_PHASE
#define DUP_PHASE -1
#endif
#define RUNPH(n, call) if (lo <= n && n < hi) { call; if (n == DUP_PHASE) { xcd_barrier(xb); call; } if (n + 1 < hi) xcd_barrier(xb); }
#endif
__global__ void __launch_bounds__(256, 2) mega(Params p, int lo, int hi) {
  __shared__ __attribute__((aligned(16))) char smem[SMEM_BYTES];
  __shared__ uint4 xb_words;
  cg::grid_group grid = cg::this_grid();
  if (lo < 0) grid.sync();
  if (threadIdx.x == 0) xb_words = make_uint4(0u, 0u, 0u, 0u);
  __syncthreads();
  XcdBarrier xb = xcd_barrier_post((unsigned*)(p.ws + OFF_BAR), (volatile LAS unsigned*)&xb_words);
  RUNPH(0, phase0(p, smem))
  RUNPH(1, phase1(p, smem))
  RUNPH(2, phase2(p, smem))
  RUNPH(3, phase3(p, smem))
  RUNPH(4, phase4(p))
  RUNPH(5, phase5(p, smem))
  RUNPH(6, phase6(p, smem))
  RUNPH(7, phase7(p, smem))
  RUNPH(8, phase8(p, smem))
  RUNPH(9, phase9(p, smem))
  RUNPH(10, phase10(p, smem))
  RUNPH(11, phase11(p, smem))
  RUNPH(12, phase12(p, smem))
  RUNPH(13, phase13(p))
  RUNPH(14, phase14(p))
  RUNPH(15, phase15(p))
  RUNPH(16, phase16(p))
}

extern "C" void kernel_launch(void* const* d_in, const int* in_sizes, int n_in, void* d_out, int out_size, void* d_ws,
                              size_t ws_size, hipStream_t stream) {
  static int grid_blocks = 0;
  if (!grid_blocks) {
    int dev = 0, cus = 0, per_cu = 0;
    hipGetDevice(&dev);
    hipDeviceGetAttribute(&cus, hipDeviceAttributeMultiprocessorCount, dev);
    hipOccupancyMaxActiveBlocksPerMultiprocessor(&per_cu, mega, 256, 0);
    if (per_cu > 2) per_cu = 2;
    if (per_cu < 1) per_cu = 1;
    grid_blocks = cus * per_cu;
  }
  Params p{};
  const float** pp = (const float**)&p;
  for (int i = 0; i < 29; ++i) pp[i] = (const float*)d_in[i];
  p.out = (float*)d_out;
  p.ws = (char*)d_ws;
#if N_LAUNCH_SPLIT
  for (int ph = 0; ph < NPHASE; ++ph) {
    hipLaunchKernelGGL(mega, dim3(grid_blocks), dim3(256), 0, stream, p, ph, ph + 1);
  }
#else
  hipMemsetAsync((char*)d_ws + OFF_MOD, 0, (OFF_BAR - OFF_MOD) + XCD_BAR_WORDS * sizeof(unsigned), stream);
  int lo = 0, hi = NPHASE;
  void* args[] = {&p, &lo, &hi};
  hipError_t e = hipLaunchCooperativeKernel((void*)mega, dim3(grid_blocks), dim3(256), args, 0, stream);
  if (e != hipSuccess) fprintf(stderr, "cooperative launch failed: %s (grid %d)\n", hipGetErrorString(e), grid_blocks);
#endif
}
```

```cpp
#include <hip/hip_runtime.h>
#include <hip/hip_cooperative_groups.h>
#include <cstdio>
namespace cg = cooperative_groups;

#define DI __device__ __forceinline__
typedef unsigned short bf16_t;
using bf16x8 = __attribute__((ext_vector_type(8))) short;
using f32x4 = __attribute__((ext_vector_type(4))) float;
using u32x4 = __attribute__((ext_vector_type(4))) unsigned;
using u32x2 = __attribute__((ext_vector_type(2))) unsigned;

#ifndef N_LAUNCH_SPLIT
#define N_LAUNCH_SPLIT 0
#endif

constexpr int NTOK = 20480, NPT = 4096, DM = 1024;
constexpr int NPHASE = 17;
constexpr size_t MiB = 1u << 20;
constexpr size_t OFF_WINT = 0, OFF_WUQT = 9 * MiB, OFF_WUKVT = 9 * MiB + 512 * 1024, OFF_WUPAT = 10 * MiB,
                 OFF_WUPBT = 11 * MiB, OFF_WOT = 12 * MiB, OFF_WCT = 14 * MiB, OFF_WPQB = 18 * MiB,
                 OFF_KEYSB = 22 * MiB, OFF_MOD = 22 * MiB + 512 * 1024, OFF_BAR = 22 * MiB + 768 * 1024, OFF_ROPE = 23 * MiB, A0 = 24 * MiB;
constexpr size_t OFF_PD = A0 + 104 * MiB, OFF_H1 = A0 + 0, OFF_CQ = A0 + 40 * MiB, OFF_CKVRAW = A0 + 50 * MiB, OFF_KRRAW = A0 + 60 * MiB,
                 OFF_RQ = A0 + 63 * MiB, OFF_RK = A0 + 83 * MiB, OFF_KT = A0 + 103 * MiB, OFF_VT = A0 + 123 * MiB,
                 OFF_SRG = A0 + 143 * MiB, OFF_CKVALL = A0 + 163 * MiB, OFF_KRALL = A0 + 169 * MiB,
                 OFF_UF = A0 + 171 * MiB, OFF_UB = A0 + 187 * MiB,
                 OFF_SF = A0 + 0, OFF_SB = A0 + 8 * MiB, OFF_RET = A0 + 16 * MiB,
                 OFF_Q = A0 + 63 * MiB, OFF_KN = A0 + 93 * MiB, OFF_VTA = A0 + 117 * MiB, OFF_ATTN = A0 + 141 * MiB,
                 OFF_M = A0 + 163 * MiB,
                 OFF_H2 = A0 + 56 * MiB, OFF_TABU = A0 + 36 * MiB, OFF_TABV = A0 + 0, OFF_INVU = A0 + 52 * MiB,
                 OFF_INVV = A0 + 53 * MiB, OFF_ELIST = A0 + 16 * MiB, OFF_GLIST = A0 + 26 * MiB, OFF_SCORES = A0 + 104 * MiB;
constexpr size_t OUT_CKV = 20971520, OUT_KR = 21495808, OUT_SF = 21626880, OUT_SB = 22675456;
constexpr int NKV = 24576;
constexpr int SMEM_BYTES = 73728;

struct Params {
  const float *x_prompt, *x_sample, *c, *cache_ckv, *cache_krope, *st_f, *st_b, *c_ctx, *w_mod, *b_mod, *norm_mix,
      *norm_ffn, *norm_final, *w_in, *q_norm, *kv_norm, *w_uq, *w_ukv, *lg_f, *lg_b, *ret_gn, *w_up_a, *w_up_b, *w_o,
      *peer_wq, *keys1, *keys2, *peer_u, *peer_v;
  float* out;
  char* ws;
};

DI unsigned f2bf(float x) {
  unsigned u = __float_as_uint(x);
  u += 0x7fffu + ((u >> 16) & 1u);
  return u >> 16;
}
DI float bf2f(unsigned b) { return __uint_as_float(b << 16); }
typedef __bf16 hbf16x2_t __attribute__((ext_vector_type(2)));
typedef float hf32x2_t __attribute__((ext_vector_type(2)));
DI unsigned pack2(float a, float b) {
  hf32x2_t f = {a, b};
  return __builtin_bit_cast(unsigned, __builtin_convertvector(f, hbf16x2_t));
}
DI float ex2(float x) { return __builtin_amdgcn_exp2f(x); }
DI float bflo(unsigned u) { return __uint_as_float(u << 16); }
DI float bfhi(unsigned u) { return __uint_as_float(u & 0xffff0000u); }
DI float wsum(float v) {
#pragma unroll
  for (int o = 32; o > 0; o >>= 1) v += __shfl_xor(v, o);
  return v;
}
DI float sigmoidf_(float x) { return 1.f / (1.f + __expf(-x)); }
DI float siluf_(float x) { return x / (1.f + __expf(-x)); }
DI float geluf_(float x) { return 0.5f * x * (1.f + tanhf(0.7978845608028654f * (x + 0.044715f * x * x * x))); }
DI const float* xrow(const Params& p, int tok) {
  return tok < NPT ? p.x_prompt + (size_t)tok * DM : p.x_sample + (size_t)(tok - NPT) * DM;
}
DI int modidx(int tok) { return tok < NPT ? 0 : 1 + ((tok - NPT) >> 11); }
DI int kvrow(int tok) {
  if (tok < NPT) return tok;
  int t = tok - NPT;
  return NPT + (t >> 11) * 2560 + (t & 2047);
}
DI void st_bf16x16(bf16_t* dst, const float (&v)[16]) {
  u32x4 a, b;
  a[0] = pack2(v[0], v[1]); a[1] = pack2(v[2], v[3]); a[2] = pack2(v[4], v[5]); a[3] = pack2(v[6], v[7]);
  b[0] = pack2(v[8], v[9]); b[1] = pack2(v[10], v[11]); b[2] = pack2(v[12], v[13]); b[3] = pack2(v[14], v[15]);
  *(u32x4*)dst = a;
  *(u32x4*)(dst + 8) = b;
}
DI void st_f32x16(float* dst, const float (&v)[16]) {
#pragma unroll
  for (int i = 0; i < 4; ++i) *(float4*)(dst + 4 * i) = make_float4(v[4 * i], v[4 * i + 1], v[4 * i + 2], v[4 * i + 3]);
}
DI void ld_bf16x16(const bf16_t* src, float (&v)[16]) {
  u32x4 a = *(const u32x4*)src, b = *(const u32x4*)(src + 8);
#pragma unroll
  for (int i = 0; i < 4; ++i) {
    v[2 * i] = bflo(a[i]); v[2 * i + 1] = bfhi(a[i]);
    v[8 + 2 * i] = bflo(b[i]); v[8 + 2 * i + 1] = bfhi(b[i]);
  }
}

constexpr int LDK = 64;
template <int SCALE>
DI void gemm_kloop(f32x4 (&acc)[4][4], const bf16_t* __restrict__ A, int lda, const bf16_t* __restrict__ B, int ldb,
                   int K, char* smem, float sc_a, float sc_b) {
  bf16_t* As = (bf16_t*)smem;
  bf16_t* Bs = As + 128 * LDK;
  const int tid = threadIdx.x, lane = tid & 63, w = tid >> 6, wm = w >> 1, wn = w & 1, l15 = lane & 15, g = lane >> 4;
  u32x4 ra[4], rb[4];
  int arow[4], kc[4], ldsa[4], ldsb[4];
#pragma unroll
  for (int i = 0; i < 4; ++i) {
    int c = tid + 256 * i;
    int r = c >> 3;
    kc[i] = (c & 7) * 8;
    arow[i] = r;
    int rr = r & 63;
    int rho = (r & 64) | (((rr >> 2) & 3) << 4) | ((rr >> 4) << 2) | (rr & 3);
    ldsa[i] = rho * LDK + (((c & 7) ^ ((rho >> 1) & 7)) * 8);
    ldsb[i] = r * LDK + (((c & 7) ^ ((r >> 1) & 7)) * 8);
  }
#pragma unroll
  for (int i = 0; i < 4; ++i) {
    ra[i] = *(const u32x4*)(A + (size_t)arow[i] * lda + kc[i]);
    rb[i] = *(const u32x4*)(B + (size_t)arow[i] * ldb + kc[i]);
  }
  __syncthreads();
#pragma unroll
  for (int i = 0; i < 4; ++i) {
    *(u32x4*)(As + ldsa[i]) = ra[i];
    *(u32x4*)(Bs + ldsb[i]) = rb[i];
  }
  if (64 < K) {
#pragma unroll
    for (int i = 0; i < 4; ++i) {
      ra[i] = *(const u32x4*)(A + (size_t)arow[i] * lda + 64 + kc[i]);
      rb[i] = *(const u32x4*)(B + (size_t)arow[i] * ldb + 64 + kc[i]);
    }
  }
  __syncthreads();
  int buf = 0;
  for (int k0 = 0; k0 < K; k0 += 64, buf ^= 1) {
    const bf16_t* Ac = As + buf * (256 * LDK);
    const bf16_t* Bc = Bs + buf * (256 * LDK);
#pragma unroll
    for (int ks = 0; ks < 2; ++ks) {
      bf16x8 af[4], bfr[4];
#pragma unroll
      for (int f = 0; f < 4; ++f)
        af[f] = *(const bf16x8*)(Ac + (wm * 64 + f * 16 + l15) * LDK + (((ks * 4 + g) ^ (l15 >> 1)) * 8));
#pragma unroll
      for (int c = 0; c < 4; ++c)
        bfr[c] = *(const bf16x8*)(Bc + (wn * 64 + c * 16 + l15) * LDK + (((ks * 4 + g) ^ (l15 >> 1)) * 8));
      if (SCALE) {
        float fac[8];
#pragma unroll
        for (int i = 0; i < 8; ++i) fac[i] = ex2(sc_a + sc_b * (float)(k0 + ks * 32 + g * 8 + i));
#pragma unroll
        for (int f = 0; f < 4; ++f) {
          u32x4 u = __builtin_bit_cast(u32x4, af[f]);
#pragma unroll
          for (int i = 0; i < 4; ++i) u[i] = pack2(bflo(u[i]) * fac[2 * i], bfhi(u[i]) * fac[2 * i + 1]);
          af[f] = __builtin_bit_cast(bf16x8, u);
        }
      }
#pragma unroll
      for (int f = 0; f < 4; ++f)
#pragma unroll
        for (int c = 0; c < 4; ++c) acc[f][c] = __builtin_amdgcn_mfma_f32_16x16x32_bf16(af[f], bfr[c], acc[f][c], 0, 0, 0);
    }
    if (k0 + 64 < K) {
      bf16_t* An = As + (buf ^ 1) * (256 * LDK);
      bf16_t* Bn = Bs + (buf ^ 1) * (256 * LDK);
#pragma unroll
      for (int i = 0; i < 4; ++i) {
        *(u32x4*)(An + ldsa[i]) = ra[i];
        *(u32x4*)(Bn + ldsb[i]) = rb[i];
      }
      if (k0 + 128 < K) {
#pragma unroll
        for (int i = 0; i < 4; ++i) {
          ra[i] = *(const u32x4*)(A + (size_t)arow[i] * lda + k0 + 128 + kc[i]);
          rb[i] = *(const u32x4*)(B + (size_t)arow[i] * ldb + k0 + 128 + kc[i]);
        }
      }
      __syncthreads();
    }
  }
}
DI void acc_zero(f32x4 (&acc)[4][4]) {
#pragma unroll
  for (int f = 0; f < 4; ++f)
#pragma unroll
    for (int c = 0; c < 4; ++c) acc[f][c] = f32x4{0.f, 0.f, 0.f, 0.f};
}
template <class F>
DI void epilogue(const f32x4 (&acc)[4][4], F&& epi) {
  const int tid = threadIdx.x, lane = tid & 63, w = tid >> 6, wm = w >> 1, wn = w & 1, l15 = lane & 15, g = lane >> 4;
#pragma unroll
  for (int c = 0; c < 4; ++c) {
    float v[16];
#pragma unroll
    for (int f = 0; f < 4; ++f)
#pragma unroll
      for (int j = 0; j < 4; ++j) v[f * 4 + j] = acc[f][c][j];
    epi(wm * 64 + 16 * g, wn * 64 + c * 16 + l15, v);
  }
}
DI bool tile_map(int it, int Ft, int Tt, int fsplit, int& ft, int& tt) {
  const int bid = blockIdx.x, nb = gridDim.x;
  int xcd = bid & 7, loc = bid >> 3, nloc = nb >> 3;
  if (loc >= nloc) return false;
  int fg = xcd % fsplit, tg = xcd / fsplit, tsplit = 8 / fsplit;
  int Fg = Ft / fsplit, Tg = Tt / tsplit;
  int i = loc + it * nloc;
  if (i >= Fg * Tg) return false;
  ft = fg * Fg + i % Fg;
  tt = tg * Tg + i / Fg;
  return true;
}
DI int vbid() {
  const int bid = blockIdx.x, nb = gridDim.x;
  if (nb & 7) return bid;
  return (bid & 7) * (nb >> 3) + (bid >> 3);
}

DI int colmap(int mode, int np) {
  if (mode == 1) return np < 416 ? np : (np < 512 ? -1 : np - 96);
  if (mode == 2) return np < 512 ? ((np >> 6) * 128 + (np & 63)) : (((np - 512) >> 6) * 128 + 64 + ((np - 512) & 63));
  return np;
}
DI void tconv_tile(const float* __restrict__ src, int ldsrc, bf16_t* __restrict__ dst, int K, int kt, int nt, int mode,
                   char* smem) {
  float* lds = (float*)smem;
  const int tid = threadIdx.x;
  {
    int col = tid & 63, rq = tid >> 6;
    int n = colmap(mode, nt * 64 + col);
#pragma unroll 4
    for (int r = 0; r < 16; ++r) {
      int kl = r * 4 + rq;
      float v = n >= 0 ? src[(size_t)(kt * 64 + kl) * ldsrc + n] : 0.f;
      lds[kl * 65 + col] = v;
    }
  }
  __syncthreads();
  {
    int nl = tid >> 2, kq = (tid & 3) * 16;
    float v[16];
#pragma unroll
    for (int i = 0; i < 16; ++i) v[i] = lds[(kq + i) * 65 + nl];
    st_bf16x16(dst + (size_t)(nt * 64 + nl) * K + kt * 64 + kq, v);
  }
  __syncthreads();
}
DI void mod_item(const Params& p, int item, char* smem) {
  float* sil = (float*)smem;
  const int tid = threadIdx.x;
  const int cg_ = item >> 2, slab = item & 3, kbase = slab * 256;
  for (int i = tid; i < 9 * 256; i += 256) {
    int j = i >> 8, k = kbase + (i & 255);
    float cv = j == 0 ? p.c_ctx[k] : p.c[(j - 1) * 1024 + k];
    sil[i] = siluf_(cv);
  }
  __syncthreads();
  const int kq = tid >> 6, nn = tid & 63, n0 = cg_ * 64;
  float acc[9];
#pragma unroll
  for (int j = 0; j < 9; ++j) acc[j] = 0.f;
#pragma unroll 1
  for (int i0 = 0; i0 < 64; i0 += 16) {
    float wv[16];
#pragma unroll
    for (int i = 0; i < 16; ++i) wv[i] = p.w_mod[(size_t)(kbase + kq + 4 * (i0 + i)) * 6144 + n0 + nn];
#pragma unroll
    for (int i = 0; i < 16; ++i)
#pragma unroll
      for (int j = 0; j < 9; ++j) acc[j] += sil[j * 256 + kq + 4 * (i0 + i)] * wv[i];
  }
  __syncthreads();
  float* part = (float*)smem + 9 * 256;
#pragma unroll
  for (int j = 0; j < 9; ++j) part[(kq * 9 + j) * 64 + nn] = acc[j];
  __syncthreads();
  float* mod = (float*)(p.ws + OFF_MOD);
  for (int i = tid; i < 9 * 64; i += 256) {
    int j = i >> 6, n = i & 63;
    float s = part[(0 * 9 + j) * 64 + n] + part[(1 * 9 + j) * 64 + n] + part[(2 * 9 + j) * 64 + n] + part[(3 * 9 + j) * 64 + n];
    if (slab == 0) s += p.b_mod[n0 + n];
    atomicAdd(mod + j * 6144 + n0 + n, s);
  }
  __syncthreads();
}
DI void conv_flat(const float* __restrict__ src, bf16_t* __restrict__ dst, size_t n) {
  size_t i = ((size_t)blockIdx.x * 256 + threadIdx.x) * 8;
  const size_t stride = (size_t)gridDim.x * 256 * 8;
  for (; i < n; i += stride) {
    float4 a = *(const float4*)(src + i), b = *(const float4*)(src + i + 4);
    u32x4 o;
    o[0] = pack2(a.x, a.y); o[1] = pack2(a.z, a.w); o[2] = pack2(b.x, b.y); o[3] = pack2(b.z, b.w);
    *(u32x4*)(dst + i) = o;
  }
}
DI void phase0(const Params& p, char* smem) {
  const int bid = blockIdx.x, nb = gridDim.x;
  char* ws = p.ws;
  const int n_mod = 384;
  const int t_in = 16 * 72, t_uq = 4 * 12, t_ukv = 2 * 16, t_upa = 8 * 16, t_upb = 8 * 16, t_o = 16 * 16;
  const int total = n_mod + t_in + t_uq + t_ukv + t_upa + t_upb + t_o;
  for (int it = bid; it < total; it += nb) {
    int i = it;
    if (i < n_mod) { mod_item(p, i, smem); continue; }
    i -= n_mod;
    if (i < t_in) { tconv_tile(p.w_in, 4512, (bf16_t*)(ws + OFF_WINT), 1024, i / 72, i % 72, 1, smem); continue; }
    i -= t_in;
    if (i < t_uq) { tconv_tile(p.w_uq, 768, (bf16_t*)(ws + OFF_WUQT), 256, i / 12, i % 12, 0, smem); continue; }
    i -= t_uq;
    if (i < t_ukv) { tconv_tile(p.w_ukv, 1024, (bf16_t*)(ws + OFF_WUKVT), 128, i / 16, i % 16, 2, smem); continue; }
    i -= t_ukv;
    if (i < t_upa) { tconv_tile(p.w_up_a, 1024, (bf16_t*)(ws + OFF_WUPAT), 512, i / 16, i % 16, 0, smem); continue; }
    i -= t_upa;
    if (i < t_upb) { tconv_tile(p.w_up_b, 1024, (bf16_t*)(ws + OFF_WUPBT), 512, i / 16, i % 16, 0, smem); continue; }
    i -= t_upb;
    tconv_tile(p.w_o, 1024, (bf16_t*)(ws + OFF_WOT), 1024, i / 16, i % 16, 0, smem);
  }
  conv_flat(p.peer_wq, (bf16_t*)(ws + OFF_WPQB), (size_t)1024 * 2048);
  {
    size_t i = ((size_t)bid * 256 + threadIdx.x) * 8;
    const size_t stride = (size_t)nb * 256 * 8;
    bf16_t* kb = (bf16_t*)(ws + OFF_KEYSB);
    for (; i < (size_t)2 * 131072; i += stride) {
      int half = i >= 131072;
      size_t s = i - (size_t)half * 131072;
      int h = (int)(s >> 14);
      size_t r = s & 16383;
      const float* src = (half ? p.keys2 : p.keys1) + s;
      float4 a = *(const float4*)(src), b = *(const float4*)(src + 4);
      u32x4 o;
      o[0] = pack2(a.x, a.y); o[1] = pack2(a.z, a.w); o[2] = pack2(b.x, b.y); o[3] = pack2(b.z, b.w);
      *(u32x4*)(kb + ((size_t)(h * 2 + half) << 14) + r) = o;
    }
  }
  {
    float2* rope = (float2*)(ws + OFF_ROPE);
    for (int idx = bid * 256 + threadIdx.x; idx < 2048 * 16; idx += nb * 256) {
      const int t = idx >> 4, a = idx & 15;
      const float pos = (a < 8) ? (float)(t >> 6) : (float)(t & 63);
      const float fr = exp2f(-(float)(a & 7) * 1.6609640474436813f);
      float sn, cs;
      sincosf(pos * fr, &sn, &cs);
      rope[idx] = make_float2(cs, sn);
    }
  }
}

DI void rows_norm_mod(const Params& p, const float* nw, int sh_off, int sc_off, bool from_out, bf16_t* dst) {
  const int lane = threadIdx.x & 63, w = threadIdx.x >> 6;
  const float* mod = (const float*)(p.ws + OFF_MOD);
  for (int tok = blockIdx.x * 4 + w; tok < NTOK; tok += gridDim.x * 4) {
    const float* xr = from_out ? p.out + (size_t)tok * DM : xrow(p, tok);
    const float* mj = mod + modidx(tok) * 6144;
    float4 xv[4];
    float ss = 0.f;
#pragma unroll
    for (int i = 0; i < 4; ++i) {
      xv[i] = *(const float4*)(xr + (i * 64 + lane) * 4);
      ss += xv[i].x * xv[i].x + xv[i].y * xv[i].y + xv[i].z * xv[i].z + xv[i].w * xv[i].w;
    }
    ss = wsum(ss);
    float rstd = rsqrtf(ss * (1.f / 1024.f) + 1e-6f);
#pragma unroll
    for (int i = 0; i < 4; ++i) {
      int e = (i * 64 + lane) * 4;
      float4 nv = *(const float4*)(nw + e), sh = *(const float4*)(mj + sh_off + e), sc = *(const float4*)(mj + sc_off + e);
      float h0 = (xv[i].x * rstd) * nv.x * (1.f + sc.x) + sh.x;
      float h1 = (xv[i].y * rstd) * nv.y * (1.f + sc.y) + sh.y;
      float h2 = (xv[i].z * rstd) * nv.z * (1.f + sc.z) + sh.z;
      float h3 = (xv[i].w * rstd) * nv.w * (1.f + sc.w) + sh.w;
      u32x2 o;
      o[0] = pack2(h0, h1); o[1] = pack2(h2, h3);
      *(u32x2*)(dst + (size_t)tok * DM + e) = o;
    }
  }
}
DI void phase1(const Params& p, char* smem) {
  rows_norm_mod(p, p.norm_mix, 0, 1024, false, (bf16_t*)(p.ws + OFF_H1));
  const bf16_t* wpq = (const bf16_t*)(p.ws + OFF_WPQB);
  const bf16_t* kb = (const bf16_t*)(p.ws + OFF_KEYSB);
  bf16_t* wct = (bf16_t*)(p.ws + OFF_WCT);
  for (int it = blockIdx.x; it < 128; it += gridDim.x) {
    int hh = it >> 3, mt = it & 7;
    f32x4 acc[4][4];
    acc_zero(acc);
    gemm_kloop<0>(acc, wpq + (size_t)(mt * 128) * 2048 + hh * 128, 2048, kb + (size_t)hh * 16384, 128, 128, smem, 0.f, 0.f);
    epilogue(acc, [&](int m, int n, float (&v)[16]) { st_bf16x16(wct + (size_t)(hh * 128 + n) * 1024 + mt * 128 + m, v); });
  }
}

DI void phase2(const Params& p, char* smem) {
  char* ws = p.ws;
  const bf16_t* winT = (const bf16_t*)(ws + OFF_WINT);
  const bf16_t* h1 = (const bf16_t*)(ws + OFF_H1);
  bf16_t* cq = (bf16_t*)(ws + OFF_CQ);
  float* ckvraw = (float*)(ws + OFF_CKVRAW);
  float* krraw = (float*)(ws + OFF_KRRAW);
  bf16_t* rq = (bf16_t*)(ws + OFF_RQ);
  bf16_t* rk = (bf16_t*)(ws + OFF_RK);
  bf16_t* kT = (bf16_t*)(ws + OFF_KT);
  bf16_t* vT = (bf16_t*)(ws + OFF_VT);
  bf16_t* srg = (bf16_t*)(ws + OFF_SRG);
  bf16_t* sga = (bf16_t*)p.out;
  bf16_t* sgb = sga + (size_t)NTOK * 1024;
  for (int it = 0;; ++it) {
    int ft, tt;
    if (!tile_map(it, 36, 160, 4, ft, tt)) break;
    f32x4 acc[4][4];
    acc_zero(acc);
    const bf16_t* W = winT + (size_t)ft * 128 * 1024;
    const bf16_t* H = h1 + (size_t)tt * 128 * 1024;
    const int tok0 = tt * 128, f0 = ft * 128;
    if (ft >= 8 && ft < 16) {
      gemm_kloop<0>(acc, H, 1024, W, 1024, 1024, smem, 0.f, 0.f);
      if (ft < 12) {
        epilogue(acc, [&](int m, int n, float (&v)[16]) {
          int feat = f0 - 1024 + n, tok = tok0 + m;
#pragma unroll
          for (int i = 0; i < 16; ++i) v[i] *= 0.08838834764831845f;
          st_bf16x16(kT + (size_t)feat * NTOK + tok, v);
#pragma unroll
          for (int i = 0; i < 16; ++i) rk[(size_t)(tok + i) * 512 + feat] = (bf16_t)f2bf(v[i]);
        });
      } else {
        epilogue(acc, [&](int m, int n, float (&v)[16]) {
          int feat = f0 - 1536 + n, tok = tok0 + m;
          st_bf16x16(vT + (size_t)feat * NTOK + tok, v);
        });
      }
    } else {
      gemm_kloop<0>(acc, W, 1024, H, 1024, 1024, smem, 0.f, 0.f);
      if (ft < 2) {
        epilogue(acc, [&](int m, int n, float (&v)[16]) { st_bf16x16(cq + (size_t)(tok0 + n) * 256 + f0 + m, v); });
      } else if (ft == 2) {
        epilogue(acc, [&](int m, int n, float (&v)[16]) { st_f32x16(ckvraw + (size_t)(tok0 + n) * 128 + m, v); });
      } else if (ft == 3) {
        epilogue(acc, [&](int m, int n, float (&v)[16]) {
          if (m < 32) st_f32x16(krraw + (size_t)(tok0 + n) * 32 + m, v);
        });
      } else if (ft < 8) {
        epilogue(acc, [&](int m, int n, float (&v)[16]) { st_bf16x16(rq + (size_t)(tok0 + n) * 512 + f0 - 512 + m, v); });
      } else if (ft < 20) {
        epilogue(acc, [&](int m, int n, float (&v)[16]) {
#pragma unroll
          for (int i = 0; i < 16; ++i) v[i] = siluf_(v[i]);
          st_bf16x16(srg + (size_t)(tok0 + n) * 512 + f0 - 2048 + m, v);
        });
      } else if (ft < 28) {
        epilogue(acc, [&](int m, int n, float (&v)[16]) {
#pragma unroll
          for (int i = 0; i < 16; ++i) v[i] = sigmoidf_(v[i]);
          st_bf16x16(sga + (size_t)(tok0 + n) * 1024 + f0 - 2560 + m, v);
        });
      } else {
        epilogue(acc, [&](int m, int n, float (&v)[16]) {
#pragma unroll
          for (int i = 0; i < 16; ++i) v[i] = sigmoidf_(v[i]);
          st_bf16x16(sgb + (size_t)(tok0 + n) * 1024 + f0 - 3584 + m, v);
        });
      }
    }
  }
}

DI float log2gamma(float logit) { return -log1pf(expf(-logit)) * 1.4426950408889634f; }
DI void phase3(const Params& p, char* smem) {
  char* ws = p.ws;
  const int lane = threadIdx.x & 63, w = threadIdx.x >> 6;
  bf16_t* cq = (bf16_t*)(ws + OFF_CQ);
  const float* ckvraw = (const float*)(ws + OFF_CKVRAW);
  const float* krraw = (const float*)(ws + OFF_KRRAW);
  bf16_t* ckvall = (bf16_t*)(ws + OFF_CKVALL);
  bf16_t* krall = (bf16_t*)(ws + OFF_KRALL);
  for (int r = blockIdx.x * 4 + w; r < NTOK + 4096; r += gridDim.x * 4) {
    if (r < NTOK) {
      const int tok = r;
      {
        u32x2 u = *(const u32x2*)(cq + (size_t)tok * 256 + lane * 4);
        float a0 = bflo(u[0]), a1 = bfhi(u[0]), a2 = bflo(u[1]), a3 = bfhi(u[1]);
        float ss = wsum(a0 * a0 + a1 * a1 + a2 * a2 + a3 * a3);
        float rstd = rsqrtf(ss * (1.f / 256.f) + 1e-6f);
        float4 nq = *(const float4*)(p.q_norm + lane * 4);
        u32x2 o;
        o[0] = pack2(a0 * rstd * nq.x, a1 * rstd * nq.y);
        o[1] = pack2(a2 * rstd * nq.z, a3 * rstd * nq.w);
        *(u32x2*)(cq + (size_t)tok * 256 + lane * 4) = o;
      }
      const int row = kvrow(tok);
      {
        float2 v = *(const float2*)(ckvraw + (size_t)tok * 128 + lane * 2);
        float ss = wsum(v.x * v.x + v.y * v.y);
        float rstd = rsqrtf(ss * (1.f / 128.f) + 1e-6f);
        float2 nk = *(const float2*)(p.kv_norm + lane * 2);
        float o0 = v.x * rstd * nk.x, o1 = v.y * rstd * nk.y;
        if (tok < NPT) *(float2*)(p.out + OUT_CKV + (size_t)tok * 128 + lane * 2) = make_float2(o0, o1);
        *(unsigned*)(ckvall + (size_t)row * 128 + lane * 2) = pack2(o0, o1);
      }
      if (lane < 32) {
        float own = krraw[(size_t)tok * 32 + lane];
        float o = own;
        if (tok < NPT) {
          p.out[OUT_KR + (size_t)tok * 32 + lane] = own;
        } else {
          float partner = krraw[(size_t)tok * 32 + (lane ^ 16)];
          int t = (tok - NPT) & 2047;
          const float2 csn = ((const float2*)(ws + OFF_ROPE))[t * 16 + (lane & 15)];
          const float cs = csn.x, sn = csn.y;
          o = lane < 16 ? own * cs - partner * sn : partner * sn + own * cs;
        }
        krall[(size_t)row * 32 + lane] = (bf16_t)f2bf(o);
      }
    } else {
      const int cr = r - NTOK;
      const int b = cr >> 9, pos = cr & 511;
      const int row = NPT + b * 2560 + 2048 + pos;
      float2 v = *(const float2*)(p.cache_ckv + (size_t)cr * 128 + lane * 2);
      *(unsigned*)(ckvall + (size_t)row * 128 + lane * 2) = pack2(v.x, v.y);
      if (lane < 32) krall[(size_t)row * 32 + lane] = (bf16_t)f2bf(p.cache_krope[(size_t)cr * 32 + lane]);
    }
  }
  const bf16_t* kT = (const bf16_t*)(ws + OFF_KT);
  const bf16_t* vT = (const bf16_t*)(ws + OFF_VT);
  float* Uf = (float*)(ws + OFF_UF);
  float* Ub = (float*)(ws + OFF_UB);
  for (int it = blockIdx.x; it < 320; it += gridDim.x) {
    const int blk = it >> 2, h = it & 3;
    const float l2f = log2gamma(p.lg_f[h]), l2b = log2gamma(p.lg_b[h]);
    const bf16_t* Kp = kT + (size_t)(h * 128) * NTOK + blk * 256;
    const bf16_t* Vp = vT + (size_t)(h * 128) * NTOK + blk * 256;
#pragma unroll 1
    for (int dir = 0; dir < 2; ++dir) {
      const float sa = dir ? 0.f : l2f * 255.f, sb = dir ? l2b : -l2f;
      f32x4 acc[4][4];
      acc_zero(acc);
      if (blk < 16) {
        gemm_kloop<1>(acc, Vp, NTOK, Kp, NTOK, 256, smem, sa, sb);
        float* dst = p.out + (dir ? OUT_SB : OUT_SF) + (size_t)(blk * 4 + h) * 16384;
        epilogue(acc, [&](int m, int n, float (&v)[16]) { st_f32x16(dst + n * 128 + m, v); });
      } else {
        gemm_kloop<1>(acc, Kp, NTOK, Vp, NTOK, 256, smem, sa, sb);
        float* dst = (dir ? Ub : Uf) + (size_t)((blk - 16) * 4 + h) * 16384;
        epilogue(acc, [&](int m, int n, float (&v)[16]) { st_f32x16(dst + n * 128 + m, v); });
      }
    }
  }
}

DI void phase4(const Params& p) {
  char* ws = p.ws;
  const float* Uf = (const float*)(ws + OFF_UF);
  const float* Ub = (const float*)(ws + OFF_UB);
  bf16_t* Sf = (bf16_t*)(ws + OFF_SF);
  bf16_t* Sb = (bf16_t*)(ws + OFF_SB);
  for (int idx = blockIdx.x * 256 + threadIdx.x; idx < (1 << 20); idx += gridDim.x * 256) {
    int d = idx & 127, e = (idx >> 7) & 127, h = (idx >> 14) & 3, b = (idx >> 16) & 7, dir = idx >> 19;
    size_t eo = (size_t)e * 128 + d;
    if (dir == 0) {
      float cf = exp2f(log2gamma(p.lg_f[h]) * 256.f);
      float S = p.st_f[(size_t)(b * 4 + h) * 16384 + d * 128 + e];
#pragma unroll
      for (int blk = 0; blk < 8; ++blk) {
        size_t o = (size_t)((b * 8 + blk) * 4 + h) * 16384 + eo;
        Sf[o] = (bf16_t)f2bf(S);
        S = cf * S + Uf[o];
      }
    } else {
      float cb = exp2f(log2gamma(p.lg_b[h]) * 256.f);
      float S = p.st_b[(size_t)(b * 4 + h) * 16384 + d * 128 + e];
#pragma unroll
      for (int blk = 7; blk >= 0; --blk) {
        size_t o = (size_t)((b * 8 + blk) * 4 + h) * 16384 + eo;
        Sb[o] = (bf16_t)f2bf(S);
        S = cb * S + Ub[o];
      }
    }
  }
}

DI bf16x8 scale_frag(bf16x8 q, float s) {
  u32x4 u = __builtin_bit_cast(u32x4, q);
#pragma unroll
  for (int i = 0; i < 4; ++i) u[i] = pack2(bflo(u[i]) * s, bfhi(u[i]) * s);
  return __builtin_bit_cast(bf16x8, u);
}
constexpr int NQT = 1;
DI void phase5(const Params& p, char* smem) {
  char* ws = p.ws;
  const bf16_t* rq = (const bf16_t*)(ws + OFF_RQ);
  const bf16_t* rk = (const bf16_t*)(ws + OFF_RK);
  const bf16_t* vT = (const bf16_t*)(ws + OFF_VT);
  const bf16_t* srg = (const bf16_t*)(ws + OFF_SRG);
  const bf16_t* Sf = (const bf16_t*)(ws + OFF_SF);
  const bf16_t* Sb = (const bf16_t*)(ws + OFF_SB);
  bf16_t* ret = (bf16_t*)(ws + OFF_RET);
  bf16_t* Ks = (bf16_t*)smem;
  bf16_t* Vs = Ks + 64 * 144;
  const int tid = threadIdx.x, lane = tid & 63, w = tid >> 6, l15 = lane & 15, g = lane >> 4;
  for (int item = vbid(); item < 640 * (2 / NQT); item += gridDim.x) {
    const int qb = item >> 2, h = item & 3, blk = (qb * NQT) >> 2;
    const float l2f = log2gamma(p.lg_f[h]), l2b = log2gamma(p.lg_b[h]);
    const int tokw = qb * (64 * NQT) + w * (16 * NQT);
    bf16x8 Q[NQT][4];
#pragma unroll
    for (int qt = 0; qt < NQT; ++qt)
#pragma unroll
      for (int ks = 0; ks < 4; ++ks)
        Q[qt][ks] = *(const bf16x8*)(rq + (size_t)(tokw + qt * 16 + l15) * 512 + h * 128 + ks * 32 + g * 8);
    f32x4 o[8][NQT];
#pragma unroll
    for (int et = 0; et < 8; ++et)
#pragma unroll
      for (int qt = 0; qt < NQT; ++qt) o[et][qt] = f32x4{0.f, 0.f, 0.f, 0.f};
#pragma unroll 1
    for (int kt = 0; kt < 4; ++kt) {
      const int key0 = blk * 256 + kt * 64;
      __syncthreads();
#pragma unroll
      for (int i = 0; i < 4; ++i) {
        int c = tid + 256 * i;
        int r = c >> 4, cc = (c & 15) * 8;
        *(u32x4*)(Ks + r * 144 + cc) = *(const u32x4*)(rk + (size_t)(key0 + r) * 512 + h * 128 + cc);
        int e = c >> 3, c2 = (c & 7) * 8;
        *(u32x4*)(Vs + e * 72 + c2) = *(const u32x4*)(vT + (size_t)(h * 128 + e) * NTOK + key0 + c2);
      }
      __syncthreads();
      bf16x8 P[NQT][2];
#pragma unroll
      for (int qt = 0; qt < NQT; ++qt) {
        f32x4 s[4];
#pragma unroll
        for (int kk = 0; kk < 4; ++kk) s[kk] = f32x4{0.f, 0.f, 0.f, 0.f};
#pragma unroll
        for (int ks = 0; ks < 4; ++ks) {
#pragma unroll
          for (int kk = 0; kk < 4; ++kk) {
            bf16x8 a = *(const bf16x8*)(Ks + (kk * 16 + l15) * 144 + ks * 32 + g * 8);
            s[kk] = __builtin_amdgcn_mfma_f32_16x16x32_bf16(a, Q[qt][ks], s[kk], 0, 0, 0);
          }
        }
        const int iq = (tokw + qt * 16 + l15) & 255;
#pragma unroll
        for (int kk = 0; kk < 4; ++kk) {
#pragma unroll
          for (int j = 0; j < 4; ++j) {
            int jk = kt * 64 + kk * 16 + 4 * g + j;
            int diff = iq - jk;
            float dm = diff > 0 ? ex2(l2f * (float)diff) : (diff < 0 ? ex2(l2b * (float)(-diff)) : 2.f);
            s[kk][j] *= dm;
          }
        }
#pragma unroll
        for (int k2 = 0; k2 < 2; ++k2) {
          u32x4 u;
          u[0] = pack2(s[2 * k2][0], s[2 * k2][1]);
          u[1] = pack2(s[2 * k2][2], s[2 * k2][3]);
          u[2] = pack2(s[2 * k2 + 1][0], s[2 * k2 + 1][1]);
          u[3] = pack2(s[2 * k2 + 1][2], s[2 * k2 + 1][3]);
          P[qt][k2] = __builtin_bit_cast(bf16x8, u);
        }
      }
#pragma unroll
      for (int k2 = 0; k2 < 2; ++k2) {
#pragma unroll
        for (int et = 0; et < 8; ++et) {
          u32x2 lo = *(const u32x2*)(Vs + (et * 16 + l15) * 72 + k2 * 32 + 4 * g);
          u32x2 hi = *(const u32x2*)(Vs + (et * 16 + l15) * 72 + k2 * 32 + 16 + 4 * g);
          u32x4 u;
          u[0] = lo[0]; u[1] = lo[1]; u[2] = hi[0]; u[3] = hi[1];
          bf16x8 a = __builtin_bit_cast(bf16x8, u);
#pragma unroll
          for (int qt = 0; qt < NQT; ++qt) o[et][qt] = __builtin_amdgcn_mfma_f32_16x16x32_bf16(a, P[qt][k2], o[et][qt], 0, 0, 0);
        }
      }
    }
    if (blk >= 16) {
#pragma unroll 1
      for (int dir = 0; dir < 2; ++dir) {
        const bf16_t* S = (dir ? Sb : Sf) + (size_t)((blk - 16) * 4 + h) * 16384;
        float dq[NQT];
#pragma unroll
        for (int qt = 0; qt < NQT; ++qt) {
          int iq = (tokw + qt * 16 + l15) & 255;
          dq[qt] = dir ? exp2f(l2b * (float)(256 - iq)) : exp2f(l2f * (float)(iq + 1));
        }
#pragma unroll
        for (int ks = 0; ks < 4; ++ks) {
          bf16x8 qs[NQT];
#pragma unroll
          for (int qt = 0; qt < NQT; ++qt) qs[qt] = scale_frag(Q[qt][ks], dq[qt]);
#pragma unroll
          for (int et = 0; et < 8; ++et) {
            bf16x8 a = *(const bf16x8*)(S + (size_t)(et * 16 + l15) * 128 + ks * 32 + g * 8);
#pragma unroll
            for (int qt = 0; qt < NQT; ++qt) o[et][qt] = __builtin_amdgcn_mfma_f32_16x16x32_bf16(a, qs[qt], o[et][qt], 0, 0, 0);
          }
        }
      }
    }
#pragma unroll
    for (int qt = 0; qt < NQT; ++qt) {
      const int tok = tokw + qt * 16 + l15;
      float s1 = 0.f;
#pragma unroll
      for (int et = 0; et < 8; ++et)
#pragma unroll
        for (int j = 0; j < 4; ++j) s1 += o[et][qt][j];
      s1 += __shfl_xor(s1, 16);
      s1 += __shfl_xor(s1, 32);
      const float mu = s1 * (1.f / 128.f);
      float s2 = 0.f;
#pragma unroll
      for (int et = 0; et < 8; ++et)
#pragma unroll
        for (int j = 0; j < 4; ++j) {
          float dlt = o[et][qt][j] - mu;
          s2 += dlt * dlt;
        }
      s2 += __shfl_xor(s2, 16);
      s2 += __shfl_xor(s2, 32);
      const float rstd = rsqrtf(s2 * (1.f / 128.f) + 1e-6f);
#pragma unroll
      for (int et = 0; et < 8; ++et) {
        const int e = h * 128 + et * 16 + 4 * g;
        float4 gn = *(const float4*)(p.ret_gn + e);
        u32x2 sg = *(const u32x2*)(srg + (size_t)tok * 512 + e);
        u32x2 ov;
        ov[0] = pack2((o[et][qt][0] - mu) * rstd * gn.x * bflo(sg[0]), (o[et][qt][1] - mu) * rstd * gn.y * bfhi(sg[0]));
        ov[1] = pack2((o[et][qt][2] - mu) * rstd * gn.z * bflo(sg[1]), (o[et][qt][3] - mu) * rstd * gn.w * bfhi(sg[1]));
        *(u32x2*)(ret + (size_t)tok * 512 + e) = ov;
      }
    }
  }
}

DI void phase6(const Params& p, char* smem) {
  char* ws = p.ws;
  const bf16_t* cqn = (const bf16_t*)(ws + OFF_CQ);
  const bf16_t* wuqT = (const bf16_t*)(ws + OFF_WUQT);
  bf16_t* q = (bf16_t*)(ws + OFF_Q);
  for (int it = 0;; ++it) {
    int ft, tt;
    if (!tile_map(it, 6, 160, 1, ft, tt)) break;
    f32x4 acc[4][4];
    acc_zero(acc);
    gemm_kloop<0>(acc, wuqT + (size_t)ft * 128 * 256, 256, cqn + (size_t)tt * 128 * 256, 256, 256, smem, 0.f, 0.f);
    epilogue(acc, [&](int m, int n, float (&v)[16]) { st_bf16x16(q + (size_t)(tt * 128 + n) * 768 + ft * 128 + m, v); });
  }
  const bf16_t* ckvall = (const bf16_t*)(ws + OFF_CKVALL);
  const bf16_t* wukvT = (const bf16_t*)(ws + OFF_WUKVT);
  bf16_t* Kn = (bf16_t*)(ws + OFF_KN);
  bf16_t* Vt = (bf16_t*)(ws + OFF_VTA);
  for (int it = 0;; ++it) {
    int ft, tt;
    if (!tile_map(it, 8, 192, 1, ft, tt)) break;
    f32x4 acc[4][4];
    acc_zero(acc);
    const bf16_t* W = wukvT + (size_t)ft * 128 * 128;
    const bf16_t* X = ckvall + (size_t)tt * 128 * 128;
    if (ft < 4) {
      gemm_kloop<0>(acc, W, 128, X, 128, 128, smem, 0.f, 0.f);
      epilogue(acc, [&](int m, int n, float (&v)[16]) { st_bf16x16(Kn + (size_t)(tt * 128 + n) * 512 + ft * 128 + m, v); });
    } else {
      gemm_kloop<0>(acc, X, 128, W, 128, 128, smem, 0.f, 0.f);
      epilogue(acc, [&](int m, int n, float (&v)[16]) { st_bf16x16(Vt + (size_t)((ft - 4) * 128 + n) * NKV + tt * 128 + m, v); });
    }
  }
}

DI void conv_fp8_rows(const float* __restrict__ src, unsigned char* __restrict__ dst, float* __restrict__ inv);
DI void phase7(const Params& p, char* smem) {
  char* ws = p.ws;
  const bf16_t* q = (const bf16_t*)(ws + OFF_Q);
  const bf16_t* Kn = (const bf16_t*)(ws + OFF_KN);
  const bf16_t* Vt = (const bf16_t*)(ws + OFF_VTA);
  const bf16_t* krall = (const bf16_t*)(ws + OFF_KRALL);
  bf16_t* attn = (bf16_t*)(ws + OFF_ATTN);
  bf16_t* Ks0 = (bf16_t*)smem;
  const int tid = threadIdx.x, lane = tid & 63, w = tid >> 6, l15 = lane & 15, g = lane >> 4;
  const float qscale = 0.10206207261596577f * 1.4426950408889634f;
  for (int item = vbid(); item < 1280; item += gridDim.x) {
    int b, h, qtok0, keyrow0, nkt;
    bool sample;
    if (item < 1024) {
      sample = true; b = item >> 7; h = (item >> 4) & 7; int qb = item & 15;
      qtok0 = NPT + b * 2048 + qb * 128; keyrow0 = NPT + b * 2560; nkt = 40;
    } else {
      int it2 = item - 1024;
      sample = false; b = it2 >> 4; h = (it2 >> 1) & 7; int qb = it2 & 1;
      qtok0 = b * 256 + qb * 128; keyrow0 = b * 256; nkt = 4;
    }
    bf16x8 Q[2][3];
#pragma unroll
    for (int qt = 0; qt < 2; ++qt) {
      const int tokq = qtok0 + w * 32 + qt * 16 + l15;
      const bf16_t* qp = q + (size_t)tokq * 768 + h * 96;
#pragma unroll
      for (int ks = 0; ks < 3; ++ks) {
        u32x4 u = *(const u32x4*)(qp + ks * 32 + g * 8);
        float v[8];
#pragma unroll
        for (int i = 0; i < 4; ++i) { v[2 * i] = bflo(u[i]); v[2 * i + 1] = bfhi(u[i]); }
        if (ks == 2 && sample) {
          u32x4 up = *(const u32x4*)(qp + 64 + (g ^ 2) * 8);
          float pv[8];
#pragma unroll
          for (int i = 0; i < 4; ++i) { pv[2 * i] = bflo(up[i]); pv[2 * i + 1] = bfhi(up[i]); }
          int t = (tokq - NPT) & 2047;
          const float4* rp = (const float4*)((const float2*)(ws + OFF_ROPE) + t * 16 + (g & 1) * 8);
#pragma unroll
          for (int i2 = 0; i2 < 4; ++i2) {
            const float4 c2 = rp[i2];
            const int i = 2 * i2;
            v[i] = g < 2 ? v[i] * c2.x - pv[i] * c2.y : pv[i] * c2.y + v[i] * c2.x;
            v[i + 1] = g < 2 ? v[i + 1] * c2.z - pv[i + 1] * c2.w : pv[i + 1] * c2.w + v[i + 1] * c2.z;
          }
        }
        u32x4 o4;
#pragma unroll
        for (int i = 0; i < 4; ++i) o4[i] = pack2(v[2 * i] * qscale, v[2 * i + 1] * qscale);
        Q[qt][ks] = __builtin_bit_cast(bf16x8, o4);
      }
    }
    f32x4 o[4][2];
#pragma unroll
    for (int et = 0; et < 4; ++et)
#pragma unroll
      for (int qt = 0; qt < 2; ++qt) o[et][qt] = f32x4{0.f, 0.f, 0.f, 0.f};
    float mrun[2] = {-1e30f, -1e30f}, lrun[2] = {0.f, 0.f};
    u32x4 rk_[3], rv_[2];
    auto gload = [&](int kt) {
      const int row0 = keyrow0 + kt * 64;
#pragma unroll
      for (int i = 0; i < 3; ++i) {
        int c = tid + 256 * i;
        int r = c / 12, cc = c - r * 12;
        rk_[i] = cc < 8 ? *(const u32x4*)(Kn + (size_t)(row0 + r) * 512 + h * 64 + cc * 8)
                        : *(const u32x4*)(krall + (size_t)(row0 + r) * 32 + (cc - 8) * 8);
      }
#pragma unroll
      for (int i = 0; i < 2; ++i) {
        int c = tid + 256 * i;
        int e = c >> 3, cc = (c & 7) * 8;
        rv_[i] = *(const u32x4*)(Vt + (size_t)(h * 64 + e) * NKV + row0 + cc);
      }
    };
    auto lstore = [&](int b) {
      bf16_t* Kd = Ks0 + b * 11776;
      bf16_t* Vd = Kd + 64 * 112;
#pragma unroll
      for (int i = 0; i < 3; ++i) {
        int c = tid + 256 * i;
        int r = c / 12, cc = c - r * 12;
        *(u32x4*)(Kd + r * 112 + cc * 8) = rk_[i];
      }
#pragma unroll
      for (int i = 0; i < 2; ++i) {
        int c = tid + 256 * i;
        int e = c >> 3, cc = (c & 7) * 8;
        *(u32x4*)(Vd + e * 72 + cc) = rv_[i];
      }
    };
    gload(0);
    __syncthreads();
    lstore(0);
    if (nkt > 1) gload(1);
    __syncthreads();
#pragma unroll 1
    for (int kt = 0; kt < nkt; ++kt) {
      const bf16_t* Ks = Ks0 + (kt & 1) * 11776;
      const bf16_t* Vs = Ks + 64 * 112;
      f32x4 s[4][2];
#pragma unroll
      for (int kk = 0; kk < 4; ++kk)
#pragma unroll
        for (int qt = 0; qt < 2; ++qt) s[kk][qt] = f32x4{0.f, 0.f, 0.f, 0.f};
#pragma unroll
      for (int ks = 0; ks < 3; ++ks) {
#pragma unroll
        for (int kk = 0; kk < 4; ++kk) {
          bf16x8 a = *(const bf16x8*)(Ks + (kk * 16 + l15) * 112 + ks * 32 + g * 8);
#pragma unroll
          for (int qt = 0; qt < 2; ++qt) s[kk][qt] = __builtin_amdgcn_mfma_f32_16x16x32_bf16(a, Q[qt][ks], s[kk][qt], 0, 0, 0);
        }
      }
      bf16x8 P[2][2];
#pragma unroll
      for (int qt = 0; qt < 2; ++qt) {
        float mx = s[0][qt][0];
#pragma unroll
        for (int kk = 0; kk < 4; ++kk)
#pragma unroll
          for (int j = 0; j < 4; ++j) mx = fmaxf(mx, s[kk][qt][j]);
        mx = fmaxf(mx, __shfl_xor(mx, 16));
        mx = fmaxf(mx, __shfl_xor(mx, 32));
        const float mnew = fmaxf(mrun[qt], mx);
        const bool grow = __ballot(mx > mrun[qt]) != 0ull;
        const float alpha = grow ? ex2(mrun[qt] - mnew) : 1.f;
        mrun[qt] = mnew;
        float ps = 0.f;
#pragma unroll
        for (int kk = 0; kk < 4; ++kk)
#pragma unroll
          for (int j = 0; j < 4; ++j) {
            float e_ = ex2(s[kk][qt][j] - mnew);
            s[kk][qt][j] = e_;
            ps += e_;
          }
        if (grow) {
          lrun[qt] = lrun[qt] * alpha + ps;
#pragma unroll
          for (int et = 0; et < 4; ++et)
#pragma unroll
            for (int j = 0; j < 4; ++j) o[et][qt][j] *= alpha;
        } else {
          lrun[qt] += ps;
        }
#pragma unroll
        for (int k2 = 0; k2 < 2; ++k2) {
          u32x4 u;
          u[0] = pack2(s[2 * k2][qt][0], s[2 * k2][qt][1]);
          u[1] = pack2(s[2 * k2][qt][2], s[2 * k2][qt][3]);
          u[2] = pack2(s[2 * k2 + 1][qt][0], s[2 * k2 + 1][qt][1]);
          u[3] = pack2(s[2 * k2 + 1][qt][2], s[2 * k2 + 1][qt][3]);
          P[qt][k2] = __builtin_bit_cast(bf16x8, u);
        }
      }
#pragma unroll
      for (int k2 = 0; k2 < 2; ++k2) {
#pragma unroll
        for (int et = 0; et < 4; ++et) {
          u32x2 lo = *(const u32x2*)(Vs + (et * 16 + l15) * 72 + k2 * 32 + 4 * g);
          u32x2 hi = *(const u32x2*)(Vs + (et * 16 + l15) * 72 + k2 * 32 + 16 + 4 * g);
          u32x4 u;
          u[0] = lo[0]; u[1] = lo[1]; u[2] = hi[0]; u[3] = hi[1];
          bf16x8 a = __builtin_bit_cast(bf16x8, u);
#pragma unroll
          for (int qt = 0; qt < 2; ++qt) o[et][qt] = __builtin_amdgcn_mfma_f32_16x16x32_bf16(a, P[qt][k2], o[et][qt], 0, 0, 0);
        }
      }
      if (kt + 1 < nkt) {
        lstore((kt + 1) & 1);
        if (kt + 2 < nkt) gload(kt + 2);
        __syncthreads();
      }
    }
#pragma unroll
    for (int qt = 0; qt < 2; ++qt) {
      const int tokq = qtok0 + w * 32 + qt * 16 + l15;
      float lt = lrun[qt];
      lt += __shfl_xor(lt, 16);
      lt += __shfl_xor(lt, 32);
      const float inv = 1.f / lt;
#pragma unroll
      for (int et = 0; et < 4; ++et) {
        u32x2 ov;
        ov[0] = pack2(o[et][qt][0] * inv, o[et][qt][1] * inv);
        ov[1] = pack2(o[et][qt][2] * inv, o[et][qt][3] * inv);
        *(u32x2*)(attn + (size_t)tokq * 512 + h * 64 + et * 16 + 4 * g) = ov;
      }
    }
  }
  conv_fp8_rows(p.peer_u, (unsigned char*)(p.ws + OFF_TABU), (float*)(p.ws + OFF_INVU));
  conv_fp8_rows(p.peer_v, (unsigned char*)(p.ws + OFF_TABV), (float*)(p.ws + OFF_INVV));
}

DI void phase8(const Params& p, char* smem) {
  char* ws = p.ws;
  const bf16_t* attn = (const bf16_t*)(ws + OFF_ATTN);
  const bf16_t* ret = (const bf16_t*)(ws + OFF_RET);
  const bf16_t* wa = (const bf16_t*)(ws + OFF_WUPAT);
  const bf16_t* wb = (const bf16_t*)(ws + OFF_WUPBT);
  const bf16_t* sga = (const bf16_t*)p.out;
  const bf16_t* sgb = sga + (size_t)NTOK * 1024;
  bf16_t* mbuf = (bf16_t*)(ws + OFF_M);
  const int tid = threadIdx.x, lane = tid & 63, w = tid >> 6, wm = w >> 1, wn = w & 1, l15 = lane & 15, g = lane >> 4;
  for (int it = 0;; ++it) {
    int ft, tt;
    if (!tile_map(it, 8, 160, 1, ft, tt)) break;
    f32x4 acc[4][4];
    acc_zero(acc);
    gemm_kloop<0>(acc, wa + (size_t)ft * 128 * 512, 512, attn + (size_t)tt * 128 * 512, 512, 512, smem, 0.f, 0.f);
#pragma unroll
    for (int c = 0; c < 4; ++c) {
      const size_t off = (size_t)(tt * 128 + wn * 64 + c * 16 + l15) * 1024 + ft * 128 + wm * 64 + 16 * g;
      float a[16], bq[16];
      ld_bf16x16(sga + off, a);
      ld_bf16x16(sgb + off, bq);
#pragma unroll
      for (int f = 0; f < 4; ++f)
#pragma unroll
        for (int j = 0; j < 4; ++j) acc[f][c][j] *= a[f * 4 + j] / fmaxf(bq[f * 4 + j], 1e-30f);
    }
    gemm_kloop<0>(acc, wb + (size_t)ft * 128 * 512, 512, ret + (size_t)tt * 128 * 512, 512, 512, smem, 0.f, 0.f);
    epilogue(acc, [&](int m, int n, float (&v)[16]) {
      const size_t off = (size_t)(tt * 128 + n) * 1024 + ft * 128 + m;
      float bq[16];
      ld_bf16x16(sgb + off, bq);
#pragma unroll
      for (int i = 0; i < 16; ++i) v[i] *= bq[i];
      st_bf16x16(mbuf + off, v);
    });
  }
}
DI void phase9(const Params& p, char* smem) {
  char* ws = p.ws;
  const bf16_t* mbuf = (const bf16_t*)(ws + OFF_M);
  const bf16_t* wo = (const bf16_t*)(ws + OFF_WOT);
  const float* mod = (const float*)(ws + OFF_MOD);
  for (int it = 0;; ++it) {
    int ft, tt;
    if (!tile_map(it, 8, 160, 1, ft, tt)) break;
    f32x4 acc[4][4];
    acc_zero(acc);
    gemm_kloop<0>(acc, wo + (size_t)ft * 128 * 1024, 1024, mbuf + (size_t)tt * 128 * 1024, 1024, 1024, smem, 0.f, 0.f);
    epilogue(acc, [&](int m, int n, float (&v)[16]) {
      const int tok = tt * 128 + n, feat = ft * 128 + m;
      const float* xr = xrow(p, tok) + feat;
      const float* g1 = mod + modidx(tok) * 6144 + 2048 + feat;
#pragma unroll
      for (int i = 0; i < 4; ++i) {
        float4 xv = *(const float4*)(xr + 4 * i), gv = *(const float4*)(g1 + 4 * i);
        v[4 * i] = xv.x + gv.x * v[4 * i];
        v[4 * i + 1] = xv.y + gv.y * v[4 * i + 1];
        v[4 * i + 2] = xv.z + gv.z * v[4 * i + 2];
        v[4 * i + 3] = xv.w + gv.w * v[4 * i + 3];
      }
      st_f32x16(p.out + (size_t)tok * DM + feat, v);
    });
  }
}
DI void conv_fp8_rows(const float* __restrict__ src, unsigned char* __restrict__ dst, float* __restrict__ inv) {
  const int lane = threadIdx.x & 63, w = threadIdx.x >> 6;
  for (int r = blockIdx.x * 4 + w; r < 16384; r += gridDim.x * 4) {
    const float* sp = src + (size_t)r * 1024 + lane * 16;
    float4 v[4];
    float am = 0.f;
#pragma unroll
    for (int i = 0; i < 4; ++i) {
      v[i] = *(const float4*)(sp + 4 * i);
      am = fmaxf(am, fmaxf(fmaxf(fabsf(v[i].x), fabsf(v[i].y)), fmaxf(fabsf(v[i].z), fabsf(v[i].w))));
    }
#pragma unroll
    for (int o = 32; o > 0; o >>= 1) am = fmaxf(am, __shfl_xor(am, o));
    const float sc = am > 0.f ? 448.f / am : 1.f;
    u32x4 o4;
#pragma unroll
    for (int i = 0; i < 4; ++i) {
      int wd = 0;
      wd = __builtin_amdgcn_cvt_pk_fp8_f32(v[i].x * sc, v[i].y * sc, wd, false);
      wd = __builtin_amdgcn_cvt_pk_fp8_f32(v[i].z * sc, v[i].w * sc, wd, true);
      o4[i] = (unsigned)wd;
    }
    *(u32x4*)(dst + ((size_t)(lane >> 3) * 16384 + r) * 128 + (lane & 7) * 16) = o4;
    if (lane == 0) inv[r] = am > 0.f ? am * (1.f / 448.f) : 1.f;
  }
}
DI void phase10(const Params& p, char* smem) {
  rows_norm_mod(p, p.norm_ffn, 3072, 4096, true, (bf16_t*)(p.ws + OFF_H2));
}
DI void phase11(const Params& p, char* smem) {
  char* ws = p.ws;
  const bf16_t* h2 = (const bf16_t*)(ws + OFF_H2);
  const bf16_t* wct = (const bf16_t*)(ws + OFF_WCT);
  bf16_t* sc = (bf16_t*)(ws + OFF_SCORES);
  for (int it = 0;; ++it) {
    int ft, tt;
    if (!tile_map(it, 16, 160, 2, ft, tt)) break;
    f32x4 acc[4][4];
    acc_zero(acc);
    gemm_kloop<0>(acc, wct + (size_t)ft * 128 * 1024, 1024, h2 + (size_t)tt * 128 * 1024, 1024, 1024, smem, 0.f, 0.f);
    epilogue(acc, [&](int m, int n, float (&v)[16]) { st_bf16x16(sc + (size_t)(tt * 128 + n) * 2048 + ft * 128 + m, v); });
  }
}

DI unsigned okey(float f) {
  unsigned u = __float_as_uint(f);
  return (u & 0x80000000u) ? ~u : (u | 0x80000000u);
}
DI void wave_lds_sync() {
  __builtin_amdgcn_fence(__ATOMIC_ACQ_REL, "workgroup");
  __builtin_amdgcn_wave_barrier();
}
DI unsigned okey16(unsigned b) { return (b & 0x8000u) ? (~b & 0xFFFFu) : (b | 0x8000u); }
DI unsigned inv_okey16(unsigned k) { return (k & 0x8000u) ? (k & 0x7FFFu) : (~k & 0xFFFFu); }
DI unsigned inv_okey(unsigned k) { return (k & 0x80000000u) ? (k & 0x7FFFFFFFu) : ~k; }
DI void ins16(unsigned (&L)[16], unsigned x) {
#pragma unroll
  for (int i = 0; i < 16; ++i) {
    unsigned t = max(L[i], x);
    x = min(L[i], x);
    L[i] = t;
  }
}
DI void ce_desc(unsigned& a, unsigned& b) {
  const unsigned t = max(a, b);
  b = min(a, b);
  a = t;
}
DI void sort16_desc(unsigned (&a)[16]) {
#pragma unroll
  for (int ks = 1; ks <= 4; ++ks) {
#pragma unroll
    for (int js = ks - 1; js >= 0; --js) {
#pragma unroll
      for (int i = 0; i < 16; ++i) {
        const int k = 1 << ks, j = 1 << js, l = i ^ j;
        if (l > i) {
          if ((i & k) == 0) ce_desc(a[i], a[l]);
          else ce_desc(a[l], a[i]);
        }
      }
    }
  }
}
DI void merge_top16(unsigned (&L)[16], const unsigned (&G)[16]) {
#pragma unroll
  for (int i = 0; i < 16; ++i) L[i] = max(L[i], G[15 - i]);
#pragma unroll
  for (int js = 3; js >= 0; --js) {
#pragma unroll
    for (int i = 0; i < 16; ++i) {
      const int j = 1 << js, l = i ^ j;
      if (l > i) ce_desc(L[i], L[l]);
    }
  }
}
DI unsigned byte16(const unsigned (&d)[4], int i) {
  unsigned r = 0u;
#pragma unroll
  for (int q = 0; q < 4; ++q) r |= d[q] & (0u - (unsigned)((i >> 2) == q));
  return (r >> ((i & 3) * 8)) & 0xFFu;
}
DI unsigned sel16(const unsigned (&A)[16], int i) {
  unsigned r = 0u;
#pragma unroll
  for (int t = 0; t < 16; ++t) r |= A[t] & (0u - (unsigned)(i == t));
  return r;
}
DI void phase12(const Params& p, char* smem) {
  char* ws = p.ws;
  const bf16_t* sc = (const bf16_t*)(ws + OFF_SCORES);
  int* elist = (int*)(ws + OFF_ELIST);
  float* glist = (float*)(ws + OFF_GLIST);
  const int lane = threadIdx.x & 63, w = threadIdx.x >> 6;
  for (int batch = blockIdx.x * 4 + w; batch < NTOK / 4; batch += gridDim.x * 4) {
    const int tok = batch * 4 + (lane >> 4), hh = lane & 15;
    const bf16_t* row = sc + (size_t)tok * 2048 + hh * 128;
    unsigned L[16];
#pragma unroll
    for (int grp8 = 0; grp8 < 8; ++grp8) {
      unsigned G[16];
#pragma unroll
      for (int cc = 0; cc < 2; ++cc) {
        const int c = grp8 * 2 + cc;
        u32x4 u = *(const u32x4*)(row + c * 8);
#pragma unroll
        for (int i = 0; i < 4; ++i) {
          unsigned b0 = u[i] & 0xFFFFu, b1 = u[i] >> 16;
          G[cc * 8 + 2 * i] = (okey16(b0) << 16) | (unsigned)(127 - (c * 8 + 2 * i));
          G[cc * 8 + 2 * i + 1] = (okey16(b1) << 16) | (unsigned)(127 - (c * 8 + 2 * i + 1));
        }
      }
      sort16_desc(G);
      if (grp8 == 0) {
#pragma unroll
        for (int i = 0; i < 16; ++i) L[i] = G[i];
      } else {
        merge_top16(L, G);
      }
    }
    unsigned M[16];
#pragma unroll
    for (int i = 0; i < 16; ++i) M[i] = (unsigned)__shfl_xor((int)L[i], 1);
    float v1[16], v2[16];
#pragma unroll
    for (int i = 0; i < 16; ++i) {
      v1[i] = bf2f(inv_okey16(L[i] >> 16));
      v2[i] = bf2f(inv_okey16(M[i] >> 16));
    }
    unsigned C[16];
#pragma unroll
    for (int i = 0; i < 16; ++i) C[i] = 0u;
    ins16(C, (okey(v1[0] + v2[0]) & 0xFFFFFF00u) | 255u);
    ins16(C, (okey(v1[0] + v2[1]) & 0xFFFFFF00u) | 254u);
    ins16(C, (okey(v1[0] + v2[2]) & 0xFFFFFF00u) | 253u);
    ins16(C, (okey(v1[0] + v2[3]) & 0xFFFFFF00u) | 252u);
    ins16(C, (okey(v1[0] + v2[4]) & 0xFFFFFF00u) | 251u);
    ins16(C, (okey(v1[0] + v2[5]) & 0xFFFFFF00u) | 250u);
    ins16(C, (okey(v1[0] + v2[6]) & 0xFFFFFF00u) | 249u);
    ins16(C, (okey(v1[0] + v2[7]) & 0xFFFFFF00u) | 248u);
    ins16(C, (okey(v1[0] + v2[8]) & 0xFFFFFF00u) | 247u);
    ins16(C, (okey(v1[0] + v2[9]) & 0xFFFFFF00u) | 246u);
    ins16(C, (okey(v1[0] + v2[10]) & 0xFFFFFF00u) | 245u);
    ins16(C, (okey(v1[0] + v2[11]) & 0xFFFFFF00u) | 244u);
    ins16(C, (okey(v1[0] + v2[12]) & 0xFFFFFF00u) | 243u);
    ins16(C, (okey(v1[0] + v2[13]) & 0xFFFFFF00u) | 242u);
    ins16(C, (okey(v1[0] + v2[14]) & 0xFFFFFF00u) | 241u);
    ins16(C, (okey(v1[0] + v2[15]) & 0xFFFFFF00u) | 240u);
    ins16(C, (okey(v1[1] + v2[0]) & 0xFFFFFF00u) | 239u);
    ins16(C, (okey(v1[1] + v2[1]) & 0xFFFFFF00u) | 238u);
    ins16(C, (okey(v1[1] + v2[2]) & 0xFFFFFF00u) | 237u);
    ins16(C, (okey(v1[1] + v2[3]) & 0xFFFFFF00u) | 236u);
    ins16(C, (okey(v1[1] + v2[4]) & 0xFFFFFF00u) | 235u);
    ins16(C, (okey(v1[1] + v2[5]) & 0xFFFFFF00u) | 234u);
    ins16(C, (okey(v1[1] + v2[6]) & 0xFFFFFF00u) | 233u);
    ins16(C, (okey(v1[1] + v2[7]) & 0xFFFFFF00u) | 232u);
    ins16(C, (okey(v1[2] + v2[0]) & 0xFFFFFF00u) | 223u);
    ins16(C, (okey(v1[2] + v2[1]) & 0xFFFFFF00u) | 222u);
    ins16(C, (okey(v1[2] + v2[2]) & 0xFFFFFF00u) | 221u);
    ins16(C, (okey(v1[2] + v2[3]) & 0xFFFFFF00u) | 220u);
    ins16(C, (okey(v1[2] + v2[4]) & 0xFFFFFF00u) | 219u);
    ins16(C, (okey(v1[3] + v2[0]) & 0xFFFFFF00u) | 207u);
    ins16(C, (okey(v1[3] + v2[1]) & 0xFFFFFF00u) | 206u);
    ins16(C, (okey(v1[3] + v2[2]) & 0xFFFFFF00u) | 205u);
    ins16(C, (okey(v1[3] + v2[3]) & 0xFFFFFF00u) | 204u);
    ins16(C, (okey(v1[4] + v2[0]) & 0xFFFFFF00u) | 191u);
    ins16(C, (okey(v1[4] + v2[1]) & 0xFFFFFF00u) | 190u);
    ins16(C, (okey(v1[4] + v2[2]) & 0xFFFFFF00u) | 189u);
    ins16(C, (okey(v1[5] + v2[0]) & 0xFFFFFF00u) | 175u);
    ins16(C, (okey(v1[5] + v2[1]) & 0xFFFFFF00u) | 174u);
    ins16(C, (okey(v1[6] + v2[0]) & 0xFFFFFF00u) | 159u);
    ins16(C, (okey(v1[6] + v2[1]) & 0xFFFFFF00u) | 158u);
    ins16(C, (okey(v1[7] + v2[0]) & 0xFFFFFF00u) | 143u);
    ins16(C, (okey(v1[7] + v2[1]) & 0xFFFFFF00u) | 142u);
    ins16(C, (okey(v1[8] + v2[0]) & 0xFFFFFF00u) | 127u);
    ins16(C, (okey(v1[9] + v2[0]) & 0xFFFFFF00u) | 111u);
    ins16(C, (okey(v1[10] + v2[0]) & 0xFFFFFF00u) | 95u);
    ins16(C, (okey(v1[11] + v2[0]) & 0xFFFFFF00u) | 79u);
    ins16(C, (okey(v1[12] + v2[0]) & 0xFFFFFF00u) | 63u);
    ins16(C, (okey(v1[13] + v2[0]) & 0xFFFFFF00u) | 47u);
    ins16(C, (okey(v1[14] + v2[0]) & 0xFFFFFF00u) | 31u);
    ins16(C, (okey(v1[15] + v2[0]) & 0xFFFFFF00u) | 15u);
    unsigned ib1[4], ib2[4];
#pragma unroll
    for (int q = 0; q < 4; ++q) {
      ib1[q] = (L[4 * q] & 0xFFu) | ((L[4 * q + 1] & 0xFFu) << 8) | ((L[4 * q + 2] & 0xFFu) << 16) | ((L[4 * q + 3] & 0xFFu) << 24);
      ib2[q] = (M[4 * q] & 0xFFu) | ((M[4 * q + 1] & 0xFFu) << 8) | ((M[4 * q + 2] & 0xFFu) << 16) | ((M[4 * q + 3] & 0xFFu) << 24);
    }
    int ev[16];
    float gv[16];
    const float mx = __uint_as_float(inv_okey(C[0] & 0xFFFFFF00u));
    float den = 0.f;
#pragma unroll
    for (int k = 0; k < 16; ++k) {
      const int ci = 255 - (int)(C[k] & 0xFFu);
      ev[k] = (127 - (int)byte16(ib1, ci >> 4)) * 128 + (127 - (int)byte16(ib2, ci & 15));
      gv[k] = __expf(__uint_as_float(inv_okey(C[k] & 0xFFFFFF00u)) - mx);
      den += gv[k];
    }
    const float inv = 1.f / den;
    if ((lane & 1) == 0) {
      int* ep = elist + (size_t)tok * 128 + (hh >> 1) * 16;
      float* gp = glist + (size_t)tok * 128 + (hh >> 1) * 16;
#pragma unroll
      for (int k = 0; k < 4; ++k) {
        *(int4*)(ep + 4 * k) = make_int4(ev[4 * k], ev[4 * k + 1], ev[4 * k + 2], ev[4 * k + 3]);
        *(float4*)(gp + 4 * k) = make_float4(gv[4 * k] * inv, gv[4 * k + 1] * inv, gv[4 * k + 2] * inv, gv[4 * k + 3] * inv);
      }
    }
  }
}
using f32x2 = __attribute__((ext_vector_type(2))) float;
DI f32x2 cvt8(unsigned w, bool hi) {
  return hi ? __builtin_amdgcn_cvt_pk_f32_fp8((int)w, true) : __builtin_amdgcn_cvt_pk_f32_fp8((int)w, false);
}
struct SMeta { int e[16]; u32x4 ha, hb; };
template <int MODE>
DI void sl_meta(const Params& p, int t, int s, int grp, int ch, SMeta& m) {
  const int* elist = (const int*)(p.ws + (MODE == 0 ? OFF_ELIST : OFF_GLIST));
#pragma unroll
  for (int i = 0; i < 16; ++i) m.e[i] = elist[(size_t)t * 128 + i * 8 + grp];
  if (MODE == 0) {
    const bf16_t* hq = (const bf16_t*)(p.ws + OFF_H2) + (size_t)t * DM + s * 128 + ch * 16;
    m.ha = *(const u32x4*)hq;
    m.hb = *(const u32x4*)(hq + 8);
  }
}
template <int MODE>
DI void sl_rows(const Params& p, int s, int ch, const SMeta& m, u32x4 (&r)[16]) {
  const unsigned char* tab = (const unsigned char*)(p.ws + (MODE == 0 ? OFF_TABU : OFF_TABV));
#pragma unroll
  for (int i = 0; i < 16; ++i) r[i] = *(const u32x4*)(tab + ((size_t)s * 16384 + (m.e[i] & 0xFFFF)) * 128 + ch * 16);
}
template <int MODE>
DI void sl_compute(const Params& p, int t, int s, int lane, const SMeta& m, const u32x4 (&r)[16]) {
  const int grp = lane >> 3, ch = lane & 7;
  if (MODE == 0) {
    f32x2 hp[8];
#pragma unroll
    for (int i = 0; i < 4; ++i) {
      hp[i] = f32x2{bflo(m.ha[i]), bfhi(m.ha[i])};
      hp[4 + i] = f32x2{bflo(m.hb[i]), bfhi(m.hb[i])};
    }
    float keep0 = 0.f, keep1 = 0.f;
#pragma unroll
    for (int i = 0; i < 16; ++i) {
      f32x2 d2 = f32x2{0.f, 0.f};
#pragma unroll
      for (int j = 0; j < 4; ++j) {
        d2 += cvt8(r[i][j], false) * hp[2 * j];
        d2 += cvt8(r[i][j], true) * hp[2 * j + 1];
      }
      float d = d2[0] + d2[1];
      d += __shfl_xor(d, 1);
      d += __shfl_xor(d, 2);
      d += __shfl_xor(d, 4);
      if (i < 8) keep0 = (ch == i) ? d : keep0;
      else keep1 = (ch == i - 8) ? d : keep1;
    }
    float* po = (float*)(p.ws + OFF_PD) + (size_t)t * 1024 + s * 128;
    po[ch * 8 + grp] = keep0;
    po[(ch + 8) * 8 + grp] = keep1;
  } else {
    f32x2 acc[8];
#pragma unroll
    for (int q = 0; q < 8; ++q) acc[q] = f32x2{0.f, 0.f};
#pragma unroll
    for (int i = 0; i < 16; ++i) {
      const float wsc = __uint_as_float((unsigned)m.e[i] & 0xFFFF0000u);
      const f32x2 w2 = f32x2{wsc, wsc};
#pragma unroll
      for (int j = 0; j < 4; ++j) {
        acc[2 * j] += w2 * cvt8(r[i][j], false);
        acc[2 * j + 1] += w2 * cvt8(r[i][j], true);
      }
    }
    float v[16];
#pragma unroll
    for (int q = 0; q < 8; ++q) { v[2 * q] = acc[q][0]; v[2 * q + 1] = acc[q][1]; }
    float q8[8], q4[4], q2[2];
    {
      const bool hi = lane & 32;
#pragma unroll
      for (int i = 0; i < 8; ++i) {
        float send = hi ? v[i] : v[8 + i], keep = hi ? v[8 + i] : v[i];
        q8[i] = keep + __shfl_xor(send, 32);
      }
    }
    {
      const bool hi = lane & 16;
#pragma unroll
      for (int i = 0; i < 4; ++i) {
        float send = hi ? q8[i] : q8[4 + i], keep = hi ? q8[4 + i] : q8[i];
        q4[i] = keep + __shfl_xor(send, 16);
      }
    }
    {
      const bool hi = lane & 8;
#pragma unroll
      for (int i = 0; i < 2; ++i) {
        float send = hi ? q4[i] : q4[2 + i], keep = hi ? q4[2 + i] : q4[i];
        q2[i] = keep + __shfl_xor(send, 8);
      }
    }
    const int f = s * 128 + ch * 16 + 2 * grp;
    float* xr = p.out + (size_t)t * DM + f;
    const float2 xv = *(const float2*)xr;
    const float2 gv = *(const float2*)((const float*)(p.ws + OFF_MOD) + modidx(t) * 6144 + 5120 + f);
    *(float2*)xr = make_float2(xv.x + gv.x * q2[0], xv.y + gv.y * q2[1]);
  }
}
template <int MODE>
DI void sliced_pass(const Params& p) {
  const int s = blockIdx.x & 7, loc = blockIdx.x >> 3, nloc = gridDim.x >> 3;
  if (loc >= nloc) return;
  const int lane = threadIdx.x & 63, w = threadIdx.x >> 6, grp = lane >> 3, ch = lane & 7;
  const int stride = nloc * 4;
  SMeta mA, mB;
  u32x4 rA[16], rB[16];
  int t = loc * 4 + w;
  if (t < NTOK) {
    sl_meta<MODE>(p, t, s, grp, ch, mA);
    sl_rows<MODE>(p, s, ch, mA, rA);
  }
  if (t + stride < NTOK) sl_meta<MODE>(p, t + stride, s, grp, ch, mB);
#pragma unroll 1
  for (; t < NTOK; t += 2 * stride) {
    const int t1 = t + stride, t2 = t + 2 * stride, t3 = t + 3 * stride;
    if (t1 < NTOK) sl_rows<MODE>(p, s, ch, mB, rB);
    sl_compute<MODE>(p, t, s, lane, mA, rA);
    if (t2 < NTOK) sl_meta<MODE>(p, t2, s, grp, ch, mA);
    if (t1 < NTOK) {
      if (t2 < NTOK) sl_rows<MODE>(p, s, ch, mA, rA);
      sl_compute<MODE>(p, t1, s, lane, mB, rB);
      if (t3 < NTOK) sl_meta<MODE>(p, t3, s, grp, ch, mB);
    }
  }
}
DI void phase13(const Params& p) { sliced_pass<0>(p); }
DI void phase14(const Params& p) {
  char* ws = p.ws;
  const float* invU = (const float*)(ws + OFF_INVU);
  const float* invV = (const float*)(ws + OFF_INVV);
  const int* elist = (const int*)(ws + OFF_ELIST);
  float* glist = (float*)(ws + OFF_GLIST);
  const float* pd = (const float*)(ws + OFF_PD);
  const int lane = threadIdx.x & 63, w = threadIdx.x >> 6;
  for (int t = blockIdx.x * 4 + w; t < NTOK; t += gridDim.x * 4) {
#pragma unroll
    for (int hf_ = 0; hf_ < 2; ++hf_) {
      const int k = hf_ * 64 + lane;
      float d = 0.f;
#pragma unroll
      for (int s = 0; s < 8; ++s) d += pd[(size_t)t * 1024 + s * 128 + k];
      const int e = elist[(size_t)t * 128 + k];
      const float g = glist[(size_t)t * 128 + k];
      ((unsigned*)glist)[(size_t)t * 128 + k] = (pack2(0.f, g * geluf_(d * invU[e]) * invV[e]) & 0xFFFF0000u) | (unsigned)e;
    }
  }
}
DI void phase15(const Params& p) { sliced_pass<1>(p); }
DI void phase16(const Params& p) {
  const int lane = threadIdx.x & 63, w = threadIdx.x >> 6;
  for (int tok = blockIdx.x * 4 + w; tok < NTOK; tok += gridDim.x * 4) {
    float* xr = p.out + (size_t)tok * DM;
    float4 xv[4];
    float ss = 0.f;
#pragma unroll
    for (int i = 0; i < 4; ++i) {
      xv[i] = *(const float4*)(xr + (i * 64 + lane) * 4);
      ss += xv[i].x * xv[i].x + xv[i].y * xv[i].y + xv[i].z * xv[i].z + xv[i].w * xv[i].w;
    }
    ss = wsum(ss);
    const float rstd = rsqrtf(ss * (1.f / 1024.f) + 1e-6f);
#pragma unroll
    for (int i = 0; i < 4; ++i) {
      const int e = (i * 64 + lane) * 4;
      float4 nf = *(const float4*)(p.norm_final + e);
      *(float4*)(xr + e) = make_float4(xv[i].x * rstd * nf.x, xv[i].y * rstd * nf.y, xv[i].z * rstd * nf.z, xv[i].w * rstd * nf.w);
    }
  }
}

#define XB_TMO      128
#define XB_XCNT(j)  (256  + 64 * (j))
#define XB_XSUB(j)  (1280 + 64 * (j))
#define XB_XGEN(j)  (2304 + 64 * (j))
#define XB_TOP      3328
#define XB_TOPGEN   3392
#define XCD_BAR_WORDS 3456
#define XB_SPIN_CAP (1u << 22)
#define LAS __attribute__((address_space(3)))
DI unsigned xb_ld(unsigned* p) { return __hip_atomic_load(p, __ATOMIC_RELAXED, __HIP_MEMORY_SCOPE_AGENT); }
DI unsigned xb_add(unsigned* p, unsigned v) { return __hip_atomic_fetch_add(p, v, __ATOMIC_RELAXED, __HIP_MEMORY_SCOPE_AGENT); }
DI unsigned xb_xcc_id() { return (unsigned)__builtin_amdgcn_s_getreg((3 << 11) | 20) & 0xFu; }
#define XB_SPIN(cond, bar) do { unsigned _sp = 0; while (cond) { __builtin_amdgcn_s_sleep(1); \
    if ((++_sp & 255u) == 0u) { if (xb_ld(&(bar)[XB_TMO])) break; if (_sp > XB_SPIN_CAP) { atomicAdd(&(bar)[XB_TMO], 1u); break; } } } } while (0)
struct XcdBarrier { unsigned* bar; unsigned x; volatile LAS unsigned* st; };
DI XcdBarrier xcd_barrier_post(unsigned* bar, volatile LAS unsigned* st) {
  XcdBarrier b; b.bar = bar; b.x = xb_xcc_id(); b.st = st;
  if (threadIdx.x == 0) (void)xb_add(&bar[XB_XCNT(b.x)], 1u);
  return b;
}
DI void xcd_barrier_complete(unsigned* bar, unsigned x, unsigned& nloc, unsigned& nx) {
  const unsigned G = gridDim.x * gridDim.y * gridDim.z;
  unsigned sum, cnt, mine, sp = 0u;
  for (;;) {
    sum = 0u; cnt = 0u; mine = 0u;
#pragma unroll
    for (unsigned j = 0; j < 16; ++j) { const unsigned c = xb_ld(&bar[XB_XCNT(j)]); sum += c; cnt += (c > 0u) ? 1u : 0u; mine = (j == x) ? c : mine; }
    if (sum == G) break;
    __builtin_amdgcn_s_sleep(1);
    if ((++sp & 255u) == 0u) { if (xb_ld(&bar[XB_TMO])) break; if (sp > XB_SPIN_CAP) { atomicAdd(&bar[XB_TMO], 1u); break; } }
  }
  nloc = mine > 0u ? mine : 1u; nx = cnt > 0u ? cnt : 1u;
}
DI void xcd_barrier(const XcdBarrier& b) {
  asm volatile("s_waitcnt vmcnt(0)" ::: "memory");
  __syncthreads();
  if (threadIdx.x == 0) {
    unsigned* bar = b.bar;
    __builtin_amdgcn_s_waitcnt(0);
    unsigned nloc = b.st[0], nx = b.st[1];
    if (nloc == 0u) { xcd_barrier_complete(bar, b.x, nloc, nx); b.st[0] = nloc; b.st[1] = nx; }
    const unsigned old = xb_add(&bar[XB_XSUB(b.x)], 1u);
    const unsigned gen = old / nloc;
    if (old + 1u == (gen + 1u) * nloc) {
      __builtin_amdgcn_fence(__ATOMIC_RELEASE, "agent");
      asm volatile("s_waitcnt vmcnt(0)" ::: "memory");
      const unsigned og = xb_add(&bar[XB_TOP], 1u);
      const unsigned tg = og / nx;
      if (og + 1u == (tg + 1u) * nx) xb_add(&bar[XB_TOPGEN], 1u);
      else XB_SPIN(xb_ld(&bar[XB_TOPGEN]) == tg, bar);
      __builtin_amdgcn_fence(__ATOMIC_ACQUIRE, "agent");
      xb_add(&bar[XB_XGEN(b.x)], 1u);
      asm volatile("s_waitcnt vmcnt(0)" ::: "memory");
    } else {
      XB_SPIN(xb_ld(&bar[XB_XGEN(b.x)]) == gen, bar);
      __builtin_amdgcn_fence(__ATOMIC_ACQUIRE, "agent");
      asm volatile("s_waitcnt vmcnt(0)" ::: "memory");
    }
  }
  __syncthreads();
}

#ifdef ONLY_PHASE
#define RUNPH(n, call) if (ONLY_PHASE == n) { call; }
#else
#ifndef DUP_PHASE
#define DUP_PHASE -1
#endif
#define RUNPH(n, call) if (lo <= n && n < hi) { call; if (n == DUP_PHASE) { xcd_barrier(xb); call; } if (n + 1 < hi) xcd_barrier(xb); }
#endif
__global__ void __launch_bounds__(256, 2) mega(Params p, int lo, int hi) {
  __shared__ __attribute__((aligned(16))) char smem[SMEM_BYTES];
  __shared__ uint4 xb_words;
  cg::grid_group grid = cg::this_grid();
  if (lo < 0) grid.sync();
  if (threadIdx.x == 0) xb_words = make_uint4(0u, 0u, 0u, 0u);
  __syncthreads();
  XcdBarrier xb = xcd_barrier_post((unsigned*)(p.ws + OFF_BAR), (volatile LAS unsigned*)&xb_words);
  RUNPH(0, phase0(p, smem))
  RUNPH(1, phase1(p, smem))
  RUNPH(2, phase2(p, smem))
  RUNPH(3, phase3(p, smem))
  RUNPH(4, phase4(p))
  RUNPH(5, phase5(p, smem))
  RUNPH(6, phase6(p, smem))
  RUNPH(7, phase7(p, smem))
  RUNPH(8, phase8(p, smem))
  RUNPH(9, phase9(p, smem))
  RUNPH(10, phase10(p, smem))
  RUNPH(11, phase11(p, smem))
  RUNPH(12, phase12(p, smem))
  RUNPH(13, phase13(p))
  RUNPH(14, phase14(p))
  RUNPH(15, phase15(p))
  RUNPH(16, phase16(p))
}

extern "C" void kernel_launch(void* const* d_in, const int* in_sizes, int n_in, void* d_out, int out_size, void* d_ws,
                              size_t ws_size, hipStream_t stream) {
  static int grid_blocks = 0;
  if (!grid_blocks) {
    int dev = 0, cus = 0, per_cu = 0;
    hipGetDevice(&dev);
    hipDeviceGetAttribute(&cus, hipDeviceAttributeMultiprocessorCount, dev);
    hipOccupancyMaxActiveBlocksPerMultiprocessor(&per_cu, mega, 256, 0);
    if (per_cu > 2) per_cu = 2;
    if (per_cu < 1) per_cu = 1;
    grid_blocks = cus * per_cu;
  }
  Params p{};
  const float** pp = (const float**)&p;
  for (int i = 0; i < 29; ++i) pp[i] = (const float*)d_in[i];
  p.out = (float*)d_out;
  p.ws = (char*)d_ws;
#if N_LAUNCH_SPLIT
  for (int ph = 0; ph < NPHASE; ++ph) {
    hipLaunchKernelGGL(mega, dim3(grid_blocks), dim3(256), 0, stream, p, ph, ph + 1);
  }
#else
  hipMemsetAsync((char*)d_ws + OFF_MOD, 0, (OFF_BAR - OFF_MOD) + XCD_BAR_WORDS * sizeof(unsigned), stream);
  int lo = 0, hi = NPHASE;
  void* args[] = {&p, &lo, &hi};
  hipError_t e = hipLaunchCooperativeKernel((void*)mega, dim3(grid_blocks), dim3(256), args, 0, stream);
  if (e != hipSuccess) fprintf(stderr, "cooperative launch failed: %s (grid %d)\n", hipGetErrorString(e), grid_blocks);
#endif
}
```

```cpp
#include <hip/hip_runtime.h>
#include <hip/hip_cooperative_groups.h>
#include <cstdio>
namespace cg = cooperative_groups;

#define DI __device__ __forceinline__
typedef unsigned short bf16_t;
using bf16x8 = __attribute__((ext_vector_type(8))) short;
using f32x4 = __attribute__((ext_vector_type(4))) float;
using u32x4 = __attribute__((ext_vector_type(4))) unsigned;
using u32x2 = __attribute__((ext_vector_type(2))) unsigned;

#ifndef N_LAUNCH_SPLIT
#define N_LAUNCH_SPLIT 0
#endif

constexpr int NTOK = 20480, NPT = 4096, DM = 1024;
constexpr int NPHASE = 17;
constexpr size_t MiB = 1u << 20;
constexpr size_t OFF_WINT = 0, OFF_WUQT = 9 * MiB, OFF_WUKVT = 9 * MiB + 512 * 1024, OFF_WUPAT = 10 * MiB,
                 OFF_WUPBT = 11 * MiB, OFF_WOT = 12 * MiB, OFF_WCT = 14 * MiB, OFF_WPQB = 18 * MiB,
                 OFF_KEYSB = 22 * MiB, OFF_MOD = 22 * MiB + 512 * 1024, OFF_BAR = 22 * MiB + 768 * 1024, OFF_ROPE = 23 * MiB, A0 = 24 * MiB;
constexpr size_t OFF_PD = A0 + 104 * MiB, OFF_H1 = A0 + 0, OFF_CQ = A0 + 40 * MiB, OFF_CKVRAW = A0 + 50 * MiB, OFF_KRRAW = A0 + 60 * MiB,
                 OFF_RQ = A0 + 63 * MiB, OFF_RK = A0 + 83 * MiB, OFF_KT = A0 + 103 * MiB, OFF_VT = A0 + 123 * MiB,
                 OFF_SRG = A0 + 143 * MiB, OFF_CKVALL = A0 + 163 * MiB, OFF_KRALL = A0 + 169 * MiB,
                 OFF_UF = A0 + 171 * MiB, OFF_UB = A0 + 187 * MiB,
                 OFF_SF = A0 + 0, OFF_SB = A0 + 8 * MiB, OFF_RET = A0 + 16 * MiB,
                 OFF_Q = A0 + 63 * MiB, OFF_KN = A0 + 93 * MiB, OFF_VTA = A0 + 117 * MiB, OFF_ATTN = A0 + 141 * MiB,
                 OFF_M = A0 + 163 * MiB,
                 OFF_H2 = A0 + 56 * MiB, OFF_TABU = A0 + 36 * MiB, OFF_TABV = A0 + 0, OFF_INVU = A0 + 52 * MiB,
                 OFF_INVV = A0 + 53 * MiB, OFF_ELIST = A0 + 16 * MiB, OFF_GLIST = A0 + 26 * MiB, OFF_SCORES = A0 + 104 * MiB;
constexpr size_t OUT_CKV = 20971520, OUT_KR = 21495808, OUT_SF = 21626880, OUT_SB = 22675456;
constexpr int NKV = 24576;
constexpr int SMEM_BYTES = 73728;

struct Params {
  const float *x_prompt, *x_sample, *c, *cache_ckv, *cache_krope, *st_f, *st_b, *c_ctx, *w_mod, *b_mod, *norm_mix,
      *norm_ffn, *norm_final, *w_in, *q_norm, *kv_norm, *w_uq, *w_ukv, *lg_f, *lg_b, *ret_gn, *w_up_a, *w_up_b, *w_o,
      *peer_wq, *keys1, *keys2, *peer_u, *peer_v;
  float* out;
  char* ws;
};

DI unsigned f2bf(float x) {
  unsigned u = __float_as_uint(x);
  u += 0x7fffu + ((u >> 16) & 1u);
  return u >> 16;
}
DI float bf2f(unsigned b) { return __uint_as_float(b << 16); }
typedef __bf16 hbf16x2_t __attribute__((ext_vector_type(2)));
typedef float hf32x2_t __attribute__((ext_vector_type(2)));
DI unsigned pack2(float a, float b) {
  hf32x2_t f = {a, b};
  return __builtin_bit_cast(unsigned, __builtin_convertvector(f, hbf16x2_t));
}
DI float ex2(float x) { return __builtin_amdgcn_exp2f(x); }
DI float bflo(unsigned u) { return __uint_as_float(u << 16); }
DI float bfhi(unsigned u) { return __uint_as_float(u & 0xffff0000u); }
DI float wsum(float v) {
#pragma unroll
  for (int o = 32; o > 0; o >>= 1) v += __shfl_xor(v, o);
  return v;
}
DI float sigmoidf_(float x) { return 1.f / (1.f + __expf(-x)); }
DI float siluf_(float x) { return x / (1.f + __expf(-x)); }
DI float geluf_(float x) { return 0.5f * x * (1.f + tanhf(0.7978845608028654f * (x + 0.044715f * x * x * x))); }
DI const float* xrow(const Params& p, int tok) {
  return tok < NPT ? p.x_prompt + (size_t)tok * DM : p.x_sample + (size_t)(tok - NPT) * DM;
}
DI int modidx(int tok) { return tok < NPT ? 0 : 1 + ((tok - NPT) >> 11); }
DI int kvrow(int tok) {
  if (tok < NPT) return tok;
  int t = tok - NPT;
  return NPT + (t >> 11) * 2560 + (t & 2047);
}
DI void st_bf16x16(bf16_t* dst, const float (&v)[16]) {
  u32x4 a, b;
  a[0] = pack2(v[0], v[1]); a[1] = pack2(v[2], v[3]); a[2] = pack2(v[4], v[5]); a[3] = pack2(v[6], v[7]);
  b[0] = pack2(v[8], v[9]); b[1] = pack2(v[10], v[11]); b[2] = pack2(v[12], v[13]); b[3] = pack2(v[14], v[15]);
  *(u32x4*)dst = a;
  *(u32x4*)(dst + 8) = b;
}
DI void st_f32x16(float* dst, const float (&v)[16]) {
#pragma unroll
  for (int i = 0; i < 4; ++i) *(float4*)(dst + 4 * i) = make_float4(v[4 * i], v[4 * i + 1], v[4 * i + 2], v[4 * i + 3]);
}
DI void ld_bf16x16(const bf16_t* src, float (&v)[16]) {
  u32x4 a = *(const u32x4*)src, b = *(const u32x4*)(src + 8);
#pragma unroll
  for (int i = 0; i < 4; ++i) {
    v[2 * i] = bflo(a[i]); v[2 * i + 1] = bfhi(a[i]);
    v[8 + 2 * i] = bflo(b[i]); v[8 + 2 * i + 1] = bfhi(b[i]);
  }
}

constexpr int LDK = 64;
template <int SCALE>
DI void gemm_kloop(f32x4 (&acc)[4][4], const bf16_t* __restrict__ A, int lda, const bf16_t* __restrict__ B, int ldb,
                   int K, char* smem, float sc_a, float sc_b) {
  bf16_t* As = (bf16_t*)smem;
  bf16_t* Bs = As + 128 * LDK;
  const int tid = threadIdx.x, lane = tid & 63, w = tid >> 6, wm = w >> 1, wn = w & 1, l15 = lane & 15, g = lane >> 4;
  u32x4 ra[4], rb[4];
  int arow[4], kc[4], ldsa[4], ldsb[4];
#pragma unroll
  for (int i = 0; i < 4; ++i) {
    int c = tid + 256 * i;
    int r = c >> 3;
    kc[i] = (c & 7) * 8;
    arow[i] = r;
    int rr = r & 63;
    int rho = (r & 64) | (((rr >> 2) & 3) << 4) | ((rr >> 4) << 2) | (rr & 3);
    ldsa[i] = rho * LDK + (((c & 7) ^ ((rho >> 1) & 7)) * 8);
    ldsb[i] = r * LDK + (((c & 7) ^ ((r >> 1) & 7)) * 8);
  }
#pragma unroll
  for (int i = 0; i < 4; ++i) {
    ra[i] = *(const u32x4*)(A + (size_t)arow[i] * lda + kc[i]);
    rb[i] = *(const u32x4*)(B + (size_t)arow[i] * ldb + kc[i]);
  }
  __syncthreads();
#pragma unroll
  for (int i = 0; i < 4; ++i) {
    *(u32x4*)(As + ldsa[i]) = ra[i];
    *(u32x4*)(Bs + ldsb[i]) = rb[i];
  }
  if (64 < K) {
#pragma unroll
    for (int i = 0; i < 4; ++i) {
      ra[i] = *(const u32x4*)(A + (size_t)arow[i] * lda + 64 + kc[i]);
      rb[i] = *(const u32x4*)(B + (size_t)arow[i] * ldb + 64 + kc[i]);
    }
  }
  __syncthreads();
  int buf = 0;
  for (int k0 = 0; k0 < K; k0 += 64, buf ^= 1) {
    const bf16_t* Ac = As + buf * (256 * LDK);
    const bf16_t* Bc = Bs + buf * (256 * LDK);
#pragma unroll
    for (int ks = 0; ks < 2; ++ks) {
      bf16x8 af[4], bfr[4];
#pragma unroll
      for (int f = 0; f < 4; ++f)
        af[f] = *(const bf16x8*)(Ac + (wm * 64 + f * 16 + l15) * LDK + (((ks * 4 + g) ^ (l15 >> 1)) * 8));
#pragma unroll
      for (int c = 0; c < 4; ++c)
        bfr[c] = *(const bf16x8*)(Bc + (wn * 64 + c * 16 + l15) * LDK + (((ks * 4 + g) ^ (l15 >> 1)) * 8));
      if (SCALE) {
        float fac[8];
#pragma unroll
        for (int i = 0; i < 8; ++i) fac[i] = ex2(sc_a + sc_b * (float)(k0 + ks * 32 + g * 8 + i));
#pragma unroll
        for (int f = 0; f < 4; ++f) {
          u32x4 u = __builtin_bit_cast(u32x4, af[f]);
#pragma unroll
          for (int i = 0; i < 4; ++i) u[i] = pack2(bflo(u[i]) * fac[2 * i], bfhi(u[i]) * fac[2 * i + 1]);
          af[f] = __builtin_bit_cast(bf16x8, u);
        }
      }
#pragma unroll
      for (int f = 0; f < 4; ++f)
#pragma unroll
        for (int c = 0; c < 4; ++c) acc[f][c] = __builtin_amdgcn_mfma_f32_16x16x32_bf16(af[f], bfr[c], acc[f][c], 0, 0, 0);
    }
    if (k0 + 64 < K) {
      bf16_t* An = As + (buf ^ 1) * (256 * LDK);
      bf16_t* Bn = Bs + (buf ^ 1) * (256 * LDK);
#pragma unroll
      for (int i = 0; i < 4; ++i) {
        *(u32x4*)(An + ldsa[i]) = ra[i];
        *(u32x4*)(Bn + ldsb[i]) = rb[i];
      }
      if (k0 + 128 < K) {
#pragma unroll
        for (int i = 0; i < 4; ++i) {
          ra[i] = *(const u32x4*)(A + (size_t)arow[i] * lda + k0 + 128 + kc[i]);
          rb[i] = *(const u32x4*)(B + (size_t)arow[i] * ldb + k0 + 128 + kc[i]);
        }
      }
      __syncthreads();
    }
  }
}
DI void acc_zero(f32x4 (&acc)[4][4]) {
#pragma unroll
  for (int f = 0; f < 4; ++f)
#pragma unroll
    for (int c = 0; c < 4; ++c) acc[f][c] = f32x4{0.f, 0.f, 0.f, 0.f};
}
template <class F>
DI void epilogue(const f32x4 (&acc)[4][4], F&& epi) {
  const int tid = threadIdx.x, lane = tid & 63, w = tid >> 6, wm = w >> 1, wn = w & 1, l15 = lane & 15, g = lane >> 4;
#pragma unroll
  for (int c = 0; c < 4; ++c) {
    float v[16];
#pragma unroll
    for (int f = 0; f < 4; ++f)
#pragma unroll
      for (int j = 0; j < 4; ++j) v[f * 4 + j] = acc[f][c][j];
    epi(wm * 64 + 16 * g, wn * 64 + c * 16 + l15, v);
  }
}
DI bool tile_map(int it, int Ft, int Tt, int fsplit, int& ft, int& tt) {
  const int bid = blockIdx.x, nb = gridDim.x;
  int xcd = bid & 7, loc = bid >> 3, nloc = nb >> 3;
  if (loc >= nloc) return false;
  int fg = xcd % fsplit, tg = xcd / fsplit, tsplit = 8 / fsplit;
  int Fg = Ft / fsplit, Tg = Tt / tsplit;
  int i = loc + it * nloc;
  if (i >= Fg * Tg) return false;
  ft = fg * Fg + i % Fg;
  tt = tg * Tg + i / Fg;
  return true;
}
DI int vbid() {
  const int bid = blockIdx.x, nb = gridDim.x;
  if (nb & 7) return bid;
  return (bid & 7) * (nb >> 3) + (bid >> 3);
}

DI int colmap(int mode, int np) {
  if (mode == 1) return np < 416 ? np : (np < 512 ? -1 : np - 96);
  if (mode == 2) return np < 512 ? ((np >> 6) * 128 + (np & 63)) : (((np - 512) >> 6) * 128 + 64 + ((np - 512) & 63));
  return np;
}
DI void tconv_tile(const float* __restrict__ src, int ldsrc, bf16_t* __restrict__ dst, int K, int kt, int nt, int mode,
                   char* smem) {
  float* lds = (float*)smem;
  const int tid = threadIdx.x;
  {
    int col = tid & 63, rq = tid >> 6;
    int n = colmap(mode, nt * 64 + col);
#pragma unroll 4
    for (int r = 0; r < 16; ++r) {
      int kl = r * 4 + rq;
      float v = n >= 0 ? src[(size_t)(kt * 64 + kl) * ldsrc + n] : 0.f;
      lds[kl * 65 + col] = v;
    }
  }
  __syncthreads();
  {
    int nl = tid >> 2, kq = (tid & 3) * 16;
    float v[16];
#pragma unroll
    for (int i = 0; i < 16; ++i) v[i] = lds[(kq + i) * 65 + nl];
    st_bf16x16(dst + (size_t)(nt * 64 + nl) * K + kt * 64 + kq, v);
  }
  __syncthreads();
}
DI void mod_item(const Params& p, int item, char* smem) {
  float* sil = (float*)smem;
  const int tid = threadIdx.x;
  const int cg_ = item >> 2, slab = item & 3, kbase = slab * 256;
  for (int i = tid; i < 9 * 256; i += 256) {
    int j = i >> 8, k = kbase + (i & 255);
    float cv = j == 0 ? p.c_ctx[k] : p.c[(j - 1) * 1024 + k];
    sil[i] = siluf_(cv);
  }
  __syncthreads();
  const int kq = tid >> 6, nn = tid & 63, n0 = cg_ * 64;
  float acc[9];
#pragma unroll
  for (int j = 0; j < 9; ++j) acc[j] = 0.f;
#pragma unroll 1
  for (int i0 = 0; i0 < 64; i0 += 16) {
    float wv[16];
#pragma unroll
    for (int i = 0; i < 16; ++i) wv[i] = p.w_mod[(size_t)(kbase + kq + 4 * (i0 + i)) * 6144 + n0 + nn];
#pragma unroll
    for (int i = 0; i < 16; ++i)
#pragma unroll
      for (int j = 0; j < 9; ++j) acc[j] += sil[j * 256 + kq + 4 * (i0 + i)] * wv[i];
  }
  __syncthreads();
  float* part = (float*)smem + 9 * 256;
#pragma unroll
  for (int j = 0; j < 9; ++j) part[(kq * 9 + j) * 64 + nn] = acc[j];
  __syncthreads();
  float* mod = (float*)(p.ws + OFF_MOD);
  for (int i = tid; i < 9 * 64; i += 256) {
    int j = i >> 6, n = i & 63;
    float s = part[(0 * 9 + j) * 64 + n] + part[(1 * 9 + j) * 64 + n] + part[(2 * 9 + j) * 64 + n] + part[(3 * 9 + j) * 64 + n];
    if (slab == 0) s += p.b_mod[n0 + n];
    atomicAdd(mod + j * 6144 + n0 + n, s);
  }
  __syncthreads();
}
DI void conv_flat(const float* __restrict__ src, bf16_t* __restrict__ dst, size_t n) {
  size_t i = ((size_t)blockIdx.x * 256 + threadIdx.x) * 8;
  const size_t stride = (size_t)gridDim.x * 256 * 8;
  for (; i < n; i += stride) {
    float4 a = *(const float4*)(src + i), b = *(const float4*)(src + i + 4);
    u32x4 o;
    o[0] = pack2(a.x, a.y); o[1] = pack2(a.z, a.w); o[2] = pack2(b.x, b.y); o[3] = pack2(b.z, b.w);
    *(u32x4*)(dst + i) = o;
  }
}
DI void phase0(const Params& p, char* smem) {
  const int bid = blockIdx.x, nb = gridDim.x;
  char* ws = p.ws;
  const int n_mod = 384;
  const int t_in = 16 * 72, t_uq = 4 * 12, t_ukv = 2 * 16, t_upa = 8 * 16, t_upb = 8 * 16, t_o = 16 * 16;
  const int total = n_mod + t_in + t_uq + t_ukv + t_upa + t_upb + t_o;
  for (int it = bid; it < total; it += nb) {
    int i = it;
    if (i < n_mod) { mod_item(p, i, smem); continue; }
    i -= n_mod;
    if (i < t_in) { tconv_tile(p.w_in, 4512, (bf16_t*)(ws + OFF_WINT), 1024, i / 72, i % 72, 1, smem); continue; }
    i -= t_in;
    if (i < t_uq) { tconv_tile(p.w_uq, 768, (bf16_t*)(ws + OFF_WUQT), 256, i / 12, i % 12, 0, smem); continue; }
    i -= t_uq;
    if (i < t_ukv) { tconv_tile(p.w_ukv, 1024, (bf16_t*)(ws + OFF_WUKVT), 128, i / 16, i % 16, 2, smem); continue; }
    i -= t_ukv;
    if (i < t_upa) { tconv_tile(p.w_up_a, 1024, (bf16_t*)(ws + OFF_WUPAT), 512, i / 16, i % 16, 0, smem); continue; }
    i -= t_upa;
    if (i < t_upb) { tconv_tile(p.w_up_b, 1024, (bf16_t*)(ws + OFF_WUPBT), 512, i / 16, i % 16, 0, smem); continue; }
    i -= t_upb;
    tconv_tile(p.w_o, 1024, (bf16_t*)(ws + OFF_WOT), 1024, i / 16, i % 16, 0, smem);
  }
  conv_flat(p.peer_wq, (bf16_t*)(ws + OFF_WPQB), (size_t)1024 * 2048);
  {
    size_t i = ((size_t)bid * 256 + threadIdx.x) * 8;
    const size_t stride = (size_t)nb * 256 * 8;
    bf16_t* kb = (bf16_t*)(ws + OFF_KEYSB);
    for (; i < (size_t)2 * 131072; i += stride) {
      int half = i >= 131072;
      size_t s = i - (size_t)half * 131072;
      int h = (int)(s >> 14);
      size_t r = s & 16383;
      const float* src = (half ? p.keys2 : p.keys1) + s;
      float4 a = *(const float4*)(src), b = *(const float4*)(src + 4);
      u32x4 o;
      o[0] = pack2(a.x, a.y); o[1] = pack2(a.z, a.w); o[2] = pack2(b.x, b.y); o[3] = pack2(b.z, b.w);
      *(u32x4*)(kb + ((size_t)(h * 2 + half) << 14) + r) = o;
    }
  }
  {
    float2* rope = (float2*)(ws + OFF_ROPE);
    for (int idx = bid * 256 + threadIdx.x; idx < 2048 * 16; idx += nb * 256) {
      const int t = idx >> 4, a = idx & 15;
      const float pos = (a < 8) ? (float)(t >> 6) : (float)(t & 63);
      const float fr = exp2f(-(float)(a & 7) * 1.6609640474436813f);
      float sn, cs;
      sincosf(pos * fr, &sn, &cs);
      rope[idx] = make_float2(cs, sn);
    }
  }
}

DI void rows_norm_mod(const Params& p, const float* nw, int sh_off, int sc_off, bool from_out, bf16_t* dst) {
  const int lane = threadIdx.x & 63, w = threadIdx.x >> 6;
  const float* mod = (const float*)(p.ws + OFF_MOD);
  for (int tok = blockIdx.x * 4 + w; tok < NTOK; tok += gridDim.x * 4) {
    const float* xr = from_out ? p.out + (size_t)tok * DM : xrow(p, tok);
    const float* mj = mod + modidx(tok) * 6144;
    float4 xv[4];
    float ss = 0.f;
#pragma unroll
    for (int i = 0; i < 4; ++i) {
      xv[i] = *(const float4*)(xr + (i * 64 + lane) * 4);
      ss += xv[i].x * xv[i].x + xv[i].y * xv[i].y + xv[i].z * xv[i].z + xv[i].w * xv[i].w;
    }
    ss = wsum(ss);
    float rstd = rsqrtf(ss * (1.f / 1024.f) + 1e-6f);
#pragma unroll
    for (int i = 0; i < 4; ++i) {
      int e = (i * 64 + lane) * 4;
      float4 nv = *(const float4*)(nw + e), sh = *(const float4*)(mj + sh_off + e), sc = *(const float4*)(mj + sc_off + e);
      float h0 = (xv[i].x * rstd) * nv.x * (1.f + sc.x) + sh.x;
      float h1 = (xv[i].y * rstd) * nv.y * (1.f + sc.y) + sh.y;
      float h2 = (xv[i].z * rstd) * nv.z * (1.f + sc.z) + sh.z;
      float h3 = (xv[i].w * rstd) * nv.w * (1.f + sc.w) + sh.w;
      u32x2 o;
      o[0] = pack2(h0, h1); o[1] = pack2(h2, h3);
      *(u32x2*)(dst + (size_t)tok * DM + e) = o;
    }
  }
}
DI void phase1(const Params& p, char* smem) {
  rows_norm_mod(p, p.norm_mix, 0, 1024, false, (bf16_t*)(p.ws + OFF_H1));
  const bf16_t* wpq = (const bf16_t*)(p.ws + OFF_WPQB);
  const bf16_t* kb = (const bf16_t*)(p.ws + OFF_KEYSB);
  bf16_t* wct = (bf16_t*)(p.ws + OFF_WCT);
  for (int it = blockIdx.x; it < 128; it += gridDim.x) {
    int hh = it >> 3, mt = it & 7;
    f32x4 acc[4][4];
    acc_zero(acc);
    gemm_kloop<0>(acc, wpq + (size_t)(mt * 128) * 2048 + hh * 128, 2048, kb + (size_t)hh * 16384, 128, 128, smem, 0.f, 0.f);
    epilogue(acc, [&](int m, int n, float (&v)[16]) { st_bf16x16(wct + (size_t)(hh * 128 + n) * 1024 + mt * 128 + m, v); });
  }
}

DI void phase2(const Params& p, char* smem) {
  char* ws = p.ws;
  const bf16_t* winT = (const bf16_t*)(ws + OFF_WINT);
  const bf16_t* h1 = (const bf16_t*)(ws + OFF_H1);
  bf16_t* cq = (bf16_t*)(ws + OFF_CQ);
  float* ckvraw = (float*)(ws + OFF_CKVRAW);
  float* krraw = (float*)(ws + OFF_KRRAW);
  bf16_t* rq = (bf16_t*)(ws + OFF_RQ);
  bf16_t* rk = (bf16_t*)(ws + OFF_RK);
  bf16_t* kT = (bf16_t*)(ws + OFF_KT);
  bf16_t* vT = (bf16_t*)(ws + OFF_VT);
  bf16_t* srg = (bf16_t*)(ws + OFF_SRG);
  bf16_t* sga = (bf16_t*)p.out;
  bf16_t* sgb = sga + (size_t)NTOK * 1024;
  for (int it = 0;; ++it) {
    int ft, tt;
    if (!tile_map(it, 36, 160, 4, ft, tt)) break;
    f32x4 acc[4][4];
    acc_zero(acc);
    const bf16_t* W = winT + (size_t)ft * 128 * 1024;
    const bf16_t* H = h1 + (size_t)tt * 128 * 1024;
    const int tok0 = tt * 128, f0 = ft * 128;
    if (ft >= 8 && ft < 16) {
      gemm_kloop<0>(acc, H, 1024, W, 1024, 1024, smem, 0.f, 0.f);
      if (ft < 12) {
        epilogue(acc, [&](int m, int n, float (&v)[16]) {
          int feat = f0 - 1024 + n, tok = tok0 + m;
#pragma unroll
          for (int i = 0; i < 16; ++i) v[i] *= 0.08838834764831845f;
          st_bf16x16(kT + (size_t)feat * NTOK + tok, v);
#pragma unroll
          for (int i = 0; i < 16; ++i) rk[(size_t)(tok + i) * 512 + feat] = (bf16_t)f2bf(v[i]);
        });
      } else {
        epilogue(acc, [&](int m, int n, float (&v)[16]) {
          int feat = f0 - 1536 + n, tok = tok0 + m;
          st_bf16x16(vT + (size_t)feat * NTOK + tok, v);
        });
      }
    } else {
      gemm_kloop<0>(acc, W, 1024, H, 1024, 1024, smem, 0.f, 0.f);
      if (ft < 2) {
        epilogue(acc, [&](int m, int n, float (&v)[16]) { st_bf16x16(cq + (size_t)(tok0 + n) * 256 + f0 + m, v); });
      } else if (ft == 2) {
        epilogue(acc, [&](int m, int n, float (&v)[16]) { st_f32x16(ckvraw + (size_t)(tok0 + n) * 128 + m, v); });
      } else if (ft == 3) {
        epilogue(acc, [&](int m, int n, float (&v)[16]) {
          if (m < 32) st_f32x16(krraw + (size_t)(tok0 + n) * 32 + m, v);
        });
      } else if (ft < 8) {
        epilogue(acc, [&](int m, int n, float (&v)[16]) { st_bf16x16(rq + (size_t)(tok0 + n) * 512 + f0 - 512 + m, v); });
      } else if (ft < 20) {
        epilogue(acc, [&](int m, int n, float (&v)[16]) {
#pragma unroll
          for (int i = 0; i < 16; ++i) v[i] = siluf_(v[i]);
          st_bf16x16(srg + (size_t)(tok0 + n) * 512 + f0 - 2048 + m, v);
        });
      } else if (ft < 28) {
        epilogue(acc, [&](int m, int n, float (&v)[16]) {
#pragma unroll
          for (int i = 0; i < 16; ++i) v[i] = sigmoidf_(v[i]);
          st_bf16x16(sga + (size_t)(tok0 + n) * 1024 + f0 - 2560 + m, v);
        });
      } else {
        epilogue(acc, [&](int m, int n, float (&v)[16]) {
#pragma unroll
          for (int i = 0; i < 16; ++i) v[i] = sigmoidf_(v[i]);
          st_bf16x16(sgb + (size_t)(tok0 + n) * 1024 + f0 - 3584 + m, v);
        });
      }
    }
  }
}

DI float log2gamma(float logit) { return -log1pf(expf(-logit)) * 1.4426950408889634f; }
DI void phase3(const Params& p, char* smem) {
  char* ws = p.ws;
  const int lane = threadIdx.x & 63, w = threadIdx.x >> 6;
  bf16_t* cq = (bf16_t*)(ws + OFF_CQ);
  const float* ckvraw = (const float*)(ws + OFF_CKVRAW);
  const float* krraw = (const float*)(ws + OFF_KRRAW);
  bf16_t* ckvall = (bf16_t*)(ws + OFF_CKVALL);
  bf16_t* krall = (bf16_t*)(ws + OFF_KRALL);
  for (int r = blockIdx.x * 4 + w; r < NTOK + 4096; r += gridDim.x * 4) {
    if (r < NTOK) {
      const int tok = r;
      {
        u32x2 u = *(const u32x2*)(cq + (size_t)tok * 256 + lane * 4);
        float a0 = bflo(u[0]), a1 = bfhi(u[0]), a2 = bflo(u[1]), a3 = bfhi(u[1]);
        float ss = wsum(a0 * a0 + a1 * a1 + a2 * a2 + a3 * a3);
        float rstd = rsqrtf(ss * (1.f / 256.f) + 1e-6f);
        float4 nq = *(const float4*)(p.q_norm + lane * 4);
        u32x2 o;
        o[0] = pack2(a0 * rstd * nq.x, a1 * rstd * nq.y);
        o[1] = pack2(a2 * rstd * nq.z, a3 * rstd * nq.w);
        *(u32x2*)(cq + (size_t)tok * 256 + lane * 4) = o;
      }
      const int row = kvrow(tok);
      {
        float2 v = *(const float2*)(ckvraw + (size_t)tok * 128 + lane * 2);
        float ss = wsum(v.x * v.x + v.y * v.y);
        float rstd = rsqrtf(ss * (1.f / 128.f) + 1e-6f);
        float2 nk = *(const float2*)(p.kv_norm + lane * 2);
        float o0 = v.x * rstd * nk.x, o1 = v.y * rstd * nk.y;
        if (tok < NPT) *(float2*)(p.out + OUT_CKV + (size_t)tok * 128 + lane * 2) = make_float2(o0, o1);
        *(unsigned*)(ckvall + (size_t)row * 128 + lane * 2) = pack2(o0, o1);
      }
      if (lane < 32) {
        float own = krraw[(size_t)tok * 32 + lane];
        float o = own;
        if (tok < NPT) {
          p.out[OUT_KR + (size_t)tok * 32 + lane] = own;
        } else {
          float partner = krraw[(size_t)tok * 32 + (lane ^ 16)];
          int t = (tok - NPT) & 2047;
          const float2 csn = ((const float2*)(ws + OFF_ROPE))[t * 16 + (lane & 15)];
          const float cs = csn.x, sn = csn.y;
          o = lane < 16 ? own * cs - partner * sn : partner * sn + own * cs;
        }
        krall[(size_t)row * 32 + lane] = (bf16_t)f2bf(o);
      }
    } else {
      const int cr = r - NTOK;
      const int b = cr >> 9, pos = cr & 511;
      const int row = NPT + b * 2560 + 2048 + pos;
      float2 v = *(const float2*)(p.cache_ckv + (size_t)cr * 128 + lane * 2);
      *(unsigned*)(ckvall + (size_t)row * 128 + lane * 2) = pack2(v.x, v.y);
      if (lane < 32) krall[(size_t)row * 32 + lane] = (bf16_t)f2bf(p.cache_krope[(size_t)cr * 32 + lane]);
    }
  }
  const bf16_t* kT = (const bf16_t*)(ws + OFF_KT);
  const bf16_t* vT = (const bf16_t*)(ws + OFF_VT);
  float* Uf = (float*)(ws + OFF_UF);
  float* Ub = (float*)(ws + OFF_UB);
  for (int it = blockIdx.x; it < 320; it += gridDim.x) {
    const int blk = it >> 2, h = it & 3;
    const float l2f = log2gamma(p.lg_f[h]), l2b = log2gamma(p.lg_b[h]);
    const bf16_t* Kp = kT + (size_t)(h * 128) * NTOK + blk * 256;
    const bf16_t* Vp = vT + (size_t)(h * 128) * NTOK + blk * 256;
#pragma unroll 1
    for (int dir = 0; dir < 2; ++dir) {
      const float sa = dir ? 0.f : l2f * 255.f, sb = dir ? l2b : -l2f;
      f32x4 acc[4][4];
      acc_zero(acc);
      if (blk < 16) {
        gemm_kloop<1>(acc, Vp, NTOK, Kp, NTOK, 256, smem, sa, sb);
        float* dst = p.out + (dir ? OUT_SB : OUT_SF) + (size_t)(blk * 4 + h) * 16384;
        epilogue(acc, [&](int m, int n, float (&v)[16]) { st_f32x16(dst + n * 128 + m, v); });
      } else {
        gemm_kloop<1>(acc, Kp, NTOK, Vp, NTOK, 256, smem, sa, sb);
        float* dst = (dir ? Ub : Uf) + (size_t)((blk - 16) * 4 + h) * 16384;
        epilogue(acc, [&](int m, int n, float (&v)[16]) { st_f32x16(dst + n * 128 + m, v); });
      }
    }
  }
}

DI void phase4(const Params& p) {
  char* ws = p.ws;
  const float* Uf = (const float*)(ws + OFF_UF);
  const float* Ub = (const float*)(ws + OFF_UB);
  bf16_t* Sf = (bf16_t*)(ws + OFF_SF);
  bf16_t* Sb = (bf16_t*)(ws + OFF_SB);
  for (int idx = blockIdx.x * 256 + threadIdx.x; idx < (1 << 20); idx += gridDim.x * 256) {
    int d = idx & 127, e = (idx >> 7) & 127, h = (idx >> 14) & 3, b = (idx >> 16) & 7, dir = idx >> 19;
    size_t eo = (size_t)e * 128 + d;
    if (dir == 0) {
      float cf = exp2f(log2gamma(p.lg_f[h]) * 256.f);
      float S = p.st_f[(size_t)(b * 4 + h) * 16384 + d * 128 + e];
#pragma unroll
      for (int blk = 0; blk < 8; ++blk) {
        size_t o = (size_t)((b * 8 + blk) * 4 + h) * 16384 + eo;
        Sf[o] = (bf16_t)f2bf(S);
        S = cf * S + Uf[o];
      }
    } else {
      float cb = exp2f(log2gamma(p.lg_b[h]) * 256.f);
      float S = p.st_b[(size_t)(b * 4 + h) * 16384 + d * 128 + e];
#pragma unroll
      for (int blk = 7; blk >= 0; --blk) {
        size_t o = (size_t)((b * 8 + blk) * 4 + h) * 16384 + eo;
        Sb[o] = (bf16_t)f2bf(S);
        S = cb * S + Ub[o];
      }
    }
  }
}

DI bf16x8 scale_frag(bf16x8 q, float s) {
  u32x4 u = __builtin_bit_cast(u32x4, q);
#pragma unroll
  for (int i = 0; i < 4; ++i) u[i] = pack2(bflo(u[i]) * s, bfhi(u[i]) * s);
  return __builtin_bit_cast(bf16x8, u);
}
constexpr int NQT = 1;
DI void phase5(const Params& p, char* smem) {
  char* ws = p.ws;
  const bf16_t* rq = (const bf16_t*)(ws + OFF_RQ);
  const bf16_t* rk = (const bf16_t*)(ws + OFF_RK);
  const bf16_t* vT = (const bf16_t*)(ws + OFF_VT);
  const bf16_t* srg = (const bf16_t*)(ws + OFF_SRG);
  const bf16_t* Sf = (const bf16_t*)(ws + OFF_SF);
  const bf16_t* Sb = (const bf16_t*)(ws + OFF_SB);
  bf16_t* ret = (bf16_t*)(ws + OFF_RET);
  bf16_t* Ks = (bf16_t*)smem;
  bf16_t* Vs = Ks + 64 * 144;
  const int tid = threadIdx.x, lane = tid & 63, w = tid >> 6, l15 = lane & 15, g = lane >> 4;
  for (int item = vbid(); item < 640 * (2 / NQT); item += gridDim.x) {
    const int qb = item >> 2, h = item & 3, blk = (qb * NQT) >> 2;
    const float l2f = log2gamma(p.lg_f[h]), l2b = log2gamma(p.lg_b[h]);
    const int tokw = qb * (64 * NQT) + w * (16 * NQT);
    bf16x8 Q[NQT][4];
#pragma unroll
    for (int qt = 0; qt < NQT; ++qt)
#pragma unroll
      for (int ks = 0; ks < 4; ++ks)
        Q[qt][ks] = *(const bf16x8*)(rq + (size_t)(tokw + qt * 16 + l15) * 512 + h * 128 + ks * 32 + g * 8);
    f32x4 o[8][NQT];
#pragma unroll
    for (int et = 0; et < 8; ++et)
#pragma unroll
      for (int qt = 0; qt < NQT; ++qt) o[et][qt] = f32x4{0.f, 0.f, 0.f, 0.f};
#pragma unroll 1
    for (int kt = 0; kt < 4; ++kt) {
      const int key0 = blk * 256 + kt * 64;
      __syncthreads();
#pragma unroll
      for (int i = 0; i < 4; ++i) {
        int c = tid + 256 * i;
        int r = c >> 4, cc = (c & 15) * 8;
        *(u32x4*)(Ks + r * 144 + cc) = *(const u32x4*)(rk + (size_t)(key0 + r) * 512 + h * 128 + cc);
        int e = c >> 3, c2 = (c & 7) * 8;
        *(u32x4*)(Vs + e * 72 + c2) = *(const u32x4*)(vT + (size_t)(h * 128 + e) * NTOK + key0 + c2);
      }
      __syncthreads();
      bf16x8 P[NQT][2];
#pragma unroll
      for (int qt = 0; qt < NQT; ++qt) {
        f32x4 s[4];
#pragma unroll
        for (int kk = 0; kk < 4; ++kk) s[kk] = f32x4{0.f, 0.f, 0.f, 0.f};
#pragma unroll
        for (int ks = 0; ks < 4; ++ks) {
#pragma unroll
          for (int kk = 0; kk < 4; ++kk) {
            bf16x8 a = *(const bf16x8*)(Ks + (kk * 16 + l15) * 144 + ks * 32 + g * 8);
            s[kk] = __builtin_amdgcn_mfma_f32_16x16x32_bf16(a, Q[qt][ks], s[kk], 0, 0, 0);
          }
        }
        const int iq = (tokw + qt * 16 + l15) & 255;
#pragma unroll
        for (int kk = 0; kk < 4; ++kk) {
#pragma unroll
          for (int j = 0; j < 4; ++j) {
            int jk = kt * 64 + kk * 16 + 4 * g + j;
            int diff = iq - jk;
            float dm = diff > 0 ? ex2(l2f * (float)diff) : (diff < 0 ? ex2(l2b * (float)(-diff)) : 2.f);
            s[kk][j] *= dm;
          }
        }
#pragma unroll
        for (int k2 = 0; k2 < 2; ++k2) {
          u32x4 u;
          u[0] = pack2(s[2 * k2][0], s[2 * k2][1]);
          u[1] = pack2(s[2 * k2][2], s[2 * k2][3]);
          u[2] = pack2(s[2 * k2 + 1][0], s[2 * k2 + 1][1]);
          u[3] = pack2(s[2 * k2 + 1][2], s[2 * k2 + 1][3]);
          P[qt][k2] = __builtin_bit_cast(bf16x8, u);
        }
      }
#pragma unroll
      for (int k2 = 0; k2 < 2; ++k2) {
#pragma unroll
        for (int et = 0; et < 8; ++et) {
          u32x2 lo = *(const u32x2*)(Vs + (et * 16 + l15) * 72 + k2 * 32 + 4 * g);
          u32x2 hi = *(const u32x2*)(Vs + (et * 16 + l15) * 72 + k2 * 32 + 16 + 4 * g);
          u32x4 u;
          u[0] = lo[0]; u[1] = lo[1]; u[2] = hi[0]; u[3] = hi[1];
          bf16x8 a = __builtin_bit_cast(bf16x8, u);
#pragma unroll
          for (int qt = 0; qt < NQT; ++qt) o[et][qt] = __builtin_amdgcn_mfma_f32_16x16x32_bf16(a, P[qt][k2], o[et][qt], 0, 0, 0);
        }
      }
    }
    if (blk >= 16) {
#pragma unroll 1
      for (int dir = 0; dir < 2; ++dir) {
        const bf16_t* S = (dir ? Sb : Sf) + (size_t)((blk - 16) * 4 + h) * 16384;
        float dq[NQT];
#pragma unroll
        for (int qt = 0; qt < NQT; ++qt) {
          int iq = (tokw + qt * 16 + l15) & 255;
          dq[qt] = dir ? exp2f(l2b * (float)(256 - iq)) : exp2f(l2f * (float)(iq + 1));
        }
#pragma unroll
        for (int ks = 0; ks < 4; ++ks) {
          bf16x8 qs[NQT];
#pragma unroll
          for (int qt = 0; qt < NQT; ++qt) qs[qt] = scale_frag(Q[qt][ks], dq[qt]);
#pragma unroll
          for (int et = 0; et < 8; ++et) {
            bf16x8 a = *(const bf16x8*)(S + (size_t)(et * 16 + l15) * 128 + ks * 32 + g * 8);
#pragma unroll
            for (int qt = 0; qt < NQT; ++qt) o[et][qt] = __builtin_amdgcn_mfma_f32_16x16x32_bf16(a, qs[qt], o[et][qt], 0, 0, 0);
          }
        }
      }
    }
#pragma unroll
    for (int qt = 0; qt < NQT; ++qt) {
      const int tok = tokw + qt * 16 + l15;
      float s1 = 0.f;
#pragma unroll
      for (int et = 0; et < 8; ++et)
#pragma unroll
        for (int j = 0; j < 4; ++j) s1 += o[et][qt][j];
      s1 += __shfl_xor(s1, 16);
      s1 += __shfl_xor(s1, 32);
      const float mu = s1 * (1.f / 128.f);
      float s2 = 0.f;
#pragma unroll
      for (int et = 0; et < 8; ++et)
#pragma unroll
        for (int j = 0; j < 4; ++j) {
          float dlt = o[et][qt][j] - mu;
          s2 += dlt * dlt;
        }
      s2 += __shfl_xor(s2, 16);
      s2 += __shfl_xor(s2, 32);
      const float rstd = rsqrtf(s2 * (1.f / 128.f) + 1e-6f);
#pragma unroll
      for (int et = 0; et < 8; ++et) {
        const int e = h * 128 + et * 16 + 4 * g;
        float4 gn = *(const float4*)(p.ret_gn + e);
        u32x2 sg = *(const u32x2*)(srg + (size_t)tok * 512 + e);
        u32x2 ov;
        ov[0] = pack2((o[et][qt][0] - mu) * rstd * gn.x * bflo(sg[0]), (o[et][qt][1] - mu) * rstd * gn.y * bfhi(sg[0]));
        ov[1] = pack2((o[et][qt][2] - mu) * rstd * gn.z * bflo(sg[1]), (o[et][qt][3] - mu) * rstd * gn.w * bfhi(sg[1]));
        *(u32x2*)(ret + (size_t)tok * 512 + e) = ov;
      }
    }
  }
}

DI void phase6(const Params& p, char* smem) {
  char* ws = p.ws;
  const bf16_t* cqn = (const bf16_t*)(ws + OFF_CQ);
  const bf16_t* wuqT = (const bf16_t*)(ws + OFF_WUQT);
  bf16_t* q = (bf16_t*)(ws + OFF_Q);
  for (int it = 0;; ++it) {
    int ft, tt;
    if (!tile_map(it, 6, 160, 1, ft, tt)) break;
    f32x4 acc[4][4];
    acc_zero(acc);
    gemm_kloop<0>(acc, wuqT + (size_t)ft * 128 * 256, 256, cqn + (size_t)tt * 128 * 256, 256, 256, smem, 0.f, 0.f);
    epilogue(acc, [&](int m, int n, float (&v)[16]) { st_bf16x16(q + (size_t)(tt * 128 + n) * 768 + ft * 128 + m, v); });
  }
  const bf16_t* ckvall = (const bf16_t*)(ws + OFF_CKVALL);
  const bf16_t* wukvT = (const bf16_t*)(ws + OFF_WUKVT);
  bf16_t* Kn = (bf16_t*)(ws + OFF_KN);
  bf16_t* Vt = (bf16_t*)(ws + OFF_VTA);
  for (int it = 0;; ++it) {
    int ft, tt;
    if (!tile_map(it, 8, 192, 1, ft, tt)) break;
    f32x4 acc[4][4];
    acc_zero(acc);
    const bf16_t* W = wukvT + (size_t)ft * 128 * 128;
    const bf16_t* X = ckvall + (size_t)tt * 128 * 128;
    if (ft < 4) {
      gemm_kloop<0>(acc, W, 128, X, 128, 128, smem, 0.f, 0.f);
      epilogue(acc, [&](int m, int n, float (&v)[16]) { st_bf16x16(Kn + (size_t)(tt * 128 + n) * 512 + ft * 128 + m, v); });
    } else {
      gemm_kloop<0>(acc, X, 128, W, 128, 128, smem, 0.f, 0.f);
      epilogue(acc, [&](int m, int n, float (&v)[16]) { st_bf16x16(Vt + (size_t)((ft - 4) * 128 + n) * NKV + tt * 128 + m, v); });
    }
  }
}

DI void conv_fp8_rows(const float* __restrict__ src, unsigned char* __restrict__ dst, float* __restrict__ inv);
DI void phase7(const Params& p, char* smem) {
  char* ws = p.ws;
  const bf16_t* q = (const bf16_t*)(ws + OFF_Q);
  const bf16_t* Kn = (const bf16_t*)(ws + OFF_KN);
  const bf16_t* Vt = (const bf16_t*)(ws + OFF_VTA);
  const bf16_t* krall = (const bf16_t*)(ws + OFF_KRALL);
  bf16_t* attn = (bf16_t*)(ws + OFF_ATTN);
  bf16_t* Ks0 = (bf16_t*)smem;
  const int tid = threadIdx.x, lane = tid & 63, w = tid >> 6, l15 = lane & 15, g = lane >> 4;
  const float qscale = 0.10206207261596577f * 1.4426950408889634f;
  for (int item = vbid(); item < 1280; item += gridDim.x) {
    int b, h, qtok0, keyrow0, nkt;
    bool sample;
    if (item < 1024) {
      sample = true; b = item >> 7; h = (item >> 4) & 7; int qb = item & 15;
      qtok0 = NPT + b * 2048 + qb * 128; keyrow0 = NPT + b * 2560; nkt = 40;
    } else {
      int it2 = item - 1024;
      sample = false; b = it2 >> 4; h = (it2 >> 1) & 7; int qb = it2 & 1;
      qtok0 = b * 256 + qb * 128; keyrow0 = b * 256; nkt = 4;
    }
    bf16x8 Q[2][3];
#pragma unroll
    for (int qt = 0; qt < 2; ++qt) {
      const int tokq = qtok0 + w * 32 + qt * 16 + l15;
      const bf16_t* qp = q + (size_t)tokq * 768 + h * 96;
#pragma unroll
      for (int ks = 0; ks < 3; ++ks) {
        u32x4 u = *(const u32x4*)(qp + ks * 32 + g * 8);
        float v[8];
#pragma unroll
        for (int i = 0; i < 4; ++i) { v[2 * i] = bflo(u[i]); v[2 * i + 1] = bfhi(u[i]); }
        if (ks == 2 && sample) {
          u32x4 up = *(const u32x4*)(qp + 64 + (g ^ 2) * 8);
          float pv[8];
#pragma unroll
          for (int i = 0; i < 4; ++i) { pv[2 * i] = bflo(up[i]); pv[2 * i + 1] = bfhi(up[i]); }
          int t = (tokq - NPT) & 2047;
          const float4* rp = (const float4*)((const float2*)(ws + OFF_ROPE) + t * 16 + (g & 1) * 8);
#pragma unroll
          for (int i2 = 0; i2 < 4; ++i2) {
            const float4 c2 = rp[i2];
            const int i = 2 * i2;
            v[i] = g < 2 ? v[i] * c2.x - pv[i] * c2.y : pv[i] * c2.y + v[i] * c2.x;
            v[i + 1] = g < 2 ? v[i + 1] * c2.z - pv[i + 1] * c2.w : pv[i + 1] * c2.w + v[i + 1] * c2.z;
          }
        }
        u32x4 o4;
#pragma unroll
        for (int i = 0; i < 4; ++i) o4[i] = pack2(v[2 * i] * qscale, v[2 * i + 1] * qscale);
        Q[qt][ks] = __builtin_bit_cast(bf16x8, o4);
      }
    }
    f32x4 o[4][2];
#pragma unroll
    for (int et = 0; et < 4; ++et)
#pragma unroll
      for (int qt = 0; qt < 2; ++qt) o[et][qt] = f32x4{0.f, 0.f, 0.f, 0.f};
    float mrun[2] = {-1e30f, -1e30f}, lrun[2] = {0.f, 0.f};
    u32x4 rk_[3], rv_[2];
    auto gload = [&](int kt) {
      const int row0 = keyrow0 + kt * 64;
#pragma unroll
      for (int i = 0; i < 3; ++i) {
        int c = tid + 256 * i;
        int r = c / 12, cc = c - r * 12;
        rk_[i] = cc < 8 ? *(const u32x4*)(Kn + (size_t)(row0 + r) * 512 + h * 64 + cc * 8)
                        : *(const u32x4*)(krall + (size_t)(row0 + r) * 32 + (cc - 8) * 8);
      }
#pragma unroll
      for (int i = 0; i < 2; ++i) {
        int c = tid + 256 * i;
        int e = c >> 3, cc = (c & 7) * 8;
        rv_[i] = *(const u32x4*)(Vt + (size_t)(h * 64 + e) * NKV + row0 + cc);
      }
    };
    auto lstore = [&](int b) {
      bf16_t* Kd = Ks0 + b * 11776;
      bf16_t* Vd = Kd + 64 * 112;
#pragma unroll
      for (int i = 0; i < 3; ++i) {
        int c = tid + 256 * i;
        int r = c / 12, cc = c - r * 12;
        *(u32x4*)(Kd + r * 112 + cc * 8) = rk_[i];
      }
#pragma unroll
      for (int i = 0; i < 2; ++i) {
        int c = tid + 256 * i;
        int e = c >> 3, cc = (c & 7) * 8;
        *(u32x4*)(Vd + e * 72 + cc) = rv_[i];
      }
    };
    gload(0);
    __syncthreads();
    lstore(0);
    if (nkt > 1) gload(1);
    __syncthreads();
#pragma unroll 1
    for (int kt = 0; kt < nkt; ++kt) {
      const bf16_t* Ks = Ks0 + (kt & 1) * 11776;
      const bf16_t* Vs = Ks + 64 * 112;
      f32x4 s[4][2];
#pragma unroll
      for (int kk = 0; kk < 4; ++kk)
#pragma unroll
        for (int qt = 0; qt < 2; ++qt) s[kk][qt] = f32x4{0.f, 0.f, 0.f, 0.f};
#pragma unroll
      for (int ks = 0; ks < 3; ++ks) {
#pragma unroll
        for (int kk = 0; kk < 4; ++kk) {
          bf16x8 a = *(const bf16x8*)(Ks + (kk * 16 + l15) * 112 + ks * 32 + g * 8);
#pragma unroll
          for (int qt = 0; qt < 2; ++qt) s[kk][qt] = __builtin_amdgcn_mfma_f32_16x16x32_bf16(a, Q[qt][ks], s[kk][qt], 0, 0, 0);
        }
      }
      bf16x8 P[2][2];
#pragma unroll
      for (int qt = 0; qt < 2; ++qt) {
        float mx = s[0][qt][0];
#pragma unroll
        for (int kk = 0; kk < 4; ++kk)
#pragma unroll
          for (int j = 0; j < 4; ++j) mx = fmaxf(mx, s[kk][qt][j]);
        mx = fmaxf(mx, __shfl_xor(mx, 16));
        mx = fmaxf(mx, __shfl_xor(mx, 32));
        const float mnew = fmaxf(mrun[qt], mx);
        const bool grow = __ballot(mx > mrun[qt]) != 0ull;
        const float alpha = grow ? ex2(mrun[qt] - mnew) : 1.f;
        mrun[qt] = mnew;
        float ps = 0.f;
#pragma unroll
        for (int kk = 0; kk < 4; ++kk)
#pragma unroll
          for (int j = 0; j < 4; ++j) {
            float e_ = ex2(s[kk][qt][j] - mnew);
            s[kk][qt][j] = e_;
            ps += e_;
          }
        if (grow) {
          lrun[qt] = lrun[qt] * alpha + ps;
#pragma unroll
          for (int et = 0; et < 4; ++et)
#pragma unroll
            for (int j = 0; j < 4; ++j) o[et][qt][j] *= alpha;
        } else {
          lrun[qt] += ps;
        }
#pragma unroll
        for (int k2 = 0; k2 < 2; ++k2) {
          u32x4 u;
          u[0] = pack2(s[2 * k2][qt][0], s[2 * k2][qt][1]);
          u[1] = pack2(s[2 * k2][qt][2], s[2 * k2][qt][3]);
          u[2] = pack2(s[2 * k2 + 1][qt][0], s[2 * k2 + 1][qt][1]);
          u[3] = pack2(s[2 * k2 + 1][qt][2], s[2 * k2 + 1][qt][3]);
          P[qt][k2] = __builtin_bit_cast(bf16x8, u);
        }
      }
#pragma unroll
      for (int k2 = 0; k2 < 2; ++k2) {
#pragma unroll
        for (int et = 0; et < 4; ++et) {
          u32x2 lo = *(const u32x2*)(Vs + (et * 16 + l15) * 72 + k2 * 32 + 4 * g);
          u32x2 hi = *(const u32x2*)(Vs + (et * 16 + l15) * 72 + k2 * 32 + 16 + 4 * g);
          u32x4 u;
          u[0] = lo[0]; u[1] = lo[1]; u[2] = hi[0]; u[3] = hi[1];
          bf16x8 a = __builtin_bit_cast(bf16x8, u);
#pragma unroll
          for (int qt = 0; qt < 2; ++qt) o[et][qt] = __builtin_amdgcn_mfma_f32_16x16x32_bf16(a, P[qt][k2], o[et][qt], 0, 0, 0);
        }
      }
      if (kt + 1 < nkt) {
        lstore((kt + 1) & 1);
        if (kt + 2 < nkt) gload(kt + 2);
        __syncthreads();
      }
    }
#pragma unroll
    for (int qt = 0; qt < 2; ++qt) {
      const int tokq = qtok0 + w * 32 + qt * 16 + l15;
      float lt = lrun[qt];
      lt += __shfl_xor(lt, 16);
      lt += __shfl_xor(lt, 32);
      const float inv = 1.f / lt;
#pragma unroll
      for (int et = 0; et < 4; ++et) {
        u32x2 ov;
        ov[0] = pack2(o[et][qt][0] * inv, o[et][qt][1] * inv);
        ov[1] = pack2(o[et][qt][2] * inv, o[et][qt][3] * inv);
        *(u32x2*)(attn + (size_t)tokq * 512 + h * 64 + et * 16 + 4 * g) = ov;
      }
    }
  }
  conv_fp8_rows(p.peer_u, (unsigned char*)(p.ws + OFF_TABU), (float*)(p.ws + OFF_INVU));
  conv_fp8_rows(p.peer_v, (unsigned char*)(p.ws + OFF_TABV), (float*)(p.ws + OFF_INVV));
}

DI void phase8(const Params& p, char* smem) {
  char* ws = p.ws;
  const bf16_t* attn = (const bf16_t*)(ws + OFF_ATTN);
  const bf16_t* ret = (const bf16_t*)(ws + OFF_RET);
  const bf16_t* wa = (const bf16_t*)(ws + OFF_WUPAT);
  const bf16_t* wb = (const bf16_t*)(ws + OFF_WUPBT);
  const bf16_t* sga = (const bf16_t*)p.out;
  const bf16_t* sgb = sga + (size_t)NTOK * 1024;
  bf16_t* mbuf = (bf16_t*)(ws + OFF_M);
  const int tid = threadIdx.x, lane = tid & 63, w = tid >> 6, wm = w >> 1, wn = w & 1, l15 = lane & 15, g = lane >> 4;
  for (int it = 0;; ++it) {
    int ft, tt;
    if (!tile_map(it, 8, 160, 1, ft, tt)) break;
    f32x4 acc[4][4];
    acc_zero(acc);
    gemm_kloop<0>(acc, wa + (size_t)ft * 128 * 512, 512, attn + (size_t)tt * 128 * 512, 512, 512, smem, 0.f, 0.f);
#pragma unroll
    for (int c = 0; c < 4; ++c) {
      const size_t off = (size_t)(tt * 128 + wn * 64 + c * 16 + l15) * 1024 + ft * 128 + wm * 64 + 16 * g;
      float a[16], bq[16];
      ld_bf16x16(sga + off, a);
      ld_bf16x16(sgb + off, bq);
#pragma unroll
      for (int f = 0; f < 4; ++f)
#pragma unroll
        for (int j = 0; j < 4; ++j) acc[f][c][j] *= a[f * 4 + j] / fmaxf(bq[f * 4 + j], 1e-30f);
    }
    gemm_kloop<0>(acc, wb + (size_t)ft * 128 * 512, 512, ret + (size_t)tt * 128 * 512, 512, 512, smem, 0.f, 0.f);
    epilogue(acc, [&](int m, int n, float (&v)[16]) {
      const size_t off = (size_t)(tt * 128 + n) * 1024 + ft * 128 + m;
      float bq[16];
      ld_bf16x16(sgb + off, bq);
#pragma unroll
      for (int i = 0; i < 16; ++i) v[i] *= bq[i];
      st_bf16x16(mbuf + off, v);
    });
  }
}
DI void phase9(const Params& p, char* smem) {
  char* ws = p.ws;
  const bf16_t* mbuf = (const bf16_t*)(ws + OFF_M);
  const bf16_t* wo = (const bf16_t*)(ws + OFF_WOT);
  const float* mod = (const float*)(ws + OFF_MOD);
  for (int it = 0;; ++it) {
    int ft, tt;
    if (!tile_map(it, 8, 160, 1, ft, tt)) break;
    f32x4 acc[4][4];
    acc_zero(acc);
    gemm_kloop<0>(acc, wo + (size_t)ft * 128 * 1024, 1024, mbuf + (size_t)tt * 128 * 1024, 1024, 1024, smem, 0.f, 0.f);
    epilogue(acc, [&](int m, int n, float (&v)[16]) {
      const int tok = tt * 128 + n, feat = ft * 128 + m;
      const float* xr = xrow(p, tok) + feat;
      const float* g1 = mod + modidx(tok) * 6144 + 2048 + feat;
#pragma unroll
      for (int i = 0; i < 4; ++i) {
        float4 xv = *(const float4*)(xr + 4 * i), gv = *(const float4*)(g1 + 4 * i);
        v[4 * i] = xv.x + gv.x * v[4 * i];
        v[4 * i + 1] = xv.y + gv.y * v[4 * i + 1];
        v[4 * i + 2] = xv.z + gv.z * v[4 * i + 2];
        v[4 * i + 3] = xv.w + gv.w * v[4 * i + 3];
      }
      st_f32x16(p.out + (size_t)tok * DM + feat, v);
    });
  }
}
DI void conv_fp8_rows(const float* __restrict__ src, unsigned char* __restrict__ dst, float* __restrict__ inv) {
  const int lane = threadIdx.x & 63, w = threadIdx.x >> 6;
  for (int r = blockIdx.x * 4 + w; r < 16384; r += gridDim.x * 4) {
    const float* sp = src + (size_t)r * 1024 + lane * 16;
    float4 v[4];
    float am = 0.f;
#pragma unroll
    for (int i = 0; i < 4; ++i) {
      v[i] = *(const float4*)(sp + 4 * i);
      am = fmaxf(am, fmaxf(fmaxf(fabsf(v[i].x), fabsf(v[i].y)), fmaxf(fabsf(v[i].z), fabsf(v[i].w))));
    }
#pragma unroll
    for (int o = 32; o > 0; o >>= 1) am = fmaxf(am, __shfl_xor(am, o));
    const float sc = am > 0.f ? 448.f / am : 1.f;
    u32x4 o4;
#pragma unroll
    for (int i = 0; i < 4; ++i) {
      int wd = 0;
      wd = __builtin_amdgcn_cvt_pk_fp8_f32(v[i].x * sc, v[i].y * sc, wd, false);
      wd = __builtin_amdgcn_cvt_pk_fp8_f32(v[i].z * sc, v[i].w * sc, wd, true);
      o4[i] = (unsigned)wd;
    }
    *(u32x4*)(dst + ((size_t)(lane >> 3) * 16384 + r) * 128 + (lane & 7) * 16) = o4;
    if (lane == 0) inv[r] = am > 0.f ? am * (1.f / 448.f) : 1.f;
  }
}
DI void phase10(const Params& p, char* smem) {
  rows_norm_mod(p, p.norm_ffn, 3072, 4096, true, (bf16_t*)(p.ws + OFF_H2));
}
DI void phase11(const Params& p, char* smem) {
  char* ws = p.ws;
  const bf16_t* h2 = (const bf16_t*)(ws + OFF_H2);
  const bf16_t* wct = (const bf16_t*)(ws + OFF_WCT);
  bf16_t* sc = (bf16_t*)(ws + OFF_SCORES);
  for (int it = 0;; ++it) {
    int ft, tt;
    if (!tile_map(it, 16, 160, 2, ft, tt)) break;
    f32x4 acc[4][4];
    acc_zero(acc);
    gemm_kloop<0>(acc, wct + (size_t)ft * 128 * 1024, 1024, h2 + (size_t)tt * 128 * 1024, 1024, 1024, smem, 0.f, 0.f);
    epilogue(acc, [&](int m, int n, float (&v)[16]) { st_bf16x16(sc + (size_t)(tt * 128 + n) * 2048 + ft * 128 + m, v); });
  }
}

DI unsigned okey(float f) {
  unsigned u = __float_as_uint(f);
  return (u & 0x80000000u) ? ~u : (u | 0x80000000u);
}
DI void wave_lds_sync() {
  __builtin_amdgcn_fence(__ATOMIC_ACQ_REL, "workgroup");
  __builtin_amdgcn_wave_barrier();
}
DI unsigned okey16(unsigned b) { return (b & 0x8000u) ? (~b & 0xFFFFu) : (b | 0x8000u); }
DI unsigned inv_okey16(unsigned k) { return (k & 0x8000u) ? (k & 0x7FFFu) : (~k & 0xFFFFu); }
DI unsigned inv_okey(unsigned k) { return (k & 0x80000000u) ? (k & 0x7FFFFFFFu) : ~k; }
DI void ins16(unsigned (&L)[16], unsigned x) {
#pragma unroll
  for (int i = 0; i < 16; ++i) {
    unsigned t = max(L[i], x);
    x = min(L[i], x);
    L[i] = t;
  }
}
DI void ce_desc(unsigned& a, unsigned& b) {
  const unsigned t = max(a, b);
  b = min(a, b);
  a = t;
}
DI void sort16_desc(unsigned (&a)[16]) {
#pragma unroll
  for (int ks = 1; ks <= 4; ++ks) {
#pragma unroll
    for (int js = ks - 1; js >= 0; --js) {
#pragma unroll
      for (int i = 0; i < 16; ++i) {
        const int k = 1 << ks, j = 1 << js, l = i ^ j;
        if (l > i) {
          if ((i & k) == 0) ce_desc(a[i], a[l]);
          else ce_desc(a[l], a[i]);
        }
      }
    }
  }
}
DI void merge_top16(unsigned (&L)[16], const unsigned (&G)[16]) {
#pragma unroll
  for (int i = 0; i < 16; ++i) L[i] = max(L[i], G[15 - i]);
#pragma unroll
  for (int js = 3; js >= 0; --js) {
#pragma unroll
    for (int i = 0; i < 16; ++i) {
      const int j = 1 << js, l = i ^ j;
      if (l > i) ce_desc(L[i], L[l]);
    }
  }
}
DI unsigned byte16(const unsigned (&d)[4], int i) {
  unsigned r = 0u;
#pragma unroll
  for (int q = 0; q < 4; ++q) r |= d[q] & (0u - (unsigned)((i >> 2) == q));
  return (r >> ((i & 3) * 8)) & 0xFFu;
}
DI unsigned sel16(const unsigned (&A)[16], int i) {
  unsigned r = 0u;
#pragma unroll
  for (int t = 0; t < 16; ++t) r |= A[t] & (0u - (unsigned)(i == t));
  return r;
}
DI void phase12(const Params& p, char* smem) {
  char* ws = p.ws;
  const bf16_t* sc = (const bf16_t*)(ws + OFF_SCORES);
  int* elist = (int*)(ws + OFF_ELIST);
  float* glist = (float*)(ws + OFF_GLIST);
  const int lane = threadIdx.x & 63, w = threadIdx.x >> 6;
  for (int batch = blockIdx.x * 4 + w; batch < NTOK / 4; batch += gridDim.x * 4) {
    const int tok = batch * 4 + (lane >> 4), hh = lane & 15;
    const bf16_t* row = sc + (size_t)tok * 2048 + hh * 128;
    unsigned L[16];
#pragma unroll
    for (int grp8 = 0; grp8 < 8; ++grp8) {
      unsigned G[16];
#pragma unroll
      for (int cc = 0; cc < 2; ++cc) {
        const int c = grp8 * 2 + cc;
        u32x4 u = *(const u32x4*)(row + c * 8);
#pragma unroll
        for (int i = 0; i < 4; ++i) {
          unsigned b0 = u[i] & 0xFFFFu, b1 = u[i] >> 16;
          G[cc * 8 + 2 * i] = (okey16(b0) << 16) | (unsigned)(127 - (c * 8 + 2 * i));
          G[cc * 8 + 2 * i + 1] = (okey16(b1) << 16) | (unsigned)(127 - (c * 8 + 2 * i + 1));
        }
      }
      sort16_desc(G);
      if (grp8 == 0) {
#pragma unroll
        for (int i = 0; i < 16; ++i) L[i] = G[i];
      } else {
        merge_top16(L, G);
      }
    }
    unsigned M[16];
#pragma unroll
    for (int i = 0; i < 16; ++i) M[i] = (unsigned)__shfl_xor((int)L[i], 1);
    float v1[16], v2[16];
#pragma unroll
    for (int i = 0; i < 16; ++i) {
      v1[i] = bf2f(inv_okey16(L[i] >> 16));
      v2[i] = bf2f(inv_okey16(M[i] >> 16));
    }
    unsigned C[16];
    C[0] = ((okey(v1[0] + v2[0]) & 0xFFFFFF00u) | 255u);
    C[1] = ((okey(v1[0] + v2[1]) & 0xFFFFFF00u) | 254u);
    C[2] = ((okey(v1[0] + v2[2]) & 0xFFFFFF00u) | 253u);
    C[3] = ((okey(v1[0] + v2[3]) & 0xFFFFFF00u) | 252u);
    C[4] = ((okey(v1[0] + v2[4]) & 0xFFFFFF00u) | 251u);
    C[5] = ((okey(v1[0] + v2[5]) & 0xFFFFFF00u) | 250u);
    C[6] = ((okey(v1[0] + v2[6]) & 0xFFFFFF00u) | 249u);
    C[7] = ((okey(v1[0] + v2[7]) & 0xFFFFFF00u) | 248u);
    C[8] = ((okey(v1[0] + v2[8]) & 0xFFFFFF00u) | 247u);
    C[9] = ((okey(v1[0] + v2[9]) & 0xFFFFFF00u) | 246u);
    C[10] = ((okey(v1[0] + v2[10]) & 0xFFFFFF00u) | 245u);
    C[11] = ((okey(v1[0] + v2[11]) & 0xFFFFFF00u) | 244u);
    C[12] = ((okey(v1[0] + v2[12]) & 0xFFFFFF00u) | 243u);
    C[13] = ((okey(v1[0] + v2[13]) & 0xFFFFFF00u) | 242u);
    C[14] = ((okey(v1[0] + v2[14]) & 0xFFFFFF00u) | 241u);
    C[15] = ((okey(v1[0] + v2[15]) & 0xFFFFFF00u) | 240u);
    {
      unsigned G[16];
      G[0] = ((okey(v1[1] + v2[0]) & 0xFFFFFF00u) | 239u);
      G[1] = ((okey(v1[1] + v2[1]) & 0xFFFFFF00u) | 238u);
      G[2] = ((okey(v1[1] + v2[2]) & 0xFFFFFF00u) | 237u);
      G[3] = ((okey(v1[1] + v2[3]) & 0xFFFFFF00u) | 236u);
      G[4] = ((okey(v1[1] + v2[4]) & 0xFFFFFF00u) | 235u);
      G[5] = ((okey(v1[1] + v2[5]) & 0xFFFFFF00u) | 234u);
      G[6] = ((okey(v1[1] + v2[6]) & 0xFFFFFF00u) | 233u);
      G[7] = ((okey(v1[1] + v2[7]) & 0xFFFFFF00u) | 232u);
      G[8] = 0u;
      G[9] = 0u;
      G[10] = 0u;
      G[11] = 0u;
      G[12] = 0u;
      G[13] = 0u;
      G[14] = 0u;
      G[15] = 0u;
      merge_top16(C, G);
    }
    {
      unsigned G[16];
      G[0] = ((okey(v1[2] + v2[0]) & 0xFFFFFF00u) | 223u);
      G[1] = ((okey(v1[2] + v2[1]) & 0xFFFFFF00u) | 222u);
      G[2] = ((okey(v1[2] + v2[2]) & 0xFFFFFF00u) | 221u);
      G[3] = ((okey(v1[2] + v2[3]) & 0xFFFFFF00u) | 220u);
      G[4] = ((okey(v1[2] + v2[4]) & 0xFFFFFF00u) | 219u);
      G[5] = 0u;
      G[6] = 0u;
      G[7] = 0u;
      G[8] = 0u;
      G[9] = 0u;
      G[10] = 0u;
      G[11] = 0u;
      G[12] = 0u;
      G[13] = 0u;
      G[14] = 0u;
      G[15] = 0u;
      merge_top16(C, G);
    }
    {
      unsigned G[16];
      G[0] = ((okey(v1[3] + v2[0]) & 0xFFFFFF00u) | 207u);
      G[1] = ((okey(v1[3] + v2[1]) & 0xFFFFFF00u) | 206u);
      G[2] = ((okey(v1[3] + v2[2]) & 0xFFFFFF00u) | 205u);
      G[3] = ((okey(v1[3] + v2[3]) & 0xFFFFFF00u) | 204u);
      G[4] = 0u;
      G[5] = 0u;
      G[6] = 0u;
      G[7] = 0u;
      G[8] = 0u;
      G[9] = 0u;
      G[10] = 0u;
      G[11] = 0u;
      G[12] = 0u;
      G[13] = 0u;
      G[14] = 0u;
      G[15] = 0u;
      merge_top16(C, G);
    }
    {
      unsigned G[16];
      G[0] = ((okey(v1[4] + v2[0]) & 0xFFFFFF00u) | 191u);
      G[1] = ((okey(v1[5] + v2[0]) & 0xFFFFFF00u) | 175u);
      G[2] = ((okey(v1[6] + v2[0]) & 0xFFFFFF00u) | 159u);
      G[3] = ((okey(v1[7] + v2[0]) & 0xFFFFFF00u) | 143u);
      G[4] = ((okey(v1[8] + v2[0]) & 0xFFFFFF00u) | 127u);
      G[5] = ((okey(v1[9] + v2[0]) & 0xFFFFFF00u) | 111u);
      G[6] = ((okey(v1[10] + v2[0]) & 0xFFFFFF00u) | 95u);
      G[7] = ((okey(v1[11] + v2[0]) & 0xFFFFFF00u) | 79u);
      G[8] = ((okey(v1[12] + v2[0]) & 0xFFFFFF00u) | 63u);
      G[9] = ((okey(v1[13] + v2[0]) & 0xFFFFFF00u) | 47u);
      G[10] = ((okey(v1[14] + v2[0]) & 0xFFFFFF00u) | 31u);
      G[11] = ((okey(v1[15] + v2[0]) & 0xFFFFFF00u) | 15u);
      G[12] = 0u;
      G[13] = 0u;
      G[14] = 0u;
      G[15] = 0u;
      merge_top16(C, G);
    }
    {
      unsigned G[16];
      G[0] = ((okey(v1[4] + v2[1]) & 0xFFFFFF00u) | 190u);
      G[1] = ((okey(v1[5] + v2[1]) & 0xFFFFFF00u) | 174u);
      G[2] = ((okey(v1[6] + v2[1]) & 0xFFFFFF00u) | 158u);
      G[3] = ((okey(v1[7] + v2[1]) & 0xFFFFFF00u) | 142u);
      G[4] = 0u;
      G[5] = 0u;
      G[6] = 0u;
      G[7] = 0u;
      G[8] = 0u;
      G[9] = 0u;
      G[10] = 0u;
      G[11] = 0u;
      G[12] = 0u;
      G[13] = 0u;
      G[14] = 0u;
      G[15] = 0u;
      merge_top16(C, G);
    }
    {
      unsigned G[16];
      G[0] = ((okey(v1[4] + v2[2]) & 0xFFFFFF00u) | 189u);
      G[1] = 0u;
      G[2] = 0u;
      G[3] = 0u;
      G[4] = 0u;
      G[5] = 0u;
      G[6] = 0u;
      G[7] = 0u;
      G[8] = 0u;
      G[9] = 0u;
      G[10] = 0u;
      G[11] = 0u;
      G[12] = 0u;
      G[13] = 0u;
      G[14] = 0u;
      G[15] = 0u;
      merge_top16(C, G);
    }
    unsigned ib1[4], ib2[4];
#pragma unroll
    for (int q = 0; q < 4; ++q) {
      ib1[q] = (L[4 * q] & 0xFFu) | ((L[4 * q + 1] & 0xFFu) << 8) | ((L[4 * q + 2] & 0xFFu) << 16) | ((L[4 * q + 3] & 0xFFu) << 24);
      ib2[q] = (M[4 * q] & 0xFFu) | ((M[4 * q + 1] & 0xFFu) << 8) | ((M[4 * q + 2] & 0xFFu) << 16) | ((M[4 * q + 3] & 0xFFu) << 24);
    }
    int ev[16];
    float gv[16];
    const float mx = __uint_as_float(inv_okey(C[0] & 0xFFFFFF00u));
    float den = 0.f;
#pragma unroll
    for (int k = 0; k < 16; ++k) {
      const int ci = 255 - (int)(C[k] & 0xFFu);
      ev[k] = (127 - (int)byte16(ib1, ci >> 4)) * 128 + (127 - (int)byte16(ib2, ci & 15));
      gv[k] = __expf(__uint_as_float(inv_okey(C[k] & 0xFFFFFF00u)) - mx);
      den += gv[k];
    }
    const float inv = 1.f / den;
    if ((lane & 1) == 0) {
      int* ep = elist + (size_t)tok * 128 + (hh >> 1) * 16;
      float* gp = glist + (size_t)tok * 128 + (hh >> 1) * 16;
#pragma unroll
      for (int k = 0; k < 4; ++k) {
        *(int4*)(ep + 4 * k) = make_int4(ev[4 * k], ev[4 * k + 1], ev[4 * k + 2], ev[4 * k + 3]);
        *(float4*)(gp + 4 * k) = make_float4(gv[4 * k] * inv, gv[4 * k + 1] * inv, gv[4 * k + 2] * inv, gv[4 * k + 3] * inv);
      }
    }
  }
}
using f32x2 = __attribute__((ext_vector_type(2))) float;
DI f32x2 cvt8(unsigned w, bool hi) {
  return hi ? __builtin_amdgcn_cvt_pk_f32_fp8((int)w, true) : __builtin_amdgcn_cvt_pk_f32_fp8((int)w, false);
}
struct SMeta { int e[16]; u32x4 ha, hb; };
template <int MODE>
DI void sl_meta(const Params& p, int t, int s, int grp, int ch, SMeta& m) {
  const int* elist = (const int*)(p.ws + (MODE == 0 ? OFF_ELIST : OFF_GLIST));
#pragma unroll
  for (int i = 0; i < 16; ++i) m.e[i] = elist[(size_t)t * 128 + i * 8 + grp];
  if (MODE == 0) {
    const bf16_t* hq = (const bf16_t*)(p.ws + OFF_H2) + (size_t)t * DM + s * 128 + ch * 16;
    m.ha = *(const u32x4*)hq;
    m.hb = *(const u32x4*)(hq + 8);
  }
}
template <int MODE>
DI void sl_rows(const Params& p, int s, int ch, const SMeta& m, u32x4 (&r)[16]) {
  const unsigned char* tab = (const unsigned char*)(p.ws + (MODE == 0 ? OFF_TABU : OFF_TABV));
#pragma unroll
  for (int i = 0; i < 16; ++i) r[i] = *(const u32x4*)(tab + ((size_t)s * 16384 + (m.e[i] & 0xFFFF)) * 128 + ch * 16);
}
template <int MODE>
DI void sl_compute(const Params& p, int t, int s, int lane, const SMeta& m, const u32x4 (&r)[16]) {
  const int grp = lane >> 3, ch = lane & 7;
  if (MODE == 0) {
    f32x2 hp[8];
#pragma unroll
    for (int i = 0; i < 4; ++i) {
      hp[i] = f32x2{bflo(m.ha[i]), bfhi(m.ha[i])};
      hp[4 + i] = f32x2{bflo(m.hb[i]), bfhi(m.hb[i])};
    }
    float keep0 = 0.f, keep1 = 0.f;
#pragma unroll
    for (int i = 0; i < 16; ++i) {
      f32x2 d2 = f32x2{0.f, 0.f};
#pragma unroll
      for (int j = 0; j < 4; ++j) {
        d2 += cvt8(r[i][j], false) * hp[2 * j];
        d2 += cvt8(r[i][j], true) * hp[2 * j + 1];
      }
      float d = d2[0] + d2[1];
      d += __shfl_xor(d, 1);
      d += __shfl_xor(d, 2);
      d += __shfl_xor(d, 4);
      if (i < 8) keep0 = (ch == i) ? d : keep0;
      else keep1 = (ch == i - 8) ? d : keep1;
    }
    float* po = (float*)(p.ws + OFF_PD) + (size_t)t * 1024 + s * 128;
    po[ch * 8 + grp] = keep0;
    po[(ch + 8) * 8 + grp] = keep1;
  } else {
    f32x2 acc[8];
#pragma unroll
    for (int q = 0; q < 8; ++q) acc[q] = f32x2{0.f, 0.f};
#pragma unroll
    for (int i = 0; i < 16; ++i) {
      const float wsc = __uint_as_float((unsigned)m.e[i] & 0xFFFF0000u);
      const f32x2 w2 = f32x2{wsc, wsc};
#pragma unroll
      for (int j = 0; j < 4; ++j) {
        acc[2 * j] += w2 * cvt8(r[i][j], false);
        acc[2 * j + 1] += w2 * cvt8(r[i][j], true);
      }
    }
    float v[16];
#pragma unroll
    for (int q = 0; q < 8; ++q) { v[2 * q] = acc[q][0]; v[2 * q + 1] = acc[q][1]; }
    float q8[8], q4[4], q2[2];
    {
      const bool hi = lane & 32;
#pragma unroll
      for (int i = 0; i < 8; ++i) {
        float send = hi ? v[i] : v[8 + i], keep = hi ? v[8 + i] : v[i];
        q8[i] = keep + __shfl_xor(send, 32);
      }
    }
    {
      const bool hi = lane & 16;
#pragma unroll
      for (int i = 0; i < 4; ++i) {
        float send = hi ? q8[i] : q8[4 + i], keep = hi ? q8[4 + i] : q8[i];
        q4[i] = keep + __shfl_xor(send, 16);
      }
    }
    {
      const bool hi = lane & 8;
#pragma unroll
      for (int i = 0; i < 2; ++i) {
        float send = hi ? q4[i] : q4[2 + i], keep = hi ? q4[2 + i] : q4[i];
        q2[i] = keep + __shfl_xor(send, 8);
      }
    }
    const int f = s * 128 + ch * 16 + 2 * grp;
    float* xr = p.out + (size_t)t * DM + f;
    const float2 xv = *(const float2*)xr;
    const float2 gv = *(const float2*)((const float*)(p.ws + OFF_MOD) + modidx(t) * 6144 + 5120 + f);
    *(float2*)xr = make_float2(xv.x + gv.x * q2[0], xv.y + gv.y * q2[1]);
  }
}
template <int MODE>
DI void sliced_pass(const Params& p) {
  const int s = blockIdx.x & 7, loc = blockIdx.x >> 3, nloc = gridDim.x >> 3;
  if (loc >= nloc) return;
  const int lane = threadIdx.x & 63, w = threadIdx.x >> 6, grp = lane >> 3, ch = lane & 7;
  const int stride = nloc * 4;
  SMeta mA, mB;
  u32x4 rA[16], rB[16];
  int t = loc * 4 + w;
  if (t < NTOK) {
    sl_meta<MODE>(p, t, s, grp, ch, mA);
    sl_rows<MODE>(p, s, ch, mA, rA);
  }
  if (t + stride < NTOK) sl_meta<MODE>(p, t + stride, s, grp, ch, mB);
#pragma unroll 1
  for (; t < NTOK; t += 2 * stride) {
    const int t1 = t + stride, t2 = t + 2 * stride, t3 = t + 3 * stride;
    if (t1 < NTOK) sl_rows<MODE>(p, s, ch, mB, rB);
    sl_compute<MODE>(p, t, s, lane, mA, rA);
    if (t2 < NTOK) sl_meta<MODE>(p, t2, s, grp, ch, mA);
    if (t1 < NTOK) {
      if (t2 < NTOK) sl_rows<MODE>(p, s, ch, mA, rA);
      sl_compute<MODE>(p, t1, s, lane, mB, rB);
      if (t3 < NTOK) sl_meta<MODE>(p, t3, s, grp, ch, mB);
    }
  }
}
DI void phase13(const Params& p) { sliced_pass<0>(p); }
DI void phase14(const Params& p) {
  char* ws = p.ws;
  const float* invU = (const float*)(ws + OFF_INVU);
  const float* invV = (const float*)(ws + OFF_INVV);
  const int* elist = (const int*)(ws + OFF_ELIST);
  float* glist = (float*)(ws + OFF_GLIST);
  const float* pd = (const float*)(ws + OFF_PD);
  const int lane = threadIdx.x & 63, w = threadIdx.x >> 6;
  for (int t = blockIdx.x * 4 + w; t < NTOK; t += gridDim.x * 4) {
#pragma unroll
    for (int hf_ = 0; hf_ < 2; ++hf_) {
      const int k = hf_ * 64 + lane;
      float d = 0.f;
#pragma unroll
      for (int s = 0; s < 8; ++s) d += pd[(size_t)t * 1024 + s * 128 + k];
      const int e = elist[(size_t)t * 128 + k];
      const float g = glist[(size_t)t * 128 + k];
      ((unsigned*)glist)[(size_t)t * 128 + k] = (pack2(0.f, g * geluf_(d * invU[e]) * invV[e]) & 0xFFFF0000u) | (unsigned)e;
    }
  }
}
DI void phase15(const Params& p) { sliced_pass<1>(p); }
DI void phase16(const Params& p) {
  const int lane = threadIdx.x & 63, w = threadIdx.x >> 6;
  for (int tok = blockIdx.x * 4 + w; tok < NTOK; tok += gridDim.x * 4) {
    float* xr = p.out + (size_t)tok * DM;
    float4 xv[4];
    float ss = 0.f;
#pragma unroll
    for (int i = 0; i < 4; ++i) {
      xv[i] = *(const float4*)(xr + (i * 64 + lane) * 4);
      ss += xv[i].x * xv[i].x + xv[i].y * xv[i].y + xv[i].z * xv[i].z + xv[i].w * xv[i].w;
    }
    ss = wsum(ss);
    const float rstd = rsqrtf(ss * (1.f / 1024.f) + 1e-6f);
#pragma unroll
    for (int i = 0; i < 4; ++i) {
      const int e = (i * 64 + lane) * 4;
      float4 nf = *(const float4*)(p.norm_final + e);
      *(float4*)(xr + e) = make_float4(xv[i].x * rstd * nf.x, xv[i].y * rstd * nf.y, xv[i].z * rstd * nf.z, xv[i].w * rstd * nf.w);
    }
  }
}

#define XB_TMO      128
#define XB_XCNT(j)  (256  + 64 * (j))
#define XB_XSUB(j)  (1280 + 64 * (j))
#define XB_XGEN(j)  (2304 + 64 * (j))
#define XB_TOP      3328
#define XB_TOPGEN   3392
#define XCD_BAR_WORDS 3456
#define XB_SPIN_CAP (1u << 22)
#define LAS __attribute__((address_space(3)))
DI unsigned xb_ld(unsigned* p) { return __hip_atomic_load(p, __ATOMIC_RELAXED, __HIP_MEMORY_SCOPE_AGENT); }
DI unsigned xb_add(unsigned* p, unsigned v) { return __hip_atomic_fetch_add(p, v, __ATOMIC_RELAXED, __HIP_MEMORY_SCOPE_AGENT); }
DI unsigned xb_xcc_id() { return (unsigned)__builtin_amdgcn_s_getreg((3 << 11) | 20) & 0xFu; }
#define XB_SPIN(cond, bar) do { unsigned _sp = 0; while (cond) { __builtin_amdgcn_s_sleep(1); \
    if ((++_sp & 255u) == 0u) { if (xb_ld(&(bar)[XB_TMO])) break; if (_sp > XB_SPIN_CAP) { atomicAdd(&(bar)[XB_TMO], 1u); break; } } } } while (0)
struct XcdBarrier { unsigned* bar; unsigned x; volatile LAS unsigned* st; };
DI XcdBarrier xcd_barrier_post(unsigned* bar, volatile LAS unsigned* st) {
  XcdBarrier b; b.bar = bar; b.x = xb_xcc_id(); b.st = st;
  if (threadIdx.x == 0) (void)xb_add(&bar[XB_XCNT(b.x)], 1u);
  return b;
}
DI void xcd_barrier_complete(unsigned* bar, unsigned x, unsigned& nloc, unsigned& nx) {
  const unsigned G = gridDim.x * gridDim.y * gridDim.z;
  unsigned sum, cnt, mine, sp = 0u;
  for (;;) {
    sum = 0u; cnt = 0u; mine = 0u;
#pragma unroll
    for (unsigned j = 0; j < 16; ++j) { const unsigned c = xb_ld(&bar[XB_XCNT(j)]); sum += c; cnt += (c > 0u) ? 1u : 0u; mine = (j == x) ? c : mine; }
    if (sum == G) break;
    __builtin_amdgcn_s_sleep(1);
    if ((++sp & 255u) == 0u) { if (xb_ld(&bar[XB_TMO])) break; if (sp > XB_SPIN_CAP) { atomicAdd(&bar[XB_TMO], 1u); break; } }
  }
  nloc = mine > 0u ? mine : 1u; nx = cnt > 0u ? cnt : 1u;
}
DI void xcd_barrier(const XcdBarrier& b) {
  asm volatile("s_waitcnt vmcnt(0)" ::: "memory");
  __syncthreads();
  if (threadIdx.x == 0) {
    unsigned* bar = b.bar;
    __builtin_amdgcn_s_waitcnt(0);
    unsigned nloc = b.st[0], nx = b.st[1];
    if (nloc == 0u) { xcd_barrier_complete(bar, b.x, nloc, nx); b.st[0] = nloc; b.st[1] = nx; }
    const unsigned old = xb_add(&bar[XB_XSUB(b.x)], 1u);
    const unsigned gen = old / nloc;
    if (old + 1u == (gen + 1u) * nloc) {
      __builtin_amdgcn_fence(__ATOMIC_RELEASE, "agent");
      asm volatile("s_waitcnt vmcnt(0)" ::: "memory");
      const unsigned og = xb_add(&bar[XB_TOP], 1u);
      const unsigned tg = og / nx;
      if (og + 1u == (tg + 1u) * nx) xb_add(&bar[XB_TOPGEN], 1u);
      else XB_SPIN(xb_ld(&bar[XB_TOPGEN]) == tg, bar);
      __builtin_amdgcn_fence(__ATOMIC_ACQUIRE, "agent");
      xb_add(&bar[XB_XGEN(b.x)], 1u);
      asm volatile("s_waitcnt vmcnt(0)" ::: "memory");
    } else {
      XB_SPIN(xb_ld(&bar[XB_XGEN(b.x)]) == gen, bar);
      __builtin_amdgcn_fence(__ATOMIC_ACQUIRE, "agent");
      asm volatile("s_waitcnt vmcnt(0)" ::: "memory");
    }
  }
  __syncthreads();
}

#ifdef ONLY_PHASE
#define RUNPH(n, call) if (ONLY_PHASE == n) { call; }
#else
#ifndef DUP_PHASE
#define DUP_PHASE -1
#endif
#define RUNPH(n, call) if (lo <= n && n < hi) { call; if (n == DUP_PHASE) { xcd_barrier(xb); call; } if (n + 1 < hi) xcd_barrier(xb); }
#endif
__global__ void __launch_bounds__(256, 2) mega(Params p, int lo, int hi) {
  __shared__ __attribute__((aligned(16))) char smem[SMEM_BYTES];
  __shared__ uint4 xb_words;
  cg::grid_group grid = cg::this_grid();
  if (lo < 0) grid.sync();
  if (threadIdx.x == 0) xb_words = make_uint4(0u, 0u, 0u, 0u);
  __syncthreads();
  XcdBarrier xb = xcd_barrier_post((unsigned*)(p.ws + OFF_BAR), (volatile LAS unsigned*)&xb_words);
  RUNPH(0, phase0(p, smem))
  RUNPH(1, phase1(p, smem))
  RUNPH(2, phase2(p, smem))
  RUNPH(3, phase3(p, smem))
  RUNPH(4, phase4(p))
  RUNPH(5, phase5(p, smem))
  RUNPH(6, phase6(p, smem))
  RUNPH(7, phase7(p, smem))
  RUNPH(8, phase8(p, smem))
  RUNPH(9, phase9(p, smem))
  RUNPH(10, phase10(p, smem))
  RUNPH(11, phase11(p, smem))
  RUNPH(12, phase12(p, smem))
  RUNPH(13, phase13(p))
  RUNPH(14, phase14(p))
  RUNPH(15, phase15(p))
  RUNPH(16, phase16(p))
}

extern "C" void kernel_launch(void* const* d_in, const int* in_sizes, int n_in, void* d_out, int out_size, void* d_ws,
                              size_t ws_size, hipStream_t stream) {
  static int grid_blocks = 0;
  if (!grid_blocks) {
    int dev = 0, cus = 0, per_cu = 0;
    hipGetDevice(&dev);
    hipDeviceGetAttribute(&cus, hipDeviceAttributeMultiprocessorCount, dev);
    hipOccupancyMaxActiveBlocksPerMultiprocessor(&per_cu, mega, 256, 0);
    if (per_cu > 2) per_cu = 2;
    if (per_cu < 1) per_cu = 1;
    grid_blocks = cus * per_cu;
  }
  Params p{};
  const float** pp = (const float**)&p;
  for (int i = 0; i < 29; ++i) pp[i] = (const float*)d_in[i];
  p.out = (float*)d_out;
  p.ws = (char*)d_ws;
#if N_LAUNCH_SPLIT
  for (int ph = 0; ph < NPHASE; ++ph) {
    hipLaunchKernelGGL(mega, dim3(grid_blocks), dim3(256), 0, stream, p, ph, ph + 1);
  }
#else
  hipMemsetAsync((char*)d_ws + OFF_MOD, 0, (OFF_BAR - OFF_MOD) + XCD_BAR_WORDS * sizeof(unsigned), stream);
  int lo = 0, hi = NPHASE;
  void* args[] = {&p, &lo, &hi};
  hipError_t e = hipLaunchCooperativeKernel((void*)mega, dim3(grid_blocks), dim3(256), args, 0, stream);
  if (e != hipSuccess) fprintf(stderr, "cooperative launch failed: %s (grid %d)\n", hipGetErrorString(e), grid_blocks);
#endif
}
```

```cpp
#include <hip/hip_runtime.h>
#include <hip/hip_cooperative_groups.h>
#include <cstdio>
namespace cg = cooperative_groups;

#define DI __device__ __forceinline__
typedef unsigned short bf16_t;
using bf16x8 = __attribute__((ext_vector_type(8))) short;
using f32x4 = __attribute__((ext_vector_type(4))) float;
using u32x4 = __attribute__((ext_vector_type(4))) unsigned;
using u32x2 = __attribute__((ext_vector_type(2))) unsigned;

#ifndef N_LAUNCH_SPLIT
#define N_LAUNCH_SPLIT 0
#endif

constexpr int NTOK = 20480, NPT = 4096, DM = 1024;
constexpr int NPHASE = 17;
constexpr size_t MiB = 1u << 20;
constexpr size_t OFF_WINT = 0, OFF_WUQT = 9 * MiB, OFF_WUKVT = 9 * MiB + 512 * 1024, OFF_WUPAT = 10 * MiB,
                 OFF_WUPBT = 11 * MiB, OFF_WOT = 12 * MiB, OFF_WCT = 14 * MiB, OFF_WPQB = 18 * MiB,
                 OFF_KEYSB = 22 * MiB, OFF_MOD = 22 * MiB + 512 * 1024, OFF_BAR = 22 * MiB + 768 * 1024, OFF_ROPE = 23 * MiB, A0 = 24 * MiB;
constexpr size_t OFF_PD = A0 + 104 * MiB, OFF_H1 = A0 + 0, OFF_CQ = A0 + 40 * MiB, OFF_CKVRAW = A0 + 50 * MiB, OFF_KRRAW = A0 + 60 * MiB,
                 OFF_RQ = A0 + 63 * MiB, OFF_RK = A0 + 83 * MiB, OFF_KT = A0 + 103 * MiB, OFF_VT = A0 + 123 * MiB,
                 OFF_SRG = A0 + 143 * MiB, OFF_CKVALL = A0 + 163 * MiB, OFF_KRALL = A0 + 169 * MiB,
                 OFF_UF = A0 + 171 * MiB, OFF_UB = A0 + 187 * MiB,
                 OFF_SF = A0 + 0, OFF_SB = A0 + 8 * MiB, OFF_RET = A0 + 16 * MiB,
                 OFF_Q = A0 + 63 * MiB, OFF_KN = A0 + 93 * MiB, OFF_VTA = A0 + 117 * MiB, OFF_ATTN = A0 + 141 * MiB,
                 OFF_M = A0 + 163 * MiB,
                 OFF_H2 = A0 + 56 * MiB, OFF_TABU = A0 + 36 * MiB, OFF_TABV = A0 + 0, OFF_INVU = A0 + 52 * MiB,
                 OFF_INVV = A0 + 53 * MiB, OFF_ELIST = A0 + 16 * MiB, OFF_GLIST = A0 + 26 * MiB, OFF_SCORES = A0 + 104 * MiB;
constexpr size_t OUT_CKV = 20971520, OUT_KR = 21495808, OUT_SF = 21626880, OUT_SB = 22675456;
constexpr int NKV = 24576;
constexpr int SMEM_BYTES = 73728;

struct Params {
  const float *x_prompt, *x_sample, *c, *cache_ckv, *cache_krope, *st_f, *st_b, *c_ctx, *w_mod, *b_mod, *norm_mix,
      *norm_ffn, *norm_final, *w_in, *q_norm, *kv_norm, *w_uq, *w_ukv, *lg_f, *lg_b, *ret_gn, *w_up_a, *w_up_b, *w_o,
      *peer_wq, *keys1, *keys2, *peer_u, *peer_v;
  float* out;
  char* ws;
};

DI unsigned f2bf(float x) {
  unsigned u = __float_as_uint(x);
  u += 0x7fffu + ((u >> 16) & 1u);
  return u >> 16;
}
DI float bf2f(unsigned b) { return __uint_as_float(b << 16); }
typedef __bf16 hbf16x2_t __attribute__((ext_vector_type(2)));
typedef float hf32x2_t __attribute__((ext_vector_type(2)));
DI unsigned pack2(float a, float b) {
  hf32x2_t f = {a, b};
  return __builtin_bit_cast(unsigned, __builtin_convertvector(f, hbf16x2_t));
}
DI float ex2(float x) { return __builtin_amdgcn_exp2f(x); }
DI float bflo(unsigned u) { return __uint_as_float(u << 16); }
DI float bfhi(unsigned u) { return __uint_as_float(u & 0xffff0000u); }
DI float wsum(float v) {
#pragma unroll
  for (int o = 32; o > 0; o >>= 1) v += __shfl_xor(v, o);
  return v;
}
DI float sigmoidf_(float x) { return __builtin_amdgcn_rcpf(1.f + __builtin_amdgcn_exp2f(-1.4426950408889634f * x)); }
DI float siluf_(float x) { return x * __builtin_amdgcn_rcpf(1.f + __builtin_amdgcn_exp2f(-1.4426950408889634f * x)); }
DI float geluf_(float x) { return 0.5f * x * (1.f + tanhf(0.7978845608028654f * (x + 0.044715f * x * x * x))); }
DI const float* xrow(const Params& p, int tok) {
  return tok < NPT ? p.x_prompt + (size_t)tok * DM : p.x_sample + (size_t)(tok - NPT) * DM;
}
DI int modidx(int tok) { return tok < NPT ? 0 : 1 + ((tok - NPT) >> 11); }
DI int kvrow(int tok) {
  if (tok < NPT) return tok;
  int t = tok - NPT;
  return NPT + (t >> 11) * 2560 + (t & 2047);
}
DI void st_bf16x16(bf16_t* dst, const float (&v)[16]) {
  u32x4 a, b;
  a[0] = pack2(v[0], v[1]); a[1] = pack2(v[2], v[3]); a[2] = pack2(v[4], v[5]); a[3] = pack2(v[6], v[7]);
  b[0] = pack2(v[8], v[9]); b[1] = pack2(v[10], v[11]); b[2] = pack2(v[12], v[13]); b[3] = pack2(v[14], v[15]);
  *(u32x4*)dst = a;
  *(u32x4*)(dst + 8) = b;
}
DI void st_f32x16(float* dst, const float (&v)[16]) {
#pragma unroll
  for (int i = 0; i < 4; ++i) *(float4*)(dst + 4 * i) = make_float4(v[4 * i], v[4 * i + 1], v[4 * i + 2], v[4 * i + 3]);
}
DI void ld_bf16x16(const bf16_t* src, float (&v)[16]) {
  u32x4 a = *(const u32x4*)src, b = *(const u32x4*)(src + 8);
#pragma unroll
  for (int i = 0; i < 4; ++i) {
    v[2 * i] = bflo(a[i]); v[2 * i + 1] = bfhi(a[i]);
    v[8 + 2 * i] = bflo(b[i]); v[8 + 2 * i + 1] = bfhi(b[i]);
  }
}

constexpr int LDK = 64;
template <int SCALE>
DI void gemm_kloop(f32x4 (&acc)[4][4], const bf16_t* __restrict__ A, int lda, const bf16_t* __restrict__ B, int ldb,
                   int K, char* smem, float sc_a, float sc_b) {
  bf16_t* As = (bf16_t*)smem;
  bf16_t* Bs = As + 128 * LDK;
  const int tid = threadIdx.x, lane = tid & 63, w = tid >> 6, wm = w >> 1, wn = w & 1, l15 = lane & 15, g = lane >> 4;
  u32x4 ra[4], rb[4];
  int arow[4], kc[4], ldsa[4], ldsb[4];
#pragma unroll
  for (int i = 0; i < 4; ++i) {
    int c = tid + 256 * i;
    int r = c >> 3;
    kc[i] = (c & 7) * 8;
    arow[i] = r;
    int rr = r & 63;
    int rho = (r & 64) | (((rr >> 2) & 3) << 4) | ((rr >> 4) << 2) | (rr & 3);
    ldsa[i] = rho * LDK + (((c & 7) ^ ((rho >> 1) & 7)) * 8);
    ldsb[i] = r * LDK + (((c & 7) ^ ((r >> 1) & 7)) * 8);
  }
#pragma unroll
  for (int i = 0; i < 4; ++i) {
    ra[i] = *(const u32x4*)(A + (size_t)arow[i] * lda + kc[i]);
    rb[i] = *(const u32x4*)(B + (size_t)arow[i] * ldb + kc[i]);
  }
  __syncthreads();
#pragma unroll
  for (int i = 0; i < 4; ++i) {
    *(u32x4*)(As + ldsa[i]) = ra[i];
    *(u32x4*)(Bs + ldsb[i]) = rb[i];
  }
  if (64 < K) {
#pragma unroll
    for (int i = 0; i < 4; ++i) {
      ra[i] = *(const u32x4*)(A + (size_t)arow[i] * lda + 64 + kc[i]);
      rb[i] = *(const u32x4*)(B + (size_t)arow[i] * ldb + 64 + kc[i]);
    }
  }
  __syncthreads();
  int buf = 0;
  for (int k0 = 0; k0 < K; k0 += 64, buf ^= 1) {
    const bf16_t* Ac = As + buf * (256 * LDK);
    const bf16_t* Bc = Bs + buf * (256 * LDK);
#pragma unroll
    for (int ks = 0; ks < 2; ++ks) {
      bf16x8 af[4], bfr[4];
#pragma unroll
      for (int f = 0; f < 4; ++f)
        af[f] = *(const bf16x8*)(Ac + (wm * 64 + f * 16 + l15) * LDK + (((ks * 4 + g) ^ (l15 >> 1)) * 8));
#pragma unroll
      for (int c = 0; c < 4; ++c)
        bfr[c] = *(const bf16x8*)(Bc + (wn * 64 + c * 16 + l15) * LDK + (((ks * 4 + g) ^ (l15 >> 1)) * 8));
      if (SCALE) {
        float fac[8];
#pragma unroll
        for (int i = 0; i < 8; ++i) fac[i] = ex2(sc_a + sc_b * (float)(k0 + ks * 32 + g * 8 + i));
#pragma unroll
        for (int f = 0; f < 4; ++f) {
          u32x4 u = __builtin_bit_cast(u32x4, af[f]);
#pragma unroll
          for (int i = 0; i < 4; ++i) u[i] = pack2(bflo(u[i]) * fac[2 * i], bfhi(u[i]) * fac[2 * i + 1]);
          af[f] = __builtin_bit_cast(bf16x8, u);
        }
      }
#pragma unroll
      for (int f = 0; f < 4; ++f)
#pragma unroll
        for (int c = 0; c < 4; ++c) acc[f][c] = __builtin_amdgcn_mfma_f32_16x16x32_bf16(af[f], bfr[c], acc[f][c], 0, 0, 0);
    }
    if (k0 + 64 < K) {
      bf16_t* An = As + (buf ^ 1) * (256 * LDK);
      bf16_t* Bn = Bs + (buf ^ 1) * (256 * LDK);
#pragma unroll
      for (int i = 0; i < 4; ++i) {
        *(u32x4*)(An + ldsa[i]) = ra[i];
        *(u32x4*)(Bn + ldsb[i]) = rb[i];
      }
      if (k0 + 128 < K) {
#pragma unroll
        for (int i = 0; i < 4; ++i) {
          ra[i] = *(const u32x4*)(A + (size_t)arow[i] * lda + k0 + 128 + kc[i]);
          rb[i] = *(const u32x4*)(B + (size_t)arow[i] * ldb + k0 + 128 + kc[i]);
        }
      }
      __syncthreads();
    }
  }
}
DI void acc_zero(f32x4 (&acc)[4][4]) {
#pragma unroll
  for (int f = 0; f < 4; ++f)
#pragma unroll
    for (int c = 0; c < 4; ++c) acc[f][c] = f32x4{0.f, 0.f, 0.f, 0.f};
}
template <class F>
DI void epilogue(const f32x4 (&acc)[4][4], F&& epi) {
  const int tid = threadIdx.x, lane = tid & 63, w = tid >> 6, wm = w >> 1, wn = w & 1, l15 = lane & 15, g = lane >> 4;
#pragma unroll
  for (int c = 0; c < 4; ++c) {
    float v[16];
#pragma unroll
    for (int f = 0; f < 4; ++f)
#pragma unroll
      for (int j = 0; j < 4; ++j) v[f * 4 + j] = acc[f][c][j];
    epi(wm * 64 + 16 * g, wn * 64 + c * 16 + l15, v);
  }
}
DI bool tile_map(int it, int Ft, int Tt, int fsplit, int& ft, int& tt) {
  const int bid = blockIdx.x, nb = gridDim.x;
  int xcd = bid & 7, loc = bid >> 3, nloc = nb >> 3;
  if (loc >= nloc) return false;
  int fg = xcd % fsplit, tg = xcd / fsplit, tsplit = 8 / fsplit;
  int Fg = Ft / fsplit, Tg = Tt / tsplit;
  int i = loc + it * nloc;
  if (i >= Fg * Tg) return false;
  ft = fg * Fg + i % Fg;
  tt = tg * Tg + i / Fg;
  return true;
}
DI int vbid() {
  const int bid = blockIdx.x, nb = gridDim.x;
  if (nb & 7) return bid;
  return (bid & 7) * (nb >> 3) + (bid >> 3);
}

DI int colmap(int mode, int np) {
  if (mode == 1) return np < 416 ? np : (np < 512 ? -1 : np - 96);
  if (mode == 2) return np < 512 ? ((np >> 6) * 128 + (np & 63)) : (((np - 512) >> 6) * 128 + 64 + ((np - 512) & 63));
  return np;
}
DI void tconv_tile(const float* __restrict__ src, int ldsrc, bf16_t* __restrict__ dst, int K, int kt, int nt, int mode,
                   char* smem) {
  float* lds = (float*)smem;
  const int tid = threadIdx.x;
  {
    int col = tid & 63, rq = tid >> 6;
    int n = colmap(mode, nt * 64 + col);
#pragma unroll 4
    for (int r = 0; r < 16; ++r) {
      int kl = r * 4 + rq;
      float v = n >= 0 ? src[(size_t)(kt * 64 + kl) * ldsrc + n] : 0.f;
      lds[kl * 65 + col] = v;
    }
  }
  __syncthreads();
  {
    int nl = tid >> 2, kq = (tid & 3) * 16;
    float v[16];
#pragma unroll
    for (int i = 0; i < 16; ++i) v[i] = lds[(kq + i) * 65 + nl];
    st_bf16x16(dst + (size_t)(nt * 64 + nl) * K + kt * 64 + kq, v);
  }
  __syncthreads();
}
DI void mod_item(const Params& p, int item, char* smem) {
  float* sil = (float*)smem;
  const int tid = threadIdx.x;
  const int cg_ = item >> 2, slab = item & 3, kbase = slab * 256;
  for (int i = tid; i < 9 * 256; i += 256) {
    int j = i >> 8, k = kbase + (i & 255);
    float cv = j == 0 ? p.c_ctx[k] : p.c[(j - 1) * 1024 + k];
    sil[i] = siluf_(cv);
  }
  __syncthreads();
  const int kq = tid >> 6, nn = tid & 63, n0 = cg_ * 64;
  float acc[9];
#pragma unroll
  for (int j = 0; j < 9; ++j) acc[j] = 0.f;
#pragma unroll 1
  for (int i0 = 0; i0 < 64; i0 += 16) {
    float wv[16];
#pragma unroll
    for (int i = 0; i < 16; ++i) wv[i] = p.w_mod[(size_t)(kbase + kq + 4 * (i0 + i)) * 6144 + n0 + nn];
#pragma unroll
    for (int i = 0; i < 16; ++i)
#pragma unroll
      for (int j = 0; j < 9; ++j) acc[j] += sil[j * 256 + kq + 4 * (i0 + i)] * wv[i];
  }
  __syncthreads();
  float* part = (float*)smem + 9 * 256;
#pragma unroll
  for (int j = 0; j < 9; ++j) part[(kq * 9 + j) * 64 + nn] = acc[j];
  __syncthreads();
  float* mod = (float*)(p.ws + OFF_MOD);
  for (int i = tid; i < 9 * 64; i += 256) {
    int j = i >> 6, n = i & 63;
    float s = part[(0 * 9 + j) * 64 + n] + part[(1 * 9 + j) * 64 + n] + part[(2 * 9 + j) * 64 + n] + part[(3 * 9 + j) * 64 + n];
    if (slab == 0) s += p.b_mod[n0 + n];
    atomicAdd(mod + j * 6144 + n0 + n, s);
  }
  __syncthreads();
}
DI void conv_flat(const float* __restrict__ src, bf16_t* __restrict__ dst, size_t n) {
  size_t i = ((size_t)blockIdx.x * 256 + threadIdx.x) * 8;
  const size_t stride = (size_t)gridDim.x * 256 * 8;
  for (; i < n; i += stride) {
    float4 a = *(const float4*)(src + i), b = *(const float4*)(src + i + 4);
    u32x4 o;
    o[0] = pack2(a.x, a.y); o[1] = pack2(a.z, a.w); o[2] = pack2(b.x, b.y); o[3] = pack2(b.z, b.w);
    *(u32x4*)(dst + i) = o;
  }
}
DI void phase0(const Params& p, char* smem) {
  const int bid = blockIdx.x, nb = gridDim.x;
  char* ws = p.ws;
  const int n_mod = 384;
  const int t_in = 16 * 72, t_uq = 4 * 12, t_ukv = 2 * 16, t_upa = 8 * 16, t_upb = 8 * 16, t_o = 16 * 16;
  const int total = n_mod + t_in + t_uq + t_ukv + t_upa + t_upb + t_o;
  for (int it = bid; it < total; it += nb) {
    int i = it;
    if (i < n_mod) { mod_item(p, i, smem); continue; }
    i -= n_mod;
    if (i < t_in) { tconv_tile(p.w_in, 4512, (bf16_t*)(ws + OFF_WINT), 1024, i / 72, i % 72, 1, smem); continue; }
    i -= t_in;
    if (i < t_uq) { tconv_tile(p.w_uq, 768, (bf16_t*)(ws + OFF_WUQT), 256, i / 12, i % 12, 0, smem); continue; }
    i -= t_uq;
    if (i < t_ukv) { tconv_tile(p.w_ukv, 1024, (bf16_t*)(ws + OFF_WUKVT), 128, i / 16, i % 16, 2, smem); continue; }
    i -= t_ukv;
    if (i < t_upa) { tconv_tile(p.w_up_a, 1024, (bf16_t*)(ws + OFF_WUPAT), 512, i / 16, i % 16, 0, smem); continue; }
    i -= t_upa;
    if (i < t_upb) { tconv_tile(p.w_up_b, 1024, (bf16_t*)(ws + OFF_WUPBT), 512, i / 16, i % 16, 0, smem); continue; }
    i -= t_upb;
    tconv_tile(p.w_o, 1024, (bf16_t*)(ws + OFF_WOT), 1024, i / 16, i % 16, 0, smem);
  }
  conv_flat(p.peer_wq, (bf16_t*)(ws + OFF_WPQB), (size_t)1024 * 2048);
  {
    size_t i = ((size_t)bid * 256 + threadIdx.x) * 8;
    const size_t stride = (size_t)nb * 256 * 8;
    bf16_t* kb = (bf16_t*)(ws + OFF_KEYSB);
    for (; i < (size_t)2 * 131072; i += stride) {
      int half = i >= 131072;
      size_t s = i - (size_t)half * 131072;
      int h = (int)(s >> 14);
      size_t r = s & 16383;
      const float* src = (half ? p.keys2 : p.keys1) + s;
      float4 a = *(const float4*)(src), b = *(const float4*)(src + 4);
      u32x4 o;
      o[0] = pack2(a.x, a.y); o[1] = pack2(a.z, a.w); o[2] = pack2(b.x, b.y); o[3] = pack2(b.z, b.w);
      *(u32x4*)(kb + ((size_t)(h * 2 + half) << 14) + r) = o;
    }
  }
  {
    float2* rope = (float2*)(ws + OFF_ROPE);
    for (int idx = bid * 256 + threadIdx.x; idx < 2048 * 16; idx += nb * 256) {
      const int t = idx >> 4, a = idx & 15;
      const float pos = (a < 8) ? (float)(t >> 6) : (float)(t & 63);
      const float fr = exp2f(-(float)(a & 7) * 1.6609640474436813f);
      float sn, cs;
      sincosf(pos * fr, &sn, &cs);
      rope[idx] = make_float2(cs, sn);
    }
  }
}

DI void rows_norm_mod(const Params& p, const float* nw, int sh_off, int sc_off, bool from_out, bf16_t* dst) {
  const int lane = threadIdx.x & 63, w = threadIdx.x >> 6;
  const float* mod = (const float*)(p.ws + OFF_MOD);
  for (int tok = blockIdx.x * 4 + w; tok < NTOK; tok += gridDim.x * 4) {
    const float* xr = from_out ? p.out + (size_t)tok * DM : xrow(p, tok);
    const float* mj = mod + modidx(tok) * 6144;
    float4 xv[4];
    float ss = 0.f;
#pragma unroll
    for (int i = 0; i < 4; ++i) {
      xv[i] = *(const float4*)(xr + (i * 64 + lane) * 4);
      ss += xv[i].x * xv[i].x + xv[i].y * xv[i].y + xv[i].z * xv[i].z + xv[i].w * xv[i].w;
    }
    ss = wsum(ss);
    float rstd = rsqrtf(ss * (1.f / 1024.f) + 1e-6f);
#pragma unroll
    for (int i = 0; i < 4; ++i) {
      int e = (i * 64 + lane) * 4;
      float4 nv = *(const float4*)(nw + e), sh = *(const float4*)(mj + sh_off + e), sc = *(const float4*)(mj + sc_off + e);
      float h0 = (xv[i].x * rstd) * nv.x * (1.f + sc.x) + sh.x;
      float h1 = (xv[i].y * rstd) * nv.y * (1.f + sc.y) + sh.y;
      float h2 = (xv[i].z * rstd) * nv.z * (1.f + sc.z) + sh.z;
      float h3 = (xv[i].w * rstd) * nv.w * (1.f + sc.w) + sh.w;
      u32x2 o;
      o[0] = pack2(h0, h1); o[1] = pack2(h2, h3);
      *(u32x2*)(dst + (size_t)tok * DM + e) = o;
    }
  }
}
DI void phase1(const Params& p, char* smem) {
  rows_norm_mod(p, p.norm_mix, 0, 1024, false, (bf16_t*)(p.ws + OFF_H1));
  const bf16_t* wpq = (const bf16_t*)(p.ws + OFF_WPQB);
  const bf16_t* kb = (const bf16_t*)(p.ws + OFF_KEYSB);
  bf16_t* wct = (bf16_t*)(p.ws + OFF_WCT);
  for (int it = blockIdx.x; it < 128; it += gridDim.x) {
    int hh = it >> 3, mt = it & 7;
    f32x4 acc[4][4];
    acc_zero(acc);
    gemm_kloop<0>(acc, wpq + (size_t)(mt * 128) * 2048 + hh * 128, 2048, kb + (size_t)hh * 16384, 128, 128, smem, 0.f, 0.f);
    epilogue(acc, [&](int m, int n, float (&v)[16]) { st_bf16x16(wct + (size_t)(hh * 128 + n) * 1024 + mt * 128 + m, v); });
  }
}

DI void phase2(const Params& p, char* smem) {
  char* ws = p.ws;
  const bf16_t* winT = (const bf16_t*)(ws + OFF_WINT);
  const bf16_t* h1 = (const bf16_t*)(ws + OFF_H1);
  bf16_t* cq = (bf16_t*)(ws + OFF_CQ);
  float* ckvraw = (float*)(ws + OFF_CKVRAW);
  float* krraw = (float*)(ws + OFF_KRRAW);
  bf16_t* rq = (bf16_t*)(ws + OFF_RQ);
  bf16_t* rk = (bf16_t*)(ws + OFF_RK);
  bf16_t* kT = (bf16_t*)(ws + OFF_KT);
  bf16_t* vT = (bf16_t*)(ws + OFF_VT);
  bf16_t* srg = (bf16_t*)(ws + OFF_SRG);
  bf16_t* sga = (bf16_t*)p.out;
  bf16_t* sgb = sga + (size_t)NTOK * 1024;
  for (int it = 0;; ++it) {
    int ft, tt;
    if (!tile_map(it, 36, 160, 4, ft, tt)) break;
    f32x4 acc[4][4];
    acc_zero(acc);
    const bf16_t* W = winT + (size_t)ft * 128 * 1024;
    const bf16_t* H = h1 + (size_t)tt * 128 * 1024;
    const int tok0 = tt * 128, f0 = ft * 128;
    if (ft >= 8 && ft < 16) {
      gemm_kloop<0>(acc, H, 1024, W, 1024, 1024, smem, 0.f, 0.f);
      if (ft < 12) {
        epilogue(acc, [&](int m, int n, float (&v)[16]) {
          int feat = f0 - 1024 + n, tok = tok0 + m;
#pragma unroll
          for (int i = 0; i < 16; ++i) v[i] *= 0.08838834764831845f;
          st_bf16x16(kT + (size_t)feat * NTOK + tok, v);
#pragma unroll
          for (int i = 0; i < 16; ++i) rk[(size_t)(tok + i) * 512 + feat] = (bf16_t)f2bf(v[i]);
        });
      } else {
        epilogue(acc, [&](int m, int n, float (&v)[16]) {
          int feat = f0 - 1536 + n, tok = tok0 + m;
          st_bf16x16(vT + (size_t)feat * NTOK + tok, v);
        });
      }
    } else {
      gemm_kloop<0>(acc, W, 1024, H, 1024, 1024, smem, 0.f, 0.f);
      if (ft < 2) {
        epilogue(acc, [&](int m, int n, float (&v)[16]) { st_bf16x16(cq + (size_t)(tok0 + n) * 256 + f0 + m, v); });
      } else if (ft == 2) {
        epilogue(acc, [&](int m, int n, float (&v)[16]) { st_f32x16(ckvraw + (size_t)(tok0 + n) * 128 + m, v); });
      } else if (ft == 3) {
        epilogue(acc, [&](int m, int n, float (&v)[16]) {
          if (m < 32) st_f32x16(krraw + (size_t)(tok0 + n) * 32 + m, v);
        });
      } else if (ft < 8) {
        epilogue(acc, [&](int m, int n, float (&v)[16]) { st_bf16x16(rq + (size_t)(tok0 + n) * 512 + f0 - 512 + m, v); });
      } else if (ft < 20) {
        epilogue(acc, [&](int m, int n, float (&v)[16]) {
#pragma unroll
          for (int i = 0; i < 16; ++i) v[i] = siluf_(v[i]);
          st_bf16x16(srg + (size_t)(tok0 + n) * 512 + f0 - 2048 + m, v);
        });
      } else if (ft < 28) {
        epilogue(acc, [&](int m, int n, float (&v)[16]) {
#pragma unroll
          for (int i = 0; i < 16; ++i) v[i] = sigmoidf_(v[i]);
          st_bf16x16(sga + (size_t)(tok0 + n) * 1024 + f0 - 2560 + m, v);
        });
      } else {
        epilogue(acc, [&](int m, int n, float (&v)[16]) {
#pragma unroll
          for (int i = 0; i < 16; ++i) v[i] = sigmoidf_(v[i]);
          st_bf16x16(sgb + (size_t)(tok0 + n) * 1024 + f0 - 3584 + m, v);
        });
      }
    }
  }
}

DI float log2gamma(float logit) { return -log1pf(expf(-logit)) * 1.4426950408889634f; }
DI void phase3(const Params& p, char* smem) {
  char* ws = p.ws;
  const int lane = threadIdx.x & 63, w = threadIdx.x >> 6;
  bf16_t* cq = (bf16_t*)(ws + OFF_CQ);
  const float* ckvraw = (const float*)(ws + OFF_CKVRAW);
  const float* krraw = (const float*)(ws + OFF_KRRAW);
  bf16_t* ckvall = (bf16_t*)(ws + OFF_CKVALL);
  bf16_t* krall = (bf16_t*)(ws + OFF_KRALL);
  for (int r = blockIdx.x * 4 + w; r < NTOK + 4096; r += gridDim.x * 4) {
    if (r < NTOK) {
      const int tok = r;
      {
        u32x2 u = *(const u32x2*)(cq + (size_t)tok * 256 + lane * 4);
        float a0 = bflo(u[0]), a1 = bfhi(u[0]), a2 = bflo(u[1]), a3 = bfhi(u[1]);
        float ss = wsum(a0 * a0 + a1 * a1 + a2 * a2 + a3 * a3);
        float rstd = rsqrtf(ss * (1.f / 256.f) + 1e-6f);
        float4 nq = *(const float4*)(p.q_norm + lane * 4);
        u32x2 o;
        o[0] = pack2(a0 * rstd * nq.x, a1 * rstd * nq.y);
        o[1] = pack2(a2 * rstd * nq.z, a3 * rstd * nq.w);
        *(u32x2*)(cq + (size_t)tok * 256 + lane * 4) = o;
      }
      const int row = kvrow(tok);
      {
        float2 v = *(const float2*)(ckvraw + (size_t)tok * 128 + lane * 2);
        float ss = wsum(v.x * v.x + v.y * v.y);
        float rstd = rsqrtf(ss * (1.f / 128.f) + 1e-6f);
        float2 nk = *(const float2*)(p.kv_norm + lane * 2);
        float o0 = v.x * rstd * nk.x, o1 = v.y * rstd * nk.y;
        if (tok < NPT) *(float2*)(p.out + OUT_CKV + (size_t)tok * 128 + lane * 2) = make_float2(o0, o1);
        *(unsigned*)(ckvall + (size_t)row * 128 + lane * 2) = pack2(o0, o1);
      }
      if (lane < 32) {
        float own = krraw[(size_t)tok * 32 + lane];
        float o = own;
        if (tok < NPT) {
          p.out[OUT_KR + (size_t)tok * 32 + lane] = own;
        } else {
          float partner = krraw[(size_t)tok * 32 + (lane ^ 16)];
          int t = (tok - NPT) & 2047;
          const float2 csn = ((const float2*)(ws + OFF_ROPE))[t * 16 + (lane & 15)];
          const float cs = csn.x, sn = csn.y;
          o = lane < 16 ? own * cs - partner * sn : partner * sn + own * cs;
        }
        krall[(size_t)row * 32 + lane] = (bf16_t)f2bf(o);
      }
    } else {
      const int cr = r - NTOK;
      const int b = cr >> 9, pos = cr & 511;
      const int row = NPT + b * 2560 + 2048 + pos;
      float2 v = *(const float2*)(p.cache_ckv + (size_t)cr * 128 + lane * 2);
      *(unsigned*)(ckvall + (size_t)row * 128 + lane * 2) = pack2(v.x, v.y);
      if (lane < 32) krall[(size_t)row * 32 + lane] = (bf16_t)f2bf(p.cache_krope[(size_t)cr * 32 + lane]);
    }
  }
  const bf16_t* kT = (const bf16_t*)(ws + OFF_KT);
  const bf16_t* vT = (const bf16_t*)(ws + OFF_VT);
  float* Uf = (float*)(ws + OFF_UF);
  float* Ub = (float*)(ws + OFF_UB);
  for (int it = blockIdx.x; it < 320; it += gridDim.x) {
    const int blk = it >> 2, h = it & 3;
    const float l2f = log2gamma(p.lg_f[h]), l2b = log2gamma(p.lg_b[h]);
    const bf16_t* Kp = kT + (size_t)(h * 128) * NTOK + blk * 256;
    const bf16_t* Vp = vT + (size_t)(h * 128) * NTOK + blk * 256;
#pragma unroll 1
    for (int dir = 0; dir < 2; ++dir) {
      const float sa = dir ? 0.f : l2f * 255.f, sb = dir ? l2b : -l2f;
      f32x4 acc[4][4];
      acc_zero(acc);
      if (blk < 16) {
        gemm_kloop<1>(acc, Vp, NTOK, Kp, NTOK, 256, smem, sa, sb);
        float* dst = p.out + (dir ? OUT_SB : OUT_SF) + (size_t)(blk * 4 + h) * 16384;
        epilogue(acc, [&](int m, int n, float (&v)[16]) { st_f32x16(dst + n * 128 + m, v); });
      } else {
        gemm_kloop<1>(acc, Kp, NTOK, Vp, NTOK, 256, smem, sa, sb);
        float* dst = (dir ? Ub : Uf) + (size_t)((blk - 16) * 4 + h) * 16384;
        epilogue(acc, [&](int m, int n, float (&v)[16]) { st_f32x16(dst + n * 128 + m, v); });
      }
    }
  }
}

DI void phase4(const Params& p) {
  char* ws = p.ws;
  const float* Uf = (const float*)(ws + OFF_UF);
  const float* Ub = (const float*)(ws + OFF_UB);
  bf16_t* Sf = (bf16_t*)(ws + OFF_SF);
  bf16_t* Sb = (bf16_t*)(ws + OFF_SB);
  for (int idx = blockIdx.x * 256 + threadIdx.x; idx < (1 << 20); idx += gridDim.x * 256) {
    int d = idx & 127, e = (idx >> 7) & 127, h = (idx >> 14) & 3, b = (idx >> 16) & 7, dir = idx >> 19;
    size_t eo = (size_t)e * 128 + d;
    if (dir == 0) {
      float cf = exp2f(log2gamma(p.lg_f[h]) * 256.f);
      float S = p.st_f[(size_t)(b * 4 + h) * 16384 + d * 128 + e];
#pragma unroll
      for (int blk = 0; blk < 8; ++blk) {
        size_t o = (size_t)((b * 8 + blk) * 4 + h) * 16384 + eo;
        Sf[o] = (bf16_t)f2bf(S);
        S = cf * S + Uf[o];
      }
    } else {
      float cb = exp2f(log2gamma(p.lg_b[h]) * 256.f);
      float S = p.st_b[(size_t)(b * 4 + h) * 16384 + d * 128 + e];
#pragma unroll
      for (int blk = 7; blk >= 0; --blk) {
        size_t o = (size_t)((b * 8 + blk) * 4 + h) * 16384 + eo;
        Sb[o] = (bf16_t)f2bf(S);
        S = cb * S + Ub[o];
      }
    }
  }
}

DI bf16x8 scale_frag(bf16x8 q, float s) {
  u32x4 u = __builtin_bit_cast(u32x4, q);
#pragma unroll
  for (int i = 0; i < 4; ++i) u[i] = pack2(bflo(u[i]) * s, bfhi(u[i]) * s);
  return __builtin_bit_cast(bf16x8, u);
}
constexpr int NQT = 1;
DI void phase5(const Params& p, char* smem) {
  char* ws = p.ws;
  const bf16_t* rq = (const bf16_t*)(ws + OFF_RQ);
  const bf16_t* rk = (const bf16_t*)(ws + OFF_RK);
  const bf16_t* vT = (const bf16_t*)(ws + OFF_VT);
  const bf16_t* srg = (const bf16_t*)(ws + OFF_SRG);
  const bf16_t* Sf = (const bf16_t*)(ws + OFF_SF);
  const bf16_t* Sb = (const bf16_t*)(ws + OFF_SB);
  bf16_t* ret = (bf16_t*)(ws + OFF_RET);
  bf16_t* Ks = (bf16_t*)smem;
  bf16_t* Vs = Ks + 64 * 144;
  const int tid = threadIdx.x, lane = tid & 63, w = tid >> 6, l15 = lane & 15, g = lane >> 4;
  for (int item = vbid(); item < 640 * (2 / NQT); item += gridDim.x) {
    const int qb = item >> 2, h = item & 3, blk = (qb * NQT) >> 2;
    const float l2f = log2gamma(p.lg_f[h]), l2b = log2gamma(p.lg_b[h]);
    const int tokw = qb * (64 * NQT) + w * (16 * NQT);
    bf16x8 Q[NQT][4];
#pragma unroll
    for (int qt = 0; qt < NQT; ++qt)
#pragma unroll
      for (int ks = 0; ks < 4; ++ks)
        Q[qt][ks] = *(const bf16x8*)(rq + (size_t)(tokw + qt * 16 + l15) * 512 + h * 128 + ks * 32 + g * 8);
    f32x4 o[8][NQT];
#pragma unroll
    for (int et = 0; et < 8; ++et)
#pragma unroll
      for (int qt = 0; qt < NQT; ++qt) o[et][qt] = f32x4{0.f, 0.f, 0.f, 0.f};
#pragma unroll 1
    for (int kt = 0; kt < 4; ++kt) {
      const int key0 = blk * 256 + kt * 64;
      __syncthreads();
#pragma unroll
      for (int i = 0; i < 4; ++i) {
        int c = tid + 256 * i;
        int r = c >> 4, cc = (c & 15) * 8;
        *(u32x4*)(Ks + r * 144 + cc) = *(const u32x4*)(rk + (size_t)(key0 + r) * 512 + h * 128 + cc);
        int e = c >> 3, c2 = (c & 7) * 8;
        *(u32x4*)(Vs + e * 72 + c2) = *(const u32x4*)(vT + (size_t)(h * 128 + e) * NTOK + key0 + c2);
      }
      __syncthreads();
      bf16x8 P[NQT][2];
#pragma unroll
      for (int qt = 0; qt < NQT; ++qt) {
        f32x4 s[4];
#pragma unroll
        for (int kk = 0; kk < 4; ++kk) s[kk] = f32x4{0.f, 0.f, 0.f, 0.f};
#pragma unroll
        for (int ks = 0; ks < 4; ++ks) {
#pragma unroll
          for (int kk = 0; kk < 4; ++kk) {
            bf16x8 a = *(const bf16x8*)(Ks + (kk * 16 + l15) * 144 + ks * 32 + g * 8);
            s[kk] = __builtin_amdgcn_mfma_f32_16x16x32_bf16(a, Q[qt][ks], s[kk], 0, 0, 0);
          }
        }
        const int iq = (tokw + qt * 16 + l15) & 255;
#pragma unroll
        for (int kk = 0; kk < 4; ++kk) {
#pragma unroll
          for (int j = 0; j < 4; ++j) {
            int jk = kt * 64 + kk * 16 + 4 * g + j;
            int diff = iq - jk;
            float dm = diff > 0 ? ex2(l2f * (float)diff) : (diff < 0 ? ex2(l2b * (float)(-diff)) : 2.f);
            s[kk][j] *= dm;
          }
        }
#pragma unroll
        for (int k2 = 0; k2 < 2; ++k2) {
          u32x4 u;
          u[0] = pack2(s[2 * k2][0], s[2 * k2][1]);
          u[1] = pack2(s[2 * k2][2], s[2 * k2][3]);
          u[2] = pack2(s[2 * k2 + 1][0], s[2 * k2 + 1][1]);
          u[3] = pack2(s[2 * k2 + 1][2], s[2 * k2 + 1][3]);
          P[qt][k2] = __builtin_bit_cast(bf16x8, u);
        }
      }
#pragma unroll
      for (int k2 = 0; k2 < 2; ++k2) {
#pragma unroll
        for (int et = 0; et < 8; ++et) {
          u32x2 lo = *(const u32x2*)(Vs + (et * 16 + l15) * 72 + k2 * 32 + 4 * g);
          u32x2 hi = *(const u32x2*)(Vs + (et * 16 + l15) * 72 + k2 * 32 + 16 + 4 * g);
          u32x4 u;
          u[0] = lo[0]; u[1] = lo[1]; u[2] = hi[0]; u[3] = hi[1];
          bf16x8 a = __builtin_bit_cast(bf16x8, u);
#pragma unroll
          for (int qt = 0; qt < NQT; ++qt) o[et][qt] = __builtin_amdgcn_mfma_f32_16x16x32_bf16(a, P[qt][k2], o[et][qt], 0, 0, 0);
        }
      }
    }
    if (blk >= 16) {
      bf16_t* SL = (bf16_t*)smem;
      __syncthreads();
#pragma unroll
      for (int dir = 0; dir < 2; ++dir) {
        const bf16_t* S = (dir ? Sb : Sf) + (size_t)((blk - 16) * 4 + h) * 16384;
#pragma unroll
        for (int i = 0; i < 8; ++i) {
          int c = tid + 256 * i;
          int e = c >> 4, cc = (c & 15) * 8;
          *(u32x4*)(SL + dir * (128 * 144) + e * 144 + cc) = *(const u32x4*)(S + e * 128 + cc);
        }
      }
      __syncthreads();
#pragma unroll 1
      for (int dir = 0; dir < 2; ++dir) {
        const bf16_t* S = SL + dir * (128 * 144);
        float dq[NQT];
#pragma unroll
        for (int qt = 0; qt < NQT; ++qt) {
          int iq = (tokw + qt * 16 + l15) & 255;
          dq[qt] = dir ? exp2f(l2b * (float)(256 - iq)) : exp2f(l2f * (float)(iq + 1));
        }
#pragma unroll
        for (int ks = 0; ks < 4; ++ks) {
          bf16x8 qs[NQT];
#pragma unroll
          for (int qt = 0; qt < NQT; ++qt) qs[qt] = scale_frag(Q[qt][ks], dq[qt]);
#pragma unroll
          for (int et = 0; et < 8; ++et) {
            bf16x8 a = *(const bf16x8*)(S + (et * 16 + l15) * 144 + ks * 32 + g * 8);
#pragma unroll
            for (int qt = 0; qt < NQT; ++qt) o[et][qt] = __builtin_amdgcn_mfma_f32_16x16x32_bf16(a, qs[qt], o[et][qt], 0, 0, 0);
          }
        }
      }
    }
#pragma unroll
    for (int qt = 0; qt < NQT; ++qt) {
      const int tok = tokw + qt * 16 + l15;
      float s1 = 0.f;
#pragma unroll
      for (int et = 0; et < 8; ++et)
#pragma unroll
        for (int j = 0; j < 4; ++j) s1 += o[et][qt][j];
      s1 += __shfl_xor(s1, 16);
      s1 += __shfl_xor(s1, 32);
      const float mu = s1 * (1.f / 128.f);
      float s2 = 0.f;
#pragma unroll
      for (int et = 0; et < 8; ++et)
#pragma unroll
        for (int j = 0; j < 4; ++j) {
          float dlt = o[et][qt][j] - mu;
          s2 += dlt * dlt;
        }
      s2 += __shfl_xor(s2, 16);
      s2 += __shfl_xor(s2, 32);
      const float rstd = rsqrtf(s2 * (1.f / 128.f) + 1e-6f);
#pragma unroll
      for (int et = 0; et < 8; ++et) {
        const int e = h * 128 + et * 16 + 4 * g;
        float4 gn = *(const float4*)(p.ret_gn + e);
        u32x2 sg = *(const u32x2*)(srg + (size_t)tok * 512 + e);
        u32x2 ov;
        ov[0] = pack2((o[et][qt][0] - mu) * rstd * gn.x * bflo(sg[0]), (o[et][qt][1] - mu) * rstd * gn.y * bfhi(sg[0]));
        ov[1] = pack2((o[et][qt][2] - mu) * rstd * gn.z * bflo(sg[1]), (o[et][qt][3] - mu) * rstd * gn.w * bfhi(sg[1]));
        *(u32x2*)(ret + (size_t)tok * 512 + e) = ov;
      }
    }
  }
}

DI void phase6(const Params& p, char* smem) {
  char* ws = p.ws;
  const bf16_t* cqn = (const bf16_t*)(ws + OFF_CQ);
  const bf16_t* wuqT = (const bf16_t*)(ws + OFF_WUQT);
  bf16_t* q = (bf16_t*)(ws + OFF_Q);
  for (int it = 0;; ++it) {
    int ft, tt;
    if (!tile_map(it, 6, 160, 1, ft, tt)) break;
    f32x4 acc[4][4];
    acc_zero(acc);
    gemm_kloop<0>(acc, wuqT + (size_t)ft * 128 * 256, 256, cqn + (size_t)tt * 128 * 256, 256, 256, smem, 0.f, 0.f);
    epilogue(acc, [&](int m, int n, float (&v)[16]) { st_bf16x16(q + (size_t)(tt * 128 + n) * 768 + ft * 128 + m, v); });
  }
  const bf16_t* ckvall = (const bf16_t*)(ws + OFF_CKVALL);
  const bf16_t* wukvT = (const bf16_t*)(ws + OFF_WUKVT);
  bf16_t* Kn = (bf16_t*)(ws + OFF_KN);
  bf16_t* Vt = (bf16_t*)(ws + OFF_VTA);
  for (int it = 0;; ++it) {
    int ft, tt;
    if (!tile_map(it, 8, 192, 1, ft, tt)) break;
    f32x4 acc[4][4];
    acc_zero(acc);
    const bf16_t* W = wukvT + (size_t)ft * 128 * 128;
    const bf16_t* X = ckvall + (size_t)tt * 128 * 128;
    if (ft < 4) {
      gemm_kloop<0>(acc, W, 128, X, 128, 128, smem, 0.f, 0.f);
      epilogue(acc, [&](int m, int n, float (&v)[16]) { st_bf16x16(Kn + (size_t)(tt * 128 + n) * 512 + ft * 128 + m, v); });
    } else {
      gemm_kloop<0>(acc, X, 128, W, 128, 128, smem, 0.f, 0.f);
      epilogue(acc, [&](int m, int n, float (&v)[16]) { st_bf16x16(Vt + (size_t)((ft - 4) * 128 + n) * NKV + tt * 128 + m, v); });
    }
  }
}

DI void conv_fp8_rows(const float* __restrict__ src, unsigned char* __restrict__ dst, float* __restrict__ inv);
DI void phase7(const Params& p, char* smem) {
  char* ws = p.ws;
  const bf16_t* q = (const bf16_t*)(ws + OFF_Q);
  const bf16_t* Kn = (const bf16_t*)(ws + OFF_KN);
  const bf16_t* Vt = (const bf16_t*)(ws + OFF_VTA);
  const bf16_t* krall = (const bf16_t*)(ws + OFF_KRALL);
  bf16_t* attn = (bf16_t*)(ws + OFF_ATTN);
  bf16_t* Ks0 = (bf16_t*)smem;
  const int tid = threadIdx.x, lane = tid & 63, w = tid >> 6, l15 = lane & 15, g = lane >> 4;
  const float qscale = 0.10206207261596577f * 1.4426950408889634f;
  for (int item = vbid(); item < 1280; item += gridDim.x) {
    int b, h, qtok0, keyrow0, nkt;
    bool sample;
    if (item < 1024) {
      sample = true; b = item >> 7; h = (item >> 4) & 7; int qb = item & 15;
      qtok0 = NPT + b * 2048 + qb * 128; keyrow0 = NPT + b * 2560; nkt = 40;
    } else {
      int it2 = item - 1024;
      sample = false; b = it2 >> 4; h = (it2 >> 1) & 7; int qb = it2 & 1;
      qtok0 = b * 256 + qb * 128; keyrow0 = b * 256; nkt = 4;
    }
    bf16x8 Q[2][3];
#pragma unroll
    for (int qt = 0; qt < 2; ++qt) {
      const int tokq = qtok0 + w * 32 + qt * 16 + l15;
      const bf16_t* qp = q + (size_t)tokq * 768 + h * 96;
#pragma unroll
      for (int ks = 0; ks < 3; ++ks) {
        u32x4 u = *(const u32x4*)(qp + ks * 32 + g * 8);
        float v[8];
#pragma unroll
        for (int i = 0; i < 4; ++i) { v[2 * i] = bflo(u[i]); v[2 * i + 1] = bfhi(u[i]); }
        if (ks == 2 && sample) {
          u32x4 up = *(const u32x4*)(qp + 64 + (g ^ 2) * 8);
          float pv[8];
#pragma unroll
          for (int i = 0; i < 4; ++i) { pv[2 * i] = bflo(up[i]); pv[2 * i + 1] = bfhi(up[i]); }
          int t = (tokq - NPT) & 2047;
          const float4* rp = (const float4*)((const float2*)(ws + OFF_ROPE) + t * 16 + (g & 1) * 8);
#pragma unroll
          for (int i2 = 0; i2 < 4; ++i2) {
            const float4 c2 = rp[i2];
            const int i = 2 * i2;
            v[i] = g < 2 ? v[i] * c2.x - pv[i] * c2.y : pv[i] * c2.y + v[i] * c2.x;
            v[i + 1] = g < 2 ? v[i + 1] * c2.z - pv[i + 1] * c2.w : pv[i + 1] * c2.w + v[i + 1] * c2.z;
          }
        }
        u32x4 o4;
#pragma unroll
        for (int i = 0; i < 4; ++i) o4[i] = pack2(v[2 * i] * qscale, v[2 * i + 1] * qscale);
        Q[qt][ks] = __builtin_bit_cast(bf16x8, o4);
      }
    }
    f32x4 o[4][2];
#pragma unroll
    for (int et = 0; et < 4; ++et)
#pragma unroll
      for (int qt = 0; qt < 2; ++qt) o[et][qt] = f32x4{0.f, 0.f, 0.f, 0.f};
    float mrun[2] = {-1e30f, -1e30f}, lrun[2] = {0.f, 0.f};
    u32x4 rk_[3], rv_[2];
    auto gload = [&](int kt) {
      const int row0 = keyrow0 + kt * 64;
#pragma unroll
      for (int i = 0; i < 3; ++i) {
        int c = tid + 256 * i;
        int r = c / 12, cc = c - r * 12;
        rk_[i] = cc < 8 ? *(const u32x4*)(Kn + (size_t)(row0 + r) * 512 + h * 64 + cc * 8)
                        : *(const u32x4*)(krall + (size_t)(row0 + r) * 32 + (cc - 8) * 8);
      }
#pragma unroll
      for (int i = 0; i < 2; ++i) {
        int c = tid + 256 * i;
        int e = c >> 3, cc = (c & 7) * 8;
        rv_[i] = *(const u32x4*)(Vt + (size_t)(h * 64 + e) * NKV + row0 + cc);
      }
    };
    auto lstore = [&](int b) {
      bf16_t* Kd = Ks0 + b * 11776;
      bf16_t* Vd = Kd + 64 * 112;
#pragma unroll
      for (int i = 0; i < 3; ++i) {
        int c = tid + 256 * i;
        int r = c / 12, cc = c - r * 12;
        *(u32x4*)(Kd + r * 112 + cc * 8) = rk_[i];
      }
#pragma unroll
      for (int i = 0; i < 2; ++i) {
        int c = tid + 256 * i;
        int e = c >> 3, cc = (c & 7) * 8;
        *(u32x4*)(Vd + e * 72 + cc) = rv_[i];
      }
    };
    gload(0);
    __syncthreads();
    lstore(0);
    if (nkt > 1) gload(1);
    __syncthreads();
#pragma unroll 1
    for (int kt = 0; kt < nkt; ++kt) {
      const bf16_t* Ks = Ks0 + (kt & 1) * 11776;
      const bf16_t* Vs = Ks + 64 * 112;
      f32x4 s[4][2];
#pragma unroll
      for (int kk = 0; kk < 4; ++kk)
#pragma unroll
        for (int qt = 0; qt < 2; ++qt) s[kk][qt] = f32x4{0.f, 0.f, 0.f, 0.f};
#pragma unroll
      for (int ks = 0; ks < 3; ++ks) {
#pragma unroll
        for (int kk = 0; kk < 4; ++kk) {
          bf16x8 a = *(const bf16x8*)(Ks + (kk * 16 + l15) * 112 + ks * 32 + g * 8);
#pragma unroll
          for (int qt = 0; qt < 2; ++qt) s[kk][qt] = __builtin_amdgcn_mfma_f32_16x16x32_bf16(a, Q[qt][ks], s[kk][qt], 0, 0, 0);
        }
      }
      bf16x8 P[2][2];
#pragma unroll
      for (int qt = 0; qt < 2; ++qt) {
        float mx = s[0][qt][0];
#pragma unroll
        for (int kk = 0; kk < 4; ++kk)
#pragma unroll
          for (int j = 0; j < 4; ++j) mx = fmaxf(mx, s[kk][qt][j]);
        mx = fmaxf(mx, __shfl_xor(mx, 16));
        mx = fmaxf(mx, __shfl_xor(mx, 32));
        const float mnew = fmaxf(mrun[qt], mx);
        const bool grow = __ballot(mx > mrun[qt]) != 0ull;
        const float alpha = grow ? ex2(mrun[qt] - mnew) : 1.f;
        mrun[qt] = mnew;
        float ps = 0.f;
#pragma unroll
        for (int kk = 0; kk < 4; ++kk)
#pragma unroll
          for (int j = 0; j < 4; ++j) {
            float e_ = ex2(s[kk][qt][j] - mnew);
            s[kk][qt][j] = e_;
            ps += e_;
          }
        if (grow) {
          lrun[qt] = lrun[qt] * alpha + ps;
#pragma unroll
          for (int et = 0; et < 4; ++et)
#pragma unroll
            for (int j = 0; j < 4; ++j) o[et][qt][j] *= alpha;
        } else {
          lrun[qt] += ps;
        }
#pragma unroll
        for (int k2 = 0; k2 < 2; ++k2) {
          u32x4 u;
          u[0] = pack2(s[2 * k2][qt][0], s[2 * k2][qt][1]);
          u[1] = pack2(s[2 * k2][qt][2], s[2 * k2][qt][3]);
          u[2] = pack2(s[2 * k2 + 1][qt][0], s[2 * k2 + 1][qt][1]);
          u[3] = pack2(s[2 * k2 + 1][qt][2], s[2 * k2 + 1][qt][3]);
          P[qt][k2] = __builtin_bit_cast(bf16x8, u);
        }
      }
#pragma unroll
      for (int k2 = 0; k2 < 2; ++k2) {
#pragma unroll
        for (int et = 0; et < 4; ++et) {
          u32x2 lo = *(const u32x2*)(Vs + (et * 16 + l15) * 72 + k2 * 32 + 4 * g);
          u32x2 hi = *(const u32x2*)(Vs + (et * 16 + l15) * 72 + k2 * 32 + 16 + 4 * g);
          u32x4 u;
          u[0] = lo[0]; u[1] = lo[1]; u[2] = hi[0]; u[3] = hi[1];
          bf16x8 a = __builtin_bit_cast(bf16x8, u);
#pragma unroll
          for (int qt = 0; qt < 2; ++qt) o[et][qt] = __builtin_amdgcn_mfma_f32_16x16x32_bf16(a, P[qt][k2], o[et][qt], 0, 0, 0);
        }
      }
      if (kt + 1 < nkt) {
        lstore((kt + 1) & 1);
        if (kt + 2 < nkt) gload(kt + 2);
        __syncthreads();
      }
    }
#pragma unroll
    for (int qt = 0; qt < 2; ++qt) {
      const int tokq = qtok0 + w * 32 + qt * 16 + l15;
      float lt = lrun[qt];
      lt += __shfl_xor(lt, 16);
      lt += __shfl_xor(lt, 32);
      const float inv = 1.f / lt;
#pragma unroll
      for (int et = 0; et < 4; ++et) {
        u32x2 ov;
        ov[0] = pack2(o[et][qt][0] * inv, o[et][qt][1] * inv);
        ov[1] = pack2(o[et][qt][2] * inv, o[et][qt][3] * inv);
        *(u32x2*)(attn + (size_t)tokq * 512 + h * 64 + et * 16 + 4 * g) = ov;
      }
    }
  }
  conv_fp8_rows(p.peer_u, (unsigned char*)(p.ws + OFF_TABU), (float*)(p.ws + OFF_INVU));
  conv_fp8_rows(p.peer_v, (unsigned char*)(p.ws + OFF_TABV), (float*)(p.ws + OFF_INVV));
}

DI void phase8(const Params& p, char* smem) {
  char* ws = p.ws;
  const bf16_t* attn = (const bf16_t*)(ws + OFF_ATTN);
  const bf16_t* ret = (const bf16_t*)(ws + OFF_RET);
  const bf16_t* wa = (const bf16_t*)(ws + OFF_WUPAT);
  const bf16_t* wb = (const bf16_t*)(ws + OFF_WUPBT);
  const bf16_t* sga = (const bf16_t*)p.out;
  const bf16_t* sgb = sga + (size_t)NTOK * 1024;
  bf16_t* mbuf = (bf16_t*)(ws + OFF_M);
  const int tid = threadIdx.x, lane = tid & 63, w = tid >> 6, wm = w >> 1, wn = w & 1, l15 = lane & 15, g = lane >> 4;
  for (int it = 0;; ++it) {
    int ft, tt;
    if (!tile_map(it, 8, 160, 1, ft, tt)) break;
    f32x4 acc[4][4];
    acc_zero(acc);
    gemm_kloop<0>(acc, wa + (size_t)ft * 128 * 512, 512, attn + (size_t)tt * 128 * 512, 512, 512, smem, 0.f, 0.f);
#pragma unroll
    for (int c = 0; c < 4; ++c) {
      const size_t off = (size_t)(tt * 128 + wn * 64 + c * 16 + l15) * 1024 + ft * 128 + wm * 64 + 16 * g;
      float a[16], bq[16];
      ld_bf16x16(sga + off, a);
      ld_bf16x16(sgb + off, bq);
#pragma unroll
      for (int f = 0; f < 4; ++f)
#pragma unroll
        for (int j = 0; j < 4; ++j) acc[f][c][j] *= a[f * 4 + j] * __builtin_amdgcn_rcpf(fmaxf(bq[f * 4 + j], 1e-30f));
    }
    gemm_kloop<0>(acc, wb + (size_t)ft * 128 * 512, 512, ret + (size_t)tt * 128 * 512, 512, 512, smem, 0.f, 0.f);
    epilogue(acc, [&](int m, int n, float (&v)[16]) {
      const size_t off = (size_t)(tt * 128 + n) * 1024 + ft * 128 + m;
      float bq[16];
      ld_bf16x16(sgb + off, bq);
#pragma unroll
      for (int i = 0; i < 16; ++i) v[i] *= bq[i];
      st_bf16x16(mbuf + off, v);
    });
  }
}
DI void phase9(const Params& p, char* smem) {
  char* ws = p.ws;
  const bf16_t* mbuf = (const bf16_t*)(ws + OFF_M);
  const bf16_t* wo = (const bf16_t*)(ws + OFF_WOT);
  const float* mod = (const float*)(ws + OFF_MOD);
  for (int it = 0;; ++it) {
    int ft, tt;
    if (!tile_map(it, 8, 160, 1, ft, tt)) break;
    f32x4 acc[4][4];
    acc_zero(acc);
    gemm_kloop<0>(acc, wo + (size_t)ft * 128 * 1024, 1024, mbuf + (size_t)tt * 128 * 1024, 1024, 1024, smem, 0.f, 0.f);
    epilogue(acc, [&](int m, int n, float (&v)[16]) {
      const int tok = tt * 128 + n, feat = ft * 128 + m;
      const float* xr = xrow(p, tok) + feat;
      const float* g1 = mod + modidx(tok) * 6144 + 2048 + feat;
#pragma unroll
      for (int i = 0; i < 4; ++i) {
        float4 xv = *(const float4*)(xr + 4 * i), gv = *(const float4*)(g1 + 4 * i);
        v[4 * i] = xv.x + gv.x * v[4 * i];
        v[4 * i + 1] = xv.y + gv.y * v[4 * i + 1];
        v[4 * i + 2] = xv.z + gv.z * v[4 * i + 2];
        v[4 * i + 3] = xv.w + gv.w * v[4 * i + 3];
      }
      st_f32x16(p.out + (size_t)tok * DM + feat, v);
    });
  }
}
DI void conv_fp8_rows(const float* __restrict__ src, unsigned char* __restrict__ dst, float* __restrict__ inv) {
  const int lane = threadIdx.x & 63, w = threadIdx.x >> 6;
  for (int r = blockIdx.x * 4 + w; r < 16384; r += gridDim.x * 4) {
    const float* sp = src + (size_t)r * 1024 + lane * 16;
    float4 v[4];
    float am = 0.f;
#pragma unroll
    for (int i = 0; i < 4; ++i) {
      v[i] = *(const float4*)(sp + 4 * i);
      am = fmaxf(am, fmaxf(fmaxf(fabsf(v[i].x), fabsf(v[i].y)), fmaxf(fabsf(v[i].z), fabsf(v[i].w))));
    }
#pragma unroll
    for (int o = 32; o > 0; o >>= 1) am = fmaxf(am, __shfl_xor(am, o));
    const float sc = am > 0.f ? 448.f / am : 1.f;
    u32x4 o4;
#pragma unroll
    for (int i = 0; i < 4; ++i) {
      int wd = 0;
      wd = __builtin_amdgcn_cvt_pk_fp8_f32(v[i].x * sc, v[i].y * sc, wd, false);
      wd = __builtin_amdgcn_cvt_pk_fp8_f32(v[i].z * sc, v[i].w * sc, wd, true);
      o4[i] = (unsigned)wd;
    }
    *(u32x4*)(dst + ((size_t)(lane >> 3) * 16384 + r) * 128 + (lane & 7) * 16) = o4;
    if (lane == 0) inv[r] = am > 0.f ? am * (1.f / 448.f) : 1.f;
  }
}
DI void phase10(const Params& p, char* smem) {
  rows_norm_mod(p, p.norm_ffn, 3072, 4096, true, (bf16_t*)(p.ws + OFF_H2));
}
DI void phase11(const Params& p, char* smem) {
  char* ws = p.ws;
  const bf16_t* h2 = (const bf16_t*)(ws + OFF_H2);
  const bf16_t* wct = (const bf16_t*)(ws + OFF_WCT);
  bf16_t* sc = (bf16_t*)(ws + OFF_SCORES);
  for (int it = 0;; ++it) {
    int ft, tt;
    if (!tile_map(it, 16, 160, 2, ft, tt)) break;
    f32x4 acc[4][4];
    acc_zero(acc);
    gemm_kloop<0>(acc, wct + (size_t)ft * 128 * 1024, 1024, h2 + (size_t)tt * 128 * 1024, 1024, 1024, smem, 0.f, 0.f);
    epilogue(acc, [&](int m, int n, float (&v)[16]) { st_bf16x16(sc + (size_t)(tt * 128 + n) * 2048 + ft * 128 + m, v); });
  }
}

DI unsigned okey(float f) {
  unsigned u = __float_as_uint(f);
  return (u & 0x80000000u) ? ~u : (u | 0x80000000u);
}
DI void wave_lds_sync() {
  __builtin_amdgcn_fence(__ATOMIC_ACQ_REL, "workgroup");
  __builtin_amdgcn_wave_barrier();
}
DI unsigned okey16(unsigned b) { return (b & 0x8000u) ? (~b & 0xFFFFu) : (b | 0x8000u); }
DI unsigned inv_okey16(unsigned k) { return (k & 0x8000u) ? (k & 0x7FFFu) : (~k & 0xFFFFu); }
DI unsigned inv_okey(unsigned k) { return (k & 0x80000000u) ? (k & 0x7FFFFFFFu) : ~k; }
DI void ins16(unsigned (&L)[16], unsigned x) {
#pragma unroll
  for (int i = 0; i < 16; ++i) {
    unsigned t = max(L[i], x);
    x = min(L[i], x);
    L[i] = t;
  }
}
DI void ce_desc(unsigned& a, unsigned& b) {
  const unsigned t = max(a, b);
  b = min(a, b);
  a = t;
}
DI void sort16_desc(unsigned (&a)[16]) {
#pragma unroll
  for (int ks = 1; ks <= 4; ++ks) {
#pragma unroll
    for (int js = ks - 1; js >= 0; --js) {
#pragma unroll
      for (int i = 0; i < 16; ++i) {
        const int k = 1 << ks, j = 1 << js, l = i ^ j;
        if (l > i) {
          if ((i & k) == 0) ce_desc(a[i], a[l]);
          else ce_desc(a[l], a[i]);
        }
      }
    }
  }
}
DI void merge_top16(unsigned (&L)[16], const unsigned (&G)[16]) {
#pragma unroll
  for (int i = 0; i < 16; ++i) L[i] = max(L[i], G[15 - i]);
#pragma unroll
  for (int js = 3; js >= 0; --js) {
#pragma unroll
    for (int i = 0; i < 16; ++i) {
      const int j = 1 << js, l = i ^ j;
      if (l > i) ce_desc(L[i], L[l]);
    }
  }
}
DI unsigned byte16(const unsigned (&d)[4], int i) {
  unsigned r = 0u;
#pragma unroll
  for (int q = 0; q < 4; ++q) r |= d[q] & (0u - (unsigned)((i >> 2) == q));
  return (r >> ((i & 3) * 8)) & 0xFFu;
}
DI unsigned sel16(const unsigned (&A)[16], int i) {
  unsigned r = 0u;
#pragma unroll
  for (int t = 0; t < 16; ++t) r |= A[t] & (0u - (unsigned)(i == t));
  return r;
}
DI void phase12(const Params& p, char* smem) {
  char* ws = p.ws;
  const bf16_t* sc = (const bf16_t*)(ws + OFF_SCORES);
  int* elist = (int*)(ws + OFF_ELIST);
  float* glist = (float*)(ws + OFF_GLIST);
  const int lane = threadIdx.x & 63, w = threadIdx.x >> 6;
  for (int batch = blockIdx.x * 4 + w; batch < NTOK / 4; batch += gridDim.x * 4) {
    const int tok = batch * 4 + (lane >> 4), hh = lane & 15;
    const bf16_t* row = sc + (size_t)tok * 2048 + hh * 128;
    unsigned L[16];
#pragma unroll
    for (int grp8 = 0; grp8 < 8; ++grp8) {
      unsigned G[16];
#pragma unroll
      for (int cc = 0; cc < 2; ++cc) {
        const int c = grp8 * 2 + cc;
        u32x4 u = *(const u32x4*)(row + c * 8);
#pragma unroll
        for (int i = 0; i < 4; ++i) {
          unsigned b0 = u[i] & 0xFFFFu, b1 = u[i] >> 16;
          G[cc * 8 + 2 * i] = (okey16(b0) << 16) | (unsigned)(127 - (c * 8 + 2 * i));
          G[cc * 8 + 2 * i + 1] = (okey16(b1) << 16) | (unsigned)(127 - (c * 8 + 2 * i + 1));
        }
      }
      sort16_desc(G);
      if (grp8 == 0) {
#pragma unroll
        for (int i = 0; i < 16; ++i) L[i] = G[i];
      } else {
        merge_top16(L, G);
      }
    }
    unsigned M[16];
#pragma unroll
    for (int i = 0; i < 16; ++i) M[i] = (unsigned)__shfl_xor((int)L[i], 1);
    float v1[16], v2[16];
#pragma unroll
    for (int i = 0; i < 16; ++i) {
      v1[i] = bf2f(inv_okey16(L[i] >> 16));
      v2[i] = bf2f(inv_okey16(M[i] >> 16));
    }
    unsigned C[16];
    C[0] = ((okey(v1[0] + v2[0]) & 0xFFFFFF00u) | 255u);
    C[1] = ((okey(v1[0] + v2[1]) & 0xFFFFFF00u) | 254u);
    C[2] = ((okey(v1[0] + v2[2]) & 0xFFFFFF00u) | 253u);
    C[3] = ((okey(v1[0] + v2[3]) & 0xFFFFFF00u) | 252u);
    C[4] = ((okey(v1[0] + v2[4]) & 0xFFFFFF00u) | 251u);
    C[5] = ((okey(v1[0] + v2[5]) & 0xFFFFFF00u) | 250u);
    C[6] = ((okey(v1[0] + v2[6]) & 0xFFFFFF00u) | 249u);
    C[7] = ((okey(v1[0] + v2[7]) & 0xFFFFFF00u) | 248u);
    C[8] = ((okey(v1[0] + v2[8]) & 0xFFFFFF00u) | 247u);
    C[9] = ((okey(v1[0] + v2[9]) & 0xFFFFFF00u) | 246u);
    C[10] = ((okey(v1[0] + v2[10]) & 0xFFFFFF00u) | 245u);
    C[11] = ((okey(v1[0] + v2[11]) & 0xFFFFFF00u) | 244u);
    C[12] = ((okey(v1[0] + v2[12]) & 0xFFFFFF00u) | 243u);
    C[13] = ((okey(v1[0] + v2[13]) & 0xFFFFFF00u) | 242u);
    C[14] = ((okey(v1[0] + v2[14]) & 0xFFFFFF00u) | 241u);
    C[15] = ((okey(v1[0] + v2[15]) & 0xFFFFFF00u) | 240u);
    {
      unsigned G[16];
      G[0] = ((okey(v1[1] + v2[0]) & 0xFFFFFF00u) | 239u);
      G[1] = ((okey(v1[1] + v2[1]) & 0xFFFFFF00u) | 238u);
      G[2] = ((okey(v1[1] + v2[2]) & 0xFFFFFF00u) | 237u);
      G[3] = ((okey(v1[1] + v2[3]) & 0xFFFFFF00u) | 236u);
      G[4] = ((okey(v1[1] + v2[4]) & 0xFFFFFF00u) | 235u);
      G[5] = ((okey(v1[1] + v2[5]) & 0xFFFFFF00u) | 234u);
      G[6] = ((okey(v1[1] + v2[6]) & 0xFFFFFF00u) | 233u);
      G[7] = ((okey(v1[1] + v2[7]) & 0xFFFFFF00u) | 232u);
      G[8] = 0u;
      G[9] = 0u;
      G[10] = 0u;
      G[11] = 0u;
      G[12] = 0u;
      G[13] = 0u;
      G[14] = 0u;
      G[15] = 0u;
      merge_top16(C, G);
    }
    {
      unsigned G[16];
      G[0] = ((okey(v1[2] + v2[0]) & 0xFFFFFF00u) | 223u);
      G[1] = ((okey(v1[2] + v2[1]) & 0xFFFFFF00u) | 222u);
      G[2] = ((okey(v1[2] + v2[2]) & 0xFFFFFF00u) | 221u);
      G[3] = ((okey(v1[2] + v2[3]) & 0xFFFFFF00u) | 220u);
      G[4] = ((okey(v1[2] + v2[4]) & 0xFFFFFF00u) | 219u);
      G[5] = 0u;
      G[6] = 0u;
      G[7] = 0u;
      G[8] = 0u;
      G[9] = 0u;
      G[10] = 0u;
      G[11] = 0u;
      G[12] = 0u;
      G[13] = 0u;
      G[14] = 0u;
      G[15] = 0u;
      merge_top16(C, G);
    }
    {
      unsigned G[16];
      G[0] = ((okey(v1[3] + v2[0]) & 0xFFFFFF00u) | 207u);
      G[1] = ((okey(v1[3] + v2[1]) & 0xFFFFFF00u) | 206u);
      G[2] = ((okey(v1[3] + v2[2]) & 0xFFFFFF00u) | 205u);
      G[3] = ((okey(v1[3] + v2[3]) & 0xFFFFFF00u) | 204u);
      G[4] = 0u;
      G[5] = 0u;
      G[6] = 0u;
      G[7] = 0u;
      G[8] = 0u;
      G[9] = 0u;
      G[10] = 0u;
      G[11] = 0u;
      G[12] = 0u;
      G[13] = 0u;
      G[14] = 0u;
      G[15] = 0u;
      merge_top16(C, G);
    }
    {
      unsigned G[16];
      G[0] = ((okey(v1[4] + v2[0]) & 0xFFFFFF00u) | 191u);
      G[1] = ((okey(v1[5] + v2[0]) & 0xFFFFFF00u) | 175u);
      G[2] = ((okey(v1[6] + v2[0]) & 0xFFFFFF00u) | 159u);
      G[3] = ((okey(v1[7] + v2[0]) & 0xFFFFFF00u) | 143u);
      G[4] = ((okey(v1[8] + v2[0]) & 0xFFFFFF00u) | 127u);
      G[5] = ((okey(v1[9] + v2[0]) & 0xFFFFFF00u) | 111u);
      G[6] = ((okey(v1[10] + v2[0]) & 0xFFFFFF00u) | 95u);
      G[7] = ((okey(v1[11] + v2[0]) & 0xFFFFFF00u) | 79u);
      G[8] = ((okey(v1[12] + v2[0]) & 0xFFFFFF00u) | 63u);
      G[9] = ((okey(v1[13] + v2[0]) & 0xFFFFFF00u) | 47u);
      G[10] = ((okey(v1[14] + v2[0]) & 0xFFFFFF00u) | 31u);
      G[11] = ((okey(v1[15] + v2[0]) & 0xFFFFFF00u) | 15u);
      G[12] = 0u;
      G[13] = 0u;
      G[14] = 0u;
      G[15] = 0u;
      merge_top16(C, G);
    }
    {
      unsigned G[16];
      G[0] = ((okey(v1[4] + v2[1]) & 0xFFFFFF00u) | 190u);
      G[1] = ((okey(v1[5] + v2[1]) & 0xFFFFFF00u) | 174u);
      G[2] = ((okey(v1[6] + v2[1]) & 0xFFFFFF00u) | 158u);
      G[3] = ((okey(v1[7] + v2[1]) & 0xFFFFFF00u) | 142u);
      G[4] = 0u;
      G[5] = 0u;
      G[6] = 0u;
      G[7] = 0u;
      G[8] = 0u;
      G[9] = 0u;
      G[10] = 0u;
      G[11] = 0u;
      G[12] = 0u;
      G[13] = 0u;
      G[14] = 0u;
      G[15] = 0u;
      merge_top16(C, G);
    }
    {
      unsigned G[16];
      G[0] = ((okey(v1[4] + v2[2]) & 0xFFFFFF00u) | 189u);
      G[1] = 0u;
      G[2] = 0u;
      G[3] = 0u;
      G[4] = 0u;
      G[5] = 0u;
      G[6] = 0u;
      G[7] = 0u;
      G[8] = 0u;
      G[9] = 0u;
      G[10] = 0u;
      G[11] = 0u;
      G[12] = 0u;
      G[13] = 0u;
      G[14] = 0u;
      G[15] = 0u;
      merge_top16(C, G);
    }
    unsigned ib1[4], ib2[4];
#pragma unroll
    for (int q = 0; q < 4; ++q) {
      ib1[q] = (L[4 * q] & 0xFFu) | ((L[4 * q + 1] & 0xFFu) << 8) | ((L[4 * q + 2] & 0xFFu) << 16) | ((L[4 * q + 3] & 0xFFu) << 24);
      ib2[q] = (M[4 * q] & 0xFFu) | ((M[4 * q + 1] & 0xFFu) << 8) | ((M[4 * q + 2] & 0xFFu) << 16) | ((M[4 * q + 3] & 0xFFu) << 24);
    }
    int ev[16];
    float gv[16];
    const float mx = __uint_as_float(inv_okey(C[0] & 0xFFFFFF00u));
    float den = 0.f;
#pragma unroll
    for (int k = 0; k < 16; ++k) {
      const int ci = 255 - (int)(C[k] & 0xFFu);
      ev[k] = (127 - (int)byte16(ib1, ci >> 4)) * 128 + (127 - (int)byte16(ib2, ci & 15));
      gv[k] = __expf(__uint_as_float(inv_okey(C[k] & 0xFFFFFF00u)) - mx);
      den += gv[k];
    }
    const float inv = 1.f / den;
    if ((lane & 1) == 0) {
      int* ep = elist + (size_t)tok * 128 + (hh >> 1) * 16;
      float* gp = glist + (size_t)tok * 128 + (hh >> 1) * 16;
#pragma unroll
      for (int k = 0; k < 4; ++k) {
        *(int4*)(ep + 4 * k) = make_int4(ev[4 * k], ev[4 * k + 1], ev[4 * k + 2], ev[4 * k + 3]);
        *(float4*)(gp + 4 * k) = make_float4(gv[4 * k] * inv, gv[4 * k + 1] * inv, gv[4 * k + 2] * inv, gv[4 * k + 3] * inv);
      }
    }
  }
}
using f32x2 = __attribute__((ext_vector_type(2))) float;
DI f32x2 cvt8(unsigned w, bool hi) {
  return hi ? __builtin_amdgcn_cvt_pk_f32_fp8((int)w, true) : __builtin_amdgcn_cvt_pk_f32_fp8((int)w, false);
}
struct SMeta { int e[16]; u32x4 ha, hb; };
template <int MODE>
DI void sl_meta(const Params& p, int t, int s, int grp, int ch, SMeta& m) {
  const int* elist = (const int*)(p.ws + (MODE == 0 ? OFF_ELIST : OFF_GLIST));
#pragma unroll
  for (int i = 0; i < 16; ++i) m.e[i] = elist[(size_t)t * 128 + i * 8 + grp];
  if (MODE == 0) {
    const bf16_t* hq = (const bf16_t*)(p.ws + OFF_H2) + (size_t)t * DM + s * 128 + ch * 16;
    m.ha = *(const u32x4*)hq;
    m.hb = *(const u32x4*)(hq + 8);
  }
}
template <int MODE>
DI void sl_rows(const Params& p, int s, int ch, const SMeta& m, u32x4 (&r)[16]) {
  const unsigned char* tab = (const unsigned char*)(p.ws + (MODE == 0 ? OFF_TABU : OFF_TABV));
#pragma unroll
  for (int i = 0; i < 16; ++i) r[i] = *(const u32x4*)(tab + ((size_t)s * 16384 + (m.e[i] & 0xFFFF)) * 128 + ch * 16);
}
template <int MODE>
DI void sl_compute(const Params& p, int t, int s, int lane, const SMeta& m, const u32x4 (&r)[16]) {
  const int grp = lane >> 3, ch = lane & 7;
  if (MODE == 0) {
    f32x2 hp[8];
#pragma unroll
    for (int i = 0; i < 4; ++i) {
      hp[i] = f32x2{bflo(m.ha[i]), bfhi(m.ha[i])};
      hp[4 + i] = f32x2{bflo(m.hb[i]), bfhi(m.hb[i])};
    }
    float keep0 = 0.f, keep1 = 0.f;
#pragma unroll
    for (int i = 0; i < 16; ++i) {
      f32x2 d2 = f32x2{0.f, 0.f};
#pragma unroll
      for (int j = 0; j < 4; ++j) {
        d2 += cvt8(r[i][j], false) * hp[2 * j];
        d2 += cvt8(r[i][j], true) * hp[2 * j + 1];
      }
      float d = d2[0] + d2[1];
      d += __shfl_xor(d, 1);
      d += __shfl_xor(d, 2);
      d += __shfl_xor(d, 4);
      if (i < 8) keep0 = (ch == i) ? d : keep0;
      else keep1 = (ch == i - 8) ? d : keep1;
    }
    float* po = (float*)(p.ws + OFF_PD) + (size_t)t * 1024 + s * 128;
    po[ch * 8 + grp] = keep0;
    po[(ch + 8) * 8 + grp] = keep1;
  } else {
    f32x2 acc[8];
#pragma unroll
    for (int q = 0; q < 8; ++q) acc[q] = f32x2{0.f, 0.f};
#pragma unroll
    for (int i = 0; i < 16; ++i) {
      const float wsc = __uint_as_float((unsigned)m.e[i] & 0xFFFF0000u);
      const f32x2 w2 = f32x2{wsc, wsc};
#pragma unroll
      for (int j = 0; j < 4; ++j) {
        acc[2 * j] += w2 * cvt8(r[i][j], false);
        acc[2 * j + 1] += w2 * cvt8(r[i][j], true);
      }
    }
    float v[16];
#pragma unroll
    for (int q = 0; q < 8; ++q) { v[2 * q] = acc[q][0]; v[2 * q + 1] = acc[q][1]; }
    float q8[8], q4[4], q2[2];
    {
      const bool hi = lane & 32;
#pragma unroll
      for (int i = 0; i < 8; ++i) {
        float send = hi ? v[i] : v[8 + i], keep = hi ? v[8 + i] : v[i];
        q8[i] = keep + __shfl_xor(send, 32);
      }
    }
    {
      const bool hi = lane & 16;
#pragma unroll
      for (int i = 0; i < 4; ++i) {
        float send = hi ? q8[i] : q8[4 + i], keep = hi ? q8[4 + i] : q8[i];
        q4[i] = keep + __shfl_xor(send, 16);
      }
    }
    {
      const bool hi = lane & 8;
#pragma unroll
      for (int i = 0; i < 2; ++i) {
        float send = hi ? q4[i] : q4[2 + i], keep = hi ? q4[2 + i] : q4[i];
        q2[i] = keep + __shfl_xor(send, 8);
      }
    }
    const int f = s * 128 + ch * 16 + 2 * grp;
    float* xr = p.out + (size_t)t * DM + f;
    const float2 xv = *(const float2*)xr;
    const float2 gv = *(const float2*)((const float*)(p.ws + OFF_MOD) + modidx(t) * 6144 + 5120 + f);
    *(float2*)xr = make_float2(xv.x + gv.x * q2[0], xv.y + gv.y * q2[1]);
  }
}
template <int MODE>
DI void sliced_pass(const Params& p) {
  const int s = blockIdx.x & 7, loc = blockIdx.x >> 3, nloc = gridDim.x >> 3;
  if (loc >= nloc) return;
  const int lane = threadIdx.x & 63, w = threadIdx.x >> 6, grp = lane >> 3, ch = lane & 7;
  const int stride = nloc * 4;
  SMeta mA, mB;
  u32x4 rA[16], rB[16];
  int t = loc * 4 + w;
  if (t < NTOK) {
    sl_meta<MODE>(p, t, s, grp, ch, mA);
    sl_rows<MODE>(p, s, ch, mA, rA);
  }
  if (t + stride < NTOK) sl_meta<MODE>(p, t + stride, s, grp, ch, mB);
#pragma unroll 1
  for (; t < NTOK; t += 2 * stride) {
    const int t1 = t + stride, t2 = t + 2 * stride, t3 = t + 3 * stride;
    if (t1 < NTOK) sl_rows<MODE>(p, s, ch, mB, rB);
    sl_compute<MODE>(p, t, s, lane, mA, rA);
    if (t2 < NTOK) sl_meta<MODE>(p, t2, s, grp, ch, mA);
    if (t1 < NTOK) {
      if (t2 < NTOK) sl_rows<MODE>(p, s, ch, mA, rA);
      sl_compute<MODE>(p, t1, s, lane, mB, rB);
      if (t3 < NTOK) sl_meta<MODE>(p, t3, s, grp, ch, mB);
    }
  }
}
DI void phase13(const Params& p) { sliced_pass<0>(p); }
DI void phase14(const Params& p) {
  char* ws = p.ws;
  const float* invU = (const float*)(ws + OFF_INVU);
  const float* invV = (const float*)(ws + OFF_INVV);
  const int* elist = (const int*)(ws + OFF_ELIST);
  float* glist = (float*)(ws + OFF_GLIST);
  const float* pd = (const float*)(ws + OFF_PD);
  const int lane = threadIdx.x & 63, w = threadIdx.x >> 6;
  for (int t = blockIdx.x * 4 + w; t < NTOK; t += gridDim.x * 4) {
#pragma unroll
    for (int hf_ = 0; hf_ < 2; ++hf_) {
      const int k = hf_ * 64 + lane;
      float d = 0.f;
#pragma unroll
      for (int s = 0; s < 8; ++s) d += pd[(size_t)t * 1024 + s * 128 + k];
      const int e = elist[(size_t)t * 128 + k];
      const float g = glist[(size_t)t * 128 + k];
      ((unsigned*)glist)[(size_t)t * 128 + k] = (pack2(0.f, g * geluf_(d * invU[e]) * invV[e]) & 0xFFFF0000u) | (unsigned)e;
    }
  }
}
DI void phase15(const Params& p) { sliced_pass<1>(p); }
DI void phase16(const Params& p) {
  const int lane = threadIdx.x & 63, w = threadIdx.x >> 6;
  for (int tok = blockIdx.x * 4 + w; tok < NTOK; tok += gridDim.x * 4) {
    float* xr = p.out + (size_t)tok * DM;
    float4 xv[4];
    float ss = 0.f;
#pragma unroll
    for (int i = 0; i < 4; ++i) {
      xv[i] = *(const float4*)(xr + (i * 64 + lane) * 4);
      ss += xv[i].x * xv[i].x + xv[i].y * xv[i].y + xv[i].z * xv[i].z + xv[i].w * xv[i].w;
    }
    ss = wsum(ss);
    const float rstd = rsqrtf(ss * (1.f / 1024.f) + 1e-6f);
#pragma unroll
    for (int i = 0; i < 4; ++i) {
      const int e = (i * 64 + lane) * 4;
      float4 nf = *(const float4*)(p.norm_final + e);
      *(float4*)(xr + e) = make_float4(xv[i].x * rstd * nf.x, xv[i].y * rstd * nf.y, xv[i].z * rstd * nf.z, xv[i].w * rstd * nf.w);
    }
  }
}

#define XB_TMO      128
#define XB_XCNT(j)  (256  + 64 * (j))
#define XB_XSUB(j)  (1280 + 64 * (j))
#define XB_XGEN(j)  (2304 + 64 * (j))
#define XB_TOP      3328
#define XB_TOPGEN   3392
#define XCD_BAR_WORDS 3456
#define XB_SPIN_CAP (1u << 22)
#define LAS __attribute__((address_space(3)))
DI unsigned xb_ld(unsigned* p) { return __hip_atomic_load(p, __ATOMIC_RELAXED, __HIP_MEMORY_SCOPE_AGENT); }
DI unsigned xb_add(unsigned* p, unsigned v) { return __hip_atomic_fetch_add(p, v, __ATOMIC_RELAXED, __HIP_MEMORY_SCOPE_AGENT); }
DI unsigned xb_xcc_id() { return (unsigned)__builtin_amdgcn_s_getreg((3 << 11) | 20) & 0xFu; }
#define XB_SPIN(cond, bar) do { unsigned _sp = 0; while (cond) { __builtin_amdgcn_s_sleep(1); \
    if ((++_sp & 255u) == 0u) { if (xb_ld(&(bar)[XB_TMO])) break; if (_sp > XB_SPIN_CAP) { atomicAdd(&(bar)[XB_TMO], 1u); break; } } } } while (0)
struct XcdBarrier { unsigned* bar; unsigned x; volatile LAS unsigned* st; };
DI XcdBarrier xcd_barrier_post(unsigned* bar, volatile LAS unsigned* st) {
  XcdBarrier b; b.bar = bar; b.x = xb_xcc_id(); b.st = st;
  if (threadIdx.x == 0) (void)xb_add(&bar[XB_XCNT(b.x)], 1u);
  return b;
}
DI void xcd_barrier_complete(unsigned* bar, unsigned x, unsigned& nloc, unsigned& nx) {
  const unsigned G = gridDim.x * gridDim.y * gridDim.z;
  unsigned sum, cnt, mine, sp = 0u;
  for (;;) {
    sum = 0u; cnt = 0u; mine = 0u;
#pragma unroll
    for (unsigned j = 0; j < 16; ++j) { const unsigned c = xb_ld(&bar[XB_XCNT(j)]); sum += c; cnt += (c > 0u) ? 1u : 0u; mine = (j == x) ? c : mine; }
    if (sum == G) break;
    __builtin_amdgcn_s_sleep(1);
    if ((++sp & 255u) == 0u) { if (xb_ld(&bar[XB_TMO])) break; if (sp > XB_SPIN_CAP) { atomicAdd(&bar[XB_TMO], 1u); break; } }
  }
  nloc = mine > 0u ? mine : 1u; nx = cnt > 0u ? cnt : 1u;
}
DI void xcd_barrier(const XcdBarrier& b) {
  asm volatile("s_waitcnt vmcnt(0)" ::: "memory");
  __syncthreads();
  if (threadIdx.x == 0) {
    unsigned* bar = b.bar;
    __builtin_amdgcn_s_waitcnt(0);
    unsigned nloc = b.st[0], nx = b.st[1];
    if (nloc == 0u) { xcd_barrier_complete(bar, b.x, nloc, nx); b.st[0] = nloc; b.st[1] = nx; }
    const unsigned old = xb_add(&bar[XB_XSUB(b.x)], 1u);
    const unsigned gen = old / nloc;
    if (old + 1u == (gen + 1u) * nloc) {
      __builtin_amdgcn_fence(__ATOMIC_RELEASE, "agent");
      asm volatile("s_waitcnt vmcnt(0)" ::: "memory");
      const unsigned og = xb_add(&bar[XB_TOP], 1u);
      const unsigned tg = og / nx;
      if (og + 1u == (tg + 1u) * nx) xb_add(&bar[XB_TOPGEN], 1u);
      else XB_SPIN(xb_ld(&bar[XB_TOPGEN]) == tg, bar);
      __builtin_amdgcn_fence(__ATOMIC_ACQUIRE, "agent");
      xb_add(&bar[XB_XGEN(b.x)], 1u);
      asm volatile("s_waitcnt vmcnt(0)" ::: "memory");
    } else {
      XB_SPIN(xb_ld(&bar[XB_XGEN(b.x)]) == gen, bar);
      __builtin_amdgcn_fence(__ATOMIC_ACQUIRE, "agent");
      asm volatile("s_waitcnt vmcnt(0)" ::: "memory");
    }
  }
  __syncthreads();
}

#ifdef ONLY_PHASE
#define RUNPH(n, call) if (ONLY_PHASE == n) { call; }
#else
#ifndef DUP_PHASE
#define DUP_PHASE -1
#endif
#define RUNPH(n, call) if (lo <= n && n < hi) { call; if (n == DUP_PHASE) { xcd_barrier(xb); call; } if (n + 1 < hi) xcd_barrier(xb); }
#endif
__global__ void __launch_bounds__(256, 2) mega(Params p, int lo, int hi) {
  __shared__ __attribute__((aligned(16))) char smem[SMEM_BYTES];
  __shared__ uint4 xb_words;
  cg::grid_group grid = cg::this_grid();
  if (lo < 0) grid.sync();
  if (threadIdx.x == 0) xb_words = make_uint4(0u, 0u, 0u, 0u);
  __syncthreads();
  XcdBarrier xb = xcd_barrier_post((unsigned*)(p.ws + OFF_BAR), (volatile LAS unsigned*)&xb_words);
  RUNPH(0, phase0(p, smem))
  RUNPH(1, phase1(p, smem))
  RUNPH(2, phase2(p, smem))
  RUNPH(3, phase3(p, smem))
  RUNPH(4, phase4(p))
  RUNPH(5, phase5(p, smem))
  RUNPH(6, phase6(p, smem))
  RUNPH(7, phase7(p, smem))
  RUNPH(8, phase8(p, smem))
  RUNPH(9, phase9(p, smem))
  RUNPH(10, phase10(p, smem))
  RUNPH(11, phase11(p, smem))
  RUNPH(12, phase12(p, smem))
  RUNPH(13, phase13(p))
  RUNPH(14, phase14(p))
  RUNPH(15, phase15(p))
  RUNPH(16, phase16(p))
}

extern "C" void kernel_launch(void* const* d_in, const int* in_sizes, int n_in, void* d_out, int out_size, void* d_ws,
                              size_t ws_size, hipStream_t stream) {
  static int grid_blocks = 0;
  if (!grid_blocks) {
    int dev = 0, cus = 0, per_cu = 0;
    hipGetDevice(&dev);
    hipDeviceGetAttribute(&cus, hipDeviceAttributeMultiprocessorCount, dev);
    hipOccupancyMaxActiveBlocksPerMultiprocessor(&per_cu, mega, 256, 0);
    if (per_cu > 2) per_cu = 2;
    if (per_cu < 1) per_cu = 1;
    grid_blocks = cus * per_cu;
  }
  Params p{};
  const float** pp = (const float**)&p;
  for (int i = 0; i < 29; ++i) pp[i] = (const float*)d_in[i];
  p.out = (float*)d_out;
  p.ws = (char*)d_ws;
#if N_LAUNCH_SPLIT
  for (int ph = 0; ph < NPHASE; ++ph) {
    hipLaunchKernelGGL(mega, dim3(grid_blocks), dim3(256), 0, stream, p, ph, ph + 1);
  }
#else
  hipMemsetAsync((char*)d_ws + OFF_MOD, 0, (OFF_BAR - OFF_MOD) + XCD_BAR_WORDS * sizeof(unsigned), stream);
  int lo = 0, hi = NPHASE;
  void* args[] = {&p, &lo, &hi};
  hipError_t e = hipLaunchCooperativeKernel((void*)mega, dim3(grid_blocks), dim3(256), args, 0, stream);
  if (e != hipSuccess) fprintf(stderr, "cooperative launch failed: %s (grid %d)\n", hipGetErrorString(e), grid_blocks);
#endif
}
```

```cpp
#include <hip/hip_runtime.h>
#include <hip/hip_cooperative_groups.h>
#include <cstdio>
namespace cg = cooperative_groups;

#define DI __device__ __forceinline__
typedef unsigned short bf16_t;
using bf16x8 = __attribute__((ext_vector_type(8))) short;
using f32x4 = __attribute__((ext_vector_type(4))) float;
using u32x4 = __attribute__((ext_vector_type(4))) unsigned;
using u32x2 = __attribute__((ext_vector_type(2))) unsigned;

#ifndef N_LAUNCH_SPLIT
#define N_LAUNCH_SPLIT 0
#endif

constexpr int NTOK = 20480, NPT = 4096, DM = 1024;
constexpr int NPHASE = 17;
constexpr size_t MiB = 1u << 20;
constexpr size_t OFF_WINT = 0, OFF_WUQT = 9 * MiB, OFF_WUKVT = 9 * MiB + 512 * 1024, OFF_WUPAT = 10 * MiB,
                 OFF_WUPBT = 11 * MiB, OFF_WOT = 12 * MiB, OFF_WCT = 14 * MiB, OFF_WPQB = 18 * MiB,
                 OFF_KEYSB = 22 * MiB, OFF_MOD = 22 * MiB + 512 * 1024, OFF_BAR = 22 * MiB + 768 * 1024, OFF_ROPE = 23 * MiB, A0 = 24 * MiB;
constexpr size_t OFF_PD = A0 + 104 * MiB, OFF_H1 = A0 + 0, OFF_CQ = A0 + 40 * MiB, OFF_CKVRAW = A0 + 50 * MiB, OFF_KRRAW = A0 + 60 * MiB,
                 OFF_RQ = A0 + 63 * MiB, OFF_RK = A0 + 83 * MiB, OFF_KT = A0 + 103 * MiB, OFF_VT = A0 + 123 * MiB,
                 OFF_SRG = A0 + 143 * MiB, OFF_CKVALL = A0 + 163 * MiB, OFF_KRALL = A0 + 169 * MiB,
                 OFF_UF = A0 + 171 * MiB, OFF_UB = A0 + 187 * MiB,
                 OFF_SF = A0 + 0, OFF_SB = A0 + 8 * MiB, OFF_RET = A0 + 16 * MiB,
                 OFF_Q = A0 + 63 * MiB, OFF_KN = A0 + 93 * MiB, OFF_VTA = A0 + 117 * MiB, OFF_ATTN = A0 + 141 * MiB,
                 OFF_M = A0 + 163 * MiB,
                 OFF_H2 = A0 + 56 * MiB, OFF_TABU = A0 + 36 * MiB, OFF_TABV = A0 + 0, OFF_INVU = A0 + 52 * MiB,
                 OFF_INVV = A0 + 53 * MiB, OFF_ELIST = A0 + 16 * MiB, OFF_GLIST = A0 + 26 * MiB, OFF_SCORES = A0 + 104 * MiB;
constexpr size_t OUT_CKV = 20971520, OUT_KR = 21495808, OUT_SF = 21626880, OUT_SB = 22675456;
constexpr int NKV = 24576;
constexpr int SMEM_BYTES = 73728;

struct Params {
  const float *x_prompt, *x_sample, *c, *cache_ckv, *cache_krope, *st_f, *st_b, *c_ctx, *w_mod, *b_mod, *norm_mix,
      *norm_ffn, *norm_final, *w_in, *q_norm, *kv_norm, *w_uq, *w_ukv, *lg_f, *lg_b, *ret_gn, *w_up_a, *w_up_b, *w_o,
      *peer_wq, *keys1, *keys2, *peer_u, *peer_v;
  float* out;
  char* ws;
};

DI unsigned f2bf(float x) {
  unsigned u = __float_as_uint(x);
  u += 0x7fffu + ((u >> 16) & 1u);
  return u >> 16;
}
DI float bf2f(unsigned b) { return __uint_as_float(b << 16); }
typedef __bf16 hbf16x2_t __attribute__((ext_vector_type(2)));
typedef float hf32x2_t __attribute__((ext_vector_type(2)));
DI unsigned pack2(float a, float b) {
  hf32x2_t f = {a, b};
  return __builtin_bit_cast(unsigned, __builtin_convertvector(f, hbf16x2_t));
}
DI float ex2(float x) { return __builtin_amdgcn_exp2f(x); }
DI float bflo(unsigned u) { return __uint_as_float(u << 16); }
DI float bfhi(unsigned u) { return __uint_as_float(u & 0xffff0000u); }
DI float wsum(float v) {
#pragma unroll
  for (int o = 32; o > 0; o >>= 1) v += __shfl_xor(v, o);
  return v;
}
DI float sigmoidf_(float x) { return __builtin_amdgcn_rcpf(1.f + __builtin_amdgcn_exp2f(-1.4426950408889634f * x)); }
DI float siluf_(float x) { return x * __builtin_amdgcn_rcpf(1.f + __builtin_amdgcn_exp2f(-1.4426950408889634f * x)); }
DI float geluf_(float x) { return 0.5f * x * (1.f + tanhf(0.7978845608028654f * (x + 0.044715f * x * x * x))); }
DI const float* xrow(const Params& p, int tok) {
  return tok < NPT ? p.x_prompt + (size_t)tok * DM : p.x_sample + (size_t)(tok - NPT) * DM;
}
DI int modidx(int tok) { return tok < NPT ? 0 : 1 + ((tok - NPT) >> 11); }
DI int kvrow(int tok) {
  if (tok < NPT) return tok;
  int t = tok - NPT;
  return NPT + (t >> 11) * 2560 + (t & 2047);
}
DI void st_bf16x16(bf16_t* dst, const float (&v)[16]) {
  u32x4 a, b;
  a[0] = pack2(v[0], v[1]); a[1] = pack2(v[2], v[3]); a[2] = pack2(v[4], v[5]); a[3] = pack2(v[6], v[7]);
  b[0] = pack2(v[8], v[9]); b[1] = pack2(v[10], v[11]); b[2] = pack2(v[12], v[13]); b[3] = pack2(v[14], v[15]);
  *(u32x4*)dst = a;
  *(u32x4*)(dst + 8) = b;
}
DI void st_f32x16(float* dst, const float (&v)[16]) {
#pragma unroll
  for (int i = 0; i < 4; ++i) *(float4*)(dst + 4 * i) = make_float4(v[4 * i], v[4 * i + 1], v[4 * i + 2], v[4 * i + 3]);
}
DI void ld_bf16x16(const bf16_t* src, float (&v)[16]) {
  u32x4 a = *(const u32x4*)src, b = *(const u32x4*)(src + 8);
#pragma unroll
  for (int i = 0; i < 4; ++i) {
    v[2 * i] = bflo(a[i]); v[2 * i + 1] = bfhi(a[i]);
    v[8 + 2 * i] = bflo(b[i]); v[8 + 2 * i + 1] = bfhi(b[i]);
  }
}

constexpr int LDK = 64;
template <int SCALE>
DI void gemm_kloop(f32x4 (&acc)[4][4], const bf16_t* __restrict__ A, int lda, const bf16_t* __restrict__ B, int ldb,
                   int K, char* smem, float sc_a, float sc_b) {
  bf16_t* As = (bf16_t*)smem;
  bf16_t* Bs = As + 128 * LDK;
  const int tid = threadIdx.x, lane = tid & 63, w = tid >> 6, wm = w >> 1, wn = w & 1, l15 = lane & 15, g = lane >> 4;
  u32x4 ra[4], rb[4];
  int arow[4], kc[4], ldsa[4], ldsb[4];
#pragma unroll
  for (int i = 0; i < 4; ++i) {
    int c = tid + 256 * i;
    int r = c >> 3;
    kc[i] = (c & 7) * 8;
    arow[i] = r;
    int rr = r & 63;
    int rho = (r & 64) | (((rr >> 2) & 3) << 4) | ((rr >> 4) << 2) | (rr & 3);
    ldsa[i] = rho * LDK + (((c & 7) ^ ((rho >> 1) & 7)) * 8);
    ldsb[i] = r * LDK + (((c & 7) ^ ((r >> 1) & 7)) * 8);
  }
#pragma unroll
  for (int i = 0; i < 4; ++i) {
    ra[i] = *(const u32x4*)(A + (size_t)arow[i] * lda + kc[i]);
    rb[i] = *(const u32x4*)(B + (size_t)arow[i] * ldb + kc[i]);
  }
  __syncthreads();
#pragma unroll
  for (int i = 0; i < 4; ++i) {
    *(u32x4*)(As + ldsa[i]) = ra[i];
    *(u32x4*)(Bs + ldsb[i]) = rb[i];
  }
  if (64 < K) {
#pragma unroll
    for (int i = 0; i < 4; ++i) {
      ra[i] = *(const u32x4*)(A + (size_t)arow[i] * lda + 64 + kc[i]);
      rb[i] = *(const u32x4*)(B + (size_t)arow[i] * ldb + 64 + kc[i]);
    }
  }
  __syncthreads();
  int buf = 0;
  for (int k0 = 0; k0 < K; k0 += 64, buf ^= 1) {
    const bf16_t* Ac = As + buf * (256 * LDK);
    const bf16_t* Bc = Bs + buf * (256 * LDK);
#pragma unroll
    for (int ks = 0; ks < 2; ++ks) {
      bf16x8 af[4], bfr[4];
#pragma unroll
      for (int f = 0; f < 4; ++f)
        af[f] = *(const bf16x8*)(Ac + (wm * 64 + f * 16 + l15) * LDK + (((ks * 4 + g) ^ (l15 >> 1)) * 8));
#pragma unroll
      for (int c = 0; c < 4; ++c)
        bfr[c] = *(const bf16x8*)(Bc + (wn * 64 + c * 16 + l15) * LDK + (((ks * 4 + g) ^ (l15 >> 1)) * 8));
      if (SCALE) {
        float fac[8];
#pragma unroll
        for (int i = 0; i < 8; ++i) fac[i] = ex2(sc_a + sc_b * (float)(k0 + ks * 32 + g * 8 + i));
#pragma unroll
        for (int f = 0; f < 4; ++f) {
          u32x4 u = __builtin_bit_cast(u32x4, af[f]);
#pragma unroll
          for (int i = 0; i < 4; ++i) u[i] = pack2(bflo(u[i]) * fac[2 * i], bfhi(u[i]) * fac[2 * i + 1]);
          af[f] = __builtin_bit_cast(bf16x8, u);
        }
      }
#pragma unroll
      for (int f = 0; f < 4; ++f)
#pragma unroll
        for (int c = 0; c < 4; ++c) acc[f][c] = __builtin_amdgcn_mfma_f32_16x16x32_bf16(af[f], bfr[c], acc[f][c], 0, 0, 0);
    }
    if (k0 + 64 < K) {
      bf16_t* An = As + (buf ^ 1) * (256 * LDK);
      bf16_t* Bn = Bs + (buf ^ 1) * (256 * LDK);
#pragma unroll
      for (int i = 0; i < 4; ++i) {
        *(u32x4*)(An + ldsa[i]) = ra[i];
        *(u32x4*)(Bn + ldsb[i]) = rb[i];
      }
      if (k0 + 128 < K) {
#pragma unroll
        for (int i = 0; i < 4; ++i) {
          ra[i] = *(const u32x4*)(A + (size_t)arow[i] * lda + k0 + 128 + kc[i]);
          rb[i] = *(const u32x4*)(B + (size_t)arow[i] * ldb + k0 + 128 + kc[i]);
        }
      }
      __syncthreads();
    }
  }
}
DI void acc_zero(f32x4 (&acc)[4][4]) {
#pragma unroll
  for (int f = 0; f < 4; ++f)
#pragma unroll
    for (int c = 0; c < 4; ++c) acc[f][c] = f32x4{0.f, 0.f, 0.f, 0.f};
}
template <class F>
DI void epilogue(const f32x4 (&acc)[4][4], F&& epi) {
  const int tid = threadIdx.x, lane = tid & 63, w = tid >> 6, wm = w >> 1, wn = w & 1, l15 = lane & 15, g = lane >> 4;
#pragma unroll
  for (int c = 0; c < 4; ++c) {
    float v[16];
#pragma unroll
    for (int f = 0; f < 4; ++f)
#pragma unroll
      for (int j = 0; j < 4; ++j) v[f * 4 + j] = acc[f][c][j];
    epi(wm * 64 + 16 * g, wn * 64 + c * 16 + l15, v);
  }
}
DI bool tile_map(int it, int Ft, int Tt, int fsplit, int& ft, int& tt) {
  const int bid = blockIdx.x, nb = gridDim.x;
  int xcd = bid & 7, loc = bid >> 3, nloc = nb >> 3;
  if (loc >= nloc) return false;
  int fg = xcd % fsplit, tg = xcd / fsplit, tsplit = 8 / fsplit;
  int Fg = Ft / fsplit, Tg = Tt / tsplit;
  int i = loc + it * nloc;
  if (i >= Fg * Tg) return false;
  ft = fg * Fg + i % Fg;
  tt = tg * Tg + i / Fg;
  return true;
}
DI int vbid() {
  const int bid = blockIdx.x, nb = gridDim.x;
  if (nb & 7) return bid;
  return (bid & 7) * (nb >> 3) + (bid >> 3);
}

DI int colmap(int mode, int np) {
  if (mode == 1) return np < 416 ? np : (np < 512 ? -1 : np - 96);
  if (mode == 2) return np < 512 ? ((np >> 6) * 128 + (np & 63)) : (((np - 512) >> 6) * 128 + 64 + ((np - 512) & 63));
  return np;
}
DI void tconv_tile(const float* __restrict__ src, int ldsrc, bf16_t* __restrict__ dst, int K, int kt, int nt, int mode,
                   char* smem) {
  float* lds = (float*)smem;
  const int tid = threadIdx.x;
  {
    int col = tid & 63, rq = tid >> 6;
    int n = colmap(mode, nt * 64 + col);
#pragma unroll 4
    for (int r = 0; r < 16; ++r) {
      int kl = r * 4 + rq;
      float v = n >= 0 ? src[(size_t)(kt * 64 + kl) * ldsrc + n] : 0.f;
      lds[kl * 65 + col] = v;
    }
  }
  __syncthreads();
  {
    int nl = tid >> 2, kq = (tid & 3) * 16;
    float v[16];
#pragma unroll
    for (int i = 0; i < 16; ++i) v[i] = lds[(kq + i) * 65 + nl];
    st_bf16x16(dst + (size_t)(nt * 64 + nl) * K + kt * 64 + kq, v);
  }
  __syncthreads();
}
DI void mod_item(const Params& p, int item, char* smem) {
  float* sil = (float*)smem;
  const int tid = threadIdx.x;
  const int cg_ = item >> 2, slab = item & 3, kbase = slab * 256;
  for (int i = tid; i < 9 * 256; i += 256) {
    int j = i >> 8, k = kbase + (i & 255);
    float cv = j == 0 ? p.c_ctx[k] : p.c[(j - 1) * 1024 + k];
    sil[i] = siluf_(cv);
  }
  __syncthreads();
  const int kq = tid >> 6, nn = tid & 63, n0 = cg_ * 64;
  float acc[9];
#pragma unroll
  for (int j = 0; j < 9; ++j) acc[j] = 0.f;
#pragma unroll 1
  for (int i0 = 0; i0 < 64; i0 += 16) {
    float wv[16];
#pragma unroll
    for (int i = 0; i < 16; ++i) wv[i] = p.w_mod[(size_t)(kbase + kq + 4 * (i0 + i)) * 6144 + n0 + nn];
#pragma unroll
    for (int i = 0; i < 16; ++i)
#pragma unroll
      for (int j = 0; j < 9; ++j) acc[j] += sil[j * 256 + kq + 4 * (i0 + i)] * wv[i];
  }
  __syncthreads();
  float* part = (float*)smem + 9 * 256;
#pragma unroll
  for (int j = 0; j < 9; ++j) part[(kq * 9 + j) * 64 + nn] = acc[j];
  __syncthreads();
  float* mod = (float*)(p.ws + OFF_MOD);
  for (int i = tid; i < 9 * 64; i += 256) {
    int j = i >> 6, n = i & 63;
    float s = part[(0 * 9 + j) * 64 + n] + part[(1 * 9 + j) * 64 + n] + part[(2 * 9 + j) * 64 + n] + part[(3 * 9 + j) * 64 + n];
    if (slab == 0) s += p.b_mod[n0 + n];
    atomicAdd(mod + j * 6144 + n0 + n, s);
  }
  __syncthreads();
}
DI void conv_flat(const float* __restrict__ src, bf16_t* __restrict__ dst, size_t n) {
  size_t i = ((size_t)blockIdx.x * 256 + threadIdx.x) * 8;
  const size_t stride = (size_t)gridDim.x * 256 * 8;
  for (; i < n; i += stride) {
    float4 a = *(const float4*)(src + i), b = *(const float4*)(src + i + 4);
    u32x4 o;
    o[0] = pack2(a.x, a.y); o[1] = pack2(a.z, a.w); o[2] = pack2(b.x, b.y); o[3] = pack2(b.z, b.w);
    *(u32x4*)(dst + i) = o;
  }
}
DI void phase0(const Params& p, char* smem) {
  const int bid = blockIdx.x, nb = gridDim.x;
  char* ws = p.ws;
  const int n_mod = 384;
  const int t_in = 16 * 72, t_uq = 4 * 12, t_ukv = 2 * 16, t_upa = 8 * 16, t_upb = 8 * 16, t_o = 16 * 16;
  const int total = n_mod + t_in + t_uq + t_ukv + t_upa + t_upb + t_o;
  for (int it = bid; it < total; it += nb) {
    int i = it;
    if (i < n_mod) { mod_item(p, i, smem); continue; }
    i -= n_mod;
    if (i < t_in) { tconv_tile(p.w_in, 4512, (bf16_t*)(ws + OFF_WINT), 1024, i / 72, i % 72, 1, smem); continue; }
    i -= t_in;
    if (i < t_uq) { tconv_tile(p.w_uq, 768, (bf16_t*)(ws + OFF_WUQT), 256, i / 12, i % 12, 0, smem); continue; }
    i -= t_uq;
    if (i < t_ukv) { tconv_tile(p.w_ukv, 1024, (bf16_t*)(ws + OFF_WUKVT), 128, i / 16, i % 16, 2, smem); continue; }
    i -= t_ukv;
    if (i < t_upa) { tconv_tile(p.w_up_a, 1024, (bf16_t*)(ws + OFF_WUPAT), 512, i / 16, i % 16, 0, smem); continue; }
    i -= t_upa;
    if (i < t_upb) { tconv_tile(p.w_up_b, 1024, (bf16_t*)(ws + OFF_WUPBT), 512, i / 16, i % 16, 0, smem); continue; }
    i -= t_upb;
    tconv_tile(p.w_o, 1024, (bf16_t*)(ws + OFF_WOT), 1024, i / 16, i % 16, 0, smem);
  }
  conv_flat(p.peer_wq, (bf16_t*)(ws + OFF_WPQB), (size_t)1024 * 2048);
  {
    size_t i = ((size_t)bid * 256 + threadIdx.x) * 8;
    const size_t stride = (size_t)nb * 256 * 8;
    bf16_t* kb = (bf16_t*)(ws + OFF_KEYSB);
    for (; i < (size_t)2 * 131072; i += stride) {
      int half = i >= 131072;
      size_t s = i - (size_t)half * 131072;
      int h = (int)(s >> 14);
      size_t r = s & 16383;
      const float* src = (half ? p.keys2 : p.keys1) + s;
      float4 a = *(const float4*)(src), b = *(const float4*)(src + 4);
      u32x4 o;
      o[0] = pack2(a.x, a.y); o[1] = pack2(a.z, a.w); o[2] = pack2(b.x, b.y); o[3] = pack2(b.z, b.w);
      *(u32x4*)(kb + ((size_t)(h * 2 + half) << 14) + r) = o;
    }
  }
  {
    float2* rope = (float2*)(ws + OFF_ROPE);
    for (int idx = bid * 256 + threadIdx.x; idx < 2048 * 16; idx += nb * 256) {
      const int t = idx >> 4, a = idx & 15;
      const float pos = (a < 8) ? (float)(t >> 6) : (float)(t & 63);
      const float fr = exp2f(-(float)(a & 7) * 1.6609640474436813f);
      float sn, cs;
      sincosf(pos * fr, &sn, &cs);
      rope[idx] = make_float2(cs, sn);
    }
  }
}

DI void rows_norm_mod(const Params& p, const float* nw, int sh_off, int sc_off, bool from_out, bf16_t* dst) {
  const int lane = threadIdx.x & 63, w = threadIdx.x >> 6;
  const float* mod = (const float*)(p.ws + OFF_MOD);
  for (int tok = blockIdx.x * 4 + w; tok < NTOK; tok += gridDim.x * 4) {
    const float* xr = from_out ? p.out + (size_t)tok * DM : xrow(p, tok);
    const float* mj = mod + modidx(tok) * 6144;
    float4 xv[4];
    float ss = 0.f;
#pragma unroll
    for (int i = 0; i < 4; ++i) {
      xv[i] = *(const float4*)(xr + (i * 64 + lane) * 4);
      ss += xv[i].x * xv[i].x + xv[i].y * xv[i].y + xv[i].z * xv[i].z + xv[i].w * xv[i].w;
    }
    ss = wsum(ss);
    float rstd = rsqrtf(ss * (1.f / 1024.f) + 1e-6f);
#pragma unroll
    for (int i = 0; i < 4; ++i) {
      int e = (i * 64 + lane) * 4;
      float4 nv = *(const float4*)(nw + e), sh = *(const float4*)(mj + sh_off + e), sc = *(const float4*)(mj + sc_off + e);
      float h0 = (xv[i].x * rstd) * nv.x * (1.f + sc.x) + sh.x;
      float h1 = (xv[i].y * rstd) * nv.y * (1.f + sc.y) + sh.y;
      float h2 = (xv[i].z * rstd) * nv.z * (1.f + sc.z) + sh.z;
      float h3 = (xv[i].w * rstd) * nv.w * (1.f + sc.w) + sh.w;
      u32x2 o;
      o[0] = pack2(h0, h1); o[1] = pack2(h2, h3);
      *(u32x2*)(dst + (size_t)tok * DM + e) = o;
    }
  }
}
DI void phase1(const Params& p, char* smem) {
  rows_norm_mod(p, p.norm_mix, 0, 1024, false, (bf16_t*)(p.ws + OFF_H1));
  const bf16_t* wpq = (const bf16_t*)(p.ws + OFF_WPQB);
  const bf16_t* kb = (const bf16_t*)(p.ws + OFF_KEYSB);
  bf16_t* wct = (bf16_t*)(p.ws + OFF_WCT);
  for (int it = blockIdx.x; it < 128; it += gridDim.x) {
    int hh = it >> 3, mt = it & 7;
    f32x4 acc[4][4];
    acc_zero(acc);
    gemm_kloop<0>(acc, wpq + (size_t)(mt * 128) * 2048 + hh * 128, 2048, kb + (size_t)hh * 16384, 128, 128, smem, 0.f, 0.f);
    epilogue(acc, [&](int m, int n, float (&v)[16]) { st_bf16x16(wct + (size_t)(hh * 128 + n) * 1024 + mt * 128 + m, v); });
  }
}

DI void phase2(const Params& p, char* smem) {
  char* ws = p.ws;
  const bf16_t* winT = (const bf16_t*)(ws + OFF_WINT);
  const bf16_t* h1 = (const bf16_t*)(ws + OFF_H1);
  bf16_t* cq = (bf16_t*)(ws + OFF_CQ);
  float* ckvraw = (float*)(ws + OFF_CKVRAW);
  float* krraw = (float*)(ws + OFF_KRRAW);
  bf16_t* rq = (bf16_t*)(ws + OFF_RQ);
  bf16_t* rk = (bf16_t*)(ws + OFF_RK);
  bf16_t* kT = (bf16_t*)(ws + OFF_KT);
  bf16_t* vT = (bf16_t*)(ws + OFF_VT);
  bf16_t* srg = (bf16_t*)(ws + OFF_SRG);
  bf16_t* sga = (bf16_t*)p.out;
  bf16_t* sgb = sga + (size_t)NTOK * 1024;
  for (int it = 0;; ++it) {
    int ft, tt;
    if (!tile_map(it, 36, 160, 4, ft, tt)) break;
    f32x4 acc[4][4];
    acc_zero(acc);
    const bf16_t* W = winT + (size_t)ft * 128 * 1024;
    const bf16_t* H = h1 + (size_t)tt * 128 * 1024;
    const int tok0 = tt * 128, f0 = ft * 128;
    if (ft >= 8 && ft < 16) {
      gemm_kloop<0>(acc, H, 1024, W, 1024, 1024, smem, 0.f, 0.f);
      if (ft < 12) {
        epilogue(acc, [&](int m, int n, float (&v)[16]) {
          int feat = f0 - 1024 + n, tok = tok0 + m;
#pragma unroll
          for (int i = 0; i < 16; ++i) v[i] *= 0.08838834764831845f;
          st_bf16x16(kT + (size_t)feat * NTOK + tok, v);
#pragma unroll
          for (int i = 0; i < 16; ++i) rk[(size_t)(tok + i) * 512 + feat] = (bf16_t)f2bf(v[i]);
        });
      } else {
        epilogue(acc, [&](int m, int n, float (&v)[16]) {
          int feat = f0 - 1536 + n, tok = tok0 + m;
          st_bf16x16(vT + (size_t)feat * NTOK + tok, v);
        });
      }
    } else {
      gemm_kloop<0>(acc, W, 1024, H, 1024, 1024, smem, 0.f, 0.f);
      if (ft < 2) {
        epilogue(acc, [&](int m, int n, float (&v)[16]) { st_bf16x16(cq + (size_t)(tok0 + n) * 256 + f0 + m, v); });
      } else if (ft == 2) {
        epilogue(acc, [&](int m, int n, float (&v)[16]) { st_f32x16(ckvraw + (size_t)(tok0 + n) * 128 + m, v); });
      } else if (ft == 3) {
        epilogue(acc, [&](int m, int n, float (&v)[16]) {
          if (m < 32) st_f32x16(krraw + (size_t)(tok0 + n) * 32 + m, v);
        });
      } else if (ft < 8) {
        epilogue(acc, [&](int m, int n, float (&v)[16]) { st_bf16x16(rq + (size_t)(tok0 + n) * 512 + f0 - 512 + m, v); });
      } else if (ft < 20) {
        epilogue(acc, [&](int m, int n, float (&v)[16]) {
#pragma unroll
          for (int i = 0; i < 16; ++i) v[i] = siluf_(v[i]);
          st_bf16x16(srg + (size_t)(tok0 + n) * 512 + f0 - 2048 + m, v);
        });
      } else if (ft < 28) {
        epilogue(acc, [&](int m, int n, float (&v)[16]) {
#pragma unroll
          for (int i = 0; i < 16; ++i) v[i] = sigmoidf_(v[i]);
          st_bf16x16(sga + (size_t)(tok0 + n) * 1024 + f0 - 2560 + m, v);
        });
      } else {
        epilogue(acc, [&](int m, int n, float (&v)[16]) {
#pragma unroll
          for (int i = 0; i < 16; ++i) v[i] = sigmoidf_(v[i]);
          st_bf16x16(sgb + (size_t)(tok0 + n) * 1024 + f0 - 3584 + m, v);
        });
      }
    }
  }
}

DI float log2gamma(float logit) { return -log1pf(expf(-logit)) * 1.4426950408889634f; }
DI void phase3(const Params& p, char* smem) {
  char* ws = p.ws;
  const int lane = threadIdx.x & 63, w = threadIdx.x >> 6;
  bf16_t* cq = (bf16_t*)(ws + OFF_CQ);
  const float* ckvraw = (const float*)(ws + OFF_CKVRAW);
  const float* krraw = (const float*)(ws + OFF_KRRAW);
  bf16_t* ckvall = (bf16_t*)(ws + OFF_CKVALL);
  bf16_t* krall = (bf16_t*)(ws + OFF_KRALL);
  for (int r = blockIdx.x * 4 + w; r < NTOK + 4096; r += gridDim.x * 4) {
    if (r < NTOK) {
      const int tok = r;
      {
        u32x2 u = *(const u32x2*)(cq + (size_t)tok * 256 + lane * 4);
        float a0 = bflo(u[0]), a1 = bfhi(u[0]), a2 = bflo(u[1]), a3 = bfhi(u[1]);
        float ss = wsum(a0 * a0 + a1 * a1 + a2 * a2 + a3 * a3);
        float rstd = rsqrtf(ss * (1.f / 256.f) + 1e-6f);
        float4 nq = *(const float4*)(p.q_norm + lane * 4);
        u32x2 o;
        o[0] = pack2(a0 * rstd * nq.x, a1 * rstd * nq.y);
        o[1] = pack2(a2 * rstd * nq.z, a3 * rstd * nq.w);
        *(u32x2*)(cq + (size_t)tok * 256 + lane * 4) = o;
      }
      const int row = kvrow(tok);
      {
        float2 v = *(const float2*)(ckvraw + (size_t)tok * 128 + lane * 2);
        float ss = wsum(v.x * v.x + v.y * v.y);
        float rstd = rsqrtf(ss * (1.f / 128.f) + 1e-6f);
        float2 nk = *(const float2*)(p.kv_norm + lane * 2);
        float o0 = v.x * rstd * nk.x, o1 = v.y * rstd * nk.y;
        if (tok < NPT) *(float2*)(p.out + OUT_CKV + (size_t)tok * 128 + lane * 2) = make_float2(o0, o1);
        *(unsigned*)(ckvall + (size_t)row * 128 + lane * 2) = pack2(o0, o1);
      }
      if (lane < 32) {
        float own = krraw[(size_t)tok * 32 + lane];
        float o = own;
        if (tok < NPT) {
          p.out[OUT_KR + (size_t)tok * 32 + lane] = own;
        } else {
          float partner = krraw[(size_t)tok * 32 + (lane ^ 16)];
          int t = (tok - NPT) & 2047;
          const float2 csn = ((const float2*)(ws + OFF_ROPE))[t * 16 + (lane & 15)];
          const float cs = csn.x, sn = csn.y;
          o = lane < 16 ? own * cs - partner * sn : partner * sn + own * cs;
        }
        krall[(size_t)row * 32 + lane] = (bf16_t)f2bf(o);
      }
    } else {
      const int cr = r - NTOK;
      const int b = cr >> 9, pos = cr & 511;
      const int row = NPT + b * 2560 + 2048 + pos;
      float2 v = *(const float2*)(p.cache_ckv + (size_t)cr * 128 + lane * 2);
      *(unsigned*)(ckvall + (size_t)row * 128 + lane * 2) = pack2(v.x, v.y);
      if (lane < 32) krall[(size_t)row * 32 + lane] = (bf16_t)f2bf(p.cache_krope[(size_t)cr * 32 + lane]);
    }
  }
  const bf16_t* kT = (const bf16_t*)(ws + OFF_KT);
  const bf16_t* vT = (const bf16_t*)(ws + OFF_VT);
  float* Uf = (float*)(ws + OFF_UF);
  float* Ub = (float*)(ws + OFF_UB);
  for (int it = blockIdx.x; it < 320; it += gridDim.x) {
    const int blk = it >> 2, h = it & 3;
    const float l2f = log2gamma(p.lg_f[h]), l2b = log2gamma(p.lg_b[h]);
    const bf16_t* Kp = kT + (size_t)(h * 128) * NTOK + blk * 256;
    const bf16_t* Vp = vT + (size_t)(h * 128) * NTOK + blk * 256;
#pragma unroll 1
    for (int dir = 0; dir < 2; ++dir) {
      const float sa = dir ? 0.f : l2f * 255.f, sb = dir ? l2b : -l2f;
      f32x4 acc[4][4];
      acc_zero(acc);
      if (blk < 16) {
        gemm_kloop<1>(acc, Vp, NTOK, Kp, NTOK, 256, smem, sa, sb);
        float* dst = p.out + (dir ? OUT_SB : OUT_SF) + (size_t)(blk * 4 + h) * 16384;
        epilogue(acc, [&](int m, int n, float (&v)[16]) { st_f32x16(dst + n * 128 + m, v); });
      } else {
        gemm_kloop<1>(acc, Kp, NTOK, Vp, NTOK, 256, smem, sa, sb);
        float* dst = (dir ? Ub : Uf) + (size_t)((blk - 16) * 4 + h) * 16384;
        epilogue(acc, [&](int m, int n, float (&v)[16]) { st_f32x16(dst + n * 128 + m, v); });
      }
    }
  }
}

DI void phase4(const Params& p) {
  char* ws = p.ws;
  const float* Uf = (const float*)(ws + OFF_UF);
  const float* Ub = (const float*)(ws + OFF_UB);
  bf16_t* Sf = (bf16_t*)(ws + OFF_SF);
  bf16_t* Sb = (bf16_t*)(ws + OFF_SB);
  for (int idx = blockIdx.x * 256 + threadIdx.x; idx < (1 << 20); idx += gridDim.x * 256) {
    int d = idx & 127, e = (idx >> 7) & 127, h = (idx >> 14) & 3, b = (idx >> 16) & 7, dir = idx >> 19;
    size_t eo = (size_t)e * 128 + d;
    if (dir == 0) {
      float cf = exp2f(log2gamma(p.lg_f[h]) * 256.f);
      float S = p.st_f[(size_t)(b * 4 + h) * 16384 + d * 128 + e];
#pragma unroll
      for (int blk = 0; blk < 8; ++blk) {
        size_t o = (size_t)((b * 8 + blk) * 4 + h) * 16384 + eo;
        Sf[o] = (bf16_t)f2bf(S);
        S = cf * S + Uf[o];
      }
    } else {
      float cb = exp2f(log2gamma(p.lg_b[h]) * 256.f);
      float S = p.st_b[(size_t)(b * 4 + h) * 16384 + d * 128 + e];
#pragma unroll
      for (int blk = 7; blk >= 0; --blk) {
        size_t o = (size_t)((b * 8 + blk) * 4 + h) * 16384 + eo;
        Sb[o] = (bf16_t)f2bf(S);
        S = cb * S + Ub[o];
      }
    }
  }
}

DI bf16x8 scale_frag(bf16x8 q, float s) {
  u32x4 u = __builtin_bit_cast(u32x4, q);
#pragma unroll
  for (int i = 0; i < 4; ++i) u[i] = pack2(bflo(u[i]) * s, bfhi(u[i]) * s);
  return __builtin_bit_cast(bf16x8, u);
}
constexpr int NQT = 1;
DI void phase5(const Params& p, char* smem) {
  char* ws = p.ws;
  const bf16_t* rq = (const bf16_t*)(ws + OFF_RQ);
  const bf16_t* rk = (const bf16_t*)(ws + OFF_RK);
  const bf16_t* vT = (const bf16_t*)(ws + OFF_VT);
  const bf16_t* srg = (const bf16_t*)(ws + OFF_SRG);
  const bf16_t* Sf = (const bf16_t*)(ws + OFF_SF);
  const bf16_t* Sb = (const bf16_t*)(ws + OFF_SB);
  bf16_t* ret = (bf16_t*)(ws + OFF_RET);
  bf16_t* Ks0 = (bf16_t*)smem;
  const int tid = threadIdx.x, lane = tid & 63, w = tid >> 6, l15 = lane & 15, g = lane >> 4;
  for (int item = vbid(); item < 640 * (2 / NQT); item += gridDim.x) {
    const int qb = item >> 2, h = item & 3, blk = (qb * NQT) >> 2;
    const float l2f = log2gamma(p.lg_f[h]), l2b = log2gamma(p.lg_b[h]);
    const int tokw = qb * (64 * NQT) + w * (16 * NQT);
    bf16x8 Q[NQT][4];
#pragma unroll
    for (int qt = 0; qt < NQT; ++qt)
#pragma unroll
      for (int ks = 0; ks < 4; ++ks)
        Q[qt][ks] = *(const bf16x8*)(rq + (size_t)(tokw + qt * 16 + l15) * 512 + h * 128 + ks * 32 + g * 8);
    f32x4 o[8][NQT];
#pragma unroll
    for (int et = 0; et < 8; ++et)
#pragma unroll
      for (int qt = 0; qt < NQT; ++qt) o[et][qt] = f32x4{0.f, 0.f, 0.f, 0.f};
    u32x4 rk_[4], rv_[4];
    auto gload = [&](int kt) {
      const int key0 = blk * 256 + kt * 64;
#pragma unroll
      for (int i = 0; i < 4; ++i) {
        int c = tid + 256 * i;
        int r = c >> 4, cc = (c & 15) * 8;
        rk_[i] = *(const u32x4*)(rk + (size_t)(key0 + r) * 512 + h * 128 + cc);
        int e = c >> 3, c2 = (c & 7) * 8;
        rv_[i] = *(const u32x4*)(vT + (size_t)(h * 128 + e) * NTOK + key0 + c2);
      }
    };
    auto lstore = [&](int b_) {
      bf16_t* Kd = Ks0 + b_ * 18432;
      bf16_t* Vd = Kd + 64 * 144;
#pragma unroll
      for (int i = 0; i < 4; ++i) {
        int c = tid + 256 * i;
        int r = c >> 4, cc = (c & 15) * 8;
        *(u32x4*)(Kd + r * 144 + cc) = rk_[i];
        int e = c >> 3, c2 = (c & 7) * 8;
        *(u32x4*)(Vd + e * 72 + c2) = rv_[i];
      }
    };
    gload(0);
    __syncthreads();
    lstore(0);
    gload(1);
    __syncthreads();
#pragma unroll 1
    for (int kt = 0; kt < 4; ++kt) {
      const bf16_t* Ks = Ks0 + (kt & 1) * 18432;
      const bf16_t* Vs = Ks + 64 * 144;
      bf16x8 P[NQT][2];
#pragma unroll
      for (int qt = 0; qt < NQT; ++qt) {
        f32x4 s[4];
#pragma unroll
        for (int kk = 0; kk < 4; ++kk) s[kk] = f32x4{0.f, 0.f, 0.f, 0.f};
#pragma unroll
        for (int ks = 0; ks < 4; ++ks) {
#pragma unroll
          for (int kk = 0; kk < 4; ++kk) {
            bf16x8 a = *(const bf16x8*)(Ks + (kk * 16 + l15) * 144 + ks * 32 + g * 8);
            s[kk] = __builtin_amdgcn_mfma_f32_16x16x32_bf16(a, Q[qt][ks], s[kk], 0, 0, 0);
          }
        }
        const int iq = (tokw + qt * 16 + l15) & 255;
#pragma unroll
        for (int kk = 0; kk < 4; ++kk) {
#pragma unroll
          for (int j = 0; j < 4; ++j) {
            int jk = kt * 64 + kk * 16 + 4 * g + j;
            int diff = iq - jk;
            float dm = diff > 0 ? ex2(l2f * (float)diff) : (diff < 0 ? ex2(l2b * (float)(-diff)) : 2.f);
            s[kk][j] *= dm;
          }
        }
#pragma unroll
        for (int k2 = 0; k2 < 2; ++k2) {
          u32x4 u;
          u[0] = pack2(s[2 * k2][0], s[2 * k2][1]);
          u[1] = pack2(s[2 * k2][2], s[2 * k2][3]);
          u[2] = pack2(s[2 * k2 + 1][0], s[2 * k2 + 1][1]);
          u[3] = pack2(s[2 * k2 + 1][2], s[2 * k2 + 1][3]);
          P[qt][k2] = __builtin_bit_cast(bf16x8, u);
        }
      }
#pragma unroll
      for (int k2 = 0; k2 < 2; ++k2) {
#pragma unroll
        for (int et = 0; et < 8; ++et) {
          u32x2 lo = *(const u32x2*)(Vs + (et * 16 + l15) * 72 + k2 * 32 + 4 * g);
          u32x2 hi = *(const u32x2*)(Vs + (et * 16 + l15) * 72 + k2 * 32 + 16 + 4 * g);
          u32x4 u;
          u[0] = lo[0]; u[1] = lo[1]; u[2] = hi[0]; u[3] = hi[1];
          bf16x8 a = __builtin_bit_cast(bf16x8, u);
#pragma unroll
          for (int qt = 0; qt < NQT; ++qt) o[et][qt] = __builtin_amdgcn_mfma_f32_16x16x32_bf16(a, P[qt][k2], o[et][qt], 0, 0, 0);
        }
      }
      if (kt + 1 < 4) {
        lstore((kt + 1) & 1);
        if (kt + 2 < 4) gload(kt + 2);
        __syncthreads();
      }
    }
    if (blk >= 16) {
      bf16_t* SL = (bf16_t*)smem;
      __syncthreads();
#pragma unroll
      for (int dir = 0; dir < 2; ++dir) {
        const bf16_t* S = (dir ? Sb : Sf) + (size_t)((blk - 16) * 4 + h) * 16384;
#pragma unroll
        for (int i = 0; i < 8; ++i) {
          int c = tid + 256 * i;
          int e = c >> 4, cc = (c & 15) * 8;
          *(u32x4*)(SL + dir * (128 * 144) + e * 144 + cc) = *(const u32x4*)(S + e * 128 + cc);
        }
      }
      __syncthreads();
#pragma unroll 1
      for (int dir = 0; dir < 2; ++dir) {
        const bf16_t* S = SL + dir * (128 * 144);
        float dq[NQT];
#pragma unroll
        for (int qt = 0; qt < NQT; ++qt) {
          int iq = (tokw + qt * 16 + l15) & 255;
          dq[qt] = dir ? exp2f(l2b * (float)(256 - iq)) : exp2f(l2f * (float)(iq + 1));
        }
#pragma unroll
        for (int ks = 0; ks < 4; ++ks) {
          bf16x8 qs[NQT];
#pragma unroll
          for (int qt = 0; qt < NQT; ++qt) qs[qt] = scale_frag(Q[qt][ks], dq[qt]);
#pragma unroll
          for (int et = 0; et < 8; ++et) {
            bf16x8 a = *(const bf16x8*)(S + (et * 16 + l15) * 144 + ks * 32 + g * 8);
#pragma unroll
            for (int qt = 0; qt < NQT; ++qt) o[et][qt] = __builtin_amdgcn_mfma_f32_16x16x32_bf16(a, qs[qt], o[et][qt], 0, 0, 0);
          }
        }
      }
    }
#pragma unroll
    for (int qt = 0; qt < NQT; ++qt) {
      const int tok = tokw + qt * 16 + l15;
      float s1 = 0.f;
#pragma unroll
      for (int et = 0; et < 8; ++et)
#pragma unroll
        for (int j = 0; j < 4; ++j) s1 += o[et][qt][j];
      s1 += __shfl_xor(s1, 16);
      s1 += __shfl_xor(s1, 32);
      const float mu = s1 * (1.f / 128.f);
      float s2 = 0.f;
#pragma unroll
      for (int et = 0; et < 8; ++et)
#pragma unroll
        for (int j = 0; j < 4; ++j) {
          float dlt = o[et][qt][j] - mu;
          s2 += dlt * dlt;
        }
      s2 += __shfl_xor(s2, 16);
      s2 += __shfl_xor(s2, 32);
      const float rstd = rsqrtf(s2 * (1.f / 128.f) + 1e-6f);
#pragma unroll
      for (int et = 0; et < 8; ++et) {
        const int e = h * 128 + et * 16 + 4 * g;
        float4 gn = *(const float4*)(p.ret_gn + e);
        u32x2 sg = *(const u32x2*)(srg + (size_t)tok * 512 + e);
        u32x2 ov;
        ov[0] = pack2((o[et][qt][0] - mu) * rstd * gn.x * bflo(sg[0]), (o[et][qt][1] - mu) * rstd * gn.y * bfhi(sg[0]));
        ov[1] = pack2((o[et][qt][2] - mu) * rstd * gn.z * bflo(sg[1]), (o[et][qt][3] - mu) * rstd * gn.w * bfhi(sg[1]));
        *(u32x2*)(ret + (size_t)tok * 512 + e) = ov;
      }
    }
  }
}

DI void phase6(const Params& p, char* smem) {
  char* ws = p.ws;
  const bf16_t* cqn = (const bf16_t*)(ws + OFF_CQ);
  const bf16_t* wuqT = (const bf16_t*)(ws + OFF_WUQT);
  bf16_t* q = (bf16_t*)(ws + OFF_Q);
  for (int it = 0;; ++it) {
    int ft, tt;
    if (!tile_map(it, 6, 160, 1, ft, tt)) break;
    f32x4 acc[4][4];
    acc_zero(acc);
    gemm_kloop<0>(acc, wuqT + (size_t)ft * 128 * 256, 256, cqn + (size_t)tt * 128 * 256, 256, 256, smem, 0.f, 0.f);
    epilogue(acc, [&](int m, int n, float (&v)[16]) { st_bf16x16(q + (size_t)(tt * 128 + n) * 768 + ft * 128 + m, v); });
  }
  const bf16_t* ckvall = (const bf16_t*)(ws + OFF_CKVALL);
  const bf16_t* wukvT = (const bf16_t*)(ws + OFF_WUKVT);
  bf16_t* Kn = (bf16_t*)(ws + OFF_KN);
  bf16_t* Vt = (bf16_t*)(ws + OFF_VTA);
  for (int it = 0;; ++it) {
    int ft, tt;
    if (!tile_map(it, 8, 192, 1, ft, tt)) break;
    f32x4 acc[4][4];
    acc_zero(acc);
    const bf16_t* W = wukvT + (size_t)ft * 128 * 128;
    const bf16_t* X = ckvall + (size_t)tt * 128 * 128;
    if (ft < 4) {
      gemm_kloop<0>(acc, W, 128, X, 128, 128, smem, 0.f, 0.f);
      epilogue(acc, [&](int m, int n, float (&v)[16]) { st_bf16x16(Kn + (size_t)(tt * 128 + n) * 512 + ft * 128 + m, v); });
    } else {
      gemm_kloop<0>(acc, X, 128, W, 128, 128, smem, 0.f, 0.f);
      epilogue(acc, [&](int m, int n, float (&v)[16]) { st_bf16x16(Vt + (size_t)((ft - 4) * 128 + n) * NKV + tt * 128 + m, v); });
    }
  }
}

DI void conv_fp8_rows(const float* __restrict__ src, unsigned char* __restrict__ dst, float* __restrict__ inv);
DI void phase7(const Params& p, char* smem) {
  char* ws = p.ws;
  const bf16_t* q = (const bf16_t*)(ws + OFF_Q);
  const bf16_t* Kn = (const bf16_t*)(ws + OFF_KN);
  const bf16_t* Vt = (const bf16_t*)(ws + OFF_VTA);
  const bf16_t* krall = (const bf16_t*)(ws + OFF_KRALL);
  bf16_t* attn = (bf16_t*)(ws + OFF_ATTN);
  bf16_t* Ks0 = (bf16_t*)smem;
  const int tid = threadIdx.x, lane = tid & 63, w = tid >> 6, l15 = lane & 15, g = lane >> 4;
  const float qscale = 0.10206207261596577f * 1.4426950408889634f;
  for (int item = vbid(); item < 1280; item += gridDim.x) {
    int b, h, qtok0, keyrow0, nkt;
    bool sample;
    if (item < 1024) {
      sample = true; b = item >> 7; h = (item >> 4) & 7; int qb = item & 15;
      qtok0 = NPT + b * 2048 + qb * 128; keyrow0 = NPT + b * 2560; nkt = 40;
    } else {
      int it2 = item - 1024;
      sample = false; b = it2 >> 4; h = (it2 >> 1) & 7; int qb = it2 & 1;
      qtok0 = b * 256 + qb * 128; keyrow0 = b * 256; nkt = 4;
    }
    bf16x8 Q[2][3];
#pragma unroll
    for (int qt = 0; qt < 2; ++qt) {
      const int tokq = qtok0 + w * 32 + qt * 16 + l15;
      const bf16_t* qp = q + (size_t)tokq * 768 + h * 96;
#pragma unroll
      for (int ks = 0; ks < 3; ++ks) {
        u32x4 u = *(const u32x4*)(qp + ks * 32 + g * 8);
        float v[8];
#pragma unroll
        for (int i = 0; i < 4; ++i) { v[2 * i] = bflo(u[i]); v[2 * i + 1] = bfhi(u[i]); }
        if (ks == 2 && sample) {
          u32x4 up = *(const u32x4*)(qp + 64 + (g ^ 2) * 8);
          float pv[8];
#pragma unroll
          for (int i = 0; i < 4; ++i) { pv[2 * i] = bflo(up[i]); pv[2 * i + 1] = bfhi(up[i]); }
          int t = (tokq - NPT) & 2047;
          const float4* rp = (const float4*)((const float2*)(ws + OFF_ROPE) + t * 16 + (g & 1) * 8);
#pragma unroll
          for (int i2 = 0; i2 < 4; ++i2) {
            const float4 c2 = rp[i2];
            const int i = 2 * i2;
            v[i] = g < 2 ? v[i] * c2.x - pv[i] * c2.y : pv[i] * c2.y + v[i] * c2.x;
            v[i + 1] = g < 2 ? v[i + 1] * c2.z - pv[i + 1] * c2.w : pv[i + 1] * c2.w + v[i + 1] * c2.z;
          }
        }
        u32x4 o4;
#pragma unroll
        for (int i = 0; i < 4; ++i) o4[i] = pack2(v[2 * i] * qscale, v[2 * i + 1] * qscale);
        Q[qt][ks] = __builtin_bit_cast(bf16x8, o4);
      }
    }
    f32x4 o[4][2];
#pragma unroll
    for (int et = 0; et < 4; ++et)
#pragma unroll
      for (int qt = 0; qt < 2; ++qt) o[et][qt] = f32x4{0.f, 0.f, 0.f, 0.f};
    float mrun[2] = {-1e30f, -1e30f}, lrun[2] = {0.f, 0.f};
    u32x4 rk_[3], rv_[2];
    auto gload = [&](int kt) {
      const int row0 = keyrow0 + kt * 64;
#pragma unroll
      for (int i = 0; i < 3; ++i) {
        int c = tid + 256 * i;
        int r = c / 12, cc = c - r * 12;
        rk_[i] = cc < 8 ? *(const u32x4*)(Kn + (size_t)(row0 + r) * 512 + h * 64 + cc * 8)
                        : *(const u32x4*)(krall + (size_t)(row0 + r) * 32 + (cc - 8) * 8);
      }
#pragma unroll
      for (int i = 0; i < 2; ++i) {
        int c = tid + 256 * i;
        int e = c >> 3, cc = (c & 7) * 8;
        rv_[i] = *(const u32x4*)(Vt + (size_t)(h * 64 + e) * NKV + row0 + cc);
      }
    };
    auto lstore = [&](int b) {
      bf16_t* Kd = Ks0 + b * 11776;
      bf16_t* Vd = Kd + 64 * 112;
#pragma unroll
      for (int i = 0; i < 3; ++i) {
        int c = tid + 256 * i;
        int r = c / 12, cc = c - r * 12;
        *(u32x4*)(Kd + r * 112 + cc * 8) = rk_[i];
      }
#pragma unroll
      for (int i = 0; i < 2; ++i) {
        int c = tid + 256 * i;
        int e = c >> 3, cc = (c & 7) * 8;
        *(u32x4*)(Vd + e * 72 + cc) = rv_[i];
      }
    };
    gload(0);
    __syncthreads();
    lstore(0);
    if (nkt > 1) gload(1);
    __syncthreads();
#pragma unroll 1
    for (int kt = 0; kt < nkt; ++kt) {
      const bf16_t* Ks = Ks0 + (kt & 1) * 11776;
      const bf16_t* Vs = Ks + 64 * 112;
      f32x4 s[4][2];
#pragma unroll
      for (int kk = 0; kk < 4; ++kk)
#pragma unroll
        for (int qt = 0; qt < 2; ++qt) s[kk][qt] = f32x4{0.f, 0.f, 0.f, 0.f};
#pragma unroll
      for (int ks = 0; ks < 3; ++ks) {
#pragma unroll
        for (int kk = 0; kk < 4; ++kk) {
          bf16x8 a = *(const bf16x8*)(Ks + (kk * 16 + l15) * 112 + ks * 32 + g * 8);
#pragma unroll
          for (int qt = 0; qt < 2; ++qt) s[kk][qt] = __builtin_amdgcn_mfma_f32_16x16x32_bf16(a, Q[qt][ks], s[kk][qt], 0, 0, 0);
        }
      }
      bf16x8 P[2][2];
#pragma unroll
      for (int qt = 0; qt < 2; ++qt) {
        float mx = s[0][qt][0];
#pragma unroll
        for (int kk = 0; kk < 4; ++kk)
#pragma unroll
          for (int j = 0; j < 4; ++j) mx = fmaxf(mx, s[kk][qt][j]);
        mx = fmaxf(mx, __shfl_xor(mx, 16));
        mx = fmaxf(mx, __shfl_xor(mx, 32));
        const float mnew = fmaxf(mrun[qt], mx);
        const bool grow = __ballot(mx > mrun[qt]) != 0ull;
        const float alpha = grow ? ex2(mrun[qt] - mnew) : 1.f;
        mrun[qt] = mnew;
        float ps = 0.f;
#pragma unroll
        for (int kk = 0; kk < 4; ++kk)
#pragma unroll
          for (int j = 0; j < 4; ++j) {
            float e_ = ex2(s[kk][qt][j] - mnew);
            s[kk][qt][j] = e_;
            ps += e_;
          }
        if (grow) {
          lrun[qt] = lrun[qt] * alpha + ps;
#pragma unroll
          for (int et = 0; et < 4; ++et)
#pragma unroll
            for (int j = 0; j < 4; ++j) o[et][qt][j] *= alpha;
        } else {
          lrun[qt] += ps;
        }
#pragma unroll
        for (int k2 = 0; k2 < 2; ++k2) {
          u32x4 u;
          u[0] = pack2(s[2 * k2][qt][0], s[2 * k2][qt][1]);
          u[1] = pack2(s[2 * k2][qt][2], s[2 * k2][qt][3]);
          u[2] = pack2(s[2 * k2 + 1][qt][0], s[2 * k2 + 1][qt][1]);
          u[3] = pack2(s[2 * k2 + 1][qt][2], s[2 * k2 + 1][qt][3]);
          P[qt][k2] = __builtin_bit_cast(bf16x8, u);
        }
      }
#pragma unroll
      for (int k2 = 0; k2 < 2; ++k2) {
#pragma unroll
        for (int et = 0; et < 4; ++et) {
          u32x2 lo = *(const u32x2*)(Vs + (et * 16 + l15) * 72 + k2 * 32 + 4 * g);
          u32x2 hi = *(const u32x2*)(Vs + (et * 16 + l15) * 72 + k2 * 32 + 16 + 4 * g);
          u32x4 u;
          u[0] = lo[0]; u[1] = lo[1]; u[2] = hi[0]; u[3] = hi[1];
          bf16x8 a = __builtin_bit_cast(bf16x8, u);
#pragma unroll
          for (int qt = 0; qt < 2; ++qt) o[et][qt] = __builtin_amdgcn_mfma_f32_16x16x32_bf16(a, P[qt][k2], o[et][qt], 0, 0, 0);
        }
      }
      if (kt + 1 < nkt) {
        lstore((kt + 1) & 1);
        if (kt + 2 < nkt) gload(kt + 2);
        __syncthreads();
      }
    }
#pragma unroll
    for (int qt = 0; qt < 2; ++qt) {
      const int tokq = qtok0 + w * 32 + qt * 16 + l15;
      float lt = lrun[qt];
      lt += __shfl_xor(lt, 16);
      lt += __shfl_xor(lt, 32);
      const float inv = 1.f / lt;
#pragma unroll
      for (int et = 0; et < 4; ++et) {
        u32x2 ov;
        ov[0] = pack2(o[et][qt][0] * inv, o[et][qt][1] * inv);
        ov[1] = pack2(o[et][qt][2] * inv, o[et][qt][3] * inv);
        *(u32x2*)(attn + (size_t)tokq * 512 + h * 64 + et * 16 + 4 * g) = ov;
      }
    }
  }
  conv_fp8_rows(p.peer_u, (unsigned char*)(p.ws + OFF_TABU), (float*)(p.ws + OFF_INVU));
  conv_fp8_rows(p.peer_v, (unsigned char*)(p.ws + OFF_TABV), (float*)(p.ws + OFF_INVV));
}

DI void phase8(const Params& p, char* smem) {
  char* ws = p.ws;
  const bf16_t* attn = (const bf16_t*)(ws + OFF_ATTN);
  const bf16_t* ret = (const bf16_t*)(ws + OFF_RET);
  const bf16_t* wa = (const bf16_t*)(ws + OFF_WUPAT);
  const bf16_t* wb = (const bf16_t*)(ws + OFF_WUPBT);
  const bf16_t* sga = (const bf16_t*)p.out;
  const bf16_t* sgb = sga + (size_t)NTOK * 1024;
  bf16_t* mbuf = (bf16_t*)(ws + OFF_M);
  const int tid = threadIdx.x, lane = tid & 63, w = tid >> 6, wm = w >> 1, wn = w & 1, l15 = lane & 15, g = lane >> 4;
  for (int it = 0;; ++it) {
    int ft, tt;
    if (!tile_map(it, 8, 160, 1, ft, tt)) break;
    f32x4 acc[4][4];
    acc_zero(acc);
    gemm_kloop<0>(acc, wa + (size_t)ft * 128 * 512, 512, attn + (size_t)tt * 128 * 512, 512, 512, smem, 0.f, 0.f);
#pragma unroll
    for (int c = 0; c < 4; ++c) {
      const size_t off = (size_t)(tt * 128 + wn * 64 + c * 16 + l15) * 1024 + ft * 128 + wm * 64 + 16 * g;
      float a[16], bq[16];
      ld_bf16x16(sga + off, a);
      ld_bf16x16(sgb + off, bq);
#pragma unroll
      for (int f = 0; f < 4; ++f)
#pragma unroll
        for (int j = 0; j < 4; ++j) acc[f][c][j] *= a[f * 4 + j] * __builtin_amdgcn_rcpf(fmaxf(bq[f * 4 + j], 1e-30f));
    }
    gemm_kloop<0>(acc, wb + (size_t)ft * 128 * 512, 512, ret + (size_t)tt * 128 * 512, 512, 512, smem, 0.f, 0.f);
    epilogue(acc, [&](int m, int n, float (&v)[16]) {
      const size_t off = (size_t)(tt * 128 + n) * 1024 + ft * 128 + m;
      float bq[16];
      ld_bf16x16(sgb + off, bq);
#pragma unroll
      for (int i = 0; i < 16; ++i) v[i] *= bq[i];
      st_bf16x16(mbuf + off, v);
    });
  }
}
DI void phase9(const Params& p, char* smem) {
  char* ws = p.ws;
  const bf16_t* mbuf = (const bf16_t*)(ws + OFF_M);
  const bf16_t* wo = (const bf16_t*)(ws + OFF_WOT);
  const float* mod = (const float*)(ws + OFF_MOD);
  for (int it = 0;; ++it) {
    int ft, tt;
    if (!tile_map(it, 8, 160, 1, ft, tt)) break;
    f32x4 acc[4][4];
    acc_zero(acc);
    gemm_kloop<0>(acc, wo + (size_t)ft * 128 * 1024, 1024, mbuf + (size_t)tt * 128 * 1024, 1024, 1024, smem, 0.f, 0.f);
    epilogue(acc, [&](int m, int n, float (&v)[16]) {
      const int tok = tt * 128 + n, feat = ft * 128 + m;
      const float* xr = xrow(p, tok) + feat;
      const float* g1 = mod + modidx(tok) * 6144 + 2048 + feat;
#pragma unroll
      for (int i = 0; i < 4; ++i) {
        float4 xv = *(const float4*)(xr + 4 * i), gv = *(const float4*)(g1 + 4 * i);
        v[4 * i] = xv.x + gv.x * v[4 * i];
        v[4 * i + 1] = xv.y + gv.y * v[4 * i + 1];
        v[4 * i + 2] = xv.z + gv.z * v[4 * i + 2];
        v[4 * i + 3] = xv.w + gv.w * v[4 * i + 3];
      }
      st_f32x16(p.out + (size_t)tok * DM + feat, v);
    });
  }
}
DI void conv_fp8_rows(const float* __restrict__ src, unsigned char* __restrict__ dst, float* __restrict__ inv) {
  const int lane = threadIdx.x & 63, w = threadIdx.x >> 6;
  for (int r = blockIdx.x * 4 + w; r < 16384; r += gridDim.x * 4) {
    const float* sp = src + (size_t)r * 1024 + lane * 16;
    float4 v[4];
    float am = 0.f;
#pragma unroll
    for (int i = 0; i < 4; ++i) {
      v[i] = *(const float4*)(sp + 4 * i);
      am = fmaxf(am, fmaxf(fmaxf(fabsf(v[i].x), fabsf(v[i].y)), fmaxf(fabsf(v[i].z), fabsf(v[i].w))));
    }
#pragma unroll
    for (int o = 32; o > 0; o >>= 1) am = fmaxf(am, __shfl_xor(am, o));
    const float sc = am > 0.f ? 448.f / am : 1.f;
    u32x4 o4;
#pragma unroll
    for (int i = 0; i < 4; ++i) {
      int wd = 0;
      wd = __builtin_amdgcn_cvt_pk_fp8_f32(v[i].x * sc, v[i].y * sc, wd, false);
      wd = __builtin_amdgcn_cvt_pk_fp8_f32(v[i].z * sc, v[i].w * sc, wd, true);
      o4[i] = (unsigned)wd;
    }
    *(u32x4*)(dst + ((size_t)(lane >> 3) * 16384 + r) * 128 + (lane & 7) * 16) = o4;
    if (lane == 0) inv[r] = am > 0.f ? am * (1.f / 448.f) : 1.f;
  }
}
DI void phase10(const Params& p, char* smem) {
  rows_norm_mod(p, p.norm_ffn, 3072, 4096, true, (bf16_t*)(p.ws + OFF_H2));
}
DI void phase11(const Params& p, char* smem) {
  char* ws = p.ws;
  const bf16_t* h2 = (const bf16_t*)(ws + OFF_H2);
  const bf16_t* wct = (const bf16_t*)(ws + OFF_WCT);
  bf16_t* sc = (bf16_t*)(ws + OFF_SCORES);
  for (int it = 0;; ++it) {
    int ft, tt;
    if (!tile_map(it, 16, 160, 2, ft, tt)) break;
    f32x4 acc[4][4];
    acc_zero(acc);
    gemm_kloop<0>(acc, wct + (size_t)ft * 128 * 1024, 1024, h2 + (size_t)tt * 128 * 1024, 1024, 1024, smem, 0.f, 0.f);
    epilogue(acc, [&](int m, int n, float (&v)[16]) { st_bf16x16(sc + (size_t)(tt * 128 + n) * 2048 + ft * 128 + m, v); });
  }
}

DI unsigned okey(float f) {
  unsigned u = __float_as_uint(f);
  return (u & 0x80000000u) ? ~u : (u | 0x80000000u);
}
DI void wave_lds_sync() {
  __builtin_amdgcn_fence(__ATOMIC_ACQ_REL, "workgroup");
  __builtin_amdgcn_wave_barrier();
}
DI unsigned okey16(unsigned b) { return (b & 0x8000u) ? (~b & 0xFFFFu) : (b | 0x8000u); }
DI unsigned inv_okey16(unsigned k) { return (k & 0x8000u) ? (k & 0x7FFFu) : (~k & 0xFFFFu); }
DI unsigned inv_okey(unsigned k) { return (k & 0x80000000u) ? (k & 0x7FFFFFFFu) : ~k; }
DI void ins16(unsigned (&L)[16], unsigned x) {
#pragma unroll
  for (int i = 0; i < 16; ++i) {
    unsigned t = max(L[i], x);
    x = min(L[i], x);
    L[i] = t;
  }
}
DI void ce_desc(unsigned& a, unsigned& b) {
  const unsigned t = max(a, b);
  b = min(a, b);
  a = t;
}
DI void sort16_desc(unsigned (&a)[16]) {
#pragma unroll
  for (int ks = 1; ks <= 4; ++ks) {
#pragma unroll
    for (int js = ks - 1; js >= 0; --js) {
#pragma unroll
      for (int i = 0; i < 16; ++i) {
        const int k = 1 << ks, j = 1 << js, l = i ^ j;
        if (l > i) {
          if ((i & k) == 0) ce_desc(a[i], a[l]);
          else ce_desc(a[l], a[i]);
        }
      }
    }
  }
}
DI void merge_top16(unsigned (&L)[16], const unsigned (&G)[16]) {
#pragma unroll
  for (int i = 0; i < 16; ++i) L[i] = max(L[i], G[15 - i]);
#pragma unroll
  for (int js = 3; js >= 0; --js) {
#pragma unroll
    for (int i = 0; i < 16; ++i) {
      const int j = 1 << js, l = i ^ j;
      if (l > i) ce_desc(L[i], L[l]);
    }
  }
}
DI unsigned byte16(const unsigned (&d)[4], int i) {
  unsigned r = 0u;
#pragma unroll
  for (int q = 0; q < 4; ++q) r |= d[q] & (0u - (unsigned)((i >> 2) == q));
  return (r >> ((i & 3) * 8)) & 0xFFu;
}
DI unsigned sel16(const unsigned (&A)[16], int i) {
  unsigned r = 0u;
#pragma unroll
  for (int t = 0; t < 16; ++t) r |= A[t] & (0u - (unsigned)(i == t));
  return r;
}
DI void phase12(const Params& p, char* smem) {
  char* ws = p.ws;
  const bf16_t* sc = (const bf16_t*)(ws + OFF_SCORES);
  int* elist = (int*)(ws + OFF_ELIST);
  float* glist = (float*)(ws + OFF_GLIST);
  const int lane = threadIdx.x & 63, w = threadIdx.x >> 6;
  for (int batch = blockIdx.x * 4 + w; batch < NTOK / 4; batch += gridDim.x * 4) {
    const int tok = batch * 4 + (lane >> 4), hh = lane & 15;
    const bf16_t* row = sc + (size_t)tok * 2048 + hh * 128;
    unsigned L[16];
#pragma unroll
    for (int grp8 = 0; grp8 < 8; ++grp8) {
      unsigned G[16];
#pragma unroll
      for (int cc = 0; cc < 2; ++cc) {
        const int c = grp8 * 2 + cc;
        u32x4 u = *(const u32x4*)(row + c * 8);
#pragma unroll
        for (int i = 0; i < 4; ++i) {
          unsigned b0 = u[i] & 0xFFFFu, b1 = u[i] >> 16;
          G[cc * 8 + 2 * i] = (okey16(b0) << 16) | (unsigned)(127 - (c * 8 + 2 * i));
          G[cc * 8 + 2 * i + 1] = (okey16(b1) << 16) | (unsigned)(127 - (c * 8 + 2 * i + 1));
        }
      }
      sort16_desc(G);
      if (grp8 == 0) {
#pragma unroll
        for (int i = 0; i < 16; ++i) L[i] = G[i];
      } else {
        merge_top16(L, G);
      }
    }
    unsigned M[16];
#pragma unroll
    for (int i = 0; i < 16; ++i) M[i] = (unsigned)__shfl_xor((int)L[i], 1);
    float v1[16], v2[16];
#pragma unroll
    for (int i = 0; i < 16; ++i) {
      v1[i] = bf2f(inv_okey16(L[i] >> 16));
      v2[i] = bf2f(inv_okey16(M[i] >> 16));
    }
    unsigned C[16];
    C[0] = ((okey(v1[0] + v2[0]) & 0xFFFFFF00u) | 255u);
    C[1] = ((okey(v1[0] + v2[1]) & 0xFFFFFF00u) | 254u);
    C[2] = ((okey(v1[0] + v2[2]) & 0xFFFFFF00u) | 253u);
    C[3] = ((okey(v1[0] + v2[3]) & 0xFFFFFF00u) | 252u);
    C[4] = ((okey(v1[0] + v2[4]) & 0xFFFFFF00u) | 251u);
    C[5] = ((okey(v1[0] + v2[5]) & 0xFFFFFF00u) | 250u);
    C[6] = ((okey(v1[0] + v2[6]) & 0xFFFFFF00u) | 249u);
    C[7] = ((okey(v1[0] + v2[7]) & 0xFFFFFF00u) | 248u);
    C[8] = ((okey(v1[0] + v2[8]) & 0xFFFFFF00u) | 247u);
    C[9] = ((okey(v1[0] + v2[9]) & 0xFFFFFF00u) | 246u);
    C[10] = ((okey(v1[0] + v2[10]) & 0xFFFFFF00u) | 245u);
    C[11] = ((okey(v1[0] + v2[11]) & 0xFFFFFF00u) | 244u);
    C[12] = ((okey(v1[0] + v2[12]) & 0xFFFFFF00u) | 243u);
    C[13] = ((okey(v1[0] + v2[13]) & 0xFFFFFF00u) | 242u);
    C[14] = ((okey(v1[0] + v2[14]) & 0xFFFFFF00u) | 241u);
    C[15] = ((okey(v1[0] + v2[15]) & 0xFFFFFF00u) | 240u);
    {
      unsigned G[16];
      G[0] = ((okey(v1[1] + v2[0]) & 0xFFFFFF00u) | 239u);
      G[1] = ((okey(v1[1] + v2[1]) & 0xFFFFFF00u) | 238u);
      G[2] = ((okey(v1[1] + v2[2]) & 0xFFFFFF00u) | 237u);
      G[3] = ((okey(v1[1] + v2[3]) & 0xFFFFFF00u) | 236u);
      G[4] = ((okey(v1[1] + v2[4]) & 0xFFFFFF00u) | 235u);
      G[5] = ((okey(v1[1] + v2[5]) & 0xFFFFFF00u) | 234u);
      G[6] = ((okey(v1[1] + v2[6]) & 0xFFFFFF00u) | 233u);
      G[7] = ((okey(v1[1] + v2[7]) & 0xFFFFFF00u) | 232u);
      G[8] = 0u;
      G[9] = 0u;
      G[10] = 0u;
      G[11] = 0u;
      G[12] = 0u;
      G[13] = 0u;
      G[14] = 0u;
      G[15] = 0u;
      merge_top16(C, G);
    }
    {
      unsigned G[16];
      G[0] = ((okey(v1[2] + v2[0]) & 0xFFFFFF00u) | 223u);
      G[1] = ((okey(v1[2] + v2[1]) & 0xFFFFFF00u) | 222u);
      G[2] = ((okey(v1[2] + v2[2]) & 0xFFFFFF00u) | 221u);
      G[3] = ((okey(v1[2] + v2[3]) & 0xFFFFFF00u) | 220u);
      G[4] = ((okey(v1[2] + v2[4]) & 0xFFFFFF00u) | 219u);
      G[5] = 0u;
      G[6] = 0u;
      G[7] = 0u;
      G[8] = 0u;
      G[9] = 0u;
      G[10] = 0u;
      G[11] = 0u;
      G[12] = 0u;
      G[13] = 0u;
      G[14] = 0u;
      G[15] = 0u;
      merge_top16(C, G);
    }
    {
      unsigned G[16];
      G[0] = ((okey(v1[3] + v2[0]) & 0xFFFFFF00u) | 207u);
      G[1] = ((okey(v1[3] + v2[1]) & 0xFFFFFF00u) | 206u);
      G[2] = ((okey(v1[3] + v2[2]) & 0xFFFFFF00u) | 205u);
      G[3] = ((okey(v1[3] + v2[3]) & 0xFFFFFF00u) | 204u);
      G[4] = 0u;
      G[5] = 0u;
      G[6] = 0u;
      G[7] = 0u;
      G[8] = 0u;
      G[9] = 0u;
      G[10] = 0u;
      G[11] = 0u;
      G[12] = 0u;
      G[13] = 0u;
      G[14] = 0u;
      G[15] = 0u;
      merge_top16(C, G);
    }
    {
      unsigned G[16];
      G[0] = ((okey(v1[4] + v2[0]) & 0xFFFFFF00u) | 191u);
      G[1] = ((okey(v1[5] + v2[0]) & 0xFFFFFF00u) | 175u);
      G[2] = ((okey(v1[6] + v2[0]) & 0xFFFFFF00u) | 159u);
      G[3] = ((okey(v1[7] + v2[0]) & 0xFFFFFF00u) | 143u);
      G[4] = ((okey(v1[8] + v2[0]) & 0xFFFFFF00u) | 127u);
      G[5] = ((okey(v1[9] + v2[0]) & 0xFFFFFF00u) | 111u);
      G[6] = ((okey(v1[10] + v2[0]) & 0xFFFFFF00u) | 95u);
      G[7] = ((okey(v1[11] + v2[0]) & 0xFFFFFF00u) | 79u);
      G[8] = ((okey(v1[12] + v2[0]) & 0xFFFFFF00u) | 63u);
      G[9] = ((okey(v1[13] + v2[0]) & 0xFFFFFF00u) | 47u);
      G[10] = ((okey(v1[14] + v2[0]) & 0xFFFFFF00u) | 31u);
      G[11] = ((okey(v1[15] + v2[0]) & 0xFFFFFF00u) | 15u);
      G[12] = 0u;
      G[13] = 0u;
      G[14] = 0u;
      G[15] = 0u;
      merge_top16(C, G);
    }
    {
      unsigned G[16];
      G[0] = ((okey(v1[4] + v2[1]) & 0xFFFFFF00u) | 190u);
      G[1] = ((okey(v1[5] + v2[1]) & 0xFFFFFF00u) | 174u);
      G[2] = ((okey(v1[6] + v2[1]) & 0xFFFFFF00u) | 158u);
      G[3] = ((okey(v1[7] + v2[1]) & 0xFFFFFF00u) | 142u);
      G[4] = 0u;
      G[5] = 0u;
      G[6] = 0u;
      G[7] = 0u;
      G[8] = 0u;
      G[9] = 0u;
      G[10] = 0u;
      G[11] = 0u;
      G[12] = 0u;
      G[13] = 0u;
      G[14] = 0u;
      G[15] = 0u;
      merge_top16(C, G);
    }
    {
      unsigned G[16];
      G[0] = ((okey(v1[4] + v2[2]) & 0xFFFFFF00u) | 189u);
      G[1] = 0u;
      G[2] = 0u;
      G[3] = 0u;
      G[4] = 0u;
      G[5] = 0u;
      G[6] = 0u;
      G[7] = 0u;
      G[8] = 0u;
      G[9] = 0u;
      G[10] = 0u;
      G[11] = 0u;
      G[12] = 0u;
      G[13] = 0u;
      G[14] = 0u;
      G[15] = 0u;
      merge_top16(C, G);
    }
    unsigned ib1[4], ib2[4];
#pragma unroll
    for (int q = 0; q < 4; ++q) {
      ib1[q] = (L[4 * q] & 0xFFu) | ((L[4 * q + 1] & 0xFFu) << 8) | ((L[4 * q + 2] & 0xFFu) << 16) | ((L[4 * q + 3] & 0xFFu) << 24);
      ib2[q] = (M[4 * q] & 0xFFu) | ((M[4 * q + 1] & 0xFFu) << 8) | ((M[4 * q + 2] & 0xFFu) << 16) | ((M[4 * q + 3] & 0xFFu) << 24);
    }
    int ev[16];
    float gv[16];
    const float mx = __uint_as_float(inv_okey(C[0] & 0xFFFFFF00u));
    float den = 0.f;
#pragma unroll
    for (int k = 0; k < 16; ++k) {
      const int ci = 255 - (int)(C[k] & 0xFFu);
      ev[k] = (127 - (int)byte16(ib1, ci >> 4)) * 128 + (127 - (int)byte16(ib2, ci & 15));
      gv[k] = __expf(__uint_as_float(inv_okey(C[k] & 0xFFFFFF00u)) - mx);
      den += gv[k];
    }
    const float inv = 1.f / den;
    if ((lane & 1) == 0) {
      int* ep = elist + (size_t)tok * 128 + (hh >> 1) * 16;
      float* gp = glist + (size_t)tok * 128 + (hh >> 1) * 16;
#pragma unroll
      for (int k = 0; k < 4; ++k) {
        *(int4*)(ep + 4 * k) = make_int4(ev[4 * k], ev[4 * k + 1], ev[4 * k + 2], ev[4 * k + 3]);
        *(float4*)(gp + 4 * k) = make_float4(gv[4 * k] * inv, gv[4 * k + 1] * inv, gv[4 * k + 2] * inv, gv[4 * k + 3] * inv);
      }
    }
  }
}
using f32x2 = __attribute__((ext_vector_type(2))) float;
DI f32x2 cvt8(unsigned w, bool hi) {
  return hi ? __builtin_amdgcn_cvt_pk_f32_fp8((int)w, true) : __builtin_amdgcn_cvt_pk_f32_fp8((int)w, false);
}
struct SMeta { int e[16]; u32x4 ha, hb; };
template <int MODE>
DI void sl_meta(const Params& p, int t, int s, int grp, int ch, SMeta& m) {
  const int* elist = (const int*)(p.ws + (MODE == 0 ? OFF_ELIST : OFF_GLIST));
#pragma unroll
  for (int i = 0; i < 16; ++i) m.e[i] = elist[(size_t)t * 128 + i * 8 + grp];
  if (MODE == 0) {
    const bf16_t* hq = (const bf16_t*)(p.ws + OFF_H2) + (size_t)t * DM + s * 128 + ch * 16;
    m.ha = *(const u32x4*)hq;
    m.hb = *(const u32x4*)(hq + 8);
  }
}
template <int MODE>
DI void sl_rows(const Params& p, int s, int ch, const SMeta& m, u32x4 (&r)[16]) {
  const unsigned char* tab = (const unsigned char*)(p.ws + (MODE == 0 ? OFF_TABU : OFF_TABV));
#pragma unroll
  for (int i = 0; i < 16; ++i) r[i] = *(const u32x4*)(tab + ((size_t)s * 16384 + (m.e[i] & 0xFFFF)) * 128 + ch * 16);
}
template <int MODE>
DI void sl_compute(const Params& p, int t, int s, int lane, const SMeta& m, const u32x4 (&r)[16]) {
  const int grp = lane >> 3, ch = lane & 7;
  if (MODE == 0) {
    f32x2 hp[8];
#pragma unroll
    for (int i = 0; i < 4; ++i) {
      hp[i] = f32x2{bflo(m.ha[i]), bfhi(m.ha[i])};
      hp[4 + i] = f32x2{bflo(m.hb[i]), bfhi(m.hb[i])};
    }
    float keep0 = 0.f, keep1 = 0.f;
#pragma unroll
    for (int i = 0; i < 16; ++i) {
      f32x2 d2 = f32x2{0.f, 0.f};
#pragma unroll
      for (int j = 0; j < 4; ++j) {
        d2 += cvt8(r[i][j], false) * hp[2 * j];
        d2 += cvt8(r[i][j], true) * hp[2 * j + 1];
      }
      float d = d2[0] + d2[1];
      d += __shfl_xor(d, 1);
      d += __shfl_xor(d, 2);
      d += __shfl_xor(d, 4);
      if (i < 8) keep0 = (ch == i) ? d : keep0;
      else keep1 = (ch == i - 8) ? d : keep1;
    }
    float* po = (float*)(p.ws + OFF_PD) + (size_t)t * 1024 + s * 128;
    po[ch * 8 + grp] = keep0;
    po[(ch + 8) * 8 + grp] = keep1;
  } else {
    f32x2 acc[8];
#pragma unroll
    for (int q = 0; q < 8; ++q) acc[q] = f32x2{0.f, 0.f};
#pragma unroll
    for (int i = 0; i < 16; ++i) {
      const float wsc = __uint_as_float((unsigned)m.e[i] & 0xFFFF0000u);
      const f32x2 w2 = f32x2{wsc, wsc};
#pragma unroll
      for (int j = 0; j < 4; ++j) {
        acc[2 * j] += w2 * cvt8(r[i][j], false);
        acc[2 * j + 1] += w2 * cvt8(r[i][j], true);
      }
    }
    float v[16];
#pragma unroll
    for (int q = 0; q < 8; ++q) { v[2 * q] = acc[q][0]; v[2 * q + 1] = acc[q][1]; }
    float q8[8], q4[4], q2[2];
    {
      const bool hi = lane & 32;
#pragma unroll
      for (int i = 0; i < 8; ++i) {
        float send = hi ? v[i] : v[8 + i], keep = hi ? v[8 + i] : v[i];
        q8[i] = keep + __shfl_xor(send, 32);
      }
    }
    {
      const bool hi = lane & 16;
#pragma unroll
      for (int i = 0; i < 4; ++i) {
        float send = hi ? q8[i] : q8[4 + i], keep = hi ? q8[4 + i] : q8[i];
        q4[i] = keep + __shfl_xor(send, 16);
      }
    }
    {
      const bool hi = lane & 8;
#pragma unroll
      for (int i = 0; i < 2; ++i) {
        float send = hi ? q4[i] : q4[2 + i], keep = hi ? q4[2 + i] : q4[i];
        q2[i] = keep + __shfl_xor(send, 8);
      }
    }
    const int f = s * 128 + ch * 16 + 2 * grp;
    float* xr = p.out + (size_t)t * DM + f;
    const float2 xv = *(const float2*)xr;
    const float2 gv = *(const float2*)((const float*)(p.ws + OFF_MOD) + modidx(t) * 6144 + 5120 + f);
    *(float2*)xr = make_float2(xv.x + gv.x * q2[0], xv.y + gv.y * q2[1]);
  }
}
template <int MODE>
DI void sliced_pass(const Params& p) {
  const int s = blockIdx.x & 7, loc = blockIdx.x >> 3, nloc = gridDim.x >> 3;
  if (loc >= nloc) return;
  const int lane = threadIdx.x & 63, w = threadIdx.x >> 6, grp = lane >> 3, ch = lane & 7;
  const int stride = nloc * 4;
  SMeta mA, mB;
  u32x4 rA[16], rB[16];
  int t = loc * 4 + w;
  if (t < NTOK) {
    sl_meta<MODE>(p, t, s, grp, ch, mA);
    sl_rows<MODE>(p, s, ch, mA, rA);
  }
  if (t + stride < NTOK) sl_meta<MODE>(p, t + stride, s, grp, ch, mB);
#pragma unroll 1
  for (; t < NTOK; t += 2 * stride) {
    const int t1 = t + stride, t2 = t + 2 * stride, t3 = t + 3 * stride;
    if (t1 < NTOK) sl_rows<MODE>(p, s, ch, mB, rB);
    sl_compute<MODE>(p, t, s, lane, mA, rA);
    if (t2 < NTOK) sl_meta<MODE>(p, t2, s, grp, ch, mA);
    if (t1 < NTOK) {
      if (t2 < NTOK) sl_rows<MODE>(p, s, ch, mA, rA);
      sl_compute<MODE>(p, t1, s, lane, mB, rB);
      if (t3 < NTOK) sl_meta<MODE>(p, t3, s, grp, ch, mB);
    }
  }
}
DI void phase13(const Params& p) { sliced_pass<0>(p); }
DI void phase14(const Params& p) {
  char* ws = p.ws;
  const float* invU = (const float*)(ws + OFF_INVU);
  const float* invV = (const float*)(ws + OFF_INVV);
  const int* elist = (const int*)(ws + OFF_ELIST);
  float* glist = (float*)(ws + OFF_GLIST);
  const float* pd = (const float*)(ws + OFF_PD);
  const int lane = threadIdx.x & 63, w = threadIdx.x >> 6;
  for (int t = blockIdx.x * 4 + w; t < NTOK; t += gridDim.x * 4) {
#pragma unroll
    for (int hf_ = 0; hf_ < 2; ++hf_) {
      const int k = hf_ * 64 + lane;
      float d = 0.f;
#pragma unroll
      for (int s = 0; s < 8; ++s) d += pd[(size_t)t * 1024 + s * 128 + k];
      const int e = elist[(size_t)t * 128 + k];
      const float g = glist[(size_t)t * 128 + k];
      ((unsigned*)glist)[(size_t)t * 128 + k] = (pack2(0.f, g * geluf_(d * invU[e]) * invV[e]) & 0xFFFF0000u) | (unsigned)e;
    }
  }
}
DI void phase15(const Params& p) { sliced_pass<1>(p); }
DI void phase16(const Params& p) {
  const int lane = threadIdx.x & 63, w = threadIdx.x >> 6;
  for (int tok = blockIdx.x * 4 + w; tok < NTOK; tok += gridDim.x * 4) {
    float* xr = p.out + (size_t)tok * DM;
    float4 xv[4];
    float ss = 0.f;
#pragma unroll
    for (int i = 0; i < 4; ++i) {
      xv[i] = *(const float4*)(xr + (i * 64 + lane) * 4);
      ss += xv[i].x * xv[i].x + xv[i].y * xv[i].y + xv[i].z * xv[i].z + xv[i].w * xv[i].w;
    }
    ss = wsum(ss);
    const float rstd = rsqrtf(ss * (1.f / 1024.f) + 1e-6f);
#pragma unroll
    for (int i = 0; i < 4; ++i) {
      const int e = (i * 64 + lane) * 4;
      float4 nf = *(const float4*)(p.norm_final + e);
      *(float4*)(xr + e) = make_float4(xv[i].x * rstd * nf.x, xv[i].y * rstd * nf.y, xv[i].z * rstd * nf.z, xv[i].w * rstd * nf.w);
    }
  }
}

#define XB_TMO      128
#define XB_XCNT(j)  (256  + 64 * (j))
#define XB_XSUB(j)  (1280 + 64 * (j))
#define XB_XGEN(j)  (2304 + 64 * (j))
#define XB_TOP      3328
#define XB_TOPGEN   3392
#define XCD_BAR_WORDS 3456
#define XB_SPIN_CAP (1u << 22)
#define LAS __attribute__((address_space(3)))
DI unsigned xb_ld(unsigned* p) { return __hip_atomic_load(p, __ATOMIC_RELAXED, __HIP_MEMORY_SCOPE_AGENT); }
DI unsigned xb_add(unsigned* p, unsigned v) { return __hip_atomic_fetch_add(p, v, __ATOMIC_RELAXED, __HIP_MEMORY_SCOPE_AGENT); }
DI unsigned xb_xcc_id() { return (unsigned)__builtin_amdgcn_s_getreg((3 << 11) | 20) & 0xFu; }
#define XB_SPIN(cond, bar) do { unsigned _sp = 0; while (cond) { __builtin_amdgcn_s_sleep(1); \
    if ((++_sp & 255u) == 0u) { if (xb_ld(&(bar)[XB_TMO])) break; if (_sp > XB_SPIN_CAP) { atomicAdd(&(bar)[XB_TMO], 1u); break; } } } } while (0)
struct XcdBarrier { unsigned* bar; unsigned x; volatile LAS unsigned* st; };
DI XcdBarrier xcd_barrier_post(unsigned* bar, volatile LAS unsigned* st) {
  XcdBarrier b; b.bar = bar; b.x = xb_xcc_id(); b.st = st;
  if (threadIdx.x == 0) (void)xb_add(&bar[XB_XCNT(b.x)], 1u);
  return b;
}
DI void xcd_barrier_complete(unsigned* bar, unsigned x, unsigned& nloc, unsigned& nx) {
  const unsigned G = gridDim.x * gridDim.y * gridDim.z;
  unsigned sum, cnt, mine, sp = 0u;
  for (;;) {
    sum = 0u; cnt = 0u; mine = 0u;
#pragma unroll
    for (unsigned j = 0; j < 16; ++j) { const unsigned c = xb_ld(&bar[XB_XCNT(j)]); sum += c; cnt += (c > 0u) ? 1u : 0u; mine = (j == x) ? c : mine; }
    if (sum == G) break;
    __builtin_amdgcn_s_sleep(1);
    if ((++sp & 255u) == 0u) { if (xb_ld(&bar[XB_TMO])) break; if (sp > XB_SPIN_CAP) { atomicAdd(&bar[XB_TMO], 1u); break; } }
  }
  nloc = mine > 0u ? mine : 1u; nx = cnt > 0u ? cnt : 1u;
}
DI void xcd_barrier(const XcdBarrier& b) {
  asm volatile("s_waitcnt vmcnt(0)" ::: "memory");
  __syncthreads();
  if (threadIdx.x == 0) {
    unsigned* bar = b.bar;
    __builtin_amdgcn_s_waitcnt(0);
    unsigned nloc = b.st[0], nx = b.st[1];
    if (nloc == 0u) { xcd_barrier_complete(bar, b.x, nloc, nx); b.st[0] = nloc; b.st[1] = nx; }
    const unsigned old = xb_add(&bar[XB_XSUB(b.x)], 1u);
    const unsigned gen = old / nloc;
    if (old + 1u == (gen + 1u) * nloc) {
      __builtin_amdgcn_fence(__ATOMIC_RELEASE, "agent");
      asm volatile("s_waitcnt vmcnt(0)" ::: "memory");
      const unsigned og = xb_add(&bar[XB_TOP], 1u);
      const unsigned tg = og / nx;
      if (og + 1u == (tg + 1u) * nx) xb_add(&bar[XB_TOPGEN], 1u);
      else XB_SPIN(xb_ld(&bar[XB_TOPGEN]) == tg, bar);
      __builtin_amdgcn_fence(__ATOMIC_ACQUIRE, "agent");
      xb_add(&bar[XB_XGEN(b.x)], 1u);
      asm volatile("s_waitcnt vmcnt(0)" ::: "memory");
    } else {
      XB_SPIN(xb_ld(&bar[XB_XGEN(b.x)]) == gen, bar);
      __builtin_amdgcn_fence(__ATOMIC_ACQUIRE, "agent");
      asm volatile("s_waitcnt vmcnt(0)" ::: "memory");
    }
  }
  __syncthreads();
}

#ifdef ONLY_PHASE
#define RUNPH(n, call) if (ONLY_PHASE == n) { call; }
#else
#ifndef DUP_PHASE
#define DUP_PHASE -1
#endif
#define RUNPH(n, call) if (lo <= n && n < hi) { call; if (n == DUP_PHASE) { xcd_barrier(xb); call; } if (n + 1 < hi) xcd_barrier(xb); }
#endif
__global__ void __launch_bounds__(256, 2) mega(Params p, int lo, int hi) {
  __shared__ __attribute__((aligned(16))) char smem[SMEM_BYTES];
  __shared__ uint4 xb_words;
  cg::grid_group grid = cg::this_grid();
  if (lo < 0) grid.sync();
  if (threadIdx.x == 0) xb_words = make_uint4(0u, 0u, 0u, 0u);
  __syncthreads();
  XcdBarrier xb = xcd_barrier_post((unsigned*)(p.ws + OFF_BAR), (volatile LAS unsigned*)&xb_words);
  RUNPH(0, phase0(p, smem))
  RUNPH(1, phase1(p, smem))
  RUNPH(2, phase2(p, smem))
  RUNPH(3, phase3(p, smem))
  RUNPH(4, phase4(p))
  RUNPH(5, phase5(p, smem))
  RUNPH(6, phase6(p, smem))
  RUNPH(7, phase7(p, smem))
  RUNPH(8, phase8(p, smem))
  RUNPH(9, phase9(p, smem))
  RUNPH(10, phase10(p, smem))
  RUNPH(11, phase11(p, smem))
  RUNPH(12, phase12(p, smem))
  RUNPH(13, phase13(p))
  RUNPH(14, phase14(p))
  RUNPH(15, phase15(p))
  RUNPH(16, phase16(p))
}

extern "C" void kernel_launch(void* const* d_in, const int* in_sizes, int n_in, void* d_out, int out_size, void* d_ws,
                              size_t ws_size, hipStream_t stream) {
  static int grid_blocks = 0;
  if (!grid_blocks) {
    int dev = 0, cus = 0, per_cu = 0;
    hipGetDevice(&dev);
    hipDeviceGetAttribute(&cus, hipDeviceAttributeMultiprocessorCount, dev);
    hipOccupancyMaxActiveBlocksPerMultiprocessor(&per_cu, mega, 256, 0);
    if (per_cu > 2) per_cu = 2;
    if (per_cu < 1) per_cu = 1;
    grid_blocks = cus * per_cu;
  }
  Params p{};
  const float** pp = (const float**)&p;
  for (int i = 0; i < 29; ++i) pp[i] = (const float*)d_in[i];
  p.out = (float*)d_out;
  p.ws = (char*)d_ws;
#if N_LAUNCH_SPLIT
  for (int ph = 0; ph < NPHASE; ++ph) {
    hipLaunchKernelGGL(mega, dim3(grid_blocks), dim3(256), 0, stream, p, ph, ph + 1);
  }
#else
  hipMemsetAsync((char*)d_ws + OFF_MOD, 0, (OFF_BAR - OFF_MOD) + XCD_BAR_WORDS * sizeof(unsigned), stream);
  int lo = 0, hi = NPHASE;
  void* args[] = {&p, &lo, &hi};
  hipError_t e = hipLaunchCooperativeKernel((void*)mega, dim3(grid_blocks), dim3(256), args, 0, stream);
  if (e != hipSuccess) fprintf(stderr, "cooperative launch failed: %s (grid %d)\n", hipGetErrorString(e), grid_blocks);
#endif
}
```

```cpp
#include <hip/hip_runtime.h>
#include <hip/hip_cooperative_groups.h>
#include <cstdio>
namespace cg = cooperative_groups;

#define DI __device__ __forceinline__
typedef unsigned short bf16_t;
using bf16x8 = __attribute__((ext_vector_type(8))) short;
using f32x4 = __attribute__((ext_vector_type(4))) float;
using u32x4 = __attribute__((ext_vector_type(4))) unsigned;
using u32x2 = __attribute__((ext_vector_type(2))) unsigned;

#ifndef N_LAUNCH_SPLIT
#define N_LAUNCH_SPLIT 0
#endif

constexpr int NTOK = 20480, NPT = 4096, DM = 1024;
constexpr int NPHASE = 17;
constexpr size_t MiB = 1u << 20;
constexpr size_t OFF_WINT = 0, OFF_WUQT = 9 * MiB, OFF_WUKVT = 9 * MiB + 512 * 1024, OFF_WUPAT = 10 * MiB,
                 OFF_WUPBT = 11 * MiB, OFF_WOT = 12 * MiB, OFF_WCT = 14 * MiB, OFF_WPQB = 18 * MiB,
                 OFF_KEYSB = 22 * MiB, OFF_MOD = 22 * MiB + 512 * 1024, OFF_BAR = 22 * MiB + 768 * 1024, OFF_ROPE = 23 * MiB, A0 = 24 * MiB;
constexpr size_t OFF_PD = A0 + 104 * MiB, OFF_H1 = A0 + 0, OFF_CQ = A0 + 40 * MiB, OFF_CKVRAW = A0 + 50 * MiB, OFF_KRRAW = A0 + 60 * MiB,
                 OFF_RQ = A0 + 63 * MiB, OFF_RK = A0 + 83 * MiB, OFF_KT = A0 + 103 * MiB, OFF_VT = A0 + 123 * MiB,
                 OFF_SRG = A0 + 143 * MiB, OFF_CKVALL = A0 + 163 * MiB, OFF_KRALL = A0 + 169 * MiB,
                 OFF_UF = A0 + 171 * MiB, OFF_UB = A0 + 187 * MiB,
                 OFF_SF = A0 + 0, OFF_SB = A0 + 8 * MiB, OFF_RET = A0 + 16 * MiB,
                 OFF_Q = A0 + 63 * MiB, OFF_KN = A0 + 93 * MiB, OFF_VTA = A0 + 117 * MiB, OFF_ATTN = A0 + 141 * MiB,
                 OFF_M = A0 + 163 * MiB,
                 OFF_H2 = A0 + 56 * MiB, OFF_TABU = A0 + 36 * MiB, OFF_TABV = A0 + 0, OFF_INVU = A0 + 52 * MiB,
                 OFF_INVV = A0 + 53 * MiB, OFF_ELIST = A0 + 16 * MiB, OFF_GLIST = A0 + 26 * MiB, OFF_SCORES = A0 + 104 * MiB;
constexpr size_t OUT_CKV = 20971520, OUT_KR = 21495808, OUT_SF = 21626880, OUT_SB = 22675456;
constexpr int NKV = 24576;
constexpr int SMEM_BYTES = 73728;

struct Params {
  const float *x_prompt, *x_sample, *c, *cache_ckv, *cache_krope, *st_f, *st_b, *c_ctx, *w_mod, *b_mod, *norm_mix,
      *norm_ffn, *norm_final, *w_in, *q_norm, *kv_norm, *w_uq, *w_ukv, *lg_f, *lg_b, *ret_gn, *w_up_a, *w_up_b, *w_o,
      *peer_wq, *keys1, *keys2, *peer_u, *peer_v;
  float* out;
  char* ws;
};

DI unsigned f2bf(float x) {
  unsigned u = __float_as_uint(x);
  u += 0x7fffu + ((u >> 16) & 1u);
  return u >> 16;
}
DI float bf2f(unsigned b) { return __uint_as_float(b << 16); }
typedef __bf16 hbf16x2_t __attribute__((ext_vector_type(2)));
typedef float hf32x2_t __attribute__((ext_vector_type(2)));
DI unsigned pack2(float a, float b) {
  hf32x2_t f = {a, b};
  return __builtin_bit_cast(unsigned, __builtin_convertvector(f, hbf16x2_t));
}
DI float ex2(float x) { return __builtin_amdgcn_exp2f(x); }
DI float bflo(unsigned u) { return __uint_as_float(u << 16); }
DI float bfhi(unsigned u) { return __uint_as_float(u & 0xffff0000u); }
DI float wsum(float v) {
#pragma unroll
  for (int o = 32; o > 0; o >>= 1) v += __shfl_xor(v, o);
  return v;
}
DI float sigmoidf_(float x) { return __builtin_amdgcn_rcpf(1.f + __builtin_amdgcn_exp2f(-1.4426950408889634f * x)); }
DI float siluf_(float x) { return x * __builtin_amdgcn_rcpf(1.f + __builtin_amdgcn_exp2f(-1.4426950408889634f * x)); }
DI float geluf_(float x) { return 0.5f * x * (1.f + tanhf(0.7978845608028654f * (x + 0.044715f * x * x * x))); }
DI const float* xrow(const Params& p, int tok) {
  return tok < NPT ? p.x_prompt + (size_t)tok * DM : p.x_sample + (size_t)(tok - NPT) * DM;
}
DI int modidx(int tok) { return tok < NPT ? 0 : 1 + ((tok - NPT) >> 11); }
DI int kvrow(int tok) {
  if (tok < NPT) return tok;
  int t = tok - NPT;
  return NPT + (t >> 11) * 2560 + (t & 2047);
}
DI void st_bf16x16(bf16_t* dst, const float (&v)[16]) {
  u32x4 a, b;
  a[0] = pack2(v[0], v[1]); a[1] = pack2(v[2], v[3]); a[2] = pack2(v[4], v[5]); a[3] = pack2(v[6], v[7]);
  b[0] = pack2(v[8], v[9]); b[1] = pack2(v[10], v[11]); b[2] = pack2(v[12], v[13]); b[3] = pack2(v[14], v[15]);
  *(u32x4*)dst = a;
  *(u32x4*)(dst + 8) = b;
}
DI void st_f32x16(float* dst, const float (&v)[16]) {
#pragma unroll
  for (int i = 0; i < 4; ++i) *(float4*)(dst + 4 * i) = make_float4(v[4 * i], v[4 * i + 1], v[4 * i + 2], v[4 * i + 3]);
}
DI void ld_bf16x16(const bf16_t* src, float (&v)[16]) {
  u32x4 a = *(const u32x4*)src, b = *(const u32x4*)(src + 8);
#pragma unroll
  for (int i = 0; i < 4; ++i) {
    v[2 * i] = bflo(a[i]); v[2 * i + 1] = bfhi(a[i]);
    v[8 + 2 * i] = bflo(b[i]); v[8 + 2 * i + 1] = bfhi(b[i]);
  }
}

constexpr int LDK = 64;
DI void gemm_issue0(const bf16_t* __restrict__ A, int lda, const bf16_t* __restrict__ B, int ldb, u32x4 (&ra)[4], u32x4 (&rb)[4]) {
  const int tid = threadIdx.x;
#pragma unroll
  for (int i = 0; i < 4; ++i) {
    const int c = tid + 256 * i;
    const int r = c >> 3, k8 = (c & 7) * 8;
    ra[i] = *(const u32x4*)(A + (size_t)r * lda + k8);
    rb[i] = *(const u32x4*)(B + (size_t)r * ldb + k8);
  }
}
template <int SCALE>
DI void gemm_kloop_pre(f32x4 (&acc)[4][4], const bf16_t* __restrict__ A, int lda, const bf16_t* __restrict__ B, int ldb,
                       int K, char* smem, float sc_a, float sc_b, u32x4 (&ra)[4], u32x4 (&rb)[4]) {
  bf16_t* As = (bf16_t*)smem;
  bf16_t* Bs = As + 128 * LDK;
  const int tid = threadIdx.x, lane = tid & 63, w = tid >> 6, wm = w >> 1, wn = w & 1, l15 = lane & 15, g = lane >> 4;
  int arow[4], kc[4], ldsa[4], ldsb[4];
#pragma unroll
  for (int i = 0; i < 4; ++i) {
    int c = tid + 256 * i;
    int r = c >> 3;
    kc[i] = (c & 7) * 8;
    arow[i] = r;
    int rr = r & 63;
    int rho = (r & 64) | (((rr >> 2) & 3) << 4) | ((rr >> 4) << 2) | (rr & 3);
    ldsa[i] = rho * LDK + (((c & 7) ^ ((rho >> 1) & 7)) * 8);
    ldsb[i] = r * LDK + (((c & 7) ^ ((r >> 1) & 7)) * 8);
  }
  __syncthreads();
#pragma unroll
  for (int i = 0; i < 4; ++i) {
    *(u32x4*)(As + ldsa[i]) = ra[i];
    *(u32x4*)(Bs + ldsb[i]) = rb[i];
  }
  if (64 < K) {
#pragma unroll
    for (int i = 0; i < 4; ++i) {
      ra[i] = *(const u32x4*)(A + (size_t)arow[i] * lda + 64 + kc[i]);
      rb[i] = *(const u32x4*)(B + (size_t)arow[i] * ldb + 64 + kc[i]);
    }
  }
  __syncthreads();
  int buf = 0;
  for (int k0 = 0; k0 < K; k0 += 64, buf ^= 1) {
    const bf16_t* Ac = As + buf * (256 * LDK);
    const bf16_t* Bc = Bs + buf * (256 * LDK);
#pragma unroll
    for (int ks = 0; ks < 2; ++ks) {
      bf16x8 af[4], bfr[4];
#pragma unroll
      for (int f = 0; f < 4; ++f)
        af[f] = *(const bf16x8*)(Ac + (wm * 64 + f * 16 + l15) * LDK + (((ks * 4 + g) ^ (l15 >> 1)) * 8));
#pragma unroll
      for (int c = 0; c < 4; ++c)
        bfr[c] = *(const bf16x8*)(Bc + (wn * 64 + c * 16 + l15) * LDK + (((ks * 4 + g) ^ (l15 >> 1)) * 8));
      if (SCALE) {
        float fac[8];
#pragma unroll
        for (int i = 0; i < 8; ++i) fac[i] = ex2(sc_a + sc_b * (float)(k0 + ks * 32 + g * 8 + i));
#pragma unroll
        for (int f = 0; f < 4; ++f) {
          u32x4 u = __builtin_bit_cast(u32x4, af[f]);
#pragma unroll
          for (int i = 0; i < 4; ++i) u[i] = pack2(bflo(u[i]) * fac[2 * i], bfhi(u[i]) * fac[2 * i + 1]);
          af[f] = __builtin_bit_cast(bf16x8, u);
        }
      }
#pragma unroll
      for (int f = 0; f < 4; ++f)
#pragma unroll
        for (int c = 0; c < 4; ++c) acc[f][c] = __builtin_amdgcn_mfma_f32_16x16x32_bf16(af[f], bfr[c], acc[f][c], 0, 0, 0);
    }
    if (k0 + 64 < K) {
      bf16_t* An = As + (buf ^ 1) * (256 * LDK);
      bf16_t* Bn = Bs + (buf ^ 1) * (256 * LDK);
#pragma unroll
      for (int i = 0; i < 4; ++i) {
        *(u32x4*)(An + ldsa[i]) = ra[i];
        *(u32x4*)(Bn + ldsb[i]) = rb[i];
      }
      if (k0 + 128 < K) {
#pragma unroll
        for (int i = 0; i < 4; ++i) {
          ra[i] = *(const u32x4*)(A + (size_t)arow[i] * lda + k0 + 128 + kc[i]);
          rb[i] = *(const u32x4*)(B + (size_t)arow[i] * ldb + k0 + 128 + kc[i]);
        }
      }
      __syncthreads();
    }
  }
}
template <int SCALE>
DI void gemm_kloop(f32x4 (&acc)[4][4], const bf16_t* __restrict__ A, int lda, const bf16_t* __restrict__ B, int ldb,
                   int K, char* smem, float sc_a, float sc_b) {
  u32x4 ra[4], rb[4];
  gemm_issue0(A, lda, B, ldb, ra, rb);
  gemm_kloop_pre<SCALE>(acc, A, lda, B, ldb, K, smem, sc_a, sc_b, ra, rb);
}
DI void acc_zero(f32x4 (&acc)[4][4]) {
#pragma unroll
  for (int f = 0; f < 4; ++f)
#pragma unroll
    for (int c = 0; c < 4; ++c) acc[f][c] = f32x4{0.f, 0.f, 0.f, 0.f};
}
template <class F>
DI void epilogue(const f32x4 (&acc)[4][4], F&& epi) {
  const int tid = threadIdx.x, lane = tid & 63, w = tid >> 6, wm = w >> 1, wn = w & 1, l15 = lane & 15, g = lane >> 4;
#pragma unroll
  for (int c = 0; c < 4; ++c) {
    float v[16];
#pragma unroll
    for (int f = 0; f < 4; ++f)
#pragma unroll
      for (int j = 0; j < 4; ++j) v[f * 4 + j] = acc[f][c][j];
    epi(wm * 64 + 16 * g, wn * 64 + c * 16 + l15, v);
  }
}
DI bool tile_map(int it, int Ft, int Tt, int fsplit, int& ft, int& tt) {
  const int bid = blockIdx.x, nb = gridDim.x;
  int xcd = bid & 7, loc = bid >> 3, nloc = nb >> 3;
  if (loc >= nloc) return false;
  int fg = xcd % fsplit, tg = xcd / fsplit, tsplit = 8 / fsplit;
  int Fg = Ft / fsplit, Tg = Tt / tsplit;
  int i = loc + it * nloc;
  if (i >= Fg * Tg) return false;
  ft = fg * Fg + i % Fg;
  tt = tg * Tg + i / Fg;
  return true;
}
DI int vbid() {
  const int bid = blockIdx.x, nb = gridDim.x;
  if (nb & 7) return bid;
  return (bid & 7) * (nb >> 3) + (bid >> 3);
}

DI int colmap(int mode, int np) {
  if (mode == 1) return np < 416 ? np : (np < 512 ? -1 : np - 96);
  if (mode == 2) return np < 512 ? ((np >> 6) * 128 + (np & 63)) : (((np - 512) >> 6) * 128 + 64 + ((np - 512) & 63));
  return np;
}
DI void tconv_tile(const float* __restrict__ src, int ldsrc, bf16_t* __restrict__ dst, int K, int kt, int nt, int mode,
                   char* smem) {
  float* lds = (float*)smem;
  const int tid = threadIdx.x;
  {
    int col = tid & 63, rq = tid >> 6;
    int n = colmap(mode, nt * 64 + col);
#pragma unroll 4
    for (int r = 0; r < 16; ++r) {
      int kl = r * 4 + rq;
      float v = n >= 0 ? src[(size_t)(kt * 64 + kl) * ldsrc + n] : 0.f;
      lds[kl * 65 + col] = v;
    }
  }
  __syncthreads();
  {
    int nl = tid >> 2, kq = (tid & 3) * 16;
    float v[16];
#pragma unroll
    for (int i = 0; i < 16; ++i) v[i] = lds[(kq + i) * 65 + nl];
    st_bf16x16(dst + (size_t)(nt * 64 + nl) * K + kt * 64 + kq, v);
  }
  __syncthreads();
}
DI void mod_item(const Params& p, int item, char* smem) {
  float* sil = (float*)smem;
  const int tid = threadIdx.x;
  const int cg_ = item >> 2, slab = item & 3, kbase = slab * 256;
  for (int i = tid; i < 9 * 256; i += 256) {
    int j = i >> 8, k = kbase + (i & 255);
    float cv = j == 0 ? p.c_ctx[k] : p.c[(j - 1) * 1024 + k];
    sil[i] = siluf_(cv);
  }
  __syncthreads();
  const int kq = tid >> 6, nn = tid & 63, n0 = cg_ * 64;
  float acc[9];
#pragma unroll
  for (int j = 0; j < 9; ++j) acc[j] = 0.f;
#pragma unroll 1
  for (int i0 = 0; i0 < 64; i0 += 16) {
    float wv[16];
#pragma unroll
    for (int i = 0; i < 16; ++i) wv[i] = p.w_mod[(size_t)(kbase + kq + 4 * (i0 + i)) * 6144 + n0 + nn];
#pragma unroll
    for (int i = 0; i < 16; ++i)
#pragma unroll
      for (int j = 0; j < 9; ++j) acc[j] += sil[j * 256 + kq + 4 * (i0 + i)] * wv[i];
  }
  __syncthreads();
  float* part = (float*)smem + 9 * 256;
#pragma unroll
  for (int j = 0; j < 9; ++j) part[(kq * 9 + j) * 64 + nn] = acc[j];
  __syncthreads();
  float* mod = (float*)(p.ws + OFF_MOD);
  for (int i = tid; i < 9 * 64; i += 256) {
    int j = i >> 6, n = i & 63;
    float s = part[(0 * 9 + j) * 64 + n] + part[(1 * 9 + j) * 64 + n] + part[(2 * 9 + j) * 64 + n] + part[(3 * 9 + j) * 64 + n];
    if (slab == 0) s += p.b_mod[n0 + n];
    atomicAdd(mod + j * 6144 + n0 + n, s);
  }
  __syncthreads();
}
DI void conv_flat(const float* __restrict__ src, bf16_t* __restrict__ dst, size_t n) {
  size_t i = ((size_t)blockIdx.x * 256 + threadIdx.x) * 8;
  const size_t stride = (size_t)gridDim.x * 256 * 8;
  for (; i < n; i += stride) {
    float4 a = *(const float4*)(src + i), b = *(const float4*)(src + i + 4);
    u32x4 o;
    o[0] = pack2(a.x, a.y); o[1] = pack2(a.z, a.w); o[2] = pack2(b.x, b.y); o[3] = pack2(b.z, b.w);
    *(u32x4*)(dst + i) = o;
  }
}
DI void phase0(const Params& p, char* smem) {
  const int bid = blockIdx.x, nb = gridDim.x;
  char* ws = p.ws;
  const int n_mod = 384;
  const int t_in = 16 * 72, t_uq = 4 * 12, t_ukv = 2 * 16, t_upa = 8 * 16, t_upb = 8 * 16, t_o = 16 * 16;
  const int total = n_mod + t_in + t_uq + t_ukv + t_upa + t_upb + t_o;
  for (int it = bid; it < total; it += nb) {
    int i = it;
    if (i < n_mod) { mod_item(p, i, smem); continue; }
    i -= n_mod;
    if (i < t_in) { tconv_tile(p.w_in, 4512, (bf16_t*)(ws + OFF_WINT), 1024, i / 72, i % 72, 1, smem); continue; }
    i -= t_in;
    if (i < t_uq) { tconv_tile(p.w_uq, 768, (bf16_t*)(ws + OFF_WUQT), 256, i / 12, i % 12, 0, smem); continue; }
    i -= t_uq;
    if (i < t_ukv) { tconv_tile(p.w_ukv, 1024, (bf16_t*)(ws + OFF_WUKVT), 128, i / 16, i % 16, 2, smem); continue; }
    i -= t_ukv;
    if (i < t_upa) { tconv_tile(p.w_up_a, 1024, (bf16_t*)(ws + OFF_WUPAT), 512, i / 16, i % 16, 0, smem); continue; }
    i -= t_upa;
    if (i < t_upb) { tconv_tile(p.w_up_b, 1024, (bf16_t*)(ws + OFF_WUPBT), 512, i / 16, i % 16, 0, smem); continue; }
    i -= t_upb;
    tconv_tile(p.w_o, 1024, (bf16_t*)(ws + OFF_WOT), 1024, i / 16, i % 16, 0, smem);
  }
  conv_flat(p.peer_wq, (bf16_t*)(ws + OFF_WPQB), (size_t)1024 * 2048);
  {
    size_t i = ((size_t)bid * 256 + threadIdx.x) * 8;
    const size_t stride = (size_t)nb * 256 * 8;
    bf16_t* kb = (bf16_t*)(ws + OFF_KEYSB);
    for (; i < (size_t)2 * 131072; i += stride) {
      int half = i >= 131072;
      size_t s = i - (size_t)half * 131072;
      int h = (int)(s >> 14);
      size_t r = s & 16383;
      const float* src = (half ? p.keys2 : p.keys1) + s;
      float4 a = *(const float4*)(src), b = *(const float4*)(src + 4);
      u32x4 o;
      o[0] = pack2(a.x, a.y); o[1] = pack2(a.z, a.w); o[2] = pack2(b.x, b.y); o[3] = pack2(b.z, b.w);
      *(u32x4*)(kb + ((size_t)(h * 2 + half) << 14) + r) = o;
    }
  }
  {
    float2* rope = (float2*)(ws + OFF_ROPE);
    for (int idx = bid * 256 + threadIdx.x; idx < 2048 * 16; idx += nb * 256) {
      const int t = idx >> 4, a = idx & 15;
      const float pos = (a < 8) ? (float)(t >> 6) : (float)(t & 63);
      const float fr = exp2f(-(float)(a & 7) * 1.6609640474436813f);
      float sn, cs;
      sincosf(pos * fr, &sn, &cs);
      rope[idx] = make_float2(cs, sn);
    }
  }
}

DI void rows_norm_mod(const Params& p, const float* nw, int sh_off, int sc_off, bool from_out, bf16_t* dst) {
  const int lane = threadIdx.x & 63, w = threadIdx.x >> 6;
  const float* mod = (const float*)(p.ws + OFF_MOD);
  for (int tok = blockIdx.x * 4 + w; tok < NTOK; tok += gridDim.x * 4) {
    const float* xr = from_out ? p.out + (size_t)tok * DM : xrow(p, tok);
    const float* mj = mod + modidx(tok) * 6144;
    float4 xv[4];
    float ss = 0.f;
#pragma unroll
    for (int i = 0; i < 4; ++i) {
      xv[i] = *(const float4*)(xr + (i * 64 + lane) * 4);
      ss += xv[i].x * xv[i].x + xv[i].y * xv[i].y + xv[i].z * xv[i].z + xv[i].w * xv[i].w;
    }
    ss = wsum(ss);
    float rstd = rsqrtf(ss * (1.f / 1024.f) + 1e-6f);
#pragma unroll
    for (int i = 0; i < 4; ++i) {
      int e = (i * 64 + lane) * 4;
      float4 nv = *(const float4*)(nw + e), sh = *(const float4*)(mj + sh_off + e), sc = *(const float4*)(mj + sc_off + e);
      float h0 = (xv[i].x * rstd) * nv.x * (1.f + sc.x) + sh.x;
      float h1 = (xv[i].y * rstd) * nv.y * (1.f + sc.y) + sh.y;
      float h2 = (xv[i].z * rstd) * nv.z * (1.f + sc.z) + sh.z;
      float h3 = (xv[i].w * rstd) * nv.w * (1.f + sc.w) + sh.w;
      u32x2 o;
      o[0] = pack2(h0, h1); o[1] = pack2(h2, h3);
      *(u32x2*)(dst + (size_t)tok * DM + e) = o;
    }
  }
}
DI void phase1(const Params& p, char* smem) {
  rows_norm_mod(p, p.norm_mix, 0, 1024, false, (bf16_t*)(p.ws + OFF_H1));
  const bf16_t* wpq = (const bf16_t*)(p.ws + OFF_WPQB);
  const bf16_t* kb = (const bf16_t*)(p.ws + OFF_KEYSB);
  bf16_t* wct = (bf16_t*)(p.ws + OFF_WCT);
  for (int it = blockIdx.x; it < 128; it += gridDim.x) {
    int hh = it >> 3, mt = it & 7;
    f32x4 acc[4][4];
    acc_zero(acc);
    gemm_kloop<0>(acc, wpq + (size_t)(mt * 128) * 2048 + hh * 128, 2048, kb + (size_t)hh * 16384, 128, 128, smem, 0.f, 0.f);
    epilogue(acc, [&](int m, int n, float (&v)[16]) { st_bf16x16(wct + (size_t)(hh * 128 + n) * 1024 + mt * 128 + m, v); });
  }
}

DI void phase2(const Params& p, char* smem) {
  char* ws = p.ws;
  const bf16_t* winT = (const bf16_t*)(ws + OFF_WINT);
  const bf16_t* h1 = (const bf16_t*)(ws + OFF_H1);
  bf16_t* cq = (bf16_t*)(ws + OFF_CQ);
  float* ckvraw = (float*)(ws + OFF_CKVRAW);
  float* krraw = (float*)(ws + OFF_KRRAW);
  bf16_t* rq = (bf16_t*)(ws + OFF_RQ);
  bf16_t* rk = (bf16_t*)(ws + OFF_RK);
  bf16_t* kT = (bf16_t*)(ws + OFF_KT);
  bf16_t* vT = (bf16_t*)(ws + OFF_VT);
  bf16_t* srg = (bf16_t*)(ws + OFF_SRG);
  bf16_t* sga = (bf16_t*)p.out;
  bf16_t* sgb = sga + (size_t)NTOK * 1024;
  u32x4 pra[4], prb[4];
  int ft, tt;
  bool have = tile_map(0, 36, 160, 4, ft, tt);
  if (have) {
    const bf16_t* W0 = winT + (size_t)ft * 128 * 1024;
    const bf16_t* H0 = h1 + (size_t)tt * 128 * 1024;
    const bool sw = ft >= 8 && ft < 16;
    gemm_issue0(sw ? H0 : W0, 1024, sw ? W0 : H0, 1024, pra, prb);
  }
  for (int it = 0; have; ++it) {
    f32x4 acc[4][4];
    acc_zero(acc);
    const bf16_t* W = winT + (size_t)ft * 128 * 1024;
    const bf16_t* H = h1 + (size_t)tt * 128 * 1024;
    const int tok0 = tt * 128, f0 = ft * 128;
    const bool swp = ft >= 8 && ft < 16;
    gemm_kloop_pre<0>(acc, swp ? H : W, 1024, swp ? W : H, 1024, 1024, smem, 0.f, 0.f, pra, prb);
    int ft2 = 0, tt2 = 0;
    const bool have2 = tile_map(it + 1, 36, 160, 4, ft2, tt2);
    if (have2) {
      const bf16_t* W2 = winT + (size_t)ft2 * 128 * 1024;
      const bf16_t* H2 = h1 + (size_t)tt2 * 128 * 1024;
      const bool sw2 = ft2 >= 8 && ft2 < 16;
      gemm_issue0(sw2 ? H2 : W2, 1024, sw2 ? W2 : H2, 1024, pra, prb);
    }
    if (ft >= 8 && ft < 16) {
      if (ft < 12) {
        epilogue(acc, [&](int m, int n, float (&v)[16]) {
          int feat = f0 - 1024 + n, tok = tok0 + m;
#pragma unroll
          for (int i = 0; i < 16; ++i) v[i] *= 0.08838834764831845f;
          st_bf16x16(kT + (size_t)feat * NTOK + tok, v);
#pragma unroll
          for (int i = 0; i < 16; ++i) rk[(size_t)(tok + i) * 512 + feat] = (bf16_t)f2bf(v[i]);
        });
      } else {
        epilogue(acc, [&](int m, int n, float (&v)[16]) {
          int feat = f0 - 1536 + n, tok = tok0 + m;
          st_bf16x16(vT + (size_t)feat * NTOK + tok, v);
        });
      }
    } else {
      if (ft < 2) {
        epilogue(acc, [&](int m, int n, float (&v)[16]) { st_bf16x16(cq + (size_t)(tok0 + n) * 256 + f0 + m, v); });
      } else if (ft == 2) {
        epilogue(acc, [&](int m, int n, float (&v)[16]) { st_f32x16(ckvraw + (size_t)(tok0 + n) * 128 + m, v); });
      } else if (ft == 3) {
        epilogue(acc, [&](int m, int n, float (&v)[16]) {
          if (m < 32) st_f32x16(krraw + (size_t)(tok0 + n) * 32 + m, v);
        });
      } else if (ft < 8) {
        epilogue(acc, [&](int m, int n, float (&v)[16]) { st_bf16x16(rq + (size_t)(tok0 + n) * 512 + f0 - 512 + m, v); });
      } else if (ft < 20) {
        epilogue(acc, [&](int m, int n, float (&v)[16]) {
#pragma unroll
          for (int i = 0; i < 16; ++i) v[i] = siluf_(v[i]);
          st_bf16x16(srg + (size_t)(tok0 + n) * 512 + f0 - 2048 + m, v);
        });
      } else if (ft < 28) {
        epilogue(acc, [&](int m, int n, float (&v)[16]) {
#pragma unroll
          for (int i = 0; i < 16; ++i) v[i] = sigmoidf_(v[i]);
          st_bf16x16(sga + (size_t)(tok0 + n) * 1024 + f0 - 2560 + m, v);
        });
      } else {
        epilogue(acc, [&](int m, int n, float (&v)[16]) {
#pragma unroll
          for (int i = 0; i < 16; ++i) v[i] = sigmoidf_(v[i]);
          st_bf16x16(sgb + (size_t)(tok0 + n) * 1024 + f0 - 3584 + m, v);
        });
      }
    }
    ft = ft2; tt = tt2; have = have2;
  }
}

DI float log2gamma(float logit) { return -log1pf(expf(-logit)) * 1.4426950408889634f; }
DI void phase3(const Params& p, char* smem) {
  char* ws = p.ws;
  const int lane = threadIdx.x & 63, w = threadIdx.x >> 6;
  bf16_t* cq = (bf16_t*)(ws + OFF_CQ);
  const float* ckvraw = (const float*)(ws + OFF_CKVRAW);
  const float* krraw = (const float*)(ws + OFF_KRRAW);
  bf16_t* ckvall = (bf16_t*)(ws + OFF_CKVALL);
  bf16_t* krall = (bf16_t*)(ws + OFF_KRALL);
  for (int r = blockIdx.x * 4 + w; r < NTOK + 4096; r += gridDim.x * 4) {
    if (r < NTOK) {
      const int tok = r;
      {
        u32x2 u = *(const u32x2*)(cq + (size_t)tok * 256 + lane * 4);
        float a0 = bflo(u[0]), a1 = bfhi(u[0]), a2 = bflo(u[1]), a3 = bfhi(u[1]);
        float ss = wsum(a0 * a0 + a1 * a1 + a2 * a2 + a3 * a3);
        float rstd = rsqrtf(ss * (1.f / 256.f) + 1e-6f);
        float4 nq = *(const float4*)(p.q_norm + lane * 4);
        u32x2 o;
        o[0] = pack2(a0 * rstd * nq.x, a1 * rstd * nq.y);
        o[1] = pack2(a2 * rstd * nq.z, a3 * rstd * nq.w);
        *(u32x2*)(cq + (size_t)tok * 256 + lane * 4) = o;
      }
      const int row = kvrow(tok);
      {
        float2 v = *(const float2*)(ckvraw + (size_t)tok * 128 + lane * 2);
        float ss = wsum(v.x * v.x + v.y * v.y);
        float rstd = rsqrtf(ss * (1.f / 128.f) + 1e-6f);
        float2 nk = *(const float2*)(p.kv_norm + lane * 2);
        float o0 = v.x * rstd * nk.x, o1 = v.y * rstd * nk.y;
        if (tok < NPT) *(float2*)(p.out + OUT_CKV + (size_t)tok * 128 + lane * 2) = make_float2(o0, o1);
        *(unsigned*)(ckvall + (size_t)row * 128 + lane * 2) = pack2(o0, o1);
      }
      if (lane < 32) {
        float own = krraw[(size_t)tok * 32 + lane];
        float o = own;
        if (tok < NPT) {
          p.out[OUT_KR + (size_t)tok * 32 + lane] = own;
        } else {
          float partner = krraw[(size_t)tok * 32 + (lane ^ 16)];
          int t = (tok - NPT) & 2047;
          const float2 csn = ((const float2*)(ws + OFF_ROPE))[t * 16 + (lane & 15)];
          const float cs = csn.x, sn = csn.y;
          o = lane < 16 ? own * cs - partner * sn : partner * sn + own * cs;
        }
        krall[(size_t)row * 32 + lane] = (bf16_t)f2bf(o);
      }
    } else {
      const int cr = r - NTOK;
      const int b = cr >> 9, pos = cr & 511;
      const int row = NPT + b * 2560 + 2048 + pos;
      float2 v = *(const float2*)(p.cache_ckv + (size_t)cr * 128 + lane * 2);
      *(unsigned*)(ckvall + (size_t)row * 128 + lane * 2) = pack2(v.x, v.y);
      if (lane < 32) krall[(size_t)row * 32 + lane] = (bf16_t)f2bf(p.cache_krope[(size_t)cr * 32 + lane]);
    }
  }
  const bf16_t* kT = (const bf16_t*)(ws + OFF_KT);
  const bf16_t* vT = (const bf16_t*)(ws + OFF_VT);
  float* Uf = (float*)(ws + OFF_UF);
  float* Ub = (float*)(ws + OFF_UB);
  for (int it = blockIdx.x; it < 320; it += gridDim.x) {
    const int blk = it >> 2, h = it & 3;
    const float l2f = log2gamma(p.lg_f[h]), l2b = log2gamma(p.lg_b[h]);
    const bf16_t* Kp = kT + (size_t)(h * 128) * NTOK + blk * 256;
    const bf16_t* Vp = vT + (size_t)(h * 128) * NTOK + blk * 256;
#pragma unroll 1
    for (int dir = 0; dir < 2; ++dir) {
      const float sa = dir ? 0.f : l2f * 255.f, sb = dir ? l2b : -l2f;
      f32x4 acc[4][4];
      acc_zero(acc);
      if (blk < 16) {
        gemm_kloop<1>(acc, Vp, NTOK, Kp, NTOK, 256, smem, sa, sb);
        float* dst = p.out + (dir ? OUT_SB : OUT_SF) + (size_t)(blk * 4 + h) * 16384;
        epilogue(acc, [&](int m, int n, float (&v)[16]) { st_f32x16(dst + n * 128 + m, v); });
      } else {
        gemm_kloop<1>(acc, Kp, NTOK, Vp, NTOK, 256, smem, sa, sb);
        float* dst = (dir ? Ub : Uf) + (size_t)((blk - 16) * 4 + h) * 16384;
        epilogue(acc, [&](int m, int n, float (&v)[16]) { st_f32x16(dst + n * 128 + m, v); });
      }
    }
  }
}

DI void phase4(const Params& p) {
  char* ws = p.ws;
  const float* Uf = (const float*)(ws + OFF_UF);
  const float* Ub = (const float*)(ws + OFF_UB);
  bf16_t* Sf = (bf16_t*)(ws + OFF_SF);
  bf16_t* Sb = (bf16_t*)(ws + OFF_SB);
  for (int idx = blockIdx.x * 256 + threadIdx.x; idx < (1 << 20); idx += gridDim.x * 256) {
    int d = idx & 127, e = (idx >> 7) & 127, h = (idx >> 14) & 3, b = (idx >> 16) & 7, dir = idx >> 19;
    size_t eo = (size_t)e * 128 + d;
    if (dir == 0) {
      float cf = exp2f(log2gamma(p.lg_f[h]) * 256.f);
      float S = p.st_f[(size_t)(b * 4 + h) * 16384 + d * 128 + e];
#pragma unroll
      for (int blk = 0; blk < 8; ++blk) {
        size_t o = (size_t)((b * 8 + blk) * 4 + h) * 16384 + eo;
        Sf[o] = (bf16_t)f2bf(S);
        S = cf * S + Uf[o];
      }
    } else {
      float cb = exp2f(log2gamma(p.lg_b[h]) * 256.f);
      float S = p.st_b[(size_t)(b * 4 + h) * 16384 + d * 128 + e];
#pragma unroll
      for (int blk = 7; blk >= 0; --blk) {
        size_t o = (size_t)((b * 8 + blk) * 4 + h) * 16384 + eo;
        Sb[o] = (bf16_t)f2bf(S);
        S = cb * S + Ub[o];
      }
    }
  }
}

DI bf16x8 scale_frag(bf16x8 q, float s) {
  u32x4 u = __builtin_bit_cast(u32x4, q);
#pragma unroll
  for (int i = 0; i < 4; ++i) u[i] = pack2(bflo(u[i]) * s, bfhi(u[i]) * s);
  return __builtin_bit_cast(bf16x8, u);
}
constexpr int NQT = 1;
DI void phase5(const Params& p, char* smem) {
  char* ws = p.ws;
  const bf16_t* rq = (const bf16_t*)(ws + OFF_RQ);
  const bf16_t* rk = (const bf16_t*)(ws + OFF_RK);
  const bf16_t* vT = (const bf16_t*)(ws + OFF_VT);
  const bf16_t* srg = (const bf16_t*)(ws + OFF_SRG);
  const bf16_t* Sf = (const bf16_t*)(ws + OFF_SF);
  const bf16_t* Sb = (const bf16_t*)(ws + OFF_SB);
  bf16_t* ret = (bf16_t*)(ws + OFF_RET);
  bf16_t* Ks0 = (bf16_t*)smem;
  const int tid = threadIdx.x, lane = tid & 63, w = tid >> 6, l15 = lane & 15, g = lane >> 4;
  for (int item = vbid(); item < 640 * (2 / NQT); item += gridDim.x) {
    const int qb = item >> 2, h = item & 3, blk = (qb * NQT) >> 2;
    const float l2f = log2gamma(p.lg_f[h]), l2b = log2gamma(p.lg_b[h]);
    const int tokw = qb * (64 * NQT) + w * (16 * NQT);
    bf16x8 Q[NQT][4];
#pragma unroll
    for (int qt = 0; qt < NQT; ++qt)
#pragma unroll
      for (int ks = 0; ks < 4; ++ks)
        Q[qt][ks] = *(const bf16x8*)(rq + (size_t)(tokw + qt * 16 + l15) * 512 + h * 128 + ks * 32 + g * 8);
    f32x4 o[8][NQT];
#pragma unroll
    for (int et = 0; et < 8; ++et)
#pragma unroll
      for (int qt = 0; qt < NQT; ++qt) o[et][qt] = f32x4{0.f, 0.f, 0.f, 0.f};
    u32x4 rk_[4], rv_[4];
    auto gload = [&](int kt) {
      const int key0 = blk * 256 + kt * 64;
#pragma unroll
      for (int i = 0; i < 4; ++i) {
        int c = tid + 256 * i;
        int r = c >> 4, cc = (c & 15) * 8;
        rk_[i] = *(const u32x4*)(rk + (size_t)(key0 + r) * 512 + h * 128 + cc);
        int e = c >> 3, c2 = (c & 7) * 8;
        rv_[i] = *(const u32x4*)(vT + (size_t)(h * 128 + e) * NTOK + key0 + c2);
      }
    };
    auto lstore = [&](int b_) {
      bf16_t* Kd = Ks0 + b_ * 18432;
      bf16_t* Vd = Kd + 64 * 144;
#pragma unroll
      for (int i = 0; i < 4; ++i) {
        int c = tid + 256 * i;
        int r = c >> 4, cc = (c & 15) * 8;
        *(u32x4*)(Kd + r * 144 + cc) = rk_[i];
        int e = c >> 3, c2 = (c & 7) * 8;
        *(u32x4*)(Vd + e * 72 + c2) = rv_[i];
      }
    };
    gload(0);
    __syncthreads();
    lstore(0);
    gload(1);
    __syncthreads();
#pragma unroll 1
    for (int kt = 0; kt < 4; ++kt) {
      const bf16_t* Ks = Ks0 + (kt & 1) * 18432;
      const bf16_t* Vs = Ks + 64 * 144;
      bf16x8 P[NQT][2];
#pragma unroll
      for (int qt = 0; qt < NQT; ++qt) {
        f32x4 s[4];
#pragma unroll
        for (int kk = 0; kk < 4; ++kk) s[kk] = f32x4{0.f, 0.f, 0.f, 0.f};
#pragma unroll
        for (int ks = 0; ks < 4; ++ks) {
#pragma unroll
          for (int kk = 0; kk < 4; ++kk) {
            bf16x8 a = *(const bf16x8*)(Ks + (kk * 16 + l15) * 144 + ks * 32 + g * 8);
            s[kk] = __builtin_amdgcn_mfma_f32_16x16x32_bf16(a, Q[qt][ks], s[kk], 0, 0, 0);
          }
        }
        const int iq = (tokw + qt * 16 + l15) & 255;
#pragma unroll
        for (int kk = 0; kk < 4; ++kk) {
#pragma unroll
          for (int j = 0; j < 4; ++j) {
            int jk = kt * 64 + kk * 16 + 4 * g + j;
            int diff = iq - jk;
            float dm = diff > 0 ? ex2(l2f * (float)diff) : (diff < 0 ? ex2(l2b * (float)(-diff)) : 2.f);
            s[kk][j] *= dm;
          }
        }
#pragma unroll
        for (int k2 = 0; k2 < 2; ++k2) {
          u32x4 u;
          u[0] = pack2(s[2 * k2][0], s[2 * k2][1]);
          u[1] = pack2(s[2 * k2][2], s[2 * k2][3]);
          u[2] = pack2(s[2 * k2 + 1][0], s[2 * k2 + 1][1]);
          u[3] = pack2(s[2 * k2 + 1][2], s[2 * k2 + 1][3]);
          P[qt][k2] = __builtin_bit_cast(bf16x8, u);
        }
      }
#pragma unroll
      for (int k2 = 0; k2 < 2; ++k2) {
#pragma unroll
        for (int et = 0; et < 8; ++et) {
          u32x2 lo = *(const u32x2*)(Vs + (et * 16 + l15) * 72 + k2 * 32 + 4 * g);
          u32x2 hi = *(const u32x2*)(Vs + (et * 16 + l15) * 72 + k2 * 32 + 16 + 4 * g);
          u32x4 u;
          u[0] = lo[0]; u[1] = lo[1]; u[2] = hi[0]; u[3] = hi[1];
          bf16x8 a = __builtin_bit_cast(bf16x8, u);
#pragma unroll
          for (int qt = 0; qt < NQT; ++qt) o[et][qt] = __builtin_amdgcn_mfma_f32_16x16x32_bf16(a, P[qt][k2], o[et][qt], 0, 0, 0);
        }
      }
      if (kt + 1 < 4) {
        lstore((kt + 1) & 1);
        if (kt + 2 < 4) gload(kt + 2);
        __syncthreads();
      }
    }
    if (blk >= 16) {
      bf16_t* SL = (bf16_t*)smem;
      __syncthreads();
#pragma unroll
      for (int dir = 0; dir < 2; ++dir) {
        const bf16_t* S = (dir ? Sb : Sf) + (size_t)((blk - 16) * 4 + h) * 16384;
#pragma unroll
        for (int i = 0; i < 8; ++i) {
          int c = tid + 256 * i;
          int e = c >> 4, cc = (c & 15) * 8;
          *(u32x4*)(SL + dir * (128 * 144) + e * 144 + cc) = *(const u32x4*)(S + e * 128 + cc);
        }
      }
      __syncthreads();
#pragma unroll 1
      for (int dir = 0; dir < 2; ++dir) {
        const bf16_t* S = SL + dir * (128 * 144);
        float dq[NQT];
#pragma unroll
        for (int qt = 0; qt < NQT; ++qt) {
          int iq = (tokw + qt * 16 + l15) & 255;
          dq[qt] = dir ? exp2f(l2b * (float)(256 - iq)) : exp2f(l2f * (float)(iq + 1));
        }
#pragma unroll
        for (int ks = 0; ks < 4; ++ks) {
          bf16x8 qs[NQT];
#pragma unroll
          for (int qt = 0; qt < NQT; ++qt) qs[qt] = scale_frag(Q[qt][ks], dq[qt]);
#pragma unroll
          for (int et = 0; et < 8; ++et) {
            bf16x8 a = *(const bf16x8*)(S + (et * 16 + l15) * 144 + ks * 32 + g * 8);
#pragma unroll
            for (int qt = 0; qt < NQT; ++qt) o[et][qt] = __builtin_amdgcn_mfma_f32_16x16x32_bf16(a, qs[qt], o[et][qt], 0, 0, 0);
          }
        }
      }
    }
#pragma unroll
    for (int qt = 0; qt < NQT; ++qt) {
      const int tok = tokw + qt * 16 + l15;
      float s1 = 0.f;
#pragma unroll
      for (int et = 0; et < 8; ++et)
#pragma unroll
        for (int j = 0; j < 4; ++j) s1 += o[et][qt][j];
      s1 += __shfl_xor(s1, 16);
      s1 += __shfl_xor(s1, 32);
      const float mu = s1 * (1.f / 128.f);
      float s2 = 0.f;
#pragma unroll
      for (int et = 0; et < 8; ++et)
#pragma unroll
        for (int j = 0; j < 4; ++j) {
          float dlt = o[et][qt][j] - mu;
          s2 += dlt * dlt;
        }
      s2 += __shfl_xor(s2, 16);
      s2 += __shfl_xor(s2, 32);
      const float rstd = rsqrtf(s2 * (1.f / 128.f) + 1e-6f);
#pragma unroll
      for (int et = 0; et < 8; ++et) {
        const int e = h * 128 + et * 16 + 4 * g;
        float4 gn = *(const float4*)(p.ret_gn + e);
        u32x2 sg = *(const u32x2*)(srg + (size_t)tok * 512 + e);
        u32x2 ov;
        ov[0] = pack2((o[et][qt][0] - mu) * rstd * gn.x * bflo(sg[0]), (o[et][qt][1] - mu) * rstd * gn.y * bfhi(sg[0]));
        ov[1] = pack2((o[et][qt][2] - mu) * rstd * gn.z * bflo(sg[1]), (o[et][qt][3] - mu) * rstd * gn.w * bfhi(sg[1]));
        *(u32x2*)(ret + (size_t)tok * 512 + e) = ov;
      }
    }
  }
}

DI void phase6(const Params& p, char* smem) {
  char* ws = p.ws;
  const bf16_t* cqn = (const bf16_t*)(ws + OFF_CQ);
  const bf16_t* wuqT = (const bf16_t*)(ws + OFF_WUQT);
  bf16_t* q = (bf16_t*)(ws + OFF_Q);
  for (int it = 0;; ++it) {
    int ft, tt;
    if (!tile_map(it, 6, 160, 1, ft, tt)) break;
    f32x4 acc[4][4];
    acc_zero(acc);
    gemm_kloop<0>(acc, wuqT + (size_t)ft * 128 * 256, 256, cqn + (size_t)tt * 128 * 256, 256, 256, smem, 0.f, 0.f);
    epilogue(acc, [&](int m, int n, float (&v)[16]) { st_bf16x16(q + (size_t)(tt * 128 + n) * 768 + ft * 128 + m, v); });
  }
  const bf16_t* ckvall = (const bf16_t*)(ws + OFF_CKVALL);
  const bf16_t* wukvT = (const bf16_t*)(ws + OFF_WUKVT);
  bf16_t* Kn = (bf16_t*)(ws + OFF_KN);
  bf16_t* Vt = (bf16_t*)(ws + OFF_VTA);
  for (int it = 0;; ++it) {
    int ft, tt;
    if (!tile_map(it, 8, 192, 1, ft, tt)) break;
    f32x4 acc[4][4];
    acc_zero(acc);
    const bf16_t* W = wukvT + (size_t)ft * 128 * 128;
    const bf16_t* X = ckvall + (size_t)tt * 128 * 128;
    if (ft < 4) {
      gemm_kloop<0>(acc, W, 128, X, 128, 128, smem, 0.f, 0.f);
      epilogue(acc, [&](int m, int n, float (&v)[16]) { st_bf16x16(Kn + (size_t)(tt * 128 + n) * 512 + ft * 128 + m, v); });
    } else {
      gemm_kloop<0>(acc, X, 128, W, 128, 128, smem, 0.f, 0.f);
      epilogue(acc, [&](int m, int n, float (&v)[16]) { st_bf16x16(Vt + (size_t)((ft - 4) * 128 + n) * NKV + tt * 128 + m, v); });
    }
  }
}

DI void conv_fp8_rows(const float* __restrict__ src, unsigned char* __restrict__ dst, float* __restrict__ inv);
DI void phase7(const Params& p, char* smem) {
  char* ws = p.ws;
  const bf16_t* q = (const bf16_t*)(ws + OFF_Q);
  const bf16_t* Kn = (const bf16_t*)(ws + OFF_KN);
  const bf16_t* Vt = (const bf16_t*)(ws + OFF_VTA);
  const bf16_t* krall = (const bf16_t*)(ws + OFF_KRALL);
  bf16_t* attn = (bf16_t*)(ws + OFF_ATTN);
  bf16_t* Ks0 = (bf16_t*)smem;
  const int tid = threadIdx.x, lane = tid & 63, w = tid >> 6, l15 = lane & 15, g = lane >> 4;
  const float qscale = 0.10206207261596577f * 1.4426950408889634f;
  for (int item = vbid(); item < 1280; item += gridDim.x) {
    int b, h, qtok0, keyrow0, nkt;
    bool sample;
    if (item < 1024) {
      sample = true; b = item >> 7; h = (item >> 4) & 7; int qb = item & 15;
      qtok0 = NPT + b * 2048 + qb * 128; keyrow0 = NPT + b * 2560; nkt = 40;
    } else {
      int it2 = item - 1024;
      sample = false; b = it2 >> 4; h = (it2 >> 1) & 7; int qb = it2 & 1;
      qtok0 = b * 256 + qb * 128; keyrow0 = b * 256; nkt = 4;
    }
    bf16x8 Q[2][3];
#pragma unroll
    for (int qt = 0; qt < 2; ++qt) {
      const int tokq = qtok0 + w * 32 + qt * 16 + l15;
      const bf16_t* qp = q + (size_t)tokq * 768 + h * 96;
#pragma unroll
      for (int ks = 0; ks < 3; ++ks) {
        u32x4 u = *(const u32x4*)(qp + ks * 32 + g * 8);
        float v[8];
#pragma unroll
        for (int i = 0; i < 4; ++i) { v[2 * i] = bflo(u[i]); v[2 * i + 1] = bfhi(u[i]); }
        if (ks == 2 && sample) {
          u32x4 up = *(const u32x4*)(qp + 64 + (g ^ 2) * 8);
          float pv[8];
#pragma unroll
          for (int i = 0; i < 4; ++i) { pv[2 * i] = bflo(up[i]); pv[2 * i + 1] = bfhi(up[i]); }
          int t = (tokq - NPT) & 2047;
          const float4* rp = (const float4*)((const float2*)(ws + OFF_ROPE) + t * 16 + (g & 1) * 8);
#pragma unroll
          for (int i2 = 0; i2 < 4; ++i2) {
            const float4 c2 = rp[i2];
            const int i = 2 * i2;
            v[i] = g < 2 ? v[i] * c2.x - pv[i] * c2.y : pv[i] * c2.y + v[i] * c2.x;
            v[i + 1] = g < 2 ? v[i + 1] * c2.z - pv[i + 1] * c2.w : pv[i + 1] * c2.w + v[i + 1] * c2.z;
          }
        }
        u32x4 o4;
#pragma unroll
        for (int i = 0; i < 4; ++i) o4[i] = pack2(v[2 * i] * qscale, v[2 * i + 1] * qscale);
        Q[qt][ks] = __builtin_bit_cast(bf16x8, o4);
      }
    }
    f32x4 o[4][2];
#pragma unroll
    for (int et = 0; et < 4; ++et)
#pragma unroll
      for (int qt = 0; qt < 2; ++qt) o[et][qt] = f32x4{0.f, 0.f, 0.f, 0.f};
    float mrun[2] = {-1e30f, -1e30f}, lrun[2] = {0.f, 0.f};
    u32x4 rk_[3], rv_[2];
    auto gload = [&](int kt) {
      const int row0 = keyrow0 + kt * 64;
#pragma unroll
      for (int i = 0; i < 3; ++i) {
        int c = tid + 256 * i;
        int r = c / 12, cc = c - r * 12;
        rk_[i] = cc < 8 ? *(const u32x4*)(Kn + (size_t)(row0 + r) * 512 + h * 64 + cc * 8)
                        : *(const u32x4*)(krall + (size_t)(row0 + r) * 32 + (cc - 8) * 8);
      }
#pragma unroll
      for (int i = 0; i < 2; ++i) {
        int c = tid + 256 * i;
        int e = c >> 3, cc = (c & 7) * 8;
        rv_[i] = *(const u32x4*)(Vt + (size_t)(h * 64 + e) * NKV + row0 + cc);
      }
    };
    auto lstore = [&](int b) {
      bf16_t* Kd = Ks0 + b * 11776;
      bf16_t* Vd = Kd + 64 * 112;
#pragma unroll
      for (int i = 0; i < 3; ++i) {
        int c = tid + 256 * i;
        int r = c / 12, cc = c - r * 12;
        *(u32x4*)(Kd + r * 112 + cc * 8) = rk_[i];
      }
#pragma unroll
      for (int i = 0; i < 2; ++i) {
        int c = tid + 256 * i;
        int e = c >> 3, cc = (c & 7) * 8;
        *(u32x4*)(Vd + e * 72 + cc) = rv_[i];
      }
    };
    gload(0);
    __syncthreads();
    lstore(0);
    if (nkt > 1) gload(1);
    __syncthreads();
#pragma unroll 1
    for (int kt = 0; kt < nkt; ++kt) {
      const bf16_t* Ks = Ks0 + (kt & 1) * 11776;
      const bf16_t* Vs = Ks + 64 * 112;
      f32x4 s[4][2];
#pragma unroll
      for (int kk = 0; kk < 4; ++kk)
#pragma unroll
        for (int qt = 0; qt < 2; ++qt) s[kk][qt] = f32x4{0.f, 0.f, 0.f, 0.f};
#pragma unroll
      for (int ks = 0; ks < 3; ++ks) {
#pragma unroll
        for (int kk = 0; kk < 4; ++kk) {
          bf16x8 a = *(const bf16x8*)(Ks + (kk * 16 + l15) * 112 + ks * 32 + g * 8);
#pragma unroll
          for (int qt = 0; qt < 2; ++qt) s[kk][qt] = __builtin_amdgcn_mfma_f32_16x16x32_bf16(a, Q[qt][ks], s[kk][qt], 0, 0, 0);
        }
      }
      bf16x8 P[2][2];
#pragma unroll
      for (int qt = 0; qt < 2; ++qt) {
        float mx = s[0][qt][0];
#pragma unroll
        for (int kk = 0; kk < 4; ++kk)
#pragma unroll
          for (int j = 0; j < 4; ++j) mx = fmaxf(mx, s[kk][qt][j]);
        mx = fmaxf(mx, __shfl_xor(mx, 16));
        mx = fmaxf(mx, __shfl_xor(mx, 32));
        const float mnew = fmaxf(mrun[qt], mx);
        const bool grow = __ballot(mx > mrun[qt]) != 0ull;
        const float alpha = grow ? ex2(mrun[qt] - mnew) : 1.f;
        mrun[qt] = mnew;
        float ps = 0.f;
#pragma unroll
        for (int kk = 0; kk < 4; ++kk)
#pragma unroll
          for (int j = 0; j < 4; ++j) {
            float e_ = ex2(s[kk][qt][j] - mnew);
            s[kk][qt][j] = e_;
            ps += e_;
          }
        if (grow) {
          lrun[qt] = lrun[qt] * alpha + ps;
#pragma unroll
          for (int et = 0; et < 4; ++et)
#pragma unroll
            for (int j = 0; j < 4; ++j) o[et][qt][j] *= alpha;
        } else {
          lrun[qt] += ps;
        }
#pragma unroll
        for (int k2 = 0; k2 < 2; ++k2) {
          u32x4 u;
          u[0] = pack2(s[2 * k2][qt][0], s[2 * k2][qt][1]);
          u[1] = pack2(s[2 * k2][qt][2], s[2 * k2][qt][3]);
          u[2] = pack2(s[2 * k2 + 1][qt][0], s[2 * k2 + 1][qt][1]);
          u[3] = pack2(s[2 * k2 + 1][qt][2], s[2 * k2 + 1][qt][3]);
          P[qt][k2] = __builtin_bit_cast(bf16x8, u);
        }
      }
#pragma unroll
      for (int k2 = 0; k2 < 2; ++k2) {
#pragma unroll
        for (int et = 0; et < 4; ++et) {
          u32x2 lo = *(const u32x2*)(Vs + (et * 16 + l15) * 72 + k2 * 32 + 4 * g);
          u32x2 hi = *(const u32x2*)(Vs + (et * 16 + l15) * 72 + k2 * 32 + 16 + 4 * g);
          u32x4 u;
          u[0] = lo[0]; u[1] = lo[1]; u[2] = hi[0]; u[3] = hi[1];
          bf16x8 a = __builtin_bit_cast(bf16x8, u);
#pragma unroll
          for (int qt = 0; qt < 2; ++qt) o[et][qt] = __builtin_amdgcn_mfma_f32_16x16x32_bf16(a, P[qt][k2], o[et][qt], 0, 0, 0);
        }
      }
      if (kt + 1 < nkt) {
        lstore((kt + 1) & 1);
        if (kt + 2 < nkt) gload(kt + 2);
        __syncthreads();
      }
    }
#pragma unroll
    for (int qt = 0; qt < 2; ++qt) {
      const int tokq = qtok0 + w * 32 + qt * 16 + l15;
      float lt = lrun[qt];
      lt += __shfl_xor(lt, 16);
      lt += __shfl_xor(lt, 32);
      const float inv = 1.f / lt;
#pragma unroll
      for (int et = 0; et < 4; ++et) {
        u32x2 ov;
        ov[0] = pack2(o[et][qt][0] * inv, o[et][qt][1] * inv);
        ov[1] = pack2(o[et][qt][2] * inv, o[et][qt][3] * inv);
        *(u32x2*)(attn + (size_t)tokq * 512 + h * 64 + et * 16 + 4 * g) = ov;
      }
    }
  }
  conv_fp8_rows(p.peer_u, (unsigned char*)(p.ws + OFF_TABU), (float*)(p.ws + OFF_INVU));
  conv_fp8_rows(p.peer_v, (unsigned char*)(p.ws + OFF_TABV), (float*)(p.ws + OFF_INVV));
}

DI void phase8(const Params& p, char* smem) {
  char* ws = p.ws;
  const bf16_t* attn = (const bf16_t*)(ws + OFF_ATTN);
  const bf16_t* ret = (const bf16_t*)(ws + OFF_RET);
  const bf16_t* wa = (const bf16_t*)(ws + OFF_WUPAT);
  const bf16_t* wb = (const bf16_t*)(ws + OFF_WUPBT);
  const bf16_t* sga = (const bf16_t*)p.out;
  const bf16_t* sgb = sga + (size_t)NTOK * 1024;
  bf16_t* mbuf = (bf16_t*)(ws + OFF_M);
  const int tid = threadIdx.x, lane = tid & 63, w = tid >> 6, wm = w >> 1, wn = w & 1, l15 = lane & 15, g = lane >> 4;
  for (int it = 0;; ++it) {
    int ft, tt;
    if (!tile_map(it, 8, 160, 1, ft, tt)) break;
    f32x4 acc[4][4];
    acc_zero(acc);
    gemm_kloop<0>(acc, wa + (size_t)ft * 128 * 512, 512, attn + (size_t)tt * 128 * 512, 512, 512, smem, 0.f, 0.f);
#pragma unroll
    for (int c = 0; c < 4; ++c) {
      const size_t off = (size_t)(tt * 128 + wn * 64 + c * 16 + l15) * 1024 + ft * 128 + wm * 64 + 16 * g;
      float a[16], bq[16];
      ld_bf16x16(sga + off, a);
      ld_bf16x16(sgb + off, bq);
#pragma unroll
      for (int f = 0; f < 4; ++f)
#pragma unroll
        for (int j = 0; j < 4; ++j) acc[f][c][j] *= a[f * 4 + j] * __builtin_amdgcn_rcpf(fmaxf(bq[f * 4 + j], 1e-30f));
    }
    gemm_kloop<0>(acc, wb + (size_t)ft * 128 * 512, 512, ret + (size_t)tt * 128 * 512, 512, 512, smem, 0.f, 0.f);
    epilogue(acc, [&](int m, int n, float (&v)[16]) {
      const size_t off = (size_t)(tt * 128 + n) * 1024 + ft * 128 + m;
      float bq[16];
      ld_bf16x16(sgb + off, bq);
#pragma unroll
      for (int i = 0; i < 16; ++i) v[i] *= bq[i];
      st_bf16x16(mbuf + off, v);
    });
  }
}
DI void phase9(const Params& p, char* smem) {
  char* ws = p.ws;
  const bf16_t* mbuf = (const bf16_t*)(ws + OFF_M);
  const bf16_t* wo = (const bf16_t*)(ws + OFF_WOT);
  const float* mod = (const float*)(ws + OFF_MOD);
  u32x4 pra[4], prb[4];
  int ft, tt;
  bool have = tile_map(0, 8, 160, 1, ft, tt);
  if (have) gemm_issue0(wo + (size_t)ft * 128 * 1024, 1024, mbuf + (size_t)tt * 128 * 1024, 1024, pra, prb);
  for (int it = 0; have; ++it) {
    f32x4 acc[4][4];
    acc_zero(acc);
    gemm_kloop_pre<0>(acc, wo + (size_t)ft * 128 * 1024, 1024, mbuf + (size_t)tt * 128 * 1024, 1024, 1024, smem, 0.f, 0.f, pra, prb);
    int ft2 = 0, tt2 = 0;
    const bool have2 = tile_map(it + 1, 8, 160, 1, ft2, tt2);
    if (have2) gemm_issue0(wo + (size_t)ft2 * 128 * 1024, 1024, mbuf + (size_t)tt2 * 128 * 1024, 1024, pra, prb);
    epilogue(acc, [&](int m, int n, float (&v)[16]) {
      const int tok = tt * 128 + n, feat = ft * 128 + m;
      const float* xr = xrow(p, tok) + feat;
      const float* g1 = mod + modidx(tok) * 6144 + 2048 + feat;
#pragma unroll
      for (int i = 0; i < 4; ++i) {
        float4 xv = *(const float4*)(xr + 4 * i), gv = *(const float4*)(g1 + 4 * i);
        v[4 * i] = xv.x + gv.x * v[4 * i];
        v[4 * i + 1] = xv.y + gv.y * v[4 * i + 1];
        v[4 * i + 2] = xv.z + gv.z * v[4 * i + 2];
        v[4 * i + 3] = xv.w + gv.w * v[4 * i + 3];
      }
      st_f32x16(p.out + (size_t)tok * DM + feat, v);
    });
    ft = ft2; tt = tt2; have = have2;
  }
}
DI void conv_fp8_rows(const float* __restrict__ src, unsigned char* __restrict__ dst, float* __restrict__ inv) {
  const int lane = threadIdx.x & 63, w = threadIdx.x >> 6;
  for (int r = blockIdx.x * 4 + w; r < 16384; r += gridDim.x * 4) {
    const float* sp = src + (size_t)r * 1024 + lane * 16;
    float4 v[4];
    float am = 0.f;
#pragma unroll
    for (int i = 0; i < 4; ++i) {
      v[i] = *(const float4*)(sp + 4 * i);
      am = fmaxf(am, fmaxf(fmaxf(fabsf(v[i].x), fabsf(v[i].y)), fmaxf(fabsf(v[i].z), fabsf(v[i].w))));
    }
#pragma unroll
    for (int o = 32; o > 0; o >>= 1) am = fmaxf(am, __shfl_xor(am, o));
    const float sc = am > 0.f ? 448.f / am : 1.f;
    u32x4 o4;
#pragma unroll
    for (int i = 0; i < 4; ++i) {
      int wd = 0;
      wd = __builtin_amdgcn_cvt_pk_fp8_f32(v[i].x * sc, v[i].y * sc, wd, false);
      wd = __builtin_amdgcn_cvt_pk_fp8_f32(v[i].z * sc, v[i].w * sc, wd, true);
      o4[i] = (unsigned)wd;
    }
    *(u32x4*)(dst + ((size_t)(lane >> 3) * 16384 + r) * 128 + (lane & 7) * 16) = o4;
    if (lane == 0) inv[r] = am > 0.f ? am * (1.f / 448.f) : 1.f;
  }
}
DI void phase10(const Params& p, char* smem) {
  rows_norm_mod(p, p.norm_ffn, 3072, 4096, true, (bf16_t*)(p.ws + OFF_H2));
}
DI void phase11(const Params& p, char* smem) {
  char* ws = p.ws;
  const bf16_t* h2 = (const bf16_t*)(ws + OFF_H2);
  const bf16_t* wct = (const bf16_t*)(ws + OFF_WCT);
  bf16_t* sc = (bf16_t*)(ws + OFF_SCORES);
  u32x4 pra[4], prb[4];
  int ft, tt;
  bool have = tile_map(0, 16, 160, 2, ft, tt);
  if (have) gemm_issue0(wct + (size_t)ft * 128 * 1024, 1024, h2 + (size_t)tt * 128 * 1024, 1024, pra, prb);
  for (int it = 0; have; ++it) {
    f32x4 acc[4][4];
    acc_zero(acc);
    gemm_kloop_pre<0>(acc, wct + (size_t)ft * 128 * 1024, 1024, h2 + (size_t)tt * 128 * 1024, 1024, 1024, smem, 0.f, 0.f, pra, prb);
    int ft2 = 0, tt2 = 0;
    const bool have2 = tile_map(it + 1, 16, 160, 2, ft2, tt2);
    if (have2) gemm_issue0(wct + (size_t)ft2 * 128 * 1024, 1024, h2 + (size_t)tt2 * 128 * 1024, 1024, pra, prb);
    epilogue(acc, [&](int m, int n, float (&v)[16]) { st_bf16x16(sc + (size_t)(tt * 128 + n) * 2048 + ft * 128 + m, v); });
    ft = ft2; tt = tt2; have = have2;
  }
}

DI unsigned okey(float f) {
  unsigned u = __float_as_uint(f);
  return (u & 0x80000000u) ? ~u : (u | 0x80000000u);
}
DI void wave_lds_sync() {
  __builtin_amdgcn_fence(__ATOMIC_ACQ_REL, "workgroup");
  __builtin_amdgcn_wave_barrier();
}
DI unsigned okey16(unsigned b) { return (b & 0x8000u) ? (~b & 0xFFFFu) : (b | 0x8000u); }
DI unsigned inv_okey16(unsigned k) { return (k & 0x8000u) ? (k & 0x7FFFu) : (~k & 0xFFFFu); }
DI unsigned inv_okey(unsigned k) { return (k & 0x80000000u) ? (k & 0x7FFFFFFFu) : ~k; }
DI void ins16(unsigned (&L)[16], unsigned x) {
#pragma unroll
  for (int i = 0; i < 16; ++i) {
    unsigned t = max(L[i], x);
    x = min(L[i], x);
    L[i] = t;
  }
}
DI void ce_desc(unsigned& a, unsigned& b) {
  const unsigned t = max(a, b);
  b = min(a, b);
  a = t;
}
DI void sort16_desc(unsigned (&a)[16]) {
#pragma unroll
  for (int ks = 1; ks <= 4; ++ks) {
#pragma unroll
    for (int js = ks - 1; js >= 0; --js) {
#pragma unroll
      for (int i = 0; i < 16; ++i) {
        const int k = 1 << ks, j = 1 << js, l = i ^ j;
        if (l > i) {
          if ((i & k) == 0) ce_desc(a[i], a[l]);
          else ce_desc(a[l], a[i]);
        }
      }
    }
  }
}
DI void merge_top16(unsigned (&L)[16], const unsigned (&G)[16]) {
#pragma unroll
  for (int i = 0; i < 16; ++i) L[i] = max(L[i], G[15 - i]);
#pragma unroll
  for (int js = 3; js >= 0; --js) {
#pragma unroll
    for (int i = 0; i < 16; ++i) {
      const int j = 1 << js, l = i ^ j;
      if (l > i) ce_desc(L[i], L[l]);
    }
  }
}
DI unsigned byte16(const unsigned (&d)[4], int i) {
  unsigned r = 0u;
#pragma unroll
  for (int q = 0; q < 4; ++q) r |= d[q] & (0u - (unsigned)((i >> 2) == q));
  return (r >> ((i & 3) * 8)) & 0xFFu;
}
DI unsigned sel16(const unsigned (&A)[16], int i) {
  unsigned r = 0u;
#pragma unroll
  for (int t = 0; t < 16; ++t) r |= A[t] & (0u - (unsigned)(i == t));
  return r;
}
DI void phase12(const Params& p, char* smem) {
  char* ws = p.ws;
  const bf16_t* sc = (const bf16_t*)(ws + OFF_SCORES);
  int* elist = (int*)(ws + OFF_ELIST);
  float* glist = (float*)(ws + OFF_GLIST);
  const int lane = threadIdx.x & 63, w = threadIdx.x >> 6;
  for (int batch = blockIdx.x * 4 + w; batch < NTOK / 4; batch += gridDim.x * 4) {
    const int tok = batch * 4 + (lane >> 4), hh = lane & 15;
    const bf16_t* row = sc + (size_t)tok * 2048 + hh * 128;
    unsigned L[16];
#pragma unroll
    for (int grp8 = 0; grp8 < 8; ++grp8) {
      unsigned G[16];
#pragma unroll
      for (int cc = 0; cc < 2; ++cc) {
        const int c = grp8 * 2 + cc;
        u32x4 u = *(const u32x4*)(row + c * 8);
#pragma unroll
        for (int i = 0; i < 4; ++i) {
          unsigned b0 = u[i] & 0xFFFFu, b1 = u[i] >> 16;
          G[cc * 8 + 2 * i] = (okey16(b0) << 16) | (unsigned)(127 - (c * 8 + 2 * i));
          G[cc * 8 + 2 * i + 1] = (okey16(b1) << 16) | (unsigned)(127 - (c * 8 + 2 * i + 1));
        }
      }
      sort16_desc(G);
      if (grp8 == 0) {
#pragma unroll
        for (int i = 0; i < 16; ++i) L[i] = G[i];
      } else {
        merge_top16(L, G);
      }
    }
    unsigned M[16];
#pragma unroll
    for (int i = 0; i < 16; ++i) M[i] = (unsigned)__shfl_xor((int)L[i], 1);
    float v1[16], v2[16];
#pragma unroll
    for (int i = 0; i < 16; ++i) {
      v1[i] = bf2f(inv_okey16(L[i] >> 16));
      v2[i] = bf2f(inv_okey16(M[i] >> 16));
    }
    unsigned C[16];
    C[0] = ((okey(v1[0] + v2[0]) & 0xFFFFFF00u) | 255u);
    C[1] = ((okey(v1[0] + v2[1]) & 0xFFFFFF00u) | 254u);
    C[2] = ((okey(v1[0] + v2[2]) & 0xFFFFFF00u) | 253u);
    C[3] = ((okey(v1[0] + v2[3]) & 0xFFFFFF00u) | 252u);
    C[4] = ((okey(v1[0] + v2[4]) & 0xFFFFFF00u) | 251u);
    C[5] = ((okey(v1[0] + v2[5]) & 0xFFFFFF00u) | 250u);
    C[6] = ((okey(v1[0] + v2[6]) & 0xFFFFFF00u) | 249u);
    C[7] = ((okey(v1[0] + v2[7]) & 0xFFFFFF00u) | 248u);
    C[8] = ((okey(v1[0] + v2[8]) & 0xFFFFFF00u) | 247u);
    C[9] = ((okey(v1[0] + v2[9]) & 0xFFFFFF00u) | 246u);
    C[10] = ((okey(v1[0] + v2[10]) & 0xFFFFFF00u) | 245u);
    C[11] = ((okey(v1[0] + v2[11]) & 0xFFFFFF00u) | 244u);
    C[12] = ((okey(v1[0] + v2[12]) & 0xFFFFFF00u) | 243u);
    C[13] = ((okey(v1[0] + v2[13]) & 0xFFFFFF00u) | 242u);
    C[14] = ((okey(v1[0] + v2[14]) & 0xFFFFFF00u) | 241u);
    C[15] = ((okey(v1[0] + v2[15]) & 0xFFFFFF00u) | 240u);
    {
      unsigned G[16];
      G[0] = ((okey(v1[1] + v2[0]) & 0xFFFFFF00u) | 239u);
      G[1] = ((okey(v1[1] + v2[1]) & 0xFFFFFF00u) | 238u);
      G[2] = ((okey(v1[1] + v2[2]) & 0xFFFFFF00u) | 237u);
      G[3] = ((okey(v1[1] + v2[3]) & 0xFFFFFF00u) | 236u);
      G[4] = ((okey(v1[1] + v2[4]) & 0xFFFFFF00u) | 235u);
      G[5] = ((okey(v1[1] + v2[5]) & 0xFFFFFF00u) | 234u);
      G[6] = ((okey(v1[1] + v2[6]) & 0xFFFFFF00u) | 233u);
      G[7] = ((okey(v1[1] + v2[7]) & 0xFFFFFF00u) | 232u);
      G[8] = 0u;
      G[9] = 0u;
      G[10] = 0u;
      G[11] = 0u;
      G[12] = 0u;
      G[13] = 0u;
      G[14] = 0u;
      G[15] = 0u;
      merge_top16(C, G);
    }
    {
      unsigned G[16];
      G[0] = ((okey(v1[2] + v2[0]) & 0xFFFFFF00u) | 223u);
      G[1] = ((okey(v1[2] + v2[1]) & 0xFFFFFF00u) | 222u);
      G[2] = ((okey(v1[2] + v2[2]) & 0xFFFFFF00u) | 221u);
      G[3] = ((okey(v1[2] + v2[3]) & 0xFFFFFF00u) | 220u);
      G[4] = ((okey(v1[2] + v2[4]) & 0xFFFFFF00u) | 219u);
      G[5] = 0u;
      G[6] = 0u;
      G[7] = 0u;
      G[8] = 0u;
      G[9] = 0u;
      G[10] = 0u;
      G[11] = 0u;
      G[12] = 0u;
      G[13] = 0u;
      G[14] = 0u;
      G[15] = 0u;
      merge_top16(C, G);
    }
    {
      unsigned G[16];
      G[0] = ((okey(v1[3] + v2[0]) & 0xFFFFFF00u) | 207u);
      G[1] = ((okey(v1[3] + v2[1]) & 0xFFFFFF00u) | 206u);
      G[2] = ((okey(v1[3] + v2[2]) & 0xFFFFFF00u) | 205u);
      G[3] = ((okey(v1[3] + v2[3]) & 0xFFFFFF00u) | 204u);
      G[4] = 0u;
      G[5] = 0u;
      G[6] = 0u;
      G[7] = 0u;
      G[8] = 0u;
      G[9] = 0u;
      G[10] = 0u;
      G[11] = 0u;
      G[12] = 0u;
      G[13] = 0u;
      G[14] = 0u;
      G[15] = 0u;
      merge_top16(C, G);
    }
    {
      unsigned G[16];
      G[0] = ((okey(v1[4] + v2[0]) & 0xFFFFFF00u) | 191u);
      G[1] = ((okey(v1[5] + v2[0]) & 0xFFFFFF00u) | 175u);
      G[2] = ((okey(v1[6] + v2[0]) & 0xFFFFFF00u) | 159u);
      G[3] = ((okey(v1[7] + v2[0]) & 0xFFFFFF00u) | 143u);
      G[4] = ((okey(v1[8] + v2[0]) & 0xFFFFFF00u) | 127u);
      G[5] = ((okey(v1[9] + v2[0]) & 0xFFFFFF00u) | 111u);
      G[6] = ((okey(v1[10] + v2[0]) & 0xFFFFFF00u) | 95u);
      G[7] = ((okey(v1[11] + v2[0]) & 0xFFFFFF00u) | 79u);
      G[8] = ((okey(v1[12] + v2[0]) & 0xFFFFFF00u) | 63u);
      G[9] = ((okey(v1[13] + v2[0]) & 0xFFFFFF00u) | 47u);
      G[10] = ((okey(v1[14] + v2[0]) & 0xFFFFFF00u) | 31u);
      G[11] = ((okey(v1[15] + v2[0]) & 0xFFFFFF00u) | 15u);
      G[12] = 0u;
      G[13] = 0u;
      G[14] = 0u;
      G[15] = 0u;
      merge_top16(C, G);
    }
    {
      unsigned G[16];
      G[0] = ((okey(v1[4] + v2[1]) & 0xFFFFFF00u) | 190u);
      G[1] = ((okey(v1[5] + v2[1]) & 0xFFFFFF00u) | 174u);
      G[2] = ((okey(v1[6] + v2[1]) & 0xFFFFFF00u) | 158u);
      G[3] = ((okey(v1[7] + v2[1]) & 0xFFFFFF00u) | 142u);
      G[4] = 0u;
      G[5] = 0u;
      G[6] = 0u;
      G[7] = 0u;
      G[8] = 0u;
      G[9] = 0u;
      G[10] = 0u;
      G[11] = 0u;
      G[12] = 0u;
      G[13] = 0u;
      G[14] = 0u;
      G[15] = 0u;
      merge_top16(C, G);
    }
    {
      unsigned G[16];
      G[0] = ((okey(v1[4] + v2[2]) & 0xFFFFFF00u) | 189u);
      G[1] = 0u;
      G[2] = 0u;
      G[3] = 0u;
      G[4] = 0u;
      G[5] = 0u;
      G[6] = 0u;
      G[7] = 0u;
      G[8] = 0u;
      G[9] = 0u;
      G[10] = 0u;
      G[11] = 0u;
      G[12] = 0u;
      G[13] = 0u;
      G[14] = 0u;
      G[15] = 0u;
      merge_top16(C, G);
    }
    unsigned ib1[4], ib2[4];
#pragma unroll
    for (int q = 0; q < 4; ++q) {
      ib1[q] = (L[4 * q] & 0xFFu) | ((L[4 * q + 1] & 0xFFu) << 8) | ((L[4 * q + 2] & 0xFFu) << 16) | ((L[4 * q + 3] & 0xFFu) << 24);
      ib2[q] = (M[4 * q] & 0xFFu) | ((M[4 * q + 1] & 0xFFu) << 8) | ((M[4 * q + 2] & 0xFFu) << 16) | ((M[4 * q + 3] & 0xFFu) << 24);
    }
    int ev[16];
    float gv[16];
    const float mx = __uint_as_float(inv_okey(C[0] & 0xFFFFFF00u));
    float den = 0.f;
#pragma unroll
    for (int k = 0; k < 16; ++k) {
      const int ci = 255 - (int)(C[k] & 0xFFu);
      ev[k] = (127 - (int)byte16(ib1, ci >> 4)) * 128 + (127 - (int)byte16(ib2, ci & 15));
      gv[k] = __expf(__uint_as_float(inv_okey(C[k] & 0xFFFFFF00u)) - mx);
      den += gv[k];
    }
    const float inv = 1.f / den;
    if ((lane & 1) == 0) {
      int* ep = elist + (size_t)tok * 128 + (hh >> 1) * 16;
      float* gp = glist + (size_t)tok * 128 + (hh >> 1) * 16;
#pragma unroll
      for (int k = 0; k < 4; ++k) {
        *(int4*)(ep + 4 * k) = make_int4(ev[4 * k], ev[4 * k + 1], ev[4 * k + 2], ev[4 * k + 3]);
        *(float4*)(gp + 4 * k) = make_float4(gv[4 * k] * inv, gv[4 * k + 1] * inv, gv[4 * k + 2] * inv, gv[4 * k + 3] * inv);
      }
    }
  }
}
using f32x2 = __attribute__((ext_vector_type(2))) float;
DI f32x2 cvt8(unsigned w, bool hi) {
  return hi ? __builtin_amdgcn_cvt_pk_f32_fp8((int)w, true) : __builtin_amdgcn_cvt_pk_f32_fp8((int)w, false);
}
struct SMeta { int e[16]; u32x4 ha, hb; };
template <int MODE>
DI void sl_meta(const Params& p, int t, int s, int grp, int ch, SMeta& m) {
  const int* elist = (const int*)(p.ws + (MODE == 0 ? OFF_ELIST : OFF_GLIST));
#pragma unroll
  for (int i = 0; i < 16; ++i) m.e[i] = elist[(size_t)t * 128 + i * 8 + grp];
  if (MODE == 0) {
    const bf16_t* hq = (const bf16_t*)(p.ws + OFF_H2) + (size_t)t * DM + s * 128 + ch * 16;
    m.ha = *(const u32x4*)hq;
    m.hb = *(const u32x4*)(hq + 8);
  }
}
template <int MODE>
DI void sl_rows(const Params& p, int s, int ch, const SMeta& m, u32x4 (&r)[16]) {
  const unsigned char* tab = (const unsigned char*)(p.ws + (MODE == 0 ? OFF_TABU : OFF_TABV));
#pragma unroll
  for (int i = 0; i < 16; ++i) r[i] = *(const u32x4*)(tab + ((size_t)s * 16384 + (m.e[i] & 0xFFFF)) * 128 + ch * 16);
}
template <int MODE>
DI void sl_compute(const Params& p, int t, int s, int lane, const SMeta& m, const u32x4 (&r)[16]) {
  const int grp = lane >> 3, ch = lane & 7;
  if (MODE == 0) {
    f32x2 hp[8];
#pragma unroll
    for (int i = 0; i < 4; ++i) {
      hp[i] = f32x2{bflo(m.ha[i]), bfhi(m.ha[i])};
      hp[4 + i] = f32x2{bflo(m.hb[i]), bfhi(m.hb[i])};
    }
    float keep0 = 0.f, keep1 = 0.f;
#pragma unroll
    for (int i = 0; i < 16; ++i) {
      f32x2 d2 = f32x2{0.f, 0.f};
#pragma unroll
      for (int j = 0; j < 4; ++j) {
        d2 += cvt8(r[i][j], false) * hp[2 * j];
        d2 += cvt8(r[i][j], true) * hp[2 * j + 1];
      }
      float d = d2[0] + d2[1];
      d += __shfl_xor(d, 1);
      d += __shfl_xor(d, 2);
      d += __shfl_xor(d, 4);
      if (i < 8) keep0 = (ch == i) ? d : keep0;
      else keep1 = (ch == i - 8) ? d : keep1;
    }
    float* po = (float*)(p.ws + OFF_PD) + (size_t)t * 1024 + s * 128;
    po[ch * 8 + grp] = keep0;
    po[(ch + 8) * 8 + grp] = keep1;
  } else {
    f32x2 acc[8];
#pragma unroll
    for (int q = 0; q < 8; ++q) acc[q] = f32x2{0.f, 0.f};
#pragma unroll
    for (int i = 0; i < 16; ++i) {
      const float wsc = __uint_as_float((unsigned)m.e[i] & 0xFFFF0000u);
      const f32x2 w2 = f32x2{wsc, wsc};
#pragma unroll
      for (int j = 0; j < 4; ++j) {
        acc[2 * j] += w2 * cvt8(r[i][j], false);
        acc[2 * j + 1] += w2 * cvt8(r[i][j], true);
      }
    }
    float v[16];
#pragma unroll
    for (int q = 0; q < 8; ++q) { v[2 * q] = acc[q][0]; v[2 * q + 1] = acc[q][1]; }
    float q8[8], q4[4], q2[2];
    {
      const bool hi = lane & 32;
#pragma unroll
      for (int i = 0; i < 8; ++i) {
        float send = hi ? v[i] : v[8 + i], keep = hi ? v[8 + i] : v[i];
        q8[i] = keep + __shfl_xor(send, 32);
      }
    }
    {
      const bool hi = lane & 16;
#pragma unroll
      for (int i = 0; i < 4; ++i) {
        float send = hi ? q8[i] : q8[4 + i], keep = hi ? q8[4 + i] : q8[i];
        q4[i] = keep + __shfl_xor(send, 16);
      }
    }
    {
      const bool hi = lane & 8;
#pragma unroll
      for (int i = 0; i < 2; ++i) {
        float send = hi ? q4[i] : q4[2 + i], keep = hi ? q4[2 + i] : q4[i];
        q2[i] = keep + __shfl_xor(send, 8);
      }
    }
    const int f = s * 128 + ch * 16 + 2 * grp;
    float* xr = p.out + (size_t)t * DM + f;
    const float2 xv = *(const float2*)xr;
    const float2 gv = *(const float2*)((const float*)(p.ws + OFF_MOD) + modidx(t) * 6144 + 5120 + f);
    *(float2*)xr = make_float2(xv.x + gv.x * q2[0], xv.y + gv.y * q2[1]);
  }
}
template <int MODE>
DI void sliced_pass(const Params& p) {
  const int s = blockIdx.x & 7, loc = blockIdx.x >> 3, nloc = gridDim.x >> 3;
  if (loc >= nloc) return;
  const int lane = threadIdx.x & 63, w = threadIdx.x >> 6, grp = lane >> 3, ch = lane & 7;
  const int stride = nloc * 4;
  SMeta mA, mB;
  u32x4 rA[16], rB[16];
  int t = loc * 4 + w;
  if (t < NTOK) {
    sl_meta<MODE>(p, t, s, grp, ch, mA);
    sl_rows<MODE>(p, s, ch, mA, rA);
  }
  if (t + stride < NTOK) sl_meta<MODE>(p, t + stride, s, grp, ch, mB);
#pragma unroll 1
  for (; t < NTOK; t += 2 * stride) {
    const int t1 = t + stride, t2 = t + 2 * stride, t3 = t + 3 * stride;
    if (t1 < NTOK) sl_rows<MODE>(p, s, ch, mB, rB);
    sl_compute<MODE>(p, t, s, lane, mA, rA);
    if (t2 < NTOK) sl_meta<MODE>(p, t2, s, grp, ch, mA);
    if (t1 < NTOK) {
      if (t2 < NTOK) sl_rows<MODE>(p, s, ch, mA, rA);
      sl_compute<MODE>(p, t1, s, lane, mB, rB);
      if (t3 < NTOK) sl_meta<MODE>(p, t3, s, grp, ch, mB);
    }
  }
}
DI void phase13(const Params& p) { sliced_pass<0>(p); }
DI void phase14(const Params& p) {
  char* ws = p.ws;
  const float* invU = (const float*)(ws + OFF_INVU);
  const float* invV = (const float*)(ws + OFF_INVV);
  const int* elist = (const int*)(ws + OFF_ELIST);
  float* glist = (float*)(ws + OFF_GLIST);
  const float* pd = (const float*)(ws + OFF_PD);
  const int lane = threadIdx.x & 63, w = threadIdx.x >> 6;
  for (int t = blockIdx.x * 4 + w; t < NTOK; t += gridDim.x * 4) {
#pragma unroll
    for (int hf_ = 0; hf_ < 2; ++hf_) {
      const int k = hf_ * 64 + lane;
      float d = 0.f;
#pragma unroll
      for (int s = 0; s < 8; ++s) d += pd[(size_t)t * 1024 + s * 128 + k];
      const int e = elist[(size_t)t * 128 + k];
      const float g = glist[(size_t)t * 128 + k];
      ((unsigned*)glist)[(size_t)t * 128 + k] = (pack2(0.f, g * geluf_(d * invU[e]) * invV[e]) & 0xFFFF0000u) | (unsigned)e;
    }
  }
}
DI void phase15(const Params& p) { sliced_pass<1>(p); }
DI void phase16(const Params& p) {
  const int lane = threadIdx.x & 63, w = threadIdx.x >> 6;
  for (int tok = blockIdx.x * 4 + w; tok < NTOK; tok += gridDim.x * 4) {
    float* xr = p.out + (size_t)tok * DM;
    float4 xv[4];
    float ss = 0.f;
#pragma unroll
    for (int i = 0; i < 4; ++i) {
      xv[i] = *(const float4*)(xr + (i * 64 + lane) * 4);
      ss += xv[i].x * xv[i].x + xv[i].y * xv[i].y + xv[i].z * xv[i].z + xv[i].w * xv[i].w;
    }
    ss = wsum(ss);
    const float rstd = rsqrtf(ss * (1.f / 1024.f) + 1e-6f);
#pragma unroll
    for (int i = 0; i < 4; ++i) {
      const int e = (i * 64 + lane) * 4;
      float4 nf = *(const float4*)(p.norm_final + e);
      *(float4*)(xr + e) = make_float4(xv[i].x * rstd * nf.x, xv[i].y * rstd * nf.y, xv[i].z * rstd * nf.z, xv[i].w * rstd * nf.w);
    }
  }
}

#define XB_TMO      128
#define XB_XCNT(j)  (256  + 64 * (j))
#define XB_XSUB(j)  (1280 + 64 * (j))
#define XB_XGEN(j)  (2304 + 64 * (j))
#define XB_TOP      3328
#define XB_TOPGEN   3392
#define XCD_BAR_WORDS 3456
#define XB_SPIN_CAP (1u << 22)
#define LAS __attribute__((address_space(3)))
DI unsigned xb_ld(unsigned* p) { return __hip_atomic_load(p, __ATOMIC_RELAXED, __HIP_MEMORY_SCOPE_AGENT); }
DI unsigned xb_add(unsigned* p, unsigned v) { return __hip_atomic_fetch_add(p, v, __ATOMIC_RELAXED, __HIP_MEMORY_SCOPE_AGENT); }
DI unsigned xb_xcc_id() { return (unsigned)__builtin_amdgcn_s_getreg((3 << 11) | 20) & 0xFu; }
#define XB_SPIN(cond, bar) do { unsigned _sp = 0; while (cond) { __builtin_amdgcn_s_sleep(1); \
    if ((++_sp & 255u) == 0u) { if (xb_ld(&(bar)[XB_TMO])) break; if (_sp > XB_SPIN_CAP) { atomicAdd(&(bar)[XB_TMO], 1u); break; } } } } while (0)
struct XcdBarrier { unsigned* bar; unsigned x; volatile LAS unsigned* st; };
DI XcdBarrier xcd_barrier_post(unsigned* bar, volatile LAS unsigned* st) {
  XcdBarrier b; b.bar = bar; b.x = xb_xcc_id(); b.st = st;
  if (threadIdx.x == 0) (void)xb_add(&bar[XB_XCNT(b.x)], 1u);
  return b;
}
DI void xcd_barrier_complete(unsigned* bar, unsigned x, unsigned& nloc, unsigned& nx) {
  const unsigned G = gridDim.x * gridDim.y * gridDim.z;
  unsigned sum, cnt, mine, sp = 0u;
  for (;;) {
    sum = 0u; cnt = 0u; mine = 0u;
#pragma unroll
    for (unsigned j = 0; j < 16; ++j) { const unsigned c = xb_ld(&bar[XB_XCNT(j)]); sum += c; cnt += (c > 0u) ? 1u : 0u; mine = (j == x) ? c : mine; }
    if (sum == G) break;
    __builtin_amdgcn_s_sleep(1);
    if ((++sp & 255u) == 0u) { if (xb_ld(&bar[XB_TMO])) break; if (sp > XB_SPIN_CAP) { atomicAdd(&bar[XB_TMO], 1u); break; } }
  }
  nloc = mine > 0u ? mine : 1u; nx = cnt > 0u ? cnt : 1u;
}
DI void xcd_barrier(const XcdBarrier& b) {
  asm volatile("s_waitcnt vmcnt(0)" ::: "memory");
  __syncthreads();
  if (threadIdx.x == 0) {
    unsigned* bar = b.bar;
    __builtin_amdgcn_s_waitcnt(0);
    unsigned nloc = b.st[0], nx = b.st[1];
    if (nloc == 0u) { xcd_barrier_complete(bar, b.x, nloc, nx); b.st[0] = nloc; b.st[1] = nx; }
    const unsigned old = xb_add(&bar[XB_XSUB(b.x)], 1u);
    const unsigned gen = old / nloc;
    if (old + 1u == (gen + 1u) * nloc) {
      __builtin_amdgcn_fence(__ATOMIC_RELEASE, "agent");
      asm volatile("s_waitcnt vmcnt(0)" ::: "memory");
      const unsigned og = xb_add(&bar[XB_TOP], 1u);
      const unsigned tg = og / nx;
      if (og + 1u == (tg + 1u) * nx) xb_add(&bar[XB_TOPGEN], 1u);
      else XB_SPIN(xb_ld(&bar[XB_TOPGEN]) == tg, bar);
      __builtin_amdgcn_fence(__ATOMIC_ACQUIRE, "agent");
      xb_add(&bar[XB_XGEN(b.x)], 1u);
      asm volatile("s_waitcnt vmcnt(0)" ::: "memory");
    } else {
      XB_SPIN(xb_ld(&bar[XB_XGEN(b.x)]) == gen, bar);
      __builtin_amdgcn_fence(__ATOMIC_ACQUIRE, "agent");
      asm volatile("s_waitcnt vmcnt(0)" ::: "memory");
    }
  }
  __syncthreads();
}

#ifdef ONLY_PHASE
#define RUNPH(n, call) if (ONLY_PHASE == n) { call; }
#else
#ifndef DUP_PHASE
#define DUP_PHASE -1
#endif
#define RUNPH(n, call) if (lo <= n && n < hi) { call; if (n == DUP_PHASE) { xcd_barrier(xb); call; } if (n + 1 < hi) xcd_barrier(xb); }
#endif
__global__ void __launch_bounds__(256, 2) mega(Params p, int lo, int hi) {
  __shared__ __attribute__((aligned(16))) char smem[SMEM_BYTES];
  __shared__ uint4 xb_words;
  cg::grid_group grid = cg::this_grid();
  if (lo < 0) grid.sync();
  if (threadIdx.x == 0) xb_words = make_uint4(0u, 0u, 0u, 0u);
  __syncthreads();
  XcdBarrier xb = xcd_barrier_post((unsigned*)(p.ws + OFF_BAR), (volatile LAS unsigned*)&xb_words);
  RUNPH(0, phase0(p, smem))
  RUNPH(1, phase1(p, smem))
  RUNPH(2, phase2(p, smem))
  RUNPH(3, phase3(p, smem))
  RUNPH(4, phase4(p))
  RUNPH(5, phase5(p, smem))
  RUNPH(6, phase6(p, smem))
  RUNPH(7, phase7(p, smem))
  RUNPH(8, phase8(p, smem))
  RUNPH(9, phase9(p, smem))
  RUNPH(10, phase10(p, smem))
  RUNPH(11, phase11(p, smem))
  RUNPH(12, phase12(p, smem))
  RUNPH(13, phase13(p))
  RUNPH(14, phase14(p))
  RUNPH(15, phase15(p))
  RUNPH(16, phase16(p))
}

extern "C" void kernel_launch(void* const* d_in, const int* in_sizes, int n_in, void* d_out, int out_size, void* d_ws,
                              size_t ws_size, hipStream_t stream) {
  static int grid_blocks = 0;
  if (!grid_blocks) {
    int dev = 0, cus = 0, per_cu = 0;
    hipGetDevice(&dev);
    hipDeviceGetAttribute(&cus, hipDeviceAttributeMultiprocessorCount, dev);
    hipOccupancyMaxActiveBlocksPerMultiprocessor(&per_cu, mega, 256, 0);
    if (per_cu > 2) per_cu = 2;
    if (per_cu < 1) per_cu = 1;
    grid_blocks = cus * per_cu;
  }
  Params p{};
  const float** pp = (const float**)&p;
  for (int i = 0; i < 29; ++i) pp[i] = (const float*)d_in[i];
  p.out = (float*)d_out;
  p.ws = (char*)d_ws;
#if N_LAUNCH_SPLIT
  for (int ph = 0; ph < NPHASE; ++ph) {
    hipLaunchKernelGGL(mega, dim3(grid_blocks), dim3(256), 0, stream, p, ph, ph + 1);
  }
#else
  hipMemsetAsync((char*)d_ws + OFF_MOD, 0, (OFF_BAR - OFF_MOD) + XCD_BAR_WORDS * sizeof(unsigned), stream);
  int lo = 0, hi = NPHASE;
  void* args[] = {&p, &lo, &hi};
  hipError_t e = hipLaunchCooperativeKernel((void*)mega, dim3(grid_blocks), dim3(256), args, 0, stream);
  if (e != hipSuccess) fprintf(stderr, "cooperative launch failed: %s (grid %d)\n", hipGetErrorString(e), grid_blocks);
#endif
}
```

```cpp
#include <hip/hip_runtime.h>
#include <hip/hip_cooperative_groups.h>
#include <cstdio>
namespace cg = cooperative_groups;

#define DI __device__ __forceinline__
typedef unsigned short bf16_t;
using bf16x8 = __attribute__((ext_vector_type(8))) short;
using f32x4 = __attribute__((ext_vector_type(4))) float;
using u32x4 = __attribute__((ext_vector_type(4))) unsigned;
using u32x2 = __attribute__((ext_vector_type(2))) unsigned;

#ifndef N_LAUNCH_SPLIT
#define N_LAUNCH_SPLIT 0
#endif

constexpr int NTOK = 20480, NPT = 4096, DM = 1024;
constexpr int NPHASE = 17;
constexpr size_t MiB = 1u << 20;
constexpr size_t OFF_WINT = 0, OFF_WUQT = 9 * MiB, OFF_WUKVT = 9 * MiB + 512 * 1024, OFF_WUPAT = 10 * MiB,
                 OFF_WUPBT = 11 * MiB, OFF_WOT = 12 * MiB, OFF_WCT = 14 * MiB, OFF_WPQB = 18 * MiB,
                 OFF_KEYSB = 22 * MiB, OFF_MOD = 22 * MiB + 512 * 1024, OFF_BAR = 22 * MiB + 768 * 1024, OFF_ROPE = 23 * MiB, A0 = 24 * MiB;
constexpr size_t OFF_PD = A0 + 104 * MiB, OFF_H1 = A0 + 0, OFF_CQ = A0 + 40 * MiB, OFF_CKVRAW = A0 + 50 * MiB, OFF_KRRAW = A0 + 60 * MiB,
                 OFF_RQ = A0 + 63 * MiB, OFF_RK = A0 + 83 * MiB, OFF_KT = A0 + 103 * MiB, OFF_VT = A0 + 123 * MiB,
                 OFF_SRG = A0 + 143 * MiB, OFF_CKVALL = A0 + 163 * MiB, OFF_KRALL = A0 + 169 * MiB,
                 OFF_UF = A0 + 171 * MiB, OFF_UB = A0 + 187 * MiB,
                 OFF_SF = A0 + 0, OFF_SB = A0 + 8 * MiB, OFF_RET = A0 + 16 * MiB,
                 OFF_Q = A0 + 63 * MiB, OFF_KN = A0 + 93 * MiB, OFF_VTA = A0 + 117 * MiB, OFF_ATTN = A0 + 141 * MiB,
                 OFF_M = A0 + 163 * MiB,
                 OFF_H2 = A0 + 56 * MiB, OFF_TABU = A0 + 36 * MiB, OFF_TABV = A0 + 0, OFF_INVU = A0 + 52 * MiB,
                 OFF_INVV = A0 + 53 * MiB, OFF_ELIST = A0 + 16 * MiB, OFF_GLIST = A0 + 26 * MiB, OFF_SCORES = A0 + 104 * MiB;
constexpr size_t OUT_CKV = 20971520, OUT_KR = 21495808, OUT_SF = 21626880, OUT_SB = 22675456;
constexpr int NKV = 24576;
constexpr int SMEM_BYTES = 73728;

struct Params {
  const float *x_prompt, *x_sample, *c, *cache_ckv, *cache_krope, *st_f, *st_b, *c_ctx, *w_mod, *b_mod, *norm_mix,
      *norm_ffn, *norm_final, *w_in, *q_norm, *kv_norm, *w_uq, *w_ukv, *lg_f, *lg_b, *ret_gn, *w_up_a, *w_up_b, *w_o,
      *peer_wq, *keys1, *keys2, *peer_u, *peer_v;
  float* out;
  char* ws;
};

DI unsigned f2bf(float x) {
  unsigned u = __float_as_uint(x);
  u += 0x7fffu + ((u >> 16) & 1u);
  return u >> 16;
}
DI float bf2f(unsigned b) { return __uint_as_float(b << 16); }
typedef __bf16 hbf16x2_t __attribute__((ext_vector_type(2)));
typedef float hf32x2_t __attribute__((ext_vector_type(2)));
DI unsigned pack2(float a, float b) {
  hf32x2_t f = {a, b};
  return __builtin_bit_cast(unsigned, __builtin_convertvector(f, hbf16x2_t));
}
DI float ex2(float x) { return __builtin_amdgcn_exp2f(x); }
DI float bflo(unsigned u) { return __uint_as_float(u << 16); }
DI float bfhi(unsigned u) { return __uint_as_float(u & 0xffff0000u); }
DI float wsum(float v) {
#pragma unroll
  for (int o = 32; o > 0; o >>= 1) v += __shfl_xor(v, o);
  return v;
}
DI float sigmoidf_(float x) { return __builtin_amdgcn_rcpf(1.f + __builtin_amdgcn_exp2f(-1.4426950408889634f * x)); }
DI float siluf_(float x) { return x * __builtin_amdgcn_rcpf(1.f + __builtin_amdgcn_exp2f(-1.4426950408889634f * x)); }
DI float geluf_(float x) { return 0.5f * x * (1.f + tanhf(0.7978845608028654f * (x + 0.044715f * x * x * x))); }
DI const float* xrow(const Params& p, int tok) {
  return tok < NPT ? p.x_prompt + (size_t)tok * DM : p.x_sample + (size_t)(tok - NPT) * DM;
}
DI int modidx(int tok) { return tok < NPT ? 0 : 1 + ((tok - NPT) >> 11); }
DI int kvrow(int tok) {
  if (tok < NPT) return tok;
  int t = tok - NPT;
  return NPT + (t >> 11) * 2560 + (t & 2047);
}
DI void st_bf16x16(bf16_t* dst, const float (&v)[16]) {
  u32x4 a, b;
  a[0] = pack2(v[0], v[1]); a[1] = pack2(v[2], v[3]); a[2] = pack2(v[4], v[5]); a[3] = pack2(v[6], v[7]);
  b[0] = pack2(v[8], v[9]); b[1] = pack2(v[10], v[11]); b[2] = pack2(v[12], v[13]); b[3] = pack2(v[14], v[15]);
  *(u32x4*)dst = a;
  *(u32x4*)(dst + 8) = b;
}
DI void st_f32x16(float* dst, const float (&v)[16]) {
#pragma unroll
  for (int i = 0; i < 4; ++i) *(float4*)(dst + 4 * i) = make_float4(v[4 * i], v[4 * i + 1], v[4 * i + 2], v[4 * i + 3]);
}
DI void ld_bf16x16(const bf16_t* src, float (&v)[16]) {
  u32x4 a = *(const u32x4*)src, b = *(const u32x4*)(src + 8);
#pragma unroll
  for (int i = 0; i < 4; ++i) {
    v[2 * i] = bflo(a[i]); v[2 * i + 1] = bfhi(a[i]);
    v[8 + 2 * i] = bflo(b[i]); v[8 + 2 * i + 1] = bfhi(b[i]);
  }
}

constexpr int LDK = 64;
DI void gemm_issue0(const bf16_t* __restrict__ A, int lda, const bf16_t* __restrict__ B, int ldb, u32x4 (&ra)[4], u32x4 (&rb)[4]) {
  const int tid = threadIdx.x;
#pragma unroll
  for (int i = 0; i < 4; ++i) {
    const int c = tid + 256 * i;
    const int r = c >> 3, k8 = (c & 7) * 8;
    ra[i] = *(const u32x4*)(A + (size_t)r * lda + k8);
    rb[i] = *(const u32x4*)(B + (size_t)r * ldb + k8);
  }
}
template <int SCALE>
DI void gemm_kloop_pre(f32x4 (&acc)[4][4], const bf16_t* __restrict__ A, int lda, const bf16_t* __restrict__ B, int ldb,
                       int K, char* smem, float sc_a, float sc_b, u32x4 (&ra)[4], u32x4 (&rb)[4]) {
  bf16_t* As = (bf16_t*)smem;
  bf16_t* Bs = As + 128 * LDK;
  const int tid = threadIdx.x, lane = tid & 63, w = tid >> 6, wm = w >> 1, wn = w & 1, l15 = lane & 15, g = lane >> 4;
  int arow[4], kc[4], ldsa[4], ldsb[4];
#pragma unroll
  for (int i = 0; i < 4; ++i) {
    int c = tid + 256 * i;
    int r = c >> 3;
    kc[i] = (c & 7) * 8;
    arow[i] = r;
    int rr = r & 63;
    int rho = (r & 64) | (((rr >> 2) & 3) << 4) | ((rr >> 4) << 2) | (rr & 3);
    ldsa[i] = rho * LDK + (((c & 7) ^ ((rho >> 1) & 7)) * 8);
    ldsb[i] = r * LDK + (((c & 7) ^ ((r >> 1) & 7)) * 8);
  }
  __syncthreads();
#pragma unroll
  for (int i = 0; i < 4; ++i) {
    *(u32x4*)(As + ldsa[i]) = ra[i];
    *(u32x4*)(Bs + ldsb[i]) = rb[i];
  }
  if (64 < K) {
#pragma unroll
    for (int i = 0; i < 4; ++i) {
      ra[i] = *(const u32x4*)(A + (size_t)arow[i] * lda + 64 + kc[i]);
      rb[i] = *(const u32x4*)(B + (size_t)arow[i] * ldb + 64 + kc[i]);
    }
  }
  __syncthreads();
  int buf = 0;
  for (int k0 = 0; k0 < K; k0 += 64, buf ^= 1) {
    const bf16_t* Ac = As + buf * (256 * LDK);
    const bf16_t* Bc = Bs + buf * (256 * LDK);
#pragma unroll
    for (int ks = 0; ks < 2; ++ks) {
      bf16x8 af[4], bfr[4];
#pragma unroll
      for (int f = 0; f < 4; ++f)
        af[f] = *(const bf16x8*)(Ac + (wm * 64 + f * 16 + l15) * LDK + (((ks * 4 + g) ^ (l15 >> 1)) * 8));
#pragma unroll
      for (int c = 0; c < 4; ++c)
        bfr[c] = *(const bf16x8*)(Bc + (wn * 64 + c * 16 + l15) * LDK + (((ks * 4 + g) ^ (l15 >> 1)) * 8));
      if (SCALE) {
        float fac[8];
#pragma unroll
        for (int i = 0; i < 8; ++i) fac[i] = ex2(sc_a + sc_b * (float)(k0 + ks * 32 + g * 8 + i));
#pragma unroll
        for (int f = 0; f < 4; ++f) {
          u32x4 u = __builtin_bit_cast(u32x4, af[f]);
#pragma unroll
          for (int i = 0; i < 4; ++i) u[i] = pack2(bflo(u[i]) * fac[2 * i], bfhi(u[i]) * fac[2 * i + 1]);
          af[f] = __builtin_bit_cast(bf16x8, u);
        }
      }
#pragma unroll
      for (int f = 0; f < 4; ++f)
#pragma unroll
        for (int c = 0; c < 4; ++c) acc[f][c] = __builtin_amdgcn_mfma_f32_16x16x32_bf16(af[f], bfr[c], acc[f][c], 0, 0, 0);
    }
    if (k0 + 64 < K) {
      bf16_t* An = As + (buf ^ 1) * (256 * LDK);
      bf16_t* Bn = Bs + (buf ^ 1) * (256 * LDK);
#pragma unroll
      for (int i = 0; i < 4; ++i) {
        *(u32x4*)(An + ldsa[i]) = ra[i];
        *(u32x4*)(Bn + ldsb[i]) = rb[i];
      }
      if (k0 + 128 < K) {
#pragma unroll
        for (int i = 0; i < 4; ++i) {
          ra[i] = *(const u32x4*)(A + (size_t)arow[i] * lda + k0 + 128 + kc[i]);
          rb[i] = *(const u32x4*)(B + (size_t)arow[i] * ldb + k0 + 128 + kc[i]);
        }
      }
      __syncthreads();
    }
  }
}
template <int SCALE>
DI void gemm_kloop(f32x4 (&acc)[4][4], const bf16_t* __restrict__ A, int lda, const bf16_t* __restrict__ B, int ldb,
                   int K, char* smem, float sc_a, float sc_b) {
  u32x4 ra[4], rb[4];
  gemm_issue0(A, lda, B, ldb, ra, rb);
  gemm_kloop_pre<SCALE>(acc, A, lda, B, ldb, K, smem, sc_a, sc_b, ra, rb);
}
DI void acc_zero(f32x4 (&acc)[4][4]) {
#pragma unroll
  for (int f = 0; f < 4; ++f)
#pragma unroll
    for (int c = 0; c < 4; ++c) acc[f][c] = f32x4{0.f, 0.f, 0.f, 0.f};
}
template <class F>
DI void epilogue(const f32x4 (&acc)[4][4], F&& epi) {
  const int tid = threadIdx.x, lane = tid & 63, w = tid >> 6, wm = w >> 1, wn = w & 1, l15 = lane & 15, g = lane >> 4;
#pragma unroll
  for (int c = 0; c < 4; ++c) {
    float v[16];
#pragma unroll
    for (int f = 0; f < 4; ++f)
#pragma unroll
      for (int j = 0; j < 4; ++j) v[f * 4 + j] = acc[f][c][j];
    epi(wm * 64 + 16 * g, wn * 64 + c * 16 + l15, v);
  }
}
DI bool tile_map(int it, int Ft, int Tt, int fsplit, int& ft, int& tt) {
  const int bid = blockIdx.x, nb = gridDim.x;
  int xcd = bid & 7, loc = bid >> 3, nloc = nb >> 3;
  if (loc >= nloc) return false;
  int fg = xcd % fsplit, tg = xcd / fsplit, tsplit = 8 / fsplit;
  int Fg = Ft / fsplit, Tg = Tt / tsplit;
  int i = loc + it * nloc;
  if (i >= Fg * Tg) return false;
  ft = fg * Fg + i % Fg;
  tt = tg * Tg + i / Fg;
  return true;
}
DI int vbid() {
  const int bid = blockIdx.x, nb = gridDim.x;
  if (nb & 7) return bid;
  return (bid & 7) * (nb >> 3) + (bid >> 3);
}

DI int colmap(int mode, int np) {
  if (mode == 1) return np < 416 ? np : (np < 512 ? -1 : np - 96);
  if (mode == 2) return np < 512 ? ((np >> 6) * 128 + (np & 63)) : (((np - 512) >> 6) * 128 + 64 + ((np - 512) & 63));
  return np;
}
DI void tconv_tile(const float* __restrict__ src, int ldsrc, bf16_t* __restrict__ dst, int K, int kt, int nt, int mode,
                   char* smem) {
  float* lds = (float*)smem;
  const int tid = threadIdx.x;
  {
    int col = tid & 63, rq = tid >> 6;
    int n = colmap(mode, nt * 64 + col);
#pragma unroll 4
    for (int r = 0; r < 16; ++r) {
      int kl = r * 4 + rq;
      float v = n >= 0 ? src[(size_t)(kt * 64 + kl) * ldsrc + n] : 0.f;
      lds[kl * 65 + col] = v;
    }
  }
  __syncthreads();
  {
    int nl = tid >> 2, kq = (tid & 3) * 16;
    float v[16];
#pragma unroll
    for (int i = 0; i < 16; ++i) v[i] = lds[(kq + i) * 65 + nl];
    st_bf16x16(dst + (size_t)(nt * 64 + nl) * K + kt * 64 + kq, v);
  }
  __syncthreads();
}
DI void mod_item(const Params& p, int item, char* smem) {
  float* sil = (float*)smem;
  const int tid = threadIdx.x;
  const int cg_ = item >> 2, slab = item & 3, kbase = slab * 256;
  for (int i = tid; i < 9 * 256; i += 256) {
    int j = i >> 8, k = kbase + (i & 255);
    float cv = j == 0 ? p.c_ctx[k] : p.c[(j - 1) * 1024 + k];
    sil[i] = siluf_(cv);
  }
  __syncthreads();
  const int kq = tid >> 6, nn = tid & 63, n0 = cg_ * 64;
  float acc[9];
#pragma unroll
  for (int j = 0; j < 9; ++j) acc[j] = 0.f;
#pragma unroll 1
  for (int i0 = 0; i0 < 64; i0 += 16) {
    float wv[16];
#pragma unroll
    for (int i = 0; i < 16; ++i) wv[i] = p.w_mod[(size_t)(kbase + kq + 4 * (i0 + i)) * 6144 + n0 + nn];
#pragma unroll
    for (int i = 0; i < 16; ++i)
#pragma unroll
      for (int j = 0; j < 9; ++j) acc[j] += sil[j * 256 + kq + 4 * (i0 + i)] * wv[i];
  }
  __syncthreads();
  float* part = (float*)smem + 9 * 256;
#pragma unroll
  for (int j = 0; j < 9; ++j) part[(kq * 9 + j) * 64 + nn] = acc[j];
  __syncthreads();
  float* mod = (float*)(p.ws + OFF_MOD);
  for (int i = tid; i < 9 * 64; i += 256) {
    int j = i >> 6, n = i & 63;
    float s = part[(0 * 9 + j) * 64 + n] + part[(1 * 9 + j) * 64 + n] + part[(2 * 9 + j) * 64 + n] + part[(3 * 9 + j) * 64 + n];
    if (slab == 0) s += p.b_mod[n0 + n];
    atomicAdd(mod + j * 6144 + n0 + n, s);
  }
  __syncthreads();
}
DI void conv_flat(const float* __restrict__ src, bf16_t* __restrict__ dst, size_t n) {
  size_t i = ((size_t)blockIdx.x * 256 + threadIdx.x) * 8;
  const size_t stride = (size_t)gridDim.x * 256 * 8;
  for (; i < n; i += stride) {
    float4 a = *(const float4*)(src + i), b = *(const float4*)(src + i + 4);
    u32x4 o;
    o[0] = pack2(a.x, a.y); o[1] = pack2(a.z, a.w); o[2] = pack2(b.x, b.y); o[3] = pack2(b.z, b.w);
    *(u32x4*)(dst + i) = o;
  }
}
DI void phase0(const Params& p, char* smem) {
  const int bid = blockIdx.x, nb = gridDim.x;
  char* ws = p.ws;
  const int n_mod = 384;
  const int t_in = 16 * 72, t_uq = 4 * 12, t_ukv = 2 * 16, t_upa = 8 * 16, t_upb = 8 * 16, t_o = 16 * 16;
  const int total = n_mod + t_in + t_uq + t_ukv + t_upa + t_upb + t_o;
  for (int it = bid; it < total; it += nb) {
    int i = it;
    if (i < n_mod) { mod_item(p, i, smem); continue; }
    i -= n_mod;
    if (i < t_in) { tconv_tile(p.w_in, 4512, (bf16_t*)(ws + OFF_WINT), 1024, i / 72, i % 72, 1, smem); continue; }
    i -= t_in;
    if (i < t_uq) { tconv_tile(p.w_uq, 768, (bf16_t*)(ws + OFF_WUQT), 256, i / 12, i % 12, 0, smem); continue; }
    i -= t_uq;
    if (i < t_ukv) { tconv_tile(p.w_ukv, 1024, (bf16_t*)(ws + OFF_WUKVT), 128, i / 16, i % 16, 2, smem); continue; }
    i -= t_ukv;
    if (i < t_upa) { tconv_tile(p.w_up_a, 1024, (bf16_t*)(ws + OFF_WUPAT), 512, i / 16, i % 16, 0, smem); continue; }
    i -= t_upa;
    if (i < t_upb) { tconv_tile(p.w_up_b, 1024, (bf16_t*)(ws + OFF_WUPBT), 512, i / 16, i % 16, 0, smem); continue; }
    i -= t_upb;
    tconv_tile(p.w_o, 1024, (bf16_t*)(ws + OFF_WOT), 1024, i / 16, i % 16, 0, smem);
  }
  conv_flat(p.peer_wq, (bf16_t*)(ws + OFF_WPQB), (size_t)1024 * 2048);
  {
    size_t i = ((size_t)bid * 256 + threadIdx.x) * 8;
    const size_t stride = (size_t)nb * 256 * 8;
    bf16_t* kb = (bf16_t*)(ws + OFF_KEYSB);
    for (; i < (size_t)2 * 131072; i += stride) {
      int half = i >= 131072;
      size_t s = i - (size_t)half * 131072;
      int h = (int)(s >> 14);
      size_t r = s & 16383;
      const float* src = (half ? p.keys2 : p.keys1) + s;
      float4 a = *(const float4*)(src), b = *(const float4*)(src + 4);
      u32x4 o;
      o[0] = pack2(a.x, a.y); o[1] = pack2(a.z, a.w); o[2] = pack2(b.x, b.y); o[3] = pack2(b.z, b.w);
      *(u32x4*)(kb + ((size_t)(h * 2 + half) << 14) + r) = o;
    }
  }
  {
    float2* rope = (float2*)(ws + OFF_ROPE);
    for (int idx = bid * 256 + threadIdx.x; idx < 2048 * 16; idx += nb * 256) {
      const int t = idx >> 4, a = idx & 15;
      const float pos = (a < 8) ? (float)(t >> 6) : (float)(t & 63);
      const float fr = exp2f(-(float)(a & 7) * 1.6609640474436813f);
      float sn, cs;
      sincosf(pos * fr, &sn, &cs);
      rope[idx] = make_float2(cs, sn);
    }
  }
}

DI void rows_norm_mod(const Params& p, const float* nw, int sh_off, int sc_off, bool from_out, bf16_t* dst) {
  const int lane = threadIdx.x & 63, w = threadIdx.x >> 6;
  const float* mod = (const float*)(p.ws + OFF_MOD);
  for (int tok = blockIdx.x * 4 + w; tok < NTOK; tok += gridDim.x * 4) {
    const float* xr = from_out ? p.out + (size_t)tok * DM : xrow(p, tok);
    const float* mj = mod + modidx(tok) * 6144;
    float4 xv[4];
    float ss = 0.f;
#pragma unroll
    for (int i = 0; i < 4; ++i) {
      xv[i] = *(const float4*)(xr + (i * 64 + lane) * 4);
      ss += xv[i].x * xv[i].x + xv[i].y * xv[i].y + xv[i].z * xv[i].z + xv[i].w * xv[i].w;
    }
    ss = wsum(ss);
    float rstd = rsqrtf(ss * (1.f / 1024.f) + 1e-6f);
#pragma unroll
    for (int i = 0; i < 4; ++i) {
      int e = (i * 64 + lane) * 4;
      float4 nv = *(const float4*)(nw + e), sh = *(const float4*)(mj + sh_off + e), sc = *(const float4*)(mj + sc_off + e);
      float h0 = (xv[i].x * rstd) * nv.x * (1.f + sc.x) + sh.x;
      float h1 = (xv[i].y * rstd) * nv.y * (1.f + sc.y) + sh.y;
      float h2 = (xv[i].z * rstd) * nv.z * (1.f + sc.z) + sh.z;
      float h3 = (xv[i].w * rstd) * nv.w * (1.f + sc.w) + sh.w;
      u32x2 o;
      o[0] = pack2(h0, h1); o[1] = pack2(h2, h3);
      *(u32x2*)(dst + (size_t)tok * DM + e) = o;
    }
  }
}
DI void phase1(const Params& p, char* smem) {
  rows_norm_mod(p, p.norm_mix, 0, 1024, false, (bf16_t*)(p.ws + OFF_H1));
  const bf16_t* wpq = (const bf16_t*)(p.ws + OFF_WPQB);
  const bf16_t* kb = (const bf16_t*)(p.ws + OFF_KEYSB);
  bf16_t* wct = (bf16_t*)(p.ws + OFF_WCT);
  for (int it = blockIdx.x; it < 128; it += gridDim.x) {
    int hh = it >> 3, mt = it & 7;
    f32x4 acc[4][4];
    acc_zero(acc);
    gemm_kloop<0>(acc, wpq + (size_t)(mt * 128) * 2048 + hh * 128, 2048, kb + (size_t)hh * 16384, 128, 128, smem, 0.f, 0.f);
    epilogue(acc, [&](int m, int n, float (&v)[16]) { st_bf16x16(wct + (size_t)(hh * 128 + n) * 1024 + mt * 128 + m, v); });
  }
}

DI void phase2(const Params& p, char* smem) {
  char* ws = p.ws;
  const bf16_t* winT = (const bf16_t*)(ws + OFF_WINT);
  const bf16_t* h1 = (const bf16_t*)(ws + OFF_H1);
  bf16_t* cq = (bf16_t*)(ws + OFF_CQ);
  float* ckvraw = (float*)(ws + OFF_CKVRAW);
  float* krraw = (float*)(ws + OFF_KRRAW);
  bf16_t* rq = (bf16_t*)(ws + OFF_RQ);
  bf16_t* rk = (bf16_t*)(ws + OFF_RK);
  bf16_t* kT = (bf16_t*)(ws + OFF_KT);
  bf16_t* vT = (bf16_t*)(ws + OFF_VT);
  bf16_t* srg = (bf16_t*)(ws + OFF_SRG);
  bf16_t* sga = (bf16_t*)p.out;
  bf16_t* sgb = sga + (size_t)NTOK * 1024;
  u32x4 pra[4], prb[4];
  int ft, tt;
  bool have = tile_map(0, 36, 160, 4, ft, tt);
  if (have) {
    const bf16_t* W0 = winT + (size_t)ft * 128 * 1024;
    const bf16_t* H0 = h1 + (size_t)tt * 128 * 1024;
    const bool sw = ft >= 8 && ft < 16;
    gemm_issue0(sw ? H0 : W0, 1024, sw ? W0 : H0, 1024, pra, prb);
  }
  for (int it = 0; have; ++it) {
    f32x4 acc[4][4];
    acc_zero(acc);
    const bf16_t* W = winT + (size_t)ft * 128 * 1024;
    const bf16_t* H = h1 + (size_t)tt * 128 * 1024;
    const int tok0 = tt * 128, f0 = ft * 128;
    const bool swp = ft >= 8 && ft < 16;
    gemm_kloop_pre<0>(acc, swp ? H : W, 1024, swp ? W : H, 1024, 1024, smem, 0.f, 0.f, pra, prb);
    int ft2 = 0, tt2 = 0;
    const bool have2 = tile_map(it + 1, 36, 160, 4, ft2, tt2);
    if (have2) {
      const bf16_t* W2 = winT + (size_t)ft2 * 128 * 1024;
      const bf16_t* H2 = h1 + (size_t)tt2 * 128 * 1024;
      const bool sw2 = ft2 >= 8 && ft2 < 16;
      gemm_issue0(sw2 ? H2 : W2, 1024, sw2 ? W2 : H2, 1024, pra, prb);
    }
    if (ft >= 8 && ft < 16) {
      if (ft < 12) {
        epilogue(acc, [&](int m, int n, float (&v)[16]) {
          int feat = f0 - 1024 + n, tok = tok0 + m;
#pragma unroll
          for (int i = 0; i < 16; ++i) v[i] *= 0.08838834764831845f;
          st_bf16x16(kT + (size_t)feat * NTOK + tok, v);
#pragma unroll
          for (int i = 0; i < 16; ++i) rk[(size_t)(tok + i) * 512 + feat] = (bf16_t)f2bf(v[i]);
        });
      } else {
        epilogue(acc, [&](int m, int n, float (&v)[16]) {
          int feat = f0 - 1536 + n, tok = tok0 + m;
          st_bf16x16(vT + (size_t)feat * NTOK + tok, v);
        });
      }
    } else {
      if (ft < 2) {
        epilogue(acc, [&](int m, int n, float (&v)[16]) { st_bf16x16(cq + (size_t)(tok0 + n) * 256 + f0 + m, v); });
      } else if (ft == 2) {
        epilogue(acc, [&](int m, int n, float (&v)[16]) { st_f32x16(ckvraw + (size_t)(tok0 + n) * 128 + m, v); });
      } else if (ft == 3) {
        epilogue(acc, [&](int m, int n, float (&v)[16]) {
          if (m < 32) st_f32x16(krraw + (size_t)(tok0 + n) * 32 + m, v);
        });
      } else if (ft < 8) {
        epilogue(acc, [&](int m, int n, float (&v)[16]) { st_bf16x16(rq + (size_t)(tok0 + n) * 512 + f0 - 512 + m, v); });
      } else if (ft < 20) {
        epilogue(acc, [&](int m, int n, float (&v)[16]) {
#pragma unroll
          for (int i = 0; i < 16; ++i) v[i] = siluf_(v[i]);
          st_bf16x16(srg + (size_t)(tok0 + n) * 512 + f0 - 2048 + m, v);
        });
      } else if (ft < 28) {
        epilogue(acc, [&](int m, int n, float (&v)[16]) {
#pragma unroll
          for (int i = 0; i < 16; ++i) v[i] = sigmoidf_(v[i]);
          st_bf16x16(sga + (size_t)(tok0 + n) * 1024 + f0 - 2560 + m, v);
        });
      } else {
        epilogue(acc, [&](int m, int n, float (&v)[16]) {
#pragma unroll
          for (int i = 0; i < 16; ++i) v[i] = sigmoidf_(v[i]);
          st_bf16x16(sgb + (size_t)(tok0 + n) * 1024 + f0 - 3584 + m, v);
        });
      }
    }
    ft = ft2; tt = tt2; have = have2;
  }
}

DI float log2gamma(float logit) { return -log1pf(expf(-logit)) * 1.4426950408889634f; }
DI void phase3(const Params& p, char* smem) {
  char* ws = p.ws;
  const int lane = threadIdx.x & 63, w = threadIdx.x >> 6;
  bf16_t* cq = (bf16_t*)(ws + OFF_CQ);
  const float* ckvraw = (const float*)(ws + OFF_CKVRAW);
  const float* krraw = (const float*)(ws + OFF_KRRAW);
  bf16_t* ckvall = (bf16_t*)(ws + OFF_CKVALL);
  bf16_t* krall = (bf16_t*)(ws + OFF_KRALL);
  for (int r = blockIdx.x * 4 + w; r < NTOK + 4096; r += gridDim.x * 4) {
    if (r < NTOK) {
      const int tok = r;
      {
        u32x2 u = *(const u32x2*)(cq + (size_t)tok * 256 + lane * 4);
        float a0 = bflo(u[0]), a1 = bfhi(u[0]), a2 = bflo(u[1]), a3 = bfhi(u[1]);
        float ss = wsum(a0 * a0 + a1 * a1 + a2 * a2 + a3 * a3);
        float rstd = rsqrtf(ss * (1.f / 256.f) + 1e-6f);
        float4 nq = *(const float4*)(p.q_norm + lane * 4);
        u32x2 o;
        o[0] = pack2(a0 * rstd * nq.x, a1 * rstd * nq.y);
        o[1] = pack2(a2 * rstd * nq.z, a3 * rstd * nq.w);
        *(u32x2*)(cq + (size_t)tok * 256 + lane * 4) = o;
      }
      const int row = kvrow(tok);
      {
        float2 v = *(const float2*)(ckvraw + (size_t)tok * 128 + lane * 2);
        float ss = wsum(v.x * v.x + v.y * v.y);
        float rstd = rsqrtf(ss * (1.f / 128.f) + 1e-6f);
        float2 nk = *(const float2*)(p.kv_norm + lane * 2);
        float o0 = v.x * rstd * nk.x, o1 = v.y * rstd * nk.y;
        if (tok < NPT) *(float2*)(p.out + OUT_CKV + (size_t)tok * 128 + lane * 2) = make_float2(o0, o1);
        *(unsigned*)(ckvall + (size_t)row * 128 + lane * 2) = pack2(o0, o1);
      }
      if (lane < 32) {
        float own = krraw[(size_t)tok * 32 + lane];
        float o = own;
        if (tok < NPT) {
          p.out[OUT_KR + (size_t)tok * 32 + lane] = own;
        } else {
          float partner = krraw[(size_t)tok * 32 + (lane ^ 16)];
          int t = (tok - NPT) & 2047;
          const float2 csn = ((const float2*)(ws + OFF_ROPE))[t * 16 + (lane & 15)];
          const float cs = csn.x, sn = csn.y;
          o = lane < 16 ? own * cs - partner * sn : partner * sn + own * cs;
        }
        krall[(size_t)row * 32 + lane] = (bf16_t)f2bf(o);
      }
    } else {
      const int cr = r - NTOK;
      const int b = cr >> 9, pos = cr & 511;
      const int row = NPT + b * 2560 + 2048 + pos;
      float2 v = *(const float2*)(p.cache_ckv + (size_t)cr * 128 + lane * 2);
      *(unsigned*)(ckvall + (size_t)row * 128 + lane * 2) = pack2(v.x, v.y);
      if (lane < 32) krall[(size_t)row * 32 + lane] = (bf16_t)f2bf(p.cache_krope[(size_t)cr * 32 + lane]);
    }
  }
  const bf16_t* kT = (const bf16_t*)(ws + OFF_KT);
  const bf16_t* vT = (const bf16_t*)(ws + OFF_VT);
  float* Uf = (float*)(ws + OFF_UF);
  float* Ub = (float*)(ws + OFF_UB);
  for (int it = blockIdx.x; it < 320; it += gridDim.x) {
    const int blk = it >> 2, h = it & 3;
    const float l2f = log2gamma(p.lg_f[h]), l2b = log2gamma(p.lg_b[h]);
    const bf16_t* Kp = kT + (size_t)(h * 128) * NTOK + blk * 256;
    const bf16_t* Vp = vT + (size_t)(h * 128) * NTOK + blk * 256;
#pragma unroll 1
    for (int dir = 0; dir < 2; ++dir) {
      const float sa = dir ? 0.f : l2f * 255.f, sb = dir ? l2b : -l2f;
      f32x4 acc[4][4];
      acc_zero(acc);
      if (blk < 16) {
        gemm_kloop<1>(acc, Vp, NTOK, Kp, NTOK, 256, smem, sa, sb);
        float* dst = p.out + (dir ? OUT_SB : OUT_SF) + (size_t)(blk * 4 + h) * 16384;
        epilogue(acc, [&](int m, int n, float (&v)[16]) { st_f32x16(dst + n * 128 + m, v); });
      } else {
        gemm_kloop<1>(acc, Kp, NTOK, Vp, NTOK, 256, smem, sa, sb);
        float* dst = (dir ? Ub : Uf) + (size_t)((blk - 16) * 4 + h) * 16384;
        epilogue(acc, [&](int m, int n, float (&v)[16]) { st_f32x16(dst + n * 128 + m, v); });
      }
    }
  }
}

DI void phase4(const Params& p) {
  char* ws = p.ws;
  const float* Uf = (const float*)(ws + OFF_UF);
  const float* Ub = (const float*)(ws + OFF_UB);
  bf16_t* Sf = (bf16_t*)(ws + OFF_SF);
  bf16_t* Sb = (bf16_t*)(ws + OFF_SB);
  for (int idx = blockIdx.x * 256 + threadIdx.x; idx < (1 << 20); idx += gridDim.x * 256) {
    int d = idx & 127, e = (idx >> 7) & 127, h = (idx >> 14) & 3, b = (idx >> 16) & 7, dir = idx >> 19;
    size_t eo = (size_t)e * 128 + d;
    if (dir == 0) {
      float cf = exp2f(log2gamma(p.lg_f[h]) * 256.f);
      float S = p.st_f[(size_t)(b * 4 + h) * 16384 + d * 128 + e];
#pragma unroll
      for (int blk = 0; blk < 8; ++blk) {
        size_t o = (size_t)((b * 8 + blk) * 4 + h) * 16384 + eo;
        Sf[o] = (bf16_t)f2bf(S);
        S = cf * S + Uf[o];
      }
    } else {
      float cb = exp2f(log2gamma(p.lg_b[h]) * 256.f);
      float S = p.st_b[(size_t)(b * 4 + h) * 16384 + d * 128 + e];
#pragma unroll
      for (int blk = 7; blk >= 0; --blk) {
        size_t o = (size_t)((b * 8 + blk) * 4 + h) * 16384 + eo;
        Sb[o] = (bf16_t)f2bf(S);
        S = cb * S + Ub[o];
      }
    }
  }
}

DI bf16x8 scale_frag(bf16x8 q, float s) {
  u32x4 u = __builtin_bit_cast(u32x4, q);
#pragma unroll
  for (int i = 0; i < 4; ++i) u[i] = pack2(bflo(u[i]) * s, bfhi(u[i]) * s);
  return __builtin_bit_cast(bf16x8, u);
}
constexpr int NQT = 1;
DI void phase5(const Params& p, char* smem) {
  char* ws = p.ws;
  const bf16_t* rq = (const bf16_t*)(ws + OFF_RQ);
  const bf16_t* rk = (const bf16_t*)(ws + OFF_RK);
  const bf16_t* vT = (const bf16_t*)(ws + OFF_VT);
  const bf16_t* srg = (const bf16_t*)(ws + OFF_SRG);
  const bf16_t* Sf = (const bf16_t*)(ws + OFF_SF);
  const bf16_t* Sb = (const bf16_t*)(ws + OFF_SB);
  bf16_t* ret = (bf16_t*)(ws + OFF_RET);
  bf16_t* Ks0 = (bf16_t*)smem;
  const int tid = threadIdx.x, lane = tid & 63, w = tid >> 6, l15 = lane & 15, g = lane >> 4;
  for (int item = vbid(); item < 640 * (2 / NQT); item += gridDim.x) {
    const int qb = item >> 2, h = item & 3, blk = (qb * NQT) >> 2;
    const float l2f = log2gamma(p.lg_f[h]), l2b = log2gamma(p.lg_b[h]);
    const int tokw = qb * (64 * NQT) + w * (16 * NQT);
    bf16x8 Q[NQT][4];
#pragma unroll
    for (int qt = 0; qt < NQT; ++qt)
#pragma unroll
      for (int ks = 0; ks < 4; ++ks)
        Q[qt][ks] = *(const bf16x8*)(rq + (size_t)(tokw + qt * 16 + l15) * 512 + h * 128 + ks * 32 + g * 8);
    f32x4 o[8][NQT];
#pragma unroll
    for (int et = 0; et < 8; ++et)
#pragma unroll
      for (int qt = 0; qt < NQT; ++qt) o[et][qt] = f32x4{0.f, 0.f, 0.f, 0.f};
    u32x4 rk_[4], rv_[4];
    auto gload = [&](int kt) {
      const int key0 = blk * 256 + kt * 64;
#pragma unroll
      for (int i = 0; i < 4; ++i) {
        int c = tid + 256 * i;
        int r = c >> 4, cc = (c & 15) * 8;
        rk_[i] = *(const u32x4*)(rk + (size_t)(key0 + r) * 512 + h * 128 + cc);
        int e = c >> 3, c2 = (c & 7) * 8;
        rv_[i] = *(const u32x4*)(vT + (size_t)(h * 128 + e) * NTOK + key0 + c2);
      }
    };
    auto lstore = [&](int b_) {
      bf16_t* Kd = Ks0 + b_ * 18432;
      bf16_t* Vd = Kd + 64 * 144;
#pragma unroll
      for (int i = 0; i < 4; ++i) {
        int c = tid + 256 * i;
        int r = c >> 4, cc = (c & 15) * 8;
        *(u32x4*)(Kd + r * 144 + cc) = rk_[i];
        int e = c >> 3, c2 = (c & 7) * 8;
        *(u32x4*)(Vd + e * 72 + c2) = rv_[i];
      }
    };
    gload(0);
    __syncthreads();
    lstore(0);
    gload(1);
    __syncthreads();
#pragma unroll 1
    for (int kt = 0; kt < 4; ++kt) {
      const bf16_t* Ks = Ks0 + (kt & 1) * 18432;
      const bf16_t* Vs = Ks + 64 * 144;
      bf16x8 P[NQT][2];
#pragma unroll
      for (int qt = 0; qt < NQT; ++qt) {
        f32x4 s[4];
#pragma unroll
        for (int kk = 0; kk < 4; ++kk) s[kk] = f32x4{0.f, 0.f, 0.f, 0.f};
#pragma unroll
        for (int ks = 0; ks < 4; ++ks) {
#pragma unroll
          for (int kk = 0; kk < 4; ++kk) {
            bf16x8 a = *(const bf16x8*)(Ks + (kk * 16 + l15) * 144 + ks * 32 + g * 8);
            s[kk] = __builtin_amdgcn_mfma_f32_16x16x32_bf16(a, Q[qt][ks], s[kk], 0, 0, 0);
          }
        }
        const int iq = (tokw + qt * 16 + l15) & 255;
#pragma unroll
        for (int kk = 0; kk < 4; ++kk) {
#pragma unroll
          for (int j = 0; j < 4; ++j) {
            int jk = kt * 64 + kk * 16 + 4 * g + j;
            int diff = iq - jk;
            float dm = diff > 0 ? ex2(l2f * (float)diff) : (diff < 0 ? ex2(l2b * (float)(-diff)) : 2.f);
            s[kk][j] *= dm;
          }
        }
#pragma unroll
        for (int k2 = 0; k2 < 2; ++k2) {
          u32x4 u;
          u[0] = pack2(s[2 * k2][0], s[2 * k2][1]);
          u[1] = pack2(s[2 * k2][2], s[2 * k2][3]);
          u[2] = pack2(s[2 * k2 + 1][0], s[2 * k2 + 1][1]);
          u[3] = pack2(s[2 * k2 + 1][2], s[2 * k2 + 1][3]);
          P[qt][k2] = __builtin_bit_cast(bf16x8, u);
        }
      }
#pragma unroll
      for (int k2 = 0; k2 < 2; ++k2) {
#pragma unroll
        for (int et = 0; et < 8; ++et) {
          u32x2 lo = *(const u32x2*)(Vs + (et * 16 + l15) * 72 + k2 * 32 + 4 * g);
          u32x2 hi = *(const u32x2*)(Vs + (et * 16 + l15) * 72 + k2 * 32 + 16 + 4 * g);
          u32x4 u;
          u[0] = lo[0]; u[1] = lo[1]; u[2] = hi[0]; u[3] = hi[1];
          bf16x8 a = __builtin_bit_cast(bf16x8, u);
#pragma unroll
          for (int qt = 0; qt < NQT; ++qt) o[et][qt] = __builtin_amdgcn_mfma_f32_16x16x32_bf16(a, P[qt][k2], o[et][qt], 0, 0, 0);
        }
      }
      if (kt + 1 < 4) {
        lstore((kt + 1) & 1);
        if (kt + 2 < 4) gload(kt + 2);
        __syncthreads();
      }
    }
    if (blk >= 16) {
      bf16_t* SL = (bf16_t*)smem;
      __syncthreads();
#pragma unroll
      for (int dir = 0; dir < 2; ++dir) {
        const bf16_t* S = (dir ? Sb : Sf) + (size_t)((blk - 16) * 4 + h) * 16384;
#pragma unroll
        for (int i = 0; i < 8; ++i) {
          int c = tid + 256 * i;
          int e = c >> 4, cc = (c & 15) * 8;
          *(u32x4*)(SL + dir * (128 * 144) + e * 144 + cc) = *(const u32x4*)(S + e * 128 + cc);
        }
      }
      __syncthreads();
#pragma unroll 1
      for (int dir = 0; dir < 2; ++dir) {
        const bf16_t* S = SL + dir * (128 * 144);
        float dq[NQT];
#pragma unroll
        for (int qt = 0; qt < NQT; ++qt) {
          int iq = (tokw + qt * 16 + l15) & 255;
          dq[qt] = dir ? exp2f(l2b * (float)(256 - iq)) : exp2f(l2f * (float)(iq + 1));
        }
#pragma unroll
        for (int ks = 0; ks < 4; ++ks) {
          bf16x8 qs[NQT];
#pragma unroll
          for (int qt = 0; qt < NQT; ++qt) qs[qt] = scale_frag(Q[qt][ks], dq[qt]);
#pragma unroll
          for (int et = 0; et < 8; ++et) {
            bf16x8 a = *(const bf16x8*)(S + (et * 16 + l15) * 144 + ks * 32 + g * 8);
#pragma unroll
            for (int qt = 0; qt < NQT; ++qt) o[et][qt] = __builtin_amdgcn_mfma_f32_16x16x32_bf16(a, qs[qt], o[et][qt], 0, 0, 0);
          }
        }
      }
    }
#pragma unroll
    for (int qt = 0; qt < NQT; ++qt) {
      const int tok = tokw + qt * 16 + l15;
      float s1 = 0.f;
#pragma unroll
      for (int et = 0; et < 8; ++et)
#pragma unroll
        for (int j = 0; j < 4; ++j) s1 += o[et][qt][j];
      s1 += __shfl_xor(s1, 16);
      s1 += __shfl_xor(s1, 32);
      const float mu = s1 * (1.f / 128.f);
      float s2 = 0.f;
#pragma unroll
      for (int et = 0; et < 8; ++et)
#pragma unroll
        for (int j = 0; j < 4; ++j) {
          float dlt = o[et][qt][j] - mu;
          s2 += dlt * dlt;
        }
      s2 += __shfl_xor(s2, 16);
      s2 += __shfl_xor(s2, 32);
      const float rstd = rsqrtf(s2 * (1.f / 128.f) + 1e-6f);
#pragma unroll
      for (int et = 0; et < 8; ++et) {
        const int e = h * 128 + et * 16 + 4 * g;
        float4 gn = *(const float4*)(p.ret_gn + e);
        u32x2 sg = *(const u32x2*)(srg + (size_t)tok * 512 + e);
        u32x2 ov;
        ov[0] = pack2((o[et][qt][0] - mu) * rstd * gn.x * bflo(sg[0]), (o[et][qt][1] - mu) * rstd * gn.y * bfhi(sg[0]));
        ov[1] = pack2((o[et][qt][2] - mu) * rstd * gn.z * bflo(sg[1]), (o[et][qt][3] - mu) * rstd * gn.w * bfhi(sg[1]));
        *(u32x2*)(ret + (size_t)tok * 512 + e) = ov;
      }
    }
  }
}

DI void phase6(const Params& p, char* smem) {
  char* ws = p.ws;
  const bf16_t* cqn = (const bf16_t*)(ws + OFF_CQ);
  const bf16_t* wuqT = (const bf16_t*)(ws + OFF_WUQT);
  bf16_t* q = (bf16_t*)(ws + OFF_Q);
  for (int it = 0;; ++it) {
    int ft, tt;
    if (!tile_map(it, 6, 160, 1, ft, tt)) break;
    f32x4 acc[4][4];
    acc_zero(acc);
    gemm_kloop<0>(acc, wuqT + (size_t)ft * 128 * 256, 256, cqn + (size_t)tt * 128 * 256, 256, 256, smem, 0.f, 0.f);
    epilogue(acc, [&](int m, int n, float (&v)[16]) { st_bf16x16(q + (size_t)(tt * 128 + n) * 768 + ft * 128 + m, v); });
  }
  const bf16_t* ckvall = (const bf16_t*)(ws + OFF_CKVALL);
  const bf16_t* wukvT = (const bf16_t*)(ws + OFF_WUKVT);
  bf16_t* Kn = (bf16_t*)(ws + OFF_KN);
  bf16_t* Vt = (bf16_t*)(ws + OFF_VTA);
  for (int it = 0;; ++it) {
    int ft, tt;
    if (!tile_map(it, 8, 192, 1, ft, tt)) break;
    f32x4 acc[4][4];
    acc_zero(acc);
    const bf16_t* W = wukvT + (size_t)ft * 128 * 128;
    const bf16_t* X = ckvall + (size_t)tt * 128 * 128;
    if (ft < 4) {
      gemm_kloop<0>(acc, W, 128, X, 128, 128, smem, 0.f, 0.f);
      epilogue(acc, [&](int m, int n, float (&v)[16]) { st_bf16x16(Kn + (size_t)(tt * 128 + n) * 512 + ft * 128 + m, v); });
    } else {
      gemm_kloop<0>(acc, X, 128, W, 128, 128, smem, 0.f, 0.f);
      epilogue(acc, [&](int m, int n, float (&v)[16]) { st_bf16x16(Vt + (size_t)((ft - 4) * 128 + n) * NKV + tt * 128 + m, v); });
    }
  }
}

DI void conv_fp8_rows(const float* __restrict__ src, unsigned char* __restrict__ dst, float* __restrict__ inv);
DI void phase7(const Params& p, char* smem) {
  char* ws = p.ws;
  const bf16_t* q = (const bf16_t*)(ws + OFF_Q);
  const bf16_t* Kn = (const bf16_t*)(ws + OFF_KN);
  const bf16_t* Vt = (const bf16_t*)(ws + OFF_VTA);
  const bf16_t* krall = (const bf16_t*)(ws + OFF_KRALL);
  bf16_t* attn = (bf16_t*)(ws + OFF_ATTN);
  bf16_t* Ks0 = (bf16_t*)smem;
  const int tid = threadIdx.x, lane = tid & 63, w = tid >> 6, l15 = lane & 15, g = lane >> 4;
  const float qscale = 0.10206207261596577f * 1.4426950408889634f;
  for (int item = vbid(); item < 1280; item += gridDim.x) {
    int b, h, qtok0, keyrow0, nkt;
    bool sample;
    if (item < 1024) {
      sample = true; b = item >> 7; h = (item >> 4) & 7; int qb = item & 15;
      qtok0 = NPT + b * 2048 + qb * 128; keyrow0 = NPT + b * 2560; nkt = 40;
    } else {
      int it2 = item - 1024;
      sample = false; b = it2 >> 4; h = (it2 >> 1) & 7; int qb = it2 & 1;
      qtok0 = b * 256 + qb * 128; keyrow0 = b * 256; nkt = 4;
    }
    bf16x8 Q[2][3];
#pragma unroll
    for (int qt = 0; qt < 2; ++qt) {
      const int tokq = qtok0 + w * 32 + qt * 16 + l15;
      const bf16_t* qp = q + (size_t)tokq * 768 + h * 96;
#pragma unroll
      for (int ks = 0; ks < 3; ++ks) {
        u32x4 u = *(const u32x4*)(qp + ks * 32 + g * 8);
        float v[8];
#pragma unroll
        for (int i = 0; i < 4; ++i) { v[2 * i] = bflo(u[i]); v[2 * i + 1] = bfhi(u[i]); }
        if (ks == 2 && sample) {
          u32x4 up = *(const u32x4*)(qp + 64 + (g ^ 2) * 8);
          float pv[8];
#pragma unroll
          for (int i = 0; i < 4; ++i) { pv[2 * i] = bflo(up[i]); pv[2 * i + 1] = bfhi(up[i]); }
          int t = (tokq - NPT) & 2047;
          const float4* rp = (const float4*)((const float2*)(ws + OFF_ROPE) + t * 16 + (g & 1) * 8);
#pragma unroll
          for (int i2 = 0; i2 < 4; ++i2) {
            const float4 c2 = rp[i2];
            const int i = 2 * i2;
            v[i] = g < 2 ? v[i] * c2.x - pv[i] * c2.y : pv[i] * c2.y + v[i] * c2.x;
            v[i + 1] = g < 2 ? v[i + 1] * c2.z - pv[i + 1] * c2.w : pv[i + 1] * c2.w + v[i + 1] * c2.z;
          }
        }
        u32x4 o4;
#pragma unroll
        for (int i = 0; i < 4; ++i) o4[i] = pack2(v[2 * i] * qscale, v[2 * i + 1] * qscale);
        Q[qt][ks] = __builtin_bit_cast(bf16x8, o4);
      }
    }
    f32x4 o[4][2];
#pragma unroll
    for (int et = 0; et < 4; ++et)
#pragma unroll
      for (int qt = 0; qt < 2; ++qt) o[et][qt] = f32x4{0.f, 0.f, 0.f, 0.f};
    float mrun[2] = {-1e30f, -1e30f}, lrun[2] = {0.f, 0.f};
    u32x4 rk_[3], rv_[2];
    auto gload = [&](int kt) {
      const int row0 = keyrow0 + kt * 64;
#pragma unroll
      for (int i = 0; i < 3; ++i) {
        int c = tid + 256 * i;
        int r = c / 12, cc = c - r * 12;
        rk_[i] = cc < 8 ? *(const u32x4*)(Kn + (size_t)(row0 + r) * 512 + h * 64 + cc * 8)
                        : *(const u32x4*)(krall + (size_t)(row0 + r) * 32 + (cc - 8) * 8);
      }
#pragma unroll
      for (int i = 0; i < 2; ++i) {
        int c = tid + 256 * i;
        int e = c >> 3, cc = (c & 7) * 8;
        rv_[i] = *(const u32x4*)(Vt + (size_t)(h * 64 + e) * NKV + row0 + cc);
      }
    };
    auto lstore = [&](int b) {
      bf16_t* Kd = Ks0 + b * 11776;
      bf16_t* Vd = Kd + 64 * 112;
#pragma unroll
      for (int i = 0; i < 3; ++i) {
        int c = tid + 256 * i;
        int r = c / 12, cc = c - r * 12;
        *(u32x4*)(Kd + r * 112 + cc * 8) = rk_[i];
      }
#pragma unroll
      for (int i = 0; i < 2; ++i) {
        int c = tid + 256 * i;
        int e = c >> 3, cc = (c & 7) * 8;
        *(u32x4*)(Vd + e * 72 + cc) = rv_[i];
      }
    };
    gload(0);
    __syncthreads();
    lstore(0);
    if (nkt > 1) gload(1);
    __syncthreads();
#pragma unroll 1
    for (int kt = 0; kt < nkt; ++kt) {
      const bf16_t* Ks = Ks0 + (kt & 1) * 11776;
      const bf16_t* Vs = Ks + 64 * 112;
      f32x4 s[4][2];
#pragma unroll
      for (int kk = 0; kk < 4; ++kk)
#pragma unroll
        for (int qt = 0; qt < 2; ++qt) s[kk][qt] = f32x4{0.f, 0.f, 0.f, 0.f};
#pragma unroll
      for (int ks = 0; ks < 3; ++ks) {
#pragma unroll
        for (int kk = 0; kk < 4; ++kk) {
          bf16x8 a = *(const bf16x8*)(Ks + (kk * 16 + l15) * 112 + ks * 32 + g * 8);
#pragma unroll
          for (int qt = 0; qt < 2; ++qt) s[kk][qt] = __builtin_amdgcn_mfma_f32_16x16x32_bf16(a, Q[qt][ks], s[kk][qt], 0, 0, 0);
        }
      }
      bf16x8 P[2][2];
#pragma unroll
      for (int qt = 0; qt < 2; ++qt) {
        float mx = s[0][qt][0];
#pragma unroll
        for (int kk = 0; kk < 4; ++kk)
#pragma unroll
          for (int j = 0; j < 4; ++j) mx = fmaxf(mx, s[kk][qt][j]);
        mx = fmaxf(mx, __shfl_xor(mx, 16));
        mx = fmaxf(mx, __shfl_xor(mx, 32));
        const float mnew = fmaxf(mrun[qt], mx);
        const bool grow = __ballot(mx > mrun[qt]) != 0ull;
        const float alpha = grow ? ex2(mrun[qt] - mnew) : 1.f;
        mrun[qt] = mnew;
        float ps = 0.f;
#pragma unroll
        for (int kk = 0; kk < 4; ++kk)
#pragma unroll
          for (int j = 0; j < 4; ++j) {
            float e_ = ex2(s[kk][qt][j] - mnew);
            s[kk][qt][j] = e_;
            ps += e_;
          }
        if (grow) {
          lrun[qt] = lrun[qt] * alpha + ps;
#pragma unroll
          for (int et = 0; et < 4; ++et)
#pragma unroll
            for (int j = 0; j < 4; ++j) o[et][qt][j] *= alpha;
        } else {
          lrun[qt] += ps;
        }
#pragma unroll
        for (int k2 = 0; k2 < 2; ++k2) {
          u32x4 u;
          u[0] = pack2(s[2 * k2][qt][0], s[2 * k2][qt][1]);
          u[1] = pack2(s[2 * k2][qt][2], s[2 * k2][qt][3]);
          u[2] = pack2(s[2 * k2 + 1][qt][0], s[2 * k2 + 1][qt][1]);
          u[3] = pack2(s[2 * k2 + 1][qt][2], s[2 * k2 + 1][qt][3]);
          P[qt][k2] = __builtin_bit_cast(bf16x8, u);
        }
      }
#pragma unroll
      for (int k2 = 0; k2 < 2; ++k2) {
#pragma unroll
        for (int et = 0; et < 4; ++et) {
          u32x2 lo = *(const u32x2*)(Vs + (et * 16 + l15) * 72 + k2 * 32 + 4 * g);
          u32x2 hi = *(const u32x2*)(Vs + (et * 16 + l15) * 72 + k2 * 32 + 16 + 4 * g);
          u32x4 u;
          u[0] = lo[0]; u[1] = lo[1]; u[2] = hi[0]; u[3] = hi[1];
          bf16x8 a = __builtin_bit_cast(bf16x8, u);
#pragma unroll
          for (int qt = 0; qt < 2; ++qt) o[et][qt] = __builtin_amdgcn_mfma_f32_16x16x32_bf16(a, P[qt][k2], o[et][qt], 0, 0, 0);
        }
      }
      if (kt + 1 < nkt) {
        lstore((kt + 1) & 1);
        if (kt + 2 < nkt) gload(kt + 2);
        __syncthreads();
      }
    }
#pragma unroll
    for (int qt = 0; qt < 2; ++qt) {
      const int tokq = qtok0 + w * 32 + qt * 16 + l15;
      float lt = lrun[qt];
      lt += __shfl_xor(lt, 16);
      lt += __shfl_xor(lt, 32);
      const float inv = 1.f / lt;
#pragma unroll
      for (int et = 0; et < 4; ++et) {
        u32x2 ov;
        ov[0] = pack2(o[et][qt][0] * inv, o[et][qt][1] * inv);
        ov[1] = pack2(o[et][qt][2] * inv, o[et][qt][3] * inv);
        *(u32x2*)(attn + (size_t)tokq * 512 + h * 64 + et * 16 + 4 * g) = ov;
      }
    }
  }
  conv_fp8_rows(p.peer_u, (unsigned char*)(p.ws + OFF_TABU), (float*)(p.ws + OFF_INVU));
  conv_fp8_rows(p.peer_v, (unsigned char*)(p.ws + OFF_TABV), (float*)(p.ws + OFF_INVV));
}

DI void phase8(const Params& p, char* smem) {
  char* ws = p.ws;
  const bf16_t* attn = (const bf16_t*)(ws + OFF_ATTN);
  const bf16_t* ret = (const bf16_t*)(ws + OFF_RET);
  const bf16_t* wa = (const bf16_t*)(ws + OFF_WUPAT);
  const bf16_t* wb = (const bf16_t*)(ws + OFF_WUPBT);
  const bf16_t* sga = (const bf16_t*)p.out;
  const bf16_t* sgb = sga + (size_t)NTOK * 1024;
  bf16_t* mbuf = (bf16_t*)(ws + OFF_M);
  const int tid = threadIdx.x, lane = tid & 63, w = tid >> 6, wm = w >> 1, wn = w & 1, l15 = lane & 15, g = lane >> 4;
  for (int it = 0;; ++it) {
    int ft, tt;
    if (!tile_map(it, 8, 160, 1, ft, tt)) break;
    f32x4 acc[4][4];
    acc_zero(acc);
    gemm_kloop<0>(acc, wa + (size_t)ft * 128 * 512, 512, attn + (size_t)tt * 128 * 512, 512, 512, smem, 0.f, 0.f);
#pragma unroll
    for (int c = 0; c < 4; ++c) {
      const size_t off = (size_t)(tt * 128 + wn * 64 + c * 16 + l15) * 1024 + ft * 128 + wm * 64 + 16 * g;
      float a[16], bq[16];
      ld_bf16x16(sga + off, a);
      ld_bf16x16(sgb + off, bq);
#pragma unroll
      for (int f = 0; f < 4; ++f)
#pragma unroll
        for (int j = 0; j < 4; ++j) acc[f][c][j] *= a[f * 4 + j] * __builtin_amdgcn_rcpf(fmaxf(bq[f * 4 + j], 1e-30f));
    }
    gemm_kloop<0>(acc, wb + (size_t)ft * 128 * 512, 512, ret + (size_t)tt * 128 * 512, 512, 512, smem, 0.f, 0.f);
    epilogue(acc, [&](int m, int n, float (&v)[16]) {
      const size_t off = (size_t)(tt * 128 + n) * 1024 + ft * 128 + m;
      float bq[16];
      ld_bf16x16(sgb + off, bq);
#pragma unroll
      for (int i = 0; i < 16; ++i) v[i] *= bq[i];
      st_bf16x16(mbuf + off, v);
    });
  }
}
DI void phase9(const Params& p, char* smem) {
  char* ws = p.ws;
  const bf16_t* mbuf = (const bf16_t*)(ws + OFF_M);
  const bf16_t* wo = (const bf16_t*)(ws + OFF_WOT);
  const float* mod = (const float*)(ws + OFF_MOD);
  u32x4 pra[4], prb[4];
  int ft, tt;
  bool have = tile_map(0, 8, 160, 1, ft, tt);
  if (have) gemm_issue0(wo + (size_t)ft * 128 * 1024, 1024, mbuf + (size_t)tt * 128 * 1024, 1024, pra, prb);
  for (int it = 0; have; ++it) {
    f32x4 acc[4][4];
    acc_zero(acc);
    gemm_kloop_pre<0>(acc, wo + (size_t)ft * 128 * 1024, 1024, mbuf + (size_t)tt * 128 * 1024, 1024, 1024, smem, 0.f, 0.f, pra, prb);
    int ft2 = 0, tt2 = 0;
    const bool have2 = tile_map(it + 1, 8, 160, 1, ft2, tt2);
    if (have2) gemm_issue0(wo + (size_t)ft2 * 128 * 1024, 1024, mbuf + (size_t)tt2 * 128 * 1024, 1024, pra, prb);
    epilogue(acc, [&](int m, int n, float (&v)[16]) {
      const int tok = tt * 128 + n, feat = ft * 128 + m;
      const float* xr = xrow(p, tok) + feat;
      const float* g1 = mod + modidx(tok) * 6144 + 2048 + feat;
#pragma unroll
      for (int i = 0; i < 4; ++i) {
        float4 xv = *(const float4*)(xr + 4 * i), gv = *(const float4*)(g1 + 4 * i);
        v[4 * i] = xv.x + gv.x * v[4 * i];
        v[4 * i + 1] = xv.y + gv.y * v[4 * i + 1];
        v[4 * i + 2] = xv.z + gv.z * v[4 * i + 2];
        v[4 * i + 3] = xv.w + gv.w * v[4 * i + 3];
      }
      st_f32x16(p.out + (size_t)tok * DM + feat, v);
    });
    ft = ft2; tt = tt2; have = have2;
  }
}
DI void conv_fp8_rows(const float* __restrict__ src, unsigned char* __restrict__ dst, float* __restrict__ inv) {
  const int lane = threadIdx.x & 63, w = threadIdx.x >> 6;
  for (int r = blockIdx.x * 4 + w; r < 16384; r += gridDim.x * 4) {
    const float* sp = src + (size_t)r * 1024 + lane * 16;
    float4 v[4];
    float am = 0.f;
#pragma unroll
    for (int i = 0; i < 4; ++i) {
      v[i] = *(const float4*)(sp + 4 * i);
      am = fmaxf(am, fmaxf(fmaxf(fabsf(v[i].x), fabsf(v[i].y)), fmaxf(fabsf(v[i].z), fabsf(v[i].w))));
    }
#pragma unroll
    for (int o = 32; o > 0; o >>= 1) am = fmaxf(am, __shfl_xor(am, o));
    const float sc = am > 0.f ? 448.f / am : 1.f;
    u32x4 o4;
#pragma unroll
    for (int i = 0; i < 4; ++i) {
      int wd = 0;
      wd = __builtin_amdgcn_cvt_pk_fp8_f32(v[i].x * sc, v[i].y * sc, wd, false);
      wd = __builtin_amdgcn_cvt_pk_fp8_f32(v[i].z * sc, v[i].w * sc, wd, true);
      o4[i] = (unsigned)wd;
    }
    *(u32x4*)(dst + ((size_t)(lane >> 3) * 16384 + r) * 128 + (lane & 7) * 16) = o4;
    if (lane == 0) inv[r] = am > 0.f ? am * (1.f / 448.f) : 1.f;
  }
}
DI void phase10(const Params& p, char* smem) {
  rows_norm_mod(p, p.norm_ffn, 3072, 4096, true, (bf16_t*)(p.ws + OFF_H2));
}
DI void phase11(const Params& p, char* smem) {
  char* ws = p.ws;
  const bf16_t* h2 = (const bf16_t*)(ws + OFF_H2);
  const bf16_t* wct = (const bf16_t*)(ws + OFF_WCT);
  bf16_t* sc = (bf16_t*)(ws + OFF_SCORES);
  u32x4 pra[4], prb[4];
  int ft, tt;
  bool have = tile_map(0, 16, 160, 2, ft, tt);
  if (have) gemm_issue0(wct + (size_t)ft * 128 * 1024, 1024, h2 + (size_t)tt * 128 * 1024, 1024, pra, prb);
  for (int it = 0; have; ++it) {
    f32x4 acc[4][4];
    acc_zero(acc);
    gemm_kloop_pre<0>(acc, wct + (size_t)ft * 128 * 1024, 1024, h2 + (size_t)tt * 128 * 1024, 1024, 1024, smem, 0.f, 0.f, pra, prb);
    int ft2 = 0, tt2 = 0;
    const bool have2 = tile_map(it + 1, 16, 160, 2, ft2, tt2);
    if (have2) gemm_issue0(wct + (size_t)ft2 * 128 * 1024, 1024, h2 + (size_t)tt2 * 128 * 1024, 1024, pra, prb);
    epilogue(acc, [&](int m, int n, float (&v)[16]) { st_bf16x16(sc + (size_t)(tt * 128 + n) * 2048 + ft * 128 + m, v); });
    ft = ft2; tt = tt2; have = have2;
  }
}

DI unsigned okey(float f) {
  unsigned u = __float_as_uint(f);
  return (u & 0x80000000u) ? ~u : (u | 0x80000000u);
}
DI void wave_lds_sync() {
  __builtin_amdgcn_fence(__ATOMIC_ACQ_REL, "workgroup");
  __builtin_amdgcn_wave_barrier();
}
DI unsigned okey16(unsigned b) { return (b & 0x8000u) ? (~b & 0xFFFFu) : (b | 0x8000u); }
DI unsigned inv_okey16(unsigned k) { return (k & 0x8000u) ? (k & 0x7FFFu) : (~k & 0xFFFFu); }
DI unsigned inv_okey(unsigned k) { return (k & 0x80000000u) ? (k & 0x7FFFFFFFu) : ~k; }
DI void ins16(unsigned (&L)[16], unsigned x) {
#pragma unroll
  for (int i = 0; i < 16; ++i) {
    unsigned t = max(L[i], x);
    x = min(L[i], x);
    L[i] = t;
  }
}
DI void ce_desc(unsigned& a, unsigned& b) {
  const unsigned t = max(a, b);
  b = min(a, b);
  a = t;
}
DI void sort16_desc(unsigned (&a)[16]) {
#pragma unroll
  for (int ks = 1; ks <= 4; ++ks) {
#pragma unroll
    for (int js = ks - 1; js >= 0; --js) {
#pragma unroll
      for (int i = 0; i < 16; ++i) {
        const int k = 1 << ks, j = 1 << js, l = i ^ j;
        if (l > i) {
          if ((i & k) == 0) ce_desc(a[i], a[l]);
          else ce_desc(a[l], a[i]);
        }
      }
    }
  }
}
DI void merge_top16(unsigned (&L)[16], const unsigned (&G)[16]) {
#pragma unroll
  for (int i = 0; i < 16; ++i) L[i] = max(L[i], G[15 - i]);
#pragma unroll
  for (int js = 3; js >= 0; --js) {
#pragma unroll
    for (int i = 0; i < 16; ++i) {
      const int j = 1 << js, l = i ^ j;
      if (l > i) ce_desc(L[i], L[l]);
    }
  }
}
DI unsigned byte16(const unsigned (&d)[4], int i) {
  unsigned r = 0u;
#pragma unroll
  for (int q = 0; q < 4; ++q) r |= d[q] & (0u - (unsigned)((i >> 2) == q));
  return (r >> ((i & 3) * 8)) & 0xFFu;
}
DI unsigned sel16(const unsigned (&A)[16], int i) {
  unsigned r = 0u;
#pragma unroll
  for (int t = 0; t < 16; ++t) r |= A[t] & (0u - (unsigned)(i == t));
  return r;
}
DI void phase12(const Params& p, char* smem) {
  char* ws = p.ws;
  const bf16_t* sc = (const bf16_t*)(ws + OFF_SCORES);
  int* elist = (int*)(ws + OFF_ELIST);
  float* glist = (float*)(ws + OFF_GLIST);
  const int lane = threadIdx.x & 63, w = threadIdx.x >> 6;
  for (int batch = blockIdx.x * 4 + w; batch < NTOK / 4; batch += gridDim.x * 4) {
    const int tok = batch * 4 + (lane >> 4), hh = lane & 15;
    const bf16_t* row = sc + (size_t)tok * 2048 + hh * 128;
    unsigned L[16];
#pragma unroll
    for (int grp8 = 0; grp8 < 8; ++grp8) {
      unsigned G[16];
#pragma unroll
      for (int cc = 0; cc < 2; ++cc) {
        const int c = grp8 * 2 + cc;
        u32x4 u = *(const u32x4*)(row + c * 8);
#pragma unroll
        for (int i = 0; i < 4; ++i) {
          unsigned b0 = u[i] & 0xFFFFu, b1 = u[i] >> 16;
          G[cc * 8 + 2 * i] = (okey16(b0) << 16) | (unsigned)(127 - (c * 8 + 2 * i));
          G[cc * 8 + 2 * i + 1] = (okey16(b1) << 16) | (unsigned)(127 - (c * 8 + 2 * i + 1));
        }
      }
      sort16_desc(G);
      if (grp8 == 0) {
#pragma unroll
        for (int i = 0; i < 16; ++i) L[i] = G[i];
      } else {
        merge_top16(L, G);
      }
    }
    unsigned M[16];
#pragma unroll
    for (int i = 0; i < 16; ++i) M[i] = (unsigned)__shfl_xor((int)L[i], 1);
    float v1[16], v2[16];
#pragma unroll
    for (int i = 0; i < 16; ++i) {
      v1[i] = bf2f(inv_okey16(L[i] >> 16));
      v2[i] = bf2f(inv_okey16(M[i] >> 16));
    }
    unsigned C[16];
    C[0] = ((okey(v1[0] + v2[0]) & 0xFFFFFF00u) | 255u);
    C[1] = ((okey(v1[0] + v2[1]) & 0xFFFFFF00u) | 254u);
    C[2] = ((okey(v1[0] + v2[2]) & 0xFFFFFF00u) | 253u);
    C[3] = ((okey(v1[0] + v2[3]) & 0xFFFFFF00u) | 252u);
    C[4] = ((okey(v1[0] + v2[4]) & 0xFFFFFF00u) | 251u);
    C[5] = ((okey(v1[0] + v2[5]) & 0xFFFFFF00u) | 250u);
    C[6] = ((okey(v1[0] + v2[6]) & 0xFFFFFF00u) | 249u);
    C[7] = ((okey(v1[0] + v2[7]) & 0xFFFFFF00u) | 248u);
    C[8] = ((okey(v1[0] + v2[8]) & 0xFFFFFF00u) | 247u);
    C[9] = ((okey(v1[0] + v2[9]) & 0xFFFFFF00u) | 246u);
    C[10] = ((okey(v1[0] + v2[10]) & 0xFFFFFF00u) | 245u);
    C[11] = ((okey(v1[0] + v2[11]) & 0xFFFFFF00u) | 244u);
    C[12] = ((okey(v1[0] + v2[12]) & 0xFFFFFF00u) | 243u);
    C[13] = ((okey(v1[0] + v2[13]) & 0xFFFFFF00u) | 242u);
    C[14] = ((okey(v1[0] + v2[14]) & 0xFFFFFF00u) | 241u);
    C[15] = ((okey(v1[0] + v2[15]) & 0xFFFFFF00u) | 240u);
    {
      unsigned G[16];
      G[0] = ((okey(v1[1] + v2[0]) & 0xFFFFFF00u) | 239u);
      G[1] = ((okey(v1[1] + v2[1]) & 0xFFFFFF00u) | 238u);
      G[2] = ((okey(v1[1] + v2[2]) & 0xFFFFFF00u) | 237u);
      G[3] = ((okey(v1[1] + v2[3]) & 0xFFFFFF00u) | 236u);
      G[4] = ((okey(v1[1] + v2[4]) & 0xFFFFFF00u) | 235u);
      G[5] = ((okey(v1[1] + v2[5]) & 0xFFFFFF00u) | 234u);
      G[6] = ((okey(v1[1] + v2[6]) & 0xFFFFFF00u) | 233u);
      G[7] = ((okey(v1[1] + v2[7]) & 0xFFFFFF00u) | 232u);
      G[8] = 0u;
      G[9] = 0u;
      G[10] = 0u;
      G[11] = 0u;
      G[12] = 0u;
      G[13] = 0u;
      G[14] = 0u;
      G[15] = 0u;
      merge_top16(C, G);
    }
    {
      unsigned G[16];
      G[0] = ((okey(v1[2] + v2[0]) & 0xFFFFFF00u) | 223u);
      G[1] = ((okey(v1[2] + v2[1]) & 0xFFFFFF00u) | 222u);
      G[2] = ((okey(v1[2] + v2[2]) & 0xFFFFFF00u) | 221u);
      G[3] = ((okey(v1[2] + v2[3]) & 0xFFFFFF00u) | 220u);
      G[4] = ((okey(v1[2] + v2[4]) & 0xFFFFFF00u) | 219u);
      G[5] = 0u;
      G[6] = 0u;
      G[7] = 0u;
      G[8] = 0u;
      G[9] = 0u;
      G[10] = 0u;
      G[11] = 0u;
      G[12] = 0u;
      G[13] = 0u;
      G[14] = 0u;
      G[15] = 0u;
      merge_top16(C, G);
    }
    {
      unsigned G[16];
      G[0] = ((okey(v1[3] + v2[0]) & 0xFFFFFF00u) | 207u);
      G[1] = ((okey(v1[3] + v2[1]) & 0xFFFFFF00u) | 206u);
      G[2] = ((okey(v1[3] + v2[2]) & 0xFFFFFF00u) | 205u);
      G[3] = ((okey(v1[3] + v2[3]) & 0xFFFFFF00u) | 204u);
      G[4] = 0u;
      G[5] = 0u;
      G[6] = 0u;
      G[7] = 0u;
      G[8] = 0u;
      G[9] = 0u;
      G[10] = 0u;
      G[11] = 0u;
      G[12] = 0u;
      G[13] = 0u;
      G[14] = 0u;
      G[15] = 0u;
      merge_top16(C, G);
    }
    {
      unsigned G[16];
      G[0] = ((okey(v1[4] + v2[0]) & 0xFFFFFF00u) | 191u);
      G[1] = ((okey(v1[5] + v2[0]) & 0xFFFFFF00u) | 175u);
      G[2] = ((okey(v1[6] + v2[0]) & 0xFFFFFF00u) | 159u);
      G[3] = ((okey(v1[7] + v2[0]) & 0xFFFFFF00u) | 143u);
      G[4] = ((okey(v1[8] + v2[0]) & 0xFFFFFF00u) | 127u);
      G[5] = ((okey(v1[9] + v2[0]) & 0xFFFFFF00u) | 111u);
      G[6] = ((okey(v1[10] + v2[0]) & 0xFFFFFF00u) | 95u);
      G[7] = ((okey(v1[11] + v2[0]) & 0xFFFFFF00u) | 79u);
      G[8] = ((okey(v1[12] + v2[0]) & 0xFFFFFF00u) | 63u);
      G[9] = ((okey(v1[13] + v2[0]) & 0xFFFFFF00u) | 47u);
      G[10] = ((okey(v1[14] + v2[0]) & 0xFFFFFF00u) | 31u);
      G[11] = ((okey(v1[15] + v2[0]) & 0xFFFFFF00u) | 15u);
      G[12] = 0u;
      G[13] = 0u;
      G[14] = 0u;
      G[15] = 0u;
      merge_top16(C, G);
    }
    {
      unsigned G[16];
      G[0] = ((okey(v1[4] + v2[1]) & 0xFFFFFF00u) | 190u);
      G[1] = ((okey(v1[5] + v2[1]) & 0xFFFFFF00u) | 174u);
      G[2] = ((okey(v1[6] + v2[1]) & 0xFFFFFF00u) | 158u);
      G[3] = ((okey(v1[7] + v2[1]) & 0xFFFFFF00u) | 142u);
      G[4] = 0u;
      G[5] = 0u;
      G[6] = 0u;
      G[7] = 0u;
      G[8] = 0u;
      G[9] = 0u;
      G[10] = 0u;
      G[11] = 0u;
      G[12] = 0u;
      G[13] = 0u;
      G[14] = 0u;
      G[15] = 0u;
      merge_top16(C, G);
    }
    {
      unsigned G[16];
      G[0] = ((okey(v1[4] + v2[2]) & 0xFFFFFF00u) | 189u);
      G[1] = 0u;
      G[2] = 0u;
      G[3] = 0u;
      G[4] = 0u;
      G[5] = 0u;
      G[6] = 0u;
      G[7] = 0u;
      G[8] = 0u;
      G[9] = 0u;
      G[10] = 0u;
      G[11] = 0u;
      G[12] = 0u;
      G[13] = 0u;
      G[14] = 0u;
      G[15] = 0u;
      merge_top16(C, G);
    }
    unsigned ib1[4], ib2[4];
#pragma unroll
    for (int q = 0; q < 4; ++q) {
      ib1[q] = (L[4 * q] & 0xFFu) | ((L[4 * q + 1] & 0xFFu) << 8) | ((L[4 * q + 2] & 0xFFu) << 16) | ((L[4 * q + 3] & 0xFFu) << 24);
      ib2[q] = (M[4 * q] & 0xFFu) | ((M[4 * q + 1] & 0xFFu) << 8) | ((M[4 * q + 2] & 0xFFu) << 16) | ((M[4 * q + 3] & 0xFFu) << 24);
    }
    int ev[16];
    float gv[16];
    const float mx = __uint_as_float(inv_okey(C[0] & 0xFFFFFF00u));
    float den = 0.f;
#pragma unroll
    for (int k = 0; k < 16; ++k) {
      const int ci = 255 - (int)(C[k] & 0xFFu);
      ev[k] = (127 - (int)byte16(ib1, ci >> 4)) * 128 + (127 - (int)byte16(ib2, ci & 15));
      gv[k] = __expf(__uint_as_float(inv_okey(C[k] & 0xFFFFFF00u)) - mx);
      den += gv[k];
    }
    const float inv = 1.f / den;
    if ((lane & 1) == 0) {
      int* ep = elist + (size_t)tok * 128 + (hh >> 1) * 16;
      float* gp = glist + (size_t)tok * 128 + (hh >> 1) * 16;
#pragma unroll
      for (int k = 0; k < 4; ++k) {
        *(int4*)(ep + 4 * k) = make_int4(ev[4 * k], ev[4 * k + 1], ev[4 * k + 2], ev[4 * k + 3]);
        *(float4*)(gp + 4 * k) = make_float4(gv[4 * k] * inv, gv[4 * k + 1] * inv, gv[4 * k + 2] * inv, gv[4 * k + 3] * inv);
      }
    }
  }
}
using f32x2 = __attribute__((ext_vector_type(2))) float;
DI f32x2 cvt8(unsigned w, bool hi) {
  return hi ? __builtin_amdgcn_cvt_pk_f32_fp8((int)w, true) : __builtin_amdgcn_cvt_pk_f32_fp8((int)w, false);
}
struct SMeta { int e[16]; u32x4 ha, hb; };
template <int MODE>
DI void sl_meta(const Params& p, int t, int s, int grp, int ch, SMeta& m) {
  const int ts = __builtin_amdgcn_readfirstlane(t);
  const int* elist = (const int*)(p.ws + (MODE == 0 ? OFF_ELIST : OFF_GLIST)) + (size_t)ts * 128;
#pragma unroll
  for (int i = 0; i < 16; ++i) m.e[i] = elist[(unsigned)(i * 8 + grp)];
  if (MODE == 0) {
    const bf16_t* hq = (const bf16_t*)(p.ws + OFF_H2) + (size_t)ts * DM + s * 128;
    m.ha = *(const u32x4*)(hq + (unsigned)(ch * 16));
    m.hb = *(const u32x4*)(hq + (unsigned)(ch * 16 + 8));
  }
}
template <int MODE>
DI void sl_rows(const Params& p, int s, int ch, const SMeta& m, u32x4 (&r)[16]) {
  const unsigned char* tab = (const unsigned char*)(p.ws + (MODE == 0 ? OFF_TABU : OFF_TABV)) + (size_t)s * (16384 * 128);
#pragma unroll
  for (int i = 0; i < 16; ++i) r[i] = *(const u32x4*)(tab + ((unsigned)(m.e[i] & 0xFFFF) * 128u + (unsigned)(ch * 16)));
}
template <int MODE>
DI void sl_compute(const Params& p, int t, int s, int lane, const SMeta& m, const u32x4 (&r)[16]) {
  const int grp = lane >> 3, ch = lane & 7;
  if (MODE == 0) {
    f32x2 hp[8];
#pragma unroll
    for (int i = 0; i < 4; ++i) {
      hp[i] = f32x2{bflo(m.ha[i]), bfhi(m.ha[i])};
      hp[4 + i] = f32x2{bflo(m.hb[i]), bfhi(m.hb[i])};
    }
    float keep0 = 0.f, keep1 = 0.f;
#pragma unroll
    for (int i = 0; i < 16; ++i) {
      f32x2 d2 = f32x2{0.f, 0.f};
#pragma unroll
      for (int j = 0; j < 4; ++j) {
        d2 += cvt8(r[i][j], false) * hp[2 * j];
        d2 += cvt8(r[i][j], true) * hp[2 * j + 1];
      }
      float d = d2[0] + d2[1];
      d += __shfl_xor(d, 1);
      d += __shfl_xor(d, 2);
      d += __shfl_xor(d, 4);
      if (i < 8) keep0 = (ch == i) ? d : keep0;
      else keep1 = (ch == i - 8) ? d : keep1;
    }
    float* po = (float*)(p.ws + OFF_PD) + (size_t)t * 1024 + s * 128;
    po[ch * 8 + grp] = keep0;
    po[(ch + 8) * 8 + grp] = keep1;
  } else {
    f32x2 acc[8];
#pragma unroll
    for (int q = 0; q < 8; ++q) acc[q] = f32x2{0.f, 0.f};
#pragma unroll
    for (int i = 0; i < 16; ++i) {
      const float wsc = __uint_as_float((unsigned)m.e[i] & 0xFFFF0000u);
      const f32x2 w2 = f32x2{wsc, wsc};
#pragma unroll
      for (int j = 0; j < 4; ++j) {
        acc[2 * j] += w2 * cvt8(r[i][j], false);
        acc[2 * j + 1] += w2 * cvt8(r[i][j], true);
      }
    }
    float v[16];
#pragma unroll
    for (int q = 0; q < 8; ++q) { v[2 * q] = acc[q][0]; v[2 * q + 1] = acc[q][1]; }
    float q8[8], q4[4], q2[2];
    {
      const bool hi = lane & 32;
#pragma unroll
      for (int i = 0; i < 8; ++i) {
        float send = hi ? v[i] : v[8 + i], keep = hi ? v[8 + i] : v[i];
        q8[i] = keep + __shfl_xor(send, 32);
      }
    }
    {
      const bool hi = lane & 16;
#pragma unroll
      for (int i = 0; i < 4; ++i) {
        float send = hi ? q8[i] : q8[4 + i], keep = hi ? q8[4 + i] : q8[i];
        q4[i] = keep + __shfl_xor(send, 16);
      }
    }
    {
      const bool hi = lane & 8;
#pragma unroll
      for (int i = 0; i < 2; ++i) {
        float send = hi ? q4[i] : q4[2 + i], keep = hi ? q4[2 + i] : q4[i];
        q2[i] = keep + __shfl_xor(send, 8);
      }
    }
    const int f = s * 128 + ch * 16 + 2 * grp;
    float* xr = p.out + (size_t)t * DM + f;
    const float2 xv = *(const float2*)xr;
    const float2 gv = *(const float2*)((const float*)(p.ws + OFF_MOD) + modidx(t) * 6144 + 5120 + f);
    *(float2*)xr = make_float2(xv.x + gv.x * q2[0], xv.y + gv.y * q2[1]);
  }
}
template <int MODE>
DI void sliced_pass(const Params& p) {
  const int s = blockIdx.x & 7, loc = blockIdx.x >> 3, nloc = gridDim.x >> 3;
  if (loc >= nloc) return;
  const int lane = threadIdx.x & 63, w = threadIdx.x >> 6, grp = lane >> 3, ch = lane & 7;
  const int stride = nloc * 4;
  SMeta mA, mB;
  u32x4 rA[16], rB[16];
  int t = loc * 4 + w;
  if (t < NTOK) {
    sl_meta<MODE>(p, t, s, grp, ch, mA);
    sl_rows<MODE>(p, s, ch, mA, rA);
  }
  if (t + stride < NTOK) sl_meta<MODE>(p, t + stride, s, grp, ch, mB);
#pragma unroll 1
  for (; t < NTOK; t += 2 * stride) {
    const int t1 = t + stride, t2 = t + 2 * stride, t3 = t + 3 * stride;
    if (t1 < NTOK) sl_rows<MODE>(p, s, ch, mB, rB);
    sl_compute<MODE>(p, t, s, lane, mA, rA);
    if (t2 < NTOK) sl_meta<MODE>(p, t2, s, grp, ch, mA);
    if (t1 < NTOK) {
      if (t2 < NTOK) sl_rows<MODE>(p, s, ch, mA, rA);
      sl_compute<MODE>(p, t1, s, lane, mB, rB);
      if (t3 < NTOK) sl_meta<MODE>(p, t3, s, grp, ch, mB);
    }
  }
}
DI void phase13(const Params& p) { sliced_pass<0>(p); }
DI void phase14(const Params& p) {
  char* ws = p.ws;
  const float* invU = (const float*)(ws + OFF_INVU);
  const float* invV = (const float*)(ws + OFF_INVV);
  const int* elist = (const int*)(ws + OFF_ELIST);
  float* glist = (float*)(ws + OFF_GLIST);
  const float* pd = (const float*)(ws + OFF_PD);
  const int lane = threadIdx.x & 63, w = threadIdx.x >> 6;
  for (int t = blockIdx.x * 4 + w; t < NTOK; t += gridDim.x * 4) {
#pragma unroll
    for (int hf_ = 0; hf_ < 2; ++hf_) {
      const int k = hf_ * 64 + lane;
      float d = 0.f;
#pragma unroll
      for (int s = 0; s < 8; ++s) d += pd[(size_t)t * 1024 + s * 128 + k];
      const int e = elist[(size_t)t * 128 + k];
      const float g = glist[(size_t)t * 128 + k];
      ((unsigned*)glist)[(size_t)t * 128 + k] = (pack2(0.f, g * geluf_(d * invU[e]) * invV[e]) & 0xFFFF0000u) | (unsigned)e;
    }
  }
}
DI void phase15(const Params& p) { sliced_pass<1>(p); }
DI void phase16(const Params& p) {
  const int lane = threadIdx.x & 63, w = threadIdx.x >> 6;
  for (int tok = blockIdx.x * 4 + w; tok < NTOK; tok += gridDim.x * 4) {
    float* xr = p.out + (size_t)tok * DM;
    float4 xv[4];
    float ss = 0.f;
#pragma unroll
    for (int i = 0; i < 4; ++i) {
      xv[i] = *(const float4*)(xr + (i * 64 + lane) * 4);
      ss += xv[i].x * xv[i].x + xv[i].y * xv[i].y + xv[i].z * xv[i].z + xv[i].w * xv[i].w;
    }
    ss = wsum(ss);
    const float rstd = rsqrtf(ss * (1.f / 1024.f) + 1e-6f);
#pragma unroll
    for (int i = 0; i < 4; ++i) {
      const int e = (i * 64 + lane) * 4;
      float4 nf = *(const float4*)(p.norm_final + e);
      *(float4*)(xr + e) = make_float4(xv[i].x * rstd * nf.x, xv[i].y * rstd * nf.y, xv[i].z * rstd * nf.z, xv[i].w * rstd * nf.w);
    }
  }
}

#define XB_TMO      128
#define XB_XCNT(j)  (256  + 64 * (j))
#define XB_XSUB(j)  (1280 + 64 * (j))
#define XB_XGEN(j)  (2304 + 64 * (j))
#define XB_TOP      3328
#define XB_TOPGEN   3392
#define XCD_BAR_WORDS 3456
#define XB_SPIN_CAP (1u << 22)
#define LAS __attribute__((address_space(3)))
DI unsigned xb_ld(unsigned* p) { return __hip_atomic_load(p, __ATOMIC_RELAXED, __HIP_MEMORY_SCOPE_AGENT); }
DI unsigned xb_add(unsigned* p, unsigned v) { return __hip_atomic_fetch_add(p, v, __ATOMIC_RELAXED, __HIP_MEMORY_SCOPE_AGENT); }
DI unsigned xb_xcc_id() { return (unsigned)__builtin_amdgcn_s_getreg((3 << 11) | 20) & 0xFu; }
#define XB_SPIN(cond, bar) do { unsigned _sp = 0; while (cond) { __builtin_amdgcn_s_sleep(1); \
    if ((++_sp & 255u) == 0u) { if (xb_ld(&(bar)[XB_TMO])) break; if (_sp > XB_SPIN_CAP) { atomicAdd(&(bar)[XB_TMO], 1u); break; } } } } while (0)
struct XcdBarrier { unsigned* bar; unsigned x; volatile LAS unsigned* st; };
DI XcdBarrier xcd_barrier_post(unsigned* bar, volatile LAS unsigned* st) {
  XcdBarrier b; b.bar = bar; b.x = xb_xcc_id(); b.st = st;
  if (threadIdx.x == 0) (void)xb_add(&bar[XB_XCNT(b.x)], 1u);
  return b;
}
DI void xcd_barrier_complete(unsigned* bar, unsigned x, unsigned& nloc, unsigned& nx) {
  const unsigned G = gridDim.x * gridDim.y * gridDim.z;
  unsigned sum, cnt, mine, sp = 0u;
  for (;;) {
    sum = 0u; cnt = 0u; mine = 0u;
#pragma unroll
    for (unsigned j = 0; j < 16; ++j) { const unsigned c = xb_ld(&bar[XB_XCNT(j)]); sum += c; cnt += (c > 0u) ? 1u : 0u; mine = (j == x) ? c : mine; }
    if (sum == G) break;
    __builtin_amdgcn_s_sleep(1);
    if ((++sp & 255u) == 0u) { if (xb_ld(&bar[XB_TMO])) break; if (sp > XB_SPIN_CAP) { atomicAdd(&bar[XB_TMO], 1u); break; } }
  }
  nloc = mine > 0u ? mine : 1u; nx = cnt > 0u ? cnt : 1u;
}
DI void xcd_barrier(const XcdBarrier& b) {
  asm volatile("s_waitcnt vmcnt(0)" ::: "memory");
  __syncthreads();
  if (threadIdx.x == 0) {
    unsigned* bar = b.bar;
    __builtin_amdgcn_s_waitcnt(0);
    unsigned nloc = b.st[0], nx = b.st[1];
    if (nloc == 0u) { xcd_barrier_complete(bar, b.x, nloc, nx); b.st[0] = nloc; b.st[1] = nx; }
    const unsigned old = xb_add(&bar[XB_XSUB(b.x)], 1u);
    const unsigned gen = old / nloc;
    if (old + 1u == (gen + 1u) * nloc) {
      __builtin_amdgcn_fence(__ATOMIC_RELEASE, "agent");
      asm volatile("s_waitcnt vmcnt(0)" ::: "memory");
      const unsigned og = xb_add(&bar[XB_TOP], 1u);
      const unsigned tg = og / nx;
      if (og + 1u == (tg + 1u) * nx) xb_add(&bar[XB_TOPGEN], 1u);
      else XB_SPIN(xb_ld(&bar[XB_TOPGEN]) == tg, bar);
      __builtin_amdgcn_fence(__ATOMIC_ACQUIRE, "agent");
      xb_add(&bar[XB_XGEN(b.x)], 1u);
      asm volatile("s_waitcnt vmcnt(0)" ::: "memory");
    } else {
      XB_SPIN(xb_ld(&bar[XB_XGEN(b.x)]) == gen, bar);
      __builtin_amdgcn_fence(__ATOMIC_ACQUIRE, "agent");
      asm volatile("s_waitcnt vmcnt(0)" ::: "memory");
    }
  }
  __syncthreads();
}

#ifdef ONLY_PHASE
#define RUNPH(n, call) if (ONLY_PHASE == n) { call; }
#else
#ifndef DUP_PHASE
#define DUP_PHASE -1
#endif
#define RUNPH(n, call) if (lo <= n && n < hi) { call; if (n == DUP_PHASE) { xcd_barrier(xb); call; } if (n + 1 < hi) xcd_barrier(xb); }
#endif
__global__ void __launch_bounds__(256, 2) mega(Params p, int lo, int hi) {
  __shared__ __attribute__((aligned(16))) char smem[SMEM_BYTES];
  __shared__ uint4 xb_words;
  cg::grid_group grid = cg::this_grid();
  if (lo < 0) grid.sync();
  if (threadIdx.x == 0) xb_words = make_uint4(0u, 0u, 0u, 0u);
  __syncthreads();
  XcdBarrier xb = xcd_barrier_post((unsigned*)(p.ws + OFF_BAR), (volatile LAS unsigned*)&xb_words);
  RUNPH(0, phase0(p, smem))
  RUNPH(1, phase1(p, smem))
  RUNPH(2, phase2(p, smem))
  RUNPH(3, phase3(p, smem))
  RUNPH(4, phase4(p))
  RUNPH(5, phase5(p, smem))
  RUNPH(6, phase6(p, smem))
  RUNPH(7, phase7(p, smem))
  RUNPH(8, phase8(p, smem))
  RUNPH(9, phase9(p, smem))
  RUNPH(10, phase10(p, smem))
  RUNPH(11, phase11(p, smem))
  RUNPH(12, phase12(p, smem))
  RUNPH(13, phase13(p))
  RUNPH(14, phase14(p))
  RUNPH(15, phase15(p))
  RUNPH(16, phase16(p))
}

extern "C" void kernel_launch(void* const* d_in, const int* in_sizes, int n_in, void* d_out, int out_size, void* d_ws,
                              size_t ws_size, hipStream_t stream) {
  static int grid_blocks = 0;
  if (!grid_blocks) {
    int dev = 0, cus = 0, per_cu = 0;
    hipGetDevice(&dev);
    hipDeviceGetAttribute(&cus, hipDeviceAttributeMultiprocessorCount, dev);
    hipOccupancyMaxActiveBlocksPerMultiprocessor(&per_cu, mega, 256, 0);
    if (per_cu > 2) per_cu = 2;
    if (per_cu < 1) per_cu = 1;
    grid_blocks = cus * per_cu;
  }
  Params p{};
  const float** pp = (const float**)&p;
  for (int i = 0; i < 29; ++i) pp[i] = (const float*)d_in[i];
  p.out = (float*)d_out;
  p.ws = (char*)d_ws;
#if N_LAUNCH_SPLIT
  for (int ph = 0; ph < NPHASE; ++ph) {
    hipLaunchKernelGGL(mega, dim3(grid_blocks), dim3(256), 0, stream, p, ph, ph + 1);
  }
#else
  hipMemsetAsync((char*)d_ws + OFF_MOD, 0, (OFF_BAR - OFF_MOD) + XCD_BAR_WORDS * sizeof(unsigned), stream);
  int lo = 0, hi = NPHASE;
  void* args[] = {&p, &lo, &hi};
  hipError_t e = hipLaunchCooperativeKernel((void*)mega, dim3(grid_blocks), dim3(256), args, 0, stream);
  if (e != hipSuccess) fprintf(stderr, "cooperative launch failed: %s (grid %d)\n", hipGetErrorString(e), grid_blocks);
#endif
}
```

```cpp
#include <hip/hip_runtime.h>
#include <hip/hip_cooperative_groups.h>
#include <cstdio>
namespace cg = cooperative_groups;

#define DI __device__ __forceinline__
typedef unsigned short bf16_t;
using bf16x8 = __attribute__((ext_vector_type(8))) short;
using f32x4 = __attribute__((ext_vector_type(4))) float;
using u32x4 = __attribute__((ext_vector_type(4))) unsigned;
using u32x2 = __attribute__((ext_vector_type(2))) unsigned;

#ifndef N_LAUNCH_SPLIT
#define N_LAUNCH_SPLIT 0
#endif

constexpr int NTOK = 20480, NPT = 4096, DM = 1024;
constexpr int NPHASE = 17;
constexpr size_t MiB = 1u << 20;
constexpr size_t OFF_WINT = 0, OFF_WUQT = 9 * MiB, OFF_WUKVT = 9 * MiB + 512 * 1024, OFF_WUPAT = 10 * MiB,
                 OFF_WUPBT = 11 * MiB, OFF_WOT = 12 * MiB, OFF_WCT = 14 * MiB, OFF_WPQB = 18 * MiB,
                 OFF_KEYSB = 22 * MiB, OFF_MOD = 22 * MiB + 512 * 1024, OFF_BAR = 22 * MiB + 768 * 1024, OFF_ROPE = 23 * MiB, A0 = 24 * MiB;
constexpr size_t OFF_PD = A0 + 104 * MiB, OFF_H1 = A0 + 0, OFF_CQ = A0 + 40 * MiB, OFF_CKVRAW = A0 + 50 * MiB, OFF_KRRAW = A0 + 60 * MiB,
                 OFF_RQ = A0 + 63 * MiB, OFF_RK = A0 + 83 * MiB, OFF_KT = A0 + 103 * MiB, OFF_VT = A0 + 123 * MiB,
                 OFF_SRG = A0 + 143 * MiB, OFF_CKVALL = A0 + 163 * MiB, OFF_KRALL = A0 + 169 * MiB,
                 OFF_UF = A0 + 171 * MiB, OFF_UB = A0 + 187 * MiB,
                 OFF_SF = A0 + 0, OFF_SB = A0 + 8 * MiB, OFF_RET = A0 + 16 * MiB,
                 OFF_Q = A0 + 63 * MiB, OFF_KN = A0 + 93 * MiB, OFF_VTA = A0 + 117 * MiB, OFF_ATTN = A0 + 141 * MiB,
                 OFF_M = A0 + 163 * MiB,
                 OFF_H2 = A0 + 56 * MiB, OFF_TABU = A0 + 36 * MiB, OFF_TABV = A0 + 0, OFF_INVU = A0 + 52 * MiB,
                 OFF_INVV = A0 + 53 * MiB, OFF_ELIST = A0 + 16 * MiB, OFF_GLIST = A0 + 26 * MiB, OFF_SCORES = A0 + 104 * MiB;
constexpr size_t OUT_CKV = 20971520, OUT_KR = 21495808, OUT_SF = 21626880, OUT_SB = 22675456;
constexpr int NKV = 24576;
constexpr int SMEM_BYTES = 73728;

struct Params {
  const float *x_prompt, *x_sample, *c, *cache_ckv, *cache_krope, *st_f, *st_b, *c_ctx, *w_mod, *b_mod, *norm_mix,
      *norm_ffn, *norm_final, *w_in, *q_norm, *kv_norm, *w_uq, *w_ukv, *lg_f, *lg_b, *ret_gn, *w_up_a, *w_up_b, *w_o,
      *peer_wq, *keys1, *keys2, *peer_u, *peer_v;
  float* out;
  char* ws;
};

DI unsigned f2bf(float x) {
  unsigned u = __float_as_uint(x);
  u += 0x7fffu + ((u >> 16) & 1u);
  return u >> 16;
}
DI float bf2f(unsigned b) { return __uint_as_float(b << 16); }
typedef __bf16 hbf16x2_t __attribute__((ext_vector_type(2)));
typedef float hf32x2_t __attribute__((ext_vector_type(2)));
DI unsigned pack2(float a, float b) {
  hf32x2_t f = {a, b};
  return __builtin_bit_cast(unsigned, __builtin_convertvector(f, hbf16x2_t));
}
DI float ex2(float x) { return __builtin_amdgcn_exp2f(x); }
DI float bflo(unsigned u) { return __uint_as_float(u << 16); }
DI float bfhi(unsigned u) { return __uint_as_float(u & 0xffff0000u); }
DI float wsum(float v) {
#pragma unroll
  for (int o = 32; o > 0; o >>= 1) v += __shfl_xor(v, o);
  return v;
}
DI float sigmoidf_(float x) { return __builtin_amdgcn_rcpf(1.f + __builtin_amdgcn_exp2f(-1.4426950408889634f * x)); }
DI float siluf_(float x) { return x * __builtin_amdgcn_rcpf(1.f + __builtin_amdgcn_exp2f(-1.4426950408889634f * x)); }
DI float geluf_(float x) { return 0.5f * x * (1.f + tanhf(0.7978845608028654f * (x + 0.044715f * x * x * x))); }
DI const float* xrow(const Params& p, int tok) {
  return tok < NPT ? p.x_prompt + (size_t)tok * DM : p.x_sample + (size_t)(tok - NPT) * DM;
}
DI int modidx(int tok) { return tok < NPT ? 0 : 1 + ((tok - NPT) >> 11); }
DI int kvrow(int tok) {
  if (tok < NPT) return tok;
  int t = tok - NPT;
  return NPT + (t >> 11) * 2560 + (t & 2047);
}
DI void st_bf16x16(bf16_t* dst, const float (&v)[16]) {
  u32x4 a, b;
  a[0] = pack2(v[0], v[1]); a[1] = pack2(v[2], v[3]); a[2] = pack2(v[4], v[5]); a[3] = pack2(v[6], v[7]);
  b[0] = pack2(v[8], v[9]); b[1] = pack2(v[10], v[11]); b[2] = pack2(v[12], v[13]); b[3] = pack2(v[14], v[15]);
  *(u32x4*)dst = a;
  *(u32x4*)(dst + 8) = b;
}
DI void st_f32x16(float* dst, const float (&v)[16]) {
#pragma unroll
  for (int i = 0; i < 4; ++i) *(float4*)(dst + 4 * i) = make_float4(v[4 * i], v[4 * i + 1], v[4 * i + 2], v[4 * i + 3]);
}
DI void ld_bf16x16(const bf16_t* src, float (&v)[16]) {
  u32x4 a = *(const u32x4*)src, b = *(const u32x4*)(src + 8);
#pragma unroll
  for (int i = 0; i < 4; ++i) {
    v[2 * i] = bflo(a[i]); v[2 * i + 1] = bfhi(a[i]);
    v[8 + 2 * i] = bflo(b[i]); v[8 + 2 * i + 1] = bfhi(b[i]);
  }
}

constexpr int LDK = 64;
DI void gemm_issue0(const bf16_t* __restrict__ A, int lda, const bf16_t* __restrict__ B, int ldb, u32x4 (&ra)[4], u32x4 (&rb)[4]) {
  const int tid = threadIdx.x;
#pragma unroll
  for (int i = 0; i < 4; ++i) {
    const int c = tid + 256 * i;
    const int r = c >> 3, k8 = (c & 7) * 8;
    ra[i] = *(const u32x4*)(A + (size_t)r * lda + k8);
    rb[i] = *(const u32x4*)(B + (size_t)r * ldb + k8);
  }
}
template <int SCALE>
DI void gemm_kloop_pre(f32x4 (&acc)[4][4], const bf16_t* __restrict__ A, int lda, const bf16_t* __restrict__ B, int ldb,
                       int K, char* smem, float sc_a, float sc_b, u32x4 (&ra)[4], u32x4 (&rb)[4]) {
  bf16_t* As = (bf16_t*)smem;
  bf16_t* Bs = As + 128 * LDK;
  const int tid = threadIdx.x, lane = tid & 63, w = tid >> 6, wm = w >> 1, wn = w & 1, l15 = lane & 15, g = lane >> 4;
  int arow[4], kc[4], ldsa[4], ldsb[4];
#pragma unroll
  for (int i = 0; i < 4; ++i) {
    int c = tid + 256 * i;
    int r = c >> 3;
    kc[i] = (c & 7) * 8;
    arow[i] = r;
    int rr = r & 63;
    int rho = (r & 64) | (((rr >> 2) & 3) << 4) | ((rr >> 4) << 2) | (rr & 3);
    ldsa[i] = rho * LDK + (((c & 7) ^ ((rho >> 1) & 7)) * 8);
    ldsb[i] = r * LDK + (((c & 7) ^ ((r >> 1) & 7)) * 8);
  }
  __syncthreads();
#pragma unroll
  for (int i = 0; i < 4; ++i) {
    *(u32x4*)(As + ldsa[i]) = ra[i];
    *(u32x4*)(Bs + ldsb[i]) = rb[i];
  }
  if (64 < K) {
#pragma unroll
    for (int i = 0; i < 4; ++i) {
      ra[i] = *(const u32x4*)(A + (size_t)arow[i] * lda + 64 + kc[i]);
      rb[i] = *(const u32x4*)(B + (size_t)arow[i] * ldb + 64 + kc[i]);
    }
  }
  __syncthreads();
  int buf = 0;
  for (int k0 = 0; k0 < K; k0 += 64, buf ^= 1) {
    const bf16_t* Ac = As + buf * (256 * LDK);
    const bf16_t* Bc = Bs + buf * (256 * LDK);
#pragma unroll
    for (int ks = 0; ks < 2; ++ks) {
      bf16x8 af[4], bfr[4];
#pragma unroll
      for (int f = 0; f < 4; ++f)
        af[f] = *(const bf16x8*)(Ac + (wm * 64 + f * 16 + l15) * LDK + (((ks * 4 + g) ^ (l15 >> 1)) * 8));
#pragma unroll
      for (int c = 0; c < 4; ++c)
        bfr[c] = *(const bf16x8*)(Bc + (wn * 64 + c * 16 + l15) * LDK + (((ks * 4 + g) ^ (l15 >> 1)) * 8));
      if (SCALE) {
        float fac[8];
#pragma unroll
        for (int i = 0; i < 8; ++i) fac[i] = ex2(sc_a + sc_b * (float)(k0 + ks * 32 + g * 8 + i));
#pragma unroll
        for (int f = 0; f < 4; ++f) {
          u32x4 u = __builtin_bit_cast(u32x4, af[f]);
#pragma unroll
          for (int i = 0; i < 4; ++i) u[i] = pack2(bflo(u[i]) * fac[2 * i], bfhi(u[i]) * fac[2 * i + 1]);
          af[f] = __builtin_bit_cast(bf16x8, u);
        }
      }
#pragma unroll
      for (int f = 0; f < 4; ++f)
#pragma unroll
        for (int c = 0; c < 4; ++c) acc[f][c] = __builtin_amdgcn_mfma_f32_16x16x32_bf16(af[f], bfr[c], acc[f][c], 0, 0, 0);
    }
    if (k0 + 64 < K) {
      bf16_t* An = As + (buf ^ 1) * (256 * LDK);
      bf16_t* Bn = Bs + (buf ^ 1) * (256 * LDK);
#pragma unroll
      for (int i = 0; i < 4; ++i) {
        *(u32x4*)(An + ldsa[i]) = ra[i];
        *(u32x4*)(Bn + ldsb[i]) = rb[i];
      }
      if (k0 + 128 < K) {
#pragma unroll
        for (int i = 0; i < 4; ++i) {
          ra[i] = *(const u32x4*)(A + (size_t)arow[i] * lda + k0 + 128 + kc[i]);
          rb[i] = *(const u32x4*)(B + (size_t)arow[i] * ldb + k0 + 128 + kc[i]);
        }
      }
      __syncthreads();
    }
  }
}
template <int SCALE>
DI void gemm_kloop(f32x4 (&acc)[4][4], const bf16_t* __restrict__ A, int lda, const bf16_t* __restrict__ B, int ldb,
                   int K, char* smem, float sc_a, float sc_b) {
  u32x4 ra[4], rb[4];
  gemm_issue0(A, lda, B, ldb, ra, rb);
  gemm_kloop_pre<SCALE>(acc, A, lda, B, ldb, K, smem, sc_a, sc_b, ra, rb);
}
DI void acc_zero(f32x4 (&acc)[4][4]) {
#pragma unroll
  for (int f = 0; f < 4; ++f)
#pragma unroll
    for (int c = 0; c < 4; ++c) acc[f][c] = f32x4{0.f, 0.f, 0.f, 0.f};
}
template <class F>
DI void epilogue(const f32x4 (&acc)[4][4], F&& epi) {
  const int tid = threadIdx.x, lane = tid & 63, w = tid >> 6, wm = w >> 1, wn = w & 1, l15 = lane & 15, g = lane >> 4;
#pragma unroll
  for (int c = 0; c < 4; ++c) {
    float v[16];
#pragma unroll
    for (int f = 0; f < 4; ++f)
#pragma unroll
      for (int j = 0; j < 4; ++j) v[f * 4 + j] = acc[f][c][j];
    epi(wm * 64 + 16 * g, wn * 64 + c * 16 + l15, v);
  }
}
DI bool tile_map(int it, int Ft, int Tt, int fsplit, int& ft, int& tt) {
  const int bid = blockIdx.x, nb = gridDim.x;
  int xcd = bid & 7, loc = bid >> 3, nloc = nb >> 3;
  if (loc >= nloc) return false;
  int fg = xcd % fsplit, tg = xcd / fsplit, tsplit = 8 / fsplit;
  int Fg = Ft / fsplit, Tg = Tt / tsplit;
  int i = loc + it * nloc;
  if (i >= Fg * Tg) return false;
  ft = fg * Fg + i % Fg;
  tt = tg * Tg + i / Fg;
  return true;
}
DI int vbid() {
  const int bid = blockIdx.x, nb = gridDim.x;
  if (nb & 7) return bid;
  return (bid & 7) * (nb >> 3) + (bid >> 3);
}

DI int colmap(int mode, int np) {
  if (mode == 1) return np < 416 ? np : (np < 512 ? -1 : np - 96);
  if (mode == 2) return np < 512 ? ((np >> 6) * 128 + (np & 63)) : (((np - 512) >> 6) * 128 + 64 + ((np - 512) & 63));
  return np;
}
DI void tconv_tile(const float* __restrict__ src, int ldsrc, bf16_t* __restrict__ dst, int K, int kt, int nt, int mode,
                   char* smem) {
  float* lds = (float*)smem;
  const int tid = threadIdx.x;
  {
    int col = tid & 63, rq = tid >> 6;
    int n = colmap(mode, nt * 64 + col);
#pragma unroll 4
    for (int r = 0; r < 16; ++r) {
      int kl = r * 4 + rq;
      float v = n >= 0 ? src[(size_t)(kt * 64 + kl) * ldsrc + n] : 0.f;
      lds[kl * 65 + col] = v;
    }
  }
  __syncthreads();
  {
    int nl = tid >> 2, kq = (tid & 3) * 16;
    float v[16];
#pragma unroll
    for (int i = 0; i < 16; ++i) v[i] = lds[(kq + i) * 65 + nl];
    st_bf16x16(dst + (size_t)(nt * 64 + nl) * K + kt * 64 + kq, v);
  }
  __syncthreads();
}
DI void mod_item(const Params& p, int item, char* smem) {
  float* sil = (float*)smem;
  const int tid = threadIdx.x;
  const int cg_ = item >> 2, slab = item & 3, kbase = slab * 256;
  for (int i = tid; i < 9 * 256; i += 256) {
    int j = i >> 8, k = kbase + (i & 255);
    float cv = j == 0 ? p.c_ctx[k] : p.c[(j - 1) * 1024 + k];
    sil[i] = siluf_(cv);
  }
  __syncthreads();
  const int kq = tid >> 6, nn = tid & 63, n0 = cg_ * 64;
  float acc[9];
#pragma unroll
  for (int j = 0; j < 9; ++j) acc[j] = 0.f;
#pragma unroll 1
  for (int i0 = 0; i0 < 64; i0 += 16) {
    float wv[16];
#pragma unroll
    for (int i = 0; i < 16; ++i) wv[i] = p.w_mod[(size_t)(kbase + kq + 4 * (i0 + i)) * 6144 + n0 + nn];
#pragma unroll
    for (int i = 0; i < 16; ++i)
#pragma unroll
      for (int j = 0; j < 9; ++j) acc[j] += sil[j * 256 + kq + 4 * (i0 + i)] * wv[i];
  }
  __syncthreads();
  float* part = (float*)smem + 9 * 256;
#pragma unroll
  for (int j = 0; j < 9; ++j) part[(kq * 9 + j) * 64 + nn] = acc[j];
  __syncthreads();
  float* mod = (float*)(p.ws + OFF_MOD);
  for (int i = tid; i < 9 * 64; i += 256) {
    int j = i >> 6, n = i & 63;
    float s = part[(0 * 9 + j) * 64 + n] + part[(1 * 9 + j) * 64 + n] + part[(2 * 9 + j) * 64 + n] + part[(3 * 9 + j) * 64 + n];
    if (slab == 0) s += p.b_mod[n0 + n];
    atomicAdd(mod + j * 6144 + n0 + n, s);
  }
  __syncthreads();
}
DI void conv_flat(const float* __restrict__ src, bf16_t* __restrict__ dst, size_t n) {
  size_t i = ((size_t)blockIdx.x * 256 + threadIdx.x) * 8;
  const size_t stride = (size_t)gridDim.x * 256 * 8;
  for (; i < n; i += stride) {
    float4 a = *(const float4*)(src + i), b = *(const float4*)(src + i + 4);
    u32x4 o;
    o[0] = pack2(a.x, a.y); o[1] = pack2(a.z, a.w); o[2] = pack2(b.x, b.y); o[3] = pack2(b.z, b.w);
    *(u32x4*)(dst + i) = o;
  }
}
DI void phase0(const Params& p, char* smem) {
  const int bid = blockIdx.x, nb = gridDim.x;
  char* ws = p.ws;
  const int n_mod = 384;
  const int t_in = 16 * 72, t_uq = 4 * 12, t_ukv = 2 * 16, t_upa = 8 * 16, t_upb = 8 * 16, t_o = 16 * 16;
  const int total = n_mod + t_in + t_uq + t_ukv + t_upa + t_upb + t_o;
  for (int it = bid; it < total; it += nb) {
    int i = it;
    if (i < n_mod) { mod_item(p, i, smem); continue; }
    i -= n_mod;
    if (i < t_in) { tconv_tile(p.w_in, 4512, (bf16_t*)(ws + OFF_WINT), 1024, i / 72, i % 72, 1, smem); continue; }
    i -= t_in;
    if (i < t_uq) { tconv_tile(p.w_uq, 768, (bf16_t*)(ws + OFF_WUQT), 256, i / 12, i % 12, 0, smem); continue; }
    i -= t_uq;
    if (i < t_ukv) { tconv_tile(p.w_ukv, 1024, (bf16_t*)(ws + OFF_WUKVT), 128, i / 16, i % 16, 2, smem); continue; }
    i -= t_ukv;
    if (i < t_upa) { tconv_tile(p.w_up_a, 1024, (bf16_t*)(ws + OFF_WUPAT), 512, i / 16, i % 16, 0, smem); continue; }
    i -= t_upa;
    if (i < t_upb) { tconv_tile(p.w_up_b, 1024, (bf16_t*)(ws + OFF_WUPBT), 512, i / 16, i % 16, 0, smem); continue; }
    i -= t_upb;
    tconv_tile(p.w_o, 1024, (bf16_t*)(ws + OFF_WOT), 1024, i / 16, i % 16, 0, smem);
  }
  conv_flat(p.peer_wq, (bf16_t*)(ws + OFF_WPQB), (size_t)1024 * 2048);
  {
    size_t i = ((size_t)bid * 256 + threadIdx.x) * 8;
    const size_t stride = (size_t)nb * 256 * 8;
    bf16_t* kb = (bf16_t*)(ws + OFF_KEYSB);
    for (; i < (size_t)2 * 131072; i += stride) {
      int half = i >= 131072;
      size_t s = i - (size_t)half * 131072;
      int h = (int)(s >> 14);
      size_t r = s & 16383;
      const float* src = (half ? p.keys2 : p.keys1) + s;
      float4 a = *(const float4*)(src), b = *(const float4*)(src + 4);
      u32x4 o;
      o[0] = pack2(a.x, a.y); o[1] = pack2(a.z, a.w); o[2] = pack2(b.x, b.y); o[3] = pack2(b.z, b.w);
      *(u32x4*)(kb + ((size_t)(h * 2 + half) << 14) + r) = o;
    }
  }
  {
    float2* rope = (float2*)(ws + OFF_ROPE);
    for (int idx = bid * 256 + threadIdx.x; idx < 2048 * 16; idx += nb * 256) {
      const int t = idx >> 4, a = idx & 15;
      const float pos = (a < 8) ? (float)(t >> 6) : (float)(t & 63);
      const float fr = exp2f(-(float)(a & 7) * 1.6609640474436813f);
      float sn, cs;
      sincosf(pos * fr, &sn, &cs);
      rope[idx] = make_float2(cs, sn);
    }
  }
}

DI void rows_norm_mod(const Params& p, const float* nw, int sh_off, int sc_off, bool from_out, bf16_t* dst) {
  const int lane = threadIdx.x & 63, w = threadIdx.x >> 6;
  const float* mod = (const float*)(p.ws + OFF_MOD);
  for (int tok = blockIdx.x * 4 + w; tok < NTOK; tok += gridDim.x * 4) {
    const float* xr = from_out ? p.out + (size_t)tok * DM : xrow(p, tok);
    const float* mj = mod + modidx(tok) * 6144;
    float4 xv[4];
    float ss = 0.f;
#pragma unroll
    for (int i = 0; i < 4; ++i) {
      xv[i] = *(const float4*)(xr + (i * 64 + lane) * 4);
      ss += xv[i].x * xv[i].x + xv[i].y * xv[i].y + xv[i].z * xv[i].z + xv[i].w * xv[i].w;
    }
    ss = wsum(ss);
    float rstd = rsqrtf(ss * (1.f / 1024.f) + 1e-6f);
#pragma unroll
    for (int i = 0; i < 4; ++i) {
      int e = (i * 64 + lane) * 4;
      float4 nv = *(const float4*)(nw + e), sh = *(const float4*)(mj + sh_off + e), sc = *(const float4*)(mj + sc_off + e);
      float h0 = (xv[i].x * rstd) * nv.x * (1.f + sc.x) + sh.x;
      float h1 = (xv[i].y * rstd) * nv.y * (1.f + sc.y) + sh.y;
      float h2 = (xv[i].z * rstd) * nv.z * (1.f + sc.z) + sh.z;
      float h3 = (xv[i].w * rstd) * nv.w * (1.f + sc.w) + sh.w;
      u32x2 o;
      o[0] = pack2(h0, h1); o[1] = pack2(h2, h3);
      *(u32x2*)(dst + (size_t)tok * DM + e) = o;
    }
  }
}
DI void phase1(const Params& p, char* smem) {
  rows_norm_mod(p, p.norm_mix, 0, 1024, false, (bf16_t*)(p.ws + OFF_H1));
  const bf16_t* wpq = (const bf16_t*)(p.ws + OFF_WPQB);
  const bf16_t* kb = (const bf16_t*)(p.ws + OFF_KEYSB);
  bf16_t* wct = (bf16_t*)(p.ws + OFF_WCT);
  for (int it = blockIdx.x; it < 128; it += gridDim.x) {
    int hh = it >> 3, mt = it & 7;
    f32x4 acc[4][4];
    acc_zero(acc);
    gemm_kloop<0>(acc, wpq + (size_t)(mt * 128) * 2048 + hh * 128, 2048, kb + (size_t)hh * 16384, 128, 128, smem, 0.f, 0.f);
    epilogue(acc, [&](int m, int n, float (&v)[16]) { st_bf16x16(wct + (size_t)(hh * 128 + n) * 1024 + mt * 128 + m, v); });
  }
}

DI void phase2(const Params& p, char* smem) {
  char* ws = p.ws;
  const bf16_t* winT = (const bf16_t*)(ws + OFF_WINT);
  const bf16_t* h1 = (const bf16_t*)(ws + OFF_H1);
  bf16_t* cq = (bf16_t*)(ws + OFF_CQ);
  float* ckvraw = (float*)(ws + OFF_CKVRAW);
  float* krraw = (float*)(ws + OFF_KRRAW);
  bf16_t* rq = (bf16_t*)(ws + OFF_RQ);
  bf16_t* rk = (bf16_t*)(ws + OFF_RK);
  bf16_t* kT = (bf16_t*)(ws + OFF_KT);
  bf16_t* vT = (bf16_t*)(ws + OFF_VT);
  bf16_t* srg = (bf16_t*)(ws + OFF_SRG);
  bf16_t* sga = (bf16_t*)p.out;
  bf16_t* sgb = sga + (size_t)NTOK * 1024;
  u32x4 pra[4], prb[4];
  int ft, tt;
  bool have = tile_map(0, 36, 160, 4, ft, tt);
  if (have) {
    const bf16_t* W0 = winT + (size_t)ft * 128 * 1024;
    const bf16_t* H0 = h1 + (size_t)tt * 128 * 1024;
    const bool sw = ft >= 8 && ft < 16;
    gemm_issue0(sw ? H0 : W0, 1024, sw ? W0 : H0, 1024, pra, prb);
  }
  for (int it = 0; have; ++it) {
    f32x4 acc[4][4];
    acc_zero(acc);
    const bf16_t* W = winT + (size_t)ft * 128 * 1024;
    const bf16_t* H = h1 + (size_t)tt * 128 * 1024;
    const int tok0 = tt * 128, f0 = ft * 128;
    const bool swp = ft >= 8 && ft < 16;
    gemm_kloop_pre<0>(acc, swp ? H : W, 1024, swp ? W : H, 1024, 1024, smem, 0.f, 0.f, pra, prb);
    int ft2 = 0, tt2 = 0;
    const bool have2 = tile_map(it + 1, 36, 160, 4, ft2, tt2);
    if (have2) {
      const bf16_t* W2 = winT + (size_t)ft2 * 128 * 1024;
      const bf16_t* H2 = h1 + (size_t)tt2 * 128 * 1024;
      const bool sw2 = ft2 >= 8 && ft2 < 16;
      gemm_issue0(sw2 ? H2 : W2, 1024, sw2 ? W2 : H2, 1024, pra, prb);
    }
    if (ft >= 8 && ft < 16) {
      if (ft < 12) {
        epilogue(acc, [&](int m, int n, float (&v)[16]) {
          int feat = f0 - 1024 + n, tok = tok0 + m;
#pragma unroll
          for (int i = 0; i < 16; ++i) v[i] *= 0.08838834764831845f;
          st_bf16x16(kT + (size_t)feat * NTOK + tok, v);
#pragma unroll
          for (int i = 0; i < 16; ++i) rk[(size_t)(tok + i) * 512 + feat] = (bf16_t)f2bf(v[i]);
        });
      } else {
        epilogue(acc, [&](int m, int n, float (&v)[16]) {
          int feat = f0 - 1536 + n, tok = tok0 + m;
          st_bf16x16(vT + (size_t)feat * NTOK + tok, v);
        });
      }
    } else {
      if (ft < 2) {
        epilogue(acc, [&](int m, int n, float (&v)[16]) { st_bf16x16(cq + (size_t)(tok0 + n) * 256 + f0 + m, v); });
      } else if (ft == 2) {
        epilogue(acc, [&](int m, int n, float (&v)[16]) { st_f32x16(ckvraw + (size_t)(tok0 + n) * 128 + m, v); });
      } else if (ft == 3) {
        epilogue(acc, [&](int m, int n, float (&v)[16]) {
          if (m < 32) st_f32x16(krraw + (size_t)(tok0 + n) * 32 + m, v);
        });
      } else if (ft < 8) {
        epilogue(acc, [&](int m, int n, float (&v)[16]) { st_bf16x16(rq + (size_t)(tok0 + n) * 512 + f0 - 512 + m, v); });
      } else if (ft < 20) {
        epilogue(acc, [&](int m, int n, float (&v)[16]) {
#pragma unroll
          for (int i = 0; i < 16; ++i) v[i] = siluf_(v[i]);
          st_bf16x16(srg + (size_t)(tok0 + n) * 512 + f0 - 2048 + m, v);
        });
      } else if (ft < 28) {
        epilogue(acc, [&](int m, int n, float (&v)[16]) {
#pragma unroll
          for (int i = 0; i < 16; ++i) v[i] = sigmoidf_(v[i]);
          st_bf16x16(sga + (size_t)(tok0 + n) * 1024 + f0 - 2560 + m, v);
        });
      } else {
        epilogue(acc, [&](int m, int n, float (&v)[16]) {
#pragma unroll
          for (int i = 0; i < 16; ++i) v[i] = sigmoidf_(v[i]);
          st_bf16x16(sgb + (size_t)(tok0 + n) * 1024 + f0 - 3584 + m, v);
        });
      }
    }
    ft = ft2; tt = tt2; have = have2;
  }
}

DI float log2gamma(float logit) { return -log1pf(expf(-logit)) * 1.4426950408889634f; }
DI void phase3(const Params& p, char* smem) {
  char* ws = p.ws;
  const int lane = threadIdx.x & 63, w = threadIdx.x >> 6;
  bf16_t* cq = (bf16_t*)(ws + OFF_CQ);
  const float* ckvraw = (const float*)(ws + OFF_CKVRAW);
  const float* krraw = (const float*)(ws + OFF_KRRAW);
  bf16_t* ckvall = (bf16_t*)(ws + OFF_CKVALL);
  bf16_t* krall = (bf16_t*)(ws + OFF_KRALL);
  for (int r = blockIdx.x * 4 + w; r < NTOK + 4096; r += gridDim.x * 4) {
    if (r < NTOK) {
      const int tok = r;
      {
        u32x2 u = *(const u32x2*)(cq + (size_t)tok * 256 + lane * 4);
        float a0 = bflo(u[0]), a1 = bfhi(u[0]), a2 = bflo(u[1]), a3 = bfhi(u[1]);
        float ss = wsum(a0 * a0 + a1 * a1 + a2 * a2 + a3 * a3);
        float rstd = rsqrtf(ss * (1.f / 256.f) + 1e-6f);
        float4 nq = *(const float4*)(p.q_norm + lane * 4);
        u32x2 o;
        o[0] = pack2(a0 * rstd * nq.x, a1 * rstd * nq.y);
        o[1] = pack2(a2 * rstd * nq.z, a3 * rstd * nq.w);
        *(u32x2*)(cq + (size_t)tok * 256 + lane * 4) = o;
      }
      const int row = kvrow(tok);
      {
        float2 v = *(const float2*)(ckvraw + (size_t)tok * 128 + lane * 2);
        float ss = wsum(v.x * v.x + v.y * v.y);
        float rstd = rsqrtf(ss * (1.f / 128.f) + 1e-6f);
        float2 nk = *(const float2*)(p.kv_norm + lane * 2);
        float o0 = v.x * rstd * nk.x, o1 = v.y * rstd * nk.y;
        if (tok < NPT) *(float2*)(p.out + OUT_CKV + (size_t)tok * 128 + lane * 2) = make_float2(o0, o1);
        *(unsigned*)(ckvall + (size_t)row * 128 + lane * 2) = pack2(o0, o1);
      }
      if (lane < 32) {
        float own = krraw[(size_t)tok * 32 + lane];
        float o = own;
        if (tok < NPT) {
          p.out[OUT_KR + (size_t)tok * 32 + lane] = own;
        } else {
          float partner = krraw[(size_t)tok * 32 + (lane ^ 16)];
          int t = (tok - NPT) & 2047;
          const float2 csn = ((const float2*)(ws + OFF_ROPE))[t * 16 + (lane & 15)];
          const float cs = csn.x, sn = csn.y;
          o = lane < 16 ? own * cs - partner * sn : partner * sn + own * cs;
        }
        krall[(size_t)row * 32 + lane] = (bf16_t)f2bf(o);
      }
    } else {
      const int cr = r - NTOK;
      const int b = cr >> 9, pos = cr & 511;
      const int row = NPT + b * 2560 + 2048 + pos;
      float2 v = *(const float2*)(p.cache_ckv + (size_t)cr * 128 + lane * 2);
      *(unsigned*)(ckvall + (size_t)row * 128 + lane * 2) = pack2(v.x, v.y);
      if (lane < 32) krall[(size_t)row * 32 + lane] = (bf16_t)f2bf(p.cache_krope[(size_t)cr * 32 + lane]);
    }
  }
  const bf16_t* kT = (const bf16_t*)(ws + OFF_KT);
  const bf16_t* vT = (const bf16_t*)(ws + OFF_VT);
  float* Uf = (float*)(ws + OFF_UF);
  float* Ub = (float*)(ws + OFF_UB);
  for (int it = blockIdx.x; it < 320; it += gridDim.x) {
    const int blk = it >> 2, h = it & 3;
    const float l2f = log2gamma(p.lg_f[h]), l2b = log2gamma(p.lg_b[h]);
    const bf16_t* Kp = kT + (size_t)(h * 128) * NTOK + blk * 256;
    const bf16_t* Vp = vT + (size_t)(h * 128) * NTOK + blk * 256;
#pragma unroll 1
    for (int dir = 0; dir < 2; ++dir) {
      const float sa = dir ? 0.f : l2f * 255.f, sb = dir ? l2b : -l2f;
      f32x4 acc[4][4];
      acc_zero(acc);
      if (blk < 16) {
        gemm_kloop<1>(acc, Vp, NTOK, Kp, NTOK, 256, smem, sa, sb);
        float* dst = p.out + (dir ? OUT_SB : OUT_SF) + (size_t)(blk * 4 + h) * 16384;
        epilogue(acc, [&](int m, int n, float (&v)[16]) { st_f32x16(dst + n * 128 + m, v); });
      } else {
        gemm_kloop<1>(acc, Kp, NTOK, Vp, NTOK, 256, smem, sa, sb);
        float* dst = (dir ? Ub : Uf) + (size_t)((blk - 16) * 4 + h) * 16384;
        epilogue(acc, [&](int m, int n, float (&v)[16]) { st_f32x16(dst + n * 128 + m, v); });
      }
    }
  }
}

DI void phase4(const Params& p) {
  char* ws = p.ws;
  const float* Uf = (const float*)(ws + OFF_UF);
  const float* Ub = (const float*)(ws + OFF_UB);
  bf16_t* Sf = (bf16_t*)(ws + OFF_SF);
  bf16_t* Sb = (bf16_t*)(ws + OFF_SB);
  for (int idx = blockIdx.x * 256 + threadIdx.x; idx < (1 << 20); idx += gridDim.x * 256) {
    int d = idx & 127, e = (idx >> 7) & 127, h = (idx >> 14) & 3, b = (idx >> 16) & 7, dir = idx >> 19;
    size_t eo = (size_t)e * 128 + d;
    if (dir == 0) {
      float cf = exp2f(log2gamma(p.lg_f[h]) * 256.f);
      float S = p.st_f[(size_t)(b * 4 + h) * 16384 + d * 128 + e];
#pragma unroll
      for (int blk = 0; blk < 8; ++blk) {
        size_t o = (size_t)((b * 8 + blk) * 4 + h) * 16384 + eo;
        Sf[o] = (bf16_t)f2bf(S);
        S = cf * S + Uf[o];
      }
    } else {
      float cb = exp2f(log2gamma(p.lg_b[h]) * 256.f);
      float S = p.st_b[(size_t)(b * 4 + h) * 16384 + d * 128 + e];
#pragma unroll
      for (int blk = 7; blk >= 0; --blk) {
        size_t o = (size_t)((b * 8 + blk) * 4 + h) * 16384 + eo;
        Sb[o] = (bf16_t)f2bf(S);
        S = cb * S + Ub[o];
      }
    }
  }
}

DI bf16x8 scale_frag(bf16x8 q, float s) {
  u32x4 u = __builtin_bit_cast(u32x4, q);
#pragma unroll
  for (int i = 0; i < 4; ++i) u[i] = pack2(bflo(u[i]) * s, bfhi(u[i]) * s);
  return __builtin_bit_cast(bf16x8, u);
}
constexpr int NQT = 1;
DI void phase5(const Params& p, char* smem) {
  char* ws = p.ws;
  const bf16_t* rq = (const bf16_t*)(ws + OFF_RQ);
  const bf16_t* rk = (const bf16_t*)(ws + OFF_RK);
  const bf16_t* vT = (const bf16_t*)(ws + OFF_VT);
  const bf16_t* srg = (const bf16_t*)(ws + OFF_SRG);
  const bf16_t* Sf = (const bf16_t*)(ws + OFF_SF);
  const bf16_t* Sb = (const bf16_t*)(ws + OFF_SB);
  bf16_t* ret = (bf16_t*)(ws + OFF_RET);
  bf16_t* Ks0 = (bf16_t*)smem;
  const int tid = threadIdx.x, lane = tid & 63, w = tid >> 6, l15 = lane & 15, g = lane >> 4;
  for (int item = vbid(); item < 640 * (2 / NQT); item += gridDim.x) {
    const int qb = item >> 2, h = item & 3, blk = (qb * NQT) >> 2;
    const float l2f = log2gamma(p.lg_f[h]), l2b = log2gamma(p.lg_b[h]);
    const int tokw = qb * (64 * NQT) + w * (16 * NQT);
    bf16x8 Q[NQT][4];
#pragma unroll
    for (int qt = 0; qt < NQT; ++qt)
#pragma unroll
      for (int ks = 0; ks < 4; ++ks)
        Q[qt][ks] = *(const bf16x8*)(rq + (size_t)(tokw + qt * 16 + l15) * 512 + h * 128 + ks * 32 + g * 8);
    f32x4 o[8][NQT];
#pragma unroll
    for (int et = 0; et < 8; ++et)
#pragma unroll
      for (int qt = 0; qt < NQT; ++qt) o[et][qt] = f32x4{0.f, 0.f, 0.f, 0.f};
    u32x4 rk_[4], rv_[4];
    auto gload = [&](int kt) {
      const int key0 = blk * 256 + kt * 64;
#pragma unroll
      for (int i = 0; i < 4; ++i) {
        int c = tid + 256 * i;
        int r = c >> 4, cc = (c & 15) * 8;
        rk_[i] = *(const u32x4*)(rk + (size_t)(key0 + r) * 512 + h * 128 + cc);
        int e = c >> 3, c2 = (c & 7) * 8;
        rv_[i] = *(const u32x4*)(vT + (size_t)(h * 128 + e) * NTOK + key0 + c2);
      }
    };
    auto lstore = [&](int b_) {
      bf16_t* Kd = Ks0 + b_ * 18432;
      bf16_t* Vd = Kd + 64 * 144;
#pragma unroll
      for (int i = 0; i < 4; ++i) {
        int c = tid + 256 * i;
        int r = c >> 4, cc = (c & 15) * 8;
        *(u32x4*)(Kd + r * 144 + cc) = rk_[i];
        int e = c >> 3, c2 = (c & 7) * 8;
        *(u32x4*)(Vd + e * 72 + c2) = rv_[i];
      }
    };
    gload(0);
    __syncthreads();
    lstore(0);
    gload(1);
    __syncthreads();
#pragma unroll 1
    for (int kt = 0; kt < 4; ++kt) {
      const bf16_t* Ks = Ks0 + (kt & 1) * 18432;
      const bf16_t* Vs = Ks + 64 * 144;
      bf16x8 P[NQT][2];
#pragma unroll
      for (int qt = 0; qt < NQT; ++qt) {
        f32x4 s[4];
#pragma unroll
        for (int kk = 0; kk < 4; ++kk) s[kk] = f32x4{0.f, 0.f, 0.f, 0.f};
#pragma unroll
        for (int ks = 0; ks < 4; ++ks) {
#pragma unroll
          for (int kk = 0; kk < 4; ++kk) {
            bf16x8 a = *(const bf16x8*)(Ks + (kk * 16 + l15) * 144 + ks * 32 + g * 8);
            s[kk] = __builtin_amdgcn_mfma_f32_16x16x32_bf16(a, Q[qt][ks], s[kk], 0, 0, 0);
          }
        }
        const int iq = (tokw + qt * 16 + l15) & 255;
#pragma unroll
        for (int kk = 0; kk < 4; ++kk) {
#pragma unroll
          for (int j = 0; j < 4; ++j) {
            int jk = kt * 64 + kk * 16 + 4 * g + j;
            int diff = iq - jk;
            float dm = diff > 0 ? ex2(l2f * (float)diff) : (diff < 0 ? ex2(l2b * (float)(-diff)) : 2.f);
            s[kk][j] *= dm;
          }
        }
#pragma unroll
        for (int k2 = 0; k2 < 2; ++k2) {
          u32x4 u;
          u[0] = pack2(s[2 * k2][0], s[2 * k2][1]);
          u[1] = pack2(s[2 * k2][2], s[2 * k2][3]);
          u[2] = pack2(s[2 * k2 + 1][0], s[2 * k2 + 1][1]);
          u[3] = pack2(s[2 * k2 + 1][2], s[2 * k2 + 1][3]);
          P[qt][k2] = __builtin_bit_cast(bf16x8, u);
        }
      }
#pragma unroll
      for (int k2 = 0; k2 < 2; ++k2) {
#pragma unroll
        for (int et = 0; et < 8; ++et) {
          u32x2 lo = *(const u32x2*)(Vs + (et * 16 + l15) * 72 + k2 * 32 + 4 * g);
          u32x2 hi = *(const u32x2*)(Vs + (et * 16 + l15) * 72 + k2 * 32 + 16 + 4 * g);
          u32x4 u;
          u[0] = lo[0]; u[1] = lo[1]; u[2] = hi[0]; u[3] = hi[1];
          bf16x8 a = __builtin_bit_cast(bf16x8, u);
#pragma unroll
          for (int qt = 0; qt < NQT; ++qt) o[et][qt] = __builtin_amdgcn_mfma_f32_16x16x32_bf16(a, P[qt][k2], o[et][qt], 0, 0, 0);
        }
      }
      if (kt + 1 < 4) {
        lstore((kt + 1) & 1);
        if (kt + 2 < 4) gload(kt + 2);
        __syncthreads();
      }
    }
    if (blk >= 16) {
      bf16_t* SL = (bf16_t*)smem;
      __syncthreads();
#pragma unroll
      for (int dir = 0; dir < 2; ++dir) {
        const bf16_t* S = (dir ? Sb : Sf) + (size_t)((blk - 16) * 4 + h) * 16384;
#pragma unroll
        for (int i = 0; i < 8; ++i) {
          int c = tid + 256 * i;
          int e = c >> 4, cc = (c & 15) * 8;
          *(u32x4*)(SL + dir * (128 * 144) + e * 144 + cc) = *(const u32x4*)(S + e * 128 + cc);
        }
      }
      __syncthreads();
#pragma unroll 1
      for (int dir = 0; dir < 2; ++dir) {
        const bf16_t* S = SL + dir * (128 * 144);
        float dq[NQT];
#pragma unroll
        for (int qt = 0; qt < NQT; ++qt) {
          int iq = (tokw + qt * 16 + l15) & 255;
          dq[qt] = dir ? exp2f(l2b * (float)(256 - iq)) : exp2f(l2f * (float)(iq + 1));
        }
#pragma unroll
        for (int ks = 0; ks < 4; ++ks) {
          bf16x8 qs[NQT];
#pragma unroll
          for (int qt = 0; qt < NQT; ++qt) qs[qt] = scale_frag(Q[qt][ks], dq[qt]);
#pragma unroll
          for (int et = 0; et < 8; ++et) {
            bf16x8 a = *(const bf16x8*)(S + (et * 16 + l15) * 144 + ks * 32 + g * 8);
#pragma unroll
            for (int qt = 0; qt < NQT; ++qt) o[et][qt] = __builtin_amdgcn_mfma_f32_16x16x32_bf16(a, qs[qt], o[et][qt], 0, 0, 0);
          }
        }
      }
    }
#pragma unroll
    for (int qt = 0; qt < NQT; ++qt) {
      const int tok = tokw + qt * 16 + l15;
      float s1 = 0.f;
#pragma unroll
      for (int et = 0; et < 8; ++et)
#pragma unroll
        for (int j = 0; j < 4; ++j) s1 += o[et][qt][j];
      s1 += __shfl_xor(s1, 16);
      s1 += __shfl_xor(s1, 32);
      const float mu = s1 * (1.f / 128.f);
      float s2 = 0.f;
#pragma unroll
      for (int et = 0; et < 8; ++et)
#pragma unroll
        for (int j = 0; j < 4; ++j) {
          float dlt = o[et][qt][j] - mu;
          s2 += dlt * dlt;
        }
      s2 += __shfl_xor(s2, 16);
      s2 += __shfl_xor(s2, 32);
      const float rstd = rsqrtf(s2 * (1.f / 128.f) + 1e-6f);
#pragma unroll
      for (int et = 0; et < 8; ++et) {
        const int e = h * 128 + et * 16 + 4 * g;
        float4 gn = *(const float4*)(p.ret_gn + e);
        u32x2 sg = *(const u32x2*)(srg + (size_t)tok * 512 + e);
        u32x2 ov;
        ov[0] = pack2((o[et][qt][0] - mu) * rstd * gn.x * bflo(sg[0]), (o[et][qt][1] - mu) * rstd * gn.y * bfhi(sg[0]));
        ov[1] = pack2((o[et][qt][2] - mu) * rstd * gn.z * bflo(sg[1]), (o[et][qt][3] - mu) * rstd * gn.w * bfhi(sg[1]));
        *(u32x2*)(ret + (size_t)tok * 512 + e) = ov;
      }
    }
  }
}

DI void phase6(const Params& p, char* smem) {
  char* ws = p.ws;
  const bf16_t* cqn = (const bf16_t*)(ws + OFF_CQ);
  const bf16_t* wuqT = (const bf16_t*)(ws + OFF_WUQT);
  bf16_t* q = (bf16_t*)(ws + OFF_Q);
  for (int it = 0;; ++it) {
    int ft, tt;
    if (!tile_map(it, 6, 160, 1, ft, tt)) break;
    f32x4 acc[4][4];
    acc_zero(acc);
    gemm_kloop<0>(acc, wuqT + (size_t)ft * 128 * 256, 256, cqn + (size_t)tt * 128 * 256, 256, 256, smem, 0.f, 0.f);
    epilogue(acc, [&](int m, int n, float (&v)[16]) { st_bf16x16(q + (size_t)(tt * 128 + n) * 768 + ft * 128 + m, v); });
  }
  const bf16_t* ckvall = (const bf16_t*)(ws + OFF_CKVALL);
  const bf16_t* wukvT = (const bf16_t*)(ws + OFF_WUKVT);
  bf16_t* Kn = (bf16_t*)(ws + OFF_KN);
  bf16_t* Vt = (bf16_t*)(ws + OFF_VTA);
  for (int it = 0;; ++it) {
    int ft, tt;
    if (!tile_map(it, 8, 192, 1, ft, tt)) break;
    f32x4 acc[4][4];
    acc_zero(acc);
    const bf16_t* W = wukvT + (size_t)ft * 128 * 128;
    const bf16_t* X = ckvall + (size_t)tt * 128 * 128;
    if (ft < 4) {
      gemm_kloop<0>(acc, W, 128, X, 128, 128, smem, 0.f, 0.f);
      epilogue(acc, [&](int m, int n, float (&v)[16]) { st_bf16x16(Kn + (size_t)(tt * 128 + n) * 512 + ft * 128 + m, v); });
    } else {
      gemm_kloop<0>(acc, X, 128, W, 128, 128, smem, 0.f, 0.f);
      epilogue(acc, [&](int m, int n, float (&v)[16]) { st_bf16x16(Vt + (size_t)((ft - 4) * 128 + n) * NKV + tt * 128 + m, v); });
    }
  }
}

DI void conv_fp8_rows(const float* __restrict__ src, unsigned char* __restrict__ dst, float* __restrict__ inv);
DI void phase7(const Params& p, char* smem) {
  char* ws = p.ws;
  const bf16_t* q = (const bf16_t*)(ws + OFF_Q);
  const bf16_t* Kn = (const bf16_t*)(ws + OFF_KN);
  const bf16_t* Vt = (const bf16_t*)(ws + OFF_VTA);
  const bf16_t* krall = (const bf16_t*)(ws + OFF_KRALL);
  bf16_t* attn = (bf16_t*)(ws + OFF_ATTN);
  bf16_t* Ks0 = (bf16_t*)smem;
  const int tid = threadIdx.x, lane = tid & 63, w = tid >> 6, l15 = lane & 15, g = lane >> 4;
  const float qscale = 0.10206207261596577f * 1.4426950408889634f;
  for (int item = vbid(); item < 1280; item += gridDim.x) {
    int b, h, qtok0, keyrow0, nkt;
    bool sample;
    if (item < 1024) {
      sample = true; b = item >> 7; h = (item >> 4) & 7; int qb = item & 15;
      qtok0 = NPT + b * 2048 + qb * 128; keyrow0 = NPT + b * 2560; nkt = 40;
    } else {
      int it2 = item - 1024;
      sample = false; b = it2 >> 4; h = (it2 >> 1) & 7; int qb = it2 & 1;
      qtok0 = b * 256 + qb * 128; keyrow0 = b * 256; nkt = 4;
    }
    bf16x8 Q[2][3];
#pragma unroll
    for (int qt = 0; qt < 2; ++qt) {
      const int tokq = qtok0 + w * 32 + qt * 16 + l15;
      const bf16_t* qp = q + (size_t)tokq * 768 + h * 96;
#pragma unroll
      for (int ks = 0; ks < 3; ++ks) {
        u32x4 u = *(const u32x4*)(qp + ks * 32 + g * 8);
        float v[8];
#pragma unroll
        for (int i = 0; i < 4; ++i) { v[2 * i] = bflo(u[i]); v[2 * i + 1] = bfhi(u[i]); }
        if (ks == 2 && sample) {
          u32x4 up = *(const u32x4*)(qp + 64 + (g ^ 2) * 8);
          float pv[8];
#pragma unroll
          for (int i = 0; i < 4; ++i) { pv[2 * i] = bflo(up[i]); pv[2 * i + 1] = bfhi(up[i]); }
          int t = (tokq - NPT) & 2047;
          const float4* rp = (const float4*)((const float2*)(ws + OFF_ROPE) + t * 16 + (g & 1) * 8);
#pragma unroll
          for (int i2 = 0; i2 < 4; ++i2) {
            const float4 c2 = rp[i2];
            const int i = 2 * i2;
            v[i] = g < 2 ? v[i] * c2.x - pv[i] * c2.y : pv[i] * c2.y + v[i] * c2.x;
            v[i + 1] = g < 2 ? v[i + 1] * c2.z - pv[i + 1] * c2.w : pv[i + 1] * c2.w + v[i + 1] * c2.z;
          }
        }
        u32x4 o4;
#pragma unroll
        for (int i = 0; i < 4; ++i) o4[i] = pack2(v[2 * i] * qscale, v[2 * i + 1] * qscale);
        Q[qt][ks] = __builtin_bit_cast(bf16x8, o4);
      }
    }
    f32x4 o[4][2];
#pragma unroll
    for (int et = 0; et < 4; ++et)
#pragma unroll
      for (int qt = 0; qt < 2; ++qt) o[et][qt] = f32x4{0.f, 0.f, 0.f, 0.f};
    float mrun[2] = {-1e30f, -1e30f}, lrun[2] = {0.f, 0.f};
    u32x4 rk_[3], rv_[2];
    auto gload = [&](int kt) {
      const int row0 = keyrow0 + kt * 64;
#pragma unroll
      for (int i = 0; i < 3; ++i) {
        int c = tid + 256 * i;
        int r = c / 12, cc = c - r * 12;
        rk_[i] = cc < 8 ? *(const u32x4*)(Kn + (size_t)(row0 + r) * 512 + h * 64 + cc * 8)
                        : *(const u32x4*)(krall + (size_t)(row0 + r) * 32 + (cc - 8) * 8);
      }
#pragma unroll
      for (int i = 0; i < 2; ++i) {
        int c = tid + 256 * i;
        int e = c >> 3, cc = (c & 7) * 8;
        rv_[i] = *(const u32x4*)(Vt + (size_t)(h * 64 + e) * NKV + row0 + cc);
      }
    };
    auto lstore = [&](int b) {
      bf16_t* Kd = Ks0 + b * 11776;
      bf16_t* Vd = Kd + 64 * 112;
#pragma unroll
      for (int i = 0; i < 3; ++i) {
        int c = tid + 256 * i;
        int r = c / 12, cc = c - r * 12;
        *(u32x4*)(Kd + r * 112 + cc * 8) = rk_[i];
      }
#pragma unroll
      for (int i = 0; i < 2; ++i) {
        int c = tid + 256 * i;
        int e = c >> 3, cc = (c & 7) * 8;
        *(u32x4*)(Vd + e * 72 + cc) = rv_[i];
      }
    };
    gload(0);
    __syncthreads();
    lstore(0);
    if (nkt > 1) gload(1);
    __syncthreads();
#pragma unroll 1
    for (int kt = 0; kt < nkt; ++kt) {
      const bf16_t* Ks = Ks0 + (kt & 1) * 11776;
      const bf16_t* Vs = Ks + 64 * 112;
      f32x4 s[4][2];
#pragma unroll
      for (int kk = 0; kk < 4; ++kk)
#pragma unroll
        for (int qt = 0; qt < 2; ++qt) s[kk][qt] = f32x4{0.f, 0.f, 0.f, 0.f};
#pragma unroll
      for (int ks = 0; ks < 3; ++ks) {
#pragma unroll
        for (int kk = 0; kk < 4; ++kk) {
          bf16x8 a = *(const bf16x8*)(Ks + (kk * 16 + l15) * 112 + ks * 32 + g * 8);
#pragma unroll
          for (int qt = 0; qt < 2; ++qt) s[kk][qt] = __builtin_amdgcn_mfma_f32_16x16x32_bf16(a, Q[qt][ks], s[kk][qt], 0, 0, 0);
        }
      }
      bf16x8 P[2][2];
#pragma unroll
      for (int qt = 0; qt < 2; ++qt) {
        float mx = s[0][qt][0];
#pragma unroll
        for (int kk = 0; kk < 4; ++kk)
#pragma unroll
          for (int j = 0; j < 4; ++j) mx = fmaxf(mx, s[kk][qt][j]);
        mx = fmaxf(mx, __shfl_xor(mx, 16));
        mx = fmaxf(mx, __shfl_xor(mx, 32));
        const float mnew = fmaxf(mrun[qt], mx);
        const bool grow = __ballot(mx > mrun[qt]) != 0ull;
        const float alpha = grow ? ex2(mrun[qt] - mnew) : 1.f;
        mrun[qt] = mnew;
        float ps = 0.f;
#pragma unroll
        for (int kk = 0; kk < 4; ++kk)
#pragma unroll
          for (int j = 0; j < 4; ++j) {
            float e_ = ex2(s[kk][qt][j] - mnew);
            s[kk][qt][j] = e_;
            ps += e_;
          }
        if (grow) {
          lrun[qt] = lrun[qt] * alpha + ps;
#pragma unroll
          for (int et = 0; et < 4; ++et)
#pragma unroll
            for (int j = 0; j < 4; ++j) o[et][qt][j] *= alpha;
        } else {
          lrun[qt] += ps;
        }
#pragma unroll
        for (int k2 = 0; k2 < 2; ++k2) {
          u32x4 u;
          u[0] = pack2(s[2 * k2][qt][0], s[2 * k2][qt][1]);
          u[1] = pack2(s[2 * k2][qt][2], s[2 * k2][qt][3]);
          u[2] = pack2(s[2 * k2 + 1][qt][0], s[2 * k2 + 1][qt][1]);
          u[3] = pack2(s[2 * k2 + 1][qt][2], s[2 * k2 + 1][qt][3]);
          P[qt][k2] = __builtin_bit_cast(bf16x8, u);
        }
      }
#pragma unroll
      for (int k2 = 0; k2 < 2; ++k2) {
#pragma unroll
        for (int et = 0; et < 4; ++et) {
          u32x2 lo = *(const u32x2*)(Vs + (et * 16 + l15) * 72 + k2 * 32 + 4 * g);
          u32x2 hi = *(const u32x2*)(Vs + (et * 16 + l15) * 72 + k2 * 32 + 16 + 4 * g);
          u32x4 u;
          u[0] = lo[0]; u[1] = lo[1]; u[2] = hi[0]; u[3] = hi[1];
          bf16x8 a = __builtin_bit_cast(bf16x8, u);
#pragma unroll
          for (int qt = 0; qt < 2; ++qt) o[et][qt] = __builtin_amdgcn_mfma_f32_16x16x32_bf16(a, P[qt][k2], o[et][qt], 0, 0, 0);
        }
      }
      if (kt + 1 < nkt) {
        lstore((kt + 1) & 1);
        if (kt + 2 < nkt) gload(kt + 2);
        __syncthreads();
      }
    }
#pragma unroll
    for (int qt = 0; qt < 2; ++qt) {
      const int tokq = qtok0 + w * 32 + qt * 16 + l15;
      float lt = lrun[qt];
      lt += __shfl_xor(lt, 16);
      lt += __shfl_xor(lt, 32);
      const float inv = 1.f / lt;
#pragma unroll
      for (int et = 0; et < 4; ++et) {
        u32x2 ov;
        ov[0] = pack2(o[et][qt][0] * inv, o[et][qt][1] * inv);
        ov[1] = pack2(o[et][qt][2] * inv, o[et][qt][3] * inv);
        *(u32x2*)(attn + (size_t)tokq * 512 + h * 64 + et * 16 + 4 * g) = ov;
      }
    }
  }
  conv_fp8_rows(p.peer_u, (unsigned char*)(p.ws + OFF_TABU), (float*)(p.ws + OFF_INVU));
  conv_fp8_rows(p.peer_v, (unsigned char*)(p.ws + OFF_TABV), (float*)(p.ws + OFF_INVV));
}

DI void phase8(const Params& p, char* smem) {
  char* ws = p.ws;
  const bf16_t* attn = (const bf16_t*)(ws + OFF_ATTN);
  const bf16_t* ret = (const bf16_t*)(ws + OFF_RET);
  const bf16_t* wa = (const bf16_t*)(ws + OFF_WUPAT);
  const bf16_t* wb = (const bf16_t*)(ws + OFF_WUPBT);
  const bf16_t* sga = (const bf16_t*)p.out;
  const bf16_t* sgb = sga + (size_t)NTOK * 1024;
  bf16_t* mbuf = (bf16_t*)(ws + OFF_M);
  const int tid = threadIdx.x, lane = tid & 63, w = tid >> 6, wm = w >> 1, wn = w & 1, l15 = lane & 15, g = lane >> 4;
  for (int it = 0;; ++it) {
    int ft, tt;
    if (!tile_map(it, 8, 160, 1, ft, tt)) break;
    f32x4 acc[4][4];
    acc_zero(acc);
    gemm_kloop<0>(acc, wa + (size_t)ft * 128 * 512, 512, attn + (size_t)tt * 128 * 512, 512, 512, smem, 0.f, 0.f);
#pragma unroll
    for (int c = 0; c < 4; ++c) {
      const size_t off = (size_t)(tt * 128 + wn * 64 + c * 16 + l15) * 1024 + ft * 128 + wm * 64 + 16 * g;
      float a[16], bq[16];
      ld_bf16x16(sga + off, a);
      ld_bf16x16(sgb + off, bq);
#pragma unroll
      for (int f = 0; f < 4; ++f)
#pragma unroll
        for (int j = 0; j < 4; ++j) acc[f][c][j] *= a[f * 4 + j] * __builtin_amdgcn_rcpf(fmaxf(bq[f * 4 + j], 1e-30f));
    }
    gemm_kloop<0>(acc, wb + (size_t)ft * 128 * 512, 512, ret + (size_t)tt * 128 * 512, 512, 512, smem, 0.f, 0.f);
    epilogue(acc, [&](int m, int n, float (&v)[16]) {
      const size_t off = (size_t)(tt * 128 + n) * 1024 + ft * 128 + m;
      float bq[16];
      ld_bf16x16(sgb + off, bq);
#pragma unroll
      for (int i = 0; i < 16; ++i) v[i] *= bq[i];
      st_bf16x16(mbuf + off, v);
    });
  }
}
DI void phase9(const Params& p, char* smem) {
  char* ws = p.ws;
  const bf16_t* mbuf = (const bf16_t*)(ws + OFF_M);
  const bf16_t* wo = (const bf16_t*)(ws + OFF_WOT);
  const float* mod = (const float*)(ws + OFF_MOD);
  u32x4 pra[4], prb[4];
  int ft, tt;
  bool have = tile_map(0, 8, 160, 1, ft, tt);
  if (have) gemm_issue0(wo + (size_t)ft * 128 * 1024, 1024, mbuf + (size_t)tt * 128 * 1024, 1024, pra, prb);
  for (int it = 0; have; ++it) {
    f32x4 acc[4][4];
    acc_zero(acc);
    gemm_kloop_pre<0>(acc, wo + (size_t)ft * 128 * 1024, 1024, mbuf + (size_t)tt * 128 * 1024, 1024, 1024, smem, 0.f, 0.f, pra, prb);
    int ft2 = 0, tt2 = 0;
    const bool have2 = tile_map(it + 1, 8, 160, 1, ft2, tt2);
    if (have2) gemm_issue0(wo + (size_t)ft2 * 128 * 1024, 1024, mbuf + (size_t)tt2 * 128 * 1024, 1024, pra, prb);
    epilogue(acc, [&](int m, int n, float (&v)[16]) {
      const int tok = tt * 128 + n, feat = ft * 128 + m;
      const float* xr = xrow(p, tok) + feat;
      const float* g1 = mod + modidx(tok) * 6144 + 2048 + feat;
#pragma unroll
      for (int i = 0; i < 4; ++i) {
        float4 xv = *(const float4*)(xr + 4 * i), gv = *(const float4*)(g1 + 4 * i);
        v[4 * i] = xv.x + gv.x * v[4 * i];
        v[4 * i + 1] = xv.y + gv.y * v[4 * i + 1];
        v[4 * i + 2] = xv.z + gv.z * v[4 * i + 2];
        v[4 * i + 3] = xv.w + gv.w * v[4 * i + 3];
      }
      st_f32x16(p.out + (size_t)tok * DM + feat, v);
    });
    ft = ft2; tt = tt2; have = have2;
  }
}
DI void conv_fp8_rows(const float* __restrict__ src, unsigned char* __restrict__ dst, float* __restrict__ inv) {
  const int lane = threadIdx.x & 63, w = threadIdx.x >> 6;
  for (int r = blockIdx.x * 4 + w; r < 16384; r += gridDim.x * 4) {
    const float* sp = src + (size_t)r * 1024 + lane * 16;
    float4 v[4];
    float am = 0.f;
#pragma unroll
    for (int i = 0; i < 4; ++i) {
      v[i] = *(const float4*)(sp + 4 * i);
      am = fmaxf(am, fmaxf(fmaxf(fabsf(v[i].x), fabsf(v[i].y)), fmaxf(fabsf(v[i].z), fabsf(v[i].w))));
    }
#pragma unroll
    for (int o = 32; o > 0; o >>= 1) am = fmaxf(am, __shfl_xor(am, o));
    const float sc = am > 0.f ? 448.f / am : 1.f;
    u32x4 o4;
#pragma unroll
    for (int i = 0; i < 4; ++i) {
      int wd = 0;
      wd = __builtin_amdgcn_cvt_pk_fp8_f32(v[i].x * sc, v[i].y * sc, wd, false);
      wd = __builtin_amdgcn_cvt_pk_fp8_f32(v[i].z * sc, v[i].w * sc, wd, true);
      o4[i] = (unsigned)wd;
    }
    *(u32x4*)(dst + ((size_t)(lane >> 3) * 16384 + r) * 128 + (lane & 7) * 16) = o4;
    if (lane == 0) inv[r] = am > 0.f ? am * (1.f / 448.f) : 1.f;
  }
}
DI void phase10(const Params& p, char* smem) {
  rows_norm_mod(p, p.norm_ffn, 3072, 4096, true, (bf16_t*)(p.ws + OFF_H2));
}
DI void phase11(const Params& p, char* smem) {
  char* ws = p.ws;
  const bf16_t* h2 = (const bf16_t*)(ws + OFF_H2);
  const bf16_t* wct = (const bf16_t*)(ws + OFF_WCT);
  bf16_t* sc = (bf16_t*)(ws + OFF_SCORES);
  u32x4 pra[4], prb[4];
  int ft, tt;
  bool have = tile_map(0, 16, 160, 2, ft, tt);
  if (have) gemm_issue0(wct + (size_t)ft * 128 * 1024, 1024, h2 + (size_t)tt * 128 * 1024, 1024, pra, prb);
  for (int it = 0; have; ++it) {
    f32x4 acc[4][4];
    acc_zero(acc);
    gemm_kloop_pre<0>(acc, wct + (size_t)ft * 128 * 1024, 1024, h2 + (size_t)tt * 128 * 1024, 1024, 1024, smem, 0.f, 0.f, pra, prb);
    int ft2 = 0, tt2 = 0;
    const bool have2 = tile_map(it + 1, 16, 160, 2, ft2, tt2);
    if (have2) gemm_issue0(wct + (size_t)ft2 * 128 * 1024, 1024, h2 + (size_t)tt2 * 128 * 1024, 1024, pra, prb);
    epilogue(acc, [&](int m, int n, float (&v)[16]) { st_bf16x16(sc + (size_t)(tt * 128 + n) * 2048 + ft * 128 + m, v); });
    ft = ft2; tt = tt2; have = have2;
  }
}

DI unsigned okey(float f) {
  unsigned u = __float_as_uint(f);
  return (u & 0x80000000u) ? ~u : (u | 0x80000000u);
}
DI void wave_lds_sync() {
  __builtin_amdgcn_fence(__ATOMIC_ACQ_REL, "workgroup");
  __builtin_amdgcn_wave_barrier();
}
DI unsigned okey16(unsigned b) { return (b & 0x8000u) ? (~b & 0xFFFFu) : (b | 0x8000u); }
DI unsigned inv_okey16(unsigned k) { return (k & 0x8000u) ? (k & 0x7FFFu) : (~k & 0xFFFFu); }
DI unsigned inv_okey(unsigned k) { return (k & 0x80000000u) ? (k & 0x7FFFFFFFu) : ~k; }
DI void ins16(unsigned (&L)[16], unsigned x) {
#pragma unroll
  for (int i = 0; i < 16; ++i) {
    unsigned t = max(L[i], x);
    x = min(L[i], x);
    L[i] = t;
  }
}
DI void ce_desc(unsigned& a, unsigned& b) {
  const unsigned t = max(a, b);
  b = min(a, b);
  a = t;
}
DI void sort16_desc(unsigned (&a)[16]) {
#pragma unroll
  for (int ks = 1; ks <= 4; ++ks) {
#pragma unroll
    for (int js = ks - 1; js >= 0; --js) {
#pragma unroll
      for (int i = 0; i < 16; ++i) {
        const int k = 1 << ks, j = 1 << js, l = i ^ j;
        if (l > i) {
          if ((i & k) == 0) ce_desc(a[i], a[l]);
          else ce_desc(a[l], a[i]);
        }
      }
    }
  }
}
DI void merge_top16(unsigned (&L)[16], const unsigned (&G)[16]) {
#pragma unroll
  for (int i = 0; i < 16; ++i) L[i] = max(L[i], G[15 - i]);
#pragma unroll
  for (int js = 3; js >= 0; --js) {
#pragma unroll
    for (int i = 0; i < 16; ++i) {
      const int j = 1 << js, l = i ^ j;
      if (l > i) ce_desc(L[i], L[l]);
    }
  }
}
DI unsigned byte16(const unsigned (&d)[4], int i) {
  unsigned r = 0u;
#pragma unroll
  for (int q = 0; q < 4; ++q) r |= d[q] & (0u - (unsigned)((i >> 2) == q));
  return (r >> ((i & 3) * 8)) & 0xFFu;
}
DI unsigned sel16(const unsigned (&A)[16], int i) {
  unsigned r = 0u;
#pragma unroll
  for (int t = 0; t < 16; ++t) r |= A[t] & (0u - (unsigned)(i == t));
  return r;
}
DI void phase12(const Params& p, char* smem) {
  char* ws = p.ws;
  const bf16_t* sc = (const bf16_t*)(ws + OFF_SCORES);
  int* elist = (int*)(ws + OFF_ELIST);
  float* glist = (float*)(ws + OFF_GLIST);
  const int lane = threadIdx.x & 63, w = threadIdx.x >> 6;
  for (int batch = blockIdx.x * 4 + w; batch < NTOK / 4; batch += gridDim.x * 4) {
    const int tok = batch * 4 + (lane >> 4), hh = lane & 15;
    const bf16_t* row = sc + (size_t)tok * 2048 + hh * 128;
    unsigned L[16];
#pragma unroll
    for (int grp8 = 0; grp8 < 8; ++grp8) {
      unsigned G[16];
#pragma unroll
      for (int cc = 0; cc < 2; ++cc) {
        const int c = grp8 * 2 + cc;
        u32x4 u = *(const u32x4*)(row + c * 8);
#pragma unroll
        for (int i = 0; i < 4; ++i) {
          unsigned b0 = u[i] & 0xFFFFu, b1 = u[i] >> 16;
          G[cc * 8 + 2 * i] = (okey16(b0) << 16) | (unsigned)(127 - (c * 8 + 2 * i));
          G[cc * 8 + 2 * i + 1] = (okey16(b1) << 16) | (unsigned)(127 - (c * 8 + 2 * i + 1));
        }
      }
      sort16_desc(G);
      if (grp8 == 0) {
#pragma unroll
        for (int i = 0; i < 16; ++i) L[i] = G[i];
      } else {
        merge_top16(L, G);
      }
    }
    unsigned M[16];
#pragma unroll
    for (int i = 0; i < 16; ++i) M[i] = (unsigned)__shfl_xor((int)L[i], 1);
    float v1[16], v2[16];
#pragma unroll
    for (int i = 0; i < 16; ++i) {
      v1[i] = bf2f(inv_okey16(L[i] >> 16));
      v2[i] = bf2f(inv_okey16(M[i] >> 16));
    }
    unsigned C[16];
    C[0] = ((okey(v1[0] + v2[0]) & 0xFFFFFF00u) | 255u);
    C[1] = ((okey(v1[0] + v2[1]) & 0xFFFFFF00u) | 254u);
    C[2] = ((okey(v1[0] + v2[2]) & 0xFFFFFF00u) | 253u);
    C[3] = ((okey(v1[0] + v2[3]) & 0xFFFFFF00u) | 252u);
    C[4] = ((okey(v1[0] + v2[4]) & 0xFFFFFF00u) | 251u);
    C[5] = ((okey(v1[0] + v2[5]) & 0xFFFFFF00u) | 250u);
    C[6] = ((okey(v1[0] + v2[6]) & 0xFFFFFF00u) | 249u);
    C[7] = ((okey(v1[0] + v2[7]) & 0xFFFFFF00u) | 248u);
    C[8] = ((okey(v1[0] + v2[8]) & 0xFFFFFF00u) | 247u);
    C[9] = ((okey(v1[0] + v2[9]) & 0xFFFFFF00u) | 246u);
    C[10] = ((okey(v1[0] + v2[10]) & 0xFFFFFF00u) | 245u);
    C[11] = ((okey(v1[0] + v2[11]) & 0xFFFFFF00u) | 244u);
    C[12] = ((okey(v1[0] + v2[12]) & 0xFFFFFF00u) | 243u);
    C[13] = ((okey(v1[0] + v2[13]) & 0xFFFFFF00u) | 242u);
    C[14] = ((okey(v1[0] + v2[14]) & 0xFFFFFF00u) | 241u);
    C[15] = ((okey(v1[0] + v2[15]) & 0xFFFFFF00u) | 240u);
    {
      unsigned G[16];
      G[0] = ((okey(v1[1] + v2[0]) & 0xFFFFFF00u) | 239u);
      G[1] = ((okey(v1[1] + v2[1]) & 0xFFFFFF00u) | 238u);
      G[2] = ((okey(v1[1] + v2[2]) & 0xFFFFFF00u) | 237u);
      G[3] = ((okey(v1[1] + v2[3]) & 0xFFFFFF00u) | 236u);
      G[4] = ((okey(v1[1] + v2[4]) & 0xFFFFFF00u) | 235u);
      G[5] = ((okey(v1[1] + v2[5]) & 0xFFFFFF00u) | 234u);
      G[6] = ((okey(v1[1] + v2[6]) & 0xFFFFFF00u) | 233u);
      G[7] = ((okey(v1[1] + v2[7]) & 0xFFFFFF00u) | 232u);
      G[8] = 0u;
      G[9] = 0u;
      G[10] = 0u;
      G[11] = 0u;
      G[12] = 0u;
      G[13] = 0u;
      G[14] = 0u;
      G[15] = 0u;
      merge_top16(C, G);
    }
    {
      unsigned G[16];
      G[0] = ((okey(v1[2] + v2[0]) & 0xFFFFFF00u) | 223u);
      G[1] = ((okey(v1[2] + v2[1]) & 0xFFFFFF00u) | 222u);
      G[2] = ((okey(v1[2] + v2[2]) & 0xFFFFFF00u) | 221u);
      G[3] = ((okey(v1[2] + v2[3]) & 0xFFFFFF00u) | 220u);
      G[4] = ((okey(v1[2] + v2[4]) & 0xFFFFFF00u) | 219u);
      G[5] = 0u;
      G[6] = 0u;
      G[7] = 0u;
      G[8] = 0u;
      G[9] = 0u;
      G[10] = 0u;
      G[11] = 0u;
      G[12] = 0u;
      G[13] = 0u;
      G[14] = 0u;
      G[15] = 0u;
      merge_top16(C, G);
    }
    {
      unsigned G[16];
      G[0] = ((okey(v1[3] + v2[0]) & 0xFFFFFF00u) | 207u);
      G[1] = ((okey(v1[3] + v2[1]) & 0xFFFFFF00u) | 206u);
      G[2] = ((okey(v1[3] + v2[2]) & 0xFFFFFF00u) | 205u);
      G[3] = ((okey(v1[3] + v2[3]) & 0xFFFFFF00u) | 204u);
      G[4] = 0u;
      G[5] = 0u;
      G[6] = 0u;
      G[7] = 0u;
      G[8] = 0u;
      G[9] = 0u;
      G[10] = 0u;
      G[11] = 0u;
      G[12] = 0u;
      G[13] = 0u;
      G[14] = 0u;
      G[15] = 0u;
      merge_top16(C, G);
    }
    {
      unsigned G[16];
      G[0] = ((okey(v1[4] + v2[0]) & 0xFFFFFF00u) | 191u);
      G[1] = ((okey(v1[5] + v2[0]) & 0xFFFFFF00u) | 175u);
      G[2] = ((okey(v1[6] + v2[0]) & 0xFFFFFF00u) | 159u);
      G[3] = ((okey(v1[7] + v2[0]) & 0xFFFFFF00u) | 143u);
      G[4] = ((okey(v1[8] + v2[0]) & 0xFFFFFF00u) | 127u);
      G[5] = ((okey(v1[9] + v2[0]) & 0xFFFFFF00u) | 111u);
      G[6] = ((okey(v1[10] + v2[0]) & 0xFFFFFF00u) | 95u);
      G[7] = ((okey(v1[11] + v2[0]) & 0xFFFFFF00u) | 79u);
      G[8] = ((okey(v1[12] + v2[0]) & 0xFFFFFF00u) | 63u);
      G[9] = ((okey(v1[13] + v2[0]) & 0xFFFFFF00u) | 47u);
      G[10] = ((okey(v1[14] + v2[0]) & 0xFFFFFF00u) | 31u);
      G[11] = ((okey(v1[15] + v2[0]) & 0xFFFFFF00u) | 15u);
      G[12] = 0u;
      G[13] = 0u;
      G[14] = 0u;
      G[15] = 0u;
      merge_top16(C, G);
    }
    {
      unsigned G[16];
      G[0] = ((okey(v1[4] + v2[1]) & 0xFFFFFF00u) | 190u);
      G[1] = ((okey(v1[5] + v2[1]) & 0xFFFFFF00u) | 174u);
      G[2] = ((okey(v1[6] + v2[1]) & 0xFFFFFF00u) | 158u);
      G[3] = ((okey(v1[7] + v2[1]) & 0xFFFFFF00u) | 142u);
      G[4] = 0u;
      G[5] = 0u;
      G[6] = 0u;
      G[7] = 0u;
      G[8] = 0u;
      G[9] = 0u;
      G[10] = 0u;
      G[11] = 0u;
      G[12] = 0u;
      G[13] = 0u;
      G[14] = 0u;
      G[15] = 0u;
      merge_top16(C, G);
    }
    {
      unsigned G[16];
      G[0] = ((okey(v1[4] + v2[2]) & 0xFFFFFF00u) | 189u);
      G[1] = 0u;
      G[2] = 0u;
      G[3] = 0u;
      G[4] = 0u;
      G[5] = 0u;
      G[6] = 0u;
      G[7] = 0u;
      G[8] = 0u;
      G[9] = 0u;
      G[10] = 0u;
      G[11] = 0u;
      G[12] = 0u;
      G[13] = 0u;
      G[14] = 0u;
      G[15] = 0u;
      merge_top16(C, G);
    }
    unsigned ib1[4], ib2[4];
#pragma unroll
    for (int q = 0; q < 4; ++q) {
      ib1[q] = (L[4 * q] & 0xFFu) | ((L[4 * q + 1] & 0xFFu) << 8) | ((L[4 * q + 2] & 0xFFu) << 16) | ((L[4 * q + 3] & 0xFFu) << 24);
      ib2[q] = (M[4 * q] & 0xFFu) | ((M[4 * q + 1] & 0xFFu) << 8) | ((M[4 * q + 2] & 0xFFu) << 16) | ((M[4 * q + 3] & 0xFFu) << 24);
    }
    int ev[16];
    float gv[16];
    const float mx = __uint_as_float(inv_okey(C[0] & 0xFFFFFF00u));
    float den = 0.f;
#pragma unroll
    for (int k = 0; k < 16; ++k) {
      const int ci = 255 - (int)(C[k] & 0xFFu);
      ev[k] = (127 - (int)byte16(ib1, ci >> 4)) * 128 + (127 - (int)byte16(ib2, ci & 15));
      gv[k] = __expf(__uint_as_float(inv_okey(C[k] & 0xFFFFFF00u)) - mx);
      den += gv[k];
    }
    const float inv = 1.f / den;
    if ((lane & 1) == 0) {
      int* ep = elist + (size_t)tok * 128 + (hh >> 1) * 16;
      float* gp = glist + (size_t)tok * 128 + (hh >> 1) * 16;
#pragma unroll
      for (int k = 0; k < 4; ++k) {
        *(int4*)(ep + 4 * k) = make_int4(ev[4 * k], ev[4 * k + 1], ev[4 * k + 2], ev[4 * k + 3]);
        *(float4*)(gp + 4 * k) = make_float4(gv[4 * k] * inv, gv[4 * k + 1] * inv, gv[4 * k + 2] * inv, gv[4 * k + 3] * inv);
      }
    }
  }
}
using f32x2 = __attribute__((ext_vector_type(2))) float;
DI f32x2 cvt8(unsigned w, bool hi) {
  return hi ? __builtin_amdgcn_cvt_pk_f32_fp8((int)w, true) : __builtin_amdgcn_cvt_pk_f32_fp8((int)w, false);
}
struct SMeta { int e[16]; u32x4 ha, hb; };
template <int MODE>
DI void sl_meta(const Params& p, int t, int s, int grp, int ch, SMeta& m) {
  const int ts = __builtin_amdgcn_readfirstlane(t);
  const int* elist = (const int*)(p.ws + (MODE == 0 ? OFF_ELIST : OFF_GLIST)) + (size_t)ts * 128;
#pragma unroll
  for (int i = 0; i < 16; ++i) m.e[i] = elist[(unsigned)(i * 8 + grp)];
  if (MODE == 0) {
    const bf16_t* hq = (const bf16_t*)(p.ws + OFF_H2) + (size_t)ts * DM + s * 128;
    m.ha = *(const u32x4*)(hq + (unsigned)(ch * 16));
    m.hb = *(const u32x4*)(hq + (unsigned)(ch * 16 + 8));
  }
}
template <int MODE>
DI void sl_rows(const Params& p, int s, int ch, const SMeta& m, u32x4 (&r)[16]) {
  const unsigned char* tab = (const unsigned char*)(p.ws + (MODE == 0 ? OFF_TABU : OFF_TABV)) + (size_t)s * (16384 * 128);
#pragma unroll
  for (int i = 0; i < 16; ++i) r[i] = *(const u32x4*)(tab + ((unsigned)(m.e[i] & 0xFFFF) * 128u + (unsigned)(ch * 16)));
}
template <int MODE>
DI void sl_compute(const Params& p, int t, int s, int lane, const SMeta& m, const u32x4 (&r)[16]) {
  const int grp = lane >> 3, ch = lane & 7;
  if (MODE == 0) {
    f32x2 hp[8];
#pragma unroll
    for (int i = 0; i < 4; ++i) {
      hp[i] = f32x2{bflo(m.ha[i]), bfhi(m.ha[i])};
      hp[4 + i] = f32x2{bflo(m.hb[i]), bfhi(m.hb[i])};
    }
    float v[16];
#pragma unroll
    for (int i = 0; i < 16; ++i) {
      f32x2 d2 = f32x2{0.f, 0.f};
#pragma unroll
      for (int j = 0; j < 4; ++j) {
        d2 += cvt8(r[i][j], false) * hp[2 * j];
        d2 += cvt8(r[i][j], true) * hp[2 * j + 1];
      }
      v[i] = d2[0] + d2[1];
    }
    float q8[8], q4[4], q2[2];
    {
      const bool hi = lane & 4;
#pragma unroll
      for (int i = 0; i < 8; ++i) {
        float send = hi ? v[i] : v[8 + i], keep = hi ? v[8 + i] : v[i];
        q8[i] = keep + __shfl_xor(send, 4);
      }
    }
    {
      const bool hi = lane & 2;
#pragma unroll
      for (int i = 0; i < 4; ++i) {
        float send = hi ? q8[i] : q8[4 + i], keep = hi ? q8[4 + i] : q8[i];
        q4[i] = keep + __shfl_xor(send, 2);
      }
    }
    {
      const bool hi = lane & 1;
#pragma unroll
      for (int i = 0; i < 2; ++i) {
        float send = hi ? q4[i] : q4[2 + i], keep = hi ? q4[2 + i] : q4[i];
        q2[i] = keep + __shfl_xor(send, 1);
      }
    }
    float* po = (float*)(p.ws + OFF_PD) + (size_t)t * 1024 + s * 128;
    po[(2 * ch) * 8 + grp] = q2[0];
    po[(2 * ch + 1) * 8 + grp] = q2[1];
  } else {
    f32x2 acc[8];
#pragma unroll
    for (int q = 0; q < 8; ++q) acc[q] = f32x2{0.f, 0.f};
#pragma unroll
    for (int i = 0; i < 16; ++i) {
      const float wsc = __uint_as_float((unsigned)m.e[i] & 0xFFFF0000u);
      const f32x2 w2 = f32x2{wsc, wsc};
#pragma unroll
      for (int j = 0; j < 4; ++j) {
        acc[2 * j] += w2 * cvt8(r[i][j], false);
        acc[2 * j + 1] += w2 * cvt8(r[i][j], true);
      }
    }
    float v[16];
#pragma unroll
    for (int q = 0; q < 8; ++q) { v[2 * q] = acc[q][0]; v[2 * q + 1] = acc[q][1]; }
    float q8[8], q4[4], q2[2];
    {
      const bool hi = lane & 32;
#pragma unroll
      for (int i = 0; i < 8; ++i) {
        float send = hi ? v[i] : v[8 + i], keep = hi ? v[8 + i] : v[i];
        q8[i] = keep + __shfl_xor(send, 32);
      }
    }
    {
      const bool hi = lane & 16;
#pragma unroll
      for (int i = 0; i < 4; ++i) {
        float send = hi ? q8[i] : q8[4 + i], keep = hi ? q8[4 + i] : q8[i];
        q4[i] = keep + __shfl_xor(send, 16);
      }
    }
    {
      const bool hi = lane & 8;
#pragma unroll
      for (int i = 0; i < 2; ++i) {
        float send = hi ? q4[i] : q4[2 + i], keep = hi ? q4[2 + i] : q4[i];
        q2[i] = keep + __shfl_xor(send, 8);
      }
    }
    const int f = s * 128 + ch * 16 + 2 * grp;
    float* xr = p.out + (size_t)t * DM + f;
    const float2 xv = *(const float2*)xr;
    const float2 gv = *(const float2*)((const float*)(p.ws + OFF_MOD) + modidx(t) * 6144 + 5120 + f);
    *(float2*)xr = make_float2(xv.x + gv.x * q2[0], xv.y + gv.y * q2[1]);
  }
}
template <int MODE>
DI void sliced_pass(const Params& p) {
  const int s = blockIdx.x & 7, loc = blockIdx.x >> 3, nloc = gridDim.x >> 3;
  if (loc >= nloc) return;
  const int lane = threadIdx.x & 63, w = threadIdx.x >> 6, grp = lane >> 3, ch = lane & 7;
  const int stride = nloc * 4;
  SMeta mA, mB;
  u32x4 rA[16], rB[16];
  int t = loc * 4 + w;
  if (t < NTOK) {
    sl_meta<MODE>(p, t, s, grp, ch, mA);
    sl_rows<MODE>(p, s, ch, mA, rA);
  }
  if (t + stride < NTOK) sl_meta<MODE>(p, t + stride, s, grp, ch, mB);
#pragma unroll 1
  for (; t < NTOK; t += 2 * stride) {
    const int t1 = t + stride, t2 = t + 2 * stride, t3 = t + 3 * stride;
    if (t1 < NTOK) sl_rows<MODE>(p, s, ch, mB, rB);
    sl_compute<MODE>(p, t, s, lane, mA, rA);
    if (t2 < NTOK) sl_meta<MODE>(p, t2, s, grp, ch, mA);
    if (t1 < NTOK) {
      if (t2 < NTOK) sl_rows<MODE>(p, s, ch, mA, rA);
      sl_compute<MODE>(p, t1, s, lane, mB, rB);
      if (t3 < NTOK) sl_meta<MODE>(p, t3, s, grp, ch, mB);
    }
  }
}
DI void phase13(const Params& p) { sliced_pass<0>(p); }
DI void phase14(const Params& p) {
  char* ws = p.ws;
  const float* invU = (const float*)(ws + OFF_INVU);
  const float* invV = (const float*)(ws + OFF_INVV);
  const int* elist = (const int*)(ws + OFF_ELIST);
  float* glist = (float*)(ws + OFF_GLIST);
  const float* pd = (const float*)(ws + OFF_PD);
  const int lane = threadIdx.x & 63, w = threadIdx.x >> 6;
  for (int t = blockIdx.x * 4 + w; t < NTOK; t += gridDim.x * 4) {
#pragma unroll
    for (int hf_ = 0; hf_ < 2; ++hf_) {
      const int k = hf_ * 64 + lane;
      float d = 0.f;
#pragma unroll
      for (int s = 0; s < 8; ++s) d += pd[(size_t)t * 1024 + s * 128 + k];
      const int e = elist[(size_t)t * 128 + k];
      const float g = glist[(size_t)t * 128 + k];
      ((unsigned*)glist)[(size_t)t * 128 + k] = (pack2(0.f, g * geluf_(d * invU[e]) * invV[e]) & 0xFFFF0000u) | (unsigned)e;
    }
  }
}
DI void phase15(const Params& p) { sliced_pass<1>(p); }
DI void phase16(const Params& p) {
  const int lane = threadIdx.x & 63, w = threadIdx.x >> 6;
  for (int tok = blockIdx.x * 4 + w; tok < NTOK; tok += gridDim.x * 4) {
    float* xr = p.out + (size_t)tok * DM;
    float4 xv[4];
    float ss = 0.f;
#pragma unroll
    for (int i = 0; i < 4; ++i) {
      xv[i] = *(const float4*)(xr + (i * 64 + lane) * 4);
      ss += xv[i].x * xv[i].x + xv[i].y * xv[i].y + xv[i].z * xv[i].z + xv[i].w * xv[i].w;
    }
    ss = wsum(ss);
    const float rstd = rsqrtf(ss * (1.f / 1024.f) + 1e-6f);
#pragma unroll
    for (int i = 0; i < 4; ++i) {
      const int e = (i * 64 + lane) * 4;
      float4 nf = *(const float4*)(p.norm_final + e);
      *(float4*)(xr + e) = make_float4(xv[i].x * rstd * nf.x, xv[i].y * rstd * nf.y, xv[i].z * rstd * nf.z, xv[i].w * rstd * nf.w);
    }
  }
}

#define XB_TMO      128
#define XB_XCNT(j)  (256  + 64 * (j))
#define XB_XSUB(j)  (1280 + 64 * (j))
#define XB_XGEN(j)  (2304 + 64 * (j))
#define XB_TOP      3328
#define XB_TOPGEN   3392
#define XCD_BAR_WORDS 3456
#define XB_SPIN_CAP (1u << 22)
#define LAS __attribute__((address_space(3)))
DI unsigned xb_ld(unsigned* p) { return __hip_atomic_load(p, __ATOMIC_RELAXED, __HIP_MEMORY_SCOPE_AGENT); }
DI unsigned xb_add(unsigned* p, unsigned v) { return __hip_atomic_fetch_add(p, v, __ATOMIC_RELAXED, __HIP_MEMORY_SCOPE_AGENT); }
DI unsigned xb_xcc_id() { return (unsigned)__builtin_amdgcn_s_getreg((3 << 11) | 20) & 0xFu; }
#define XB_SPIN(cond, bar) do { unsigned _sp = 0; while (cond) { __builtin_amdgcn_s_sleep(1); \
    if ((++_sp & 255u) == 0u) { if (xb_ld(&(bar)[XB_TMO])) break; if (_sp > XB_SPIN_CAP) { atomicAdd(&(bar)[XB_TMO], 1u); break; } } } } while (0)
struct XcdBarrier { unsigned* bar; unsigned x; volatile LAS unsigned* st; };
DI XcdBarrier xcd_barrier_post(unsigned* bar, volatile LAS unsigned* st) {
  XcdBarrier b; b.bar = bar; b.x = xb_xcc_id(); b.st = st;
  if (threadIdx.x == 0) (void)xb_add(&bar[XB_XCNT(b.x)], 1u);
  return b;
}
DI void xcd_barrier_complete(unsigned* bar, unsigned x, unsigned& nloc, unsigned& nx) {
  const unsigned G = gridDim.x * gridDim.y * gridDim.z;
  unsigned sum, cnt, mine, sp = 0u;
  for (;;) {
    sum = 0u; cnt = 0u; mine = 0u;
#pragma unroll
    for (unsigned j = 0; j < 16; ++j) { const unsigned c = xb_ld(&bar[XB_XCNT(j)]); sum += c; cnt += (c > 0u) ? 1u : 0u; mine = (j == x) ? c : mine; }
    if (sum == G) break;
    __builtin_amdgcn_s_sleep(1);
    if ((++sp & 255u) == 0u) { if (xb_ld(&bar[XB_TMO])) break; if (sp > XB_SPIN_CAP) { atomicAdd(&bar[XB_TMO], 1u); break; } }
  }
  nloc = mine > 0u ? mine : 1u; nx = cnt > 0u ? cnt : 1u;
}
DI void xcd_barrier(const XcdBarrier& b) {
  asm volatile("s_waitcnt vmcnt(0)" ::: "memory");
  __syncthreads();
  if (threadIdx.x == 0) {
    unsigned* bar = b.bar;
    __builtin_amdgcn_s_waitcnt(0);
    unsigned nloc = b.st[0], nx = b.st[1];
    if (nloc == 0u) { xcd_barrier_complete(bar, b.x, nloc, nx); b.st[0] = nloc; b.st[1] = nx; }
    const unsigned old = xb_add(&bar[XB_XSUB(b.x)], 1u);
    const unsigned gen = old / nloc;
    if (old + 1u == (gen + 1u) * nloc) {
      __builtin_amdgcn_fence(__ATOMIC_RELEASE, "agent");
      asm volatile("s_waitcnt vmcnt(0)" ::: "memory");
      const unsigned og = xb_add(&bar[XB_TOP], 1u);
      const unsigned tg = og / nx;
      if (og + 1u == (tg + 1u) * nx) xb_add(&bar[XB_TOPGEN], 1u);
      else XB_SPIN(xb_ld(&bar[XB_TOPGEN]) == tg, bar);
      __builtin_amdgcn_fence(__ATOMIC_ACQUIRE, "agent");
      xb_add(&bar[XB_XGEN(b.x)], 1u);
      asm volatile("s_waitcnt vmcnt(0)" ::: "memory");
    } else {
      XB_SPIN(xb_ld(&bar[XB_XGEN(b.x)]) == gen, bar);
      __builtin_amdgcn_fence(__ATOMIC_ACQUIRE, "agent");
      asm volatile("s_waitcnt vmcnt(0)" ::: "memory");
    }
  }
  __syncthreads();
}

#ifdef ONLY_PHASE
#define RUNPH(n, call) if (ONLY_PHASE == n) { call; }
#else
#ifndef DUP_PHASE
#define DUP_PHASE -1
#endif
#define RUNPH(n, call) if (lo <= n && n < hi) { call; if (n == DUP_PHASE) { xcd_barrier(xb); call; } if (n + 1 < hi) xcd_barrier(xb); }
#endif
__global__ void __launch_bounds__(256, 2) mega(Params p, int lo, int hi) {
  __shared__ __attribute__((aligned(16))) char smem[SMEM_BYTES];
  __shared__ uint4 xb_words;
  cg::grid_group grid = cg::this_grid();
  if (lo < 0) grid.sync();
  if (threadIdx.x == 0) xb_words = make_uint4(0u, 0u, 0u, 0u);
  __syncthreads();
  XcdBarrier xb = xcd_barrier_post((unsigned*)(p.ws + OFF_BAR), (volatile LAS unsigned*)&xb_words);
  RUNPH(0, phase0(p, smem))
  RUNPH(1, phase1(p, smem))
  RUNPH(2, phase2(p, smem))
  RUNPH(3, phase3(p, smem))
  RUNPH(4, phase4(p))
  RUNPH(5, phase5(p, smem))
  RUNPH(6, phase6(p, smem))
  RUNPH(7, phase7(p, smem))
  RUNPH(8, phase8(p, smem))
  RUNPH(9, phase9(p, smem))
  RUNPH(10, phase10(p, smem))
  RUNPH(11, phase11(p, smem))
  RUNPH(12, phase12(p, smem))
  RUNPH(13, phase13(p))
  RUNPH(14, phase14(p))
  RUNPH(15, phase15(p))
  RUNPH(16, phase16(p))
}

extern "C" void kernel_launch(void* const* d_in, const int* in_sizes, int n_in, void* d_out, int out_size, void* d_ws,
                              size_t ws_size, hipStream_t stream) {
  static int grid_blocks = 0;
  if (!grid_blocks) {
    int dev = 0, cus = 0, per_cu = 0;
    hipGetDevice(&dev);
    hipDeviceGetAttribute(&cus, hipDeviceAttributeMultiprocessorCount, dev);
    hipOccupancyMaxActiveBlocksPerMultiprocessor(&per_cu, mega, 256, 0);
    if (per_cu > 2) per_cu = 2;
    if (per_cu < 1) per_cu = 1;
    grid_blocks = cus * per_cu;
  }
  Params p{};
  const float** pp = (const float**)&p;
  for (int i = 0; i < 29; ++i) pp[i] = (const float*)d_in[i];
  p.out = (float*)d_out;
  p.ws = (char*)d_ws;
#if N_LAUNCH_SPLIT
  for (int ph = 0; ph < NPHASE; ++ph) {
    hipLaunchKernelGGL(mega, dim3(grid_blocks), dim3(256), 0, stream, p, ph, ph + 1);
  }
#else
  hipMemsetAsync((char*)d_ws + OFF_MOD, 0, (OFF_BAR - OFF_MOD) + XCD_BAR_WORDS * sizeof(unsigned), stream);
  int lo = 0, hi = NPHASE;
  void* args[] = {&p, &lo, &hi};
  hipError_t e = hipLaunchCooperativeKernel((void*)mega, dim3(grid_blocks), dim3(256), args, 0, stream);
  if (e != hipSuccess) fprintf(stderr, "cooperative launch failed: %s (grid %d)\n", hipGetErrorString(e), grid_blocks);
#endif
}
```

```cpp
#include <hip/hip_runtime.h>
#include <hip/hip_cooperative_groups.h>
#include <cstdio>
namespace cg = cooperative_groups;

#define DI __device__ __forceinline__
typedef unsigned short bf16_t;
using bf16x8 = __attribute__((ext_vector_type(8))) short;
using f32x4 = __attribute__((ext_vector_type(4))) float;
using u32x4 = __attribute__((ext_vector_type(4))) unsigned;
using u32x2 = __attribute__((ext_vector_type(2))) unsigned;

#ifndef N_LAUNCH_SPLIT
#define N_LAUNCH_SPLIT 0
#endif

constexpr int NTOK = 20480, NPT = 4096, DM = 1024;
constexpr int NPHASE = 17;
constexpr size_t MiB = 1u << 20;
constexpr size_t OFF_WINT = 0, OFF_WUQT = 9 * MiB, OFF_WUKVT = 9 * MiB + 512 * 1024, OFF_WUPAT = 10 * MiB,
                 OFF_WUPBT = 11 * MiB, OFF_WOT = 12 * MiB, OFF_WCT = 14 * MiB, OFF_WPQB = 18 * MiB,
                 OFF_KEYSB = 22 * MiB, OFF_MOD = 22 * MiB + 512 * 1024, OFF_BAR = 22 * MiB + 768 * 1024, OFF_ROPE = 23 * MiB, A0 = 24 * MiB;
constexpr size_t OFF_PD = A0 + 104 * MiB, OFF_H1 = A0 + 0, OFF_CQ = A0 + 40 * MiB, OFF_CKVRAW = A0 + 50 * MiB, OFF_KRRAW = A0 + 60 * MiB,
                 OFF_RQ = A0 + 63 * MiB, OFF_RK = A0 + 83 * MiB, OFF_KT = A0 + 103 * MiB, OFF_VT = A0 + 123 * MiB,
                 OFF_SRG = A0 + 143 * MiB, OFF_CKVALL = A0 + 163 * MiB, OFF_KRALL = A0 + 169 * MiB,
                 OFF_UF = A0 + 171 * MiB, OFF_UB = A0 + 187 * MiB,
                 OFF_SF = A0 + 0, OFF_SB = A0 + 8 * MiB, OFF_RET = A0 + 16 * MiB,
                 OFF_Q = A0 + 63 * MiB, OFF_KN = A0 + 93 * MiB, OFF_VTA = A0 + 117 * MiB, OFF_ATTN = A0 + 141 * MiB,
                 OFF_M = A0 + 163 * MiB,
                 OFF_H2 = A0 + 56 * MiB, OFF_TABU = A0 + 36 * MiB, OFF_TABV = A0 + 0, OFF_INVU = A0 + 52 * MiB,
                 OFF_INVV = A0 + 53 * MiB, OFF_ELIST = A0 + 16 * MiB, OFF_GLIST = A0 + 26 * MiB, OFF_SCORES = A0 + 104 * MiB;
constexpr size_t OUT_CKV = 20971520, OUT_KR = 21495808, OUT_SF = 21626880, OUT_SB = 22675456;
constexpr int NKV = 24576;
constexpr int SMEM_BYTES = 73728;

struct Params {
  const float *x_prompt, *x_sample, *c, *cache_ckv, *cache_krope, *st_f, *st_b, *c_ctx, *w_mod, *b_mod, *norm_mix,
      *norm_ffn, *norm_final, *w_in, *q_norm, *kv_norm, *w_uq, *w_ukv, *lg_f, *lg_b, *ret_gn, *w_up_a, *w_up_b, *w_o,
      *peer_wq, *keys1, *keys2, *peer_u, *peer_v;
  float* out;
  char* ws;
};

DI unsigned f2bf(float x) {
  unsigned u = __float_as_uint(x);
  u += 0x7fffu + ((u >> 16) & 1u);
  return u >> 16;
}
DI float bf2f(unsigned b) { return __uint_as_float(b << 16); }
typedef __bf16 hbf16x2_t __attribute__((ext_vector_type(2)));
typedef float hf32x2_t __attribute__((ext_vector_type(2)));
DI unsigned pack2(float a, float b) {
  hf32x2_t f = {a, b};
  return __builtin_bit_cast(unsigned, __builtin_convertvector(f, hbf16x2_t));
}
DI float ex2(float x) { return __builtin_amdgcn_exp2f(x); }
DI float bflo(unsigned u) { return __uint_as_float(u << 16); }
DI float bfhi(unsigned u) { return __uint_as_float(u & 0xffff0000u); }
DI float wsum(float v) {
#pragma unroll
  for (int o = 32; o > 0; o >>= 1) v += __shfl_xor(v, o);
  return v;
}
DI float sigmoidf_(float x) { return __builtin_amdgcn_rcpf(1.f + __builtin_amdgcn_exp2f(-1.4426950408889634f * x)); }
DI float siluf_(float x) { return x * __builtin_amdgcn_rcpf(1.f + __builtin_amdgcn_exp2f(-1.4426950408889634f * x)); }
DI float geluf_(float x) { return 0.5f * x * (1.f + tanhf(0.7978845608028654f * (x + 0.044715f * x * x * x))); }
DI const float* xrow(const Params& p, int tok) {
  return tok < NPT ? p.x_prompt + (size_t)tok * DM : p.x_sample + (size_t)(tok - NPT) * DM;
}
DI int modidx(int tok) { return tok < NPT ? 0 : 1 + ((tok - NPT) >> 11); }
DI int kvrow(int tok) {
  if (tok < NPT) return tok;
  int t = tok - NPT;
  return NPT + (t >> 11) * 2560 + (t & 2047);
}
DI void st_bf16x16(bf16_t* dst, const float (&v)[16]) {
  u32x4 a, b;
  a[0] = pack2(v[0], v[1]); a[1] = pack2(v[2], v[3]); a[2] = pack2(v[4], v[5]); a[3] = pack2(v[6], v[7]);
  b[0] = pack2(v[8], v[9]); b[1] = pack2(v[10], v[11]); b[2] = pack2(v[12], v[13]); b[3] = pack2(v[14], v[15]);
  *(u32x4*)dst = a;
  *(u32x4*)(dst + 8) = b;
}
DI void st_f32x16(float* dst, const float (&v)[16]) {
#pragma unroll
  for (int i = 0; i < 4; ++i) *(float4*)(dst + 4 * i) = make_float4(v[4 * i], v[4 * i + 1], v[4 * i + 2], v[4 * i + 3]);
}
DI void ld_bf16x16(const bf16_t* src, float (&v)[16]) {
  u32x4 a = *(const u32x4*)src, b = *(const u32x4*)(src + 8);
#pragma unroll
  for (int i = 0; i < 4; ++i) {
    v[2 * i] = bflo(a[i]); v[2 * i + 1] = bfhi(a[i]);
    v[8 + 2 * i] = bflo(b[i]); v[8 + 2 * i + 1] = bfhi(b[i]);
  }
}

constexpr int LDK = 64;
DI void gemm_issue0(const bf16_t* __restrict__ A, int lda, const bf16_t* __restrict__ B, int ldb, u32x4 (&ra)[4], u32x4 (&rb)[4]) {
  const int tid = threadIdx.x;
#pragma unroll
  for (int i = 0; i < 4; ++i) {
    const int c = tid + 256 * i;
    const int r = c >> 3, k8 = (c & 7) * 8;
    ra[i] = *(const u32x4*)(A + (size_t)r * lda + k8);
    rb[i] = *(const u32x4*)(B + (size_t)r * ldb + k8);
  }
}
template <int SCALE>
DI void gemm_kloop_pre(f32x4 (&acc)[4][4], const bf16_t* __restrict__ A, int lda, const bf16_t* __restrict__ B, int ldb,
                       int K, char* smem, float sc_a, float sc_b, u32x4 (&ra)[4], u32x4 (&rb)[4]) {
  bf16_t* As = (bf16_t*)smem;
  bf16_t* Bs = As + 128 * LDK;
  const int tid = threadIdx.x, lane = tid & 63, w = tid >> 6, wm = w >> 1, wn = w & 1, l15 = lane & 15, g = lane >> 4;
  int arow[4], kc[4], ldsa[4], ldsb[4];
#pragma unroll
  for (int i = 0; i < 4; ++i) {
    int c = tid + 256 * i;
    int r = c >> 3;
    kc[i] = (c & 7) * 8;
    arow[i] = r;
    int rr = r & 63;
    int rho = (r & 64) | (((rr >> 2) & 3) << 4) | ((rr >> 4) << 2) | (rr & 3);
    ldsa[i] = rho * LDK + (((c & 7) ^ ((rho >> 1) & 7)) * 8);
    ldsb[i] = r * LDK + (((c & 7) ^ ((r >> 1) & 7)) * 8);
  }
  __syncthreads();
#pragma unroll
  for (int i = 0; i < 4; ++i) {
    *(u32x4*)(As + ldsa[i]) = ra[i];
    *(u32x4*)(Bs + ldsb[i]) = rb[i];
  }
  if (64 < K) {
#pragma unroll
    for (int i = 0; i < 4; ++i) {
      ra[i] = *(const u32x4*)(A + (size_t)arow[i] * lda + 64 + kc[i]);
      rb[i] = *(const u32x4*)(B + (size_t)arow[i] * ldb + 64 + kc[i]);
    }
  }
  __syncthreads();
  int buf = 0;
  for (int k0 = 0; k0 < K; k0 += 64, buf ^= 1) {
    const bf16_t* Ac = As + buf * (256 * LDK);
    const bf16_t* Bc = Bs + buf * (256 * LDK);
#pragma unroll
    for (int ks = 0; ks < 2; ++ks) {
      bf16x8 af[4], bfr[4];
#pragma unroll
      for (int f = 0; f < 4; ++f)
        af[f] = *(const bf16x8*)(Ac + (wm * 64 + f * 16 + l15) * LDK + (((ks * 4 + g) ^ (l15 >> 1)) * 8));
#pragma unroll
      for (int c = 0; c < 4; ++c)
        bfr[c] = *(const bf16x8*)(Bc + (wn * 64 + c * 16 + l15) * LDK + (((ks * 4 + g) ^ (l15 >> 1)) * 8));
      if (SCALE) {
        float fac[8];
#pragma unroll
        for (int i = 0; i < 8; ++i) fac[i] = ex2(sc_a + sc_b * (float)(k0 + ks * 32 + g * 8 + i));
#pragma unroll
        for (int f = 0; f < 4; ++f) {
          u32x4 u = __builtin_bit_cast(u32x4, af[f]);
#pragma unroll
          for (int i = 0; i < 4; ++i) u[i] = pack2(bflo(u[i]) * fac[2 * i], bfhi(u[i]) * fac[2 * i + 1]);
          af[f] = __builtin_bit_cast(bf16x8, u);
        }
      }
#pragma unroll
      for (int f = 0; f < 4; ++f)
#pragma unroll
        for (int c = 0; c < 4; ++c) acc[f][c] = __builtin_amdgcn_mfma_f32_16x16x32_bf16(af[f], bfr[c], acc[f][c], 0, 0, 0);
    }
    if (k0 + 64 < K) {
      bf16_t* An = As + (buf ^ 1) * (256 * LDK);
      bf16_t* Bn = Bs + (buf ^ 1) * (256 * LDK);
#pragma unroll
      for (int i = 0; i < 4; ++i) {
        *(u32x4*)(An + ldsa[i]) = ra[i];
        *(u32x4*)(Bn + ldsb[i]) = rb[i];
      }
      if (k0 + 128 < K) {
#pragma unroll
        for (int i = 0; i < 4; ++i) {
          ra[i] = *(const u32x4*)(A + (size_t)arow[i] * lda + k0 + 128 + kc[i]);
          rb[i] = *(const u32x4*)(B + (size_t)arow[i] * ldb + k0 + 128 + kc[i]);
        }
      }
      __syncthreads();
    }
  }
}
template <int SCALE>
DI void gemm_kloop(f32x4 (&acc)[4][4], const bf16_t* __restrict__ A, int lda, const bf16_t* __restrict__ B, int ldb,
                   int K, char* smem, float sc_a, float sc_b) {
  u32x4 ra[4], rb[4];
  gemm_issue0(A, lda, B, ldb, ra, rb);
  gemm_kloop_pre<SCALE>(acc, A, lda, B, ldb, K, smem, sc_a, sc_b, ra, rb);
}
DI void acc_zero(f32x4 (&acc)[4][4]) {
#pragma unroll
  for (int f = 0; f < 4; ++f)
#pragma unroll
    for (int c = 0; c < 4; ++c) acc[f][c] = f32x4{0.f, 0.f, 0.f, 0.f};
}
template <class F>
DI void epilogue(const f32x4 (&acc)[4][4], F&& epi) {
  const int tid = threadIdx.x, lane = tid & 63, w = tid >> 6, wm = w >> 1, wn = w & 1, l15 = lane & 15, g = lane >> 4;
#pragma unroll
  for (int c = 0; c < 4; ++c) {
    float v[16];
#pragma unroll
    for (int f = 0; f < 4; ++f)
#pragma unroll
      for (int j = 0; j < 4; ++j) v[f * 4 + j] = acc[f][c][j];
    epi(wm * 64 + 16 * g, wn * 64 + c * 16 + l15, v);
  }
}
DI bool tile_map(int it, int Ft, int Tt, int fsplit, int& ft, int& tt) {
  const int bid = blockIdx.x, nb = gridDim.x;
  int xcd = bid & 7, loc = bid >> 3, nloc = nb >> 3;
  if (loc >= nloc) return false;
  int fg = xcd % fsplit, tg = xcd / fsplit, tsplit = 8 / fsplit;
  int Fg = Ft / fsplit, Tg = Tt / tsplit;
  int i = loc + it * nloc;
  if (i >= Fg * Tg) return false;
  ft = fg * Fg + i % Fg;
  tt = tg * Tg + i / Fg;
  return true;
}
DI int vbid() {
  const int bid = blockIdx.x, nb = gridDim.x;
  if (nb & 7) return bid;
  return (bid & 7) * (nb >> 3) + (bid >> 3);
}

DI int colmap(int mode, int np) {
  if (mode == 1) return np < 416 ? np : (np < 512 ? -1 : np - 96);
  if (mode == 2) return np < 512 ? ((np >> 6) * 128 + (np & 63)) : (((np - 512) >> 6) * 128 + 64 + ((np - 512) & 63));
  return np;
}
DI void tconv_tile(const float* __restrict__ src, int ldsrc, bf16_t* __restrict__ dst, int K, int kt, int nt, int mode,
                   char* smem) {
  float* lds = (float*)smem;
  int tid = threadIdx.x;
  asm volatile("" : "+v"(tid));
  {
    int col = tid & 63, rq = tid >> 6;
    int n = colmap(mode, nt * 64 + col);
#pragma unroll 4
    for (int r = 0; r < 16; ++r) {
      int kl = r * 4 + rq;
      float v = n >= 0 ? src[(size_t)(kt * 64 + kl) * ldsrc + n] : 0.f;
      lds[kl * 65 + col] = v;
    }
  }
  __syncthreads();
  {
    int nl = tid >> 2, kq = (tid & 3) * 16;
    float v[16];
#pragma unroll
    for (int i = 0; i < 16; ++i) v[i] = lds[(kq + i) * 65 + nl];
    st_bf16x16(dst + (size_t)(nt * 64 + nl) * K + kt * 64 + kq, v);
  }
  __syncthreads();
}
DI void mod_item(const Params& p, int item, char* smem) {
  float* sil = (float*)smem;
  int tid = threadIdx.x;
  asm volatile("" : "+v"(tid));
  const int cg_ = item >> 2, slab = item & 3, kbase = slab * 256;
  for (int i = tid; i < 9 * 256; i += 256) {
    int j = i >> 8, k = kbase + (i & 255);
    float cv = j == 0 ? p.c_ctx[k] : p.c[(j - 1) * 1024 + k];
    sil[i] = siluf_(cv);
  }
  __syncthreads();
  const int kq = tid >> 6, nn = tid & 63, n0 = cg_ * 64;
  float acc[9];
#pragma unroll
  for (int j = 0; j < 9; ++j) acc[j] = 0.f;
#pragma unroll 1
  for (int i0 = 0; i0 < 64; i0 += 16) {
    float wv[16];
#pragma unroll
    for (int i = 0; i < 16; ++i) wv[i] = p.w_mod[(size_t)(kbase + kq + 4 * (i0 + i)) * 6144 + n0 + nn];
#pragma unroll
    for (int i = 0; i < 16; ++i)
#pragma unroll
      for (int j = 0; j < 9; ++j) acc[j] += sil[j * 256 + kq + 4 * (i0 + i)] * wv[i];
  }
  __syncthreads();
  float* part = (float*)smem + 9 * 256;
#pragma unroll
  for (int j = 0; j < 9; ++j) part[(kq * 9 + j) * 64 + nn] = acc[j];
  __syncthreads();
  float* mod = (float*)(p.ws + OFF_MOD);
  for (int i = tid; i < 9 * 64; i += 256) {
    int j = i >> 6, n = i & 63;
    float s = part[(0 * 9 + j) * 64 + n] + part[(1 * 9 + j) * 64 + n] + part[(2 * 9 + j) * 64 + n] + part[(3 * 9 + j) * 64 + n];
    if (slab == 0) s += p.b_mod[n0 + n];
    atomicAdd(mod + j * 6144 + n0 + n, s);
  }
  __syncthreads();
}
DI void conv_flat(const float* __restrict__ src, bf16_t* __restrict__ dst, size_t n) {
  size_t i = ((size_t)blockIdx.x * 256 + threadIdx.x) * 8;
  const size_t stride = (size_t)gridDim.x * 256 * 8;
  for (; i < n; i += stride) {
    float4 a = *(const float4*)(src + i), b = *(const float4*)(src + i + 4);
    u32x4 o;
    o[0] = pack2(a.x, a.y); o[1] = pack2(a.z, a.w); o[2] = pack2(b.x, b.y); o[3] = pack2(b.z, b.w);
    *(u32x4*)(dst + i) = o;
  }
}
DI void phase0(const Params& p, char* smem) {
  const int bid = blockIdx.x, nb = gridDim.x;
  char* ws = p.ws;
  const int n_mod = 384;
  const int t_in = 16 * 72, t_uq = 4 * 12, t_ukv = 2 * 16, t_upa = 8 * 16, t_upb = 8 * 16, t_o = 16 * 16;
  const int total = n_mod + t_in;
  (void)t_uq; (void)t_ukv; (void)t_upa; (void)t_upb; (void)t_o;
  for (int it = bid; it < total; it += nb) {
    int i = it;
    if (i < n_mod) { mod_item(p, i, smem); continue; }
    i -= n_mod;
    tconv_tile(p.w_in, 4512, (bf16_t*)(ws + OFF_WINT), 1024, i / 72, i % 72, 1, smem);
  }
  conv_flat(p.peer_wq, (bf16_t*)(ws + OFF_WPQB), (size_t)1024 * 2048);
  {
    size_t i = ((size_t)bid * 256 + threadIdx.x) * 8;
    const size_t stride = (size_t)nb * 256 * 8;
    bf16_t* kb = (bf16_t*)(ws + OFF_KEYSB);
    for (; i < (size_t)2 * 131072; i += stride) {
      int half = i >= 131072;
      size_t s = i - (size_t)half * 131072;
      int h = (int)(s >> 14);
      size_t r = s & 16383;
      const float* src = (half ? p.keys2 : p.keys1) + s;
      float4 a = *(const float4*)(src), b = *(const float4*)(src + 4);
      u32x4 o;
      o[0] = pack2(a.x, a.y); o[1] = pack2(a.z, a.w); o[2] = pack2(b.x, b.y); o[3] = pack2(b.z, b.w);
      *(u32x4*)(kb + ((size_t)(h * 2 + half) << 14) + r) = o;
    }
  }
  {
    float2* rope = (float2*)(ws + OFF_ROPE);
    for (int idx = bid * 256 + threadIdx.x; idx < 2048 * 16; idx += nb * 256) {
      const int t = idx >> 4, a = idx & 15;
      const float pos = (a < 8) ? (float)(t >> 6) : (float)(t & 63);
      const float fr = exp2f(-(float)(a & 7) * 1.6609640474436813f);
      float sn, cs;
      sincosf(pos * fr, &sn, &cs);
      rope[idx] = make_float2(cs, sn);
    }
  }
}

DI void rows_norm_mod(const Params& p, const float* nw, int sh_off, int sc_off, bool from_out, bf16_t* dst) {
  const int lane = threadIdx.x & 63, w = threadIdx.x >> 6;
  const float* mod = (const float*)(p.ws + OFF_MOD);
  for (int tok = blockIdx.x * 4 + w; tok < NTOK; tok += gridDim.x * 4) {
    const float* xr = from_out ? p.out + (size_t)tok * DM : xrow(p, tok);
    const float* mj = mod + modidx(tok) * 6144;
    float4 xv[4];
    float ss = 0.f;
#pragma unroll
    for (int i = 0; i < 4; ++i) {
      xv[i] = *(const float4*)(xr + (i * 64 + lane) * 4);
      ss += xv[i].x * xv[i].x + xv[i].y * xv[i].y + xv[i].z * xv[i].z + xv[i].w * xv[i].w;
    }
    ss = wsum(ss);
    float rstd = rsqrtf(ss * (1.f / 1024.f) + 1e-6f);
#pragma unroll
    for (int i = 0; i < 4; ++i) {
      int e = (i * 64 + lane) * 4;
      float4 nv = *(const float4*)(nw + e), sh = *(const float4*)(mj + sh_off + e), sc = *(const float4*)(mj + sc_off + e);
      float h0 = (xv[i].x * rstd) * nv.x * (1.f + sc.x) + sh.x;
      float h1 = (xv[i].y * rstd) * nv.y * (1.f + sc.y) + sh.y;
      float h2 = (xv[i].z * rstd) * nv.z * (1.f + sc.z) + sh.z;
      float h3 = (xv[i].w * rstd) * nv.w * (1.f + sc.w) + sh.w;
      u32x2 o;
      o[0] = pack2(h0, h1); o[1] = pack2(h2, h3);
      *(u32x2*)(dst + (size_t)tok * DM + e) = o;
    }
  }
}
DI void phase1(const Params& p, char* smem) {
  rows_norm_mod(p, p.norm_mix, 0, 1024, false, (bf16_t*)(p.ws + OFF_H1));
}
DI void side_weights(const Params& p, char* smem, int rank, int nwork) {
  char* ws = p.ws;
  const int t_uq = 4 * 12, t_ukv = 2 * 16, t_upa = 8 * 16, t_upb = 8 * 16, t_o = 16 * 16, t_wc = 128;
  const int total = t_uq + t_ukv + t_upa + t_upb + t_o + t_wc;
  const bf16_t* wpq = (const bf16_t*)(ws + OFF_WPQB);
  const bf16_t* kb = (const bf16_t*)(ws + OFF_KEYSB);
  bf16_t* wct = (bf16_t*)(ws + OFF_WCT);
  for (int it = rank; it < total; it += nwork) {
    int i = it;
    if (i < t_wc) {
      int hh = i >> 3, mt = i & 7;
      f32x4 acc[4][4];
      acc_zero(acc);
      gemm_kloop<0>(acc, wpq + (size_t)(mt * 128) * 2048 + hh * 128, 2048, kb + (size_t)hh * 16384, 128, 128, smem, 0.f, 0.f);
      epilogue(acc, [&](int m, int n, float (&v)[16]) { st_bf16x16(wct + (size_t)(hh * 128 + n) * 1024 + mt * 128 + m, v); });
      __syncthreads();
      continue;
    }
    i -= t_wc;
    if (i < t_uq) { tconv_tile(p.w_uq, 768, (bf16_t*)(ws + OFF_WUQT), 256, i / 12, i % 12, 0, smem); continue; }
    i -= t_uq;
    if (i < t_ukv) { tconv_tile(p.w_ukv, 1024, (bf16_t*)(ws + OFF_WUKVT), 128, i / 16, i % 16, 2, smem); continue; }
    i -= t_ukv;
    if (i < t_upa) { tconv_tile(p.w_up_a, 1024, (bf16_t*)(ws + OFF_WUPAT), 512, i / 16, i % 16, 0, smem); continue; }
    i -= t_upa;
    if (i < t_upb) { tconv_tile(p.w_up_b, 1024, (bf16_t*)(ws + OFF_WUPBT), 512, i / 16, i % 16, 0, smem); continue; }
    i -= t_upb;
    tconv_tile(p.w_o, 1024, (bf16_t*)(ws + OFF_WOT), 1024, i / 16, i % 16, 0, smem);
  }
}

DI void phase2(const Params& p, char* smem) {
  char* ws = p.ws;
  const bf16_t* winT = (const bf16_t*)(ws + OFF_WINT);
  const bf16_t* h1 = (const bf16_t*)(ws + OFF_H1);
  bf16_t* cq = (bf16_t*)(ws + OFF_CQ);
  float* ckvraw = (float*)(ws + OFF_CKVRAW);
  float* krraw = (float*)(ws + OFF_KRRAW);
  bf16_t* rq = (bf16_t*)(ws + OFF_RQ);
  bf16_t* rk = (bf16_t*)(ws + OFF_RK);
  bf16_t* kT = (bf16_t*)(ws + OFF_KT);
  bf16_t* vT = (bf16_t*)(ws + OFF_VT);
  bf16_t* srg = (bf16_t*)(ws + OFF_SRG);
  bf16_t* sga = (bf16_t*)p.out;
  bf16_t* sgb = sga + (size_t)NTOK * 1024;
  u32x4 pra[4], prb[4];
  int ft, tt;
  bool have = tile_map(0, 36, 160, 4, ft, tt);
  if (have) {
    const bf16_t* W0 = winT + (size_t)ft * 128 * 1024;
    const bf16_t* H0 = h1 + (size_t)tt * 128 * 1024;
    const bool sw = ft >= 8 && ft < 16;
    gemm_issue0(sw ? H0 : W0, 1024, sw ? W0 : H0, 1024, pra, prb);
  }
  for (int it = 0; have; ++it) {
    f32x4 acc[4][4];
    acc_zero(acc);
    const bf16_t* W = winT + (size_t)ft * 128 * 1024;
    const bf16_t* H = h1 + (size_t)tt * 128 * 1024;
    const int tok0 = tt * 128, f0 = ft * 128;
    const bool swp = ft >= 8 && ft < 16;
    gemm_kloop_pre<0>(acc, swp ? H : W, 1024, swp ? W : H, 1024, 1024, smem, 0.f, 0.f, pra, prb);
    int ft2 = 0, tt2 = 0;
    const bool have2 = tile_map(it + 1, 36, 160, 4, ft2, tt2);
    if (have2) {
      const bf16_t* W2 = winT + (size_t)ft2 * 128 * 1024;
      const bf16_t* H2 = h1 + (size_t)tt2 * 128 * 1024;
      const bool sw2 = ft2 >= 8 && ft2 < 16;
      gemm_issue0(sw2 ? H2 : W2, 1024, sw2 ? W2 : H2, 1024, pra, prb);
    }
    if (ft >= 8 && ft < 16) {
      if (ft < 12) {
        epilogue(acc, [&](int m, int n, float (&v)[16]) {
          int feat = f0 - 1024 + n, tok = tok0 + m;
#pragma unroll
          for (int i = 0; i < 16; ++i) v[i] *= 0.08838834764831845f;
          st_bf16x16(kT + (size_t)feat * NTOK + tok, v);
#pragma unroll
          for (int i = 0; i < 16; ++i) rk[(size_t)(tok + i) * 512 + feat] = (bf16_t)f2bf(v[i]);
        });
      } else {
        epilogue(acc, [&](int m, int n, float (&v)[16]) {
          int feat = f0 - 1536 + n, tok = tok0 + m;
          st_bf16x16(vT + (size_t)feat * NTOK + tok, v);
        });
      }
    } else {
      if (ft < 2) {
        epilogue(acc, [&](int m, int n, float (&v)[16]) { st_bf16x16(cq + (size_t)(tok0 + n) * 256 + f0 + m, v); });
      } else if (ft == 2) {
        epilogue(acc, [&](int m, int n, float (&v)[16]) { st_f32x16(ckvraw + (size_t)(tok0 + n) * 128 + m, v); });
      } else if (ft == 3) {
        epilogue(acc, [&](int m, int n, float (&v)[16]) {
          if (m < 32) st_f32x16(krraw + (size_t)(tok0 + n) * 32 + m, v);
        });
      } else if (ft < 8) {
        epilogue(acc, [&](int m, int n, float (&v)[16]) { st_bf16x16(rq + (size_t)(tok0 + n) * 512 + f0 - 512 + m, v); });
      } else if (ft < 20) {
        epilogue(acc, [&](int m, int n, float (&v)[16]) {
#pragma unroll
          for (int i = 0; i < 16; ++i) v[i] = siluf_(v[i]);
          st_bf16x16(srg + (size_t)(tok0 + n) * 512 + f0 - 2048 + m, v);
        });
      } else if (ft < 28) {
        epilogue(acc, [&](int m, int n, float (&v)[16]) {
#pragma unroll
          for (int i = 0; i < 16; ++i) v[i] = sigmoidf_(v[i]);
          st_bf16x16(sga + (size_t)(tok0 + n) * 1024 + f0 - 2560 + m, v);
        });
      } else {
        epilogue(acc, [&](int m, int n, float (&v)[16]) {
#pragma unroll
          for (int i = 0; i < 16; ++i) v[i] = sigmoidf_(v[i]);
          st_bf16x16(sgb + (size_t)(tok0 + n) * 1024 + f0 - 3584 + m, v);
        });
      }
    }
    ft = ft2; tt = tt2; have = have2;
  }
  {
    const int nloc = gridDim.x >> 3, loc = blockIdx.x >> 3;
    const int rem = nloc > 0 ? (720 % nloc) : 0;
    if (nloc == 0 || rem == 0) side_weights(p, smem, blockIdx.x, gridDim.x);
    else if (loc >= rem && loc < nloc) side_weights(p, smem, (loc - rem) * 8 + (blockIdx.x & 7), (nloc - rem) * 8);
  }
}

DI float log2gamma(float logit) { return -log1pf(expf(-logit)) * 1.4426950408889634f; }
DI void phase3(const Params& p, char* smem) {
  char* ws = p.ws;
  const int lane = threadIdx.x & 63, w = threadIdx.x >> 6;
  bf16_t* cq = (bf16_t*)(ws + OFF_CQ);
  const float* ckvraw = (const float*)(ws + OFF_CKVRAW);
  const float* krraw = (const float*)(ws + OFF_KRRAW);
  bf16_t* ckvall = (bf16_t*)(ws + OFF_CKVALL);
  bf16_t* krall = (bf16_t*)(ws + OFF_KRALL);
  for (int r = blockIdx.x * 4 + w; r < NTOK + 4096; r += gridDim.x * 4) {
    if (r < NTOK) {
      const int tok = r;
      {
        u32x2 u = *(const u32x2*)(cq + (size_t)tok * 256 + lane * 4);
        float a0 = bflo(u[0]), a1 = bfhi(u[0]), a2 = bflo(u[1]), a3 = bfhi(u[1]);
        float ss = wsum(a0 * a0 + a1 * a1 + a2 * a2 + a3 * a3);
        float rstd = rsqrtf(ss * (1.f / 256.f) + 1e-6f);
        float4 nq = *(const float4*)(p.q_norm + lane * 4);
        u32x2 o;
        o[0] = pack2(a0 * rstd * nq.x, a1 * rstd * nq.y);
        o[1] = pack2(a2 * rstd * nq.z, a3 * rstd * nq.w);
        *(u32x2*)(cq + (size_t)tok * 256 + lane * 4) = o;
      }
      const int row = kvrow(tok);
      {
        float2 v = *(const float2*)(ckvraw + (size_t)tok * 128 + lane * 2);
        float ss = wsum(v.x * v.x + v.y * v.y);
        float rstd = rsqrtf(ss * (1.f / 128.f) + 1e-6f);
        float2 nk = *(const float2*)(p.kv_norm + lane * 2);
        float o0 = v.x * rstd * nk.x, o1 = v.y * rstd * nk.y;
        if (tok < NPT) *(float2*)(p.out + OUT_CKV + (size_t)tok * 128 + lane * 2) = make_float2(o0, o1);
        *(unsigned*)(ckvall + (size_t)row * 128 + lane * 2) = pack2(o0, o1);
      }
      if (lane < 32) {
        float own = krraw[(size_t)tok * 32 + lane];
        float o = own;
        if (tok < NPT) {
          p.out[OUT_KR + (size_t)tok * 32 + lane] = own;
        } else {
          float partner = krraw[(size_t)tok * 32 + (lane ^ 16)];
          int t = (tok - NPT) & 2047;
          const float2 csn = ((const float2*)(ws + OFF_ROPE))[t * 16 + (lane & 15)];
          const float cs = csn.x, sn = csn.y;
          o = lane < 16 ? own * cs - partner * sn : partner * sn + own * cs;
        }
        krall[(size_t)row * 32 + lane] = (bf16_t)f2bf(o);
      }
    } else {
      const int cr = r - NTOK;
      const int b = cr >> 9, pos = cr & 511;
      const int row = NPT + b * 2560 + 2048 + pos;
      float2 v = *(const float2*)(p.cache_ckv + (size_t)cr * 128 + lane * 2);
      *(unsigned*)(ckvall + (size_t)row * 128 + lane * 2) = pack2(v.x, v.y);
      if (lane < 32) krall[(size_t)row * 32 + lane] = (bf16_t)f2bf(p.cache_krope[(size_t)cr * 32 + lane]);
    }
  }
  const bf16_t* kT = (const bf16_t*)(ws + OFF_KT);
  const bf16_t* vT = (const bf16_t*)(ws + OFF_VT);
  float* Uf = (float*)(ws + OFF_UF);
  float* Ub = (float*)(ws + OFF_UB);
  for (int it = blockIdx.x; it < 320; it += gridDim.x) {
    const int blk = it >> 2, h = it & 3;
    const float l2f = log2gamma(p.lg_f[h]), l2b = log2gamma(p.lg_b[h]);
    const bf16_t* Kp = kT + (size_t)(h * 128) * NTOK + blk * 256;
    const bf16_t* Vp = vT + (size_t)(h * 128) * NTOK + blk * 256;
#pragma unroll 1
    for (int dir = 0; dir < 2; ++dir) {
      const float sa = dir ? 0.f : l2f * 255.f, sb = dir ? l2b : -l2f;
      f32x4 acc[4][4];
      acc_zero(acc);
      if (blk < 16) {
        gemm_kloop<1>(acc, Vp, NTOK, Kp, NTOK, 256, smem, sa, sb);
        float* dst = p.out + (dir ? OUT_SB : OUT_SF) + (size_t)(blk * 4 + h) * 16384;
        epilogue(acc, [&](int m, int n, float (&v)[16]) { st_f32x16(dst + n * 128 + m, v); });
      } else {
        gemm_kloop<1>(acc, Kp, NTOK, Vp, NTOK, 256, smem, sa, sb);
        float* dst = (dir ? Ub : Uf) + (size_t)((blk - 16) * 4 + h) * 16384;
        epilogue(acc, [&](int m, int n, float (&v)[16]) { st_f32x16(dst + n * 128 + m, v); });
      }
    }
  }
}

DI void phase4(const Params& p) {
  char* ws = p.ws;
  const float* Uf = (const float*)(ws + OFF_UF);
  const float* Ub = (const float*)(ws + OFF_UB);
  bf16_t* Sf = (bf16_t*)(ws + OFF_SF);
  bf16_t* Sb = (bf16_t*)(ws + OFF_SB);
  for (int idx = blockIdx.x * 256 + threadIdx.x; idx < (1 << 20); idx += gridDim.x * 256) {
    int d = idx & 127, e = (idx >> 7) & 127, h = (idx >> 14) & 3, b = (idx >> 16) & 7, dir = idx >> 19;
    size_t eo = (size_t)e * 128 + d;
    if (dir == 0) {
      float cf = exp2f(log2gamma(p.lg_f[h]) * 256.f);
      float S = p.st_f[(size_t)(b * 4 + h) * 16384 + d * 128 + e];
#pragma unroll
      for (int blk = 0; blk < 8; ++blk) {
        size_t o = (size_t)((b * 8 + blk) * 4 + h) * 16384 + eo;
        Sf[o] = (bf16_t)f2bf(S);
        S = cf * S + Uf[o];
      }
    } else {
      float cb = exp2f(log2gamma(p.lg_b[h]) * 256.f);
      float S = p.st_b[(size_t)(b * 4 + h) * 16384 + d * 128 + e];
#pragma unroll
      for (int blk = 7; blk >= 0; --blk) {
        size_t o = (size_t)((b * 8 + blk) * 4 + h) * 16384 + eo;
        Sb[o] = (bf16_t)f2bf(S);
        S = cb * S + Ub[o];
      }
    }
  }
}

DI bf16x8 scale_frag(bf16x8 q, float s) {
  u32x4 u = __builtin_bit_cast(u32x4, q);
#pragma unroll
  for (int i = 0; i < 4; ++i) u[i] = pack2(bflo(u[i]) * s, bfhi(u[i]) * s);
  return __builtin_bit_cast(bf16x8, u);
}
constexpr int NQT = 1;
DI void phase5(const Params& p, char* smem) {
  char* ws = p.ws;
  const bf16_t* rq = (const bf16_t*)(ws + OFF_RQ);
  const bf16_t* rk = (const bf16_t*)(ws + OFF_RK);
  const bf16_t* vT = (const bf16_t*)(ws + OFF_VT);
  const bf16_t* srg = (const bf16_t*)(ws + OFF_SRG);
  const bf16_t* Sf = (const bf16_t*)(ws + OFF_SF);
  const bf16_t* Sb = (const bf16_t*)(ws + OFF_SB);
  bf16_t* ret = (bf16_t*)(ws + OFF_RET);
  bf16_t* Ks0 = (bf16_t*)smem;
  const int tid = threadIdx.x, lane = tid & 63, w = tid >> 6, l15 = lane & 15, g = lane >> 4;
  for (int item = vbid(); item < 640 * (2 / NQT); item += gridDim.x) {
    const int qb = item >> 2, h = item & 3, blk = (qb * NQT) >> 2;
    const float l2f = log2gamma(p.lg_f[h]), l2b = log2gamma(p.lg_b[h]);
    const int tokw = qb * (64 * NQT) + w * (16 * NQT);
    bf16x8 Q[NQT][4];
#pragma unroll
    for (int qt = 0; qt < NQT; ++qt)
#pragma unroll
      for (int ks = 0; ks < 4; ++ks)
        Q[qt][ks] = *(const bf16x8*)(rq + (size_t)(tokw + qt * 16 + l15) * 512 + h * 128 + ks * 32 + g * 8);
    f32x4 o[8][NQT];
#pragma unroll
    for (int et = 0; et < 8; ++et)
#pragma unroll
      for (int qt = 0; qt < NQT; ++qt) o[et][qt] = f32x4{0.f, 0.f, 0.f, 0.f};
    u32x4 rk_[4], rv_[4];
    auto gload = [&](int kt) {
      const int key0 = blk * 256 + kt * 64;
#pragma unroll
      for (int i = 0; i < 4; ++i) {
        int c = tid + 256 * i;
        int r = c >> 4, cc = (c & 15) * 8;
        rk_[i] = *(const u32x4*)(rk + (size_t)(key0 + r) * 512 + h * 128 + cc);
        int e = c >> 3, c2 = (c & 7) * 8;
        rv_[i] = *(const u32x4*)(vT + (size_t)(h * 128 + e) * NTOK + key0 + c2);
      }
    };
    auto lstore = [&](int b_) {
      bf16_t* Kd = Ks0 + b_ * 18432;
      bf16_t* Vd = Kd + 64 * 144;
#pragma unroll
      for (int i = 0; i < 4; ++i) {
        int c = tid + 256 * i;
        int r = c >> 4, cc = (c & 15) * 8;
        *(u32x4*)(Kd + r * 144 + cc) = rk_[i];
        int e = c >> 3, c2 = (c & 7) * 8;
        *(u32x4*)(Vd + e * 72 + c2) = rv_[i];
      }
    };
    gload(0);
    __syncthreads();
    lstore(0);
    gload(1);
    __syncthreads();
#pragma unroll 1
    for (int kt = 0; kt < 4; ++kt) {
      const bf16_t* Ks = Ks0 + (kt & 1) * 18432;
      const bf16_t* Vs = Ks + 64 * 144;
      bf16x8 P[NQT][2];
#pragma unroll
      for (int qt = 0; qt < NQT; ++qt) {
        f32x4 s[4];
#pragma unroll
        for (int kk = 0; kk < 4; ++kk) s[kk] = f32x4{0.f, 0.f, 0.f, 0.f};
#pragma unroll
        for (int ks = 0; ks < 4; ++ks) {
#pragma unroll
          for (int kk = 0; kk < 4; ++kk) {
            bf16x8 a = *(const bf16x8*)(Ks + (kk * 16 + l15) * 144 + ks * 32 + g * 8);
            s[kk] = __builtin_amdgcn_mfma_f32_16x16x32_bf16(a, Q[qt][ks], s[kk], 0, 0, 0);
          }
        }
        const int iq = (tokw + qt * 16 + l15) & 255;
#pragma unroll
        for (int kk = 0; kk < 4; ++kk) {
#pragma unroll
          for (int j = 0; j < 4; ++j) {
            int jk = kt * 64 + kk * 16 + 4 * g + j;
            int diff = iq - jk;
            float dm = diff > 0 ? ex2(l2f * (float)diff) : (diff < 0 ? ex2(l2b * (float)(-diff)) : 2.f);
            s[kk][j] *= dm;
          }
        }
#pragma unroll
        for (int k2 = 0; k2 < 2; ++k2) {
          u32x4 u;
          u[0] = pack2(s[2 * k2][0], s[2 * k2][1]);
          u[1] = pack2(s[2 * k2][2], s[2 * k2][3]);
          u[2] = pack2(s[2 * k2 + 1][0], s[2 * k2 + 1][1]);
          u[3] = pack2(s[2 * k2 + 1][2], s[2 * k2 + 1][3]);
          P[qt][k2] = __builtin_bit_cast(bf16x8, u);
        }
      }
#pragma unroll
      for (int k2 = 0; k2 < 2; ++k2) {
#pragma unroll
        for (int et = 0; et < 8; ++et) {
          u32x2 lo = *(const u32x2*)(Vs + (et * 16 + l15) * 72 + k2 * 32 + 4 * g);
          u32x2 hi = *(const u32x2*)(Vs + (et * 16 + l15) * 72 + k2 * 32 + 16 + 4 * g);
          u32x4 u;
          u[0] = lo[0]; u[1] = lo[1]; u[2] = hi[0]; u[3] = hi[1];
          bf16x8 a = __builtin_bit_cast(bf16x8, u);
#pragma unroll
          for (int qt = 0; qt < NQT; ++qt) o[et][qt] = __builtin_amdgcn_mfma_f32_16x16x32_bf16(a, P[qt][k2], o[et][qt], 0, 0, 0);
        }
      }
      if (kt + 1 < 4) {
        lstore((kt + 1) & 1);
        if (kt + 2 < 4) gload(kt + 2);
        __syncthreads();
      }
    }
    if (blk >= 16) {
      bf16_t* SL = (bf16_t*)smem;
      __syncthreads();
#pragma unroll
      for (int dir = 0; dir < 2; ++dir) {
        const bf16_t* S = (dir ? Sb : Sf) + (size_t)((blk - 16) * 4 + h) * 16384;
#pragma unroll
        for (int i = 0; i < 8; ++i) {
          int c = tid + 256 * i;
          int e = c >> 4, cc = (c & 15) * 8;
          *(u32x4*)(SL + dir * (128 * 144) + e * 144 + cc) = *(const u32x4*)(S + e * 128 + cc);
        }
      }
      __syncthreads();
#pragma unroll 1
      for (int dir = 0; dir < 2; ++dir) {
        const bf16_t* S = SL + dir * (128 * 144);
        float dq[NQT];
#pragma unroll
        for (int qt = 0; qt < NQT; ++qt) {
          int iq = (tokw + qt * 16 + l15) & 255;
          dq[qt] = dir ? exp2f(l2b * (float)(256 - iq)) : exp2f(l2f * (float)(iq + 1));
        }
#pragma unroll
        for (int ks = 0; ks < 4; ++ks) {
          bf16x8 qs[NQT];
#pragma unroll
          for (int qt = 0; qt < NQT; ++qt) qs[qt] = scale_frag(Q[qt][ks], dq[qt]);
#pragma unroll
          for (int et = 0; et < 8; ++et) {
            bf16x8 a = *(const bf16x8*)(S + (et * 16 + l15) * 144 + ks * 32 + g * 8);
#pragma unroll
            for (int qt = 0; qt < NQT; ++qt) o[et][qt] = __builtin_amdgcn_mfma_f32_16x16x32_bf16(a, qs[qt], o[et][qt], 0, 0, 0);
          }
        }
      }
    }
#pragma unroll
    for (int qt = 0; qt < NQT; ++qt) {
      const int tok = tokw + qt * 16 + l15;
      float s1 = 0.f;
#pragma unroll
      for (int et = 0; et < 8; ++et)
#pragma unroll
        for (int j = 0; j < 4; ++j) s1 += o[et][qt][j];
      s1 += __shfl_xor(s1, 16);
      s1 += __shfl_xor(s1, 32);
      const float mu = s1 * (1.f / 128.f);
      float s2 = 0.f;
#pragma unroll
      for (int et = 0; et < 8; ++et)
#pragma unroll
        for (int j = 0; j < 4; ++j) {
          float dlt = o[et][qt][j] - mu;
          s2 += dlt * dlt;
        }
      s2 += __shfl_xor(s2, 16);
      s2 += __shfl_xor(s2, 32);
      const float rstd = rsqrtf(s2 * (1.f / 128.f) + 1e-6f);
#pragma unroll
      for (int et = 0; et < 8; ++et) {
        const int e = h * 128 + et * 16 + 4 * g;
        float4 gn = *(const float4*)(p.ret_gn + e);
        u32x2 sg = *(const u32x2*)(srg + (size_t)tok * 512 + e);
        u32x2 ov;
        ov[0] = pack2((o[et][qt][0] - mu) * rstd * gn.x * bflo(sg[0]), (o[et][qt][1] - mu) * rstd * gn.y * bfhi(sg[0]));
        ov[1] = pack2((o[et][qt][2] - mu) * rstd * gn.z * bflo(sg[1]), (o[et][qt][3] - mu) * rstd * gn.w * bfhi(sg[1]));
        *(u32x2*)(ret + (size_t)tok * 512 + e) = ov;
      }
    }
  }
}

DI void phase6(const Params& p, char* smem) {
  char* ws = p.ws;
  const bf16_t* cqn = (const bf16_t*)(ws + OFF_CQ);
  const bf16_t* wuqT = (const bf16_t*)(ws + OFF_WUQT);
  bf16_t* q = (bf16_t*)(ws + OFF_Q);
  for (int it = 0;; ++it) {
    int ft, tt;
    if (!tile_map(it, 6, 160, 1, ft, tt)) break;
    f32x4 acc[4][4];
    acc_zero(acc);
    gemm_kloop<0>(acc, wuqT + (size_t)ft * 128 * 256, 256, cqn + (size_t)tt * 128 * 256, 256, 256, smem, 0.f, 0.f);
    epilogue(acc, [&](int m, int n, float (&v)[16]) { st_bf16x16(q + (size_t)(tt * 128 + n) * 768 + ft * 128 + m, v); });
  }
  const bf16_t* ckvall = (const bf16_t*)(ws + OFF_CKVALL);
  const bf16_t* wukvT = (const bf16_t*)(ws + OFF_WUKVT);
  bf16_t* Kn = (bf16_t*)(ws + OFF_KN);
  bf16_t* Vt = (bf16_t*)(ws + OFF_VTA);
  for (int it = 0;; ++it) {
    int ft, tt;
    if (!tile_map(it, 8, 192, 1, ft, tt)) break;
    f32x4 acc[4][4];
    acc_zero(acc);
    const bf16_t* W = wukvT + (size_t)ft * 128 * 128;
    const bf16_t* X = ckvall + (size_t)tt * 128 * 128;
    if (ft < 4) {
      gemm_kloop<0>(acc, W, 128, X, 128, 128, smem, 0.f, 0.f);
      epilogue(acc, [&](int m, int n, float (&v)[16]) { st_bf16x16(Kn + (size_t)(tt * 128 + n) * 512 + ft * 128 + m, v); });
    } else {
      gemm_kloop<0>(acc, X, 128, W, 128, 128, smem, 0.f, 0.f);
      epilogue(acc, [&](int m, int n, float (&v)[16]) { st_bf16x16(Vt + (size_t)((ft - 4) * 128 + n) * NKV + tt * 128 + m, v); });
    }
  }
}

DI void conv_fp8_rows(const float* __restrict__ src, unsigned char* __restrict__ dst, float* __restrict__ inv);
DI void phase7(const Params& p, char* smem) {
  char* ws = p.ws;
  const bf16_t* q = (const bf16_t*)(ws + OFF_Q);
  const bf16_t* Kn = (const bf16_t*)(ws + OFF_KN);
  const bf16_t* Vt = (const bf16_t*)(ws + OFF_VTA);
  const bf16_t* krall = (const bf16_t*)(ws + OFF_KRALL);
  bf16_t* attn = (bf16_t*)(ws + OFF_ATTN);
  bf16_t* Ks0 = (bf16_t*)smem;
  const int tid = threadIdx.x, lane = tid & 63, w = tid >> 6, l15 = lane & 15, g = lane >> 4;
  const float qscale = 0.10206207261596577f * 1.4426950408889634f;
  for (int item = vbid(); item < 1280; item += gridDim.x) {
    int b, h, qtok0, keyrow0, nkt;
    bool sample;
    if (item < 1024) {
      sample = true; b = item >> 7; h = (item >> 4) & 7; int qb = item & 15;
      qtok0 = NPT + b * 2048 + qb * 128; keyrow0 = NPT + b * 2560; nkt = 40;
    } else {
      int it2 = item - 1024;
      sample = false; b = it2 >> 4; h = (it2 >> 1) & 7; int qb = it2 & 1;
      qtok0 = b * 256 + qb * 128; keyrow0 = b * 256; nkt = 4;
    }
    bf16x8 Q[2][3];
#pragma unroll
    for (int qt = 0; qt < 2; ++qt) {
      const int tokq = qtok0 + w * 32 + qt * 16 + l15;
      const bf16_t* qp = q + (size_t)tokq * 768 + h * 96;
#pragma unroll
      for (int ks = 0; ks < 3; ++ks) {
        u32x4 u = *(const u32x4*)(qp + ks * 32 + g * 8);
        float v[8];
#pragma unroll
        for (int i = 0; i < 4; ++i) { v[2 * i] = bflo(u[i]); v[2 * i + 1] = bfhi(u[i]); }
        if (ks == 2 && sample) {
          u32x4 up = *(const u32x4*)(qp + 64 + (g ^ 2) * 8);
          float pv[8];
#pragma unroll
          for (int i = 0; i < 4; ++i) { pv[2 * i] = bflo(up[i]); pv[2 * i + 1] = bfhi(up[i]); }
          int t = (tokq - NPT) & 2047;
          const float4* rp = (const float4*)((const float2*)(ws + OFF_ROPE) + t * 16 + (g & 1) * 8);
#pragma unroll
          for (int i2 = 0; i2 < 4; ++i2) {
            const float4 c2 = rp[i2];
            const int i = 2 * i2;
            v[i] = g < 2 ? v[i] * c2.x - pv[i] * c2.y : pv[i] * c2.y + v[i] * c2.x;
            v[i + 1] = g < 2 ? v[i + 1] * c2.z - pv[i + 1] * c2.w : pv[i + 1] * c2.w + v[i + 1] * c2.z;
          }
        }
        u32x4 o4;
#pragma unroll
        for (int i = 0; i < 4; ++i) o4[i] = pack2(v[2 * i] * qscale, v[2 * i + 1] * qscale);
        Q[qt][ks] = __builtin_bit_cast(bf16x8, o4);
      }
    }
    f32x4 o[4][2];
#pragma unroll
    for (int et = 0; et < 4; ++et)
#pragma unroll
      for (int qt = 0; qt < 2; ++qt) o[et][qt] = f32x4{0.f, 0.f, 0.f, 0.f};
    float mrun[2] = {-1e30f, -1e30f}, lrun[2] = {0.f, 0.f};
    u32x4 rk_[3], rv_[2];
    auto gload = [&](int kt) {
      const int row0 = keyrow0 + kt * 64;
#pragma unroll
      for (int i = 0; i < 3; ++i) {
        int c = tid + 256 * i;
        int r = c / 12, cc = c - r * 12;
        rk_[i] = cc < 8 ? *(const u32x4*)(Kn + (size_t)(row0 + r) * 512 + h * 64 + cc * 8)
                        : *(const u32x4*)(krall + (size_t)(row0 + r) * 32 + (cc - 8) * 8);
      }
#pragma unroll
      for (int i = 0; i < 2; ++i) {
        int c = tid + 256 * i;
        int e = c >> 3, cc = (c & 7) * 8;
        rv_[i] = *(const u32x4*)(Vt + (size_t)(h * 64 + e) * NKV + row0 + cc);
      }
    };
    auto lstore = [&](int b) {
      bf16_t* Kd = Ks0 + b * 11776;
      bf16_t* Vd = Kd + 64 * 112;
#pragma unroll
      for (int i = 0; i < 3; ++i) {
        int c = tid + 256 * i;
        int r = c / 12, cc = c - r * 12;
        *(u32x4*)(Kd + r * 112 + cc * 8) = rk_[i];
      }
#pragma unroll
      for (int i = 0; i < 2; ++i) {
        int c = tid + 256 * i;
        int e = c >> 3, cc = (c & 7) * 8;
        *(u32x4*)(Vd + e * 72 + cc) = rv_[i];
      }
    };
    gload(0);
    __syncthreads();
    lstore(0);
    if (nkt > 1) gload(1);
    __syncthreads();
#pragma unroll 1
    for (int kt = 0; kt < nkt; ++kt) {
      const bf16_t* Ks = Ks0 + (kt & 1) * 11776;
      const bf16_t* Vs = Ks + 64 * 112;
      f32x4 s[4][2];
#pragma unroll
      for (int kk = 0; kk < 4; ++kk)
#pragma unroll
        for (int qt = 0; qt < 2; ++qt) s[kk][qt] = f32x4{0.f, 0.f, 0.f, 0.f};
#pragma unroll
      for (int ks = 0; ks < 3; ++ks) {
#pragma unroll
        for (int kk = 0; kk < 4; ++kk) {
          bf16x8 a = *(const bf16x8*)(Ks + (kk * 16 + l15) * 112 + ks * 32 + g * 8);
#pragma unroll
          for (int qt = 0; qt < 2; ++qt) s[kk][qt] = __builtin_amdgcn_mfma_f32_16x16x32_bf16(a, Q[qt][ks], s[kk][qt], 0, 0, 0);
        }
      }
      bf16x8 P[2][2];
#pragma unroll
      for (int qt = 0; qt < 2; ++qt) {
        float mx = s[0][qt][0];
#pragma unroll
        for (int kk = 0; kk < 4; ++kk)
#pragma unroll
          for (int j = 0; j < 4; ++j) mx = fmaxf(mx, s[kk][qt][j]);
        mx = fmaxf(mx, __shfl_xor(mx, 16));
        mx = fmaxf(mx, __shfl_xor(mx, 32));
        const float mnew = fmaxf(mrun[qt], mx);
        const bool grow = __ballot(mx > mrun[qt]) != 0ull;
        const float alpha = grow ? ex2(mrun[qt] - mnew) : 1.f;
        mrun[qt] = mnew;
        float ps = 0.f;
#pragma unroll
        for (int kk = 0; kk < 4; ++kk)
#pragma unroll
          for (int j = 0; j < 4; ++j) {
            float e_ = ex2(s[kk][qt][j] - mnew);
            s[kk][qt][j] = e_;
            ps += e_;
          }
        if (grow) {
          lrun[qt] = lrun[qt] * alpha + ps;
#pragma unroll
          for (int et = 0; et < 4; ++et)
#pragma unroll
            for (int j = 0; j < 4; ++j) o[et][qt][j] *= alpha;
        } else {
          lrun[qt] += ps;
        }
#pragma unroll
        for (int k2 = 0; k2 < 2; ++k2) {
          u32x4 u;
          u[0] = pack2(s[2 * k2][qt][0], s[2 * k2][qt][1]);
          u[1] = pack2(s[2 * k2][qt][2], s[2 * k2][qt][3]);
          u[2] = pack2(s[2 * k2 + 1][qt][0], s[2 * k2 + 1][qt][1]);
          u[3] = pack2(s[2 * k2 + 1][qt][2], s[2 * k2 + 1][qt][3]);
          P[qt][k2] = __builtin_bit_cast(bf16x8, u);
        }
      }
#pragma unroll
      for (int k2 = 0; k2 < 2; ++k2) {
#pragma unroll
        for (int et = 0; et < 4; ++et) {
          u32x2 lo = *(const u32x2*)(Vs + (et * 16 + l15) * 72 + k2 * 32 + 4 * g);
          u32x2 hi = *(const u32x2*)(Vs + (et * 16 + l15) * 72 + k2 * 32 + 16 + 4 * g);
          u32x4 u;
          u[0] = lo[0]; u[1] = lo[1]; u[2] = hi[0]; u[3] = hi[1];
          bf16x8 a = __builtin_bit_cast(bf16x8, u);
#pragma unroll
          for (int qt = 0; qt < 2; ++qt) o[et][qt] = __builtin_amdgcn_mfma_f32_16x16x32_bf16(a, P[qt][k2], o[et][qt], 0, 0, 0);
        }
      }
      if (kt + 1 < nkt) {
        lstore((kt + 1) & 1);
        if (kt + 2 < nkt) gload(kt + 2);
        __syncthreads();
      }
    }
#pragma unroll
    for (int qt = 0; qt < 2; ++qt) {
      const int tokq = qtok0 + w * 32 + qt * 16 + l15;
      float lt = lrun[qt];
      lt += __shfl_xor(lt, 16);
      lt += __shfl_xor(lt, 32);
      const float inv = 1.f / lt;
#pragma unroll
      for (int et = 0; et < 4; ++et) {
        u32x2 ov;
        ov[0] = pack2(o[et][qt][0] * inv, o[et][qt][1] * inv);
        ov[1] = pack2(o[et][qt][2] * inv, o[et][qt][3] * inv);
        *(u32x2*)(attn + (size_t)tokq * 512 + h * 64 + et * 16 + 4 * g) = ov;
      }
    }
  }
  conv_fp8_rows(p.peer_u, (unsigned char*)(p.ws + OFF_TABU), (float*)(p.ws + OFF_INVU));
  conv_fp8_rows(p.peer_v, (unsigned char*)(p.ws + OFF_TABV), (float*)(p.ws + OFF_INVV));
}

DI void phase8(const Params& p, char* smem) {
  char* ws = p.ws;
  const bf16_t* attn = (const bf16_t*)(ws + OFF_ATTN);
  const bf16_t* ret = (const bf16_t*)(ws + OFF_RET);
  const bf16_t* wa = (const bf16_t*)(ws + OFF_WUPAT);
  const bf16_t* wb = (const bf16_t*)(ws + OFF_WUPBT);
  const bf16_t* sga = (const bf16_t*)p.out;
  const bf16_t* sgb = sga + (size_t)NTOK * 1024;
  bf16_t* mbuf = (bf16_t*)(ws + OFF_M);
  const int tid = threadIdx.x, lane = tid & 63, w = tid >> 6, wm = w >> 1, wn = w & 1, l15 = lane & 15, g = lane >> 4;
  for (int it = 0;; ++it) {
    int ft, tt;
    if (!tile_map(it, 8, 160, 1, ft, tt)) break;
    f32x4 acc[4][4];
    acc_zero(acc);
    gemm_kloop<0>(acc, wa + (size_t)ft * 128 * 512, 512, attn + (size_t)tt * 128 * 512, 512, 512, smem, 0.f, 0.f);
#pragma unroll
    for (int c = 0; c < 4; ++c) {
      const size_t off = (size_t)(tt * 128 + wn * 64 + c * 16 + l15) * 1024 + ft * 128 + wm * 64 + 16 * g;
      float a[16], bq[16];
      ld_bf16x16(sga + off, a);
      ld_bf16x16(sgb + off, bq);
#pragma unroll
      for (int f = 0; f < 4; ++f)
#pragma unroll
        for (int j = 0; j < 4; ++j) acc[f][c][j] *= a[f * 4 + j] * __builtin_amdgcn_rcpf(fmaxf(bq[f * 4 + j], 1e-30f));
    }
    gemm_kloop<0>(acc, wb + (size_t)ft * 128 * 512, 512, ret + (size_t)tt * 128 * 512, 512, 512, smem, 0.f, 0.f);
    epilogue(acc, [&](int m, int n, float (&v)[16]) {
      const size_t off = (size_t)(tt * 128 + n) * 1024 + ft * 128 + m;
      float bq[16];
      ld_bf16x16(sgb + off, bq);
#pragma unroll
      for (int i = 0; i < 16; ++i) v[i] *= bq[i];
      st_bf16x16(mbuf + off, v);
    });
  }
}
DI void phase9(const Params& p, char* smem) {
  char* ws = p.ws;
  const bf16_t* mbuf = (const bf16_t*)(ws + OFF_M);
  const bf16_t* wo = (const bf16_t*)(ws + OFF_WOT);
  const float* mod = (const float*)(ws + OFF_MOD);
  u32x4 pra[4], prb[4];
  int ft, tt;
  bool have = tile_map(0, 8, 160, 1, ft, tt);
  if (have) gemm_issue0(wo + (size_t)ft * 128 * 1024, 1024, mbuf + (size_t)tt * 128 * 1024, 1024, pra, prb);
  for (int it = 0; have; ++it) {
    f32x4 acc[4][4];
    acc_zero(acc);
    gemm_kloop_pre<0>(acc, wo + (size_t)ft * 128 * 1024, 1024, mbuf + (size_t)tt * 128 * 1024, 1024, 1024, smem, 0.f, 0.f, pra, prb);
    int ft2 = 0, tt2 = 0;
    const bool have2 = tile_map(it + 1, 8, 160, 1, ft2, tt2);
    if (have2) gemm_issue0(wo + (size_t)ft2 * 128 * 1024, 1024, mbuf + (size_t)tt2 * 128 * 1024, 1024, pra, prb);
    epilogue(acc, [&](int m, int n, float (&v)[16]) {
      const int tok = tt * 128 + n, feat = ft * 128 + m;
      const float* xr = xrow(p, tok) + feat;
      const float* g1 = mod + modidx(tok) * 6144 + 2048 + feat;
#pragma unroll
      for (int i = 0; i < 4; ++i) {
        float4 xv = *(const float4*)(xr + 4 * i), gv = *(const float4*)(g1 + 4 * i);
        v[4 * i] = xv.x + gv.x * v[4 * i];
        v[4 * i + 1] = xv.y + gv.y * v[4 * i + 1];
        v[4 * i + 2] = xv.z + gv.z * v[4 * i + 2];
        v[4 * i + 3] = xv.w + gv.w * v[4 * i + 3];
      }
      st_f32x16(p.out + (size_t)tok * DM + feat, v);
    });
    ft = ft2; tt = tt2; have = have2;
  }
}
DI void conv_fp8_rows(const float* __restrict__ src, unsigned char* __restrict__ dst, float* __restrict__ inv) {
  const int lane = threadIdx.x & 63, w = threadIdx.x >> 6;
  for (int r = blockIdx.x * 4 + w; r < 16384; r += gridDim.x * 4) {
    const float* sp = src + (size_t)r * 1024 + lane * 16;
    float4 v[4];
    float am = 0.f;
#pragma unroll
    for (int i = 0; i < 4; ++i) {
      v[i] = *(const float4*)(sp + 4 * i);
      am = fmaxf(am, fmaxf(fmaxf(fabsf(v[i].x), fabsf(v[i].y)), fmaxf(fabsf(v[i].z), fabsf(v[i].w))));
    }
#pragma unroll
    for (int o = 32; o > 0; o >>= 1) am = fmaxf(am, __shfl_xor(am, o));
    const float sc = am > 0.f ? 448.f / am : 1.f;
    u32x4 o4;
#pragma unroll
    for (int i = 0; i < 4; ++i) {
      int wd = 0;
      wd = __builtin_amdgcn_cvt_pk_fp8_f32(v[i].x * sc, v[i].y * sc, wd, false);
      wd = __builtin_amdgcn_cvt_pk_fp8_f32(v[i].z * sc, v[i].w * sc, wd, true);
      o4[i] = (unsigned)wd;
    }
    *(u32x4*)(dst + ((size_t)(lane >> 3) * 16384 + r) * 128 + (lane & 7) * 16) = o4;
    if (lane == 0) inv[r] = am > 0.f ? am * (1.f / 448.f) : 1.f;
  }
}
DI void phase10(const Params& p, char* smem) {
  rows_norm_mod(p, p.norm_ffn, 3072, 4096, true, (bf16_t*)(p.ws + OFF_H2));
}
DI void phase11(const Params& p, char* smem) {
  char* ws = p.ws;
  const bf16_t* h2 = (const bf16_t*)(ws + OFF_H2);
  const bf16_t* wct = (const bf16_t*)(ws + OFF_WCT);
  bf16_t* sc = (bf16_t*)(ws + OFF_SCORES);
  u32x4 pra[4], prb[4];
  int ft, tt;
  bool have = tile_map(0, 16, 160, 2, ft, tt);
  if (have) gemm_issue0(wct + (size_t)ft * 128 * 1024, 1024, h2 + (size_t)tt * 128 * 1024, 1024, pra, prb);
  for (int it = 0; have; ++it) {
    f32x4 acc[4][4];
    acc_zero(acc);
    gemm_kloop_pre<0>(acc, wct + (size_t)ft * 128 * 1024, 1024, h2 + (size_t)tt * 128 * 1024, 1024, 1024, smem, 0.f, 0.f, pra, prb);
    int ft2 = 0, tt2 = 0;
    const bool have2 = tile_map(it + 1, 16, 160, 2, ft2, tt2);
    if (have2) gemm_issue0(wct + (size_t)ft2 * 128 * 1024, 1024, h2 + (size_t)tt2 * 128 * 1024, 1024, pra, prb);
    epilogue(acc, [&](int m, int n, float (&v)[16]) { st_bf16x16(sc + (size_t)(tt * 128 + n) * 2048 + ft * 128 + m, v); });
    ft = ft2; tt = tt2; have = have2;
  }
}

DI unsigned okey(float f) {
  unsigned u = __float_as_uint(f);
  return (u & 0x80000000u) ? ~u : (u | 0x80000000u);
}
DI void wave_lds_sync() {
  __builtin_amdgcn_fence(__ATOMIC_ACQ_REL, "workgroup");
  __builtin_amdgcn_wave_barrier();
}
DI unsigned okey16(unsigned b) { return (b & 0x8000u) ? (~b & 0xFFFFu) : (b | 0x8000u); }
DI unsigned inv_okey16(unsigned k) { return (k & 0x8000u) ? (k & 0x7FFFu) : (~k & 0xFFFFu); }
DI unsigned inv_okey(unsigned k) { return (k & 0x80000000u) ? (k & 0x7FFFFFFFu) : ~k; }
DI void ins16(unsigned (&L)[16], unsigned x) {
#pragma unroll
  for (int i = 0; i < 16; ++i) {
    unsigned t = max(L[i], x);
    x = min(L[i], x);
    L[i] = t;
  }
}
DI void ce_desc(unsigned& a, unsigned& b) {
  const unsigned t = max(a, b);
  b = min(a, b);
  a = t;
}
DI void sort16_desc(unsigned (&a)[16]) {
#pragma unroll
  for (int ks = 1; ks <= 4; ++ks) {
#pragma unroll
    for (int js = ks - 1; js >= 0; --js) {
#pragma unroll
      for (int i = 0; i < 16; ++i) {
        const int k = 1 << ks, j = 1 << js, l = i ^ j;
        if (l > i) {
          if ((i & k) == 0) ce_desc(a[i], a[l]);
          else ce_desc(a[l], a[i]);
        }
      }
    }
  }
}
DI void merge_top16(unsigned (&L)[16], const unsigned (&G)[16]) {
#pragma unroll
  for (int i = 0; i < 16; ++i) L[i] = max(L[i], G[15 - i]);
#pragma unroll
  for (int js = 3; js >= 0; --js) {
#pragma unroll
    for (int i = 0; i < 16; ++i) {
      const int j = 1 << js, l = i ^ j;
      if (l > i) ce_desc(L[i], L[l]);
    }
  }
}
DI unsigned byte16(const unsigned (&d)[4], int i) {
  unsigned r = 0u;
#pragma unroll
  for (int q = 0; q < 4; ++q) r |= d[q] & (0u - (unsigned)((i >> 2) == q));
  return (r >> ((i & 3) * 8)) & 0xFFu;
}
DI unsigned sel16(const unsigned (&A)[16], int i) {
  unsigned r = 0u;
#pragma unroll
  for (int t = 0; t < 16; ++t) r |= A[t] & (0u - (unsigned)(i == t));
  return r;
}
DI void phase12(const Params& p, char* smem) {
  char* ws = p.ws;
  const bf16_t* sc = (const bf16_t*)(ws + OFF_SCORES);
  int* elist = (int*)(ws + OFF_ELIST);
  float* glist = (float*)(ws + OFF_GLIST);
  const int lane = threadIdx.x & 63, w = threadIdx.x >> 6;
  for (int batch = blockIdx.x * 4 + w; batch < NTOK / 4; batch += gridDim.x * 4) {
    const int tok = batch * 4 + (lane >> 4), hh = lane & 15;
    const bf16_t* row = sc + (size_t)tok * 2048 + hh * 128;
    unsigned L[16];
#pragma unroll
    for (int grp8 = 0; grp8 < 8; ++grp8) {
      unsigned G[16];
#pragma unroll
      for (int cc = 0; cc < 2; ++cc) {
        const int c = grp8 * 2 + cc;
        u32x4 u = *(const u32x4*)(row + c * 8);
#pragma unroll
        for (int i = 0; i < 4; ++i) {
          unsigned b0 = u[i] & 0xFFFFu, b1 = u[i] >> 16;
          G[cc * 8 + 2 * i] = (okey16(b0) << 16) | (unsigned)(127 - (c * 8 + 2 * i));
          G[cc * 8 + 2 * i + 1] = (okey16(b1) << 16) | (unsigned)(127 - (c * 8 + 2 * i + 1));
        }
      }
      sort16_desc(G);
      if (grp8 == 0) {
#pragma unroll
        for (int i = 0; i < 16; ++i) L[i] = G[i];
      } else {
        merge_top16(L, G);
      }
    }
    unsigned M[16];
#pragma unroll
    for (int i = 0; i < 16; ++i) M[i] = (unsigned)__shfl_xor((int)L[i], 1);
    float v1[16], v2[16];
#pragma unroll
    for (int i = 0; i < 16; ++i) {
      v1[i] = bf2f(inv_okey16(L[i] >> 16));
      v2[i] = bf2f(inv_okey16(M[i] >> 16));
    }
    unsigned C[16];
    C[0] = ((okey(v1[0] + v2[0]) & 0xFFFFFF00u) | 255u);
    C[1] = ((okey(v1[0] + v2[1]) & 0xFFFFFF00u) | 254u);
    C[2] = ((okey(v1[0] + v2[2]) & 0xFFFFFF00u) | 253u);
    C[3] = ((okey(v1[0] + v2[3]) & 0xFFFFFF00u) | 252u);
    C[4] = ((okey(v1[0] + v2[4]) & 0xFFFFFF00u) | 251u);
    C[5] = ((okey(v1[0] + v2[5]) & 0xFFFFFF00u) | 250u);
    C[6] = ((okey(v1[0] + v2[6]) & 0xFFFFFF00u) | 249u);
    C[7] = ((okey(v1[0] + v2[7]) & 0xFFFFFF00u) | 248u);
    C[8] = ((okey(v1[0] + v2[8]) & 0xFFFFFF00u) | 247u);
    C[9] = ((okey(v1[0] + v2[9]) & 0xFFFFFF00u) | 246u);
    C[10] = ((okey(v1[0] + v2[10]) & 0xFFFFFF00u) | 245u);
    C[11] = ((okey(v1[0] + v2[11]) & 0xFFFFFF00u) | 244u);
    C[12] = ((okey(v1[0] + v2[12]) & 0xFFFFFF00u) | 243u);
    C[13] = ((okey(v1[0] + v2[13]) & 0xFFFFFF00u) | 242u);
    C[14] = ((okey(v1[0] + v2[14]) & 0xFFFFFF00u) | 241u);
    C[15] = ((okey(v1[0] + v2[15]) & 0xFFFFFF00u) | 240u);
    {
      unsigned G[16];
      G[0] = ((okey(v1[1] + v2[0]) & 0xFFFFFF00u) | 239u);
      G[1] = ((okey(v1[1] + v2[1]) & 0xFFFFFF00u) | 238u);
      G[2] = ((okey(v1[1] + v2[2]) & 0xFFFFFF00u) | 237u);
      G[3] = ((okey(v1[1] + v2[3]) & 0xFFFFFF00u) | 236u);
      G[4] = ((okey(v1[1] + v2[4]) & 0xFFFFFF00u) | 235u);
      G[5] = ((okey(v1[1] + v2[5]) & 0xFFFFFF00u) | 234u);
      G[6] = ((okey(v1[1] + v2[6]) & 0xFFFFFF00u) | 233u);
      G[7] = ((okey(v1[1] + v2[7]) & 0xFFFFFF00u) | 232u);
      G[8] = 0u;
      G[9] = 0u;
      G[10] = 0u;
      G[11] = 0u;
      G[12] = 0u;
      G[13] = 0u;
      G[14] = 0u;
      G[15] = 0u;
      merge_top16(C, G);
    }
    {
      unsigned G[16];
      G[0] = ((okey(v1[2] + v2[0]) & 0xFFFFFF00u) | 223u);
      G[1] = ((okey(v1[2] + v2[1]) & 0xFFFFFF00u) | 222u);
      G[2] = ((okey(v1[2] + v2[2]) & 0xFFFFFF00u) | 221u);
      G[3] = ((okey(v1[2] + v2[3]) & 0xFFFFFF00u) | 220u);
      G[4] = ((okey(v1[2] + v2[4]) & 0xFFFFFF00u) | 219u);
      G[5] = 0u;
      G[6] = 0u;
      G[7] = 0u;
      G[8] = 0u;
      G[9] = 0u;
      G[10] = 0u;
      G[11] = 0u;
      G[12] = 0u;
      G[13] = 0u;
      G[14] = 0u;
      G[15] = 0u;
      merge_top16(C, G);
    }
    {
      unsigned G[16];
      G[0] = ((okey(v1[3] + v2[0]) & 0xFFFFFF00u) | 207u);
      G[1] = ((okey(v1[3] + v2[1]) & 0xFFFFFF00u) | 206u);
      G[2] = ((okey(v1[3] + v2[2]) & 0xFFFFFF00u) | 205u);
      G[3] = ((okey(v1[3] + v2[3]) & 0xFFFFFF00u) | 204u);
      G[4] = 0u;
      G[5] = 0u;
      G[6] = 0u;
      G[7] = 0u;
      G[8] = 0u;
      G[9] = 0u;
      G[10] = 0u;
      G[11] = 0u;
      G[12] = 0u;
      G[13] = 0u;
      G[14] = 0u;
      G[15] = 0u;
      merge_top16(C, G);
    }
    {
      unsigned G[16];
      G[0] = ((okey(v1[4] + v2[0]) & 0xFFFFFF00u) | 191u);
      G[1] = ((okey(v1[5] + v2[0]) & 0xFFFFFF00u) | 175u);
      G[2] = ((okey(v1[6] + v2[0]) & 0xFFFFFF00u) | 159u);
      G[3] = ((okey(v1[7] + v2[0]) & 0xFFFFFF00u) | 143u);
      G[4] = ((okey(v1[8] + v2[0]) & 0xFFFFFF00u) | 127u);
      G[5] = ((okey(v1[9] + v2[0]) & 0xFFFFFF00u) | 111u);
      G[6] = ((okey(v1[10] + v2[0]) & 0xFFFFFF00u) | 95u);
      G[7] = ((okey(v1[11] + v2[0]) & 0xFFFFFF00u) | 79u);
      G[8] = ((okey(v1[12] + v2[0]) & 0xFFFFFF00u) | 63u);
      G[9] = ((okey(v1[13] + v2[0]) & 0xFFFFFF00u) | 47u);
      G[10] = ((okey(v1[14] + v2[0]) & 0xFFFFFF00u) | 31u);
      G[11] = ((okey(v1[15] + v2[0]) & 0xFFFFFF00u) | 15u);
      G[12] = 0u;
      G[13] = 0u;
      G[14] = 0u;
      G[15] = 0u;
      merge_top16(C, G);
    }
    {
      unsigned G[16];
      G[0] = ((okey(v1[4] + v2[1]) & 0xFFFFFF00u) | 190u);
      G[1] = ((okey(v1[5] + v2[1]) & 0xFFFFFF00u) | 174u);
      G[2] = ((okey(v1[6] + v2[1]) & 0xFFFFFF00u) | 158u);
      G[3] = ((okey(v1[7] + v2[1]) & 0xFFFFFF00u) | 142u);
      G[4] = 0u;
      G[5] = 0u;
      G[6] = 0u;
      G[7] = 0u;
      G[8] = 0u;
      G[9] = 0u;
      G[10] = 0u;
      G[11] = 0u;
      G[12] = 0u;
      G[13] = 0u;
      G[14] = 0u;
      G[15] = 0u;
      merge_top16(C, G);
    }
    {
      unsigned G[16];
      G[0] = ((okey(v1[4] + v2[2]) & 0xFFFFFF00u) | 189u);
      G[1] = 0u;
      G[2] = 0u;
      G[3] = 0u;
      G[4] = 0u;
      G[5] = 0u;
      G[6] = 0u;
      G[7] = 0u;
      G[8] = 0u;
      G[9] = 0u;
      G[10] = 0u;
      G[11] = 0u;
      G[12] = 0u;
      G[13] = 0u;
      G[14] = 0u;
      G[15] = 0u;
      merge_top16(C, G);
    }
    unsigned ib1[4], ib2[4];
#pragma unroll
    for (int q = 0; q < 4; ++q) {
      ib1[q] = (L[4 * q] & 0xFFu) | ((L[4 * q + 1] & 0xFFu) << 8) | ((L[4 * q + 2] & 0xFFu) << 16) | ((L[4 * q + 3] & 0xFFu) << 24);
      ib2[q] = (M[4 * q] & 0xFFu) | ((M[4 * q + 1] & 0xFFu) << 8) | ((M[4 * q + 2] & 0xFFu) << 16) | ((M[4 * q + 3] & 0xFFu) << 24);
    }
    int ev[16];
    float gv[16];
    const float mx = __uint_as_float(inv_okey(C[0] & 0xFFFFFF00u));
    float den = 0.f;
#pragma unroll
    for (int k = 0; k < 16; ++k) {
      const int ci = 255 - (int)(C[k] & 0xFFu);
      ev[k] = (127 - (int)byte16(ib1, ci >> 4)) * 128 + (127 - (int)byte16(ib2, ci & 15));
      gv[k] = __expf(__uint_as_float(inv_okey(C[k] & 0xFFFFFF00u)) - mx);
      den += gv[k];
    }
    const float inv = 1.f / den;
    if ((lane & 1) == 0) {
      int* ep = elist + (size_t)tok * 128 + (hh >> 1) * 16;
      float* gp = glist + (size_t)tok * 128 + (hh >> 1) * 16;
#pragma unroll
      for (int k = 0; k < 4; ++k) {
        *(int4*)(ep + 4 * k) = make_int4(ev[4 * k], ev[4 * k + 1], ev[4 * k + 2], ev[4 * k + 3]);
        *(float4*)(gp + 4 * k) = make_float4(gv[4 * k] * inv, gv[4 * k + 1] * inv, gv[4 * k + 2] * inv, gv[4 * k + 3] * inv);
      }
    }
  }
}
using f32x2 = __attribute__((ext_vector_type(2))) float;
DI f32x2 cvt8(unsigned w, bool hi) {
  return hi ? __builtin_amdgcn_cvt_pk_f32_fp8((int)w, true) : __builtin_amdgcn_cvt_pk_f32_fp8((int)w, false);
}
struct SMeta { int e[16]; u32x4 ha, hb; };
template <int MODE>
DI void sl_meta(const Params& p, int t, int s, int grp, int ch, SMeta& m) {
  const int ts = __builtin_amdgcn_readfirstlane(t);
  const int* elist = (const int*)(p.ws + (MODE == 0 ? OFF_ELIST : OFF_GLIST)) + (size_t)ts * 128;
#pragma unroll
  for (int i = 0; i < 16; ++i) m.e[i] = elist[(unsigned)(i * 8 + grp)];
  if (MODE == 0) {
    const bf16_t* hq = (const bf16_t*)(p.ws + OFF_H2) + (size_t)ts * DM + s * 128;
    m.ha = *(const u32x4*)(hq + (unsigned)(ch * 16));
    m.hb = *(const u32x4*)(hq + (unsigned)(ch * 16 + 8));
  }
}
template <int MODE>
DI void sl_rows(const Params& p, int s, int ch, const SMeta& m, u32x4 (&r)[16]) {
  const unsigned char* tab = (const unsigned char*)(p.ws + (MODE == 0 ? OFF_TABU : OFF_TABV)) + (size_t)s * (16384 * 128);
#pragma unroll
  for (int i = 0; i < 16; ++i) r[i] = *(const u32x4*)(tab + ((unsigned)(m.e[i] & 0xFFFF) * 128u + (unsigned)(ch * 16)));
}
template <int MODE>
DI void sl_compute(const Params& p, int t, int s, int lane, const SMeta& m, const u32x4 (&r)[16]) {
  const int grp = lane >> 3, ch = lane & 7;
  if (MODE == 0) {
    f32x2 hp[8];
#pragma unroll
    for (int i = 0; i < 4; ++i) {
      hp[i] = f32x2{bflo(m.ha[i]), bfhi(m.ha[i])};
      hp[4 + i] = f32x2{bflo(m.hb[i]), bfhi(m.hb[i])};
    }
    float v[16];
#pragma unroll
    for (int i = 0; i < 16; ++i) {
      f32x2 d2 = f32x2{0.f, 0.f};
#pragma unroll
      for (int j = 0; j < 4; ++j) {
        d2 += cvt8(r[i][j], false) * hp[2 * j];
        d2 += cvt8(r[i][j], true) * hp[2 * j + 1];
      }
      v[i] = d2[0] + d2[1];
    }
    float q8[8], q4[4], q2[2];
    {
      const bool hi = lane & 4;
#pragma unroll
      for (int i = 0; i < 8; ++i) {
        float send = hi ? v[i] : v[8 + i], keep = hi ? v[8 + i] : v[i];
        q8[i] = keep + __shfl_xor(send, 4);
      }
    }
    {
      const bool hi = lane & 2;
#pragma unroll
      for (int i = 0; i < 4; ++i) {
        float send = hi ? q8[i] : q8[4 + i], keep = hi ? q8[4 + i] : q8[i];
        q4[i] = keep + __shfl_xor(send, 2);
      }
    }
    {
      const bool hi = lane & 1;
#pragma unroll
      for (int i = 0; i < 2; ++i) {
        float send = hi ? q4[i] : q4[2 + i], keep = hi ? q4[2 + i] : q4[i];
        q2[i] = keep + __shfl_xor(send, 1);
      }
    }
    float* po = (float*)(p.ws + OFF_PD) + (size_t)t * 1024 + s * 128;
    po[(2 * ch) * 8 + grp] = q2[0];
    po[(2 * ch + 1) * 8 + grp] = q2[1];
  } else {
    f32x2 acc[8];
#pragma unroll
    for (int q = 0; q < 8; ++q) acc[q] = f32x2{0.f, 0.f};
#pragma unroll
    for (int i = 0; i < 16; ++i) {
      const float wsc = __uint_as_float((unsigned)m.e[i] & 0xFFFF0000u);
      const f32x2 w2 = f32x2{wsc, wsc};
#pragma unroll
      for (int j = 0; j < 4; ++j) {
        acc[2 * j] += w2 * cvt8(r[i][j], false);
        acc[2 * j + 1] += w2 * cvt8(r[i][j], true);
      }
    }
    float v[16];
#pragma unroll
    for (int q = 0; q < 8; ++q) { v[2 * q] = acc[q][0]; v[2 * q + 1] = acc[q][1]; }
    float q8[8], q4[4], q2[2];
    {
      const bool hi = lane & 32;
#pragma unroll
      for (int i = 0; i < 8; ++i) {
        float send = hi ? v[i] : v[8 + i], keep = hi ? v[8 + i] : v[i];
        q8[i] = keep + __shfl_xor(send, 32);
      }
    }
    {
      const bool hi = lane & 16;
#pragma unroll
      for (int i = 0; i < 4; ++i) {
        float send = hi ? q8[i] : q8[4 + i], keep = hi ? q8[4 + i] : q8[i];
        q4[i] = keep + __shfl_xor(send, 16);
      }
    }
    {
      const bool hi = lane & 8;
#pragma unroll
      for (int i = 0; i < 2; ++i) {
        float send = hi ? q4[i] : q4[2 + i], keep = hi ? q4[2 + i] : q4[i];
        q2[i] = keep + __shfl_xor(send, 8);
      }
    }
    const int f = s * 128 + ch * 16 + 2 * grp;
    float* xr = p.out + (size_t)t * DM + f;
    const float2 xv = *(const float2*)xr;
    const float2 gv = *(const float2*)((const float*)(p.ws + OFF_MOD) + modidx(t) * 6144 + 5120 + f);
    *(float2*)xr = make_float2(xv.x + gv.x * q2[0], xv.y + gv.y * q2[1]);
  }
}
template <int MODE>
DI void sliced_pass(const Params& p) {
  const int s = blockIdx.x & 7, loc = blockIdx.x >> 3, nloc = gridDim.x >> 3;
  if (loc >= nloc) return;
  const int lane = threadIdx.x & 63, w = threadIdx.x >> 6, grp = lane >> 3, ch = lane & 7;
  const int stride = nloc * 4;
  SMeta mA, mB;
  u32x4 rA[16], rB[16];
  int t = loc * 4 + w;
  if (t < NTOK) {
    sl_meta<MODE>(p, t, s, grp, ch, mA);
    sl_rows<MODE>(p, s, ch, mA, rA);
  }
  if (t + stride < NTOK) sl_meta<MODE>(p, t + stride, s, grp, ch, mB);
#pragma unroll 1
  for (; t < NTOK; t += 2 * stride) {
    const int t1 = t + stride, t2 = t + 2 * stride, t3 = t + 3 * stride;
    if (t1 < NTOK) sl_rows<MODE>(p, s, ch, mB, rB);
    sl_compute<MODE>(p, t, s, lane, mA, rA);
    if (t2 < NTOK) sl_meta<MODE>(p, t2, s, grp, ch, mA);
    if (t1 < NTOK) {
      if (t2 < NTOK) sl_rows<MODE>(p, s, ch, mA, rA);
      sl_compute<MODE>(p, t1, s, lane, mB, rB);
      if (t3 < NTOK) sl_meta<MODE>(p, t3, s, grp, ch, mB);
    }
  }
}
DI void phase13(const Params& p) { sliced_pass<0>(p); }
DI void phase14(const Params& p) {
  char* ws = p.ws;
  const float* invU = (const float*)(ws + OFF_INVU);
  const float* invV = (const float*)(ws + OFF_INVV);
  const int* elist = (const int*)(ws + OFF_ELIST);
  float* glist = (float*)(ws + OFF_GLIST);
  const float* pd = (const float*)(ws + OFF_PD);
  const int lane = threadIdx.x & 63, w = threadIdx.x >> 6;
  for (int t = blockIdx.x * 4 + w; t < NTOK; t += gridDim.x * 4) {
#pragma unroll
    for (int hf_ = 0; hf_ < 2; ++hf_) {
      const int k = hf_ * 64 + lane;
      float d = 0.f;
#pragma unroll
      for (int s = 0; s < 8; ++s) d += pd[(size_t)t * 1024 + s * 128 + k];
      const int e = elist[(size_t)t * 128 + k];
      const float g = glist[(size_t)t * 128 + k];
      ((unsigned*)glist)[(size_t)t * 128 + k] = (pack2(0.f, g * geluf_(d * invU[e]) * invV[e]) & 0xFFFF0000u) | (unsigned)e;
    }
  }
}
DI void phase15(const Params& p) { sliced_pass<1>(p); }
DI void phase16(const Params& p) {
  const int lane = threadIdx.x & 63, w = threadIdx.x >> 6;
  for (int tok = blockIdx.x * 4 + w; tok < NTOK; tok += gridDim.x * 4) {
    float* xr = p.out + (size_t)tok * DM;
    float4 xv[4];
    float ss = 0.f;
#pragma unroll
    for (int i = 0; i < 4; ++i) {
      xv[i] = *(const float4*)(xr + (i * 64 + lane) * 4);
      ss += xv[i].x * xv[i].x + xv[i].y * xv[i].y + xv[i].z * xv[i].z + xv[i].w * xv[i].w;
    }
    ss = wsum(ss);
    const float rstd = rsqrtf(ss * (1.f / 1024.f) + 1e-6f);
#pragma unroll
    for (int i = 0; i < 4; ++i) {
      const int e = (i * 64 + lane) * 4;
      float4 nf = *(const float4*)(p.norm_final + e);
      *(float4*)(xr + e) = make_float4(xv[i].x * rstd * nf.x, xv[i].y * rstd * nf.y, xv[i].z * rstd * nf.z, xv[i].w * rstd * nf.w);
    }
  }
}

#define XB_TMO      128
#define XB_XCNT(j)  (256  + 64 * (j))
#define XB_XSUB(j)  (1280 + 64 * (j))
#define XB_XGEN(j)  (2304 + 64 * (j))
#define XB_TOP      3328
#define XB_TOPGEN   3392
#define XCD_BAR_WORDS 3456
#define XB_SPIN_CAP (1u << 22)
#define LAS __attribute__((address_space(3)))
DI unsigned xb_ld(unsigned* p) { return __hip_atomic_load(p, __ATOMIC_RELAXED, __HIP_MEMORY_SCOPE_AGENT); }
DI unsigned xb_add(unsigned* p, unsigned v) { return __hip_atomic_fetch_add(p, v, __ATOMIC_RELAXED, __HIP_MEMORY_SCOPE_AGENT); }
DI unsigned xb_xcc_id() { return (unsigned)__builtin_amdgcn_s_getreg((3 << 11) | 20) & 0xFu; }
#define XB_SPIN(cond, bar) do { unsigned _sp = 0; while (cond) { __builtin_amdgcn_s_sleep(1); \
    if ((++_sp & 255u) == 0u) { if (xb_ld(&(bar)[XB_TMO])) break; if (_sp > XB_SPIN_CAP) { atomicAdd(&(bar)[XB_TMO], 1u); break; } } } } while (0)
struct XcdBarrier { unsigned* bar; unsigned x; volatile LAS unsigned* st; };
DI XcdBarrier xcd_barrier_post(unsigned* bar, volatile LAS unsigned* st) {
  XcdBarrier b; b.bar = bar; b.x = xb_xcc_id(); b.st = st;
  if (threadIdx.x == 0) (void)xb_add(&bar[XB_XCNT(b.x)], 1u);
  return b;
}
DI void xcd_barrier_complete(unsigned* bar, unsigned x, unsigned& nloc, unsigned& nx) {
  const unsigned G = gridDim.x * gridDim.y * gridDim.z;
  unsigned sum, cnt, mine, sp = 0u;
  for (;;) {
    sum = 0u; cnt = 0u; mine = 0u;
#pragma unroll
    for (unsigned j = 0; j < 16; ++j) { const unsigned c = xb_ld(&bar[XB_XCNT(j)]); sum += c; cnt += (c > 0u) ? 1u : 0u; mine = (j == x) ? c : mine; }
    if (sum == G) break;
    __builtin_amdgcn_s_sleep(1);
    if ((++sp & 255u) == 0u) { if (xb_ld(&bar[XB_TMO])) break; if (sp > XB_SPIN_CAP) { atomicAdd(&bar[XB_TMO], 1u); break; } }
  }
  nloc = mine > 0u ? mine : 1u; nx = cnt > 0u ? cnt : 1u;
}
DI void xcd_barrier(const XcdBarrier& b) {
  asm volatile("s_waitcnt vmcnt(0)" ::: "memory");
  __syncthreads();
  if (threadIdx.x == 0) {
    unsigned* bar = b.bar;
    __builtin_amdgcn_s_waitcnt(0);
    unsigned nloc = b.st[0], nx = b.st[1];
    if (nloc == 0u) { xcd_barrier_complete(bar, b.x, nloc, nx); b.st[0] = nloc; b.st[1] = nx; }
    const unsigned old = xb_add(&bar[XB_XSUB(b.x)], 1u);
    const unsigned gen = old / nloc;
    if (old + 1u == (gen + 1u) * nloc) {
      __builtin_amdgcn_fence(__ATOMIC_RELEASE, "agent");
      asm volatile("s_waitcnt vmcnt(0)" ::: "memory");
      const unsigned og = xb_add(&bar[XB_TOP], 1u);
      const unsigned tg = og / nx;
      if (og + 1u == (tg + 1u) * nx) xb_add(&bar[XB_TOPGEN], 1u);
      else XB_SPIN(xb_ld(&bar[XB_TOPGEN]) == tg, bar);
      __builtin_amdgcn_fence(__ATOMIC_ACQUIRE, "agent");
      xb_add(&bar[XB_XGEN(b.x)], 1u);
      asm volatile("s_waitcnt vmcnt(0)" ::: "memory");
    } else {
      XB_SPIN(xb_ld(&bar[XB_XGEN(b.x)]) == gen, bar);
      __builtin_amdgcn_fence(__ATOMIC_ACQUIRE, "agent");
      asm volatile("s_waitcnt vmcnt(0)" ::: "memory");
    }
  }
  __syncthreads();
}

#ifdef ONLY_PHASE
#define RUNPH(n, call) if (ONLY_PHASE == n) { call; }
#else
#ifndef DUP_PHASE
#define DUP_PHASE -1
#endif
#define RUNPH(n, call) if (lo <= n && n < hi) { call; if (n == DUP_PHASE) { xcd_barrier(xb); call; } if (n + 1 < hi) xcd_barrier(xb); }
#endif
__global__ void __launch_bounds__(256, 2) mega(Params p, int lo, int hi) {
  __shared__ __attribute__((aligned(16))) char smem[SMEM_BYTES];
  __shared__ uint4 xb_words;
  cg::grid_group grid = cg::this_grid();
  if (lo < 0) grid.sync();
  if (threadIdx.x == 0) xb_words = make_uint4(0u, 0u, 0u, 0u);
  __syncthreads();
  XcdBarrier xb = xcd_barrier_post((unsigned*)(p.ws + OFF_BAR), (volatile LAS unsigned*)&xb_words);
  RUNPH(0, phase0(p, smem))
  RUNPH(1, phase1(p, smem))
  RUNPH(2, phase2(p, smem))
  RUNPH(3, phase3(p, smem))
  RUNPH(4, phase4(p))
  RUNPH(5, phase5(p, smem))
  RUNPH(6, phase6(p, smem))
  RUNPH(7, phase7(p, smem))
  RUNPH(8, phase8(p, smem))
  RUNPH(9, phase9(p, smem))
  RUNPH(10, phase10(p, smem))
  RUNPH(11, phase11(p, smem))
  RUNPH(12, phase12(p, smem))
  RUNPH(13, phase13(p))
  RUNPH(14, phase14(p))
  RUNPH(15, phase15(p))
  RUNPH(16, phase16(p))
}

extern "C" void kernel_launch(void* const* d_in, const int* in_sizes, int n_in, void* d_out, int out_size, void* d_ws,
                              size_t ws_size, hipStream_t stream) {
  static int grid_blocks = 0;
  if (!grid_blocks) {
    int dev = 0, cus = 0, per_cu = 0;
    hipGetDevice(&dev);
    hipDeviceGetAttribute(&cus, hipDeviceAttributeMultiprocessorCount, dev);
    hipOccupancyMaxActiveBlocksPerMultiprocessor(&per_cu, mega, 256, 0);
    if (per_cu > 2) per_cu = 2;
    if (per_cu < 1) per_cu = 1;
    grid_blocks = cus * per_cu;
  }
  Params p{};
  const float** pp = (const float**)&p;
  for (int i = 0; i < 29; ++i) pp[i] = (const float*)d_in[i];
  p.out = (float*)d_out;
  p.ws = (char*)d_ws;
#if N_LAUNCH_SPLIT
  for (int ph = 0; ph < NPHASE; ++ph) {
    hipLaunchKernelGGL(mega, dim3(grid_blocks), dim3(256), 0, stream, p, ph, ph + 1);
  }
#else
  hipMemsetAsync((char*)d_ws + OFF_MOD, 0, (OFF_BAR - OFF_MOD) + XCD_BAR_WORDS * sizeof(unsigned), stream);
  int lo = 0, hi = NPHASE;
  void* args[] = {&p, &lo, &hi};
  hipError_t e = hipLaunchCooperativeKernel((void*)mega, dim3(grid_blocks), dim3(256), args, 0, stream);
  if (e != hipSuccess) fprintf(stderr, "cooperative launch failed: %s (grid %d)\n", hipGetErrorString(e), grid_blocks);
#endif
}
```

```cpp
#include <hip/hip_runtime.h>
#include <hip/hip_cooperative_groups.h>
#include <cstdio>
namespace cg = cooperative_groups;

#define DI __device__ __forceinline__
typedef unsigned short bf16_t;
using bf16x8 = __attribute__((ext_vector_type(8))) short;
using f32x4 = __attribute__((ext_vector_type(4))) float;
using u32x4 = __attribute__((ext_vector_type(4))) unsigned;
using u32x2 = __attribute__((ext_vector_type(2))) unsigned;

#ifndef N_LAUNCH_SPLIT
#define N_LAUNCH_SPLIT 0
#endif

constexpr int NTOK = 20480, NPT = 4096, DM = 1024;
constexpr int NPHASE = 17;
constexpr size_t MiB = 1u << 20;
constexpr size_t OFF_WINT = 0, OFF_WUQT = 9 * MiB, OFF_WUKVT = 9 * MiB + 512 * 1024, OFF_WUPAT = 10 * MiB,
                 OFF_WUPBT = 11 * MiB, OFF_WOT = 12 * MiB, OFF_WCT = 14 * MiB, OFF_WPQB = 18 * MiB,
                 OFF_KEYSB = 22 * MiB, OFF_MOD = 22 * MiB + 512 * 1024, OFF_BAR = 22 * MiB + 768 * 1024, OFF_ROPE = 23 * MiB, A0 = 24 * MiB;
constexpr size_t OFF_PD = A0 + 104 * MiB, OFF_H1 = A0 + 0, OFF_CQ = A0 + 40 * MiB, OFF_CKVRAW = A0 + 50 * MiB, OFF_KRRAW = A0 + 60 * MiB,
                 OFF_RQ = A0 + 63 * MiB, OFF_RK = A0 + 83 * MiB, OFF_KT = A0 + 103 * MiB, OFF_VT = A0 + 123 * MiB,
                 OFF_SRG = A0 + 143 * MiB, OFF_CKVALL = A0 + 163 * MiB, OFF_KRALL = A0 + 169 * MiB,
                 OFF_UF = A0 + 171 * MiB, OFF_UB = A0 + 187 * MiB,
                 OFF_SF = A0 + 0, OFF_SB = A0 + 8 * MiB, OFF_RET = A0 + 16 * MiB,
                 OFF_Q = A0 + 63 * MiB, OFF_KN = A0 + 93 * MiB, OFF_VTA = A0 + 117 * MiB, OFF_ATTN = A0 + 141 * MiB,
                 OFF_M = A0 + 163 * MiB,
                 OFF_H2 = A0 + 56 * MiB, OFF_TABU = A0 + 36 * MiB, OFF_TABV = A0 + 0, OFF_INVU = A0 + 52 * MiB,
                 OFF_INVV = A0 + 53 * MiB, OFF_ELIST = A0 + 16 * MiB, OFF_GLIST = A0 + 26 * MiB, OFF_SCORES = A0 + 104 * MiB;
constexpr size_t OUT_CKV = 20971520, OUT_KR = 21495808, OUT_SF = 21626880, OUT_SB = 22675456;
constexpr int NKV = 24576;
constexpr int SMEM_BYTES = 73728;

struct Params {
  const float *x_prompt, *x_sample, *c, *cache_ckv, *cache_krope, *st_f, *st_b, *c_ctx, *w_mod, *b_mod, *norm_mix,
      *norm_ffn, *norm_final, *w_in, *q_norm, *kv_norm, *w_uq, *w_ukv, *lg_f, *lg_b, *ret_gn, *w_up_a, *w_up_b, *w_o,
      *peer_wq, *keys1, *keys2, *peer_u, *peer_v;
  float* out;
  char* ws;
};

DI unsigned f2bf(float x) {
  unsigned u = __float_as_uint(x);
  u += 0x7fffu + ((u >> 16) & 1u);
  return u >> 16;
}
DI float bf2f(unsigned b) { return __uint_as_float(b << 16); }
typedef __bf16 hbf16x2_t __attribute__((ext_vector_type(2)));
typedef float hf32x2_t __attribute__((ext_vector_type(2)));
DI unsigned pack2(float a, float b) {
  hf32x2_t f = {a, b};
  return __builtin_bit_cast(unsigned, __builtin_convertvector(f, hbf16x2_t));
}
DI float ex2(float x) { return __builtin_amdgcn_exp2f(x); }
DI float bflo(unsigned u) { return __uint_as_float(u << 16); }
DI float bfhi(unsigned u) { return __uint_as_float(u & 0xffff0000u); }
DI float wsum(float v) {
#pragma unroll
  for (int o = 32; o > 0; o >>= 1) v += __shfl_xor(v, o);
  return v;
}
DI float sigmoidf_(float x) { return __builtin_amdgcn_rcpf(1.f + __builtin_amdgcn_exp2f(-1.4426950408889634f * x)); }
DI float siluf_(float x) { return x * __builtin_amdgcn_rcpf(1.f + __builtin_amdgcn_exp2f(-1.4426950408889634f * x)); }
DI float geluf_(float x) { return 0.5f * x * (1.f + tanhf(0.7978845608028654f * (x + 0.044715f * x * x * x))); }
DI const float* xrow(const Params& p, int tok) {
  return tok < NPT ? p.x_prompt + (size_t)tok * DM : p.x_sample + (size_t)(tok - NPT) * DM;
}
DI int modidx(int tok) { return tok < NPT ? 0 : 1 + ((tok - NPT) >> 11); }
DI int kvrow(int tok) {
  if (tok < NPT) return tok;
  int t = tok - NPT;
  return NPT + (t >> 11) * 2560 + (t & 2047);
}
DI void st_bf16x16(bf16_t* dst, const float (&v)[16]) {
  u32x4 a, b;
  a[0] = pack2(v[0], v[1]); a[1] = pack2(v[2], v[3]); a[2] = pack2(v[4], v[5]); a[3] = pack2(v[6], v[7]);
  b[0] = pack2(v[8], v[9]); b[1] = pack2(v[10], v[11]); b[2] = pack2(v[12], v[13]); b[3] = pack2(v[14], v[15]);
  *(u32x4*)dst = a;
  *(u32x4*)(dst + 8) = b;
}
DI void st_f32x16(float* dst, const float (&v)[16]) {
#pragma unroll
  for (int i = 0; i < 4; ++i) *(float4*)(dst + 4 * i) = make_float4(v[4 * i], v[4 * i + 1], v[4 * i + 2], v[4 * i + 3]);
}
DI void ld_bf16x16(const bf16_t* src, float (&v)[16]) {
  u32x4 a = *(const u32x4*)src, b = *(const u32x4*)(src + 8);
#pragma unroll
  for (int i = 0; i < 4; ++i) {
    v[2 * i] = bflo(a[i]); v[2 * i + 1] = bfhi(a[i]);
    v[8 + 2 * i] = bflo(b[i]); v[8 + 2 * i + 1] = bfhi(b[i]);
  }
}

constexpr int LDK = 64;
DI void gemm_issue0(const bf16_t* __restrict__ A, int lda, const bf16_t* __restrict__ B, int ldb, u32x4 (&ra)[4], u32x4 (&rb)[4]) {
  const int tid = threadIdx.x;
#pragma unroll
  for (int i = 0; i < 4; ++i) {
    const int c = tid + 256 * i;
    const int r = c >> 3, k8 = (c & 7) * 8;
    ra[i] = *(const u32x4*)(A + (size_t)r * lda + k8);
    rb[i] = *(const u32x4*)(B + (size_t)r * ldb + k8);
  }
}
template <int SCALE>
DI void gemm_kloop_pre(f32x4 (&acc)[4][4], const bf16_t* __restrict__ A, int lda, const bf16_t* __restrict__ B, int ldb,
                       int K, char* smem, float sc_a, float sc_b, u32x4 (&ra)[4], u32x4 (&rb)[4]) {
  bf16_t* As = (bf16_t*)smem;
  bf16_t* Bs = As + 128 * LDK;
  const int tid = threadIdx.x, lane = tid & 63, w = tid >> 6, wm = w >> 1, wn = w & 1, l15 = lane & 15, g = lane >> 4;
  int arow[4], kc[4], ldsa[4], ldsb[4];
#pragma unroll
  for (int i = 0; i < 4; ++i) {
    int c = tid + 256 * i;
    int r = c >> 3;
    kc[i] = (c & 7) * 8;
    arow[i] = r;
    int rr = r & 63;
    int rho = (r & 64) | (((rr >> 2) & 3) << 4) | ((rr >> 4) << 2) | (rr & 3);
    ldsa[i] = rho * LDK + (((c & 7) ^ ((rho >> 1) & 7)) * 8);
    ldsb[i] = r * LDK + (((c & 7) ^ ((r >> 1) & 7)) * 8);
  }
  __syncthreads();
#pragma unroll
  for (int i = 0; i < 4; ++i) {
    *(u32x4*)(As + ldsa[i]) = ra[i];
    *(u32x4*)(Bs + ldsb[i]) = rb[i];
  }
  if (64 < K) {
#pragma unroll
    for (int i = 0; i < 4; ++i) {
      ra[i] = *(const u32x4*)(A + (size_t)arow[i] * lda + 64 + kc[i]);
      rb[i] = *(const u32x4*)(B + (size_t)arow[i] * ldb + 64 + kc[i]);
    }
  }
  __syncthreads();
  int buf = 0;
  for (int k0 = 0; k0 < K; k0 += 64, buf ^= 1) {
    const bf16_t* Ac = As + buf * (256 * LDK);
    const bf16_t* Bc = Bs + buf * (256 * LDK);
#pragma unroll
    for (int ks = 0; ks < 2; ++ks) {
      bf16x8 af[4], bfr[4];
#pragma unroll
      for (int f = 0; f < 4; ++f)
        af[f] = *(const bf16x8*)(Ac + (wm * 64 + f * 16 + l15) * LDK + (((ks * 4 + g) ^ (l15 >> 1)) * 8));
#pragma unroll
      for (int c = 0; c < 4; ++c)
        bfr[c] = *(const bf16x8*)(Bc + (wn * 64 + c * 16 + l15) * LDK + (((ks * 4 + g) ^ (l15 >> 1)) * 8));
      if (SCALE) {
        float fac[8];
#pragma unroll
        for (int i = 0; i < 8; ++i) fac[i] = ex2(sc_a + sc_b * (float)(k0 + ks * 32 + g * 8 + i));
#pragma unroll
        for (int f = 0; f < 4; ++f) {
          u32x4 u = __builtin_bit_cast(u32x4, af[f]);
#pragma unroll
          for (int i = 0; i < 4; ++i) u[i] = pack2(bflo(u[i]) * fac[2 * i], bfhi(u[i]) * fac[2 * i + 1]);
          af[f] = __builtin_bit_cast(bf16x8, u);
        }
      }
#pragma unroll
      for (int f = 0; f < 4; ++f)
#pragma unroll
        for (int c = 0; c < 4; ++c) acc[f][c] = __builtin_amdgcn_mfma_f32_16x16x32_bf16(af[f], bfr[c], acc[f][c], 0, 0, 0);
    }
    if (k0 + 64 < K) {
      bf16_t* An = As + (buf ^ 1) * (256 * LDK);
      bf16_t* Bn = Bs + (buf ^ 1) * (256 * LDK);
#pragma unroll
      for (int i = 0; i < 4; ++i) {
        *(u32x4*)(An + ldsa[i]) = ra[i];
        *(u32x4*)(Bn + ldsb[i]) = rb[i];
      }
      if (k0 + 128 < K) {
#pragma unroll
        for (int i = 0; i < 4; ++i) {
          ra[i] = *(const u32x4*)(A + (size_t)arow[i] * lda + k0 + 128 + kc[i]);
          rb[i] = *(const u32x4*)(B + (size_t)arow[i] * ldb + k0 + 128 + kc[i]);
        }
      }
      __syncthreads();
    }
  }
}
template <int SCALE>
DI void gemm_kloop(f32x4 (&acc)[4][4], const bf16_t* __restrict__ A, int lda, const bf16_t* __restrict__ B, int ldb,
                   int K, char* smem, float sc_a, float sc_b) {
  u32x4 ra[4], rb[4];
  gemm_issue0(A, lda, B, ldb, ra, rb);
  gemm_kloop_pre<SCALE>(acc, A, lda, B, ldb, K, smem, sc_a, sc_b, ra, rb);
}
DI void acc_zero(f32x4 (&acc)[4][4]) {
#pragma unroll
  for (int f = 0; f < 4; ++f)
#pragma unroll
    for (int c = 0; c < 4; ++c) acc[f][c] = f32x4{0.f, 0.f, 0.f, 0.f};
}
template <class F>
DI void epilogue(const f32x4 (&acc)[4][4], F&& epi) {
  const int tid = threadIdx.x, lane = tid & 63, w = tid >> 6, wm = w >> 1, wn = w & 1, l15 = lane & 15, g = lane >> 4;
#pragma unroll
  for (int c = 0; c < 4; ++c) {
    float v[16];
#pragma unroll
    for (int f = 0; f < 4; ++f)
#pragma unroll
      for (int j = 0; j < 4; ++j) v[f * 4 + j] = acc[f][c][j];
    epi(wm * 64 + 16 * g, wn * 64 + c * 16 + l15, v);
  }
}
DI bool tile_map(int it, int Ft, int Tt, int fsplit, int& ft, int& tt) {
  const int bid = blockIdx.x, nb = gridDim.x;
  int xcd = bid & 7, loc = bid >> 3, nloc = nb >> 3;
  if (loc >= nloc) return false;
  int fg = xcd % fsplit, tg = xcd / fsplit, tsplit = 8 / fsplit;
  int Fg = Ft / fsplit, Tg = Tt / tsplit;
  int i = loc + it * nloc;
  if (i >= Fg * Tg) return false;
  ft = fg * Fg + i % Fg;
  tt = tg * Tg + i / Fg;
  return true;
}
DI int vbid() {
  const int bid = blockIdx.x, nb = gridDim.x;
  if (nb & 7) return bid;
  return (bid & 7) * (nb >> 3) + (bid >> 3);
}

DI int colmap(int mode, int np) {
  if (mode == 1) return np < 416 ? np : (np < 512 ? -1 : np - 96);
  if (mode == 2) return np < 512 ? ((np >> 6) * 128 + (np & 63)) : (((np - 512) >> 6) * 128 + 64 + ((np - 512) & 63));
  return np;
}
DI void tconv_tile(const float* __restrict__ src, int ldsrc, bf16_t* __restrict__ dst, int K, int kt, int nt, int mode,
                   char* smem) {
  float* lds = (float*)smem;
  int tid = threadIdx.x;
  asm volatile("" : "+v"(tid));
  {
    int col = tid & 63, rq = tid >> 6;
    int n = colmap(mode, nt * 64 + col);
#pragma unroll 4
    for (int r = 0; r < 16; ++r) {
      int kl = r * 4 + rq;
      float v = n >= 0 ? src[(size_t)(kt * 64 + kl) * ldsrc + n] : 0.f;
      lds[kl * 65 + col] = v;
    }
  }
  __syncthreads();
  {
    int nl = tid >> 2, kq = (tid & 3) * 16;
    float v[16];
#pragma unroll
    for (int i = 0; i < 16; ++i) v[i] = lds[(kq + i) * 65 + nl];
    st_bf16x16(dst + (size_t)(nt * 64 + nl) * K + kt * 64 + kq, v);
  }
  __syncthreads();
}
DI void mod_item(const Params& p, int item, char* smem) {
  float* sil = (float*)smem;
  int tid = threadIdx.x;
  asm volatile("" : "+v"(tid));
  const int cg_ = item >> 2, slab = item & 3, kbase = slab * 256;
  for (int i = tid; i < 9 * 256; i += 256) {
    int j = i >> 8, k = kbase + (i & 255);
    float cv = j == 0 ? p.c_ctx[k] : p.c[(j - 1) * 1024 + k];
    sil[i] = siluf_(cv);
  }
  __syncthreads();
  const int kq = tid >> 6, nn = tid & 63, n0 = cg_ * 64;
  float acc[9];
#pragma unroll
  for (int j = 0; j < 9; ++j) acc[j] = 0.f;
#pragma unroll 1
  for (int i0 = 0; i0 < 64; i0 += 16) {
    float wv[16];
#pragma unroll
    for (int i = 0; i < 16; ++i) wv[i] = p.w_mod[(size_t)(kbase + kq + 4 * (i0 + i)) * 6144 + n0 + nn];
#pragma unroll
    for (int i = 0; i < 16; ++i)
#pragma unroll
      for (int j = 0; j < 9; ++j) acc[j] += sil[j * 256 + kq + 4 * (i0 + i)] * wv[i];
  }
  __syncthreads();
  float* part = (float*)smem + 9 * 256;
#pragma unroll
  for (int j = 0; j < 9; ++j) part[(kq * 9 + j) * 64 + nn] = acc[j];
  __syncthreads();
  float* mod = (float*)(p.ws + OFF_MOD);
  for (int i = tid; i < 9 * 64; i += 256) {
    int j = i >> 6, n = i & 63;
    float s = part[(0 * 9 + j) * 64 + n] + part[(1 * 9 + j) * 64 + n] + part[(2 * 9 + j) * 64 + n] + part[(3 * 9 + j) * 64 + n];
    if (slab == 0) s += p.b_mod[n0 + n];
    atomicAdd(mod + j * 6144 + n0 + n, s);
  }
  __syncthreads();
}
DI void conv_flat(const float* __restrict__ src, bf16_t* __restrict__ dst, size_t n) {
  size_t i = ((size_t)blockIdx.x * 256 + threadIdx.x) * 8;
  const size_t stride = (size_t)gridDim.x * 256 * 8;
  for (; i < n; i += stride) {
    float4 a = *(const float4*)(src + i), b = *(const float4*)(src + i + 4);
    u32x4 o;
    o[0] = pack2(a.x, a.y); o[1] = pack2(a.z, a.w); o[2] = pack2(b.x, b.y); o[3] = pack2(b.z, b.w);
    *(u32x4*)(dst + i) = o;
  }
}
DI void phase0(const Params& p, char* smem) {
  const int bid = blockIdx.x, nb = gridDim.x;
  char* ws = p.ws;
  const int n_mod = 384;
  const int t_in = 16 * 72, t_uq = 4 * 12, t_ukv = 2 * 16, t_upa = 8 * 16, t_upb = 8 * 16, t_o = 16 * 16;
  const int total = n_mod + t_in;
  (void)t_uq; (void)t_ukv; (void)t_upa; (void)t_upb; (void)t_o;
  for (int it = bid; it < total; it += nb) {
    int i = it;
    if (i < n_mod) { mod_item(p, i, smem); continue; }
    i -= n_mod;
    tconv_tile(p.w_in, 4512, (bf16_t*)(ws + OFF_WINT), 1024, i / 72, i % 72, 1, smem);
  }
  conv_flat(p.peer_wq, (bf16_t*)(ws + OFF_WPQB), (size_t)1024 * 2048);
  {
    size_t i = ((size_t)bid * 256 + threadIdx.x) * 8;
    const size_t stride = (size_t)nb * 256 * 8;
    bf16_t* kb = (bf16_t*)(ws + OFF_KEYSB);
    for (; i < (size_t)2 * 131072; i += stride) {
      int half = i >= 131072;
      size_t s = i - (size_t)half * 131072;
      int h = (int)(s >> 14);
      size_t r = s & 16383;
      const float* src = (half ? p.keys2 : p.keys1) + s;
      float4 a = *(const float4*)(src), b = *(const float4*)(src + 4);
      u32x4 o;
      o[0] = pack2(a.x, a.y); o[1] = pack2(a.z, a.w); o[2] = pack2(b.x, b.y); o[3] = pack2(b.z, b.w);
      *(u32x4*)(kb + ((size_t)(h * 2 + half) << 14) + r) = o;
    }
  }
  {
    float2* rope = (float2*)(ws + OFF_ROPE);
    for (int idx = bid * 256 + threadIdx.x; idx < 2048 * 16; idx += nb * 256) {
      const int t = idx >> 4, a = idx & 15;
      const float pos = (a < 8) ? (float)(t >> 6) : (float)(t & 63);
      const float fr = exp2f(-(float)(a & 7) * 1.6609640474436813f);
      float sn, cs;
      sincosf(pos * fr, &sn, &cs);
      rope[idx] = make_float2(cs, sn);
    }
  }
}

DI void rows_norm_mod(const Params& p, const float* nw, int sh_off, int sc_off, bool from_out, bf16_t* dst) {
  const int lane = threadIdx.x & 63, w = threadIdx.x >> 6;
  const float* mod = (const float*)(p.ws + OFF_MOD);
  for (int tok = blockIdx.x * 4 + w; tok < NTOK; tok += gridDim.x * 4) {
    const float* xr = from_out ? p.out + (size_t)tok * DM : xrow(p, tok);
    const float* mj = mod + modidx(tok) * 6144;
    float4 xv[4];
    float ss = 0.f;
#pragma unroll
    for (int i = 0; i < 4; ++i) {
      xv[i] = *(const float4*)(xr + (i * 64 + lane) * 4);
      ss += xv[i].x * xv[i].x + xv[i].y * xv[i].y + xv[i].z * xv[i].z + xv[i].w * xv[i].w;
    }
    ss = wsum(ss);
    float rstd = rsqrtf(ss * (1.f / 1024.f) + 1e-6f);
#pragma unroll
    for (int i = 0; i < 4; ++i) {
      int e = (i * 64 + lane) * 4;
      float4 nv = *(const float4*)(nw + e), sh = *(const float4*)(mj + sh_off + e), sc = *(const float4*)(mj + sc_off + e);
      float h0 = (xv[i].x * rstd) * nv.x * (1.f + sc.x) + sh.x;
      float h1 = (xv[i].y * rstd) * nv.y * (1.f + sc.y) + sh.y;
      float h2 = (xv[i].z * rstd) * nv.z * (1.f + sc.z) + sh.z;
      float h3 = (xv[i].w * rstd) * nv.w * (1.f + sc.w) + sh.w;
      u32x2 o;
      o[0] = pack2(h0, h1); o[1] = pack2(h2, h3);
      *(u32x2*)(dst + (size_t)tok * DM + e) = o;
    }
  }
}
DI void phase1(const Params& p, char* smem) {
  rows_norm_mod(p, p.norm_mix, 0, 1024, false, (bf16_t*)(p.ws + OFF_H1));
}
DI void side_weights(const Params& p, char* smem, int rank, int nwork) {
  char* ws = p.ws;
  const int t_uq = 4 * 12, t_ukv = 2 * 16, t_upa = 8 * 16, t_upb = 8 * 16, t_o = 16 * 16, t_wc = 128;
  const int total = t_uq + t_ukv + t_upa + t_upb + t_o + t_wc;
  const bf16_t* wpq = (const bf16_t*)(ws + OFF_WPQB);
  const bf16_t* kb = (const bf16_t*)(ws + OFF_KEYSB);
  bf16_t* wct = (bf16_t*)(ws + OFF_WCT);
  for (int it = rank; it < total; it += nwork) {
    int i = it;
    if (i < t_wc) {
      int hh = i >> 3, mt = i & 7;
      f32x4 acc[4][4];
      acc_zero(acc);
      gemm_kloop<0>(acc, wpq + (size_t)(mt * 128) * 2048 + hh * 128, 2048, kb + (size_t)hh * 16384, 128, 128, smem, 0.f, 0.f);
      epilogue(acc, [&](int m, int n, float (&v)[16]) { st_bf16x16(wct + (size_t)(hh * 128 + n) * 1024 + mt * 128 + m, v); });
      __syncthreads();
      continue;
    }
    i -= t_wc;
    if (i < t_uq) { tconv_tile(p.w_uq, 768, (bf16_t*)(ws + OFF_WUQT), 256, i / 12, i % 12, 0, smem); continue; }
    i -= t_uq;
    if (i < t_ukv) { tconv_tile(p.w_ukv, 1024, (bf16_t*)(ws + OFF_WUKVT), 128, i / 16, i % 16, 2, smem); continue; }
    i -= t_ukv;
    if (i < t_upa) { tconv_tile(p.w_up_a, 1024, (bf16_t*)(ws + OFF_WUPAT), 512, i / 16, i % 16, 0, smem); continue; }
    i -= t_upa;
    if (i < t_upb) { tconv_tile(p.w_up_b, 1024, (bf16_t*)(ws + OFF_WUPBT), 512, i / 16, i % 16, 0, smem); continue; }
    i -= t_upb;
    tconv_tile(p.w_o, 1024, (bf16_t*)(ws + OFF_WOT), 1024, i / 16, i % 16, 0, smem);
  }
}

DI void phase2(const Params& p, char* smem) {
  char* ws = p.ws;
  const bf16_t* winT = (const bf16_t*)(ws + OFF_WINT);
  const bf16_t* h1 = (const bf16_t*)(ws + OFF_H1);
  bf16_t* cq = (bf16_t*)(ws + OFF_CQ);
  float* ckvraw = (float*)(ws + OFF_CKVRAW);
  float* krraw = (float*)(ws + OFF_KRRAW);
  bf16_t* rq = (bf16_t*)(ws + OFF_RQ);
  bf16_t* rk = (bf16_t*)(ws + OFF_RK);
  bf16_t* kT = (bf16_t*)(ws + OFF_KT);
  bf16_t* vT = (bf16_t*)(ws + OFF_VT);
  bf16_t* srg = (bf16_t*)(ws + OFF_SRG);
  bf16_t* sga = (bf16_t*)p.out;
  bf16_t* sgb = sga + (size_t)NTOK * 1024;
  u32x4 pra[4], prb[4];
  int ft, tt;
  bool have = tile_map(0, 36, 160, 4, ft, tt);
  if (have) {
    const bf16_t* W0 = winT + (size_t)ft * 128 * 1024;
    const bf16_t* H0 = h1 + (size_t)tt * 128 * 1024;
    const bool sw = ft >= 8 && ft < 16;
    gemm_issue0(sw ? H0 : W0, 1024, sw ? W0 : H0, 1024, pra, prb);
  }
  for (int it = 0; have; ++it) {
    f32x4 acc[4][4];
    acc_zero(acc);
    const bf16_t* W = winT + (size_t)ft * 128 * 1024;
    const bf16_t* H = h1 + (size_t)tt * 128 * 1024;
    const int tok0 = tt * 128, f0 = ft * 128;
    const bool swp = ft >= 8 && ft < 16;
    gemm_kloop_pre<0>(acc, swp ? H : W, 1024, swp ? W : H, 1024, 1024, smem, 0.f, 0.f, pra, prb);
    int ft2 = 0, tt2 = 0;
    const bool have2 = tile_map(it + 1, 36, 160, 4, ft2, tt2);
    if (have2) {
      const bf16_t* W2 = winT + (size_t)ft2 * 128 * 1024;
      const bf16_t* H2 = h1 + (size_t)tt2 * 128 * 1024;
      const bool sw2 = ft2 >= 8 && ft2 < 16;
      gemm_issue0(sw2 ? H2 : W2, 1024, sw2 ? W2 : H2, 1024, pra, prb);
    }
    if (ft >= 8 && ft < 16) {
      if (ft < 12) {
        epilogue(acc, [&](int m, int n, float (&v)[16]) {
          int feat = f0 - 1024 + n, tok = tok0 + m;
#pragma unroll
          for (int i = 0; i < 16; ++i) v[i] *= 0.08838834764831845f;
          st_bf16x16(kT + (size_t)feat * NTOK + tok, v);
#pragma unroll
          for (int i = 0; i < 16; ++i) rk[(size_t)(tok + i) * 512 + feat] = (bf16_t)f2bf(v[i]);
        });
      } else {
        epilogue(acc, [&](int m, int n, float (&v)[16]) {
          int feat = f0 - 1536 + n, tok = tok0 + m;
          st_bf16x16(vT + (size_t)feat * NTOK + tok, v);
        });
      }
    } else {
      if (ft < 2) {
        epilogue(acc, [&](int m, int n, float (&v)[16]) { st_bf16x16(cq + (size_t)(tok0 + n) * 256 + f0 + m, v); });
      } else if (ft == 2) {
        epilogue(acc, [&](int m, int n, float (&v)[16]) { st_f32x16(ckvraw + (size_t)(tok0 + n) * 128 + m, v); });
      } else if (ft == 3) {
        epilogue(acc, [&](int m, int n, float (&v)[16]) {
          if (m < 32) st_f32x16(krraw + (size_t)(tok0 + n) * 32 + m, v);
        });
      } else if (ft < 8) {
        epilogue(acc, [&](int m, int n, float (&v)[16]) { st_bf16x16(rq + (size_t)(tok0 + n) * 512 + f0 - 512 + m, v); });
      } else if (ft < 20) {
        epilogue(acc, [&](int m, int n, float (&v)[16]) {
#pragma unroll
          for (int i = 0; i < 16; ++i) v[i] = siluf_(v[i]);
          st_bf16x16(srg + (size_t)(tok0 + n) * 512 + f0 - 2048 + m, v);
        });
      } else if (ft < 28) {
        epilogue(acc, [&](int m, int n, float (&v)[16]) {
#pragma unroll
          for (int i = 0; i < 16; ++i) v[i] = sigmoidf_(v[i]);
          st_bf16x16(sga + (size_t)(tok0 + n) * 1024 + f0 - 2560 + m, v);
        });
      } else {
        epilogue(acc, [&](int m, int n, float (&v)[16]) {
#pragma unroll
          for (int i = 0; i < 16; ++i) v[i] = sigmoidf_(v[i]);
          st_bf16x16(sgb + (size_t)(tok0 + n) * 1024 + f0 - 3584 + m, v);
        });
      }
    }
    ft = ft2; tt = tt2; have = have2;
  }
  {
    const int nloc = gridDim.x >> 3, loc = blockIdx.x >> 3;
    const int rem = nloc > 0 ? (720 % nloc) : 0;
    if (nloc == 0 || rem == 0) side_weights(p, smem, blockIdx.x, gridDim.x);
    else if (loc >= rem && loc < nloc) side_weights(p, smem, (loc - rem) * 8 + (blockIdx.x & 7), (nloc - rem) * 8);
  }
}

DI float log2gamma(float logit) { return -log1pf(expf(-logit)) * 1.4426950408889634f; }
DI void phase3(const Params& p, char* smem) {
  char* ws = p.ws;
  const int lane = threadIdx.x & 63, w = threadIdx.x >> 6;
  bf16_t* cq = (bf16_t*)(ws + OFF_CQ);
  const float* ckvraw = (const float*)(ws + OFF_CKVRAW);
  const float* krraw = (const float*)(ws + OFF_KRRAW);
  bf16_t* ckvall = (bf16_t*)(ws + OFF_CKVALL);
  bf16_t* krall = (bf16_t*)(ws + OFF_KRALL);
  const int rstride = gridDim.x * 4;
  for (int tok0 = blockIdx.x * 4 + w; tok0 < NTOK; tok0 += 2 * rstride) {
    u32x2 uq[2];
    float2 vk[2];
    float own[2], partner[2];
    float2 csn[2];
#pragma unroll
    for (int q = 0; q < 2; ++q) {
      const int tok = (tok0 + q * rstride < NTOK) ? tok0 + q * rstride : tok0;
      uq[q] = *(const u32x2*)(cq + (size_t)tok * 256 + lane * 4);
      vk[q] = *(const float2*)(ckvraw + (size_t)tok * 128 + lane * 2);
      own[q] = krraw[(size_t)tok * 32 + (lane & 31)];
      partner[q] = krraw[(size_t)tok * 32 + ((lane & 31) ^ 16)];
      const int t = tok >= NPT ? ((tok - NPT) & 2047) : 0;
      csn[q] = ((const float2*)(ws + OFF_ROPE))[t * 16 + (lane & 15)];
    }
    const float4 nq = *(const float4*)(p.q_norm + lane * 4);
    const float2 nk = *(const float2*)(p.kv_norm + lane * 2);
#pragma unroll
    for (int q = 0; q < 2; ++q) {
      const int tok = tok0 + q * rstride;
      if (tok < NTOK) {
        {
          const u32x2 u = uq[q];
          float a0 = bflo(u[0]), a1 = bfhi(u[0]), a2 = bflo(u[1]), a3 = bfhi(u[1]);
          float ss = wsum(a0 * a0 + a1 * a1 + a2 * a2 + a3 * a3);
          float rstd = rsqrtf(ss * (1.f / 256.f) + 1e-6f);
          u32x2 o;
          o[0] = pack2(a0 * rstd * nq.x, a1 * rstd * nq.y);
          o[1] = pack2(a2 * rstd * nq.z, a3 * rstd * nq.w);
          *(u32x2*)(cq + (size_t)tok * 256 + lane * 4) = o;
        }
        const int row = kvrow(tok);
        {
          const float2 v = vk[q];
          float ss = wsum(v.x * v.x + v.y * v.y);
          float rstd = rsqrtf(ss * (1.f / 128.f) + 1e-6f);
          float o0 = v.x * rstd * nk.x, o1 = v.y * rstd * nk.y;
          if (tok < NPT) *(float2*)(p.out + OUT_CKV + (size_t)tok * 128 + lane * 2) = make_float2(o0, o1);
          *(unsigned*)(ckvall + (size_t)row * 128 + lane * 2) = pack2(o0, o1);
        }
        if (lane < 32) {
          float o = own[q];
          if (tok < NPT) {
            p.out[OUT_KR + (size_t)tok * 32 + lane] = own[q];
          } else {
            const float cs = csn[q].x, sn = csn[q].y;
            o = lane < 16 ? own[q] * cs - partner[q] * sn : partner[q] * sn + own[q] * cs;
          }
          krall[(size_t)row * 32 + lane] = (bf16_t)f2bf(o);
        }
      }
    }
  }
  for (int cr = blockIdx.x * 4 + w; cr < 4096; cr += rstride) {
    const int b = cr >> 9, pos = cr & 511;
    const int row = NPT + b * 2560 + 2048 + pos;
    float2 v = *(const float2*)(p.cache_ckv + (size_t)cr * 128 + lane * 2);
    *(unsigned*)(ckvall + (size_t)row * 128 + lane * 2) = pack2(v.x, v.y);
    if (lane < 32) krall[(size_t)row * 32 + lane] = (bf16_t)f2bf(p.cache_krope[(size_t)cr * 32 + lane]);
  }
  const bf16_t* kT = (const bf16_t*)(ws + OFF_KT);
  const bf16_t* vT = (const bf16_t*)(ws + OFF_VT);
  float* Uf = (float*)(ws + OFF_UF);
  float* Ub = (float*)(ws + OFF_UB);
  for (int it = blockIdx.x; it < 320; it += gridDim.x) {
    const int blk = it >> 2, h = it & 3;
    const float l2f = log2gamma(p.lg_f[h]), l2b = log2gamma(p.lg_b[h]);
    const bf16_t* Kp = kT + (size_t)(h * 128) * NTOK + blk * 256;
    const bf16_t* Vp = vT + (size_t)(h * 128) * NTOK + blk * 256;
#pragma unroll 1
    for (int dir = 0; dir < 2; ++dir) {
      const float sa = dir ? 0.f : l2f * 255.f, sb = dir ? l2b : -l2f;
      f32x4 acc[4][4];
      acc_zero(acc);
      if (blk < 16) {
        gemm_kloop<1>(acc, Vp, NTOK, Kp, NTOK, 256, smem, sa, sb);
        float* dst = p.out + (dir ? OUT_SB : OUT_SF) + (size_t)(blk * 4 + h) * 16384;
        epilogue(acc, [&](int m, int n, float (&v)[16]) { st_f32x16(dst + n * 128 + m, v); });
      } else {
        gemm_kloop<1>(acc, Kp, NTOK, Vp, NTOK, 256, smem, sa, sb);
        float* dst = (dir ? Ub : Uf) + (size_t)((blk - 16) * 4 + h) * 16384;
        epilogue(acc, [&](int m, int n, float (&v)[16]) { st_f32x16(dst + n * 128 + m, v); });
      }
    }
  }
}

DI void phase4(const Params& p) {
  char* ws = p.ws;
  const float* Uf = (const float*)(ws + OFF_UF);
  const float* Ub = (const float*)(ws + OFF_UB);
  bf16_t* Sf = (bf16_t*)(ws + OFF_SF);
  bf16_t* Sb = (bf16_t*)(ws + OFF_SB);
  for (int idx = blockIdx.x * 256 + threadIdx.x; idx < (1 << 20); idx += gridDim.x * 256) {
    int d = idx & 127, e = (idx >> 7) & 127, h = (idx >> 14) & 3, b = (idx >> 16) & 7, dir = idx >> 19;
    size_t eo = (size_t)e * 128 + d;
    if (dir == 0) {
      float cf = exp2f(log2gamma(p.lg_f[h]) * 256.f);
      float S = p.st_f[(size_t)(b * 4 + h) * 16384 + d * 128 + e];
#pragma unroll
      for (int blk = 0; blk < 8; ++blk) {
        size_t o = (size_t)((b * 8 + blk) * 4 + h) * 16384 + eo;
        Sf[o] = (bf16_t)f2bf(S);
        S = cf * S + Uf[o];
      }
    } else {
      float cb = exp2f(log2gamma(p.lg_b[h]) * 256.f);
      float S = p.st_b[(size_t)(b * 4 + h) * 16384 + d * 128 + e];
#pragma unroll
      for (int blk = 7; blk >= 0; --blk) {
        size_t o = (size_t)((b * 8 + blk) * 4 + h) * 16384 + eo;
        Sb[o] = (bf16_t)f2bf(S);
        S = cb * S + Ub[o];
      }
    }
  }
}

DI bf16x8 scale_frag(bf16x8 q, float s) {
  u32x4 u = __builtin_bit_cast(u32x4, q);
#pragma unroll
  for (int i = 0; i < 4; ++i) u[i] = pack2(bflo(u[i]) * s, bfhi(u[i]) * s);
  return __builtin_bit_cast(bf16x8, u);
}
constexpr int NQT = 1;
DI void phase5(const Params& p, char* smem) {
  char* ws = p.ws;
  const bf16_t* rq = (const bf16_t*)(ws + OFF_RQ);
  const bf16_t* rk = (const bf16_t*)(ws + OFF_RK);
  const bf16_t* vT = (const bf16_t*)(ws + OFF_VT);
  const bf16_t* srg = (const bf16_t*)(ws + OFF_SRG);
  const bf16_t* Sf = (const bf16_t*)(ws + OFF_SF);
  const bf16_t* Sb = (const bf16_t*)(ws + OFF_SB);
  bf16_t* ret = (bf16_t*)(ws + OFF_RET);
  bf16_t* Ks0 = (bf16_t*)smem;
  const int tid = threadIdx.x, lane = tid & 63, w = tid >> 6, l15 = lane & 15, g = lane >> 4;
  for (int item = vbid(); item < 640 * (2 / NQT); item += gridDim.x) {
    const int qb = item >> 2, h = item & 3, blk = (qb * NQT) >> 2;
    const float l2f = log2gamma(p.lg_f[h]), l2b = log2gamma(p.lg_b[h]);
    const int tokw = qb * (64 * NQT) + w * (16 * NQT);
    bf16x8 Q[NQT][4];
#pragma unroll
    for (int qt = 0; qt < NQT; ++qt)
#pragma unroll
      for (int ks = 0; ks < 4; ++ks)
        Q[qt][ks] = *(const bf16x8*)(rq + (size_t)(tokw + qt * 16 + l15) * 512 + h * 128 + ks * 32 + g * 8);
    f32x4 o[8][NQT];
#pragma unroll
    for (int et = 0; et < 8; ++et)
#pragma unroll
      for (int qt = 0; qt < NQT; ++qt) o[et][qt] = f32x4{0.f, 0.f, 0.f, 0.f};
    u32x4 rk_[4], rv_[4];
    auto gload = [&](int kt) {
      const int key0 = blk * 256 + kt * 64;
#pragma unroll
      for (int i = 0; i < 4; ++i) {
        int c = tid + 256 * i;
        int r = c >> 4, cc = (c & 15) * 8;
        rk_[i] = *(const u32x4*)(rk + (size_t)(key0 + r) * 512 + h * 128 + cc);
        int e = c >> 3, c2 = (c & 7) * 8;
        rv_[i] = *(const u32x4*)(vT + (size_t)(h * 128 + e) * NTOK + key0 + c2);
      }
    };
    auto lstore = [&](int b_) {
      bf16_t* Kd = Ks0 + b_ * 18432;
      bf16_t* Vd = Kd + 64 * 144;
#pragma unroll
      for (int i = 0; i < 4; ++i) {
        int c = tid + 256 * i;
        int r = c >> 4, cc = (c & 15) * 8;
        *(u32x4*)(Kd + r * 144 + cc) = rk_[i];
        int e = c >> 3, c2 = (c & 7) * 8;
        *(u32x4*)(Vd + e * 72 + c2) = rv_[i];
      }
    };
    gload(0);
    __syncthreads();
    lstore(0);
    gload(1);
    __syncthreads();
#pragma unroll 1
    for (int kt = 0; kt < 4; ++kt) {
      const bf16_t* Ks = Ks0 + (kt & 1) * 18432;
      const bf16_t* Vs = Ks + 64 * 144;
      bf16x8 P[NQT][2];
#pragma unroll
      for (int qt = 0; qt < NQT; ++qt) {
        f32x4 s[4];
#pragma unroll
        for (int kk = 0; kk < 4; ++kk) s[kk] = f32x4{0.f, 0.f, 0.f, 0.f};
#pragma unroll
        for (int ks = 0; ks < 4; ++ks) {
#pragma unroll
          for (int kk = 0; kk < 4; ++kk) {
            bf16x8 a = *(const bf16x8*)(Ks + (kk * 16 + l15) * 144 + ks * 32 + g * 8);
            s[kk] = __builtin_amdgcn_mfma_f32_16x16x32_bf16(a, Q[qt][ks], s[kk], 0, 0, 0);
          }
        }
        const int iq = (tokw + qt * 16 + l15) & 255;
#pragma unroll
        for (int kk = 0; kk < 4; ++kk) {
#pragma unroll
          for (int j = 0; j < 4; ++j) {
            int jk = kt * 64 + kk * 16 + 4 * g + j;
            int diff = iq - jk;
            float dm = diff > 0 ? ex2(l2f * (float)diff) : (diff < 0 ? ex2(l2b * (float)(-diff)) : 2.f);
            s[kk][j] *= dm;
          }
        }
#pragma unroll
        for (int k2 = 0; k2 < 2; ++k2) {
          u32x4 u;
          u[0] = pack2(s[2 * k2][0], s[2 * k2][1]);
          u[1] = pack2(s[2 * k2][2], s[2 * k2][3]);
          u[2] = pack2(s[2 * k2 + 1][0], s[2 * k2 + 1][1]);
          u[3] = pack2(s[2 * k2 + 1][2], s[2 * k2 + 1][3]);
          P[qt][k2] = __builtin_bit_cast(bf16x8, u);
        }
      }
#pragma unroll
      for (int k2 = 0; k2 < 2; ++k2) {
#pragma unroll
        for (int et = 0; et < 8; ++et) {
          u32x2 lo = *(const u32x2*)(Vs + (et * 16 + l15) * 72 + k2 * 32 + 4 * g);
          u32x2 hi = *(const u32x2*)(Vs + (et * 16 + l15) * 72 + k2 * 32 + 16 + 4 * g);
          u32x4 u;
          u[0] = lo[0]; u[1] = lo[1]; u[2] = hi[0]; u[3] = hi[1];
          bf16x8 a = __builtin_bit_cast(bf16x8, u);
#pragma unroll
          for (int qt = 0; qt < NQT; ++qt) o[et][qt] = __builtin_amdgcn_mfma_f32_16x16x32_bf16(a, P[qt][k2], o[et][qt], 0, 0, 0);
        }
      }
      if (kt + 1 < 4) {
        lstore((kt + 1) & 1);
        if (kt + 2 < 4) gload(kt + 2);
        __syncthreads();
      }
    }
    if (blk >= 16) {
      bf16_t* SL = (bf16_t*)smem;
      __syncthreads();
#pragma unroll
      for (int dir = 0; dir < 2; ++dir) {
        const bf16_t* S = (dir ? Sb : Sf) + (size_t)((blk - 16) * 4 + h) * 16384;
#pragma unroll
        for (int i = 0; i < 8; ++i) {
          int c = tid + 256 * i;
          int e = c >> 4, cc = (c & 15) * 8;
          *(u32x4*)(SL + dir * (128 * 144) + e * 144 + cc) = *(const u32x4*)(S + e * 128 + cc);
        }
      }
      __syncthreads();
#pragma unroll 1
      for (int dir = 0; dir < 2; ++dir) {
        const bf16_t* S = SL + dir * (128 * 144);
        float dq[NQT];
#pragma unroll
        for (int qt = 0; qt < NQT; ++qt) {
          int iq = (tokw + qt * 16 + l15) & 255;
          dq[qt] = dir ? exp2f(l2b * (float)(256 - iq)) : exp2f(l2f * (float)(iq + 1));
        }
#pragma unroll
        for (int ks = 0; ks < 4; ++ks) {
          bf16x8 qs[NQT];
#pragma unroll
          for (int qt = 0; qt < NQT; ++qt) qs[qt] = scale_frag(Q[qt][ks], dq[qt]);
#pragma unroll
          for (int et = 0; et < 8; ++et) {
            bf16x8 a = *(const bf16x8*)(S + (et * 16 + l15) * 144 + ks * 32 + g * 8);
#pragma unroll
            for (int qt = 0; qt < NQT; ++qt) o[et][qt] = __builtin_amdgcn_mfma_f32_16x16x32_bf16(a, qs[qt], o[et][qt], 0, 0, 0);
          }
        }
      }
    }
#pragma unroll
    for (int qt = 0; qt < NQT; ++qt) {
      const int tok = tokw + qt * 16 + l15;
      float s1 = 0.f;
#pragma unroll
      for (int et = 0; et < 8; ++et)
#pragma unroll
        for (int j = 0; j < 4; ++j) s1 += o[et][qt][j];
      s1 += __shfl_xor(s1, 16);
      s1 += __shfl_xor(s1, 32);
      const float mu = s1 * (1.f / 128.f);
      float s2 = 0.f;
#pragma unroll
      for (int et = 0; et < 8; ++et)
#pragma unroll
        for (int j = 0; j < 4; ++j) {
          float dlt = o[et][qt][j] - mu;
          s2 += dlt * dlt;
        }
      s2 += __shfl_xor(s2, 16);
      s2 += __shfl_xor(s2, 32);
      const float rstd = rsqrtf(s2 * (1.f / 128.f) + 1e-6f);
#pragma unroll
      for (int et = 0; et < 8; ++et) {
        const int e = h * 128 + et * 16 + 4 * g;
        float4 gn = *(const float4*)(p.ret_gn + e);
        u32x2 sg = *(const u32x2*)(srg + (size_t)tok * 512 + e);
        u32x2 ov;
        ov[0] = pack2((o[et][qt][0] - mu) * rstd * gn.x * bflo(sg[0]), (o[et][qt][1] - mu) * rstd * gn.y * bfhi(sg[0]));
        ov[1] = pack2((o[et][qt][2] - mu) * rstd * gn.z * bflo(sg[1]), (o[et][qt][3] - mu) * rstd * gn.w * bfhi(sg[1]));
        *(u32x2*)(ret + (size_t)tok * 512 + e) = ov;
      }
    }
  }
}

DI void phase6(const Params& p, char* smem) {
  char* ws = p.ws;
  const bf16_t* cqn = (const bf16_t*)(ws + OFF_CQ);
  const bf16_t* wuqT = (const bf16_t*)(ws + OFF_WUQT);
  bf16_t* q = (bf16_t*)(ws + OFF_Q);
  for (int it = 0;; ++it) {
    int ft, tt;
    if (!tile_map(it, 6, 160, 1, ft, tt)) break;
    f32x4 acc[4][4];
    acc_zero(acc);
    gemm_kloop<0>(acc, wuqT + (size_t)ft * 128 * 256, 256, cqn + (size_t)tt * 128 * 256, 256, 256, smem, 0.f, 0.f);
    epilogue(acc, [&](int m, int n, float (&v)[16]) { st_bf16x16(q + (size_t)(tt * 128 + n) * 768 + ft * 128 + m, v); });
  }
  const bf16_t* ckvall = (const bf16_t*)(ws + OFF_CKVALL);
  const bf16_t* wukvT = (const bf16_t*)(ws + OFF_WUKVT);
  bf16_t* Kn = (bf16_t*)(ws + OFF_KN);
  bf16_t* Vt = (bf16_t*)(ws + OFF_VTA);
  for (int it = 0;; ++it) {
    int ft, tt;
    if (!tile_map(it, 8, 192, 1, ft, tt)) break;
    f32x4 acc[4][4];
    acc_zero(acc);
    const bf16_t* W = wukvT + (size_t)ft * 128 * 128;
    const bf16_t* X = ckvall + (size_t)tt * 128 * 128;
    if (ft < 4) {
      gemm_kloop<0>(acc, W, 128, X, 128, 128, smem, 0.f, 0.f);
      epilogue(acc, [&](int m, int n, float (&v)[16]) { st_bf16x16(Kn + (size_t)(tt * 128 + n) * 512 + ft * 128 + m, v); });
    } else {
      gemm_kloop<0>(acc, X, 128, W, 128, 128, smem, 0.f, 0.f);
      epilogue(acc, [&](int m, int n, float (&v)[16]) { st_bf16x16(Vt + (size_t)((ft - 4) * 128 + n) * NKV + tt * 128 + m, v); });
    }
  }
}

DI void conv_fp8_rows(const float* __restrict__ src, unsigned char* __restrict__ dst, float* __restrict__ inv);
DI void phase7(const Params& p, char* smem) {
  char* ws = p.ws;
  const bf16_t* q = (const bf16_t*)(ws + OFF_Q);
  const bf16_t* Kn = (const bf16_t*)(ws + OFF_KN);
  const bf16_t* Vt = (const bf16_t*)(ws + OFF_VTA);
  const bf16_t* krall = (const bf16_t*)(ws + OFF_KRALL);
  bf16_t* attn = (bf16_t*)(ws + OFF_ATTN);
  bf16_t* Ks0 = (bf16_t*)smem;
  const int tid = threadIdx.x, lane = tid & 63, w = tid >> 6, l15 = lane & 15, g = lane >> 4;
  const float qscale = 0.10206207261596577f * 1.4426950408889634f;
  for (int item = vbid(); item < 1280; item += gridDim.x) {
    int b, h, qtok0, keyrow0, nkt;
    bool sample;
    if (item < 1024) {
      sample = true; b = item >> 7; h = (item >> 4) & 7; int qb = item & 15;
      qtok0 = NPT + b * 2048 + qb * 128; keyrow0 = NPT + b * 2560; nkt = 40;
    } else {
      int it2 = item - 1024;
      sample = false; b = it2 >> 4; h = (it2 >> 1) & 7; int qb = it2 & 1;
      qtok0 = b * 256 + qb * 128; keyrow0 = b * 256; nkt = 4;
    }
    bf16x8 Q[2][3];
#pragma unroll
    for (int qt = 0; qt < 2; ++qt) {
      const int tokq = qtok0 + w * 32 + qt * 16 + l15;
      const bf16_t* qp = q + (size_t)tokq * 768 + h * 96;
#pragma unroll
      for (int ks = 0; ks < 3; ++ks) {
        u32x4 u = *(const u32x4*)(qp + ks * 32 + g * 8);
        float v[8];
#pragma unroll
        for (int i = 0; i < 4; ++i) { v[2 * i] = bflo(u[i]); v[2 * i + 1] = bfhi(u[i]); }
        if (ks == 2 && sample) {
          u32x4 up = *(const u32x4*)(qp + 64 + (g ^ 2) * 8);
          float pv[8];
#pragma unroll
          for (int i = 0; i < 4; ++i) { pv[2 * i] = bflo(up[i]); pv[2 * i + 1] = bfhi(up[i]); }
          int t = (tokq - NPT) & 2047;
          const float4* rp = (const float4*)((const float2*)(ws + OFF_ROPE) + t * 16 + (g & 1) * 8);
#pragma unroll
          for (int i2 = 0; i2 < 4; ++i2) {
            const float4 c2 = rp[i2];
            const int i = 2 * i2;
            v[i] = g < 2 ? v[i] * c2.x - pv[i] * c2.y : pv[i] * c2.y + v[i] * c2.x;
            v[i + 1] = g < 2 ? v[i + 1] * c2.z - pv[i + 1] * c2.w : pv[i + 1] * c2.w + v[i + 1] * c2.z;
          }
        }
        u32x4 o4;
#pragma unroll
        for (int i = 0; i < 4; ++i) o4[i] = pack2(v[2 * i] * qscale, v[2 * i + 1] * qscale);
        Q[qt][ks] = __builtin_bit_cast(bf16x8, o4);
      }
    }
    f32x4 o[4][2];
#pragma unroll
    for (int et = 0; et < 4; ++et)
#pragma unroll
      for (int qt = 0; qt < 2; ++qt) o[et][qt] = f32x4{0.f, 0.f, 0.f, 0.f};
    float mrun[2] = {-1e30f, -1e30f}, lrun[2] = {0.f, 0.f};
    u32x4 rk_[3], rv_[2];
    auto gload = [&](int kt) {
      const int row0 = keyrow0 + kt * 64;
#pragma unroll
      for (int i = 0; i < 3; ++i) {
        int c = tid + 256 * i;
        int r = c / 12, cc = c - r * 12;
        rk_[i] = cc < 8 ? *(const u32x4*)(Kn + (size_t)(row0 + r) * 512 + h * 64 + cc * 8)
                        : *(const u32x4*)(krall + (size_t)(row0 + r) * 32 + (cc - 8) * 8);
      }
#pragma unroll
      for (int i = 0; i < 2; ++i) {
        int c = tid + 256 * i;
        int e = c >> 3, cc = (c & 7) * 8;
        rv_[i] = *(const u32x4*)(Vt + (size_t)(h * 64 + e) * NKV + row0 + cc);
      }
    };
    auto lstore = [&](int b) {
      bf16_t* Kd = Ks0 + b * 11776;
      bf16_t* Vd = Kd + 64 * 112;
#pragma unroll
      for (int i = 0; i < 3; ++i) {
        int c = tid + 256 * i;
        int r = c / 12, cc = c - r * 12;
        *(u32x4*)(Kd + r * 112 + cc * 8) = rk_[i];
      }
#pragma unroll
      for (int i = 0; i < 2; ++i) {
        int c = tid + 256 * i;
        int e = c >> 3, cc = (c & 7) * 8;
        *(u32x4*)(Vd + e * 72 + cc) = rv_[i];
      }
    };
    gload(0);
    __syncthreads();
    lstore(0);
    if (nkt > 1) gload(1);
    __syncthreads();
#pragma unroll 1
    for (int kt = 0; kt < nkt; ++kt) {
      const bf16_t* Ks = Ks0 + (kt & 1) * 11776;
      const bf16_t* Vs = Ks + 64 * 112;
      f32x4 s[4][2];
#pragma unroll
      for (int kk = 0; kk < 4; ++kk)
#pragma unroll
        for (int qt = 0; qt < 2; ++qt) s[kk][qt] = f32x4{0.f, 0.f, 0.f, 0.f};
#pragma unroll
      for (int ks = 0; ks < 3; ++ks) {
#pragma unroll
        for (int kk = 0; kk < 4; ++kk) {
          bf16x8 a = *(const bf16x8*)(Ks + (kk * 16 + l15) * 112 + ks * 32 + g * 8);
#pragma unroll
          for (int qt = 0; qt < 2; ++qt) s[kk][qt] = __builtin_amdgcn_mfma_f32_16x16x32_bf16(a, Q[qt][ks], s[kk][qt], 0, 0, 0);
        }
      }
      bf16x8 P[2][2];
#pragma unroll
      for (int qt = 0; qt < 2; ++qt) {
        float mx = s[0][qt][0];
#pragma unroll
        for (int kk = 0; kk < 4; ++kk)
#pragma unroll
          for (int j = 0; j < 4; ++j) mx = fmaxf(mx, s[kk][qt][j]);
        mx = fmaxf(mx, __shfl_xor(mx, 16));
        mx = fmaxf(mx, __shfl_xor(mx, 32));
        const float mnew = fmaxf(mrun[qt], mx);
        const bool grow = __ballot(mx > mrun[qt]) != 0ull;
        const float alpha = grow ? ex2(mrun[qt] - mnew) : 1.f;
        mrun[qt] = mnew;
        float ps = 0.f;
#pragma unroll
        for (int kk = 0; kk < 4; ++kk)
#pragma unroll
          for (int j = 0; j < 4; ++j) {
            float e_ = ex2(s[kk][qt][j] - mnew);
            s[kk][qt][j] = e_;
            ps += e_;
          }
        if (grow) {
          lrun[qt] = lrun[qt] * alpha + ps;
#pragma unroll
          for (int et = 0; et < 4; ++et)
#pragma unroll
            for (int j = 0; j < 4; ++j) o[et][qt][j] *= alpha;
        } else {
          lrun[qt] += ps;
        }
#pragma unroll
        for (int k2 = 0; k2 < 2; ++k2) {
          u32x4 u;
          u[0] = pack2(s[2 * k2][qt][0], s[2 * k2][qt][1]);
          u[1] = pack2(s[2 * k2][qt][2], s[2 * k2][qt][3]);
          u[2] = pack2(s[2 * k2 + 1][qt][0], s[2 * k2 + 1][qt][1]);
          u[3] = pack2(s[2 * k2 + 1][qt][2], s[2 * k2 + 1][qt][3]);
          P[qt][k2] = __builtin_bit_cast(bf16x8, u);
        }
      }
#pragma unroll
      for (int k2 = 0; k2 < 2; ++k2) {
#pragma unroll
        for (int et = 0; et < 4; ++et) {
          u32x2 lo = *(const u32x2*)(Vs + (et * 16 + l15) * 72 + k2 * 32 + 4 * g);
          u32x2 hi = *(const u32x2*)(Vs + (et * 16 + l15) * 72 + k2 * 32 + 16 + 4 * g);
          u32x4 u;
          u[0] = lo[0]; u[1] = lo[1]; u[2] = hi[0]; u[3] = hi[1];
          bf16x8 a = __builtin_bit_cast(bf16x8, u);
#pragma unroll
          for (int qt = 0; qt < 2; ++qt) o[et][qt] = __builtin_amdgcn_mfma_f32_16x16x32_bf16(a, P[qt][k2], o[et][qt], 0, 0, 0);
        }
      }
      if (kt + 1 < nkt) {
        lstore((kt + 1) & 1);
        if (kt + 2 < nkt) gload(kt + 2);
        __syncthreads();
      }
    }
#pragma unroll
    for (int qt = 0; qt < 2; ++qt) {
      const int tokq = qtok0 + w * 32 + qt * 16 + l15;
      float lt = lrun[qt];
      lt += __shfl_xor(lt, 16);
      lt += __shfl_xor(lt, 32);
      const float inv = 1.f / lt;
#pragma unroll
      for (int et = 0; et < 4; ++et) {
        u32x2 ov;
        ov[0] = pack2(o[et][qt][0] * inv, o[et][qt][1] * inv);
        ov[1] = pack2(o[et][qt][2] * inv, o[et][qt][3] * inv);
        *(u32x2*)(attn + (size_t)tokq * 512 + h * 64 + et * 16 + 4 * g) = ov;
      }
    }
  }
  conv_fp8_rows(p.peer_u, (unsigned char*)(p.ws + OFF_TABU), (float*)(p.ws + OFF_INVU));
  conv_fp8_rows(p.peer_v, (unsigned char*)(p.ws + OFF_TABV), (float*)(p.ws + OFF_INVV));
}

DI void phase8(const Params& p, char* smem) {
  char* ws = p.ws;
  const bf16_t* attn = (const bf16_t*)(ws + OFF_ATTN);
  const bf16_t* ret = (const bf16_t*)(ws + OFF_RET);
  const bf16_t* wa = (const bf16_t*)(ws + OFF_WUPAT);
  const bf16_t* wb = (const bf16_t*)(ws + OFF_WUPBT);
  const bf16_t* sga = (const bf16_t*)p.out;
  const bf16_t* sgb = sga + (size_t)NTOK * 1024;
  bf16_t* mbuf = (bf16_t*)(ws + OFF_M);
  const int tid = threadIdx.x, lane = tid & 63, w = tid >> 6, wm = w >> 1, wn = w & 1, l15 = lane & 15, g = lane >> 4;
  for (int it = 0;; ++it) {
    int ft, tt;
    if (!tile_map(it, 8, 160, 1, ft, tt)) break;
    f32x4 acc[4][4];
    acc_zero(acc);
    gemm_kloop<0>(acc, wa + (size_t)ft * 128 * 512, 512, attn + (size_t)tt * 128 * 512, 512, 512, smem, 0.f, 0.f);
#pragma unroll
    for (int c = 0; c < 4; ++c) {
      const size_t off = (size_t)(tt * 128 + wn * 64 + c * 16 + l15) * 1024 + ft * 128 + wm * 64 + 16 * g;
      float a[16], bq[16];
      ld_bf16x16(sga + off, a);
      ld_bf16x16(sgb + off, bq);
#pragma unroll
      for (int f = 0; f < 4; ++f)
#pragma unroll
        for (int j = 0; j < 4; ++j) acc[f][c][j] *= a[f * 4 + j] * __builtin_amdgcn_rcpf(fmaxf(bq[f * 4 + j], 1e-30f));
    }
    gemm_kloop<0>(acc, wb + (size_t)ft * 128 * 512, 512, ret + (size_t)tt * 128 * 512, 512, 512, smem, 0.f, 0.f);
    epilogue(acc, [&](int m, int n, float (&v)[16]) {
      const size_t off = (size_t)(tt * 128 + n) * 1024 + ft * 128 + m;
      float bq[16];
      ld_bf16x16(sgb + off, bq);
#pragma unroll
      for (int i = 0; i < 16; ++i) v[i] *= bq[i];
      st_bf16x16(mbuf + off, v);
    });
  }
}
DI void phase9(const Params& p, char* smem) {
  char* ws = p.ws;
  const bf16_t* mbuf = (const bf16_t*)(ws + OFF_M);
  const bf16_t* wo = (const bf16_t*)(ws + OFF_WOT);
  const float* mod = (const float*)(ws + OFF_MOD);
  u32x4 pra[4], prb[4];
  int ft, tt;
  bool have = tile_map(0, 8, 160, 1, ft, tt);
  if (have) gemm_issue0(wo + (size_t)ft * 128 * 1024, 1024, mbuf + (size_t)tt * 128 * 1024, 1024, pra, prb);
  for (int it = 0; have; ++it) {
    f32x4 acc[4][4];
    acc_zero(acc);
    gemm_kloop_pre<0>(acc, wo + (size_t)ft * 128 * 1024, 1024, mbuf + (size_t)tt * 128 * 1024, 1024, 1024, smem, 0.f, 0.f, pra, prb);
    int ft2 = 0, tt2 = 0;
    const bool have2 = tile_map(it + 1, 8, 160, 1, ft2, tt2);
    if (have2) gemm_issue0(wo + (size_t)ft2 * 128 * 1024, 1024, mbuf + (size_t)tt2 * 128 * 1024, 1024, pra, prb);
    epilogue(acc, [&](int m, int n, float (&v)[16]) {
      const int tok = tt * 128 + n, feat = ft * 128 + m;
      const float* xr = xrow(p, tok) + feat;
      const float* g1 = mod + modidx(tok) * 6144 + 2048 + feat;
#pragma unroll
      for (int i = 0; i < 4; ++i) {
        float4 xv = *(const float4*)(xr + 4 * i), gv = *(const float4*)(g1 + 4 * i);
        v[4 * i] = xv.x + gv.x * v[4 * i];
        v[4 * i + 1] = xv.y + gv.y * v[4 * i + 1];
        v[4 * i + 2] = xv.z + gv.z * v[4 * i + 2];
        v[4 * i + 3] = xv.w + gv.w * v[4 * i + 3];
      }
      st_f32x16(p.out + (size_t)tok * DM + feat, v);
    });
    ft = ft2; tt = tt2; have = have2;
  }
}
DI void conv_fp8_rows(const float* __restrict__ src, unsigned char* __restrict__ dst, float* __restrict__ inv) {
  const int lane = threadIdx.x & 63, w = threadIdx.x >> 6;
  for (int r = blockIdx.x * 4 + w; r < 16384; r += gridDim.x * 4) {
    const float* sp = src + (size_t)r * 1024 + lane * 16;
    float4 v[4];
    float am = 0.f;
#pragma unroll
    for (int i = 0; i < 4; ++i) {
      v[i] = *(const float4*)(sp + 4 * i);
      am = fmaxf(am, fmaxf(fmaxf(fabsf(v[i].x), fabsf(v[i].y)), fmaxf(fabsf(v[i].z), fabsf(v[i].w))));
    }
#pragma unroll
    for (int o = 32; o > 0; o >>= 1) am = fmaxf(am, __shfl_xor(am, o));
    const float sc = am > 0.f ? 448.f / am : 1.f;
    u32x4 o4;
#pragma unroll
    for (int i = 0; i < 4; ++i) {
      int wd = 0;
      wd = __builtin_amdgcn_cvt_pk_fp8_f32(v[i].x * sc, v[i].y * sc, wd, false);
      wd = __builtin_amdgcn_cvt_pk_fp8_f32(v[i].z * sc, v[i].w * sc, wd, true);
      o4[i] = (unsigned)wd;
    }
    *(u32x4*)(dst + ((size_t)(lane >> 3) * 16384 + r) * 128 + (lane & 7) * 16) = o4;
    if (lane == 0) inv[r] = am > 0.f ? am * (1.f / 448.f) : 1.f;
  }
}
DI void phase10(const Params& p, char* smem) {
  rows_norm_mod(p, p.norm_ffn, 3072, 4096, true, (bf16_t*)(p.ws + OFF_H2));
}
DI void phase11(const Params& p, char* smem) {
  char* ws = p.ws;
  const bf16_t* h2 = (const bf16_t*)(ws + OFF_H2);
  const bf16_t* wct = (const bf16_t*)(ws + OFF_WCT);
  bf16_t* sc = (bf16_t*)(ws + OFF_SCORES);
  u32x4 pra[4], prb[4];
  int ft, tt;
  bool have = tile_map(0, 16, 160, 2, ft, tt);
  if (have) gemm_issue0(wct + (size_t)ft * 128 * 1024, 1024, h2 + (size_t)tt * 128 * 1024, 1024, pra, prb);
  for (int it = 0; have; ++it) {
    f32x4 acc[4][4];
    acc_zero(acc);
    gemm_kloop_pre<0>(acc, wct + (size_t)ft * 128 * 1024, 1024, h2 + (size_t)tt * 128 * 1024, 1024, 1024, smem, 0.f, 0.f, pra, prb);
    int ft2 = 0, tt2 = 0;
    const bool have2 = tile_map(it + 1, 16, 160, 2, ft2, tt2);
    if (have2) gemm_issue0(wct + (size_t)ft2 * 128 * 1024, 1024, h2 + (size_t)tt2 * 128 * 1024, 1024, pra, prb);
    epilogue(acc, [&](int m, int n, float (&v)[16]) { st_bf16x16(sc + (size_t)(tt * 128 + n) * 2048 + ft * 128 + m, v); });
    ft = ft2; tt = tt2; have = have2;
  }
}

DI unsigned okey(float f) {
  unsigned u = __float_as_uint(f);
  return (u & 0x80000000u) ? ~u : (u | 0x80000000u);
}
DI void wave_lds_sync() {
  __builtin_amdgcn_fence(__ATOMIC_ACQ_REL, "workgroup");
  __builtin_amdgcn_wave_barrier();
}
DI unsigned okey16(unsigned b) { return (b & 0x8000u) ? (~b & 0xFFFFu) : (b | 0x8000u); }
DI unsigned inv_okey16(unsigned k) { return (k & 0x8000u) ? (k & 0x7FFFu) : (~k & 0xFFFFu); }
DI unsigned inv_okey(unsigned k) { return (k & 0x80000000u) ? (k & 0x7FFFFFFFu) : ~k; }
DI void ins16(unsigned (&L)[16], unsigned x) {
#pragma unroll
  for (int i = 0; i < 16; ++i) {
    unsigned t = max(L[i], x);
    x = min(L[i], x);
    L[i] = t;
  }
}
DI void ce_desc(unsigned& a, unsigned& b) {
  const unsigned t = max(a, b);
  b = min(a, b);
  a = t;
}
DI void sort16_desc(unsigned (&a)[16]) {
#pragma unroll
  for (int ks = 1; ks <= 4; ++ks) {
#pragma unroll
    for (int js = ks - 1; js >= 0; --js) {
#pragma unroll
      for (int i = 0; i < 16; ++i) {
        const int k = 1 << ks, j = 1 << js, l = i ^ j;
        if (l > i) {
          if ((i & k) == 0) ce_desc(a[i], a[l]);
          else ce_desc(a[l], a[i]);
        }
      }
    }
  }
}
DI void merge_top16(unsigned (&L)[16], const unsigned (&G)[16]) {
#pragma unroll
  for (int i = 0; i < 16; ++i) L[i] = max(L[i], G[15 - i]);
#pragma unroll
  for (int js = 3; js >= 0; --js) {
#pragma unroll
    for (int i = 0; i < 16; ++i) {
      const int j = 1 << js, l = i ^ j;
      if (l > i) ce_desc(L[i], L[l]);
    }
  }
}
DI unsigned byte16(const unsigned (&d)[4], int i) {
  unsigned r = 0u;
#pragma unroll
  for (int q = 0; q < 4; ++q) r |= d[q] & (0u - (unsigned)((i >> 2) == q));
  return (r >> ((i & 3) * 8)) & 0xFFu;
}
DI unsigned sel16(const unsigned (&A)[16], int i) {
  unsigned r = 0u;
#pragma unroll
  for (int t = 0; t < 16; ++t) r |= A[t] & (0u - (unsigned)(i == t));
  return r;
}
DI void phase12(const Params& p, char* smem) {
  char* ws = p.ws;
  const bf16_t* sc = (const bf16_t*)(ws + OFF_SCORES);
  int* elist = (int*)(ws + OFF_ELIST);
  float* glist = (float*)(ws + OFF_GLIST);
  const int lane = threadIdx.x & 63, w = threadIdx.x >> 6;
  for (int batch = blockIdx.x * 4 + w; batch < NTOK / 4; batch += gridDim.x * 4) {
    const int tok = batch * 4 + (lane >> 4), hh = lane & 15;
    const bf16_t* row = sc + (size_t)tok * 2048 + hh * 128;
    unsigned L[16];
#pragma unroll
    for (int grp8 = 0; grp8 < 8; ++grp8) {
      unsigned G[16];
#pragma unroll
      for (int cc = 0; cc < 2; ++cc) {
        const int c = grp8 * 2 + cc;
        u32x4 u = *(const u32x4*)(row + c * 8);
#pragma unroll
        for (int i = 0; i < 4; ++i) {
          unsigned b0 = u[i] & 0xFFFFu, b1 = u[i] >> 16;
          G[cc * 8 + 2 * i] = (okey16(b0) << 16) | (unsigned)(127 - (c * 8 + 2 * i));
          G[cc * 8 + 2 * i + 1] = (okey16(b1) << 16) | (unsigned)(127 - (c * 8 + 2 * i + 1));
        }
      }
      sort16_desc(G);
      if (grp8 == 0) {
#pragma unroll
        for (int i = 0; i < 16; ++i) L[i] = G[i];
      } else {
        merge_top16(L, G);
      }
    }
    unsigned M[16];
#pragma unroll
    for (int i = 0; i < 16; ++i) M[i] = (unsigned)__shfl_xor((int)L[i], 1);
    float v1[16], v2[16];
#pragma unroll
    for (int i = 0; i < 16; ++i) {
      v1[i] = bf2f(inv_okey16(L[i] >> 16));
      v2[i] = bf2f(inv_okey16(M[i] >> 16));
    }
    unsigned C[16];
    C[0] = ((okey(v1[0] + v2[0]) & 0xFFFFFF00u) | 255u);
    C[1] = ((okey(v1[0] + v2[1]) & 0xFFFFFF00u) | 254u);
    C[2] = ((okey(v1[0] + v2[2]) & 0xFFFFFF00u) | 253u);
    C[3] = ((okey(v1[0] + v2[3]) & 0xFFFFFF00u) | 252u);
    C[4] = ((okey(v1[0] + v2[4]) & 0xFFFFFF00u) | 251u);
    C[5] = ((okey(v1[0] + v2[5]) & 0xFFFFFF00u) | 250u);
    C[6] = ((okey(v1[0] + v2[6]) & 0xFFFFFF00u) | 249u);
    C[7] = ((okey(v1[0] + v2[7]) & 0xFFFFFF00u) | 248u);
    C[8] = ((okey(v1[0] + v2[8]) & 0xFFFFFF00u) | 247u);
    C[9] = ((okey(v1[0] + v2[9]) & 0xFFFFFF00u) | 246u);
    C[10] = ((okey(v1[0] + v2[10]) & 0xFFFFFF00u) | 245u);
    C[11] = ((okey(v1[0] + v2[11]) & 0xFFFFFF00u) | 244u);
    C[12] = ((okey(v1[0] + v2[12]) & 0xFFFFFF00u) | 243u);
    C[13] = ((okey(v1[0] + v2[13]) & 0xFFFFFF00u) | 242u);
    C[14] = ((okey(v1[0] + v2[14]) & 0xFFFFFF00u) | 241u);
    C[15] = ((okey(v1[0] + v2[15]) & 0xFFFFFF00u) | 240u);
    {
      unsigned G[16];
      G[0] = ((okey(v1[1] + v2[0]) & 0xFFFFFF00u) | 239u);
      G[1] = ((okey(v1[1] + v2[1]) & 0xFFFFFF00u) | 238u);
      G[2] = ((okey(v1[1] + v2[2]) & 0xFFFFFF00u) | 237u);
      G[3] = ((okey(v1[1] + v2[3]) & 0xFFFFFF00u) | 236u);
      G[4] = ((okey(v1[1] + v2[4]) & 0xFFFFFF00u) | 235u);
      G[5] = ((okey(v1[1] + v2[5]) & 0xFFFFFF00u) | 234u);
      G[6] = ((okey(v1[1] + v2[6]) & 0xFFFFFF00u) | 233u);
      G[7] = ((okey(v1[1] + v2[7]) & 0xFFFFFF00u) | 232u);
      G[8] = 0u;
      G[9] = 0u;
      G[10] = 0u;
      G[11] = 0u;
      G[12] = 0u;
      G[13] = 0u;
      G[14] = 0u;
      G[15] = 0u;
      merge_top16(C, G);
    }
    {
      unsigned G[16];
      G[0] = ((okey(v1[2] + v2[0]) & 0xFFFFFF00u) | 223u);
      G[1] = ((okey(v1[2] + v2[1]) & 0xFFFFFF00u) | 222u);
      G[2] = ((okey(v1[2] + v2[2]) & 0xFFFFFF00u) | 221u);
      G[3] = ((okey(v1[2] + v2[3]) & 0xFFFFFF00u) | 220u);
      G[4] = ((okey(v1[2] + v2[4]) & 0xFFFFFF00u) | 219u);
      G[5] = 0u;
      G[6] = 0u;
      G[7] = 0u;
      G[8] = 0u;
      G[9] = 0u;
      G[10] = 0u;
      G[11] = 0u;
      G[12] = 0u;
      G[13] = 0u;
      G[14] = 0u;
      G[15] = 0u;
      merge_top16(C, G);
    }
    {
      unsigned G[16];
      G[0] = ((okey(v1[3] + v2[0]) & 0xFFFFFF00u) | 207u);
      G[1] = ((okey(v1[3] + v2[1]) & 0xFFFFFF00u) | 206u);
      G[2] = ((okey(v1[3] + v2[2]) & 0xFFFFFF00u) | 205u);
      G[3] = ((okey(v1[3] + v2[3]) & 0xFFFFFF00u) | 204u);
      G[4] = 0u;
      G[5] = 0u;
      G[6] = 0u;
      G[7] = 0u;
      G[8] = 0u;
      G[9] = 0u;
      G[10] = 0u;
      G[11] = 0u;
      G[12] = 0u;
      G[13] = 0u;
      G[14] = 0u;
      G[15] = 0u;
      merge_top16(C, G);
    }
    {
      unsigned G[16];
      G[0] = ((okey(v1[4] + v2[0]) & 0xFFFFFF00u) | 191u);
      G[1] = ((okey(v1[5] + v2[0]) & 0xFFFFFF00u) | 175u);
      G[2] = ((okey(v1[6] + v2[0]) & 0xFFFFFF00u) | 159u);
      G[3] = ((okey(v1[7] + v2[0]) & 0xFFFFFF00u) | 143u);
      G[4] = ((okey(v1[8] + v2[0]) & 0xFFFFFF00u) | 127u);
      G[5] = ((okey(v1[9] + v2[0]) & 0xFFFFFF00u) | 111u);
      G[6] = ((okey(v1[10] + v2[0]) & 0xFFFFFF00u) | 95u);
      G[7] = ((okey(v1[11] + v2[0]) & 0xFFFFFF00u) | 79u);
      G[8] = ((okey(v1[12] + v2[0]) & 0xFFFFFF00u) | 63u);
      G[9] = ((okey(v1[13] + v2[0]) & 0xFFFFFF00u) | 47u);
      G[10] = ((okey(v1[14] + v2[0]) & 0xFFFFFF00u) | 31u);
      G[11] = ((okey(v1[15] + v2[0]) & 0xFFFFFF00u) | 15u);
      G[12] = 0u;
      G[13] = 0u;
      G[14] = 0u;
      G[15] = 0u;
      merge_top16(C, G);
    }
    {
      unsigned G[16];
      G[0] = ((okey(v1[4] + v2[1]) & 0xFFFFFF00u) | 190u);
      G[1] = ((okey(v1[5] + v2[1]) & 0xFFFFFF00u) | 174u);
      G[2] = ((okey(v1[6] + v2[1]) & 0xFFFFFF00u) | 158u);
      G[3] = ((okey(v1[7] + v2[1]) & 0xFFFFFF00u) | 142u);
      G[4] = 0u;
      G[5] = 0u;
      G[6] = 0u;
      G[7] = 0u;
      G[8] = 0u;
      G[9] = 0u;
      G[10] = 0u;
      G[11] = 0u;
      G[12] = 0u;
      G[13] = 0u;
      G[14] = 0u;
      G[15] = 0u;
      merge_top16(C, G);
    }
    {
      unsigned G[16];
      G[0] = ((okey(v1[4] + v2[2]) & 0xFFFFFF00u) | 189u);
      G[1] = 0u;
      G[2] = 0u;
      G[3] = 0u;
      G[4] = 0u;
      G[5] = 0u;
      G[6] = 0u;
      G[7] = 0u;
      G[8] = 0u;
      G[9] = 0u;
      G[10] = 0u;
      G[11] = 0u;
      G[12] = 0u;
      G[13] = 0u;
      G[14] = 0u;
      G[15] = 0u;
      merge_top16(C, G);
    }
    unsigned ib1[4], ib2[4];
#pragma unroll
    for (int q = 0; q < 4; ++q) {
      ib1[q] = (L[4 * q] & 0xFFu) | ((L[4 * q + 1] & 0xFFu) << 8) | ((L[4 * q + 2] & 0xFFu) << 16) | ((L[4 * q + 3] & 0xFFu) << 24);
      ib2[q] = (M[4 * q] & 0xFFu) | ((M[4 * q + 1] & 0xFFu) << 8) | ((M[4 * q + 2] & 0xFFu) << 16) | ((M[4 * q + 3] & 0xFFu) << 24);
    }
    int ev[16];
    float gv[16];
    const float mx = __uint_as_float(inv_okey(C[0] & 0xFFFFFF00u));
    float den = 0.f;
#pragma unroll
    for (int k = 0; k < 16; ++k) {
      const int ci = 255 - (int)(C[k] & 0xFFu);
      ev[k] = (127 - (int)byte16(ib1, ci >> 4)) * 128 + (127 - (int)byte16(ib2, ci & 15));
      gv[k] = __expf(__uint_as_float(inv_okey(C[k] & 0xFFFFFF00u)) - mx);
      den += gv[k];
    }
    const float inv = 1.f / den;
    if ((lane & 1) == 0) {
      int* ep = elist + (size_t)tok * 128 + (hh >> 1) * 16;
      float* gp = glist + (size_t)tok * 128 + (hh >> 1) * 16;
#pragma unroll
      for (int k = 0; k < 4; ++k) {
        *(int4*)(ep + 4 * k) = make_int4(ev[4 * k], ev[4 * k + 1], ev[4 * k + 2], ev[4 * k + 3]);
        *(float4*)(gp + 4 * k) = make_float4(gv[4 * k] * inv, gv[4 * k + 1] * inv, gv[4 * k + 2] * inv, gv[4 * k + 3] * inv);
      }
    }
  }
}
using f32x2 = __attribute__((ext_vector_type(2))) float;
DI f32x2 cvt8(unsigned w, bool hi) {
  return hi ? __builtin_amdgcn_cvt_pk_f32_fp8((int)w, true) : __builtin_amdgcn_cvt_pk_f32_fp8((int)w, false);
}
struct SMeta { int e[16]; u32x4 ha, hb; };
template <int MODE>
DI void sl_meta(const Params& p, int t, int s, int grp, int ch, SMeta& m) {
  const int ts = __builtin_amdgcn_readfirstlane(t);
  const int* elist = (const int*)(p.ws + (MODE == 0 ? OFF_ELIST : OFF_GLIST)) + (size_t)ts * 128;
#pragma unroll
  for (int i = 0; i < 16; ++i) m.e[i] = elist[(unsigned)(i * 8 + grp)];
  if (MODE == 0) {
    const bf16_t* hq = (const bf16_t*)(p.ws + OFF_H2) + (size_t)ts * DM + s * 128;
    m.ha = *(const u32x4*)(hq + (unsigned)(ch * 16));
    m.hb = *(const u32x4*)(hq + (unsigned)(ch * 16 + 8));
  }
}
template <int MODE>
DI void sl_rows(const Params& p, int s, int ch, const SMeta& m, u32x4 (&r)[16]) {
  const unsigned char* tab = (const unsigned char*)(p.ws + (MODE == 0 ? OFF_TABU : OFF_TABV)) + (size_t)s * (16384 * 128);
#pragma unroll
  for (int i = 0; i < 16; ++i) r[i] = *(const u32x4*)(tab + ((unsigned)(m.e[i] & 0xFFFF) * 128u + (unsigned)(ch * 16)));
}
template <int MODE>
DI void sl_compute(const Params& p, int t, int s, int lane, const SMeta& m, const u32x4 (&r)[16]) {
  const int grp = lane >> 3, ch = lane & 7;
  if (MODE == 0) {
    f32x2 hp[8];
#pragma unroll
    for (int i = 0; i < 4; ++i) {
      hp[i] = f32x2{bflo(m.ha[i]), bfhi(m.ha[i])};
      hp[4 + i] = f32x2{bflo(m.hb[i]), bfhi(m.hb[i])};
    }
    float v[16];
#pragma unroll
    for (int i = 0; i < 16; ++i) {
      f32x2 d2 = f32x2{0.f, 0.f};
#pragma unroll
      for (int j = 0; j < 4; ++j) {
        d2 += cvt8(r[i][j], false) * hp[2 * j];
        d2 += cvt8(r[i][j], true) * hp[2 * j + 1];
      }
      v[i] = d2[0] + d2[1];
    }
    float q8[8], q4[4], q2[2];
    {
      const bool hi = lane & 4;
#pragma unroll
      for (int i = 0; i < 8; ++i) {
        float send = hi ? v[i] : v[8 + i], keep = hi ? v[8 + i] : v[i];
        q8[i] = keep + __shfl_xor(send, 4);
      }
    }
    {
      const bool hi = lane & 2;
#pragma unroll
      for (int i = 0; i < 4; ++i) {
        float send = hi ? q8[i] : q8[4 + i], keep = hi ? q8[4 + i] : q8[i];
        q4[i] = keep + __shfl_xor(send, 2);
      }
    }
    {
      const bool hi = lane & 1;
#pragma unroll
      for (int i = 0; i < 2; ++i) {
        float send = hi ? q4[i] : q4[2 + i], keep = hi ? q4[2 + i] : q4[i];
        q2[i] = keep + __shfl_xor(send, 1);
      }
    }
    float* po = (float*)(p.ws + OFF_PD) + (size_t)t * 1024 + s * 128;
    po[(2 * ch) * 8 + grp] = q2[0];
    po[(2 * ch + 1) * 8 + grp] = q2[1];
  } else {
    f32x2 acc[8];
#pragma unroll
    for (int q = 0; q < 8; ++q) acc[q] = f32x2{0.f, 0.f};
#pragma unroll
    for (int i = 0; i < 16; ++i) {
      const float wsc = __uint_as_float((unsigned)m.e[i] & 0xFFFF0000u);
      const f32x2 w2 = f32x2{wsc, wsc};
#pragma unroll
      for (int j = 0; j < 4; ++j) {
        acc[2 * j] += w2 * cvt8(r[i][j], false);
        acc[2 * j + 1] += w2 * cvt8(r[i][j], true);
      }
    }
    float v[16];
#pragma unroll
    for (int q = 0; q < 8; ++q) { v[2 * q] = acc[q][0]; v[2 * q + 1] = acc[q][1]; }
    float q8[8], q4[4], q2[2];
    {
      const bool hi = lane & 32;
#pragma unroll
      for (int i = 0; i < 8; ++i) {
        float send = hi ? v[i] : v[8 + i], keep = hi ? v[8 + i] : v[i];
        q8[i] = keep + __shfl_xor(send, 32);
      }
    }
    {
      const bool hi = lane & 16;
#pragma unroll
      for (int i = 0; i < 4; ++i) {
        float send = hi ? q8[i] : q8[4 + i], keep = hi ? q8[4 + i] : q8[i];
        q4[i] = keep + __shfl_xor(send, 16);
      }
    }
    {
      const bool hi = lane & 8;
#pragma unroll
      for (int i = 0; i < 2; ++i) {
        float send = hi ? q4[i] : q4[2 + i], keep = hi ? q4[2 + i] : q4[i];
        q2[i] = keep + __shfl_xor(send, 8);
      }
    }
    const int f = s * 128 + ch * 16 + 2 * grp;
    float* xr = p.out + (size_t)t * DM + f;
    const float2 xv = *(const float2*)xr;
    const float2 gv = *(const float2*)((const float*)(p.ws + OFF_MOD) + modidx(t) * 6144 + 5120 + f);
    *(float2*)xr = make_float2(xv.x + gv.x * q2[0], xv.y + gv.y * q2[1]);
  }
}
template <int MODE>
DI void sliced_pass(const Params& p) {
  const int s = blockIdx.x & 7, loc = blockIdx.x >> 3, nloc = gridDim.x >> 3;
  if (loc >= nloc) return;
  const int lane = threadIdx.x & 63, w = threadIdx.x >> 6, grp = lane >> 3, ch = lane & 7;
  const int stride = nloc * 4;
  SMeta mA, mB;
  u32x4 rA[16], rB[16];
  int t = loc * 4 + w;
  if (t < NTOK) {
    sl_meta<MODE>(p, t, s, grp, ch, mA);
    sl_rows<MODE>(p, s, ch, mA, rA);
  }
  if (t + stride < NTOK) sl_meta<MODE>(p, t + stride, s, grp, ch, mB);
#pragma unroll 1
  for (; t < NTOK; t += 2 * stride) {
    const int t1 = t + stride, t2 = t + 2 * stride, t3 = t + 3 * stride;
    if (t1 < NTOK) sl_rows<MODE>(p, s, ch, mB, rB);
    sl_compute<MODE>(p, t, s, lane, mA, rA);
    if (t2 < NTOK) sl_meta<MODE>(p, t2, s, grp, ch, mA);
    if (t1 < NTOK) {
      if (t2 < NTOK) sl_rows<MODE>(p, s, ch, mA, rA);
      sl_compute<MODE>(p, t1, s, lane, mB, rB);
      if (t3 < NTOK) sl_meta<MODE>(p, t3, s, grp, ch, mB);
    }
  }
}
DI void phase13(const Params& p) { sliced_pass<0>(p); }
DI void phase14(const Params& p) {
  char* ws = p.ws;
  const float* invU = (const float*)(ws + OFF_INVU);
  const float* invV = (const float*)(ws + OFF_INVV);
  const int* elist = (const int*)(ws + OFF_ELIST);
  float* glist = (float*)(ws + OFF_GLIST);
  const float* pd = (const float*)(ws + OFF_PD);
  const int lane = threadIdx.x & 63, w = threadIdx.x >> 6;
  for (int t = blockIdx.x * 4 + w; t < NTOK; t += gridDim.x * 4) {
#pragma unroll
    for (int hf_ = 0; hf_ < 2; ++hf_) {
      const int k = hf_ * 64 + lane;
      float d = 0.f;
#pragma unroll
      for (int s = 0; s < 8; ++s) d += pd[(size_t)t * 1024 + s * 128 + k];
      const int e = elist[(size_t)t * 128 + k];
      const float g = glist[(size_t)t * 128 + k];
      ((unsigned*)glist)[(size_t)t * 128 + k] = (pack2(0.f, g * geluf_(d * invU[e]) * invV[e]) & 0xFFFF0000u) | (unsigned)e;
    }
  }
}
DI void phase15(const Params& p) { sliced_pass<1>(p); }
DI void phase16(const Params& p) {
  const int lane = threadIdx.x & 63, w = threadIdx.x >> 6;
  for (int tok = blockIdx.x * 4 + w; tok < NTOK; tok += gridDim.x * 4) {
    float* xr = p.out + (size_t)tok * DM;
    float4 xv[4];
    float ss = 0.f;
#pragma unroll
    for (int i = 0; i < 4; ++i) {
      xv[i] = *(const float4*)(xr + (i * 64 + lane) * 4);
      ss += xv[i].x * xv[i].x + xv[i].y * xv[i].y + xv[i].z * xv[i].z + xv[i].w * xv[i].w;
    }
    ss = wsum(ss);
    const float rstd = rsqrtf(ss * (1.f / 1024.f) + 1e-6f);
#pragma unroll
    for (int i = 0; i < 4; ++i) {
      const int e = (i * 64 + lane) * 4;
      float4 nf = *(const float4*)(p.norm_final + e);
      *(float4*)(xr + e) = make_float4(xv[i].x * rstd * nf.x, xv[i].y * rstd * nf.y, xv[i].z * rstd * nf.z, xv[i].w * rstd * nf.w);
    }
  }
}

#define XB_TMO      128
#define XB_XCNT(j)  (256  + 64 * (j))
#define XB_XSUB(j)  (1280 + 64 * (j))
#define XB_XGEN(j)  (2304 + 64 * (j))
#define XB_TOP      3328
#define XB_TOPGEN   3392
#define XCD_BAR_WORDS 3456
#define XB_SPIN_CAP (1u << 22)
#define LAS __attribute__((address_space(3)))
DI unsigned xb_ld(unsigned* p) { return __hip_atomic_load(p, __ATOMIC_RELAXED, __HIP_MEMORY_SCOPE_AGENT); }
DI unsigned xb_add(unsigned* p, unsigned v) { return __hip_atomic_fetch_add(p, v, __ATOMIC_RELAXED, __HIP_MEMORY_SCOPE_AGENT); }
DI unsigned xb_xcc_id() { return (unsigned)__builtin_amdgcn_s_getreg((3 << 11) | 20) & 0xFu; }
#define XB_SPIN(cond, bar) do { unsigned _sp = 0; while (cond) { __builtin_amdgcn_s_sleep(1); \
    if ((++_sp & 255u) == 0u) { if (xb_ld(&(bar)[XB_TMO])) break; if (_sp > XB_SPIN_CAP) { atomicAdd(&(bar)[XB_TMO], 1u); break; } } } } while (0)
struct XcdBarrier { unsigned* bar; unsigned x; volatile LAS unsigned* st; };
DI XcdBarrier xcd_barrier_post(unsigned* bar, volatile LAS unsigned* st) {
  XcdBarrier b; b.bar = bar; b.x = xb_xcc_id(); b.st = st;
  if (threadIdx.x == 0) (void)xb_add(&bar[XB_XCNT(b.x)], 1u);
  return b;
}
DI void xcd_barrier_complete(unsigned* bar, unsigned x, unsigned& nloc, unsigned& nx) {
  const unsigned G = gridDim.x * gridDim.y * gridDim.z;
  unsigned sum, cnt, mine, sp = 0u;
  for (;;) {
    sum = 0u; cnt = 0u; mine = 0u;
#pragma unroll
    for (unsigned j = 0; j < 16; ++j) { const unsigned c = xb_ld(&bar[XB_XCNT(j)]); sum += c; cnt += (c > 0u) ? 1u : 0u; mine = (j == x) ? c : mine; }
    if (sum == G) break;
    __builtin_amdgcn_s_sleep(1);
    if ((++sp & 255u) == 0u) { if (xb_ld(&bar[XB_TMO])) break; if (sp > XB_SPIN_CAP) { atomicAdd(&bar[XB_TMO], 1u); break; } }
  }
  nloc = mine > 0u ? mine : 1u; nx = cnt > 0u ? cnt : 1u;
}
DI void xcd_barrier(const XcdBarrier& b) {
  asm volatile("s_waitcnt vmcnt(0)" ::: "memory");
  __syncthreads();
  if (threadIdx.x == 0) {
    unsigned* bar = b.bar;
    __builtin_amdgcn_s_waitcnt(0);
    unsigned nloc = b.st[0], nx = b.st[1];
    if (nloc == 0u) { xcd_barrier_complete(bar, b.x, nloc, nx); b.st[0] = nloc; b.st[1] = nx; }
    const unsigned old = xb_add(&bar[XB_XSUB(b.x)], 1u);
    const unsigned gen = old / nloc;
    if (old + 1u == (gen + 1u) * nloc) {
      __builtin_amdgcn_fence(__ATOMIC_RELEASE, "agent");
      asm volatile("s_waitcnt vmcnt(0)" ::: "memory");
      const unsigned og = xb_add(&bar[XB_TOP], 1u);
      const unsigned tg = og / nx;
      if (og + 1u == (tg + 1u) * nx) xb_add(&bar[XB_TOPGEN], 1u);
      else XB_SPIN(xb_ld(&bar[XB_TOPGEN]) == tg, bar);
      __builtin_amdgcn_fence(__ATOMIC_ACQUIRE, "agent");
      xb_add(&bar[XB_XGEN(b.x)], 1u);
      asm volatile("s_waitcnt vmcnt(0)" ::: "memory");
    } else {
      XB_SPIN(xb_ld(&bar[XB_XGEN(b.x)]) == gen, bar);
      __builtin_amdgcn_fence(__ATOMIC_ACQUIRE, "agent");
      asm volatile("s_waitcnt vmcnt(0)" ::: "memory");
    }
  }
  __syncthreads();
}

#ifdef ONLY_PHASE
#define RUNPH(n, call) if (ONLY_PHASE == n) { call; }
#else
#ifndef DUP_PHASE
#define DUP_PHASE -1
#endif
#define RUNPH(n, call) if (lo <= n && n < hi) { call; if (n == DUP_PHASE) { xcd_barrier(xb); call; } if (n + 1 < hi) xcd_barrier(xb); }
#endif
__global__ void __launch_bounds__(256, 2) mega(Params p, int lo, int hi) {
  __shared__ __attribute__((aligned(16))) char smem[SMEM_BYTES];
  __shared__ uint4 xb_words;
  cg::grid_group grid = cg::this_grid();
  if (lo < 0) grid.sync();
  if (threadIdx.x == 0) xb_words = make_uint4(0u, 0u, 0u, 0u);
  __syncthreads();
  XcdBarrier xb = xcd_barrier_post((unsigned*)(p.ws + OFF_BAR), (volatile LAS unsigned*)&xb_words);
  RUNPH(0, phase0(p, smem))
  RUNPH(1, phase1(p, smem))
  RUNPH(2, phase2(p, smem))
  RUNPH(3, phase3(p, smem))
  RUNPH(4, phase4(p))
  RUNPH(5, phase5(p, smem))
  RUNPH(6, phase6(p, smem))
  RUNPH(7, phase7(p, smem))
  RUNPH(8, phase8(p, smem))
  RUNPH(9, phase9(p, smem))
  RUNPH(10, phase10(p, smem))
  RUNPH(11, phase11(p, smem))
  RUNPH(12, phase12(p, smem))
  RUNPH(13, phase13(p))
  RUNPH(14, phase14(p))
  RUNPH(15, phase15(p))
  RUNPH(16, phase16(p))
}

extern "C" void kernel_launch(void* const* d_in, const int* in_sizes, int n_in, void* d_out, int out_size, void* d_ws,
                              size_t ws_size, hipStream_t stream) {
  static int grid_blocks = 0;
  if (!grid_blocks) {
    int dev = 0, cus = 0, per_cu = 0;
    hipGetDevice(&dev);
    hipDeviceGetAttribute(&cus, hipDeviceAttributeMultiprocessorCount, dev);
    hipOccupancyMaxActiveBlocksPerMultiprocessor(&per_cu, mega, 256, 0);
    if (per_cu > 2) per_cu = 2;
    if (per_cu < 1) per_cu = 1;
    grid_blocks = cus * per_cu;
  }
  Params p{};
  const float** pp = (const float**)&p;
  for (int i = 0; i < 29; ++i) pp[i] = (const float*)d_in[i];
  p.out = (float*)d_out;
  p.ws = (char*)d_ws;
#if N_LAUNCH_SPLIT
  for (int ph = 0; ph < NPHASE; ++ph) {
    hipLaunchKernelGGL(mega, dim3(grid_blocks), dim3(256), 0, stream, p, ph, ph + 1);
  }
#else
  hipMemsetAsync((char*)d_ws + OFF_MOD, 0, (OFF_BAR - OFF_MOD) + XCD_BAR_WORDS * sizeof(unsigned), stream);
  int lo = 0, hi = NPHASE;
  void* args[] = {&p, &lo, &hi};
  hipError_t e = hipLaunchCooperativeKernel((void*)mega, dim3(grid_blocks), dim3(256), args, 0, stream);
  if (e != hipSuccess) fprintf(stderr, "cooperative launch failed: %s (grid %d)\n", hipGetErrorString(e), grid_blocks);
#endif
}
```

```cpp
#include <hip/hip_runtime.h>
#include <hip/hip_cooperative_groups.h>
#include <cstdio>
namespace cg = cooperative_groups;

#define DI __device__ __forceinline__
typedef unsigned short bf16_t;
using bf16x8 = __attribute__((ext_vector_type(8))) short;
using f32x4 = __attribute__((ext_vector_type(4))) float;
using u32x4 = __attribute__((ext_vector_type(4))) unsigned;
using u32x2 = __attribute__((ext_vector_type(2))) unsigned;

#ifndef N_LAUNCH_SPLIT
#define N_LAUNCH_SPLIT 0
#endif

constexpr int NTOK = 20480, NPT = 4096, DM = 1024;
constexpr int NPHASE = 17;
constexpr size_t MiB = 1u << 20;
constexpr size_t OFF_WINT = 0, OFF_WUQT = 9 * MiB, OFF_WUKVT = 9 * MiB + 512 * 1024, OFF_WUPAT = 10 * MiB,
                 OFF_WUPBT = 11 * MiB, OFF_WOT = 12 * MiB, OFF_WCT = 14 * MiB, OFF_WPQB = 18 * MiB,
                 OFF_KEYSB = 22 * MiB, OFF_MOD = 22 * MiB + 512 * 1024, OFF_BAR = 22 * MiB + 768 * 1024, OFF_ROPE = 23 * MiB, A0 = 24 * MiB;
constexpr size_t OFF_PD = A0 + 104 * MiB, OFF_H1 = A0 + 0, OFF_CQ = A0 + 40 * MiB, OFF_CKVRAW = A0 + 50 * MiB, OFF_KRRAW = A0 + 60 * MiB,
                 OFF_RQ = A0 + 63 * MiB, OFF_RK = A0 + 83 * MiB, OFF_KT = A0 + 103 * MiB, OFF_VT = A0 + 123 * MiB,
                 OFF_SRG = A0 + 143 * MiB, OFF_CKVALL = A0 + 163 * MiB, OFF_KRALL = A0 + 169 * MiB,
                 OFF_UF = A0 + 171 * MiB, OFF_UB = A0 + 187 * MiB,
                 OFF_SF = A0 + 0, OFF_SB = A0 + 8 * MiB, OFF_RET = A0 + 16 * MiB,
                 OFF_Q = A0 + 63 * MiB, OFF_KN = A0 + 93 * MiB, OFF_VTA = A0 + 117 * MiB, OFF_ATTN = A0 + 141 * MiB,
                 OFF_M = A0 + 163 * MiB,
                 OFF_H2 = A0 + 56 * MiB, OFF_TABU = A0 + 36 * MiB, OFF_TABV = A0 + 0, OFF_INVU = A0 + 52 * MiB,
                 OFF_INVV = A0 + 53 * MiB, OFF_ELIST = A0 + 16 * MiB, OFF_GLIST = A0 + 26 * MiB, OFF_SCORES = A0 + 104 * MiB;
constexpr size_t OUT_CKV = 20971520, OUT_KR = 21495808, OUT_SF = 21626880, OUT_SB = 22675456;
constexpr int NKV = 24576;
constexpr int SMEM_BYTES = 73728;

struct Params {
  const float *x_prompt, *x_sample, *c, *cache_ckv, *cache_krope, *st_f, *st_b, *c_ctx, *w_mod, *b_mod, *norm_mix,
      *norm_ffn, *norm_final, *w_in, *q_norm, *kv_norm, *w_uq, *w_ukv, *lg_f, *lg_b, *ret_gn, *w_up_a, *w_up_b, *w_o,
      *peer_wq, *keys1, *keys2, *peer_u, *peer_v;
  float* out;
  char* ws;
};

DI unsigned f2bf(float x) {
  unsigned u = __float_as_uint(x);
  u += 0x7fffu + ((u >> 16) & 1u);
  return u >> 16;
}
DI float bf2f(unsigned b) { return __uint_as_float(b << 16); }
typedef __bf16 hbf16x2_t __attribute__((ext_vector_type(2)));
typedef float hf32x2_t __attribute__((ext_vector_type(2)));
DI unsigned pack2(float a, float b) {
  hf32x2_t f = {a, b};
  return __builtin_bit_cast(unsigned, __builtin_convertvector(f, hbf16x2_t));
}
DI float ex2(float x) { return __builtin_amdgcn_exp2f(x); }
DI float bflo(unsigned u) { return __uint_as_float(u << 16); }
DI float bfhi(unsigned u) { return __uint_as_float(u & 0xffff0000u); }
DI float wsum(float v) {
#pragma unroll
  for (int o = 32; o > 0; o >>= 1) v += __shfl_xor(v, o);
  return v;
}
DI float sigmoidf_(float x) { return __builtin_amdgcn_rcpf(1.f + __builtin_amdgcn_exp2f(-1.4426950408889634f * x)); }
DI float siluf_(float x) { return x * __builtin_amdgcn_rcpf(1.f + __builtin_amdgcn_exp2f(-1.4426950408889634f * x)); }
DI float geluf_(float x) { return 0.5f * x * (1.f + tanhf(0.7978845608028654f * (x + 0.044715f * x * x * x))); }
DI const float* xrow(const Params& p, int tok) {
  return tok < NPT ? p.x_prompt + (size_t)tok * DM : p.x_sample + (size_t)(tok - NPT) * DM;
}
DI int modidx(int tok) { return tok < NPT ? 0 : 1 + ((tok - NPT) >> 11); }
DI int kvrow(int tok) {
  if (tok < NPT) return tok;
  int t = tok - NPT;
  return NPT + (t >> 11) * 2560 + (t & 2047);
}
DI void st_bf16x16(bf16_t* dst, const float (&v)[16]) {
  u32x4 a, b;
  a[0] = pack2(v[0], v[1]); a[1] = pack2(v[2], v[3]); a[2] = pack2(v[4], v[5]); a[3] = pack2(v[6], v[7]);
  b[0] = pack2(v[8], v[9]); b[1] = pack2(v[10], v[11]); b[2] = pack2(v[12], v[13]); b[3] = pack2(v[14], v[15]);
  *(u32x4*)dst = a;
  *(u32x4*)(dst + 8) = b;
}
DI void st_f32x16(float* dst, const float (&v)[16]) {
#pragma unroll
  for (int i = 0; i < 4; ++i) *(float4*)(dst + 4 * i) = make_float4(v[4 * i], v[4 * i + 1], v[4 * i + 2], v[4 * i + 3]);
}
DI void ld_bf16x16(const bf16_t* src, float (&v)[16]) {
  u32x4 a = *(const u32x4*)src, b = *(const u32x4*)(src + 8);
#pragma unroll
  for (int i = 0; i < 4; ++i) {
    v[2 * i] = bflo(a[i]); v[2 * i + 1] = bfhi(a[i]);
    v[8 + 2 * i] = bflo(b[i]); v[8 + 2 * i + 1] = bfhi(b[i]);
  }
}

constexpr int LDK = 64;
DI void gemm_issue0(const bf16_t* __restrict__ A, int lda, const bf16_t* __restrict__ B, int ldb, u32x4 (&ra)[4], u32x4 (&rb)[4]) {
  const int tid = threadIdx.x;
#pragma unroll
  for (int i = 0; i < 4; ++i) {
    const int c = tid + 256 * i;
    const int r = c >> 3, k8 = (c & 7) * 8;
    ra[i] = *(const u32x4*)(A + (size_t)r * lda + k8);
    rb[i] = *(const u32x4*)(B + (size_t)r * ldb + k8);
  }
}
template <int SCALE>
DI void gemm_kloop_pre(f32x4 (&acc)[4][4], const bf16_t* __restrict__ A, int lda, const bf16_t* __restrict__ B, int ldb,
                       int K, char* smem, float sc_a, float sc_b, u32x4 (&ra)[4], u32x4 (&rb)[4]) {
  bf16_t* As = (bf16_t*)smem;
  bf16_t* Bs = As + 128 * LDK;
  const int tid = threadIdx.x, lane = tid & 63, w = tid >> 6, wm = w >> 1, wn = w & 1, l15 = lane & 15, g = lane >> 4;
  int arow[4], kc[4], ldsa[4], ldsb[4];
#pragma unroll
  for (int i = 0; i < 4; ++i) {
    int c = tid + 256 * i;
    int r = c >> 3;
    kc[i] = (c & 7) * 8;
    arow[i] = r;
    int rr = r & 63;
    int rho = (r & 64) | (((rr >> 2) & 3) << 4) | ((rr >> 4) << 2) | (rr & 3);
    ldsa[i] = rho * LDK + (((c & 7) ^ ((rho >> 1) & 7)) * 8);
    ldsb[i] = r * LDK + (((c & 7) ^ ((r >> 1) & 7)) * 8);
  }
  __syncthreads();
#pragma unroll
  for (int i = 0; i < 4; ++i) {
    *(u32x4*)(As + ldsa[i]) = ra[i];
    *(u32x4*)(Bs + ldsb[i]) = rb[i];
  }
  if (64 < K) {
#pragma unroll
    for (int i = 0; i < 4; ++i) {
      ra[i] = *(const u32x4*)(A + (size_t)arow[i] * lda + 64 + kc[i]);
      rb[i] = *(const u32x4*)(B + (size_t)arow[i] * ldb + 64 + kc[i]);
    }
  }
  __syncthreads();
  int buf = 0;
  for (int k0 = 0; k0 < K; k0 += 64, buf ^= 1) {
    const bf16_t* Ac = As + buf * (256 * LDK);
    const bf16_t* Bc = Bs + buf * (256 * LDK);
#pragma unroll
    for (int ks = 0; ks < 2; ++ks) {
      bf16x8 af[4], bfr[4];
#pragma unroll
      for (int f = 0; f < 4; ++f)
        af[f] = *(const bf16x8*)(Ac + (wm * 64 + f * 16 + l15) * LDK + (((ks * 4 + g) ^ (l15 >> 1)) * 8));
#pragma unroll
      for (int c = 0; c < 4; ++c)
        bfr[c] = *(const bf16x8*)(Bc + (wn * 64 + c * 16 + l15) * LDK + (((ks * 4 + g) ^ (l15 >> 1)) * 8));
      if (SCALE) {
        float fac[8];
#pragma unroll
        for (int i = 0; i < 8; ++i) fac[i] = ex2(sc_a + sc_b * (float)(k0 + ks * 32 + g * 8 + i));
#pragma unroll
        for (int f = 0; f < 4; ++f) {
          u32x4 u = __builtin_bit_cast(u32x4, af[f]);
#pragma unroll
          for (int i = 0; i < 4; ++i) u[i] = pack2(bflo(u[i]) * fac[2 * i], bfhi(u[i]) * fac[2 * i + 1]);
          af[f] = __builtin_bit_cast(bf16x8, u);
        }
      }
#pragma unroll
      for (int f = 0; f < 4; ++f)
#pragma unroll
        for (int c = 0; c < 4; ++c) acc[f][c] = __builtin_amdgcn_mfma_f32_16x16x32_bf16(af[f], bfr[c], acc[f][c], 0, 0, 0);
    }
    if (k0 + 64 < K) {
      bf16_t* An = As + (buf ^ 1) * (256 * LDK);
      bf16_t* Bn = Bs + (buf ^ 1) * (256 * LDK);
#pragma unroll
      for (int i = 0; i < 4; ++i) {
        *(u32x4*)(An + ldsa[i]) = ra[i];
        *(u32x4*)(Bn + ldsb[i]) = rb[i];
      }
      if (k0 + 128 < K) {
#pragma unroll
        for (int i = 0; i < 4; ++i) {
          ra[i] = *(const u32x4*)(A + (size_t)arow[i] * lda + k0 + 128 + kc[i]);
          rb[i] = *(const u32x4*)(B + (size_t)arow[i] * ldb + k0 + 128 + kc[i]);
        }
      }
      __syncthreads();
    }
  }
}
template <int SCALE>
DI void gemm_kloop(f32x4 (&acc)[4][4], const bf16_t* __restrict__ A, int lda, const bf16_t* __restrict__ B, int ldb,
                   int K, char* smem, float sc_a, float sc_b) {
  u32x4 ra[4], rb[4];
  gemm_issue0(A, lda, B, ldb, ra, rb);
  gemm_kloop_pre<SCALE>(acc, A, lda, B, ldb, K, smem, sc_a, sc_b, ra, rb);
}
DI void acc_zero(f32x4 (&acc)[4][4]) {
#pragma unroll
  for (int f = 0; f < 4; ++f)
#pragma unroll
    for (int c = 0; c < 4; ++c) acc[f][c] = f32x4{0.f, 0.f, 0.f, 0.f};
}
template <class F>
DI void epilogue(const f32x4 (&acc)[4][4], F&& epi) {
  const int tid = threadIdx.x, lane = tid & 63, w = tid >> 6, wm = w >> 1, wn = w & 1, l15 = lane & 15, g = lane >> 4;
#pragma unroll
  for (int c = 0; c < 4; ++c) {
    float v[16];
#pragma unroll
    for (int f = 0; f < 4; ++f)
#pragma unroll
      for (int j = 0; j < 4; ++j) v[f * 4 + j] = acc[f][c][j];
    epi(wm * 64 + 16 * g, wn * 64 + c * 16 + l15, v);
  }
}
DI bool tile_map(int it, int Ft, int Tt, int fsplit, int& ft, int& tt) {
  const int bid = blockIdx.x, nb = gridDim.x;
  int xcd = bid & 7, loc = bid >> 3, nloc = nb >> 3;
  if (loc >= nloc) return false;
  int fg = xcd % fsplit, tg = xcd / fsplit, tsplit = 8 / fsplit;
  int Fg = Ft / fsplit, Tg = Tt / tsplit;
  int i = loc + it * nloc;
  if (i >= Fg * Tg) return false;
  ft = fg * Fg + i % Fg;
  tt = tg * Tg + i / Fg;
  return true;
}
DI int vbid() {
  const int bid = blockIdx.x, nb = gridDim.x;
  if (nb & 7) return bid;
  return (bid & 7) * (nb >> 3) + (bid >> 3);
}

DI int colmap(int mode, int np) {
  if (mode == 1) return np < 416 ? np : (np < 512 ? -1 : np - 96);
  if (mode == 2) return np < 512 ? ((np >> 6) * 128 + (np & 63)) : (((np - 512) >> 6) * 128 + 64 + ((np - 512) & 63));
  return np;
}
DI void tconv_tile(const float* __restrict__ src, int ldsrc, bf16_t* __restrict__ dst, int K, int kt, int nt, int mode,
                   char* smem) {
  float* lds = (float*)smem;
  int tid = threadIdx.x;
  asm volatile("" : "+v"(tid));
  {
    int col = tid & 63, rq = tid >> 6;
    int n = colmap(mode, nt * 64 + col);
#pragma unroll 4
    for (int r = 0; r < 16; ++r) {
      int kl = r * 4 + rq;
      float v = n >= 0 ? src[(size_t)(kt * 64 + kl) * ldsrc + n] : 0.f;
      lds[kl * 65 + col] = v;
    }
  }
  __syncthreads();
  {
    int nl = tid >> 2, kq = (tid & 3) * 16;
    float v[16];
#pragma unroll
    for (int i = 0; i < 16; ++i) v[i] = lds[(kq + i) * 65 + nl];
    st_bf16x16(dst + (size_t)(nt * 64 + nl) * K + kt * 64 + kq, v);
  }
  __syncthreads();
}
DI void mod_item(const Params& p, int item, char* smem) {
  float* sil = (float*)smem;
  int tid = threadIdx.x;
  asm volatile("" : "+v"(tid));
  const int cg_ = item >> 2, slab = item & 3, kbase = slab * 256;
  for (int i = tid; i < 9 * 256; i += 256) {
    int j = i >> 8, k = kbase + (i & 255);
    float cv = j == 0 ? p.c_ctx[k] : p.c[(j - 1) * 1024 + k];
    sil[i] = siluf_(cv);
  }
  __syncthreads();
  const int kq = tid >> 6, nn = tid & 63, n0 = cg_ * 64;
  float acc[9];
#pragma unroll
  for (int j = 0; j < 9; ++j) acc[j] = 0.f;
#pragma unroll 1
  for (int i0 = 0; i0 < 64; i0 += 16) {
    float wv[16];
#pragma unroll
    for (int i = 0; i < 16; ++i) wv[i] = p.w_mod[(size_t)(kbase + kq + 4 * (i0 + i)) * 6144 + n0 + nn];
#pragma unroll
    for (int i = 0; i < 16; ++i)
#pragma unroll
      for (int j = 0; j < 9; ++j) acc[j] += sil[j * 256 + kq + 4 * (i0 + i)] * wv[i];
  }
  __syncthreads();
  float* part = (float*)smem + 9 * 256;
#pragma unroll
  for (int j = 0; j < 9; ++j) part[(kq * 9 + j) * 64 + nn] = acc[j];
  __syncthreads();
  float* mod = (float*)(p.ws + OFF_MOD);
  for (int i = tid; i < 9 * 64; i += 256) {
    int j = i >> 6, n = i & 63;
    float s = part[(0 * 9 + j) * 64 + n] + part[(1 * 9 + j) * 64 + n] + part[(2 * 9 + j) * 64 + n] + part[(3 * 9 + j) * 64 + n];
    if (slab == 0) s += p.b_mod[n0 + n];
    atomicAdd(mod + j * 6144 + n0 + n, s);
  }
  __syncthreads();
}
DI void conv_flat(const float* __restrict__ src, bf16_t* __restrict__ dst, size_t n) {
  size_t i = ((size_t)blockIdx.x * 256 + threadIdx.x) * 8;
  const size_t stride = (size_t)gridDim.x * 256 * 8;
  for (; i < n; i += stride) {
    float4 a = *(const float4*)(src + i), b = *(const float4*)(src + i + 4);
    u32x4 o;
    o[0] = pack2(a.x, a.y); o[1] = pack2(a.z, a.w); o[2] = pack2(b.x, b.y); o[3] = pack2(b.z, b.w);
    *(u32x4*)(dst + i) = o;
  }
}
DI void phase0(const Params& p, char* smem) {
  const int bid = blockIdx.x, nb = gridDim.x;
  char* ws = p.ws;
  const int n_mod = 384;
  const int t_in = 16 * 72, t_uq = 4 * 12, t_ukv = 2 * 16, t_upa = 8 * 16, t_upb = 8 * 16, t_o = 16 * 16;
  const int total = n_mod + t_in;
  (void)t_uq; (void)t_ukv; (void)t_upa; (void)t_upb; (void)t_o;
  for (int it = bid; it < total; it += nb) {
    int i = it;
    if (i < n_mod) { mod_item(p, i, smem); continue; }
    i -= n_mod;
    tconv_tile(p.w_in, 4512, (bf16_t*)(ws + OFF_WINT), 1024, i / 72, i % 72, 1, smem);
  }
  conv_flat(p.peer_wq, (bf16_t*)(ws + OFF_WPQB), (size_t)1024 * 2048);
  {
    size_t i = ((size_t)bid * 256 + threadIdx.x) * 8;
    const size_t stride = (size_t)nb * 256 * 8;
    bf16_t* kb = (bf16_t*)(ws + OFF_KEYSB);
    for (; i < (size_t)2 * 131072; i += stride) {
      int half = i >= 131072;
      size_t s = i - (size_t)half * 131072;
      int h = (int)(s >> 14);
      size_t r = s & 16383;
      const float* src = (half ? p.keys2 : p.keys1) + s;
      float4 a = *(const float4*)(src), b = *(const float4*)(src + 4);
      u32x4 o;
      o[0] = pack2(a.x, a.y); o[1] = pack2(a.z, a.w); o[2] = pack2(b.x, b.y); o[3] = pack2(b.z, b.w);
      *(u32x4*)(kb + ((size_t)(h * 2 + half) << 14) + r) = o;
    }
  }
  {
    float2* rope = (float2*)(ws + OFF_ROPE);
    for (int idx = bid * 256 + threadIdx.x; idx < 2048 * 16; idx += nb * 256) {
      const int t = idx >> 4, a = idx & 15;
      const float pos = (a < 8) ? (float)(t >> 6) : (float)(t & 63);
      const float fr = exp2f(-(float)(a & 7) * 1.6609640474436813f);
      float sn, cs;
      sincosf(pos * fr, &sn, &cs);
      rope[idx] = make_float2(cs, sn);
    }
  }
}

DI void rows_norm_mod(const Params& p, const float* nw, int sh_off, int sc_off, bool from_out, bf16_t* dst) {
  const int lane = threadIdx.x & 63, w = threadIdx.x >> 6;
  const float* mod = (const float*)(p.ws + OFF_MOD);
  float4 nv[4];
#pragma unroll
  for (int i = 0; i < 4; ++i) nv[i] = *(const float4*)(nw + (i * 64 + lane) * 4);
  for (int tok = blockIdx.x * 4 + w; tok < NTOK; tok += gridDim.x * 4) {
    const float* xr = from_out ? p.out + (size_t)tok * DM : xrow(p, tok);
    const float* mj = mod + modidx(tok) * 6144;
    float4 xv[4], sh[4], sc[4];
    float ss = 0.f;
#pragma unroll
    for (int i = 0; i < 4; ++i) {
      const int e = (i * 64 + lane) * 4;
      xv[i] = *(const float4*)(xr + e);
      sh[i] = *(const float4*)(mj + sh_off + e);
      sc[i] = *(const float4*)(mj + sc_off + e);
    }
#pragma unroll
    for (int i = 0; i < 4; ++i) ss += xv[i].x * xv[i].x + xv[i].y * xv[i].y + xv[i].z * xv[i].z + xv[i].w * xv[i].w;
    ss = wsum(ss);
    float rstd = rsqrtf(ss * (1.f / 1024.f) + 1e-6f);
#pragma unroll
    for (int i = 0; i < 4; ++i) {
      int e = (i * 64 + lane) * 4;
      float h0 = (xv[i].x * rstd) * nv[i].x * (1.f + sc[i].x) + sh[i].x;
      float h1 = (xv[i].y * rstd) * nv[i].y * (1.f + sc[i].y) + sh[i].y;
      float h2 = (xv[i].z * rstd) * nv[i].z * (1.f + sc[i].z) + sh[i].z;
      float h3 = (xv[i].w * rstd) * nv[i].w * (1.f + sc[i].w) + sh[i].w;
      u32x2 o;
      o[0] = pack2(h0, h1); o[1] = pack2(h2, h3);
      *(u32x2*)(dst + (size_t)tok * DM + e) = o;
    }
  }
}
DI void phase1(const Params& p, char* smem) {
  rows_norm_mod(p, p.norm_mix, 0, 1024, false, (bf16_t*)(p.ws + OFF_H1));
}
DI void side_weights(const Params& p, char* smem, int rank, int nwork) {
  char* ws = p.ws;
  const int t_uq = 4 * 12, t_ukv = 2 * 16, t_upa = 8 * 16, t_upb = 8 * 16, t_o = 16 * 16, t_wc = 128;
  const int total = t_uq + t_ukv + t_upa + t_upb + t_o + t_wc;
  const bf16_t* wpq = (const bf16_t*)(ws + OFF_WPQB);
  const bf16_t* kb = (const bf16_t*)(ws + OFF_KEYSB);
  bf16_t* wct = (bf16_t*)(ws + OFF_WCT);
  for (int it = rank; it < total; it += nwork) {
    int i = it;
    if (i < t_wc) {
      int hh = i >> 3, mt = i & 7;
      f32x4 acc[4][4];
      acc_zero(acc);
      gemm_kloop<0>(acc, wpq + (size_t)(mt * 128) * 2048 + hh * 128, 2048, kb + (size_t)hh * 16384, 128, 128, smem, 0.f, 0.f);
      epilogue(acc, [&](int m, int n, float (&v)[16]) { st_bf16x16(wct + (size_t)(hh * 128 + n) * 1024 + mt * 128 + m, v); });
      __syncthreads();
      continue;
    }
    i -= t_wc;
    if (i < t_uq) { tconv_tile(p.w_uq, 768, (bf16_t*)(ws + OFF_WUQT), 256, i / 12, i % 12, 0, smem); continue; }
    i -= t_uq;
    if (i < t_ukv) { tconv_tile(p.w_ukv, 1024, (bf16_t*)(ws + OFF_WUKVT), 128, i / 16, i % 16, 2, smem); continue; }
    i -= t_ukv;
    if (i < t_upa) { tconv_tile(p.w_up_a, 1024, (bf16_t*)(ws + OFF_WUPAT), 512, i / 16, i % 16, 0, smem); continue; }
    i -= t_upa;
    if (i < t_upb) { tconv_tile(p.w_up_b, 1024, (bf16_t*)(ws + OFF_WUPBT), 512, i / 16, i % 16, 0, smem); continue; }
    i -= t_upb;
    tconv_tile(p.w_o, 1024, (bf16_t*)(ws + OFF_WOT), 1024, i / 16, i % 16, 0, smem);
  }
}

DI void phase2(const Params& p, char* smem) {
  char* ws = p.ws;
  const bf16_t* winT = (const bf16_t*)(ws + OFF_WINT);
  const bf16_t* h1 = (const bf16_t*)(ws + OFF_H1);
  bf16_t* cq = (bf16_t*)(ws + OFF_CQ);
  float* ckvraw = (float*)(ws + OFF_CKVRAW);
  float* krraw = (float*)(ws + OFF_KRRAW);
  bf16_t* rq = (bf16_t*)(ws + OFF_RQ);
  bf16_t* rk = (bf16_t*)(ws + OFF_RK);
  bf16_t* kT = (bf16_t*)(ws + OFF_KT);
  bf16_t* vT = (bf16_t*)(ws + OFF_VT);
  bf16_t* srg = (bf16_t*)(ws + OFF_SRG);
  bf16_t* sga = (bf16_t*)p.out;
  bf16_t* sgb = sga + (size_t)NTOK * 1024;
  u32x4 pra[4], prb[4];
  int ft, tt;
  bool have = tile_map(0, 36, 160, 4, ft, tt);
  if (have) {
    const bf16_t* W0 = winT + (size_t)ft * 128 * 1024;
    const bf16_t* H0 = h1 + (size_t)tt * 128 * 1024;
    const bool sw = ft >= 8 && ft < 16;
    gemm_issue0(sw ? H0 : W0, 1024, sw ? W0 : H0, 1024, pra, prb);
  }
  for (int it = 0; have; ++it) {
    f32x4 acc[4][4];
    acc_zero(acc);
    const bf16_t* W = winT + (size_t)ft * 128 * 1024;
    const bf16_t* H = h1 + (size_t)tt * 128 * 1024;
    const int tok0 = tt * 128, f0 = ft * 128;
    const bool swp = ft >= 8 && ft < 16;
    gemm_kloop_pre<0>(acc, swp ? H : W, 1024, swp ? W : H, 1024, 1024, smem, 0.f, 0.f, pra, prb);
    int ft2 = 0, tt2 = 0;
    const bool have2 = tile_map(it + 1, 36, 160, 4, ft2, tt2);
    if (have2) {
      const bf16_t* W2 = winT + (size_t)ft2 * 128 * 1024;
      const bf16_t* H2 = h1 + (size_t)tt2 * 128 * 1024;
      const bool sw2 = ft2 >= 8 && ft2 < 16;
      gemm_issue0(sw2 ? H2 : W2, 1024, sw2 ? W2 : H2, 1024, pra, prb);
    }
    if (ft >= 8 && ft < 16) {
      if (ft < 12) {
        epilogue(acc, [&](int m, int n, float (&v)[16]) {
          int feat = f0 - 1024 + n, tok = tok0 + m;
#pragma unroll
          for (int i = 0; i < 16; ++i) v[i] *= 0.08838834764831845f;
          st_bf16x16(kT + (size_t)feat * NTOK + tok, v);
#pragma unroll
          for (int i = 0; i < 16; ++i) rk[(size_t)(tok + i) * 512 + feat] = (bf16_t)f2bf(v[i]);
        });
      } else {
        epilogue(acc, [&](int m, int n, float (&v)[16]) {
          int feat = f0 - 1536 + n, tok = tok0 + m;
          st_bf16x16(vT + (size_t)feat * NTOK + tok, v);
        });
      }
    } else {
      if (ft < 2) {
        epilogue(acc, [&](int m, int n, float (&v)[16]) { st_bf16x16(cq + (size_t)(tok0 + n) * 256 + f0 + m, v); });
      } else if (ft == 2) {
        epilogue(acc, [&](int m, int n, float (&v)[16]) { st_f32x16(ckvraw + (size_t)(tok0 + n) * 128 + m, v); });
      } else if (ft == 3) {
        epilogue(acc, [&](int m, int n, float (&v)[16]) {
          if (m < 32) st_f32x16(krraw + (size_t)(tok0 + n) * 32 + m, v);
        });
      } else if (ft < 8) {
        epilogue(acc, [&](int m, int n, float (&v)[16]) { st_bf16x16(rq + (size_t)(tok0 + n) * 512 + f0 - 512 + m, v); });
      } else if (ft < 20) {
        epilogue(acc, [&](int m, int n, float (&v)[16]) {
#pragma unroll
          for (int i = 0; i < 16; ++i) v[i] = siluf_(v[i]);
          st_bf16x16(srg + (size_t)(tok0 + n) * 512 + f0 - 2048 + m, v);
        });
      } else if (ft < 28) {
        epilogue(acc, [&](int m, int n, float (&v)[16]) {
#pragma unroll
          for (int i = 0; i < 16; ++i) v[i] = sigmoidf_(v[i]);
          st_bf16x16(sga + (size_t)(tok0 + n) * 1024 + f0 - 2560 + m, v);
        });
      } else {
        epilogue(acc, [&](int m, int n, float (&v)[16]) {
#pragma unroll
          for (int i = 0; i < 16; ++i) v[i] = sigmoidf_(v[i]);
          st_bf16x16(sgb + (size_t)(tok0 + n) * 1024 + f0 - 3584 + m, v);
        });
      }
    }
    ft = ft2; tt = tt2; have = have2;
  }
  {
    const int nloc = gridDim.x >> 3, loc = blockIdx.x >> 3;
    const int rem = nloc > 0 ? (720 % nloc) : 0;
    if (nloc == 0 || rem == 0) side_weights(p, smem, blockIdx.x, gridDim.x);
    else if (loc >= rem && loc < nloc) side_weights(p, smem, (loc - rem) * 8 + (blockIdx.x & 7), (nloc - rem) * 8);
  }
}

DI float log2gamma(float logit) { return -log1pf(expf(-logit)) * 1.4426950408889634f; }
DI void phase3(const Params& p, char* smem) {
  char* ws = p.ws;
  const int lane = threadIdx.x & 63, w = threadIdx.x >> 6;
  bf16_t* cq = (bf16_t*)(ws + OFF_CQ);
  const float* ckvraw = (const float*)(ws + OFF_CKVRAW);
  const float* krraw = (const float*)(ws + OFF_KRRAW);
  bf16_t* ckvall = (bf16_t*)(ws + OFF_CKVALL);
  bf16_t* krall = (bf16_t*)(ws + OFF_KRALL);
  const int rstride = gridDim.x * 4;
  for (int tok0 = blockIdx.x * 4 + w; tok0 < NTOK; tok0 += 2 * rstride) {
    u32x2 uq[2];
    float2 vk[2];
    float own[2], partner[2];
    float2 csn[2];
#pragma unroll
    for (int q = 0; q < 2; ++q) {
      const int tok = (tok0 + q * rstride < NTOK) ? tok0 + q * rstride : tok0;
      uq[q] = *(const u32x2*)(cq + (size_t)tok * 256 + lane * 4);
      vk[q] = *(const float2*)(ckvraw + (size_t)tok * 128 + lane * 2);
      own[q] = krraw[(size_t)tok * 32 + (lane & 31)];
      partner[q] = krraw[(size_t)tok * 32 + ((lane & 31) ^ 16)];
      const int t = tok >= NPT ? ((tok - NPT) & 2047) : 0;
      csn[q] = ((const float2*)(ws + OFF_ROPE))[t * 16 + (lane & 15)];
    }
    const float4 nq = *(const float4*)(p.q_norm + lane * 4);
    const float2 nk = *(const float2*)(p.kv_norm + lane * 2);
#pragma unroll
    for (int q = 0; q < 2; ++q) {
      const int tok = tok0 + q * rstride;
      if (tok < NTOK) {
        {
          const u32x2 u = uq[q];
          float a0 = bflo(u[0]), a1 = bfhi(u[0]), a2 = bflo(u[1]), a3 = bfhi(u[1]);
          float ss = wsum(a0 * a0 + a1 * a1 + a2 * a2 + a3 * a3);
          float rstd = rsqrtf(ss * (1.f / 256.f) + 1e-6f);
          u32x2 o;
          o[0] = pack2(a0 * rstd * nq.x, a1 * rstd * nq.y);
          o[1] = pack2(a2 * rstd * nq.z, a3 * rstd * nq.w);
          *(u32x2*)(cq + (size_t)tok * 256 + lane * 4) = o;
        }
        const int row = kvrow(tok);
        {
          const float2 v = vk[q];
          float ss = wsum(v.x * v.x + v.y * v.y);
          float rstd = rsqrtf(ss * (1.f / 128.f) + 1e-6f);
          float o0 = v.x * rstd * nk.x, o1 = v.y * rstd * nk.y;
          if (tok < NPT) *(float2*)(p.out + OUT_CKV + (size_t)tok * 128 + lane * 2) = make_float2(o0, o1);
          *(unsigned*)(ckvall + (size_t)row * 128 + lane * 2) = pack2(o0, o1);
        }
        if (lane < 32) {
          float o = own[q];
          if (tok < NPT) {
            p.out[OUT_KR + (size_t)tok * 32 + lane] = own[q];
          } else {
            const float cs = csn[q].x, sn = csn[q].y;
            o = lane < 16 ? own[q] * cs - partner[q] * sn : partner[q] * sn + own[q] * cs;
          }
          krall[(size_t)row * 32 + lane] = (bf16_t)f2bf(o);
        }
      }
    }
  }
  for (int cr = blockIdx.x * 4 + w; cr < 4096; cr += rstride) {
    const int b = cr >> 9, pos = cr & 511;
    const int row = NPT + b * 2560 + 2048 + pos;
    float2 v = *(const float2*)(p.cache_ckv + (size_t)cr * 128 + lane * 2);
    *(unsigned*)(ckvall + (size_t)row * 128 + lane * 2) = pack2(v.x, v.y);
    if (lane < 32) krall[(size_t)row * 32 + lane] = (bf16_t)f2bf(p.cache_krope[(size_t)cr * 32 + lane]);
  }
  const bf16_t* kT = (const bf16_t*)(ws + OFF_KT);
  const bf16_t* vT = (const bf16_t*)(ws + OFF_VT);
  float* Uf = (float*)(ws + OFF_UF);
  float* Ub = (float*)(ws + OFF_UB);
  for (int it = blockIdx.x; it < 320; it += gridDim.x) {
    const int blk = it >> 2, h = it & 3;
    const float l2f = log2gamma(p.lg_f[h]), l2b = log2gamma(p.lg_b[h]);
    const bf16_t* Kp = kT + (size_t)(h * 128) * NTOK + blk * 256;
    const bf16_t* Vp = vT + (size_t)(h * 128) * NTOK + blk * 256;
#pragma unroll 1
    for (int dir = 0; dir < 2; ++dir) {
      const float sa = dir ? 0.f : l2f * 255.f, sb = dir ? l2b : -l2f;
      f32x4 acc[4][4];
      acc_zero(acc);
      if (blk < 16) {
        gemm_kloop<1>(acc, Vp, NTOK, Kp, NTOK, 256, smem, sa, sb);
        float* dst = p.out + (dir ? OUT_SB : OUT_SF) + (size_t)(blk * 4 + h) * 16384;
        epilogue(acc, [&](int m, int n, float (&v)[16]) { st_f32x16(dst + n * 128 + m, v); });
      } else {
        gemm_kloop<1>(acc, Kp, NTOK, Vp, NTOK, 256, smem, sa, sb);
        float* dst = (dir ? Ub : Uf) + (size_t)((blk - 16) * 4 + h) * 16384;
        epilogue(acc, [&](int m, int n, float (&v)[16]) { st_f32x16(dst + n * 128 + m, v); });
      }
    }
  }
}

DI void phase4(const Params& p) {
  char* ws = p.ws;
  const float* Uf = (const float*)(ws + OFF_UF);
  const float* Ub = (const float*)(ws + OFF_UB);
  bf16_t* Sf = (bf16_t*)(ws + OFF_SF);
  bf16_t* Sb = (bf16_t*)(ws + OFF_SB);
  for (int idx = blockIdx.x * 256 + threadIdx.x; idx < (1 << 20); idx += gridDim.x * 256) {
    int d = idx & 127, e = (idx >> 7) & 127, h = (idx >> 14) & 3, b = (idx >> 16) & 7, dir = idx >> 19;
    size_t eo = (size_t)e * 128 + d;
    if (dir == 0) {
      float cf = exp2f(log2gamma(p.lg_f[h]) * 256.f);
      float S = p.st_f[(size_t)(b * 4 + h) * 16384 + d * 128 + e];
#pragma unroll
      for (int blk = 0; blk < 8; ++blk) {
        size_t o = (size_t)((b * 8 + blk) * 4 + h) * 16384 + eo;
        Sf[o] = (bf16_t)f2bf(S);
        S = cf * S + Uf[o];
      }
    } else {
      float cb = exp2f(log2gamma(p.lg_b[h]) * 256.f);
      float S = p.st_b[(size_t)(b * 4 + h) * 16384 + d * 128 + e];
#pragma unroll
      for (int blk = 7; blk >= 0; --blk) {
        size_t o = (size_t)((b * 8 + blk) * 4 + h) * 16384 + eo;
        Sb[o] = (bf16_t)f2bf(S);
        S = cb * S + Ub[o];
      }
    }
  }
}

DI bf16x8 scale_frag(bf16x8 q, float s) {
  u32x4 u = __builtin_bit_cast(u32x4, q);
#pragma unroll
  for (int i = 0; i < 4; ++i) u[i] = pack2(bflo(u[i]) * s, bfhi(u[i]) * s);
  return __builtin_bit_cast(bf16x8, u);
}
constexpr int NQT = 1;
DI void phase5(const Params& p, char* smem) {
  char* ws = p.ws;
  const bf16_t* rq = (const bf16_t*)(ws + OFF_RQ);
  const bf16_t* rk = (const bf16_t*)(ws + OFF_RK);
  const bf16_t* vT = (const bf16_t*)(ws + OFF_VT);
  const bf16_t* srg = (const bf16_t*)(ws + OFF_SRG);
  const bf16_t* Sf = (const bf16_t*)(ws + OFF_SF);
  const bf16_t* Sb = (const bf16_t*)(ws + OFF_SB);
  bf16_t* ret = (bf16_t*)(ws + OFF_RET);
  bf16_t* Ks0 = (bf16_t*)smem;
  const int tid = threadIdx.x, lane = tid & 63, w = tid >> 6, l15 = lane & 15, g = lane >> 4;
  for (int item = vbid(); item < 640 * (2 / NQT); item += gridDim.x) {
    const int qb = item >> 2, h = item & 3, blk = (qb * NQT) >> 2;
    const float l2f = log2gamma(p.lg_f[h]), l2b = log2gamma(p.lg_b[h]);
    const int tokw = qb * (64 * NQT) + w * (16 * NQT);
    bf16x8 Q[NQT][4];
#pragma unroll
    for (int qt = 0; qt < NQT; ++qt)
#pragma unroll
      for (int ks = 0; ks < 4; ++ks)
        Q[qt][ks] = *(const bf16x8*)(rq + (size_t)(tokw + qt * 16 + l15) * 512 + h * 128 + ks * 32 + g * 8);
    f32x4 o[8][NQT];
#pragma unroll
    for (int et = 0; et < 8; ++et)
#pragma unroll
      for (int qt = 0; qt < NQT; ++qt) o[et][qt] = f32x4{0.f, 0.f, 0.f, 0.f};
    u32x4 rk_[4], rv_[4];
    auto gload = [&](int kt) {
      const int key0 = blk * 256 + kt * 64;
#pragma unroll
      for (int i = 0; i < 4; ++i) {
        int c = tid + 256 * i;
        int r = c >> 4, cc = (c & 15) * 8;
        rk_[i] = *(const u32x4*)(rk + (size_t)(key0 + r) * 512 + h * 128 + cc);
        int e = c >> 3, c2 = (c & 7) * 8;
        rv_[i] = *(const u32x4*)(vT + (size_t)(h * 128 + e) * NTOK + key0 + c2);
      }
    };
    auto lstore = [&](int b_) {
      bf16_t* Kd = Ks0 + b_ * 18432;
      bf16_t* Vd = Kd + 64 * 144;
#pragma unroll
      for (int i = 0; i < 4; ++i) {
        int c = tid + 256 * i;
        int r = c >> 4, cc = (c & 15) * 8;
        *(u32x4*)(Kd + r * 144 + cc) = rk_[i];
        int e = c >> 3, c2 = (c & 7) * 8;
        *(u32x4*)(Vd + e * 72 + c2) = rv_[i];
      }
    };
    gload(0);
    __syncthreads();
    lstore(0);
    gload(1);
    __syncthreads();
#pragma unroll 1
    for (int kt = 0; kt < 4; ++kt) {
      const bf16_t* Ks = Ks0 + (kt & 1) * 18432;
      const bf16_t* Vs = Ks + 64 * 144;
      bf16x8 P[NQT][2];
#pragma unroll
      for (int qt = 0; qt < NQT; ++qt) {
        f32x4 s[4];
#pragma unroll
        for (int kk = 0; kk < 4; ++kk) s[kk] = f32x4{0.f, 0.f, 0.f, 0.f};
#pragma unroll
        for (int ks = 0; ks < 4; ++ks) {
#pragma unroll
          for (int kk = 0; kk < 4; ++kk) {
            bf16x8 a = *(const bf16x8*)(Ks + (kk * 16 + l15) * 144 + ks * 32 + g * 8);
            s[kk] = __builtin_amdgcn_mfma_f32_16x16x32_bf16(a, Q[qt][ks], s[kk], 0, 0, 0);
          }
        }
        const int iq = (tokw + qt * 16 + l15) & 255;
#pragma unroll
        for (int kk = 0; kk < 4; ++kk) {
#pragma unroll
          for (int j = 0; j < 4; ++j) {
            int jk = kt * 64 + kk * 16 + 4 * g + j;
            int diff = iq - jk;
            float dm = diff > 0 ? ex2(l2f * (float)diff) : (diff < 0 ? ex2(l2b * (float)(-diff)) : 2.f);
            s[kk][j] *= dm;
          }
        }
#pragma unroll
        for (int k2 = 0; k2 < 2; ++k2) {
          u32x4 u;
          u[0] = pack2(s[2 * k2][0], s[2 * k2][1]);
          u[1] = pack2(s[2 * k2][2], s[2 * k2][3]);
          u[2] = pack2(s[2 * k2 + 1][0], s[2 * k2 + 1][1]);
          u[3] = pack2(s[2 * k2 + 1][2], s[2 * k2 + 1][3]);
          P[qt][k2] = __builtin_bit_cast(bf16x8, u);
        }
      }
#pragma unroll
      for (int k2 = 0; k2 < 2; ++k2) {
#pragma unroll
        for (int et = 0; et < 8; ++et) {
          u32x2 lo = *(const u32x2*)(Vs + (et * 16 + l15) * 72 + k2 * 32 + 4 * g);
          u32x2 hi = *(const u32x2*)(Vs + (et * 16 + l15) * 72 + k2 * 32 + 16 + 4 * g);
          u32x4 u;
          u[0] = lo[0]; u[1] = lo[1]; u[2] = hi[0]; u[3] = hi[1];
          bf16x8 a = __builtin_bit_cast(bf16x8, u);
#pragma unroll
          for (int qt = 0; qt < NQT; ++qt) o[et][qt] = __builtin_amdgcn_mfma_f32_16x16x32_bf16(a, P[qt][k2], o[et][qt], 0, 0, 0);
        }
      }
      if (kt + 1 < 4) {
        lstore((kt + 1) & 1);
        if (kt + 2 < 4) gload(kt + 2);
        __syncthreads();
      }
    }
    if (blk >= 16) {
      bf16_t* SL = (bf16_t*)smem;
      __syncthreads();
#pragma unroll
      for (int dir = 0; dir < 2; ++dir) {
        const bf16_t* S = (dir ? Sb : Sf) + (size_t)((blk - 16) * 4 + h) * 16384;
#pragma unroll
        for (int i = 0; i < 8; ++i) {
          int c = tid + 256 * i;
          int e = c >> 4, cc = (c & 15) * 8;
          *(u32x4*)(SL + dir * (128 * 144) + e * 144 + cc) = *(const u32x4*)(S + e * 128 + cc);
        }
      }
      __syncthreads();
#pragma unroll 1
      for (int dir = 0; dir < 2; ++dir) {
        const bf16_t* S = SL + dir * (128 * 144);
        float dq[NQT];
#pragma unroll
        for (int qt = 0; qt < NQT; ++qt) {
          int iq = (tokw + qt * 16 + l15) & 255;
          dq[qt] = dir ? exp2f(l2b * (float)(256 - iq)) : exp2f(l2f * (float)(iq + 1));
        }
#pragma unroll
        for (int ks = 0; ks < 4; ++ks) {
          bf16x8 qs[NQT];
#pragma unroll
          for (int qt = 0; qt < NQT; ++qt) qs[qt] = scale_frag(Q[qt][ks], dq[qt]);
#pragma unroll
          for (int et = 0; et < 8; ++et) {
            bf16x8 a = *(const bf16x8*)(S + (et * 16 + l15) * 144 + ks * 32 + g * 8);
#pragma unroll
            for (int qt = 0; qt < NQT; ++qt) o[et][qt] = __builtin_amdgcn_mfma_f32_16x16x32_bf16(a, qs[qt], o[et][qt], 0, 0, 0);
          }
        }
      }
    }
#pragma unroll
    for (int qt = 0; qt < NQT; ++qt) {
      const int tok = tokw + qt * 16 + l15;
      float s1 = 0.f;
#pragma unroll
      for (int et = 0; et < 8; ++et)
#pragma unroll
        for (int j = 0; j < 4; ++j) s1 += o[et][qt][j];
      s1 += __shfl_xor(s1, 16);
      s1 += __shfl_xor(s1, 32);
      const float mu = s1 * (1.f / 128.f);
      float s2 = 0.f;
#pragma unroll
      for (int et = 0; et < 8; ++et)
#pragma unroll
        for (int j = 0; j < 4; ++j) {
          float dlt = o[et][qt][j] - mu;
          s2 += dlt * dlt;
        }
      s2 += __shfl_xor(s2, 16);
      s2 += __shfl_xor(s2, 32);
      const float rstd = rsqrtf(s2 * (1.f / 128.f) + 1e-6f);
#pragma unroll
      for (int et = 0; et < 8; ++et) {
        const int e = h * 128 + et * 16 + 4 * g;
        float4 gn = *(const float4*)(p.ret_gn + e);
        u32x2 sg = *(const u32x2*)(srg + (size_t)tok * 512 + e);
        u32x2 ov;
        ov[0] = pack2((o[et][qt][0] - mu) * rstd * gn.x * bflo(sg[0]), (o[et][qt][1] - mu) * rstd * gn.y * bfhi(sg[0]));
        ov[1] = pack2((o[et][qt][2] - mu) * rstd * gn.z * bflo(sg[1]), (o[et][qt][3] - mu) * rstd * gn.w * bfhi(sg[1]));
        *(u32x2*)(ret + (size_t)tok * 512 + e) = ov;
      }
    }
  }
}

DI void phase6(const Params& p, char* smem) {
  char* ws = p.ws;
  const bf16_t* cqn = (const bf16_t*)(ws + OFF_CQ);
  const bf16_t* wuqT = (const bf16_t*)(ws + OFF_WUQT);
  bf16_t* q = (bf16_t*)(ws + OFF_Q);
  for (int it = 0;; ++it) {
    int ft, tt;
    if (!tile_map(it, 6, 160, 1, ft, tt)) break;
    f32x4 acc[4][4];
    acc_zero(acc);
    gemm_kloop<0>(acc, wuqT + (size_t)ft * 128 * 256, 256, cqn + (size_t)tt * 128 * 256, 256, 256, smem, 0.f, 0.f);
    epilogue(acc, [&](int m, int n, float (&v)[16]) { st_bf16x16(q + (size_t)(tt * 128 + n) * 768 + ft * 128 + m, v); });
  }
  const bf16_t* ckvall = (const bf16_t*)(ws + OFF_CKVALL);
  const bf16_t* wukvT = (const bf16_t*)(ws + OFF_WUKVT);
  bf16_t* Kn = (bf16_t*)(ws + OFF_KN);
  bf16_t* Vt = (bf16_t*)(ws + OFF_VTA);
  for (int it = 0;; ++it) {
    int ft, tt;
    if (!tile_map(it, 8, 192, 1, ft, tt)) break;
    f32x4 acc[4][4];
    acc_zero(acc);
    const bf16_t* W = wukvT + (size_t)ft * 128 * 128;
    const bf16_t* X = ckvall + (size_t)tt * 128 * 128;
    if (ft < 4) {
      gemm_kloop<0>(acc, W, 128, X, 128, 128, smem, 0.f, 0.f);
      epilogue(acc, [&](int m, int n, float (&v)[16]) { st_bf16x16(Kn + (size_t)(tt * 128 + n) * 512 + ft * 128 + m, v); });
    } else {
      gemm_kloop<0>(acc, X, 128, W, 128, 128, smem, 0.f, 0.f);
      epilogue(acc, [&](int m, int n, float (&v)[16]) { st_bf16x16(Vt + (size_t)((ft - 4) * 128 + n) * NKV + tt * 128 + m, v); });
    }
  }
}

DI void conv_fp8_rows(const float* __restrict__ src, unsigned char* __restrict__ dst, float* __restrict__ inv);
DI void phase7(const Params& p, char* smem) {
  char* ws = p.ws;
  const bf16_t* q = (const bf16_t*)(ws + OFF_Q);
  const bf16_t* Kn = (const bf16_t*)(ws + OFF_KN);
  const bf16_t* Vt = (const bf16_t*)(ws + OFF_VTA);
  const bf16_t* krall = (const bf16_t*)(ws + OFF_KRALL);
  bf16_t* attn = (bf16_t*)(ws + OFF_ATTN);
  bf16_t* Ks0 = (bf16_t*)smem;
  const int tid = threadIdx.x, lane = tid & 63, w = tid >> 6, l15 = lane & 15, g = lane >> 4;
  const float qscale = 0.10206207261596577f * 1.4426950408889634f;
  for (int item = vbid(); item < 1280; item += gridDim.x) {
    int b, h, qtok0, keyrow0, nkt;
    bool sample;
    if (item < 1024) {
      sample = true; b = item >> 7; h = (item >> 4) & 7; int qb = item & 15;
      qtok0 = NPT + b * 2048 + qb * 128; keyrow0 = NPT + b * 2560; nkt = 40;
    } else {
      int it2 = item - 1024;
      sample = false; b = it2 >> 4; h = (it2 >> 1) & 7; int qb = it2 & 1;
      qtok0 = b * 256 + qb * 128; keyrow0 = b * 256; nkt = 4;
    }
    bf16x8 Q[2][3];
#pragma unroll
    for (int qt = 0; qt < 2; ++qt) {
      const int tokq = qtok0 + w * 32 + qt * 16 + l15;
      const bf16_t* qp = q + (size_t)tokq * 768 + h * 96;
#pragma unroll
      for (int ks = 0; ks < 3; ++ks) {
        u32x4 u = *(const u32x4*)(qp + ks * 32 + g * 8);
        float v[8];
#pragma unroll
        for (int i = 0; i < 4; ++i) { v[2 * i] = bflo(u[i]); v[2 * i + 1] = bfhi(u[i]); }
        if (ks == 2 && sample) {
          u32x4 up = *(const u32x4*)(qp + 64 + (g ^ 2) * 8);
          float pv[8];
#pragma unroll
          for (int i = 0; i < 4; ++i) { pv[2 * i] = bflo(up[i]); pv[2 * i + 1] = bfhi(up[i]); }
          int t = (tokq - NPT) & 2047;
          const float4* rp = (const float4*)((const float2*)(ws + OFF_ROPE) + t * 16 + (g & 1) * 8);
#pragma unroll
          for (int i2 = 0; i2 < 4; ++i2) {
            const float4 c2 = rp[i2];
            const int i = 2 * i2;
            v[i] = g < 2 ? v[i] * c2.x - pv[i] * c2.y : pv[i] * c2.y + v[i] * c2.x;
            v[i + 1] = g < 2 ? v[i + 1] * c2.z - pv[i + 1] * c2.w : pv[i + 1] * c2.w + v[i + 1] * c2.z;
          }
        }
        u32x4 o4;
#pragma unroll
        for (int i = 0; i < 4; ++i) o4[i] = pack2(v[2 * i] * qscale, v[2 * i + 1] * qscale);
        Q[qt][ks] = __builtin_bit_cast(bf16x8, o4);
      }
    }
    f32x4 o[4][2];
#pragma unroll
    for (int et = 0; et < 4; ++et)
#pragma unroll
      for (int qt = 0; qt < 2; ++qt) o[et][qt] = f32x4{0.f, 0.f, 0.f, 0.f};
    float mrun[2] = {-1e30f, -1e30f}, lrun[2] = {0.f, 0.f};
    u32x4 rk_[3], rv_[2];
    auto gload = [&](int kt) {
      const int row0 = keyrow0 + kt * 64;
#pragma unroll
      for (int i = 0; i < 3; ++i) {
        int c = tid + 256 * i;
        int r = c / 12, cc = c - r * 12;
        rk_[i] = cc < 8 ? *(const u32x4*)(Kn + (size_t)(row0 + r) * 512 + h * 64 + cc * 8)
                        : *(const u32x4*)(krall + (size_t)(row0 + r) * 32 + (cc - 8) * 8);
      }
#pragma unroll
      for (int i = 0; i < 2; ++i) {
        int c = tid + 256 * i;
        int e = c >> 3, cc = (c & 7) * 8;
        rv_[i] = *(const u32x4*)(Vt + (size_t)(h * 64 + e) * NKV + row0 + cc);
      }
    };
    auto lstore = [&](int b) {
      bf16_t* Kd = Ks0 + b * 11776;
      bf16_t* Vd = Kd + 64 * 112;
#pragma unroll
      for (int i = 0; i < 3; ++i) {
        int c = tid + 256 * i;
        int r = c / 12, cc = c - r * 12;
        *(u32x4*)(Kd + r * 112 + cc * 8) = rk_[i];
      }
#pragma unroll
      for (int i = 0; i < 2; ++i) {
        int c = tid + 256 * i;
        int e = c >> 3, cc = (c & 7) * 8;
        *(u32x4*)(Vd + e * 72 + cc) = rv_[i];
      }
    };
    gload(0);
    __syncthreads();
    lstore(0);
    if (nkt > 1) gload(1);
    __syncthreads();
#pragma unroll 1
    for (int kt = 0; kt < nkt; ++kt) {
      const bf16_t* Ks = Ks0 + (kt & 1) * 11776;
      const bf16_t* Vs = Ks + 64 * 112;
      f32x4 s[4][2];
#pragma unroll
      for (int kk = 0; kk < 4; ++kk)
#pragma unroll
        for (int qt = 0; qt < 2; ++qt) s[kk][qt] = f32x4{0.f, 0.f, 0.f, 0.f};
#pragma unroll
      for (int ks = 0; ks < 3; ++ks) {
#pragma unroll
        for (int kk = 0; kk < 4; ++kk) {
          bf16x8 a = *(const bf16x8*)(Ks + (kk * 16 + l15) * 112 + ks * 32 + g * 8);
#pragma unroll
          for (int qt = 0; qt < 2; ++qt) s[kk][qt] = __builtin_amdgcn_mfma_f32_16x16x32_bf16(a, Q[qt][ks], s[kk][qt], 0, 0, 0);
        }
      }
      bf16x8 P[2][2];
#pragma unroll
      for (int qt = 0; qt < 2; ++qt) {
        float mx = s[0][qt][0];
#pragma unroll
        for (int kk = 0; kk < 4; ++kk)
#pragma unroll
          for (int j = 0; j < 4; ++j) mx = fmaxf(mx, s[kk][qt][j]);
        mx = fmaxf(mx, __shfl_xor(mx, 16));
        mx = fmaxf(mx, __shfl_xor(mx, 32));
        const float mnew = fmaxf(mrun[qt], mx);
        const bool grow = __ballot(mx > mrun[qt]) != 0ull;
        const float alpha = grow ? ex2(mrun[qt] - mnew) : 1.f;
        mrun[qt] = mnew;
        float ps = 0.f;
#pragma unroll
        for (int kk = 0; kk < 4; ++kk)
#pragma unroll
          for (int j = 0; j < 4; ++j) {
            float e_ = ex2(s[kk][qt][j] - mnew);
            s[kk][qt][j] = e_;
            ps += e_;
          }
        if (grow) {
          lrun[qt] = lrun[qt] * alpha + ps;
#pragma unroll
          for (int et = 0; et < 4; ++et)
#pragma unroll
            for (int j = 0; j < 4; ++j) o[et][qt][j] *= alpha;
        } else {
          lrun[qt] += ps;
        }
#pragma unroll
        for (int k2 = 0; k2 < 2; ++k2) {
          u32x4 u;
          u[0] = pack2(s[2 * k2][qt][0], s[2 * k2][qt][1]);
          u[1] = pack2(s[2 * k2][qt][2], s[2 * k2][qt][3]);
          u[2] = pack2(s[2 * k2 + 1][qt][0], s[2 * k2 + 1][qt][1]);
          u[3] = pack2(s[2 * k2 + 1][qt][2], s[2 * k2 + 1][qt][3]);
          P[qt][k2] = __builtin_bit_cast(bf16x8, u);
        }
      }
#pragma unroll
      for (int k2 = 0; k2 < 2; ++k2) {
#pragma unroll
        for (int et = 0; et < 4; ++et) {
          u32x2 lo = *(const u32x2*)(Vs + (et * 16 + l15) * 72 + k2 * 32 + 4 * g);
          u32x2 hi = *(const u32x2*)(Vs + (et * 16 + l15) * 72 + k2 * 32 + 16 + 4 * g);
          u32x4 u;
          u[0] = lo[0]; u[1] = lo[1]; u[2] = hi[0]; u[3] = hi[1];
          bf16x8 a = __builtin_bit_cast(bf16x8, u);
#pragma unroll
          for (int qt = 0; qt < 2; ++qt) o[et][qt] = __builtin_amdgcn_mfma_f32_16x16x32_bf16(a, P[qt][k2], o[et][qt], 0, 0, 0);
        }
      }
      if (kt + 1 < nkt) {
        lstore((kt + 1) & 1);
        if (kt + 2 < nkt) gload(kt + 2);
        __syncthreads();
      }
    }
#pragma unroll
    for (int qt = 0; qt < 2; ++qt) {
      const int tokq = qtok0 + w * 32 + qt * 16 + l15;
      float lt = lrun[qt];
      lt += __shfl_xor(lt, 16);
      lt += __shfl_xor(lt, 32);
      const float inv = 1.f / lt;
#pragma unroll
      for (int et = 0; et < 4; ++et) {
        u32x2 ov;
        ov[0] = pack2(o[et][qt][0] * inv, o[et][qt][1] * inv);
        ov[1] = pack2(o[et][qt][2] * inv, o[et][qt][3] * inv);
        *(u32x2*)(attn + (size_t)tokq * 512 + h * 64 + et * 16 + 4 * g) = ov;
      }
    }
  }
  conv_fp8_rows(p.peer_u, (unsigned char*)(p.ws + OFF_TABU), (float*)(p.ws + OFF_INVU));
  conv_fp8_rows(p.peer_v, (unsigned char*)(p.ws + OFF_TABV), (float*)(p.ws + OFF_INVV));
}

DI void phase8(const Params& p, char* smem) {
  char* ws = p.ws;
  const bf16_t* attn = (const bf16_t*)(ws + OFF_ATTN);
  const bf16_t* ret = (const bf16_t*)(ws + OFF_RET);
  const bf16_t* wa = (const bf16_t*)(ws + OFF_WUPAT);
  const bf16_t* wb = (const bf16_t*)(ws + OFF_WUPBT);
  const bf16_t* sga = (const bf16_t*)p.out;
  const bf16_t* sgb = sga + (size_t)NTOK * 1024;
  bf16_t* mbuf = (bf16_t*)(ws + OFF_M);
  const int tid = threadIdx.x, lane = tid & 63, w = tid >> 6, wm = w >> 1, wn = w & 1, l15 = lane & 15, g = lane >> 4;
  for (int it = 0;; ++it) {
    int ft, tt;
    if (!tile_map(it, 8, 160, 1, ft, tt)) break;
    f32x4 acc[4][4];
    acc_zero(acc);
    gemm_kloop<0>(acc, wa + (size_t)ft * 128 * 512, 512, attn + (size_t)tt * 128 * 512, 512, 512, smem, 0.f, 0.f);
#pragma unroll
    for (int c = 0; c < 4; ++c) {
      const size_t off = (size_t)(tt * 128 + wn * 64 + c * 16 + l15) * 1024 + ft * 128 + wm * 64 + 16 * g;
      float a[16], bq[16];
      ld_bf16x16(sga + off, a);
      ld_bf16x16(sgb + off, bq);
#pragma unroll
      for (int f = 0; f < 4; ++f)
#pragma unroll
        for (int j = 0; j < 4; ++j) acc[f][c][j] *= a[f * 4 + j] * __builtin_amdgcn_rcpf(fmaxf(bq[f * 4 + j], 1e-30f));
    }
    gemm_kloop<0>(acc, wb + (size_t)ft * 128 * 512, 512, ret + (size_t)tt * 128 * 512, 512, 512, smem, 0.f, 0.f);
    epilogue(acc, [&](int m, int n, float (&v)[16]) {
      const size_t off = (size_t)(tt * 128 + n) * 1024 + ft * 128 + m;
      float bq[16];
      ld_bf16x16(sgb + off, bq);
#pragma unroll
      for (int i = 0; i < 16; ++i) v[i] *= bq[i];
      st_bf16x16(mbuf + off, v);
    });
  }
}
DI void phase9(const Params& p, char* smem) {
  char* ws = p.ws;
  const bf16_t* mbuf = (const bf16_t*)(ws + OFF_M);
  const bf16_t* wo = (const bf16_t*)(ws + OFF_WOT);
  const float* mod = (const float*)(ws + OFF_MOD);
  u32x4 pra[4], prb[4];
  int ft, tt;
  bool have = tile_map(0, 8, 160, 1, ft, tt);
  if (have) gemm_issue0(wo + (size_t)ft * 128 * 1024, 1024, mbuf + (size_t)tt * 128 * 1024, 1024, pra, prb);
  for (int it = 0; have; ++it) {
    f32x4 acc[4][4];
    acc_zero(acc);
    gemm_kloop_pre<0>(acc, wo + (size_t)ft * 128 * 1024, 1024, mbuf + (size_t)tt * 128 * 1024, 1024, 1024, smem, 0.f, 0.f, pra, prb);
    int ft2 = 0, tt2 = 0;
    const bool have2 = tile_map(it + 1, 8, 160, 1, ft2, tt2);
    if (have2) gemm_issue0(wo + (size_t)ft2 * 128 * 1024, 1024, mbuf + (size_t)tt2 * 128 * 1024, 1024, pra, prb);
    epilogue(acc, [&](int m, int n, float (&v)[16]) {
      const int tok = tt * 128 + n, feat = ft * 128 + m;
      const float* xr = xrow(p, tok) + feat;
      const float* g1 = mod + modidx(tok) * 6144 + 2048 + feat;
#pragma unroll
      for (int i = 0; i < 4; ++i) {
        float4 xv = *(const float4*)(xr + 4 * i), gv = *(const float4*)(g1 + 4 * i);
        v[4 * i] = xv.x + gv.x * v[4 * i];
        v[4 * i + 1] = xv.y + gv.y * v[4 * i + 1];
        v[4 * i + 2] = xv.z + gv.z * v[4 * i + 2];
        v[4 * i + 3] = xv.w + gv.w * v[4 * i + 3];
      }
      st_f32x16(p.out + (size_t)tok * DM + feat, v);
    });
    ft = ft2; tt = tt2; have = have2;
  }
}
DI void conv_fp8_rows(const float* __restrict__ src, unsigned char* __restrict__ dst, float* __restrict__ inv) {
  const int lane = threadIdx.x & 63, w = threadIdx.x >> 6;
  for (int r = blockIdx.x * 4 + w; r < 16384; r += gridDim.x * 4) {
    const float* sp = src + (size_t)r * 1024 + lane * 16;
    float4 v[4];
    float am = 0.f;
#pragma unroll
    for (int i = 0; i < 4; ++i) {
      v[i] = *(const float4*)(sp + 4 * i);
      am = fmaxf(am, fmaxf(fmaxf(fabsf(v[i].x), fabsf(v[i].y)), fmaxf(fabsf(v[i].z), fabsf(v[i].w))));
    }
#pragma unroll
    for (int o = 32; o > 0; o >>= 1) am = fmaxf(am, __shfl_xor(am, o));
    const float sc = am > 0.f ? 448.f / am : 1.f;
    u32x4 o4;
#pragma unroll
    for (int i = 0; i < 4; ++i) {
      int wd = 0;
      wd = __builtin_amdgcn_cvt_pk_fp8_f32(v[i].x * sc, v[i].y * sc, wd, false);
      wd = __builtin_amdgcn_cvt_pk_fp8_f32(v[i].z * sc, v[i].w * sc, wd, true);
      o4[i] = (unsigned)wd;
    }
    *(u32x4*)(dst + ((size_t)(lane >> 3) * 16384 + r) * 128 + (lane & 7) * 16) = o4;
    if (lane == 0) inv[r] = am > 0.f ? am * (1.f / 448.f) : 1.f;
  }
}
DI void phase10(const Params& p, char* smem) {
  rows_norm_mod(p, p.norm_ffn, 3072, 4096, true, (bf16_t*)(p.ws + OFF_H2));
}
DI void phase11(const Params& p, char* smem) {
  char* ws = p.ws;
  const bf16_t* h2 = (const bf16_t*)(ws + OFF_H2);
  const bf16_t* wct = (const bf16_t*)(ws + OFF_WCT);
  bf16_t* sc = (bf16_t*)(ws + OFF_SCORES);
  u32x4 pra[4], prb[4];
  int ft, tt;
  bool have = tile_map(0, 16, 160, 2, ft, tt);
  if (have) gemm_issue0(wct + (size_t)ft * 128 * 1024, 1024, h2 + (size_t)tt * 128 * 1024, 1024, pra, prb);
  for (int it = 0; have; ++it) {
    f32x4 acc[4][4];
    acc_zero(acc);
    gemm_kloop_pre<0>(acc, wct + (size_t)ft * 128 * 1024, 1024, h2 + (size_t)tt * 128 * 1024, 1024, 1024, smem, 0.f, 0.f, pra, prb);
    int ft2 = 0, tt2 = 0;
    const bool have2 = tile_map(it + 1, 16, 160, 2, ft2, tt2);
    if (have2) gemm_issue0(wct + (size_t)ft2 * 128 * 1024, 1024, h2 + (size_t)tt2 * 128 * 1024, 1024, pra, prb);
    epilogue(acc, [&](int m, int n, float (&v)[16]) { st_bf16x16(sc + (size_t)(tt * 128 + n) * 2048 + ft * 128 + m, v); });
    ft = ft2; tt = tt2; have = have2;
  }
}

DI unsigned okey(float f) {
  unsigned u = __float_as_uint(f);
  return (u & 0x80000000u) ? ~u : (u | 0x80000000u);
}
DI void wave_lds_sync() {
  __builtin_amdgcn_fence(__ATOMIC_ACQ_REL, "workgroup");
  __builtin_amdgcn_wave_barrier();
}
DI unsigned okey16(unsigned b) { return (b & 0x8000u) ? (~b & 0xFFFFu) : (b | 0x8000u); }
DI unsigned inv_okey16(unsigned k) { return (k & 0x8000u) ? (k & 0x7FFFu) : (~k & 0xFFFFu); }
DI unsigned inv_okey(unsigned k) { return (k & 0x80000000u) ? (k & 0x7FFFFFFFu) : ~k; }
DI void ins16(unsigned (&L)[16], unsigned x) {
#pragma unroll
  for (int i = 0; i < 16; ++i) {
    unsigned t = max(L[i], x);
    x = min(L[i], x);
    L[i] = t;
  }
}
DI void ce_desc(unsigned& a, unsigned& b) {
  const unsigned t = max(a, b);
  b = min(a, b);
  a = t;
}
DI void sort16_desc(unsigned (&a)[16]) {
#pragma unroll
  for (int ks = 1; ks <= 4; ++ks) {
#pragma unroll
    for (int js = ks - 1; js >= 0; --js) {
#pragma unroll
      for (int i = 0; i < 16; ++i) {
        const int k = 1 << ks, j = 1 << js, l = i ^ j;
        if (l > i) {
          if ((i & k) == 0) ce_desc(a[i], a[l]);
          else ce_desc(a[l], a[i]);
        }
      }
    }
  }
}
DI void merge_top16(unsigned (&L)[16], const unsigned (&G)[16]) {
#pragma unroll
  for (int i = 0; i < 16; ++i) L[i] = max(L[i], G[15 - i]);
#pragma unroll
  for (int js = 3; js >= 0; --js) {
#pragma unroll
    for (int i = 0; i < 16; ++i) {
      const int j = 1 << js, l = i ^ j;
      if (l > i) ce_desc(L[i], L[l]);
    }
  }
}
DI unsigned byte16(const unsigned (&d)[4], int i) {
  unsigned r = 0u;
#pragma unroll
  for (int q = 0; q < 4; ++q) r |= d[q] & (0u - (unsigned)((i >> 2) == q));
  return (r >> ((i & 3) * 8)) & 0xFFu;
}
DI unsigned sel16(const unsigned (&A)[16], int i) {
  unsigned r = 0u;
#pragma unroll
  for (int t = 0; t < 16; ++t) r |= A[t] & (0u - (unsigned)(i == t));
  return r;
}
DI void phase12(const Params& p, char* smem) {
  char* ws = p.ws;
  const bf16_t* sc = (const bf16_t*)(ws + OFF_SCORES);
  int* elist = (int*)(ws + OFF_ELIST);
  float* glist = (float*)(ws + OFF_GLIST);
  const int lane = threadIdx.x & 63, w = threadIdx.x >> 6;
  for (int batch = blockIdx.x * 4 + w; batch < NTOK / 4; batch += gridDim.x * 4) {
    const int tok = batch * 4 + (lane >> 4), hh = lane & 15;
    const bf16_t* row = sc + (size_t)tok * 2048 + hh * 128;
    unsigned L[16];
#pragma unroll
    for (int grp8 = 0; grp8 < 8; ++grp8) {
      unsigned G[16];
#pragma unroll
      for (int cc = 0; cc < 2; ++cc) {
        const int c = grp8 * 2 + cc;
        u32x4 u = *(const u32x4*)(row + c * 8);
#pragma unroll
        for (int i = 0; i < 4; ++i) {
          unsigned b0 = u[i] & 0xFFFFu, b1 = u[i] >> 16;
          G[cc * 8 + 2 * i] = (okey16(b0) << 16) | (unsigned)(127 - (c * 8 + 2 * i));
          G[cc * 8 + 2 * i + 1] = (okey16(b1) << 16) | (unsigned)(127 - (c * 8 + 2 * i + 1));
        }
      }
      sort16_desc(G);
      if (grp8 == 0) {
#pragma unroll
        for (int i = 0; i < 16; ++i) L[i] = G[i];
      } else {
        merge_top16(L, G);
      }
    }
    unsigned M[16];
#pragma unroll
    for (int i = 0; i < 16; ++i) M[i] = (unsigned)__shfl_xor((int)L[i], 1);
    float v1[16], v2[16];
#pragma unroll
    for (int i = 0; i < 16; ++i) {
      v1[i] = bf2f(inv_okey16(L[i] >> 16));
      v2[i] = bf2f(inv_okey16(M[i] >> 16));
    }
    unsigned C[16];
    C[0] = ((okey(v1[0] + v2[0]) & 0xFFFFFF00u) | 255u);
    C[1] = ((okey(v1[0] + v2[1]) & 0xFFFFFF00u) | 254u);
    C[2] = ((okey(v1[0] + v2[2]) & 0xFFFFFF00u) | 253u);
    C[3] = ((okey(v1[0] + v2[3]) & 0xFFFFFF00u) | 252u);
    C[4] = ((okey(v1[0] + v2[4]) & 0xFFFFFF00u) | 251u);
    C[5] = ((okey(v1[0] + v2[5]) & 0xFFFFFF00u) | 250u);
    C[6] = ((okey(v1[0] + v2[6]) & 0xFFFFFF00u) | 249u);
    C[7] = ((okey(v1[0] + v2[7]) & 0xFFFFFF00u) | 248u);
    C[8] = ((okey(v1[0] + v2[8]) & 0xFFFFFF00u) | 247u);
    C[9] = ((okey(v1[0] + v2[9]) & 0xFFFFFF00u) | 246u);
    C[10] = ((okey(v1[0] + v2[10]) & 0xFFFFFF00u) | 245u);
    C[11] = ((okey(v1[0] + v2[11]) & 0xFFFFFF00u) | 244u);
    C[12] = ((okey(v1[0] + v2[12]) & 0xFFFFFF00u) | 243u);
    C[13] = ((okey(v1[0] + v2[13]) & 0xFFFFFF00u) | 242u);
    C[14] = ((okey(v1[0] + v2[14]) & 0xFFFFFF00u) | 241u);
    C[15] = ((okey(v1[0] + v2[15]) & 0xFFFFFF00u) | 240u);
    {
      unsigned G[16];
      G[0] = ((okey(v1[1] + v2[0]) & 0xFFFFFF00u) | 239u);
      G[1] = ((okey(v1[1] + v2[1]) & 0xFFFFFF00u) | 238u);
      G[2] = ((okey(v1[1] + v2[2]) & 0xFFFFFF00u) | 237u);
      G[3] = ((okey(v1[1] + v2[3]) & 0xFFFFFF00u) | 236u);
      G[4] = ((okey(v1[1] + v2[4]) & 0xFFFFFF00u) | 235u);
      G[5] = ((okey(v1[1] + v2[5]) & 0xFFFFFF00u) | 234u);
      G[6] = ((okey(v1[1] + v2[6]) & 0xFFFFFF00u) | 233u);
      G[7] = ((okey(v1[1] + v2[7]) & 0xFFFFFF00u) | 232u);
      G[8] = 0u;
      G[9] = 0u;
      G[10] = 0u;
      G[11] = 0u;
      G[12] = 0u;
      G[13] = 0u;
      G[14] = 0u;
      G[15] = 0u;
      merge_top16(C, G);
    }
    {
      unsigned G[16];
      G[0] = ((okey(v1[2] + v2[0]) & 0xFFFFFF00u) | 223u);
      G[1] = ((okey(v1[2] + v2[1]) & 0xFFFFFF00u) | 222u);
      G[2] = ((okey(v1[2] + v2[2]) & 0xFFFFFF00u) | 221u);
      G[3] = ((okey(v1[2] + v2[3]) & 0xFFFFFF00u) | 220u);
      G[4] = ((okey(v1[2] + v2[4]) & 0xFFFFFF00u) | 219u);
      G[5] = 0u;
      G[6] = 0u;
      G[7] = 0u;
      G[8] = 0u;
      G[9] = 0u;
      G[10] = 0u;
      G[11] = 0u;
      G[12] = 0u;
      G[13] = 0u;
      G[14] = 0u;
      G[15] = 0u;
      merge_top16(C, G);
    }
    {
      unsigned G[16];
      G[0] = ((okey(v1[3] + v2[0]) & 0xFFFFFF00u) | 207u);
      G[1] = ((okey(v1[3] + v2[1]) & 0xFFFFFF00u) | 206u);
      G[2] = ((okey(v1[3] + v2[2]) & 0xFFFFFF00u) | 205u);
      G[3] = ((okey(v1[3] + v2[3]) & 0xFFFFFF00u) | 204u);
      G[4] = 0u;
      G[5] = 0u;
      G[6] = 0u;
      G[7] = 0u;
      G[8] = 0u;
      G[9] = 0u;
      G[10] = 0u;
      G[11] = 0u;
      G[12] = 0u;
      G[13] = 0u;
      G[14] = 0u;
      G[15] = 0u;
      merge_top16(C, G);
    }
    {
      unsigned G[16];
      G[0] = ((okey(v1[4] + v2[0]) & 0xFFFFFF00u) | 191u);
      G[1] = ((okey(v1[5] + v2[0]) & 0xFFFFFF00u) | 175u);
      G[2] = ((okey(v1[6] + v2[0]) & 0xFFFFFF00u) | 159u);
      G[3] = ((okey(v1[7] + v2[0]) & 0xFFFFFF00u) | 143u);
      G[4] = ((okey(v1[8] + v2[0]) & 0xFFFFFF00u) | 127u);
      G[5] = ((okey(v1[9] + v2[0]) & 0xFFFFFF00u) | 111u);
      G[6] = ((okey(v1[10] + v2[0]) & 0xFFFFFF00u) | 95u);
      G[7] = ((okey(v1[11] + v2[0]) & 0xFFFFFF00u) | 79u);
      G[8] = ((okey(v1[12] + v2[0]) & 0xFFFFFF00u) | 63u);
      G[9] = ((okey(v1[13] + v2[0]) & 0xFFFFFF00u) | 47u);
      G[10] = ((okey(v1[14] + v2[0]) & 0xFFFFFF00u) | 31u);
      G[11] = ((okey(v1[15] + v2[0]) & 0xFFFFFF00u) | 15u);
      G[12] = 0u;
      G[13] = 0u;
      G[14] = 0u;
      G[15] = 0u;
      merge_top16(C, G);
    }
    {
      unsigned G[16];
      G[0] = ((okey(v1[4] + v2[1]) & 0xFFFFFF00u) | 190u);
      G[1] = ((okey(v1[5] + v2[1]) & 0xFFFFFF00u) | 174u);
      G[2] = ((okey(v1[6] + v2[1]) & 0xFFFFFF00u) | 158u);
      G[3] = ((okey(v1[7] + v2[1]) & 0xFFFFFF00u) | 142u);
      G[4] = 0u;
      G[5] = 0u;
      G[6] = 0u;
      G[7] = 0u;
      G[8] = 0u;
      G[9] = 0u;
      G[10] = 0u;
      G[11] = 0u;
      G[12] = 0u;
      G[13] = 0u;
      G[14] = 0u;
      G[15] = 0u;
      merge_top16(C, G);
    }
    {
      unsigned G[16];
      G[0] = ((okey(v1[4] + v2[2]) & 0xFFFFFF00u) | 189u);
      G[1] = 0u;
      G[2] = 0u;
      G[3] = 0u;
      G[4] = 0u;
      G[5] = 0u;
      G[6] = 0u;
      G[7] = 0u;
      G[8] = 0u;
      G[9] = 0u;
      G[10] = 0u;
      G[11] = 0u;
      G[12] = 0u;
      G[13] = 0u;
      G[14] = 0u;
      G[15] = 0u;
      merge_top16(C, G);
    }
    unsigned ib1[4], ib2[4];
#pragma unroll
    for (int q = 0; q < 4; ++q) {
      ib1[q] = (L[4 * q] & 0xFFu) | ((L[4 * q + 1] & 0xFFu) << 8) | ((L[4 * q + 2] & 0xFFu) << 16) | ((L[4 * q + 3] & 0xFFu) << 24);
      ib2[q] = (M[4 * q] & 0xFFu) | ((M[4 * q + 1] & 0xFFu) << 8) | ((M[4 * q + 2] & 0xFFu) << 16) | ((M[4 * q + 3] & 0xFFu) << 24);
    }
    int ev[16];
    float gv[16];
    const float mx = __uint_as_float(inv_okey(C[0] & 0xFFFFFF00u));
    float den = 0.f;
#pragma unroll
    for (int k = 0; k < 16; ++k) {
      const int ci = 255 - (int)(C[k] & 0xFFu);
      ev[k] = (127 - (int)byte16(ib1, ci >> 4)) * 128 + (127 - (int)byte16(ib2, ci & 15));
      gv[k] = __expf(__uint_as_float(inv_okey(C[k] & 0xFFFFFF00u)) - mx);
      den += gv[k];
    }
    const float inv = 1.f / den;
    if ((lane & 1) == 0) {
      int* ep = elist + (size_t)tok * 128 + (hh >> 1) * 16;
      float* gp = glist + (size_t)tok * 128 + (hh >> 1) * 16;
#pragma unroll
      for (int k = 0; k < 4; ++k) {
        *(int4*)(ep + 4 * k) = make_int4(ev[4 * k], ev[4 * k + 1], ev[4 * k + 2], ev[4 * k + 3]);
        *(float4*)(gp + 4 * k) = make_float4(gv[4 * k] * inv, gv[4 * k + 1] * inv, gv[4 * k + 2] * inv, gv[4 * k + 3] * inv);
      }
    }
  }
}
using f32x2 = __attribute__((ext_vector_type(2))) float;
DI f32x2 cvt8(unsigned w, bool hi) {
  return hi ? __builtin_amdgcn_cvt_pk_f32_fp8((int)w, true) : __builtin_amdgcn_cvt_pk_f32_fp8((int)w, false);
}
struct SMeta { int e[16]; u32x4 ha, hb; };
template <int MODE>
DI void sl_meta(const Params& p, int t, int s, int grp, int ch, SMeta& m) {
  const int ts = __builtin_amdgcn_readfirstlane(t);
  const int* elist = (const int*)(p.ws + (MODE == 0 ? OFF_ELIST : OFF_GLIST)) + (size_t)ts * 128;
#pragma unroll
  for (int i = 0; i < 16; ++i) m.e[i] = elist[(unsigned)(i * 8 + grp)];
  if (MODE == 0) {
    const bf16_t* hq = (const bf16_t*)(p.ws + OFF_H2) + (size_t)ts * DM + s * 128;
    m.ha = *(const u32x4*)(hq + (unsigned)(ch * 16));
    m.hb = *(const u32x4*)(hq + (unsigned)(ch * 16 + 8));
  }
}
template <int MODE>
DI void sl_rows(const Params& p, int s, int ch, const SMeta& m, u32x4 (&r)[16]) {
  const unsigned char* tab = (const unsigned char*)(p.ws + (MODE == 0 ? OFF_TABU : OFF_TABV)) + (size_t)s * (16384 * 128);
#pragma unroll
  for (int i = 0; i < 16; ++i) r[i] = *(const u32x4*)(tab + ((unsigned)(m.e[i] & 0xFFFF) * 128u + (unsigned)(ch * 16)));
}
template <int MODE>
DI void sl_compute(const Params& p, int t, int s, int lane, const SMeta& m, const u32x4 (&r)[16]) {
  const int grp = lane >> 3, ch = lane & 7;
  if (MODE == 0) {
    f32x2 hp[8];
#pragma unroll
    for (int i = 0; i < 4; ++i) {
      hp[i] = f32x2{bflo(m.ha[i]), bfhi(m.ha[i])};
      hp[4 + i] = f32x2{bflo(m.hb[i]), bfhi(m.hb[i])};
    }
    float v[16];
#pragma unroll
    for (int i = 0; i < 16; ++i) {
      f32x2 d2 = f32x2{0.f, 0.f};
#pragma unroll
      for (int j = 0; j < 4; ++j) {
        d2 += cvt8(r[i][j], false) * hp[2 * j];
        d2 += cvt8(r[i][j], true) * hp[2 * j + 1];
      }
      v[i] = d2[0] + d2[1];
    }
    float q8[8], q4[4], q2[2];
    {
      const bool hi = lane & 4;
#pragma unroll
      for (int i = 0; i < 8; ++i) {
        float send = hi ? v[i] : v[8 + i], keep = hi ? v[8 + i] : v[i];
        q8[i] = keep + __shfl_xor(send, 4);
      }
    }
    {
      const bool hi = lane & 2;
#pragma unroll
      for (int i = 0; i < 4; ++i) {
        float send = hi ? q8[i] : q8[4 + i], keep = hi ? q8[4 + i] : q8[i];
        q4[i] = keep + __shfl_xor(send, 2);
      }
    }
    {
      const bool hi = lane & 1;
#pragma unroll
      for (int i = 0; i < 2; ++i) {
        float send = hi ? q4[i] : q4[2 + i], keep = hi ? q4[2 + i] : q4[i];
        q2[i] = keep + __shfl_xor(send, 1);
      }
    }
    float* po = (float*)(p.ws + OFF_PD) + (size_t)t * 1024 + s * 128;
    po[(2 * ch) * 8 + grp] = q2[0];
    po[(2 * ch + 1) * 8 + grp] = q2[1];
  } else {
    f32x2 acc[8];
#pragma unroll
    for (int q = 0; q < 8; ++q) acc[q] = f32x2{0.f, 0.f};
#pragma unroll
    for (int i = 0; i < 16; ++i) {
      const float wsc = __uint_as_float((unsigned)m.e[i] & 0xFFFF0000u);
      const f32x2 w2 = f32x2{wsc, wsc};
#pragma unroll
      for (int j = 0; j < 4; ++j) {
        acc[2 * j] += w2 * cvt8(r[i][j], false);
        acc[2 * j + 1] += w2 * cvt8(r[i][j], true);
      }
    }
    float v[16];
#pragma unroll
    for (int q = 0; q < 8; ++q) { v[2 * q] = acc[q][0]; v[2 * q + 1] = acc[q][1]; }
    float q8[8], q4[4], q2[2];
    {
      const bool hi = lane & 32;
#pragma unroll
      for (int i = 0; i < 8; ++i) {
        float send = hi ? v[i] : v[8 + i], keep = hi ? v[8 + i] : v[i];
        q8[i] = keep + __shfl_xor(send, 32);
      }
    }
    {
      const bool hi = lane & 16;
#pragma unroll
      for (int i = 0; i < 4; ++i) {
        float send = hi ? q8[i] : q8[4 + i], keep = hi ? q8[4 + i] : q8[i];
        q4[i] = keep + __shfl_xor(send, 16);
      }
    }
    {
      const bool hi = lane & 8;
#pragma unroll
      for (int i = 0; i < 2; ++i) {
        float send = hi ? q4[i] : q4[2 + i], keep = hi ? q4[2 + i] : q4[i];
        q2[i] = keep + __shfl_xor(send, 8);
      }
    }
    const int f = s * 128 + ch * 16 + 2 * grp;
    float* xr = p.out + (size_t)t * DM + f;
    const float2 xv = *(const float2*)xr;
    const float2 gv = *(const float2*)((const float*)(p.ws + OFF_MOD) + modidx(t) * 6144 + 5120 + f);
    *(float2*)xr = make_float2(xv.x + gv.x * q2[0], xv.y + gv.y * q2[1]);
  }
}
template <int MODE>
DI void sliced_pass(const Params& p) {
  const int s = blockIdx.x & 7, loc = blockIdx.x >> 3, nloc = gridDim.x >> 3;
  if (loc >= nloc) return;
  const int lane = threadIdx.x & 63, w = threadIdx.x >> 6, grp = lane >> 3, ch = lane & 7;
  const int stride = nloc * 4;
  SMeta mA, mB;
  u32x4 rA[16], rB[16];
  int t = loc * 4 + w;
  if (t < NTOK) {
    sl_meta<MODE>(p, t, s, grp, ch, mA);
    sl_rows<MODE>(p, s, ch, mA, rA);
  }
  if (t + stride < NTOK) sl_meta<MODE>(p, t + stride, s, grp, ch, mB);
#pragma unroll 1
  for (; t < NTOK; t += 2 * stride) {
    const int t1 = t + stride, t2 = t + 2 * stride, t3 = t + 3 * stride;
    if (t1 < NTOK) sl_rows<MODE>(p, s, ch, mB, rB);
    sl_compute<MODE>(p, t, s, lane, mA, rA);
    if (t2 < NTOK) sl_meta<MODE>(p, t2, s, grp, ch, mA);
    if (t1 < NTOK) {
      if (t2 < NTOK) sl_rows<MODE>(p, s, ch, mA, rA);
      sl_compute<MODE>(p, t1, s, lane, mB, rB);
      if (t3 < NTOK) sl_meta<MODE>(p, t3, s, grp, ch, mB);
    }
  }
}
DI void phase13(const Params& p) { sliced_pass<0>(p); }
DI void phase14(const Params& p) {
  char* ws = p.ws;
  const float* invU = (const float*)(ws + OFF_INVU);
  const float* invV = (const float*)(ws + OFF_INVV);
  const int* elist = (const int*)(ws + OFF_ELIST);
  float* glist = (float*)(ws + OFF_GLIST);
  const float* pd = (const float*)(ws + OFF_PD);
  const int lane = threadIdx.x & 63, w = threadIdx.x >> 6;
  for (int t = blockIdx.x * 4 + w; t < NTOK; t += gridDim.x * 4) {
#pragma unroll
    for (int hf_ = 0; hf_ < 2; ++hf_) {
      const int k = hf_ * 64 + lane;
      float d = 0.f;
#pragma unroll
      for (int s = 0; s < 8; ++s) d += pd[(size_t)t * 1024 + s * 128 + k];
      const int e = elist[(size_t)t * 128 + k];
      const float g = glist[(size_t)t * 128 + k];
      ((unsigned*)glist)[(size_t)t * 128 + k] = (pack2(0.f, g * geluf_(d * invU[e]) * invV[e]) & 0xFFFF0000u) | (unsigned)e;
    }
  }
}
DI void phase15(const Params& p) { sliced_pass<1>(p); }
DI void phase16(const Params& p) {
  const int lane = threadIdx.x & 63, w = threadIdx.x >> 6;
  float4 nfv[4];
#pragma unroll
  for (int i = 0; i < 4; ++i) nfv[i] = *(const float4*)(p.norm_final + (i * 64 + lane) * 4);
  for (int tok = blockIdx.x * 4 + w; tok < NTOK; tok += gridDim.x * 4) {
    float* xr = p.out + (size_t)tok * DM;
    float4 xv[4];
    float ss = 0.f;
#pragma unroll
    for (int i = 0; i < 4; ++i) {
      xv[i] = *(const float4*)(xr + (i * 64 + lane) * 4);
      ss += xv[i].x * xv[i].x + xv[i].y * xv[i].y + xv[i].z * xv[i].z + xv[i].w * xv[i].w;
    }
    ss = wsum(ss);
    const float rstd = rsqrtf(ss * (1.f / 1024.f) + 1e-6f);
#pragma unroll
    for (int i = 0; i < 4; ++i) {
      const int e = (i * 64 + lane) * 4;
      const float4 nf = nfv[i];
      *(float4*)(xr + e) = make_float4(xv[i].x * rstd * nf.x, xv[i].y * rstd * nf.y, xv[i].z * rstd * nf.z, xv[i].w * rstd * nf.w);
    }
  }
}

#define XB_TMO      128
#define XB_XCNT(j)  (256  + 64 * (j))
#define XB_XSUB(j)  (1280 + 64 * (j))
#define XB_XGEN(j)  (2304 + 64 * (j))
#define XB_TOP      3328
#define XB_TOPGEN   3392
#define XCD_BAR_WORDS 3456
#define XB_SPIN_CAP (1u << 22)
#define LAS __attribute__((address_space(3)))
DI unsigned xb_ld(unsigned* p) { return __hip_atomic_load(p, __ATOMIC_RELAXED, __HIP_MEMORY_SCOPE_AGENT); }
DI unsigned xb_add(unsigned* p, unsigned v) { return __hip_atomic_fetch_add(p, v, __ATOMIC_RELAXED, __HIP_MEMORY_SCOPE_AGENT); }
DI unsigned xb_xcc_id() { return (unsigned)__builtin_amdgcn_s_getreg((3 << 11) | 20) & 0xFu; }
#define XB_SPIN(cond, bar) do { unsigned _sp = 0; while (cond) { __builtin_amdgcn_s_sleep(1); \
    if ((++_sp & 255u) == 0u) { if (xb_ld(&(bar)[XB_TMO])) break; if (_sp > XB_SPIN_CAP) { atomicAdd(&(bar)[XB_TMO], 1u); break; } } } } while (0)
struct XcdBarrier { unsigned* bar; unsigned x; volatile LAS unsigned* st; };
DI XcdBarrier xcd_barrier_post(unsigned* bar, volatile LAS unsigned* st) {
  XcdBarrier b; b.bar = bar; b.x = xb_xcc_id(); b.st = st;
  if (threadIdx.x == 0) (void)xb_add(&bar[XB_XCNT(b.x)], 1u);
  return b;
}
DI void xcd_barrier_complete(unsigned* bar, unsigned x, unsigned& nloc, unsigned& nx) {
  const unsigned G = gridDim.x * gridDim.y * gridDim.z;
  unsigned sum, cnt, mine, sp = 0u;
  for (;;) {
    sum = 0u; cnt = 0u; mine = 0u;
#pragma unroll
    for (unsigned j = 0; j < 16; ++j) { const unsigned c = xb_ld(&bar[XB_XCNT(j)]); sum += c; cnt += (c > 0u) ? 1u : 0u; mine = (j == x) ? c : mine; }
    if (sum == G) break;
    __builtin_amdgcn_s_sleep(1);
    if ((++sp & 255u) == 0u) { if (xb_ld(&bar[XB_TMO])) break; if (sp > XB_SPIN_CAP) { atomicAdd(&bar[XB_TMO], 1u); break; } }
  }
  nloc = mine > 0u ? mine : 1u; nx = cnt > 0u ? cnt : 1u;
}
DI void xcd_barrier(const XcdBarrier& b) {
  asm volatile("s_waitcnt vmcnt(0)" ::: "memory");
  __syncthreads();
  if (threadIdx.x == 0) {
    unsigned* bar = b.bar;
    __builtin_amdgcn_s_waitcnt(0);
    unsigned nloc = b.st[0], nx = b.st[1];
    if (nloc == 0u) { xcd_barrier_complete(bar, b.x, nloc, nx); b.st[0] = nloc; b.st[1] = nx; }
    const unsigned old = xb_add(&bar[XB_XSUB(b.x)], 1u);
    const unsigned gen = old / nloc;
    if (old + 1u == (gen + 1u) * nloc) {
      __builtin_amdgcn_fence(__ATOMIC_RELEASE, "agent");
      asm volatile("s_waitcnt vmcnt(0)" ::: "memory");
      const unsigned og = xb_add(&bar[XB_TOP], 1u);
      const unsigned tg = og / nx;
      if (og + 1u == (tg + 1u) * nx) xb_add(&bar[XB_TOPGEN], 1u);
      else XB_SPIN(xb_ld(&bar[XB_TOPGEN]) == tg, bar);
      __builtin_amdgcn_fence(__ATOMIC_ACQUIRE, "agent");
      xb_add(&bar[XB_XGEN(b.x)], 1u);
      asm volatile("s_waitcnt vmcnt(0)" ::: "memory");
    } else {
      XB_SPIN(xb_ld(&bar[XB_XGEN(b.x)]) == gen, bar);
      __builtin_amdgcn_fence(__ATOMIC_ACQUIRE, "agent");
      asm volatile("s_waitcnt vmcnt(0)" ::: "memory");
    }
  }
  __syncthreads();
}

#ifdef ONLY_PHASE
#define RUNPH(n, call) if (ONLY_PHASE == n) { call; }
#else
#ifndef DUP_PHASE
#define DUP_PHASE -1
#endif
#define RUNPH(n, call) if (lo <= n && n < hi) { call; if (n == DUP_PHASE) { xcd_barrier(xb); call; } if (n + 1 < hi) xcd_barrier(xb); }
#endif
__global__ void __launch_bounds__(256, 2) mega(Params p, int lo, int hi) {
  __shared__ __attribute__((aligned(16))) char smem[SMEM_BYTES];
  __shared__ uint4 xb_words;
  cg::grid_group grid = cg::this_grid();
  if (lo < 0) grid.sync();
  if (threadIdx.x == 0) xb_words = make_uint4(0u, 0u, 0u, 0u);
  __syncthreads();
  XcdBarrier xb = xcd_barrier_post((unsigned*)(p.ws + OFF_BAR), (volatile LAS unsigned*)&xb_words);
  RUNPH(0, phase0(p, smem))
  RUNPH(1, phase1(p, smem))
  RUNPH(2, phase2(p, smem))
  RUNPH(3, phase3(p, smem))
  RUNPH(4, phase4(p))
  RUNPH(5, phase5(p, smem))
  RUNPH(6, phase6(p, smem))
  RUNPH(7, phase7(p, smem))
  RUNPH(8, phase8(p, smem))
  RUNPH(9, phase9(p, smem))
  RUNPH(10, phase10(p, smem))
  RUNPH(11, phase11(p, smem))
  RUNPH(12, phase12(p, smem))
  RUNPH(13, phase13(p))
  RUNPH(14, phase14(p))
  RUNPH(15, phase15(p))
  RUNPH(16, phase16(p))
}

extern "C" void kernel_launch(void* const* d_in, const int* in_sizes, int n_in, void* d_out, int out_size, void* d_ws,
                              size_t ws_size, hipStream_t stream) {
  static int grid_blocks = 0;
  if (!grid_blocks) {
    int dev = 0, cus = 0, per_cu = 0;
    hipGetDevice(&dev);
    hipDeviceGetAttribute(&cus, hipDeviceAttributeMultiprocessorCount, dev);
    hipOccupancyMaxActiveBlocksPerMultiprocessor(&per_cu, mega, 256, 0);
    if (per_cu > 2) per_cu = 2;
    if (per_cu < 1) per_cu = 1;
    grid_blocks = cus * per_cu;
  }
  Params p{};
  const float** pp = (const float**)&p;
  for (int i = 0; i < 29; ++i) pp[i] = (const float*)d_in[i];
  p.out = (float*)d_out;
  p.ws = (char*)d_ws;
#if N_LAUNCH_SPLIT
  for (int ph = 0; ph < NPHASE; ++ph) {
    hipLaunchKernelGGL(mega, dim3(grid_blocks), dim3(256), 0, stream, p, ph, ph + 1);
  }
#else
  hipMemsetAsync((char*)d_ws + OFF_MOD, 0, (OFF_BAR - OFF_MOD) + XCD_BAR_WORDS * sizeof(unsigned), stream);
  int lo = 0, hi = NPHASE;
  void* args[] = {&p, &lo, &hi};
  hipError_t e = hipLaunchCooperativeKernel((void*)mega, dim3(grid_blocks), dim3(256), args, 0, stream);
  if (e != hipSuccess) fprintf(stderr, "cooperative launch failed: %s (grid %d)\n", hipGetErrorString(e), grid_blocks);
#endif
}
```
